# Optimizing an MI355X kernel written in HIP

```python
import math
import jax
import jax.numpy as jnp
from jax import lax
import numpy as np

D_MODEL = 2048
BATCH = 2
SEQ = 4096
DEPTH = 2

N_MEM = 256
MIX_A = D_MODEL // 4
MIX_B = D_MODEL // 4
MIX_C = D_MODEL // 4
MIX_D = D_MODEL - MIX_A - MIX_B - MIX_C
MIX_WIDTH = MIX_A + MIX_B + MIX_C + MIX_D

A_HEADS = 4
A_VDIM = MIX_A // A_HEADS
A_QKDIM = A_VDIM // 2
B_HDIM = 64
B_HEADS = MIX_B // B_HDIM
B_DECAY_LORA = 64
B_AAA_LORA = 64
B_GATE_LORA = 128
LN_X_EPS = 64e-5
C_HEADS = 4
C_HDIM = MIX_C // C_HEADS
C_PATTERNS = ((128, 1), (512, 4), (2048, 16))
D_GSIZE = 16
D_GROUPS = MIX_D // D_GSIZE
D_STATE = 64

IN_A = 3 * MIX_A
IN_B = 3 * MIX_B + 2 * B_DECAY_LORA + 2 * B_AAA_LORA + B_GATE_LORA
IN_C = 3 * MIX_C
IN_D = MIX_D
IN_TOTAL = IN_A + IN_B + IN_C + IN_D

XA_HEADS = 4
XA_HDIM = D_MODEL // XA_HEADS

N_GROUPS = 4
EXPERTS_PER_GROUP = 8
N_EXPERTS = N_GROUPS * EXPERTS_PER_GROUP
TOP_K = 2
D_EXPERT = D_MODEL // 4
MOE_BLOCK = 128

ROPE_THETA = 10000.0
Q_BLOCK = 128
RMS_EPS = 1e-6
NEG_INF = -1e30

kernel_name = 'hybrid_parallel_heads_encoder'

F32 = jnp.float32


def rms_norm(x, g, eps=RMS_EPS):
    xf = x.astype(F32)
    y = xf * lax.rsqrt(jnp.mean(xf * xf, axis=-1, keepdims=True) + eps)
    return (y * g.astype(F32)).astype(x.dtype)


def rope_tables(seq, dim):
    inv = 1.0 / (ROPE_THETA ** (jnp.arange(0, dim, 2, dtype=F32) / dim))
    ang = jnp.arange(seq, dtype=F32)[:, None] * inv[None, :]
    return jnp.cos(ang), jnp.sin(ang)


def apply_rope(x, cos, sin):
    xf = x.astype(F32)
    x1, x2 = jnp.split(xf, 2, axis=-1)
    return jnp.concatenate([x1 * cos - x2 * sin, x2 * cos + x1 * sin], axis=-1).astype(x.dtype)


def diff_attention(z, lam_vecs, subln_g, layer_idx):
    b, s, _ = z.shape
    q, k, v = jnp.split(z, 3, axis=-1)
    q = q.reshape(b, s, A_HEADS, 2, A_QKDIM).transpose(0, 2, 3, 1, 4)
    k = k.reshape(b, s, A_HEADS, 2, A_QKDIM).transpose(0, 2, 3, 1, 4)
    v = v.reshape(b, s, A_HEADS, A_VDIM).transpose(0, 2, 1, 3)
    cos, sin = rope_tables(s, A_QKDIM)
    q = apply_rope(q, cos, sin)
    k = apply_rope(k, cos, sin)
    lam_init = 0.8 - 0.6 * math.exp(-0.3 * layer_idx)
    lf = lam_vecs.astype(F32)
    lam = jnp.exp(jnp.sum(lf[0] * lf[1])) - jnp.exp(jnp.sum(lf[2] * lf[3])) + lam_init
    scale = A_QKDIM ** -0.5
    nb = s // Q_BLOCK
    qb = q.reshape(b, A_HEADS, 2, nb, Q_BLOCK, A_QKDIM).transpose(3, 0, 1, 2, 4, 5)

    def block(qi):
        sc = jnp.einsum('bhcqd,bhckd->bhcqk', qi, k).astype(F32) * scale
        p = jax.nn.softmax(sc, axis=-1)
        attn = p[:, :, 0] - lam * p[:, :, 1]
        return jnp.einsum('bhqk,bhkd->bhqd', attn.astype(v.dtype), v)

    o = lax.map(block, qb)
    o = o.transpose(1, 0, 3, 2, 4).reshape(b, s, A_HEADS, A_VDIM)
    o = rms_norm(o.astype(F32), subln_g) * (1.0 - lam_init)
    return o.reshape(b, s, MIX_A)


def token_shift_centred(z, mu):
    zp = jnp.pad(z, ((0, 0), (1, 0), (0, 0)))[:, :-1]
    zn = jnp.pad(z, ((0, 0), (0, 1), (0, 0)))[:, 1:]
    return z + mu[0] * (zp - z) + mu[1] * (zn - z)


def rwkv7_bidir(z, mu, w0, w2, a0, a2, g2, k_k, k_a, r_k, lnx_w, lnx_b):
    b, s, _ = z.shape
    z = token_shift_centred(z.astype(F32), mu.astype(F32))
    cuts = [MIX_B, 2 * MIX_B, 3 * MIX_B, 3 * MIX_B + 2 * B_DECAY_LORA,
            3 * MIX_B + 2 * B_DECAY_LORA + 2 * B_AAA_LORA]
    r, k, v, wd, ad, gd = jnp.split(z, cuts, axis=-1)
    wd = wd.reshape(b, s, 2, B_DECAY_LORA)
    ad = ad.reshape(b, s, 2, B_AAA_LORA)
    logw = -jax.nn.softplus(-(w0 + jnp.einsum('bsdr,drc->bsdc', jnp.tanh(wd), w2))) - 0.5
    decay = jnp.exp(-jnp.exp(logw))
    a = jax.nn.sigmoid(a0 + jnp.einsum('bsdr,drc->bsdc', ad, a2))
    g = jax.nn.sigmoid(gd) @ g2

    def heads(t):
        return t.reshape(t.shape[:-1] + (B_HEADS, B_HDIM))

    kk = heads(k * k_k)
    kk = kk * lax.rsqrt(jnp.sum(kk * kk, axis=-1, keepdims=True) + 1e-12)
    kmod = k[:, :, None, :] * (1.0 + (a - 1.0) * k_a)
    r_h, v_h = heads(r), heads(v)
    a_h, w_h, k_h = heads(a), heads(decay), heads(kmod)

    def dirs(t):
        t = jnp.broadcast_to(t, (b, s, 2, B_HEADS, B_HDIM))
        t = jnp.stack([t[:, :, 0], jnp.flip(t[:, :, 1], axis=1)], axis=0)
        return jnp.moveaxis(t, 2, 0)

    xs = (dirs(r_h[:, :, None]), dirs(w_h), dirs(k_h), dirs(v_h[:, :, None]),
          dirs(-kk[:, :, None]), dirs(kk[:, :, None] * a_h))

    def step(state, inp):
        rt, wt, kt, vt, at, bt = inp
        sa = jnp.einsum('dbhij,dbhj->dbhi', state, at)
        state = state * wt[..., None, :] + sa[..., :, None] * bt[..., None, :] + vt[..., :, None] * kt[..., None, :]
        return state, jnp.einsum('dbhij,dbhj->dbhi', state, rt)

    s0 = jnp.zeros((2, b, B_HEADS, B_HDIM, B_HDIM), F32)
    _, ys = lax.scan(step, s0, xs)
    y = jnp.moveaxis(ys[:, 0] + jnp.flip(ys[:, 1], axis=0), 0, 1)
    mean = jnp.mean(y, axis=-1, keepdims=True)
    var = jnp.mean(jnp.square(y - mean), axis=-1, keepdims=True)
    y = ((y - mean) * lax.rsqrt(var + LN_X_EPS)).reshape(b, s, MIX_B) * lnx_w + lnx_b
    k_bonus = heads(0.5 * (kmod[:, :, 0] + kmod[:, :, 1]))
    bonus = jnp.sum(r_h * k_bonus * r_k, axis=-1, keepdims=True) * v_h
    return (y + bonus.reshape(b, s, MIX_B)) * g


def dilated_attention(z):
    b, s, _ = z.shape
    q, k, v = jnp.split(z, 3, axis=-1)
    q = q.reshape(b, s, C_HEADS, C_HDIM).transpose(0, 2, 1, 3)
    k = k.reshape(b, s, C_HEADS, C_HDIM).transpose(0, 2, 1, 3)
    v = v.reshape(b, s, C_HEADS, C_HDIM).transpose(0, 2, 1, 3)
    cos, sin = rope_tables(s, C_HDIM)
    q = apply_rope(q, cos, sin)
    k = apply_rope(k, cos, sin)
    offs = jnp.asarray(np.stack([np.arange(-(w // (2 * d)), w // (2 * d) + 1) * d
                                 for w, d in C_PATTERNS]), jnp.int32)
    scale = C_HDIM ** -0.5
    nb = s // Q_BLOCK
    qb = q.reshape(b, C_HEADS, nb, Q_BLOCK, C_HDIM).transpose(2, 0, 1, 3, 4)
    starts = jnp.arange(nb, dtype=jnp.int32) * Q_BLOCK

    def block(args):
        qi, st = args
        pos = st + jnp.arange(Q_BLOCK, dtype=jnp.int32)
        idx = pos[None, :, None] + offs[:, None, :]
        valid = (idx >= 0) & (idx < s)
        idx = jnp.clip(idx, 0, s - 1)
        kg = k[:, :, idx]
        vg = v[:, :, idx]
        sc = jnp.einsum('bhqd,bhpqkd->bhpqk', qi, kg).astype(F32) * scale
        sc = jnp.where(valid, sc, NEG_INF)
        m = jnp.max(sc, axis=-1, keepdims=True)
        e = jnp.exp(sc - m)
        den = jnp.sum(e, axis=-1, keepdims=True)
        o = jnp.einsum('bhpqk,bhpqkd->bhpqd', (e / den).astype(v.dtype), vg).astype(F32)
        lse = (m + jnp.log(den))[..., 0]
        wgt = jax.nn.softmax(lse, axis=2)
        return jnp.einsum('bhpq,bhpqd->bhqd', wgt, o)

    o = lax.map(block, (qb, starts))
    return o.transpose(1, 0, 3, 2, 4).reshape(b, s, MIX_C)


def cmul(ar, ai, br, bi):
    return ar * br - ai * bi, ar * bi + ai * br


def s5_combine(e1, e2):
    a1r, a1i, x1r, x1i = e1
    a2r, a2i, x2r, x2i = e2
    ar, ai = cmul(a2r, a2i, a1r, a1i)
    xr, xi = cmul(a2r, a2i, x1r, x1i)
    return ar, ai, xr + x2r, xi + x2i


def s5_bidir(u, a_re, a_im, log_dt, b_re, b_im, c_re, c_im, d_skip, glu_w, glu_b):
    b, s, _ = u.shape
    uf = u.astype(F32)
    ug = uf.reshape(b, s, D_GROUPS, D_GSIZE)
    b_re, b_im = b_re.astype(F32), b_im.astype(F32)
    x_re = jnp.zeros((b, s, D_GROUPS, D_STATE), F32)
    x_im = jnp.zeros((b, s, D_GROUPS, D_STATE), F32)
    for direction in range(2):
        lr = jnp.minimum(a_re[direction].astype(F32), -1e-4)
        li = a_im[direction].astype(F32)
        dt = jnp.exp(log_dt[direction].astype(F32))[:, None]
        mag = jnp.exp(dt * lr)
        abr, abi = mag * jnp.cos(dt * li), mag * jnp.sin(dt * li)
        den = lr * lr + li * li
        fr, fi = cmul(abr - 1.0, abi, lr / den, -li / den)
        bbr, bbi = cmul(fr[..., None], fi[..., None], b_re, b_im)
        bur = jnp.einsum('gnc,bsgc->bsgn', bbr, ug)
        bui = jnp.einsum('gnc,bsgc->bsgn', bbi, ug)
        ar = jnp.broadcast_to(abr, bur.shape)
        ai = jnp.broadcast_to(abi, bur.shape)
        _, _, xr, xi = lax.associative_scan(s5_combine, (ar, ai, bur, bui),
                                            reverse=(direction == 1), axis=1)
        x_re = x_re + xr
        x_im = x_im + xi
    y = (jnp.einsum('gcn,bsgn->bsgc', c_re.astype(F32), x_re)
         - jnp.einsum('gcn,bsgn->bsgc', c_im.astype(F32), x_im))
    y = y.reshape(b, s, MIX_D) + d_skip * uf
    gl = jax.nn.gelu(y)
    return gl * jax.nn.sigmoid(gl @ glu_w + glu_b)


def cross_attention(h, memn, wq, wkv, wo):
    b, s, _ = h.shape
    m = memn.shape[1]
    q = (h @ wq).reshape(b, s, XA_HEADS, XA_HDIM)
    k, v = jnp.split(memn @ wkv, 2, axis=-1)
    k = k.reshape(b, m, XA_HEADS, XA_HDIM)
    v = v.reshape(b, m, XA_HEADS, XA_HDIM)
    sc = jnp.einsum('bshd,bmhd->bhsm', q, k).astype(F32) * (XA_HDIM ** -0.5)
    p = jax.nn.softmax(sc, axis=-1)
    o = jnp.einsum('bhsm,bmhd->bshd', p.astype(v.dtype), v).reshape(b, s, D_MODEL)
    return o @ wo


def hier_moe(h, wr_group, wr_expert, w1, w3, w2):
    b, s, d = h.shape
    t = b * s
    xt = h.reshape(t, d)
    gp = jax.nn.softmax((xt @ wr_group).astype(F32), axis=-1)
    g_idx = jnp.argmax(gp, axis=-1)
    g_w = jnp.take_along_axis(gp, g_idx[:, None], axis=-1)
    el = (xt @ wr_expert).astype(F32).reshape(t, N_GROUPS, EXPERTS_PER_GROUP)
    el = jnp.take_along_axis(el, g_idx[:, None, None], axis=1)[:, 0]
    ep = jax.nn.softmax(el, axis=-1)
    top_w, top_i = lax.top_k(ep, TOP_K)
    top_w = top_w / jnp.sum(top_w, axis=-1, keepdims=True)
    eid = (g_idx[:, None] * EXPERTS_PER_GROUP + top_i).reshape(-1).astype(jnp.int32)
    gate = (g_w * top_w).reshape(-1)
    tok = jnp.repeat(jnp.arange(t, dtype=jnp.int32), TOP_K)
    n_assign = t * TOP_K
    order = jnp.argsort(eid)
    se = eid[order]
    counts = jnp.bincount(eid, length=N_EXPERTS)
    padded = ((counts + MOE_BLOCK - 1) // MOE_BLOCK) * MOE_BLOCK
    pad_end = jnp.cumsum(padded)
    pad_start = pad_end - padded
    start = jnp.cumsum(counts) - counts
    dest = pad_start[se] + (jnp.arange(n_assign, dtype=jnp.int32) - start[se])
    cap = n_assign + N_EXPERTS * MOE_BLOCK
    nb = cap // MOE_BLOCK
    slot_tok = jnp.zeros((cap,), jnp.int32).at[dest].set(tok[order])
    slot_gate = jnp.zeros((cap,), F32).at[dest].set(gate[order])
    blk_exp = jnp.minimum(jnp.searchsorted(pad_end, jnp.arange(nb) * MOE_BLOCK, side='right'),
                          N_EXPERTS - 1)
    xs = xt[slot_tok].reshape(nb, MOE_BLOCK, d)

    def run(args):
        xb, e = args
        return (jax.nn.silu(xb @ w1[e]) * (xb @ w3[e])) @ w2[e]

    ys = lax.map(run, (xs, blk_exp)).reshape(cap, d)
    out = jnp.zeros((t, d), F32).at[slot_tok].add(ys.astype(F32) * slot_gate[:, None])
    return out.reshape(b, s, d).astype(h.dtype)


def setup_inputs(seed: int = 0) -> dict:
    key = jax.random.key(seed)
    keys = jax.random.split(key, 64)
    counter = [0]

    def nxt():
        counter[0] += 1
        return keys[counter[0] - 1]

    def nrm(shape, scale):
        return jax.random.normal(nxt(), shape, F32) * scale

    def unif(shape, lo, hi):
        return jax.random.uniform(nxt(), shape, F32, lo, hi)

    def gain(shape):
        return 1.0 + nrm(shape, 0.05)

    L, D = DEPTH, D_MODEL
    state_n = jnp.arange(D_STATE, dtype=F32)
    return {
        'x': nrm((BATCH, SEQ, D), 1.0),
        'mem': nrm((BATCH, N_MEM, D), 1.0),
        'norm_mix': gain((L, D)),
        'w_in': nrm((L, D, IN_TOTAL), D ** -0.5),
        'w_out': nrm((L, MIX_WIDTH, D), MIX_WIDTH ** -0.5),
        'diff_lambda': nrm((L, 4, A_QKDIM), 0.1),
        'diff_subln': gain((L, A_VDIM)),
        'rwkv_mu': unif((L, 2, IN_B), 0.0, 0.5),
        'rwkv_w0': unif((L, 2, MIX_B), -6.0, -1.0),
        'rwkv_w2': nrm((L, 2, B_DECAY_LORA, MIX_B), 0.1),
        'rwkv_a0': nrm((L, 2, MIX_B), 0.1),
        'rwkv_a2': nrm((L, 2, B_AAA_LORA, MIX_B), 0.1),
        'rwkv_g2': nrm((L, B_GATE_LORA, MIX_B), B_GATE_LORA ** -0.5),
        'rwkv_kk': 0.85 + nrm((L, MIX_B), 0.05),
        'rwkv_ka': gain((L, MIX_B)),
        'rwkv_rk': nrm((L, B_HEADS, B_HDIM), 0.1),
        'rwkv_lnx_w': gain((L, MIX_B)),
        'rwkv_lnx_b': nrm((L, MIX_B), 0.01),
        's5_a_re': -0.5 + nrm((L, 2, D_GROUPS, D_STATE), 0.02),
        's5_a_im': math.pi * state_n + nrm((L, 2, D_GROUPS, D_STATE), 0.02),
        's5_log_dt': unif((L, 2, D_GROUPS), math.log(0.001), math.log(0.1)),
        's5_b_re': nrm((L, D_GROUPS, D_STATE, D_GSIZE), (2 * D_GSIZE) ** -0.5),
        's5_b_im': nrm((L, D_GROUPS, D_STATE, D_GSIZE), (2 * D_GSIZE) ** -0.5),
        's5_c_re': nrm((L, D_GROUPS, D_GSIZE, D_STATE), (2 * D_STATE) ** -0.5),
        's5_c_im': nrm((L, D_GROUPS, D_GSIZE, D_STATE), (2 * D_STATE) ** -0.5),
        's5_d': nrm((L, MIX_D), 1.0),
        's5_glu_w': nrm((L, MIX_D, MIX_D), MIX_D ** -0.5),
        's5_glu_b': nrm((L, MIX_D), 0.01),
        'mix_out_norm': gain((L, 2, MIX_C)),
        'norm_cross': gain((L, D)),
        'norm_mem': gain((L, D)),
        'xa_wq': nrm((L, D, D), D ** -0.5),
        'xa_wkv': nrm((L, D, 2 * D), D ** -0.5),
        'xa_wo': nrm((L, D, D), D ** -0.5),
        'norm_moe': gain((L, D)),
        'router_group': nrm((L, D, N_GROUPS), D ** -0.5),
        'router_expert': nrm((L, D, N_EXPERTS), D ** -0.5),
        'moe_w1': nrm((L, N_EXPERTS, D, D_EXPERT), D ** -0.5),
        'moe_w3': nrm((L, N_EXPERTS, D, D_EXPERT), D ** -0.5),
        'moe_w2': nrm((L, N_EXPERTS, D_EXPERT, D), D_EXPERT ** -0.5),
        'norm_final': gain((D,)),
    }


def reference(x, mem, norm_mix, w_in, w_out, diff_lambda, diff_subln, rwkv_mu, rwkv_w0, rwkv_w2,
              rwkv_a0, rwkv_a2, rwkv_g2, rwkv_kk, rwkv_ka, rwkv_rk, rwkv_lnx_w, rwkv_lnx_b,
              s5_a_re, s5_a_im, s5_log_dt, s5_b_re, s5_b_im, s5_c_re, s5_c_im, s5_d, s5_glu_w,
              s5_glu_b, mix_out_norm, norm_cross, norm_mem, xa_wq, xa_wkv, xa_wo, norm_moe,
              router_group, router_expert, moe_w1, moe_w3, moe_w2, norm_final):
    h = x
    for l in range(DEPTH):
        z = rms_norm(h, norm_mix[l]) @ w_in[l]
        za, zb, zc, zd = jnp.split(z, [IN_A, IN_A + IN_B, IN_A + IN_B + IN_C], axis=-1)
        oa = diff_attention(za, diff_lambda[l], diff_subln[l], l)
        ob = rwkv7_bidir(zb, rwkv_mu[l], rwkv_w0[l], rwkv_w2[l], rwkv_a0[l], rwkv_a2[l], rwkv_g2[l],
                         rwkv_kk[l], rwkv_ka[l], rwkv_rk[l], rwkv_lnx_w[l], rwkv_lnx_b[l])
        oc = rms_norm(dilated_attention(zc).astype(F32), mix_out_norm[l, 0])
        od = rms_norm(s5_bidir(zd, s5_a_re[l], s5_a_im[l], s5_log_dt[l], s5_b_re[l], s5_b_im[l],
                               s5_c_re[l], s5_c_im[l], s5_d[l], s5_glu_w[l], s5_glu_b[l]),
                      mix_out_norm[l, 1])
        mix = jnp.concatenate([oa, ob, oc, od], axis=-1).astype(h.dtype)
        h = h + mix @ w_out[l]
        h = h + cross_attention(rms_norm(h, norm_cross[l]), rms_norm(mem, norm_mem[l]),
                                xa_wq[l], xa_wkv[l], xa_wo[l])
        h = h + hier_moe(rms_norm(h, norm_moe[l]), router_group[l], router_expert[l],
                         moe_w1[l], moe_w3[l], moe_w2[l])
    return rms_norm(h, norm_final)
```

```cpp
#include <hip/hip_runtime.h>
#include <cstdio>
#include <cstdint>
#include <cstring>

#define GAS __attribute__((address_space(1)))
#define LAS __attribute__((address_space(3)))
typedef unsigned short bf16;
typedef short bf16x8 __attribute__((ext_vector_type(8)));
typedef short s16x4 __attribute__((ext_vector_type(4)));
typedef float f32x2 __attribute__((ext_vector_type(2)));
typedef float f32x4 __attribute__((ext_vector_type(4)));
typedef float f32x16 __attribute__((ext_vector_type(16)));
typedef unsigned u32x2 __attribute__((ext_vector_type(2)));
typedef unsigned u32x4 __attribute__((ext_vector_type(4)));
typedef GAS unsigned gu32;

constexpr int DM = 2048, BATCH = 2, SEQ = 4096, NTOK = BATCH * SEQ, DEPTH = 2, NMEM = 256;
constexpr int IN_A = 1536, IN_B = 1920, IN_C = 1536, IN_D = 512, IN_TOTAL = 5504, ZLD = 5632;
constexpr int ZA = 0, ZB = 1536, ZC = 3456, ZD = 4992;
constexpr int NEXP = 32, DEXP = 512, ECAP = 8192;
constexpr int SLOT_CAP = 24576;
constexpr int S5CH = 16, S5NCH = SEQ / S5CH;
constexpr float RMS_EPS = 1e-6f;

enum { I_X = 0, I_MEM, I_NORM_MIX, I_W_IN, I_W_OUT, I_DIFF_LAMBDA, I_DIFF_SUBLN, I_RWKV_MU, I_RWKV_W0, I_RWKV_W2, I_RWKV_A0, I_RWKV_A2, I_RWKV_G2,
       I_RWKV_KK, I_RWKV_KA, I_RWKV_RK, I_RWKV_LNX_W, I_RWKV_LNX_B, I_S5_A_RE, I_S5_A_IM, I_S5_LOG_DT, I_S5_B_RE, I_S5_B_IM, I_S5_C_RE, I_S5_C_IM,
       I_S5_D, I_S5_GLU_W, I_S5_GLU_B, I_MIX_OUT_NORM, I_NORM_CROSS, I_NORM_MEM, I_XA_WQ, I_XA_WKV, I_XA_WO, I_NORM_MOE, I_ROUTER_GROUP,
       I_ROUTER_EXPERT, I_MOE_W1, I_MOE_W3, I_MOE_W2, I_NORM_FINAL, N_INPUTS };

constexpr size_t al256(size_t x) { return (x + 255) / 256 * 256; }
constexpr size_t WS_CTL = 0, CTL_BYTES = 1u << 20;
constexpr size_t WS_WIN  = WS_CTL + CTL_BYTES;
constexpr size_t WS_WOUT = WS_WIN + (size_t)DEPTH * ZLD * DM * 2;
constexpr size_t WS_WQK  = WS_WOUT + (size_t)DEPTH * DM * DM * 2;
constexpr size_t WS_VWO  = WS_WQK + (size_t)DEPTH * BATCH * 1024 * DM * 2;
constexpr size_t WS_W13  = WS_VWO + (size_t)DEPTH * BATCH * DM * 1024 * 2;
constexpr size_t WS_W2   = WS_W13 + (size_t)DEPTH * NEXP * 1024 * DM * 2;
constexpr size_t WS_ROPE = WS_W2 + (size_t)DEPTH * NEXP * DM * DEXP * 2;
constexpr size_t WS_S5P  = WS_ROPE + (size_t)SEQ * (32 + 32 + 64 + 64) * 4;
constexpr size_t S5P_LAYER = (size_t)(2 * 32 * 64 * 2 + 2 * 32 * 64 * 16 * 2) * 4;
constexpr size_t WS_H    = al256(WS_S5P + DEPTH * S5P_LAYER);
constexpr size_t WS_HN   = WS_H + (size_t)NTOK * DM * 4;
constexpr size_t WS_MIX  = WS_HN + (size_t)NTOK * DM * 2;
constexpr size_t WS_P    = WS_MIX + (size_t)NTOK * DM * 2;
constexpr size_t WS_ETOK = WS_P + (size_t)NTOK * 1024 * 2;
constexpr size_t WS_EGATE= WS_ETOK + (size_t)NEXP * ECAP * 4;
constexpr size_t WS_TINFO= WS_EGATE + (size_t)NEXP * ECAP * 4;
constexpr size_t WS_SCR  = al256(WS_TINFO + (size_t)NTOK * 16);
constexpr size_t SC_WKVT = WS_SCR;
constexpr size_t SC_MEMN = SC_WKVT + (size_t)DEPTH * 4096 * DM * 2;
constexpr size_t SC_KVB  = SC_MEMN + (size_t)DEPTH * 512 * DM * 2;
constexpr size_t SC_WQB  = SC_KVB + (size_t)DEPTH * 512 * 4096 * 2;
constexpr size_t SC_WOT  = SC_WQB + (size_t)DEPTH * DM * DM * 2;
constexpr size_t SC_PRO_END = SC_WOT + (size_t)DEPTH * DM * DM * 2;
constexpr size_t SC_Z    = WS_SCR;
constexpr size_t SC_RW   = SC_Z + (size_t)NTOK * ZLD * 2;
constexpr size_t RWSZ    = (size_t)NTOK * 512 * 4;
constexpr size_t SC_YS   = SC_RW + 10 * RWSZ;
constexpr size_t SC_OC   = SC_YS + 2 * RWSZ;
constexpr size_t SC_LSE  = SC_OC + 3 * RWSZ;
constexpr size_t SC_CARRY= SC_LSE + (size_t)3 * NTOK * 4 * 4;
constexpr size_t SC_MIX_END = SC_CARRY + (size_t)2 * BATCH * S5NCH * 32 * 64 * 2 * 4;
constexpr size_t SC_HMID = WS_SCR;
constexpr size_t SC_YBUF = SC_HMID + (size_t)SLOT_CAP * DEXP * 2;
constexpr size_t SC_MOE_END = SC_YBUF + (size_t)SLOT_CAP * DM * 2;
constexpr size_t cmax(size_t a, size_t b) { return a > b ? a : b; }
constexpr size_t WS_END = cmax(cmax(SC_PRO_END, SC_MIX_END), SC_MOE_END);

constexpr int CW_BAR = 4096;
constexpr int CW_Q = 8192;
constexpr int CW_CNT = 16384;

constexpr int RING_BYTES = 131072;
constexpr int MISC_OFF = RING_BYTES;
constexpr int LDS_BYTES = 147456;

__device__ __forceinline__ float bf2f(unsigned short b) { return __uint_as_float(((unsigned)b) << 16); }
__device__ __forceinline__ unsigned pk2(float lo, float hi) { unsigned r; asm volatile("v_cvt_pk_bf16_f32 %0, %1, %2" : "=v"(r) : "v"(lo), "v"(hi)); return r; }
__device__ __forceinline__ bf16 f2bf(float f) { return (bf16)(pk2(f, 0.f) & 0xffffu); }
__device__ __forceinline__ float wave_sum(float v) {
#pragma unroll
    for (int o = 1; o < 64; o <<= 1) v += __shfl_xor(v, o);
    return v;
}
__device__ __forceinline__ float wave_max(float v) {
#pragma unroll
    for (int o = 1; o < 64; o <<= 1) v = fmaxf(v, __shfl_xor(v, o));
    return v;
}
__device__ __forceinline__ float sigmoidf_(float x) { return 1.f / (1.f + __expf(-x)); }
#define LDS_WAIT() asm volatile("s_waitcnt lgkmcnt(0)" ::: "memory")
#define VM_WAIT() asm volatile("s_waitcnt vmcnt(0)" ::: "memory")

__device__ __forceinline__ int tid_from_wave(int wave) { int t = wave * 64 + (int)__builtin_amdgcn_mbcnt_hi(~0u, __builtin_amdgcn_mbcnt_lo(~0u, 0u)); asm volatile("" : "+v"(t)); return t; }
#define XB_TMO      128
#define XB_XCNT(j)  (256  + 64 * (j))
#define XB_XSUB(j)  (1280 + 64 * (j))
#define XB_XGEN(j)  (2304 + 64 * (j))
#define XB_TOP      3328
#define XB_TOPGEN   3392
#define XCD_BAR_WORDS 3456
#define XB_SPIN_CAP (1u << 18)

__device__ __forceinline__ unsigned xb_ld(unsigned* p)              { return __hip_atomic_load(p, __ATOMIC_RELAXED, __HIP_MEMORY_SCOPE_AGENT); }
__device__ __forceinline__ unsigned xb_add(unsigned* p, unsigned v) { return __hip_atomic_fetch_add(p, v, __ATOMIC_RELAXED, __HIP_MEMORY_SCOPE_AGENT); }
__device__ __forceinline__ unsigned xb_xcc_id() { return (unsigned)__builtin_amdgcn_s_getreg((3 << 11) | 20) & 0xFu; }
#define XB_SPIN(cond, bar) do { unsigned _sp = 0; while (cond) { __builtin_amdgcn_s_sleep(1); \
    if ((++_sp & 255u) == 0u) { if (xb_ld(&(bar)[XB_TMO])) break; if (_sp > XB_SPIN_CAP) { atomicAdd(&(bar)[XB_TMO], 1u); break; } } } } while (0)

struct XcdBarrier {
    unsigned* bar; unsigned x;
    volatile LAS unsigned* st;
};

__device__ __forceinline__ XcdBarrier xcd_barrier_post(unsigned* bar, volatile LAS unsigned* st) {
    XcdBarrier b; b.bar = bar; b.x = xb_xcc_id(); b.st = st;
    if (threadIdx.x == 0) (void)xb_add(&bar[XB_XCNT(b.x)], 1u);
    return b;
}
__device__ __forceinline__ void xcd_barrier_complete(unsigned* bar, unsigned x, unsigned& nloc, unsigned& nx) {
    const unsigned G = gridDim.x * gridDim.y * gridDim.z;
    unsigned sum, cnt, mine, sp = 0u;
    for (;;) {
        sum = 0u; cnt = 0u; mine = 0u;
#pragma unroll
        for (unsigned j = 0; j < 16; ++j) { const unsigned c = xb_ld(&bar[XB_XCNT(j)]); sum += c; cnt += (c > 0u) ? 1u : 0u; mine = (j == x) ? c : mine; }
        if (sum == G) break;
        __builtin_amdgcn_s_sleep(1);
        if ((++sp & 255u) == 0u) { if (xb_ld(&bar[XB_TMO])) break; if (sp > XB_SPIN_CAP) { atomicAdd(&bar[XB_TMO], 1u); break; } }
    }
    nloc = mine > 0u ? mine : 1u; nx = cnt > 0u ? cnt : 1u;
}

__device__ __forceinline__ void xcd_barrier(const XcdBarrier& b) {
    asm volatile("s_waitcnt vmcnt(0)" ::: "memory");
    __syncthreads();
    if (threadIdx.x == 0) {
        unsigned* bar = b.bar;
        __builtin_amdgcn_s_waitcnt(0);
        unsigned nloc = b.st[0], nx = b.st[1];
        if (nloc == 0u) { xcd_barrier_complete(bar, b.x, nloc, nx); b.st[0] = nloc; b.st[1] = nx; }
        const unsigned old = xb_add(&bar[XB_XSUB(b.x)], 1u);
        const unsigned gen = old / nloc;
        if (old + 1u == (gen + 1u) * nloc) {
            __builtin_amdgcn_fence(__ATOMIC_RELEASE, "agent");
            asm volatile("s_waitcnt vmcnt(0)" ::: "memory");
            const unsigned og = xb_add(&bar[XB_TOP], 1u);
            const unsigned tg = og / nx;
            if (og + 1u == (tg + 1u) * nx) xb_add(&bar[XB_TOPGEN], 1u);
            else XB_SPIN(xb_ld(&bar[XB_TOPGEN]) == tg, bar);
            __builtin_amdgcn_fence(__ATOMIC_ACQUIRE, "agent");
            xb_add(&bar[XB_XGEN(b.x)], 1u);
            asm volatile("s_waitcnt vmcnt(0)" ::: "memory");
        } else {
            XB_SPIN(xb_ld(&bar[XB_XGEN(b.x)]) == gen, bar);
            __builtin_amdgcn_fence(__ATOMIC_ACQUIRE, "agent");
            asm volatile("s_waitcnt vmcnt(0)" ::: "memory");
        }
    }
    __syncthreads();
}


namespace pg8 {
constexpr int BM = 256, BK = 64, HALF = 128, HTB = HALF * BK * 2, STAGE_BYTES = 8 * HTB, NXCD = 8, WGM = 8;
__host__ __device__ __forceinline__ int lds_byte(int r, int c) { const int st = (r >> 4) * 2 + (c >> 5), rr = r & 15, cc = c & 31, ob = rr * 64 + cc * 2; return st * 1024 + (ob ^ (((ob >> 9) & 1) << 5)); }
__host__ __device__ __forceinline__ void stage_rc(int b, int& R, int& C) { const int st = b / 1024, sb = b % 1024, swz = sb ^ (((sb >> 9) & 1) << 5); R = (st >> 1) * 16 + swz / 64; C = (st & 1) * 32 + (swz % 64) / 2; }
__host__ __device__ __forceinline__ int perm32(int rho) { const int n = rho >> 4, i = rho & 15; return 8 * (i >> 2) + 4 * n + (i & 3); }

struct Unit { const char* A; const char* B; char* C; int row0, col0, aux; };
struct GemmP { int K, lda, ldb; };

__device__ __forceinline__ void xcd_tile(int L, int nM, int nN, int& pm, int& pn) {
    const int nwg = nM * nN; int wgid = L;
    { const int q = nwg / NXCD, r = nwg % NXCD, xcd = wgid % NXCD, off = wgid / NXCD; wgid = (xcd < r ? xcd * (q + 1) : r * (q + 1) + (xcd - r) * q) + off; }
    const int nig = WGM * nN, gid = wgid / nig, fm = gid * WGM, gsz = (nM - fm) < WGM ? (nM - fm) : WGM;
    pm = fm + ((wgid % nig) % gsz); pn = (wgid % nig) / gsz;
}

typedef f32x4 Acc[2][2][4][2];

template <class Epi, class Sched, bool GATHER>
__device__ __forceinline__ void gemm_phase(LAS unsigned char* lds, const GemmP g, const Sched& S, const Epi& E, const int wave_id) {
    const int tid = tid_from_wave(wave_id), wid = __builtin_amdgcn_readfirstlane(tid >> 6), lane = tid & 63, wr = wid >> 2, wc = wid & 3, fr = lane & 15, fq = lane >> 4;
    const int K = g.K, nt = K / BK;
    int Rr[2], Cc[2]; unsigned voffB[2];
#pragma unroll
    for (int i = 0; i < 2; ++i) { int R, C; stage_rc(tid * 16 + i * 8192, R, C); const int Rb = Epi::PERM ? ((R & ~31) + perm32(R & 31)) : R;
        Rr[i] = R; Cc[i] = C; voffB[i] = (unsigned)(Rb * g.ldb + C) * 2u; }
    const size_t kstep = (size_t)(BK * 2);
    const size_t hstepB = (size_t)HALF * g.ldb * 2;
    const unsigned ldsw = (unsigned)wid * 1024u;
    const int aoff = lds_byte(wr * 64 + fr, fq * 8), boff = lds_byte(wc * 32 + fr, fq * 8);
#define PG8_SA(b, h) (((b) * 2 + (h)) * HTB)
#define PG8_SB(b, h) ((4 + (b) * 2 + (h)) * HTB)
#define PG8_STAGE_B(bufoff, gbase) do { _Pragma("unroll") for (int _i = 0; _i < 2; ++_i) \
        __builtin_amdgcn_global_load_lds((const unsigned*)((const char*)(gbase) + voffB[_i]), (LAS unsigned*)(lds + (bufoff) + ldsw + _i * 8192), 16, 0, 0); } while (0)
#define PG8_STAGE_A(bufoff, gbase, OFF, h) do { _Pragma("unroll") for (int _i = 0; _i < 2; ++_i) \
        __builtin_amdgcn_global_load_lds((const unsigned*)((const char*)(gbase) + (OFF)[h][_i]), (LAS unsigned*)(lds + (bufoff) + ldsw + _i * 8192), 16, 0, 0); } while (0)
#define PG8_OFFS(u, OFF) do { _Pragma("unroll") for (int _h = 0; _h < 2; ++_h) _Pragma("unroll") for (int _i = 0; _i < 2; ++_i) { \
        const int _row = _h * HALF + Rr[_i]; const int _src = GATHER ? S.arow((u), _row) : _row; (OFF)[_h][_i] = (unsigned)(_src * g.lda + Cc[_i]) * 2u; } } while (0)
#define PG8_LDA(dst, b, h) do { _Pragma("unroll") for (int m = 0; m < 4; ++m) _Pragma("unroll") for (int k = 0; k < 2; ++k) dst[m][k] = *(const LAS bf16x8*)(lds + PG8_SA(b, h) + aoff + m * 2048 + k * 1024); } while (0)
#define PG8_LDB(dst, b, h) do { _Pragma("unroll") for (int n = 0; n < 2; ++n) _Pragma("unroll") for (int k = 0; k < 2; ++k) dst[n][k] = *(const LAS bf16x8*)(lds + PG8_SB(b, h) + boff + n * 2048 + k * 1024); } while (0)
#define PG8_MMA(ai, bj, At, Bt) do { __builtin_amdgcn_s_setprio(1); _Pragma("unroll") for (int m = 0; m < 4; ++m) _Pragma("unroll") for (int n = 0; n < 2; ++n) _Pragma("unroll") for (int k = 0; k < 2; ++k) \
        acc[ai][bj][m][n] = __builtin_amdgcn_mfma_f32_16x16x32_bf16(Bt[n][k], At[m][k], acc[ai][bj][m][n], 0, 0, 0); __builtin_amdgcn_s_setprio(0); } while (0)
#define PG8_WAIT_V(n) asm volatile("s_waitcnt vmcnt(" #n ")" ::: "memory")
#define PG8_WAIT_L(n) asm volatile("s_waitcnt lgkmcnt(" #n ")" ::: "memory")
#define PG8_BAR __builtin_amdgcn_s_barrier()
#define PG8_SCHED __builtin_amdgcn_sched_barrier(0)
    Unit cur, nxt; int ui = 0;
    if (!S.next(0, cur)) return;
    f32x4 acc[2][2][4][2];
#pragma unroll
    for (int a = 0; a < 2; ++a)
#pragma unroll
        for (int b = 0; b < 2; ++b)
#pragma unroll
            for (int m = 0; m < 4; ++m)
#pragma unroll
                for (int n = 0; n < 2; ++n) acc[a][b][m][n] = (f32x4){0.f, 0.f, 0.f, 0.f};
    bf16x8 At[4][2], B0[2][2], B1[2][2];
    const char* cA = cur.A; const char* cB = cur.B;
    unsigned coffA[2][2], noffA[2][2];
    PG8_OFFS(cur, coffA);
    PG8_STAGE_B(PG8_SB(0, 0), cB); PG8_STAGE_A(PG8_SA(0, 0), cA, coffA, 0); PG8_STAGE_B(PG8_SB(0, 1), cB + hstepB); PG8_STAGE_A(PG8_SA(0, 1), cA, coffA, 1);
    if (wr == 1) PG8_BAR;
    PG8_WAIT_V(4); PG8_BAR;
    PG8_STAGE_B(PG8_SB(1, 0), cB + kstep); PG8_STAGE_A(PG8_SA(1, 0), cA + kstep, coffA, 0); PG8_STAGE_B(PG8_SB(1, 1), cB + hstepB + kstep);
    PG8_WAIT_V(6); PG8_BAR;
    for (;;) {
        const bool has_next = S.next(ui + 1, nxt);
        const char* nA = has_next ? nxt.A : cA; const char* nB = has_next ? nxt.B : cB;
        if (has_next) { PG8_OFFS(nxt, noffA); }
        else {
#pragma unroll
            for (int _h = 0; _h < 2; ++_h)
#pragma unroll
                for (int _i = 0; _i < 2; ++_i) noffA[_h][_i] = coffA[_h][_i]; }
        for (int t = 0; t < nt; t += 2) {
            const bool last = (t == nt - 2);
            const char* a1 = cA + (size_t)(t + 1) * kstep;
            const char* a2 = last ? nA : cA + (size_t)(t + 2) * kstep; const char* b2 = last ? nB : cB + (size_t)(t + 2) * kstep;
            const char* a3 = a2 + kstep; const char* b3 = b2 + kstep;
            unsigned o2[2][2];
#pragma unroll
            for (int _h = 0; _h < 2; ++_h)
#pragma unroll
                for (int _i = 0; _i < 2; ++_i) o2[_h][_i] = last ? noffA[_h][_i] : coffA[_h][_i];
            PG8_LDB(B0, 0, 0); PG8_SCHED; PG8_LDA(At, 0, 0); PG8_STAGE_A(PG8_SA(1, 1), a1, coffA, 1);
            PG8_WAIT_L(8); PG8_BAR; PG8_WAIT_L(0); PG8_MMA(0, 0, At, B0); PG8_BAR; PG8_SCHED;
            PG8_LDB(B1, 0, 1); PG8_STAGE_B(PG8_SB(0, 0), b2);
            PG8_BAR; PG8_WAIT_L(0); PG8_MMA(0, 1, At, B1); PG8_BAR;
            PG8_LDA(At, 0, 1); PG8_STAGE_A(PG8_SA(0, 0), a2, o2, 0);
            PG8_BAR; PG8_WAIT_L(0); PG8_MMA(1, 0, At, B0); PG8_BAR; PG8_SCHED;
            PG8_STAGE_B(PG8_SB(0, 1), b2 + hstepB);
            PG8_WAIT_V(6); PG8_BAR; PG8_MMA(1, 1, At, B1); PG8_BAR;
            PG8_LDB(B0, 1, 0); PG8_SCHED; PG8_LDA(At, 1, 0); PG8_STAGE_A(PG8_SA(0, 1), a2, o2, 1);
            PG8_WAIT_L(8); PG8_BAR; PG8_WAIT_L(0); PG8_MMA(0, 0, At, B0); PG8_BAR; PG8_SCHED;
            PG8_LDB(B1, 1, 1); PG8_STAGE_B(PG8_SB(1, 0), b3);
            PG8_BAR; PG8_WAIT_L(0); PG8_MMA(0, 1, At, B1); PG8_BAR;
            PG8_LDA(At, 1, 1); PG8_STAGE_A(PG8_SA(1, 0), a3, o2, 0);
            PG8_BAR; PG8_WAIT_L(0); PG8_MMA(1, 0, At, B0); PG8_BAR; PG8_SCHED;
            PG8_STAGE_B(PG8_SB(1, 1), b3 + hstepB);
            PG8_WAIT_V(6); PG8_BAR; PG8_MMA(1, 1, At, B1); PG8_BAR;
        }
        if constexpr (!Epi::AFTER_DRAIN) { E(acc, cur, wr, wc, fr, fq); }
        if (!has_next) break;
#pragma unroll
        for (int a = 0; a < 2; ++a)
#pragma unroll
            for (int b = 0; b < 2; ++b)
#pragma unroll
                for (int m = 0; m < 4; ++m)
#pragma unroll
                    for (int n = 0; n < 2; ++n) acc[a][b][m][n] = (f32x4){0.f, 0.f, 0.f, 0.f};
        cur = nxt; cA = nA; cB = nB; ++ui;
#pragma unroll
        for (int _h = 0; _h < 2; ++_h)
#pragma unroll
            for (int _i = 0; _i < 2; ++_i) coffA[_h][_i] = noffA[_h][_i];
    }
    PG8_WAIT_V(0);
    if (wr == 0) PG8_BAR;
    PG8_BAR;
    if constexpr (Epi::AFTER_DRAIN) { E.fused(acc, cur, wr, wc, fr, fq, lds, wid, lane); }
#undef PG8_SA
#undef PG8_SB
#undef PG8_STAGE_A
#undef PG8_STAGE_B
#undef PG8_OFFS
#undef PG8_LDA
#undef PG8_LDB
#undef PG8_MMA
#undef PG8_WAIT_V
#undef PG8_WAIT_L
#undef PG8_BAR
#undef PG8_SCHED
}

struct EpiBf16 {
    static constexpr bool PERM = true, AFTER_DRAIN = false;
    int ldc;
    __device__ __forceinline__ void operator()(const Acc& acc, const Unit& u, int wr, int wc, int fr, int fq) const {
        bf16* base = (bf16*)u.C + (size_t)(wr * 64 + fr) * ldc + wc * 32 + 8 * fq;
#pragma unroll
        for (int ai = 0; ai < 2; ++ai)
#pragma unroll
            for (int m = 0; m < 4; ++m) { bf16* rowp = base + (size_t)(ai * HALF + m * 16) * ldc;
#pragma unroll
                for (int bj = 0; bj < 2; ++bj) { const f32x4 v0 = acc[ai][bj][m][0], v1 = acc[ai][bj][m][1];
                    u32x4 w; w.x = pk2(v0[0], v0[1]); w.y = pk2(v0[2], v0[3]); w.z = pk2(v1[0], v1[1]); w.w = pk2(v1[2], v1[3]);
                    *(u32x4*)(rowp + bj * HALF) = w; } }
    }
};
struct EpiF32Res {
    static constexpr bool PERM = false, AFTER_DRAIN = false;
    int ldc; const float* resid; float* out;
    __device__ __forceinline__ void operator()(const Acc& acc, const Unit& u, int wr, int wc, int fr, int fq) const {
        const size_t o0 = (size_t)(u.row0 + wr * 64 + fr) * ldc + u.col0 + wc * 32 + 4 * fq;
#pragma unroll
        for (int ai = 0; ai < 2; ++ai)
#pragma unroll
            for (int m = 0; m < 4; ++m) { const size_t ro = o0 + (size_t)(ai * HALF + m * 16) * ldc;
#pragma unroll
                for (int bj = 0; bj < 2; ++bj)
#pragma unroll
                    for (int n = 0; n < 2; ++n) { const size_t o = ro + bj * HALF + n * 16; const f32x4 b = *(const f32x4*)(resid + o); *(f32x4*)(out + o) = acc[ai][bj][m][n] + b; } }
    }
};
struct EpiSwiGlu {
    static constexpr bool PERM = true, AFTER_DRAIN = false;
    int ldc;
    __device__ __forceinline__ void operator()(const Acc& acc, const Unit& u, int wr, int wc, int fr, int fq) const {
        bf16* base = (bf16*)u.C + (size_t)(wr * 64 + fr) * ldc + wc * 32 + 8 * fq;
#pragma unroll
        for (int ai = 0; ai < 2; ++ai)
#pragma unroll
            for (int m = 0; m < 4; ++m) { bf16* rowp = base + (size_t)(ai * HALF + m * 16) * ldc;
                float h[8];
#pragma unroll
                for (int n = 0; n < 2; ++n)
#pragma unroll
                    for (int e = 0; e < 4; ++e) { const float a = acc[ai][0][m][n][e], b = acc[ai][1][m][n][e]; h[n * 4 + e] = a / (1.f + __expf(-a)) * b; }
                u32x4 w; w.x = pk2(h[0], h[1]); w.y = pk2(h[2], h[3]); w.z = pk2(h[4], h[5]); w.w = pk2(h[6], h[7]);
                *(u32x4*)rowp = w; }
    }
};
struct EpiGate {
    static constexpr bool PERM = true, AFTER_DRAIN = false;
    int ldc; const float* egate; const int* cnt_lds_unused;
    __device__ __forceinline__ void operator()(const Acc& acc, const Unit& u, int wr, int wc, int fr, int fq) const {
        bf16* base = (bf16*)u.C + (size_t)(wr * 64 + fr) * ldc + wc * 32 + 8 * fq;
        const int e = u.aux >> 16, nvalid = u.aux & 0xffff;
        const float* gp = egate + (size_t)e * ECAP + u.row0;
#pragma unroll
        for (int ai = 0; ai < 2; ++ai)
#pragma unroll
            for (int m = 0; m < 4; ++m) { const int r = ai * HALF + wr * 64 + m * 16 + fr; const float gt = (r < nvalid) ? gp[r] : 0.f;
                bf16* rowp = base + (size_t)(ai * HALF + m * 16) * ldc;
#pragma unroll
                for (int bj = 0; bj < 2; ++bj) { const f32x4 v0 = acc[ai][bj][m][0] * gt, v1 = acc[ai][bj][m][1] * gt;
                    u32x4 w; w.x = pk2(v0[0], v0[1]); w.y = pk2(v0[2], v0[3]); w.z = pk2(v1[0], v1[1]); w.w = pk2(v1[2], v1[3]);
                    *(u32x4*)(rowp + bj * HALF) = w; } }
    }
};
struct EpiSoftmax {
    static constexpr bool PERM = true, AFTER_DRAIN = true;
    int ldc; float scale_log2e;
    __device__ __forceinline__ void operator()(const Acc&, const Unit&, int, int, int, int) const {}
    __device__ __forceinline__ void fused(const Acc& acc, const Unit& u, int wr, int wc, int fr, int fq, LAS unsigned char* lds, int wid, int lane) const {
        LAS float* RM = (LAS float*)lds;
        LAS float* RS = (LAS float*)(lds + 4096);
        float mx[2][4];
#pragma unroll
        for (int ai = 0; ai < 2; ++ai)
#pragma unroll
            for (int m = 0; m < 4; ++m) { float v = -3.0e38f;
#pragma unroll
                for (int bj = 0; bj < 2; ++bj)
#pragma unroll
                    for (int n = 0; n < 2; ++n) { const f32x4 x = acc[ai][bj][m][n]; v = fmaxf(v, fmaxf(fmaxf(x[0], x[1]), fmaxf(x[2], x[3]))); }
                v = fmaxf(v, __shfl_xor(v, 16)); v = fmaxf(v, __shfl_xor(v, 32));
                if (fq == 0) RM[(ai * HALF + wr * 64 + m * 16 + fr) * 4 + wc] = v; }
        asm volatile("s_waitcnt lgkmcnt(0)" ::: "memory"); __builtin_amdgcn_s_barrier(); asm volatile("" ::: "memory");
#pragma unroll
        for (int ai = 0; ai < 2; ++ai)
#pragma unroll
            for (int m = 0; m < 4; ++m) { const int row = ai * HALF + wr * 64 + m * 16 + fr; const f32x4 q = *(const LAS f32x4*)(RM + row * 4);
                const float M = fmaxf(fmaxf(q[0], q[1]), fmaxf(q[2], q[3])); const float mc = -M * scale_log2e; float s = 0.f;
#pragma unroll
                for (int bj = 0; bj < 2; ++bj)
#pragma unroll
                    for (int n = 0; n < 2; ++n)
#pragma unroll
                        for (int e = 0; e < 4; ++e) s += __builtin_amdgcn_exp2f(fmaf(acc[ai][bj][m][n][e], scale_log2e, mc));
                s += __shfl_xor(s, 16); s += __shfl_xor(s, 32);
                if (fq == 0) RS[row * 4 + wc] = s; }
        asm volatile("s_waitcnt lgkmcnt(0)" ::: "memory"); __builtin_amdgcn_s_barrier(); asm volatile("" ::: "memory");
        bf16* base = (bf16*)u.C + (size_t)(wr * 64 + fr) * ldc + wc * 32 + 8 * fq;
#pragma unroll
        for (int ai = 0; ai < 2; ++ai)
#pragma unroll
            for (int m = 0; m < 4; ++m) { const int row = ai * HALF + wr * 64 + m * 16 + fr; const f32x4 q = *(const LAS f32x4*)(RS + row * 4); const f32x4 qm = *(const LAS f32x4*)(RM + row * 4);
                const float M = fmaxf(fmaxf(qm[0], qm[1]), fmaxf(qm[2], qm[3])); const float mc = -M * scale_log2e;
                const float inv = 1.f / ((q[0] + q[1]) + (q[2] + q[3])); bf16* rowp = base + (size_t)(ai * HALF + m * 16) * ldc;
#pragma unroll
                for (int bj = 0; bj < 2; ++bj) { float pp[8];
#pragma unroll
                    for (int n = 0; n < 2; ++n)
#pragma unroll
                        for (int e = 0; e < 4; ++e) pp[n * 4 + e] = __builtin_amdgcn_exp2f(fmaf(acc[ai][bj][m][n][e], scale_log2e, mc)) * inv;
                    u32x4 w; w.x = pk2(pp[0], pp[1]); w.y = pk2(pp[2], pp[3]); w.z = pk2(pp[4], pp[5]); w.w = pk2(pp[6], pp[7]);
                    *(u32x4*)(rowp + bj * HALF) = w; } }
        asm volatile("s_waitcnt lgkmcnt(0)" ::: "memory"); __builtin_amdgcn_s_barrier(); asm volatile("" ::: "memory");
    }
};
}

namespace att {
constexpr int KVBLK = 64;
constexpr size_t SHM_V = KVBLK * 128 * 2, SHM_K = KVBLK * 128 * 2;
#define KSWZ(row, colB) ((row) * 256 + ((colB) ^ (((row) & 7) << 4)))
#define SBAR() __builtin_amdgcn_sched_barrier(0)
__device__ __forceinline__ int crow(int r, int hi) { return (r & 3) + 8 * (r >> 2) + 4 * hi; }
__device__ __forceinline__ bf16x8 ld8(const bf16* p) { return *reinterpret_cast<const bf16x8*>(p); }

__device__ __forceinline__ void partialSM(f32x16& p0, f32x16& p1, float& m_reg, float& mn, float& alpha, const float SCALE, const float THR) {
  const float C = SCALE * 1.4426950408889634f;
  float pmax = p0[0];
#pragma unroll
  for (int r = 1; r < 16; ++r) pmax = fmaxf(pmax, p0[r]);
#pragma unroll
  for (int r = 0; r < 16; ++r) pmax = fmaxf(pmax, p1[r]);
  { auto rr = __builtin_amdgcn_permlane32_swap(__float_as_uint(pmax), __float_as_uint(pmax), false, false);
    pmax = fmaxf(__uint_as_float(rr[0]), __uint_as_float(rr[1])); }
  if (__builtin_expect(__all(pmax - m_reg <= THR / SCALE), 1)) { mn = m_reg; alpha = 1.f; }
  else { mn = fmaxf(m_reg, pmax); alpha = __builtin_amdgcn_exp2f((m_reg - mn) * C); m_reg = mn; }
  const float mnC = -mn * C;
#pragma unroll
  for (int r = 0; r < 16; ++r) p0[r] = fmaf(p0[r], C, mnC);
#pragma unroll
  for (int r = 0; r < 16; ++r) p1[r] = fmaf(p1[r], C, mnC);
#pragma unroll
  for (int r = 0; r < 16; ++r) p0[r] = __builtin_amdgcn_exp2f(p0[r]);
}
__device__ __forceinline__ void finishSM(f32x16& p0, f32x16& p1, float alpha, float& l_reg, bf16x8& pa0, bf16x8& pa1, bf16x8& pa2, bf16x8& pa3) {
#pragma unroll
  for (int r = 0; r < 16; ++r) p1[r] = __builtin_amdgcn_exp2f(p1[r]);
  float ps = 0;
#pragma unroll
  for (int r = 0; r < 16; ++r) ps += p0[r];
#pragma unroll
  for (int r = 0; r < 16; ++r) ps += p1[r];
  { auto rr = __builtin_amdgcn_permlane32_swap(__float_as_uint(ps), __float_as_uint(ps), false, false);
    ps = __uint_as_float(rr[0]) + __uint_as_float(rr[1]); }
  l_reg = l_reg * alpha + ps;
#define PK4(P, BASE, OUT) do { unsigned a0 = pk2(P[BASE + 0], P[BASE + 1]), a1 = pk2(P[BASE + 2], P[BASE + 3]);   \
    unsigned b0 = pk2(P[BASE + 4], P[BASE + 5]), b1 = pk2(P[BASE + 6], P[BASE + 7]);                              \
    auto r0 = __builtin_amdgcn_permlane32_swap(a0, b0, false, false); auto r1 = __builtin_amdgcn_permlane32_swap(a1, b1, false, false); \
    u32x4 w = {r0[0], r1[0], r0[1], r1[1]}; OUT = *reinterpret_cast<bf16x8*>(&w); } while (0)
  PK4(p0, 0, pa0); PK4(p0, 8, pa1); PK4(p1, 0, pa2); PK4(p1, 8, pa3);
#undef PK4
}
template <int ND0> __device__ __forceinline__ void qkt(f32x16& p0, f32x16& p1, const char* Ks, const bf16x8* qr, int r32, int hi, int c0) {
  p0 = f32x16{}; p1 = f32x16{};
#pragma unroll
  for (int d0 = 0; d0 < ND0; ++d0) { const int cb = (c0 + d0 * 16 + hi * 8) * 2;
    const bf16x8 b0 = *reinterpret_cast<const bf16x8*>(Ks + KSWZ(r32, cb));
    const bf16x8 b1 = *reinterpret_cast<const bf16x8*>(Ks + KSWZ(32 + r32, cb));
    p0 = __builtin_amdgcn_mfma_f32_32x32x16_bf16(b0, qr[d0], p0, 0, 0, 0);
    p1 = __builtin_amdgcn_mfma_f32_32x32x16_bf16(b1, qr[d0], p1, 0, 0, 0); }
}
__device__ __forceinline__ int v_st(int k, int c) { const int kk = (k & ~0xC) | ((k & 4) << 1) | ((k & 8) >> 1); return ((kk >> 3) * 4 + (c >> 5)) * 512 + ((kk & 7) * 32 + (c & 31)) * 2; }
__device__ __forceinline__ int v_rd_base(int lane) { return ((lane & 3) << 3) | (((lane >> 2) & 3) << 6) | (((lane >> 4) & 1) << 5) | (((lane >> 5) & 1) << 8); }
constexpr int v_rd_off(int d0, int ks, int half) { return d0 * 512 + ks * 4096 + half * 2048; }
template <int OFF> __device__ __forceinline__ s16x4 tr_read(int vb) {
  s16x4 r; asm volatile("ds_read_b64_tr_b16 %0, %1 offset:%2" : "=&v"(r) : "v"(vb), "i"(OFF) : "memory"); return r;
}
template <int D0> __device__ __forceinline__ void pv_one(f32x16& od, int vb, bf16x8 pa0, bf16x8 pa1, bf16x8 pa2, bf16x8 pa3) {
  const s16x4 l0 = tr_read<v_rd_off(D0, 0, 0)>(vb), h0 = tr_read<v_rd_off(D0, 0, 1)>(vb), l1 = tr_read<v_rd_off(D0, 1, 0)>(vb), h1 = tr_read<v_rd_off(D0, 1, 1)>(vb);
  const s16x4 l2 = tr_read<v_rd_off(D0, 2, 0)>(vb), h2 = tr_read<v_rd_off(D0, 2, 1)>(vb), l3 = tr_read<v_rd_off(D0, 3, 0)>(vb), h3 = tr_read<v_rd_off(D0, 3, 1)>(vb);
  asm volatile("s_waitcnt lgkmcnt(0)" ::: "memory"); SBAR();
#define PK(L, H) (bf16x8){L[0], L[1], L[2], L[3], H[0], H[1], H[2], H[3]}
  od = __builtin_amdgcn_mfma_f32_32x32x16_bf16(pa0, PK(l0, h0), od, 0, 0, 0);
  od = __builtin_amdgcn_mfma_f32_32x32x16_bf16(pa1, PK(l1, h1), od, 0, 0, 0);
  od = __builtin_amdgcn_mfma_f32_32x32x16_bf16(pa2, PK(l2, h2), od, 0, 0, 0);
  od = __builtin_amdgcn_mfma_f32_32x32x16_bf16(pa3, PK(l3, h3), od, 0, 0, 0);
#undef PK
}
__device__ __forceinline__ void pv_d0(f32x16* o, int vb, bf16x8 pa0, bf16x8 pa1, bf16x8 pa2, bf16x8 pa3) {
  pv_one<0>(o[0], vb, pa0, pa1, pa2, pa3); pv_one<1>(o[1], vb, pa0, pa1, pa2, pa3); pv_one<2>(o[2], vb, pa0, pa1, pa2, pa3); pv_one<3>(o[3], vb, pa0, pa1, pa2, pa3);
}

__device__ __forceinline__ void diff_attn_unit(const bf16* Qb, const bf16* Kh, const bf16* Vh, int ld, int seq, bf16* outb, int ldo,
                                               const float lam, const float post_scale, const float* subln_g, char* lds, const int wave_id) {
  constexpr float SCALE = 0.125f, THR = 8.f;
  const int tid = tid_from_wave(wave_id), wid = __builtin_amdgcn_readfirstlane(tid >> 6), lane = tid & 63, r32 = lane & 31, hi = lane >> 5;
  const int csel = wid >> 2, wq = wid & 3;
  char* V_lds = lds; char* K_lds = lds + 2 * SHM_V;
  float* ws = (float*)(lds + 2 * SHM_V + 2 * SHM_K) + wid * 64; float* li_l = ws; float* al_l = ws + 32;
  float m_reg = -1e30f, l_reg = 0; f32x16 o[4] = {}; bf16x8 qr[4];
  const bf16* Qw = Qb + (long)(wq * 32 + r32) * ld + csel * 64 + hi * 8;
#pragma unroll
  for (int d0 = 0; d0 < 4; ++d0) qr[d0] = ld8(Qw + d0 * 16);
  const int sr = tid >> 4, sc = (tid & 15) * 8, vst0 = v_st(sr, sc), vst1 = v_st(32 + sr, sc);
  const int vb0 = (int)(uintptr_t)V_lds + v_rd_base(lane);
  const int kc0 = csel * 64;
  struct { bf16x8 vs0, vs1, ks0, ks1; } sr_[2];
#define SLOAD(i, k0) do { sr_[i].vs0 = ld8(&Vh[(long)((k0) + sr) * ld + sc]); sr_[i].vs1 = ld8(&Vh[(long)((k0) + 32 + sr) * ld + sc]); \
    sr_[i].ks0 = ld8(&Kh[(long)((k0) + sr) * ld + sc]); sr_[i].ks1 = ld8(&Kh[(long)((k0) + 32 + sr) * ld + sc]); } while (0)
#define SWRITE(b, i) do { *(bf16x8*)(V_lds + (b) * SHM_V + vst0) = sr_[i].vs0;          \
    *(bf16x8*)(V_lds + (b) * SHM_V + vst1) = sr_[i].vs1; const int kc = sc * 2;               \
    *(bf16x8*)(K_lds + (b) * SHM_K + KSWZ(sr, kc)) = sr_[i].ks0;                       \
    *(bf16x8*)(K_lds + (b) * SHM_K + KSWZ(32 + sr, kc)) = sr_[i].ks1; } while (0)
#define SWAIT() asm volatile("s_waitcnt vmcnt(4)" ::: "memory")
#define RESC(a) do { if (__any((a) < 1.f)) { if (hi == 0) al_l[r32] = (a); asm volatile("s_waitcnt lgkmcnt(0)" ::: "memory"); \
    _Pragma("unroll") for (int d = 0; d < 4; ++d) _Pragma("unroll") for (int r = 0; r < 16; ++r) o[d][r] *= al_l[crow(r, hi)]; } } while (0)
  f32x16 pA0, pA1, pB0, pB1; float mnA, mnB, alA, alB; bf16x8 pa0, pa1, pa2, pa3; const int NT = seq / KVBLK;
  constexpr int SE = 0, SO = 1;
  __syncthreads();
  SLOAD(SE, 0); asm volatile("s_waitcnt vmcnt(0)" ::: "memory"); SWRITE(0, SE); __syncthreads();
  qkt<4>(pA0, pA1, K_lds, qr, r32, hi, kc0); partialSM(pA0, pA1, m_reg, mnA, alA, SCALE, THR);
  SLOAD(SO, KVBLK); if (2 < NT) SLOAD(SE, 2 * KVBLK);
  SWAIT(); SWRITE(1, SO); __syncthreads();
  for (int j = 1; j + 1 < NT; j += 2) {
    SBAR(); qkt<4>(pB0, pB1, K_lds + SHM_K, qr, r32, hi, kc0);
    finishSM(pA0, pA1, alA, l_reg, pa0, pa1, pa2, pa3); SBAR();
    SLOAD(SO, (j + 2) * KVBLK); SBAR();
    pv_d0(o, vb0, pa0, pa1, pa2, pa3); partialSM(pB0, pB1, m_reg, mnB, alB, SCALE, THR);
    __syncthreads(); SWAIT(); SWRITE(0, SE);
    RESC(alB); __syncthreads();
    SBAR(); qkt<4>(pA0, pA1, K_lds, qr, r32, hi, kc0);
    finishSM(pB0, pB1, alB, l_reg, pa0, pa1, pa2, pa3); SBAR();
    if (j + 3 < NT) SLOAD(SE, (j + 3) * KVBLK); SBAR();
    pv_d0(o, vb0 + (int)SHM_V, pa0, pa1, pa2, pa3); partialSM(pA0, pA1, m_reg, mnA, alA, SCALE, THR);
    __syncthreads(); SWAIT(); SWRITE(1, SO);
    RESC(alA); __syncthreads();
  }
  SBAR(); qkt<4>(pB0, pB1, K_lds + SHM_K, qr, r32, hi, kc0);
  finishSM(pA0, pA1, alA, l_reg, pa0, pa1, pa2, pa3); SBAR();
  pv_d0(o, vb0, pa0, pa1, pa2, pa3); partialSM(pB0, pB1, m_reg, mnB, alB, SCALE, THR);
  __syncthreads(); RESC(alB);
  finishSM(pB0, pB1, alB, l_reg, pa0, pa1, pa2, pa3); SBAR();
  pv_d0(o, vb0 + (int)SHM_V, pa0, pa1, pa2, pa3);
  asm volatile("s_waitcnt vmcnt(0)" ::: "memory");
  if (hi == 0) li_l[r32] = l_reg; asm volatile("s_waitcnt lgkmcnt(0)" ::: "memory");
  float rli[16];
#pragma unroll
  for (int r = 0; r < 16; ++r) rli[r] = __builtin_amdgcn_rcpf(li_l[crow(r, hi)]);
  __syncthreads();
  float* X = (float*)lds + (size_t)wq * 4096;
  if (csel == 1) {
#pragma unroll
    for (int d0 = 0; d0 < 4; ++d0)
#pragma unroll
      for (int r = 0; r < 16; ++r) X[(d0 * 16 + r) * 64 + lane] = o[d0][r] * rli[r];
  }
  __syncthreads();
  if (csel == 0) {
    float ss[16];
#pragma unroll
    for (int r = 0; r < 16; ++r) ss[r] = 0.f;
#pragma unroll
    for (int d0 = 0; d0 < 4; ++d0)
#pragma unroll
      for (int r = 0; r < 16; ++r) { const float v = o[d0][r] * rli[r] - lam * X[(d0 * 16 + r) * 64 + lane]; o[d0][r] = v; ss[r] += v * v; }
#pragma unroll
    for (int r = 0; r < 16; ++r) { float s = ss[r];
      s += __shfl_xor(s, 1); s += __shfl_xor(s, 2); s += __shfl_xor(s, 4); s += __shfl_xor(s, 8); s += __shfl_xor(s, 16);
      ss[r] = __builtin_amdgcn_rsqf(s * (1.f / 128.f) + RMS_EPS) * post_scale; }
    float gg[4];
#pragma unroll
    for (int d0 = 0; d0 < 4; ++d0) gg[d0] = subln_g[d0 * 32 + r32];
    bf16* Ow = outb + (long)(wq * 32) * ldo;
#pragma unroll
    for (int r = 0; r < 16; ++r) { const int orow = crow(r, hi);
#pragma unroll
      for (int d0 = 0; d0 < 4; ++d0) Ow[(long)orow * ldo + d0 * 32 + r32] = f2bf(o[d0][r] * ss[r] * gg[d0]); }
  }
#undef SLOAD
#undef SWRITE
#undef SWAIT
}

__device__ __forceinline__ void dil_attn_unit(const bf16* Qh, const bf16* Kh, const bf16* Vh, int ld, int dil, int rho, int u0, int L,
                                              float* Oc, float* lsep, char* lds, const int wave_id) {
  constexpr float SCALE = 0.08838834764831845f; constexpr float C = SCALE * 1.4426950408889634f;
  const int tid = tid_from_wave(wave_id), wid = __builtin_amdgcn_readfirstlane(tid >> 6), lane = tid & 63, r32 = lane & 31, hi = lane >> 5;
  char* V_lds = lds; char* K_lds = lds + 2 * SHM_V;
  float* ws = (float*)(lds + 2 * SHM_V + 2 * SHM_K) + wid * 64; float* li_l = ws; float* al_l = ws + 32;
  float m_reg = -1e30f, l_reg = 0; f32x16 o[4] = {}; bf16x8 qr[8];
  const int uq = u0 + wid * 32 + r32;
  const bf16* Qw = Qh + (long)(rho + dil * uq) * ld + hi * 8;
#pragma unroll
  for (int d0 = 0; d0 < 8; ++d0) qr[d0] = ld8(Qw + d0 * 16);
  const int sr = tid >> 4, sc = (tid & 15) * 8, vst0 = v_st(sr, sc), vst1 = v_st(32 + sr, sc);
  const int vb0 = (int)(uintptr_t)V_lds + v_rd_base(lane);
  const int tlo = wid >> 1;
  for (int t = 0; t < 6; ++t) {
    const int kt0 = u0 - 64 + 64 * t;
    __syncthreads();
    { int ua = kt0 + sr, ub = kt0 + 32 + sr; ua = ua < 0 ? 0 : (ua >= L ? L - 1 : ua); ub = ub < 0 ? 0 : (ub >= L ? L - 1 : ub);
      const long ra = (long)(rho + dil * ua) * ld + sc, rb = (long)(rho + dil * ub) * ld + sc;
      const bf16x8 va = ld8(Vh + ra), vb = ld8(Vh + rb), ka = ld8(Kh + ra), kb = ld8(Kh + rb);
      *(bf16x8*)(V_lds + vst0) = va; *(bf16x8*)(V_lds + vst1) = vb; const int kc = sc * 2;
      *(bf16x8*)(K_lds + KSWZ(sr, kc)) = ka; *(bf16x8*)(K_lds + KSWZ(32 + sr, kc)) = kb; }
    __syncthreads();
    if (t >= tlo && t <= tlo + 2) {
      f32x16 p0, p1;
      qkt<8>(p0, p1, K_lds, qr, r32, hi, 0);
#pragma unroll
      for (int r = 0; r < 16; ++r) { const int uk0 = kt0 + crow(r, hi), uk1 = uk0 + 32; const int d0 = uk0 - uq, d1 = uk1 - uq;
        const bool ok0 = (uk0 >= 0) && (uk0 < L) && (d0 >= -64) && (d0 <= 64), ok1 = (uk1 >= 0) && (uk1 < L) && (d1 >= -64) && (d1 <= 64);
        p0[r] = ok0 ? p0[r] : -1e30f; p1[r] = ok1 ? p1[r] : -1e30f; }
      float pmax = p0[0];
#pragma unroll
      for (int r = 1; r < 16; ++r) pmax = fmaxf(pmax, p0[r]);
#pragma unroll
      for (int r = 0; r < 16; ++r) pmax = fmaxf(pmax, p1[r]);
      { auto rr = __builtin_amdgcn_permlane32_swap(__float_as_uint(pmax), __float_as_uint(pmax), false, false);
        pmax = fmaxf(__uint_as_float(rr[0]), __uint_as_float(rr[1])); }
      const float mn = fmaxf(m_reg, pmax); const float alpha = __builtin_amdgcn_exp2f((m_reg - mn) * C); m_reg = mn;
      const float mnC = -mn * C;
#pragma unroll
      for (int r = 0; r < 16; ++r) { p0[r] = __builtin_amdgcn_exp2f(fmaf(p0[r], C, mnC)); p1[r] = fmaf(p1[r], C, mnC); }
      bf16x8 pa0, pa1, pa2, pa3;
      finishSM(p0, p1, alpha, l_reg, pa0, pa1, pa2, pa3);
      RESC(alpha);
      pv_d0(o, vb0, pa0, pa1, pa2, pa3);
    }
  }
  if (hi == 0) li_l[r32] = l_reg; asm volatile("s_waitcnt lgkmcnt(0)" ::: "memory");
  float rli[16];
#pragma unroll
  for (int r = 0; r < 16; ++r) rli[r] = __builtin_amdgcn_rcpf(li_l[crow(r, hi)]);
#pragma unroll
  for (int r = 0; r < 16; ++r) { const int uo = u0 + wid * 32 + crow(r, hi); float* orow = Oc + (long)(rho + dil * uo) * 512;
#pragma unroll
    for (int d0 = 0; d0 < 4; ++d0) orow[d0 * 32 + r32] = o[d0][r] * rli[r]; }
  if (hi == 0) lsep[(long)(rho + dil * uq) * 4] = m_reg * SCALE + __logf(l_reg);
}
#undef RESC
#undef KSWZ
#undef SBAR
}

struct Args { const float* in[N_INPUTS]; float* out; unsigned char* ws; int ph_lo, ph_hi; };
typedef const __attribute__((address_space(4))) Args* ArgsP;
struct Frame {
    LAS unsigned char* lds; volatile LAS unsigned* MISC; unsigned* ctl; unsigned char* ws;
    int tid, lane, wave, G, bid;
};
constexpr int PH_P0 = 0, PH_P1 = 1, PH_P2 = 2, PH_L0 = 3, NPH_L = 12, PH_FINAL = PH_L0 + DEPTH * NPH_L, NPHASES = PH_FINAL + 1;
enum { LP_NORM1 = 0, LP_G1, LP_PREP, LP_MIX, LP_POST, LP_G2, LP_NORM2, LP_GS, LP_GO, LP_NORM3, LP_M1, LP_M2 };

__device__ __forceinline__ int q_next(Frame& F, int q) {
    __syncthreads();
    if (F.tid == 0) F.MISC[0] = __hip_atomic_fetch_add(F.ctl + CW_Q + 64 * q, 1u, __ATOMIC_RELAXED, __HIP_MEMORY_SCOPE_AGENT);
    __syncthreads();
    return (int)F.MISC[0];
}

template <class RowMap>
__device__ __forceinline__ void transpose_item(const float* W, int ldn, bf16* WT, int ldt, RowMap rm, LAS float* scr, int k0, int n0, int lane) {
#pragma unroll 8
    for (int i = 0; i < 32; ++i) { const int kk = 2 * i + (lane >> 5); scr[kk * 33 + (lane & 31)] = W[(size_t)(k0 + kk) * ldn + n0 + (lane & 31)]; }
    LDS_WAIT(); asm volatile("" ::: "memory");
    const int c = lane & 7;
#pragma unroll
    for (int j = 0; j < 4; ++j) { const int n = (lane >> 3) + 8 * j; const LAS float* s = scr + (8 * c) * 33 + n;
        u32x4 o; o.x = pk2(s[0 * 33], s[1 * 33]); o.y = pk2(s[2 * 33], s[3 * 33]); o.z = pk2(s[4 * 33], s[5 * 33]); o.w = pk2(s[6 * 33], s[7 * 33]);
        *(u32x4*)(WT + (size_t)rm(n0 + n) * ldt + k0 + 8 * c) = o; }
    LDS_WAIT(); asm volatile("" ::: "memory");
}
struct RmId { __device__ __forceinline__ int operator()(int n) const { return n; } };
struct RmW13 { int off; __device__ __forceinline__ int operator()(int n) const { return 256 * (n >> 7) + off + (n & 127); } };

__device__ __forceinline__ void p0_prologue(Frame& F, ArgsP a) {
    unsigned char* ws = F.ws;
    LAS float* scr = (LAS float*)(F.lds + F.wave * 16384);
    const int gw = F.bid * 8 + F.wave, NGW = F.G * 8;
    constexpr int I_WIN = (DM / 64) * (IN_TOTAL / 32), I_SQ = (DM / 64) * (DM / 32), I_WKV = (DM / 64) * (4096 / 32), I_W1 = (DM / 64) * (DEXP / 32), I_W2 = (DEXP / 64) * (DM / 32);
    constexpr int PER_L = I_WIN + I_SQ + I_WKV + I_SQ + NEXP * (2 * I_W1 + I_W2);
    for (int it = gw; it < DEPTH * PER_L; it += NGW) {
        const int l = it / PER_L; int r = it % PER_L;
        if (r < I_WIN) { const int nb = IN_TOTAL / 32; transpose_item(a->in[I_W_IN] + (size_t)l * DM * IN_TOTAL, IN_TOTAL, (bf16*)(ws + WS_WIN) + (size_t)l * ZLD * DM, DM, RmId{}, scr, 64 * (r / nb), 32 * (r % nb), F.lane); continue; } r -= I_WIN;
        if (r < I_SQ) { const int nb = DM / 32; transpose_item(a->in[I_W_OUT] + (size_t)l * DM * DM, DM, (bf16*)(ws + WS_WOUT) + (size_t)l * DM * DM, DM, RmId{}, scr, 64 * (r / nb), 32 * (r % nb), F.lane); continue; } r -= I_SQ;
        if (r < I_WKV) { const int nb = 4096 / 32; transpose_item(a->in[I_XA_WKV] + (size_t)l * DM * 4096, 4096, (bf16*)(ws + SC_WKVT) + (size_t)l * 4096 * DM, DM, RmId{}, scr, 64 * (r / nb), 32 * (r % nb), F.lane); continue; } r -= I_WKV;
        if (r < I_SQ) { const int nb = DM / 32; transpose_item(a->in[I_XA_WO] + (size_t)l * DM * DM, DM, (bf16*)(ws + SC_WOT) + (size_t)l * DM * DM, DM, RmId{}, scr, 64 * (r / nb), 32 * (r % nb), F.lane); continue; } r -= I_SQ;
        const int e = r / (2 * I_W1 + I_W2); r = r % (2 * I_W1 + I_W2);
        const size_t le = (size_t)l * NEXP + e;
        if (r < I_W1) { const int nb = DEXP / 32; transpose_item(a->in[I_MOE_W1] + le * DM * DEXP, DEXP, (bf16*)(ws + WS_W13) + le * 1024 * DM, DM, RmW13{0}, scr, 64 * (r / nb), 32 * (r % nb), F.lane); continue; } r -= I_W1;
        if (r < I_W1) { const int nb = DEXP / 32; transpose_item(a->in[I_MOE_W3] + le * DM * DEXP, DEXP, (bf16*)(ws + WS_W13) + le * 1024 * DM, DM, RmW13{128}, scr, 64 * (r / nb), 32 * (r % nb), F.lane); continue; } r -= I_W1;
        { const int nb = DM / 32; transpose_item(a->in[I_MOE_W2] + le * DEXP * DM, DM, (bf16*)(ws + WS_W2) + le * DM * DEXP, DEXP, RmId{}, scr, 64 * (r / nb), 32 * (r % nb), F.lane); }
    }
    const int gt = F.bid * 512 + F.tid, NGT = F.G * 512;
    for (int i = gt; i < DEPTH * (ZLD - IN_TOTAL) * DM / 8; i += NGT) { const int l = i / ((ZLD - IN_TOTAL) * DM / 8), r = i % ((ZLD - IN_TOTAL) * DM / 8);
        *(u32x4*)((bf16*)(ws + WS_WIN) + (size_t)l * ZLD * DM + (size_t)IN_TOTAL * DM + (size_t)r * 8) = (u32x4){0u, 0u, 0u, 0u}; }
    for (int i = gt; i < DEPTH * DM * DM / 8; i += NGT) { const f32x4 x0 = *(const f32x4*)(a->in[I_XA_WQ] + (size_t)i * 8), x1 = *(const f32x4*)(a->in[I_XA_WQ] + (size_t)i * 8 + 4);
        u32x4 o; o.x = pk2(x0[0], x0[1]); o.y = pk2(x0[2], x0[3]); o.z = pk2(x1[0], x1[1]); o.w = pk2(x1[2], x1[3]); *(u32x4*)((bf16*)(ws + SC_WQB) + (size_t)i * 8) = o; }
    { float* cosA = (float*)(ws + WS_ROPE); float* sinA = cosA + SEQ * 32; float* cosC = sinA + SEQ * 32; float* sinC = cosC + SEQ * 64;
      for (int i = gt; i < SEQ * 96; i += NGT) { const int s = i / 96, j = i % 96; const bool isA = j < 32; const int jj = isA ? j : j - 32; const float dim = isA ? 64.f : 128.f;
          const float inv = 1.0f / powf(10000.0f, (float)(2 * jj) / dim); const float ang = (float)s * inv; float sn, cs; sincosf(ang, &sn, &cs);
          if (isA) { cosA[s * 32 + jj] = cs; sinA[s * 32 + jj] = sn; } else { cosC[s * 64 + jj] = cs; sinC[s * 64 + jj] = sn; } } }
    for (int i = gt; i < DEPTH * 2 * 32 * 64; i += NGT) { const int l = i / (2 * 32 * 64), r = i % (2 * 32 * 64), dir = r / (32 * 64), g = (r / 64) % 32, n = r % 64;
        float* ab = (float*)(ws + WS_S5P + l * S5P_LAYER); float* bb = ab + 2 * 32 * 64 * 2;
        const size_t pi = (((size_t)l * 2 + dir) * 32 + g) * 64 + n;
        const float lr = fminf(a->in[I_S5_A_RE][pi], -1e-4f), li = a->in[I_S5_A_IM][pi], dt = __expf(a->in[I_S5_LOG_DT][((size_t)l * 2 + dir) * 32 + g]);
        const float mag = __expf(dt * lr); float sn, cs; sincosf(dt * li, &sn, &cs); const float abr = mag * cs, abi = mag * sn;
        const float den = lr * lr + li * li; const float ir = lr / den, ii = -li / den;
        const float fr_ = (abr - 1.f) * ir - abi * ii, fi_ = (abr - 1.f) * ii + abi * ir;
        ab[(size_t)r * 2] = abr; ab[(size_t)r * 2 + 1] = abi;
        const size_t bi = (((size_t)l * 32 + g) * 64 + n) * 16;
#pragma unroll
        for (int c = 0; c < 16; ++c) { const float br = a->in[I_S5_B_RE][bi + c], bim = a->in[I_S5_B_IM][bi + c];
            bb[((size_t)r * 16 + c) * 2] = fr_ * br - fi_ * bim; bb[((size_t)r * 16 + c) * 2 + 1] = fr_ * bim + fi_ * br; } }
    for (int it = gw; it < DEPTH * BATCH * NMEM; it += NGW) { const int l = it / (BATCH * NMEM), row = it % (BATCH * NMEM);
        const f32x4* xr = (const f32x4*)(a->in[I_MEM] + (size_t)row * DM) + F.lane; const f32x4* gr = (const f32x4*)(a->in[I_NORM_MEM] + (size_t)l * DM) + F.lane;
        f32x4 v[8]; float s = 0.f;
#pragma unroll
        for (int j = 0; j < 8; ++j) { v[j] = xr[64 * j]; s += (v[j].x * v[j].x + v[j].y * v[j].y) + (v[j].z * v[j].z + v[j].w * v[j].w); }
        const float rstd = 1.f / sqrtf(wave_sum(s) * (1.f / DM) + RMS_EPS);
        u32x2* o8 = (u32x2*)((bf16*)(ws + SC_MEMN) + ((size_t)l * 512 + row) * DM) + F.lane;
#pragma unroll
        for (int j = 0; j < 8; ++j) { const f32x4 gv = gr[64 * j]; u32x2 w; w.x = pk2(v[j].x * rstd * gv.x, v[j].y * rstd * gv.y); w.y = pk2(v[j].z * rstd * gv.z, v[j].w * rstd * gv.w); o8[64 * j] = w; } }
}

struct SchedDense { const char* A; const char* B; char* C; int nM, nN, G, c, lda, ldb, ldcb  , cesz  ;
    __device__ __forceinline__ bool next(int i, pg8::Unit& u) const { const long L = (long)i * G + c; if (L >= (long)nM * nN) return false; int pm, pn; pg8::xcd_tile((int)L, nM, nN, pm, pn);
        u.A = A + (size_t)pm * 256 * lda * 2; u.B = B + (size_t)pn * 256 * ldb * 2; u.C = C + (size_t)pm * 256 * ldcb + (size_t)pn * 256 * cesz; u.row0 = pm * 256; u.col0 = pn * 256; u.aux = 0; return true; }
    __device__ __forceinline__ int arow(const pg8::Unit&, int r) const { return r; } };
struct SchedBatch { const char* A; const char* B; char* C; size_t sA, sB, sC; int nM, nN, nb, G, c, lda, ldb, ldcb, cesz, rowsPerBatch;
    __device__ __forceinline__ bool next(int i, pg8::Unit& u) const { const long L = (long)i * G + c; const int per = nM * nN; if (L >= (long)per * nb) return false; const int b = (int)(L / per), r = (int)(L % per), pm = r / nN, pn = r % nN;
        u.A = A + b * sA + (size_t)pm * 256 * lda * 2; u.B = B + b * sB + (size_t)pn * 256 * ldb * 2; u.C = C + b * sC + (size_t)pm * 256 * ldcb + (size_t)pn * 256 * cesz; u.row0 = b * rowsPerBatch + pm * 256; u.col0 = pn * 256; u.aux = b; return true; }
    __device__ __forceinline__ int arow(const pg8::Unit&, int r) const { return r; } };
struct SchedXaPre { unsigned char* ws; int G, c, kind;
    __device__ __forceinline__ bool next(int i, pg8::Unit& u) const { const long L = (long)i * G + c; if (L >= 128) return false; const int r = (int)L, p = r >> 3, t = r & 7, l = p >> 3, b = (p >> 2) & 1, h = p & 3;
        const bf16* kvb = (const bf16*)(ws + SC_KVB) + (size_t)l * 512 * 4096 + (size_t)(b * 256) * 4096;
        if (kind == 0) { u.A = (const char*)(kvb + h * 512); u.B = (const char*)((const bf16*)(ws + SC_WQB) + (size_t)l * DM * DM + (size_t)(t * 256) * DM + h * 512);
            u.C = (char*)((bf16*)(ws + WS_WQK) + ((size_t)(l * 2 + b) * 1024 + h * 256) * DM + t * 256); u.aux = DM; }
        else { u.A = (const char*)((const bf16*)(ws + SC_WOT) + (size_t)l * DM * DM + (size_t)(t * 256) * DM + h * 512); u.B = (const char*)(kvb + 2048 + h * 512);
            u.C = (char*)((bf16*)(ws + WS_VWO) + ((size_t)(l * 2 + b) * DM + t * 256) * 1024 + h * 256); u.aux = 1024; }
        u.row0 = 0; u.col0 = 0; return true; }
    __device__ __forceinline__ int arow(const pg8::Unit&, int r) const { return r; } };
struct EpiBf16U { static constexpr bool PERM = true, AFTER_DRAIN = false;
    __device__ __forceinline__ void operator()(const pg8::Acc& acc, const pg8::Unit& u, int wr, int wc, int fr, int fq) const { pg8::EpiBf16 e{u.aux}; e(acc, u, wr, wc, fr, fq); } };
struct SchedMoe { unsigned char* ws; const volatile LAS int* tp; const volatile LAS int* cnt; int layer, G, c, which;
    __device__ __forceinline__ bool next(int i, pg8::Unit& u) const {
        const int npn = which == 0 ? 4 : 8; const long L = (long)i * G + c; const int ntile = tp[32]; if (L >= (long)ntile * npn) return false;
        const int mt = (int)(L / npn), pn = (int)(L % npn); int e = 0;
#pragma unroll 1
        for (int k = 1; k < 32; ++k) e += (mt >= tp[k]) ? 1 : 0;
        const int lt = mt - tp[e]; const int nvalid = min(256, cnt[e] - lt * 256);
        u.row0 = lt * 256; u.col0 = pn * 256; u.aux = (e << 16) | nvalid;
        if (which == 0) { u.A = (const char*)(ws + WS_HN); u.B = (const char*)((const bf16*)(ws + WS_W13) + ((size_t)(layer * NEXP + e) * 1024 + pn * 256) * DM);
            u.C = (char*)((bf16*)(ws + SC_HMID) + (size_t)(mt * 256) * DEXP + pn * 128); }
        else { u.A = (const char*)((const bf16*)(ws + SC_HMID) + (size_t)(mt * 256) * DEXP); u.B = (const char*)((const bf16*)(ws + WS_W2) + ((size_t)(layer * NEXP + e) * DM + pn * 256) * DEXP);
            u.C = (char*)((bf16*)(ws + SC_YBUF) + (size_t)(mt * 256) * DM + pn * 256); }
        return true; }
    __device__ __forceinline__ int arow(const pg8::Unit& u, int r) const { const int e = u.aux >> 16, nvalid = u.aux & 0xffff; const int idx = (r < nvalid) ? (u.row0 + r) : u.row0;
        return ((const int*)(ws + WS_ETOK))[(size_t)e * ECAP + idx]; } };

__device__ __forceinline__ void moe_prefix(Frame& F, int layer, volatile LAS int* tp, volatile LAS int* cnt) {
    __syncthreads();
    if (F.tid < 32) cnt[F.tid] = (int)__hip_atomic_load(F.ctl + CW_CNT + layer * 64 + F.tid, __ATOMIC_RELAXED, __HIP_MEMORY_SCOPE_AGENT);
    __syncthreads();
    if (F.tid == 0) { int s = 0; for (int e = 0; e < 32; ++e) { tp[e] = s; s += (cnt[e] + 255) >> 8; } tp[32] = s; }
    __syncthreads();
}
template <int MODE>
__device__ __forceinline__ void norm_phase(Frame& F, ArgsP a, const float* src, const float* gain, int layer) {
    unsigned char* ws = F.ws; float* H = (float*)(ws + WS_H); bf16* HN = (bf16*)(ws + WS_HN);
    volatile LAS int* tp = (volatile LAS int*)(F.lds + 1024); volatile LAS int* cnt = tp + 40;
    if (MODE & 1) moe_prefix(F, layer - 1, tp, cnt);
    const int gw = F.bid * 8 + F.wave, NGW = F.G * 8;
    const f32x4* gr = (const f32x4*)gain + F.lane;
    for (int row = gw; row < NTOK; row += NGW) {
        const f32x4* xr = (const f32x4*)(src + (size_t)row * DM) + F.lane;
        f32x4 v[8];
#pragma unroll
        for (int j = 0; j < 8; ++j) v[j] = xr[64 * j];
        if (MODE & 1) {
            const int* ti = (const int*)(ws + WS_TINFO) + (size_t)row * 4;
            const int e0 = ti[0], p0 = ti[1], e1 = ti[2], p1 = ti[3];
            const size_t s0 = (size_t)tp[e0] * 256 + p0, s1 = (size_t)tp[e1] * 256 + p1;
            const u32x2* y0 = (const u32x2*)((const bf16*)(ws + SC_YBUF) + s0 * DM) + F.lane; const u32x2* y1 = (const u32x2*)((const bf16*)(ws + SC_YBUF) + s1 * DM) + F.lane;
#pragma unroll
            for (int j = 0; j < 8; ++j) { const u32x2 a0 = y0[64 * j], a1 = y1[64 * j];
                v[j].x += __uint_as_float(a0.x << 16) + __uint_as_float(a1.x << 16); v[j].y += __uint_as_float(a0.x & 0xffff0000u) + __uint_as_float(a1.x & 0xffff0000u);
                v[j].z += __uint_as_float(a0.y << 16) + __uint_as_float(a1.y << 16); v[j].w += __uint_as_float(a0.y & 0xffff0000u) + __uint_as_float(a1.y & 0xffff0000u); }
            if (!(MODE & 4)) { f32x4* hr = (f32x4*)(H + (size_t)row * DM) + F.lane;
#pragma unroll
                for (int j = 0; j < 8; ++j) hr[64 * j] = v[j]; }
        }
        float s = 0.f;
#pragma unroll
        for (int j = 0; j < 8; ++j) s += (v[j].x * v[j].x + v[j].y * v[j].y) + (v[j].z * v[j].z + v[j].w * v[j].w);
        const float rstd = 1.f / sqrtf(wave_sum(s) * (1.f / DM) + RMS_EPS);
#pragma unroll
        for (int j = 0; j < 8; ++j) { const f32x4 gv = gr[64 * j]; v[j].x *= rstd * gv.x; v[j].y *= rstd * gv.y; v[j].z *= rstd * gv.z; v[j].w *= rstd * gv.w; }
        if (MODE & 4) { f32x4* orow = (f32x4*)(a->out + (size_t)row * DM) + F.lane;
#pragma unroll
            for (int j = 0; j < 8; ++j) orow[64 * j] = v[j]; }
        else { u32x2* o8 = (u32x2*)(HN + (size_t)row * DM) + F.lane;
#pragma unroll
            for (int j = 0; j < 8; ++j) { u32x2 w; w.x = pk2(v[j].x, v[j].y); w.y = pk2(v[j].z, v[j].w); o8[64 * j] = w; } }
        if (MODE & 2) {
            const float* wg = a->in[I_ROUTER_GROUP] + (size_t)layer * DM * 4; const float* we = a->in[I_ROUTER_EXPERT] + (size_t)layer * DM * 32;
            float lg[4] = {0.f, 0.f, 0.f, 0.f};
#pragma unroll 2
            for (int j = 0; j < 8; ++j) { const int k0 = (64 * j + F.lane) * 4;
#pragma unroll
                for (int q = 0; q < 4; ++q) { const f32x4 w4 = *(const f32x4*)(wg + (size_t)(k0 + q) * 4); const float x = v[j][q]; lg[0] += x * w4.x; lg[1] += x * w4.y; lg[2] += x * w4.z; lg[3] += x * w4.w; } }
#pragma unroll
            for (int q = 0; q < 4; ++q) lg[q] = wave_sum(lg[q]);
            int gi = 0; float gm = lg[0];
#pragma unroll
            for (int q = 1; q < 4; ++q) if (lg[q] > gm) { gm = lg[q]; gi = q; }
            const float gw_ = 1.f / (__expf(lg[0] - gm) + __expf(lg[1] - gm) + __expf(lg[2] - gm) + __expf(lg[3] - gm));
            float le[8] = {0.f, 0.f, 0.f, 0.f, 0.f, 0.f, 0.f, 0.f};
#pragma unroll 2
            for (int j = 0; j < 8; ++j) { const int k0 = (64 * j + F.lane) * 4;
#pragma unroll
                for (int q = 0; q < 4; ++q) { const float* wp = we + (size_t)(k0 + q) * 32 + gi * 8; const f32x4 wa = *(const f32x4*)wp, wb = *(const f32x4*)(wp + 4); const float x = v[j][q];
                    le[0] += x * wa.x; le[1] += x * wa.y; le[2] += x * wa.z; le[3] += x * wa.w; le[4] += x * wb.x; le[5] += x * wb.y; le[6] += x * wb.z; le[7] += x * wb.w; } }
#pragma unroll
            for (int q = 0; q < 8; ++q) le[q] = wave_sum(le[q]);
            int i0 = 0; float m0 = le[0];
#pragma unroll
            for (int q = 1; q < 8; ++q) if (le[q] > m0) { m0 = le[q]; i0 = q; }
            int i1 = -1; float m1 = -3.0e38f;
#pragma unroll
            for (int q = 0; q < 8; ++q) if (q != i0 && le[q] > m1) { m1 = le[q]; i1 = q; }
            const float t = __expf(m1 - m0); const float w0 = 1.f / (1.f + t), w1 = t / (1.f + t);
            if (F.lane == 0) {
                const int e0 = gi * 8 + i0, e1 = gi * 8 + i1;
                const int p0 = (int)__hip_atomic_fetch_add(F.ctl + CW_CNT + layer * 64 + e0, 1u, __ATOMIC_RELAXED, __HIP_MEMORY_SCOPE_AGENT);
                const int p1 = (int)__hip_atomic_fetch_add(F.ctl + CW_CNT + layer * 64 + e1, 1u, __ATOMIC_RELAXED, __HIP_MEMORY_SCOPE_AGENT);
                int* et = (int*)(ws + WS_ETOK); float* eg = (float*)(ws + WS_EGATE); int* ti = (int*)(ws + WS_TINFO) + (size_t)row * 4;
                et[(size_t)e0 * ECAP + p0] = row; eg[(size_t)e0 * ECAP + p0] = gw_ * w0; et[(size_t)e1 * ECAP + p1] = row; eg[(size_t)e1 * ECAP + p1] = gw_ * w1;
                ti[0] = e0; ti[1] = p0; ti[2] = e1; ti[3] = p1;
            }
        }
    }
}

__device__ __forceinline__ void rope_token(Frame& F, bf16* zrow, int s) {
    const float* cosA = (const float*)(F.ws + WS_ROPE); const float* sinA = cosA + SEQ * 32; const float* cosC = sinA + SEQ * 32; const float* sinC = cosC + SEQ * 64;
    { const int i = F.lane & 31; const float cs = cosA[s * 32 + i], sn = sinA[s * 32 + i];
#pragma unroll
      for (int it = 0; it < 8; ++it) { bf16* p = zrow + ZA + (it * 2 + (F.lane >> 5)) * 64; const float x1 = bf2f(p[i]), x2 = bf2f(p[i + 32]); p[i] = f2bf(x1 * cs - x2 * sn); p[i + 32] = f2bf(x2 * cs + x1 * sn); } }
    { const int i = F.lane; const float cs = cosC[s * 64 + i], sn = sinC[s * 64 + i];
#pragma unroll
      for (int it = 0; it < 8; ++it) { bf16* p = zrow + ZC + it * 128; const float x1 = bf2f(p[i]), x2 = bf2f(p[i + 64]); p[i] = f2bf(x1 * cs - x2 * sn); p[i + 64] = f2bf(x2 * cs + x1 * sn); } }
}

constexpr int RWT = 8;
__device__ __forceinline__ void rwkv_prep_tile(Frame& F, ArgsP a, int layer, int tile) {
    unsigned char* ws = F.ws; const bf16* Z = (const bf16*)(ws + SC_Z);
    LAS float* zr = (LAS float*)F.lds; LAS float* act = zr + (RWT + 2) * IN_B;
    const int t0 = tile * RWT; const int b = t0 / SEQ, s0 = t0 % SEQ;
    __syncthreads();
    for (int i = F.tid; i < (RWT + 2) * (IN_B / 8); i += 512) { const int rr = i / (IN_B / 8), c8 = i % (IN_B / 8); const int s = s0 - 1 + rr;
        f32x4 lo = {0.f, 0.f, 0.f, 0.f}, hi = {0.f, 0.f, 0.f, 0.f};
        if (s >= 0 && s < SEQ) { const u32x4 w = *(const u32x4*)(Z + (size_t)(b * SEQ + s) * ZLD + ZB + c8 * 8);
            lo = (f32x4){__uint_as_float(w.x << 16), __uint_as_float(w.x & 0xffff0000u), __uint_as_float(w.y << 16), __uint_as_float(w.y & 0xffff0000u)};
            hi = (f32x4){__uint_as_float(w.z << 16), __uint_as_float(w.z & 0xffff0000u), __uint_as_float(w.w << 16), __uint_as_float(w.w & 0xffff0000u)}; }
        *(LAS f32x4*)(zr + rr * IN_B + c8 * 8) = lo; *(LAS f32x4*)(zr + rr * IN_B + c8 * 8 + 4) = hi; }
    __syncthreads();
    const float* mu = a->in[I_RWKV_MU] + (size_t)layer * 2 * IN_B;
#define ZS(t, col) (zr[((t) + 1) * IN_B + (col)] + mu[(col)] * (zr[(t) * IN_B + (col)] - zr[((t) + 1) * IN_B + (col)]) + mu[IN_B + (col)] * (zr[((t) + 2) * IN_B + (col)] - zr[((t) + 1) * IN_B + (col)]))
    for (int i = F.tid; i < RWT * 384; i += 512) { const int t = i / 384, j = i % 384; const int col = 1536 + j; const float x = ZS(t, col);
        act[t * 384 + j] = (j < 128) ? tanhf(x) : ((j < 256) ? x : sigmoidf_(x)); }
    __syncthreads();
    const int c = F.tid;
    float aw0[RWT], aw1[RWT], aa0[RWT], aa1[RWT], ag[RWT];
#pragma unroll
    for (int t = 0; t < RWT; ++t) { aw0[t] = 0.f; aw1[t] = 0.f; aa0[t] = 0.f; aa1[t] = 0.f; ag[t] = 0.f; }
    const float* w2 = a->in[I_RWKV_W2] + (size_t)layer * 2 * 64 * 512; const float* a2 = a->in[I_RWKV_A2] + (size_t)layer * 2 * 64 * 512; const float* g2 = a->in[I_RWKV_G2] + (size_t)layer * 128 * 512;
#pragma unroll 1
    for (int r = 0; r < 64; r += 4) {
        float wv0[4], wv1[4], av0[4], av1[4];
#pragma unroll
        for (int q = 0; q < 4; ++q) { wv0[q] = w2[(size_t)(r + q) * 512 + c]; wv1[q] = w2[(size_t)(64 + r + q) * 512 + c]; av0[q] = a2[(size_t)(r + q) * 512 + c]; av1[q] = a2[(size_t)(64 + r + q) * 512 + c]; }
#pragma unroll
        for (int t = 0; t < RWT; ++t) { const f32x4 x0 = *(const LAS f32x4*)(act + t * 384 + r), x1 = *(const LAS f32x4*)(act + t * 384 + 64 + r), y0 = *(const LAS f32x4*)(act + t * 384 + 128 + r), y1 = *(const LAS f32x4*)(act + t * 384 + 192 + r);
#pragma unroll
            for (int q = 0; q < 4; ++q) { aw0[t] += x0[q] * wv0[q]; aw1[t] += x1[q] * wv1[q]; aa0[t] += y0[q] * av0[q]; aa1[t] += y1[q] * av1[q]; } }
    }
#pragma unroll 1
    for (int r = 0; r < 128; r += 4) {
        float gv[4];
#pragma unroll
        for (int q = 0; q < 4; ++q) gv[q] = g2[(size_t)(r + q) * 512 + c];
#pragma unroll
        for (int t = 0; t < RWT; ++t) { const f32x4 x = *(const LAS f32x4*)(act + t * 384 + 256 + r);
#pragma unroll
            for (int q = 0; q < 4; ++q) ag[t] += x[q] * gv[q]; }
    }
    const float w00 = a->in[I_RWKV_W0][(size_t)layer * 1024 + c], w01 = a->in[I_RWKV_W0][(size_t)layer * 1024 + 512 + c];
    const float a00 = a->in[I_RWKV_A0][(size_t)layer * 1024 + c], a01 = a->in[I_RWKV_A0][(size_t)layer * 1024 + 512 + c];
    const float kkw = a->in[I_RWKV_KK][(size_t)layer * 512 + c], kaw = a->in[I_RWKV_KA][(size_t)layer * 512 + c];
    float* RW = (float*)(ws + SC_RW); const size_t N1 = (size_t)NTOK * 512;
#pragma unroll
    for (int t = 0; t < RWT; ++t) {
        const float r_ = ZS(t, c), k_ = ZS(t, 512 + c), v_ = ZS(t, 1024 + c);
        const float x0 = -(w00 + aw0[t]), x1 = -(w01 + aw1[t]);
        const float sp0 = fmaxf(x0, 0.f) + log1pf(__expf(-fabsf(x0))), sp1 = fmaxf(x1, 0.f) + log1pf(__expf(-fabsf(x1)));
        const float d0 = __expf(-__expf(-sp0 - 0.5f)), d1 = __expf(-__expf(-sp1 - 0.5f));
        const float al0 = sigmoidf_(a00 + aa0[t]), al1 = sigmoidf_(a01 + aa1[t]);
        float kk = k_ * kkw; const float ssq = wave_sum(kk * kk); kk *= 1.f / sqrtf(ssq + 1e-12f);
        const float km0 = k_ * (1.f + (al0 - 1.f) * kaw), km1 = k_ * (1.f + (al1 - 1.f) * kaw);
        const size_t o = (size_t)(t0 + t) * 512 + c;
        RW[0 * N1 + o] = r_; RW[1 * N1 + o] = v_; RW[2 * N1 + o] = kk; RW[3 * N1 + o] = d0; RW[4 * N1 + o] = d1;
        RW[5 * N1 + o] = km0; RW[6 * N1 + o] = km1; RW[7 * N1 + o] = kk * al0; RW[8 * N1 + o] = kk * al1; RW[9 * N1 + o] = ag[t];
    }
#undef ZS
}

__device__ __forceinline__ void s5_carry_task(Frame& F, int layer, int task) {
    unsigned char* ws = F.ws; const bf16* Z = (const bf16*)(ws + SC_Z);
    const int dir = task & 1, g = (task >> 1) & 31, b = task >> 6; const int n = F.lane;
    const float* ab = (const float*)(ws + WS_S5P + layer * S5P_LAYER); const float* bb = ab + 2 * 32 * 64 * 2;
    const int pr = (dir * 32 + g) * 64 + n;
    const float abr = ab[pr * 2], abi = ab[pr * 2 + 1];
    float bbr[16], bbi[16];
#pragma unroll
    for (int c = 0; c < 16; ++c) { bbr[c] = bb[((size_t)pr * 16 + c) * 2]; bbi[c] = bb[((size_t)pr * 16 + c) * 2 + 1]; }
    LAS float* ul = (LAS float*)(F.lds + 65536 + F.wave * 4096);
    float* carry = (float*)(ws + SC_CARRY);
    float xr = 0.f, xi = 0.f;
    for (int blk = 0; blk < SEQ / 64; ++blk) {
        { const int sl = dir ? (SEQ - 1 - (blk * 64 + n)) : (blk * 64 + n); const bf16* zp = Z + (size_t)(b * SEQ + sl) * ZLD + ZD + g * 16;
          const u32x4 w0 = *(const u32x4*)zp, w1 = *(const u32x4*)(zp + 8);
          LAS f32x4* d = (LAS f32x4*)(ul + n * 16);
          d[0] = (f32x4){__uint_as_float(w0.x << 16), __uint_as_float(w0.x & 0xffff0000u), __uint_as_float(w0.y << 16), __uint_as_float(w0.y & 0xffff0000u)};
          d[1] = (f32x4){__uint_as_float(w0.z << 16), __uint_as_float(w0.z & 0xffff0000u), __uint_as_float(w0.w << 16), __uint_as_float(w0.w & 0xffff0000u)};
          d[2] = (f32x4){__uint_as_float(w1.x << 16), __uint_as_float(w1.x & 0xffff0000u), __uint_as_float(w1.y << 16), __uint_as_float(w1.y & 0xffff0000u)};
          d[3] = (f32x4){__uint_as_float(w1.z << 16), __uint_as_float(w1.z & 0xffff0000u), __uint_as_float(w1.w << 16), __uint_as_float(w1.w & 0xffff0000u)}; }
        LDS_WAIT(); asm volatile("" ::: "memory");
#pragma unroll 4
        for (int i = 0; i < 64; ++i) {
            const int step = blk * 64 + i;
            if ((step & (S5CH - 1)) == 0) { const int sl = dir ? (SEQ - 1 - step) : step; const int ch = sl / S5CH;
                float* cp = carry + ((((size_t)dir * BATCH + b) * S5NCH + ch) * 32 + g) * 128 + n * 2; cp[0] = xr; cp[1] = xi; }
            const f32x4 u0 = *(const LAS f32x4*)(ul + i * 16), u1 = *(const LAS f32x4*)(ul + i * 16 + 4), u2 = *(const LAS f32x4*)(ul + i * 16 + 8), u3 = *(const LAS f32x4*)(ul + i * 16 + 12);
            float br = 0.f, bi = 0.f;
#pragma unroll
            for (int c = 0; c < 4; ++c) { br += bbr[c] * u0[c] + bbr[4 + c] * u1[c] + bbr[8 + c] * u2[c] + bbr[12 + c] * u3[c]; bi += bbi[c] * u0[c] + bbi[4 + c] * u1[c] + bbi[8 + c] * u2[c] + bbi[12 + c] * u3[c]; }
            const float nr = abr * xr - abi * xi + br, ni = abr * xi + abi * xr + bi; xr = nr; xi = ni;
        }
        asm volatile("" ::: "memory");
    }
}

__device__ __forceinline__ void prep_phase(Frame& F, ArgsP a, int layer) {
    const int q = layer * 8 + 0;
    for (;;) { const int it = q_next(F, q);
        if (it < 16) { s5_carry_task(F, layer, it * 8 + F.wave); continue; }
        if (it < 16 + NTOK / RWT) { rwkv_prep_tile(F, a, layer, it - 16); continue; }
        const int r = it - 16 - NTOK / RWT; if (r >= NTOK / 64) break;
        for (int k = 0; k < 8; ++k) { const int tok = r * 64 + F.wave * 8 + k; rope_token(F, (bf16*)(F.ws + SC_Z) + (size_t)tok * ZLD, tok % SEQ); }
    }
}

__device__ __forceinline__ void rwkv_scan_naive(Frame& F, int chain) {
    unsigned char* ws = F.ws; const float* RW = (const float*)(ws + SC_RW); const size_t N1 = (size_t)NTOK * 512;
    const int dir = chain & 1, h = (chain >> 1) & 7, b = chain >> 4;
    const float* Rp = RW; const float* Vp = RW + N1; const float* KKp = RW + 2 * N1; const float* Wp = RW + (3 + dir) * N1; const float* KMp = RW + (5 + dir) * N1; const float* BBp = RW + (7 + dir) * N1;
    float* YS = (float*)(ws + SC_YS) + (size_t)dir * N1;
    LAS float* L = (LAS float*)(F.lds + F.wave * 2048);
    float st[64];
#pragma unroll
    for (int j = 0; j < 64; ++j) st[j] = 0.f;
    size_t idx = (size_t)(b * SEQ + (dir ? SEQ - 1 : 0)) * 512 + h * 64 + F.lane;
    float va = -KKp[idx], vw = Wp[idx], vb = BBp[idx], vk = KMp[idx], vr = Rp[idx], vv = Vp[idx];
    for (int t = 0; t < SEQ; ++t) {
        L[F.lane] = va; L[64 + F.lane] = vw; L[128 + F.lane] = vb; L[192 + F.lane] = vk; L[256 + F.lane] = vr;
        const float v = vv; const size_t oidx = idx;
        if (t + 1 < SEQ) { idx = dir ? idx - 512 : idx + 512; va = -KKp[idx]; vw = Wp[idx]; vb = BBp[idx]; vk = KMp[idx]; vr = Rp[idx]; vv = Vp[idx]; }
        LDS_WAIT(); asm volatile("" ::: "memory");
        float sa0 = 0.f, sa1 = 0.f, sa2 = 0.f, sa3 = 0.f;
#pragma unroll
        for (int j = 0; j < 64; j += 4) { const f32x4 x = *(const LAS f32x4*)(L + j); sa0 += st[j] * x[0]; sa1 += st[j + 1] * x[1]; sa2 += st[j + 2] * x[2]; sa3 += st[j + 3] * x[3]; }
        const float sa = (sa0 + sa1) + (sa2 + sa3);
        float y0 = 0.f, y1 = 0.f, y2 = 0.f, y3 = 0.f;
#pragma unroll
        for (int j = 0; j < 64; j += 4) { const f32x4 w4 = *(const LAS f32x4*)(L + 64 + j), b4 = *(const LAS f32x4*)(L + 128 + j), k4 = *(const LAS f32x4*)(L + 192 + j), r4 = *(const LAS f32x4*)(L + 256 + j);
            st[j] = st[j] * w4[0] + (sa * b4[0] + v * k4[0]); st[j + 1] = st[j + 1] * w4[1] + (sa * b4[1] + v * k4[1]); st[j + 2] = st[j + 2] * w4[2] + (sa * b4[2] + v * k4[2]); st[j + 3] = st[j + 3] * w4[3] + (sa * b4[3] + v * k4[3]);
            y0 += st[j] * r4[0]; y1 += st[j + 1] * r4[1]; y2 += st[j + 2] * r4[2]; y3 += st[j + 3] * r4[3]; }
        YS[oidx] = (y0 + y1) + (y2 + y3);
        asm volatile("" ::: "memory");
    }
}

__device__ __forceinline__ void s5_unit(Frame& F, ArgsP a, int layer, int unit) {
    unsigned char* ws = F.ws; const bf16* Z = (const bf16*)(ws + SC_Z);
    const int b = unit / S5NCH, ch = unit % S5NCH; const int tok0 = b * SEQ + ch * S5CH;
    LAS float* ybuf = (LAS float*)F.lds;
    LAS float* glT = (LAS float*)(F.lds + 32768);
    LAS float* xs = (LAS float*)(F.lds + 65536 + F.wave * 8192);
    const float* ab = (const float*)(ws + WS_S5P + layer * S5P_LAYER); const float* bb = ab + 2 * 32 * 64 * 2;
    const float* carry = (const float*)(ws + SC_CARRY);
    const int n = F.lane;
    __syncthreads();
    for (int gi = 0; gi < 4; ++gi) {
        const int g = gi * 8 + F.wave;
#pragma unroll 1
        for (int dir = 0; dir < 2; ++dir) {
            const int pr = (dir * 32 + g) * 64 + n; const float abr = ab[pr * 2], abi = ab[pr * 2 + 1];
            float bbr[16], bbi[16];
#pragma unroll
            for (int c = 0; c < 16; ++c) { bbr[c] = bb[((size_t)pr * 16 + c) * 2]; bbi[c] = bb[((size_t)pr * 16 + c) * 2 + 1]; }
            const float* cp = carry + ((((size_t)dir * BATCH + b) * S5NCH + ch) * 32 + g) * 128 + n * 2; float xr = cp[0], xi = cp[1];
#pragma unroll 1
            for (int i = 0; i < S5CH; ++i) { const int tl = dir ? (S5CH - 1 - i) : i; const bf16* zp = Z + (size_t)(tok0 + tl) * ZLD + ZD + g * 16;
                const u32x4 w0 = *(const u32x4*)zp, w1 = *(const u32x4*)(zp + 8);
                const float u[16] = {__uint_as_float(w0.x << 16), __uint_as_float(w0.x & 0xffff0000u), __uint_as_float(w0.y << 16), __uint_as_float(w0.y & 0xffff0000u),
                                     __uint_as_float(w0.z << 16), __uint_as_float(w0.z & 0xffff0000u), __uint_as_float(w0.w << 16), __uint_as_float(w0.w & 0xffff0000u),
                                     __uint_as_float(w1.x << 16), __uint_as_float(w1.x & 0xffff0000u), __uint_as_float(w1.y << 16), __uint_as_float(w1.y & 0xffff0000u),
                                     __uint_as_float(w1.z << 16), __uint_as_float(w1.z & 0xffff0000u), __uint_as_float(w1.w << 16), __uint_as_float(w1.w & 0xffff0000u)};
                float br = 0.f, bi = 0.f;
#pragma unroll
                for (int c = 0; c < 16; ++c) { br += bbr[c] * u[c]; bi += bbi[c] * u[c]; }
                const float nr = abr * xr - abi * xi + br, ni = abr * xi + abi * xr + bi; xr = nr; xi = ni;
                LAS float* xp = xs + (tl * 64 + n) * 2;
                if (dir == 0) { xp[0] = xr; xp[1] = xi; } else { xp[0] += xr; xp[1] += xi; } }
        }
        LDS_WAIT(); asm volatile("" ::: "memory");
        { const int c = F.lane & 15, sq = F.lane >> 4; const float* cre = a->in[I_S5_C_RE] + (((size_t)layer * 32 + g) * 16 + c) * 64; const float* cim = a->in[I_S5_C_IM] + (((size_t)layer * 32 + g) * 16 + c) * 64;
          float y[4] = {0.f, 0.f, 0.f, 0.f};
#pragma unroll 4
          for (int nn = 0; nn < 64; nn += 4) { const f32x4 cr = *(const f32x4*)(cre + nn), ci = *(const f32x4*)(cim + nn);
#pragma unroll
              for (int s = 0; s < 4; ++s) { const LAS f32x4* xp = (const LAS f32x4*)(xs + ((sq * 4 + s) * 64 + nn) * 2); const f32x4 xa = xp[0], xb = xp[1];
                  y[s] += cr[0] * xa[0] - ci[0] * xa[1] + cr[1] * xa[2] - ci[1] * xa[3] + cr[2] * xb[0] - ci[2] * xb[1] + cr[3] * xb[2] - ci[3] * xb[3]; } }
          const float dsk = a->in[I_S5_D][(size_t)layer * 512 + g * 16 + c];
#pragma unroll
          for (int s = 0; s < 4; ++s) { const int tl = sq * 4 + s; const float uu = bf2f(Z[(size_t)(tok0 + tl) * ZLD + ZD + g * 16 + c]); const float yy = y[s] + dsk * uu;
              const float x3 = yy * yy * yy; const float gl = 0.5f * yy * (1.f + tanhf(0.7978845608028654f * (yy + 0.044715f * x3)));
              ybuf[tl * 512 + g * 16 + c] = gl; glT[(g * 16 + c) * 16 + tl] = gl; } }
        LDS_WAIT(); asm volatile("" ::: "memory");
    }
    __syncthreads();
    { const int c = F.tid; const float* gw = a->in[I_S5_GLU_W] + (size_t)layer * 512 * 512; float acc[16];
#pragma unroll
      for (int s = 0; s < 16; ++s) acc[s] = 0.f;
#pragma unroll 2
      for (int k = 0; k < 512; ++k) { const float w = gw[(size_t)k * 512 + c]; const LAS f32x4* gp = (const LAS f32x4*)(glT + k * 16); const f32x4 g0 = gp[0], g1 = gp[1], g2 = gp[2], g3 = gp[3];
#pragma unroll
          for (int q = 0; q < 4; ++q) { acc[q] += g0[q] * w; acc[4 + q] += g1[q] * w; acc[8 + q] += g2[q] * w; acc[12 + q] += g3[q] * w; } }
      const float bias = a->in[I_S5_GLU_B][(size_t)layer * 512 + c];
      __syncthreads();
#pragma unroll
      for (int s = 0; s < 16; ++s) { const float gl = ybuf[s * 512 + c]; ybuf[s * 512 + c] = gl * sigmoidf_(acc[s] + bias); } }
    __syncthreads();
    { const float* gn = a->in[I_MIX_OUT_NORM] + ((size_t)layer * 2 + 1) * 512; bf16* MIX = (bf16*)(ws + WS_MIX);
#pragma unroll
      for (int q = 0; q < 2; ++q) { const int tl = F.wave * 2 + q; float v[8]; float s = 0.f;
#pragma unroll
          for (int j = 0; j < 8; ++j) { v[j] = ybuf[tl * 512 + j * 64 + F.lane]; s += v[j] * v[j]; }
          const float rstd = 1.f / sqrtf(wave_sum(s) * (1.f / 512.f) + RMS_EPS);
#pragma unroll
          for (int j = 0; j < 8; ++j) MIX[(size_t)(tok0 + tl) * DM + 1536 + j * 64 + F.lane] = f2bf(v[j] * rstd * gn[j * 64 + F.lane]); } }
}

__device__ __forceinline__ void mix_phase(Frame& F, ArgsP a, int layer) {
    constexpr int NB = 4, NA = BATCH * 4 * (SEQ / 128), NC = BATCH * 4 * 48, ND = BATCH * S5NCH;
    for (;;) { const int it = q_next(F, layer * 8 + 1); if (it >= NB) break; rwkv_scan_naive(F, it * 8 + F.wave); }
    for (;;) { const int it = q_next(F, layer * 8 + 2); if (it >= NA) break;
        unsigned char* ws = F.ws; asm volatile("" : "+s"(ws)); const bf16* Z = (const bf16*)(ws + SC_Z);
        const int qb = it % (SEQ / 128), h = (it / (SEQ / 128)) % 4, b = it / (4 * (SEQ / 128));
        const bf16* zb = Z + (size_t)(b * SEQ) * ZLD + ZA;
        float lam, lam_init;
        { const float* lv = a->in[I_DIFF_LAMBDA] + (size_t)layer * 4 * 64; float d1 = 0.f, d2 = 0.f;
          for (int i = 0; i < 64; ++i) { d1 += lv[i] * lv[64 + i]; d2 += lv[128 + i] * lv[192 + i]; }
          lam_init = 0.8f - 0.6f * expf(-0.3f * (float)layer); lam = expf(d1) - expf(d2) + lam_init; }
        att::diff_attn_unit(zb + (size_t)(qb * 128) * ZLD + h * 128, zb + 512 + h * 128, zb + 1024 + h * 128, ZLD, SEQ,
                            (bf16*)(ws + WS_MIX) + (size_t)(b * SEQ + qb * 128) * DM + h * 128, DM, lam, 1.f - lam_init, a->in[I_DIFF_SUBLN] + (size_t)layer * 128, (char*)F.lds, F.wave); }
    for (;;) { const int it = q_next(F, layer * 8 + 3); if (it >= NC) break;
        unsigned char* ws = F.ws; asm volatile("" : "+s"(ws)); const bf16* Z = (const bf16*)(ws + SC_Z);
        const int r = it % 48, h = (it / 48) % 4, b = it / (48 * 4); const int p = r / 16, rr = r % 16;
        const int dil = p == 0 ? 1 : (p == 1 ? 4 : 16); const int L = SEQ / dil; const int nqb = L / 256; const int rho = rr / nqb, qb = rr % nqb;
        const bf16* zb = Z + (size_t)(b * SEQ) * ZLD + ZC;
        att::dil_attn_unit(zb + h * 128, zb + 512 + h * 128, zb + 1024 + h * 128, ZLD, dil, rho, qb * 256, L,
                           (float*)(ws + SC_OC) + ((size_t)p * NTOK + (size_t)b * SEQ) * 512 + h * 128, (float*)(ws + SC_LSE) + ((size_t)p * NTOK + (size_t)b * SEQ) * 4 + h, (char*)F.lds, F.wave); }
    for (;;) { const int it = q_next(F, layer * 8 + 4); if (it >= ND) break; s5_unit(F, a, layer, it); }
}

__device__ __forceinline__ void post_phase(Frame& F, ArgsP a, int layer) {
    unsigned char* ws = F.ws; bf16* MIX = (bf16*)(ws + WS_MIX);
    const int gw = F.bid * 8 + F.wave, NGW = F.G * 8;
    const float* RW = (const float*)(ws + SC_RW); const size_t N1 = (size_t)NTOK * 512; const float* YS = (const float*)(ws + SC_YS);
    for (int it = gw; it < NTOK * 8; it += NGW) { const int tok = it >> 3, h = it & 7; const size_t o = (size_t)tok * 512 + h * 64 + F.lane; const int c = h * 64 + F.lane;
        const float y = YS[o] + YS[N1 + o];
        const float mean = wave_sum(y) * (1.f / 64.f); const float d = y - mean; const float var = wave_sum(d * d) * (1.f / 64.f);
        const float yn = d * (1.f / sqrtf(var + 64e-5f)) * a->in[I_RWKV_LNX_W][(size_t)layer * 512 + c] + a->in[I_RWKV_LNX_B][(size_t)layer * 512 + c];
        const float r_ = RW[o], v_ = RW[N1 + o], kb = 0.5f * (RW[5 * N1 + o] + RW[6 * N1 + o]);
        const float bon = wave_sum(r_ * kb * a->in[I_RWKV_RK][(size_t)layer * 512 + c]) * v_;
        MIX[(size_t)tok * DM + 512 + c] = f2bf((yn + bon) * RW[9 * N1 + o]); }
    const float* OC = (const float*)(ws + SC_OC); const float* LSE = (const float*)(ws + SC_LSE); const float* gn = a->in[I_MIX_OUT_NORM] + ((size_t)layer * 2 + 0) * 512;
    for (int tok = gw; tok < NTOK; tok += NGW) { const int h = F.lane >> 4;
        const float l0 = LSE[((size_t)0 * NTOK + tok) * 4 + h], l1 = LSE[((size_t)1 * NTOK + tok) * 4 + h], l2 = LSE[((size_t)2 * NTOK + tok) * 4 + h];
        const float m = fmaxf(l0, fmaxf(l1, l2)); float w0 = __expf(l0 - m), w1 = __expf(l1 - m), w2 = __expf(l2 - m); const float inv = 1.f / (w0 + w1 + w2); w0 *= inv; w1 *= inv; w2 *= inv;
        float v[8]; float s = 0.f;
        const f32x4* p0 = (const f32x4*)(OC + ((size_t)0 * NTOK + tok) * 512) + F.lane * 2; const f32x4* p1 = (const f32x4*)(OC + ((size_t)1 * NTOK + tok) * 512) + F.lane * 2; const f32x4* p2 = (const f32x4*)(OC + ((size_t)2 * NTOK + tok) * 512) + F.lane * 2;
#pragma unroll
        for (int j = 0; j < 2; ++j) { const f32x4 a0 = p0[j], a1 = p1[j], a2 = p2[j];
#pragma unroll
            for (int e = 0; e < 4; ++e) { const float x = w0 * a0[e] + w1 * a1[e] + w2 * a2[e]; v[j * 4 + e] = x; s += x * x; } }
        const float rstd = 1.f / sqrtf(wave_sum(s) * (1.f / 512.f) + RMS_EPS);
        const f32x4 g0 = *((const f32x4*)gn + F.lane * 2), g1 = *((const f32x4*)gn + F.lane * 2 + 1);
        u32x4 w; w.x = pk2(v[0] * rstd * g0[0], v[1] * rstd * g0[1]); w.y = pk2(v[2] * rstd * g0[2], v[3] * rstd * g0[3]); w.z = pk2(v[4] * rstd * g1[0], v[5] * rstd * g1[1]); w.w = pk2(v[6] * rstd * g1[2], v[7] * rstd * g1[3]);
        *(u32x4*)(MIX + (size_t)tok * DM + 1024 + F.lane * 8) = w; }
}

#ifndef MK_FUSED
#define MK_FUSED 0
#endif
__global__ void __launch_bounds__(512, 2) enc_fwd(Args args_) {
    extern __shared__ __attribute__((aligned(16))) unsigned char lds_raw[];
    Frame F;
    F.lds = (LAS unsigned char*)lds_raw; F.MISC = (volatile LAS unsigned*)(F.lds + MISC_OFF);
    F.tid = threadIdx.x; F.lane = F.tid & 63; F.wave = __builtin_amdgcn_readfirstlane(F.tid >> 6); F.G = gridDim.x; F.bid = blockIdx.x;
    const int wave0 = F.wave;
    ArgsP ap = (ArgsP)__builtin_amdgcn_kernarg_segment_ptr();
    unsigned char* ws = ap->ws; F.ws = ws; F.ctl = (unsigned*)(ws + WS_CTL);
    for (int u = F.tid; u < (LDS_BYTES - MISC_OFF) / 4; u += 512) ((LAS unsigned*)(F.lds + MISC_OFF))[u] = 0u;
    __syncthreads();
    const int lo = ap->ph_lo, hi = ap->ph_hi;
    if (hi - lo > 1) (void)xcd_barrier_post(F.ctl + CW_BAR, F.MISC + 8);
#ifdef DBG_ONLY
#define IN(k) (((k) < PH_L0 ? (k) : ((k) == PH_FINAL ? 100 : 3 + ((k) - PH_L0) % NPH_L)) == DBG_ONLY && lo <= (k) && (k) < hi)
#else
#define IN(k) ({ int lo_ = lo, hi_ = hi; asm volatile("" : "+s"(lo_), "+s"(hi_)); lo_ <= (k) && (k) < hi_; })
#endif
#define args (*ap)
#define REFRESH() do { int wv_ = wave0, bi_ = blockIdx.x, gg_ = gridDim.x; asm volatile("" : "+s"(wv_), "+s"(bi_), "+s"(gg_)); const int t_ = tid_from_wave(wv_); F.tid = t_; F.lane = t_ & 63; F.wave = wv_; F.bid = bi_; F.G = gg_; ap = (ArgsP)__builtin_amdgcn_kernarg_segment_ptr(); asm volatile("" : "+s"(ap)); unsigned char* w_ = ap->ws; F.ws = w_; ws = w_; F.ctl = (unsigned*)(w_ + WS_CTL); } while (0)
#define SEAM(k) do { if (IN(k) && IN((k) + 1)) { XcdBarrier b_; b_.bar = (unsigned*)(ap->ws + WS_CTL) + CW_BAR; b_.x = xb_xcc_id(); b_.st = F.MISC + 8; xcd_barrier(b_); } } while (0)

    if (IN(PH_P0)) { REFRESH(); p0_prologue(F, ap); } SEAM(PH_P0);
    if (IN(PH_P1)) { REFRESH();
        SchedBatch S{(const char*)(ws + SC_MEMN), (const char*)(ws + SC_WKVT), (char*)(ws + SC_KVB), (size_t)512 * DM * 2, (size_t)4096 * DM * 2, (size_t)512 * 4096 * 2, 2, 16, DEPTH, F.G, F.bid, DM, DM, 4096 * 2, 2, 512};
        pg8::gemm_phase<pg8::EpiBf16, SchedBatch, false>(F.lds, pg8::GemmP{DM, DM, DM}, S, pg8::EpiBf16{4096}, F.wave);
    } SEAM(PH_P1);
    if (IN(PH_P2)) { REFRESH();
        { SchedXaPre S{ws, F.G, F.bid, 0}; pg8::gemm_phase<EpiBf16U, SchedXaPre, false>(F.lds, pg8::GemmP{512, 4096, DM}, S, EpiBf16U{}, F.wave); }
        { SchedXaPre S{ws, F.G, F.bid, 1}; pg8::gemm_phase<EpiBf16U, SchedXaPre, false>(F.lds, pg8::GemmP{512, DM, 4096}, S, EpiBf16U{}, F.wave); }
    } SEAM(PH_P2);

    for (int l = 0; l < DEPTH; ++l) {
        const int pb = PH_L0 + l * NPH_L;
        float* H = (float*)(ws + WS_H);
        if (IN(pb + LP_NORM1)) { REFRESH(); if (l == 0) norm_phase<0>(F, ap, args.in[I_X], args.in[I_NORM_MIX], l); else norm_phase<1>(F, ap, H, args.in[I_NORM_MIX] + (size_t)l * DM, l); } SEAM(pb + LP_NORM1);
        if (IN(pb + LP_G1)) { REFRESH();
            SchedDense S{(const char*)(ws + WS_HN), (const char*)(ws + WS_WIN) + (size_t)l * ZLD * DM * 2, (char*)(ws + SC_Z), NTOK / 256, ZLD / 256, F.G, F.bid, DM, DM, ZLD * 2, 2};
            pg8::gemm_phase<pg8::EpiBf16, SchedDense, false>(F.lds, pg8::GemmP{DM, DM, DM}, S, pg8::EpiBf16{ZLD}, F.wave);
        } SEAM(pb + LP_G1);
        if (IN(pb + LP_PREP)) { REFRESH(); prep_phase(F, ap, l); } SEAM(pb + LP_PREP);
        if (IN(pb + LP_MIX)) { REFRESH(); mix_phase(F, ap, l); } SEAM(pb + LP_MIX);
        if (IN(pb + LP_POST)) { REFRESH(); post_phase(F, ap, l); } SEAM(pb + LP_POST);
        if (IN(pb + LP_G2)) { REFRESH();
            SchedDense S{(const char*)(ws + WS_MIX), (const char*)(ws + WS_WOUT) + (size_t)l * DM * DM * 2, (char*)H, NTOK / 256, DM / 256, F.G, F.bid, DM, DM, DM * 4, 4};
            pg8::gemm_phase<pg8::EpiF32Res, SchedDense, false>(F.lds, pg8::GemmP{DM, DM, DM}, S, pg8::EpiF32Res{DM, l == 0 ? args.in[I_X] : (const float*)H, H}, F.wave);
        } SEAM(pb + LP_G2);
        if (IN(pb + LP_NORM2)) { REFRESH(); norm_phase<0>(F, ap, H, args.in[I_NORM_CROSS] + (size_t)l * DM, l); } SEAM(pb + LP_NORM2);
        if (IN(pb + LP_GS)) { REFRESH();
            SchedBatch S{(const char*)(ws + WS_HN), (const char*)(ws + WS_WQK) + (size_t)l * 2 * 1024 * DM * 2, (char*)(ws + WS_P), (size_t)SEQ * DM * 2, (size_t)1024 * DM * 2, (size_t)SEQ * 1024 * 2, SEQ / 256, 4, BATCH, F.G, F.bid, DM, DM, 1024 * 2, 2, SEQ};
            pg8::gemm_phase<pg8::EpiSoftmax, SchedBatch, false>(F.lds, pg8::GemmP{DM, DM, DM}, S, pg8::EpiSoftmax{1024, 0.044194173824159216f * 1.4426950408889634f}, F.wave);
        } SEAM(pb + LP_GS);
        if (IN(pb + LP_GO)) { REFRESH();
            SchedBatch S{(const char*)(ws + WS_P), (const char*)(ws + WS_VWO) + (size_t)l * 2 * DM * 1024 * 2, (char*)H, (size_t)SEQ * 1024 * 2, (size_t)DM * 1024 * 2, (size_t)SEQ * DM * 4, SEQ / 256, DM / 256, BATCH, F.G, F.bid, 1024, 1024, DM * 4, 4, SEQ};
            pg8::gemm_phase<pg8::EpiF32Res, SchedBatch, false>(F.lds, pg8::GemmP{1024, 1024, 1024}, S, pg8::EpiF32Res{DM, (const float*)H, H}, F.wave);
        } SEAM(pb + LP_GO);
        if (IN(pb + LP_NORM3)) { REFRESH(); norm_phase<2>(F, ap, H, args.in[I_NORM_MOE] + (size_t)l * DM, l); } SEAM(pb + LP_NORM3);
        if (IN(pb + LP_M1)) { REFRESH();
            volatile LAS int* tp = (volatile LAS int*)(F.lds + MISC_OFF + 256); volatile LAS int* cnt = tp + 40;
            moe_prefix(F, l, tp, cnt);
            SchedMoe S{ws, tp, cnt, l, F.G, F.bid, 0};
            pg8::gemm_phase<pg8::EpiSwiGlu, SchedMoe, true>(F.lds, pg8::GemmP{DM, DM, DM}, S, pg8::EpiSwiGlu{DEXP}, F.wave);
        } SEAM(pb + LP_M1);
        if (IN(pb + LP_M2)) { REFRESH();
            volatile LAS int* tp = (volatile LAS int*)(F.lds + MISC_OFF + 256); volatile LAS int* cnt = tp + 40;
            moe_prefix(F, l, tp, cnt);
            SchedMoe S{ws, tp, cnt, l, F.G, F.bid, 1};
            pg8::gemm_phase<pg8::EpiGate, SchedMoe, false>(F.lds, pg8::GemmP{DEXP, DEXP, DEXP}, S, pg8::EpiGate{DM, (const float*)(ws + WS_EGATE), nullptr}, F.wave);
        } SEAM(pb + LP_M2);
    }
    if (IN(PH_FINAL)) { REFRESH(); norm_phase<5>(F, ap, (const float*)(ws + WS_H), args.in[I_NORM_FINAL], DEPTH); }
#undef IN
#undef SEAM
#undef args
}

extern "C" void kernel_launch(void* const* d_in, const int* in_sizes, int n_in, void* d_out, int out_size, void* d_ws, size_t ws_size, hipStream_t stream) {
    static int grid = 0;
    if (grid == 0) {
        if (n_in != N_INPUTS || out_size != NTOK * DM || ws_size < WS_END) { fprintf(stderr, "kernel_launch: built for %d inputs, out %d, ws >= %zu; got %d, %d, %zu\n", N_INPUTS, NTOK * DM, WS_END, n_in, out_size, ws_size); grid = -1; return; }
        int dev = 0, cus = 0, per_cu = 0;
        if (hipGetDevice(&dev) != hipSuccess || hipDeviceGetAttribute(&cus, hipDeviceAttributeMultiprocessorCount, dev) != hipSuccess) { fprintf(stderr, "kernel_launch: device query failed\n"); grid = -1; return; }
        if (hipFuncSetAttribute((const void*)enc_fwd, hipFuncAttributeMaxDynamicSharedMemorySize, LDS_BYTES) != hipSuccess) { fprintf(stderr, "kernel_launch: hipFuncSetAttribute failed\n"); grid = -1; return; }
        if (hipOccupancyMaxActiveBlocksPerMultiprocessor(&per_cu, (const void*)enc_fwd, 512, LDS_BYTES) != hipSuccess || per_cu < 1) fprintf(stderr, "kernel_launch: occupancy query says %d blocks per CU\n", per_cu);
        grid = cus;
    }
    if (grid < 0) return;
    hipMemsetAsync((char*)d_ws + WS_CTL, 0, CTL_BYTES, stream);
    Args a; memset(&a, 0, sizeof(a));
    for (int i = 0; i < N_INPUTS; ++i) a.in[i] = (const float*)d_in[i];
    a.out = (float*)d_out; a.ws = (unsigned char*)d_ws;
#if MK_FUSED
    a.ph_lo = 0; a.ph_hi = NPHASES;
    hipLaunchKernelGGL(enc_fwd, dim3(grid), dim3(512), LDS_BYTES, stream, a);
#else
    for (int p = 0; p < NPHASES; ++p) { a.ph_lo = p; a.ph_hi = p + 1; hipLaunchKernelGGL(enc_fwd, dim3(grid), dim3(512), LDS_BYTES, stream, a); }
#endif
    const hipError_t le = hipPeekAtLastError();
    if (le != hipSuccess) fprintf(stderr, "kernel_launch: launch failed: %s\n", hipGetErrorName(le));
}
```

```cpp
#include <hip/hip_runtime.h>
#include <cstdio>
#include <cstdint>
#include <cstring>

#define GAS __attribute__((address_space(1)))
#define LAS __attribute__((address_space(3)))
typedef unsigned short bf16;
typedef short bf16x8 __attribute__((ext_vector_type(8)));
typedef short s16x4 __attribute__((ext_vector_type(4)));
typedef float f32x2 __attribute__((ext_vector_type(2)));
typedef float f32x4 __attribute__((ext_vector_type(4)));
typedef float f32x16 __attribute__((ext_vector_type(16)));
typedef unsigned u32x2 __attribute__((ext_vector_type(2)));
typedef unsigned u32x4 __attribute__((ext_vector_type(4)));
typedef GAS unsigned gu32;

constexpr int DM = 2048, BATCH = 2, SEQ = 4096, NTOK = BATCH * SEQ, DEPTH = 2, NMEM = 256;
constexpr int IN_A = 1536, IN_B = 1920, IN_C = 1536, IN_D = 512, IN_TOTAL = 5504, ZLD = 5632;
constexpr int ZA = 0, ZB = 1536, ZC = 3456, ZD = 4992;
constexpr int NEXP = 32, DEXP = 512, ECAP = 8192;
constexpr int SLOT_CAP = 24576;
constexpr int S5CH = 16, S5NCH = SEQ / S5CH;
constexpr float RMS_EPS = 1e-6f;

enum { I_X = 0, I_MEM, I_NORM_MIX, I_W_IN, I_W_OUT, I_DIFF_LAMBDA, I_DIFF_SUBLN, I_RWKV_MU, I_RWKV_W0, I_RWKV_W2, I_RWKV_A0, I_RWKV_A2, I_RWKV_G2,
       I_RWKV_KK, I_RWKV_KA, I_RWKV_RK, I_RWKV_LNX_W, I_RWKV_LNX_B, I_S5_A_RE, I_S5_A_IM, I_S5_LOG_DT, I_S5_B_RE, I_S5_B_IM, I_S5_C_RE, I_S5_C_IM,
       I_S5_D, I_S5_GLU_W, I_S5_GLU_B, I_MIX_OUT_NORM, I_NORM_CROSS, I_NORM_MEM, I_XA_WQ, I_XA_WKV, I_XA_WO, I_NORM_MOE, I_ROUTER_GROUP,
       I_ROUTER_EXPERT, I_MOE_W1, I_MOE_W3, I_MOE_W2, I_NORM_FINAL, N_INPUTS };

constexpr size_t al256(size_t x) { return (x + 255) / 256 * 256; }
constexpr size_t WS_CTL = 0, CTL_BYTES = 1u << 20;
constexpr size_t WS_WIN  = WS_CTL + CTL_BYTES;
constexpr size_t WS_WOUT = WS_WIN + (size_t)DEPTH * ZLD * DM * 2;
constexpr size_t WS_WQK  = WS_WOUT + (size_t)DEPTH * DM * DM * 2;
constexpr size_t WS_VWO  = WS_WQK + (size_t)DEPTH * BATCH * 1024 * DM * 2;
constexpr size_t WS_W13  = WS_VWO + (size_t)DEPTH * BATCH * DM * 1024 * 2;
constexpr size_t WS_W2   = WS_W13 + (size_t)DEPTH * NEXP * 1024 * DM * 2;
constexpr size_t WS_ROPE = WS_W2 + (size_t)DEPTH * NEXP * DM * DEXP * 2;
constexpr size_t WS_S5P  = WS_ROPE + (size_t)SEQ * (32 + 32 + 64 + 64) * 4;
constexpr size_t S5P_LAYER = (size_t)(2 * 32 * 64 * 2 + 2 * 32 * 64 * 16 * 2) * 4;
constexpr size_t WS_H    = al256(WS_S5P + DEPTH * S5P_LAYER);
constexpr size_t WS_HN   = WS_H + (size_t)NTOK * DM * 4;
constexpr size_t WS_MIX  = WS_HN + (size_t)NTOK * DM * 2;
constexpr size_t WS_P    = WS_MIX + (size_t)NTOK * DM * 2;
constexpr size_t WS_ETOK = WS_P + (size_t)NTOK * 1024 * 2;
constexpr size_t WS_EGATE= WS_ETOK + (size_t)NEXP * ECAP * 4;
constexpr size_t WS_TINFO= WS_EGATE + (size_t)NEXP * ECAP * 4;
constexpr size_t WS_SCR  = al256(WS_TINFO + (size_t)NTOK * 16);
constexpr size_t SC_WKVT = WS_SCR;
constexpr size_t SC_MEMN = SC_WKVT + (size_t)DEPTH * 4096 * DM * 2;
constexpr size_t SC_KVB  = SC_MEMN + (size_t)DEPTH * 512 * DM * 2;
constexpr size_t SC_WQB  = SC_KVB + (size_t)DEPTH * 512 * 4096 * 2;
constexpr size_t SC_WOT  = SC_WQB + (size_t)DEPTH * DM * DM * 2;
constexpr size_t SC_PRO_END = SC_WOT + (size_t)DEPTH * DM * DM * 2;
constexpr size_t SC_Z    = WS_SCR;
constexpr size_t SC_RW   = SC_Z + (size_t)NTOK * ZLD * 2;
constexpr size_t RWSZ    = (size_t)NTOK * 512 * 4;
constexpr size_t SC_YS   = SC_RW + 10 * RWSZ;
constexpr size_t SC_OC   = SC_YS + 2 * RWSZ;
constexpr size_t SC_LSE  = SC_OC + 3 * RWSZ;
constexpr size_t SC_CARRY= SC_LSE + (size_t)3 * NTOK * 4 * 4;
constexpr size_t SC_MIX_END = SC_CARRY + (size_t)2 * BATCH * S5NCH * 32 * 64 * 2 * 4;
constexpr size_t SC_HMID = WS_SCR;
constexpr size_t SC_YBUF = SC_HMID + (size_t)SLOT_CAP * DEXP * 2;
constexpr size_t SC_MOE_END = SC_YBUF + (size_t)SLOT_CAP * DM * 2;
constexpr size_t cmax(size_t a, size_t b) { return a > b ? a : b; }
constexpr size_t WS_END = cmax(cmax(SC_PRO_END, SC_MIX_END), SC_MOE_END);

constexpr int CW_BAR = 4096;
constexpr int CW_Q = 8192;
constexpr int CW_CNT = 16384;

constexpr int RING_BYTES = 131072;
constexpr int MISC_OFF = RING_BYTES;
constexpr int LDS_BYTES = 147456;

__device__ __forceinline__ float bf2f(unsigned short b) { return __uint_as_float(((unsigned)b) << 16); }
__device__ __forceinline__ unsigned pk2(float lo, float hi) { unsigned r; asm volatile("v_cvt_pk_bf16_f32 %0, %1, %2" : "=v"(r) : "v"(lo), "v"(hi)); return r; }
__device__ __forceinline__ bf16 f2bf(float f) { return (bf16)(pk2(f, 0.f) & 0xffffu); }
__device__ __forceinline__ float wave_sum(float v) {
#pragma unroll
    for (int o = 1; o < 64; o <<= 1) v += __shfl_xor(v, o);
    return v;
}
__device__ __forceinline__ float wave_max(float v) {
#pragma unroll
    for (int o = 1; o < 64; o <<= 1) v = fmaxf(v, __shfl_xor(v, o));
    return v;
}
__device__ __forceinline__ float sigmoidf_(float x) { return 1.f / (1.f + __expf(-x)); }
#define LDS_WAIT() asm volatile("s_waitcnt lgkmcnt(0)" ::: "memory")
#define VM_WAIT() asm volatile("s_waitcnt vmcnt(0)" ::: "memory")

__device__ __forceinline__ int tid_from_wave(int wave) { int t = wave * 64 + (int)__builtin_amdgcn_mbcnt_hi(~0u, __builtin_amdgcn_mbcnt_lo(~0u, 0u)); asm volatile("" : "+v"(t)); return t; }
#define XB_TMO      128
#define XB_XCNT(j)  (256  + 64 * (j))
#define XB_XSUB(j)  (1280 + 64 * (j))
#define XB_XGEN(j)  (2304 + 64 * (j))
#define XB_TOP      3328
#define XB_TOPGEN   3392
#define XCD_BAR_WORDS 3456
#define XB_SPIN_CAP (1u << 18)

__device__ __forceinline__ unsigned xb_ld(unsigned* p)              { return __hip_atomic_load(p, __ATOMIC_RELAXED, __HIP_MEMORY_SCOPE_AGENT); }
__device__ __forceinline__ unsigned xb_add(unsigned* p, unsigned v) { return __hip_atomic_fetch_add(p, v, __ATOMIC_RELAXED, __HIP_MEMORY_SCOPE_AGENT); }
__device__ __forceinline__ unsigned xb_xcc_id() { return (unsigned)__builtin_amdgcn_s_getreg((3 << 11) | 20) & 0xFu; }
#define XB_SPIN(cond, bar) do { unsigned _sp = 0; while (cond) { __builtin_amdgcn_s_sleep(1); \
    if ((++_sp & 255u) == 0u) { if (xb_ld(&(bar)[XB_TMO])) break; if (_sp > XB_SPIN_CAP) { atomicAdd(&(bar)[XB_TMO], 1u); break; } } } } while (0)

struct XcdBarrier {
    unsigned* bar; unsigned x;
    volatile LAS unsigned* st;
};

__device__ __forceinline__ XcdBarrier xcd_barrier_post(unsigned* bar, volatile LAS unsigned* st) {
    XcdBarrier b; b.bar = bar; b.x = xb_xcc_id(); b.st = st;
    if (threadIdx.x == 0) (void)xb_add(&bar[XB_XCNT(b.x)], 1u);
    return b;
}
__device__ __forceinline__ void xcd_barrier_complete(unsigned* bar, unsigned x, unsigned& nloc, unsigned& nx) {
    const unsigned G = gridDim.x * gridDim.y * gridDim.z;
    unsigned sum, cnt, mine, sp = 0u;
    for (;;) {
        sum = 0u; cnt = 0u; mine = 0u;
#pragma unroll
        for (unsigned j = 0; j < 16; ++j) { const unsigned c = xb_ld(&bar[XB_XCNT(j)]); sum += c; cnt += (c > 0u) ? 1u : 0u; mine = (j == x) ? c : mine; }
        if (sum == G) break;
        __builtin_amdgcn_s_sleep(1);
        if ((++sp & 255u) == 0u) { if (xb_ld(&bar[XB_TMO])) break; if (sp > XB_SPIN_CAP) { atomicAdd(&bar[XB_TMO], 1u); break; } }
    }
    nloc = mine > 0u ? mine : 1u; nx = cnt > 0u ? cnt : 1u;
}

__device__ __forceinline__ void xcd_barrier(const XcdBarrier& b) {
    asm volatile("s_waitcnt vmcnt(0)" ::: "memory");
    __syncthreads();
    if (threadIdx.x == 0) {
        unsigned* bar = b.bar;
        __builtin_amdgcn_s_waitcnt(0);
        unsigned nloc = b.st[0], nx = b.st[1];
        if (nloc == 0u) { xcd_barrier_complete(bar, b.x, nloc, nx); b.st[0] = nloc; b.st[1] = nx; }
        const unsigned old = xb_add(&bar[XB_XSUB(b.x)], 1u);
        const unsigned gen = old / nloc;
        if (old + 1u == (gen + 1u) * nloc) {
            __builtin_amdgcn_fence(__ATOMIC_RELEASE, "agent");
            asm volatile("s_waitcnt vmcnt(0)" ::: "memory");
            const unsigned og = xb_add(&bar[XB_TOP], 1u);
            const unsigned tg = og / nx;
            if (og + 1u == (tg + 1u) * nx) xb_add(&bar[XB_TOPGEN], 1u);
            else XB_SPIN(xb_ld(&bar[XB_TOPGEN]) == tg, bar);
            __builtin_amdgcn_fence(__ATOMIC_ACQUIRE, "agent");
            xb_add(&bar[XB_XGEN(b.x)], 1u);
            asm volatile("s_waitcnt vmcnt(0)" ::: "memory");
        } else {
            XB_SPIN(xb_ld(&bar[XB_XGEN(b.x)]) == gen, bar);
            __builtin_amdgcn_fence(__ATOMIC_ACQUIRE, "agent");
            asm volatile("s_waitcnt vmcnt(0)" ::: "memory");
        }
    }
    __syncthreads();
}


namespace pg8 {
constexpr int BM = 256, BK = 64, HALF = 128, HTB = HALF * BK * 2, STAGE_BYTES = 8 * HTB, NXCD = 8, WGM = 8;
__host__ __device__ __forceinline__ int lds_byte(int r, int c) { const int st = (r >> 4) * 2 + (c >> 5), rr = r & 15, cc = c & 31, ob = rr * 64 + cc * 2; return st * 1024 + (ob ^ (((ob >> 9) & 1) << 5)); }
__host__ __device__ __forceinline__ void stage_rc(int b, int& R, int& C) { const int st = b / 1024, sb = b % 1024, swz = sb ^ (((sb >> 9) & 1) << 5); R = (st >> 1) * 16 + swz / 64; C = (st & 1) * 32 + (swz % 64) / 2; }
__host__ __device__ __forceinline__ int perm32(int rho) { const int n = rho >> 4, i = rho & 15; return 8 * (i >> 2) + 4 * n + (i & 3); }

struct Unit { const char* A; const char* B; char* C; int row0, col0, aux; };
struct GemmP { int K, lda, ldb; };

__device__ __forceinline__ void xcd_tile(int L, int nM, int nN, int& pm, int& pn) {
    const int nwg = nM * nN; int wgid = L;
    { const int q = nwg / NXCD, r = nwg % NXCD, xcd = wgid % NXCD, off = wgid / NXCD; wgid = (xcd < r ? xcd * (q + 1) : r * (q + 1) + (xcd - r) * q) + off; }
    const int nig = WGM * nN, gid = wgid / nig, fm = gid * WGM, gsz = (nM - fm) < WGM ? (nM - fm) : WGM;
    pm = fm + ((wgid % nig) % gsz); pn = (wgid % nig) / gsz;
}

typedef f32x4 Acc[2][2][4][2];

template <class Epi, class Sched, bool GATHER>
__device__ __forceinline__ void gemm_phase(LAS unsigned char* lds, const GemmP g, const Sched& S, const Epi& E, const int wave_id) {
    const int tid = tid_from_wave(wave_id), wid = __builtin_amdgcn_readfirstlane(tid >> 6), lane = tid & 63, wr = wid >> 2, wc = wid & 3, fr = lane & 15, fq = lane >> 4;
    const int K = g.K, nt = K / BK;
    int Rr[2], Cc[2]; unsigned voffB[2];
#pragma unroll
    for (int i = 0; i < 2; ++i) { int R, C; stage_rc(tid * 16 + i * 8192, R, C); const int Rb = Epi::PERM ? ((R & ~31) + perm32(R & 31)) : R;
        Rr[i] = R; Cc[i] = C; voffB[i] = (unsigned)(Rb * g.ldb + C) * 2u; }
    const size_t kstep = (size_t)(BK * 2);
    const size_t hstepB = (size_t)HALF * g.ldb * 2;
    const unsigned ldsw = (unsigned)wid * 1024u;
    const int aoff = lds_byte(wr * 64 + fr, fq * 8), boff = lds_byte(wc * 32 + fr, fq * 8);
#define PG8_SA(b, h) (((b) * 2 + (h)) * HTB)
#define PG8_SB(b, h) ((4 + (b) * 2 + (h)) * HTB)
#define PG8_STAGE_B(bufoff, gbase) do { _Pragma("unroll") for (int _i = 0; _i < 2; ++_i) \
        __builtin_amdgcn_global_load_lds((const unsigned*)((const char*)(gbase) + voffB[_i]), (LAS unsigned*)(lds + (bufoff) + ldsw + _i * 8192), 16, 0, 0); } while (0)
#define PG8_STAGE_A(bufoff, gbase, OFF, h) do { _Pragma("unroll") for (int _i = 0; _i < 2; ++_i) \
        __builtin_amdgcn_global_load_lds((const unsigned*)((const char*)(gbase) + (OFF)[h][_i]), (LAS unsigned*)(lds + (bufoff) + ldsw + _i * 8192), 16, 0, 0); } while (0)
#define PG8_OFFS(u, OFF) do { _Pragma("unroll") for (int _h = 0; _h < 2; ++_h) _Pragma("unroll") for (int _i = 0; _i < 2; ++_i) { \
        const int _row = _h * HALF + Rr[_i]; const int _src = GATHER ? S.arow((u), _row) : _row; (OFF)[_h][_i] = (unsigned)(_src * g.lda + Cc[_i]) * 2u; } } while (0)
#define PG8_LDA(dst, b, h) do { _Pragma("unroll") for (int m = 0; m < 4; ++m) _Pragma("unroll") for (int k = 0; k < 2; ++k) dst[m][k] = *(const LAS bf16x8*)(lds + PG8_SA(b, h) + aoff + m * 2048 + k * 1024); } while (0)
#define PG8_LDB(dst, b, h) do { _Pragma("unroll") for (int n = 0; n < 2; ++n) _Pragma("unroll") for (int k = 0; k < 2; ++k) dst[n][k] = *(const LAS bf16x8*)(lds + PG8_SB(b, h) + boff + n * 2048 + k * 1024); } while (0)
#define PG8_MMA(ai, bj, At, Bt) do { __builtin_amdgcn_s_setprio(1); _Pragma("unroll") for (int m = 0; m < 4; ++m) _Pragma("unroll") for (int n = 0; n < 2; ++n) _Pragma("unroll") for (int k = 0; k < 2; ++k) \
        acc[ai][bj][m][n] = __builtin_amdgcn_mfma_f32_16x16x32_bf16(Bt[n][k], At[m][k], acc[ai][bj][m][n], 0, 0, 0); __builtin_amdgcn_s_setprio(0); } while (0)
#define PG8_WAIT_V(n) asm volatile("s_waitcnt vmcnt(" #n ")" ::: "memory")
#define PG8_WAIT_L(n) asm volatile("s_waitcnt lgkmcnt(" #n ")" ::: "memory")
#define PG8_BAR __builtin_amdgcn_s_barrier()
#define PG8_SCHED __builtin_amdgcn_sched_barrier(0)
    Unit cur, nxt; int ui = 0;
    if (!S.next(0, cur)) return;
    f32x4 acc[2][2][4][2];
#pragma unroll
    for (int a = 0; a < 2; ++a)
#pragma unroll
        for (int b = 0; b < 2; ++b)
#pragma unroll
            for (int m = 0; m < 4; ++m)
#pragma unroll
                for (int n = 0; n < 2; ++n) acc[a][b][m][n] = (f32x4){0.f, 0.f, 0.f, 0.f};
    bf16x8 At[4][2], B0[2][2], B1[2][2];
    const char* cA = cur.A; const char* cB = cur.B;
    unsigned coffA[2][2], noffA[2][2];
    PG8_OFFS(cur, coffA);
    PG8_STAGE_B(PG8_SB(0, 0), cB); PG8_STAGE_A(PG8_SA(0, 0), cA, coffA, 0); PG8_STAGE_B(PG8_SB(0, 1), cB + hstepB); PG8_STAGE_A(PG8_SA(0, 1), cA, coffA, 1);
    if (wr == 1) PG8_BAR;
    PG8_WAIT_V(4); PG8_BAR;
    PG8_STAGE_B(PG8_SB(1, 0), cB + kstep); PG8_STAGE_A(PG8_SA(1, 0), cA + kstep, coffA, 0); PG8_STAGE_B(PG8_SB(1, 1), cB + hstepB + kstep);
    PG8_WAIT_V(6); PG8_BAR;
    for (;;) {
        const bool has_next = S.next(ui + 1, nxt);
        const char* nA = has_next ? nxt.A : cA; const char* nB = has_next ? nxt.B : cB;
        if (has_next) { PG8_OFFS(nxt, noffA); }
        else {
#pragma unroll
            for (int _h = 0; _h < 2; ++_h)
#pragma unroll
                for (int _i = 0; _i < 2; ++_i) noffA[_h][_i] = coffA[_h][_i]; }
        for (int t = 0; t < nt; t += 2) {
            const bool last = (t == nt - 2);
            const char* a1 = cA + (size_t)(t + 1) * kstep;
            const char* a2 = last ? nA : cA + (size_t)(t + 2) * kstep; const char* b2 = last ? nB : cB + (size_t)(t + 2) * kstep;
            const char* a3 = a2 + kstep; const char* b3 = b2 + kstep;
            unsigned o2[2][2];
#pragma unroll
            for (int _h = 0; _h < 2; ++_h)
#pragma unroll
                for (int _i = 0; _i < 2; ++_i) o2[_h][_i] = last ? noffA[_h][_i] : coffA[_h][_i];
            PG8_LDB(B0, 0, 0); PG8_SCHED; PG8_LDA(At, 0, 0); PG8_STAGE_A(PG8_SA(1, 1), a1, coffA, 1);
            PG8_WAIT_L(8); PG8_BAR; PG8_WAIT_L(0); PG8_MMA(0, 0, At, B0); PG8_BAR; PG8_SCHED;
            PG8_LDB(B1, 0, 1); PG8_STAGE_B(PG8_SB(0, 0), b2);
            PG8_BAR; PG8_WAIT_L(0); PG8_MMA(0, 1, At, B1); PG8_BAR;
            PG8_LDA(At, 0, 1); PG8_STAGE_A(PG8_SA(0, 0), a2, o2, 0);
            PG8_BAR; PG8_WAIT_L(0); PG8_MMA(1, 0, At, B0); PG8_BAR; PG8_SCHED;
            PG8_STAGE_B(PG8_SB(0, 1), b2 + hstepB);
            PG8_WAIT_V(6); PG8_BAR; PG8_MMA(1, 1, At, B1); PG8_BAR;
            PG8_LDB(B0, 1, 0); PG8_SCHED; PG8_LDA(At, 1, 0); PG8_STAGE_A(PG8_SA(0, 1), a2, o2, 1);
            PG8_WAIT_L(8); PG8_BAR; PG8_WAIT_L(0); PG8_MMA(0, 0, At, B0); PG8_BAR; PG8_SCHED;
            PG8_LDB(B1, 1, 1); PG8_STAGE_B(PG8_SB(1, 0), b3);
            PG8_BAR; PG8_WAIT_L(0); PG8_MMA(0, 1, At, B1); PG8_BAR;
            PG8_LDA(At, 1, 1); PG8_STAGE_A(PG8_SA(1, 0), a3, o2, 0);
            PG8_BAR; PG8_WAIT_L(0); PG8_MMA(1, 0, At, B0); PG8_BAR; PG8_SCHED;
            PG8_STAGE_B(PG8_SB(1, 1), b3 + hstepB);
            PG8_WAIT_V(6); PG8_BAR; PG8_MMA(1, 1, At, B1); PG8_BAR;
        }
        if constexpr (!Epi::AFTER_DRAIN) { E(acc, cur, wr, wc, fr, fq); }
        if (!has_next) break;
#pragma unroll
        for (int a = 0; a < 2; ++a)
#pragma unroll
            for (int b = 0; b < 2; ++b)
#pragma unroll
                for (int m = 0; m < 4; ++m)
#pragma unroll
                    for (int n = 0; n < 2; ++n) acc[a][b][m][n] = (f32x4){0.f, 0.f, 0.f, 0.f};
        cur = nxt; cA = nA; cB = nB; ++ui;
#pragma unroll
        for (int _h = 0; _h < 2; ++_h)
#pragma unroll
            for (int _i = 0; _i < 2; ++_i) coffA[_h][_i] = noffA[_h][_i];
    }
    PG8_WAIT_V(0);
    if (wr == 0) PG8_BAR;
    PG8_BAR;
    if constexpr (Epi::AFTER_DRAIN) { E.fused(acc, cur, wr, wc, fr, fq, lds, wid, lane); }
#undef PG8_SA
#undef PG8_SB
#undef PG8_STAGE_A
#undef PG8_STAGE_B
#undef PG8_OFFS
#undef PG8_LDA
#undef PG8_LDB
#undef PG8_MMA
#undef PG8_WAIT_V
#undef PG8_WAIT_L
#undef PG8_BAR
#undef PG8_SCHED
}

struct EpiBf16 {
    static constexpr bool PERM = true, AFTER_DRAIN = false;
    int ldc;
    __device__ __forceinline__ void operator()(const Acc& acc, const Unit& u, int wr, int wc, int fr, int fq) const {
        bf16* base = (bf16*)u.C + (size_t)(wr * 64 + fr) * ldc + wc * 32 + 8 * fq;
#pragma unroll
        for (int ai = 0; ai < 2; ++ai)
#pragma unroll
            for (int m = 0; m < 4; ++m) { bf16* rowp = base + (size_t)(ai * HALF + m * 16) * ldc;
#pragma unroll
                for (int bj = 0; bj < 2; ++bj) { const f32x4 v0 = acc[ai][bj][m][0], v1 = acc[ai][bj][m][1];
                    u32x4 w; w.x = pk2(v0[0], v0[1]); w.y = pk2(v0[2], v0[3]); w.z = pk2(v1[0], v1[1]); w.w = pk2(v1[2], v1[3]);
                    *(u32x4*)(rowp + bj * HALF) = w; } }
    }
};
struct EpiF32Res {
    static constexpr bool PERM = false, AFTER_DRAIN = false;
    int ldc; const float* resid; float* out;
    __device__ __forceinline__ void operator()(const Acc& acc, const Unit& u, int wr, int wc, int fr, int fq) const {
        const size_t o0 = (size_t)(u.row0 + wr * 64 + fr) * ldc + u.col0 + wc * 32 + 4 * fq;
#pragma unroll
        for (int ai = 0; ai < 2; ++ai)
#pragma unroll
            for (int m = 0; m < 4; ++m) { const size_t ro = o0 + (size_t)(ai * HALF + m * 16) * ldc;
#pragma unroll
                for (int bj = 0; bj < 2; ++bj)
#pragma unroll
                    for (int n = 0; n < 2; ++n) { const size_t o = ro + bj * HALF + n * 16; const f32x4 b = *(const f32x4*)(resid + o); *(f32x4*)(out + o) = acc[ai][bj][m][n] + b; } }
    }
};
struct EpiSwiGlu {
    static constexpr bool PERM = true, AFTER_DRAIN = false;
    int ldc;
    __device__ __forceinline__ void operator()(const Acc& acc, const Unit& u, int wr, int wc, int fr, int fq) const {
        bf16* base = (bf16*)u.C + (size_t)(wr * 64 + fr) * ldc + wc * 32 + 8 * fq;
#pragma unroll
        for (int ai = 0; ai < 2; ++ai)
#pragma unroll
            for (int m = 0; m < 4; ++m) { bf16* rowp = base + (size_t)(ai * HALF + m * 16) * ldc;
                float h[8];
#pragma unroll
                for (int n = 0; n < 2; ++n)
#pragma unroll
                    for (int e = 0; e < 4; ++e) { const float a = acc[ai][0][m][n][e], b = acc[ai][1][m][n][e]; h[n * 4 + e] = a / (1.f + __expf(-a)) * b; }
                u32x4 w; w.x = pk2(h[0], h[1]); w.y = pk2(h[2], h[3]); w.z = pk2(h[4], h[5]); w.w = pk2(h[6], h[7]);
                *(u32x4*)rowp = w; }
    }
};
struct EpiGate {
    static constexpr bool PERM = true, AFTER_DRAIN = false;
    int ldc; const float* egate; const int* cnt_lds_unused;
    __device__ __forceinline__ void operator()(const Acc& acc, const Unit& u, int wr, int wc, int fr, int fq) const {
        bf16* base = (bf16*)u.C + (size_t)(wr * 64 + fr) * ldc + wc * 32 + 8 * fq;
        const int e = u.aux >> 16, nvalid = u.aux & 0xffff;
        const float* gp = egate + (size_t)e * ECAP + u.row0;
#pragma unroll
        for (int ai = 0; ai < 2; ++ai)
#pragma unroll
            for (int m = 0; m < 4; ++m) { const int r = ai * HALF + wr * 64 + m * 16 + fr; const float gt = (r < nvalid) ? gp[r] : 0.f;
                bf16* rowp = base + (size_t)(ai * HALF + m * 16) * ldc;
#pragma unroll
                for (int bj = 0; bj < 2; ++bj) { const f32x4 v0 = acc[ai][bj][m][0] * gt, v1 = acc[ai][bj][m][1] * gt;
                    u32x4 w; w.x = pk2(v0[0], v0[1]); w.y = pk2(v0[2], v0[3]); w.z = pk2(v1[0], v1[1]); w.w = pk2(v1[2], v1[3]);
                    *(u32x4*)(rowp + bj * HALF) = w; } }
    }
};
struct EpiSoftmax {
    static constexpr bool PERM = true, AFTER_DRAIN = true;
    int ldc; float scale_log2e;
    __device__ __forceinline__ void operator()(const Acc&, const Unit&, int, int, int, int) const {}
    __device__ __forceinline__ void fused(const Acc& acc, const Unit& u, int wr, int wc, int fr, int fq, LAS unsigned char* lds, int wid, int lane) const {
        LAS float* RM = (LAS float*)lds;
        LAS float* RS = (LAS float*)(lds + 4096);
        float mx[2][4];
#pragma unroll
        for (int ai = 0; ai < 2; ++ai)
#pragma unroll
            for (int m = 0; m < 4; ++m) { float v = -3.0e38f;
#pragma unroll
                for (int bj = 0; bj < 2; ++bj)
#pragma unroll
                    for (int n = 0; n < 2; ++n) { const f32x4 x = acc[ai][bj][m][n]; v = fmaxf(v, fmaxf(fmaxf(x[0], x[1]), fmaxf(x[2], x[3]))); }
                v = fmaxf(v, __shfl_xor(v, 16)); v = fmaxf(v, __shfl_xor(v, 32));
                if (fq == 0) RM[(ai * HALF + wr * 64 + m * 16 + fr) * 4 + wc] = v; }
        asm volatile("s_waitcnt lgkmcnt(0)" ::: "memory"); __builtin_amdgcn_s_barrier(); asm volatile("" ::: "memory");
#pragma unroll
        for (int ai = 0; ai < 2; ++ai)
#pragma unroll
            for (int m = 0; m < 4; ++m) { const int row = ai * HALF + wr * 64 + m * 16 + fr; const f32x4 q = *(const LAS f32x4*)(RM + row * 4);
                const float M = fmaxf(fmaxf(q[0], q[1]), fmaxf(q[2], q[3])); const float mc = -M * scale_log2e; float s = 0.f;
#pragma unroll
                for (int bj = 0; bj < 2; ++bj)
#pragma unroll
                    for (int n = 0; n < 2; ++n)
#pragma unroll
                        for (int e = 0; e < 4; ++e) s += __builtin_amdgcn_exp2f(fmaf(acc[ai][bj][m][n][e], scale_log2e, mc));
                s += __shfl_xor(s, 16); s += __shfl_xor(s, 32);
                if (fq == 0) RS[row * 4 + wc] = s; }
        asm volatile("s_waitcnt lgkmcnt(0)" ::: "memory"); __builtin_amdgcn_s_barrier(); asm volatile("" ::: "memory");
        bf16* base = (bf16*)u.C + (size_t)(wr * 64 + fr) * ldc + wc * 32 + 8 * fq;
#pragma unroll
        for (int ai = 0; ai < 2; ++ai)
#pragma unroll
            for (int m = 0; m < 4; ++m) { const int row = ai * HALF + wr * 64 + m * 16 + fr; const f32x4 q = *(const LAS f32x4*)(RS + row * 4); const f32x4 qm = *(const LAS f32x4*)(RM + row * 4);
                const float M = fmaxf(fmaxf(qm[0], qm[1]), fmaxf(qm[2], qm[3])); const float mc = -M * scale_log2e;
                const float inv = 1.f / ((q[0] + q[1]) + (q[2] + q[3])); bf16* rowp = base + (size_t)(ai * HALF + m * 16) * ldc;
#pragma unroll
                for (int bj = 0; bj < 2; ++bj) { float pp[8];
#pragma unroll
                    for (int n = 0; n < 2; ++n)
#pragma unroll
                        for (int e = 0; e < 4; ++e) pp[n * 4 + e] = __builtin_amdgcn_exp2f(fmaf(acc[ai][bj][m][n][e], scale_log2e, mc)) * inv;
                    u32x4 w; w.x = pk2(pp[0], pp[1]); w.y = pk2(pp[2], pp[3]); w.z = pk2(pp[4], pp[5]); w.w = pk2(pp[6], pp[7]);
                    *(u32x4*)(rowp + bj * HALF) = w; } }
        asm volatile("s_waitcnt lgkmcnt(0)" ::: "memory"); __builtin_amdgcn_s_barrier(); asm volatile("" ::: "memory");
    }
};
}

namespace att {
constexpr int KVBLK = 64;
constexpr size_t SHM_V = KVBLK * 128 * 2, SHM_K = KVBLK * 128 * 2;
#define KSWZ(row, colB) ((row) * 256 + ((colB) ^ (((row) & 7) << 4)))
#define SBAR() __builtin_amdgcn_sched_barrier(0)
__device__ __forceinline__ int crow(int r, int hi) { return (r & 3) + 8 * (r >> 2) + 4 * hi; }
__device__ __forceinline__ bf16x8 ld8(const bf16* p) { return *reinterpret_cast<const bf16x8*>(p); }

__device__ __forceinline__ void partialSM(f32x16& p0, f32x16& p1, float& m_reg, float& mn, float& alpha, const float SCALE, const float THR) {
  const float C = SCALE * 1.4426950408889634f;
  float pmax = p0[0];
#pragma unroll
  for (int r = 1; r < 16; ++r) pmax = fmaxf(pmax, p0[r]);
#pragma unroll
  for (int r = 0; r < 16; ++r) pmax = fmaxf(pmax, p1[r]);
  { auto rr = __builtin_amdgcn_permlane32_swap(__float_as_uint(pmax), __float_as_uint(pmax), false, false);
    pmax = fmaxf(__uint_as_float(rr[0]), __uint_as_float(rr[1])); }
  if (__builtin_expect(__all(pmax - m_reg <= THR / SCALE), 1)) { mn = m_reg; alpha = 1.f; }
  else { mn = fmaxf(m_reg, pmax); alpha = __builtin_amdgcn_exp2f((m_reg - mn) * C); m_reg = mn; }
  const float mnC = -mn * C;
#pragma unroll
  for (int r = 0; r < 16; ++r) p0[r] = fmaf(p0[r], C, mnC);
#pragma unroll
  for (int r = 0; r < 16; ++r) p1[r] = fmaf(p1[r], C, mnC);
#pragma unroll
  for (int r = 0; r < 16; ++r) p0[r] = __builtin_amdgcn_exp2f(p0[r]);
}
__device__ __forceinline__ void finishSM(f32x16& p0, f32x16& p1, float alpha, float& l_reg, bf16x8& pa0, bf16x8& pa1, bf16x8& pa2, bf16x8& pa3) {
#pragma unroll
  for (int r = 0; r < 16; ++r) p1[r] = __builtin_amdgcn_exp2f(p1[r]);
  float ps = 0;
#pragma unroll
  for (int r = 0; r < 16; ++r) ps += p0[r];
#pragma unroll
  for (int r = 0; r < 16; ++r) ps += p1[r];
  { auto rr = __builtin_amdgcn_permlane32_swap(__float_as_uint(ps), __float_as_uint(ps), false, false);
    ps = __uint_as_float(rr[0]) + __uint_as_float(rr[1]); }
  l_reg = l_reg * alpha + ps;
#define PK4(P, BASE, OUT) do { unsigned a0 = pk2(P[BASE + 0], P[BASE + 1]), a1 = pk2(P[BASE + 2], P[BASE + 3]);   \
    unsigned b0 = pk2(P[BASE + 4], P[BASE + 5]), b1 = pk2(P[BASE + 6], P[BASE + 7]);                              \
    auto r0 = __builtin_amdgcn_permlane32_swap(a0, b0, false, false); auto r1 = __builtin_amdgcn_permlane32_swap(a1, b1, false, false); \
    u32x4 w = {r0[0], r1[0], r0[1], r1[1]}; OUT = *reinterpret_cast<bf16x8*>(&w); } while (0)
  PK4(p0, 0, pa0); PK4(p0, 8, pa1); PK4(p1, 0, pa2); PK4(p1, 8, pa3);
#undef PK4
}
template <int ND0> __device__ __forceinline__ void qkt(f32x16& p0, f32x16& p1, const char* Ks, const bf16x8* qr, int r32, int hi, int c0) {
  p0 = f32x16{}; p1 = f32x16{};
#pragma unroll
  for (int d0 = 0; d0 < ND0; ++d0) { const int cb = (c0 + d0 * 16 + hi * 8) * 2;
    const bf16x8 b0 = *reinterpret_cast<const bf16x8*>(Ks + KSWZ(r32, cb));
    const bf16x8 b1 = *reinterpret_cast<const bf16x8*>(Ks + KSWZ(32 + r32, cb));
    p0 = __builtin_amdgcn_mfma_f32_32x32x16_bf16(b0, qr[d0], p0, 0, 0, 0);
    p1 = __builtin_amdgcn_mfma_f32_32x32x16_bf16(b1, qr[d0], p1, 0, 0, 0); }
}
__device__ __forceinline__ int v_st(int k, int c) { const int kk = (k & ~0xC) | ((k & 4) << 1) | ((k & 8) >> 1); return ((kk >> 3) * 4 + (c >> 5)) * 512 + ((kk & 7) * 32 + (c & 31)) * 2; }
__device__ __forceinline__ int v_rd_base(int lane) { return ((lane & 3) << 3) | (((lane >> 2) & 3) << 6) | (((lane >> 4) & 1) << 5) | (((lane >> 5) & 1) << 8); }
constexpr int v_rd_off(int d0, int ks, int half) { return d0 * 512 + ks * 4096 + half * 2048; }
template <int OFF> __device__ __forceinline__ s16x4 tr_read(int vb) {
  s16x4 r; asm volatile("ds_read_b64_tr_b16 %0, %1 offset:%2" : "=&v"(r) : "v"(vb), "i"(OFF) : "memory"); return r;
}
template <int D0> __device__ __forceinline__ void pv_one(f32x16& od, int vb, bf16x8 pa0, bf16x8 pa1, bf16x8 pa2, bf16x8 pa3) {
  const s16x4 l0 = tr_read<v_rd_off(D0, 0, 0)>(vb), h0 = tr_read<v_rd_off(D0, 0, 1)>(vb), l1 = tr_read<v_rd_off(D0, 1, 0)>(vb), h1 = tr_read<v_rd_off(D0, 1, 1)>(vb);
  const s16x4 l2 = tr_read<v_rd_off(D0, 2, 0)>(vb), h2 = tr_read<v_rd_off(D0, 2, 1)>(vb), l3 = tr_read<v_rd_off(D0, 3, 0)>(vb), h3 = tr_read<v_rd_off(D0, 3, 1)>(vb);
  asm volatile("s_waitcnt lgkmcnt(0)" ::: "memory"); SBAR();
#define PK(L, H) (bf16x8){L[0], L[1], L[2], L[3], H[0], H[1], H[2], H[3]}
  od = __builtin_amdgcn_mfma_f32_32x32x16_bf16(pa0, PK(l0, h0), od, 0, 0, 0);
  od = __builtin_amdgcn_mfma_f32_32x32x16_bf16(pa1, PK(l1, h1), od, 0, 0, 0);
  od = __builtin_amdgcn_mfma_f32_32x32x16_bf16(pa2, PK(l2, h2), od, 0, 0, 0);
  od = __builtin_amdgcn_mfma_f32_32x32x16_bf16(pa3, PK(l3, h3), od, 0, 0, 0);
#undef PK
}
__device__ __forceinline__ void pv_d0(f32x16* o, int vb, bf16x8 pa0, bf16x8 pa1, bf16x8 pa2, bf16x8 pa3) {
  pv_one<0>(o[0], vb, pa0, pa1, pa2, pa3); pv_one<1>(o[1], vb, pa0, pa1, pa2, pa3); pv_one<2>(o[2], vb, pa0, pa1, pa2, pa3); pv_one<3>(o[3], vb, pa0, pa1, pa2, pa3);
}

__device__ __forceinline__ void diff_attn_unit(const bf16* Qb, const bf16* Kh, const bf16* Vh, int ld, int seq, bf16* outb, int ldo,
                                               const float lam, const float post_scale, const float* subln_g, char* lds, const int wave_id) {
  constexpr float SCALE = 0.125f, THR = 8.f;
  const int tid = tid_from_wave(wave_id), wid = __builtin_amdgcn_readfirstlane(tid >> 6), lane = tid & 63, r32 = lane & 31, hi = lane >> 5;
  const int csel = wid >> 2, wq = wid & 3;
  char* V_lds = lds; char* K_lds = lds + 2 * SHM_V;
  float* ws = (float*)(lds + 2 * SHM_V + 2 * SHM_K) + wid * 64; float* li_l = ws; float* al_l = ws + 32;
  float m_reg = -1e30f, l_reg = 0; f32x16 o[4] = {}; bf16x8 qr[4];
  const bf16* Qw = Qb + (long)(wq * 32 + r32) * ld + csel * 64 + hi * 8;
#pragma unroll
  for (int d0 = 0; d0 < 4; ++d0) qr[d0] = ld8(Qw + d0 * 16);
  const int sr = tid >> 4, sc = (tid & 15) * 8, vst0 = v_st(sr, sc), vst1 = v_st(32 + sr, sc);
  const int vb0 = (int)(uintptr_t)V_lds + v_rd_base(lane);
  const int kc0 = csel * 64;
  struct { bf16x8 vs0, vs1, ks0, ks1; } sr_[2];
#define SLOAD(i, k0) do { sr_[i].vs0 = ld8(&Vh[(long)((k0) + sr) * ld + sc]); sr_[i].vs1 = ld8(&Vh[(long)((k0) + 32 + sr) * ld + sc]); \
    sr_[i].ks0 = ld8(&Kh[(long)((k0) + sr) * ld + sc]); sr_[i].ks1 = ld8(&Kh[(long)((k0) + 32 + sr) * ld + sc]); } while (0)
#define SWRITE(b, i) do { *(bf16x8*)(V_lds + (b) * SHM_V + vst0) = sr_[i].vs0;          \
    *(bf16x8*)(V_lds + (b) * SHM_V + vst1) = sr_[i].vs1; const int kc = sc * 2;               \
    *(bf16x8*)(K_lds + (b) * SHM_K + KSWZ(sr, kc)) = sr_[i].ks0;                       \
    *(bf16x8*)(K_lds + (b) * SHM_K + KSWZ(32 + sr, kc)) = sr_[i].ks1; } while (0)
#define SWAIT() asm volatile("s_waitcnt vmcnt(4)" ::: "memory")
#define RESC(a) do { if (__any((a) < 1.f)) { if (hi == 0) al_l[r32] = (a); asm volatile("s_waitcnt lgkmcnt(0)" ::: "memory"); \
    _Pragma("unroll") for (int d = 0; d < 4; ++d) _Pragma("unroll") for (int r = 0; r < 16; ++r) o[d][r] *= al_l[crow(r, hi)]; } } while (0)
  f32x16 pA0, pA1, pB0, pB1; float mnA, mnB, alA, alB; bf16x8 pa0, pa1, pa2, pa3; const int NT = seq / KVBLK;
  constexpr int SE = 0, SO = 1;
  __syncthreads();
  SLOAD(SE, 0); asm volatile("s_waitcnt vmcnt(0)" ::: "memory"); SWRITE(0, SE); __syncthreads();
  qkt<4>(pA0, pA1, K_lds, qr, r32, hi, kc0); partialSM(pA0, pA1, m_reg, mnA, alA, SCALE, THR);
  SLOAD(SO, KVBLK); if (2 < NT) SLOAD(SE, 2 * KVBLK);
  SWAIT(); SWRITE(1, SO); __syncthreads();
  for (int j = 1; j + 1 < NT; j += 2) {
    SBAR(); qkt<4>(pB0, pB1, K_lds + SHM_K, qr, r32, hi, kc0);
    finishSM(pA0, pA1, alA, l_reg, pa0, pa1, pa2, pa3); SBAR();
    SLOAD(SO, (j + 2) * KVBLK); SBAR();
    pv_d0(o, vb0, pa0, pa1, pa2, pa3); partialSM(pB0, pB1, m_reg, mnB, alB, SCALE, THR);
    __syncthreads(); SWAIT(); SWRITE(0, SE);
    RESC(alB); __syncthreads();
    SBAR(); qkt<4>(pA0, pA1, K_lds, qr, r32, hi, kc0);
    finishSM(pB0, pB1, alB, l_reg, pa0, pa1, pa2, pa3); SBAR();
    if (j + 3 < NT) SLOAD(SE, (j + 3) * KVBLK); SBAR();
    pv_d0(o, vb0 + (int)SHM_V, pa0, pa1, pa2, pa3); partialSM(pA0, pA1, m_reg, mnA, alA, SCALE, THR);
    __syncthreads(); SWAIT(); SWRITE(1, SO);
    RESC(alA); __syncthreads();
  }
  SBAR(); qkt<4>(pB0, pB1, K_lds + SHM_K, qr, r32, hi, kc0);
  finishSM(pA0, pA1, alA, l_reg, pa0, pa1, pa2, pa3); SBAR();
  pv_d0(o, vb0, pa0, pa1, pa2, pa3); partialSM(pB0, pB1, m_reg, mnB, alB, SCALE, THR);
  __syncthreads(); RESC(alB);
  finishSM(pB0, pB1, alB, l_reg, pa0, pa1, pa2, pa3); SBAR();
  pv_d0(o, vb0 + (int)SHM_V, pa0, pa1, pa2, pa3);
  asm volatile("s_waitcnt vmcnt(0)" ::: "memory");
  if (hi == 0) li_l[r32] = l_reg; asm volatile("s_waitcnt lgkmcnt(0)" ::: "memory");
  float rli[16];
#pragma unroll
  for (int r = 0; r < 16; ++r) rli[r] = __builtin_amdgcn_rcpf(li_l[crow(r, hi)]);
  __syncthreads();
  float* X = (float*)lds + (size_t)wq * 4096;
  if (csel == 1) {
#pragma unroll
    for (int d0 = 0; d0 < 4; ++d0)
#pragma unroll
      for (int r = 0; r < 16; ++r) X[(d0 * 16 + r) * 64 + lane] = o[d0][r] * rli[r];
  }
  __syncthreads();
  if (csel == 0) {
    float ss[16];
#pragma unroll
    for (int r = 0; r < 16; ++r) ss[r] = 0.f;
#pragma unroll
    for (int d0 = 0; d0 < 4; ++d0)
#pragma unroll
      for (int r = 0; r < 16; ++r) { const float v = o[d0][r] * rli[r] - lam * X[(d0 * 16 + r) * 64 + lane]; o[d0][r] = v; ss[r] += v * v; }
#pragma unroll
    for (int r = 0; r < 16; ++r) { float s = ss[r];
      s += __shfl_xor(s, 1); s += __shfl_xor(s, 2); s += __shfl_xor(s, 4); s += __shfl_xor(s, 8); s += __shfl_xor(s, 16);
      ss[r] = __builtin_amdgcn_rsqf(s * (1.f / 128.f) + RMS_EPS) * post_scale; }
    float gg[4];
#pragma unroll
    for (int d0 = 0; d0 < 4; ++d0) gg[d0] = subln_g[d0 * 32 + r32];
    bf16* Ow = outb + (long)(wq * 32) * ldo;
#pragma unroll
    for (int r = 0; r < 16; ++r) { const int orow = crow(r, hi);
#pragma unroll
      for (int d0 = 0; d0 < 4; ++d0) Ow[(long)orow * ldo + d0 * 32 + r32] = f2bf(o[d0][r] * ss[r] * gg[d0]); }
  }
#undef SLOAD
#undef SWRITE
#undef SWAIT
}

__device__ __forceinline__ void dil_attn_unit(const bf16* Qh, const bf16* Kh, const bf16* Vh, int ld, int dil, int rho, int u0, int L,
                                              float* Oc, float* lsep, char* lds, const int wave_id) {
  constexpr float SCALE = 0.08838834764831845f; constexpr float C = SCALE * 1.4426950408889634f;
  const int tid = tid_from_wave(wave_id), wid = __builtin_amdgcn_readfirstlane(tid >> 6), lane = tid & 63, r32 = lane & 31, hi = lane >> 5;
  char* V_lds = lds; char* K_lds = lds + 2 * SHM_V;
  float* ws = (float*)(lds + 2 * SHM_V + 2 * SHM_K) + wid * 64; float* li_l = ws; float* al_l = ws + 32;
  float m_reg = -1e30f, l_reg = 0; f32x16 o[4] = {}; bf16x8 qr[8];
  const int uq = u0 + wid * 32 + r32;
  const bf16* Qw = Qh + (long)(rho + dil * uq) * ld + hi * 8;
#pragma unroll
  for (int d0 = 0; d0 < 8; ++d0) qr[d0] = ld8(Qw + d0 * 16);
  const int sr = tid >> 4, sc = (tid & 15) * 8, vst0 = v_st(sr, sc), vst1 = v_st(32 + sr, sc);
  const int vb0 = (int)(uintptr_t)V_lds + v_rd_base(lane);
  const int tlo = wid >> 1;
  for (int t = 0; t < 6; ++t) {
    const int kt0 = u0 - 64 + 64 * t;
    __syncthreads();
    { int ua = kt0 + sr, ub = kt0 + 32 + sr; ua = ua < 0 ? 0 : (ua >= L ? L - 1 : ua); ub = ub < 0 ? 0 : (ub >= L ? L - 1 : ub);
      const long ra = (long)(rho + dil * ua) * ld + sc, rb = (long)(rho + dil * ub) * ld + sc;
      const bf16x8 va = ld8(Vh + ra), vb = ld8(Vh + rb), ka = ld8(Kh + ra), kb = ld8(Kh + rb);
      *(bf16x8*)(V_lds + vst0) = va; *(bf16x8*)(V_lds + vst1) = vb; const int kc = sc * 2;
      *(bf16x8*)(K_lds + KSWZ(sr, kc)) = ka; *(bf16x8*)(K_lds + KSWZ(32 + sr, kc)) = kb; }
    __syncthreads();
    if (t >= tlo && t <= tlo + 2) {
      f32x16 p0, p1;
      qkt<8>(p0, p1, K_lds, qr, r32, hi, 0);
#pragma unroll
      for (int r = 0; r < 16; ++r) { const int uk0 = kt0 + crow(r, hi), uk1 = uk0 + 32; const int d0 = uk0 - uq, d1 = uk1 - uq;
        const bool ok0 = (uk0 >= 0) && (uk0 < L) && (d0 >= -64) && (d0 <= 64), ok1 = (uk1 >= 0) && (uk1 < L) && (d1 >= -64) && (d1 <= 64);
        p0[r] = ok0 ? p0[r] : -1e30f; p1[r] = ok1 ? p1[r] : -1e30f; }
      float pmax = p0[0];
#pragma unroll
      for (int r = 1; r < 16; ++r) pmax = fmaxf(pmax, p0[r]);
#pragma unroll
      for (int r = 0; r < 16; ++r) pmax = fmaxf(pmax, p1[r]);
      { auto rr = __builtin_amdgcn_permlane32_swap(__float_as_uint(pmax), __float_as_uint(pmax), false, false);
        pmax = fmaxf(__uint_as_float(rr[0]), __uint_as_float(rr[1])); }
      const float mn = fmaxf(m_reg, pmax); const float alpha = __builtin_amdgcn_exp2f((m_reg - mn) * C); m_reg = mn;
      const float mnC = -mn * C;
#pragma unroll
      for (int r = 0; r < 16; ++r) { p0[r] = __builtin_amdgcn_exp2f(fmaf(p0[r], C, mnC)); p1[r] = fmaf(p1[r], C, mnC); }
      bf16x8 pa0, pa1, pa2, pa3;
      finishSM(p0, p1, alpha, l_reg, pa0, pa1, pa2, pa3);
      RESC(alpha);
      pv_d0(o, vb0, pa0, pa1, pa2, pa3);
    }
  }
  if (hi == 0) li_l[r32] = l_reg; asm volatile("s_waitcnt lgkmcnt(0)" ::: "memory");
  float rli[16];
#pragma unroll
  for (int r = 0; r < 16; ++r) rli[r] = __builtin_amdgcn_rcpf(li_l[crow(r, hi)]);
#pragma unroll
  for (int r = 0; r < 16; ++r) { const int uo = u0 + wid * 32 + crow(r, hi); float* orow = Oc + (long)(rho + dil * uo) * 512;
#pragma unroll
    for (int d0 = 0; d0 < 4; ++d0) orow[d0 * 32 + r32] = o[d0][r] * rli[r]; }
  if (hi == 0) lsep[(long)(rho + dil * uq) * 4] = m_reg * SCALE + __logf(l_reg);
}
#undef RESC
#undef KSWZ
#undef SBAR
}

struct Args { const float* in[N_INPUTS]; float* out; unsigned char* ws; int ph_lo, ph_hi; };
typedef const __attribute__((address_space(4))) Args* ArgsP;
struct Frame {
    LAS unsigned char* lds; volatile LAS unsigned* MISC; unsigned* ctl; unsigned char* ws;
    int tid, lane, wave, G, bid;
};
constexpr int PH_P0 = 0, PH_P1 = 1, PH_P2 = 2, PH_L0 = 3, NPH_L = 12, PH_FINAL = PH_L0 + DEPTH * NPH_L, NPHASES = PH_FINAL + 1;
enum { LP_NORM1 = 0, LP_G1, LP_PREP, LP_MIX, LP_POST, LP_G2, LP_NORM2, LP_GS, LP_GO, LP_NORM3, LP_M1, LP_M2 };

__device__ __forceinline__ int q_next(Frame& F, int q) {
    __syncthreads();
    if (F.tid == 0) F.MISC[0] = __hip_atomic_fetch_add(F.ctl + CW_Q + 64 * q, 1u, __ATOMIC_RELAXED, __HIP_MEMORY_SCOPE_AGENT);
    __syncthreads();
    return (int)F.MISC[0];
}

template <class RowMap>
__device__ __forceinline__ void transpose_item(const float* W, int ldn, bf16* WT, int ldt, RowMap rm, LAS float* scr, int k0, int n0, int lane) {
#pragma unroll 8
    for (int i = 0; i < 32; ++i) { const int kk = 2 * i + (lane >> 5); scr[kk * 33 + (lane & 31)] = W[(size_t)(k0 + kk) * ldn + n0 + (lane & 31)]; }
    LDS_WAIT(); asm volatile("" ::: "memory");
    const int c = lane & 7;
#pragma unroll
    for (int j = 0; j < 4; ++j) { const int n = (lane >> 3) + 8 * j; const LAS float* s = scr + (8 * c) * 33 + n;
        u32x4 o; o.x = pk2(s[0 * 33], s[1 * 33]); o.y = pk2(s[2 * 33], s[3 * 33]); o.z = pk2(s[4 * 33], s[5 * 33]); o.w = pk2(s[6 * 33], s[7 * 33]);
        *(u32x4*)(WT + (size_t)rm(n0 + n) * ldt + k0 + 8 * c) = o; }
    LDS_WAIT(); asm volatile("" ::: "memory");
}
struct RmId { __device__ __forceinline__ int operator()(int n) const { return n; } };
struct RmW13 { int off; __device__ __forceinline__ int operator()(int n) const { return 256 * (n >> 7) + off + (n & 127); } };

__device__ __forceinline__ void p0_prologue(Frame& F, ArgsP a) {
    unsigned char* ws = F.ws;
    LAS float* scr = (LAS float*)(F.lds + F.wave * 16384);
    const int gw = F.bid * 8 + F.wave, NGW = F.G * 8;
    constexpr int I_WIN = (DM / 64) * (IN_TOTAL / 32), I_SQ = (DM / 64) * (DM / 32), I_WKV = (DM / 64) * (4096 / 32), I_W1 = (DM / 64) * (DEXP / 32), I_W2 = (DEXP / 64) * (DM / 32);
    constexpr int PER_L = I_WIN + I_SQ + I_WKV + I_SQ + NEXP * (2 * I_W1 + I_W2);
    for (int it = gw; it < DEPTH * PER_L; it += NGW) {
        const int l = it / PER_L; int r = it % PER_L;
        if (r < I_WIN) { const int nb = IN_TOTAL / 32; transpose_item(a->in[I_W_IN] + (size_t)l * DM * IN_TOTAL, IN_TOTAL, (bf16*)(ws + WS_WIN) + (size_t)l * ZLD * DM, DM, RmId{}, scr, 64 * (r / nb), 32 * (r % nb), F.lane); continue; } r -= I_WIN;
        if (r < I_SQ) { const int nb = DM / 32; transpose_item(a->in[I_W_OUT] + (size_t)l * DM * DM, DM, (bf16*)(ws + WS_WOUT) + (size_t)l * DM * DM, DM, RmId{}, scr, 64 * (r / nb), 32 * (r % nb), F.lane); continue; } r -= I_SQ;
        if (r < I_WKV) { const int nb = 4096 / 32; transpose_item(a->in[I_XA_WKV] + (size_t)l * DM * 4096, 4096, (bf16*)(ws + SC_WKVT) + (size_t)l * 4096 * DM, DM, RmId{}, scr, 64 * (r / nb), 32 * (r % nb), F.lane); continue; } r -= I_WKV;
        if (r < I_SQ) { const int nb = DM / 32; transpose_item(a->in[I_XA_WO] + (size_t)l * DM * DM, DM, (bf16*)(ws + SC_WOT) + (size_t)l * DM * DM, DM, RmId{}, scr, 64 * (r / nb), 32 * (r % nb), F.lane); continue; } r -= I_SQ;
        const int e = r / (2 * I_W1 + I_W2); r = r % (2 * I_W1 + I_W2);
        const size_t le = (size_t)l * NEXP + e;
        if (r < I_W1) { const int nb = DEXP / 32; transpose_item(a->in[I_MOE_W1] + le * DM * DEXP, DEXP, (bf16*)(ws + WS_W13) + le * 1024 * DM, DM, RmW13{0}, scr, 64 * (r / nb), 32 * (r % nb), F.lane); continue; } r -= I_W1;
        if (r < I_W1) { const int nb = DEXP / 32; transpose_item(a->in[I_MOE_W3] + le * DM * DEXP, DEXP, (bf16*)(ws + WS_W13) + le * 1024 * DM, DM, RmW13{128}, scr, 64 * (r / nb), 32 * (r % nb), F.lane); continue; } r -= I_W1;
        { const int nb = DM / 32; transpose_item(a->in[I_MOE_W2] + le * DEXP * DM, DM, (bf16*)(ws + WS_W2) + le * DM * DEXP, DEXP, RmId{}, scr, 64 * (r / nb), 32 * (r % nb), F.lane); }
    }
    const int gt = F.bid * 512 + F.tid, NGT = F.G * 512;
    for (int i = gt; i < DEPTH * (ZLD - IN_TOTAL) * DM / 8; i += NGT) { const int l = i / ((ZLD - IN_TOTAL) * DM / 8), r = i % ((ZLD - IN_TOTAL) * DM / 8);
        *(u32x4*)((bf16*)(ws + WS_WIN) + (size_t)l * ZLD * DM + (size_t)IN_TOTAL * DM + (size_t)r * 8) = (u32x4){0u, 0u, 0u, 0u}; }
    for (int i = gt; i < DEPTH * DM * DM / 8; i += NGT) { const f32x4 x0 = *(const f32x4*)(a->in[I_XA_WQ] + (size_t)i * 8), x1 = *(const f32x4*)(a->in[I_XA_WQ] + (size_t)i * 8 + 4);
        u32x4 o; o.x = pk2(x0[0], x0[1]); o.y = pk2(x0[2], x0[3]); o.z = pk2(x1[0], x1[1]); o.w = pk2(x1[2], x1[3]); *(u32x4*)((bf16*)(ws + SC_WQB) + (size_t)i * 8) = o; }
    { float* cosA = (float*)(ws + WS_ROPE); float* sinA = cosA + SEQ * 32; float* cosC = sinA + SEQ * 32; float* sinC = cosC + SEQ * 64;
      for (int i = gt; i < SEQ * 96; i += NGT) { const int s = i / 96, j = i % 96; const bool isA = j < 32; const int jj = isA ? j : j - 32; const float dim = isA ? 64.f : 128.f;
          const float inv = 1.0f / powf(10000.0f, (float)(2 * jj) / dim); const float ang = (float)s * inv; float sn, cs; sincosf(ang, &sn, &cs);
          if (isA) { cosA[s * 32 + jj] = cs; sinA[s * 32 + jj] = sn; } else { cosC[s * 64 + jj] = cs; sinC[s * 64 + jj] = sn; } } }
    for (int i = gt; i < DEPTH * 2 * 32 * 64; i += NGT) { const int l = i / (2 * 32 * 64), r = i % (2 * 32 * 64), dir = r / (32 * 64), g = (r / 64) % 32, n = r % 64;
        float* ab = (float*)(ws + WS_S5P + l * S5P_LAYER); float* bb = ab + 2 * 32 * 64 * 2;
        const size_t pi = (((size_t)l * 2 + dir) * 32 + g) * 64 + n;
        const float lr = fminf(a->in[I_S5_A_RE][pi], -1e-4f), li = a->in[I_S5_A_IM][pi], dt = __expf(a->in[I_S5_LOG_DT][((size_t)l * 2 + dir) * 32 + g]);
        const float mag = __expf(dt * lr); float sn, cs; sincosf(dt * li, &sn, &cs); const float abr = mag * cs, abi = mag * sn;
        const float den = lr * lr + li * li; const float ir = lr / den, ii = -li / den;
        const float fr_ = (abr - 1.f) * ir - abi * ii, fi_ = (abr - 1.f) * ii + abi * ir;
        ab[(size_t)r * 2] = abr; ab[(size_t)r * 2 + 1] = abi;
        const size_t bi = (((size_t)l * 32 + g) * 64 + n) * 16;
#pragma unroll
        for (int c = 0; c < 16; ++c) { const float br = a->in[I_S5_B_RE][bi + c], bim = a->in[I_S5_B_IM][bi + c];
            bb[((size_t)r * 16 + c) * 2] = fr_ * br - fi_ * bim; bb[((size_t)r * 16 + c) * 2 + 1] = fr_ * bim + fi_ * br; } }
    for (int it = gw; it < DEPTH * BATCH * NMEM; it += NGW) { const int l = it / (BATCH * NMEM), row = it % (BATCH * NMEM);
        const f32x4* xr = (const f32x4*)(a->in[I_MEM] + (size_t)row * DM) + F.lane; const f32x4* gr = (const f32x4*)(a->in[I_NORM_MEM] + (size_t)l * DM) + F.lane;
        f32x4 v[8]; float s = 0.f;
#pragma unroll
        for (int j = 0; j < 8; ++j) { v[j] = xr[64 * j]; s += (v[j].x * v[j].x + v[j].y * v[j].y) + (v[j].z * v[j].z + v[j].w * v[j].w); }
        const float rstd = 1.f / sqrtf(wave_sum(s) * (1.f / DM) + RMS_EPS);
        u32x2* o8 = (u32x2*)((bf16*)(ws + SC_MEMN) + ((size_t)l * 512 + row) * DM) + F.lane;
#pragma unroll
        for (int j = 0; j < 8; ++j) { const f32x4 gv = gr[64 * j]; u32x2 w; w.x = pk2(v[j].x * rstd * gv.x, v[j].y * rstd * gv.y); w.y = pk2(v[j].z * rstd * gv.z, v[j].w * rstd * gv.w); o8[64 * j] = w; } }
}

struct SchedDense { const char* A; const char* B; char* C; int nM, nN, G, c, lda, ldb, ldcb  , cesz  ;
    __device__ __forceinline__ bool next(int i, pg8::Unit& u) const { const long L = (long)i * G + c; if (L >= (long)nM * nN) return false; int pm, pn; pg8::xcd_tile((int)L, nM, nN, pm, pn);
        u.A = A + (size_t)pm * 256 * lda * 2; u.B = B + (size_t)pn * 256 * ldb * 2; u.C = C + (size_t)pm * 256 * ldcb + (size_t)pn * 256 * cesz; u.row0 = pm * 256; u.col0 = pn * 256; u.aux = 0; return true; }
    __device__ __forceinline__ int arow(const pg8::Unit&, int r) const { return r; } };
struct SchedBatch { const char* A; const char* B; char* C; size_t sA, sB, sC; int nM, nN, nb, G, c, lda, ldb, ldcb, cesz, rowsPerBatch;
    __device__ __forceinline__ bool next(int i, pg8::Unit& u) const { const long L = (long)i * G + c; const int per = nM * nN; if (L >= (long)per * nb) return false; const int b = (int)(L / per), r = (int)(L % per), pm = r / nN, pn = r % nN;
        u.A = A + b * sA + (size_t)pm * 256 * lda * 2; u.B = B + b * sB + (size_t)pn * 256 * ldb * 2; u.C = C + b * sC + (size_t)pm * 256 * ldcb + (size_t)pn * 256 * cesz; u.row0 = b * rowsPerBatch + pm * 256; u.col0 = pn * 256; u.aux = b; return true; }
    __device__ __forceinline__ int arow(const pg8::Unit&, int r) const { return r; } };
struct SchedXaPre { unsigned char* ws; int G, c, kind;
    __device__ __forceinline__ bool next(int i, pg8::Unit& u) const { const long L = (long)i * G + c; if (L >= 128) return false; const int r = (int)L, p = r >> 3, t = r & 7, l = p >> 3, b = (p >> 2) & 1, h = p & 3;
        const bf16* kvb = (const bf16*)(ws + SC_KVB) + (size_t)l * 512 * 4096 + (size_t)(b * 256) * 4096;
        if (kind == 0) { u.A = (const char*)(kvb + h * 512); u.B = (const char*)((const bf16*)(ws + SC_WQB) + (size_t)l * DM * DM + (size_t)(t * 256) * DM + h * 512);
            u.C = (char*)((bf16*)(ws + WS_WQK) + ((size_t)(l * 2 + b) * 1024 + h * 256) * DM + t * 256); u.aux = DM; }
        else { u.A = (const char*)((const bf16*)(ws + SC_WOT) + (size_t)l * DM * DM + (size_t)(t * 256) * DM + h * 512); u.B = (const char*)(kvb + 2048 + h * 512);
            u.C = (char*)((bf16*)(ws + WS_VWO) + ((size_t)(l * 2 + b) * DM + t * 256) * 1024 + h * 256); u.aux = 1024; }
        u.row0 = 0; u.col0 = 0; return true; }
    __device__ __forceinline__ int arow(const pg8::Unit&, int r) const { return r; } };
struct EpiBf16U { static constexpr bool PERM = true, AFTER_DRAIN = false;
    __device__ __forceinline__ void operator()(const pg8::Acc& acc, const pg8::Unit& u, int wr, int wc, int fr, int fq) const { pg8::EpiBf16 e{u.aux}; e(acc, u, wr, wc, fr, fq); } };
struct SchedMoe { unsigned char* ws; const volatile LAS int* tp; const volatile LAS int* cnt; int layer, G, c, which;
    __device__ __forceinline__ bool next(int i, pg8::Unit& u) const {
        const int npn = which == 0 ? 4 : 8; const long L = (long)i * G + c; const int ntile = tp[32]; if (L >= (long)ntile * npn) return false;
        const int mt = (int)(L / npn), pn = (int)(L % npn); int e = 0;
#pragma unroll 1
        for (int k = 1; k < 32; ++k) e += (mt >= tp[k]) ? 1 : 0;
        const int lt = mt - tp[e]; const int nvalid = min(256, cnt[e] - lt * 256);
        u.row0 = lt * 256; u.col0 = pn * 256; u.aux = (e << 16) | nvalid;
        if (which == 0) { u.A = (const char*)(ws + WS_HN); u.B = (const char*)((const bf16*)(ws + WS_W13) + ((size_t)(layer * NEXP + e) * 1024 + pn * 256) * DM);
            u.C = (char*)((bf16*)(ws + SC_HMID) + (size_t)(mt * 256) * DEXP + pn * 128); }
        else { u.A = (const char*)((const bf16*)(ws + SC_HMID) + (size_t)(mt * 256) * DEXP); u.B = (const char*)((const bf16*)(ws + WS_W2) + ((size_t)(layer * NEXP + e) * DM + pn * 256) * DEXP);
            u.C = (char*)((bf16*)(ws + SC_YBUF) + (size_t)(mt * 256) * DM + pn * 256); }
        return true; }
    __device__ __forceinline__ int arow(const pg8::Unit& u, int r) const { const int e = u.aux >> 16, nvalid = u.aux & 0xffff; const int idx = (r < nvalid) ? (u.row0 + r) : u.row0;
        return ((const int*)(ws + WS_ETOK))[(size_t)e * ECAP + idx]; } };

__device__ __forceinline__ void moe_prefix(Frame& F, int layer, volatile LAS int* tp, volatile LAS int* cnt) {
    __syncthreads();
    if (F.tid < 32) cnt[F.tid] = (int)__hip_atomic_load(F.ctl + CW_CNT + layer * 64 + F.tid, __ATOMIC_RELAXED, __HIP_MEMORY_SCOPE_AGENT);
    __syncthreads();
    if (F.tid == 0) { int s = 0; for (int e = 0; e < 32; ++e) { tp[e] = s; s += (cnt[e] + 255) >> 8; } tp[32] = s; }
    __syncthreads();
}
template <int MODE>
__device__ __forceinline__ void norm_phase(Frame& F, ArgsP a, const float* src, const float* gain, int layer) {
    unsigned char* ws = F.ws; float* H = (float*)(ws + WS_H); bf16* HN = (bf16*)(ws + WS_HN);
    volatile LAS int* tp = (volatile LAS int*)(F.lds + 1024); volatile LAS int* cnt = tp + 40;
    if (MODE & 1) moe_prefix(F, layer - 1, tp, cnt);
    const int gw = F.bid * 8 + F.wave, NGW = F.G * 8;
    const f32x4* gr = (const f32x4*)gain + F.lane;
    for (int row = gw; row < NTOK; row += NGW) {
        const f32x4* xr = (const f32x4*)(src + (size_t)row * DM) + F.lane;
        f32x4 v[8];
#pragma unroll
        for (int j = 0; j < 8; ++j) v[j] = xr[64 * j];
        if (MODE & 1) {
            const int* ti = (const int*)(ws + WS_TINFO) + (size_t)row * 4;
            const int e0 = ti[0], p0 = ti[1], e1 = ti[2], p1 = ti[3];
            const size_t s0 = (size_t)tp[e0] * 256 + p0, s1 = (size_t)tp[e1] * 256 + p1;
            const u32x2* y0 = (const u32x2*)((const bf16*)(ws + SC_YBUF) + s0 * DM) + F.lane; const u32x2* y1 = (const u32x2*)((const bf16*)(ws + SC_YBUF) + s1 * DM) + F.lane;
#pragma unroll
            for (int j = 0; j < 8; ++j) { const u32x2 a0 = y0[64 * j], a1 = y1[64 * j];
                v[j].x += __uint_as_float(a0.x << 16) + __uint_as_float(a1.x << 16); v[j].y += __uint_as_float(a0.x & 0xffff0000u) + __uint_as_float(a1.x & 0xffff0000u);
                v[j].z += __uint_as_float(a0.y << 16) + __uint_as_float(a1.y << 16); v[j].w += __uint_as_float(a0.y & 0xffff0000u) + __uint_as_float(a1.y & 0xffff0000u); }
            if (!(MODE & 4)) { f32x4* hr = (f32x4*)(H + (size_t)row * DM) + F.lane;
#pragma unroll
                for (int j = 0; j < 8; ++j) hr[64 * j] = v[j]; }
        }
        float s = 0.f;
#pragma unroll
        for (int j = 0; j < 8; ++j) s += (v[j].x * v[j].x + v[j].y * v[j].y) + (v[j].z * v[j].z + v[j].w * v[j].w);
        const float rstd = 1.f / sqrtf(wave_sum(s) * (1.f / DM) + RMS_EPS);
#pragma unroll
        for (int j = 0; j < 8; ++j) { const f32x4 gv = gr[64 * j]; v[j].x *= rstd * gv.x; v[j].y *= rstd * gv.y; v[j].z *= rstd * gv.z; v[j].w *= rstd * gv.w; }
        if (MODE & 4) { f32x4* orow = (f32x4*)(a->out + (size_t)row * DM) + F.lane;
#pragma unroll
            for (int j = 0; j < 8; ++j) orow[64 * j] = v[j]; }
        else { u32x2* o8 = (u32x2*)(HN + (size_t)row * DM) + F.lane;
#pragma unroll
            for (int j = 0; j < 8; ++j) { u32x2 w; w.x = pk2(v[j].x, v[j].y); w.y = pk2(v[j].z, v[j].w); o8[64 * j] = w; } }
        if (MODE & 2) {
            const float* wg = a->in[I_ROUTER_GROUP] + (size_t)layer * DM * 4; const float* we = a->in[I_ROUTER_EXPERT] + (size_t)layer * DM * 32;
            float lg[4] = {0.f, 0.f, 0.f, 0.f};
#pragma unroll 2
            for (int j = 0; j < 8; ++j) { const int k0 = (64 * j + F.lane) * 4;
#pragma unroll
                for (int q = 0; q < 4; ++q) { const f32x4 w4 = *(const f32x4*)(wg + (size_t)(k0 + q) * 4); const float x = v[j][q]; lg[0] += x * w4.x; lg[1] += x * w4.y; lg[2] += x * w4.z; lg[3] += x * w4.w; } }
#pragma unroll
            for (int q = 0; q < 4; ++q) lg[q] = wave_sum(lg[q]);
            int gi = 0; float gm = lg[0];
#pragma unroll
            for (int q = 1; q < 4; ++q) if (lg[q] > gm) { gm = lg[q]; gi = q; }
            const float gw_ = 1.f / (__expf(lg[0] - gm) + __expf(lg[1] - gm) + __expf(lg[2] - gm) + __expf(lg[3] - gm));
            float le[8] = {0.f, 0.f, 0.f, 0.f, 0.f, 0.f, 0.f, 0.f};
#pragma unroll 2
            for (int j = 0; j < 8; ++j) { const int k0 = (64 * j + F.lane) * 4;
#pragma unroll
                for (int q = 0; q < 4; ++q) { const float* wp = we + (size_t)(k0 + q) * 32 + gi * 8; const f32x4 wa = *(const f32x4*)wp, wb = *(const f32x4*)(wp + 4); const float x = v[j][q];
                    le[0] += x * wa.x; le[1] += x * wa.y; le[2] += x * wa.z; le[3] += x * wa.w; le[4] += x * wb.x; le[5] += x * wb.y; le[6] += x * wb.z; le[7] += x * wb.w; } }
#pragma unroll
            for (int q = 0; q < 8; ++q) le[q] = wave_sum(le[q]);
            int i0 = 0; float m0 = le[0];
#pragma unroll
            for (int q = 1; q < 8; ++q) if (le[q] > m0) { m0 = le[q]; i0 = q; }
            int i1 = -1; float m1 = -3.0e38f;
#pragma unroll
            for (int q = 0; q < 8; ++q) if (q != i0 && le[q] > m1) { m1 = le[q]; i1 = q; }
            const float t = __expf(m1 - m0); const float w0 = 1.f / (1.f + t), w1 = t / (1.f + t);
            if (F.lane == 0) {
                const int e0 = gi * 8 + i0, e1 = gi * 8 + i1;
                const int p0 = (int)__hip_atomic_fetch_add(F.ctl + CW_CNT + layer * 64 + e0, 1u, __ATOMIC_RELAXED, __HIP_MEMORY_SCOPE_AGENT);
                const int p1 = (int)__hip_atomic_fetch_add(F.ctl + CW_CNT + layer * 64 + e1, 1u, __ATOMIC_RELAXED, __HIP_MEMORY_SCOPE_AGENT);
                int* et = (int*)(ws + WS_ETOK); float* eg = (float*)(ws + WS_EGATE); int* ti = (int*)(ws + WS_TINFO) + (size_t)row * 4;
                et[(size_t)e0 * ECAP + p0] = row; eg[(size_t)e0 * ECAP + p0] = gw_ * w0; et[(size_t)e1 * ECAP + p1] = row; eg[(size_t)e1 * ECAP + p1] = gw_ * w1;
                ti[0] = e0; ti[1] = p0; ti[2] = e1; ti[3] = p1;
            }
        }
    }
}

__device__ __forceinline__ void rope_token(Frame& F, bf16* zrow, int s) {
    const float* cosA = (const float*)(F.ws + WS_ROPE); const float* sinA = cosA + SEQ * 32; const float* cosC = sinA + SEQ * 32; const float* sinC = cosC + SEQ * 64;
    { const int i = F.lane & 31; const float cs = cosA[s * 32 + i], sn = sinA[s * 32 + i];
#pragma unroll
      for (int it = 0; it < 8; ++it) { bf16* p = zrow + ZA + (it * 2 + (F.lane >> 5)) * 64; const float x1 = bf2f(p[i]), x2 = bf2f(p[i + 32]); p[i] = f2bf(x1 * cs - x2 * sn); p[i + 32] = f2bf(x2 * cs + x1 * sn); } }
    { const int i = F.lane; const float cs = cosC[s * 64 + i], sn = sinC[s * 64 + i];
#pragma unroll
      for (int it = 0; it < 8; ++it) { bf16* p = zrow + ZC + it * 128; const float x1 = bf2f(p[i]), x2 = bf2f(p[i + 64]); p[i] = f2bf(x1 * cs - x2 * sn); p[i + 64] = f2bf(x2 * cs + x1 * sn); } }
}

constexpr int RWT = 8;
__device__ __forceinline__ void rwkv_prep_tile(Frame& F, ArgsP a, int layer, int tile) {
    unsigned char* ws = F.ws; const bf16* Z = (const bf16*)(ws + SC_Z);
    LAS float* zr = (LAS float*)F.lds; LAS float* act = zr + (RWT + 2) * IN_B;
    const int t0 = tile * RWT; const int b = t0 / SEQ, s0 = t0 % SEQ;
    __syncthreads();
    for (int i = F.tid; i < (RWT + 2) * (IN_B / 8); i += 512) { const int rr = i / (IN_B / 8), c8 = i % (IN_B / 8); const int s = s0 - 1 + rr;
        f32x4 lo = {0.f, 0.f, 0.f, 0.f}, hi = {0.f, 0.f, 0.f, 0.f};
        if (s >= 0 && s < SEQ) { const u32x4 w = *(const u32x4*)(Z + (size_t)(b * SEQ + s) * ZLD + ZB + c8 * 8);
            lo = (f32x4){__uint_as_float(w.x << 16), __uint_as_float(w.x & 0xffff0000u), __uint_as_float(w.y << 16), __uint_as_float(w.y & 0xffff0000u)};
            hi = (f32x4){__uint_as_float(w.z << 16), __uint_as_float(w.z & 0xffff0000u), __uint_as_float(w.w << 16), __uint_as_float(w.w & 0xffff0000u)}; }
        *(LAS f32x4*)(zr + rr * IN_B + c8 * 8) = lo; *(LAS f32x4*)(zr + rr * IN_B + c8 * 8 + 4) = hi; }
    __syncthreads();
    const float* mu = a->in[I_RWKV_MU] + (size_t)layer * 2 * IN_B;
#define ZS(t, col) (zr[((t) + 1) * IN_B + (col)] + mu[(col)] * (zr[(t) * IN_B + (col)] - zr[((t) + 1) * IN_B + (col)]) + mu[IN_B + (col)] * (zr[((t) + 2) * IN_B + (col)] - zr[((t) + 1) * IN_B + (col)]))
    for (int i = F.tid; i < RWT * 384; i += 512) { const int t = i / 384, j = i % 384; const int col = 1536 + j; const float x = ZS(t, col);
        act[t * 384 + j] = (j < 128) ? tanhf(x) : ((j < 256) ? x : sigmoidf_(x)); }
    __syncthreads();
    const int c = F.tid;
    float aw0[RWT], aw1[RWT], aa0[RWT], aa1[RWT], ag[RWT];
#pragma unroll
    for (int t = 0; t < RWT; ++t) { aw0[t] = 0.f; aw1[t] = 0.f; aa0[t] = 0.f; aa1[t] = 0.f; ag[t] = 0.f; }
    const float* w2 = a->in[I_RWKV_W2] + (size_t)layer * 2 * 64 * 512; const float* a2 = a->in[I_RWKV_A2] + (size_t)layer * 2 * 64 * 512; const float* g2 = a->in[I_RWKV_G2] + (size_t)layer * 128 * 512;
#pragma unroll 1
    for (int r = 0; r < 64; r += 4) {
        float wv0[4], wv1[4], av0[4], av1[4];
#pragma unroll
        for (int q = 0; q < 4; ++q) { wv0[q] = w2[(size_t)(r + q) * 512 + c]; wv1[q] = w2[(size_t)(64 + r + q) * 512 + c]; av0[q] = a2[(size_t)(r + q) * 512 + c]; av1[q] = a2[(size_t)(64 + r + q) * 512 + c]; }
#pragma unroll
        for (int t = 0; t < RWT; ++t) { const f32x4 x0 = *(const LAS f32x4*)(act + t * 384 + r), x1 = *(const LAS f32x4*)(act + t * 384 + 64 + r), y0 = *(const LAS f32x4*)(act + t * 384 + 128 + r), y1 = *(const LAS f32x4*)(act + t * 384 + 192 + r);
#pragma unroll
            for (int q = 0; q < 4; ++q) { aw0[t] += x0[q] * wv0[q]; aw1[t] += x1[q] * wv1[q]; aa0[t] += y0[q] * av0[q]; aa1[t] += y1[q] * av1[q]; } }
    }
#pragma unroll 1
    for (int r = 0; r < 128; r += 4) {
        float gv[4];
#pragma unroll
        for (int q = 0; q < 4; ++q) gv[q] = g2[(size_t)(r + q) * 512 + c];
#pragma unroll
        for (int t = 0; t < RWT; ++t) { const f32x4 x = *(const LAS f32x4*)(act + t * 384 + 256 + r);
#pragma unroll
            for (int q = 0; q < 4; ++q) ag[t] += x[q] * gv[q]; }
    }
    const float w00 = a->in[I_RWKV_W0][(size_t)layer * 1024 + c], w01 = a->in[I_RWKV_W0][(size_t)layer * 1024 + 512 + c];
    const float a00 = a->in[I_RWKV_A0][(size_t)layer * 1024 + c], a01 = a->in[I_RWKV_A0][(size_t)layer * 1024 + 512 + c];
    const float kkw = a->in[I_RWKV_KK][(size_t)layer * 512 + c], kaw = a->in[I_RWKV_KA][(size_t)layer * 512 + c];
    float* RW = (float*)(ws + SC_RW); const size_t N1 = (size_t)NTOK * 512;
#pragma unroll
    for (int t = 0; t < RWT; ++t) {
        const float r_ = ZS(t, c), k_ = ZS(t, 512 + c), v_ = ZS(t, 1024 + c);
        const float x0 = -(w00 + aw0[t]), x1 = -(w01 + aw1[t]);
        const float sp0 = fmaxf(x0, 0.f) + log1pf(__expf(-fabsf(x0))), sp1 = fmaxf(x1, 0.f) + log1pf(__expf(-fabsf(x1)));
        const float d0 = __expf(-__expf(-sp0 - 0.5f)), d1 = __expf(-__expf(-sp1 - 0.5f));
        const float al0 = sigmoidf_(a00 + aa0[t]), al1 = sigmoidf_(a01 + aa1[t]);
        float kk = k_ * kkw; const float ssq = wave_sum(kk * kk); kk *= 1.f / sqrtf(ssq + 1e-12f);
        const float km0 = k_ * (1.f + (al0 - 1.f) * kaw), km1 = k_ * (1.f + (al1 - 1.f) * kaw);
        const size_t o = (size_t)(t0 + t) * 512 + c;
        RW[0 * N1 + o] = r_; RW[1 * N1 + o] = v_; RW[2 * N1 + o] = kk; RW[3 * N1 + o] = d0; RW[4 * N1 + o] = d1;
        RW[5 * N1 + o] = km0; RW[6 * N1 + o] = km1; RW[7 * N1 + o] = kk * al0; RW[8 * N1 + o] = kk * al1; RW[9 * N1 + o] = ag[t];
    }
#undef ZS
}

__device__ __forceinline__ void s5_carry_task(Frame& F, int layer, int task) {
    unsigned char* ws = F.ws; const bf16* Z = (const bf16*)(ws + SC_Z);
    const int dir = task & 1, g = (task >> 1) & 31, b = task >> 6; const int n = F.lane;
    const float* ab = (const float*)(ws + WS_S5P + layer * S5P_LAYER); const float* bb = ab + 2 * 32 * 64 * 2;
    const int pr = (dir * 32 + g) * 64 + n;
    const float abr = ab[pr * 2], abi = ab[pr * 2 + 1];
    float bbr[16], bbi[16];
#pragma unroll
    for (int c = 0; c < 16; ++c) { bbr[c] = bb[((size_t)pr * 16 + c) * 2]; bbi[c] = bb[((size_t)pr * 16 + c) * 2 + 1]; }
    LAS float* ul = (LAS float*)(F.lds + 65536 + F.wave * 4096);
    float* carry = (float*)(ws + SC_CARRY);
    float xr = 0.f, xi = 0.f;
    for (int blk = 0; blk < SEQ / 64; ++blk) {
        { const int sl = dir ? (SEQ - 1 - (blk * 64 + n)) : (blk * 64 + n); const bf16* zp = Z + (size_t)(b * SEQ + sl) * ZLD + ZD + g * 16;
          const u32x4 w0 = *(const u32x4*)zp, w1 = *(const u32x4*)(zp + 8);
          LAS f32x4* d = (LAS f32x4*)(ul + n * 16);
          d[0] = (f32x4){__uint_as_float(w0.x << 16), __uint_as_float(w0.x & 0xffff0000u), __uint_as_float(w0.y << 16), __uint_as_float(w0.y & 0xffff0000u)};
          d[1] = (f32x4){__uint_as_float(w0.z << 16), __uint_as_float(w0.z & 0xffff0000u), __uint_as_float(w0.w << 16), __uint_as_float(w0.w & 0xffff0000u)};
          d[2] = (f32x4){__uint_as_float(w1.x << 16), __uint_as_float(w1.x & 0xffff0000u), __uint_as_float(w1.y << 16), __uint_as_float(w1.y & 0xffff0000u)};
          d[3] = (f32x4){__uint_as_float(w1.z << 16), __uint_as_float(w1.z & 0xffff0000u), __uint_as_float(w1.w << 16), __uint_as_float(w1.w & 0xffff0000u)}; }
        LDS_WAIT(); asm volatile("" ::: "memory");
#pragma unroll 4
        for (int i = 0; i < 64; ++i) {
            const int step = blk * 64 + i;
            if ((step & (S5CH - 1)) == 0) { const int sl = dir ? (SEQ - 1 - step) : step; const int ch = sl / S5CH;
                float* cp = carry + ((((size_t)dir * BATCH + b) * S5NCH + ch) * 32 + g) * 128 + n * 2; cp[0] = xr; cp[1] = xi; }
            const f32x4 u0 = *(const LAS f32x4*)(ul + i * 16), u1 = *(const LAS f32x4*)(ul + i * 16 + 4), u2 = *(const LAS f32x4*)(ul + i * 16 + 8), u3 = *(const LAS f32x4*)(ul + i * 16 + 12);
            float br = 0.f, bi = 0.f;
#pragma unroll
            for (int c = 0; c < 4; ++c) { br += bbr[c] * u0[c] + bbr[4 + c] * u1[c] + bbr[8 + c] * u2[c] + bbr[12 + c] * u3[c]; bi += bbi[c] * u0[c] + bbi[4 + c] * u1[c] + bbi[8 + c] * u2[c] + bbi[12 + c] * u3[c]; }
            const float nr = abr * xr - abi * xi + br, ni = abr * xi + abi * xr + bi; xr = nr; xi = ni;
        }
        asm volatile("" ::: "memory");
    }
}

__device__ __forceinline__ void prep_phase(Frame& F, ArgsP a, int layer) {
    const int q = layer * 8 + 0;
    for (;;) { const int it = q_next(F, q);
        if (it < 16) { s5_carry_task(F, layer, it * 8 + F.wave); continue; }
        if (it < 16 + NTOK / RWT) { rwkv_prep_tile(F, a, layer, it - 16); continue; }
        const int r = it - 16 - NTOK / RWT; if (r >= NTOK / 64) break;
        for (int k = 0; k < 8; ++k) { const int tok = r * 64 + F.wave * 8 + k; rope_token(F, (bf16*)(F.ws + SC_Z) + (size_t)tok * ZLD, tok % SEQ); }
    }
}

__device__ __forceinline__ void rwkv_scan_naive(Frame& F, int chain) {
    unsigned char* ws = F.ws; const float* RW = (const float*)(ws + SC_RW); const size_t N1 = (size_t)NTOK * 512;
    const int dir = chain & 1, h = (chain >> 1) & 7, b = chain >> 4;
    const float* Rp = RW; const float* Vp = RW + N1; const float* KKp = RW + 2 * N1; const float* Wp = RW + (3 + dir) * N1; const float* KMp = RW + (5 + dir) * N1; const float* BBp = RW + (7 + dir) * N1;
    float* YS = (float*)(ws + SC_YS) + (size_t)dir * N1;
    LAS float* L = (LAS float*)(F.lds + F.wave * 2048);
    float st[64];
#pragma unroll
    for (int j = 0; j < 64; ++j) st[j] = 0.f;
    size_t idx = (size_t)(b * SEQ + (dir ? SEQ - 1 : 0)) * 512 + h * 64 + F.lane;
    float va = -KKp[idx], vw = Wp[idx], vb = BBp[idx], vk = KMp[idx], vr = Rp[idx], vv = Vp[idx];
    for (int t = 0; t < SEQ; ++t) {
        L[F.lane] = va; L[64 + F.lane] = vw; L[128 + F.lane] = vb; L[192 + F.lane] = vk; L[256 + F.lane] = vr;
        const float v = vv; const size_t oidx = idx;
        if (t + 1 < SEQ) { idx = dir ? idx - 512 : idx + 512; va = -KKp[idx]; vw = Wp[idx]; vb = BBp[idx]; vk = KMp[idx]; vr = Rp[idx]; vv = Vp[idx]; }
        LDS_WAIT(); asm volatile("" ::: "memory");
        float sa0 = 0.f, sa1 = 0.f, sa2 = 0.f, sa3 = 0.f;
#pragma unroll
        for (int j = 0; j < 64; j += 4) { const f32x4 x = *(const LAS f32x4*)(L + j); sa0 += st[j] * x[0]; sa1 += st[j + 1] * x[1]; sa2 += st[j + 2] * x[2]; sa3 += st[j + 3] * x[3]; }
        const float sa = (sa0 + sa1) + (sa2 + sa3);
        float y0 = 0.f, y1 = 0.f, y2 = 0.f, y3 = 0.f;
#pragma unroll
        for (int j = 0; j < 64; j += 4) { const f32x4 w4 = *(const LAS f32x4*)(L + 64 + j), b4 = *(const LAS f32x4*)(L + 128 + j), k4 = *(const LAS f32x4*)(L + 192 + j), r4 = *(const LAS f32x4*)(L + 256 + j);
            st[j] = st[j] * w4[0] + (sa * b4[0] + v * k4[0]); st[j + 1] = st[j + 1] * w4[1] + (sa * b4[1] + v * k4[1]); st[j + 2] = st[j + 2] * w4[2] + (sa * b4[2] + v * k4[2]); st[j + 3] = st[j + 3] * w4[3] + (sa * b4[3] + v * k4[3]);
            y0 += st[j] * r4[0]; y1 += st[j + 1] * r4[1]; y2 += st[j + 2] * r4[2]; y3 += st[j + 3] * r4[3]; }
        YS[oidx] = (y0 + y1) + (y2 + y3);
        asm volatile("" ::: "memory");
    }
}

__device__ __forceinline__ void s5_unit(Frame& F, ArgsP a, int layer, int unit) {
    unsigned char* ws = F.ws; const bf16* Z = (const bf16*)(ws + SC_Z);
    const int b = unit / S5NCH, ch = unit % S5NCH; const int tok0 = b * SEQ + ch * S5CH;
    LAS float* ybuf = (LAS float*)F.lds;
    LAS float* glT = (LAS float*)(F.lds + 32768);
    LAS float* xs = (LAS float*)(F.lds + 65536 + F.wave * 8192);
    const float* ab = (const float*)(ws + WS_S5P + layer * S5P_LAYER); const float* bb = ab + 2 * 32 * 64 * 2;
    const float* carry = (const float*)(ws + SC_CARRY);
    const int n = F.lane;
    __syncthreads();
    for (int gi = 0; gi < 4; ++gi) {
        const int g = gi * 8 + F.wave;
#pragma unroll 1
        for (int dir = 0; dir < 2; ++dir) {
            const int pr = (dir * 32 + g) * 64 + n; const float abr = ab[pr * 2], abi = ab[pr * 2 + 1];
            float bbr[16], bbi[16];
#pragma unroll
            for (int c = 0; c < 16; ++c) { bbr[c] = bb[((size_t)pr * 16 + c) * 2]; bbi[c] = bb[((size_t)pr * 16 + c) * 2 + 1]; }
            const float* cp = carry + ((((size_t)dir * BATCH + b) * S5NCH + ch) * 32 + g) * 128 + n * 2; float xr = cp[0], xi = cp[1];
#pragma unroll 1
            for (int i = 0; i < S5CH; ++i) { const int tl = dir ? (S5CH - 1 - i) : i; const bf16* zp = Z + (size_t)(tok0 + tl) * ZLD + ZD + g * 16;
                const u32x4 w0 = *(const u32x4*)zp, w1 = *(const u32x4*)(zp + 8);
                const float u[16] = {__uint_as_float(w0.x << 16), __uint_as_float(w0.x & 0xffff0000u), __uint_as_float(w0.y << 16), __uint_as_float(w0.y & 0xffff0000u),
                                     __uint_as_float(w0.z << 16), __uint_as_float(w0.z & 0xffff0000u), __uint_as_float(w0.w << 16), __uint_as_float(w0.w & 0xffff0000u),
                                     __uint_as_float(w1.x << 16), __uint_as_float(w1.x & 0xffff0000u), __uint_as_float(w1.y << 16), __uint_as_float(w1.y & 0xffff0000u),
                                     __uint_as_float(w1.z << 16), __uint_as_float(w1.z & 0xffff0000u), __uint_as_float(w1.w << 16), __uint_as_float(w1.w & 0xffff0000u)};
                float br = 0.f, bi = 0.f;
#pragma unroll
                for (int c = 0; c < 16; ++c) { br += bbr[c] * u[c]; bi += bbi[c] * u[c]; }
                const float nr = abr * xr - abi * xi + br, ni = abr * xi + abi * xr + bi; xr = nr; xi = ni;
                LAS float* xp = xs + (tl * 64 + n) * 2;
                if (dir == 0) { xp[0] = xr; xp[1] = xi; } else { xp[0] += xr; xp[1] += xi; } }
        }
        LDS_WAIT(); asm volatile("" ::: "memory");
        { const int c = F.lane & 15, sq = F.lane >> 4; const float* cre = a->in[I_S5_C_RE] + (((size_t)layer * 32 + g) * 16 + c) * 64; const float* cim = a->in[I_S5_C_IM] + (((size_t)layer * 32 + g) * 16 + c) * 64;
          float y[4] = {0.f, 0.f, 0.f, 0.f};
#pragma unroll 4
          for (int nn = 0; nn < 64; nn += 4) { const f32x4 cr = *(const f32x4*)(cre + nn), ci = *(const f32x4*)(cim + nn);
#pragma unroll
              for (int s = 0; s < 4; ++s) { const LAS f32x4* xp = (const LAS f32x4*)(xs + ((sq * 4 + s) * 64 + nn) * 2); const f32x4 xa = xp[0], xb = xp[1];
                  y[s] += cr[0] * xa[0] - ci[0] * xa[1] + cr[1] * xa[2] - ci[1] * xa[3] + cr[2] * xb[0] - ci[2] * xb[1] + cr[3] * xb[2] - ci[3] * xb[3]; } }
          const float dsk = a->in[I_S5_D][(size_t)layer * 512 + g * 16 + c];
#pragma unroll
          for (int s = 0; s < 4; ++s) { const int tl = sq * 4 + s; const float uu = bf2f(Z[(size_t)(tok0 + tl) * ZLD + ZD + g * 16 + c]); const float yy = y[s] + dsk * uu;
              const float x3 = yy * yy * yy; const float gl = 0.5f * yy * (1.f + tanhf(0.7978845608028654f * (yy + 0.044715f * x3)));
              ybuf[tl * 512 + g * 16 + c] = gl; glT[(g * 16 + c) * 16 + tl] = gl; } }
        LDS_WAIT(); asm volatile("" ::: "memory");
    }
    __syncthreads();
    { const int c = F.tid; const float* gw = a->in[I_S5_GLU_W] + (size_t)layer * 512 * 512; float acc[16];
#pragma unroll
      for (int s = 0; s < 16; ++s) acc[s] = 0.f;
#pragma unroll 2
      for (int k = 0; k < 512; ++k) { const float w = gw[(size_t)k * 512 + c]; const LAS f32x4* gp = (const LAS f32x4*)(glT + k * 16); const f32x4 g0 = gp[0], g1 = gp[1], g2 = gp[2], g3 = gp[3];
#pragma unroll
          for (int q = 0; q < 4; ++q) { acc[q] += g0[q] * w; acc[4 + q] += g1[q] * w; acc[8 + q] += g2[q] * w; acc[12 + q] += g3[q] * w; } }
      const float bias = a->in[I_S5_GLU_B][(size_t)layer * 512 + c];
      __syncthreads();
#pragma unroll
      for (int s = 0; s < 16; ++s) { const float gl = ybuf[s * 512 + c]; ybuf[s * 512 + c] = gl * sigmoidf_(acc[s] + bias); } }
    __syncthreads();
    { const float* gn = a->in[I_MIX_OUT_NORM] + ((size_t)layer * 2 + 1) * 512; bf16* MIX = (bf16*)(ws + WS_MIX);
#pragma unroll
      for (int q = 0; q < 2; ++q) { const int tl = F.wave * 2 + q; float v[8]; float s = 0.f;
#pragma unroll
          for (int j = 0; j < 8; ++j) { v[j] = ybuf[tl * 512 + j * 64 + F.lane]; s += v[j] * v[j]; }
          const float rstd = 1.f / sqrtf(wave_sum(s) * (1.f / 512.f) + RMS_EPS);
#pragma unroll
          for (int j = 0; j < 8; ++j) MIX[(size_t)(tok0 + tl) * DM + 1536 + j * 64 + F.lane] = f2bf(v[j] * rstd * gn[j * 64 + F.lane]); } }
}

__device__ __forceinline__ void mix_phase(Frame& F, ArgsP a, int layer) {
    constexpr int NB = 4, NA = BATCH * 4 * (SEQ / 128), NC = BATCH * 4 * 48, ND = BATCH * S5NCH;
    for (;;) { const int it = q_next(F, layer * 8 + 1); if (it >= NB) break; rwkv_scan_naive(F, it * 8 + F.wave); }
    for (;;) { const int it = q_next(F, layer * 8 + 2); if (it >= NA) break;
        unsigned char* ws = F.ws; asm volatile("" : "+s"(ws)); const bf16* Z = (const bf16*)(ws + SC_Z);
        const int qb = it % (SEQ / 128), h = (it / (SEQ / 128)) % 4, b = it / (4 * (SEQ / 128));
        const bf16* zb = Z + (size_t)(b * SEQ) * ZLD + ZA;
        float lam, lam_init;
        { const float* lv = a->in[I_DIFF_LAMBDA] + (size_t)layer * 4 * 64; float d1 = 0.f, d2 = 0.f;
          for (int i = 0; i < 64; ++i) { d1 += lv[i] * lv[64 + i]; d2 += lv[128 + i] * lv[192 + i]; }
          lam_init = 0.8f - 0.6f * expf(-0.3f * (float)layer); lam = expf(d1) - expf(d2) + lam_init; }
        att::diff_attn_unit(zb + (size_t)(qb * 128) * ZLD + h * 128, zb + 512 + h * 128, zb + 1024 + h * 128, ZLD, SEQ,
                            (bf16*)(ws + WS_MIX) + (size_t)(b * SEQ + qb * 128) * DM + h * 128, DM, lam, 1.f - lam_init, a->in[I_DIFF_SUBLN] + (size_t)layer * 128, (char*)F.lds, F.wave); }
    for (;;) { const int it = q_next(F, layer * 8 + 3); if (it >= NC) break;
        unsigned char* ws = F.ws; asm volatile("" : "+s"(ws)); const bf16* Z = (const bf16*)(ws + SC_Z);
        const int r = it % 48, h = (it / 48) % 4, b = it / (48 * 4); const int p = r / 16, rr = r % 16;
        const int dil = p == 0 ? 1 : (p == 1 ? 4 : 16); const int L = SEQ / dil; const int nqb = L / 256; const int rho = rr / nqb, qb = rr % nqb;
        const bf16* zb = Z + (size_t)(b * SEQ) * ZLD + ZC;
        att::dil_attn_unit(zb + h * 128, zb + 512 + h * 128, zb + 1024 + h * 128, ZLD, dil, rho, qb * 256, L,
                           (float*)(ws + SC_OC) + ((size_t)p * NTOK + (size_t)b * SEQ) * 512 + h * 128, (float*)(ws + SC_LSE) + ((size_t)p * NTOK + (size_t)b * SEQ) * 4 + h, (char*)F.lds, F.wave); }
    for (;;) { const int it = q_next(F, layer * 8 + 4); if (it >= ND) break; s5_unit(F, a, layer, it); }
}

__device__ __forceinline__ void post_phase(Frame& F, ArgsP a, int layer) {
    unsigned char* ws = F.ws; bf16* MIX = (bf16*)(ws + WS_MIX);
    const int gw = F.bid * 8 + F.wave, NGW = F.G * 8;
    const float* RW = (const float*)(ws + SC_RW); const size_t N1 = (size_t)NTOK * 512; const float* YS = (const float*)(ws + SC_YS);
    for (int it = gw; it < NTOK * 8; it += NGW) { const int tok = it >> 3, h = it & 7; const size_t o = (size_t)tok * 512 + h * 64 + F.lane; const int c = h * 64 + F.lane;
        const float y = YS[o] + YS[N1 + o];
        const float mean = wave_sum(y) * (1.f / 64.f); const float d = y - mean; const float var = wave_sum(d * d) * (1.f / 64.f);
        const float yn = d * (1.f / sqrtf(var + 64e-5f)) * a->in[I_RWKV_LNX_W][(size_t)layer * 512 + c] + a->in[I_RWKV_LNX_B][(size_t)layer * 512 + c];
        const float r_ = RW[o], v_ = RW[N1 + o], kb = 0.5f * (RW[5 * N1 + o] + RW[6 * N1 + o]);
        const float bon = wave_sum(r_ * kb * a->in[I_RWKV_RK][(size_t)layer * 512 + c]) * v_;
        MIX[(size_t)tok * DM + 512 + c] = f2bf((yn + bon) * RW[9 * N1 + o]); }
    const float* OC = (const float*)(ws + SC_OC); const float* LSE = (const float*)(ws + SC_LSE); const float* gn = a->in[I_MIX_OUT_NORM] + ((size_t)layer * 2 + 0) * 512;
    for (int tok = gw; tok < NTOK; tok += NGW) { const int h = F.lane >> 4;
        const float l0 = LSE[((size_t)0 * NTOK + tok) * 4 + h], l1 = LSE[((size_t)1 * NTOK + tok) * 4 + h], l2 = LSE[((size_t)2 * NTOK + tok) * 4 + h];
        const float m = fmaxf(l0, fmaxf(l1, l2)); float w0 = __expf(l0 - m), w1 = __expf(l1 - m), w2 = __expf(l2 - m); const float inv = 1.f / (w0 + w1 + w2); w0 *= inv; w1 *= inv; w2 *= inv;
        float v[8]; float s = 0.f;
        const f32x4* p0 = (const f32x4*)(OC + ((size_t)0 * NTOK + tok) * 512) + F.lane * 2; const f32x4* p1 = (const f32x4*)(OC + ((size_t)1 * NTOK + tok) * 512) + F.lane * 2; const f32x4* p2 = (const f32x4*)(OC + ((size_t)2 * NTOK + tok) * 512) + F.lane * 2;
#pragma unroll
        for (int j = 0; j < 2; ++j) { const f32x4 a0 = p0[j], a1 = p1[j], a2 = p2[j];
#pragma unroll
            for (int e = 0; e < 4; ++e) { const float x = w0 * a0[e] + w1 * a1[e] + w2 * a2[e]; v[j * 4 + e] = x; s += x * x; } }
        const float rstd = 1.f / sqrtf(wave_sum(s) * (1.f / 512.f) + RMS_EPS);
        const f32x4 g0 = *((const f32x4*)gn + F.lane * 2), g1 = *((const f32x4*)gn + F.lane * 2 + 1);
        u32x4 w; w.x = pk2(v[0] * rstd * g0[0], v[1] * rstd * g0[1]); w.y = pk2(v[2] * rstd * g0[2], v[3] * rstd * g0[3]); w.z = pk2(v[4] * rstd * g1[0], v[5] * rstd * g1[1]); w.w = pk2(v[6] * rstd * g1[2], v[7] * rstd * g1[3]);
        *(u32x4*)(MIX + (size_t)tok * DM + 1024 + F.lane * 8) = w; }
}

#ifndef MK_FUSED
#define MK_FUSED 1
#endif
__global__ void __launch_bounds__(512, 2) enc_fwd(Args args_) {
    extern __shared__ __attribute__((aligned(16))) unsigned char lds_raw[];
    Frame F;
    F.lds = (LAS unsigned char*)lds_raw; F.MISC = (volatile LAS unsigned*)(F.lds + MISC_OFF);
    F.tid = threadIdx.x; F.lane = F.tid & 63; F.wave = __builtin_amdgcn_readfirstlane(F.tid >> 6); F.G = gridDim.x; F.bid = blockIdx.x;
    const int wave0 = F.wave;
    ArgsP ap = (ArgsP)__builtin_amdgcn_kernarg_segment_ptr();
    unsigned char* ws = ap->ws; F.ws = ws; F.ctl = (unsigned*)(ws + WS_CTL);
    for (int u = F.tid; u < (LDS_BYTES - MISC_OFF) / 4; u += 512) ((LAS unsigned*)(F.lds + MISC_OFF))[u] = 0u;
    __syncthreads();
    const int lo = ap->ph_lo, hi = ap->ph_hi;
    if (hi - lo > 1) (void)xcd_barrier_post(F.ctl + CW_BAR, F.MISC + 8);
#ifdef DBG_ONLY
#define IN(k) (((k) < PH_L0 ? (k) : ((k) == PH_FINAL ? 100 : 3 + ((k) - PH_L0) % NPH_L)) == DBG_ONLY && lo <= (k) && (k) < hi)
#else
#define IN(k) ({ int lo_ = lo, hi_ = hi; asm volatile("" : "+s"(lo_), "+s"(hi_)); lo_ <= (k) && (k) < hi_; })
#endif
#define args (*ap)
#define REFRESH() do { int wv_ = wave0, bi_ = blockIdx.x, gg_ = gridDim.x; asm volatile("" : "+s"(wv_), "+s"(bi_), "+s"(gg_)); const int t_ = tid_from_wave(wv_); F.tid = t_; F.lane = t_ & 63; F.wave = wv_; F.bid = bi_; F.G = gg_; ap = (ArgsP)__builtin_amdgcn_kernarg_segment_ptr(); asm volatile("" : "+s"(ap)); unsigned char* w_ = ap->ws; F.ws = w_; ws = w_; F.ctl = (unsigned*)(w_ + WS_CTL); } while (0)
#define SEAM(k) do { if (IN(k) && IN((k) + 1)) { XcdBarrier b_; b_.bar = (unsigned*)(ap->ws + WS_CTL) + CW_BAR; b_.x = xb_xcc_id(); b_.st = F.MISC + 8; xcd_barrier(b_); } } while (0)

    if (IN(PH_P0)) { REFRESH(); p0_prologue(F, ap); } SEAM(PH_P0);
    if (IN(PH_P1)) { REFRESH();
        SchedBatch S{(const char*)(ws + SC_MEMN), (const char*)(ws + SC_WKVT), (char*)(ws + SC_KVB), (size_t)512 * DM * 2, (size_t)4096 * DM * 2, (size_t)512 * 4096 * 2, 2, 16, DEPTH, F.G, F.bid, DM, DM, 4096 * 2, 2, 512};
        pg8::gemm_phase<pg8::EpiBf16, SchedBatch, false>(F.lds, pg8::GemmP{DM, DM, DM}, S, pg8::EpiBf16{4096}, F.wave);
    } SEAM(PH_P1);
    if (IN(PH_P2)) { REFRESH();
        { SchedXaPre S{ws, F.G, F.bid, 0}; pg8::gemm_phase<EpiBf16U, SchedXaPre, false>(F.lds, pg8::GemmP{512, 4096, DM}, S, EpiBf16U{}, F.wave); }
        { SchedXaPre S{ws, F.G, F.bid, 1}; pg8::gemm_phase<EpiBf16U, SchedXaPre, false>(F.lds, pg8::GemmP{512, DM, 4096}, S, EpiBf16U{}, F.wave); }
    } SEAM(PH_P2);

    for (int l = 0; l < DEPTH; ++l) {
        const int pb = PH_L0 + l * NPH_L;
        float* H = (float*)(ws + WS_H);
        if (IN(pb + LP_NORM1)) { REFRESH(); if (l == 0) norm_phase<0>(F, ap, args.in[I_X], args.in[I_NORM_MIX], l); else norm_phase<1>(F, ap, H, args.in[I_NORM_MIX] + (size_t)l * DM, l); } SEAM(pb + LP_NORM1);
        if (IN(pb + LP_G1)) { REFRESH();
            SchedDense S{(const char*)(ws + WS_HN), (const char*)(ws + WS_WIN) + (size_t)l * ZLD * DM * 2, (char*)(ws + SC_Z), NTOK / 256, ZLD / 256, F.G, F.bid, DM, DM, ZLD * 2, 2};
            pg8::gemm_phase<pg8::EpiBf16, SchedDense, false>(F.lds, pg8::GemmP{DM, DM, DM}, S, pg8::EpiBf16{ZLD}, F.wave);
        } SEAM(pb + LP_G1);
        if (IN(pb + LP_PREP)) { REFRESH(); prep_phase(F, ap, l); } SEAM(pb + LP_PREP);
        if (IN(pb + LP_MIX)) { REFRESH(); mix_phase(F, ap, l); } SEAM(pb + LP_MIX);
        if (IN(pb + LP_POST)) { REFRESH(); post_phase(F, ap, l); } SEAM(pb + LP_POST);
        if (IN(pb + LP_G2)) { REFRESH();
            SchedDense S{(const char*)(ws + WS_MIX), (const char*)(ws + WS_WOUT) + (size_t)l * DM * DM * 2, (char*)H, NTOK / 256, DM / 256, F.G, F.bid, DM, DM, DM * 4, 4};
            pg8::gemm_phase<pg8::EpiF32Res, SchedDense, false>(F.lds, pg8::GemmP{DM, DM, DM}, S, pg8::EpiF32Res{DM, l == 0 ? args.in[I_X] : (const float*)H, H}, F.wave);
        } SEAM(pb + LP_G2);
        if (IN(pb + LP_NORM2)) { REFRESH(); norm_phase<0>(F, ap, H, args.in[I_NORM_CROSS] + (size_t)l * DM, l); } SEAM(pb + LP_NORM2);
        if (IN(pb + LP_GS)) { REFRESH();
            SchedBatch S{(const char*)(ws + WS_HN), (const char*)(ws + WS_WQK) + (size_t)l * 2 * 1024 * DM * 2, (char*)(ws + WS_P), (size_t)SEQ * DM * 2, (size_t)1024 * DM * 2, (size_t)SEQ * 1024 * 2, SEQ / 256, 4, BATCH, F.G, F.bid, DM, DM, 1024 * 2, 2, SEQ};
            pg8::gemm_phase<pg8::EpiSoftmax, SchedBatch, false>(F.lds, pg8::GemmP{DM, DM, DM}, S, pg8::EpiSoftmax{1024, 0.044194173824159216f * 1.4426950408889634f}, F.wave);
        } SEAM(pb + LP_GS);
        if (IN(pb + LP_GO)) { REFRESH();
            SchedBatch S{(const char*)(ws + WS_P), (const char*)(ws + WS_VWO) + (size_t)l * 2 * DM * 1024 * 2, (char*)H, (size_t)SEQ * 1024 * 2, (size_t)DM * 1024 * 2, (size_t)SEQ * DM * 4, SEQ / 256, DM / 256, BATCH, F.G, F.bid, 1024, 1024, DM * 4, 4, SEQ};
            pg8::gemm_phase<pg8::EpiF32Res, SchedBatch, false>(F.lds, pg8::GemmP{1024, 1024, 1024}, S, pg8::EpiF32Res{DM, (const float*)H, H}, F.wave);
        } SEAM(pb + LP_GO);
        if (IN(pb + LP_NORM3)) { REFRESH(); norm_phase<2>(F, ap, H, args.in[I_NORM_MOE] + (size_t)l * DM, l); } SEAM(pb + LP_NORM3);
        if (IN(pb + LP_M1)) { REFRESH();
            volatile LAS int* tp = (volatile LAS int*)(F.lds + MISC_OFF + 256); volatile LAS int* cnt = tp + 40;
            moe_prefix(F, l, tp, cnt);
            SchedMoe S{ws, tp, cnt, l, F.G, F.bid, 0};
            pg8::gemm_phase<pg8::EpiSwiGlu, SchedMoe, true>(F.lds, pg8::GemmP{DM, DM, DM}, S, pg8::EpiSwiGlu{DEXP}, F.wave);
        } SEAM(pb + LP_M1);
        if (IN(pb + LP_M2)) { REFRESH();
            volatile LAS int* tp = (volatile LAS int*)(F.lds + MISC_OFF + 256); volatile LAS int* cnt = tp + 40;
            moe_prefix(F, l, tp, cnt);
            SchedMoe S{ws, tp, cnt, l, F.G, F.bid, 1};
            pg8::gemm_phase<pg8::EpiGate, SchedMoe, false>(F.lds, pg8::GemmP{DEXP, DEXP, DEXP}, S, pg8::EpiGate{DM, (const float*)(ws + WS_EGATE), nullptr}, F.wave);
        } SEAM(pb + LP_M2);
    }
    if (IN(PH_FINAL)) { REFRESH(); norm_phase<5>(F, ap, (const float*)(ws + WS_H), args.in[I_NORM_FINAL], DEPTH); }
#undef IN
#undef SEAM
#undef args
}

extern "C" void kernel_launch(void* const* d_in, const int* in_sizes, int n_in, void* d_out, int out_size, void* d_ws, size_t ws_size, hipStream_t stream) {
    static int grid = 0;
    if (grid == 0) {
        if (n_in != N_INPUTS || out_size != NTOK * DM || ws_size < WS_END) { fprintf(stderr, "kernel_launch: built for %d inputs, out %d, ws >= %zu; got %d, %d, %zu\n", N_INPUTS, NTOK * DM, WS_END, n_in, out_size, ws_size); grid = -1; return; }
        int dev = 0, cus = 0, per_cu = 0;
        if (hipGetDevice(&dev) != hipSuccess || hipDeviceGetAttribute(&cus, hipDeviceAttributeMultiprocessorCount, dev) != hipSuccess) { fprintf(stderr, "kernel_launch: device query failed\n"); grid = -1; return; }
        if (hipFuncSetAttribute((const void*)enc_fwd, hipFuncAttributeMaxDynamicSharedMemorySize, LDS_BYTES) != hipSuccess) { fprintf(stderr, "kernel_launch: hipFuncSetAttribute failed\n"); grid = -1; return; }
        if (hipOccupancyMaxActiveBlocksPerMultiprocessor(&per_cu, (const void*)enc_fwd, 512, LDS_BYTES) != hipSuccess || per_cu < 1) fprintf(stderr, "kernel_launch: occupancy query says %d blocks per CU\n", per_cu);
        grid = cus;
    }
    if (grid < 0) return;
    hipMemsetAsync((char*)d_ws + WS_CTL, 0, CTL_BYTES, stream);
    Args a; memset(&a, 0, sizeof(a));
    for (int i = 0; i < N_INPUTS; ++i) a.in[i] = (const float*)d_in[i];
    a.out = (float*)d_out; a.ws = (unsigned char*)d_ws;
#if MK_FUSED
    a.ph_lo = 0; a.ph_hi = NPHASES;
    hipLaunchKernelGGL(enc_fwd, dim3(grid), dim3(512), LDS_BYTES, stream, a);
#else
    for (int p = 0; p < NPHASES; ++p) { a.ph_lo = p; a.ph_hi = p + 1; hipLaunchKernelGGL(enc_fwd, dim3(grid), dim3(512), LDS_BYTES, stream, a); }
#endif
    const hipError_t le = hipPeekAtLastError();
    if (le != hipSuccess) fprintf(stderr, "kernel_launch: launch failed: %s\n", hipGetErrorName(le));
}
```

```cpp
#include <hip/hip_runtime.h>
#include <cstdio>
#include <cstdint>
#include <cstring>

#define GAS __attribute__((address_space(1)))
#define LAS __attribute__((address_space(3)))
typedef unsigned short bf16;
typedef short bf16x8 __attribute__((ext_vector_type(8)));
typedef short s16x4 __attribute__((ext_vector_type(4)));
typedef float f32x2 __attribute__((ext_vector_type(2)));
typedef float f32x4 __attribute__((ext_vector_type(4)));
typedef float f32x16 __attribute__((ext_vector_type(16)));
typedef unsigned u32x2 __attribute__((ext_vector_type(2)));
typedef unsigned u32x4 __attribute__((ext_vector_type(4)));
typedef GAS unsigned gu32;

constexpr int DM = 2048, BATCH = 2, SEQ = 4096, NTOK = BATCH * SEQ, DEPTH = 2, NMEM = 256;
constexpr int IN_A = 1536, IN_B = 1920, IN_C = 1536, IN_D = 512, IN_TOTAL = 5504, ZLD = 5632;
constexpr int ZA = 0, ZB = 1536, ZC = 3456, ZD = 4992;
constexpr int NEXP = 32, DEXP = 512, ECAP = 8192;
constexpr int SLOT_CAP = 24576;
constexpr int S5CH = 16, S5NCH = SEQ / S5CH;
constexpr float RMS_EPS = 1e-6f;

enum { I_X = 0, I_MEM, I_NORM_MIX, I_W_IN, I_W_OUT, I_DIFF_LAMBDA, I_DIFF_SUBLN, I_RWKV_MU, I_RWKV_W0, I_RWKV_W2, I_RWKV_A0, I_RWKV_A2, I_RWKV_G2,
       I_RWKV_KK, I_RWKV_KA, I_RWKV_RK, I_RWKV_LNX_W, I_RWKV_LNX_B, I_S5_A_RE, I_S5_A_IM, I_S5_LOG_DT, I_S5_B_RE, I_S5_B_IM, I_S5_C_RE, I_S5_C_IM,
       I_S5_D, I_S5_GLU_W, I_S5_GLU_B, I_MIX_OUT_NORM, I_NORM_CROSS, I_NORM_MEM, I_XA_WQ, I_XA_WKV, I_XA_WO, I_NORM_MOE, I_ROUTER_GROUP,
       I_ROUTER_EXPERT, I_MOE_W1, I_MOE_W3, I_MOE_W2, I_NORM_FINAL, N_INPUTS };

constexpr size_t al256(size_t x) { return (x + 255) / 256 * 256; }
constexpr size_t WS_CTL = 0, CTL_BYTES = 1u << 20;
constexpr size_t WS_WIN  = WS_CTL + CTL_BYTES;
constexpr size_t WS_WOUT = WS_WIN + (size_t)DEPTH * ZLD * DM * 2;
constexpr size_t WS_WQK  = WS_WOUT + (size_t)DEPTH * DM * DM * 2;
constexpr size_t WS_VWO  = WS_WQK + (size_t)DEPTH * BATCH * 1024 * DM * 2;
constexpr size_t WS_W13  = WS_VWO + (size_t)DEPTH * BATCH * DM * 1024 * 2;
constexpr size_t WS_W2   = WS_W13 + (size_t)DEPTH * NEXP * 1024 * DM * 2;
constexpr size_t WS_ROPE = WS_W2 + (size_t)DEPTH * NEXP * DM * DEXP * 2;
constexpr size_t WS_S5P  = WS_ROPE + (size_t)SEQ * (32 + 32 + 64 + 64) * 4;
constexpr size_t S5P_LAYER = (size_t)(2 * 32 * 64 * 2 + 2 * 32 * 64 * 16 * 2) * 4;
constexpr size_t WS_H    = al256(WS_S5P + DEPTH * S5P_LAYER);
constexpr size_t WS_HN   = WS_H + (size_t)NTOK * DM * 4;
constexpr size_t WS_MIX  = WS_HN + (size_t)NTOK * DM * 2;
constexpr size_t WS_P    = WS_MIX + (size_t)NTOK * DM * 2;
constexpr size_t WS_ETOK = WS_P + (size_t)NTOK * 1024 * 2;
constexpr size_t WS_EGATE= WS_ETOK + (size_t)NEXP * ECAP * 4;
constexpr size_t WS_TINFO= WS_EGATE + (size_t)NEXP * ECAP * 4;
constexpr size_t WS_SCR  = al256(WS_TINFO + (size_t)NTOK * 16);
constexpr size_t SC_WKVT = WS_SCR;
constexpr size_t SC_MEMN = SC_WKVT + (size_t)DEPTH * 4096 * DM * 2;
constexpr size_t SC_KVB  = SC_MEMN + (size_t)DEPTH * 512 * DM * 2;
constexpr size_t SC_WQB  = SC_KVB + (size_t)DEPTH * 512 * 4096 * 2;
constexpr size_t SC_WOT  = SC_WQB + (size_t)DEPTH * DM * DM * 2;
constexpr size_t SC_PRO_END = SC_WOT + (size_t)DEPTH * DM * DM * 2;
constexpr size_t SC_Z    = WS_SCR;
constexpr size_t SC_RW   = SC_Z + (size_t)NTOK * ZLD * 2;
constexpr size_t RWSZ    = (size_t)NTOK * 512 * 4;
constexpr size_t SC_YS   = SC_RW + 10 * RWSZ;
constexpr size_t SC_OC   = SC_YS + 2 * RWSZ;
constexpr size_t SC_LSE  = SC_OC + 3 * RWSZ;
constexpr size_t SC_CARRY= SC_LSE + (size_t)3 * NTOK * 4 * 4;
constexpr size_t SC_MIX_END = SC_CARRY + (size_t)2 * BATCH * S5NCH * 32 * 64 * 2 * 4;
constexpr size_t SC_HMID = WS_SCR;
constexpr size_t SC_YBUF = SC_HMID + (size_t)SLOT_CAP * DEXP * 2;
constexpr size_t SC_MOE_END = SC_YBUF + (size_t)SLOT_CAP * DM * 2;
constexpr size_t cmax(size_t a, size_t b) { return a > b ? a : b; }
constexpr size_t WS_END = cmax(cmax(SC_PRO_END, SC_MIX_END), SC_MOE_END);

constexpr int CW_BAR = 4096;
constexpr int CW_Q = 8192;
constexpr int CW_CNT = 16384;

constexpr int RING_BYTES = 131072;
constexpr int MISC_OFF = RING_BYTES;
constexpr int LDS_BYTES = 147456;

__device__ __forceinline__ float bf2f(unsigned short b) { return __uint_as_float(((unsigned)b) << 16); }
typedef __bf16 bf16x2_t __attribute__((ext_vector_type(2)));
__device__ __forceinline__ unsigned pk2c(float lo, float hi) { bf16x2_t v = {(__bf16)lo, (__bf16)hi}; return __builtin_bit_cast(unsigned, v); }
__device__ __forceinline__ unsigned pk2(float lo, float hi) { unsigned r; asm volatile("v_cvt_pk_bf16_f32 %0, %1, %2" : "=v"(r) : "v"(lo), "v"(hi)); return r; }
__device__ __forceinline__ bf16 f2bf(float f) { return (bf16)(pk2(f, 0.f) & 0xffffu); }
__device__ __forceinline__ float wave_sum(float v) {
#pragma unroll
    for (int o = 1; o < 64; o <<= 1) v += __shfl_xor(v, o);
    return v;
}
__device__ __forceinline__ float wave_max(float v) {
#pragma unroll
    for (int o = 1; o < 64; o <<= 1) v = fmaxf(v, __shfl_xor(v, o));
    return v;
}
__device__ __forceinline__ float sigmoidf_(float x) { return 1.f / (1.f + __expf(-x)); }
#define LDS_WAIT() asm volatile("s_waitcnt lgkmcnt(0)" ::: "memory")
#define VM_WAIT() asm volatile("s_waitcnt vmcnt(0)" ::: "memory")

__device__ __forceinline__ int tid_from_wave(int wave) { int t = wave * 64 + (int)__builtin_amdgcn_mbcnt_hi(~0u, __builtin_amdgcn_mbcnt_lo(~0u, 0u)); asm volatile("" : "+v"(t)); return t; }
#define XB_TMO      128
#define XB_XCNT(j)  (256  + 64 * (j))
#define XB_XSUB(j)  (1280 + 64 * (j))
#define XB_XGEN(j)  (2304 + 64 * (j))
#define XB_TOP      3328
#define XB_TOPGEN   3392
#define XCD_BAR_WORDS 3456
#define XB_SPIN_CAP (1u << 18)

__device__ __forceinline__ unsigned xb_ld(unsigned* p)              { return __hip_atomic_load(p, __ATOMIC_RELAXED, __HIP_MEMORY_SCOPE_AGENT); }
__device__ __forceinline__ unsigned xb_add(unsigned* p, unsigned v) { return __hip_atomic_fetch_add(p, v, __ATOMIC_RELAXED, __HIP_MEMORY_SCOPE_AGENT); }
__device__ __forceinline__ unsigned xb_xcc_id() { return (unsigned)__builtin_amdgcn_s_getreg((3 << 11) | 20) & 0xFu; }
#define XB_SPIN(cond, bar) do { unsigned _sp = 0; while (cond) { __builtin_amdgcn_s_sleep(1); \
    if ((++_sp & 255u) == 0u) { if (xb_ld(&(bar)[XB_TMO])) break; if (_sp > XB_SPIN_CAP) { atomicAdd(&(bar)[XB_TMO], 1u); break; } } } } while (0)

struct XcdBarrier {
    unsigned* bar; unsigned x;
    volatile LAS unsigned* st;
};

__device__ __forceinline__ XcdBarrier xcd_barrier_post(unsigned* bar, volatile LAS unsigned* st) {
    XcdBarrier b; b.bar = bar; b.x = xb_xcc_id(); b.st = st;
    if (threadIdx.x == 0) (void)xb_add(&bar[XB_XCNT(b.x)], 1u);
    return b;
}
__device__ __forceinline__ void xcd_barrier_complete(unsigned* bar, unsigned x, unsigned& nloc, unsigned& nx) {
    const unsigned G = gridDim.x * gridDim.y * gridDim.z;
    unsigned sum, cnt, mine, sp = 0u;
    for (;;) {
        sum = 0u; cnt = 0u; mine = 0u;
#pragma unroll
        for (unsigned j = 0; j < 16; ++j) { const unsigned c = xb_ld(&bar[XB_XCNT(j)]); sum += c; cnt += (c > 0u) ? 1u : 0u; mine = (j == x) ? c : mine; }
        if (sum == G) break;
        __builtin_amdgcn_s_sleep(1);
        if ((++sp & 255u) == 0u) { if (xb_ld(&bar[XB_TMO])) break; if (sp > XB_SPIN_CAP) { atomicAdd(&bar[XB_TMO], 1u); break; } }
    }
    nloc = mine > 0u ? mine : 1u; nx = cnt > 0u ? cnt : 1u;
}

__device__ __forceinline__ void xcd_barrier(const XcdBarrier& b) {
    asm volatile("s_waitcnt vmcnt(0)" ::: "memory");
    __syncthreads();
    if (threadIdx.x == 0) {
        unsigned* bar = b.bar;
        __builtin_amdgcn_s_waitcnt(0);
        unsigned nloc = b.st[0], nx = b.st[1];
        if (nloc == 0u) { xcd_barrier_complete(bar, b.x, nloc, nx); b.st[0] = nloc; b.st[1] = nx; }
        const unsigned old = xb_add(&bar[XB_XSUB(b.x)], 1u);
        const unsigned gen = old / nloc;
        if (old + 1u == (gen + 1u) * nloc) {
            __builtin_amdgcn_fence(__ATOMIC_RELEASE, "agent");
            asm volatile("s_waitcnt vmcnt(0)" ::: "memory");
            const unsigned og = xb_add(&bar[XB_TOP], 1u);
            const unsigned tg = og / nx;
            if (og + 1u == (tg + 1u) * nx) xb_add(&bar[XB_TOPGEN], 1u);
            else XB_SPIN(xb_ld(&bar[XB_TOPGEN]) == tg, bar);
            __builtin_amdgcn_fence(__ATOMIC_ACQUIRE, "agent");
            xb_add(&bar[XB_XGEN(b.x)], 1u);
            asm volatile("s_waitcnt vmcnt(0)" ::: "memory");
        } else {
            XB_SPIN(xb_ld(&bar[XB_XGEN(b.x)]) == gen, bar);
            __builtin_amdgcn_fence(__ATOMIC_ACQUIRE, "agent");
            asm volatile("s_waitcnt vmcnt(0)" ::: "memory");
        }
    }
    __syncthreads();
}


namespace pg8 {
constexpr int BM = 256, BK = 64, HALF = 128, HTB = HALF * BK * 2, STAGE_BYTES = 8 * HTB, NXCD = 8, WGM = 8;
__host__ __device__ __forceinline__ int lds_byte(int r, int c) { const int st = (r >> 4) * 2 + (c >> 5), rr = r & 15, cc = c & 31, ob = rr * 64 + cc * 2; return st * 1024 + (ob ^ (((ob >> 9) & 1) << 5)); }
__host__ __device__ __forceinline__ void stage_rc(int b, int& R, int& C) { const int st = b / 1024, sb = b % 1024, swz = sb ^ (((sb >> 9) & 1) << 5); R = (st >> 1) * 16 + swz / 64; C = (st & 1) * 32 + (swz % 64) / 2; }
__host__ __device__ __forceinline__ int perm32(int rho) { const int n = rho >> 4, i = rho & 15; return 8 * (i >> 2) + 4 * n + (i & 3); }

struct Unit { const char* A; const char* B; char* C; int row0, col0, aux; };
struct GemmP { int K, lda, ldb; };

__device__ __forceinline__ void xcd_tile(int L, int nM, int nN, int& pm, int& pn) {
    const int nwg = nM * nN; int wgid = L;
    { const int q = nwg / NXCD, r = nwg % NXCD, xcd = wgid % NXCD, off = wgid / NXCD; wgid = (xcd < r ? xcd * (q + 1) : r * (q + 1) + (xcd - r) * q) + off; }
    const int nig = WGM * nN, gid = wgid / nig, fm = gid * WGM, gsz = (nM - fm) < WGM ? (nM - fm) : WGM;
    pm = fm + ((wgid % nig) % gsz); pn = (wgid % nig) / gsz;
}

typedef f32x4 Acc[2][2][4][2];

template <class Epi, class Sched, bool GATHER>
__device__ __forceinline__ void gemm_phase(LAS unsigned char* lds, const GemmP g, const Sched& S, const Epi& E, const int wave_id) {
    const int tid = tid_from_wave(wave_id), wid = __builtin_amdgcn_readfirstlane(tid >> 6), lane = tid & 63, wr = wid >> 2, wc = wid & 3, fr = lane & 15, fq = lane >> 4;
    const int K = g.K, nt = K / BK;
    int Rr[2], Cc[2]; unsigned voffB[2];
#pragma unroll
    for (int i = 0; i < 2; ++i) { int R, C; stage_rc(tid * 16 + i * 8192, R, C); const int Rb = Epi::PERM ? ((R & ~31) + perm32(R & 31)) : R;
        Rr[i] = R; Cc[i] = C; voffB[i] = (unsigned)(Rb * g.ldb + C) * 2u; }
    const size_t kstep = (size_t)(BK * 2);
    const size_t hstepB = (size_t)HALF * g.ldb * 2;
    const unsigned ldsw = (unsigned)wid * 1024u;
    const int aoff = lds_byte(wr * 64 + fr, fq * 8), boff = lds_byte(wc * 32 + fr, fq * 8);
#define PG8_SA(b, h) (((b) * 2 + (h)) * HTB)
#define PG8_SB(b, h) ((4 + (b) * 2 + (h)) * HTB)
#define PG8_STAGE_B(bufoff, gbase) do { _Pragma("unroll") for (int _i = 0; _i < 2; ++_i) \
        __builtin_amdgcn_global_load_lds((const unsigned*)((const char*)(gbase) + voffB[_i]), (LAS unsigned*)(lds + (bufoff) + ldsw + _i * 8192), 16, 0, 0); } while (0)
#define PG8_STAGE_A(bufoff, gbase, OFF, h) do { _Pragma("unroll") for (int _i = 0; _i < 2; ++_i) \
        __builtin_amdgcn_global_load_lds((const unsigned*)((const char*)(gbase) + (OFF)[h][_i]), (LAS unsigned*)(lds + (bufoff) + ldsw + _i * 8192), 16, 0, 0); } while (0)
#define PG8_OFFS(u, OFF) do { _Pragma("unroll") for (int _h = 0; _h < 2; ++_h) _Pragma("unroll") for (int _i = 0; _i < 2; ++_i) { \
        const int _row = _h * HALF + Rr[_i]; const int _src = GATHER ? S.arow((u), _row) : _row; (OFF)[_h][_i] = (unsigned)(_src * g.lda + Cc[_i]) * 2u; } } while (0)
#define PG8_LDA(dst, b, h) do { _Pragma("unroll") for (int m = 0; m < 4; ++m) _Pragma("unroll") for (int k = 0; k < 2; ++k) dst[m][k] = *(const LAS bf16x8*)(lds + PG8_SA(b, h) + aoff + m * 2048 + k * 1024); } while (0)
#define PG8_LDB(dst, b, h) do { _Pragma("unroll") for (int n = 0; n < 2; ++n) _Pragma("unroll") for (int k = 0; k < 2; ++k) dst[n][k] = *(const LAS bf16x8*)(lds + PG8_SB(b, h) + boff + n * 2048 + k * 1024); } while (0)
#define PG8_MMA(ai, bj, At, Bt) do { __builtin_amdgcn_s_setprio(1); _Pragma("unroll") for (int m = 0; m < 4; ++m) _Pragma("unroll") for (int n = 0; n < 2; ++n) _Pragma("unroll") for (int k = 0; k < 2; ++k) \
        acc[ai][bj][m][n] = __builtin_amdgcn_mfma_f32_16x16x32_bf16(Bt[n][k], At[m][k], acc[ai][bj][m][n], 0, 0, 0); __builtin_amdgcn_s_setprio(0); } while (0)
#define PG8_WAIT_V(n) asm volatile("s_waitcnt vmcnt(" #n ")" ::: "memory")
#define PG8_WAIT_L(n) asm volatile("s_waitcnt lgkmcnt(" #n ")" ::: "memory")
#define PG8_BAR __builtin_amdgcn_s_barrier()
#define PG8_SCHED __builtin_amdgcn_sched_barrier(0)
    Unit cur, nxt; int ui = 0;
    if (!S.next(0, cur)) return;
    f32x4 acc[2][2][4][2];
#pragma unroll
    for (int a = 0; a < 2; ++a)
#pragma unroll
        for (int b = 0; b < 2; ++b)
#pragma unroll
            for (int m = 0; m < 4; ++m)
#pragma unroll
                for (int n = 0; n < 2; ++n) acc[a][b][m][n] = (f32x4){0.f, 0.f, 0.f, 0.f};
    bf16x8 At[4][2], B0[2][2], B1[2][2];
    const char* cA = cur.A; const char* cB = cur.B;
    unsigned coffA[2][2], noffA[2][2];
    PG8_OFFS(cur, coffA);
    PG8_STAGE_B(PG8_SB(0, 0), cB); PG8_STAGE_A(PG8_SA(0, 0), cA, coffA, 0); PG8_STAGE_B(PG8_SB(0, 1), cB + hstepB); PG8_STAGE_A(PG8_SA(0, 1), cA, coffA, 1);
    if (wr == 1) PG8_BAR;
    PG8_WAIT_V(4); PG8_BAR;
    PG8_STAGE_B(PG8_SB(1, 0), cB + kstep); PG8_STAGE_A(PG8_SA(1, 0), cA + kstep, coffA, 0); PG8_STAGE_B(PG8_SB(1, 1), cB + hstepB + kstep);
    PG8_WAIT_V(6); PG8_BAR;
    for (;;) {
        const bool has_next = S.next(ui + 1, nxt);
        const char* nA = has_next ? nxt.A : cA; const char* nB = has_next ? nxt.B : cB;
        if (has_next) { PG8_OFFS(nxt, noffA); }
        else {
#pragma unroll
            for (int _h = 0; _h < 2; ++_h)
#pragma unroll
                for (int _i = 0; _i < 2; ++_i) noffA[_h][_i] = coffA[_h][_i]; }
        for (int t = 0; t < nt; t += 2) {
            const bool last = (t == nt - 2);
            const char* a1 = cA + (size_t)(t + 1) * kstep;
            const char* a2 = last ? nA : cA + (size_t)(t + 2) * kstep; const char* b2 = last ? nB : cB + (size_t)(t + 2) * kstep;
            const char* a3 = a2 + kstep; const char* b3 = b2 + kstep;
            unsigned o2[2][2];
#pragma unroll
            for (int _h = 0; _h < 2; ++_h)
#pragma unroll
                for (int _i = 0; _i < 2; ++_i) o2[_h][_i] = last ? noffA[_h][_i] : coffA[_h][_i];
            PG8_LDB(B0, 0, 0); PG8_SCHED; PG8_LDA(At, 0, 0); PG8_STAGE_A(PG8_SA(1, 1), a1, coffA, 1);
            PG8_WAIT_L(8); PG8_BAR; PG8_WAIT_L(0); PG8_MMA(0, 0, At, B0); PG8_BAR; PG8_SCHED;
            PG8_LDB(B1, 0, 1); PG8_STAGE_B(PG8_SB(0, 0), b2);
            PG8_BAR; PG8_WAIT_L(0); PG8_MMA(0, 1, At, B1); PG8_BAR;
            PG8_LDA(At, 0, 1); PG8_STAGE_A(PG8_SA(0, 0), a2, o2, 0);
            PG8_BAR; PG8_WAIT_L(0); PG8_MMA(1, 0, At, B0); PG8_BAR; PG8_SCHED;
            PG8_STAGE_B(PG8_SB(0, 1), b2 + hstepB);
            PG8_WAIT_V(6); PG8_BAR; PG8_MMA(1, 1, At, B1); PG8_BAR;
            PG8_LDB(B0, 1, 0); PG8_SCHED; PG8_LDA(At, 1, 0); PG8_STAGE_A(PG8_SA(0, 1), a2, o2, 1);
            PG8_WAIT_L(8); PG8_BAR; PG8_WAIT_L(0); PG8_MMA(0, 0, At, B0); PG8_BAR; PG8_SCHED;
            PG8_LDB(B1, 1, 1); PG8_STAGE_B(PG8_SB(1, 0), b3);
            PG8_BAR; PG8_WAIT_L(0); PG8_MMA(0, 1, At, B1); PG8_BAR;
            PG8_LDA(At, 1, 1); PG8_STAGE_A(PG8_SA(1, 0), a3, o2, 0);
            PG8_BAR; PG8_WAIT_L(0); PG8_MMA(1, 0, At, B0); PG8_BAR; PG8_SCHED;
            PG8_STAGE_B(PG8_SB(1, 1), b3 + hstepB);
            PG8_WAIT_V(6); PG8_BAR; PG8_MMA(1, 1, At, B1); PG8_BAR;
        }
        if constexpr (!Epi::AFTER_DRAIN) { E(acc, cur, wr, wc, fr, fq); }
        if (!has_next) break;
#pragma unroll
        for (int a = 0; a < 2; ++a)
#pragma unroll
            for (int b = 0; b < 2; ++b)
#pragma unroll
                for (int m = 0; m < 4; ++m)
#pragma unroll
                    for (int n = 0; n < 2; ++n) acc[a][b][m][n] = (f32x4){0.f, 0.f, 0.f, 0.f};
        cur = nxt; cA = nA; cB = nB; ++ui;
#pragma unroll
        for (int _h = 0; _h < 2; ++_h)
#pragma unroll
            for (int _i = 0; _i < 2; ++_i) coffA[_h][_i] = noffA[_h][_i];
    }
    PG8_WAIT_V(0);
    if (wr == 0) PG8_BAR;
    PG8_BAR;
    if constexpr (Epi::AFTER_DRAIN) { E.fused(acc, cur, wr, wc, fr, fq, lds, wid, lane); }
#undef PG8_SA
#undef PG8_SB
#undef PG8_STAGE_A
#undef PG8_STAGE_B
#undef PG8_OFFS
#undef PG8_LDA
#undef PG8_LDB
#undef PG8_MMA
#undef PG8_WAIT_V
#undef PG8_WAIT_L
#undef PG8_BAR
#undef PG8_SCHED
}

struct EpiBf16 {
    static constexpr bool PERM = true, AFTER_DRAIN = false;
    int ldc;
    __device__ __forceinline__ void operator()(const Acc& acc, const Unit& u, int wr, int wc, int fr, int fq) const {
        bf16* base = (bf16*)u.C + (size_t)(wr * 64 + fr) * ldc + wc * 32 + 8 * fq;
#pragma unroll
        for (int ai = 0; ai < 2; ++ai)
#pragma unroll
            for (int m = 0; m < 4; ++m) { bf16* rowp = base + (size_t)(ai * HALF + m * 16) * ldc;
#pragma unroll
                for (int bj = 0; bj < 2; ++bj) { const f32x4 v0 = acc[ai][bj][m][0], v1 = acc[ai][bj][m][1];
                    u32x4 w; w.x = pk2(v0[0], v0[1]); w.y = pk2(v0[2], v0[3]); w.z = pk2(v1[0], v1[1]); w.w = pk2(v1[2], v1[3]);
                    *(u32x4*)(rowp + bj * HALF) = w; } }
    }
};
struct EpiF32Res {
    static constexpr bool PERM = false, AFTER_DRAIN = false;
    int ldc; const float* resid; float* out;
    __device__ __forceinline__ void operator()(const Acc& acc, const Unit& u, int wr, int wc, int fr, int fq) const {
        const size_t o0 = (size_t)(u.row0 + wr * 64 + fr) * ldc + u.col0 + wc * 32 + 4 * fq;
#pragma unroll
        for (int ai = 0; ai < 2; ++ai)
#pragma unroll
            for (int m = 0; m < 4; ++m) { const size_t ro = o0 + (size_t)(ai * HALF + m * 16) * ldc;
#pragma unroll
                for (int bj = 0; bj < 2; ++bj)
#pragma unroll
                    for (int n = 0; n < 2; ++n) { const size_t o = ro + bj * HALF + n * 16; const f32x4 b = *(const f32x4*)(resid + o); *(f32x4*)(out + o) = acc[ai][bj][m][n] + b; } }
    }
};
struct EpiSwiGlu {
    static constexpr bool PERM = true, AFTER_DRAIN = false;
    int ldc;
    __device__ __forceinline__ void operator()(const Acc& acc, const Unit& u, int wr, int wc, int fr, int fq) const {
        bf16* base = (bf16*)u.C + (size_t)(wr * 64 + fr) * ldc + wc * 32 + 8 * fq;
#pragma unroll
        for (int ai = 0; ai < 2; ++ai)
#pragma unroll
            for (int m = 0; m < 4; ++m) { bf16* rowp = base + (size_t)(ai * HALF + m * 16) * ldc;
                float h[8];
#pragma unroll
                for (int n = 0; n < 2; ++n)
#pragma unroll
                    for (int e = 0; e < 4; ++e) { const float a = acc[ai][0][m][n][e], b = acc[ai][1][m][n][e]; h[n * 4 + e] = a / (1.f + __expf(-a)) * b; }
                u32x4 w; w.x = pk2(h[0], h[1]); w.y = pk2(h[2], h[3]); w.z = pk2(h[4], h[5]); w.w = pk2(h[6], h[7]);
                *(u32x4*)rowp = w; }
    }
};
struct EpiGate {
    static constexpr bool PERM = true, AFTER_DRAIN = false;
    int ldc; const float* egate; const int* cnt_lds_unused;
    __device__ __forceinline__ void operator()(const Acc& acc, const Unit& u, int wr, int wc, int fr, int fq) const {
        bf16* base = (bf16*)u.C + (size_t)(wr * 64 + fr) * ldc + wc * 32 + 8 * fq;
        const int e = u.aux >> 16, nvalid = u.aux & 0xffff;
        const float* gp = egate + (size_t)e * ECAP + u.row0;
#pragma unroll
        for (int ai = 0; ai < 2; ++ai)
#pragma unroll
            for (int m = 0; m < 4; ++m) { const int r = ai * HALF + wr * 64 + m * 16 + fr; const float gt = (r < nvalid) ? gp[r] : 0.f;
                bf16* rowp = base + (size_t)(ai * HALF + m * 16) * ldc;
#pragma unroll
                for (int bj = 0; bj < 2; ++bj) { const f32x4 v0 = acc[ai][bj][m][0] * gt, v1 = acc[ai][bj][m][1] * gt;
                    u32x4 w; w.x = pk2(v0[0], v0[1]); w.y = pk2(v0[2], v0[3]); w.z = pk2(v1[0], v1[1]); w.w = pk2(v1[2], v1[3]);
                    *(u32x4*)(rowp + bj * HALF) = w; } }
    }
};
struct EpiSoftmax {
    static constexpr bool PERM = true, AFTER_DRAIN = true;
    int ldc; float scale_log2e;
    __device__ __forceinline__ void operator()(const Acc&, const Unit&, int, int, int, int) const {}
    __device__ __forceinline__ void fused(const Acc& acc, const Unit& u, int wr, int wc, int fr, int fq, LAS unsigned char* lds, int wid, int lane) const {
        LAS float* RM = (LAS float*)lds;
        LAS float* RS = (LAS float*)(lds + 4096);
        float mx[2][4];
#pragma unroll
        for (int ai = 0; ai < 2; ++ai)
#pragma unroll
            for (int m = 0; m < 4; ++m) { float v = -3.0e38f;
#pragma unroll
                for (int bj = 0; bj < 2; ++bj)
#pragma unroll
                    for (int n = 0; n < 2; ++n) { const f32x4 x = acc[ai][bj][m][n]; v = fmaxf(v, fmaxf(fmaxf(x[0], x[1]), fmaxf(x[2], x[3]))); }
                v = fmaxf(v, __shfl_xor(v, 16)); v = fmaxf(v, __shfl_xor(v, 32));
                if (fq == 0) RM[(ai * HALF + wr * 64 + m * 16 + fr) * 4 + wc] = v; }
        asm volatile("s_waitcnt lgkmcnt(0)" ::: "memory"); __builtin_amdgcn_s_barrier(); asm volatile("" ::: "memory");
#pragma unroll
        for (int ai = 0; ai < 2; ++ai)
#pragma unroll
            for (int m = 0; m < 4; ++m) { const int row = ai * HALF + wr * 64 + m * 16 + fr; const f32x4 q = *(const LAS f32x4*)(RM + row * 4);
                const float M = fmaxf(fmaxf(q[0], q[1]), fmaxf(q[2], q[3])); const float mc = -M * scale_log2e; float s = 0.f;
#pragma unroll
                for (int bj = 0; bj < 2; ++bj)
#pragma unroll
                    for (int n = 0; n < 2; ++n)
#pragma unroll
                        for (int e = 0; e < 4; ++e) s += __builtin_amdgcn_exp2f(fmaf(acc[ai][bj][m][n][e], scale_log2e, mc));
                s += __shfl_xor(s, 16); s += __shfl_xor(s, 32);
                if (fq == 0) RS[row * 4 + wc] = s; }
        asm volatile("s_waitcnt lgkmcnt(0)" ::: "memory"); __builtin_amdgcn_s_barrier(); asm volatile("" ::: "memory");
        bf16* base = (bf16*)u.C + (size_t)(wr * 64 + fr) * ldc + wc * 32 + 8 * fq;
#pragma unroll
        for (int ai = 0; ai < 2; ++ai)
#pragma unroll
            for (int m = 0; m < 4; ++m) { const int row = ai * HALF + wr * 64 + m * 16 + fr; const f32x4 q = *(const LAS f32x4*)(RS + row * 4); const f32x4 qm = *(const LAS f32x4*)(RM + row * 4);
                const float M = fmaxf(fmaxf(qm[0], qm[1]), fmaxf(qm[2], qm[3])); const float mc = -M * scale_log2e;
                const float inv = 1.f / ((q[0] + q[1]) + (q[2] + q[3])); bf16* rowp = base + (size_t)(ai * HALF + m * 16) * ldc;
#pragma unroll
                for (int bj = 0; bj < 2; ++bj) { float pp[8];
#pragma unroll
                    for (int n = 0; n < 2; ++n)
#pragma unroll
                        for (int e = 0; e < 4; ++e) pp[n * 4 + e] = __builtin_amdgcn_exp2f(fmaf(acc[ai][bj][m][n][e], scale_log2e, mc)) * inv;
                    u32x4 w; w.x = pk2(pp[0], pp[1]); w.y = pk2(pp[2], pp[3]); w.z = pk2(pp[4], pp[5]); w.w = pk2(pp[6], pp[7]);
                    *(u32x4*)(rowp + bj * HALF) = w; } }
        asm volatile("s_waitcnt lgkmcnt(0)" ::: "memory"); __builtin_amdgcn_s_barrier(); asm volatile("" ::: "memory");
    }
};
}

namespace att {
constexpr int KVBLK = 64;
constexpr size_t SHM_V = KVBLK * 128 * 2, SHM_K = KVBLK * 128 * 2;
#define KSWZ(row, colB) ((row) * 256 + ((colB) ^ (((row) & 7) << 4)))
#define SBAR() __builtin_amdgcn_sched_barrier(0)
__device__ __forceinline__ int crow(int r, int hi) { return (r & 3) + 8 * (r >> 2) + 4 * hi; }
__device__ __forceinline__ bf16x8 ld8(const bf16* p) { return *reinterpret_cast<const bf16x8*>(p); }

__device__ __forceinline__ void partialSM(f32x16& p0, f32x16& p1, float& m_reg, float& mn, float& alpha, const float SCALE, const float THR) {
  const float C = SCALE * 1.4426950408889634f;
  float pmax = p0[0];
#pragma unroll
  for (int r = 1; r < 16; ++r) pmax = fmaxf(pmax, p0[r]);
#pragma unroll
  for (int r = 0; r < 16; ++r) pmax = fmaxf(pmax, p1[r]);
  { auto rr = __builtin_amdgcn_permlane32_swap(__float_as_uint(pmax), __float_as_uint(pmax), false, false);
    pmax = fmaxf(__uint_as_float(rr[0]), __uint_as_float(rr[1])); }
  if (__builtin_expect(__all(pmax - m_reg <= THR / SCALE), 1)) { mn = m_reg; alpha = 1.f; }
  else { mn = fmaxf(m_reg, pmax); alpha = __builtin_amdgcn_exp2f((m_reg - mn) * C); m_reg = mn; }
  const float mnC = -mn * C;
#pragma unroll
  for (int r = 0; r < 16; ++r) p0[r] = fmaf(p0[r], C, mnC);
#pragma unroll
  for (int r = 0; r < 16; ++r) p1[r] = fmaf(p1[r], C, mnC);
#pragma unroll
  for (int r = 0; r < 16; ++r) p0[r] = __builtin_amdgcn_exp2f(p0[r]);
}
__device__ __forceinline__ void finishSM(f32x16& p0, f32x16& p1, float alpha, float& l_reg, bf16x8& pa0, bf16x8& pa1, bf16x8& pa2, bf16x8& pa3) {
#pragma unroll
  for (int r = 0; r < 16; ++r) p1[r] = __builtin_amdgcn_exp2f(p1[r]);
  float ps = 0;
#pragma unroll
  for (int r = 0; r < 16; ++r) ps += p0[r];
#pragma unroll
  for (int r = 0; r < 16; ++r) ps += p1[r];
  { auto rr = __builtin_amdgcn_permlane32_swap(__float_as_uint(ps), __float_as_uint(ps), false, false);
    ps = __uint_as_float(rr[0]) + __uint_as_float(rr[1]); }
  l_reg = l_reg * alpha + ps;
#define PK4(P, BASE, OUT) do { unsigned a0 = pk2(P[BASE + 0], P[BASE + 1]), a1 = pk2(P[BASE + 2], P[BASE + 3]);   \
    unsigned b0 = pk2(P[BASE + 4], P[BASE + 5]), b1 = pk2(P[BASE + 6], P[BASE + 7]);                              \
    auto r0 = __builtin_amdgcn_permlane32_swap(a0, b0, false, false); auto r1 = __builtin_amdgcn_permlane32_swap(a1, b1, false, false); \
    u32x4 w = {r0[0], r1[0], r0[1], r1[1]}; OUT = *reinterpret_cast<bf16x8*>(&w); } while (0)
  PK4(p0, 0, pa0); PK4(p0, 8, pa1); PK4(p1, 0, pa2); PK4(p1, 8, pa3);
#undef PK4
}
template <int ND0> __device__ __forceinline__ void qkt(f32x16& p0, f32x16& p1, const char* Ks, const bf16x8* qr, int r32, int hi, int c0) {
  p0 = f32x16{}; p1 = f32x16{};
#pragma unroll
  for (int d0 = 0; d0 < ND0; ++d0) { const int cb = (c0 + d0 * 16 + hi * 8) * 2;
    const bf16x8 b0 = *reinterpret_cast<const bf16x8*>(Ks + KSWZ(r32, cb));
    const bf16x8 b1 = *reinterpret_cast<const bf16x8*>(Ks + KSWZ(32 + r32, cb));
    p0 = __builtin_amdgcn_mfma_f32_32x32x16_bf16(b0, qr[d0], p0, 0, 0, 0);
    p1 = __builtin_amdgcn_mfma_f32_32x32x16_bf16(b1, qr[d0], p1, 0, 0, 0); }
}
__device__ __forceinline__ int v_st(int k, int c) { const int kk = (k & ~0xC) | ((k & 4) << 1) | ((k & 8) >> 1); return ((kk >> 3) * 4 + (c >> 5)) * 512 + ((kk & 7) * 32 + (c & 31)) * 2; }
__device__ __forceinline__ int v_rd_base(int lane) { return ((lane & 3) << 3) | (((lane >> 2) & 3) << 6) | (((lane >> 4) & 1) << 5) | (((lane >> 5) & 1) << 8); }
constexpr int v_rd_off(int d0, int ks, int half) { return d0 * 512 + ks * 4096 + half * 2048; }
template <int OFF> __device__ __forceinline__ s16x4 tr_read(int vb) {
  s16x4 r; asm volatile("ds_read_b64_tr_b16 %0, %1 offset:%2" : "=&v"(r) : "v"(vb), "i"(OFF) : "memory"); return r;
}
template <int D0> __device__ __forceinline__ void pv_one(f32x16& od, int vb, bf16x8 pa0, bf16x8 pa1, bf16x8 pa2, bf16x8 pa3) {
  const s16x4 l0 = tr_read<v_rd_off(D0, 0, 0)>(vb), h0 = tr_read<v_rd_off(D0, 0, 1)>(vb), l1 = tr_read<v_rd_off(D0, 1, 0)>(vb), h1 = tr_read<v_rd_off(D0, 1, 1)>(vb);
  const s16x4 l2 = tr_read<v_rd_off(D0, 2, 0)>(vb), h2 = tr_read<v_rd_off(D0, 2, 1)>(vb), l3 = tr_read<v_rd_off(D0, 3, 0)>(vb), h3 = tr_read<v_rd_off(D0, 3, 1)>(vb);
  asm volatile("s_waitcnt lgkmcnt(0)" ::: "memory"); SBAR();
#define PK(L, H) (bf16x8){L[0], L[1], L[2], L[3], H[0], H[1], H[2], H[3]}
  od = __builtin_amdgcn_mfma_f32_32x32x16_bf16(pa0, PK(l0, h0), od, 0, 0, 0);
  od = __builtin_amdgcn_mfma_f32_32x32x16_bf16(pa1, PK(l1, h1), od, 0, 0, 0);
  od = __builtin_amdgcn_mfma_f32_32x32x16_bf16(pa2, PK(l2, h2), od, 0, 0, 0);
  od = __builtin_amdgcn_mfma_f32_32x32x16_bf16(pa3, PK(l3, h3), od, 0, 0, 0);
#undef PK
}
__device__ __forceinline__ void pv_d0(f32x16* o, int vb, bf16x8 pa0, bf16x8 pa1, bf16x8 pa2, bf16x8 pa3) {
  pv_one<0>(o[0], vb, pa0, pa1, pa2, pa3); pv_one<1>(o[1], vb, pa0, pa1, pa2, pa3); pv_one<2>(o[2], vb, pa0, pa1, pa2, pa3); pv_one<3>(o[3], vb, pa0, pa1, pa2, pa3);
}

__device__ __forceinline__ void diff_attn_unit(const bf16* Qb, const bf16* Kh, const bf16* Vh, int ld, int seq, bf16* outb, int ldo,
                                               const float lam, const float post_scale, const float* subln_g, char* lds, const int wave_id) {
  constexpr float SCALE = 0.125f, THR = 8.f;
  const int tid = tid_from_wave(wave_id), wid = __builtin_amdgcn_readfirstlane(tid >> 6), lane = tid & 63, r32 = lane & 31, hi = lane >> 5;
  const int csel = wid >> 2, wq = wid & 3;
  char* V_lds = lds; char* K_lds = lds + 2 * SHM_V;
  float* ws = (float*)(lds + 2 * SHM_V + 2 * SHM_K) + wid * 64; float* li_l = ws; float* al_l = ws + 32;
  float m_reg = -1e30f, l_reg = 0; f32x16 o[4] = {}; bf16x8 qr[4];
  const bf16* Qw = Qb + (long)(wq * 32 + r32) * ld + csel * 64 + hi * 8;
#pragma unroll
  for (int d0 = 0; d0 < 4; ++d0) qr[d0] = ld8(Qw + d0 * 16);
  const int sr = tid >> 4, sc = (tid & 15) * 8, vst0 = v_st(sr, sc), vst1 = v_st(32 + sr, sc);
  const int vb0 = (int)(uintptr_t)V_lds + v_rd_base(lane);
  const int kc0 = csel * 64;
  struct { bf16x8 vs0, vs1, ks0, ks1; } sr_[2];
#define SLOAD(i, k0) do { sr_[i].vs0 = ld8(&Vh[(long)((k0) + sr) * ld + sc]); sr_[i].vs1 = ld8(&Vh[(long)((k0) + 32 + sr) * ld + sc]); \
    sr_[i].ks0 = ld8(&Kh[(long)((k0) + sr) * ld + sc]); sr_[i].ks1 = ld8(&Kh[(long)((k0) + 32 + sr) * ld + sc]); } while (0)
#define SWRITE(b, i) do { *(bf16x8*)(V_lds + (b) * SHM_V + vst0) = sr_[i].vs0;          \
    *(bf16x8*)(V_lds + (b) * SHM_V + vst1) = sr_[i].vs1; const int kc = sc * 2;               \
    *(bf16x8*)(K_lds + (b) * SHM_K + KSWZ(sr, kc)) = sr_[i].ks0;                       \
    *(bf16x8*)(K_lds + (b) * SHM_K + KSWZ(32 + sr, kc)) = sr_[i].ks1; } while (0)
#define SWAIT() asm volatile("s_waitcnt vmcnt(4)" ::: "memory")
#define RESC(a) do { if (__any((a) < 1.f)) { if (hi == 0) al_l[r32] = (a); asm volatile("s_waitcnt lgkmcnt(0)" ::: "memory"); \
    _Pragma("unroll") for (int d = 0; d < 4; ++d) _Pragma("unroll") for (int r = 0; r < 16; ++r) o[d][r] *= al_l[crow(r, hi)]; } } while (0)
  f32x16 pA0, pA1, pB0, pB1; float mnA, mnB, alA, alB; bf16x8 pa0, pa1, pa2, pa3; const int NT = seq / KVBLK;
  constexpr int SE = 0, SO = 1;
  __syncthreads();
  SLOAD(SE, 0); asm volatile("s_waitcnt vmcnt(0)" ::: "memory"); SWRITE(0, SE); __syncthreads();
  qkt<4>(pA0, pA1, K_lds, qr, r32, hi, kc0); partialSM(pA0, pA1, m_reg, mnA, alA, SCALE, THR);
  SLOAD(SO, KVBLK); if (2 < NT) SLOAD(SE, 2 * KVBLK);
  SWAIT(); SWRITE(1, SO); __syncthreads();
  for (int j = 1; j + 1 < NT; j += 2) {
    SBAR(); qkt<4>(pB0, pB1, K_lds + SHM_K, qr, r32, hi, kc0);
    finishSM(pA0, pA1, alA, l_reg, pa0, pa1, pa2, pa3); SBAR();
    SLOAD(SO, (j + 2) * KVBLK); SBAR();
    pv_d0(o, vb0, pa0, pa1, pa2, pa3); partialSM(pB0, pB1, m_reg, mnB, alB, SCALE, THR);
    __syncthreads(); SWAIT(); SWRITE(0, SE);
    RESC(alB); __syncthreads();
    SBAR(); qkt<4>(pA0, pA1, K_lds, qr, r32, hi, kc0);
    finishSM(pB0, pB1, alB, l_reg, pa0, pa1, pa2, pa3); SBAR();
    if (j + 3 < NT) SLOAD(SE, (j + 3) * KVBLK); SBAR();
    pv_d0(o, vb0 + (int)SHM_V, pa0, pa1, pa2, pa3); partialSM(pA0, pA1, m_reg, mnA, alA, SCALE, THR);
    __syncthreads(); SWAIT(); SWRITE(1, SO);
    RESC(alA); __syncthreads();
  }
  SBAR(); qkt<4>(pB0, pB1, K_lds + SHM_K, qr, r32, hi, kc0);
  finishSM(pA0, pA1, alA, l_reg, pa0, pa1, pa2, pa3); SBAR();
  pv_d0(o, vb0, pa0, pa1, pa2, pa3); partialSM(pB0, pB1, m_reg, mnB, alB, SCALE, THR);
  __syncthreads(); RESC(alB);
  finishSM(pB0, pB1, alB, l_reg, pa0, pa1, pa2, pa3); SBAR();
  pv_d0(o, vb0 + (int)SHM_V, pa0, pa1, pa2, pa3);
  asm volatile("s_waitcnt vmcnt(0)" ::: "memory");
  if (hi == 0) li_l[r32] = l_reg; asm volatile("s_waitcnt lgkmcnt(0)" ::: "memory");
  float rli[16];
#pragma unroll
  for (int r = 0; r < 16; ++r) rli[r] = __builtin_amdgcn_rcpf(li_l[crow(r, hi)]);
  __syncthreads();
  float* X = (float*)lds + (size_t)wq * 4096;
  if (csel == 1) {
#pragma unroll
    for (int d0 = 0; d0 < 4; ++d0)
#pragma unroll
      for (int r = 0; r < 16; ++r) X[(d0 * 16 + r) * 64 + lane] = o[d0][r] * rli[r];
  }
  __syncthreads();
  if (csel == 0) {
    float ss[16];
#pragma unroll
    for (int r = 0; r < 16; ++r) ss[r] = 0.f;
#pragma unroll
    for (int d0 = 0; d0 < 4; ++d0)
#pragma unroll
      for (int r = 0; r < 16; ++r) { const float v = o[d0][r] * rli[r] - lam * X[(d0 * 16 + r) * 64 + lane]; o[d0][r] = v; ss[r] += v * v; }
#pragma unroll
    for (int r = 0; r < 16; ++r) { float s = ss[r];
      s += __shfl_xor(s, 1); s += __shfl_xor(s, 2); s += __shfl_xor(s, 4); s += __shfl_xor(s, 8); s += __shfl_xor(s, 16);
      ss[r] = __builtin_amdgcn_rsqf(s * (1.f / 128.f) + RMS_EPS) * post_scale; }
    float gg[4];
#pragma unroll
    for (int d0 = 0; d0 < 4; ++d0) gg[d0] = subln_g[d0 * 32 + r32];
    bf16* Ow = outb + (long)(wq * 32) * ldo;
#pragma unroll
    for (int r = 0; r < 16; ++r) { const int orow = crow(r, hi);
#pragma unroll
      for (int d0 = 0; d0 < 4; ++d0) Ow[(long)orow * ldo + d0 * 32 + r32] = f2bf(o[d0][r] * ss[r] * gg[d0]); }
  }
#undef SLOAD
#undef SWRITE
#undef SWAIT
}

__device__ __forceinline__ void dil_attn_unit(const bf16* Qh, const bf16* Kh, const bf16* Vh, int ld, int dil, int rho, int u0, int L,
                                              float* Oc, float* lsep, char* lds, const int wave_id) {
  constexpr float SCALE = 0.08838834764831845f; constexpr float C = SCALE * 1.4426950408889634f;
  const int tid = tid_from_wave(wave_id), wid = __builtin_amdgcn_readfirstlane(tid >> 6), lane = tid & 63, r32 = lane & 31, hi = lane >> 5;
  char* V_lds = lds; char* K_lds = lds + 2 * SHM_V;
  float* ws = (float*)(lds + 2 * SHM_V + 2 * SHM_K) + wid * 64; float* li_l = ws; float* al_l = ws + 32;
  float m_reg = -1e30f, l_reg = 0; f32x16 o[4] = {}; bf16x8 qr[8];
  const int uq = u0 + wid * 32 + r32;
  const bf16* Qw = Qh + (long)(rho + dil * uq) * ld + hi * 8;
#pragma unroll
  for (int d0 = 0; d0 < 8; ++d0) qr[d0] = ld8(Qw + d0 * 16);
  const int sr = tid >> 4, sc = (tid & 15) * 8, vst0 = v_st(sr, sc), vst1 = v_st(32 + sr, sc);
  const int vb0 = (int)(uintptr_t)V_lds + v_rd_base(lane);
  const int tlo = wid >> 1;
  for (int t = 0; t < 6; ++t) {
    const int kt0 = u0 - 64 + 64 * t;
    __syncthreads();
    { int ua = kt0 + sr, ub = kt0 + 32 + sr; ua = ua < 0 ? 0 : (ua >= L ? L - 1 : ua); ub = ub < 0 ? 0 : (ub >= L ? L - 1 : ub);
      const long ra = (long)(rho + dil * ua) * ld + sc, rb = (long)(rho + dil * ub) * ld + sc;
      const bf16x8 va = ld8(Vh + ra), vb = ld8(Vh + rb), ka = ld8(Kh + ra), kb = ld8(Kh + rb);
      *(bf16x8*)(V_lds + vst0) = va; *(bf16x8*)(V_lds + vst1) = vb; const int kc = sc * 2;
      *(bf16x8*)(K_lds + KSWZ(sr, kc)) = ka; *(bf16x8*)(K_lds + KSWZ(32 + sr, kc)) = kb; }
    __syncthreads();
    if (t >= tlo && t <= tlo + 2) {
      f32x16 p0, p1;
      qkt<8>(p0, p1, K_lds, qr, r32, hi, 0);
#pragma unroll
      for (int r = 0; r < 16; ++r) { const int uk0 = kt0 + crow(r, hi), uk1 = uk0 + 32; const int d0 = uk0 - uq, d1 = uk1 - uq;
        const bool ok0 = (uk0 >= 0) && (uk0 < L) && (d0 >= -64) && (d0 <= 64), ok1 = (uk1 >= 0) && (uk1 < L) && (d1 >= -64) && (d1 <= 64);
        p0[r] = ok0 ? p0[r] : -1e30f; p1[r] = ok1 ? p1[r] : -1e30f; }
      float pmax = p0[0];
#pragma unroll
      for (int r = 1; r < 16; ++r) pmax = fmaxf(pmax, p0[r]);
#pragma unroll
      for (int r = 0; r < 16; ++r) pmax = fmaxf(pmax, p1[r]);
      { auto rr = __builtin_amdgcn_permlane32_swap(__float_as_uint(pmax), __float_as_uint(pmax), false, false);
        pmax = fmaxf(__uint_as_float(rr[0]), __uint_as_float(rr[1])); }
      const float mn = fmaxf(m_reg, pmax); const float alpha = __builtin_amdgcn_exp2f((m_reg - mn) * C); m_reg = mn;
      const float mnC = -mn * C;
#pragma unroll
      for (int r = 0; r < 16; ++r) { p0[r] = __builtin_amdgcn_exp2f(fmaf(p0[r], C, mnC)); p1[r] = fmaf(p1[r], C, mnC); }
      bf16x8 pa0, pa1, pa2, pa3;
      finishSM(p0, p1, alpha, l_reg, pa0, pa1, pa2, pa3);
      RESC(alpha);
      pv_d0(o, vb0, pa0, pa1, pa2, pa3);
    }
  }
  if (hi == 0) li_l[r32] = l_reg; asm volatile("s_waitcnt lgkmcnt(0)" ::: "memory");
  float rli[16];
#pragma unroll
  for (int r = 0; r < 16; ++r) rli[r] = __builtin_amdgcn_rcpf(li_l[crow(r, hi)]);
#pragma unroll
  for (int r = 0; r < 16; ++r) { const int uo = u0 + wid * 32 + crow(r, hi); float* orow = Oc + (long)(rho + dil * uo) * 512;
#pragma unroll
    for (int d0 = 0; d0 < 4; ++d0) orow[d0 * 32 + r32] = o[d0][r] * rli[r]; }
  if (hi == 0) lsep[(long)(rho + dil * uq) * 4] = m_reg * SCALE + __logf(l_reg);
}
#undef RESC
#undef KSWZ
#undef SBAR
}

struct Args { const float* in[N_INPUTS]; float* out; unsigned char* ws; int ph_lo, ph_hi; };
typedef const __attribute__((address_space(4))) Args* ArgsP;
struct Frame {
    LAS unsigned char* lds; volatile LAS unsigned* MISC; unsigned* ctl; unsigned char* ws;
    int tid, lane, wave, G, bid;
};
constexpr int PH_P0 = 0, PH_P1 = 1, PH_P2 = 2, PH_L0 = 3, NPH_L = 13, PH_FINAL = PH_L0 + DEPTH * NPH_L, NPHASES = PH_FINAL + 1;
enum { LP_NORM1 = 0, LP_G1, LP_PREP, LP_CPREP, LP_MIX, LP_POST, LP_G2, LP_NORM2, LP_GS, LP_GO, LP_NORM3, LP_M1, LP_M2 };

__device__ __forceinline__ int q_next(Frame& F, int q) {
    __syncthreads();
    if (F.tid == 0) F.MISC[0] = __hip_atomic_fetch_add(F.ctl + CW_Q + 64 * q, 1u, __ATOMIC_RELAXED, __HIP_MEMORY_SCOPE_AGENT);
    __syncthreads();
    return (int)F.MISC[0];
}

template <class RowMap>
__device__ __forceinline__ void transpose_item(const float* W, int ldn, bf16* WT, int ldt, RowMap rm, LAS float* scr, int k0, int n0, int lane) {
#pragma unroll 8
    for (int i = 0; i < 32; ++i) { const int kk = 2 * i + (lane >> 5); scr[kk * 33 + (lane & 31)] = W[(size_t)(k0 + kk) * ldn + n0 + (lane & 31)]; }
    LDS_WAIT(); asm volatile("" ::: "memory");
    const int c = lane & 7;
#pragma unroll
    for (int j = 0; j < 4; ++j) { const int n = (lane >> 3) + 8 * j; const LAS float* s = scr + (8 * c) * 33 + n;
        u32x4 o; o.x = pk2(s[0 * 33], s[1 * 33]); o.y = pk2(s[2 * 33], s[3 * 33]); o.z = pk2(s[4 * 33], s[5 * 33]); o.w = pk2(s[6 * 33], s[7 * 33]);
        *(u32x4*)(WT + (size_t)rm(n0 + n) * ldt + k0 + 8 * c) = o; }
    LDS_WAIT(); asm volatile("" ::: "memory");
}
struct RmId { __device__ __forceinline__ int operator()(int n) const { return n; } };
struct RmW13 { int off; __device__ __forceinline__ int operator()(int n) const { return 256 * (n >> 7) + off + (n & 127); } };

__device__ __forceinline__ void p0_prologue(Frame& F, ArgsP a) {
    unsigned char* ws = F.ws;
    LAS float* scr = (LAS float*)(F.lds + F.wave * 16384);
    const int gw = F.bid * 8 + F.wave, NGW = F.G * 8;
    constexpr int I_WIN = (DM / 64) * (IN_TOTAL / 32), I_SQ = (DM / 64) * (DM / 32), I_WKV = (DM / 64) * (4096 / 32), I_W1 = (DM / 64) * (DEXP / 32), I_W2 = (DEXP / 64) * (DM / 32);
    constexpr int PER_L = I_WIN + I_SQ + I_WKV + I_SQ + NEXP * (2 * I_W1 + I_W2);
    for (int it = gw; it < DEPTH * PER_L; it += NGW) {
        const int l = it / PER_L; int r = it % PER_L;
        if (r < I_WIN) { const int nb = IN_TOTAL / 32; transpose_item(a->in[I_W_IN] + (size_t)l * DM * IN_TOTAL, IN_TOTAL, (bf16*)(ws + WS_WIN) + (size_t)l * ZLD * DM, DM, RmId{}, scr, 64 * (r / nb), 32 * (r % nb), F.lane); continue; } r -= I_WIN;
        if (r < I_SQ) { const int nb = DM / 32; transpose_item(a->in[I_W_OUT] + (size_t)l * DM * DM, DM, (bf16*)(ws + WS_WOUT) + (size_t)l * DM * DM, DM, RmId{}, scr, 64 * (r / nb), 32 * (r % nb), F.lane); continue; } r -= I_SQ;
        if (r < I_WKV) { const int nb = 4096 / 32; transpose_item(a->in[I_XA_WKV] + (size_t)l * DM * 4096, 4096, (bf16*)(ws + SC_WKVT) + (size_t)l * 4096 * DM, DM, RmId{}, scr, 64 * (r / nb), 32 * (r % nb), F.lane); continue; } r -= I_WKV;
        if (r < I_SQ) { const int nb = DM / 32; transpose_item(a->in[I_XA_WO] + (size_t)l * DM * DM, DM, (bf16*)(ws + SC_WOT) + (size_t)l * DM * DM, DM, RmId{}, scr, 64 * (r / nb), 32 * (r % nb), F.lane); continue; } r -= I_SQ;
        const int e = r / (2 * I_W1 + I_W2); r = r % (2 * I_W1 + I_W2);
        const size_t le = (size_t)l * NEXP + e;
        if (r < I_W1) { const int nb = DEXP / 32; transpose_item(a->in[I_MOE_W1] + le * DM * DEXP, DEXP, (bf16*)(ws + WS_W13) + le * 1024 * DM, DM, RmW13{0}, scr, 64 * (r / nb), 32 * (r % nb), F.lane); continue; } r -= I_W1;
        if (r < I_W1) { const int nb = DEXP / 32; transpose_item(a->in[I_MOE_W3] + le * DM * DEXP, DEXP, (bf16*)(ws + WS_W13) + le * 1024 * DM, DM, RmW13{128}, scr, 64 * (r / nb), 32 * (r % nb), F.lane); continue; } r -= I_W1;
        { const int nb = DM / 32; transpose_item(a->in[I_MOE_W2] + le * DEXP * DM, DM, (bf16*)(ws + WS_W2) + le * DM * DEXP, DEXP, RmId{}, scr, 64 * (r / nb), 32 * (r % nb), F.lane); }
    }
    const int gt = F.bid * 512 + F.tid, NGT = F.G * 512;
    for (int i = gt; i < DEPTH * (ZLD - IN_TOTAL) * DM / 8; i += NGT) { const int l = i / ((ZLD - IN_TOTAL) * DM / 8), r = i % ((ZLD - IN_TOTAL) * DM / 8);
        *(u32x4*)((bf16*)(ws + WS_WIN) + (size_t)l * ZLD * DM + (size_t)IN_TOTAL * DM + (size_t)r * 8) = (u32x4){0u, 0u, 0u, 0u}; }
    for (int i = gt; i < DEPTH * DM * DM / 8; i += NGT) { const f32x4 x0 = *(const f32x4*)(a->in[I_XA_WQ] + (size_t)i * 8), x1 = *(const f32x4*)(a->in[I_XA_WQ] + (size_t)i * 8 + 4);
        u32x4 o; o.x = pk2(x0[0], x0[1]); o.y = pk2(x0[2], x0[3]); o.z = pk2(x1[0], x1[1]); o.w = pk2(x1[2], x1[3]); *(u32x4*)((bf16*)(ws + SC_WQB) + (size_t)i * 8) = o; }
    { float* cosA = (float*)(ws + WS_ROPE); float* sinA = cosA + SEQ * 32; float* cosC = sinA + SEQ * 32; float* sinC = cosC + SEQ * 64;
      for (int i = gt; i < SEQ * 96; i += NGT) { const int s = i / 96, j = i % 96; const bool isA = j < 32; const int jj = isA ? j : j - 32; const float dim = isA ? 64.f : 128.f;
          const float inv = 1.0f / powf(10000.0f, (float)(2 * jj) / dim); const float ang = (float)s * inv; float sn, cs; sincosf(ang, &sn, &cs);
          if (isA) { cosA[s * 32 + jj] = cs; sinA[s * 32 + jj] = sn; } else { cosC[s * 64 + jj] = cs; sinC[s * 64 + jj] = sn; } } }
    for (int i = gt; i < DEPTH * 2 * 32 * 64; i += NGT) { const int l = i / (2 * 32 * 64), r = i % (2 * 32 * 64), dir = r / (32 * 64), g = (r / 64) % 32, n = r % 64;
        float* ab = (float*)(ws + WS_S5P + l * S5P_LAYER); float* bb = ab + 2 * 32 * 64 * 2;
        const size_t pi = (((size_t)l * 2 + dir) * 32 + g) * 64 + n;
        const float lr = fminf(a->in[I_S5_A_RE][pi], -1e-4f), li = a->in[I_S5_A_IM][pi], dt = __expf(a->in[I_S5_LOG_DT][((size_t)l * 2 + dir) * 32 + g]);
        const float mag = __expf(dt * lr); float sn, cs; sincosf(dt * li, &sn, &cs); const float abr = mag * cs, abi = mag * sn;
        const float den = lr * lr + li * li; const float ir = lr / den, ii = -li / den;
        const float fr_ = (abr - 1.f) * ir - abi * ii, fi_ = (abr - 1.f) * ii + abi * ir;
        ab[(size_t)r * 2] = abr; ab[(size_t)r * 2 + 1] = abi;
        const size_t bi = (((size_t)l * 32 + g) * 64 + n) * 16;
#pragma unroll
        for (int c = 0; c < 16; ++c) { const float br = a->in[I_S5_B_RE][bi + c], bim = a->in[I_S5_B_IM][bi + c];
            bb[((size_t)r * 16 + c) * 2] = fr_ * br - fi_ * bim; bb[((size_t)r * 16 + c) * 2 + 1] = fr_ * bim + fi_ * br; } }
    for (int it = gw; it < DEPTH * BATCH * NMEM; it += NGW) { const int l = it / (BATCH * NMEM), row = it % (BATCH * NMEM);
        const f32x4* xr = (const f32x4*)(a->in[I_MEM] + (size_t)row * DM) + F.lane; const f32x4* gr = (const f32x4*)(a->in[I_NORM_MEM] + (size_t)l * DM) + F.lane;
        f32x4 v[8]; float s = 0.f;
#pragma unroll
        for (int j = 0; j < 8; ++j) { v[j] = xr[64 * j]; s += (v[j].x * v[j].x + v[j].y * v[j].y) + (v[j].z * v[j].z + v[j].w * v[j].w); }
        const float rstd = 1.f / sqrtf(wave_sum(s) * (1.f / DM) + RMS_EPS);
        u32x2* o8 = (u32x2*)((bf16*)(ws + SC_MEMN) + ((size_t)l * 512 + row) * DM) + F.lane;
#pragma unroll
        for (int j = 0; j < 8; ++j) { const f32x4 gv = gr[64 * j]; u32x2 w; w.x = pk2(v[j].x * rstd * gv.x, v[j].y * rstd * gv.y); w.y = pk2(v[j].z * rstd * gv.z, v[j].w * rstd * gv.w); o8[64 * j] = w; } }
}

struct SchedDense { const char* A; const char* B; char* C; int nM, nN, G, c, lda, ldb, ldcb  , cesz  ;
    __device__ __forceinline__ bool next(int i, pg8::Unit& u) const { const long L = (long)i * G + c; if (L >= (long)nM * nN) return false; int pm, pn; pg8::xcd_tile((int)L, nM, nN, pm, pn);
        u.A = A + (size_t)pm * 256 * lda * 2; u.B = B + (size_t)pn * 256 * ldb * 2; u.C = C + (size_t)pm * 256 * ldcb + (size_t)pn * 256 * cesz; u.row0 = pm * 256; u.col0 = pn * 256; u.aux = 0; return true; }
    __device__ __forceinline__ int arow(const pg8::Unit&, int r) const { return r; } };
struct SchedBatch { const char* A; const char* B; char* C; size_t sA, sB, sC; int nM, nN, nb, G, c, lda, ldb, ldcb, cesz, rowsPerBatch;
    __device__ __forceinline__ bool next(int i, pg8::Unit& u) const { const long L = (long)i * G + c; const int per = nM * nN; if (L >= (long)per * nb) return false; const int b = (int)(L / per), r = (int)(L % per), pm = r / nN, pn = r % nN;
        u.A = A + b * sA + (size_t)pm * 256 * lda * 2; u.B = B + b * sB + (size_t)pn * 256 * ldb * 2; u.C = C + b * sC + (size_t)pm * 256 * ldcb + (size_t)pn * 256 * cesz; u.row0 = b * rowsPerBatch + pm * 256; u.col0 = pn * 256; u.aux = b; return true; }
    __device__ __forceinline__ int arow(const pg8::Unit&, int r) const { return r; } };
struct SchedXaPre { unsigned char* ws; int G, c, kind;
    __device__ __forceinline__ bool next(int i, pg8::Unit& u) const { const long L = (long)i * G + c; if (L >= 128) return false; const int r = (int)L, p = r >> 3, t = r & 7, l = p >> 3, b = (p >> 2) & 1, h = p & 3;
        const bf16* kvb = (const bf16*)(ws + SC_KVB) + (size_t)l * 512 * 4096 + (size_t)(b * 256) * 4096;
        if (kind == 0) { u.A = (const char*)(kvb + h * 512); u.B = (const char*)((const bf16*)(ws + SC_WQB) + (size_t)l * DM * DM + (size_t)(t * 256) * DM + h * 512);
            u.C = (char*)((bf16*)(ws + WS_WQK) + ((size_t)(l * 2 + b) * 1024 + h * 256) * DM + t * 256); u.aux = DM; }
        else { u.A = (const char*)((const bf16*)(ws + SC_WOT) + (size_t)l * DM * DM + (size_t)(t * 256) * DM + h * 512); u.B = (const char*)(kvb + 2048 + h * 512);
            u.C = (char*)((bf16*)(ws + WS_VWO) + ((size_t)(l * 2 + b) * DM + t * 256) * 1024 + h * 256); u.aux = 1024; }
        u.row0 = 0; u.col0 = 0; return true; }
    __device__ __forceinline__ int arow(const pg8::Unit&, int r) const { return r; } };
struct EpiBf16U { static constexpr bool PERM = true, AFTER_DRAIN = false;
    __device__ __forceinline__ void operator()(const pg8::Acc& acc, const pg8::Unit& u, int wr, int wc, int fr, int fq) const { pg8::EpiBf16 e{u.aux}; e(acc, u, wr, wc, fr, fq); } };
struct SchedMoe { unsigned char* ws; const volatile LAS int* tp; const volatile LAS int* cnt; int layer, G, c, which;
    __device__ __forceinline__ bool next(int i, pg8::Unit& u) const {
        const int npn = which == 0 ? 4 : 8; const long L = (long)i * G + c; const int ntile = tp[32]; if (L >= (long)ntile * npn) return false;
        const int mt = (int)(L / npn), pn = (int)(L % npn); int e = 0;
#pragma unroll 1
        for (int k = 1; k < 32; ++k) e += (mt >= tp[k]) ? 1 : 0;
        const int lt = mt - tp[e]; const int nvalid = min(256, cnt[e] - lt * 256);
        u.row0 = lt * 256; u.col0 = pn * 256; u.aux = (e << 16) | nvalid;
        if (which == 0) { u.A = (const char*)(ws + WS_HN); u.B = (const char*)((const bf16*)(ws + WS_W13) + ((size_t)(layer * NEXP + e) * 1024 + pn * 256) * DM);
            u.C = (char*)((bf16*)(ws + SC_HMID) + (size_t)(mt * 256) * DEXP + pn * 128); }
        else { u.A = (const char*)((const bf16*)(ws + SC_HMID) + (size_t)(mt * 256) * DEXP); u.B = (const char*)((const bf16*)(ws + WS_W2) + ((size_t)(layer * NEXP + e) * DM + pn * 256) * DEXP);
            u.C = (char*)((bf16*)(ws + SC_YBUF) + (size_t)(mt * 256) * DM + pn * 256); }
        return true; }
    __device__ __forceinline__ int arow(const pg8::Unit& u, int r) const { const int e = u.aux >> 16, nvalid = u.aux & 0xffff; const int idx = (r < nvalid) ? (u.row0 + r) : u.row0;
        return ((const int*)(ws + WS_ETOK))[(size_t)e * ECAP + idx]; } };

__device__ __forceinline__ void moe_prefix(Frame& F, int layer, volatile LAS int* tp, volatile LAS int* cnt) {
    __syncthreads();
    if (F.tid < 32) cnt[F.tid] = (int)__hip_atomic_load(F.ctl + CW_CNT + layer * 64 + F.tid, __ATOMIC_RELAXED, __HIP_MEMORY_SCOPE_AGENT);
    __syncthreads();
    if (F.tid == 0) { int s = 0; for (int e = 0; e < 32; ++e) { tp[e] = s; s += (cnt[e] + 255) >> 8; } tp[32] = s; }
    __syncthreads();
}
template <int MODE>
__device__ __forceinline__ void norm_phase(Frame& F, ArgsP a, const float* src, const float* gain, int layer) {
    unsigned char* ws = F.ws; float* H = (float*)(ws + WS_H); bf16* HN = (bf16*)(ws + WS_HN);
    volatile LAS int* tp = (volatile LAS int*)(F.lds + 1024); volatile LAS int* cnt = tp + 40;
    if (MODE & 1) moe_prefix(F, layer - 1, tp, cnt);
    const int gw = F.bid * 8 + F.wave, NGW = F.G * 8;
    const f32x4* gr = (const f32x4*)gain + F.lane;
    for (int row = gw; row < NTOK; row += NGW) {
        const f32x4* xr = (const f32x4*)(src + (size_t)row * DM) + F.lane;
        f32x4 v[8];
#pragma unroll
        for (int j = 0; j < 8; ++j) v[j] = xr[64 * j];
        if (MODE & 1) {
            const int* ti = (const int*)(ws + WS_TINFO) + (size_t)row * 4;
            const int e0 = ti[0], p0 = ti[1], e1 = ti[2], p1 = ti[3];
            const size_t s0 = (size_t)tp[e0] * 256 + p0, s1 = (size_t)tp[e1] * 256 + p1;
            const u32x2* y0 = (const u32x2*)((const bf16*)(ws + SC_YBUF) + s0 * DM) + F.lane; const u32x2* y1 = (const u32x2*)((const bf16*)(ws + SC_YBUF) + s1 * DM) + F.lane;
#pragma unroll
            for (int j = 0; j < 8; ++j) { const u32x2 a0 = y0[64 * j], a1 = y1[64 * j];
                v[j].x += __uint_as_float(a0.x << 16) + __uint_as_float(a1.x << 16); v[j].y += __uint_as_float(a0.x & 0xffff0000u) + __uint_as_float(a1.x & 0xffff0000u);
                v[j].z += __uint_as_float(a0.y << 16) + __uint_as_float(a1.y << 16); v[j].w += __uint_as_float(a0.y & 0xffff0000u) + __uint_as_float(a1.y & 0xffff0000u); }
            if (!(MODE & 4)) { f32x4* hr = (f32x4*)(H + (size_t)row * DM) + F.lane;
#pragma unroll
                for (int j = 0; j < 8; ++j) hr[64 * j] = v[j]; }
        }
        float s = 0.f;
#pragma unroll
        for (int j = 0; j < 8; ++j) s += (v[j].x * v[j].x + v[j].y * v[j].y) + (v[j].z * v[j].z + v[j].w * v[j].w);
        const float rstd = 1.f / sqrtf(wave_sum(s) * (1.f / DM) + RMS_EPS);
#pragma unroll
        for (int j = 0; j < 8; ++j) { const f32x4 gv = gr[64 * j]; v[j].x *= rstd * gv.x; v[j].y *= rstd * gv.y; v[j].z *= rstd * gv.z; v[j].w *= rstd * gv.w; }
        if (MODE & 4) { f32x4* orow = (f32x4*)(a->out + (size_t)row * DM) + F.lane;
#ifdef DBG_RWCHK
            { const float* cw = (const float*)(F.ctl + 32768); const unsigned* cu = (const unsigned*)cw; const float sc = cu[DBG_RWCHK * 64 + 2] ? 1001.f : 1.f + fminf(cw[DBG_RWCHK * 64] / cw[DBG_RWCHK * 64 + 1], 100.f);
#pragma unroll
              for (int j = 0; j < 8; ++j) v[j] *= sc; }
#endif
#pragma unroll
            for (int j = 0; j < 8; ++j) orow[64 * j] = v[j]; }
        else { u32x2* o8 = (u32x2*)(HN + (size_t)row * DM) + F.lane;
#pragma unroll
            for (int j = 0; j < 8; ++j) { u32x2 w; w.x = pk2(v[j].x, v[j].y); w.y = pk2(v[j].z, v[j].w); o8[64 * j] = w; } }
        if (MODE & 2) {
            const float* wg = a->in[I_ROUTER_GROUP] + (size_t)layer * DM * 4; const float* we = a->in[I_ROUTER_EXPERT] + (size_t)layer * DM * 32;
            float lg[4] = {0.f, 0.f, 0.f, 0.f};
#pragma unroll 2
            for (int j = 0; j < 8; ++j) { const int k0 = (64 * j + F.lane) * 4;
#pragma unroll
                for (int q = 0; q < 4; ++q) { const f32x4 w4 = *(const f32x4*)(wg + (size_t)(k0 + q) * 4); const float x = v[j][q]; lg[0] += x * w4.x; lg[1] += x * w4.y; lg[2] += x * w4.z; lg[3] += x * w4.w; } }
#pragma unroll
            for (int q = 0; q < 4; ++q) lg[q] = wave_sum(lg[q]);
            int gi = 0; float gm = lg[0];
#pragma unroll
            for (int q = 1; q < 4; ++q) if (lg[q] > gm) { gm = lg[q]; gi = q; }
            const float gw_ = 1.f / (__expf(lg[0] - gm) + __expf(lg[1] - gm) + __expf(lg[2] - gm) + __expf(lg[3] - gm));
            float le[8] = {0.f, 0.f, 0.f, 0.f, 0.f, 0.f, 0.f, 0.f};
#pragma unroll 2
            for (int j = 0; j < 8; ++j) { const int k0 = (64 * j + F.lane) * 4;
#pragma unroll
                for (int q = 0; q < 4; ++q) { const float* wp = we + (size_t)(k0 + q) * 32 + gi * 8; const f32x4 wa = *(const f32x4*)wp, wb = *(const f32x4*)(wp + 4); const float x = v[j][q];
                    le[0] += x * wa.x; le[1] += x * wa.y; le[2] += x * wa.z; le[3] += x * wa.w; le[4] += x * wb.x; le[5] += x * wb.y; le[6] += x * wb.z; le[7] += x * wb.w; } }
#pragma unroll
            for (int q = 0; q < 8; ++q) le[q] = wave_sum(le[q]);
            int i0 = 0; float m0 = le[0];
#pragma unroll
            for (int q = 1; q < 8; ++q) if (le[q] > m0) { m0 = le[q]; i0 = q; }
            int i1 = -1; float m1 = -3.0e38f;
#pragma unroll
            for (int q = 0; q < 8; ++q) if (q != i0 && le[q] > m1) { m1 = le[q]; i1 = q; }
            const float t = __expf(m1 - m0); const float w0 = 1.f / (1.f + t), w1 = t / (1.f + t);
            if (F.lane == 0) {
                const int e0 = gi * 8 + i0, e1 = gi * 8 + i1;
                const int p0 = (int)__hip_atomic_fetch_add(F.ctl + CW_CNT + layer * 64 + e0, 1u, __ATOMIC_RELAXED, __HIP_MEMORY_SCOPE_AGENT);
                const int p1 = (int)__hip_atomic_fetch_add(F.ctl + CW_CNT + layer * 64 + e1, 1u, __ATOMIC_RELAXED, __HIP_MEMORY_SCOPE_AGENT);
                int* et = (int*)(ws + WS_ETOK); float* eg = (float*)(ws + WS_EGATE); int* ti = (int*)(ws + WS_TINFO) + (size_t)row * 4;
                et[(size_t)e0 * ECAP + p0] = row; eg[(size_t)e0 * ECAP + p0] = gw_ * w0; et[(size_t)e1 * ECAP + p1] = row; eg[(size_t)e1 * ECAP + p1] = gw_ * w1;
                ti[0] = e0; ti[1] = p0; ti[2] = e1; ti[3] = p1;
            }
        }
    }
}

__device__ __forceinline__ void rope_token(Frame& F, bf16* zrow, int s) {
    const float* cosA = (const float*)(F.ws + WS_ROPE); const float* sinA = cosA + SEQ * 32; const float* cosC = sinA + SEQ * 32; const float* sinC = cosC + SEQ * 64;
    { const int i = F.lane & 31; const float cs = cosA[s * 32 + i], sn = sinA[s * 32 + i];
#pragma unroll
      for (int it = 0; it < 8; ++it) { bf16* p = zrow + ZA + (it * 2 + (F.lane >> 5)) * 64; const float x1 = bf2f(p[i]), x2 = bf2f(p[i + 32]); p[i] = f2bf(x1 * cs - x2 * sn); p[i + 32] = f2bf(x2 * cs + x1 * sn); } }
    { const int i = F.lane; const float cs = cosC[s * 64 + i], sn = sinC[s * 64 + i];
#pragma unroll
      for (int it = 0; it < 8; ++it) { bf16* p = zrow + ZC + it * 128; const float x1 = bf2f(p[i]), x2 = bf2f(p[i + 64]); p[i] = f2bf(x1 * cs - x2 * sn); p[i + 64] = f2bf(x2 * cs + x1 * sn); } }
}

constexpr int RWT = 8;
__device__ __forceinline__ void rwkv_prep_tile(Frame& F, ArgsP a, int layer, int tile) {
    unsigned char* ws = F.ws; const bf16* Z = (const bf16*)(ws + SC_Z);
    LAS float* zr = (LAS float*)F.lds; LAS float* act = zr + (RWT + 2) * IN_B;
    const int t0 = tile * RWT; const int b = t0 / SEQ, s0 = t0 % SEQ;
    __syncthreads();
    for (int i = F.tid; i < (RWT + 2) * (IN_B / 8); i += 512) { const int rr = i / (IN_B / 8), c8 = i % (IN_B / 8); const int s = s0 - 1 + rr;
        f32x4 lo = {0.f, 0.f, 0.f, 0.f}, hi = {0.f, 0.f, 0.f, 0.f};
        if (s >= 0 && s < SEQ) { const u32x4 w = *(const u32x4*)(Z + (size_t)(b * SEQ + s) * ZLD + ZB + c8 * 8);
            lo = (f32x4){__uint_as_float(w.x << 16), __uint_as_float(w.x & 0xffff0000u), __uint_as_float(w.y << 16), __uint_as_float(w.y & 0xffff0000u)};
            hi = (f32x4){__uint_as_float(w.z << 16), __uint_as_float(w.z & 0xffff0000u), __uint_as_float(w.w << 16), __uint_as_float(w.w & 0xffff0000u)}; }
        *(LAS f32x4*)(zr + rr * IN_B + c8 * 8) = lo; *(LAS f32x4*)(zr + rr * IN_B + c8 * 8 + 4) = hi; }
    __syncthreads();
    const float* mu = a->in[I_RWKV_MU] + (size_t)layer * 2 * IN_B;
#define ZS(t, col) (zr[((t) + 1) * IN_B + (col)] + mu[(col)] * (zr[(t) * IN_B + (col)] - zr[((t) + 1) * IN_B + (col)]) + mu[IN_B + (col)] * (zr[((t) + 2) * IN_B + (col)] - zr[((t) + 1) * IN_B + (col)]))
    for (int i = F.tid; i < RWT * 384; i += 512) { const int t = i / 384, j = i % 384; const int col = 1536 + j; const float x = ZS(t, col);
        act[t * 384 + j] = (j < 128) ? tanhf(x) : ((j < 256) ? x : sigmoidf_(x)); }
    __syncthreads();
    const int c = F.tid;
    float aw0[RWT], aw1[RWT], aa0[RWT], aa1[RWT], ag[RWT];
#pragma unroll
    for (int t = 0; t < RWT; ++t) { aw0[t] = 0.f; aw1[t] = 0.f; aa0[t] = 0.f; aa1[t] = 0.f; ag[t] = 0.f; }
    const float* w2 = a->in[I_RWKV_W2] + (size_t)layer * 2 * 64 * 512; const float* a2 = a->in[I_RWKV_A2] + (size_t)layer * 2 * 64 * 512; const float* g2 = a->in[I_RWKV_G2] + (size_t)layer * 128 * 512;
#pragma unroll 1
    for (int r = 0; r < 64; r += 4) {
        float wv0[4], wv1[4], av0[4], av1[4];
#pragma unroll
        for (int q = 0; q < 4; ++q) { wv0[q] = w2[(size_t)(r + q) * 512 + c]; wv1[q] = w2[(size_t)(64 + r + q) * 512 + c]; av0[q] = a2[(size_t)(r + q) * 512 + c]; av1[q] = a2[(size_t)(64 + r + q) * 512 + c]; }
#pragma unroll
        for (int t = 0; t < RWT; ++t) { const f32x4 x0 = *(const LAS f32x4*)(act + t * 384 + r), x1 = *(const LAS f32x4*)(act + t * 384 + 64 + r), y0 = *(const LAS f32x4*)(act + t * 384 + 128 + r), y1 = *(const LAS f32x4*)(act + t * 384 + 192 + r);
#pragma unroll
            for (int q = 0; q < 4; ++q) { aw0[t] += x0[q] * wv0[q]; aw1[t] += x1[q] * wv1[q]; aa0[t] += y0[q] * av0[q]; aa1[t] += y1[q] * av1[q]; } }
    }
#pragma unroll 1
    for (int r = 0; r < 128; r += 4) {
        float gv[4];
#pragma unroll
        for (int q = 0; q < 4; ++q) gv[q] = g2[(size_t)(r + q) * 512 + c];
#pragma unroll
        for (int t = 0; t < RWT; ++t) { const f32x4 x = *(const LAS f32x4*)(act + t * 384 + 256 + r);
#pragma unroll
            for (int q = 0; q < 4; ++q) ag[t] += x[q] * gv[q]; }
    }
    const float w00 = a->in[I_RWKV_W0][(size_t)layer * 1024 + c], w01 = a->in[I_RWKV_W0][(size_t)layer * 1024 + 512 + c];
    const float a00 = a->in[I_RWKV_A0][(size_t)layer * 1024 + c], a01 = a->in[I_RWKV_A0][(size_t)layer * 1024 + 512 + c];
    const float kkw = a->in[I_RWKV_KK][(size_t)layer * 512 + c], kaw = a->in[I_RWKV_KA][(size_t)layer * 512 + c];
    float* RW = (float*)(ws + SC_RW); const size_t N1 = (size_t)NTOK * 512;
#pragma unroll
    for (int t = 0; t < RWT; ++t) {
        const float r_ = ZS(t, c), k_ = ZS(t, 512 + c), v_ = ZS(t, 1024 + c);
        const float x0 = -(w00 + aw0[t]), x1 = -(w01 + aw1[t]);
        const float sp0 = fmaxf(x0, 0.f) + log1pf(__expf(-fabsf(x0))), sp1 = fmaxf(x1, 0.f) + log1pf(__expf(-fabsf(x1)));
        const float d0 = -__expf(-sp0 - 0.5f), d1 = -__expf(-sp1 - 0.5f);
        const float al0 = sigmoidf_(a00 + aa0[t]), al1 = sigmoidf_(a01 + aa1[t]);
        float kk = k_ * kkw; const float ssq = wave_sum(kk * kk); kk *= 1.f / sqrtf(ssq + 1e-12f);
        const float km0 = k_ * (1.f + (al0 - 1.f) * kaw), km1 = k_ * (1.f + (al1 - 1.f) * kaw);
        const size_t o = (size_t)(t0 + t) * 512 + c;
        RW[0 * N1 + o] = r_; RW[1 * N1 + o] = v_; RW[2 * N1 + o] = kk; RW[3 * N1 + o] = d0; RW[4 * N1 + o] = d1;
        RW[5 * N1 + o] = km0; RW[6 * N1 + o] = km1; RW[7 * N1 + o] = kk * al0; RW[8 * N1 + o] = kk * al1; RW[9 * N1 + o] = ag[t];
    }
#undef ZS
}

__device__ __forceinline__ void s5_carry_task(Frame& F, int layer, int task) {
    unsigned char* ws = F.ws; const bf16* Z = (const bf16*)(ws + SC_Z);
    const int dir = task & 1, g = (task >> 1) & 31, b = task >> 6; const int n = F.lane;
    const float* ab = (const float*)(ws + WS_S5P + layer * S5P_LAYER); const float* bb = ab + 2 * 32 * 64 * 2;
    const int pr = (dir * 32 + g) * 64 + n;
    const float abr = ab[pr * 2], abi = ab[pr * 2 + 1];
    float bbr[16], bbi[16];
#pragma unroll
    for (int c = 0; c < 16; ++c) { bbr[c] = bb[((size_t)pr * 16 + c) * 2]; bbi[c] = bb[((size_t)pr * 16 + c) * 2 + 1]; }
    LAS float* ul = (LAS float*)(F.lds + 65536 + F.wave * 4096);
    float* carry = (float*)(ws + SC_CARRY);
    float xr = 0.f, xi = 0.f;
    for (int blk = 0; blk < SEQ / 64; ++blk) {
        { const int sl = dir ? (SEQ - 1 - (blk * 64 + n)) : (blk * 64 + n); const bf16* zp = Z + (size_t)(b * SEQ + sl) * ZLD + ZD + g * 16;
          const u32x4 w0 = *(const u32x4*)zp, w1 = *(const u32x4*)(zp + 8);
          LAS f32x4* d = (LAS f32x4*)(ul + n * 16);
          d[0] = (f32x4){__uint_as_float(w0.x << 16), __uint_as_float(w0.x & 0xffff0000u), __uint_as_float(w0.y << 16), __uint_as_float(w0.y & 0xffff0000u)};
          d[1] = (f32x4){__uint_as_float(w0.z << 16), __uint_as_float(w0.z & 0xffff0000u), __uint_as_float(w0.w << 16), __uint_as_float(w0.w & 0xffff0000u)};
          d[2] = (f32x4){__uint_as_float(w1.x << 16), __uint_as_float(w1.x & 0xffff0000u), __uint_as_float(w1.y << 16), __uint_as_float(w1.y & 0xffff0000u)};
          d[3] = (f32x4){__uint_as_float(w1.z << 16), __uint_as_float(w1.z & 0xffff0000u), __uint_as_float(w1.w << 16), __uint_as_float(w1.w & 0xffff0000u)}; }
        LDS_WAIT(); asm volatile("" ::: "memory");
#pragma unroll 4
        for (int i = 0; i < 64; ++i) {
            const int step = blk * 64 + i;
            if ((step & (S5CH - 1)) == 0) { const int sl = dir ? (SEQ - 1 - step) : step; const int ch = sl / S5CH;
                float* cp = carry + ((((size_t)dir * BATCH + b) * S5NCH + ch) * 32 + g) * 128 + n * 2; cp[0] = xr; cp[1] = xi; }
            const f32x4 u0 = *(const LAS f32x4*)(ul + i * 16), u1 = *(const LAS f32x4*)(ul + i * 16 + 4), u2 = *(const LAS f32x4*)(ul + i * 16 + 8), u3 = *(const LAS f32x4*)(ul + i * 16 + 12);
            float br = 0.f, bi = 0.f;
#pragma unroll
            for (int c = 0; c < 4; ++c) { br += bbr[c] * u0[c] + bbr[4 + c] * u1[c] + bbr[8 + c] * u2[c] + bbr[12 + c] * u3[c]; bi += bbi[c] * u0[c] + bbi[4 + c] * u1[c] + bbi[8 + c] * u2[c] + bbi[12 + c] * u3[c]; }
            const float nr = abr * xr - abi * xi + br, ni = abr * xi + abi * xr + bi; xr = nr; xi = ni;
        }
        asm volatile("" ::: "memory");
    }
}

__device__ __forceinline__ void prep_phase(Frame& F, ArgsP a, int layer) {
    const int q = layer * 8 + 0;
    for (;;) { const int it = q_next(F, q);
        if (it < 16) { s5_carry_task(F, layer, it * 8 + F.wave); continue; }
        if (it < 16 + NTOK / RWT) { rwkv_prep_tile(F, a, layer, it - 16); continue; }
        const int r = it - 16 - NTOK / RWT; if (r >= NTOK / 64) break;
        for (int k = 0; k < 8; ++k) { const int tok = r * 64 + F.wave * 8 + k; rope_token(F, (bf16*)(F.ws + SC_Z) + (size_t)tok * ZLD, tok % SEQ); }
    }
}

constexpr int CR_TA = 0, CR_GH = 2048, CR_WBK = 4096, CR_TM = 8192, CR_N = 8704, CR_V = 9216, CR_WL = 11264, CR_BYTES = 11520;
constexpr size_t SC_CREC = SC_MIX_END;
constexpr size_t SC_MIX_END2 = SC_CREC + (size_t)32 * 256 * CR_BYTES;
static_assert(SC_MIX_END2 <= 1140000000ull, "workspace budget");

__device__ __forceinline__ void mm16(const LAS float* A, const LAS float* B, int t, int sq, float (&out)[4]) {
    out[0] = out[1] = out[2] = out[3] = 0.f;
#pragma unroll
    for (int s4 = 0; s4 < 4; ++s4) { const f32x4 a4 = *(const LAS f32x4*)(A + t * 16 + s4 * 4);
#pragma unroll
        for (int q = 0; q < 4; ++q) { const f32x4 b4 = *(const LAS f32x4*)(B + (s4 * 4 + q) * 16 + sq * 4); const float av = a4[q];
            out[0] += av * b4[0]; out[1] += av * b4[1]; out[2] += av * b4[2]; out[3] += av * b4[3]; } }
}
__device__ __forceinline__ void st16(LAS float* M, int t, int sq, const float (&v)[4]) { *(LAS f32x4*)(M + t * 16 + sq * 4) = (f32x4){v[0], v[1], v[2], v[3]}; }

__device__ __forceinline__ void rwkv_cprep_item(Frame& F, int chain, int c, LAS float* Lw) {
    unsigned char* ws = F.ws; const float* RW = (const float*)(ws + SC_RW); const size_t N1 = (size_t)NTOK * 512;
    const int dir = chain & 1, h = (chain >> 1) & 7, b = chain >> 4; const int lane = F.lane;
    const float* Rp = RW; const float* Vp = RW + N1; const float* KKp = RW + 2 * N1; const float* LDp = RW + (3 + dir) * N1; const float* KMp = RW + (5 + dir) * N1; const float* BBp = RW + (7 + dir) * N1;
    LAS float* At = Lw; LAS float* Bt = Lw + 1024; LAS float* Kt = Lw + 2048; LAS float* mat = Lw + 3072;
    float at[16], rt[16], wb[16], wk[16], vv[16];
    { float lw = 0.f, lwi[16], bb[16], km[16];
#pragma unroll
      for (int t = 0; t < 16; ++t) { const int pos = dir ? (SEQ - 1 - 16 * c - t) : (16 * c + t); const size_t idx = (size_t)(b * SEQ + pos) * 512 + h * 64 + lane;
          const float r_ = Rp[idx], ld = LDp[idx], a_ = -KKp[idx]; km[t] = KMp[idx]; bb[t] = BBp[idx]; vv[t] = Vp[idx];
          at[t] = a_ * __expf(lw); lw += ld; lwi[t] = lw; rt[t] = r_ * __expf(lw);
          const float iw = __expf(-lw); At[t * 64 + lane] = at[t]; Bt[t * 64 + lane] = bb[t] * iw; Kt[t * 64 + lane] = km[t] * iw; }
#pragma unroll
      for (int t = 0; t < 16; ++t) { const float e = __expf(lw - lwi[t]); wb[t] = bb[t] * e; wk[t] = km[t] * e; }
      float* rec = (float*)(ws + SC_CREC + ((size_t)chain * 256 + c) * CR_BYTES + CR_WL); rec[lane] = __expf(lw); }
    LDS_WAIT(); asm volatile("" ::: "memory");
    const int t = lane >> 2, sq = lane & 3;
    float mab[4] = {0.f, 0.f, 0.f, 0.f}, mak[4] = {0.f, 0.f, 0.f, 0.f}, mrb[4] = {0.f, 0.f, 0.f, 0.f}, mrk[4] = {0.f, 0.f, 0.f, 0.f};
#pragma unroll 4
    for (int j = 0; j < 64; j += 4) { const f32x4 a4 = *(const LAS f32x4*)(At + t * 64 + j);
#pragma unroll
        for (int e = 0; e < 4; ++e) { const f32x4 b4 = *(const LAS f32x4*)(Bt + (sq * 4 + e) * 64 + j), k4 = *(const LAS f32x4*)(Kt + (sq * 4 + e) * 64 + j);
            mab[e] += a4[0] * b4[0] + a4[1] * b4[1] + a4[2] * b4[2] + a4[3] * b4[3]; mak[e] += a4[0] * k4[0] + a4[1] * k4[1] + a4[2] * k4[2] + a4[3] * k4[3]; } }
    asm volatile("" ::: "memory");
#pragma unroll
    for (int tt = 0; tt < 16; ++tt) At[tt * 64 + lane] = rt[tt];
    LDS_WAIT(); asm volatile("" ::: "memory");
#pragma unroll 4
    for (int j = 0; j < 64; j += 4) { const f32x4 a4 = *(const LAS f32x4*)(At + t * 64 + j);
#pragma unroll
        for (int e = 0; e < 4; ++e) { const f32x4 b4 = *(const LAS f32x4*)(Bt + (sq * 4 + e) * 64 + j), k4 = *(const LAS f32x4*)(Kt + (sq * 4 + e) * 64 + j);
            mrb[e] += a4[0] * b4[0] + a4[1] * b4[1] + a4[2] * b4[2] + a4[3] * b4[3]; mrk[e] += a4[0] * k4[0] + a4[1] * k4[1] + a4[2] * k4[2] + a4[3] * k4[3]; } }
#pragma unroll
    for (int e = 0; e < 4; ++e) { const int s = sq * 4 + e; if (s >= t) { mab[e] = 0.f; mak[e] = 0.f; } if (s > t) { mrb[e] = 0.f; mrk[e] = 0.f; } }
    LAS float* m0 = mat; LAS float* m1 = mat + 256; LAS float* m2 = mat + 512; LAS float* m3 = mat + 768;
    float T[4], P[4], Q[4];
    st16(m0, t, sq, mab); LDS_WAIT(); asm volatile("" ::: "memory");
#pragma unroll
    for (int e = 0; e < 4; ++e) T[e] = mab[e] + ((sq * 4 + e) == t ? 1.f : 0.f);
    mm16(m0, m0, t, sq, P);
    st16(m1, t, sq, P); st16(m2, t, sq, T); LDS_WAIT(); asm volatile("" ::: "memory");
    mm16(m2, m1, t, sq, Q);
#pragma unroll
    for (int e = 0; e < 4; ++e) T[e] += Q[e];
    mm16(m1, m1, t, sq, P);
    asm volatile("" ::: "memory");
    st16(m0, t, sq, P); st16(m2, t, sq, T); LDS_WAIT(); asm volatile("" ::: "memory");
    mm16(m2, m0, t, sq, Q);
#pragma unroll
    for (int e = 0; e < 4; ++e) T[e] += Q[e];
    mm16(m0, m0, t, sq, P);
    asm volatile("" ::: "memory");
    st16(m1, t, sq, P); st16(m2, t, sq, T); LDS_WAIT(); asm volatile("" ::: "memory");
    mm16(m2, m1, t, sq, Q);
#pragma unroll
    for (int e = 0; e < 4; ++e) T[e] += Q[e];
    asm volatile("" ::: "memory");
    st16(m2, t, sq, T); st16(m0, t, sq, mrb); st16(m1, t, sq, mak); LDS_WAIT(); asm volatile("" ::: "memory");
    float P1[4], TM[4], Nn[4];
    mm16(m0, m2, t, sq, P1); mm16(m2, m1, t, sq, TM);
    st16(m3, t, sq, P1); LDS_WAIT(); asm volatile("" ::: "memory");
    mm16(m3, m1, t, sq, Nn);
#pragma unroll
    for (int e = 0; e < 4; ++e) Nn[e] += mrk[e];
    unsigned char* rec = ws + SC_CREC + ((size_t)chain * 256 + c) * CR_BYTES;
    { u32x2 w; w.x = pk2(TM[0], TM[1]); w.y = pk2(TM[2], TM[3]); *(u32x2*)(rec + CR_TM + (16 * sq + t) * 8) = w;
      w.x = pk2(Nn[0], Nn[1]); w.y = pk2(Nn[2], Nn[3]); *(u32x2*)(rec + CR_N + (16 * sq + t) * 8) = w; }
    LAS unsigned short* TAh = (LAS unsigned short*)Bt; LAS unsigned short* GHh = TAh + 1024;
#pragma unroll
    for (int tt = 0; tt < 16; ++tt) { float ta = 0.f, gh = rt[tt];
#pragma unroll
        for (int s4 = 0; s4 < 4; ++s4) { const f32x4 t4 = *(const LAS f32x4*)(m2 + tt * 16 + s4 * 4), p4 = *(const LAS f32x4*)(m3 + tt * 16 + s4 * 4);
            ta += t4[0] * at[s4 * 4] + t4[1] * at[s4 * 4 + 1] + t4[2] * at[s4 * 4 + 2] + t4[3] * at[s4 * 4 + 3];
            gh += p4[0] * at[s4 * 4] + p4[1] * at[s4 * 4 + 1] + p4[2] * at[s4 * 4 + 2] + p4[3] * at[s4 * 4 + 3]; }
        TAh[tt * 64 + lane] = f2bf(ta); GHh[tt * 64 + lane] = f2bf(gh); }
    LDS_WAIT(); asm volatile("" ::: "memory");
    { const int r = lane & 15, g = lane >> 4;
#pragma unroll
      for (int ks = 0; ks < 2; ++ks) { const u32x2 a0 = *(const LAS u32x2*)(TAh + r * 64 + 32 * ks + 4 * g), a1 = *(const LAS u32x2*)(TAh + r * 64 + 32 * ks + 16 + 4 * g);
          *(u32x4*)(rec + CR_TA + (ks * 64 + lane) * 16) = (u32x4){a0.x, a0.y, a1.x, a1.y};
          const u32x2 g0 = *(const LAS u32x2*)(GHh + r * 64 + 32 * ks + 4 * g), g1 = *(const LAS u32x2*)(GHh + r * 64 + 32 * ks + 16 + 4 * g);
          *(u32x4*)(rec + CR_GH + (ks * 64 + lane) * 16) = (u32x4){g0.x, g0.y, g1.x, g1.y}; } }
    { const int jb = lane >> 4, r = lane & 15;
#pragma unroll
      for (int g = 0; g < 4; ++g) { u32x4 w; w.x = pk2(wb[4 * g], wb[4 * g + 1]); w.y = pk2(wb[4 * g + 2], wb[4 * g + 3]); w.z = pk2(wk[4 * g], wk[4 * g + 1]); w.w = pk2(wk[4 * g + 2], wk[4 * g + 3]);
          *(u32x4*)(rec + CR_WBK + (jb * 64 + 16 * g + r) * 16) = w;
          u32x2 x; x.x = pk2(vv[4 * g], vv[4 * g + 1]); x.y = pk2(vv[4 * g + 2], vv[4 * g + 3]); *(u32x2*)(rec + CR_V + (jb * 64 + 16 * g + r) * 8) = x; } }
    LDS_WAIT(); asm volatile("" ::: "memory");
}

__device__ __forceinline__ void cprep_phase(Frame& F, int layer) {
    LAS float* Lw = (LAS float*)(F.lds + F.wave * 16384);
    for (int it = F.bid * 8 + F.wave; it < 32 * 256; it += F.G * 8) { const int c = it >> 5, chain = it & 31; rwkv_cprep_item(F, chain, c, Lw); }
}

struct RwOps { bf16x8 ta[2], gh[2], wbk[4]; u32x2 tm, nn, vq[2]; f32x4 wl[4]; };
__device__ __forceinline__ void rw_load(RwOps& o, const unsigned char* rec, int lane, int half) {
    const int g = lane >> 4;
#pragma unroll
    for (int ks = 0; ks < 2; ++ks) { o.ta[ks] = *(const bf16x8*)(rec + CR_TA + (ks * 64 + lane) * 16); o.gh[ks] = *(const bf16x8*)(rec + CR_GH + (ks * 64 + lane) * 16); }
#pragma unroll
    for (int jb = 0; jb < 4; ++jb) { o.wbk[jb] = *(const bf16x8*)(rec + CR_WBK + (jb * 64 + lane) * 16); o.wl[jb] = *(const f32x4*)(rec + CR_WL + (jb * 16 + g * 4) * 4); }
    o.tm = *(const u32x2*)(rec + CR_TM + lane * 8); o.nn = *(const u32x2*)(rec + CR_N + lane * 8);
#pragma unroll
    for (int it = 0; it < 2; ++it) o.vq[it] = *(const u32x2*)(rec + CR_V + ((half * 2 + it) * 64 + lane) * 8);
}
__device__ __forceinline__ bf16x8 mk8(unsigned a, unsigned b, unsigned c, unsigned d) { u32x4 w = {a, b, c, d}; return *reinterpret_cast<bf16x8*>(&w); }
__device__ __forceinline__ void rw_step(const RwOps& o, f32x4 (&X)[4][2], float* ysb, const long rs, int lane) {
    const int r = lane & 15, g = lane >> 4;
    const bf16x8 tmf = mk8(o.tm.x, o.tm.y, 0u, 0u), nf = mk8(o.nn.x, o.nn.y, 0u, 0u);
#pragma unroll
    for (int it = 0; it < 2; ++it) {
        bf16x8 xb[2];
#pragma unroll
        for (int ks = 0; ks < 2; ++ks) xb[ks] = mk8(pk2c(X[2 * ks][it][0], X[2 * ks][it][1]), pk2c(X[2 * ks][it][2], X[2 * ks][it][3]), pk2c(X[2 * ks + 1][it][0], X[2 * ks + 1][it][1]), pk2c(X[2 * ks + 1][it][2], X[2 * ks + 1][it][3]));
        const bf16x8 vb = mk8(o.vq[it].x, o.vq[it].y, 0u, 0u);
        f32x4 U = {0.f, 0.f, 0.f, 0.f}, Y = {0.f, 0.f, 0.f, 0.f};
        U = __builtin_amdgcn_mfma_f32_16x16x32_bf16(o.ta[0], xb[0], U, 0, 0, 0); Y = __builtin_amdgcn_mfma_f32_16x16x32_bf16(o.gh[0], xb[0], Y, 0, 0, 0);
        U = __builtin_amdgcn_mfma_f32_16x16x32_bf16(o.ta[1], xb[1], U, 0, 0, 0); Y = __builtin_amdgcn_mfma_f32_16x16x32_bf16(o.gh[1], xb[1], Y, 0, 0, 0);
        U = __builtin_amdgcn_mfma_f32_16x16x32_bf16(tmf, vb, U, 0, 0, 0);       Y = __builtin_amdgcn_mfma_f32_16x16x32_bf16(nf, vb, Y, 0, 0, 0);
        const bf16x8 uvb = mk8(pk2c(U[0], U[1]), pk2c(U[2], U[3]), o.vq[it].x, o.vq[it].y);
#pragma unroll
        for (int jb = 0; jb < 4; ++jb) X[jb][it] = __builtin_amdgcn_mfma_f32_16x16x32_bf16(o.wbk[jb], uvb, X[jb][it] * o.wl[jb], 0, 0, 0);
#pragma unroll
        for (int q = 0; q < 4; ++q) ysb[(long)(4 * g + q) * rs + 16 * it + r] = Y[q];
    }
}
__device__ __forceinline__ void rwkv_scan_chunked(Frame& F, int chain, int half) {
    unsigned char* ws = F.ws; const int dir = chain & 1, h = (chain >> 1) & 7, b = chain >> 4; const int lane = F.lane;
    const unsigned char* rec0 = ws + SC_CREC + (size_t)chain * 256 * CR_BYTES;
#ifdef DBG_RWCHK
    float* YS = (float*)(ws + WS_HN) + (size_t)dir * NTOK * 512;
#else
    float* YS = (float*)(ws + SC_YS) + (size_t)dir * NTOK * 512;
#endif
    f32x4 X[4][2];
#pragma unroll
    for (int jb = 0; jb < 4; ++jb) { X[jb][0] = (f32x4){0.f, 0.f, 0.f, 0.f}; X[jb][1] = (f32x4){0.f, 0.f, 0.f, 0.f}; }
    RwOps oa, ob;
    rw_load(oa, rec0, lane, half);
    const long rs = dir ? -512 : 512;
    for (int c = 0; c < 256; c += 2) {
        rw_load(ob, rec0 + (size_t)(c + 1) * CR_BYTES, lane, half);
        { const int pos0 = dir ? (SEQ - 1 - 16 * c) : 16 * c; rw_step(oa, X, YS + (size_t)(b * SEQ + pos0) * 512 + h * 64 + half * 32, rs, lane); }
        if (c + 2 < 256) rw_load(oa, rec0 + (size_t)(c + 2) * CR_BYTES, lane, half);
        { const int pos0 = dir ? (SEQ - 1 - 16 * (c + 1)) : 16 * (c + 1); rw_step(ob, X, YS + (size_t)(b * SEQ + pos0) * 512 + h * 64 + half * 32, rs, lane); }
    }
}

__device__ __forceinline__ void rwkv_scan_naive(Frame& F, int chain) {
    unsigned char* ws = F.ws; const float* RW = (const float*)(ws + SC_RW); const size_t N1 = (size_t)NTOK * 512;
    const int dir = chain & 1, h = (chain >> 1) & 7, b = chain >> 4;
    const float* Rp = RW; const float* Vp = RW + N1; const float* KKp = RW + 2 * N1; const float* Wp = RW + (3 + dir) * N1; const float* KMp = RW + (5 + dir) * N1; const float* BBp = RW + (7 + dir) * N1;
    float* YS = (float*)(ws + SC_YS) + (size_t)dir * N1;
    LAS float* L = (LAS float*)(F.lds + F.wave * 2048);
    float st[64];
#pragma unroll
    for (int j = 0; j < 64; ++j) st[j] = 0.f;
    size_t idx = (size_t)(b * SEQ + (dir ? SEQ - 1 : 0)) * 512 + h * 64 + F.lane;
    float va = -KKp[idx], vw = __expf(Wp[idx]), vb = BBp[idx], vk = KMp[idx], vr = Rp[idx], vv = Vp[idx];
    for (int t = 0; t < SEQ; ++t) {
        L[F.lane] = va; L[64 + F.lane] = vw; L[128 + F.lane] = vb; L[192 + F.lane] = vk; L[256 + F.lane] = vr;
        const float v = vv; const size_t oidx = idx;
        if (t + 1 < SEQ) { idx = dir ? idx - 512 : idx + 512; va = -KKp[idx]; vw = __expf(Wp[idx]); vb = BBp[idx]; vk = KMp[idx]; vr = Rp[idx]; vv = Vp[idx]; }
        LDS_WAIT(); asm volatile("" ::: "memory");
        float sa0 = 0.f, sa1 = 0.f, sa2 = 0.f, sa3 = 0.f;
#pragma unroll
        for (int j = 0; j < 64; j += 4) { const f32x4 x = *(const LAS f32x4*)(L + j); sa0 += st[j] * x[0]; sa1 += st[j + 1] * x[1]; sa2 += st[j + 2] * x[2]; sa3 += st[j + 3] * x[3]; }
        const float sa = (sa0 + sa1) + (sa2 + sa3);
        float y0 = 0.f, y1 = 0.f, y2 = 0.f, y3 = 0.f;
#pragma unroll
        for (int j = 0; j < 64; j += 4) { const f32x4 w4 = *(const LAS f32x4*)(L + 64 + j), b4 = *(const LAS f32x4*)(L + 128 + j), k4 = *(const LAS f32x4*)(L + 192 + j), r4 = *(const LAS f32x4*)(L + 256 + j);
            st[j] = st[j] * w4[0] + (sa * b4[0] + v * k4[0]); st[j + 1] = st[j + 1] * w4[1] + (sa * b4[1] + v * k4[1]); st[j + 2] = st[j + 2] * w4[2] + (sa * b4[2] + v * k4[2]); st[j + 3] = st[j + 3] * w4[3] + (sa * b4[3] + v * k4[3]);
            y0 += st[j] * r4[0]; y1 += st[j + 1] * r4[1]; y2 += st[j + 2] * r4[2]; y3 += st[j + 3] * r4[3]; }
        YS[oidx] = (y0 + y1) + (y2 + y3);
        asm volatile("" ::: "memory");
    }
}

__device__ __forceinline__ void s5_unit(Frame& F, ArgsP a, int layer, int unit) {
    unsigned char* ws = F.ws; const bf16* Z = (const bf16*)(ws + SC_Z);
    const int b = unit / S5NCH, ch = unit % S5NCH; const int tok0 = b * SEQ + ch * S5CH;
    LAS float* ybuf = (LAS float*)F.lds;
    LAS float* glT = (LAS float*)(F.lds + 32768);
    LAS float* xs = (LAS float*)(F.lds + 65536 + F.wave * 8192);
    const float* ab = (const float*)(ws + WS_S5P + layer * S5P_LAYER); const float* bb = ab + 2 * 32 * 64 * 2;
    const float* carry = (const float*)(ws + SC_CARRY);
    const int n = F.lane;
    __syncthreads();
    for (int gi = 0; gi < 4; ++gi) {
        const int g = gi * 8 + F.wave;
#pragma unroll 1
        for (int dir = 0; dir < 2; ++dir) {
            const int pr = (dir * 32 + g) * 64 + n; const float abr = ab[pr * 2], abi = ab[pr * 2 + 1];
            float bbr[16], bbi[16];
#pragma unroll
            for (int c = 0; c < 16; ++c) { bbr[c] = bb[((size_t)pr * 16 + c) * 2]; bbi[c] = bb[((size_t)pr * 16 + c) * 2 + 1]; }
            const float* cp = carry + ((((size_t)dir * BATCH + b) * S5NCH + ch) * 32 + g) * 128 + n * 2; float xr = cp[0], xi = cp[1];
#pragma unroll 1
            for (int i = 0; i < S5CH; ++i) { const int tl = dir ? (S5CH - 1 - i) : i; const bf16* zp = Z + (size_t)(tok0 + tl) * ZLD + ZD + g * 16;
                const u32x4 w0 = *(const u32x4*)zp, w1 = *(const u32x4*)(zp + 8);
                const float u[16] = {__uint_as_float(w0.x << 16), __uint_as_float(w0.x & 0xffff0000u), __uint_as_float(w0.y << 16), __uint_as_float(w0.y & 0xffff0000u),
                                     __uint_as_float(w0.z << 16), __uint_as_float(w0.z & 0xffff0000u), __uint_as_float(w0.w << 16), __uint_as_float(w0.w & 0xffff0000u),
                                     __uint_as_float(w1.x << 16), __uint_as_float(w1.x & 0xffff0000u), __uint_as_float(w1.y << 16), __uint_as_float(w1.y & 0xffff0000u),
                                     __uint_as_float(w1.z << 16), __uint_as_float(w1.z & 0xffff0000u), __uint_as_float(w1.w << 16), __uint_as_float(w1.w & 0xffff0000u)};
                float br = 0.f, bi = 0.f;
#pragma unroll
                for (int c = 0; c < 16; ++c) { br += bbr[c] * u[c]; bi += bbi[c] * u[c]; }
                const float nr = abr * xr - abi * xi + br, ni = abr * xi + abi * xr + bi; xr = nr; xi = ni;
                LAS float* xp = xs + (tl * 64 + n) * 2;
                if (dir == 0) { xp[0] = xr; xp[1] = xi; } else { xp[0] += xr; xp[1] += xi; } }
        }
        LDS_WAIT(); asm volatile("" ::: "memory");
        { const int c = F.lane & 15, sq = F.lane >> 4; const float* cre = a->in[I_S5_C_RE] + (((size_t)layer * 32 + g) * 16 + c) * 64; const float* cim = a->in[I_S5_C_IM] + (((size_t)layer * 32 + g) * 16 + c) * 64;
          float y[4] = {0.f, 0.f, 0.f, 0.f};
#pragma unroll 4
          for (int nn = 0; nn < 64; nn += 4) { const f32x4 cr = *(const f32x4*)(cre + nn), ci = *(const f32x4*)(cim + nn);
#pragma unroll
              for (int s = 0; s < 4; ++s) { const LAS f32x4* xp = (const LAS f32x4*)(xs + ((sq * 4 + s) * 64 + nn) * 2); const f32x4 xa = xp[0], xb = xp[1];
                  y[s] += cr[0] * xa[0] - ci[0] * xa[1] + cr[1] * xa[2] - ci[1] * xa[3] + cr[2] * xb[0] - ci[2] * xb[1] + cr[3] * xb[2] - ci[3] * xb[3]; } }
          const float dsk = a->in[I_S5_D][(size_t)layer * 512 + g * 16 + c];
#pragma unroll
          for (int s = 0; s < 4; ++s) { const int tl = sq * 4 + s; const float uu = bf2f(Z[(size_t)(tok0 + tl) * ZLD + ZD + g * 16 + c]); const float yy = y[s] + dsk * uu;
              const float x3 = yy * yy * yy; const float gl = 0.5f * yy * (1.f + tanhf(0.7978845608028654f * (yy + 0.044715f * x3)));
              ybuf[tl * 512 + g * 16 + c] = gl; glT[(g * 16 + c) * 16 + tl] = gl; } }
        LDS_WAIT(); asm volatile("" ::: "memory");
    }
    __syncthreads();
    { const int c = F.tid; const float* gw = a->in[I_S5_GLU_W] + (size_t)layer * 512 * 512; float acc[16];
#pragma unroll
      for (int s = 0; s < 16; ++s) acc[s] = 0.f;
#pragma unroll 2
      for (int k = 0; k < 512; ++k) { const float w = gw[(size_t)k * 512 + c]; const LAS f32x4* gp = (const LAS f32x4*)(glT + k * 16); const f32x4 g0 = gp[0], g1 = gp[1], g2 = gp[2], g3 = gp[3];
#pragma unroll
          for (int q = 0; q < 4; ++q) { acc[q] += g0[q] * w; acc[4 + q] += g1[q] * w; acc[8 + q] += g2[q] * w; acc[12 + q] += g3[q] * w; } }
      const float bias = a->in[I_S5_GLU_B][(size_t)layer * 512 + c];
      __syncthreads();
#pragma unroll
      for (int s = 0; s < 16; ++s) { const float gl = ybuf[s * 512 + c]; ybuf[s * 512 + c] = gl * sigmoidf_(acc[s] + bias); } }
    __syncthreads();
    { const float* gn = a->in[I_MIX_OUT_NORM] + ((size_t)layer * 2 + 1) * 512; bf16* MIX = (bf16*)(ws + WS_MIX);
#pragma unroll
      for (int q = 0; q < 2; ++q) { const int tl = F.wave * 2 + q; float v[8]; float s = 0.f;
#pragma unroll
          for (int j = 0; j < 8; ++j) { v[j] = ybuf[tl * 512 + j * 64 + F.lane]; s += v[j] * v[j]; }
          const float rstd = 1.f / sqrtf(wave_sum(s) * (1.f / 512.f) + RMS_EPS);
#pragma unroll
          for (int j = 0; j < 8; ++j) MIX[(size_t)(tok0 + tl) * DM + 1536 + j * 64 + F.lane] = f2bf(v[j] * rstd * gn[j * 64 + F.lane]); } }
}

__device__ __forceinline__ void mix_phase(Frame& F, ArgsP a, int layer) {
    constexpr int NB = 8, NA = BATCH * 4 * (SEQ / 128), NC = BATCH * 4 * 48, ND = BATCH * S5NCH;
#ifdef DBG_RWCHK
    for (;;) { const int it = q_next(F, layer * 8 + 5); if (it >= 4) break; rwkv_scan_naive(F, it * 8 + F.wave); }
#endif
    for (;;) { const int it = q_next(F, layer * 8 + 1); if (it >= NB) break; rwkv_scan_chunked(F, it * 4 + (F.wave >> 1), F.wave & 1); }
    for (;;) { const int it = q_next(F, layer * 8 + 2); if (it >= NA) break;
        unsigned char* ws = F.ws; asm volatile("" : "+s"(ws)); const bf16* Z = (const bf16*)(ws + SC_Z);
        const int qb = it % (SEQ / 128), h = (it / (SEQ / 128)) % 4, b = it / (4 * (SEQ / 128));
        const bf16* zb = Z + (size_t)(b * SEQ) * ZLD + ZA;
        float lam, lam_init;
        { const float* lv = a->in[I_DIFF_LAMBDA] + (size_t)layer * 4 * 64; float d1 = 0.f, d2 = 0.f;
          for (int i = 0; i < 64; ++i) { d1 += lv[i] * lv[64 + i]; d2 += lv[128 + i] * lv[192 + i]; }
          lam_init = 0.8f - 0.6f * expf(-0.3f * (float)layer); lam = expf(d1) - expf(d2) + lam_init; }
        att::diff_attn_unit(zb + (size_t)(qb * 128) * ZLD + h * 128, zb + 512 + h * 128, zb + 1024 + h * 128, ZLD, SEQ,
                            (bf16*)(ws + WS_MIX) + (size_t)(b * SEQ + qb * 128) * DM + h * 128, DM, lam, 1.f - lam_init, a->in[I_DIFF_SUBLN] + (size_t)layer * 128, (char*)F.lds, F.wave); }
    for (;;) { const int it = q_next(F, layer * 8 + 3); if (it >= NC) break;
        unsigned char* ws = F.ws; asm volatile("" : "+s"(ws)); const bf16* Z = (const bf16*)(ws + SC_Z);
        const int r = it % 48, h = (it / 48) % 4, b = it / (48 * 4); const int p = r / 16, rr = r % 16;
        const int dil = p == 0 ? 1 : (p == 1 ? 4 : 16); const int L = SEQ / dil; const int nqb = L / 256; const int rho = rr / nqb, qb = rr % nqb;
        const bf16* zb = Z + (size_t)(b * SEQ) * ZLD + ZC;
        att::dil_attn_unit(zb + h * 128, zb + 512 + h * 128, zb + 1024 + h * 128, ZLD, dil, rho, qb * 256, L,
                           (float*)(ws + SC_OC) + ((size_t)p * NTOK + (size_t)b * SEQ) * 512 + h * 128, (float*)(ws + SC_LSE) + ((size_t)p * NTOK + (size_t)b * SEQ) * 4 + h, (char*)F.lds, F.wave); }
    for (;;) { const int it = q_next(F, layer * 8 + 4); if (it >= ND) break; s5_unit(F, a, layer, it); }
}

__device__ __forceinline__ void post_phase(Frame& F, ArgsP a, int layer) {
    unsigned char* ws = F.ws; bf16* MIX = (bf16*)(ws + WS_MIX);
    const int gw = F.bid * 8 + F.wave, NGW = F.G * 8;
    const float* RW = (const float*)(ws + SC_RW); const size_t N1 = (size_t)NTOK * 512; const float* YS = (const float*)(ws + SC_YS);
#ifdef DBG_RWCHK
    { const float* Y2 = (const float*)(ws + WS_HN); float e = 0.f, r2 = 0.f; int bad = 0;
      for (size_t i = (size_t)F.bid * 512 + F.tid; i < (size_t)2 * NTOK * 512; i += (size_t)F.G * 512) { const float a0 = ((const float*)(ws + SC_YS))[i], b0 = Y2[i]; const float d = fabsf(a0 - b0); if (!(d < 1e30f)) bad = 1; else e = fmaxf(e, d); r2 = fmaxf(r2, fabsf(a0)); }
      e = wave_max(e); r2 = wave_max(r2); bad = __any(bad) ? 1 : 0;
      if (F.lane == 0) { atomicMax(F.ctl + 32768 + layer * 64, __float_as_uint(e)); atomicMax(F.ctl + 32768 + layer * 64 + 1, __float_as_uint(r2)); if (bad) atomicMax(F.ctl + 32768 + layer * 64 + 2, 1u); } }
#endif
    for (int it = gw; it < NTOK * 8; it += NGW) { const int tok = it >> 3, h = it & 7; const size_t o = (size_t)tok * 512 + h * 64 + F.lane; const int c = h * 64 + F.lane;
        const float y = YS[o] + YS[N1 + o];
        const float mean = wave_sum(y) * (1.f / 64.f); const float d = y - mean; const float var = wave_sum(d * d) * (1.f / 64.f);
        const float yn = d * (1.f / sqrtf(var + 64e-5f)) * a->in[I_RWKV_LNX_W][(size_t)layer * 512 + c] + a->in[I_RWKV_LNX_B][(size_t)layer * 512 + c];
        const float r_ = RW[o], v_ = RW[N1 + o], kb = 0.5f * (RW[5 * N1 + o] + RW[6 * N1 + o]);
        const float bon = wave_sum(r_ * kb * a->in[I_RWKV_RK][(size_t)layer * 512 + c]) * v_;
        MIX[(size_t)tok * DM + 512 + c] = f2bf((yn + bon) * RW[9 * N1 + o]); }
    const float* OC = (const float*)(ws + SC_OC); const float* LSE = (const float*)(ws + SC_LSE); const float* gn = a->in[I_MIX_OUT_NORM] + ((size_t)layer * 2 + 0) * 512;
    for (int tok = gw; tok < NTOK; tok += NGW) { const int h = F.lane >> 4;
        const float l0 = LSE[((size_t)0 * NTOK + tok) * 4 + h], l1 = LSE[((size_t)1 * NTOK + tok) * 4 + h], l2 = LSE[((size_t)2 * NTOK + tok) * 4 + h];
        const float m = fmaxf(l0, fmaxf(l1, l2)); float w0 = __expf(l0 - m), w1 = __expf(l1 - m), w2 = __expf(l2 - m); const float inv = 1.f / (w0 + w1 + w2); w0 *= inv; w1 *= inv; w2 *= inv;
        float v[8]; float s = 0.f;
        const f32x4* p0 = (const f32x4*)(OC + ((size_t)0 * NTOK + tok) * 512) + F.lane * 2; const f32x4* p1 = (const f32x4*)(OC + ((size_t)1 * NTOK + tok) * 512) + F.lane * 2; const f32x4* p2 = (const f32x4*)(OC + ((size_t)2 * NTOK + tok) * 512) + F.lane * 2;
#pragma unroll
        for (int j = 0; j < 2; ++j) { const f32x4 a0 = p0[j], a1 = p1[j], a2 = p2[j];
#pragma unroll
            for (int e = 0; e < 4; ++e) { const float x = w0 * a0[e] + w1 * a1[e] + w2 * a2[e]; v[j * 4 + e] = x; s += x * x; } }
        const float rstd = 1.f / sqrtf(wave_sum(s) * (1.f / 512.f) + RMS_EPS);
        const f32x4 g0 = *((const f32x4*)gn + F.lane * 2), g1 = *((const f32x4*)gn + F.lane * 2 + 1);
        u32x4 w; w.x = pk2(v[0] * rstd * g0[0], v[1] * rstd * g0[1]); w.y = pk2(v[2] * rstd * g0[2], v[3] * rstd * g0[3]); w.z = pk2(v[4] * rstd * g1[0], v[5] * rstd * g1[1]); w.w = pk2(v[6] * rstd * g1[2], v[7] * rstd * g1[3]);
        *(u32x4*)(MIX + (size_t)tok * DM + 1024 + F.lane * 8) = w; }
}

#ifndef MK_FUSED
#define MK_FUSED 1
#endif
__global__ void __launch_bounds__(512, 2) enc_fwd(Args args_) {
    extern __shared__ __attribute__((aligned(16))) unsigned char lds_raw[];
    Frame F;
    F.lds = (LAS unsigned char*)lds_raw; F.MISC = (volatile LAS unsigned*)(F.lds + MISC_OFF);
    F.tid = threadIdx.x; F.lane = F.tid & 63; F.wave = __builtin_amdgcn_readfirstlane(F.tid >> 6); F.G = gridDim.x; F.bid = blockIdx.x;
    const int wave0 = F.wave;
    ArgsP ap = (ArgsP)__builtin_amdgcn_kernarg_segment_ptr();
    unsigned char* ws = ap->ws; F.ws = ws; F.ctl = (unsigned*)(ws + WS_CTL);
    for (int u = F.tid; u < (LDS_BYTES - MISC_OFF) / 4; u += 512) ((LAS unsigned*)(F.lds + MISC_OFF))[u] = 0u;
    __syncthreads();
    const int lo = ap->ph_lo, hi = ap->ph_hi;
    if (hi - lo > 1) (void)xcd_barrier_post(F.ctl + CW_BAR, F.MISC + 8);
#ifdef DBG_ONLY
#define IN(k) (((k) < PH_L0 ? (k) : ((k) == PH_FINAL ? 100 : 3 + ((k) - PH_L0) % NPH_L)) == DBG_ONLY && lo <= (k) && (k) < hi)
#else
#define IN(k) ({ int lo_ = lo, hi_ = hi; asm volatile("" : "+s"(lo_), "+s"(hi_)); lo_ <= (k) && (k) < hi_; })
#endif
#define args (*ap)
#define REFRESH() do { int wv_ = wave0, bi_ = blockIdx.x, gg_ = gridDim.x; asm volatile("" : "+s"(wv_), "+s"(bi_), "+s"(gg_)); const int t_ = tid_from_wave(wv_); F.tid = t_; F.lane = t_ & 63; F.wave = wv_; F.bid = bi_; F.G = gg_; ap = (ArgsP)__builtin_amdgcn_kernarg_segment_ptr(); asm volatile("" : "+s"(ap)); unsigned char* w_ = ap->ws; F.ws = w_; ws = w_; F.ctl = (unsigned*)(w_ + WS_CTL); } while (0)
#define SEAM(k) do { if (IN(k) && IN((k) + 1)) { XcdBarrier b_; b_.bar = (unsigned*)(ap->ws + WS_CTL) + CW_BAR; b_.x = xb_xcc_id(); b_.st = F.MISC + 8; xcd_barrier(b_); } } while (0)

    if (IN(PH_P0)) { REFRESH(); p0_prologue(F, ap); } SEAM(PH_P0);
    if (IN(PH_P1)) { REFRESH();
        SchedBatch S{(const char*)(ws + SC_MEMN), (const char*)(ws + SC_WKVT), (char*)(ws + SC_KVB), (size_t)512 * DM * 2, (size_t)4096 * DM * 2, (size_t)512 * 4096 * 2, 2, 16, DEPTH, F.G, F.bid, DM, DM, 4096 * 2, 2, 512};
        pg8::gemm_phase<pg8::EpiBf16, SchedBatch, false>(F.lds, pg8::GemmP{DM, DM, DM}, S, pg8::EpiBf16{4096}, F.wave);
    } SEAM(PH_P1);
    if (IN(PH_P2)) { REFRESH();
        { SchedXaPre S{ws, F.G, F.bid, 0}; pg8::gemm_phase<EpiBf16U, SchedXaPre, false>(F.lds, pg8::GemmP{512, 4096, DM}, S, EpiBf16U{}, F.wave); }
        { SchedXaPre S{ws, F.G, F.bid, 1}; pg8::gemm_phase<EpiBf16U, SchedXaPre, false>(F.lds, pg8::GemmP{512, DM, 4096}, S, EpiBf16U{}, F.wave); }
    } SEAM(PH_P2);

    for (int l = 0; l < DEPTH; ++l) {
        const int pb = PH_L0 + l * NPH_L;
        float* H = (float*)(ws + WS_H);
        if (IN(pb + LP_NORM1)) { REFRESH(); if (l == 0) norm_phase<0>(F, ap, args.in[I_X], args.in[I_NORM_MIX], l); else norm_phase<1>(F, ap, H, args.in[I_NORM_MIX] + (size_t)l * DM, l); } SEAM(pb + LP_NORM1);
        if (IN(pb + LP_G1)) { REFRESH();
            SchedDense S{(const char*)(ws + WS_HN), (const char*)(ws + WS_WIN) + (size_t)l * ZLD * DM * 2, (char*)(ws + SC_Z), NTOK / 256, ZLD / 256, F.G, F.bid, DM, DM, ZLD * 2, 2};
            pg8::gemm_phase<pg8::EpiBf16, SchedDense, false>(F.lds, pg8::GemmP{DM, DM, DM}, S, pg8::EpiBf16{ZLD}, F.wave);
        } SEAM(pb + LP_G1);
        if (IN(pb + LP_PREP)) { REFRESH(); prep_phase(F, ap, l); } SEAM(pb + LP_PREP);
        if (IN(pb + LP_CPREP)) { REFRESH(); cprep_phase(F, l); } SEAM(pb + LP_CPREP);
        if (IN(pb + LP_MIX)) { REFRESH(); mix_phase(F, ap, l); } SEAM(pb + LP_MIX);
        if (IN(pb + LP_POST)) { REFRESH(); post_phase(F, ap, l); } SEAM(pb + LP_POST);
        if (IN(pb + LP_G2)) { REFRESH();
            SchedDense S{(const char*)(ws + WS_MIX), (const char*)(ws + WS_WOUT) + (size_t)l * DM * DM * 2, (char*)H, NTOK / 256, DM / 256, F.G, F.bid, DM, DM, DM * 4, 4};
            pg8::gemm_phase<pg8::EpiF32Res, SchedDense, false>(F.lds, pg8::GemmP{DM, DM, DM}, S, pg8::EpiF32Res{DM, l == 0 ? args.in[I_X] : (const float*)H, H}, F.wave);
        } SEAM(pb + LP_G2);
        if (IN(pb + LP_NORM2)) { REFRESH(); norm_phase<0>(F, ap, H, args.in[I_NORM_CROSS] + (size_t)l * DM, l); } SEAM(pb + LP_NORM2);
        if (IN(pb + LP_GS)) { REFRESH();
            SchedBatch S{(const char*)(ws + WS_HN), (const char*)(ws + WS_WQK) + (size_t)l * 2 * 1024 * DM * 2, (char*)(ws + WS_P), (size_t)SEQ * DM * 2, (size_t)1024 * DM * 2, (size_t)SEQ * 1024 * 2, SEQ / 256, 4, BATCH, F.G, F.bid, DM, DM, 1024 * 2, 2, SEQ};
            pg8::gemm_phase<pg8::EpiSoftmax, SchedBatch, false>(F.lds, pg8::GemmP{DM, DM, DM}, S, pg8::EpiSoftmax{1024, 0.044194173824159216f * 1.4426950408889634f}, F.wave);
        } SEAM(pb + LP_GS);
        if (IN(pb + LP_GO)) { REFRESH();
            SchedBatch S{(const char*)(ws + WS_P), (const char*)(ws + WS_VWO) + (size_t)l * 2 * DM * 1024 * 2, (char*)H, (size_t)SEQ * 1024 * 2, (size_t)DM * 1024 * 2, (size_t)SEQ * DM * 4, SEQ / 256, DM / 256, BATCH, F.G, F.bid, 1024, 1024, DM * 4, 4, SEQ};
            pg8::gemm_phase<pg8::EpiF32Res, SchedBatch, false>(F.lds, pg8::GemmP{1024, 1024, 1024}, S, pg8::EpiF32Res{DM, (const float*)H, H}, F.wave);
        } SEAM(pb + LP_GO);
        if (IN(pb + LP_NORM3)) { REFRESH(); norm_phase<2>(F, ap, H, args.in[I_NORM_MOE] + (size_t)l * DM, l); } SEAM(pb + LP_NORM3);
        if (IN(pb + LP_M1)) { REFRESH();
            volatile LAS int* tp = (volatile LAS int*)(F.lds + MISC_OFF + 256); volatile LAS int* cnt = tp + 40;
            moe_prefix(F, l, tp, cnt);
            SchedMoe S{ws, tp, cnt, l, F.G, F.bid, 0};
            pg8::gemm_phase<pg8::EpiSwiGlu, SchedMoe, true>(F.lds, pg8::GemmP{DM, DM, DM}, S, pg8::EpiSwiGlu{DEXP}, F.wave);
        } SEAM(pb + LP_M1);
        if (IN(pb + LP_M2)) { REFRESH();
            volatile LAS int* tp = (volatile LAS int*)(F.lds + MISC_OFF + 256); volatile LAS int* cnt = tp + 40;
            moe_prefix(F, l, tp, cnt);
            SchedMoe S{ws, tp, cnt, l, F.G, F.bid, 1};
            pg8::gemm_phase<pg8::EpiGate, SchedMoe, false>(F.lds, pg8::GemmP{DEXP, DEXP, DEXP}, S, pg8::EpiGate{DM, (const float*)(ws + WS_EGATE), nullptr}, F.wave);
        } SEAM(pb + LP_M2);
    }
    if (IN(PH_FINAL)) { REFRESH(); norm_phase<5>(F, ap, (const float*)(ws + WS_H), args.in[I_NORM_FINAL], DEPTH); }
#undef IN
#undef SEAM
#undef args
}

extern "C" void kernel_launch(void* const* d_in, const int* in_sizes, int n_in, void* d_out, int out_size, void* d_ws, size_t ws_size, hipStream_t stream) {
    static int grid = 0;
    if (grid == 0) {
        if (n_in != N_INPUTS || out_size != NTOK * DM || ws_size < cmax(WS_END, SC_MIX_END2)) { fprintf(stderr, "kernel_launch: built for %d inputs, out %d, ws >= %zu; got %d, %d, %zu\n", N_INPUTS, NTOK * DM, cmax(WS_END, SC_MIX_END2), n_in, out_size, ws_size); grid = -1; return; }
        int dev = 0, cus = 0, per_cu = 0;
        if (hipGetDevice(&dev) != hipSuccess || hipDeviceGetAttribute(&cus, hipDeviceAttributeMultiprocessorCount, dev) != hipSuccess) { fprintf(stderr, "kernel_launch: device query failed\n"); grid = -1; return; }
        if (hipFuncSetAttribute((const void*)enc_fwd, hipFuncAttributeMaxDynamicSharedMemorySize, LDS_BYTES) != hipSuccess) { fprintf(stderr, "kernel_launch: hipFuncSetAttribute failed\n"); grid = -1; return; }
        if (hipOccupancyMaxActiveBlocksPerMultiprocessor(&per_cu, (const void*)enc_fwd, 512, LDS_BYTES) != hipSuccess || per_cu < 1) fprintf(stderr, "kernel_launch: occupancy query says %d blocks per CU\n", per_cu);
        grid = cus;
    }
    if (grid < 0) return;
    hipMemsetAsync((char*)d_ws + WS_CTL, 0, CTL_BYTES, stream);
    Args a; memset(&a, 0, sizeof(a));
    for (int i = 0; i < N_INPUTS; ++i) a.in[i] = (const float*)d_in[i];
    a.out = (float*)d_out; a.ws = (unsigned char*)d_ws;
#if MK_FUSED
    a.ph_lo = 0; a.ph_hi = NPHASES;
    hipLaunchKernelGGL(enc_fwd, dim3(grid), dim3(512), LDS_BYTES, stream, a);
#else
    for (int p = 0; p < NPHASES; ++p) { a.ph_lo = p; a.ph_hi = p + 1; hipLaunchKernelGGL(enc_fwd, dim3(grid), dim3(512), LDS_BYTES, stream, a); }
#endif
    const hipError_t le = hipPeekAtLastError();
    if (le != hipSuccess) fprintf(stderr, "kernel_launch: launch failed: %s\n", hipGetErrorName(le));
}
```

```cpp
#include <hip/hip_runtime.h>
#include <cstdio>
#include <cstdint>
#include <cstring>

#define GAS __attribute__((address_space(1)))
#define LAS __attribute__((address_space(3)))
typedef unsigned short bf16;
typedef short bf16x8 __attribute__((ext_vector_type(8)));
typedef short s16x4 __attribute__((ext_vector_type(4)));
typedef float f32x2 __attribute__((ext_vector_type(2)));
typedef float f32x4 __attribute__((ext_vector_type(4)));
typedef float f32x16 __attribute__((ext_vector_type(16)));
typedef unsigned u32x2 __attribute__((ext_vector_type(2)));
typedef unsigned u32x4 __attribute__((ext_vector_type(4)));
typedef GAS unsigned gu32;

constexpr int DM = 2048, BATCH = 2, SEQ = 4096, NTOK = BATCH * SEQ, DEPTH = 2, NMEM = 256;
constexpr int IN_A = 1536, IN_B = 1920, IN_C = 1536, IN_D = 512, IN_TOTAL = 5504, ZLD = 5632;
constexpr int ZA = 0, ZB = 1536, ZC = 3456, ZD = 4992;
constexpr int NEXP = 32, DEXP = 512, ECAP = 8192;
constexpr int SLOT_CAP = 24576;
constexpr int S5CH = 16, S5NCH = SEQ / S5CH;
constexpr float RMS_EPS = 1e-6f;

enum { I_X = 0, I_MEM, I_NORM_MIX, I_W_IN, I_W_OUT, I_DIFF_LAMBDA, I_DIFF_SUBLN, I_RWKV_MU, I_RWKV_W0, I_RWKV_W2, I_RWKV_A0, I_RWKV_A2, I_RWKV_G2,
       I_RWKV_KK, I_RWKV_KA, I_RWKV_RK, I_RWKV_LNX_W, I_RWKV_LNX_B, I_S5_A_RE, I_S5_A_IM, I_S5_LOG_DT, I_S5_B_RE, I_S5_B_IM, I_S5_C_RE, I_S5_C_IM,
       I_S5_D, I_S5_GLU_W, I_S5_GLU_B, I_MIX_OUT_NORM, I_NORM_CROSS, I_NORM_MEM, I_XA_WQ, I_XA_WKV, I_XA_WO, I_NORM_MOE, I_ROUTER_GROUP,
       I_ROUTER_EXPERT, I_MOE_W1, I_MOE_W3, I_MOE_W2, I_NORM_FINAL, N_INPUTS };

constexpr size_t al256(size_t x) { return (x + 255) / 256 * 256; }
constexpr size_t WS_CTL = 0, CTL_BYTES = 1u << 20;
constexpr size_t WS_WIN  = WS_CTL + CTL_BYTES;
constexpr size_t WS_WOUT = WS_WIN + (size_t)DEPTH * ZLD * DM * 2;
constexpr size_t WS_WQK  = WS_WOUT + (size_t)DEPTH * DM * DM * 2;
constexpr size_t WS_VWO  = WS_WQK + (size_t)DEPTH * BATCH * 1024 * DM * 2;
constexpr size_t WS_W13  = WS_VWO + (size_t)DEPTH * BATCH * DM * 1024 * 2;
constexpr size_t WS_W2   = WS_W13 + (size_t)DEPTH * NEXP * 1024 * DM * 2;
constexpr size_t WS_ROPE = WS_W2 + (size_t)DEPTH * NEXP * DM * DEXP * 2;
constexpr size_t WS_S5P  = WS_ROPE + (size_t)SEQ * (32 + 32 + 64 + 64) * 4;
constexpr size_t S5P_LAYER = (size_t)(2 * 32 * 64 * 2 + 2 * 32 * 64 * 16 * 2 + 2 * 32 * 64 * 2) * 4;
constexpr size_t WS_H    = al256(WS_S5P + DEPTH * S5P_LAYER);
constexpr size_t WS_HN   = WS_H + (size_t)NTOK * DM * 4;
constexpr size_t WS_MIX  = WS_HN + (size_t)NTOK * DM * 2;
constexpr size_t WS_P    = WS_MIX + (size_t)NTOK * DM * 2;
constexpr size_t WS_ETOK = WS_P + (size_t)NTOK * 1024 * 2;
constexpr size_t WS_EGATE= WS_ETOK + (size_t)NEXP * ECAP * 4;
constexpr size_t WS_TINFO= WS_EGATE + (size_t)NEXP * ECAP * 4;
constexpr size_t WS_SCR  = al256(WS_TINFO + (size_t)NTOK * 16);
constexpr size_t SC_WKVT = WS_SCR;
constexpr size_t SC_MEMN = SC_WKVT + (size_t)DEPTH * 4096 * DM * 2;
constexpr size_t SC_KVB  = SC_MEMN + (size_t)DEPTH * 512 * DM * 2;
constexpr size_t SC_WQB  = SC_KVB + (size_t)DEPTH * 512 * 4096 * 2;
constexpr size_t SC_WOT  = SC_WQB + (size_t)DEPTH * DM * DM * 2;
constexpr size_t SC_PRO_END = SC_WOT + (size_t)DEPTH * DM * DM * 2;
constexpr size_t SC_Z    = WS_SCR;
constexpr size_t SC_RW   = SC_Z + (size_t)NTOK * ZLD * 2;
constexpr size_t RWSZ    = (size_t)NTOK * 512 * 4;
constexpr size_t SC_YS   = SC_RW + 10 * RWSZ;
constexpr size_t SC_OC   = SC_YS + 2 * RWSZ;
constexpr size_t SC_LSE  = SC_OC + 3 * RWSZ;
constexpr size_t SC_CARRY= SC_LSE + (size_t)3 * NTOK * 4 * 4;
constexpr size_t SC_MIX_END = SC_CARRY + (size_t)2 * BATCH * S5NCH * 32 * 64 * 2 * 4;
constexpr size_t SC_HMID = WS_SCR;
constexpr size_t SC_YBUF = SC_HMID + (size_t)SLOT_CAP * DEXP * 2;
constexpr size_t SC_MOE_END = SC_YBUF + (size_t)SLOT_CAP * DM * 2;
constexpr size_t cmax(size_t a, size_t b) { return a > b ? a : b; }
constexpr size_t WS_END = cmax(cmax(SC_PRO_END, SC_MIX_END), SC_MOE_END);

constexpr int CW_BAR = 4096;
constexpr int CW_Q = 8192;
constexpr int CW_CNT = 16384;

constexpr int RING_BYTES = 131072;
constexpr int MISC_OFF = RING_BYTES;
constexpr int LDS_BYTES = 147456;

__device__ __forceinline__ float bf2f(unsigned short b) { return __uint_as_float(((unsigned)b) << 16); }
typedef __bf16 bf16x2_t __attribute__((ext_vector_type(2)));
__device__ __forceinline__ unsigned pk2c(float lo, float hi) { bf16x2_t v = {(__bf16)lo, (__bf16)hi}; return __builtin_bit_cast(unsigned, v); }
__device__ __forceinline__ unsigned pk2(float lo, float hi) { unsigned r; asm volatile("v_cvt_pk_bf16_f32 %0, %1, %2" : "=v"(r) : "v"(lo), "v"(hi)); return r; }
__device__ __forceinline__ bf16 f2bf(float f) { return (bf16)(pk2(f, 0.f) & 0xffffu); }
__device__ __forceinline__ float wave_sum(float v) {
#pragma unroll
    for (int o = 1; o < 64; o <<= 1) v += __shfl_xor(v, o);
    return v;
}
__device__ __forceinline__ float wave_max(float v) {
#pragma unroll
    for (int o = 1; o < 64; o <<= 1) v = fmaxf(v, __shfl_xor(v, o));
    return v;
}
__device__ __forceinline__ float sigmoidf_(float x) { return 1.f / (1.f + __expf(-x)); }
#define LDS_WAIT() asm volatile("s_waitcnt lgkmcnt(0)" ::: "memory")
#define VM_WAIT() asm volatile("s_waitcnt vmcnt(0)" ::: "memory")

__device__ __forceinline__ int tid_from_wave(int wave) { int t = wave * 64 + (int)__builtin_amdgcn_mbcnt_hi(~0u, __builtin_amdgcn_mbcnt_lo(~0u, 0u)); asm volatile("" : "+v"(t)); return t; }
#define XB_TMO      128
#define XB_XCNT(j)  (256  + 64 * (j))
#define XB_XSUB(j)  (1280 + 64 * (j))
#define XB_XGEN(j)  (2304 + 64 * (j))
#define XB_TOP      3328
#define XB_TOPGEN   3392
#define XCD_BAR_WORDS 3456
#define XB_SPIN_CAP (1u << 18)

__device__ __forceinline__ unsigned xb_ld(unsigned* p)              { return __hip_atomic_load(p, __ATOMIC_RELAXED, __HIP_MEMORY_SCOPE_AGENT); }
__device__ __forceinline__ unsigned xb_add(unsigned* p, unsigned v) { return __hip_atomic_fetch_add(p, v, __ATOMIC_RELAXED, __HIP_MEMORY_SCOPE_AGENT); }
__device__ __forceinline__ unsigned xb_xcc_id() { return (unsigned)__builtin_amdgcn_s_getreg((3 << 11) | 20) & 0xFu; }
#define XB_SPIN(cond, bar) do { unsigned _sp = 0; while (cond) { __builtin_amdgcn_s_sleep(1); \
    if ((++_sp & 255u) == 0u) { if (xb_ld(&(bar)[XB_TMO])) break; if (_sp > XB_SPIN_CAP) { atomicAdd(&(bar)[XB_TMO], 1u); break; } } } } while (0)

struct XcdBarrier {
    unsigned* bar; unsigned x;
    volatile LAS unsigned* st;
};

__device__ __forceinline__ XcdBarrier xcd_barrier_post(unsigned* bar, volatile LAS unsigned* st) {
    XcdBarrier b; b.bar = bar; b.x = xb_xcc_id(); b.st = st;
    if (threadIdx.x == 0) (void)xb_add(&bar[XB_XCNT(b.x)], 1u);
    return b;
}
__device__ __forceinline__ void xcd_barrier_complete(unsigned* bar, unsigned x, unsigned& nloc, unsigned& nx) {
    const unsigned G = gridDim.x * gridDim.y * gridDim.z;
    unsigned sum, cnt, mine, sp = 0u;
    for (;;) {
        sum = 0u; cnt = 0u; mine = 0u;
#pragma unroll
        for (unsigned j = 0; j < 16; ++j) { const unsigned c = xb_ld(&bar[XB_XCNT(j)]); sum += c; cnt += (c > 0u) ? 1u : 0u; mine = (j == x) ? c : mine; }
        if (sum == G) break;
        __builtin_amdgcn_s_sleep(1);
        if ((++sp & 255u) == 0u) { if (xb_ld(&bar[XB_TMO])) break; if (sp > XB_SPIN_CAP) { atomicAdd(&bar[XB_TMO], 1u); break; } }
    }
    nloc = mine > 0u ? mine : 1u; nx = cnt > 0u ? cnt : 1u;
}

__device__ __forceinline__ void xcd_barrier(const XcdBarrier& b) {
    asm volatile("s_waitcnt vmcnt(0)" ::: "memory");
    __syncthreads();
    if (threadIdx.x == 0) {
        unsigned* bar = b.bar;
        __builtin_amdgcn_s_waitcnt(0);
        unsigned nloc = b.st[0], nx = b.st[1];
        if (nloc == 0u) { xcd_barrier_complete(bar, b.x, nloc, nx); b.st[0] = nloc; b.st[1] = nx; }
        const unsigned old = xb_add(&bar[XB_XSUB(b.x)], 1u);
        const unsigned gen = old / nloc;
        if (old + 1u == (gen + 1u) * nloc) {
            __builtin_amdgcn_fence(__ATOMIC_RELEASE, "agent");
            asm volatile("s_waitcnt vmcnt(0)" ::: "memory");
            const unsigned og = xb_add(&bar[XB_TOP], 1u);
            const unsigned tg = og / nx;
            if (og + 1u == (tg + 1u) * nx) xb_add(&bar[XB_TOPGEN], 1u);
            else XB_SPIN(xb_ld(&bar[XB_TOPGEN]) == tg, bar);
            __builtin_amdgcn_fence(__ATOMIC_ACQUIRE, "agent");
            xb_add(&bar[XB_XGEN(b.x)], 1u);
            asm volatile("s_waitcnt vmcnt(0)" ::: "memory");
        } else {
            XB_SPIN(xb_ld(&bar[XB_XGEN(b.x)]) == gen, bar);
            __builtin_amdgcn_fence(__ATOMIC_ACQUIRE, "agent");
            asm volatile("s_waitcnt vmcnt(0)" ::: "memory");
        }
    }
    __syncthreads();
}


namespace pg8 {
constexpr int BM = 256, BK = 64, HALF = 128, HTB = HALF * BK * 2, STAGE_BYTES = 8 * HTB, NXCD = 8, WGM = 8;
__host__ __device__ __forceinline__ int lds_byte(int r, int c) { const int st = (r >> 4) * 2 + (c >> 5), rr = r & 15, cc = c & 31, ob = rr * 64 + cc * 2; return st * 1024 + (ob ^ (((ob >> 9) & 1) << 5)); }
__host__ __device__ __forceinline__ void stage_rc(int b, int& R, int& C) { const int st = b / 1024, sb = b % 1024, swz = sb ^ (((sb >> 9) & 1) << 5); R = (st >> 1) * 16 + swz / 64; C = (st & 1) * 32 + (swz % 64) / 2; }
__host__ __device__ __forceinline__ int perm32(int rho) { const int n = rho >> 4, i = rho & 15; return 8 * (i >> 2) + 4 * n + (i & 3); }

struct Unit { const char* A; const char* B; char* C; int row0, col0, aux; };
struct GemmP { int K, lda, ldb; };

__device__ __forceinline__ void xcd_tile(int L, int nM, int nN, int& pm, int& pn) {
    const int nwg = nM * nN; int wgid = L;
    { const int q = nwg / NXCD, r = nwg % NXCD, xcd = wgid % NXCD, off = wgid / NXCD; wgid = (xcd < r ? xcd * (q + 1) : r * (q + 1) + (xcd - r) * q) + off; }
    const int nig = WGM * nN, gid = wgid / nig, fm = gid * WGM, gsz = (nM - fm) < WGM ? (nM - fm) : WGM;
    pm = fm + ((wgid % nig) % gsz); pn = (wgid % nig) / gsz;
}

typedef f32x4 Acc[2][2][4][2];

template <class Epi, class Sched, bool GATHER>
__device__ __forceinline__ void gemm_phase(LAS unsigned char* lds, const GemmP g, const Sched& S, const Epi& E, const int wave_id) {
    const int tid = tid_from_wave(wave_id), wid = __builtin_amdgcn_readfirstlane(tid >> 6), lane = tid & 63, wr = wid >> 2, wc = wid & 3, fr = lane & 15, fq = lane >> 4;
    const int K = g.K, nt = K / BK;
    int Rr[2], Cc[2]; unsigned voffB[2];
#pragma unroll
    for (int i = 0; i < 2; ++i) { int R, C; stage_rc(tid * 16 + i * 8192, R, C); const int Rb = Epi::PERM ? ((R & ~31) + perm32(R & 31)) : R;
        Rr[i] = R; Cc[i] = C; voffB[i] = (unsigned)(Rb * g.ldb + C) * 2u; }
    const size_t kstep = (size_t)(BK * 2);
    const size_t hstepB = (size_t)HALF * g.ldb * 2;
    const unsigned ldsw = (unsigned)wid * 1024u;
    const int aoff = lds_byte(wr * 64 + fr, fq * 8), boff = lds_byte(wc * 32 + fr, fq * 8);
#define PG8_SA(b, h) (((b) * 2 + (h)) * HTB)
#define PG8_SB(b, h) ((4 + (b) * 2 + (h)) * HTB)
#define PG8_STAGE_B(bufoff, gbase) do { _Pragma("unroll") for (int _i = 0; _i < 2; ++_i) \
        __builtin_amdgcn_global_load_lds((const unsigned*)((const char*)(gbase) + voffB[_i]), (LAS unsigned*)(lds + (bufoff) + ldsw + _i * 8192), 16, 0, 0); } while (0)
#define PG8_STAGE_A(bufoff, gbase, OFF, h) do { _Pragma("unroll") for (int _i = 0; _i < 2; ++_i) \
        __builtin_amdgcn_global_load_lds((const unsigned*)((const char*)(gbase) + (OFF)[h][_i]), (LAS unsigned*)(lds + (bufoff) + ldsw + _i * 8192), 16, 0, 0); } while (0)
#define PG8_OFFS(u, OFF) do { _Pragma("unroll") for (int _h = 0; _h < 2; ++_h) _Pragma("unroll") for (int _i = 0; _i < 2; ++_i) { \
        const int _row = _h * HALF + Rr[_i]; const int _src = GATHER ? S.arow((u), _row) : _row; (OFF)[_h][_i] = (unsigned)(_src * g.lda + Cc[_i]) * 2u; } } while (0)
#define PG8_LDA(dst, b, h) do { _Pragma("unroll") for (int m = 0; m < 4; ++m) _Pragma("unroll") for (int k = 0; k < 2; ++k) dst[m][k] = *(const LAS bf16x8*)(lds + PG8_SA(b, h) + aoff + m * 2048 + k * 1024); } while (0)
#define PG8_LDB(dst, b, h) do { _Pragma("unroll") for (int n = 0; n < 2; ++n) _Pragma("unroll") for (int k = 0; k < 2; ++k) dst[n][k] = *(const LAS bf16x8*)(lds + PG8_SB(b, h) + boff + n * 2048 + k * 1024); } while (0)
#define PG8_MMA(ai, bj, At, Bt) do { __builtin_amdgcn_s_setprio(1); _Pragma("unroll") for (int m = 0; m < 4; ++m) _Pragma("unroll") for (int n = 0; n < 2; ++n) _Pragma("unroll") for (int k = 0; k < 2; ++k) \
        acc[ai][bj][m][n] = __builtin_amdgcn_mfma_f32_16x16x32_bf16(Bt[n][k], At[m][k], acc[ai][bj][m][n], 0, 0, 0); __builtin_amdgcn_s_setprio(0); } while (0)
#define PG8_WAIT_V(n) asm volatile("s_waitcnt vmcnt(" #n ")" ::: "memory")
#define PG8_WAIT_L(n) asm volatile("s_waitcnt lgkmcnt(" #n ")" ::: "memory")
#define PG8_BAR __builtin_amdgcn_s_barrier()
#define PG8_SCHED __builtin_amdgcn_sched_barrier(0)
    Unit cur, nxt; int ui = 0;
    if (!S.next(0, cur)) return;
    f32x4 acc[2][2][4][2];
#pragma unroll
    for (int a = 0; a < 2; ++a)
#pragma unroll
        for (int b = 0; b < 2; ++b)
#pragma unroll
            for (int m = 0; m < 4; ++m)
#pragma unroll
                for (int n = 0; n < 2; ++n) acc[a][b][m][n] = (f32x4){0.f, 0.f, 0.f, 0.f};
    bf16x8 At[4][2], B0[2][2], B1[2][2];
    const char* cA = cur.A; const char* cB = cur.B;
    unsigned coffA[2][2], noffA[2][2];
    PG8_OFFS(cur, coffA);
    PG8_STAGE_B(PG8_SB(0, 0), cB); PG8_STAGE_A(PG8_SA(0, 0), cA, coffA, 0); PG8_STAGE_B(PG8_SB(0, 1), cB + hstepB); PG8_STAGE_A(PG8_SA(0, 1), cA, coffA, 1);
    if (wr == 1) PG8_BAR;
    PG8_WAIT_V(4); PG8_BAR;
    PG8_STAGE_B(PG8_SB(1, 0), cB + kstep); PG8_STAGE_A(PG8_SA(1, 0), cA + kstep, coffA, 0); PG8_STAGE_B(PG8_SB(1, 1), cB + hstepB + kstep);
    PG8_WAIT_V(6); PG8_BAR;
    for (;;) {
        const bool has_next = S.next(ui + 1, nxt);
        const char* nA = has_next ? nxt.A : cA; const char* nB = has_next ? nxt.B : cB;
        if (has_next) { PG8_OFFS(nxt, noffA); }
        else {
#pragma unroll
            for (int _h = 0; _h < 2; ++_h)
#pragma unroll
                for (int _i = 0; _i < 2; ++_i) noffA[_h][_i] = coffA[_h][_i]; }
        for (int t = 0; t < nt; t += 2) {
            const bool last = (t == nt - 2);
            const char* a1 = cA + (size_t)(t + 1) * kstep;
            const char* a2 = last ? nA : cA + (size_t)(t + 2) * kstep; const char* b2 = last ? nB : cB + (size_t)(t + 2) * kstep;
            const char* a3 = a2 + kstep; const char* b3 = b2 + kstep;
            unsigned o2[2][2];
#pragma unroll
            for (int _h = 0; _h < 2; ++_h)
#pragma unroll
                for (int _i = 0; _i < 2; ++_i) o2[_h][_i] = last ? noffA[_h][_i] : coffA[_h][_i];
            PG8_LDB(B0, 0, 0); PG8_SCHED; PG8_LDA(At, 0, 0); PG8_STAGE_A(PG8_SA(1, 1), a1, coffA, 1);
            PG8_WAIT_L(8); PG8_BAR; PG8_WAIT_L(0); PG8_MMA(0, 0, At, B0); PG8_BAR; PG8_SCHED;
            PG8_LDB(B1, 0, 1); PG8_STAGE_B(PG8_SB(0, 0), b2);
            PG8_BAR; PG8_WAIT_L(0); PG8_MMA(0, 1, At, B1); PG8_BAR;
            PG8_LDA(At, 0, 1); PG8_STAGE_A(PG8_SA(0, 0), a2, o2, 0);
            PG8_BAR; PG8_WAIT_L(0); PG8_MMA(1, 0, At, B0); PG8_BAR; PG8_SCHED;
            PG8_STAGE_B(PG8_SB(0, 1), b2 + hstepB);
            PG8_WAIT_V(6); PG8_BAR; PG8_MMA(1, 1, At, B1); PG8_BAR;
            PG8_LDB(B0, 1, 0); PG8_SCHED; PG8_LDA(At, 1, 0); PG8_STAGE_A(PG8_SA(0, 1), a2, o2, 1);
            PG8_WAIT_L(8); PG8_BAR; PG8_WAIT_L(0); PG8_MMA(0, 0, At, B0); PG8_BAR; PG8_SCHED;
            PG8_LDB(B1, 1, 1); PG8_STAGE_B(PG8_SB(1, 0), b3);
            PG8_BAR; PG8_WAIT_L(0); PG8_MMA(0, 1, At, B1); PG8_BAR;
            PG8_LDA(At, 1, 1); PG8_STAGE_A(PG8_SA(1, 0), a3, o2, 0);
            PG8_BAR; PG8_WAIT_L(0); PG8_MMA(1, 0, At, B0); PG8_BAR; PG8_SCHED;
            PG8_STAGE_B(PG8_SB(1, 1), b3 + hstepB);
            PG8_WAIT_V(6); PG8_BAR; PG8_MMA(1, 1, At, B1); PG8_BAR;
        }
        if constexpr (!Epi::AFTER_DRAIN) { E(acc, cur, wr, wc, fr, fq); }
        if (!has_next) break;
#pragma unroll
        for (int a = 0; a < 2; ++a)
#pragma unroll
            for (int b = 0; b < 2; ++b)
#pragma unroll
                for (int m = 0; m < 4; ++m)
#pragma unroll
                    for (int n = 0; n < 2; ++n) acc[a][b][m][n] = (f32x4){0.f, 0.f, 0.f, 0.f};
        cur = nxt; cA = nA; cB = nB; ++ui;
#pragma unroll
        for (int _h = 0; _h < 2; ++_h)
#pragma unroll
            for (int _i = 0; _i < 2; ++_i) coffA[_h][_i] = noffA[_h][_i];
    }
    PG8_WAIT_V(0);
    if (wr == 0) PG8_BAR;
    PG8_BAR;
    if constexpr (Epi::AFTER_DRAIN) { E.fused(acc, cur, wr, wc, fr, fq, lds, wid, lane); }
#undef PG8_SA
#undef PG8_SB
#undef PG8_STAGE_A
#undef PG8_STAGE_B
#undef PG8_OFFS
#undef PG8_LDA
#undef PG8_LDB
#undef PG8_MMA
#undef PG8_WAIT_V
#undef PG8_WAIT_L
#undef PG8_BAR
#undef PG8_SCHED
}

struct EpiBf16 {
    static constexpr bool PERM = true, AFTER_DRAIN = false;
    int ldc;
    __device__ __forceinline__ void operator()(const Acc& acc, const Unit& u, int wr, int wc, int fr, int fq) const {
        bf16* base = (bf16*)u.C + (size_t)(wr * 64 + fr) * ldc + wc * 32 + 8 * fq;
#pragma unroll
        for (int ai = 0; ai < 2; ++ai)
#pragma unroll
            for (int m = 0; m < 4; ++m) { bf16* rowp = base + (size_t)(ai * HALF + m * 16) * ldc;
#pragma unroll
                for (int bj = 0; bj < 2; ++bj) { const f32x4 v0 = acc[ai][bj][m][0], v1 = acc[ai][bj][m][1];
                    u32x4 w; w.x = pk2(v0[0], v0[1]); w.y = pk2(v0[2], v0[3]); w.z = pk2(v1[0], v1[1]); w.w = pk2(v1[2], v1[3]);
                    *(u32x4*)(rowp + bj * HALF) = w; } }
    }
};
struct EpiF32Res {
    static constexpr bool PERM = false, AFTER_DRAIN = false;
    int ldc; const float* resid; float* out;
    __device__ __forceinline__ void operator()(const Acc& acc, const Unit& u, int wr, int wc, int fr, int fq) const {
        const size_t o0 = (size_t)(u.row0 + wr * 64 + fr) * ldc + u.col0 + wc * 32 + 4 * fq;
#pragma unroll
        for (int ai = 0; ai < 2; ++ai)
#pragma unroll
            for (int m = 0; m < 4; ++m) { const size_t ro = o0 + (size_t)(ai * HALF + m * 16) * ldc;
#pragma unroll
                for (int bj = 0; bj < 2; ++bj)
#pragma unroll
                    for (int n = 0; n < 2; ++n) { const size_t o = ro + bj * HALF + n * 16; const f32x4 b = *(const f32x4*)(resid + o); *(f32x4*)(out + o) = acc[ai][bj][m][n] + b; } }
    }
};
struct EpiSwiGlu {
    static constexpr bool PERM = true, AFTER_DRAIN = false;
    int ldc;
    __device__ __forceinline__ void operator()(const Acc& acc, const Unit& u, int wr, int wc, int fr, int fq) const {
        bf16* base = (bf16*)u.C + (size_t)(wr * 64 + fr) * ldc + wc * 32 + 8 * fq;
#pragma unroll
        for (int ai = 0; ai < 2; ++ai)
#pragma unroll
            for (int m = 0; m < 4; ++m) { bf16* rowp = base + (size_t)(ai * HALF + m * 16) * ldc;
                float h[8];
#pragma unroll
                for (int n = 0; n < 2; ++n)
#pragma unroll
                    for (int e = 0; e < 4; ++e) { const float a = acc[ai][0][m][n][e], b = acc[ai][1][m][n][e]; h[n * 4 + e] = a / (1.f + __expf(-a)) * b; }
                u32x4 w; w.x = pk2(h[0], h[1]); w.y = pk2(h[2], h[3]); w.z = pk2(h[4], h[5]); w.w = pk2(h[6], h[7]);
                *(u32x4*)rowp = w; }
    }
};
struct EpiGate {
    static constexpr bool PERM = true, AFTER_DRAIN = false;
    int ldc; const float* egate; const int* cnt_lds_unused;
    __device__ __forceinline__ void operator()(const Acc& acc, const Unit& u, int wr, int wc, int fr, int fq) const {
        bf16* base = (bf16*)u.C + (size_t)(wr * 64 + fr) * ldc + wc * 32 + 8 * fq;
        const int e = u.aux >> 16, nvalid = u.aux & 0xffff;
        const float* gp = egate + (size_t)e * ECAP + u.row0;
#pragma unroll
        for (int ai = 0; ai < 2; ++ai)
#pragma unroll
            for (int m = 0; m < 4; ++m) { const int r = ai * HALF + wr * 64 + m * 16 + fr; const float gt = (r < nvalid) ? gp[r] : 0.f;
                bf16* rowp = base + (size_t)(ai * HALF + m * 16) * ldc;
#pragma unroll
                for (int bj = 0; bj < 2; ++bj) { const f32x4 v0 = acc[ai][bj][m][0] * gt, v1 = acc[ai][bj][m][1] * gt;
                    u32x4 w; w.x = pk2(v0[0], v0[1]); w.y = pk2(v0[2], v0[3]); w.z = pk2(v1[0], v1[1]); w.w = pk2(v1[2], v1[3]);
                    *(u32x4*)(rowp + bj * HALF) = w; } }
    }
};
struct EpiSoftmax {
    static constexpr bool PERM = true, AFTER_DRAIN = true;
    int ldc; float scale_log2e;
    __device__ __forceinline__ void operator()(const Acc&, const Unit&, int, int, int, int) const {}
    __device__ __forceinline__ void fused(const Acc& acc, const Unit& u, int wr, int wc, int fr, int fq, LAS unsigned char* lds, int wid, int lane) const {
        LAS float* RM = (LAS float*)lds;
        LAS float* RS = (LAS float*)(lds + 4096);
        float mx[2][4];
#pragma unroll
        for (int ai = 0; ai < 2; ++ai)
#pragma unroll
            for (int m = 0; m < 4; ++m) { float v = -3.0e38f;
#pragma unroll
                for (int bj = 0; bj < 2; ++bj)
#pragma unroll
                    for (int n = 0; n < 2; ++n) { const f32x4 x = acc[ai][bj][m][n]; v = fmaxf(v, fmaxf(fmaxf(x[0], x[1]), fmaxf(x[2], x[3]))); }
                v = fmaxf(v, __shfl_xor(v, 16)); v = fmaxf(v, __shfl_xor(v, 32));
                if (fq == 0) RM[(ai * HALF + wr * 64 + m * 16 + fr) * 4 + wc] = v; }
        asm volatile("s_waitcnt lgkmcnt(0)" ::: "memory"); __builtin_amdgcn_s_barrier(); asm volatile("" ::: "memory");
#pragma unroll
        for (int ai = 0; ai < 2; ++ai)
#pragma unroll
            for (int m = 0; m < 4; ++m) { const int row = ai * HALF + wr * 64 + m * 16 + fr; const f32x4 q = *(const LAS f32x4*)(RM + row * 4);
                const float M = fmaxf(fmaxf(q[0], q[1]), fmaxf(q[2], q[3])); const float mc = -M * scale_log2e; float s = 0.f;
#pragma unroll
                for (int bj = 0; bj < 2; ++bj)
#pragma unroll
                    for (int n = 0; n < 2; ++n)
#pragma unroll
                        for (int e = 0; e < 4; ++e) s += __builtin_amdgcn_exp2f(fmaf(acc[ai][bj][m][n][e], scale_log2e, mc));
                s += __shfl_xor(s, 16); s += __shfl_xor(s, 32);
                if (fq == 0) RS[row * 4 + wc] = s; }
        asm volatile("s_waitcnt lgkmcnt(0)" ::: "memory"); __builtin_amdgcn_s_barrier(); asm volatile("" ::: "memory");
        bf16* base = (bf16*)u.C + (size_t)(wr * 64 + fr) * ldc + wc * 32 + 8 * fq;
#pragma unroll
        for (int ai = 0; ai < 2; ++ai)
#pragma unroll
            for (int m = 0; m < 4; ++m) { const int row = ai * HALF + wr * 64 + m * 16 + fr; const f32x4 q = *(const LAS f32x4*)(RS + row * 4); const f32x4 qm = *(const LAS f32x4*)(RM + row * 4);
                const float M = fmaxf(fmaxf(qm[0], qm[1]), fmaxf(qm[2], qm[3])); const float mc = -M * scale_log2e;
                const float inv = 1.f / ((q[0] + q[1]) + (q[2] + q[3])); bf16* rowp = base + (size_t)(ai * HALF + m * 16) * ldc;
#pragma unroll
                for (int bj = 0; bj < 2; ++bj) { float pp[8];
#pragma unroll
                    for (int n = 0; n < 2; ++n)
#pragma unroll
                        for (int e = 0; e < 4; ++e) pp[n * 4 + e] = __builtin_amdgcn_exp2f(fmaf(acc[ai][bj][m][n][e], scale_log2e, mc)) * inv;
                    u32x4 w; w.x = pk2(pp[0], pp[1]); w.y = pk2(pp[2], pp[3]); w.z = pk2(pp[4], pp[5]); w.w = pk2(pp[6], pp[7]);
                    *(u32x4*)(rowp + bj * HALF) = w; } }
        asm volatile("s_waitcnt lgkmcnt(0)" ::: "memory"); __builtin_amdgcn_s_barrier(); asm volatile("" ::: "memory");
    }
};
}

namespace att {
constexpr int KVBLK = 64;
constexpr size_t SHM_V = KVBLK * 128 * 2, SHM_K = KVBLK * 128 * 2;
#define KSWZ(row, colB) ((row) * 256 + ((colB) ^ (((row) & 7) << 4)))
#define SBAR() __builtin_amdgcn_sched_barrier(0)
__device__ __forceinline__ int crow(int r, int hi) { return (r & 3) + 8 * (r >> 2) + 4 * hi; }
__device__ __forceinline__ bf16x8 ld8(const bf16* p) { return *reinterpret_cast<const bf16x8*>(p); }

__device__ __forceinline__ void partialSM(f32x16& p0, f32x16& p1, float& m_reg, float& mn, float& alpha, const float SCALE, const float THR) {
  const float C = SCALE * 1.4426950408889634f;
  float pmax = p0[0];
#pragma unroll
  for (int r = 1; r < 16; ++r) pmax = fmaxf(pmax, p0[r]);
#pragma unroll
  for (int r = 0; r < 16; ++r) pmax = fmaxf(pmax, p1[r]);
  { auto rr = __builtin_amdgcn_permlane32_swap(__float_as_uint(pmax), __float_as_uint(pmax), false, false);
    pmax = fmaxf(__uint_as_float(rr[0]), __uint_as_float(rr[1])); }
  if (__builtin_expect(__all(pmax - m_reg <= THR / SCALE), 1)) { mn = m_reg; alpha = 1.f; }
  else { mn = fmaxf(m_reg, pmax); alpha = __builtin_amdgcn_exp2f((m_reg - mn) * C); m_reg = mn; }
  const float mnC = -mn * C;
#pragma unroll
  for (int r = 0; r < 16; ++r) p0[r] = fmaf(p0[r], C, mnC);
#pragma unroll
  for (int r = 0; r < 16; ++r) p1[r] = fmaf(p1[r], C, mnC);
#pragma unroll
  for (int r = 0; r < 16; ++r) p0[r] = __builtin_amdgcn_exp2f(p0[r]);
}
__device__ __forceinline__ void finishSM(f32x16& p0, f32x16& p1, float alpha, float& l_reg, bf16x8& pa0, bf16x8& pa1, bf16x8& pa2, bf16x8& pa3) {
#pragma unroll
  for (int r = 0; r < 16; ++r) p1[r] = __builtin_amdgcn_exp2f(p1[r]);
  float ps = 0;
#pragma unroll
  for (int r = 0; r < 16; ++r) ps += p0[r];
#pragma unroll
  for (int r = 0; r < 16; ++r) ps += p1[r];
  { auto rr = __builtin_amdgcn_permlane32_swap(__float_as_uint(ps), __float_as_uint(ps), false, false);
    ps = __uint_as_float(rr[0]) + __uint_as_float(rr[1]); }
  l_reg = l_reg * alpha + ps;
#define PK4(P, BASE, OUT) do { unsigned a0 = pk2(P[BASE + 0], P[BASE + 1]), a1 = pk2(P[BASE + 2], P[BASE + 3]);   \
    unsigned b0 = pk2(P[BASE + 4], P[BASE + 5]), b1 = pk2(P[BASE + 6], P[BASE + 7]);                              \
    auto r0 = __builtin_amdgcn_permlane32_swap(a0, b0, false, false); auto r1 = __builtin_amdgcn_permlane32_swap(a1, b1, false, false); \
    u32x4 w = {r0[0], r1[0], r0[1], r1[1]}; OUT = *reinterpret_cast<bf16x8*>(&w); } while (0)
  PK4(p0, 0, pa0); PK4(p0, 8, pa1); PK4(p1, 0, pa2); PK4(p1, 8, pa3);
#undef PK4
}
template <int ND0> __device__ __forceinline__ void qkt(f32x16& p0, f32x16& p1, const char* Ks, const bf16x8* qr, int r32, int hi, int c0) {
  p0 = f32x16{}; p1 = f32x16{};
#pragma unroll
  for (int d0 = 0; d0 < ND0; ++d0) { const int cb = (c0 + d0 * 16 + hi * 8) * 2;
    const bf16x8 b0 = *reinterpret_cast<const bf16x8*>(Ks + KSWZ(r32, cb));
    const bf16x8 b1 = *reinterpret_cast<const bf16x8*>(Ks + KSWZ(32 + r32, cb));
    p0 = __builtin_amdgcn_mfma_f32_32x32x16_bf16(b0, qr[d0], p0, 0, 0, 0);
    p1 = __builtin_amdgcn_mfma_f32_32x32x16_bf16(b1, qr[d0], p1, 0, 0, 0); }
}
__device__ __forceinline__ int v_st(int k, int c) { const int kk = (k & ~0xC) | ((k & 4) << 1) | ((k & 8) >> 1); return ((kk >> 3) * 4 + (c >> 5)) * 512 + ((kk & 7) * 32 + (c & 31)) * 2; }
__device__ __forceinline__ int v_rd_base(int lane) { return ((lane & 3) << 3) | (((lane >> 2) & 3) << 6) | (((lane >> 4) & 1) << 5) | (((lane >> 5) & 1) << 8); }
constexpr int v_rd_off(int d0, int ks, int half) { return d0 * 512 + ks * 4096 + half * 2048; }
template <int OFF> __device__ __forceinline__ s16x4 tr_read(int vb) {
  s16x4 r; asm volatile("ds_read_b64_tr_b16 %0, %1 offset:%2" : "=&v"(r) : "v"(vb), "i"(OFF) : "memory"); return r;
}
template <int D0> __device__ __forceinline__ void pv_one(f32x16& od, int vb, bf16x8 pa0, bf16x8 pa1, bf16x8 pa2, bf16x8 pa3) {
  const s16x4 l0 = tr_read<v_rd_off(D0, 0, 0)>(vb), h0 = tr_read<v_rd_off(D0, 0, 1)>(vb), l1 = tr_read<v_rd_off(D0, 1, 0)>(vb), h1 = tr_read<v_rd_off(D0, 1, 1)>(vb);
  const s16x4 l2 = tr_read<v_rd_off(D0, 2, 0)>(vb), h2 = tr_read<v_rd_off(D0, 2, 1)>(vb), l3 = tr_read<v_rd_off(D0, 3, 0)>(vb), h3 = tr_read<v_rd_off(D0, 3, 1)>(vb);
  asm volatile("s_waitcnt lgkmcnt(0)" ::: "memory"); SBAR();
#define PK(L, H) (bf16x8){L[0], L[1], L[2], L[3], H[0], H[1], H[2], H[3]}
  od = __builtin_amdgcn_mfma_f32_32x32x16_bf16(pa0, PK(l0, h0), od, 0, 0, 0);
  od = __builtin_amdgcn_mfma_f32_32x32x16_bf16(pa1, PK(l1, h1), od, 0, 0, 0);
  od = __builtin_amdgcn_mfma_f32_32x32x16_bf16(pa2, PK(l2, h2), od, 0, 0, 0);
  od = __builtin_amdgcn_mfma_f32_32x32x16_bf16(pa3, PK(l3, h3), od, 0, 0, 0);
#undef PK
}
__device__ __forceinline__ void pv_d0(f32x16* o, int vb, bf16x8 pa0, bf16x8 pa1, bf16x8 pa2, bf16x8 pa3) {
  pv_one<0>(o[0], vb, pa0, pa1, pa2, pa3); pv_one<1>(o[1], vb, pa0, pa1, pa2, pa3); pv_one<2>(o[2], vb, pa0, pa1, pa2, pa3); pv_one<3>(o[3], vb, pa0, pa1, pa2, pa3);
}

__device__ __forceinline__ void diff_attn_unit(const bf16* Qb, const bf16* Kh, const bf16* Vh, int ld, int seq, bf16* outb, int ldo,
                                               const float lam, const float post_scale, const float* subln_g, char* lds, const int wave_id) {
  constexpr float SCALE = 0.125f, THR = 8.f;
  const int tid = tid_from_wave(wave_id), wid = __builtin_amdgcn_readfirstlane(tid >> 6), lane = tid & 63, r32 = lane & 31, hi = lane >> 5;
  const int csel = wid >> 2, wq = wid & 3;
  char* V_lds = lds; char* K_lds = lds + 2 * SHM_V;
  float* ws = (float*)(lds + 2 * SHM_V + 2 * SHM_K) + wid * 64; float* li_l = ws; float* al_l = ws + 32;
  float m_reg = -1e30f, l_reg = 0; f32x16 o[4] = {}; bf16x8 qr[4];
  const bf16* Qw = Qb + (long)(wq * 32 + r32) * ld + csel * 64 + hi * 8;
#pragma unroll
  for (int d0 = 0; d0 < 4; ++d0) qr[d0] = ld8(Qw + d0 * 16);
  const int sr = tid >> 4, sc = (tid & 15) * 8, vst0 = v_st(sr, sc), vst1 = v_st(32 + sr, sc);
  const int vb0 = (int)(uintptr_t)V_lds + v_rd_base(lane);
  const int kc0 = csel * 64;
  struct { bf16x8 vs0, vs1, ks0, ks1; } sr_[2];
#define SLOAD(i, k0) do { sr_[i].vs0 = ld8(&Vh[(long)((k0) + sr) * ld + sc]); sr_[i].vs1 = ld8(&Vh[(long)((k0) + 32 + sr) * ld + sc]); \
    sr_[i].ks0 = ld8(&Kh[(long)((k0) + sr) * ld + sc]); sr_[i].ks1 = ld8(&Kh[(long)((k0) + 32 + sr) * ld + sc]); } while (0)
#define SWRITE(b, i) do { *(bf16x8*)(V_lds + (b) * SHM_V + vst0) = sr_[i].vs0;          \
    *(bf16x8*)(V_lds + (b) * SHM_V + vst1) = sr_[i].vs1; const int kc = sc * 2;               \
    *(bf16x8*)(K_lds + (b) * SHM_K + KSWZ(sr, kc)) = sr_[i].ks0;                       \
    *(bf16x8*)(K_lds + (b) * SHM_K + KSWZ(32 + sr, kc)) = sr_[i].ks1; } while (0)
#define SWAIT() asm volatile("s_waitcnt vmcnt(4)" ::: "memory")
#define RESC(a) do { if (__any((a) < 1.f)) { if (hi == 0) al_l[r32] = (a); asm volatile("s_waitcnt lgkmcnt(0)" ::: "memory"); \
    _Pragma("unroll") for (int d = 0; d < 4; ++d) _Pragma("unroll") for (int r = 0; r < 16; ++r) o[d][r] *= al_l[crow(r, hi)]; } } while (0)
  f32x16 pA0, pA1, pB0, pB1; float mnA, mnB, alA, alB; bf16x8 pa0, pa1, pa2, pa3; const int NT = seq / KVBLK;
  constexpr int SE = 0, SO = 1;
  __syncthreads();
  SLOAD(SE, 0); asm volatile("s_waitcnt vmcnt(0)" ::: "memory"); SWRITE(0, SE); __syncthreads();
  qkt<4>(pA0, pA1, K_lds, qr, r32, hi, kc0); partialSM(pA0, pA1, m_reg, mnA, alA, SCALE, THR);
  SLOAD(SO, KVBLK); if (2 < NT) SLOAD(SE, 2 * KVBLK);
  SWAIT(); SWRITE(1, SO); __syncthreads();
  for (int j = 1; j + 1 < NT; j += 2) {
    SBAR(); qkt<4>(pB0, pB1, K_lds + SHM_K, qr, r32, hi, kc0);
    finishSM(pA0, pA1, alA, l_reg, pa0, pa1, pa2, pa3); SBAR();
    SLOAD(SO, (j + 2) * KVBLK); SBAR();
    pv_d0(o, vb0, pa0, pa1, pa2, pa3); partialSM(pB0, pB1, m_reg, mnB, alB, SCALE, THR);
    __syncthreads(); SWAIT(); SWRITE(0, SE);
    RESC(alB); __syncthreads();
    SBAR(); qkt<4>(pA0, pA1, K_lds, qr, r32, hi, kc0);
    finishSM(pB0, pB1, alB, l_reg, pa0, pa1, pa2, pa3); SBAR();
    if (j + 3 < NT) SLOAD(SE, (j + 3) * KVBLK); SBAR();
    pv_d0(o, vb0 + (int)SHM_V, pa0, pa1, pa2, pa3); partialSM(pA0, pA1, m_reg, mnA, alA, SCALE, THR);
    __syncthreads(); SWAIT(); SWRITE(1, SO);
    RESC(alA); __syncthreads();
  }
  SBAR(); qkt<4>(pB0, pB1, K_lds + SHM_K, qr, r32, hi, kc0);
  finishSM(pA0, pA1, alA, l_reg, pa0, pa1, pa2, pa3); SBAR();
  pv_d0(o, vb0, pa0, pa1, pa2, pa3); partialSM(pB0, pB1, m_reg, mnB, alB, SCALE, THR);
  __syncthreads(); RESC(alB);
  finishSM(pB0, pB1, alB, l_reg, pa0, pa1, pa2, pa3); SBAR();
  pv_d0(o, vb0 + (int)SHM_V, pa0, pa1, pa2, pa3);
  asm volatile("s_waitcnt vmcnt(0)" ::: "memory");
  if (hi == 0) li_l[r32] = l_reg; asm volatile("s_waitcnt lgkmcnt(0)" ::: "memory");
  float rli[16];
#pragma unroll
  for (int r = 0; r < 16; ++r) rli[r] = __builtin_amdgcn_rcpf(li_l[crow(r, hi)]);
  __syncthreads();
  float* X = (float*)lds + (size_t)wq * 4096;
  if (csel == 1) {
#pragma unroll
    for (int d0 = 0; d0 < 4; ++d0)
#pragma unroll
      for (int r = 0; r < 16; ++r) X[(d0 * 16 + r) * 64 + lane] = o[d0][r] * rli[r];
  }
  __syncthreads();
  if (csel == 0) {
    float ss[16];
#pragma unroll
    for (int r = 0; r < 16; ++r) ss[r] = 0.f;
#pragma unroll
    for (int d0 = 0; d0 < 4; ++d0)
#pragma unroll
      for (int r = 0; r < 16; ++r) { const float v = o[d0][r] * rli[r] - lam * X[(d0 * 16 + r) * 64 + lane]; o[d0][r] = v; ss[r] += v * v; }
#pragma unroll
    for (int r = 0; r < 16; ++r) { float s = ss[r];
      s += __shfl_xor(s, 1); s += __shfl_xor(s, 2); s += __shfl_xor(s, 4); s += __shfl_xor(s, 8); s += __shfl_xor(s, 16);
      ss[r] = __builtin_amdgcn_rsqf(s * (1.f / 128.f) + RMS_EPS) * post_scale; }
    float gg[4];
#pragma unroll
    for (int d0 = 0; d0 < 4; ++d0) gg[d0] = subln_g[d0 * 32 + r32];
    bf16* Ow = outb + (long)(wq * 32) * ldo;
#pragma unroll
    for (int r = 0; r < 16; ++r) { const int orow = crow(r, hi);
#pragma unroll
      for (int d0 = 0; d0 < 4; ++d0) Ow[(long)orow * ldo + d0 * 32 + r32] = f2bf(o[d0][r] * ss[r] * gg[d0]); }
  }
#undef SLOAD
#undef SWRITE
#undef SWAIT
}

__device__ __forceinline__ void dil_attn_unit(const bf16* Qh, const bf16* Kh, const bf16* Vh, int ld, int dil, int rho, int u0, int L,
                                              float* Oc, float* lsep, char* lds, const int wave_id) {
  constexpr float SCALE = 0.08838834764831845f; constexpr float C = SCALE * 1.4426950408889634f;
  const int tid = tid_from_wave(wave_id), wid = __builtin_amdgcn_readfirstlane(tid >> 6), lane = tid & 63, r32 = lane & 31, hi = lane >> 5;
  char* V_lds = lds; char* K_lds = lds + 2 * SHM_V;
  float* ws = (float*)(lds + 2 * SHM_V + 2 * SHM_K) + wid * 64; float* li_l = ws; float* al_l = ws + 32;
  float m_reg = -1e30f, l_reg = 0; f32x16 o[4] = {}; bf16x8 qr[8];
  const int uq = u0 + wid * 32 + r32;
  const bf16* Qw = Qh + (long)(rho + dil * uq) * ld + hi * 8;
#pragma unroll
  for (int d0 = 0; d0 < 8; ++d0) qr[d0] = ld8(Qw + d0 * 16);
  const int sr = tid >> 4, sc = (tid & 15) * 8, vst0 = v_st(sr, sc), vst1 = v_st(32 + sr, sc);
  const int vb0 = (int)(uintptr_t)V_lds + v_rd_base(lane);
  const int tlo = wid >> 1;
  for (int t = 0; t < 6; ++t) {
    const int kt0 = u0 - 64 + 64 * t;
    __syncthreads();
    { int ua = kt0 + sr, ub = kt0 + 32 + sr; ua = ua < 0 ? 0 : (ua >= L ? L - 1 : ua); ub = ub < 0 ? 0 : (ub >= L ? L - 1 : ub);
      const long ra = (long)(rho + dil * ua) * ld + sc, rb = (long)(rho + dil * ub) * ld + sc;
      const bf16x8 va = ld8(Vh + ra), vb = ld8(Vh + rb), ka = ld8(Kh + ra), kb = ld8(Kh + rb);
      *(bf16x8*)(V_lds + vst0) = va; *(bf16x8*)(V_lds + vst1) = vb; const int kc = sc * 2;
      *(bf16x8*)(K_lds + KSWZ(sr, kc)) = ka; *(bf16x8*)(K_lds + KSWZ(32 + sr, kc)) = kb; }
    __syncthreads();
    if (t >= tlo && t <= tlo + 2) {
      f32x16 p0, p1;
      qkt<8>(p0, p1, K_lds, qr, r32, hi, 0);
#pragma unroll
      for (int r = 0; r < 16; ++r) { const int uk0 = kt0 + crow(r, hi), uk1 = uk0 + 32; const int d0 = uk0 - uq, d1 = uk1 - uq;
        const bool ok0 = (uk0 >= 0) && (uk0 < L) && (d0 >= -64) && (d0 <= 64), ok1 = (uk1 >= 0) && (uk1 < L) && (d1 >= -64) && (d1 <= 64);
        p0[r] = ok0 ? p0[r] : -1e30f; p1[r] = ok1 ? p1[r] : -1e30f; }
      float pmax = p0[0];
#pragma unroll
      for (int r = 1; r < 16; ++r) pmax = fmaxf(pmax, p0[r]);
#pragma unroll
      for (int r = 0; r < 16; ++r) pmax = fmaxf(pmax, p1[r]);
      { auto rr = __builtin_amdgcn_permlane32_swap(__float_as_uint(pmax), __float_as_uint(pmax), false, false);
        pmax = fmaxf(__uint_as_float(rr[0]), __uint_as_float(rr[1])); }
      const float mn = fmaxf(m_reg, pmax); const float alpha = __builtin_amdgcn_exp2f((m_reg - mn) * C); m_reg = mn;
      const float mnC = -mn * C;
#pragma unroll
      for (int r = 0; r < 16; ++r) { p0[r] = __builtin_amdgcn_exp2f(fmaf(p0[r], C, mnC)); p1[r] = fmaf(p1[r], C, mnC); }
      bf16x8 pa0, pa1, pa2, pa3;
      finishSM(p0, p1, alpha, l_reg, pa0, pa1, pa2, pa3);
      RESC(alpha);
      pv_d0(o, vb0, pa0, pa1, pa2, pa3);
    }
  }
  if (hi == 0) li_l[r32] = l_reg; asm volatile("s_waitcnt lgkmcnt(0)" ::: "memory");
  float rli[16];
#pragma unroll
  for (int r = 0; r < 16; ++r) rli[r] = __builtin_amdgcn_rcpf(li_l[crow(r, hi)]);
#pragma unroll
  for (int r = 0; r < 16; ++r) { const int uo = u0 + wid * 32 + crow(r, hi); float* orow = Oc + (long)(rho + dil * uo) * 512;
#pragma unroll
    for (int d0 = 0; d0 < 4; ++d0) orow[d0 * 32 + r32] = o[d0][r] * rli[r]; }
  if (hi == 0) lsep[(long)(rho + dil * uq) * 4] = m_reg * SCALE + __logf(l_reg);
}
#undef RESC
#undef KSWZ
#undef SBAR
}

struct Args { const float* in[N_INPUTS]; float* out; unsigned char* ws; int ph_lo, ph_hi; };
typedef const __attribute__((address_space(4))) Args* ArgsP;
struct Frame {
    LAS unsigned char* lds; volatile LAS unsigned* MISC; unsigned* ctl; unsigned char* ws;
    int tid, lane, wave, G, bid;
};
constexpr int PH_P0 = 0, PH_P1 = 1, PH_P2 = 2, PH_L0 = 3, NPH_L = 13, PH_FINAL = PH_L0 + DEPTH * NPH_L, NPHASES = PH_FINAL + 1;
enum { LP_NORM1 = 0, LP_G1, LP_PREP, LP_CPREP, LP_MIX, LP_POST, LP_G2, LP_NORM2, LP_GS, LP_GO, LP_NORM3, LP_M1, LP_M2 };

__device__ __forceinline__ int q_next(Frame& F, int q) {
    __syncthreads();
    if (F.tid == 0) F.MISC[0] = __hip_atomic_fetch_add(F.ctl + CW_Q + 64 * q, 1u, __ATOMIC_RELAXED, __HIP_MEMORY_SCOPE_AGENT);
    __syncthreads();
    return (int)F.MISC[0];
}

template <class RowMap>
__device__ __forceinline__ void transpose_item(const float* W, int ldn, bf16* WT, int ldt, RowMap rm, LAS float* scr, int k0, int n0, int lane) {
#pragma unroll 8
    for (int i = 0; i < 32; ++i) { const int kk = 2 * i + (lane >> 5); scr[kk * 33 + (lane & 31)] = W[(size_t)(k0 + kk) * ldn + n0 + (lane & 31)]; }
    LDS_WAIT(); asm volatile("" ::: "memory");
    const int c = lane & 7;
#pragma unroll
    for (int j = 0; j < 4; ++j) { const int n = (lane >> 3) + 8 * j; const LAS float* s = scr + (8 * c) * 33 + n;
        u32x4 o; o.x = pk2(s[0 * 33], s[1 * 33]); o.y = pk2(s[2 * 33], s[3 * 33]); o.z = pk2(s[4 * 33], s[5 * 33]); o.w = pk2(s[6 * 33], s[7 * 33]);
        *(u32x4*)(WT + (size_t)rm(n0 + n) * ldt + k0 + 8 * c) = o; }
    LDS_WAIT(); asm volatile("" ::: "memory");
}
struct RmId { __device__ __forceinline__ int operator()(int n) const { return n; } };
struct RmW13 { int off; __device__ __forceinline__ int operator()(int n) const { return 256 * (n >> 7) + off + (n & 127); } };

__device__ __forceinline__ void p0_prologue(Frame& F, ArgsP a) {
    unsigned char* ws = F.ws;
    LAS float* scr = (LAS float*)(F.lds + F.wave * 16384);
    const int gw = F.bid * 8 + F.wave, NGW = F.G * 8;
    constexpr int I_WIN = (DM / 64) * (IN_TOTAL / 32), I_SQ = (DM / 64) * (DM / 32), I_WKV = (DM / 64) * (4096 / 32), I_W1 = (DM / 64) * (DEXP / 32), I_W2 = (DEXP / 64) * (DM / 32);
    constexpr int PER_L = I_WIN + I_SQ + I_WKV + I_SQ + NEXP * (2 * I_W1 + I_W2);
    for (int it = gw; it < DEPTH * PER_L; it += NGW) {
        const int l = it / PER_L; int r = it % PER_L;
        if (r < I_WIN) { const int nb = IN_TOTAL / 32; transpose_item(a->in[I_W_IN] + (size_t)l * DM * IN_TOTAL, IN_TOTAL, (bf16*)(ws + WS_WIN) + (size_t)l * ZLD * DM, DM, RmId{}, scr, 64 * (r / nb), 32 * (r % nb), F.lane); continue; } r -= I_WIN;
        if (r < I_SQ) { const int nb = DM / 32; transpose_item(a->in[I_W_OUT] + (size_t)l * DM * DM, DM, (bf16*)(ws + WS_WOUT) + (size_t)l * DM * DM, DM, RmId{}, scr, 64 * (r / nb), 32 * (r % nb), F.lane); continue; } r -= I_SQ;
        if (r < I_WKV) { const int nb = 4096 / 32; transpose_item(a->in[I_XA_WKV] + (size_t)l * DM * 4096, 4096, (bf16*)(ws + SC_WKVT) + (size_t)l * 4096 * DM, DM, RmId{}, scr, 64 * (r / nb), 32 * (r % nb), F.lane); continue; } r -= I_WKV;
        if (r < I_SQ) { const int nb = DM / 32; transpose_item(a->in[I_XA_WO] + (size_t)l * DM * DM, DM, (bf16*)(ws + SC_WOT) + (size_t)l * DM * DM, DM, RmId{}, scr, 64 * (r / nb), 32 * (r % nb), F.lane); continue; } r -= I_SQ;
        const int e = r / (2 * I_W1 + I_W2); r = r % (2 * I_W1 + I_W2);
        const size_t le = (size_t)l * NEXP + e;
        if (r < I_W1) { const int nb = DEXP / 32; transpose_item(a->in[I_MOE_W1] + le * DM * DEXP, DEXP, (bf16*)(ws + WS_W13) + le * 1024 * DM, DM, RmW13{0}, scr, 64 * (r / nb), 32 * (r % nb), F.lane); continue; } r -= I_W1;
        if (r < I_W1) { const int nb = DEXP / 32; transpose_item(a->in[I_MOE_W3] + le * DM * DEXP, DEXP, (bf16*)(ws + WS_W13) + le * 1024 * DM, DM, RmW13{128}, scr, 64 * (r / nb), 32 * (r % nb), F.lane); continue; } r -= I_W1;
        { const int nb = DM / 32; transpose_item(a->in[I_MOE_W2] + le * DEXP * DM, DM, (bf16*)(ws + WS_W2) + le * DM * DEXP, DEXP, RmId{}, scr, 64 * (r / nb), 32 * (r % nb), F.lane); }
    }
    const int gt = F.bid * 512 + F.tid, NGT = F.G * 512;
    for (int i = gt; i < DEPTH * (ZLD - IN_TOTAL) * DM / 8; i += NGT) { const int l = i / ((ZLD - IN_TOTAL) * DM / 8), r = i % ((ZLD - IN_TOTAL) * DM / 8);
        *(u32x4*)((bf16*)(ws + WS_WIN) + (size_t)l * ZLD * DM + (size_t)IN_TOTAL * DM + (size_t)r * 8) = (u32x4){0u, 0u, 0u, 0u}; }
    for (int i = gt; i < DEPTH * DM * DM / 8; i += NGT) { const f32x4 x0 = *(const f32x4*)(a->in[I_XA_WQ] + (size_t)i * 8), x1 = *(const f32x4*)(a->in[I_XA_WQ] + (size_t)i * 8 + 4);
        u32x4 o; o.x = pk2(x0[0], x0[1]); o.y = pk2(x0[2], x0[3]); o.z = pk2(x1[0], x1[1]); o.w = pk2(x1[2], x1[3]); *(u32x4*)((bf16*)(ws + SC_WQB) + (size_t)i * 8) = o; }
    { float* cosA = (float*)(ws + WS_ROPE); float* sinA = cosA + SEQ * 32; float* cosC = sinA + SEQ * 32; float* sinC = cosC + SEQ * 64;
      for (int i = gt; i < SEQ * 96; i += NGT) { const int s = i / 96, j = i % 96; const bool isA = j < 32; const int jj = isA ? j : j - 32; const float dim = isA ? 64.f : 128.f;
          const float inv = 1.0f / powf(10000.0f, (float)(2 * jj) / dim); const float ang = (float)s * inv; float sn, cs; sincosf(ang, &sn, &cs);
          if (isA) { cosA[s * 32 + jj] = cs; sinA[s * 32 + jj] = sn; } else { cosC[s * 64 + jj] = cs; sinC[s * 64 + jj] = sn; } } }
    for (int i = gt; i < DEPTH * 2 * 32 * 64; i += NGT) { const int l = i / (2 * 32 * 64), r = i % (2 * 32 * 64), dir = r / (32 * 64), g = (r / 64) % 32, n = r % 64;
        float* ab = (float*)(ws + WS_S5P + l * S5P_LAYER); float* bb = ab + 2 * 32 * 64 * 2;
        const size_t pi = (((size_t)l * 2 + dir) * 32 + g) * 64 + n;
        const float lr = fminf(a->in[I_S5_A_RE][pi], -1e-4f), li = a->in[I_S5_A_IM][pi], dt = __expf(a->in[I_S5_LOG_DT][((size_t)l * 2 + dir) * 32 + g]);
        const float mag = __expf(dt * lr); float sn, cs; sincosf(dt * li, &sn, &cs); const float abr = mag * cs, abi = mag * sn;
        const float den = lr * lr + li * li; const float ir = lr / den, ii = -li / den;
        const float fr_ = (abr - 1.f) * ir - abi * ii, fi_ = (abr - 1.f) * ii + abi * ir;
        ab[(size_t)r * 2] = abr; ab[(size_t)r * 2 + 1] = abi;
        { float* ab256 = bb + 2 * 32 * 64 * 16 * 2; const float m256 = __expf(256.f * dt * lr); float s2, c2; sincosf(256.f * dt * li, &s2, &c2); ab256[(size_t)r * 2] = m256 * c2; ab256[(size_t)r * 2 + 1] = m256 * s2; }
        const size_t bi = (((size_t)l * 32 + g) * 64 + n) * 16;
#pragma unroll
        for (int c = 0; c < 16; ++c) { const float br = a->in[I_S5_B_RE][bi + c], bim = a->in[I_S5_B_IM][bi + c];
            bb[((size_t)r * 16 + c) * 2] = fr_ * br - fi_ * bim; bb[((size_t)r * 16 + c) * 2 + 1] = fr_ * bim + fi_ * br; } }
    for (int it = gw; it < DEPTH * BATCH * NMEM; it += NGW) { const int l = it / (BATCH * NMEM), row = it % (BATCH * NMEM);
        const f32x4* xr = (const f32x4*)(a->in[I_MEM] + (size_t)row * DM) + F.lane; const f32x4* gr = (const f32x4*)(a->in[I_NORM_MEM] + (size_t)l * DM) + F.lane;
        f32x4 v[8]; float s = 0.f;
#pragma unroll
        for (int j = 0; j < 8; ++j) { v[j] = xr[64 * j]; s += (v[j].x * v[j].x + v[j].y * v[j].y) + (v[j].z * v[j].z + v[j].w * v[j].w); }
        const float rstd = 1.f / sqrtf(wave_sum(s) * (1.f / DM) + RMS_EPS);
        u32x2* o8 = (u32x2*)((bf16*)(ws + SC_MEMN) + ((size_t)l * 512 + row) * DM) + F.lane;
#pragma unroll
        for (int j = 0; j < 8; ++j) { const f32x4 gv = gr[64 * j]; u32x2 w; w.x = pk2(v[j].x * rstd * gv.x, v[j].y * rstd * gv.y); w.y = pk2(v[j].z * rstd * gv.z, v[j].w * rstd * gv.w); o8[64 * j] = w; } }
}

struct SchedDense { const char* A; const char* B; char* C; int nM, nN, G, c, lda, ldb, ldcb  , cesz  ;
    __device__ __forceinline__ bool next(int i, pg8::Unit& u) const { const long L = (long)i * G + c; if (L >= (long)nM * nN) return false; int pm, pn; pg8::xcd_tile((int)L, nM, nN, pm, pn);
        u.A = A + (size_t)pm * 256 * lda * 2; u.B = B + (size_t)pn * 256 * ldb * 2; u.C = C + (size_t)pm * 256 * ldcb + (size_t)pn * 256 * cesz; u.row0 = pm * 256; u.col0 = pn * 256; u.aux = 0; return true; }
    __device__ __forceinline__ int arow(const pg8::Unit&, int r) const { return r; } };
struct SchedBatch { const char* A; const char* B; char* C; size_t sA, sB, sC; int nM, nN, nb, G, c, lda, ldb, ldcb, cesz, rowsPerBatch;
    __device__ __forceinline__ bool next(int i, pg8::Unit& u) const { const long L = (long)i * G + c; const int per = nM * nN; if (L >= (long)per * nb) return false; const int b = (int)(L / per), r = (int)(L % per), pm = r / nN, pn = r % nN;
        u.A = A + b * sA + (size_t)pm * 256 * lda * 2; u.B = B + b * sB + (size_t)pn * 256 * ldb * 2; u.C = C + b * sC + (size_t)pm * 256 * ldcb + (size_t)pn * 256 * cesz; u.row0 = b * rowsPerBatch + pm * 256; u.col0 = pn * 256; u.aux = b; return true; }
    __device__ __forceinline__ int arow(const pg8::Unit&, int r) const { return r; } };
struct SchedXaPre { unsigned char* ws; int G, c, kind;
    __device__ __forceinline__ bool next(int i, pg8::Unit& u) const { const long L = (long)i * G + c; if (L >= 128) return false; const int r = (int)L, p = r >> 3, t = r & 7, l = p >> 3, b = (p >> 2) & 1, h = p & 3;
        const bf16* kvb = (const bf16*)(ws + SC_KVB) + (size_t)l * 512 * 4096 + (size_t)(b * 256) * 4096;
        if (kind == 0) { u.A = (const char*)(kvb + h * 512); u.B = (const char*)((const bf16*)(ws + SC_WQB) + (size_t)l * DM * DM + (size_t)(t * 256) * DM + h * 512);
            u.C = (char*)((bf16*)(ws + WS_WQK) + ((size_t)(l * 2 + b) * 1024 + h * 256) * DM + t * 256); u.aux = DM; }
        else { u.A = (const char*)((const bf16*)(ws + SC_WOT) + (size_t)l * DM * DM + (size_t)(t * 256) * DM + h * 512); u.B = (const char*)(kvb + 2048 + h * 512);
            u.C = (char*)((bf16*)(ws + WS_VWO) + ((size_t)(l * 2 + b) * DM + t * 256) * 1024 + h * 256); u.aux = 1024; }
        u.row0 = 0; u.col0 = 0; return true; }
    __device__ __forceinline__ int arow(const pg8::Unit&, int r) const { return r; } };
struct EpiBf16U { static constexpr bool PERM = true, AFTER_DRAIN = false;
    __device__ __forceinline__ void operator()(const pg8::Acc& acc, const pg8::Unit& u, int wr, int wc, int fr, int fq) const { pg8::EpiBf16 e{u.aux}; e(acc, u, wr, wc, fr, fq); } };
struct SchedMoe { unsigned char* ws; const volatile LAS int* tp; const volatile LAS int* cnt; int layer, G, c, which;
    __device__ __forceinline__ bool next(int i, pg8::Unit& u) const {
        const int npn = which == 0 ? 4 : 8; const long L = (long)i * G + c; const int ntile = tp[32]; if (L >= (long)ntile * npn) return false;
        const int mt = (int)(L / npn), pn = (int)(L % npn); int e = 0;
#pragma unroll 1
        for (int k = 1; k < 32; ++k) e += (mt >= tp[k]) ? 1 : 0;
        const int lt = mt - tp[e]; const int nvalid = min(256, cnt[e] - lt * 256);
        u.row0 = lt * 256; u.col0 = pn * 256; u.aux = (e << 16) | nvalid;
        if (which == 0) { u.A = (const char*)(ws + WS_HN); u.B = (const char*)((const bf16*)(ws + WS_W13) + ((size_t)(layer * NEXP + e) * 1024 + pn * 256) * DM);
            u.C = (char*)((bf16*)(ws + SC_HMID) + (size_t)(mt * 256) * DEXP + pn * 128); }
        else { u.A = (const char*)((const bf16*)(ws + SC_HMID) + (size_t)(mt * 256) * DEXP); u.B = (const char*)((const bf16*)(ws + WS_W2) + ((size_t)(layer * NEXP + e) * DM + pn * 256) * DEXP);
            u.C = (char*)((bf16*)(ws + SC_YBUF) + (size_t)(mt * 256) * DM + pn * 256); }
        return true; }
    __device__ __forceinline__ int arow(const pg8::Unit& u, int r) const { const int e = u.aux >> 16, nvalid = u.aux & 0xffff; const int idx = (r < nvalid) ? (u.row0 + r) : u.row0;
        return ((const int*)(ws + WS_ETOK))[(size_t)e * ECAP + idx]; } };

__device__ __forceinline__ void moe_prefix(Frame& F, int layer, volatile LAS int* tp, volatile LAS int* cnt) {
    __syncthreads();
    if (F.tid < 32) cnt[F.tid] = (int)__hip_atomic_load(F.ctl + CW_CNT + layer * 64 + F.tid, __ATOMIC_RELAXED, __HIP_MEMORY_SCOPE_AGENT);
    __syncthreads();
    if (F.tid == 0) { int s = 0; for (int e = 0; e < 32; ++e) { tp[e] = s; s += (cnt[e] + 255) >> 8; } tp[32] = s; }
    __syncthreads();
}
template <int MODE>
__device__ __forceinline__ void norm_phase(Frame& F, ArgsP a, const float* src, const float* gain, int layer) {
    unsigned char* ws = F.ws; float* H = (float*)(ws + WS_H); bf16* HN = (bf16*)(ws + WS_HN);
    volatile LAS int* tp = (volatile LAS int*)(F.lds + 1024); volatile LAS int* cnt = tp + 40;
    if (MODE & 1) moe_prefix(F, layer - 1, tp, cnt);
    const int gw = F.bid * 8 + F.wave, NGW = F.G * 8;
    const f32x4* gr = (const f32x4*)gain + F.lane;
    for (int row = gw; row < NTOK; row += NGW) {
        const f32x4* xr = (const f32x4*)(src + (size_t)row * DM) + F.lane;
        f32x4 v[8];
#pragma unroll
        for (int j = 0; j < 8; ++j) v[j] = xr[64 * j];
        if (MODE & 1) {
            const int* ti = (const int*)(ws + WS_TINFO) + (size_t)row * 4;
            const int e0 = ti[0], p0 = ti[1], e1 = ti[2], p1 = ti[3];
            const size_t s0 = (size_t)tp[e0] * 256 + p0, s1 = (size_t)tp[e1] * 256 + p1;
            const u32x2* y0 = (const u32x2*)((const bf16*)(ws + SC_YBUF) + s0 * DM) + F.lane; const u32x2* y1 = (const u32x2*)((const bf16*)(ws + SC_YBUF) + s1 * DM) + F.lane;
#pragma unroll
            for (int j = 0; j < 8; ++j) { const u32x2 a0 = y0[64 * j], a1 = y1[64 * j];
                v[j].x += __uint_as_float(a0.x << 16) + __uint_as_float(a1.x << 16); v[j].y += __uint_as_float(a0.x & 0xffff0000u) + __uint_as_float(a1.x & 0xffff0000u);
                v[j].z += __uint_as_float(a0.y << 16) + __uint_as_float(a1.y << 16); v[j].w += __uint_as_float(a0.y & 0xffff0000u) + __uint_as_float(a1.y & 0xffff0000u); }
            if (!(MODE & 4)) { f32x4* hr = (f32x4*)(H + (size_t)row * DM) + F.lane;
#pragma unroll
                for (int j = 0; j < 8; ++j) hr[64 * j] = v[j]; }
        }
        float s = 0.f;
#pragma unroll
        for (int j = 0; j < 8; ++j) s += (v[j].x * v[j].x + v[j].y * v[j].y) + (v[j].z * v[j].z + v[j].w * v[j].w);
        const float rstd = 1.f / sqrtf(wave_sum(s) * (1.f / DM) + RMS_EPS);
#pragma unroll
        for (int j = 0; j < 8; ++j) { const f32x4 gv = gr[64 * j]; v[j].x *= rstd * gv.x; v[j].y *= rstd * gv.y; v[j].z *= rstd * gv.z; v[j].w *= rstd * gv.w; }
        if (MODE & 4) { f32x4* orow = (f32x4*)(a->out + (size_t)row * DM) + F.lane;
#ifdef DBG_RWCHK
            { const float* cw = (const float*)(F.ctl + 32768); const unsigned* cu = (const unsigned*)cw; const float sc = cu[DBG_RWCHK * 64 + 2] ? 1001.f : 1.f + fminf(cw[DBG_RWCHK * 64] / cw[DBG_RWCHK * 64 + 1], 100.f);
#pragma unroll
              for (int j = 0; j < 8; ++j) v[j] *= sc; }
#endif
#pragma unroll
            for (int j = 0; j < 8; ++j) orow[64 * j] = v[j]; }
        else { u32x2* o8 = (u32x2*)(HN + (size_t)row * DM) + F.lane;
#pragma unroll
            for (int j = 0; j < 8; ++j) { u32x2 w; w.x = pk2(v[j].x, v[j].y); w.y = pk2(v[j].z, v[j].w); o8[64 * j] = w; } }
        if (MODE & 2) {
            const float* wg = a->in[I_ROUTER_GROUP] + (size_t)layer * DM * 4; const float* we = a->in[I_ROUTER_EXPERT] + (size_t)layer * DM * 32;
            float lg[4] = {0.f, 0.f, 0.f, 0.f};
#pragma unroll 2
            for (int j = 0; j < 8; ++j) { const int k0 = (64 * j + F.lane) * 4;
#pragma unroll
                for (int q = 0; q < 4; ++q) { const f32x4 w4 = *(const f32x4*)(wg + (size_t)(k0 + q) * 4); const float x = v[j][q]; lg[0] += x * w4.x; lg[1] += x * w4.y; lg[2] += x * w4.z; lg[3] += x * w4.w; } }
#pragma unroll
            for (int q = 0; q < 4; ++q) lg[q] = wave_sum(lg[q]);
            int gi = 0; float gm = lg[0];
#pragma unroll
            for (int q = 1; q < 4; ++q) if (lg[q] > gm) { gm = lg[q]; gi = q; }
            const float gw_ = 1.f / (__expf(lg[0] - gm) + __expf(lg[1] - gm) + __expf(lg[2] - gm) + __expf(lg[3] - gm));
            float le[8] = {0.f, 0.f, 0.f, 0.f, 0.f, 0.f, 0.f, 0.f};
#pragma unroll 2
            for (int j = 0; j < 8; ++j) { const int k0 = (64 * j + F.lane) * 4;
#pragma unroll
                for (int q = 0; q < 4; ++q) { const float* wp = we + (size_t)(k0 + q) * 32 + gi * 8; const f32x4 wa = *(const f32x4*)wp, wb = *(const f32x4*)(wp + 4); const float x = v[j][q];
                    le[0] += x * wa.x; le[1] += x * wa.y; le[2] += x * wa.z; le[3] += x * wa.w; le[4] += x * wb.x; le[5] += x * wb.y; le[6] += x * wb.z; le[7] += x * wb.w; } }
#pragma unroll
            for (int q = 0; q < 8; ++q) le[q] = wave_sum(le[q]);
            int i0 = 0; float m0 = le[0];
#pragma unroll
            for (int q = 1; q < 8; ++q) if (le[q] > m0) { m0 = le[q]; i0 = q; }
            int i1 = -1; float m1 = -3.0e38f;
#pragma unroll
            for (int q = 0; q < 8; ++q) if (q != i0 && le[q] > m1) { m1 = le[q]; i1 = q; }
            const float t = __expf(m1 - m0); const float w0 = 1.f / (1.f + t), w1 = t / (1.f + t);
            if (F.lane == 0) {
                const int e0 = gi * 8 + i0, e1 = gi * 8 + i1;
                const int p0 = (int)__hip_atomic_fetch_add(F.ctl + CW_CNT + layer * 64 + e0, 1u, __ATOMIC_RELAXED, __HIP_MEMORY_SCOPE_AGENT);
                const int p1 = (int)__hip_atomic_fetch_add(F.ctl + CW_CNT + layer * 64 + e1, 1u, __ATOMIC_RELAXED, __HIP_MEMORY_SCOPE_AGENT);
                int* et = (int*)(ws + WS_ETOK); float* eg = (float*)(ws + WS_EGATE); int* ti = (int*)(ws + WS_TINFO) + (size_t)row * 4;
                et[(size_t)e0 * ECAP + p0] = row; eg[(size_t)e0 * ECAP + p0] = gw_ * w0; et[(size_t)e1 * ECAP + p1] = row; eg[(size_t)e1 * ECAP + p1] = gw_ * w1;
                ti[0] = e0; ti[1] = p0; ti[2] = e1; ti[3] = p1;
            }
        }
    }
}

__device__ __forceinline__ void rope_token(Frame& F, bf16* zrow, int s) {
    const float* cosA = (const float*)(F.ws + WS_ROPE); const float* sinA = cosA + SEQ * 32; const float* cosC = sinA + SEQ * 32; const float* sinC = cosC + SEQ * 64;
    { const int i = F.lane & 31; const float cs = cosA[s * 32 + i], sn = sinA[s * 32 + i];
#pragma unroll
      for (int it = 0; it < 8; ++it) { bf16* p = zrow + ZA + (it * 2 + (F.lane >> 5)) * 64; const float x1 = bf2f(p[i]), x2 = bf2f(p[i + 32]); p[i] = f2bf(x1 * cs - x2 * sn); p[i + 32] = f2bf(x2 * cs + x1 * sn); } }
    { const int i = F.lane; const float cs = cosC[s * 64 + i], sn = sinC[s * 64 + i];
#pragma unroll
      for (int it = 0; it < 8; ++it) { bf16* p = zrow + ZC + it * 128; const float x1 = bf2f(p[i]), x2 = bf2f(p[i + 64]); p[i] = f2bf(x1 * cs - x2 * sn); p[i + 64] = f2bf(x2 * cs + x1 * sn); } }
}

constexpr int RWT = 8;
__device__ __forceinline__ void rwkv_prep_tile(Frame& F, ArgsP a, int layer, int tile) {
    unsigned char* ws = F.ws; const bf16* Z = (const bf16*)(ws + SC_Z);
    LAS float* zr = (LAS float*)F.lds; LAS float* act = zr + (RWT + 2) * IN_B;
    const int t0 = tile * RWT; const int b = t0 / SEQ, s0 = t0 % SEQ;
    __syncthreads();
    for (int i = F.tid; i < (RWT + 2) * (IN_B / 8); i += 512) { const int rr = i / (IN_B / 8), c8 = i % (IN_B / 8); const int s = s0 - 1 + rr;
        f32x4 lo = {0.f, 0.f, 0.f, 0.f}, hi = {0.f, 0.f, 0.f, 0.f};
        if (s >= 0 && s < SEQ) { const u32x4 w = *(const u32x4*)(Z + (size_t)(b * SEQ + s) * ZLD + ZB + c8 * 8);
            lo = (f32x4){__uint_as_float(w.x << 16), __uint_as_float(w.x & 0xffff0000u), __uint_as_float(w.y << 16), __uint_as_float(w.y & 0xffff0000u)};
            hi = (f32x4){__uint_as_float(w.z << 16), __uint_as_float(w.z & 0xffff0000u), __uint_as_float(w.w << 16), __uint_as_float(w.w & 0xffff0000u)}; }
        *(LAS f32x4*)(zr + rr * IN_B + c8 * 8) = lo; *(LAS f32x4*)(zr + rr * IN_B + c8 * 8 + 4) = hi; }
    __syncthreads();
    const float* mu = a->in[I_RWKV_MU] + (size_t)layer * 2 * IN_B;
#define ZS(t, col) (zr[((t) + 1) * IN_B + (col)] + mu[(col)] * (zr[(t) * IN_B + (col)] - zr[((t) + 1) * IN_B + (col)]) + mu[IN_B + (col)] * (zr[((t) + 2) * IN_B + (col)] - zr[((t) + 1) * IN_B + (col)]))
    for (int i = F.tid; i < RWT * 384; i += 512) { const int t = i / 384, j = i % 384; const int col = 1536 + j; const float x = ZS(t, col);
        act[t * 384 + j] = (j < 128) ? tanhf(x) : ((j < 256) ? x : sigmoidf_(x)); }
    __syncthreads();
    const int c = F.tid;
    float aw0[RWT], aw1[RWT], aa0[RWT], aa1[RWT], ag[RWT];
#pragma unroll
    for (int t = 0; t < RWT; ++t) { aw0[t] = 0.f; aw1[t] = 0.f; aa0[t] = 0.f; aa1[t] = 0.f; ag[t] = 0.f; }
    const float* w2 = a->in[I_RWKV_W2] + (size_t)layer * 2 * 64 * 512; const float* a2 = a->in[I_RWKV_A2] + (size_t)layer * 2 * 64 * 512; const float* g2 = a->in[I_RWKV_G2] + (size_t)layer * 128 * 512;
#pragma unroll 1
    for (int r = 0; r < 64; r += 4) {
        float wv0[4], wv1[4], av0[4], av1[4];
#pragma unroll
        for (int q = 0; q < 4; ++q) { wv0[q] = w2[(size_t)(r + q) * 512 + c]; wv1[q] = w2[(size_t)(64 + r + q) * 512 + c]; av0[q] = a2[(size_t)(r + q) * 512 + c]; av1[q] = a2[(size_t)(64 + r + q) * 512 + c]; }
#pragma unroll
        for (int t = 0; t < RWT; ++t) { const f32x4 x0 = *(const LAS f32x4*)(act + t * 384 + r), x1 = *(const LAS f32x4*)(act + t * 384 + 64 + r), y0 = *(const LAS f32x4*)(act + t * 384 + 128 + r), y1 = *(const LAS f32x4*)(act + t * 384 + 192 + r);
#pragma unroll
            for (int q = 0; q < 4; ++q) { aw0[t] += x0[q] * wv0[q]; aw1[t] += x1[q] * wv1[q]; aa0[t] += y0[q] * av0[q]; aa1[t] += y1[q] * av1[q]; } }
    }
#pragma unroll 1
    for (int r = 0; r < 128; r += 4) {
        float gv[4];
#pragma unroll
        for (int q = 0; q < 4; ++q) gv[q] = g2[(size_t)(r + q) * 512 + c];
#pragma unroll
        for (int t = 0; t < RWT; ++t) { const f32x4 x = *(const LAS f32x4*)(act + t * 384 + 256 + r);
#pragma unroll
            for (int q = 0; q < 4; ++q) ag[t] += x[q] * gv[q]; }
    }
    const float w00 = a->in[I_RWKV_W0][(size_t)layer * 1024 + c], w01 = a->in[I_RWKV_W0][(size_t)layer * 1024 + 512 + c];
    const float a00 = a->in[I_RWKV_A0][(size_t)layer * 1024 + c], a01 = a->in[I_RWKV_A0][(size_t)layer * 1024 + 512 + c];
    const float kkw = a->in[I_RWKV_KK][(size_t)layer * 512 + c], kaw = a->in[I_RWKV_KA][(size_t)layer * 512 + c];
    float* RW = (float*)(ws + SC_RW); const size_t N1 = (size_t)NTOK * 512;
#pragma unroll
    for (int t = 0; t < RWT; ++t) {
        const float r_ = ZS(t, c), k_ = ZS(t, 512 + c), v_ = ZS(t, 1024 + c);
        const float x0 = -(w00 + aw0[t]), x1 = -(w01 + aw1[t]);
        const float sp0 = fmaxf(x0, 0.f) + log1pf(__expf(-fabsf(x0))), sp1 = fmaxf(x1, 0.f) + log1pf(__expf(-fabsf(x1)));
        const float d0 = -__expf(-sp0 - 0.5f), d1 = -__expf(-sp1 - 0.5f);
        const float al0 = sigmoidf_(a00 + aa0[t]), al1 = sigmoidf_(a01 + aa1[t]);
        float kk = k_ * kkw; const float ssq = wave_sum(kk * kk); kk *= 1.f / sqrtf(ssq + 1e-12f);
        const float km0 = k_ * (1.f + (al0 - 1.f) * kaw), km1 = k_ * (1.f + (al1 - 1.f) * kaw);
        const size_t o = (size_t)(t0 + t) * 512 + c;
        RW[0 * N1 + o] = r_; RW[1 * N1 + o] = v_; RW[2 * N1 + o] = kk; RW[3 * N1 + o] = d0; RW[4 * N1 + o] = d1;
        RW[5 * N1 + o] = km0; RW[6 * N1 + o] = km1; RW[7 * N1 + o] = kk * al0; RW[8 * N1 + o] = kk * al1; RW[9 * N1 + o] = ag[t];
    }
#undef ZS
}

constexpr size_t SC_S5E = SC_MIX_END + (size_t)32 * 256 * 11520;
constexpr size_t SC_MIX_END3 = SC_S5E + (size_t)2 * BATCH * 16 * 32 * 64 * 2 * 4;
template <int LEVEL>
__device__ __forceinline__ void s5_block_task(Frame& F, int layer, int task, LAS float* ul) {
    unsigned char* ws = F.ws; const bf16* Z = (const bf16*)(ws + SC_Z);
    const int blk = task & 15, dir = (task >> 4) & 1, g = (task >> 5) & 31, b = task >> 10; const int n = F.lane;
    const float* ab = (const float*)(ws + WS_S5P + layer * S5P_LAYER); const float* bb = ab + 2 * 32 * 64 * 2; const float* ab256 = bb + 2 * 32 * 64 * 16 * 2;
    const int pr = (dir * 32 + g) * 64 + n;
    const float abr = ab[pr * 2], abi = ab[pr * 2 + 1];
    float bbr[16], bbi[16];
#pragma unroll
    for (int c = 0; c < 16; ++c) { bbr[c] = bb[((size_t)pr * 16 + c) * 2]; bbi[c] = bb[((size_t)pr * 16 + c) * 2 + 1]; }
    float* E = (float*)(ws + SC_S5E);
    float xr = 0.f, xi = 0.f;
    if (LEVEL == 2) { const float pr_ = ab256[pr * 2], pi_ = ab256[pr * 2 + 1];
        for (int k = 0; k < blk; ++k) { const float* ep = E + ((((size_t)dir * BATCH + b) * 16 + k) * 32 + g) * 128 + n * 2; const float er = ep[0], ei = ep[1];
            const float nr = pr_ * xr - pi_ * xi + er, ni = pr_ * xi + pi_ * xr + ei; xr = nr; xi = ni; } }
    float* carry = (float*)(ws + SC_CARRY);
    for (int q4 = 0; q4 < 4; ++q4) {
        { const int st = blk * 256 + q4 * 64 + n; const int sl = dir ? (SEQ - 1 - st) : st; const bf16* zp = Z + (size_t)(b * SEQ + sl) * ZLD + ZD + g * 16;
          const u32x4 w0 = *(const u32x4*)zp, w1 = *(const u32x4*)(zp + 8);
          LAS f32x4* d = (LAS f32x4*)(ul + n * 16);
          d[0] = (f32x4){__uint_as_float(w0.x << 16), __uint_as_float(w0.x & 0xffff0000u), __uint_as_float(w0.y << 16), __uint_as_float(w0.y & 0xffff0000u)};
          d[1] = (f32x4){__uint_as_float(w0.z << 16), __uint_as_float(w0.z & 0xffff0000u), __uint_as_float(w0.w << 16), __uint_as_float(w0.w & 0xffff0000u)};
          d[2] = (f32x4){__uint_as_float(w1.x << 16), __uint_as_float(w1.x & 0xffff0000u), __uint_as_float(w1.y << 16), __uint_as_float(w1.y & 0xffff0000u)};
          d[3] = (f32x4){__uint_as_float(w1.z << 16), __uint_as_float(w1.z & 0xffff0000u), __uint_as_float(w1.w << 16), __uint_as_float(w1.w & 0xffff0000u)}; }
        LDS_WAIT(); asm volatile("" ::: "memory");
#pragma unroll 4
        for (int i = 0; i < 64; ++i) {
            const int step = blk * 256 + q4 * 64 + i;
            if (LEVEL == 2 && (step & (S5CH - 1)) == 0) { const int sl = dir ? (SEQ - 1 - step) : step; const int ch = sl / S5CH;
                float* cp = carry + ((((size_t)dir * BATCH + b) * S5NCH + ch) * 32 + g) * 128 + n * 2; cp[0] = xr; cp[1] = xi; }
            const f32x4 u0 = *(const LAS f32x4*)(ul + i * 16), u1 = *(const LAS f32x4*)(ul + i * 16 + 4), u2 = *(const LAS f32x4*)(ul + i * 16 + 8), u3 = *(const LAS f32x4*)(ul + i * 16 + 12);
            float br = 0.f, bi = 0.f;
#pragma unroll
            for (int c = 0; c < 4; ++c) { br += bbr[c] * u0[c] + bbr[4 + c] * u1[c] + bbr[8 + c] * u2[c] + bbr[12 + c] * u3[c]; bi += bbi[c] * u0[c] + bbi[4 + c] * u1[c] + bbi[8 + c] * u2[c] + bbi[12 + c] * u3[c]; }
            const float nr = abr * xr - abi * xi + br, ni = abr * xi + abi * xr + bi; xr = nr; xi = ni;
        }
        asm volatile("" ::: "memory");
    }
    if (LEVEL == 1) { float* ep = E + ((((size_t)dir * BATCH + b) * 16 + blk) * 32 + g) * 128 + n * 2; ep[0] = xr; ep[1] = xi; }
}

__device__ __forceinline__ void prep_phase(Frame& F, ArgsP a, int layer, const int rep) {
    const int q = (rep * 2 + layer) * 8 + 0;
    for (;;) { const int it = q_next(F, q);
        if (it < 256) { s5_block_task<1>(F, layer, it * 8 + F.wave, (LAS float*)(F.lds + F.wave * 4096)); continue; }
        if (it < 256 + NTOK / RWT) { rwkv_prep_tile(F, a, layer, it - 256); continue; }
        const int r = it - 256 - NTOK / RWT; if (r >= NTOK / 64 || rep > 0) break;
        for (int k = 0; k < 8; ++k) { const int tok = r * 64 + F.wave * 8 + k; rope_token(F, (bf16*)(F.ws + SC_Z) + (size_t)tok * ZLD, tok % SEQ); }
    }
}

constexpr int CR_TA = 0, CR_GH = 2048, CR_WBK = 4096, CR_TM = 8192, CR_N = 8704, CR_V = 9216, CR_WL = 11264, CR_BYTES = 11520;
constexpr size_t SC_CREC = SC_MIX_END;
constexpr size_t SC_MIX_END2 = SC_CREC + (size_t)32 * 256 * CR_BYTES;
static_assert(SC_MIX_END2 <= 1140000000ull, "workspace budget");

__device__ __forceinline__ void mm16(const LAS float* A, const LAS float* B, int t, int sq, float (&out)[4]) {
    out[0] = out[1] = out[2] = out[3] = 0.f;
#pragma unroll
    for (int s4 = 0; s4 < 4; ++s4) { const f32x4 a4 = *(const LAS f32x4*)(A + t * 16 + s4 * 4);
#pragma unroll
        for (int q = 0; q < 4; ++q) { const f32x4 b4 = *(const LAS f32x4*)(B + (s4 * 4 + q) * 16 + sq * 4); const float av = a4[q];
            out[0] += av * b4[0]; out[1] += av * b4[1]; out[2] += av * b4[2]; out[3] += av * b4[3]; } }
}
__device__ __forceinline__ void st16(LAS float* M, int t, int sq, const float (&v)[4]) { *(LAS f32x4*)(M + t * 16 + sq * 4) = (f32x4){v[0], v[1], v[2], v[3]}; }

__device__ __forceinline__ void rwkv_cprep_item(Frame& F, int chain, int c, LAS float* Lw) {
    unsigned char* ws = F.ws; const float* RW = (const float*)(ws + SC_RW); const size_t N1 = (size_t)NTOK * 512;
    const int dir = chain & 1, h = (chain >> 1) & 7, b = chain >> 4; const int lane = F.lane;
    const float* Rp = RW; const float* Vp = RW + N1; const float* KKp = RW + 2 * N1; const float* LDp = RW + (3 + dir) * N1; const float* KMp = RW + (5 + dir) * N1; const float* BBp = RW + (7 + dir) * N1;
    LAS float* At = Lw; LAS float* Bt = Lw + 1024; LAS float* Kt = Lw + 2048; LAS float* mat = Lw + 3072;
    float at[16], rt[16], wb[16], wk[16], vv[16];
    { float lw = 0.f, lwi[16], bb[16], km[16];
#pragma unroll
      for (int t = 0; t < 16; ++t) { const int pos = dir ? (SEQ - 1 - 16 * c - t) : (16 * c + t); const size_t idx = (size_t)(b * SEQ + pos) * 512 + h * 64 + lane;
          const float r_ = Rp[idx], ld = LDp[idx], a_ = -KKp[idx]; km[t] = KMp[idx]; bb[t] = BBp[idx]; vv[t] = Vp[idx];
          at[t] = a_ * __expf(lw); lw += ld; lwi[t] = lw; rt[t] = r_ * __expf(lw);
          const float iw = __expf(-lw); At[t * 64 + lane] = at[t]; Bt[t * 64 + lane] = bb[t] * iw; Kt[t * 64 + lane] = km[t] * iw; }
#pragma unroll
      for (int t = 0; t < 16; ++t) { const float e = __expf(lw - lwi[t]); wb[t] = bb[t] * e; wk[t] = km[t] * e; }
      float* rec = (float*)(ws + SC_CREC + ((size_t)chain * 256 + c) * CR_BYTES + CR_WL); rec[lane] = __expf(lw); }
    LDS_WAIT(); asm volatile("" ::: "memory");
    const int t = lane >> 2, sq = lane & 3;
    float mab[4] = {0.f, 0.f, 0.f, 0.f}, mak[4] = {0.f, 0.f, 0.f, 0.f}, mrb[4] = {0.f, 0.f, 0.f, 0.f}, mrk[4] = {0.f, 0.f, 0.f, 0.f};
#pragma unroll 4
    for (int j = 0; j < 64; j += 4) { const f32x4 a4 = *(const LAS f32x4*)(At + t * 64 + j);
#pragma unroll
        for (int e = 0; e < 4; ++e) { const f32x4 b4 = *(const LAS f32x4*)(Bt + (sq * 4 + e) * 64 + j), k4 = *(const LAS f32x4*)(Kt + (sq * 4 + e) * 64 + j);
            mab[e] += a4[0] * b4[0] + a4[1] * b4[1] + a4[2] * b4[2] + a4[3] * b4[3]; mak[e] += a4[0] * k4[0] + a4[1] * k4[1] + a4[2] * k4[2] + a4[3] * k4[3]; } }
    asm volatile("" ::: "memory");
#pragma unroll
    for (int tt = 0; tt < 16; ++tt) At[tt * 64 + lane] = rt[tt];
    LDS_WAIT(); asm volatile("" ::: "memory");
#pragma unroll 4
    for (int j = 0; j < 64; j += 4) { const f32x4 a4 = *(const LAS f32x4*)(At + t * 64 + j);
#pragma unroll
        for (int e = 0; e < 4; ++e) { const f32x4 b4 = *(const LAS f32x4*)(Bt + (sq * 4 + e) * 64 + j), k4 = *(const LAS f32x4*)(Kt + (sq * 4 + e) * 64 + j);
            mrb[e] += a4[0] * b4[0] + a4[1] * b4[1] + a4[2] * b4[2] + a4[3] * b4[3]; mrk[e] += a4[0] * k4[0] + a4[1] * k4[1] + a4[2] * k4[2] + a4[3] * k4[3]; } }
#pragma unroll
    for (int e = 0; e < 4; ++e) { const int s = sq * 4 + e; if (s >= t) { mab[e] = 0.f; mak[e] = 0.f; } if (s > t) { mrb[e] = 0.f; mrk[e] = 0.f; } }
    LAS float* m0 = mat; LAS float* m1 = mat + 256; LAS float* m2 = mat + 512; LAS float* m3 = mat + 768;
    float T[4], P[4], Q[4];
    st16(m0, t, sq, mab); LDS_WAIT(); asm volatile("" ::: "memory");
#pragma unroll
    for (int e = 0; e < 4; ++e) T[e] = mab[e] + ((sq * 4 + e) == t ? 1.f : 0.f);
    mm16(m0, m0, t, sq, P);
    st16(m1, t, sq, P); st16(m2, t, sq, T); LDS_WAIT(); asm volatile("" ::: "memory");
    mm16(m2, m1, t, sq, Q);
#pragma unroll
    for (int e = 0; e < 4; ++e) T[e] += Q[e];
    mm16(m1, m1, t, sq, P);
    asm volatile("" ::: "memory");
    st16(m0, t, sq, P); st16(m2, t, sq, T); LDS_WAIT(); asm volatile("" ::: "memory");
    mm16(m2, m0, t, sq, Q);
#pragma unroll
    for (int e = 0; e < 4; ++e) T[e] += Q[e];
    mm16(m0, m0, t, sq, P);
    asm volatile("" ::: "memory");
    st16(m1, t, sq, P); st16(m2, t, sq, T); LDS_WAIT(); asm volatile("" ::: "memory");
    mm16(m2, m1, t, sq, Q);
#pragma unroll
    for (int e = 0; e < 4; ++e) T[e] += Q[e];
    asm volatile("" ::: "memory");
    st16(m2, t, sq, T); st16(m0, t, sq, mrb); st16(m1, t, sq, mak); LDS_WAIT(); asm volatile("" ::: "memory");
    float P1[4], TM[4], Nn[4];
    mm16(m0, m2, t, sq, P1); mm16(m2, m1, t, sq, TM);
    st16(m3, t, sq, P1); LDS_WAIT(); asm volatile("" ::: "memory");
    mm16(m3, m1, t, sq, Nn);
#pragma unroll
    for (int e = 0; e < 4; ++e) Nn[e] += mrk[e];
    unsigned char* rec = ws + SC_CREC + ((size_t)chain * 256 + c) * CR_BYTES;
    { u32x2 w; w.x = pk2(TM[0], TM[1]); w.y = pk2(TM[2], TM[3]); *(u32x2*)(rec + CR_TM + (16 * sq + t) * 8) = w;
      w.x = pk2(Nn[0], Nn[1]); w.y = pk2(Nn[2], Nn[3]); *(u32x2*)(rec + CR_N + (16 * sq + t) * 8) = w; }
    LAS unsigned short* TAh = (LAS unsigned short*)Bt; LAS unsigned short* GHh = TAh + 1024;
#pragma unroll
    for (int tt = 0; tt < 16; ++tt) { float ta = 0.f, gh = rt[tt];
#pragma unroll
        for (int s4 = 0; s4 < 4; ++s4) { const f32x4 t4 = *(const LAS f32x4*)(m2 + tt * 16 + s4 * 4), p4 = *(const LAS f32x4*)(m3 + tt * 16 + s4 * 4);
            ta += t4[0] * at[s4 * 4] + t4[1] * at[s4 * 4 + 1] + t4[2] * at[s4 * 4 + 2] + t4[3] * at[s4 * 4 + 3];
            gh += p4[0] * at[s4 * 4] + p4[1] * at[s4 * 4 + 1] + p4[2] * at[s4 * 4 + 2] + p4[3] * at[s4 * 4 + 3]; }
        TAh[tt * 64 + lane] = f2bf(ta); GHh[tt * 64 + lane] = f2bf(gh); }
    LDS_WAIT(); asm volatile("" ::: "memory");
    { const int r = lane & 15, g = lane >> 4;
#pragma unroll
      for (int ks = 0; ks < 2; ++ks) { const u32x2 a0 = *(const LAS u32x2*)(TAh + r * 64 + 32 * ks + 4 * g), a1 = *(const LAS u32x2*)(TAh + r * 64 + 32 * ks + 16 + 4 * g);
          *(u32x4*)(rec + CR_TA + (ks * 64 + lane) * 16) = (u32x4){a0.x, a0.y, a1.x, a1.y};
          const u32x2 g0 = *(const LAS u32x2*)(GHh + r * 64 + 32 * ks + 4 * g), g1 = *(const LAS u32x2*)(GHh + r * 64 + 32 * ks + 16 + 4 * g);
          *(u32x4*)(rec + CR_GH + (ks * 64 + lane) * 16) = (u32x4){g0.x, g0.y, g1.x, g1.y}; } }
    { const int jb = lane >> 4, r = lane & 15;
#pragma unroll
      for (int g = 0; g < 4; ++g) { u32x4 w; w.x = pk2(wb[4 * g], wb[4 * g + 1]); w.y = pk2(wb[4 * g + 2], wb[4 * g + 3]); w.z = pk2(wk[4 * g], wk[4 * g + 1]); w.w = pk2(wk[4 * g + 2], wk[4 * g + 3]);
          *(u32x4*)(rec + CR_WBK + (jb * 64 + 16 * g + r) * 16) = w;
          u32x2 x; x.x = pk2(vv[4 * g], vv[4 * g + 1]); x.y = pk2(vv[4 * g + 2], vv[4 * g + 3]); *(u32x2*)(rec + CR_V + (jb * 64 + 16 * g + r) * 8) = x; } }
    LDS_WAIT(); asm volatile("" ::: "memory");
}

__device__ __forceinline__ void cprep_phase(Frame& F, int layer) {
    LAS float* Lw = (LAS float*)(F.lds + F.wave * 16384);
    for (int it = F.bid * 8 + F.wave; it < 32 * 256; it += F.G * 8) { const int c = it >> 5, chain = it & 31; rwkv_cprep_item(F, chain, c, Lw); }
    asm volatile("" ::: "memory");
    for (int it = F.bid * 8 + F.wave; it < 2048; it += F.G * 8) s5_block_task<2>(F, layer, it, Lw);
}

struct RwOps { bf16x8 ta[2], gh[2], wbk[4]; u32x2 tm, nn, vq[2]; f32x4 wl[4]; };
__device__ __forceinline__ void rw_load(RwOps& o, const unsigned char* rec, int lane, int half) {
    const int g = lane >> 4;
#pragma unroll
    for (int ks = 0; ks < 2; ++ks) { o.ta[ks] = *(const bf16x8*)(rec + CR_TA + (ks * 64 + lane) * 16); o.gh[ks] = *(const bf16x8*)(rec + CR_GH + (ks * 64 + lane) * 16); }
#pragma unroll
    for (int jb = 0; jb < 4; ++jb) { o.wbk[jb] = *(const bf16x8*)(rec + CR_WBK + (jb * 64 + lane) * 16); o.wl[jb] = *(const f32x4*)(rec + CR_WL + (jb * 16 + g * 4) * 4); }
    o.tm = *(const u32x2*)(rec + CR_TM + lane * 8); o.nn = *(const u32x2*)(rec + CR_N + lane * 8);
#pragma unroll
    for (int it = 0; it < 2; ++it) o.vq[it] = *(const u32x2*)(rec + CR_V + ((half * 2 + it) * 64 + lane) * 8);
}
__device__ __forceinline__ bf16x8 mk8(unsigned a, unsigned b, unsigned c, unsigned d) { u32x4 w = {a, b, c, d}; return *reinterpret_cast<bf16x8*>(&w); }
__device__ __forceinline__ void rw_step(const RwOps& o, f32x4 (&X)[4][2], float* ysb, const long rs, int lane) {
    const int r = lane & 15, g = lane >> 4;
    const bf16x8 tmf = mk8(o.tm.x, o.tm.y, 0u, 0u), nf = mk8(o.nn.x, o.nn.y, 0u, 0u);
#pragma unroll
    for (int it = 0; it < 2; ++it) {
        bf16x8 xb[2];
#pragma unroll
        for (int ks = 0; ks < 2; ++ks) xb[ks] = mk8(pk2c(X[2 * ks][it][0], X[2 * ks][it][1]), pk2c(X[2 * ks][it][2], X[2 * ks][it][3]), pk2c(X[2 * ks + 1][it][0], X[2 * ks + 1][it][1]), pk2c(X[2 * ks + 1][it][2], X[2 * ks + 1][it][3]));
        const bf16x8 vb = mk8(o.vq[it].x, o.vq[it].y, 0u, 0u);
        f32x4 U = {0.f, 0.f, 0.f, 0.f}, Y = {0.f, 0.f, 0.f, 0.f};
        U = __builtin_amdgcn_mfma_f32_16x16x32_bf16(o.ta[0], xb[0], U, 0, 0, 0); Y = __builtin_amdgcn_mfma_f32_16x16x32_bf16(o.gh[0], xb[0], Y, 0, 0, 0);
        U = __builtin_amdgcn_mfma_f32_16x16x32_bf16(o.ta[1], xb[1], U, 0, 0, 0); Y = __builtin_amdgcn_mfma_f32_16x16x32_bf16(o.gh[1], xb[1], Y, 0, 0, 0);
        U = __builtin_amdgcn_mfma_f32_16x16x32_bf16(tmf, vb, U, 0, 0, 0);       Y = __builtin_amdgcn_mfma_f32_16x16x32_bf16(nf, vb, Y, 0, 0, 0);
        const bf16x8 uvb = mk8(pk2c(U[0], U[1]), pk2c(U[2], U[3]), o.vq[it].x, o.vq[it].y);
#pragma unroll
        for (int jb = 0; jb < 4; ++jb) X[jb][it] = __builtin_amdgcn_mfma_f32_16x16x32_bf16(o.wbk[jb], uvb, X[jb][it] * o.wl[jb], 0, 0, 0);
#pragma unroll
        for (int q = 0; q < 4; ++q) ysb[(long)(4 * g + q) * rs + 16 * it + r] = Y[q];
    }
}
__device__ __forceinline__ void rwkv_scan_chunked(Frame& F, int chain, int half) {
    unsigned char* ws = F.ws; const int dir = chain & 1, h = (chain >> 1) & 7, b = chain >> 4; const int lane = F.lane;
    const unsigned char* rec0 = ws + SC_CREC + (size_t)chain * 256 * CR_BYTES;
#ifdef DBG_RWCHK
    float* YS = (float*)(ws + WS_HN) + (size_t)dir * NTOK * 512;
#else
    float* YS = (float*)(ws + SC_YS) + (size_t)dir * NTOK * 512;
#endif
    f32x4 X[4][2];
#pragma unroll
    for (int jb = 0; jb < 4; ++jb) { X[jb][0] = (f32x4){0.f, 0.f, 0.f, 0.f}; X[jb][1] = (f32x4){0.f, 0.f, 0.f, 0.f}; }
    RwOps oa, ob;
    rw_load(oa, rec0, lane, half);
    const long rs = dir ? -512 : 512;
    for (int c = 0; c < 256; c += 2) {
        rw_load(ob, rec0 + (size_t)(c + 1) * CR_BYTES, lane, half);
        { const int pos0 = dir ? (SEQ - 1 - 16 * c) : 16 * c; rw_step(oa, X, YS + (size_t)(b * SEQ + pos0) * 512 + h * 64 + half * 32, rs, lane); }
        if (c + 2 < 256) rw_load(oa, rec0 + (size_t)(c + 2) * CR_BYTES, lane, half);
        { const int pos0 = dir ? (SEQ - 1 - 16 * (c + 1)) : 16 * (c + 1); rw_step(ob, X, YS + (size_t)(b * SEQ + pos0) * 512 + h * 64 + half * 32, rs, lane); }
    }
}

__device__ __forceinline__ void rwkv_scan_naive(Frame& F, int chain) {
    unsigned char* ws = F.ws; const float* RW = (const float*)(ws + SC_RW); const size_t N1 = (size_t)NTOK * 512;
    const int dir = chain & 1, h = (chain >> 1) & 7, b = chain >> 4;
    const float* Rp = RW; const float* Vp = RW + N1; const float* KKp = RW + 2 * N1; const float* Wp = RW + (3 + dir) * N1; const float* KMp = RW + (5 + dir) * N1; const float* BBp = RW + (7 + dir) * N1;
    float* YS = (float*)(ws + SC_YS) + (size_t)dir * N1;
    LAS float* L = (LAS float*)(F.lds + F.wave * 2048);
    float st[64];
#pragma unroll
    for (int j = 0; j < 64; ++j) st[j] = 0.f;
    size_t idx = (size_t)(b * SEQ + (dir ? SEQ - 1 : 0)) * 512 + h * 64 + F.lane;
    float va = -KKp[idx], vw = __expf(Wp[idx]), vb = BBp[idx], vk = KMp[idx], vr = Rp[idx], vv = Vp[idx];
    for (int t = 0; t < SEQ; ++t) {
        L[F.lane] = va; L[64 + F.lane] = vw; L[128 + F.lane] = vb; L[192 + F.lane] = vk; L[256 + F.lane] = vr;
        const float v = vv; const size_t oidx = idx;
        if (t + 1 < SEQ) { idx = dir ? idx - 512 : idx + 512; va = -KKp[idx]; vw = __expf(Wp[idx]); vb = BBp[idx]; vk = KMp[idx]; vr = Rp[idx]; vv = Vp[idx]; }
        LDS_WAIT(); asm volatile("" ::: "memory");
        float sa0 = 0.f, sa1 = 0.f, sa2 = 0.f, sa3 = 0.f;
#pragma unroll
        for (int j = 0; j < 64; j += 4) { const f32x4 x = *(const LAS f32x4*)(L + j); sa0 += st[j] * x[0]; sa1 += st[j + 1] * x[1]; sa2 += st[j + 2] * x[2]; sa3 += st[j + 3] * x[3]; }
        const float sa = (sa0 + sa1) + (sa2 + sa3);
        float y0 = 0.f, y1 = 0.f, y2 = 0.f, y3 = 0.f;
#pragma unroll
        for (int j = 0; j < 64; j += 4) { const f32x4 w4 = *(const LAS f32x4*)(L + 64 + j), b4 = *(const LAS f32x4*)(L + 128 + j), k4 = *(const LAS f32x4*)(L + 192 + j), r4 = *(const LAS f32x4*)(L + 256 + j);
            st[j] = st[j] * w4[0] + (sa * b4[0] + v * k4[0]); st[j + 1] = st[j + 1] * w4[1] + (sa * b4[1] + v * k4[1]); st[j + 2] = st[j + 2] * w4[2] + (sa * b4[2] + v * k4[2]); st[j + 3] = st[j + 3] * w4[3] + (sa * b4[3] + v * k4[3]);
            y0 += st[j] * r4[0]; y1 += st[j + 1] * r4[1]; y2 += st[j + 2] * r4[2]; y3 += st[j + 3] * r4[3]; }
        YS[oidx] = (y0 + y1) + (y2 + y3);
        asm volatile("" ::: "memory");
    }
}

__device__ __forceinline__ void s5_unit(Frame& F, ArgsP a, int layer, int unit) {
    unsigned char* ws = F.ws; const bf16* Z = (const bf16*)(ws + SC_Z);
    const int b = unit / S5NCH, ch = unit % S5NCH; const int tok0 = b * SEQ + ch * S5CH;
    LAS float* ybuf = (LAS float*)F.lds;
    LAS float* glT = (LAS float*)(F.lds + 32768);
    LAS float* xs = (LAS float*)(F.lds + 65536 + F.wave * 8192);
    const float* ab = (const float*)(ws + WS_S5P + layer * S5P_LAYER); const float* bb = ab + 2 * 32 * 64 * 2;
    const float* carry = (const float*)(ws + SC_CARRY);
    const int n = F.lane;
    __syncthreads();
    LAS float* ulw = (LAS float*)(F.lds + MISC_OFF + 2048 + F.wave * 1024);
    for (int gi = 0; gi < 4; ++gi) {
        const int g = gi * 8 + F.wave;
        { const int tl = (n >> 1) & 15, hf = n & 1; const u32x4 w0 = *(const u32x4*)(Z + (size_t)(tok0 + tl) * ZLD + ZD + g * 16 + hf * 8);
          if (n < 32) { LAS f32x4* d = (LAS f32x4*)(ulw + tl * 16 + hf * 8);
            d[0] = (f32x4){__uint_as_float(w0.x << 16), __uint_as_float(w0.x & 0xffff0000u), __uint_as_float(w0.y << 16), __uint_as_float(w0.y & 0xffff0000u)};
            d[1] = (f32x4){__uint_as_float(w0.z << 16), __uint_as_float(w0.z & 0xffff0000u), __uint_as_float(w0.w << 16), __uint_as_float(w0.w & 0xffff0000u)}; } }
        float abr2[2], abi2[2], cr2[2], ci2[2];
#pragma unroll
        for (int dir = 0; dir < 2; ++dir) { const int pr = (dir * 32 + g) * 64 + n; abr2[dir] = ab[pr * 2]; abi2[dir] = ab[pr * 2 + 1];
            const float* cp = carry + ((((size_t)dir * BATCH + b) * S5NCH + ch) * 32 + g) * 128 + n * 2; cr2[dir] = cp[0]; ci2[dir] = cp[1]; }
        LDS_WAIT(); asm volatile("" ::: "memory");
#pragma unroll
        for (int dir = 0; dir < 2; ++dir) {
            const int pr = (dir * 32 + g) * 64 + n; const float abr = abr2[dir], abi = abi2[dir];
            float bbr[16], bbi[16];
            { const f32x4* bp = (const f32x4*)(bb + (size_t)pr * 32);
#pragma unroll
              for (int c4 = 0; c4 < 8; ++c4) { const f32x4 q = bp[c4]; bbr[c4 * 2] = q[0]; bbi[c4 * 2] = q[1]; bbr[c4 * 2 + 1] = q[2]; bbi[c4 * 2 + 1] = q[3]; } }
            float xr = cr2[dir], xi = ci2[dir];
#pragma unroll 4
            for (int i = 0; i < S5CH; ++i) { const int tl = dir ? (S5CH - 1 - i) : i;
                const f32x4 u0 = *(const LAS f32x4*)(ulw + tl * 16), u1 = *(const LAS f32x4*)(ulw + tl * 16 + 4), u2 = *(const LAS f32x4*)(ulw + tl * 16 + 8), u3 = *(const LAS f32x4*)(ulw + tl * 16 + 12);
                float br = 0.f, bi = 0.f;
#pragma unroll
                for (int c = 0; c < 4; ++c) { br += bbr[c] * u0[c] + bbr[4 + c] * u1[c] + bbr[8 + c] * u2[c] + bbr[12 + c] * u3[c]; bi += bbi[c] * u0[c] + bbi[4 + c] * u1[c] + bbi[8 + c] * u2[c] + bbi[12 + c] * u3[c]; }
                const float nr = abr * xr - abi * xi + br, ni = abr * xi + abi * xr + bi; xr = nr; xi = ni;
                LAS float* xp = xs + (tl * 64 + n) * 2;
                if (dir == 0) { xp[0] = xr; xp[1] = xi; } else { xp[0] += xr; xp[1] += xi; } }
        }
        LDS_WAIT(); asm volatile("" ::: "memory");
        { const int c = F.lane & 15, sq = F.lane >> 4; const float* cre = a->in[I_S5_C_RE] + (((size_t)layer * 32 + g) * 16 + c) * 64; const float* cim = a->in[I_S5_C_IM] + (((size_t)layer * 32 + g) * 16 + c) * 64;
          float y[4] = {0.f, 0.f, 0.f, 0.f};
#pragma unroll 4
          for (int nn = 0; nn < 64; nn += 4) { const f32x4 cr = *(const f32x4*)(cre + nn), ci = *(const f32x4*)(cim + nn);
#pragma unroll
              for (int s = 0; s < 4; ++s) { const LAS f32x4* xp = (const LAS f32x4*)(xs + ((sq * 4 + s) * 64 + nn) * 2); const f32x4 xa = xp[0], xb = xp[1];
                  y[s] += cr[0] * xa[0] - ci[0] * xa[1] + cr[1] * xa[2] - ci[1] * xa[3] + cr[2] * xb[0] - ci[2] * xb[1] + cr[3] * xb[2] - ci[3] * xb[3]; } }
          const float dsk = a->in[I_S5_D][(size_t)layer * 512 + g * 16 + c];
#pragma unroll
          for (int s = 0; s < 4; ++s) { const int tl = sq * 4 + s; const float uu = ulw[tl * 16 + c]; const float yy = y[s] + dsk * uu;
              const float x3 = yy * yy * yy; const float gl = 0.5f * yy * (1.f + tanhf(0.7978845608028654f * (yy + 0.044715f * x3)));
              ybuf[tl * 512 + g * 16 + c] = gl; glT[(g * 16 + c) * 16 + tl] = gl; } }
        LDS_WAIT(); asm volatile("" ::: "memory");
    }
    __syncthreads();
    { const int c = F.tid; const float* gw = a->in[I_S5_GLU_W] + (size_t)layer * 512 * 512; float acc[16];
#pragma unroll
      for (int s = 0; s < 16; ++s) acc[s] = 0.f;
#pragma unroll 2
      for (int k = 0; k < 512; ++k) { const float w = gw[(size_t)k * 512 + c]; const LAS f32x4* gp = (const LAS f32x4*)(glT + k * 16); const f32x4 g0 = gp[0], g1 = gp[1], g2 = gp[2], g3 = gp[3];
#pragma unroll
          for (int q = 0; q < 4; ++q) { acc[q] += g0[q] * w; acc[4 + q] += g1[q] * w; acc[8 + q] += g2[q] * w; acc[12 + q] += g3[q] * w; } }
      const float bias = a->in[I_S5_GLU_B][(size_t)layer * 512 + c];
      __syncthreads();
#pragma unroll
      for (int s = 0; s < 16; ++s) { const float gl = ybuf[s * 512 + c]; ybuf[s * 512 + c] = gl * sigmoidf_(acc[s] + bias); } }
    __syncthreads();
    { const float* gn = a->in[I_MIX_OUT_NORM] + ((size_t)layer * 2 + 1) * 512; bf16* MIX = (bf16*)(ws + WS_MIX);
#pragma unroll
      for (int q = 0; q < 2; ++q) { const int tl = F.wave * 2 + q; float v[8]; float s = 0.f;
#pragma unroll
          for (int j = 0; j < 8; ++j) { v[j] = ybuf[tl * 512 + j * 64 + F.lane]; s += v[j] * v[j]; }
          const float rstd = 1.f / sqrtf(wave_sum(s) * (1.f / 512.f) + RMS_EPS);
#pragma unroll
          for (int j = 0; j < 8; ++j) MIX[(size_t)(tok0 + tl) * DM + 1536 + j * 64 + F.lane] = f2bf(v[j] * rstd * gn[j * 64 + F.lane]); } }
}

template <int mask>
__device__ __forceinline__ void mix_phase(Frame& F, ArgsP a, int layer, const int rep) {
    const int qb_ = (rep * 2 + layer) * 8;
    constexpr int NB = 8, NA = BATCH * 4 * (SEQ / 128), NC = BATCH * 4 * 48, ND = BATCH * S5NCH;
#ifdef DBG_RWCHK
    for (;;) { const int it = q_next(F, layer * 8 + 5); if (it >= 4) break; rwkv_scan_naive(F, it * 8 + F.wave); }
#endif
    if (mask & 1) for (;;) { const int it = q_next(F, qb_ + 1); if (it >= NB) break; rwkv_scan_chunked(F, it * 4 + (F.wave >> 1), F.wave & 1); }
    if (mask & 2) for (;;) { const int it = q_next(F, qb_ + 2); if (it >= NA) break;
        unsigned char* ws = F.ws; asm volatile("" : "+s"(ws)); const bf16* Z = (const bf16*)(ws + SC_Z);
        const int qb = it % (SEQ / 128), h = (it / (SEQ / 128)) % 4, b = it / (4 * (SEQ / 128));
        const bf16* zb = Z + (size_t)(b * SEQ) * ZLD + ZA;
        float lam, lam_init;
        { const float* lv = a->in[I_DIFF_LAMBDA] + (size_t)layer * 4 * 64; float d1 = 0.f, d2 = 0.f;
          for (int i = 0; i < 64; ++i) { d1 += lv[i] * lv[64 + i]; d2 += lv[128 + i] * lv[192 + i]; }
          lam_init = 0.8f - 0.6f * expf(-0.3f * (float)layer); lam = expf(d1) - expf(d2) + lam_init; }
        att::diff_attn_unit(zb + (size_t)(qb * 128) * ZLD + h * 128, zb + 512 + h * 128, zb + 1024 + h * 128, ZLD, SEQ,
                            (bf16*)(ws + WS_MIX) + (size_t)(b * SEQ + qb * 128) * DM + h * 128, DM, lam, 1.f - lam_init, a->in[I_DIFF_SUBLN] + (size_t)layer * 128, (char*)F.lds, F.wave); }
    if (mask & 4) for (;;) { const int it = q_next(F, qb_ + 3); if (it >= NC) break;
        unsigned char* ws = F.ws; asm volatile("" : "+s"(ws)); const bf16* Z = (const bf16*)(ws + SC_Z);
        const int r = it % 48, h = (it / 48) % 4, b = it / (48 * 4); const int p = r / 16, rr = r % 16;
        const int dil = p == 0 ? 1 : (p == 1 ? 4 : 16); const int L = SEQ / dil; const int nqb = L / 256; const int rho = rr / nqb, qb = rr % nqb;
        const bf16* zb = Z + (size_t)(b * SEQ) * ZLD + ZC;
        att::dil_attn_unit(zb + h * 128, zb + 512 + h * 128, zb + 1024 + h * 128, ZLD, dil, rho, qb * 256, L,
                           (float*)(ws + SC_OC) + ((size_t)p * NTOK + (size_t)b * SEQ) * 512 + h * 128, (float*)(ws + SC_LSE) + ((size_t)p * NTOK + (size_t)b * SEQ) * 4 + h, (char*)F.lds, F.wave); }
    if (mask & 8) for (;;) { const int it = q_next(F, qb_ + 4); if (it >= ND) break; s5_unit(F, a, layer, it); }
}

__device__ __forceinline__ void post_phase(Frame& F, ArgsP a, int layer) {
    unsigned char* ws = F.ws; bf16* MIX = (bf16*)(ws + WS_MIX);
    const int gw = F.bid * 8 + F.wave, NGW = F.G * 8;
    const float* RW = (const float*)(ws + SC_RW); const size_t N1 = (size_t)NTOK * 512; const float* YS = (const float*)(ws + SC_YS);
#ifdef DBG_RWCHK
    { const float* Y2 = (const float*)(ws + WS_HN); float e = 0.f, r2 = 0.f; int bad = 0;
      for (size_t i = (size_t)F.bid * 512 + F.tid; i < (size_t)2 * NTOK * 512; i += (size_t)F.G * 512) { const float a0 = ((const float*)(ws + SC_YS))[i], b0 = Y2[i]; const float d = fabsf(a0 - b0); if (!(d < 1e30f)) bad = 1; else e = fmaxf(e, d); r2 = fmaxf(r2, fabsf(a0)); }
      e = wave_max(e); r2 = wave_max(r2); bad = __any(bad) ? 1 : 0;
      if (F.lane == 0) { atomicMax(F.ctl + 32768 + layer * 64, __float_as_uint(e)); atomicMax(F.ctl + 32768 + layer * 64 + 1, __float_as_uint(r2)); if (bad) atomicMax(F.ctl + 32768 + layer * 64 + 2, 1u); } }
#endif
    for (int it = gw; it < NTOK * 8; it += NGW) { const int tok = it >> 3, h = it & 7; const size_t o = (size_t)tok * 512 + h * 64 + F.lane; const int c = h * 64 + F.lane;
        const float y = YS[o] + YS[N1 + o];
        const float mean = wave_sum(y) * (1.f / 64.f); const float d = y - mean; const float var = wave_sum(d * d) * (1.f / 64.f);
        const float yn = d * (1.f / sqrtf(var + 64e-5f)) * a->in[I_RWKV_LNX_W][(size_t)layer * 512 + c] + a->in[I_RWKV_LNX_B][(size_t)layer * 512 + c];
        const float r_ = RW[o], v_ = RW[N1 + o], kb = 0.5f * (RW[5 * N1 + o] + RW[6 * N1 + o]);
        const float bon = wave_sum(r_ * kb * a->in[I_RWKV_RK][(size_t)layer * 512 + c]) * v_;
        MIX[(size_t)tok * DM + 512 + c] = f2bf((yn + bon) * RW[9 * N1 + o]); }
    const float* OC = (const float*)(ws + SC_OC); const float* LSE = (const float*)(ws + SC_LSE); const float* gn = a->in[I_MIX_OUT_NORM] + ((size_t)layer * 2 + 0) * 512;
    for (int tok = gw; tok < NTOK; tok += NGW) { const int h = F.lane >> 4;
        const float l0 = LSE[((size_t)0 * NTOK + tok) * 4 + h], l1 = LSE[((size_t)1 * NTOK + tok) * 4 + h], l2 = LSE[((size_t)2 * NTOK + tok) * 4 + h];
        const float m = fmaxf(l0, fmaxf(l1, l2)); float w0 = __expf(l0 - m), w1 = __expf(l1 - m), w2 = __expf(l2 - m); const float inv = 1.f / (w0 + w1 + w2); w0 *= inv; w1 *= inv; w2 *= inv;
        float v[8]; float s = 0.f;
        const f32x4* p0 = (const f32x4*)(OC + ((size_t)0 * NTOK + tok) * 512) + F.lane * 2; const f32x4* p1 = (const f32x4*)(OC + ((size_t)1 * NTOK + tok) * 512) + F.lane * 2; const f32x4* p2 = (const f32x4*)(OC + ((size_t)2 * NTOK + tok) * 512) + F.lane * 2;
#pragma unroll
        for (int j = 0; j < 2; ++j) { const f32x4 a0 = p0[j], a1 = p1[j], a2 = p2[j];
#pragma unroll
            for (int e = 0; e < 4; ++e) { const float x = w0 * a0[e] + w1 * a1[e] + w2 * a2[e]; v[j * 4 + e] = x; s += x * x; } }
        const float rstd = 1.f / sqrtf(wave_sum(s) * (1.f / 512.f) + RMS_EPS);
        const f32x4 g0 = *((const f32x4*)gn + F.lane * 2), g1 = *((const f32x4*)gn + F.lane * 2 + 1);
        u32x4 w; w.x = pk2(v[0] * rstd * g0[0], v[1] * rstd * g0[1]); w.y = pk2(v[2] * rstd * g0[2], v[3] * rstd * g0[3]); w.z = pk2(v[4] * rstd * g1[0], v[5] * rstd * g1[1]); w.w = pk2(v[6] * rstd * g1[2], v[7] * rstd * g1[3]);
        *(u32x4*)(MIX + (size_t)tok * DM + 1024 + F.lane * 8) = w; }
}

#ifndef MK_FUSED
#define MK_FUSED 1
#endif
__global__ void __launch_bounds__(512, 2) enc_fwd(Args args_) {
    extern __shared__ __attribute__((aligned(16))) unsigned char lds_raw[];
    Frame F;
    F.lds = (LAS unsigned char*)lds_raw; F.MISC = (volatile LAS unsigned*)(F.lds + MISC_OFF);
    F.tid = threadIdx.x; F.lane = F.tid & 63; F.wave = __builtin_amdgcn_readfirstlane(F.tid >> 6); F.G = gridDim.x; F.bid = blockIdx.x;
    const int wave0 = F.wave;
    ArgsP ap = (ArgsP)__builtin_amdgcn_kernarg_segment_ptr();
    unsigned char* ws = ap->ws; F.ws = ws; F.ctl = (unsigned*)(ws + WS_CTL);
    for (int u = F.tid; u < (LDS_BYTES - MISC_OFF) / 4; u += 512) ((LAS unsigned*)(F.lds + MISC_OFF))[u] = 0u;
    __syncthreads();
    const int lo = ap->ph_lo, hi = ap->ph_hi;
    if (hi - lo > 1) (void)xcd_barrier_post(F.ctl + CW_BAR, F.MISC + 8);
#ifdef DBG_ONLY
#define IN(k) (((k) < PH_L0 ? (k) : ((k) == PH_FINAL ? 100 : 3 + ((k) - PH_L0) % NPH_L)) == DBG_ONLY && lo <= (k) && (k) < hi)
#else
#define IN(k) ({ int lo_ = lo, hi_ = hi; asm volatile("" : "+s"(lo_), "+s"(hi_)); lo_ <= (k) && (k) < hi_; })
#endif
#define args (*ap)
#define REFRESH() do { int wv_ = wave0, bi_ = blockIdx.x, gg_ = gridDim.x; asm volatile("" : "+s"(wv_), "+s"(bi_), "+s"(gg_)); const int t_ = tid_from_wave(wv_); F.tid = t_; F.lane = t_ & 63; F.wave = wv_; F.bid = bi_; F.G = gg_; ap = (ArgsP)__builtin_amdgcn_kernarg_segment_ptr(); asm volatile("" : "+s"(ap)); unsigned char* w_ = ap->ws; F.ws = w_; ws = w_; F.ctl = (unsigned*)(w_ + WS_CTL); } while (0)
#ifndef DBG_REP_CODE
#define DBG_REP_CODE -1
#define DBG_REP_N 0
#endif
#define REPS(code) (((code) == DBG_REP_CODE && l_ == 0) ? 1 + DBG_REP_N : 1)
#define SEAM(k) do { if (IN(k) && IN((k) + 1)) { XcdBarrier b_; b_.bar = (unsigned*)(ap->ws + WS_CTL) + CW_BAR; b_.x = xb_xcc_id(); b_.st = F.MISC + 8; xcd_barrier(b_); } } while (0)

    { const int l_ = 0; if (IN(PH_P0)) { REFRESH(); for (int rep = 0; rep < REPS(0); ++rep) p0_prologue(F, ap); } } SEAM(PH_P0);
    if (IN(PH_P1)) { REFRESH();
        SchedBatch S{(const char*)(ws + SC_MEMN), (const char*)(ws + SC_WKVT), (char*)(ws + SC_KVB), (size_t)512 * DM * 2, (size_t)4096 * DM * 2, (size_t)512 * 4096 * 2, 2, 16, DEPTH, F.G, F.bid, DM, DM, 4096 * 2, 2, 512};
        pg8::gemm_phase<pg8::EpiBf16, SchedBatch, false>(F.lds, pg8::GemmP{DM, DM, DM}, S, pg8::EpiBf16{4096}, F.wave);
    } SEAM(PH_P1);
    if (IN(PH_P2)) { REFRESH();
        { SchedXaPre S{ws, F.G, F.bid, 0}; pg8::gemm_phase<EpiBf16U, SchedXaPre, false>(F.lds, pg8::GemmP{512, 4096, DM}, S, EpiBf16U{}, F.wave); }
        { SchedXaPre S{ws, F.G, F.bid, 1}; pg8::gemm_phase<EpiBf16U, SchedXaPre, false>(F.lds, pg8::GemmP{512, DM, 4096}, S, EpiBf16U{}, F.wave); }
    } SEAM(PH_P2);

    for (int l = 0; l < DEPTH; ++l) {
        const int pb = PH_L0 + l * NPH_L; const int l_ = l;
        float* H = (float*)(ws + WS_H);
        if (IN(pb + LP_NORM1)) { REFRESH(); if (l == 0) norm_phase<0>(F, ap, args.in[I_X], args.in[I_NORM_MIX], l); else norm_phase<1>(F, ap, H, args.in[I_NORM_MIX] + (size_t)l * DM, l); } SEAM(pb + LP_NORM1);
        if (IN(pb + LP_G1)) { REFRESH();
            SchedDense S{(const char*)(ws + WS_HN), (const char*)(ws + WS_WIN) + (size_t)l * ZLD * DM * 2, (char*)(ws + SC_Z), NTOK / 256, ZLD / 256, F.G, F.bid, DM, DM, ZLD * 2, 2};
            for (int rep = 0; rep < REPS(10); ++rep) pg8::gemm_phase<pg8::EpiBf16, SchedDense, false>(F.lds, pg8::GemmP{DM, DM, DM}, S, pg8::EpiBf16{ZLD}, F.wave);
        } SEAM(pb + LP_G1);
        if (IN(pb + LP_PREP)) { REFRESH(); for (int rep = 0; rep < REPS(11); ++rep) prep_phase(F, ap, l, rep); } SEAM(pb + LP_PREP);
        if (IN(pb + LP_CPREP)) { REFRESH(); for (int rep = 0; rep < REPS(12); ++rep) cprep_phase(F, l); } SEAM(pb + LP_CPREP);
        if (IN(pb + LP_MIX)) { REFRESH(); mix_phase<15>(F, ap, l, 0); if (DBG_REP_CODE >= 13 && DBG_REP_CODE <= 16 && l_ == 0) { REFRESH(); mix_phase<(DBG_REP_CODE >= 13 && DBG_REP_CODE <= 16) ? (1 << (DBG_REP_CODE - 13)) : 1>(F, ap, l, 1); if (DBG_REP_N > 1) { REFRESH(); mix_phase<(DBG_REP_CODE >= 13 && DBG_REP_CODE <= 16) ? (1 << (DBG_REP_CODE - 13)) : 1>(F, ap, l, 2); } } } SEAM(pb + LP_MIX);
        if (IN(pb + LP_POST)) { REFRESH(); for (int rep = 0; rep < REPS(17); ++rep) post_phase(F, ap, l); } SEAM(pb + LP_POST);
        if (IN(pb + LP_G2)) { REFRESH();
            SchedDense S{(const char*)(ws + WS_MIX), (const char*)(ws + WS_WOUT) + (size_t)l * DM * DM * 2, (char*)H, NTOK / 256, DM / 256, F.G, F.bid, DM, DM, DM * 4, 4};
            pg8::gemm_phase<pg8::EpiF32Res, SchedDense, false>(F.lds, pg8::GemmP{DM, DM, DM}, S, pg8::EpiF32Res{DM, l == 0 ? args.in[I_X] : (const float*)H, H}, F.wave);
        } SEAM(pb + LP_G2);
        if (IN(pb + LP_NORM2)) { REFRESH(); for (int rep = 0; rep < REPS(18); ++rep) norm_phase<0>(F, ap, H, args.in[I_NORM_CROSS] + (size_t)l * DM, l); } SEAM(pb + LP_NORM2);
        if (IN(pb + LP_GS)) { REFRESH();
            SchedBatch S{(const char*)(ws + WS_HN), (const char*)(ws + WS_WQK) + (size_t)l * 2 * 1024 * DM * 2, (char*)(ws + WS_P), (size_t)SEQ * DM * 2, (size_t)1024 * DM * 2, (size_t)SEQ * 1024 * 2, SEQ / 256, 4, BATCH, F.G, F.bid, DM, DM, 1024 * 2, 2, SEQ};
            for (int rep = 0; rep < REPS(19); ++rep) pg8::gemm_phase<pg8::EpiSoftmax, SchedBatch, false>(F.lds, pg8::GemmP{DM, DM, DM}, S, pg8::EpiSoftmax{1024, 0.044194173824159216f * 1.4426950408889634f}, F.wave);
        } SEAM(pb + LP_GS);
        if (IN(pb + LP_GO)) { REFRESH();
            SchedBatch S{(const char*)(ws + WS_P), (const char*)(ws + WS_VWO) + (size_t)l * 2 * DM * 1024 * 2, (char*)H, (size_t)SEQ * 1024 * 2, (size_t)DM * 1024 * 2, (size_t)SEQ * DM * 4, SEQ / 256, DM / 256, BATCH, F.G, F.bid, 1024, 1024, DM * 4, 4, SEQ};
            pg8::gemm_phase<pg8::EpiF32Res, SchedBatch, false>(F.lds, pg8::GemmP{1024, 1024, 1024}, S, pg8::EpiF32Res{DM, (const float*)H, H}, F.wave);
        } SEAM(pb + LP_GO);
        if (IN(pb + LP_NORM3)) { REFRESH(); norm_phase<2>(F, ap, H, args.in[I_NORM_MOE] + (size_t)l * DM, l); } SEAM(pb + LP_NORM3);
        if (IN(pb + LP_M1)) { REFRESH();
            volatile LAS int* tp = (volatile LAS int*)(F.lds + MISC_OFF + 256); volatile LAS int* cnt = tp + 40;
            moe_prefix(F, l, tp, cnt);
            SchedMoe S{ws, tp, cnt, l, F.G, F.bid, 0};
            for (int rep = 0; rep < REPS(20); ++rep) pg8::gemm_phase<pg8::EpiSwiGlu, SchedMoe, true>(F.lds, pg8::GemmP{DM, DM, DM}, S, pg8::EpiSwiGlu{DEXP}, F.wave);
        } SEAM(pb + LP_M1);
        if (IN(pb + LP_M2)) { REFRESH();
            volatile LAS int* tp = (volatile LAS int*)(F.lds + MISC_OFF + 256); volatile LAS int* cnt = tp + 40;
            moe_prefix(F, l, tp, cnt);
            SchedMoe S{ws, tp, cnt, l, F.G, F.bid, 1};
            for (int rep = 0; rep < REPS(21); ++rep) pg8::gemm_phase<pg8::EpiGate, SchedMoe, false>(F.lds, pg8::GemmP{DEXP, DEXP, DEXP}, S, pg8::EpiGate{DM, (const float*)(ws + WS_EGATE), nullptr}, F.wave);
        } SEAM(pb + LP_M2);
    }
    if (IN(PH_FINAL)) { REFRESH(); norm_phase<5>(F, ap, (const float*)(ws + WS_H), args.in[I_NORM_FINAL], DEPTH); }
#undef IN
#undef SEAM
#undef args
}

extern "C" void kernel_launch(void* const* d_in, const int* in_sizes, int n_in, void* d_out, int out_size, void* d_ws, size_t ws_size, hipStream_t stream) {
    static int grid = 0;
    if (grid == 0) {
        if (n_in != N_INPUTS || out_size != NTOK * DM || ws_size < cmax(WS_END, SC_MIX_END3)) { fprintf(stderr, "kernel_launch: built for %d inputs, out %d, ws >= %zu; got %d, %d, %zu\n", N_INPUTS, NTOK * DM, cmax(WS_END, SC_MIX_END3), n_in, out_size, ws_size); grid = -1; return; }
        int dev = 0, cus = 0, per_cu = 0;
        if (hipGetDevice(&dev) != hipSuccess || hipDeviceGetAttribute(&cus, hipDeviceAttributeMultiprocessorCount, dev) != hipSuccess) { fprintf(stderr, "kernel_launch: device query failed\n"); grid = -1; return; }
        if (hipFuncSetAttribute((const void*)enc_fwd, hipFuncAttributeMaxDynamicSharedMemorySize, LDS_BYTES) != hipSuccess) { fprintf(stderr, "kernel_launch: hipFuncSetAttribute failed\n"); grid = -1; return; }
        if (hipOccupancyMaxActiveBlocksPerMultiprocessor(&per_cu, (const void*)enc_fwd, 512, LDS_BYTES) != hipSuccess || per_cu < 1) fprintf(stderr, "kernel_launch: occupancy query says %d blocks per CU\n", per_cu);
        grid = cus;
    }
    if (grid < 0) return;
    hipMemsetAsync((char*)d_ws + WS_CTL, 0, CTL_BYTES, stream);
    Args a; memset(&a, 0, sizeof(a));
    for (int i = 0; i < N_INPUTS; ++i) a.in[i] = (const float*)d_in[i];
    a.out = (float*)d_out; a.ws = (unsigned char*)d_ws;
#if MK_FUSED
    a.ph_lo = 0; a.ph_hi = NPHASES;
    hipLaunchKernelGGL(enc_fwd, dim3(grid), dim3(512), LDS_BYTES, stream, a);
#else
    for (int p = 0; p < NPHASES; ++p) { a.ph_lo = p; a.ph_hi = p + 1; hipLaunchKernelGGL(enc_fwd, dim3(grid), dim3(512), LDS_BYTES, stream, a); }
#endif
    const hipError_t le = hipPeekAtLastError();
    if (le != hipSuccess) fprintf(stderr, "kernel_launch: launch failed: %s\n", hipGetErrorName(le));
}
```

```cpp
#include <hip/hip_runtime.h>
#include <cstdio>
#include <cstdint>
#include <cstring>

#define GAS __attribute__((address_space(1)))
#define LAS __attribute__((address_space(3)))
typedef unsigned short bf16;
typedef short bf16x8 __attribute__((ext_vector_type(8)));
typedef short s16x4 __attribute__((ext_vector_type(4)));
typedef float f32x2 __attribute__((ext_vector_type(2)));
typedef float f32x4 __attribute__((ext_vector_type(4)));
typedef float f32x16 __attribute__((ext_vector_type(16)));
typedef unsigned u32x2 __attribute__((ext_vector_type(2)));
typedef unsigned u32x4 __attribute__((ext_vector_type(4)));
typedef GAS unsigned gu32;

constexpr int DM = 2048, BATCH = 2, SEQ = 4096, NTOK = BATCH * SEQ, DEPTH = 2, NMEM = 256;
constexpr int IN_A = 1536, IN_B = 1920, IN_C = 1536, IN_D = 512, IN_TOTAL = 5504, ZLD = 5632;
constexpr int ZA = 0, ZB = 1536, ZC = 3456, ZD = 4992;
constexpr int NEXP = 32, DEXP = 512, ECAP = 8192;
constexpr int SLOT_CAP = 24576;
constexpr int S5CH = 16, S5NCH = SEQ / S5CH;
constexpr float RMS_EPS = 1e-6f;

enum { I_X = 0, I_MEM, I_NORM_MIX, I_W_IN, I_W_OUT, I_DIFF_LAMBDA, I_DIFF_SUBLN, I_RWKV_MU, I_RWKV_W0, I_RWKV_W2, I_RWKV_A0, I_RWKV_A2, I_RWKV_G2,
       I_RWKV_KK, I_RWKV_KA, I_RWKV_RK, I_RWKV_LNX_W, I_RWKV_LNX_B, I_S5_A_RE, I_S5_A_IM, I_S5_LOG_DT, I_S5_B_RE, I_S5_B_IM, I_S5_C_RE, I_S5_C_IM,
       I_S5_D, I_S5_GLU_W, I_S5_GLU_B, I_MIX_OUT_NORM, I_NORM_CROSS, I_NORM_MEM, I_XA_WQ, I_XA_WKV, I_XA_WO, I_NORM_MOE, I_ROUTER_GROUP,
       I_ROUTER_EXPERT, I_MOE_W1, I_MOE_W3, I_MOE_W2, I_NORM_FINAL, N_INPUTS };

constexpr size_t al256(size_t x) { return (x + 255) / 256 * 256; }
constexpr size_t WS_CTL = 0, CTL_BYTES = 1u << 20;
constexpr size_t WS_WIN  = WS_CTL + CTL_BYTES;
constexpr size_t WS_WOUT = WS_WIN + (size_t)DEPTH * ZLD * DM * 2;
constexpr size_t WS_WQK  = WS_WOUT + (size_t)DEPTH * DM * DM * 2;
constexpr size_t WS_VWO  = WS_WQK + (size_t)DEPTH * BATCH * 1024 * DM * 2;
constexpr size_t WS_W13  = WS_VWO + (size_t)DEPTH * BATCH * DM * 1024 * 2;
constexpr size_t WS_W2   = WS_W13 + (size_t)DEPTH * NEXP * 1024 * DM * 2;
constexpr size_t WS_ROPE = WS_W2 + (size_t)DEPTH * NEXP * DM * DEXP * 2;
constexpr size_t WS_S5P  = WS_ROPE + (size_t)SEQ * (32 + 32 + 64 + 64) * 4;
constexpr size_t S5P_LAYER = (size_t)(2 * 32 * 64 * 2 + 2 * 32 * 64 * 16 * 2 + 2 * 32 * 64 * 2) * 4;
constexpr size_t WS_H    = al256(WS_S5P + DEPTH * S5P_LAYER);
constexpr size_t WS_HN   = WS_H + (size_t)NTOK * DM * 4;
constexpr size_t WS_MIX  = WS_HN + (size_t)NTOK * DM * 2;
constexpr size_t WS_P    = WS_MIX + (size_t)NTOK * DM * 2;
constexpr size_t WS_ETOK = WS_P + (size_t)NTOK * 1024 * 2;
constexpr size_t WS_EGATE= WS_ETOK + (size_t)NEXP * ECAP * 4;
constexpr size_t WS_TINFO= WS_EGATE + (size_t)NEXP * ECAP * 4;
constexpr size_t WS_SCR  = al256(WS_TINFO + (size_t)NTOK * 16);
constexpr size_t SC_WKVT = WS_SCR;
constexpr size_t SC_MEMN = SC_WKVT + (size_t)DEPTH * 4096 * DM * 2;
constexpr size_t SC_KVB  = SC_MEMN + (size_t)DEPTH * 512 * DM * 2;
constexpr size_t SC_WQB  = SC_KVB + (size_t)DEPTH * 512 * 4096 * 2;
constexpr size_t SC_WOT  = SC_WQB + (size_t)DEPTH * DM * DM * 2;
constexpr size_t SC_PRO_END = SC_WOT + (size_t)DEPTH * DM * DM * 2;
constexpr size_t SC_Z    = WS_SCR;
constexpr size_t SC_RW   = SC_Z + (size_t)NTOK * ZLD * 2;
constexpr size_t RWSZ    = (size_t)NTOK * 512 * 4;
constexpr size_t SC_YS   = SC_RW + 10 * RWSZ;
constexpr size_t SC_OC   = SC_YS + 2 * RWSZ;
constexpr size_t SC_LSE  = SC_OC + 3 * RWSZ;
constexpr size_t SC_CARRY= SC_LSE + (size_t)3 * NTOK * 4 * 4;
constexpr size_t SC_MIX_END = SC_CARRY + (size_t)2 * BATCH * S5NCH * 32 * 64 * 2 * 4;
constexpr size_t SC_HMID = WS_SCR;
constexpr size_t SC_YBUF = SC_HMID + (size_t)SLOT_CAP * DEXP * 2;
constexpr size_t SC_MOE_END = SC_YBUF + (size_t)SLOT_CAP * DM * 2;
constexpr size_t cmax(size_t a, size_t b) { return a > b ? a : b; }
constexpr size_t WS_END = cmax(cmax(SC_PRO_END, SC_MIX_END), SC_MOE_END);

constexpr int CW_BAR = 4096;
constexpr int CW_Q = 8192;
constexpr int CW_CNT = 16384;

constexpr int RING_BYTES = 131072;
constexpr int MISC_OFF = 147456 - 1024;
constexpr int LDS_BYTES = 147456;

__device__ __forceinline__ float bf2f(unsigned short b) { return __uint_as_float(((unsigned)b) << 16); }
typedef __bf16 bf16x2_t __attribute__((ext_vector_type(2)));
__device__ __forceinline__ unsigned pk2c(float lo, float hi) { bf16x2_t v = {(__bf16)lo, (__bf16)hi}; return __builtin_bit_cast(unsigned, v); }
__device__ __forceinline__ unsigned pk2(float lo, float hi) { unsigned r; asm volatile("v_cvt_pk_bf16_f32 %0, %1, %2" : "=v"(r) : "v"(lo), "v"(hi)); return r; }
__device__ __forceinline__ bf16 f2bf(float f) { return (bf16)(pk2(f, 0.f) & 0xffffu); }
template <int CTRL> __device__ __forceinline__ float dpp_mov(float v) { return __builtin_bit_cast(float, __builtin_amdgcn_update_dpp(0, __builtin_bit_cast(int, v), CTRL, 0xf, 0xf, true)); }
__device__ __forceinline__ float row_sum(float v) { v += dpp_mov<0xB1>(v); v += dpp_mov<0x4E>(v); v += dpp_mov<0x141>(v); v += dpp_mov<0x140>(v); return v; }
__device__ __forceinline__ float row_max(float v) { v = fmaxf(v, dpp_mov<0xB1>(v)); v = fmaxf(v, dpp_mov<0x4E>(v)); v = fmaxf(v, dpp_mov<0x141>(v)); v = fmaxf(v, dpp_mov<0x140>(v)); return v; }
__device__ __forceinline__ float rdlane(float v, int l) { return __builtin_bit_cast(float, __builtin_amdgcn_readlane(__builtin_bit_cast(int, v), l)); }
__device__ __forceinline__ float wave_sum(float v) { v = row_sum(v); return (rdlane(v, 0) + rdlane(v, 16)) + (rdlane(v, 32) + rdlane(v, 48)); }
__device__ __forceinline__ float wave_max(float v) { v = row_max(v); return fmaxf(fmaxf(rdlane(v, 0), rdlane(v, 16)), fmaxf(rdlane(v, 32), rdlane(v, 48))); }
__device__ __forceinline__ float sigmoidf_(float x) { return 1.f / (1.f + __expf(-x)); }
#define LDS_WAIT() asm volatile("s_waitcnt lgkmcnt(0)" ::: "memory")
#define VM_WAIT() asm volatile("s_waitcnt vmcnt(0)" ::: "memory")

__device__ __forceinline__ int tid_from_wave(int wave) { int t = wave * 64 + (int)__builtin_amdgcn_mbcnt_hi(~0u, __builtin_amdgcn_mbcnt_lo(~0u, 0u)); asm volatile("" : "+v"(t)); return t; }

typedef __attribute__((address_space(8))) void* bufrsrc_t;
__device__ __forceinline__ __amdgpu_buffer_rsrc_t make_rsrc(const void* p, unsigned bytes) { return __builtin_amdgcn_make_buffer_rsrc((void*)p, 0, bytes, 0x00020000); }
__device__ __forceinline__ float bload_f32(__amdgpu_buffer_rsrc_t r, int voff, int soff) { return __builtin_bit_cast(float, __builtin_amdgcn_raw_buffer_load_b32(r, voff, soff, 0)); }
#define XB_TMO      128
#define XB_XCNT(j)  (256  + 64 * (j))
#define XB_XSUB(j)  (1280 + 64 * (j))
#define XB_XGEN(j)  (2304 + 64 * (j))
#define XB_TOP      3328
#define XB_TOPGEN   3392
#define XCD_BAR_WORDS 3456
#define XB_SPIN_CAP (1u << 18)

__device__ __forceinline__ unsigned xb_ld(unsigned* p)              { return __hip_atomic_load(p, __ATOMIC_RELAXED, __HIP_MEMORY_SCOPE_AGENT); }
__device__ __forceinline__ unsigned xb_add(unsigned* p, unsigned v) { return __hip_atomic_fetch_add(p, v, __ATOMIC_RELAXED, __HIP_MEMORY_SCOPE_AGENT); }
__device__ __forceinline__ unsigned xb_xcc_id() { return (unsigned)__builtin_amdgcn_s_getreg((3 << 11) | 20) & 0xFu; }
#define XB_SPIN(cond, bar) do { unsigned _sp = 0; while (cond) { __builtin_amdgcn_s_sleep(1); \
    if ((++_sp & 255u) == 0u) { if (xb_ld(&(bar)[XB_TMO])) break; if (_sp > XB_SPIN_CAP) { atomicAdd(&(bar)[XB_TMO], 1u); break; } } } } while (0)

struct XcdBarrier {
    unsigned* bar; unsigned x;
    volatile LAS unsigned* st;
};

__device__ __forceinline__ XcdBarrier xcd_barrier_post(unsigned* bar, volatile LAS unsigned* st) {
    XcdBarrier b; b.bar = bar; b.x = xb_xcc_id(); b.st = st;
    if (threadIdx.x == 0) (void)xb_add(&bar[XB_XCNT(b.x)], 1u);
    return b;
}
__device__ __forceinline__ void xcd_barrier_complete(unsigned* bar, unsigned x, unsigned& nloc, unsigned& nx) {
    const unsigned G = gridDim.x * gridDim.y * gridDim.z;
    unsigned sum, cnt, mine, sp = 0u;
    for (;;) {
        sum = 0u; cnt = 0u; mine = 0u;
#pragma unroll
        for (unsigned j = 0; j < 16; ++j) { const unsigned c = xb_ld(&bar[XB_XCNT(j)]); sum += c; cnt += (c > 0u) ? 1u : 0u; mine = (j == x) ? c : mine; }
        if (sum == G) break;
        __builtin_amdgcn_s_sleep(1);
        if ((++sp & 255u) == 0u) { if (xb_ld(&bar[XB_TMO])) break; if (sp > XB_SPIN_CAP) { atomicAdd(&bar[XB_TMO], 1u); break; } }
    }
    nloc = mine > 0u ? mine : 1u; nx = cnt > 0u ? cnt : 1u;
}

__device__ __forceinline__ void xcd_barrier(const XcdBarrier& b) {
    asm volatile("s_waitcnt vmcnt(0)" ::: "memory");
    __syncthreads();
    if (threadIdx.x == 0) {
        unsigned* bar = b.bar;
        __builtin_amdgcn_s_waitcnt(0);
        unsigned nloc = b.st[0], nx = b.st[1];
        if (nloc == 0u) { xcd_barrier_complete(bar, b.x, nloc, nx); b.st[0] = nloc; b.st[1] = nx; }
        const unsigned old = xb_add(&bar[XB_XSUB(b.x)], 1u);
        const unsigned gen = old / nloc;
        if (old + 1u == (gen + 1u) * nloc) {
            __builtin_amdgcn_fence(__ATOMIC_RELEASE, "agent");
            asm volatile("s_waitcnt vmcnt(0)" ::: "memory");
            const unsigned og = xb_add(&bar[XB_TOP], 1u);
            const unsigned tg = og / nx;
            if (og + 1u == (tg + 1u) * nx) xb_add(&bar[XB_TOPGEN], 1u);
            else XB_SPIN(xb_ld(&bar[XB_TOPGEN]) == tg, bar);
            __builtin_amdgcn_fence(__ATOMIC_ACQUIRE, "agent");
            xb_add(&bar[XB_XGEN(b.x)], 1u);
            asm volatile("s_waitcnt vmcnt(0)" ::: "memory");
        } else {
            XB_SPIN(xb_ld(&bar[XB_XGEN(b.x)]) == gen, bar);
            __builtin_amdgcn_fence(__ATOMIC_ACQUIRE, "agent");
            asm volatile("s_waitcnt vmcnt(0)" ::: "memory");
        }
    }
    __syncthreads();
}


namespace pg8 {
constexpr int BM = 256, BK = 64, HALF = 128, HTB = HALF * BK * 2, STAGE_BYTES = 8 * HTB, NXCD = 8, WGM = 8;
__host__ __device__ __forceinline__ int lds_byte(int r, int c) { const int st = (r >> 4) * 2 + (c >> 5), rr = r & 15, cc = c & 31, ob = rr * 64 + cc * 2; return st * 1024 + (ob ^ (((ob >> 9) & 1) << 5)); }
__host__ __device__ __forceinline__ void stage_rc(int b, int& R, int& C) { const int st = b / 1024, sb = b % 1024, swz = sb ^ (((sb >> 9) & 1) << 5); R = (st >> 1) * 16 + swz / 64; C = (st & 1) * 32 + (swz % 64) / 2; }
__host__ __device__ __forceinline__ int perm32(int rho) { const int n = rho >> 4, i = rho & 15; return 8 * (i >> 2) + 4 * n + (i & 3); }

struct Unit { const char* A; const char* B; char* C; int row0, col0, aux; };
struct GemmP { int K, lda, ldb; };

__device__ __forceinline__ void xcd_tile(int L, int nM, int nN, int& pm, int& pn) {
    const int nwg = nM * nN; int wgid = L;
    { const int q = nwg / NXCD, r = nwg % NXCD, xcd = wgid % NXCD, off = wgid / NXCD; wgid = (xcd < r ? xcd * (q + 1) : r * (q + 1) + (xcd - r) * q) + off; }
    const int nig = WGM * nN, gid = wgid / nig, fm = gid * WGM, gsz = (nM - fm) < WGM ? (nM - fm) : WGM;
    pm = fm + ((wgid % nig) % gsz); pn = (wgid % nig) / gsz;
}

typedef f32x4 Acc[2][2][4][2];

template <class Epi, class Sched, bool GATHER>
__device__ __forceinline__ void gemm_phase(LAS unsigned char* lds, const GemmP g, const Sched& S, const Epi& E, const int wave_id) {
    const int tid = tid_from_wave(wave_id), wid = __builtin_amdgcn_readfirstlane(tid >> 6), lane = tid & 63, wr = wid >> 2, wc = wid & 3, fr = lane & 15, fq = lane >> 4;
    const int K = g.K, nt = K / BK;
    int Rr[2], Cc[2]; unsigned voffB[2];
#pragma unroll
    for (int i = 0; i < 2; ++i) { int R, C; stage_rc(tid * 16 + i * 8192, R, C); const int Rb = Epi::PERM ? ((R & ~31) + perm32(R & 31)) : R;
        Rr[i] = R; Cc[i] = C; voffB[i] = (unsigned)(Rb * g.ldb + C) * 2u; }
    const size_t kstep = (size_t)(BK * 2);
    const size_t hstepB = (size_t)HALF * g.ldb * 2;
    const unsigned ldsw = (unsigned)wid * 1024u;
    const int aoff = lds_byte(wr * 64 + fr, fq * 8), boff = lds_byte(wc * 32 + fr, fq * 8);
#define PG8_SA(b, h) (((b) * 2 + (h)) * HTB)
#define PG8_SB(b, h) ((4 + (b) * 2 + (h)) * HTB)
#define PG8_STAGE_B(bufoff, gbase) do { _Pragma("unroll") for (int _i = 0; _i < 2; ++_i) \
        __builtin_amdgcn_global_load_lds((const unsigned*)((const char*)(gbase) + voffB[_i]), (LAS unsigned*)(lds + (bufoff) + ldsw + _i * 8192), 16, 0, 0); } while (0)
#define PG8_STAGE_A(bufoff, gbase, OFF, h) do { _Pragma("unroll") for (int _i = 0; _i < 2; ++_i) \
        __builtin_amdgcn_global_load_lds((const unsigned*)((const char*)(gbase) + (OFF)[h][_i]), (LAS unsigned*)(lds + (bufoff) + ldsw + _i * 8192), 16, 0, 0); } while (0)
#define PG8_OFFS(u, OFF) do { _Pragma("unroll") for (int _h = 0; _h < 2; ++_h) _Pragma("unroll") for (int _i = 0; _i < 2; ++_i) { \
        const int _row = _h * HALF + Rr[_i]; const int _src = GATHER ? S.arow((u), _row) : _row; (OFF)[_h][_i] = (unsigned)(_src * g.lda + Cc[_i]) * 2u; } } while (0)
#define PG8_LDA(dst, b, h) do { _Pragma("unroll") for (int m = 0; m < 4; ++m) _Pragma("unroll") for (int k = 0; k < 2; ++k) dst[m][k] = *(const LAS bf16x8*)(lds + PG8_SA(b, h) + aoff + m * 2048 + k * 1024); } while (0)
#define PG8_LDB(dst, b, h) do { _Pragma("unroll") for (int n = 0; n < 2; ++n) _Pragma("unroll") for (int k = 0; k < 2; ++k) dst[n][k] = *(const LAS bf16x8*)(lds + PG8_SB(b, h) + boff + n * 2048 + k * 1024); } while (0)
#define PG8_MMA(ai, bj, At, Bt) do { __builtin_amdgcn_s_setprio(1); _Pragma("unroll") for (int m = 0; m < 4; ++m) _Pragma("unroll") for (int n = 0; n < 2; ++n) _Pragma("unroll") for (int k = 0; k < 2; ++k) \
        acc[ai][bj][m][n] = __builtin_amdgcn_mfma_f32_16x16x32_bf16(Bt[n][k], At[m][k], acc[ai][bj][m][n], 0, 0, 0); __builtin_amdgcn_s_setprio(0); } while (0)
#define PG8_WAIT_V(n) asm volatile("s_waitcnt vmcnt(" #n ")" ::: "memory")
#define PG8_WAIT_L(n) asm volatile("s_waitcnt lgkmcnt(" #n ")" ::: "memory")
#define PG8_BAR __builtin_amdgcn_s_barrier()
#define PG8_SCHED __builtin_amdgcn_sched_barrier(0)
    Unit cur, nxt; int ui = 0;
    if (!S.next(0, cur)) return;
    f32x4 acc[2][2][4][2];
#pragma unroll
    for (int a = 0; a < 2; ++a)
#pragma unroll
        for (int b = 0; b < 2; ++b)
#pragma unroll
            for (int m = 0; m < 4; ++m)
#pragma unroll
                for (int n = 0; n < 2; ++n) acc[a][b][m][n] = (f32x4){0.f, 0.f, 0.f, 0.f};
    bf16x8 At[4][2], B0[2][2], B1[2][2];
    const char* cA = cur.A; const char* cB = cur.B;
    unsigned coffA[2][2], noffA[2][2];
    PG8_OFFS(cur, coffA);
    PG8_STAGE_B(PG8_SB(0, 0), cB); PG8_STAGE_A(PG8_SA(0, 0), cA, coffA, 0); PG8_STAGE_B(PG8_SB(0, 1), cB + hstepB); PG8_STAGE_A(PG8_SA(0, 1), cA, coffA, 1);
    if (wr == 1) PG8_BAR;
    PG8_WAIT_V(4); PG8_BAR;
    PG8_STAGE_B(PG8_SB(1, 0), cB + kstep); PG8_STAGE_A(PG8_SA(1, 0), cA + kstep, coffA, 0); PG8_STAGE_B(PG8_SB(1, 1), cB + hstepB + kstep);
    PG8_WAIT_V(6); PG8_BAR;
    for (;;) {
        const bool has_next = S.next(ui + 1, nxt);
        const char* nA = has_next ? nxt.A : cA; const char* nB = has_next ? nxt.B : cB;
        if (has_next) { PG8_OFFS(nxt, noffA); }
        else {
#pragma unroll
            for (int _h = 0; _h < 2; ++_h)
#pragma unroll
                for (int _i = 0; _i < 2; ++_i) noffA[_h][_i] = coffA[_h][_i]; }
        for (int t = 0; t < nt; t += 2) {
            const bool last = (t == nt - 2);
            const char* a1 = cA + (size_t)(t + 1) * kstep;
            const char* a2 = last ? nA : cA + (size_t)(t + 2) * kstep; const char* b2 = last ? nB : cB + (size_t)(t + 2) * kstep;
            const char* a3 = a2 + kstep; const char* b3 = b2 + kstep;
            unsigned o2[2][2];
#pragma unroll
            for (int _h = 0; _h < 2; ++_h)
#pragma unroll
                for (int _i = 0; _i < 2; ++_i) o2[_h][_i] = last ? noffA[_h][_i] : coffA[_h][_i];
            PG8_LDB(B0, 0, 0); PG8_SCHED; PG8_LDA(At, 0, 0); PG8_STAGE_A(PG8_SA(1, 1), a1, coffA, 1);
            PG8_WAIT_L(8); PG8_BAR; PG8_WAIT_L(0); PG8_MMA(0, 0, At, B0); PG8_BAR; PG8_SCHED;
            PG8_LDB(B1, 0, 1); PG8_STAGE_B(PG8_SB(0, 0), b2);
            PG8_BAR; PG8_WAIT_L(0); PG8_MMA(0, 1, At, B1); PG8_BAR;
            PG8_LDA(At, 0, 1); PG8_STAGE_A(PG8_SA(0, 0), a2, o2, 0);
            PG8_BAR; PG8_WAIT_L(0); PG8_MMA(1, 0, At, B0); PG8_BAR; PG8_SCHED;
            PG8_STAGE_B(PG8_SB(0, 1), b2 + hstepB);
            PG8_WAIT_V(6); PG8_BAR; PG8_MMA(1, 1, At, B1); PG8_BAR;
            PG8_LDB(B0, 1, 0); PG8_SCHED; PG8_LDA(At, 1, 0); PG8_STAGE_A(PG8_SA(0, 1), a2, o2, 1);
            PG8_WAIT_L(8); PG8_BAR; PG8_WAIT_L(0); PG8_MMA(0, 0, At, B0); PG8_BAR; PG8_SCHED;
            PG8_LDB(B1, 1, 1); PG8_STAGE_B(PG8_SB(1, 0), b3);
            PG8_BAR; PG8_WAIT_L(0); PG8_MMA(0, 1, At, B1); PG8_BAR;
            PG8_LDA(At, 1, 1); PG8_STAGE_A(PG8_SA(1, 0), a3, o2, 0);
            PG8_BAR; PG8_WAIT_L(0); PG8_MMA(1, 0, At, B0); PG8_BAR; PG8_SCHED;
            PG8_STAGE_B(PG8_SB(1, 1), b3 + hstepB);
            PG8_WAIT_V(6); PG8_BAR; PG8_MMA(1, 1, At, B1); PG8_BAR;
        }
        if constexpr (!Epi::AFTER_DRAIN) { E(acc, cur, wr, wc, fr, fq); }
        if (!has_next) break;
#pragma unroll
        for (int a = 0; a < 2; ++a)
#pragma unroll
            for (int b = 0; b < 2; ++b)
#pragma unroll
                for (int m = 0; m < 4; ++m)
#pragma unroll
                    for (int n = 0; n < 2; ++n) acc[a][b][m][n] = (f32x4){0.f, 0.f, 0.f, 0.f};
        cur = nxt; cA = nA; cB = nB; ++ui;
#pragma unroll
        for (int _h = 0; _h < 2; ++_h)
#pragma unroll
            for (int _i = 0; _i < 2; ++_i) coffA[_h][_i] = noffA[_h][_i];
    }
    PG8_WAIT_V(0);
    if (wr == 0) PG8_BAR;
    PG8_BAR;
    if constexpr (Epi::AFTER_DRAIN) { E.fused(acc, cur, wr, wc, fr, fq, lds, wid, lane); }
#undef PG8_SA
#undef PG8_SB
#undef PG8_STAGE_A
#undef PG8_STAGE_B
#undef PG8_OFFS
#undef PG8_LDA
#undef PG8_LDB
#undef PG8_MMA
#undef PG8_WAIT_V
#undef PG8_WAIT_L
#undef PG8_BAR
#undef PG8_SCHED
}

struct EpiBf16 {
    static constexpr bool PERM = true, AFTER_DRAIN = false;
    int ldc;
    __device__ __forceinline__ void operator()(const Acc& acc, const Unit& u, int wr, int wc, int fr, int fq) const {
        bf16* base = (bf16*)u.C + (size_t)(wr * 64 + fr) * ldc + wc * 32 + 8 * fq;
#pragma unroll
        for (int ai = 0; ai < 2; ++ai)
#pragma unroll
            for (int m = 0; m < 4; ++m) { bf16* rowp = base + (size_t)(ai * HALF + m * 16) * ldc;
#pragma unroll
                for (int bj = 0; bj < 2; ++bj) { const f32x4 v0 = acc[ai][bj][m][0], v1 = acc[ai][bj][m][1];
                    u32x4 w; w.x = pk2(v0[0], v0[1]); w.y = pk2(v0[2], v0[3]); w.z = pk2(v1[0], v1[1]); w.w = pk2(v1[2], v1[3]);
                    *(u32x4*)(rowp + bj * HALF) = w; } }
    }
};
struct EpiF32Res {
    static constexpr bool PERM = false, AFTER_DRAIN = false;
    int ldc; const float* resid; float* out;
    __device__ __forceinline__ void operator()(const Acc& acc, const Unit& u, int wr, int wc, int fr, int fq) const {
        const size_t o0 = (size_t)(u.row0 + wr * 64 + fr) * ldc + u.col0 + wc * 32 + 4 * fq;
#pragma unroll
        for (int ai = 0; ai < 2; ++ai)
#pragma unroll
            for (int m = 0; m < 4; ++m) { const size_t ro = o0 + (size_t)(ai * HALF + m * 16) * ldc;
#pragma unroll
                for (int bj = 0; bj < 2; ++bj)
#pragma unroll
                    for (int n = 0; n < 2; ++n) { const size_t o = ro + bj * HALF + n * 16; const f32x4 b = *(const f32x4*)(resid + o); *(f32x4*)(out + o) = acc[ai][bj][m][n] + b; } }
    }
};
struct EpiSwiGlu {
    static constexpr bool PERM = true, AFTER_DRAIN = false;
    int ldc;
    __device__ __forceinline__ void operator()(const Acc& acc, const Unit& u, int wr, int wc, int fr, int fq) const {
        bf16* base = (bf16*)u.C + (size_t)(wr * 64 + fr) * ldc + wc * 32 + 8 * fq;
#pragma unroll
        for (int ai = 0; ai < 2; ++ai)
#pragma unroll
            for (int m = 0; m < 4; ++m) { bf16* rowp = base + (size_t)(ai * HALF + m * 16) * ldc;
                float h[8];
#pragma unroll
                for (int n = 0; n < 2; ++n)
#pragma unroll
                    for (int e = 0; e < 4; ++e) { const float a = acc[ai][0][m][n][e], b = acc[ai][1][m][n][e]; h[n * 4 + e] = a / (1.f + __expf(-a)) * b; }
                u32x4 w; w.x = pk2(h[0], h[1]); w.y = pk2(h[2], h[3]); w.z = pk2(h[4], h[5]); w.w = pk2(h[6], h[7]);
                *(u32x4*)rowp = w; }
    }
};
struct EpiGate {
    static constexpr bool PERM = true, AFTER_DRAIN = false;
    int ldc; const float* egate; const int* cnt_lds_unused;
    __device__ __forceinline__ void operator()(const Acc& acc, const Unit& u, int wr, int wc, int fr, int fq) const {
        bf16* base = (bf16*)u.C + (size_t)(wr * 64 + fr) * ldc + wc * 32 + 8 * fq;
        const int e = u.aux >> 16, nvalid = u.aux & 0xffff;
        const float* gp = egate + (size_t)e * ECAP + u.row0;
#pragma unroll
        for (int ai = 0; ai < 2; ++ai)
#pragma unroll
            for (int m = 0; m < 4; ++m) { const int r = ai * HALF + wr * 64 + m * 16 + fr; const float gt = (r < nvalid) ? gp[r] : 0.f;
                bf16* rowp = base + (size_t)(ai * HALF + m * 16) * ldc;
#pragma unroll
                for (int bj = 0; bj < 2; ++bj) { const f32x4 v0 = acc[ai][bj][m][0] * gt, v1 = acc[ai][bj][m][1] * gt;
                    u32x4 w; w.x = pk2(v0[0], v0[1]); w.y = pk2(v0[2], v0[3]); w.z = pk2(v1[0], v1[1]); w.w = pk2(v1[2], v1[3]);
                    *(u32x4*)(rowp + bj * HALF) = w; } }
    }
};
struct EpiSoftmax {
    static constexpr bool PERM = true, AFTER_DRAIN = true;
    int ldc; float scale_log2e;
    __device__ __forceinline__ void operator()(const Acc&, const Unit&, int, int, int, int) const {}
    __device__ __forceinline__ void fused(const Acc& acc, const Unit& u, int wr, int wc, int fr, int fq, LAS unsigned char* lds, int wid, int lane) const {
        LAS float* RM = (LAS float*)lds;
        LAS float* RS = (LAS float*)(lds + 4096);
        float mx[2][4];
#pragma unroll
        for (int ai = 0; ai < 2; ++ai)
#pragma unroll
            for (int m = 0; m < 4; ++m) { float v = -3.0e38f;
#pragma unroll
                for (int bj = 0; bj < 2; ++bj)
#pragma unroll
                    for (int n = 0; n < 2; ++n) { const f32x4 x = acc[ai][bj][m][n]; v = fmaxf(v, fmaxf(fmaxf(x[0], x[1]), fmaxf(x[2], x[3]))); }
                v = fmaxf(v, __shfl_xor(v, 16)); v = fmaxf(v, __shfl_xor(v, 32));
                if (fq == 0) RM[(ai * HALF + wr * 64 + m * 16 + fr) * 4 + wc] = v; }
        asm volatile("s_waitcnt lgkmcnt(0)" ::: "memory"); __builtin_amdgcn_s_barrier(); asm volatile("" ::: "memory");
#pragma unroll
        for (int ai = 0; ai < 2; ++ai)
#pragma unroll
            for (int m = 0; m < 4; ++m) { const int row = ai * HALF + wr * 64 + m * 16 + fr; const f32x4 q = *(const LAS f32x4*)(RM + row * 4);
                const float M = fmaxf(fmaxf(q[0], q[1]), fmaxf(q[2], q[3])); const float mc = -M * scale_log2e; float s = 0.f;
#pragma unroll
                for (int bj = 0; bj < 2; ++bj)
#pragma unroll
                    for (int n = 0; n < 2; ++n)
#pragma unroll
                        for (int e = 0; e < 4; ++e) s += __builtin_amdgcn_exp2f(fmaf(acc[ai][bj][m][n][e], scale_log2e, mc));
                s += __shfl_xor(s, 16); s += __shfl_xor(s, 32);
                if (fq == 0) RS[row * 4 + wc] = s; }
        asm volatile("s_waitcnt lgkmcnt(0)" ::: "memory"); __builtin_amdgcn_s_barrier(); asm volatile("" ::: "memory");
        bf16* base = (bf16*)u.C + (size_t)(wr * 64 + fr) * ldc + wc * 32 + 8 * fq;
#pragma unroll
        for (int ai = 0; ai < 2; ++ai)
#pragma unroll
            for (int m = 0; m < 4; ++m) { const int row = ai * HALF + wr * 64 + m * 16 + fr; const f32x4 q = *(const LAS f32x4*)(RS + row * 4); const f32x4 qm = *(const LAS f32x4*)(RM + row * 4);
                const float M = fmaxf(fmaxf(qm[0], qm[1]), fmaxf(qm[2], qm[3])); const float mc = -M * scale_log2e;
                const float inv = 1.f / ((q[0] + q[1]) + (q[2] + q[3])); bf16* rowp = base + (size_t)(ai * HALF + m * 16) * ldc;
#pragma unroll
                for (int bj = 0; bj < 2; ++bj) { float pp[8];
#pragma unroll
                    for (int n = 0; n < 2; ++n)
#pragma unroll
                        for (int e = 0; e < 4; ++e) pp[n * 4 + e] = __builtin_amdgcn_exp2f(fmaf(acc[ai][bj][m][n][e], scale_log2e, mc)) * inv;
                    u32x4 w; w.x = pk2(pp[0], pp[1]); w.y = pk2(pp[2], pp[3]); w.z = pk2(pp[4], pp[5]); w.w = pk2(pp[6], pp[7]);
                    *(u32x4*)(rowp + bj * HALF) = w; } }
        asm volatile("s_waitcnt lgkmcnt(0)" ::: "memory"); __builtin_amdgcn_s_barrier(); asm volatile("" ::: "memory");
    }
};
}

namespace att {
constexpr int KVBLK = 64;
constexpr size_t SHM_V = KVBLK * 128 * 2, SHM_K = KVBLK * 128 * 2;
#define KSWZ(row, colB) ((row) * 256 + ((colB) ^ (((row) & 7) << 4)))
#define SBAR() __builtin_amdgcn_sched_barrier(0)
__device__ __forceinline__ int crow(int r, int hi) { return (r & 3) + 8 * (r >> 2) + 4 * hi; }
__device__ __forceinline__ bf16x8 ld8(const bf16* p) { return *reinterpret_cast<const bf16x8*>(p); }

__device__ __forceinline__ void partialSM(f32x16& p0, f32x16& p1, float& m_reg, float& mn, float& alpha, const float SCALE, const float THR) {
  const float C = SCALE * 1.4426950408889634f;
  float pmax = p0[0];
#pragma unroll
  for (int r = 1; r < 16; ++r) pmax = fmaxf(pmax, p0[r]);
#pragma unroll
  for (int r = 0; r < 16; ++r) pmax = fmaxf(pmax, p1[r]);
  { auto rr = __builtin_amdgcn_permlane32_swap(__float_as_uint(pmax), __float_as_uint(pmax), false, false);
    pmax = fmaxf(__uint_as_float(rr[0]), __uint_as_float(rr[1])); }
  if (__builtin_expect(__all(pmax - m_reg <= THR / SCALE), 1)) { mn = m_reg; alpha = 1.f; }
  else { mn = fmaxf(m_reg, pmax); alpha = __builtin_amdgcn_exp2f((m_reg - mn) * C); m_reg = mn; }
  const float mnC = -mn * C;
#pragma unroll
  for (int r = 0; r < 16; ++r) p0[r] = fmaf(p0[r], C, mnC);
#pragma unroll
  for (int r = 0; r < 16; ++r) p1[r] = fmaf(p1[r], C, mnC);
#pragma unroll
  for (int r = 0; r < 16; ++r) p0[r] = __builtin_amdgcn_exp2f(p0[r]);
}
__device__ __forceinline__ void finishSM(f32x16& p0, f32x16& p1, float alpha, float& l_reg, bf16x8& pa0, bf16x8& pa1, bf16x8& pa2, bf16x8& pa3) {
#pragma unroll
  for (int r = 0; r < 16; ++r) p1[r] = __builtin_amdgcn_exp2f(p1[r]);
  float ps = 0;
#pragma unroll
  for (int r = 0; r < 16; ++r) ps += p0[r];
#pragma unroll
  for (int r = 0; r < 16; ++r) ps += p1[r];
  { auto rr = __builtin_amdgcn_permlane32_swap(__float_as_uint(ps), __float_as_uint(ps), false, false);
    ps = __uint_as_float(rr[0]) + __uint_as_float(rr[1]); }
  l_reg = l_reg * alpha + ps;
#define PK4(P, BASE, OUT) do { unsigned a0 = pk2(P[BASE + 0], P[BASE + 1]), a1 = pk2(P[BASE + 2], P[BASE + 3]);   \
    unsigned b0 = pk2(P[BASE + 4], P[BASE + 5]), b1 = pk2(P[BASE + 6], P[BASE + 7]);                              \
    auto r0 = __builtin_amdgcn_permlane32_swap(a0, b0, false, false); auto r1 = __builtin_amdgcn_permlane32_swap(a1, b1, false, false); \
    u32x4 w = {r0[0], r1[0], r0[1], r1[1]}; OUT = *reinterpret_cast<bf16x8*>(&w); } while (0)
  PK4(p0, 0, pa0); PK4(p0, 8, pa1); PK4(p1, 0, pa2); PK4(p1, 8, pa3);
#undef PK4
}
template <int ND0> __device__ __forceinline__ void qkt(f32x16& p0, f32x16& p1, const char* Ks, const bf16x8* qr, int r32, int hi, int c0) {
  p0 = f32x16{}; p1 = f32x16{};
#pragma unroll
  for (int d0 = 0; d0 < ND0; ++d0) { const int cb = (c0 + d0 * 16 + hi * 8) * 2;
    const bf16x8 b0 = *reinterpret_cast<const bf16x8*>(Ks + KSWZ(r32, cb));
    const bf16x8 b1 = *reinterpret_cast<const bf16x8*>(Ks + KSWZ(32 + r32, cb));
    p0 = __builtin_amdgcn_mfma_f32_32x32x16_bf16(b0, qr[d0], p0, 0, 0, 0);
    p1 = __builtin_amdgcn_mfma_f32_32x32x16_bf16(b1, qr[d0], p1, 0, 0, 0); }
}
__device__ __forceinline__ int v_st(int k, int c) { const int kk = (k & ~0xC) | ((k & 4) << 1) | ((k & 8) >> 1); return ((kk >> 3) * 4 + (c >> 5)) * 512 + ((kk & 7) * 32 + (c & 31)) * 2; }
__device__ __forceinline__ int v_rd_base(int lane) { return ((lane & 3) << 3) | (((lane >> 2) & 3) << 6) | (((lane >> 4) & 1) << 5) | (((lane >> 5) & 1) << 8); }
constexpr int v_rd_off(int d0, int ks, int half) { return d0 * 512 + ks * 4096 + half * 2048; }
template <int OFF> __device__ __forceinline__ s16x4 tr_read(int vb) {
  s16x4 r; asm volatile("ds_read_b64_tr_b16 %0, %1 offset:%2" : "=&v"(r) : "v"(vb), "i"(OFF) : "memory"); return r;
}
template <int D0> __device__ __forceinline__ void pv_one(f32x16& od, int vb, bf16x8 pa0, bf16x8 pa1, bf16x8 pa2, bf16x8 pa3) {
  const s16x4 l0 = tr_read<v_rd_off(D0, 0, 0)>(vb), h0 = tr_read<v_rd_off(D0, 0, 1)>(vb), l1 = tr_read<v_rd_off(D0, 1, 0)>(vb), h1 = tr_read<v_rd_off(D0, 1, 1)>(vb);
  const s16x4 l2 = tr_read<v_rd_off(D0, 2, 0)>(vb), h2 = tr_read<v_rd_off(D0, 2, 1)>(vb), l3 = tr_read<v_rd_off(D0, 3, 0)>(vb), h3 = tr_read<v_rd_off(D0, 3, 1)>(vb);
  asm volatile("s_waitcnt lgkmcnt(0)" ::: "memory"); SBAR();
#define PK(L, H) (bf16x8){L[0], L[1], L[2], L[3], H[0], H[1], H[2], H[3]}
  od = __builtin_amdgcn_mfma_f32_32x32x16_bf16(pa0, PK(l0, h0), od, 0, 0, 0);
  od = __builtin_amdgcn_mfma_f32_32x32x16_bf16(pa1, PK(l1, h1), od, 0, 0, 0);
  od = __builtin_amdgcn_mfma_f32_32x32x16_bf16(pa2, PK(l2, h2), od, 0, 0, 0);
  od = __builtin_amdgcn_mfma_f32_32x32x16_bf16(pa3, PK(l3, h3), od, 0, 0, 0);
#undef PK
}
__device__ __forceinline__ void pv_d0(f32x16* o, int vb, bf16x8 pa0, bf16x8 pa1, bf16x8 pa2, bf16x8 pa3) {
  pv_one<0>(o[0], vb, pa0, pa1, pa2, pa3); pv_one<1>(o[1], vb, pa0, pa1, pa2, pa3); pv_one<2>(o[2], vb, pa0, pa1, pa2, pa3); pv_one<3>(o[3], vb, pa0, pa1, pa2, pa3);
}

__device__ __forceinline__ void diff_attn_unit(const bf16* Qb, const bf16* Kh, const bf16* Vh, int ld, int seq, bf16* outb, int ldo,
                                               const float lam, const float post_scale, const float* subln_g, char* lds, const int wave_id) {
  constexpr float SCALE = 0.125f, THR = 8.f;
  const int tid = tid_from_wave(wave_id), wid = __builtin_amdgcn_readfirstlane(tid >> 6), lane = tid & 63, r32 = lane & 31, hi = lane >> 5;
  const int csel = wid >> 2, wq = wid & 3;
  char* V_lds = lds; char* K_lds = lds + 2 * SHM_V;
  float* ws = (float*)(lds + 2 * SHM_V + 2 * SHM_K) + wid * 64; float* li_l = ws; float* al_l = ws + 32;
  float m_reg = -1e30f, l_reg = 0; f32x16 o[4] = {}; bf16x8 qr[4];
  const bf16* Qw = Qb + (long)(wq * 32 + r32) * ld + csel * 64 + hi * 8;
#pragma unroll
  for (int d0 = 0; d0 < 4; ++d0) qr[d0] = ld8(Qw + d0 * 16);
  const int sr = tid >> 4, sc = (tid & 15) * 8, vst0 = v_st(sr, sc), vst1 = v_st(32 + sr, sc);
  const int vb0 = (int)(uintptr_t)V_lds + v_rd_base(lane);
  const int kc0 = csel * 64;
  struct { bf16x8 vs0, vs1, ks0, ks1; } sr_[2];
#define SLOAD(i, k0) do { sr_[i].vs0 = ld8(&Vh[(long)((k0) + sr) * ld + sc]); sr_[i].vs1 = ld8(&Vh[(long)((k0) + 32 + sr) * ld + sc]); \
    sr_[i].ks0 = ld8(&Kh[(long)((k0) + sr) * ld + sc]); sr_[i].ks1 = ld8(&Kh[(long)((k0) + 32 + sr) * ld + sc]); } while (0)
#define SWRITE(b, i) do { *(bf16x8*)(V_lds + (b) * SHM_V + vst0) = sr_[i].vs0;          \
    *(bf16x8*)(V_lds + (b) * SHM_V + vst1) = sr_[i].vs1; const int kc = sc * 2;               \
    *(bf16x8*)(K_lds + (b) * SHM_K + KSWZ(sr, kc)) = sr_[i].ks0;                       \
    *(bf16x8*)(K_lds + (b) * SHM_K + KSWZ(32 + sr, kc)) = sr_[i].ks1; } while (0)
#define SWAIT() asm volatile("s_waitcnt vmcnt(4)" ::: "memory")
#define RESC(a) do { if (__any((a) < 1.f)) { if (hi == 0) al_l[r32] = (a); asm volatile("s_waitcnt lgkmcnt(0)" ::: "memory"); \
    _Pragma("unroll") for (int d = 0; d < 4; ++d) _Pragma("unroll") for (int r = 0; r < 16; ++r) o[d][r] *= al_l[crow(r, hi)]; } } while (0)
  f32x16 pA0, pA1, pB0, pB1; float mnA, mnB, alA, alB; bf16x8 pa0, pa1, pa2, pa3; const int NT = seq / KVBLK;
  constexpr int SE = 0, SO = 1;
  __syncthreads();
  SLOAD(SE, 0); asm volatile("s_waitcnt vmcnt(0)" ::: "memory"); SWRITE(0, SE); __syncthreads();
  qkt<4>(pA0, pA1, K_lds, qr, r32, hi, kc0); partialSM(pA0, pA1, m_reg, mnA, alA, SCALE, THR);
  SLOAD(SO, KVBLK); if (2 < NT) SLOAD(SE, 2 * KVBLK);
  SWAIT(); SWRITE(1, SO); __syncthreads();
  for (int j = 1; j + 1 < NT; j += 2) {
    SBAR(); qkt<4>(pB0, pB1, K_lds + SHM_K, qr, r32, hi, kc0);
    finishSM(pA0, pA1, alA, l_reg, pa0, pa1, pa2, pa3); SBAR();
    SLOAD(SO, (j + 2) * KVBLK); SBAR();
    pv_d0(o, vb0, pa0, pa1, pa2, pa3); partialSM(pB0, pB1, m_reg, mnB, alB, SCALE, THR);
    __syncthreads(); SWAIT(); SWRITE(0, SE);
    RESC(alB); __syncthreads();
    SBAR(); qkt<4>(pA0, pA1, K_lds, qr, r32, hi, kc0);
    finishSM(pB0, pB1, alB, l_reg, pa0, pa1, pa2, pa3); SBAR();
    if (j + 3 < NT) SLOAD(SE, (j + 3) * KVBLK); SBAR();
    pv_d0(o, vb0 + (int)SHM_V, pa0, pa1, pa2, pa3); partialSM(pA0, pA1, m_reg, mnA, alA, SCALE, THR);
    __syncthreads(); SWAIT(); SWRITE(1, SO);
    RESC(alA); __syncthreads();
  }
  SBAR(); qkt<4>(pB0, pB1, K_lds + SHM_K, qr, r32, hi, kc0);
  finishSM(pA0, pA1, alA, l_reg, pa0, pa1, pa2, pa3); SBAR();
  pv_d0(o, vb0, pa0, pa1, pa2, pa3); partialSM(pB0, pB1, m_reg, mnB, alB, SCALE, THR);
  __syncthreads(); RESC(alB);
  finishSM(pB0, pB1, alB, l_reg, pa0, pa1, pa2, pa3); SBAR();
  pv_d0(o, vb0 + (int)SHM_V, pa0, pa1, pa2, pa3);
  asm volatile("s_waitcnt vmcnt(0)" ::: "memory");
  if (hi == 0) li_l[r32] = l_reg; asm volatile("s_waitcnt lgkmcnt(0)" ::: "memory");
  float rli[16];
#pragma unroll
  for (int r = 0; r < 16; ++r) rli[r] = __builtin_amdgcn_rcpf(li_l[crow(r, hi)]);
  __syncthreads();
  float* X = (float*)lds + (size_t)wq * 4096;
  if (csel == 1) {
#pragma unroll
    for (int d0 = 0; d0 < 4; ++d0)
#pragma unroll
      for (int r = 0; r < 16; ++r) X[(d0 * 16 + r) * 64 + lane] = o[d0][r] * rli[r];
  }
  __syncthreads();
  if (csel == 0) {
    float ss[16];
#pragma unroll
    for (int r = 0; r < 16; ++r) ss[r] = 0.f;
#pragma unroll
    for (int d0 = 0; d0 < 4; ++d0)
#pragma unroll
      for (int r = 0; r < 16; ++r) { const float v = o[d0][r] * rli[r] - lam * X[(d0 * 16 + r) * 64 + lane]; o[d0][r] = v; ss[r] += v * v; }
#pragma unroll
    for (int r = 0; r < 16; ++r) { float s = ss[r];
      s += __shfl_xor(s, 1); s += __shfl_xor(s, 2); s += __shfl_xor(s, 4); s += __shfl_xor(s, 8); s += __shfl_xor(s, 16);
      ss[r] = __builtin_amdgcn_rsqf(s * (1.f / 128.f) + RMS_EPS) * post_scale; }
    float gg[4];
#pragma unroll
    for (int d0 = 0; d0 < 4; ++d0) gg[d0] = subln_g[d0 * 32 + r32];
    bf16* Ow = outb + (long)(wq * 32) * ldo;
#pragma unroll
    for (int r = 0; r < 16; ++r) { const int orow = crow(r, hi);
#pragma unroll
      for (int d0 = 0; d0 < 4; ++d0) Ow[(long)orow * ldo + d0 * 32 + r32] = f2bf(o[d0][r] * ss[r] * gg[d0]); }
  }
#undef SLOAD
#undef SWRITE
#undef SWAIT
}

__device__ __forceinline__ void dil_attn_unit(const bf16* Qh, const bf16* Kh, const bf16* Vh, int ld, int dil, int rho, int u0, int L,
                                              float* Oc, float* lsep, char* lds, const int wave_id) {
  constexpr float SCALE = 0.08838834764831845f; constexpr float C = SCALE * 1.4426950408889634f;
  const int tid = tid_from_wave(wave_id), wid = __builtin_amdgcn_readfirstlane(tid >> 6), lane = tid & 63, r32 = lane & 31, hi = lane >> 5;
  char* V_lds = lds; char* K_lds = lds + 2 * SHM_V;
  float* ws = (float*)(lds + 2 * SHM_V + 2 * SHM_K) + wid * 64; float* li_l = ws; float* al_l = ws + 32;
  float m_reg = -1e30f, l_reg = 0; f32x16 o[4] = {}; bf16x8 qr[8];
  const int uq = u0 + wid * 32 + r32;
  const bf16* Qw = Qh + (long)(rho + dil * uq) * ld + hi * 8;
#pragma unroll
  for (int d0 = 0; d0 < 8; ++d0) qr[d0] = ld8(Qw + d0 * 16);
  const int sr = tid >> 4, sc = (tid & 15) * 8, vst0 = v_st(sr, sc), vst1 = v_st(32 + sr, sc);
  const int vb0 = (int)(uintptr_t)V_lds + v_rd_base(lane);
  const int tlo = wid >> 1;
  for (int t = 0; t < 6; ++t) {
    const int kt0 = u0 - 64 + 64 * t;
    __syncthreads();
    { int ua = kt0 + sr, ub = kt0 + 32 + sr; ua = ua < 0 ? 0 : (ua >= L ? L - 1 : ua); ub = ub < 0 ? 0 : (ub >= L ? L - 1 : ub);
      const long ra = (long)(rho + dil * ua) * ld + sc, rb = (long)(rho + dil * ub) * ld + sc;
      const bf16x8 va = ld8(Vh + ra), vb = ld8(Vh + rb), ka = ld8(Kh + ra), kb = ld8(Kh + rb);
      *(bf16x8*)(V_lds + vst0) = va; *(bf16x8*)(V_lds + vst1) = vb; const int kc = sc * 2;
      *(bf16x8*)(K_lds + KSWZ(sr, kc)) = ka; *(bf16x8*)(K_lds + KSWZ(32 + sr, kc)) = kb; }
    __syncthreads();
    if (t >= tlo && t <= tlo + 2) {
      f32x16 p0, p1;
      qkt<8>(p0, p1, K_lds, qr, r32, hi, 0);
#pragma unroll
      for (int r = 0; r < 16; ++r) { const int uk0 = kt0 + crow(r, hi), uk1 = uk0 + 32; const int d0 = uk0 - uq, d1 = uk1 - uq;
        const bool ok0 = (uk0 >= 0) && (uk0 < L) && (d0 >= -64) && (d0 <= 64), ok1 = (uk1 >= 0) && (uk1 < L) && (d1 >= -64) && (d1 <= 64);
        p0[r] = ok0 ? p0[r] : -1e30f; p1[r] = ok1 ? p1[r] : -1e30f; }
      float pmax = p0[0];
#pragma unroll
      for (int r = 1; r < 16; ++r) pmax = fmaxf(pmax, p0[r]);
#pragma unroll
      for (int r = 0; r < 16; ++r) pmax = fmaxf(pmax, p1[r]);
      { auto rr = __builtin_amdgcn_permlane32_swap(__float_as_uint(pmax), __float_as_uint(pmax), false, false);
        pmax = fmaxf(__uint_as_float(rr[0]), __uint_as_float(rr[1])); }
      const float mn = fmaxf(m_reg, pmax); const float alpha = __builtin_amdgcn_exp2f((m_reg - mn) * C); m_reg = mn;
      const float mnC = -mn * C;
#pragma unroll
      for (int r = 0; r < 16; ++r) { p0[r] = __builtin_amdgcn_exp2f(fmaf(p0[r], C, mnC)); p1[r] = fmaf(p1[r], C, mnC); }
      bf16x8 pa0, pa1, pa2, pa3;
      finishSM(p0, p1, alpha, l_reg, pa0, pa1, pa2, pa3);
      RESC(alpha);
      pv_d0(o, vb0, pa0, pa1, pa2, pa3);
    }
  }
  if (hi == 0) li_l[r32] = l_reg; asm volatile("s_waitcnt lgkmcnt(0)" ::: "memory");
  float rli[16];
#pragma unroll
  for (int r = 0; r < 16; ++r) rli[r] = __builtin_amdgcn_rcpf(li_l[crow(r, hi)]);
#pragma unroll
  for (int r = 0; r < 16; ++r) { const int uo = u0 + wid * 32 + crow(r, hi); float* orow = Oc + (long)(rho + dil * uo) * 512;
#pragma unroll
    for (int d0 = 0; d0 < 4; ++d0) orow[d0 * 32 + r32] = o[d0][r] * rli[r]; }
  if (hi == 0) lsep[(long)(rho + dil * uq) * 4] = m_reg * SCALE + __logf(l_reg);
}
#undef RESC
#undef KSWZ
#undef SBAR
}

struct Args { const float* in[N_INPUTS]; float* out; unsigned char* ws; int ph_lo, ph_hi; };
typedef const __attribute__((address_space(4))) Args* ArgsP;
struct Frame {
    LAS unsigned char* lds; volatile LAS unsigned* MISC; unsigned* ctl; unsigned char* ws;
    int tid, lane, wave, G, bid;
};
constexpr int PH_P0 = 0, PH_P1 = 1, PH_P2 = 2, PH_L0 = 3, NPH_L = 13, PH_FINAL = PH_L0 + DEPTH * NPH_L, NPHASES = PH_FINAL + 1;
enum { LP_NORM1 = 0, LP_G1, LP_PREP, LP_CPREP, LP_MIX, LP_POST, LP_G2, LP_NORM2, LP_GS, LP_GO, LP_NORM3, LP_M1, LP_M2 };

__device__ __forceinline__ int q_next(Frame& F, int q) {
    __syncthreads();
    if (F.tid == 0) F.MISC[0] = __hip_atomic_fetch_add(F.ctl + CW_Q + 64 * q, 1u, __ATOMIC_RELAXED, __HIP_MEMORY_SCOPE_AGENT);
    __syncthreads();
    return (int)F.MISC[0];
}

template <class RowMap>
__device__ __forceinline__ void transpose_item(const float* W, int ldn, bf16* WT, int ldt, RowMap rm, LAS float* scr, int k0, int n0, int lane) {
#pragma unroll 8
    for (int i = 0; i < 32; ++i) { const int kk = 2 * i + (lane >> 5); scr[kk * 33 + (lane & 31)] = W[(size_t)(k0 + kk) * ldn + n0 + (lane & 31)]; }
    LDS_WAIT(); asm volatile("" ::: "memory");
    const int c = lane & 7;
#pragma unroll
    for (int j = 0; j < 4; ++j) { const int n = (lane >> 3) + 8 * j; const LAS float* s = scr + (8 * c) * 33 + n;
        u32x4 o; o.x = pk2(s[0 * 33], s[1 * 33]); o.y = pk2(s[2 * 33], s[3 * 33]); o.z = pk2(s[4 * 33], s[5 * 33]); o.w = pk2(s[6 * 33], s[7 * 33]);
        *(u32x4*)(WT + (size_t)rm(n0 + n) * ldt + k0 + 8 * c) = o; }
    LDS_WAIT(); asm volatile("" ::: "memory");
}
struct RmId { __device__ __forceinline__ int operator()(int n) const { return n; } };
struct RmW13 { int off; __device__ __forceinline__ int operator()(int n) const { return 256 * (n >> 7) + off + (n & 127); } };

__device__ __forceinline__ void p0_prologue(Frame& F, ArgsP a) {
    unsigned char* ws = F.ws;
    LAS float* scr = (LAS float*)(F.lds + F.wave * 16384);
    const int gw = F.bid * 8 + F.wave, NGW = F.G * 8;
    constexpr int I_WIN = (DM / 64) * (IN_TOTAL / 32), I_SQ = (DM / 64) * (DM / 32), I_WKV = (DM / 64) * (4096 / 32), I_W1 = (DM / 64) * (DEXP / 32), I_W2 = (DEXP / 64) * (DM / 32);
    constexpr int PER_L = I_WIN + I_SQ + I_WKV + I_SQ + NEXP * (2 * I_W1 + I_W2);
    for (int it = gw; it < DEPTH * PER_L; it += NGW) {
        const int l = it / PER_L; int r = it % PER_L;
        if (r < I_WIN) { const int nb = IN_TOTAL / 32; transpose_item(a->in[I_W_IN] + (size_t)l * DM * IN_TOTAL, IN_TOTAL, (bf16*)(ws + WS_WIN) + (size_t)l * ZLD * DM, DM, RmId{}, scr, 64 * (r / nb), 32 * (r % nb), F.lane); continue; } r -= I_WIN;
        if (r < I_SQ) { const int nb = DM / 32; transpose_item(a->in[I_W_OUT] + (size_t)l * DM * DM, DM, (bf16*)(ws + WS_WOUT) + (size_t)l * DM * DM, DM, RmId{}, scr, 64 * (r / nb), 32 * (r % nb), F.lane); continue; } r -= I_SQ;
        if (r < I_WKV) { const int nb = 4096 / 32; transpose_item(a->in[I_XA_WKV] + (size_t)l * DM * 4096, 4096, (bf16*)(ws + SC_WKVT) + (size_t)l * 4096 * DM, DM, RmId{}, scr, 64 * (r / nb), 32 * (r % nb), F.lane); continue; } r -= I_WKV;
        if (r < I_SQ) { const int nb = DM / 32; transpose_item(a->in[I_XA_WO] + (size_t)l * DM * DM, DM, (bf16*)(ws + SC_WOT) + (size_t)l * DM * DM, DM, RmId{}, scr, 64 * (r / nb), 32 * (r % nb), F.lane); continue; } r -= I_SQ;
        const int e = r / (2 * I_W1 + I_W2); r = r % (2 * I_W1 + I_W2);
        const size_t le = (size_t)l * NEXP + e;
        if (r < I_W1) { const int nb = DEXP / 32; transpose_item(a->in[I_MOE_W1] + le * DM * DEXP, DEXP, (bf16*)(ws + WS_W13) + le * 1024 * DM, DM, RmW13{0}, scr, 64 * (r / nb), 32 * (r % nb), F.lane); continue; } r -= I_W1;
        if (r < I_W1) { const int nb = DEXP / 32; transpose_item(a->in[I_MOE_W3] + le * DM * DEXP, DEXP, (bf16*)(ws + WS_W13) + le * 1024 * DM, DM, RmW13{128}, scr, 64 * (r / nb), 32 * (r % nb), F.lane); continue; } r -= I_W1;
        { const int nb = DM / 32; transpose_item(a->in[I_MOE_W2] + le * DEXP * DM, DM, (bf16*)(ws + WS_W2) + le * DM * DEXP, DEXP, RmId{}, scr, 64 * (r / nb), 32 * (r % nb), F.lane); }
    }
    const int gt = F.bid * 512 + F.tid, NGT = F.G * 512;
    for (int i = gt; i < DEPTH * (ZLD - IN_TOTAL) * DM / 8; i += NGT) { const int l = i / ((ZLD - IN_TOTAL) * DM / 8), r = i % ((ZLD - IN_TOTAL) * DM / 8);
        *(u32x4*)((bf16*)(ws + WS_WIN) + (size_t)l * ZLD * DM + (size_t)IN_TOTAL * DM + (size_t)r * 8) = (u32x4){0u, 0u, 0u, 0u}; }
    for (int i = gt; i < DEPTH * DM * DM / 8; i += NGT) { const f32x4 x0 = *(const f32x4*)(a->in[I_XA_WQ] + (size_t)i * 8), x1 = *(const f32x4*)(a->in[I_XA_WQ] + (size_t)i * 8 + 4);
        u32x4 o; o.x = pk2(x0[0], x0[1]); o.y = pk2(x0[2], x0[3]); o.z = pk2(x1[0], x1[1]); o.w = pk2(x1[2], x1[3]); *(u32x4*)((bf16*)(ws + SC_WQB) + (size_t)i * 8) = o; }
    { float* cosA = (float*)(ws + WS_ROPE); float* sinA = cosA + SEQ * 32; float* cosC = sinA + SEQ * 32; float* sinC = cosC + SEQ * 64;
      for (int i = gt; i < SEQ * 96; i += NGT) { const int s = i / 96, j = i % 96; const bool isA = j < 32; const int jj = isA ? j : j - 32; const float dim = isA ? 64.f : 128.f;
          const float inv = 1.0f / powf(10000.0f, (float)(2 * jj) / dim); const float ang = (float)s * inv; float sn, cs; sincosf(ang, &sn, &cs);
          if (isA) { cosA[s * 32 + jj] = cs; sinA[s * 32 + jj] = sn; } else { cosC[s * 64 + jj] = cs; sinC[s * 64 + jj] = sn; } } }
    for (int i = gt; i < DEPTH * 2 * 32 * 64; i += NGT) { const int l = i / (2 * 32 * 64), r = i % (2 * 32 * 64), dir = r / (32 * 64), g = (r / 64) % 32, n = r % 64;
        float* ab = (float*)(ws + WS_S5P + l * S5P_LAYER); float* bb = ab + 2 * 32 * 64 * 2;
        const size_t pi = (((size_t)l * 2 + dir) * 32 + g) * 64 + n;
        const float lr = fminf(a->in[I_S5_A_RE][pi], -1e-4f), li = a->in[I_S5_A_IM][pi], dt = __expf(a->in[I_S5_LOG_DT][((size_t)l * 2 + dir) * 32 + g]);
        const float mag = __expf(dt * lr); float sn, cs; sincosf(dt * li, &sn, &cs); const float abr = mag * cs, abi = mag * sn;
        const float den = lr * lr + li * li; const float ir = lr / den, ii = -li / den;
        const float fr_ = (abr - 1.f) * ir - abi * ii, fi_ = (abr - 1.f) * ii + abi * ir;
        ab[(size_t)r * 2] = abr; ab[(size_t)r * 2 + 1] = abi;
        { float* ab256 = bb + 2 * 32 * 64 * 16 * 2; const float m256 = __expf(256.f * dt * lr); float s2, c2; sincosf(256.f * dt * li, &s2, &c2); ab256[(size_t)r * 2] = m256 * c2; ab256[(size_t)r * 2 + 1] = m256 * s2; }
        const size_t bi = (((size_t)l * 32 + g) * 64 + n) * 16;
#pragma unroll
        for (int c = 0; c < 16; ++c) { const float br = a->in[I_S5_B_RE][bi + c], bim = a->in[I_S5_B_IM][bi + c];
            bb[((size_t)r * 16 + c) * 2] = fr_ * br - fi_ * bim; bb[((size_t)r * 16 + c) * 2 + 1] = fr_ * bim + fi_ * br; } }
    for (int it = gw; it < DEPTH * BATCH * NMEM; it += NGW) { const int l = it / (BATCH * NMEM), row = it % (BATCH * NMEM);
        const f32x4* xr = (const f32x4*)(a->in[I_MEM] + (size_t)row * DM) + F.lane; const f32x4* gr = (const f32x4*)(a->in[I_NORM_MEM] + (size_t)l * DM) + F.lane;
        f32x4 v[8]; float s = 0.f;
#pragma unroll
        for (int j = 0; j < 8; ++j) { v[j] = xr[64 * j]; s += (v[j].x * v[j].x + v[j].y * v[j].y) + (v[j].z * v[j].z + v[j].w * v[j].w); }
        const float rstd = 1.f / sqrtf(wave_sum(s) * (1.f / DM) + RMS_EPS);
        u32x2* o8 = (u32x2*)((bf16*)(ws + SC_MEMN) + ((size_t)l * 512 + row) * DM) + F.lane;
#pragma unroll
        for (int j = 0; j < 8; ++j) { const f32x4 gv = gr[64 * j]; u32x2 w; w.x = pk2(v[j].x * rstd * gv.x, v[j].y * rstd * gv.y); w.y = pk2(v[j].z * rstd * gv.z, v[j].w * rstd * gv.w); o8[64 * j] = w; } }
}

struct SchedDense { const char* A; const char* B; char* C; int nM, nN, G, c, lda, ldb, ldcb  , cesz  ;
    __device__ __forceinline__ bool next(int i, pg8::Unit& u) const { const long L = (long)i * G + c; if (L >= (long)nM * nN) return false; int pm, pn; pg8::xcd_tile((int)L, nM, nN, pm, pn);
        u.A = A + (size_t)pm * 256 * lda * 2; u.B = B + (size_t)pn * 256 * ldb * 2; u.C = C + (size_t)pm * 256 * ldcb + (size_t)pn * 256 * cesz; u.row0 = pm * 256; u.col0 = pn * 256; u.aux = 0; return true; }
    __device__ __forceinline__ int arow(const pg8::Unit&, int r) const { return r; } };
struct SchedBatch { const char* A; const char* B; char* C; size_t sA, sB, sC; int nM, nN, nb, G, c, lda, ldb, ldcb, cesz, rowsPerBatch;
    __device__ __forceinline__ bool next(int i, pg8::Unit& u) const { const long L = (long)i * G + c; const int per = nM * nN; if (L >= (long)per * nb) return false; const int b = (int)(L / per), r = (int)(L % per), pm = r / nN, pn = r % nN;
        u.A = A + b * sA + (size_t)pm * 256 * lda * 2; u.B = B + b * sB + (size_t)pn * 256 * ldb * 2; u.C = C + b * sC + (size_t)pm * 256 * ldcb + (size_t)pn * 256 * cesz; u.row0 = b * rowsPerBatch + pm * 256; u.col0 = pn * 256; u.aux = b; return true; }
    __device__ __forceinline__ int arow(const pg8::Unit&, int r) const { return r; } };
struct SchedXaPre { unsigned char* ws; int G, c, kind;
    __device__ __forceinline__ bool next(int i, pg8::Unit& u) const { const long L = (long)i * G + c; if (L >= 128) return false; const int r = (int)L, p = r >> 3, t = r & 7, l = p >> 3, b = (p >> 2) & 1, h = p & 3;
        const bf16* kvb = (const bf16*)(ws + SC_KVB) + (size_t)l * 512 * 4096 + (size_t)(b * 256) * 4096;
        if (kind == 0) { u.A = (const char*)(kvb + h * 512); u.B = (const char*)((const bf16*)(ws + SC_WQB) + (size_t)l * DM * DM + (size_t)(t * 256) * DM + h * 512);
            u.C = (char*)((bf16*)(ws + WS_WQK) + ((size_t)(l * 2 + b) * 1024 + h * 256) * DM + t * 256); u.aux = DM; }
        else { u.A = (const char*)((const bf16*)(ws + SC_WOT) + (size_t)l * DM * DM + (size_t)(t * 256) * DM + h * 512); u.B = (const char*)(kvb + 2048 + h * 512);
            u.C = (char*)((bf16*)(ws + WS_VWO) + ((size_t)(l * 2 + b) * DM + t * 256) * 1024 + h * 256); u.aux = 1024; }
        u.row0 = 0; u.col0 = 0; return true; }
    __device__ __forceinline__ int arow(const pg8::Unit&, int r) const { return r; } };
struct EpiBf16U { static constexpr bool PERM = true, AFTER_DRAIN = false;
    __device__ __forceinline__ void operator()(const pg8::Acc& acc, const pg8::Unit& u, int wr, int wc, int fr, int fq) const { pg8::EpiBf16 e{u.aux}; e(acc, u, wr, wc, fr, fq); } };
struct SchedMoe { unsigned char* ws; const volatile LAS int* tp; const volatile LAS int* cnt; int layer, G, c, which;
    __device__ __forceinline__ bool next(int i, pg8::Unit& u) const {
        const int npn = which == 0 ? 4 : 8; const long L = (long)i * G + c; const int ntile = tp[32]; if (L >= (long)ntile * npn) return false;
        const int mt = (int)(L / npn), pn = (int)(L % npn); int e = 0;
#pragma unroll 1
        for (int k = 1; k < 32; ++k) e += (mt >= tp[k]) ? 1 : 0;
        const int lt = mt - tp[e]; const int nvalid = min(256, cnt[e] - lt * 256);
        u.row0 = lt * 256; u.col0 = pn * 256; u.aux = (e << 16) | nvalid;
        if (which == 0) { u.A = (const char*)(ws + WS_HN); u.B = (const char*)((const bf16*)(ws + WS_W13) + ((size_t)(layer * NEXP + e) * 1024 + pn * 256) * DM);
            u.C = (char*)((bf16*)(ws + SC_HMID) + (size_t)(mt * 256) * DEXP + pn * 128); }
        else { u.A = (const char*)((const bf16*)(ws + SC_HMID) + (size_t)(mt * 256) * DEXP); u.B = (const char*)((const bf16*)(ws + WS_W2) + ((size_t)(layer * NEXP + e) * DM + pn * 256) * DEXP);
            u.C = (char*)((bf16*)(ws + SC_YBUF) + (size_t)(mt * 256) * DM + pn * 256); }
        return true; }
    __device__ __forceinline__ int arow(const pg8::Unit& u, int r) const { const int e = u.aux >> 16, nvalid = u.aux & 0xffff; const int idx = (r < nvalid) ? (u.row0 + r) : u.row0;
        return ((const int*)(ws + WS_ETOK))[(size_t)e * ECAP + idx]; } };

__device__ __forceinline__ void moe_prefix(Frame& F, int layer, volatile LAS int* tp, volatile LAS int* cnt) {
    __syncthreads();
    if (F.tid < 32) cnt[F.tid] = (int)__hip_atomic_load(F.ctl + CW_CNT + layer * 64 + F.tid, __ATOMIC_RELAXED, __HIP_MEMORY_SCOPE_AGENT);
    __syncthreads();
    if (F.tid == 0) { int s = 0; for (int e = 0; e < 32; ++e) { tp[e] = s; s += (cnt[e] + 255) >> 8; } tp[32] = s; }
    __syncthreads();
}
template <int MODE>
__device__ __forceinline__ void norm_phase(Frame& F, ArgsP a, const float* src, const float* gain, int layer) {
    unsigned char* ws = F.ws; float* H = (float*)(ws + WS_H); bf16* HN = (bf16*)(ws + WS_HN);
    volatile LAS int* tp = (volatile LAS int*)(F.lds + 1024); volatile LAS int* cnt = tp + 40;
    if (MODE & 1) moe_prefix(F, layer - 1, tp, cnt);
    const int gw = F.bid * 8 + F.wave, NGW = F.G * 8;
    const f32x4* gr = (const f32x4*)gain + F.lane;
    for (int row = gw; row < NTOK; row += NGW) {
        const f32x4* xr = (const f32x4*)(src + (size_t)row * DM) + F.lane;
        f32x4 v[8];
#pragma unroll
        for (int j = 0; j < 8; ++j) v[j] = xr[64 * j];
        if (MODE & 1) {
            const int* ti = (const int*)(ws + WS_TINFO) + (size_t)row * 4;
            const int e0 = ti[0], p0 = ti[1], e1 = ti[2], p1 = ti[3];
            const size_t s0 = (size_t)tp[e0] * 256 + p0, s1 = (size_t)tp[e1] * 256 + p1;
            const u32x2* y0 = (const u32x2*)((const bf16*)(ws + SC_YBUF) + s0 * DM) + F.lane; const u32x2* y1 = (const u32x2*)((const bf16*)(ws + SC_YBUF) + s1 * DM) + F.lane;
#pragma unroll
            for (int j = 0; j < 8; ++j) { const u32x2 a0 = y0[64 * j], a1 = y1[64 * j];
                v[j].x += __uint_as_float(a0.x << 16) + __uint_as_float(a1.x << 16); v[j].y += __uint_as_float(a0.x & 0xffff0000u) + __uint_as_float(a1.x & 0xffff0000u);
                v[j].z += __uint_as_float(a0.y << 16) + __uint_as_float(a1.y << 16); v[j].w += __uint_as_float(a0.y & 0xffff0000u) + __uint_as_float(a1.y & 0xffff0000u); }
            if (!(MODE & 4)) { f32x4* hr = (f32x4*)(H + (size_t)row * DM) + F.lane;
#pragma unroll
                for (int j = 0; j < 8; ++j) hr[64 * j] = v[j]; }
        }
        float s = 0.f;
#pragma unroll
        for (int j = 0; j < 8; ++j) s += (v[j].x * v[j].x + v[j].y * v[j].y) + (v[j].z * v[j].z + v[j].w * v[j].w);
        const float rstd = 1.f / sqrtf(wave_sum(s) * (1.f / DM) + RMS_EPS);
#pragma unroll
        for (int j = 0; j < 8; ++j) { const f32x4 gv = gr[64 * j]; v[j].x *= rstd * gv.x; v[j].y *= rstd * gv.y; v[j].z *= rstd * gv.z; v[j].w *= rstd * gv.w; }
        if (MODE & 4) { f32x4* orow = (f32x4*)(a->out + (size_t)row * DM) + F.lane;
#ifdef DBG_RWCHK
            { const float* cw = (const float*)(F.ctl + 32768); const unsigned* cu = (const unsigned*)cw; const float sc = cu[DBG_RWCHK * 64 + 2] ? 1001.f : 1.f + fminf(cw[DBG_RWCHK * 64] / cw[DBG_RWCHK * 64 + 1], 100.f);
#pragma unroll
              for (int j = 0; j < 8; ++j) v[j] *= sc; }
#endif
#pragma unroll
            for (int j = 0; j < 8; ++j) orow[64 * j] = v[j]; }
        else { u32x2* o8 = (u32x2*)(HN + (size_t)row * DM) + F.lane;
#pragma unroll
            for (int j = 0; j < 8; ++j) { u32x2 w; w.x = pk2(v[j].x, v[j].y); w.y = pk2(v[j].z, v[j].w); o8[64 * j] = w; } }
        if (MODE & 2) {
            const float* wg = a->in[I_ROUTER_GROUP] + (size_t)layer * DM * 4; const float* we = a->in[I_ROUTER_EXPERT] + (size_t)layer * DM * 32;
            float lg[4] = {0.f, 0.f, 0.f, 0.f};
#pragma unroll 2
            for (int j = 0; j < 8; ++j) { const int k0 = (64 * j + F.lane) * 4;
#pragma unroll
                for (int q = 0; q < 4; ++q) { const f32x4 w4 = *(const f32x4*)(wg + (size_t)(k0 + q) * 4); const float x = v[j][q]; lg[0] += x * w4.x; lg[1] += x * w4.y; lg[2] += x * w4.z; lg[3] += x * w4.w; } }
#pragma unroll
            for (int q = 0; q < 4; ++q) lg[q] = wave_sum(lg[q]);
            int gi = 0; float gm = lg[0];
#pragma unroll
            for (int q = 1; q < 4; ++q) if (lg[q] > gm) { gm = lg[q]; gi = q; }
            const float gw_ = 1.f / (__expf(lg[0] - gm) + __expf(lg[1] - gm) + __expf(lg[2] - gm) + __expf(lg[3] - gm));
            float le[8] = {0.f, 0.f, 0.f, 0.f, 0.f, 0.f, 0.f, 0.f};
#pragma unroll 2
            for (int j = 0; j < 8; ++j) { const int k0 = (64 * j + F.lane) * 4;
#pragma unroll
                for (int q = 0; q < 4; ++q) { const float* wp = we + (size_t)(k0 + q) * 32 + gi * 8; const f32x4 wa = *(const f32x4*)wp, wb = *(const f32x4*)(wp + 4); const float x = v[j][q];
                    le[0] += x * wa.x; le[1] += x * wa.y; le[2] += x * wa.z; le[3] += x * wa.w; le[4] += x * wb.x; le[5] += x * wb.y; le[6] += x * wb.z; le[7] += x * wb.w; } }
#pragma unroll
            for (int q = 0; q < 8; ++q) le[q] = wave_sum(le[q]);
            int i0 = 0; float m0 = le[0];
#pragma unroll
            for (int q = 1; q < 8; ++q) if (le[q] > m0) { m0 = le[q]; i0 = q; }
            int i1 = -1; float m1 = -3.0e38f;
#pragma unroll
            for (int q = 0; q < 8; ++q) if (q != i0 && le[q] > m1) { m1 = le[q]; i1 = q; }
            const float t = __expf(m1 - m0); const float w0 = 1.f / (1.f + t), w1 = t / (1.f + t);
            if (F.lane == 0) {
                const int e0 = gi * 8 + i0, e1 = gi * 8 + i1;
                const int p0 = (int)__hip_atomic_fetch_add(F.ctl + CW_CNT + layer * 64 + e0, 1u, __ATOMIC_RELAXED, __HIP_MEMORY_SCOPE_AGENT);
                const int p1 = (int)__hip_atomic_fetch_add(F.ctl + CW_CNT + layer * 64 + e1, 1u, __ATOMIC_RELAXED, __HIP_MEMORY_SCOPE_AGENT);
                int* et = (int*)(ws + WS_ETOK); float* eg = (float*)(ws + WS_EGATE); int* ti = (int*)(ws + WS_TINFO) + (size_t)row * 4;
                et[(size_t)e0 * ECAP + p0] = row; eg[(size_t)e0 * ECAP + p0] = gw_ * w0; et[(size_t)e1 * ECAP + p1] = row; eg[(size_t)e1 * ECAP + p1] = gw_ * w1;
                ti[0] = e0; ti[1] = p0; ti[2] = e1; ti[3] = p1;
            }
        }
    }
}

__device__ __forceinline__ void rope_token(Frame& F, bf16* zrow, int s) {
    const float* cosA = (const float*)(F.ws + WS_ROPE); const float* sinA = cosA + SEQ * 32; const float* cosC = sinA + SEQ * 32; const float* sinC = cosC + SEQ * 64;
    { const int i = F.lane & 31; const float cs = cosA[s * 32 + i], sn = sinA[s * 32 + i];
#pragma unroll
      for (int it = 0; it < 8; ++it) { bf16* p = zrow + ZA + (it * 2 + (F.lane >> 5)) * 64; const float x1 = bf2f(p[i]), x2 = bf2f(p[i + 32]); p[i] = f2bf(x1 * cs - x2 * sn); p[i + 32] = f2bf(x2 * cs + x1 * sn); } }
    { const int i = F.lane; const float cs = cosC[s * 64 + i], sn = sinC[s * 64 + i];
#pragma unroll
      for (int it = 0; it < 8; ++it) { bf16* p = zrow + ZC + it * 128; const float x1 = bf2f(p[i]), x2 = bf2f(p[i + 64]); p[i] = f2bf(x1 * cs - x2 * sn); p[i + 64] = f2bf(x2 * cs + x1 * sn); } }
}

constexpr int RWT = 8;
__device__ __forceinline__ void rwkv_prep_tile(Frame& F, ArgsP a, int layer, int tile) {
    unsigned char* ws = F.ws; const bf16* Z = (const bf16*)(ws + SC_Z);
    LAS float* zr = (LAS float*)F.lds; LAS float* act = zr + (RWT + 2) * IN_B;
    const int t0 = tile * RWT; const int b = t0 / SEQ, s0 = t0 % SEQ;
    __syncthreads();
#pragma unroll 1
    for (int i = F.tid; i < (RWT + 2) * (IN_B / 8); i += 512) { const int rr = i / (IN_B / 8), c8 = i % (IN_B / 8); const int s = s0 - 1 + rr;
        f32x4 lo = {0.f, 0.f, 0.f, 0.f}, hi = {0.f, 0.f, 0.f, 0.f};
        if (s >= 0 && s < SEQ) { const u32x4 w = *(const u32x4*)(Z + (size_t)(b * SEQ + s) * ZLD + ZB + c8 * 8);
            lo = (f32x4){__uint_as_float(w.x << 16), __uint_as_float(w.x & 0xffff0000u), __uint_as_float(w.y << 16), __uint_as_float(w.y & 0xffff0000u)};
            hi = (f32x4){__uint_as_float(w.z << 16), __uint_as_float(w.z & 0xffff0000u), __uint_as_float(w.w << 16), __uint_as_float(w.w & 0xffff0000u)}; }
        *(LAS f32x4*)(zr + rr * IN_B + c8 * 8) = lo; *(LAS f32x4*)(zr + rr * IN_B + c8 * 8 + 4) = hi; }
    __syncthreads();
    const float* mu = a->in[I_RWKV_MU] + (size_t)layer * 2 * IN_B;
#define ZS(t, col) (zr[((t) + 1) * IN_B + (col)] + mu[(col)] * (zr[(t) * IN_B + (col)] - zr[((t) + 1) * IN_B + (col)]) + mu[IN_B + (col)] * (zr[((t) + 2) * IN_B + (col)] - zr[((t) + 1) * IN_B + (col)]))
#pragma unroll 1
    for (int i = F.tid; i < RWT * 384; i += 512) { const int t = i / 384, j = i % 384; const int col = 1536 + j; const float x = ZS(t, col);
        act[t * 384 + j] = (j < 128) ? tanhf(x) : ((j < 256) ? x : sigmoidf_(x)); }
    __syncthreads();
    const int c = F.tid;
    float aw0[RWT], aw1[RWT], aa0[RWT], aa1[RWT], ag[RWT];
#pragma unroll
    for (int t = 0; t < RWT; ++t) { aw0[t] = 0.f; aw1[t] = 0.f; aa0[t] = 0.f; aa1[t] = 0.f; ag[t] = 0.f; }
    const __amdgpu_buffer_rsrc_t w2 = make_rsrc(a->in[I_RWKV_W2] + (size_t)layer * 2 * 64 * 512, 2 * 64 * 512 * 4), a2 = make_rsrc(a->in[I_RWKV_A2] + (size_t)layer * 2 * 64 * 512, 2 * 64 * 512 * 4), g2 = make_rsrc(a->in[I_RWKV_G2] + (size_t)layer * 128 * 512, 128 * 512 * 4);
#pragma unroll 1
    for (int r = 0; r < 64; r += 4) {
        float wv0[4], wv1[4], av0[4], av1[4];
#pragma unroll
        for (int q = 0; q < 4; ++q) { wv0[q] = bload_f32(w2, c * 4, (r + q) * 2048); wv1[q] = bload_f32(w2, c * 4, (64 + r + q) * 2048); av0[q] = bload_f32(a2, c * 4, (r + q) * 2048); av1[q] = bload_f32(a2, c * 4, (64 + r + q) * 2048); }
#pragma unroll
        for (int t = 0; t < RWT; ++t) { const f32x4 x0 = *(const LAS f32x4*)(act + t * 384 + r), x1 = *(const LAS f32x4*)(act + t * 384 + 64 + r), y0 = *(const LAS f32x4*)(act + t * 384 + 128 + r), y1 = *(const LAS f32x4*)(act + t * 384 + 192 + r);
#pragma unroll
            for (int q = 0; q < 4; ++q) { aw0[t] += x0[q] * wv0[q]; aw1[t] += x1[q] * wv1[q]; aa0[t] += y0[q] * av0[q]; aa1[t] += y1[q] * av1[q]; } }
    }
#pragma unroll 1
    for (int r = 0; r < 128; r += 4) {
        float gv[4];
#pragma unroll
        for (int q = 0; q < 4; ++q) gv[q] = bload_f32(g2, c * 4, (r + q) * 2048);
#pragma unroll
        for (int t = 0; t < RWT; ++t) { const f32x4 x = *(const LAS f32x4*)(act + t * 384 + 256 + r);
#pragma unroll
            for (int q = 0; q < 4; ++q) ag[t] += x[q] * gv[q]; }
    }
    const float w00 = a->in[I_RWKV_W0][(size_t)layer * 1024 + c], w01 = a->in[I_RWKV_W0][(size_t)layer * 1024 + 512 + c];
    const float a00 = a->in[I_RWKV_A0][(size_t)layer * 1024 + c], a01 = a->in[I_RWKV_A0][(size_t)layer * 1024 + 512 + c];
    const float kkw = a->in[I_RWKV_KK][(size_t)layer * 512 + c], kaw = a->in[I_RWKV_KA][(size_t)layer * 512 + c];
    float* RW = (float*)(ws + SC_RW); const size_t N1 = (size_t)NTOK * 512;
    { unsigned zo = (unsigned)(uintptr_t)zr; asm volatile("" : "+v"(zo)); zr = (LAS float*)(uintptr_t)zo; }
#pragma unroll
    for (int t = 0; t < RWT; ++t) {
        const float r_ = ZS(t, c), k_ = ZS(t, 512 + c), v_ = ZS(t, 1024 + c);
        const float x0 = -(w00 + aw0[t]), x1 = -(w01 + aw1[t]);
        const float sp0 = fmaxf(x0, 0.f) + __logf(1.f + __expf(-fabsf(x0))), sp1 = fmaxf(x1, 0.f) + __logf(1.f + __expf(-fabsf(x1)));
        const float d0 = -__expf(-sp0 - 0.5f), d1 = -__expf(-sp1 - 0.5f);
        const float al0 = sigmoidf_(a00 + aa0[t]), al1 = sigmoidf_(a01 + aa1[t]);
        float kk = k_ * kkw; const float ssq = wave_sum(kk * kk); kk *= 1.f / sqrtf(ssq + 1e-12f);
        const float km0 = k_ * (1.f + (al0 - 1.f) * kaw), km1 = k_ * (1.f + (al1 - 1.f) * kaw);
        const size_t o = (size_t)(t0 + t) * 512 + c;
        RW[0 * N1 + o] = r_; RW[1 * N1 + o] = v_; RW[2 * N1 + o] = kk; RW[3 * N1 + o] = d0; RW[4 * N1 + o] = d1;
        RW[5 * N1 + o] = km0; RW[6 * N1 + o] = km1; RW[7 * N1 + o] = kk * al0; RW[8 * N1 + o] = kk * al1; RW[9 * N1 + o] = ag[t];
        asm volatile("" ::: "memory");
    }
#undef ZS
}

constexpr size_t SC_S5E = SC_MIX_END + (size_t)32 * 256 * 11520;
constexpr size_t SC_MIX_END3 = SC_S5E + (size_t)2 * BATCH * 16 * 32 * 64 * 2 * 4;
template <int LEVEL>
__device__ __forceinline__ void s5_block_task(Frame& F, int layer, int task, LAS float* ul) {
    unsigned char* ws = F.ws; const bf16* Z = (const bf16*)(ws + SC_Z);
    const int blk = task & 15, dir = (task >> 4) & 1, g = (task >> 5) & 31, b = task >> 10; const int n = F.lane;
    const float* ab = (const float*)(ws + WS_S5P + layer * S5P_LAYER); const float* bb = ab + 2 * 32 * 64 * 2; const float* ab256 = bb + 2 * 32 * 64 * 16 * 2;
    const int pr = (dir * 32 + g) * 64 + n;
    const float abr = ab[pr * 2], abi = ab[pr * 2 + 1];
    float bbr[16], bbi[16];
#pragma unroll
    for (int c = 0; c < 16; ++c) { bbr[c] = bb[((size_t)pr * 16 + c) * 2]; bbi[c] = bb[((size_t)pr * 16 + c) * 2 + 1]; }
    float* E = (float*)(ws + SC_S5E);
    float xr = 0.f, xi = 0.f;
    if (LEVEL == 2) { const float pr_ = ab256[pr * 2], pi_ = ab256[pr * 2 + 1];
        for (int k = 0; k < blk; ++k) { const float* ep = E + ((((size_t)dir * BATCH + b) * 16 + k) * 32 + g) * 128 + n * 2; const float er = ep[0], ei = ep[1];
            const float nr = pr_ * xr - pi_ * xi + er, ni = pr_ * xi + pi_ * xr + ei; xr = nr; xi = ni; } }
    float* carry = (float*)(ws + SC_CARRY);
    for (int q4 = 0; q4 < 4; ++q4) {
        { const int st = blk * 256 + q4 * 64 + n; const int sl = dir ? (SEQ - 1 - st) : st; const bf16* zp = Z + (size_t)(b * SEQ + sl) * ZLD + ZD + g * 16;
          const u32x4 w0 = *(const u32x4*)zp, w1 = *(const u32x4*)(zp + 8);
          LAS f32x4* d = (LAS f32x4*)(ul + n * 16);
          d[0] = (f32x4){__uint_as_float(w0.x << 16), __uint_as_float(w0.x & 0xffff0000u), __uint_as_float(w0.y << 16), __uint_as_float(w0.y & 0xffff0000u)};
          d[1] = (f32x4){__uint_as_float(w0.z << 16), __uint_as_float(w0.z & 0xffff0000u), __uint_as_float(w0.w << 16), __uint_as_float(w0.w & 0xffff0000u)};
          d[2] = (f32x4){__uint_as_float(w1.x << 16), __uint_as_float(w1.x & 0xffff0000u), __uint_as_float(w1.y << 16), __uint_as_float(w1.y & 0xffff0000u)};
          d[3] = (f32x4){__uint_as_float(w1.z << 16), __uint_as_float(w1.z & 0xffff0000u), __uint_as_float(w1.w << 16), __uint_as_float(w1.w & 0xffff0000u)}; }
        LDS_WAIT(); asm volatile("" ::: "memory");
#pragma unroll 4
        for (int i = 0; i < 64; ++i) {
            const int step = blk * 256 + q4 * 64 + i;
            if (LEVEL == 2 && (step & (S5CH - 1)) == 0) { const int sl = dir ? (SEQ - 1 - step) : step; const int ch = sl / S5CH;
                float* cp = carry + ((((size_t)dir * BATCH + b) * S5NCH + ch) * 32 + g) * 128 + n * 2; cp[0] = xr; cp[1] = xi; }
            const f32x4 u0 = *(const LAS f32x4*)(ul + i * 16), u1 = *(const LAS f32x4*)(ul + i * 16 + 4), u2 = *(const LAS f32x4*)(ul + i * 16 + 8), u3 = *(const LAS f32x4*)(ul + i * 16 + 12);
            float br = 0.f, bi = 0.f;
#pragma unroll
            for (int c = 0; c < 4; ++c) { br += bbr[c] * u0[c] + bbr[4 + c] * u1[c] + bbr[8 + c] * u2[c] + bbr[12 + c] * u3[c]; bi += bbi[c] * u0[c] + bbi[4 + c] * u1[c] + bbi[8 + c] * u2[c] + bbi[12 + c] * u3[c]; }
            const float nr = abr * xr - abi * xi + br, ni = abr * xi + abi * xr + bi; xr = nr; xi = ni;
        }
        asm volatile("" ::: "memory");
    }
    if (LEVEL == 1) { float* ep = E + ((((size_t)dir * BATCH + b) * 16 + blk) * 32 + g) * 128 + n * 2; ep[0] = xr; ep[1] = xi; }
}

__device__ __forceinline__ void prep_phase(Frame& F, ArgsP a, int layer, const int rep) {
    const int qb_ = (rep * 2 + layer) * 8;
#ifndef DBG_PREPMASK
#define DBG_PREPMASK 7
#endif
    if (DBG_PREPMASK & 1) for (;;) { const int it = q_next(F, qb_ + 0); if (it >= 256) break; s5_block_task<1>(F, layer, it * 8 + F.wave, (LAS float*)(F.lds + F.wave * 4096)); }
    if (DBG_PREPMASK & 2) for (;;) { const int it = q_next(F, qb_ + 5); if (it >= NTOK / RWT) break; rwkv_prep_tile(F, a, layer, it); }
    if ((DBG_PREPMASK & 4) && rep == 0) for (;;) { const int r = q_next(F, qb_ + 6); if (r >= NTOK / 64) break;
        for (int k = 0; k < 8; ++k) { const int tok = r * 64 + F.wave * 8 + k; rope_token(F, (bf16*)(F.ws + SC_Z) + (size_t)tok * ZLD, tok % SEQ); } }
}

constexpr int CR_TA = 0, CR_GH = 2048, CR_WBK = 4096, CR_TM = 8192, CR_N = 8704, CR_V = 9216, CR_WL = 11264, CR_BYTES = 11520;
constexpr size_t SC_CREC = SC_MIX_END;
constexpr size_t SC_MIX_END2 = SC_CREC + (size_t)32 * 256 * CR_BYTES;
static_assert(SC_MIX_END2 <= 1140000000ull, "workspace budget");

__device__ __forceinline__ void mm16(const LAS float* A, const LAS float* B, int t, int sq, float (&out)[4]) {
    out[0] = out[1] = out[2] = out[3] = 0.f;
#pragma unroll
    for (int s4 = 0; s4 < 4; ++s4) { const f32x4 a4 = *(const LAS f32x4*)(A + t * 16 + s4 * 4);
#pragma unroll
        for (int q = 0; q < 4; ++q) { const f32x4 b4 = *(const LAS f32x4*)(B + (s4 * 4 + q) * 16 + sq * 4); const float av = a4[q];
            out[0] += av * b4[0]; out[1] += av * b4[1]; out[2] += av * b4[2]; out[3] += av * b4[3]; } }
}
__device__ __forceinline__ void st16(LAS float* M, int t, int sq, const float (&v)[4]) { *(LAS f32x4*)(M + t * 16 + sq * 4) = (f32x4){v[0], v[1], v[2], v[3]}; }

__device__ __forceinline__ void rwkv_cprep_item(Frame& F, int chain, int c, LAS float* Lw) {
    unsigned char* ws = F.ws; const float* RW = (const float*)(ws + SC_RW); const size_t N1 = (size_t)NTOK * 512;
    const int dir = chain & 1, h = (chain >> 1) & 7, b = chain >> 4; const int lane = F.lane;
    const float* Rp = RW; const float* Vp = RW + N1; const float* KKp = RW + 2 * N1; const float* LDp = RW + (3 + dir) * N1; const float* KMp = RW + (5 + dir) * N1; const float* BBp = RW + (7 + dir) * N1;
    constexpr int RS = 68;
    LAS float* At = Lw; LAS float* Bt = Lw + 16 * RS; LAS float* Kt = Lw + 32 * RS; LAS float* mat = Lw + 48 * RS;
    float at[16], rt[16], wb[16], wk[16];
    { float lw = 0.f, lwi[16], bb[16], km[16];
#pragma unroll
      for (int t = 0; t < 16; ++t) { const int pos = dir ? (SEQ - 1 - 16 * c - t) : (16 * c + t); const size_t idx = (size_t)(b * SEQ + pos) * 512 + h * 64 + lane;
          const float r_ = Rp[idx], ld = LDp[idx], a_ = -KKp[idx]; km[t] = KMp[idx]; bb[t] = BBp[idx];
          at[t] = a_ * __expf(lw); lw += ld; lwi[t] = lw; rt[t] = r_ * __expf(lw);
          const float iw = __expf(-lw); At[t * RS + lane] = at[t]; Bt[t * RS + lane] = bb[t] * iw; Kt[t * RS + lane] = km[t] * iw; }
#pragma unroll
      for (int t = 0; t < 16; ++t) { const float e = __expf(lw - lwi[t]); wb[t] = bb[t] * e; wk[t] = km[t] * e; }
      float* rec = (float*)(ws + SC_CREC + ((size_t)chain * 256 + c) * CR_BYTES + CR_WL); rec[lane] = __expf(lw); }
    LDS_WAIT(); asm volatile("" ::: "memory");
    const int t = lane >> 2, sq = lane & 3;
    float mab[4] = {0.f, 0.f, 0.f, 0.f}, mak[4] = {0.f, 0.f, 0.f, 0.f}, mrb[4] = {0.f, 0.f, 0.f, 0.f}, mrk[4] = {0.f, 0.f, 0.f, 0.f};
#pragma unroll 4
    for (int j = 0; j < 64; j += 4) { const f32x4 a4 = *(const LAS f32x4*)(At + t * RS + j);
#pragma unroll
        for (int e = 0; e < 4; ++e) { const f32x4 b4 = *(const LAS f32x4*)(Bt + (sq * 4 + e) * RS + j), k4 = *(const LAS f32x4*)(Kt + (sq * 4 + e) * RS + j);
            mab[e] += a4[0] * b4[0] + a4[1] * b4[1] + a4[2] * b4[2] + a4[3] * b4[3]; mak[e] += a4[0] * k4[0] + a4[1] * k4[1] + a4[2] * k4[2] + a4[3] * k4[3]; } }
    asm volatile("" ::: "memory");
#pragma unroll
    for (int tt = 0; tt < 16; ++tt) At[tt * RS + lane] = rt[tt];
    LDS_WAIT(); asm volatile("" ::: "memory");
#pragma unroll 4
    for (int j = 0; j < 64; j += 4) { const f32x4 a4 = *(const LAS f32x4*)(At + t * RS + j);
#pragma unroll
        for (int e = 0; e < 4; ++e) { const f32x4 b4 = *(const LAS f32x4*)(Bt + (sq * 4 + e) * RS + j), k4 = *(const LAS f32x4*)(Kt + (sq * 4 + e) * RS + j);
            mrb[e] += a4[0] * b4[0] + a4[1] * b4[1] + a4[2] * b4[2] + a4[3] * b4[3]; mrk[e] += a4[0] * k4[0] + a4[1] * k4[1] + a4[2] * k4[2] + a4[3] * k4[3]; } }
#pragma unroll
    for (int e = 0; e < 4; ++e) { const int s = sq * 4 + e; if (s >= t) { mab[e] = 0.f; mak[e] = 0.f; } if (s > t) { mrb[e] = 0.f; mrk[e] = 0.f; } }
    LAS float* m0 = mat; LAS float* m1 = mat + 256; LAS float* m2 = mat + 512; LAS float* m3 = mat + 768;
    float T[4], P[4], Q[4];
    st16(m0, t, sq, mab); LDS_WAIT(); asm volatile("" ::: "memory");
#pragma unroll
    for (int e = 0; e < 4; ++e) T[e] = mab[e] + ((sq * 4 + e) == t ? 1.f : 0.f);
    mm16(m0, m0, t, sq, P);
    st16(m1, t, sq, P); st16(m2, t, sq, T); LDS_WAIT(); asm volatile("" ::: "memory");
    mm16(m2, m1, t, sq, Q);
#pragma unroll
    for (int e = 0; e < 4; ++e) T[e] += Q[e];
    mm16(m1, m1, t, sq, P);
    asm volatile("" ::: "memory");
    st16(m0, t, sq, P); st16(m2, t, sq, T); LDS_WAIT(); asm volatile("" ::: "memory");
    mm16(m2, m0, t, sq, Q);
#pragma unroll
    for (int e = 0; e < 4; ++e) T[e] += Q[e];
    mm16(m0, m0, t, sq, P);
    asm volatile("" ::: "memory");
    st16(m1, t, sq, P); st16(m2, t, sq, T); LDS_WAIT(); asm volatile("" ::: "memory");
    mm16(m2, m1, t, sq, Q);
#pragma unroll
    for (int e = 0; e < 4; ++e) T[e] += Q[e];
    asm volatile("" ::: "memory");
    st16(m2, t, sq, T); st16(m0, t, sq, mrb); st16(m1, t, sq, mak); LDS_WAIT(); asm volatile("" ::: "memory");
    float P1[4], TM[4], Nn[4];
    mm16(m0, m2, t, sq, P1); mm16(m2, m1, t, sq, TM);
    st16(m3, t, sq, P1); LDS_WAIT(); asm volatile("" ::: "memory");
    mm16(m3, m1, t, sq, Nn);
#pragma unroll
    for (int e = 0; e < 4; ++e) Nn[e] += mrk[e];
    unsigned char* rec = ws + SC_CREC + ((size_t)chain * 256 + c) * CR_BYTES;
    { u32x2 w; w.x = pk2(TM[0], TM[1]); w.y = pk2(TM[2], TM[3]); *(u32x2*)(rec + CR_TM + (16 * sq + t) * 8) = w;
      w.x = pk2(Nn[0], Nn[1]); w.y = pk2(Nn[2], Nn[3]); *(u32x2*)(rec + CR_N + (16 * sq + t) * 8) = w; }
    LAS unsigned short* TAh = (LAS unsigned short*)Bt; LAS unsigned short* GHh = TAh + 1024;
#pragma unroll
    for (int tt = 0; tt < 16; ++tt) { float ta = 0.f, gh = rt[tt];
#pragma unroll
        for (int s4 = 0; s4 < 4; ++s4) { const f32x4 t4 = *(const LAS f32x4*)(m2 + tt * 16 + s4 * 4), p4 = *(const LAS f32x4*)(m3 + tt * 16 + s4 * 4);
            ta += t4[0] * at[s4 * 4] + t4[1] * at[s4 * 4 + 1] + t4[2] * at[s4 * 4 + 2] + t4[3] * at[s4 * 4 + 3];
            gh += p4[0] * at[s4 * 4] + p4[1] * at[s4 * 4 + 1] + p4[2] * at[s4 * 4 + 2] + p4[3] * at[s4 * 4 + 3]; }
        TAh[tt * 64 + lane] = f2bf(ta); GHh[tt * 64 + lane] = f2bf(gh); }
    LDS_WAIT(); asm volatile("" ::: "memory");
    { const int r = lane & 15, g = lane >> 4;
#pragma unroll
      for (int ks = 0; ks < 2; ++ks) { const u32x2 a0 = *(const LAS u32x2*)(TAh + r * 64 + 32 * ks + 4 * g), a1 = *(const LAS u32x2*)(TAh + r * 64 + 32 * ks + 16 + 4 * g);
          *(u32x4*)(rec + CR_TA + (ks * 64 + lane) * 16) = (u32x4){a0.x, a0.y, a1.x, a1.y};
          const u32x2 g0 = *(const LAS u32x2*)(GHh + r * 64 + 32 * ks + 4 * g), g1 = *(const LAS u32x2*)(GHh + r * 64 + 32 * ks + 16 + 4 * g);
          *(u32x4*)(rec + CR_GH + (ks * 64 + lane) * 16) = (u32x4){g0.x, g0.y, g1.x, g1.y}; } }
    { const int jb = lane >> 4, r = lane & 15; float vv[16];
#pragma unroll
      for (int tt = 0; tt < 16; ++tt) { const int pos = dir ? (SEQ - 1 - 16 * c - tt) : (16 * c + tt); vv[tt] = Vp[(size_t)(b * SEQ + pos) * 512 + h * 64 + lane]; }
#pragma unroll
      for (int g = 0; g < 4; ++g) { u32x4 w; w.x = pk2(wb[4 * g], wb[4 * g + 1]); w.y = pk2(wb[4 * g + 2], wb[4 * g + 3]); w.z = pk2(wk[4 * g], wk[4 * g + 1]); w.w = pk2(wk[4 * g + 2], wk[4 * g + 3]);
          *(u32x4*)(rec + CR_WBK + (jb * 64 + 16 * g + r) * 16) = w;
          u32x2 x; x.x = pk2(vv[4 * g], vv[4 * g + 1]); x.y = pk2(vv[4 * g + 2], vv[4 * g + 3]); *(u32x2*)(rec + CR_V + (jb * 64 + 16 * g + r) * 8) = x; } }
    LDS_WAIT(); asm volatile("" ::: "memory");
}

__device__ __forceinline__ void cprep_phase(Frame& F, int layer) {
    LAS float* Lw = (LAS float*)(F.lds + F.wave * 17408);
    for (int it = F.bid * 8 + F.wave; it < 32 * 256; it += F.G * 8) { const int c = it >> 5, chain = it & 31; rwkv_cprep_item(F, chain, c, Lw); }
    asm volatile("" ::: "memory");
    for (int it = F.bid * 8 + F.wave; it < 2048; it += F.G * 8) s5_block_task<2>(F, layer, it, Lw);
}

struct RwOps { bf16x8 ta[2], gh[2], wbk[4]; u32x2 tm, nn, vq[2]; f32x4 wl[4]; };
__device__ __forceinline__ void rw_load(RwOps& o, const unsigned char* rec, int lane, int half) {
    const int g = lane >> 4;
#pragma unroll
    for (int ks = 0; ks < 2; ++ks) { o.ta[ks] = *(const bf16x8*)(rec + CR_TA + (ks * 64 + lane) * 16); o.gh[ks] = *(const bf16x8*)(rec + CR_GH + (ks * 64 + lane) * 16); }
#pragma unroll
    for (int jb = 0; jb < 4; ++jb) { o.wbk[jb] = *(const bf16x8*)(rec + CR_WBK + (jb * 64 + lane) * 16); o.wl[jb] = *(const f32x4*)(rec + CR_WL + (jb * 16 + g * 4) * 4); }
    o.tm = *(const u32x2*)(rec + CR_TM + lane * 8); o.nn = *(const u32x2*)(rec + CR_N + lane * 8);
#pragma unroll
    for (int it = 0; it < 2; ++it) o.vq[it] = *(const u32x2*)(rec + CR_V + ((half * 2 + it) * 64 + lane) * 8);
}
__device__ __forceinline__ bf16x8 mk8(unsigned a, unsigned b, unsigned c, unsigned d) { u32x4 w = {a, b, c, d}; return *reinterpret_cast<bf16x8*>(&w); }
__device__ __forceinline__ void rw_step(const RwOps& o, f32x4 (&X)[4][2], float* ysb, const long rs, int lane) {
    const int r = lane & 15, g = lane >> 4;
    const bf16x8 tmf = mk8(o.tm.x, o.tm.y, 0u, 0u), nf = mk8(o.nn.x, o.nn.y, 0u, 0u);
#pragma unroll
    for (int it = 0; it < 2; ++it) {
        bf16x8 xb[2];
#pragma unroll
        for (int ks = 0; ks < 2; ++ks) xb[ks] = mk8(pk2c(X[2 * ks][it][0], X[2 * ks][it][1]), pk2c(X[2 * ks][it][2], X[2 * ks][it][3]), pk2c(X[2 * ks + 1][it][0], X[2 * ks + 1][it][1]), pk2c(X[2 * ks + 1][it][2], X[2 * ks + 1][it][3]));
        const bf16x8 vb = mk8(o.vq[it].x, o.vq[it].y, 0u, 0u);
        f32x4 U = {0.f, 0.f, 0.f, 0.f}, Y = {0.f, 0.f, 0.f, 0.f};
        U = __builtin_amdgcn_mfma_f32_16x16x32_bf16(o.ta[0], xb[0], U, 0, 0, 0); Y = __builtin_amdgcn_mfma_f32_16x16x32_bf16(o.gh[0], xb[0], Y, 0, 0, 0);
        U = __builtin_amdgcn_mfma_f32_16x16x32_bf16(o.ta[1], xb[1], U, 0, 0, 0); Y = __builtin_amdgcn_mfma_f32_16x16x32_bf16(o.gh[1], xb[1], Y, 0, 0, 0);
        U = __builtin_amdgcn_mfma_f32_16x16x32_bf16(tmf, vb, U, 0, 0, 0);       Y = __builtin_amdgcn_mfma_f32_16x16x32_bf16(nf, vb, Y, 0, 0, 0);
        const bf16x8 uvb = mk8(pk2c(U[0], U[1]), pk2c(U[2], U[3]), o.vq[it].x, o.vq[it].y);
#pragma unroll
        for (int jb = 0; jb < 4; ++jb) X[jb][it] = __builtin_amdgcn_mfma_f32_16x16x32_bf16(o.wbk[jb], uvb, X[jb][it] * o.wl[jb], 0, 0, 0);
#pragma unroll
        for (int q = 0; q < 4; ++q) ysb[(long)(4 * g + q) * rs + 16 * it + r] = Y[q];
    }
}
__device__ __forceinline__ void rwkv_scan_chunked(Frame& F, int chain, int half) {
    unsigned char* ws = F.ws; asm volatile("" : "+s"(ws)); const int dir = chain & 1, h = (chain >> 1) & 7, b = chain >> 4; const int lane = F.lane;
    const unsigned char* rec0 = ws + SC_CREC + (size_t)chain * 256 * CR_BYTES;
#ifdef DBG_RWCHK
    float* YS = (float*)(ws + WS_HN) + (size_t)dir * NTOK * 512;
#else
    float* YS = (float*)(ws + SC_YS) + (size_t)dir * NTOK * 512;
#endif
    f32x4 X[4][2];
#pragma unroll
    for (int jb = 0; jb < 4; ++jb) { X[jb][0] = (f32x4){0.f, 0.f, 0.f, 0.f}; X[jb][1] = (f32x4){0.f, 0.f, 0.f, 0.f}; }
    RwOps oa, ob;
    rw_load(oa, rec0, lane, half);
    const long rs = dir ? -512 : 512;
    for (int c = 0; c < 256; c += 2) {
        rw_load(ob, rec0 + (size_t)(c + 1) * CR_BYTES, lane, half);
        { const int pos0 = dir ? (SEQ - 1 - 16 * c) : 16 * c; rw_step(oa, X, YS + (size_t)(b * SEQ + pos0) * 512 + h * 64 + half * 32, rs, lane); }
        if (c + 2 < 256) rw_load(oa, rec0 + (size_t)(c + 2) * CR_BYTES, lane, half);
        { const int pos0 = dir ? (SEQ - 1 - 16 * (c + 1)) : 16 * (c + 1); rw_step(ob, X, YS + (size_t)(b * SEQ + pos0) * 512 + h * 64 + half * 32, rs, lane); }
    }
}

__device__ __forceinline__ void rwkv_scan_naive(Frame& F, int chain) {
    unsigned char* ws = F.ws; const float* RW = (const float*)(ws + SC_RW); const size_t N1 = (size_t)NTOK * 512;
    const int dir = chain & 1, h = (chain >> 1) & 7, b = chain >> 4;
    const float* Rp = RW; const float* Vp = RW + N1; const float* KKp = RW + 2 * N1; const float* Wp = RW + (3 + dir) * N1; const float* KMp = RW + (5 + dir) * N1; const float* BBp = RW + (7 + dir) * N1;
    float* YS = (float*)(ws + SC_YS) + (size_t)dir * N1;
    LAS float* L = (LAS float*)(F.lds + F.wave * 2048);
    float st[64];
#pragma unroll
    for (int j = 0; j < 64; ++j) st[j] = 0.f;
    size_t idx = (size_t)(b * SEQ + (dir ? SEQ - 1 : 0)) * 512 + h * 64 + F.lane;
    float va = -KKp[idx], vw = __expf(Wp[idx]), vb = BBp[idx], vk = KMp[idx], vr = Rp[idx], vv = Vp[idx];
    for (int t = 0; t < SEQ; ++t) {
        L[F.lane] = va; L[64 + F.lane] = vw; L[128 + F.lane] = vb; L[192 + F.lane] = vk; L[256 + F.lane] = vr;
        const float v = vv; const size_t oidx = idx;
        if (t + 1 < SEQ) { idx = dir ? idx - 512 : idx + 512; va = -KKp[idx]; vw = __expf(Wp[idx]); vb = BBp[idx]; vk = KMp[idx]; vr = Rp[idx]; vv = Vp[idx]; }
        LDS_WAIT(); asm volatile("" ::: "memory");
        float sa0 = 0.f, sa1 = 0.f, sa2 = 0.f, sa3 = 0.f;
#pragma unroll
        for (int j = 0; j < 64; j += 4) { const f32x4 x = *(const LAS f32x4*)(L + j); sa0 += st[j] * x[0]; sa1 += st[j + 1] * x[1]; sa2 += st[j + 2] * x[2]; sa3 += st[j + 3] * x[3]; }
        const float sa = (sa0 + sa1) + (sa2 + sa3);
        float y0 = 0.f, y1 = 0.f, y2 = 0.f, y3 = 0.f;
#pragma unroll
        for (int j = 0; j < 64; j += 4) { const f32x4 w4 = *(const LAS f32x4*)(L + 64 + j), b4 = *(const LAS f32x4*)(L + 128 + j), k4 = *(const LAS f32x4*)(L + 192 + j), r4 = *(const LAS f32x4*)(L + 256 + j);
            st[j] = st[j] * w4[0] + (sa * b4[0] + v * k4[0]); st[j + 1] = st[j + 1] * w4[1] + (sa * b4[1] + v * k4[1]); st[j + 2] = st[j + 2] * w4[2] + (sa * b4[2] + v * k4[2]); st[j + 3] = st[j + 3] * w4[3] + (sa * b4[3] + v * k4[3]);
            y0 += st[j] * r4[0]; y1 += st[j + 1] * r4[1]; y2 += st[j + 2] * r4[2]; y3 += st[j + 3] * r4[3]; }
        YS[oidx] = (y0 + y1) + (y2 + y3);
        asm volatile("" ::: "memory");
    }
}

__device__ __forceinline__ void s5_unit(Frame& F, ArgsP a, int layer, int unit) {
    unsigned char* ws = F.ws; asm volatile("" : "+s"(ws)); const bf16* Z = (const bf16*)(ws + SC_Z);
    const int b = unit / S5NCH, ch = unit % S5NCH; const int tok0 = b * SEQ + ch * S5CH;
    LAS float* ybuf = (LAS float*)F.lds;
    LAS float* glT = (LAS float*)(F.lds + 32768);
    LAS float* xs = (LAS float*)(F.lds + 65536 + F.wave * 8192);
    const float* ab = (const float*)(ws + WS_S5P + layer * S5P_LAYER); const float* bb = ab + 2 * 32 * 64 * 2;
    const float* carry = (const float*)(ws + SC_CARRY);
    const int n = F.lane;
    __syncthreads();
    LAS float* ulw = (LAS float*)(F.lds + RING_BYTES + F.wave * 1024);
    for (int gi = 0; gi < 4; ++gi) {
        const int g = gi * 8 + F.wave;
        { const int tl = (n >> 1) & 15, hf = n & 1; const u32x4 w0 = *(const u32x4*)(Z + (size_t)(tok0 + tl) * ZLD + ZD + g * 16 + hf * 8);
          if (n < 32) { LAS f32x4* d = (LAS f32x4*)(ulw + tl * 16 + hf * 8);
            d[0] = (f32x4){__uint_as_float(w0.x << 16), __uint_as_float(w0.x & 0xffff0000u), __uint_as_float(w0.y << 16), __uint_as_float(w0.y & 0xffff0000u)};
            d[1] = (f32x4){__uint_as_float(w0.z << 16), __uint_as_float(w0.z & 0xffff0000u), __uint_as_float(w0.w << 16), __uint_as_float(w0.w & 0xffff0000u)}; } }
        float abr2[2], abi2[2], cr2[2], ci2[2];
#pragma unroll
        for (int dir = 0; dir < 2; ++dir) { const int pr = (dir * 32 + g) * 64 + n; abr2[dir] = ab[pr * 2]; abi2[dir] = ab[pr * 2 + 1];
            const float* cp = carry + ((((size_t)dir * BATCH + b) * S5NCH + ch) * 32 + g) * 128 + n * 2; cr2[dir] = cp[0]; ci2[dir] = cp[1]; }
        LDS_WAIT(); asm volatile("" ::: "memory");
#pragma unroll
        for (int dir = 0; dir < 2; ++dir) {
            const int pr = (dir * 32 + g) * 64 + n; const float abr = abr2[dir], abi = abi2[dir];
            float bbr[16], bbi[16];
            { const f32x4* bp = (const f32x4*)(bb + (size_t)pr * 32);
#pragma unroll
              for (int c4 = 0; c4 < 8; ++c4) { const f32x4 q = bp[c4]; bbr[c4 * 2] = q[0]; bbi[c4 * 2] = q[1]; bbr[c4 * 2 + 1] = q[2]; bbi[c4 * 2 + 1] = q[3]; } }
            float xr = cr2[dir], xi = ci2[dir];
#pragma unroll 2
            for (int i = 0; i < S5CH; ++i) { const int tl = dir ? (S5CH - 1 - i) : i;
                const f32x4 u0 = *(const LAS f32x4*)(ulw + tl * 16), u1 = *(const LAS f32x4*)(ulw + tl * 16 + 4), u2 = *(const LAS f32x4*)(ulw + tl * 16 + 8), u3 = *(const LAS f32x4*)(ulw + tl * 16 + 12);
                float br = 0.f, bi = 0.f;
#pragma unroll
                for (int c = 0; c < 4; ++c) { br += bbr[c] * u0[c] + bbr[4 + c] * u1[c] + bbr[8 + c] * u2[c] + bbr[12 + c] * u3[c]; bi += bbi[c] * u0[c] + bbi[4 + c] * u1[c] + bbi[8 + c] * u2[c] + bbi[12 + c] * u3[c]; }
                const float nr = abr * xr - abi * xi + br, ni = abr * xi + abi * xr + bi; xr = nr; xi = ni;
                LAS float* xp = xs + (tl * 64 + n) * 2;
                if (dir == 0) { xp[0] = xr; xp[1] = xi; } else { xp[0] += xr; xp[1] += xi; } }
        }
        LDS_WAIT(); asm volatile("" ::: "memory");
        { const int c = F.lane & 15, sq = F.lane >> 4; const float* cre = a->in[I_S5_C_RE] + (((size_t)layer * 32 + g) * 16 + c) * 64; const float* cim = a->in[I_S5_C_IM] + (((size_t)layer * 32 + g) * 16 + c) * 64;
          float y[4] = {0.f, 0.f, 0.f, 0.f};
#pragma unroll 4
          for (int nn = 0; nn < 64; nn += 4) { const f32x4 cr = *(const f32x4*)(cre + nn), ci = *(const f32x4*)(cim + nn);
#pragma unroll
              for (int s = 0; s < 4; ++s) { const LAS f32x4* xp = (const LAS f32x4*)(xs + ((sq * 4 + s) * 64 + nn) * 2); const f32x4 xa = xp[0], xb = xp[1];
                  y[s] += cr[0] * xa[0] - ci[0] * xa[1] + cr[1] * xa[2] - ci[1] * xa[3] + cr[2] * xb[0] - ci[2] * xb[1] + cr[3] * xb[2] - ci[3] * xb[3]; } }
          const float dsk = a->in[I_S5_D][(size_t)layer * 512 + g * 16 + c];
#pragma unroll
          for (int s = 0; s < 4; ++s) { const int tl = sq * 4 + s; const float uu = ulw[tl * 16 + c]; const float yy = y[s] + dsk * uu;
              const float x3 = yy * yy * yy; const float gl = 0.5f * yy * (1.f + tanhf(0.7978845608028654f * (yy + 0.044715f * x3)));
              ybuf[tl * 512 + g * 16 + c] = gl; glT[(g * 16 + c) * 16 + tl] = gl; } }
        LDS_WAIT(); asm volatile("" ::: "memory");
    }
    __syncthreads();
    { const int c = F.tid; const __amdgpu_buffer_rsrc_t gw = make_rsrc(a->in[I_S5_GLU_W] + (size_t)layer * 512 * 512, 512 * 512 * 4); float acc[16];
#pragma unroll
      for (int s = 0; s < 16; ++s) acc[s] = 0.f;
#pragma unroll 1
      for (int k0 = 0; k0 < 512; k0 += 16) { float wv[16];
#pragma unroll
          for (int q = 0; q < 16; ++q) wv[q] = bload_f32(gw, c * 4, (k0 + q) * 2048);
#pragma unroll
          for (int kk = 0; kk < 16; ++kk) { const float w = wv[kk]; const LAS f32x4* gp = (const LAS f32x4*)(glT + (k0 + kk) * 16); const f32x4 g0 = gp[0], g1 = gp[1], g2 = gp[2], g3 = gp[3];
#pragma unroll
              for (int q = 0; q < 4; ++q) { acc[q] += g0[q] * w; acc[4 + q] += g1[q] * w; acc[8 + q] += g2[q] * w; acc[12 + q] += g3[q] * w; }
              if (kk & 1) asm volatile("" ::: "memory"); } }
      const float bias = a->in[I_S5_GLU_B][(size_t)layer * 512 + c];
      __syncthreads();
#pragma unroll
      for (int s = 0; s < 16; ++s) { const float gl = ybuf[s * 512 + c]; ybuf[s * 512 + c] = gl * sigmoidf_(acc[s] + bias); } }
    __syncthreads();
    { const float* gn = a->in[I_MIX_OUT_NORM] + ((size_t)layer * 2 + 1) * 512; bf16* MIX = (bf16*)(ws + WS_MIX);
#pragma unroll
      for (int q = 0; q < 2; ++q) { const int tl = F.wave * 2 + q; float v[8]; float s = 0.f;
#pragma unroll
          for (int j = 0; j < 8; ++j) { v[j] = ybuf[tl * 512 + j * 64 + F.lane]; s += v[j] * v[j]; }
          const float rstd = 1.f / sqrtf(wave_sum(s) * (1.f / 512.f) + RMS_EPS);
#pragma unroll
          for (int j = 0; j < 8; ++j) MIX[(size_t)(tok0 + tl) * DM + 1536 + j * 64 + F.lane] = f2bf(v[j] * rstd * gn[j * 64 + F.lane]); } }
}

template <int mask>
__device__ __forceinline__ void mix_phase(Frame& F, ArgsP a, int layer, const int rep) {
    const int qb_ = (rep * 2 + layer) * 8;
    constexpr int NB = 8, NA = BATCH * 4 * (SEQ / 128), NC = BATCH * 4 * 48, ND = BATCH * S5NCH;
#ifdef DBG_RWCHK
    for (;;) { const int it = q_next(F, layer * 8 + 5); if (it >= 4) break; rwkv_scan_naive(F, it * 8 + F.wave); }
#endif
    if (mask & 1) for (;;) { const int it = q_next(F, qb_ + 1); if (it >= NB) break; rwkv_scan_chunked(F, it * 4 + (F.wave >> 1), F.wave & 1); }
    if (mask & 2) for (;;) { const int it = q_next(F, qb_ + 2); if (it >= NA) break;
        unsigned char* ws = F.ws; asm volatile("" : "+s"(ws)); const bf16* Z = (const bf16*)(ws + SC_Z);
        const int qb = it % (SEQ / 128), h = (it / (SEQ / 128)) % 4, b = it / (4 * (SEQ / 128));
        const bf16* zb = Z + (size_t)(b * SEQ) * ZLD + ZA;
        float lam, lam_init;
        { const float* lv = a->in[I_DIFF_LAMBDA] + (size_t)layer * 4 * 64; float d1 = 0.f, d2 = 0.f;
          for (int i = 0; i < 64; ++i) { d1 += lv[i] * lv[64 + i]; d2 += lv[128 + i] * lv[192 + i]; }
          lam_init = 0.8f - 0.6f * expf(-0.3f * (float)layer); lam = expf(d1) - expf(d2) + lam_init; }
        att::diff_attn_unit(zb + (size_t)(qb * 128) * ZLD + h * 128, zb + 512 + h * 128, zb + 1024 + h * 128, ZLD, SEQ,
                            (bf16*)(ws + WS_MIX) + (size_t)(b * SEQ + qb * 128) * DM + h * 128, DM, lam, 1.f - lam_init, a->in[I_DIFF_SUBLN] + (size_t)layer * 128, (char*)F.lds, F.wave); }
    if (mask & 4) for (;;) { const int it = q_next(F, qb_ + 3); if (it >= NC) break;
        unsigned char* ws = F.ws; asm volatile("" : "+s"(ws)); const bf16* Z = (const bf16*)(ws + SC_Z);
        const int r = it % 48, h = (it / 48) % 4, b = it / (48 * 4); const int p = r / 16, rr = r % 16;
        const int dil = p == 0 ? 1 : (p == 1 ? 4 : 16); const int L = SEQ / dil; const int nqb = L / 256; const int rho = rr / nqb, qb = rr % nqb;
        const bf16* zb = Z + (size_t)(b * SEQ) * ZLD + ZC;
        att::dil_attn_unit(zb + h * 128, zb + 512 + h * 128, zb + 1024 + h * 128, ZLD, dil, rho, qb * 256, L,
                           (float*)(ws + SC_OC) + ((size_t)p * NTOK + (size_t)b * SEQ) * 512 + h * 128, (float*)(ws + SC_LSE) + ((size_t)p * NTOK + (size_t)b * SEQ) * 4 + h, (char*)F.lds, F.wave); }
    if (mask & 8) for (;;) { const int it = q_next(F, qb_ + 4); if (it >= ND) break; s5_unit(F, a, layer, it); }
}

__device__ __forceinline__ void post_phase(Frame& F, ArgsP a, int layer) {
    unsigned char* ws = F.ws; bf16* MIX = (bf16*)(ws + WS_MIX);
    const int gw = F.bid * 8 + F.wave, NGW = F.G * 8;
    const float* RW = (const float*)(ws + SC_RW); const size_t N1 = (size_t)NTOK * 512; const float* YS = (const float*)(ws + SC_YS);
#ifdef DBG_RWCHK
    { const float* Y2 = (const float*)(ws + WS_HN); float e = 0.f, r2 = 0.f; int bad = 0;
      for (size_t i = (size_t)F.bid * 512 + F.tid; i < (size_t)2 * NTOK * 512; i += (size_t)F.G * 512) { const float a0 = ((const float*)(ws + SC_YS))[i], b0 = Y2[i]; const float d = fabsf(a0 - b0); if (!(d < 1e30f)) bad = 1; else e = fmaxf(e, d); r2 = fmaxf(r2, fabsf(a0)); }
      e = wave_max(e); r2 = wave_max(r2); bad = __any(bad) ? 1 : 0;
      if (F.lane == 0) { atomicMax(F.ctl + 32768 + layer * 64, __float_as_uint(e)); atomicMax(F.ctl + 32768 + layer * 64 + 1, __float_as_uint(r2)); if (bad) atomicMax(F.ctl + 32768 + layer * 64 + 2, 1u); } }
#endif
    for (int it = gw; it < NTOK * 8; it += NGW) { const int tok = it >> 3, h = it & 7; const size_t o = (size_t)tok * 512 + h * 64 + F.lane; const int c = h * 64 + F.lane;
        const float y = YS[o] + YS[N1 + o];
        const float mean = wave_sum(y) * (1.f / 64.f); const float d = y - mean; const float var = wave_sum(d * d) * (1.f / 64.f);
        const float yn = d * (1.f / sqrtf(var + 64e-5f)) * a->in[I_RWKV_LNX_W][(size_t)layer * 512 + c] + a->in[I_RWKV_LNX_B][(size_t)layer * 512 + c];
        const float r_ = RW[o], v_ = RW[N1 + o], kb = 0.5f * (RW[5 * N1 + o] + RW[6 * N1 + o]);
        const float bon = wave_sum(r_ * kb * a->in[I_RWKV_RK][(size_t)layer * 512 + c]) * v_;
        MIX[(size_t)tok * DM + 512 + c] = f2bf((yn + bon) * RW[9 * N1 + o]); }
    const float* OC = (const float*)(ws + SC_OC); const float* LSE = (const float*)(ws + SC_LSE); const float* gn = a->in[I_MIX_OUT_NORM] + ((size_t)layer * 2 + 0) * 512;
    for (int tok = gw; tok < NTOK; tok += NGW) { const int h = F.lane >> 4;
        const float l0 = LSE[((size_t)0 * NTOK + tok) * 4 + h], l1 = LSE[((size_t)1 * NTOK + tok) * 4 + h], l2 = LSE[((size_t)2 * NTOK + tok) * 4 + h];
        const float m = fmaxf(l0, fmaxf(l1, l2)); float w0 = __expf(l0 - m), w1 = __expf(l1 - m), w2 = __expf(l2 - m); const float inv = 1.f / (w0 + w1 + w2); w0 *= inv; w1 *= inv; w2 *= inv;
        float v[8]; float s = 0.f;
        const f32x4* p0 = (const f32x4*)(OC + ((size_t)0 * NTOK + tok) * 512) + F.lane * 2; const f32x4* p1 = (const f32x4*)(OC + ((size_t)1 * NTOK + tok) * 512) + F.lane * 2; const f32x4* p2 = (const f32x4*)(OC + ((size_t)2 * NTOK + tok) * 512) + F.lane * 2;
#pragma unroll
        for (int j = 0; j < 2; ++j) { const f32x4 a0 = p0[j], a1 = p1[j], a2 = p2[j];
#pragma unroll
            for (int e = 0; e < 4; ++e) { const float x = w0 * a0[e] + w1 * a1[e] + w2 * a2[e]; v[j * 4 + e] = x; s += x * x; } }
        const float rstd = 1.f / sqrtf(wave_sum(s) * (1.f / 512.f) + RMS_EPS);
        const f32x4 g0 = *((const f32x4*)gn + F.lane * 2), g1 = *((const f32x4*)gn + F.lane * 2 + 1);
        u32x4 w; w.x = pk2(v[0] * rstd * g0[0], v[1] * rstd * g0[1]); w.y = pk2(v[2] * rstd * g0[2], v[3] * rstd * g0[3]); w.z = pk2(v[4] * rstd * g1[0], v[5] * rstd * g1[1]); w.w = pk2(v[6] * rstd * g1[2], v[7] * rstd * g1[3]);
        *(u32x4*)(MIX + (size_t)tok * DM + 1024 + F.lane * 8) = w; }
}

#ifndef MK_FUSED
#define MK_FUSED 1
#endif
__global__ void __launch_bounds__(512, 2) enc_fwd(Args args_) {
    extern __shared__ __attribute__((aligned(16))) unsigned char lds_raw[];
    Frame F;
    F.lds = (LAS unsigned char*)lds_raw; F.MISC = (volatile LAS unsigned*)(F.lds + MISC_OFF);
    F.tid = threadIdx.x; F.lane = F.tid & 63; F.wave = __builtin_amdgcn_readfirstlane(F.tid >> 6); F.G = gridDim.x; F.bid = blockIdx.x;
    const int wave0 = F.wave;
    ArgsP ap = (ArgsP)__builtin_amdgcn_kernarg_segment_ptr();
    unsigned char* ws = ap->ws; F.ws = ws; F.ctl = (unsigned*)(ws + WS_CTL);
    for (int u = F.tid; u < (LDS_BYTES - MISC_OFF) / 4; u += 512) ((LAS unsigned*)(F.lds + MISC_OFF))[u] = 0u;
    __syncthreads();
    const int lo = ap->ph_lo, hi = ap->ph_hi;
    if (hi - lo > 1) (void)xcd_barrier_post(F.ctl + CW_BAR, F.MISC + 8);
#ifdef DBG_ONLY
#define IN(k) (((k) < PH_L0 ? (k) : ((k) == PH_FINAL ? 100 : 3 + ((k) - PH_L0) % NPH_L)) == DBG_ONLY && lo <= (k) && (k) < hi)
#else
#define IN(k) ({ int lo_ = lo, hi_ = hi; asm volatile("" : "+s"(lo_), "+s"(hi_)); lo_ <= (k) && (k) < hi_; })
#endif
#define args (*ap)
#define REFRESH() do { int wv_ = wave0, bi_ = blockIdx.x, gg_ = gridDim.x; asm volatile("" : "+s"(wv_), "+s"(bi_), "+s"(gg_)); const int t_ = tid_from_wave(wv_); F.tid = t_; F.lane = t_ & 63; F.wave = wv_; F.bid = bi_; F.G = gg_; ap = (ArgsP)__builtin_amdgcn_kernarg_segment_ptr(); asm volatile("" : "+s"(ap)); unsigned char* w_ = ap->ws; F.ws = w_; ws = w_; F.ctl = (unsigned*)(w_ + WS_CTL); } while (0)
#ifndef DBG_MIXMASK
#define DBG_MIXMASK 15
#endif
#ifndef DBG_REP_CODE
#define DBG_REP_CODE -1
#define DBG_REP_N 0
#endif
#define REPS(code) (((code) == DBG_REP_CODE && l_ == 0) ? 1 + DBG_REP_N : 1)
#define SEAM(k) do { if (IN(k) && IN((k) + 1)) { XcdBarrier b_; b_.bar = (unsigned*)(ap->ws + WS_CTL) + CW_BAR; b_.x = xb_xcc_id(); b_.st = F.MISC + 8; xcd_barrier(b_); } } while (0)

    { const int l_ = 0; if (IN(PH_P0)) { REFRESH(); for (int rep = 0; rep < REPS(0); ++rep) p0_prologue(F, ap); } } SEAM(PH_P0);
    if (DBG_REP_CODE == 30 && hi - lo > 1) { for (int i = 0; i < 20; ++i) { XcdBarrier b_; b_.bar = (unsigned*)(ap->ws + WS_CTL) + CW_BAR; b_.x = xb_xcc_id(); b_.st = F.MISC + 8; xcd_barrier(b_); } }
    if (IN(PH_P1)) { REFRESH();
        SchedBatch S{(const char*)(ws + SC_MEMN), (const char*)(ws + SC_WKVT), (char*)(ws + SC_KVB), (size_t)512 * DM * 2, (size_t)4096 * DM * 2, (size_t)512 * 4096 * 2, 2, 16, DEPTH, F.G, F.bid, DM, DM, 4096 * 2, 2, 512};
        { const int l_ = 0; for (int rep = 0; rep < REPS(1); ++rep) pg8::gemm_phase<pg8::EpiBf16, SchedBatch, false>(F.lds, pg8::GemmP{DM, DM, DM}, S, pg8::EpiBf16{4096}, F.wave); }
    } SEAM(PH_P1);
    if (IN(PH_P2)) { REFRESH();
        { SchedXaPre S{ws, F.G, F.bid, 0}; pg8::gemm_phase<EpiBf16U, SchedXaPre, false>(F.lds, pg8::GemmP{512, 4096, DM}, S, EpiBf16U{}, F.wave); }
        { SchedXaPre S{ws, F.G, F.bid, 1}; pg8::gemm_phase<EpiBf16U, SchedXaPre, false>(F.lds, pg8::GemmP{512, DM, 4096}, S, EpiBf16U{}, F.wave); }
    } SEAM(PH_P2);

    for (int l = 0; l < DEPTH; ++l) {
        const int pb = PH_L0 + l * NPH_L; const int l_ = l;
        float* H = (float*)(ws + WS_H);
        if (IN(pb + LP_NORM1)) { REFRESH(); if (l == 0) { for (int rep = 0; rep < REPS(22); ++rep) norm_phase<0>(F, ap, args.in[I_X], args.in[I_NORM_MIX], l); } else norm_phase<1>(F, ap, H, args.in[I_NORM_MIX] + (size_t)l * DM, l); } SEAM(pb + LP_NORM1);
        if (IN(pb + LP_G1)) { REFRESH();
            SchedDense S{(const char*)(ws + WS_HN), (const char*)(ws + WS_WIN) + (size_t)l * ZLD * DM * 2, (char*)(ws + SC_Z), NTOK / 256, ZLD / 256, F.G, F.bid, DM, DM, ZLD * 2, 2};
            for (int rep = 0; rep < REPS(10); ++rep) pg8::gemm_phase<pg8::EpiBf16, SchedDense, false>(F.lds, pg8::GemmP{DM, DM, DM}, S, pg8::EpiBf16{ZLD}, F.wave);
        } SEAM(pb + LP_G1);
        if (IN(pb + LP_PREP)) { REFRESH(); for (int rep = 0; rep < REPS(11); ++rep) prep_phase(F, ap, l, rep); } SEAM(pb + LP_PREP);
        if (IN(pb + LP_CPREP)) { REFRESH(); for (int rep = 0; rep < REPS(12); ++rep) cprep_phase(F, l); } SEAM(pb + LP_CPREP);
        if (IN(pb + LP_MIX)) { REFRESH(); mix_phase<DBG_MIXMASK>(F, ap, l, 0); if (DBG_REP_CODE >= 13 && DBG_REP_CODE <= 16 && l_ == 0) { REFRESH(); mix_phase<(DBG_REP_CODE >= 13 && DBG_REP_CODE <= 16) ? (1 << (DBG_REP_CODE - 13)) : 1>(F, ap, l, 1); if (DBG_REP_N > 1) { REFRESH(); mix_phase<(DBG_REP_CODE >= 13 && DBG_REP_CODE <= 16) ? (1 << (DBG_REP_CODE - 13)) : 1>(F, ap, l, 2); } } } SEAM(pb + LP_MIX);
        if (IN(pb + LP_POST)) { REFRESH(); for (int rep = 0; rep < REPS(17); ++rep) post_phase(F, ap, l); } SEAM(pb + LP_POST);
        if (IN(pb + LP_G2)) { REFRESH();
            SchedDense S{(const char*)(ws + WS_MIX), (const char*)(ws + WS_WOUT) + (size_t)l * DM * DM * 2, (char*)H, NTOK / 256, DM / 256, F.G, F.bid, DM, DM, DM * 4, 4};
            for (int rep = 0; rep < REPS(23); ++rep) pg8::gemm_phase<pg8::EpiF32Res, SchedDense, false>(F.lds, pg8::GemmP{DM, DM, DM}, S, pg8::EpiF32Res{DM, l == 0 ? args.in[I_X] : (const float*)H, H}, F.wave);
        } SEAM(pb + LP_G2);
        if (IN(pb + LP_NORM2)) { REFRESH(); for (int rep = 0; rep < REPS(18); ++rep) norm_phase<0>(F, ap, H, args.in[I_NORM_CROSS] + (size_t)l * DM, l); } SEAM(pb + LP_NORM2);
        if (IN(pb + LP_GS)) { REFRESH();
            SchedBatch S{(const char*)(ws + WS_HN), (const char*)(ws + WS_WQK) + (size_t)l * 2 * 1024 * DM * 2, (char*)(ws + WS_P), (size_t)SEQ * DM * 2, (size_t)1024 * DM * 2, (size_t)SEQ * 1024 * 2, SEQ / 256, 4, BATCH, F.G, F.bid, DM, DM, 1024 * 2, 2, SEQ};
            for (int rep = 0; rep < REPS(19); ++rep) pg8::gemm_phase<pg8::EpiSoftmax, SchedBatch, false>(F.lds, pg8::GemmP{DM, DM, DM}, S, pg8::EpiSoftmax{1024, 0.044194173824159216f * 1.4426950408889634f}, F.wave);
        } SEAM(pb + LP_GS);
        if (IN(pb + LP_GO)) { REFRESH();
            SchedBatch S{(const char*)(ws + WS_P), (const char*)(ws + WS_VWO) + (size_t)l * 2 * DM * 1024 * 2, (char*)H, (size_t)SEQ * 1024 * 2, (size_t)DM * 1024 * 2, (size_t)SEQ * DM * 4, SEQ / 256, DM / 256, BATCH, F.G, F.bid, 1024, 1024, DM * 4, 4, SEQ};
            pg8::gemm_phase<pg8::EpiF32Res, SchedBatch, false>(F.lds, pg8::GemmP{1024, 1024, 1024}, S, pg8::EpiF32Res{DM, (const float*)H, H}, F.wave);
        } SEAM(pb + LP_GO);
        if (IN(pb + LP_NORM3)) { REFRESH(); norm_phase<2>(F, ap, H, args.in[I_NORM_MOE] + (size_t)l * DM, l); } SEAM(pb + LP_NORM3);
        if (IN(pb + LP_M1)) { REFRESH();
            volatile LAS int* tp = (volatile LAS int*)(F.lds + MISC_OFF + 256); volatile LAS int* cnt = tp + 40;
            moe_prefix(F, l, tp, cnt);
            SchedMoe S{ws, tp, cnt, l, F.G, F.bid, 0};
            for (int rep = 0; rep < REPS(20); ++rep) pg8::gemm_phase<pg8::EpiSwiGlu, SchedMoe, true>(F.lds, pg8::GemmP{DM, DM, DM}, S, pg8::EpiSwiGlu{DEXP}, F.wave);
        } SEAM(pb + LP_M1);
        if (IN(pb + LP_M2)) { REFRESH();
            volatile LAS int* tp = (volatile LAS int*)(F.lds + MISC_OFF + 256); volatile LAS int* cnt = tp + 40;
            moe_prefix(F, l, tp, cnt);
            SchedMoe S{ws, tp, cnt, l, F.G, F.bid, 1};
            for (int rep = 0; rep < REPS(21); ++rep) pg8::gemm_phase<pg8::EpiGate, SchedMoe, false>(F.lds, pg8::GemmP{DEXP, DEXP, DEXP}, S, pg8::EpiGate{DM, (const float*)(ws + WS_EGATE), nullptr}, F.wave);
        } SEAM(pb + LP_M2);
    }
    if (IN(PH_FINAL)) { REFRESH(); norm_phase<5>(F, ap, (const float*)(ws + WS_H), args.in[I_NORM_FINAL], DEPTH); }
#undef IN
#undef SEAM
#undef args
}

extern "C" void kernel_launch(void* const* d_in, const int* in_sizes, int n_in, void* d_out, int out_size, void* d_ws, size_t ws_size, hipStream_t stream) {
    static int grid = 0;
    if (grid == 0) {
        if (n_in != N_INPUTS || out_size != NTOK * DM || ws_size < cmax(WS_END, SC_MIX_END3)) { fprintf(stderr, "kernel_launch: built for %d inputs, out %d, ws >= %zu; got %d, %d, %zu\n", N_INPUTS, NTOK * DM, cmax(WS_END, SC_MIX_END3), n_in, out_size, ws_size); grid = -1; return; }
        int dev = 0, cus = 0, per_cu = 0;
        if (hipGetDevice(&dev) != hipSuccess || hipDeviceGetAttribute(&cus, hipDeviceAttributeMultiprocessorCount, dev) != hipSuccess) { fprintf(stderr, "kernel_launch: device query failed\n"); grid = -1; return; }
        if (hipFuncSetAttribute((const void*)enc_fwd, hipFuncAttributeMaxDynamicSharedMemorySize, LDS_BYTES) != hipSuccess) { fprintf(stderr, "kernel_launch: hipFuncSetAttribute failed\n"); grid = -1; return; }
        if (hipOccupancyMaxActiveBlocksPerMultiprocessor(&per_cu, (const void*)enc_fwd, 512, LDS_BYTES) != hipSuccess || per_cu < 1) fprintf(stderr, "kernel_launch: occupancy query says %d blocks per CU\n", per_cu);
        grid = cus;
    }
    if (grid < 0) return;
    hipMemsetAsync((char*)d_ws + WS_CTL, 0, CTL_BYTES, stream);
    Args a; memset(&a, 0, sizeof(a));
    for (int i = 0; i < N_INPUTS; ++i) a.in[i] = (const float*)d_in[i];
    a.out = (float*)d_out; a.ws = (unsigned char*)d_ws;
#if MK_FUSED
    a.ph_lo = 0; a.ph_hi = NPHASES;
    hipLaunchKernelGGL(enc_fwd, dim3(grid), dim3(512), LDS_BYTES, stream, a);
#else
    for (int p = 0; p < NPHASES; ++p) { a.ph_lo = p; a.ph_hi = p + 1; hipLaunchKernelGGL(enc_fwd, dim3(grid), dim3(512), LDS_BYTES, stream, a); }
#endif
    const hipError_t le = hipPeekAtLastError();
    if (le != hipSuccess) fprintf(stderr, "kernel_launch: launch failed: %s\n", hipGetErrorName(le));
}
```

```cpp
#include <hip/hip_runtime.h>
#include <cstdio>
#include <cstdint>
#include <cstring>

#define GAS __attribute__((address_space(1)))
#define LAS __attribute__((address_space(3)))
typedef unsigned short bf16;
typedef short bf16x8 __attribute__((ext_vector_type(8)));
typedef short s16x4 __attribute__((ext_vector_type(4)));
typedef float f32x2 __attribute__((ext_vector_type(2)));
typedef float f32x4 __attribute__((ext_vector_type(4)));
typedef float f32x16 __attribute__((ext_vector_type(16)));
typedef unsigned u32x2 __attribute__((ext_vector_type(2)));
typedef unsigned u32x4 __attribute__((ext_vector_type(4)));
typedef GAS unsigned gu32;

constexpr int DM = 2048, BATCH = 2, SEQ = 4096, NTOK = BATCH * SEQ, DEPTH = 2, NMEM = 256;
constexpr int IN_A = 1536, IN_B = 1920, IN_C = 1536, IN_D = 512, IN_TOTAL = 5504, ZLD = 5632;
constexpr int ZA = 0, ZB = 1536, ZC = 3456, ZD = 4992;
constexpr int NEXP = 32, DEXP = 512, ECAP = 8192;
constexpr int SLOT_CAP = 24576;
constexpr int S5CH = 16, S5NCH = SEQ / S5CH;
constexpr float RMS_EPS = 1e-6f;

enum { I_X = 0, I_MEM, I_NORM_MIX, I_W_IN, I_W_OUT, I_DIFF_LAMBDA, I_DIFF_SUBLN, I_RWKV_MU, I_RWKV_W0, I_RWKV_W2, I_RWKV_A0, I_RWKV_A2, I_RWKV_G2,
       I_RWKV_KK, I_RWKV_KA, I_RWKV_RK, I_RWKV_LNX_W, I_RWKV_LNX_B, I_S5_A_RE, I_S5_A_IM, I_S5_LOG_DT, I_S5_B_RE, I_S5_B_IM, I_S5_C_RE, I_S5_C_IM,
       I_S5_D, I_S5_GLU_W, I_S5_GLU_B, I_MIX_OUT_NORM, I_NORM_CROSS, I_NORM_MEM, I_XA_WQ, I_XA_WKV, I_XA_WO, I_NORM_MOE, I_ROUTER_GROUP,
       I_ROUTER_EXPERT, I_MOE_W1, I_MOE_W3, I_MOE_W2, I_NORM_FINAL, N_INPUTS };

constexpr size_t al256(size_t x) { return (x + 255) / 256 * 256; }
constexpr size_t WS_CTL = 0, CTL_BYTES = 1u << 20;
constexpr size_t WS_WIN  = WS_CTL + CTL_BYTES;
constexpr size_t WS_WOUT = WS_WIN + (size_t)DEPTH * ZLD * DM * 2;
constexpr size_t WS_WQK  = WS_WOUT + (size_t)DEPTH * DM * DM * 2;
constexpr size_t WS_VWO  = WS_WQK + (size_t)DEPTH * BATCH * 1024 * DM * 2;
constexpr size_t WS_W13  = WS_VWO + (size_t)DEPTH * BATCH * DM * 1024 * 2;
constexpr size_t WS_W2   = WS_W13 + (size_t)DEPTH * NEXP * 1024 * DM * 2;
constexpr size_t WS_ROPE = WS_W2 + (size_t)DEPTH * NEXP * DM * DEXP * 2;
constexpr size_t WS_S5P  = WS_ROPE + (size_t)SEQ * (32 + 32 + 64 + 64) * 4;
constexpr size_t S5P_LAYER = (size_t)(2 * 32 * 64 * 2 + 2 * 32 * 64 * 16 * 2 + 2 * 32 * 64 * 2) * 4;
constexpr size_t WS_H    = al256(WS_S5P + DEPTH * S5P_LAYER);
constexpr size_t WS_HN   = WS_H + (size_t)NTOK * DM * 4;
constexpr size_t WS_MIX  = WS_HN + (size_t)NTOK * DM * 2;
constexpr size_t WS_P    = WS_MIX + (size_t)NTOK * DM * 2;
constexpr size_t WS_ETOK = WS_P + (size_t)NTOK * 1024 * 2;
constexpr size_t WS_EGATE= WS_ETOK + (size_t)NEXP * ECAP * 4;
constexpr size_t WS_TINFO= WS_EGATE + (size_t)NEXP * ECAP * 4;
constexpr size_t WS_SCR  = al256(WS_TINFO + (size_t)NTOK * 16);
constexpr size_t SC_WKVT = WS_SCR;
constexpr size_t SC_MEMN = SC_WKVT + (size_t)DEPTH * 4096 * DM * 2;
constexpr size_t SC_KVB  = SC_MEMN + (size_t)DEPTH * 512 * DM * 2;
constexpr size_t SC_WQB  = SC_KVB + (size_t)DEPTH * 512 * 4096 * 2;
constexpr size_t SC_WOT  = SC_WQB + (size_t)DEPTH * DM * DM * 2;
constexpr size_t SC_PRO_END = SC_WOT + (size_t)DEPTH * DM * DM * 2;
constexpr size_t SC_Z    = WS_SCR;
constexpr size_t SC_RW   = SC_Z + (size_t)NTOK * ZLD * 2;
constexpr size_t RWSZ    = (size_t)NTOK * 512 * 4;
constexpr size_t SC_YS   = SC_RW + 10 * RWSZ;
constexpr size_t SC_OC   = SC_YS + 2 * RWSZ;
constexpr size_t SC_LSE  = SC_OC + 3 * RWSZ;
constexpr size_t SC_CARRY= SC_LSE + (size_t)3 * NTOK * 4 * 4;
constexpr size_t SC_MIX_END = SC_CARRY + (size_t)2 * BATCH * S5NCH * 32 * 64 * 2 * 4;
constexpr size_t SC_HMID = WS_SCR;
constexpr size_t SC_YBUF = SC_HMID + (size_t)SLOT_CAP * DEXP * 2;
constexpr size_t SC_MOE_END = SC_YBUF + (size_t)SLOT_CAP * DM * 2;
constexpr size_t cmax(size_t a, size_t b) { return a > b ? a : b; }
constexpr size_t WS_END = cmax(cmax(SC_PRO_END, SC_MIX_END), SC_MOE_END);

constexpr int CW_BAR = 4096;
constexpr int CW_Q = 8192;
constexpr int CW_CNT = 16384;

constexpr int RING_BYTES = 131072;
constexpr int MISC_OFF = 147456 - 1024;
constexpr int LDS_BYTES = 147456;

__device__ __forceinline__ float bf2f(unsigned short b) { return __uint_as_float(((unsigned)b) << 16); }
typedef __bf16 bf16x2_t __attribute__((ext_vector_type(2)));
__device__ __forceinline__ unsigned pk2c(float lo, float hi) { bf16x2_t v = {(__bf16)lo, (__bf16)hi}; return __builtin_bit_cast(unsigned, v); }
__device__ __forceinline__ unsigned pk2(float lo, float hi) { unsigned r; asm volatile("v_cvt_pk_bf16_f32 %0, %1, %2" : "=v"(r) : "v"(lo), "v"(hi)); return r; }
__device__ __forceinline__ bf16 f2bf(float f) { return (bf16)(pk2(f, 0.f) & 0xffffu); }
template <int CTRL> __device__ __forceinline__ float dpp_mov(float v) { return __builtin_bit_cast(float, __builtin_amdgcn_update_dpp(0, __builtin_bit_cast(int, v), CTRL, 0xf, 0xf, true)); }
__device__ __forceinline__ float row_sum(float v) { v += dpp_mov<0xB1>(v); v += dpp_mov<0x4E>(v); v += dpp_mov<0x141>(v); v += dpp_mov<0x140>(v); return v; }
__device__ __forceinline__ float row_max(float v) { v = fmaxf(v, dpp_mov<0xB1>(v)); v = fmaxf(v, dpp_mov<0x4E>(v)); v = fmaxf(v, dpp_mov<0x141>(v)); v = fmaxf(v, dpp_mov<0x140>(v)); return v; }
__device__ __forceinline__ float rdlane(float v, int l) { return __builtin_bit_cast(float, __builtin_amdgcn_readlane(__builtin_bit_cast(int, v), l)); }
__device__ __forceinline__ float wave_sum(float v) { v = row_sum(v); return (rdlane(v, 0) + rdlane(v, 16)) + (rdlane(v, 32) + rdlane(v, 48)); }
__device__ __forceinline__ float wave_max(float v) { v = row_max(v); return fmaxf(fmaxf(rdlane(v, 0), rdlane(v, 16)), fmaxf(rdlane(v, 32), rdlane(v, 48))); }
__device__ __forceinline__ float sigmoidf_(float x) { return 1.f / (1.f + __expf(-x)); }
#define LDS_WAIT() asm volatile("s_waitcnt lgkmcnt(0)" ::: "memory")
#define VM_WAIT() asm volatile("s_waitcnt vmcnt(0)" ::: "memory")

__device__ __forceinline__ int tid_from_wave(int wave) { int ln; asm volatile("v_mbcnt_lo_u32_b32 %0, -1, 0\n\tv_mbcnt_hi_u32_b32 %0, -1, %0" : "=v"(ln)); return wave * 64 + ln; }

typedef __attribute__((address_space(8))) void* bufrsrc_t;
__device__ __forceinline__ __amdgpu_buffer_rsrc_t make_rsrc(const void* p, unsigned bytes) { return __builtin_amdgcn_make_buffer_rsrc((void*)p, 0, bytes, 0x00020000); }
__device__ __forceinline__ float bload_f32(__amdgpu_buffer_rsrc_t r, int voff, int soff) { return __builtin_bit_cast(float, __builtin_amdgcn_raw_buffer_load_b32(r, voff, soff, 0)); }

__device__ __forceinline__ float xor_lane(float v, int lane, int m) { return __builtin_bit_cast(float, __builtin_amdgcn_ds_bpermute((lane ^ m) << 2, __builtin_bit_cast(int, v))); }
#define XB_TMO      128
#define XB_XCNT(j)  (256  + 64 * (j))
#define XB_XSUB(j)  (1280 + 64 * (j))
#define XB_XGEN(j)  (2304 + 64 * (j))
#define XB_TOP      3328
#define XB_TOPGEN   3392
#define XCD_BAR_WORDS 3456
#define XB_SPIN_CAP (1u << 18)

__device__ __forceinline__ unsigned xb_ld(unsigned* p)              { return __hip_atomic_load(p, __ATOMIC_RELAXED, __HIP_MEMORY_SCOPE_AGENT); }
__device__ __forceinline__ unsigned xb_add(unsigned* p, unsigned v) { return __hip_atomic_fetch_add(p, v, __ATOMIC_RELAXED, __HIP_MEMORY_SCOPE_AGENT); }
__device__ __forceinline__ unsigned xb_xcc_id() { return (unsigned)__builtin_amdgcn_s_getreg((3 << 11) | 20) & 0xFu; }
#define XB_SPIN(cond, bar) do { unsigned _sp = 0; while (cond) { __builtin_amdgcn_s_sleep(1); \
    if ((++_sp & 255u) == 0u) { if (xb_ld(&(bar)[XB_TMO])) break; if (_sp > XB_SPIN_CAP) { atomicAdd(&(bar)[XB_TMO], 1u); break; } } } } while (0)

struct XcdBarrier {
    unsigned* bar; unsigned x;
    volatile LAS unsigned* st;
};

__device__ __forceinline__ XcdBarrier xcd_barrier_post(unsigned* bar, volatile LAS unsigned* st) {
    XcdBarrier b; b.bar = bar; b.x = xb_xcc_id(); b.st = st;
    if (threadIdx.x == 0) (void)xb_add(&bar[XB_XCNT(b.x)], 1u);
    return b;
}
__device__ __forceinline__ void xcd_barrier_complete(unsigned* bar, unsigned x, unsigned& nloc, unsigned& nx) {
    const unsigned G = gridDim.x * gridDim.y * gridDim.z;
    unsigned sum, cnt, mine, sp = 0u;
    for (;;) {
        sum = 0u; cnt = 0u; mine = 0u;
#pragma unroll
        for (unsigned j = 0; j < 16; ++j) { const unsigned c = xb_ld(&bar[XB_XCNT(j)]); sum += c; cnt += (c > 0u) ? 1u : 0u; mine = (j == x) ? c : mine; }
        if (sum == G) break;
        __builtin_amdgcn_s_sleep(1);
        if ((++sp & 255u) == 0u) { if (xb_ld(&bar[XB_TMO])) break; if (sp > XB_SPIN_CAP) { atomicAdd(&bar[XB_TMO], 1u); break; } }
    }
    nloc = mine > 0u ? mine : 1u; nx = cnt > 0u ? cnt : 1u;
}

__device__ __forceinline__ void xcd_barrier(const XcdBarrier& b) {
    asm volatile("s_waitcnt vmcnt(0)" ::: "memory");
    __syncthreads();
    if (threadIdx.x == 0) {
        unsigned* bar = b.bar;
        __builtin_amdgcn_s_waitcnt(0);
        unsigned nloc = b.st[0], nx = b.st[1];
        if (nloc == 0u) { xcd_barrier_complete(bar, b.x, nloc, nx); b.st[0] = nloc; b.st[1] = nx; }
        const unsigned old = xb_add(&bar[XB_XSUB(b.x)], 1u);
        const unsigned gen = old / nloc;
        if (old + 1u == (gen + 1u) * nloc) {
            __builtin_amdgcn_fence(__ATOMIC_RELEASE, "agent");
            asm volatile("s_waitcnt vmcnt(0)" ::: "memory");
            const unsigned og = xb_add(&bar[XB_TOP], 1u);
            const unsigned tg = og / nx;
            if (og + 1u == (tg + 1u) * nx) xb_add(&bar[XB_TOPGEN], 1u);
            else XB_SPIN(xb_ld(&bar[XB_TOPGEN]) == tg, bar);
            __builtin_amdgcn_fence(__ATOMIC_ACQUIRE, "agent");
            xb_add(&bar[XB_XGEN(b.x)], 1u);
            asm volatile("s_waitcnt vmcnt(0)" ::: "memory");
        } else {
            XB_SPIN(xb_ld(&bar[XB_XGEN(b.x)]) == gen, bar);
            __builtin_amdgcn_fence(__ATOMIC_ACQUIRE, "agent");
            asm volatile("s_waitcnt vmcnt(0)" ::: "memory");
        }
    }
    __syncthreads();
}


namespace pg8 {
constexpr int BM = 256, BK = 64, HALF = 128, HTB = HALF * BK * 2, STAGE_BYTES = 8 * HTB, NXCD = 8, WGM = 8;
__host__ __device__ __forceinline__ int lds_byte(int r, int c) { const int st = (r >> 4) * 2 + (c >> 5), rr = r & 15, cc = c & 31, ob = rr * 64 + cc * 2; return st * 1024 + (ob ^ (((ob >> 9) & 1) << 5)); }
__host__ __device__ __forceinline__ void stage_rc(int b, int& R, int& C) { const int st = b / 1024, sb = b % 1024, swz = sb ^ (((sb >> 9) & 1) << 5); R = (st >> 1) * 16 + swz / 64; C = (st & 1) * 32 + (swz % 64) / 2; }
__host__ __device__ __forceinline__ int perm32(int rho) { const int n = rho >> 4, i = rho & 15; return 8 * (i >> 2) + 4 * n + (i & 3); }

struct Unit { const char* A; const char* B; char* C; int row0, col0, aux; };
struct GemmP { int K, lda, ldb; };

__device__ __forceinline__ void xcd_tile(int L, int nM, int nN, int& pm, int& pn) {
    const int nwg = nM * nN; int wgid = L;
    { const int q = nwg / NXCD, r = nwg % NXCD, xcd = wgid % NXCD, off = wgid / NXCD; wgid = (xcd < r ? xcd * (q + 1) : r * (q + 1) + (xcd - r) * q) + off; }
    const int nig = WGM * nN, gid = wgid / nig, fm = gid * WGM, gsz = (nM - fm) < WGM ? (nM - fm) : WGM;
    pm = fm + ((wgid % nig) % gsz); pn = (wgid % nig) / gsz;
}

typedef f32x4 Acc[2][2][4][2];

template <class Epi, class Sched, bool GATHER>
__device__ __forceinline__ void gemm_phase(LAS unsigned char* lds, const GemmP g, const Sched& S, const Epi& E, const int wave_id) {
    const int tid = tid_from_wave(wave_id), wid = __builtin_amdgcn_readfirstlane(tid >> 6), lane = tid & 63, wr = wid >> 2, wc = wid & 3, fr = lane & 15, fq = lane >> 4;
    const int K = g.K, nt = K / BK;
    int Rr[2], Cc[2]; unsigned voffB[2];
#pragma unroll
    for (int i = 0; i < 2; ++i) { int R, C; stage_rc(tid * 16 + i * 8192, R, C); const int Rb = Epi::PERM ? ((R & ~31) + perm32(R & 31)) : R;
        Rr[i] = R; Cc[i] = C; voffB[i] = (unsigned)(Rb * g.ldb + C) * 2u; }
    const size_t kstep = (size_t)(BK * 2);
    const size_t hstepB = (size_t)HALF * g.ldb * 2;
    const unsigned ldsw = (unsigned)wid * 1024u;
    const int aoff = lds_byte(wr * 64 + fr, fq * 8), boff = lds_byte(wc * 32 + fr, fq * 8);
#define PG8_SA(b, h) (((b) * 2 + (h)) * HTB)
#define PG8_SB(b, h) ((4 + (b) * 2 + (h)) * HTB)
#define PG8_STAGE_B(bufoff, gbase) do { _Pragma("unroll") for (int _i = 0; _i < 2; ++_i) \
        __builtin_amdgcn_global_load_lds((const unsigned*)((const char*)(gbase) + voffB[_i]), (LAS unsigned*)(lds + (bufoff) + ldsw + _i * 8192), 16, 0, 0); } while (0)
#define PG8_STAGE_A(bufoff, gbase, OFF, h) do { _Pragma("unroll") for (int _i = 0; _i < 2; ++_i) \
        __builtin_amdgcn_global_load_lds((const unsigned*)((const char*)(gbase) + (OFF)[h][_i]), (LAS unsigned*)(lds + (bufoff) + ldsw + _i * 8192), 16, 0, 0); } while (0)
#define PG8_OFFS(u, OFF) do { _Pragma("unroll") for (int _h = 0; _h < 2; ++_h) _Pragma("unroll") for (int _i = 0; _i < 2; ++_i) { \
        const int _row = _h * HALF + Rr[_i]; const int _src = GATHER ? S.arow((u), _row) : _row; (OFF)[_h][_i] = (unsigned)(_src * g.lda + Cc[_i]) * 2u; } } while (0)
#define PG8_LDA(dst, b, h) do { _Pragma("unroll") for (int m = 0; m < 4; ++m) _Pragma("unroll") for (int k = 0; k < 2; ++k) dst[m][k] = *(const LAS bf16x8*)(lds + PG8_SA(b, h) + aoff + m * 2048 + k * 1024); } while (0)
#define PG8_LDB(dst, b, h) do { _Pragma("unroll") for (int n = 0; n < 2; ++n) _Pragma("unroll") for (int k = 0; k < 2; ++k) dst[n][k] = *(const LAS bf16x8*)(lds + PG8_SB(b, h) + boff + n * 2048 + k * 1024); } while (0)
#define PG8_MMA(ai, bj, At, Bt) do { __builtin_amdgcn_s_setprio(1); _Pragma("unroll") for (int m = 0; m < 4; ++m) _Pragma("unroll") for (int n = 0; n < 2; ++n) _Pragma("unroll") for (int k = 0; k < 2; ++k) \
        acc[ai][bj][m][n] = __builtin_amdgcn_mfma_f32_16x16x32_bf16(Bt[n][k], At[m][k], acc[ai][bj][m][n], 0, 0, 0); __builtin_amdgcn_s_setprio(0); } while (0)
#define PG8_WAIT_V(n) asm volatile("s_waitcnt vmcnt(" #n ")" ::: "memory")
#define PG8_WAIT_L(n) asm volatile("s_waitcnt lgkmcnt(" #n ")" ::: "memory")
#define PG8_BAR __builtin_amdgcn_s_barrier()
#define PG8_SCHED __builtin_amdgcn_sched_barrier(0)
    Unit cur, nxt; int ui = 0;
    if (!S.next(0, cur)) return;
    f32x4 acc[2][2][4][2];
#pragma unroll
    for (int a = 0; a < 2; ++a)
#pragma unroll
        for (int b = 0; b < 2; ++b)
#pragma unroll
            for (int m = 0; m < 4; ++m)
#pragma unroll
                for (int n = 0; n < 2; ++n) acc[a][b][m][n] = (f32x4){0.f, 0.f, 0.f, 0.f};
    bf16x8 At[4][2], B0[2][2], B1[2][2];
    const char* cA = cur.A; const char* cB = cur.B;
    unsigned coffA[2][2], noffA[2][2];
    PG8_OFFS(cur, coffA);
    PG8_STAGE_B(PG8_SB(0, 0), cB); PG8_STAGE_A(PG8_SA(0, 0), cA, coffA, 0); PG8_STAGE_B(PG8_SB(0, 1), cB + hstepB); PG8_STAGE_A(PG8_SA(0, 1), cA, coffA, 1);
    if (wr == 1) PG8_BAR;
    PG8_WAIT_V(4); PG8_BAR;
    PG8_STAGE_B(PG8_SB(1, 0), cB + kstep); PG8_STAGE_A(PG8_SA(1, 0), cA + kstep, coffA, 0); PG8_STAGE_B(PG8_SB(1, 1), cB + hstepB + kstep);
    PG8_WAIT_V(6); PG8_BAR;
    for (;;) {
        const bool has_next = S.next(ui + 1, nxt);
        const char* nA = has_next ? nxt.A : cA; const char* nB = has_next ? nxt.B : cB;
        if (has_next) { PG8_OFFS(nxt, noffA); }
        else {
#pragma unroll
            for (int _h = 0; _h < 2; ++_h)
#pragma unroll
                for (int _i = 0; _i < 2; ++_i) noffA[_h][_i] = coffA[_h][_i]; }
        for (int t = 0; t < nt; t += 2) {
            const bool last = (t == nt - 2);
            const char* a1 = cA + (size_t)(t + 1) * kstep;
            const char* a2 = last ? nA : cA + (size_t)(t + 2) * kstep; const char* b2 = last ? nB : cB + (size_t)(t + 2) * kstep;
            const char* a3 = a2 + kstep; const char* b3 = b2 + kstep;
            unsigned o2[2][2];
#pragma unroll
            for (int _h = 0; _h < 2; ++_h)
#pragma unroll
                for (int _i = 0; _i < 2; ++_i) o2[_h][_i] = last ? noffA[_h][_i] : coffA[_h][_i];
            PG8_LDB(B0, 0, 0); PG8_SCHED; PG8_LDA(At, 0, 0); PG8_STAGE_A(PG8_SA(1, 1), a1, coffA, 1);
            PG8_WAIT_L(8); PG8_BAR; PG8_WAIT_L(0); PG8_MMA(0, 0, At, B0); PG8_BAR; PG8_SCHED;
            PG8_LDB(B1, 0, 1); PG8_STAGE_B(PG8_SB(0, 0), b2);
            PG8_BAR; PG8_WAIT_L(0); PG8_MMA(0, 1, At, B1); PG8_BAR;
            PG8_LDA(At, 0, 1); PG8_STAGE_A(PG8_SA(0, 0), a2, o2, 0);
            PG8_BAR; PG8_WAIT_L(0); PG8_MMA(1, 0, At, B0); PG8_BAR; PG8_SCHED;
            PG8_STAGE_B(PG8_SB(0, 1), b2 + hstepB);
            PG8_WAIT_V(6); PG8_BAR; PG8_MMA(1, 1, At, B1); PG8_BAR;
            PG8_LDB(B0, 1, 0); PG8_SCHED; PG8_LDA(At, 1, 0); PG8_STAGE_A(PG8_SA(0, 1), a2, o2, 1);
            PG8_WAIT_L(8); PG8_BAR; PG8_WAIT_L(0); PG8_MMA(0, 0, At, B0); PG8_BAR; PG8_SCHED;
            PG8_LDB(B1, 1, 1); PG8_STAGE_B(PG8_SB(1, 0), b3);
            PG8_BAR; PG8_WAIT_L(0); PG8_MMA(0, 1, At, B1); PG8_BAR;
            PG8_LDA(At, 1, 1); PG8_STAGE_A(PG8_SA(1, 0), a3, o2, 0);
            PG8_BAR; PG8_WAIT_L(0); PG8_MMA(1, 0, At, B0); PG8_BAR; PG8_SCHED;
            PG8_STAGE_B(PG8_SB(1, 1), b3 + hstepB);
            PG8_WAIT_V(6); PG8_BAR; PG8_MMA(1, 1, At, B1); PG8_BAR;
        }
        if constexpr (!Epi::AFTER_DRAIN) { E(acc, cur, wr, wc, fr, fq); }
        if (!has_next) break;
#pragma unroll
        for (int a = 0; a < 2; ++a)
#pragma unroll
            for (int b = 0; b < 2; ++b)
#pragma unroll
                for (int m = 0; m < 4; ++m)
#pragma unroll
                    for (int n = 0; n < 2; ++n) acc[a][b][m][n] = (f32x4){0.f, 0.f, 0.f, 0.f};
        cur = nxt; cA = nA; cB = nB; ++ui;
#pragma unroll
        for (int _h = 0; _h < 2; ++_h)
#pragma unroll
            for (int _i = 0; _i < 2; ++_i) coffA[_h][_i] = noffA[_h][_i];
    }
    PG8_WAIT_V(0);
    if (wr == 0) PG8_BAR;
    PG8_BAR;
    if constexpr (Epi::AFTER_DRAIN) { E.fused(acc, cur, wr, wc, fr, fq, lds, wid, lane); }
#undef PG8_SA
#undef PG8_SB
#undef PG8_STAGE_A
#undef PG8_STAGE_B
#undef PG8_OFFS
#undef PG8_LDA
#undef PG8_LDB
#undef PG8_MMA
#undef PG8_WAIT_V
#undef PG8_WAIT_L
#undef PG8_BAR
#undef PG8_SCHED
}

struct EpiBf16 {
    static constexpr bool PERM = true, AFTER_DRAIN = false;
    int ldc;
    __device__ __forceinline__ void operator()(const Acc& acc, const Unit& u, int wr, int wc, int fr, int fq) const {
        bf16* base = (bf16*)u.C + (size_t)(wr * 64 + fr) * ldc + wc * 32 + 8 * fq;
#pragma unroll
        for (int ai = 0; ai < 2; ++ai)
#pragma unroll
            for (int m = 0; m < 4; ++m) { bf16* rowp = base + (size_t)(ai * HALF + m * 16) * ldc;
#pragma unroll
                for (int bj = 0; bj < 2; ++bj) { const f32x4 v0 = acc[ai][bj][m][0], v1 = acc[ai][bj][m][1];
                    u32x4 w; w.x = pk2(v0[0], v0[1]); w.y = pk2(v0[2], v0[3]); w.z = pk2(v1[0], v1[1]); w.w = pk2(v1[2], v1[3]);
                    *(u32x4*)(rowp + bj * HALF) = w; } }
    }
};
struct EpiF32Res {
    static constexpr bool PERM = false, AFTER_DRAIN = false;
    int ldc; const float* resid; float* out;
    __device__ __forceinline__ void operator()(const Acc& acc, const Unit& u, int wr, int wc, int fr, int fq) const {
        const size_t o0 = (size_t)(u.row0 + wr * 64 + fr) * ldc + u.col0 + wc * 32 + 4 * fq;
#pragma unroll
        for (int ai = 0; ai < 2; ++ai)
#pragma unroll
            for (int m = 0; m < 4; ++m) { const size_t ro = o0 + (size_t)(ai * HALF + m * 16) * ldc;
#pragma unroll
                for (int bj = 0; bj < 2; ++bj)
#pragma unroll
                    for (int n = 0; n < 2; ++n) { const size_t o = ro + bj * HALF + n * 16; const f32x4 b = *(const f32x4*)(resid + o); *(f32x4*)(out + o) = acc[ai][bj][m][n] + b; } }
    }
};
struct EpiSwiGlu {
    static constexpr bool PERM = true, AFTER_DRAIN = false;
    int ldc;
    __device__ __forceinline__ void operator()(const Acc& acc, const Unit& u, int wr, int wc, int fr, int fq) const {
        bf16* base = (bf16*)u.C + (size_t)(wr * 64 + fr) * ldc + wc * 32 + 8 * fq;
#pragma unroll
        for (int ai = 0; ai < 2; ++ai)
#pragma unroll
            for (int m = 0; m < 4; ++m) { bf16* rowp = base + (size_t)(ai * HALF + m * 16) * ldc;
                float h[8];
#pragma unroll
                for (int n = 0; n < 2; ++n)
#pragma unroll
                    for (int e = 0; e < 4; ++e) { const float a = acc[ai][0][m][n][e], b = acc[ai][1][m][n][e]; h[n * 4 + e] = a / (1.f + __expf(-a)) * b; }
                u32x4 w; w.x = pk2(h[0], h[1]); w.y = pk2(h[2], h[3]); w.z = pk2(h[4], h[5]); w.w = pk2(h[6], h[7]);
                *(u32x4*)rowp = w; }
    }
};
struct EpiGate {
    static constexpr bool PERM = true, AFTER_DRAIN = false;
    int ldc; const float* egate; const int* cnt_lds_unused;
    __device__ __forceinline__ void operator()(const Acc& acc, const Unit& u, int wr, int wc, int fr, int fq) const {
        bf16* base = (bf16*)u.C + (size_t)(wr * 64 + fr) * ldc + wc * 32 + 8 * fq;
        const int e = u.aux >> 16, nvalid = u.aux & 0xffff;
        const float* gp = egate + (size_t)e * ECAP + u.row0;
#pragma unroll
        for (int ai = 0; ai < 2; ++ai)
#pragma unroll
            for (int m = 0; m < 4; ++m) { const int r = ai * HALF + wr * 64 + m * 16 + fr; const float gt = (r < nvalid) ? gp[r] : 0.f;
                bf16* rowp = base + (size_t)(ai * HALF + m * 16) * ldc;
#pragma unroll
                for (int bj = 0; bj < 2; ++bj) { const f32x4 v0 = acc[ai][bj][m][0] * gt, v1 = acc[ai][bj][m][1] * gt;
                    u32x4 w; w.x = pk2(v0[0], v0[1]); w.y = pk2(v0[2], v0[3]); w.z = pk2(v1[0], v1[1]); w.w = pk2(v1[2], v1[3]);
                    *(u32x4*)(rowp + bj * HALF) = w; } }
    }
};
struct EpiSoftmax {
    static constexpr bool PERM = true, AFTER_DRAIN = true;
    int ldc; float scale_log2e;
    __device__ __forceinline__ void operator()(const Acc&, const Unit&, int, int, int, int) const {}
    __device__ __forceinline__ void fused(const Acc& acc, const Unit& u, int wr, int wc, int fr, int fq, LAS unsigned char* lds, int wid, int lane) const {
        LAS float* RM = (LAS float*)lds;
        LAS float* RS = (LAS float*)(lds + 4096);
        float mx[2][4];
#pragma unroll
        for (int ai = 0; ai < 2; ++ai)
#pragma unroll
            for (int m = 0; m < 4; ++m) { float v = -3.0e38f;
#pragma unroll
                for (int bj = 0; bj < 2; ++bj)
#pragma unroll
                    for (int n = 0; n < 2; ++n) { const f32x4 x = acc[ai][bj][m][n]; v = fmaxf(v, fmaxf(fmaxf(x[0], x[1]), fmaxf(x[2], x[3]))); }
                v = fmaxf(v, xor_lane(v, lane, 16)); v = fmaxf(v, xor_lane(v, lane, 32));
                if (fq == 0) RM[(ai * HALF + wr * 64 + m * 16 + fr) * 4 + wc] = v; }
        asm volatile("s_waitcnt lgkmcnt(0)" ::: "memory"); __builtin_amdgcn_s_barrier(); asm volatile("" ::: "memory");
#pragma unroll
        for (int ai = 0; ai < 2; ++ai)
#pragma unroll
            for (int m = 0; m < 4; ++m) { const int row = ai * HALF + wr * 64 + m * 16 + fr; const f32x4 q = *(const LAS f32x4*)(RM + row * 4);
                const float M = fmaxf(fmaxf(q[0], q[1]), fmaxf(q[2], q[3])); const float mc = -M * scale_log2e; float s = 0.f;
#pragma unroll
                for (int bj = 0; bj < 2; ++bj)
#pragma unroll
                    for (int n = 0; n < 2; ++n)
#pragma unroll
                        for (int e = 0; e < 4; ++e) s += __builtin_amdgcn_exp2f(fmaf(acc[ai][bj][m][n][e], scale_log2e, mc));
                s += xor_lane(s, lane, 16); s += xor_lane(s, lane, 32);
                if (fq == 0) RS[row * 4 + wc] = s; }
        asm volatile("s_waitcnt lgkmcnt(0)" ::: "memory"); __builtin_amdgcn_s_barrier(); asm volatile("" ::: "memory");
        bf16* base = (bf16*)u.C + (size_t)(wr * 64 + fr) * ldc + wc * 32 + 8 * fq;
#pragma unroll
        for (int ai = 0; ai < 2; ++ai)
#pragma unroll
            for (int m = 0; m < 4; ++m) { const int row = ai * HALF + wr * 64 + m * 16 + fr; const f32x4 q = *(const LAS f32x4*)(RS + row * 4); const f32x4 qm = *(const LAS f32x4*)(RM + row * 4);
                const float M = fmaxf(fmaxf(qm[0], qm[1]), fmaxf(qm[2], qm[3])); const float mc = -M * scale_log2e;
                const float inv = 1.f / ((q[0] + q[1]) + (q[2] + q[3])); bf16* rowp = base + (size_t)(ai * HALF + m * 16) * ldc;
#pragma unroll
                for (int bj = 0; bj < 2; ++bj) { float pp[8];
#pragma unroll
                    for (int n = 0; n < 2; ++n)
#pragma unroll
                        for (int e = 0; e < 4; ++e) pp[n * 4 + e] = __builtin_amdgcn_exp2f(fmaf(acc[ai][bj][m][n][e], scale_log2e, mc)) * inv;
                    u32x4 w; w.x = pk2(pp[0], pp[1]); w.y = pk2(pp[2], pp[3]); w.z = pk2(pp[4], pp[5]); w.w = pk2(pp[6], pp[7]);
                    *(u32x4*)(rowp + bj * HALF) = w; } }
        asm volatile("s_waitcnt lgkmcnt(0)" ::: "memory"); __builtin_amdgcn_s_barrier(); asm volatile("" ::: "memory");
    }
};
}

namespace att {
constexpr int KVBLK = 64;
constexpr size_t SHM_V = KVBLK * 128 * 2, SHM_K = KVBLK * 128 * 2;
#define KSWZ(row, colB) ((row) * 256 + ((colB) ^ (((row) & 7) << 4)))
#define SBAR() __builtin_amdgcn_sched_barrier(0)
__device__ __forceinline__ int crow(int r, int hi) { return (r & 3) + 8 * (r >> 2) + 4 * hi; }
__device__ __forceinline__ bf16x8 ld8(const bf16* p) { return *reinterpret_cast<const bf16x8*>(p); }

__device__ __forceinline__ void partialSM(f32x16& p0, f32x16& p1, float& m_reg, float& mn, float& alpha, const float SCALE, const float THR) {
  const float C = SCALE * 1.4426950408889634f;
  float pmax = p0[0];
#pragma unroll
  for (int r = 1; r < 16; ++r) pmax = fmaxf(pmax, p0[r]);
#pragma unroll
  for (int r = 0; r < 16; ++r) pmax = fmaxf(pmax, p1[r]);
  { auto rr = __builtin_amdgcn_permlane32_swap(__float_as_uint(pmax), __float_as_uint(pmax), false, false);
    pmax = fmaxf(__uint_as_float(rr[0]), __uint_as_float(rr[1])); }
  if (__builtin_expect(__all(pmax - m_reg <= THR / SCALE), 1)) { mn = m_reg; alpha = 1.f; }
  else { mn = fmaxf(m_reg, pmax); alpha = __builtin_amdgcn_exp2f((m_reg - mn) * C); m_reg = mn; }
  const float mnC = -mn * C;
#pragma unroll
  for (int r = 0; r < 16; ++r) p0[r] = fmaf(p0[r], C, mnC);
#pragma unroll
  for (int r = 0; r < 16; ++r) p1[r] = fmaf(p1[r], C, mnC);
#pragma unroll
  for (int r = 0; r < 16; ++r) p0[r] = __builtin_amdgcn_exp2f(p0[r]);
}
__device__ __forceinline__ void finishSM(f32x16& p0, f32x16& p1, float alpha, float& l_reg, bf16x8& pa0, bf16x8& pa1, bf16x8& pa2, bf16x8& pa3) {
#pragma unroll
  for (int r = 0; r < 16; ++r) p1[r] = __builtin_amdgcn_exp2f(p1[r]);
  float ps = 0;
#pragma unroll
  for (int r = 0; r < 16; ++r) ps += p0[r];
#pragma unroll
  for (int r = 0; r < 16; ++r) ps += p1[r];
  { auto rr = __builtin_amdgcn_permlane32_swap(__float_as_uint(ps), __float_as_uint(ps), false, false);
    ps = __uint_as_float(rr[0]) + __uint_as_float(rr[1]); }
  l_reg = l_reg * alpha + ps;
#define PK4(P, BASE, OUT) do { unsigned a0 = pk2(P[BASE + 0], P[BASE + 1]), a1 = pk2(P[BASE + 2], P[BASE + 3]);   \
    unsigned b0 = pk2(P[BASE + 4], P[BASE + 5]), b1 = pk2(P[BASE + 6], P[BASE + 7]);                              \
    auto r0 = __builtin_amdgcn_permlane32_swap(a0, b0, false, false); auto r1 = __builtin_amdgcn_permlane32_swap(a1, b1, false, false); \
    u32x4 w = {r0[0], r1[0], r0[1], r1[1]}; OUT = *reinterpret_cast<bf16x8*>(&w); } while (0)
  PK4(p0, 0, pa0); PK4(p0, 8, pa1); PK4(p1, 0, pa2); PK4(p1, 8, pa3);
#undef PK4
}
template <int ND0> __device__ __forceinline__ void qkt(f32x16& p0, f32x16& p1, const char* Ks, const bf16x8* qr, int r32, int hi, int c0) {
  p0 = f32x16{}; p1 = f32x16{};
#pragma unroll
  for (int d0 = 0; d0 < ND0; ++d0) { const int cb = (c0 + d0 * 16 + hi * 8) * 2;
    const bf16x8 b0 = *reinterpret_cast<const bf16x8*>(Ks + KSWZ(r32, cb));
    const bf16x8 b1 = *reinterpret_cast<const bf16x8*>(Ks + KSWZ(32 + r32, cb));
    p0 = __builtin_amdgcn_mfma_f32_32x32x16_bf16(b0, qr[d0], p0, 0, 0, 0);
    p1 = __builtin_amdgcn_mfma_f32_32x32x16_bf16(b1, qr[d0], p1, 0, 0, 0); }
}
__device__ __forceinline__ int v_st(int k, int c) { const int kk = (k & ~0xC) | ((k & 4) << 1) | ((k & 8) >> 1); return ((kk >> 3) * 4 + (c >> 5)) * 512 + ((kk & 7) * 32 + (c & 31)) * 2; }
__device__ __forceinline__ int v_rd_base(int lane) { return ((lane & 3) << 3) | (((lane >> 2) & 3) << 6) | (((lane >> 4) & 1) << 5) | (((lane >> 5) & 1) << 8); }
constexpr int v_rd_off(int d0, int ks, int half) { return d0 * 512 + ks * 4096 + half * 2048; }
template <int OFF> __device__ __forceinline__ s16x4 tr_read(int vb) {
  s16x4 r; asm volatile("ds_read_b64_tr_b16 %0, %1 offset:%2" : "=&v"(r) : "v"(vb), "i"(OFF) : "memory"); return r;
}
template <int D0> __device__ __forceinline__ void pv_one(f32x16& od, int vb, bf16x8 pa0, bf16x8 pa1, bf16x8 pa2, bf16x8 pa3) {
  const s16x4 l0 = tr_read<v_rd_off(D0, 0, 0)>(vb), h0 = tr_read<v_rd_off(D0, 0, 1)>(vb), l1 = tr_read<v_rd_off(D0, 1, 0)>(vb), h1 = tr_read<v_rd_off(D0, 1, 1)>(vb);
  const s16x4 l2 = tr_read<v_rd_off(D0, 2, 0)>(vb), h2 = tr_read<v_rd_off(D0, 2, 1)>(vb), l3 = tr_read<v_rd_off(D0, 3, 0)>(vb), h3 = tr_read<v_rd_off(D0, 3, 1)>(vb);
  asm volatile("s_waitcnt lgkmcnt(0)" ::: "memory"); SBAR();
#define PK(L, H) (bf16x8){L[0], L[1], L[2], L[3], H[0], H[1], H[2], H[3]}
  od = __builtin_amdgcn_mfma_f32_32x32x16_bf16(pa0, PK(l0, h0), od, 0, 0, 0);
  od = __builtin_amdgcn_mfma_f32_32x32x16_bf16(pa1, PK(l1, h1), od, 0, 0, 0);
  od = __builtin_amdgcn_mfma_f32_32x32x16_bf16(pa2, PK(l2, h2), od, 0, 0, 0);
  od = __builtin_amdgcn_mfma_f32_32x32x16_bf16(pa3, PK(l3, h3), od, 0, 0, 0);
#undef PK
}
__device__ __forceinline__ void pv_d0(f32x16* o, int vb, bf16x8 pa0, bf16x8 pa1, bf16x8 pa2, bf16x8 pa3) {
  pv_one<0>(o[0], vb, pa0, pa1, pa2, pa3); pv_one<1>(o[1], vb, pa0, pa1, pa2, pa3); pv_one<2>(o[2], vb, pa0, pa1, pa2, pa3); pv_one<3>(o[3], vb, pa0, pa1, pa2, pa3);
}

__device__ __forceinline__ void diff_attn_unit(const bf16* Qb, const bf16* Kh, const bf16* Vh, int ld, int seq, bf16* outb, int ldo,
                                               const float lam, const float post_scale, const float* subln_g, char* lds, const int wave_id) {
  constexpr float SCALE = 0.125f, THR = 8.f;
  const int tid = tid_from_wave(wave_id), wid = __builtin_amdgcn_readfirstlane(tid >> 6), lane = tid & 63, r32 = lane & 31, hi = lane >> 5;
  const int csel = wid >> 2, wq = wid & 3;
  char* V_lds = lds; char* K_lds = lds + 2 * SHM_V;
  float* ws = (float*)(lds + 2 * SHM_V + 2 * SHM_K) + wid * 64; float* li_l = ws; float* al_l = ws + 32;
  float m_reg = -1e30f, l_reg = 0; f32x16 o[4] = {}; bf16x8 qr[4];
  const bf16* Qw = Qb + (long)(wq * 32 + r32) * ld + csel * 64 + hi * 8;
#pragma unroll
  for (int d0 = 0; d0 < 4; ++d0) qr[d0] = ld8(Qw + d0 * 16);
  const int sr = tid >> 4, sc = (tid & 15) * 8, vst0 = v_st(sr, sc), vst1 = v_st(32 + sr, sc);
  const int vb0 = (int)(uintptr_t)V_lds + v_rd_base(lane);
  const int kc0 = csel * 64;
  struct { bf16x8 vs0, vs1, ks0, ks1; } sr_[2];
#define SLOAD(i, k0) do { sr_[i].vs0 = ld8(&Vh[(long)((k0) + sr) * ld + sc]); sr_[i].vs1 = ld8(&Vh[(long)((k0) + 32 + sr) * ld + sc]); \
    sr_[i].ks0 = ld8(&Kh[(long)((k0) + sr) * ld + sc]); sr_[i].ks1 = ld8(&Kh[(long)((k0) + 32 + sr) * ld + sc]); } while (0)
#define SWRITE(b, i) do { *(bf16x8*)(V_lds + (b) * SHM_V + vst0) = sr_[i].vs0;          \
    *(bf16x8*)(V_lds + (b) * SHM_V + vst1) = sr_[i].vs1; const int kc = sc * 2;               \
    *(bf16x8*)(K_lds + (b) * SHM_K + KSWZ(sr, kc)) = sr_[i].ks0;                       \
    *(bf16x8*)(K_lds + (b) * SHM_K + KSWZ(32 + sr, kc)) = sr_[i].ks1; } while (0)
#define SWAIT() asm volatile("s_waitcnt vmcnt(4)" ::: "memory")
#define RESC(a) do { if (__any((a) < 1.f)) { if (hi == 0) al_l[r32] = (a); asm volatile("s_waitcnt lgkmcnt(0)" ::: "memory"); \
    _Pragma("unroll") for (int d = 0; d < 4; ++d) _Pragma("unroll") for (int r = 0; r < 16; ++r) o[d][r] *= al_l[crow(r, hi)]; } } while (0)
  f32x16 pA0, pA1, pB0, pB1; float mnA, mnB, alA, alB; bf16x8 pa0, pa1, pa2, pa3; const int NT = seq / KVBLK;
  constexpr int SE = 0, SO = 1;
  __syncthreads();
  SLOAD(SE, 0); asm volatile("s_waitcnt vmcnt(0)" ::: "memory"); SWRITE(0, SE); __syncthreads();
  qkt<4>(pA0, pA1, K_lds, qr, r32, hi, kc0); partialSM(pA0, pA1, m_reg, mnA, alA, SCALE, THR);
  SLOAD(SO, KVBLK); if (2 < NT) SLOAD(SE, 2 * KVBLK);
  SWAIT(); SWRITE(1, SO); __syncthreads();
  for (int j = 1; j + 1 < NT; j += 2) {
    SBAR(); qkt<4>(pB0, pB1, K_lds + SHM_K, qr, r32, hi, kc0);
    finishSM(pA0, pA1, alA, l_reg, pa0, pa1, pa2, pa3); SBAR();
    SLOAD(SO, (j + 2) * KVBLK); SBAR();
    pv_d0(o, vb0, pa0, pa1, pa2, pa3); partialSM(pB0, pB1, m_reg, mnB, alB, SCALE, THR);
    __syncthreads(); SWAIT(); SWRITE(0, SE);
    RESC(alB); __syncthreads();
    SBAR(); qkt<4>(pA0, pA1, K_lds, qr, r32, hi, kc0);
    finishSM(pB0, pB1, alB, l_reg, pa0, pa1, pa2, pa3); SBAR();
    if (j + 3 < NT) SLOAD(SE, (j + 3) * KVBLK); SBAR();
    pv_d0(o, vb0 + (int)SHM_V, pa0, pa1, pa2, pa3); partialSM(pA0, pA1, m_reg, mnA, alA, SCALE, THR);
    __syncthreads(); SWAIT(); SWRITE(1, SO);
    RESC(alA); __syncthreads();
  }
  SBAR(); qkt<4>(pB0, pB1, K_lds + SHM_K, qr, r32, hi, kc0);
  finishSM(pA0, pA1, alA, l_reg, pa0, pa1, pa2, pa3); SBAR();
  pv_d0(o, vb0, pa0, pa1, pa2, pa3); partialSM(pB0, pB1, m_reg, mnB, alB, SCALE, THR);
  __syncthreads(); RESC(alB);
  finishSM(pB0, pB1, alB, l_reg, pa0, pa1, pa2, pa3); SBAR();
  pv_d0(o, vb0 + (int)SHM_V, pa0, pa1, pa2, pa3);
  asm volatile("s_waitcnt vmcnt(0)" ::: "memory");
  if (hi == 0) li_l[r32] = l_reg; asm volatile("s_waitcnt lgkmcnt(0)" ::: "memory");
  float rli[16];
#pragma unroll
  for (int r = 0; r < 16; ++r) rli[r] = __builtin_amdgcn_rcpf(li_l[crow(r, hi)]);
  __syncthreads();
  float* X = (float*)lds + (size_t)wq * 4096;
  if (csel == 1) {
#pragma unroll
    for (int d0 = 0; d0 < 4; ++d0)
#pragma unroll
      for (int r = 0; r < 16; ++r) X[(d0 * 16 + r) * 64 + lane] = o[d0][r] * rli[r];
  }
  __syncthreads();
  if (csel == 0) {
    float ss[16];
#pragma unroll
    for (int r = 0; r < 16; ++r) ss[r] = 0.f;
#pragma unroll
    for (int d0 = 0; d0 < 4; ++d0)
#pragma unroll
      for (int r = 0; r < 16; ++r) { const float v = o[d0][r] * rli[r] - lam * X[(d0 * 16 + r) * 64 + lane]; o[d0][r] = v; ss[r] += v * v; }
#pragma unroll
    for (int r = 0; r < 16; ++r) { float s = ss[r];
      s = row_sum(s); s += xor_lane(s, lane, 16);
      ss[r] = __builtin_amdgcn_rsqf(s * (1.f / 128.f) + RMS_EPS) * post_scale; }
    float gg[4];
#pragma unroll
    for (int d0 = 0; d0 < 4; ++d0) gg[d0] = subln_g[d0 * 32 + r32];
    bf16* Ow = outb + (long)(wq * 32) * ldo;
#pragma unroll
    for (int r = 0; r < 16; ++r) { const int orow = crow(r, hi);
#pragma unroll
      for (int d0 = 0; d0 < 4; ++d0) Ow[(long)orow * ldo + d0 * 32 + r32] = f2bf(o[d0][r] * ss[r] * gg[d0]); }
  }
#undef SLOAD
#undef SWRITE
#undef SWAIT
}

__device__ __forceinline__ void dil_attn_unit(const bf16* Qh, const bf16* Kh, const bf16* Vh, int ld, int dil, int rho, int u0, int L,
                                              float* Oc, float* lsep, char* lds, const int wave_id) {
  constexpr float SCALE = 0.08838834764831845f; constexpr float C = SCALE * 1.4426950408889634f;
  const int tid = tid_from_wave(wave_id), wid = __builtin_amdgcn_readfirstlane(tid >> 6), lane = tid & 63, r32 = lane & 31, hi = lane >> 5;
  char* V_lds = lds; char* K_lds = lds + 2 * SHM_V;
  float* ws = (float*)(lds + 2 * SHM_V + 2 * SHM_K) + wid * 64; float* li_l = ws; float* al_l = ws + 32;
  float m_reg = -1e30f, l_reg = 0; f32x16 o[4] = {}; bf16x8 qr[8];
  const int uq = u0 + wid * 32 + r32;
  const bf16* Qw = Qh + (long)(rho + dil * uq) * ld + hi * 8;
#pragma unroll
  for (int d0 = 0; d0 < 8; ++d0) qr[d0] = ld8(Qw + d0 * 16);
  const int sr = tid >> 4, sc = (tid & 15) * 8, vst0 = v_st(sr, sc), vst1 = v_st(32 + sr, sc);
  const int vb0 = (int)(uintptr_t)V_lds + v_rd_base(lane);
  const int tlo = wid >> 1;
  for (int t = 0; t < 6; ++t) {
    const int kt0 = u0 - 64 + 64 * t;
    __syncthreads();
    { int ua = kt0 + sr, ub = kt0 + 32 + sr; ua = ua < 0 ? 0 : (ua >= L ? L - 1 : ua); ub = ub < 0 ? 0 : (ub >= L ? L - 1 : ub);
      const long ra = (long)(rho + dil * ua) * ld + sc, rb = (long)(rho + dil * ub) * ld + sc;
      const bf16x8 va = ld8(Vh + ra), vb = ld8(Vh + rb), ka = ld8(Kh + ra), kb = ld8(Kh + rb);
      *(bf16x8*)(V_lds + vst0) = va; *(bf16x8*)(V_lds + vst1) = vb; const int kc = sc * 2;
      *(bf16x8*)(K_lds + KSWZ(sr, kc)) = ka; *(bf16x8*)(K_lds + KSWZ(32 + sr, kc)) = kb; }
    __syncthreads();
    if (t >= tlo && t <= tlo + 2) {
      f32x16 p0, p1;
      qkt<8>(p0, p1, K_lds, qr, r32, hi, 0);
#pragma unroll
      for (int r = 0; r < 16; ++r) { const int uk0 = kt0 + crow(r, hi), uk1 = uk0 + 32; const int d0 = uk0 - uq, d1 = uk1 - uq;
        const bool ok0 = (uk0 >= 0) && (uk0 < L) && (d0 >= -64) && (d0 <= 64), ok1 = (uk1 >= 0) && (uk1 < L) && (d1 >= -64) && (d1 <= 64);
        p0[r] = ok0 ? p0[r] : -1e30f; p1[r] = ok1 ? p1[r] : -1e30f; }
      float pmax = p0[0];
#pragma unroll
      for (int r = 1; r < 16; ++r) pmax = fmaxf(pmax, p0[r]);
#pragma unroll
      for (int r = 0; r < 16; ++r) pmax = fmaxf(pmax, p1[r]);
      { auto rr = __builtin_amdgcn_permlane32_swap(__float_as_uint(pmax), __float_as_uint(pmax), false, false);
        pmax = fmaxf(__uint_as_float(rr[0]), __uint_as_float(rr[1])); }
      const float mn = fmaxf(m_reg, pmax); const float alpha = __builtin_amdgcn_exp2f((m_reg - mn) * C); m_reg = mn;
      const float mnC = -mn * C;
#pragma unroll
      for (int r = 0; r < 16; ++r) { p0[r] = __builtin_amdgcn_exp2f(fmaf(p0[r], C, mnC)); p1[r] = fmaf(p1[r], C, mnC); }
      bf16x8 pa0, pa1, pa2, pa3;
      finishSM(p0, p1, alpha, l_reg, pa0, pa1, pa2, pa3);
      RESC(alpha);
      pv_d0(o, vb0, pa0, pa1, pa2, pa3);
    }
  }
  if (hi == 0) li_l[r32] = l_reg; asm volatile("s_waitcnt lgkmcnt(0)" ::: "memory");
  float rli[16];
#pragma unroll
  for (int r = 0; r < 16; ++r) rli[r] = __builtin_amdgcn_rcpf(li_l[crow(r, hi)]);
#pragma unroll
  for (int r = 0; r < 16; ++r) { const int uo = u0 + wid * 32 + crow(r, hi); float* orow = Oc + (long)(rho + dil * uo) * 512;
#pragma unroll
    for (int d0 = 0; d0 < 4; ++d0) orow[d0 * 32 + r32] = o[d0][r] * rli[r]; }
  if (hi == 0) lsep[(long)(rho + dil * uq) * 4] = m_reg * SCALE + __logf(l_reg);
}
#undef RESC
#undef KSWZ
#undef SBAR
}

struct Args { const float* in[N_INPUTS]; float* out; unsigned char* ws; int ph_lo, ph_hi; };
typedef const __attribute__((address_space(4))) Args* ArgsP;
struct Frame {
    LAS unsigned char* lds; volatile LAS unsigned* MISC; unsigned* ctl; unsigned char* ws;
    int tid, lane, wave, G, bid;
};
constexpr int PH_P0 = 0, PH_P1 = 1, PH_P2 = 2, PH_L0 = 3, NPH_L = 13, PH_FINAL = PH_L0 + DEPTH * NPH_L, NPHASES = PH_FINAL + 1;
enum { LP_NORM1 = 0, LP_G1, LP_PREP, LP_CPREP, LP_MIX, LP_POST, LP_G2, LP_NORM2, LP_GS, LP_GO, LP_NORM3, LP_M1, LP_M2 };

__device__ __forceinline__ int q_next(Frame& F, int q) {
    __syncthreads();
    if (F.tid == 0) F.MISC[0] = __hip_atomic_fetch_add(F.ctl + CW_Q + 64 * q, 1u, __ATOMIC_RELAXED, __HIP_MEMORY_SCOPE_AGENT);
    __syncthreads();
    return (int)F.MISC[0];
}

template <class RowMap>
__device__ __forceinline__ void transpose_item(const float* W, int ldn, bf16* WT, int ldt, RowMap rm, LAS float* scr, int k0, int n0, int lane) {
#pragma unroll 8
    for (int i = 0; i < 32; ++i) { const int kk = 2 * i + (lane >> 5); scr[kk * 33 + (lane & 31)] = W[(size_t)(k0 + kk) * ldn + n0 + (lane & 31)]; }
    LDS_WAIT(); asm volatile("" ::: "memory");
    const int c = lane & 7;
#pragma unroll
    for (int j = 0; j < 4; ++j) { const int n = (lane >> 3) + 8 * j; const LAS float* s = scr + (8 * c) * 33 + n;
        u32x4 o; o.x = pk2(s[0 * 33], s[1 * 33]); o.y = pk2(s[2 * 33], s[3 * 33]); o.z = pk2(s[4 * 33], s[5 * 33]); o.w = pk2(s[6 * 33], s[7 * 33]);
        *(u32x4*)(WT + (size_t)rm(n0 + n) * ldt + k0 + 8 * c) = o; }
    LDS_WAIT(); asm volatile("" ::: "memory");
}
struct RmId { __device__ __forceinline__ int operator()(int n) const { return n; } };
struct RmW13 { int off; __device__ __forceinline__ int operator()(int n) const { return 256 * (n >> 7) + off + (n & 127); } };

__device__ __forceinline__ void p0_prologue(Frame& F, ArgsP a) {
    unsigned char* ws = F.ws;
    LAS float* scr = (LAS float*)(F.lds + F.wave * 16384);
    const int gw = F.bid * 8 + F.wave, NGW = F.G * 8;
    constexpr int I_WIN = (DM / 64) * (IN_TOTAL / 32), I_SQ = (DM / 64) * (DM / 32), I_WKV = (DM / 64) * (4096 / 32), I_W1 = (DM / 64) * (DEXP / 32), I_W2 = (DEXP / 64) * (DM / 32);
    constexpr int PER_L = I_WIN + I_SQ + I_WKV + I_SQ + NEXP * (2 * I_W1 + I_W2);
    for (int it = gw; it < DEPTH * PER_L; it += NGW) {
        const int l = it / PER_L; int r = it % PER_L;
        if (r < I_WIN) { const int nb = IN_TOTAL / 32; transpose_item(a->in[I_W_IN] + (size_t)l * DM * IN_TOTAL, IN_TOTAL, (bf16*)(ws + WS_WIN) + (size_t)l * ZLD * DM, DM, RmId{}, scr, 64 * (r / nb), 32 * (r % nb), F.lane); continue; } r -= I_WIN;
        if (r < I_SQ) { const int nb = DM / 32; transpose_item(a->in[I_W_OUT] + (size_t)l * DM * DM, DM, (bf16*)(ws + WS_WOUT) + (size_t)l * DM * DM, DM, RmId{}, scr, 64 * (r / nb), 32 * (r % nb), F.lane); continue; } r -= I_SQ;
        if (r < I_WKV) { const int nb = 4096 / 32; transpose_item(a->in[I_XA_WKV] + (size_t)l * DM * 4096, 4096, (bf16*)(ws + SC_WKVT) + (size_t)l * 4096 * DM, DM, RmId{}, scr, 64 * (r / nb), 32 * (r % nb), F.lane); continue; } r -= I_WKV;
        if (r < I_SQ) { const int nb = DM / 32; transpose_item(a->in[I_XA_WO] + (size_t)l * DM * DM, DM, (bf16*)(ws + SC_WOT) + (size_t)l * DM * DM, DM, RmId{}, scr, 64 * (r / nb), 32 * (r % nb), F.lane); continue; } r -= I_SQ;
        const int e = r / (2 * I_W1 + I_W2); r = r % (2 * I_W1 + I_W2);
        const size_t le = (size_t)l * NEXP + e;
        if (r < I_W1) { const int nb = DEXP / 32; transpose_item(a->in[I_MOE_W1] + le * DM * DEXP, DEXP, (bf16*)(ws + WS_W13) + le * 1024 * DM, DM, RmW13{0}, scr, 64 * (r / nb), 32 * (r % nb), F.lane); continue; } r -= I_W1;
        if (r < I_W1) { const int nb = DEXP / 32; transpose_item(a->in[I_MOE_W3] + le * DM * DEXP, DEXP, (bf16*)(ws + WS_W13) + le * 1024 * DM, DM, RmW13{128}, scr, 64 * (r / nb), 32 * (r % nb), F.lane); continue; } r -= I_W1;
        { const int nb = DM / 32; transpose_item(a->in[I_MOE_W2] + le * DEXP * DM, DM, (bf16*)(ws + WS_W2) + le * DM * DEXP, DEXP, RmId{}, scr, 64 * (r / nb), 32 * (r % nb), F.lane); }
    }
    const int gt = F.bid * 512 + F.tid, NGT = F.G * 512;
    for (int i = gt; i < DEPTH * (ZLD - IN_TOTAL) * DM / 8; i += NGT) { const int l = i / ((ZLD - IN_TOTAL) * DM / 8), r = i % ((ZLD - IN_TOTAL) * DM / 8);
        *(u32x4*)((bf16*)(ws + WS_WIN) + (size_t)l * ZLD * DM + (size_t)IN_TOTAL * DM + (size_t)r * 8) = (u32x4){0u, 0u, 0u, 0u}; }
    for (int i = gt; i < DEPTH * DM * DM / 8; i += NGT) { const f32x4 x0 = *(const f32x4*)(a->in[I_XA_WQ] + (size_t)i * 8), x1 = *(const f32x4*)(a->in[I_XA_WQ] + (size_t)i * 8 + 4);
        u32x4 o; o.x = pk2(x0[0], x0[1]); o.y = pk2(x0[2], x0[3]); o.z = pk2(x1[0], x1[1]); o.w = pk2(x1[2], x1[3]); *(u32x4*)((bf16*)(ws + SC_WQB) + (size_t)i * 8) = o; }
    { float* cosA = (float*)(ws + WS_ROPE); float* sinA = cosA + SEQ * 32; float* cosC = sinA + SEQ * 32; float* sinC = cosC + SEQ * 64;
      for (int i = gt; i < SEQ * 96; i += NGT) { const int s = i / 96, j = i % 96; const bool isA = j < 32; const int jj = isA ? j : j - 32; const float dim = isA ? 64.f : 128.f;
          const float inv = 1.0f / powf(10000.0f, (float)(2 * jj) / dim); const float ang = (float)s * inv; float sn, cs; sincosf(ang, &sn, &cs);
          if (isA) { cosA[s * 32 + jj] = cs; sinA[s * 32 + jj] = sn; } else { cosC[s * 64 + jj] = cs; sinC[s * 64 + jj] = sn; } } }
    for (int i = gt; i < DEPTH * 2 * 32 * 64; i += NGT) { const int l = i / (2 * 32 * 64), r = i % (2 * 32 * 64), dir = r / (32 * 64), g = (r / 64) % 32, n = r % 64;
        float* ab = (float*)(ws + WS_S5P + l * S5P_LAYER); float* bb = ab + 2 * 32 * 64 * 2;
        const size_t pi = (((size_t)l * 2 + dir) * 32 + g) * 64 + n;
        const float lr = fminf(a->in[I_S5_A_RE][pi], -1e-4f), li = a->in[I_S5_A_IM][pi], dt = __expf(a->in[I_S5_LOG_DT][((size_t)l * 2 + dir) * 32 + g]);
        const float mag = __expf(dt * lr); float sn, cs; sincosf(dt * li, &sn, &cs); const float abr = mag * cs, abi = mag * sn;
        const float den = lr * lr + li * li; const float ir = lr / den, ii = -li / den;
        const float fr_ = (abr - 1.f) * ir - abi * ii, fi_ = (abr - 1.f) * ii + abi * ir;
        ab[(size_t)r * 2] = abr; ab[(size_t)r * 2 + 1] = abi;
        { float* ab256 = bb + 2 * 32 * 64 * 16 * 2; const float m256 = __expf(256.f * dt * lr); float s2, c2; sincosf(256.f * dt * li, &s2, &c2); ab256[(size_t)r * 2] = m256 * c2; ab256[(size_t)r * 2 + 1] = m256 * s2; }
        const size_t bi = (((size_t)l * 32 + g) * 64 + n) * 16;
#pragma unroll
        for (int c = 0; c < 16; ++c) { const float br = a->in[I_S5_B_RE][bi + c], bim = a->in[I_S5_B_IM][bi + c];
            bb[((size_t)r * 16 + c) * 2] = fr_ * br - fi_ * bim; bb[((size_t)r * 16 + c) * 2 + 1] = fr_ * bim + fi_ * br; } }
    for (int it = gw; it < DEPTH * BATCH * NMEM; it += NGW) { const int l = it / (BATCH * NMEM), row = it % (BATCH * NMEM);
        const f32x4* xr = (const f32x4*)(a->in[I_MEM] + (size_t)row * DM) + F.lane; const f32x4* gr = (const f32x4*)(a->in[I_NORM_MEM] + (size_t)l * DM) + F.lane;
        f32x4 v[8]; float s = 0.f;
#pragma unroll
        for (int j = 0; j < 8; ++j) { v[j] = xr[64 * j]; s += (v[j].x * v[j].x + v[j].y * v[j].y) + (v[j].z * v[j].z + v[j].w * v[j].w); }
        const float rstd = 1.f / sqrtf(wave_sum(s) * (1.f / DM) + RMS_EPS);
        u32x2* o8 = (u32x2*)((bf16*)(ws + SC_MEMN) + ((size_t)l * 512 + row) * DM) + F.lane;
#pragma unroll
        for (int j = 0; j < 8; ++j) { const f32x4 gv = gr[64 * j]; u32x2 w; w.x = pk2(v[j].x * rstd * gv.x, v[j].y * rstd * gv.y); w.y = pk2(v[j].z * rstd * gv.z, v[j].w * rstd * gv.w); o8[64 * j] = w; } }
}

struct SchedDense { const char* A; const char* B; char* C; int nM, nN, G, c, lda, ldb, ldcb  , cesz  ;
    __device__ __forceinline__ bool next(int i, pg8::Unit& u) const { const long L = (long)i * G + c; if (L >= (long)nM * nN) return false; int pm, pn; pg8::xcd_tile((int)L, nM, nN, pm, pn);
        u.A = A + (size_t)pm * 256 * lda * 2; u.B = B + (size_t)pn * 256 * ldb * 2; u.C = C + (size_t)pm * 256 * ldcb + (size_t)pn * 256 * cesz; u.row0 = pm * 256; u.col0 = pn * 256; u.aux = 0; return true; }
    __device__ __forceinline__ int arow(const pg8::Unit&, int r) const { return r; } };
struct SchedBatch { const char* A; const char* B; char* C; size_t sA, sB, sC; int nM, nN, nb, G, c, lda, ldb, ldcb, cesz, rowsPerBatch;
    __device__ __forceinline__ bool next(int i, pg8::Unit& u) const { const long L = (long)i * G + c; const int per = nM * nN; if (L >= (long)per * nb) return false; const int b = (int)(L / per), r = (int)(L % per), pm = r / nN, pn = r % nN;
        u.A = A + b * sA + (size_t)pm * 256 * lda * 2; u.B = B + b * sB + (size_t)pn * 256 * ldb * 2; u.C = C + b * sC + (size_t)pm * 256 * ldcb + (size_t)pn * 256 * cesz; u.row0 = b * rowsPerBatch + pm * 256; u.col0 = pn * 256; u.aux = b; return true; }
    __device__ __forceinline__ int arow(const pg8::Unit&, int r) const { return r; } };
struct SchedXaPre { unsigned char* ws; int G, c, kind;
    __device__ __forceinline__ bool next(int i, pg8::Unit& u) const { const long L = (long)i * G + c; if (L >= 128) return false; const int r = (int)L, p = r >> 3, t = r & 7, l = p >> 3, b = (p >> 2) & 1, h = p & 3;
        const bf16* kvb = (const bf16*)(ws + SC_KVB) + (size_t)l * 512 * 4096 + (size_t)(b * 256) * 4096;
        if (kind == 0) { u.A = (const char*)(kvb + h * 512); u.B = (const char*)((const bf16*)(ws + SC_WQB) + (size_t)l * DM * DM + (size_t)(t * 256) * DM + h * 512);
            u.C = (char*)((bf16*)(ws + WS_WQK) + ((size_t)(l * 2 + b) * 1024 + h * 256) * DM + t * 256); u.aux = DM; }
        else { u.A = (const char*)((const bf16*)(ws + SC_WOT) + (size_t)l * DM * DM + (size_t)(t * 256) * DM + h * 512); u.B = (const char*)(kvb + 2048 + h * 512);
            u.C = (char*)((bf16*)(ws + WS_VWO) + ((size_t)(l * 2 + b) * DM + t * 256) * 1024 + h * 256); u.aux = 1024; }
        u.row0 = 0; u.col0 = 0; return true; }
    __device__ __forceinline__ int arow(const pg8::Unit&, int r) const { return r; } };
struct EpiBf16U { static constexpr bool PERM = true, AFTER_DRAIN = false;
    __device__ __forceinline__ void operator()(const pg8::Acc& acc, const pg8::Unit& u, int wr, int wc, int fr, int fq) const { pg8::EpiBf16 e{u.aux}; e(acc, u, wr, wc, fr, fq); } };
struct SchedMoe { unsigned char* ws; const volatile LAS int* tp; const volatile LAS int* cnt; int layer, G, c, which;
    __device__ __forceinline__ bool next(int i, pg8::Unit& u) const {
        const int npn = which == 0 ? 4 : 8; const long L = (long)i * G + c; const int ntile = tp[32]; if (L >= (long)ntile * npn) return false;
        const int mt = (int)(L / npn), pn = (int)(L % npn); int e = 0;
#pragma unroll 1
        for (int k = 1; k < 32; ++k) e += (mt >= tp[k]) ? 1 : 0;
        const int lt = mt - tp[e]; const int nvalid = min(256, cnt[e] - lt * 256);
        u.row0 = lt * 256; u.col0 = pn * 256; u.aux = (e << 16) | nvalid;
        if (which == 0) { u.A = (const char*)(ws + WS_HN); u.B = (const char*)((const bf16*)(ws + WS_W13) + ((size_t)(layer * NEXP + e) * 1024 + pn * 256) * DM);
            u.C = (char*)((bf16*)(ws + SC_HMID) + (size_t)(mt * 256) * DEXP + pn * 128); }
        else { u.A = (const char*)((const bf16*)(ws + SC_HMID) + (size_t)(mt * 256) * DEXP); u.B = (const char*)((const bf16*)(ws + WS_W2) + ((size_t)(layer * NEXP + e) * DM + pn * 256) * DEXP);
            u.C = (char*)((bf16*)(ws + SC_YBUF) + (size_t)(mt * 256) * DM + pn * 256); }
        return true; }
    __device__ __forceinline__ int arow(const pg8::Unit& u, int r) const { const int e = u.aux >> 16, nvalid = u.aux & 0xffff; const int idx = (r < nvalid) ? (u.row0 + r) : u.row0;
        return ((const int*)(ws + WS_ETOK))[(size_t)e * ECAP + idx]; } };

__device__ __forceinline__ void moe_prefix(Frame& F, int layer, volatile LAS int* tp, volatile LAS int* cnt) {
    __syncthreads();
    if (F.tid < 32) cnt[F.tid] = (int)__hip_atomic_load(F.ctl + CW_CNT + layer * 64 + F.tid, __ATOMIC_RELAXED, __HIP_MEMORY_SCOPE_AGENT);
    __syncthreads();
    if (F.tid == 0) { int s = 0; for (int e = 0; e < 32; ++e) { tp[e] = s; s += (cnt[e] + 255) >> 8; } tp[32] = s; }
    __syncthreads();
}
template <int MODE>
__device__ __forceinline__ void norm_phase(Frame& F, ArgsP a, const float* src, const float* gain, int layer) {
    unsigned char* ws = F.ws; float* H = (float*)(ws + WS_H); bf16* HN = (bf16*)(ws + WS_HN);
    volatile LAS int* tp = (volatile LAS int*)(F.lds + 1024); volatile LAS int* cnt = tp + 40;
    if (MODE & 1) moe_prefix(F, layer - 1, tp, cnt);
    const int gw = F.bid * 8 + F.wave, NGW = F.G * 8;
    const f32x4* gr = (const f32x4*)gain + F.lane;
    for (int row = gw; row < NTOK; row += NGW) {
        const f32x4* xr = (const f32x4*)(src + (size_t)row * DM) + F.lane;
        f32x4 v[8];
#pragma unroll
        for (int j = 0; j < 8; ++j) v[j] = xr[64 * j];
        if (MODE & 1) {
            const int* ti = (const int*)(ws + WS_TINFO) + (size_t)row * 4;
            const int e0 = ti[0], p0 = ti[1], e1 = ti[2], p1 = ti[3];
            const size_t s0 = (size_t)tp[e0] * 256 + p0, s1 = (size_t)tp[e1] * 256 + p1;
            const u32x2* y0 = (const u32x2*)((const bf16*)(ws + SC_YBUF) + s0 * DM) + F.lane; const u32x2* y1 = (const u32x2*)((const bf16*)(ws + SC_YBUF) + s1 * DM) + F.lane;
#pragma unroll
            for (int j = 0; j < 8; ++j) { const u32x2 a0 = y0[64 * j], a1 = y1[64 * j];
                v[j].x += __uint_as_float(a0.x << 16) + __uint_as_float(a1.x << 16); v[j].y += __uint_as_float(a0.x & 0xffff0000u) + __uint_as_float(a1.x & 0xffff0000u);
                v[j].z += __uint_as_float(a0.y << 16) + __uint_as_float(a1.y << 16); v[j].w += __uint_as_float(a0.y & 0xffff0000u) + __uint_as_float(a1.y & 0xffff0000u); }
            if (!(MODE & 4)) { f32x4* hr = (f32x4*)(H + (size_t)row * DM) + F.lane;
#pragma unroll
                for (int j = 0; j < 8; ++j) hr[64 * j] = v[j]; }
        }
        float s = 0.f;
#pragma unroll
        for (int j = 0; j < 8; ++j) s += (v[j].x * v[j].x + v[j].y * v[j].y) + (v[j].z * v[j].z + v[j].w * v[j].w);
        const float rstd = 1.f / sqrtf(wave_sum(s) * (1.f / DM) + RMS_EPS);
#pragma unroll
        for (int j = 0; j < 8; ++j) { const f32x4 gv = gr[64 * j]; v[j].x *= rstd * gv.x; v[j].y *= rstd * gv.y; v[j].z *= rstd * gv.z; v[j].w *= rstd * gv.w; }
        if (MODE & 4) { f32x4* orow = (f32x4*)(a->out + (size_t)row * DM) + F.lane;
#ifdef DBG_TIME_A
            { const float sc = 1.f + (float)__hip_atomic_load(F.ctl + 40000, __ATOMIC_RELAXED, __HIP_MEMORY_SCOPE_AGENT) * (1.f / 20.f);
#pragma unroll
              for (int j = 0; j < 8; ++j) v[j] *= sc; }
#endif
#ifdef DBG_RWCHK
            { const float* cw = (const float*)(F.ctl + 32768); const unsigned* cu = (const unsigned*)cw; const float sc = cu[DBG_RWCHK * 64 + 2] ? 1001.f : 1.f + fminf(cw[DBG_RWCHK * 64] / cw[DBG_RWCHK * 64 + 1], 100.f);
#pragma unroll
              for (int j = 0; j < 8; ++j) v[j] *= sc; }
#endif
#pragma unroll
            for (int j = 0; j < 8; ++j) orow[64 * j] = v[j]; }
        else { u32x2* o8 = (u32x2*)(HN + (size_t)row * DM) + F.lane;
#pragma unroll
            for (int j = 0; j < 8; ++j) { u32x2 w; w.x = pk2(v[j].x, v[j].y); w.y = pk2(v[j].z, v[j].w); o8[64 * j] = w; } }
        if (MODE & 2) {
            const float* wg = a->in[I_ROUTER_GROUP] + (size_t)layer * DM * 4; const float* we = a->in[I_ROUTER_EXPERT] + (size_t)layer * DM * 32;
            float lg[4] = {0.f, 0.f, 0.f, 0.f};
#pragma unroll 2
            for (int j = 0; j < 8; ++j) { const int k0 = (64 * j + F.lane) * 4;
#pragma unroll
                for (int q = 0; q < 4; ++q) { const f32x4 w4 = *(const f32x4*)(wg + (size_t)(k0 + q) * 4); const float x = v[j][q]; lg[0] += x * w4.x; lg[1] += x * w4.y; lg[2] += x * w4.z; lg[3] += x * w4.w; } }
#pragma unroll
            for (int q = 0; q < 4; ++q) lg[q] = wave_sum(lg[q]);
            int gi = 0; float gm = lg[0];
#pragma unroll
            for (int q = 1; q < 4; ++q) if (lg[q] > gm) { gm = lg[q]; gi = q; }
            const float gw_ = 1.f / (__expf(lg[0] - gm) + __expf(lg[1] - gm) + __expf(lg[2] - gm) + __expf(lg[3] - gm));
            float le[8] = {0.f, 0.f, 0.f, 0.f, 0.f, 0.f, 0.f, 0.f};
#pragma unroll 2
            for (int j = 0; j < 8; ++j) { const int k0 = (64 * j + F.lane) * 4;
#pragma unroll
                for (int q = 0; q < 4; ++q) { const float* wp = we + (size_t)(k0 + q) * 32 + gi * 8; const f32x4 wa = *(const f32x4*)wp, wb = *(const f32x4*)(wp + 4); const float x = v[j][q];
                    le[0] += x * wa.x; le[1] += x * wa.y; le[2] += x * wa.z; le[3] += x * wa.w; le[4] += x * wb.x; le[5] += x * wb.y; le[6] += x * wb.z; le[7] += x * wb.w; } }
#pragma unroll
            for (int q = 0; q < 8; ++q) le[q] = wave_sum(le[q]);
            int i0 = 0; float m0 = le[0];
#pragma unroll
            for (int q = 1; q < 8; ++q) if (le[q] > m0) { m0 = le[q]; i0 = q; }
            int i1 = -1; float m1 = -3.0e38f;
#pragma unroll
            for (int q = 0; q < 8; ++q) if (q != i0 && le[q] > m1) { m1 = le[q]; i1 = q; }
            const float t = __expf(m1 - m0); const float w0 = 1.f / (1.f + t), w1 = t / (1.f + t);
            if (F.lane == 0) {
                const int e0 = gi * 8 + i0, e1 = gi * 8 + i1;
                const int p0 = (int)__hip_atomic_fetch_add(F.ctl + CW_CNT + layer * 64 + e0, 1u, __ATOMIC_RELAXED, __HIP_MEMORY_SCOPE_AGENT);
                const int p1 = (int)__hip_atomic_fetch_add(F.ctl + CW_CNT + layer * 64 + e1, 1u, __ATOMIC_RELAXED, __HIP_MEMORY_SCOPE_AGENT);
                int* et = (int*)(ws + WS_ETOK); float* eg = (float*)(ws + WS_EGATE); int* ti = (int*)(ws + WS_TINFO) + (size_t)row * 4;
                et[(size_t)e0 * ECAP + p0] = row; eg[(size_t)e0 * ECAP + p0] = gw_ * w0; et[(size_t)e1 * ECAP + p1] = row; eg[(size_t)e1 * ECAP + p1] = gw_ * w1;
                ti[0] = e0; ti[1] = p0; ti[2] = e1; ti[3] = p1;
            }
        }
    }
}

__device__ __forceinline__ void rope_token(Frame& F, bf16* zrow, int s) {
    const float* cosA = (const float*)(F.ws + WS_ROPE); const float* sinA = cosA + SEQ * 32; const float* cosC = sinA + SEQ * 32; const float* sinC = cosC + SEQ * 64;
    { const int i = F.lane & 31; const float cs = cosA[s * 32 + i], sn = sinA[s * 32 + i];
#pragma unroll
      for (int it = 0; it < 8; ++it) { bf16* p = zrow + ZA + (it * 2 + (F.lane >> 5)) * 64; const float x1 = bf2f(p[i]), x2 = bf2f(p[i + 32]); p[i] = f2bf(x1 * cs - x2 * sn); p[i + 32] = f2bf(x2 * cs + x1 * sn); } }
    { const int i = F.lane; const float cs = cosC[s * 64 + i], sn = sinC[s * 64 + i];
#pragma unroll
      for (int it = 0; it < 8; ++it) { bf16* p = zrow + ZC + it * 128; const float x1 = bf2f(p[i]), x2 = bf2f(p[i + 64]); p[i] = f2bf(x1 * cs - x2 * sn); p[i + 64] = f2bf(x2 * cs + x1 * sn); } }
}

constexpr int RWT = 8;
__device__ __forceinline__ void rwkv_prep_tile(Frame& F, ArgsP a, int layer, int tile) {
    unsigned char* ws = F.ws; const bf16* Z = (const bf16*)(ws + SC_Z);
    LAS float* zr = (LAS float*)F.lds; LAS float* act = zr + (RWT + 2) * IN_B;
    const int t0 = tile * RWT; const int b = t0 / SEQ, s0 = t0 % SEQ;
    __syncthreads();
#pragma unroll 1
    for (int i = F.tid; i < (RWT + 2) * (IN_B / 8); i += 512) { const int rr = i / (IN_B / 8), c8 = i % (IN_B / 8); const int s = s0 - 1 + rr;
        f32x4 lo = {0.f, 0.f, 0.f, 0.f}, hi = {0.f, 0.f, 0.f, 0.f};
        if (s >= 0 && s < SEQ) { const u32x4 w = *(const u32x4*)(Z + (size_t)(b * SEQ + s) * ZLD + ZB + c8 * 8);
            lo = (f32x4){__uint_as_float(w.x << 16), __uint_as_float(w.x & 0xffff0000u), __uint_as_float(w.y << 16), __uint_as_float(w.y & 0xffff0000u)};
            hi = (f32x4){__uint_as_float(w.z << 16), __uint_as_float(w.z & 0xffff0000u), __uint_as_float(w.w << 16), __uint_as_float(w.w & 0xffff0000u)}; }
        *(LAS f32x4*)(zr + rr * IN_B + c8 * 8) = lo; *(LAS f32x4*)(zr + rr * IN_B + c8 * 8 + 4) = hi; }
    __syncthreads();
    const float* mu = a->in[I_RWKV_MU] + (size_t)layer * 2 * IN_B;
#define ZS(t, col) (zr[((t) + 1) * IN_B + (col)] + mu[(col)] * (zr[(t) * IN_B + (col)] - zr[((t) + 1) * IN_B + (col)]) + mu[IN_B + (col)] * (zr[((t) + 2) * IN_B + (col)] - zr[((t) + 1) * IN_B + (col)]))
#pragma unroll 1
    for (int i = F.tid; i < RWT * 384; i += 512) { const int t = i / 384, j = i % 384; const int col = 1536 + j; const float x = ZS(t, col);
        act[t * 384 + j] = (j < 128) ? tanhf(x) : ((j < 256) ? x : sigmoidf_(x)); }
    __syncthreads();
    const int c = F.tid;
    float aw0[RWT], aw1[RWT], aa0[RWT], aa1[RWT], ag[RWT];
#pragma unroll
    for (int t = 0; t < RWT; ++t) { aw0[t] = 0.f; aw1[t] = 0.f; aa0[t] = 0.f; aa1[t] = 0.f; ag[t] = 0.f; }
    const __amdgpu_buffer_rsrc_t w2 = make_rsrc(a->in[I_RWKV_W2] + (size_t)layer * 2 * 64 * 512, 2 * 64 * 512 * 4), a2 = make_rsrc(a->in[I_RWKV_A2] + (size_t)layer * 2 * 64 * 512, 2 * 64 * 512 * 4), g2 = make_rsrc(a->in[I_RWKV_G2] + (size_t)layer * 128 * 512, 128 * 512 * 4);
#pragma unroll 1
    for (int r = 0; r < 64; r += 4) {
        float wv0[4], wv1[4], av0[4], av1[4];
#pragma unroll
        for (int q = 0; q < 4; ++q) { wv0[q] = bload_f32(w2, c * 4, (r + q) * 2048); wv1[q] = bload_f32(w2, c * 4, (64 + r + q) * 2048); av0[q] = bload_f32(a2, c * 4, (r + q) * 2048); av1[q] = bload_f32(a2, c * 4, (64 + r + q) * 2048); }
#pragma unroll
        for (int t = 0; t < RWT; ++t) { const f32x4 x0 = *(const LAS f32x4*)(act + t * 384 + r), x1 = *(const LAS f32x4*)(act + t * 384 + 64 + r), y0 = *(const LAS f32x4*)(act + t * 384 + 128 + r), y1 = *(const LAS f32x4*)(act + t * 384 + 192 + r);
#pragma unroll
            for (int q = 0; q < 4; ++q) { aw0[t] += x0[q] * wv0[q]; aw1[t] += x1[q] * wv1[q]; aa0[t] += y0[q] * av0[q]; aa1[t] += y1[q] * av1[q]; } }
    }
#pragma unroll 1
    for (int r = 0; r < 128; r += 4) {
        float gv[4];
#pragma unroll
        for (int q = 0; q < 4; ++q) gv[q] = bload_f32(g2, c * 4, (r + q) * 2048);
#pragma unroll
        for (int t = 0; t < RWT; ++t) { const f32x4 x = *(const LAS f32x4*)(act + t * 384 + 256 + r);
#pragma unroll
            for (int q = 0; q < 4; ++q) ag[t] += x[q] * gv[q]; }
    }
    const float w00 = a->in[I_RWKV_W0][(size_t)layer * 1024 + c], w01 = a->in[I_RWKV_W0][(size_t)layer * 1024 + 512 + c];
    const float a00 = a->in[I_RWKV_A0][(size_t)layer * 1024 + c], a01 = a->in[I_RWKV_A0][(size_t)layer * 1024 + 512 + c];
    const float kkw = a->in[I_RWKV_KK][(size_t)layer * 512 + c], kaw = a->in[I_RWKV_KA][(size_t)layer * 512 + c];
    float* RW = (float*)(ws + SC_RW); const size_t N1 = (size_t)NTOK * 512;
    { unsigned zo = (unsigned)(uintptr_t)zr; asm volatile("" : "+v"(zo)); zr = (LAS float*)(uintptr_t)zo; }
#pragma unroll
    for (int t = 0; t < RWT; ++t) {
        const float r_ = ZS(t, c), k_ = ZS(t, 512 + c), v_ = ZS(t, 1024 + c);
        const float x0 = -(w00 + aw0[t]), x1 = -(w01 + aw1[t]);
        const float sp0 = fmaxf(x0, 0.f) + __logf(1.f + __expf(-fabsf(x0))), sp1 = fmaxf(x1, 0.f) + __logf(1.f + __expf(-fabsf(x1)));
        const float d0 = -__expf(-sp0 - 0.5f), d1 = -__expf(-sp1 - 0.5f);
        const float al0 = sigmoidf_(a00 + aa0[t]), al1 = sigmoidf_(a01 + aa1[t]);
        float kk = k_ * kkw; const float ssq = wave_sum(kk * kk); kk *= 1.f / sqrtf(ssq + 1e-12f);
        const float km0 = k_ * (1.f + (al0 - 1.f) * kaw), km1 = k_ * (1.f + (al1 - 1.f) * kaw);
        const size_t o = (size_t)(t0 + t) * 512 + c;
        RW[0 * N1 + o] = r_; RW[1 * N1 + o] = v_; RW[2 * N1 + o] = kk; RW[3 * N1 + o] = d0; RW[4 * N1 + o] = d1;
        RW[5 * N1 + o] = km0; RW[6 * N1 + o] = km1; RW[7 * N1 + o] = kk * al0; RW[8 * N1 + o] = kk * al1; RW[9 * N1 + o] = ag[t];
        asm volatile("" ::: "memory");
    }
#undef ZS
}

constexpr size_t SC_S5E = SC_MIX_END + (size_t)32 * 256 * 11520;
constexpr size_t SC_MIX_END3 = SC_S5E + (size_t)2 * BATCH * 16 * 32 * 64 * 2 * 4;
template <int LEVEL>
__device__ __forceinline__ void s5_block_task(Frame& F, int layer, int task, LAS float* ul) {
    unsigned char* ws = F.ws; const bf16* Z = (const bf16*)(ws + SC_Z);
    const int blk = task & 15, dir = (task >> 4) & 1, g = (task >> 5) & 31, b = task >> 10; const int n = F.lane;
    const float* ab = (const float*)(ws + WS_S5P + layer * S5P_LAYER); const float* bb = ab + 2 * 32 * 64 * 2; const float* ab256 = bb + 2 * 32 * 64 * 16 * 2;
    const int pr = (dir * 32 + g) * 64 + n;
    const float abr = ab[pr * 2], abi = ab[pr * 2 + 1];
    float bbr[16], bbi[16];
#pragma unroll
    for (int c = 0; c < 16; ++c) { bbr[c] = bb[((size_t)pr * 16 + c) * 2]; bbi[c] = bb[((size_t)pr * 16 + c) * 2 + 1]; }
    float* E = (float*)(ws + SC_S5E);
    float xr = 0.f, xi = 0.f;
    if (LEVEL == 2) { const float pr_ = ab256[pr * 2], pi_ = ab256[pr * 2 + 1];
        for (int k = 0; k < blk; ++k) { const float* ep = E + ((((size_t)dir * BATCH + b) * 16 + k) * 32 + g) * 128 + n * 2; const float er = ep[0], ei = ep[1];
            const float nr = pr_ * xr - pi_ * xi + er, ni = pr_ * xi + pi_ * xr + ei; xr = nr; xi = ni; } }
    float* carry = (float*)(ws + SC_CARRY);
    for (int q4 = 0; q4 < 4; ++q4) {
        { const int st = blk * 256 + q4 * 64 + n; const int sl = dir ? (SEQ - 1 - st) : st; const bf16* zp = Z + (size_t)(b * SEQ + sl) * ZLD + ZD + g * 16;
          const u32x4 w0 = *(const u32x4*)zp, w1 = *(const u32x4*)(zp + 8);
          LAS f32x4* d = (LAS f32x4*)(ul + n * 16);
          d[0] = (f32x4){__uint_as_float(w0.x << 16), __uint_as_float(w0.x & 0xffff0000u), __uint_as_float(w0.y << 16), __uint_as_float(w0.y & 0xffff0000u)};
          d[1] = (f32x4){__uint_as_float(w0.z << 16), __uint_as_float(w0.z & 0xffff0000u), __uint_as_float(w0.w << 16), __uint_as_float(w0.w & 0xffff0000u)};
          d[2] = (f32x4){__uint_as_float(w1.x << 16), __uint_as_float(w1.x & 0xffff0000u), __uint_as_float(w1.y << 16), __uint_as_float(w1.y & 0xffff0000u)};
          d[3] = (f32x4){__uint_as_float(w1.z << 16), __uint_as_float(w1.z & 0xffff0000u), __uint_as_float(w1.w << 16), __uint_as_float(w1.w & 0xffff0000u)}; }
        LDS_WAIT(); asm volatile("" ::: "memory");
#pragma unroll 4
        for (int i = 0; i < 64; ++i) {
            const int step = blk * 256 + q4 * 64 + i;
            if (LEVEL == 2 && (step & (S5CH - 1)) == 0) { const int sl = dir ? (SEQ - 1 - step) : step; const int ch = sl / S5CH;
                float* cp = carry + ((((size_t)dir * BATCH + b) * S5NCH + ch) * 32 + g) * 128 + n * 2; cp[0] = xr; cp[1] = xi; }
            const f32x4 u0 = *(const LAS f32x4*)(ul + i * 16), u1 = *(const LAS f32x4*)(ul + i * 16 + 4), u2 = *(const LAS f32x4*)(ul + i * 16 + 8), u3 = *(const LAS f32x4*)(ul + i * 16 + 12);
            float br = 0.f, bi = 0.f;
#pragma unroll
            for (int c = 0; c < 4; ++c) { br += bbr[c] * u0[c] + bbr[4 + c] * u1[c] + bbr[8 + c] * u2[c] + bbr[12 + c] * u3[c]; bi += bbi[c] * u0[c] + bbi[4 + c] * u1[c] + bbi[8 + c] * u2[c] + bbi[12 + c] * u3[c]; }
            const float nr = abr * xr - abi * xi + br, ni = abr * xi + abi * xr + bi; xr = nr; xi = ni;
        }
        asm volatile("" ::: "memory");
    }
    if (LEVEL == 1) { float* ep = E + ((((size_t)dir * BATCH + b) * 16 + blk) * 32 + g) * 128 + n * 2; ep[0] = xr; ep[1] = xi; }
}

__device__ __forceinline__ void prep_phase(Frame& F, ArgsP a, int layer, const int rep) {
    const int qb_ = (rep * 2 + layer) * 8;
#ifndef DBG_PREPMASK
#define DBG_PREPMASK 7
#endif
    if (DBG_PREPMASK & 1) for (;;) { const int it = q_next(F, qb_ + 0); if (it >= 256) break; s5_block_task<1>(F, layer, it * 8 + F.wave, (LAS float*)(F.lds + F.wave * 4096)); }
    if (DBG_PREPMASK & 2) for (;;) { const int it = q_next(F, qb_ + 5); if (it >= NTOK / RWT) break; rwkv_prep_tile(F, a, layer, it); }
    if ((DBG_PREPMASK & 4) && rep == 0) for (;;) { const int r = q_next(F, qb_ + 6); if (r >= NTOK / 64) break;
        for (int k = 0; k < 8; ++k) { const int tok = r * 64 + F.wave * 8 + k; rope_token(F, (bf16*)(F.ws + SC_Z) + (size_t)tok * ZLD, tok % SEQ); } }
}

constexpr int CR_TA = 0, CR_GH = 2048, CR_WBK = 4096, CR_TM = 8192, CR_N = 8704, CR_V = 9216, CR_WL = 11264, CR_BYTES = 11520;
constexpr size_t SC_CREC = SC_MIX_END;
constexpr size_t SC_MIX_END2 = SC_CREC + (size_t)32 * 256 * CR_BYTES;
static_assert(SC_MIX_END2 <= 1140000000ull, "workspace budget");

__device__ __forceinline__ void mm16(const LAS float* A, const LAS float* B, int t, int sq, float (&out)[4]) {
    out[0] = out[1] = out[2] = out[3] = 0.f;
#pragma unroll
    for (int s4 = 0; s4 < 4; ++s4) { const f32x4 a4 = *(const LAS f32x4*)(A + t * 16 + s4 * 4);
#pragma unroll
        for (int q = 0; q < 4; ++q) { const f32x4 b4 = *(const LAS f32x4*)(B + (s4 * 4 + q) * 16 + sq * 4); const float av = a4[q];
            out[0] += av * b4[0]; out[1] += av * b4[1]; out[2] += av * b4[2]; out[3] += av * b4[3]; } }
}
__device__ __forceinline__ void st16(LAS float* M, int t, int sq, const float (&v)[4]) { *(LAS f32x4*)(M + t * 16 + sq * 4) = (f32x4){v[0], v[1], v[2], v[3]}; }

__device__ __forceinline__ void rwkv_cprep_item(Frame& F, int chain, int c, LAS float* Lw) {
    unsigned char* ws = F.ws; const float* RW = (const float*)(ws + SC_RW); const size_t N1 = (size_t)NTOK * 512;
    const int dir = chain & 1, h = (chain >> 1) & 7, b = chain >> 4; const int lane = F.lane;
    const float* Rp = RW; const float* Vp = RW + N1; const float* KKp = RW + 2 * N1; const float* LDp = RW + (3 + dir) * N1; const float* KMp = RW + (5 + dir) * N1; const float* BBp = RW + (7 + dir) * N1;
    constexpr int RS = 68;
    LAS float* At = Lw; LAS float* Bt = Lw + 16 * RS; LAS float* Kt = Lw + 32 * RS; LAS float* mat = Lw + 48 * RS;
    float at[16], rt[16], wb[16], wk[16];
    { float lw = 0.f, lwi[16], bb[16], km[16];
#pragma unroll
      for (int t = 0; t < 16; ++t) { const int pos = dir ? (SEQ - 1 - 16 * c - t) : (16 * c + t); const size_t idx = (size_t)(b * SEQ + pos) * 512 + h * 64 + lane;
          const float r_ = Rp[idx], ld = LDp[idx], a_ = -KKp[idx]; km[t] = KMp[idx]; bb[t] = BBp[idx];
          at[t] = a_ * __expf(lw); lw += ld; lwi[t] = lw; rt[t] = r_ * __expf(lw);
          const float iw = __expf(-lw); At[t * RS + lane] = at[t]; Bt[t * RS + lane] = bb[t] * iw; Kt[t * RS + lane] = km[t] * iw; }
#pragma unroll
      for (int t = 0; t < 16; ++t) { const float e = __expf(lw - lwi[t]); wb[t] = bb[t] * e; wk[t] = km[t] * e; }
      float* rec = (float*)(ws + SC_CREC + ((size_t)chain * 256 + c) * CR_BYTES + CR_WL); rec[lane] = __expf(lw); }
    LDS_WAIT(); asm volatile("" ::: "memory");
    const int t = lane >> 2, sq = lane & 3;
    float mab[4] = {0.f, 0.f, 0.f, 0.f}, mak[4] = {0.f, 0.f, 0.f, 0.f}, mrb[4] = {0.f, 0.f, 0.f, 0.f}, mrk[4] = {0.f, 0.f, 0.f, 0.f};
#pragma unroll 4
    for (int j = 0; j < 64; j += 4) { const f32x4 a4 = *(const LAS f32x4*)(At + t * RS + j);
#pragma unroll
        for (int e = 0; e < 4; ++e) { const f32x4 b4 = *(const LAS f32x4*)(Bt + (sq * 4 + e) * RS + j), k4 = *(const LAS f32x4*)(Kt + (sq * 4 + e) * RS + j);
            mab[e] += a4[0] * b4[0] + a4[1] * b4[1] + a4[2] * b4[2] + a4[3] * b4[3]; mak[e] += a4[0] * k4[0] + a4[1] * k4[1] + a4[2] * k4[2] + a4[3] * k4[3]; } }
    asm volatile("" ::: "memory");
#pragma unroll
    for (int tt = 0; tt < 16; ++tt) At[tt * RS + lane] = rt[tt];
    LDS_WAIT(); asm volatile("" ::: "memory");
#pragma unroll 4
    for (int j = 0; j < 64; j += 4) { const f32x4 a4 = *(const LAS f32x4*)(At + t * RS + j);
#pragma unroll
        for (int e = 0; e < 4; ++e) { const f32x4 b4 = *(const LAS f32x4*)(Bt + (sq * 4 + e) * RS + j), k4 = *(const LAS f32x4*)(Kt + (sq * 4 + e) * RS + j);
            mrb[e] += a4[0] * b4[0] + a4[1] * b4[1] + a4[2] * b4[2] + a4[3] * b4[3]; mrk[e] += a4[0] * k4[0] + a4[1] * k4[1] + a4[2] * k4[2] + a4[3] * k4[3]; } }
#pragma unroll
    for (int e = 0; e < 4; ++e) { const int s = sq * 4 + e; if (s >= t) { mab[e] = 0.f; mak[e] = 0.f; } if (s > t) { mrb[e] = 0.f; mrk[e] = 0.f; } }
    LAS float* m0 = mat; LAS float* m1 = mat + 256; LAS float* m2 = mat + 512; LAS float* m3 = mat + 768;
    float T[4], P[4], Q[4];
    st16(m0, t, sq, mab); LDS_WAIT(); asm volatile("" ::: "memory");
#pragma unroll
    for (int e = 0; e < 4; ++e) T[e] = mab[e] + ((sq * 4 + e) == t ? 1.f : 0.f);
    mm16(m0, m0, t, sq, P);
    st16(m1, t, sq, P); st16(m2, t, sq, T); LDS_WAIT(); asm volatile("" ::: "memory");
    mm16(m2, m1, t, sq, Q);
#pragma unroll
    for (int e = 0; e < 4; ++e) T[e] += Q[e];
    mm16(m1, m1, t, sq, P);
    asm volatile("" ::: "memory");
    st16(m0, t, sq, P); st16(m2, t, sq, T); LDS_WAIT(); asm volatile("" ::: "memory");
    mm16(m2, m0, t, sq, Q);
#pragma unroll
    for (int e = 0; e < 4; ++e) T[e] += Q[e];
    mm16(m0, m0, t, sq, P);
    asm volatile("" ::: "memory");
    st16(m1, t, sq, P); st16(m2, t, sq, T); LDS_WAIT(); asm volatile("" ::: "memory");
    mm16(m2, m1, t, sq, Q);
#pragma unroll
    for (int e = 0; e < 4; ++e) T[e] += Q[e];
    asm volatile("" ::: "memory");
    st16(m2, t, sq, T); st16(m0, t, sq, mrb); st16(m1, t, sq, mak); LDS_WAIT(); asm volatile("" ::: "memory");
    float P1[4], TM[4], Nn[4];
    mm16(m0, m2, t, sq, P1); mm16(m2, m1, t, sq, TM);
    st16(m3, t, sq, P1); LDS_WAIT(); asm volatile("" ::: "memory");
    mm16(m3, m1, t, sq, Nn);
#pragma unroll
    for (int e = 0; e < 4; ++e) Nn[e] += mrk[e];
    unsigned char* rec = ws + SC_CREC + ((size_t)chain * 256 + c) * CR_BYTES;
    { u32x2 w; w.x = pk2(TM[0], TM[1]); w.y = pk2(TM[2], TM[3]); *(u32x2*)(rec + CR_TM + (16 * sq + t) * 8) = w;
      w.x = pk2(Nn[0], Nn[1]); w.y = pk2(Nn[2], Nn[3]); *(u32x2*)(rec + CR_N + (16 * sq + t) * 8) = w; }
    LAS unsigned short* TAh = (LAS unsigned short*)Bt; LAS unsigned short* GHh = TAh + 1024;
#pragma unroll
    for (int tt = 0; tt < 16; ++tt) { float ta = 0.f, gh = rt[tt];
#pragma unroll
        for (int s4 = 0; s4 < 4; ++s4) { const f32x4 t4 = *(const LAS f32x4*)(m2 + tt * 16 + s4 * 4), p4 = *(const LAS f32x4*)(m3 + tt * 16 + s4 * 4);
            ta += t4[0] * at[s4 * 4] + t4[1] * at[s4 * 4 + 1] + t4[2] * at[s4 * 4 + 2] + t4[3] * at[s4 * 4 + 3];
            gh += p4[0] * at[s4 * 4] + p4[1] * at[s4 * 4 + 1] + p4[2] * at[s4 * 4 + 2] + p4[3] * at[s4 * 4 + 3]; }
        TAh[tt * 64 + lane] = f2bf(ta); GHh[tt * 64 + lane] = f2bf(gh); }
    LDS_WAIT(); asm volatile("" ::: "memory");
    { const int r = lane & 15, g = lane >> 4;
#pragma unroll
      for (int ks = 0; ks < 2; ++ks) { const u32x2 a0 = *(const LAS u32x2*)(TAh + r * 64 + 32 * ks + 4 * g), a1 = *(const LAS u32x2*)(TAh + r * 64 + 32 * ks + 16 + 4 * g);
          *(u32x4*)(rec + CR_TA + (ks * 64 + lane) * 16) = (u32x4){a0.x, a0.y, a1.x, a1.y};
          const u32x2 g0 = *(const LAS u32x2*)(GHh + r * 64 + 32 * ks + 4 * g), g1 = *(const LAS u32x2*)(GHh + r * 64 + 32 * ks + 16 + 4 * g);
          *(u32x4*)(rec + CR_GH + (ks * 64 + lane) * 16) = (u32x4){g0.x, g0.y, g1.x, g1.y}; } }
    { const int jb = lane >> 4, r = lane & 15; float vv[16];
#pragma unroll
      for (int tt = 0; tt < 16; ++tt) { const int pos = dir ? (SEQ - 1 - 16 * c - tt) : (16 * c + tt); vv[tt] = Vp[(size_t)(b * SEQ + pos) * 512 + h * 64 + lane]; }
#pragma unroll
      for (int g = 0; g < 4; ++g) { u32x4 w; w.x = pk2(wb[4 * g], wb[4 * g + 1]); w.y = pk2(wb[4 * g + 2], wb[4 * g + 3]); w.z = pk2(wk[4 * g], wk[4 * g + 1]); w.w = pk2(wk[4 * g + 2], wk[4 * g + 3]);
          *(u32x4*)(rec + CR_WBK + (jb * 64 + 16 * g + r) * 16) = w;
          u32x2 x; x.x = pk2(vv[4 * g], vv[4 * g + 1]); x.y = pk2(vv[4 * g + 2], vv[4 * g + 3]); *(u32x2*)(rec + CR_V + (jb * 64 + 16 * g + r) * 8) = x; } }
    LDS_WAIT(); asm volatile("" ::: "memory");
}

__device__ __forceinline__ void cprep_phase(Frame& F, int layer) {
    LAS float* Lw = (LAS float*)(F.lds + F.wave * 17408);
    for (int it = F.bid * 8 + F.wave; it < 32 * 256; it += F.G * 8) { const int c = it >> 5, chain = it & 31; rwkv_cprep_item(F, chain, c, Lw); }
    asm volatile("" ::: "memory");
    for (int it = F.bid * 8 + F.wave; it < 2048; it += F.G * 8) s5_block_task<2>(F, layer, it, Lw);
}

template <class P, class T> struct RwPtr { typedef const T* type; };
template <class T> struct RwPtr<const LAS unsigned char*, T> { typedef const LAS T* type; };
struct RwOps { bf16x8 ta[2], gh[2], wbk[4]; u32x2 tm, nn, vq[2]; f32x4 wl[4]; };
template <class P> __device__ __forceinline__ void rw_load(RwOps& o, P rec, int lane, int half) {
    const int g = lane >> 4;
#pragma unroll
    for (int ks = 0; ks < 2; ++ks) { o.ta[ks] = *(const typename RwPtr<P, bf16x8>::type)(rec + CR_TA + (ks * 64 + lane) * 16); o.gh[ks] = *(const typename RwPtr<P, bf16x8>::type)(rec + CR_GH + (ks * 64 + lane) * 16); }
#pragma unroll
    for (int jb = 0; jb < 4; ++jb) { o.wbk[jb] = *(const typename RwPtr<P, bf16x8>::type)(rec + CR_WBK + (jb * 64 + lane) * 16); o.wl[jb] = *(const typename RwPtr<P, f32x4>::type)(rec + CR_WL + (jb * 16 + g * 4) * 4); }
    o.tm = *(const typename RwPtr<P, u32x2>::type)(rec + CR_TM + lane * 8); o.nn = *(const typename RwPtr<P, u32x2>::type)(rec + CR_N + lane * 8);
#pragma unroll
    for (int it = 0; it < 2; ++it) o.vq[it] = *(const typename RwPtr<P, u32x2>::type)(rec + CR_V + ((half * 2 + it) * 64 + lane) * 8);
}
__device__ __forceinline__ bf16x8 mk8(unsigned a, unsigned b, unsigned c, unsigned d) { u32x4 w = {a, b, c, d}; return *reinterpret_cast<bf16x8*>(&w); }
__device__ __forceinline__ void rw_step(const RwOps& o, f32x4 (&X)[4][2], float* ysb, const long rs, int lane) {
    const int r = lane & 15, g = lane >> 4;
    const bf16x8 tmf = mk8(o.tm.x, o.tm.y, 0u, 0u), nf = mk8(o.nn.x, o.nn.y, 0u, 0u);
#pragma unroll
    for (int it = 0; it < 2; ++it) {
        bf16x8 xb[2];
#pragma unroll
        for (int ks = 0; ks < 2; ++ks) xb[ks] = mk8(pk2c(X[2 * ks][it][0], X[2 * ks][it][1]), pk2c(X[2 * ks][it][2], X[2 * ks][it][3]), pk2c(X[2 * ks + 1][it][0], X[2 * ks + 1][it][1]), pk2c(X[2 * ks + 1][it][2], X[2 * ks + 1][it][3]));
        const bf16x8 vb = mk8(o.vq[it].x, o.vq[it].y, 0u, 0u);
        f32x4 U = {0.f, 0.f, 0.f, 0.f}, Y = {0.f, 0.f, 0.f, 0.f};
        U = __builtin_amdgcn_mfma_f32_16x16x32_bf16(o.ta[0], xb[0], U, 0, 0, 0); Y = __builtin_amdgcn_mfma_f32_16x16x32_bf16(o.gh[0], xb[0], Y, 0, 0, 0);
        U = __builtin_amdgcn_mfma_f32_16x16x32_bf16(o.ta[1], xb[1], U, 0, 0, 0); Y = __builtin_amdgcn_mfma_f32_16x16x32_bf16(o.gh[1], xb[1], Y, 0, 0, 0);
        U = __builtin_amdgcn_mfma_f32_16x16x32_bf16(tmf, vb, U, 0, 0, 0);       Y = __builtin_amdgcn_mfma_f32_16x16x32_bf16(nf, vb, Y, 0, 0, 0);
        const bf16x8 uvb = mk8(pk2c(U[0], U[1]), pk2c(U[2], U[3]), o.vq[it].x, o.vq[it].y);
#pragma unroll
        for (int jb = 0; jb < 4; ++jb) X[jb][it] = __builtin_amdgcn_mfma_f32_16x16x32_bf16(o.wbk[jb], uvb, X[jb][it] * o.wl[jb], 0, 0, 0);
#pragma unroll
        for (int q = 0; q < 4; ++q) ysb[(long)(4 * g + q) * rs + 16 * it + r] = Y[q];
    }
}
__device__ __forceinline__ void rwkv_scan_chunked(Frame& F, int chain, int half) {
    unsigned char* ws = F.ws; asm volatile("" : "+s"(ws)); const int dir = chain & 1, h = (chain >> 1) & 7, b = chain >> 4; const int lane = F.lane;
    const unsigned char* rec0 = ws + SC_CREC + (size_t)chain * 256 * CR_BYTES;
#ifdef DBG_RWCHK
    float* YS = (float*)(ws + WS_HN) + (size_t)dir * NTOK * 512;
#else
    float* YS = (float*)(ws + SC_YS) + (size_t)dir * NTOK * 512;
#endif
    f32x4 X[4][2];
#pragma unroll
    for (int jb = 0; jb < 4; ++jb) { X[jb][0] = (f32x4){0.f, 0.f, 0.f, 0.f}; X[jb][1] = (f32x4){0.f, 0.f, 0.f, 0.f}; }
    RwOps oa, ob;
    rw_load(oa, rec0, lane, half);
    const long rs = dir ? -512 : 512;
    for (int c = 0; c < 256; c += 2) {
        rw_load(ob, rec0 + (size_t)(c + 1) * CR_BYTES, lane, half);
        { const int pos0 = dir ? (SEQ - 1 - 16 * c) : 16 * c; rw_step(oa, X, YS + (size_t)(b * SEQ + pos0) * 512 + h * 64 + half * 32, rs, lane); }
        if (c + 2 < 256) rw_load(oa, rec0 + (size_t)(c + 2) * CR_BYTES, lane, half);
        { const int pos0 = dir ? (SEQ - 1 - 16 * (c + 1)) : 16 * (c + 1); rw_step(ob, X, YS + (size_t)(b * SEQ + pos0) * 512 + h * 64 + half * 32, rs, lane); }
    }
}

__device__ __forceinline__ void rwkv_scan_ring(Frame& F, int pair) {
    unsigned char* ws = F.ws; asm volatile("" : "+s"(ws));
    const int w = F.wave, lane = F.lane;
    LAS unsigned char* ring = F.lds;
    __syncthreads();
    if (w < 4) {
        const int chain = pair * 2 + (w >> 1), half = w & 1; const int dir = chain & 1, h = (chain >> 1) & 7, b = chain >> 4;
        float* YS = (float*)(ws + SC_YS) + (size_t)dir * NTOK * 512;
        f32x4 X[4][2];
#pragma unroll
        for (int jb = 0; jb < 4; ++jb) { X[jb][0] = (f32x4){0.f, 0.f, 0.f, 0.f}; X[jb][1] = (f32x4){0.f, 0.f, 0.f, 0.f}; }
        const long rs = dir ? -512 : 512;
        __syncthreads();
#pragma unroll 1
        for (int c = 0; c < 256; ++c) {
            RwOps o; rw_load(o, (const LAS unsigned char*)(ring + ((w >> 1) * 2 + (c & 1)) * CR_BYTES), lane, half);
            const int pos0 = dir ? (SEQ - 1 - 16 * c) : 16 * c; rw_step(o, X, YS + (size_t)(b * SEQ + pos0) * 512 + h * 64 + half * 32, rs, lane);
            __syncthreads();
        }
    } else {
        const int k = (w - 4) >> 1, part = (w - 4) & 1; const int chain = pair * 2 + k;
        const unsigned char* rec0 = ws + SC_CREC + (size_t)chain * 256 * CR_BYTES;
        LAS unsigned char* dst0 = ring + (k * 2) * CR_BYTES;
        const int i0 = (part * 64 + lane) * 16;
        u32x4 R0[6], R1[6], R2[6];
#define RW_LD(R, cc) do { const unsigned char* p_ = rec0 + (size_t)(cc) * CR_BYTES + i0; _Pragma("unroll") for (int j = 0; j < 6; ++j) if (j < 5 || i0 + 2048 * 5 < CR_BYTES) R[j] = *(const u32x4*)(p_ + 2048 * j); } while (0)
#define RW_ST(R, cc) do { LAS unsigned char* d_ = dst0 + ((cc) & 1) * CR_BYTES + i0; _Pragma("unroll") for (int j = 0; j < 6; ++j) if (j < 5 || i0 + 2048 * 5 < CR_BYTES) *(LAS u32x4*)(d_ + 2048 * j) = R[j]; } while (0)
        RW_LD(R0, 0); RW_LD(R1, 1); RW_LD(R2, 2);
        RW_ST(R0, 0); RW_LD(R0, 3);
        __syncthreads();
#pragma unroll 1
        for (int c = 0; c < 255; c += 3) {
            RW_ST(R1, c + 1); if (c + 4 < 256) RW_LD(R1, c + 4); __syncthreads();
            RW_ST(R2, c + 2); if (c + 5 < 256) RW_LD(R2, c + 5); __syncthreads();
            RW_ST(R0, c + 3); if (c + 6 < 256) RW_LD(R0, c + 6); __syncthreads();
        }
        __syncthreads();
#undef RW_LD
#undef RW_ST
    }
}

__device__ __forceinline__ void rwkv_scan_naive(Frame& F, int chain) {
    unsigned char* ws = F.ws; const float* RW = (const float*)(ws + SC_RW); const size_t N1 = (size_t)NTOK * 512;
    const int dir = chain & 1, h = (chain >> 1) & 7, b = chain >> 4;
    const float* Rp = RW; const float* Vp = RW + N1; const float* KKp = RW + 2 * N1; const float* Wp = RW + (3 + dir) * N1; const float* KMp = RW + (5 + dir) * N1; const float* BBp = RW + (7 + dir) * N1;
    float* YS = (float*)(ws + SC_YS) + (size_t)dir * N1;
    LAS float* L = (LAS float*)(F.lds + F.wave * 2048);
    float st[64];
#pragma unroll
    for (int j = 0; j < 64; ++j) st[j] = 0.f;
    size_t idx = (size_t)(b * SEQ + (dir ? SEQ - 1 : 0)) * 512 + h * 64 + F.lane;
    float va = -KKp[idx], vw = __expf(Wp[idx]), vb = BBp[idx], vk = KMp[idx], vr = Rp[idx], vv = Vp[idx];
    for (int t = 0; t < SEQ; ++t) {
        L[F.lane] = va; L[64 + F.lane] = vw; L[128 + F.lane] = vb; L[192 + F.lane] = vk; L[256 + F.lane] = vr;
        const float v = vv; const size_t oidx = idx;
        if (t + 1 < SEQ) { idx = dir ? idx - 512 : idx + 512; va = -KKp[idx]; vw = __expf(Wp[idx]); vb = BBp[idx]; vk = KMp[idx]; vr = Rp[idx]; vv = Vp[idx]; }
        LDS_WAIT(); asm volatile("" ::: "memory");
        float sa0 = 0.f, sa1 = 0.f, sa2 = 0.f, sa3 = 0.f;
#pragma unroll
        for (int j = 0; j < 64; j += 4) { const f32x4 x = *(const LAS f32x4*)(L + j); sa0 += st[j] * x[0]; sa1 += st[j + 1] * x[1]; sa2 += st[j + 2] * x[2]; sa3 += st[j + 3] * x[3]; }
        const float sa = (sa0 + sa1) + (sa2 + sa3);
        float y0 = 0.f, y1 = 0.f, y2 = 0.f, y3 = 0.f;
#pragma unroll
        for (int j = 0; j < 64; j += 4) { const f32x4 w4 = *(const LAS f32x4*)(L + 64 + j), b4 = *(const LAS f32x4*)(L + 128 + j), k4 = *(const LAS f32x4*)(L + 192 + j), r4 = *(const LAS f32x4*)(L + 256 + j);
            st[j] = st[j] * w4[0] + (sa * b4[0] + v * k4[0]); st[j + 1] = st[j + 1] * w4[1] + (sa * b4[1] + v * k4[1]); st[j + 2] = st[j + 2] * w4[2] + (sa * b4[2] + v * k4[2]); st[j + 3] = st[j + 3] * w4[3] + (sa * b4[3] + v * k4[3]);
            y0 += st[j] * r4[0]; y1 += st[j + 1] * r4[1]; y2 += st[j + 2] * r4[2]; y3 += st[j + 3] * r4[3]; }
        YS[oidx] = (y0 + y1) + (y2 + y3);
        asm volatile("" ::: "memory");
    }
}

__device__ __forceinline__ void s5_unit(Frame& F, ArgsP a, int layer, int unit) {
    unsigned char* ws = F.ws; asm volatile("" : "+s"(ws)); const bf16* Z = (const bf16*)(ws + SC_Z);
    const int b = unit / S5NCH, ch = unit % S5NCH; const int tok0 = b * SEQ + ch * S5CH;
    LAS float* ybuf = (LAS float*)F.lds;
    LAS float* glT = (LAS float*)(F.lds + 32768);
    LAS float* xs = (LAS float*)(F.lds + 65536 + F.wave * 8192);
    const float* ab = (const float*)(ws + WS_S5P + layer * S5P_LAYER); const float* bb = ab + 2 * 32 * 64 * 2;
    const float* carry = (const float*)(ws + SC_CARRY);
    const int n = F.lane;
    __syncthreads();
    LAS float* ulw = (LAS float*)(F.lds + RING_BYTES + F.wave * 1024);
    for (int gi = 0; gi < 4; ++gi) {
        const int g = gi * 8 + F.wave;
        { const int tl = (n >> 1) & 15, hf = n & 1; const u32x4 w0 = *(const u32x4*)(Z + (size_t)(tok0 + tl) * ZLD + ZD + g * 16 + hf * 8);
          if (n < 32) { LAS f32x4* d = (LAS f32x4*)(ulw + tl * 16 + hf * 8);
            d[0] = (f32x4){__uint_as_float(w0.x << 16), __uint_as_float(w0.x & 0xffff0000u), __uint_as_float(w0.y << 16), __uint_as_float(w0.y & 0xffff0000u)};
            d[1] = (f32x4){__uint_as_float(w0.z << 16), __uint_as_float(w0.z & 0xffff0000u), __uint_as_float(w0.w << 16), __uint_as_float(w0.w & 0xffff0000u)}; } }
        float abr2[2], abi2[2], cr2[2], ci2[2];
#pragma unroll
        for (int dir = 0; dir < 2; ++dir) { const int pr = (dir * 32 + g) * 64 + n; abr2[dir] = ab[pr * 2]; abi2[dir] = ab[pr * 2 + 1];
            const float* cp = carry + ((((size_t)dir * BATCH + b) * S5NCH + ch) * 32 + g) * 128 + n * 2; cr2[dir] = cp[0]; ci2[dir] = cp[1]; }
        LDS_WAIT(); asm volatile("" ::: "memory");
#pragma unroll
        for (int dir = 0; dir < 2; ++dir) {
            const int pr = (dir * 32 + g) * 64 + n; const float abr = abr2[dir], abi = abi2[dir];
            float bbr[16], bbi[16];
            { const f32x4* bp = (const f32x4*)(bb + (size_t)pr * 32);
#pragma unroll
              for (int c4 = 0; c4 < 8; ++c4) { const f32x4 q = bp[c4]; bbr[c4 * 2] = q[0]; bbi[c4 * 2] = q[1]; bbr[c4 * 2 + 1] = q[2]; bbi[c4 * 2 + 1] = q[3]; } }
            float xr = cr2[dir], xi = ci2[dir];
#pragma unroll 2
            for (int i = 0; i < S5CH; ++i) { const int tl = dir ? (S5CH - 1 - i) : i;
                const f32x4 u0 = *(const LAS f32x4*)(ulw + tl * 16), u1 = *(const LAS f32x4*)(ulw + tl * 16 + 4), u2 = *(const LAS f32x4*)(ulw + tl * 16 + 8), u3 = *(const LAS f32x4*)(ulw + tl * 16 + 12);
                float br = 0.f, bi = 0.f;
#pragma unroll
                for (int c = 0; c < 4; ++c) { br += bbr[c] * u0[c] + bbr[4 + c] * u1[c] + bbr[8 + c] * u2[c] + bbr[12 + c] * u3[c]; bi += bbi[c] * u0[c] + bbi[4 + c] * u1[c] + bbi[8 + c] * u2[c] + bbi[12 + c] * u3[c]; }
                const float nr = abr * xr - abi * xi + br, ni = abr * xi + abi * xr + bi; xr = nr; xi = ni;
                LAS float* xp = xs + (tl * 64 + n) * 2;
                if (dir == 0) { xp[0] = xr; xp[1] = xi; } else { xp[0] += xr; xp[1] += xi; } }
        }
        LDS_WAIT(); asm volatile("" ::: "memory");
        { const int c = F.lane & 15, sq = F.lane >> 4; const float* cre = a->in[I_S5_C_RE] + (((size_t)layer * 32 + g) * 16 + c) * 64; const float* cim = a->in[I_S5_C_IM] + (((size_t)layer * 32 + g) * 16 + c) * 64;
          float y[4] = {0.f, 0.f, 0.f, 0.f};
#pragma unroll 4
          for (int nn = 0; nn < 64; nn += 4) { const f32x4 cr = *(const f32x4*)(cre + nn), ci = *(const f32x4*)(cim + nn);
#pragma unroll
              for (int s = 0; s < 4; ++s) { const LAS f32x4* xp = (const LAS f32x4*)(xs + ((sq * 4 + s) * 64 + nn) * 2); const f32x4 xa = xp[0], xb = xp[1];
                  y[s] += cr[0] * xa[0] - ci[0] * xa[1] + cr[1] * xa[2] - ci[1] * xa[3] + cr[2] * xb[0] - ci[2] * xb[1] + cr[3] * xb[2] - ci[3] * xb[3]; } }
          const float dsk = a->in[I_S5_D][(size_t)layer * 512 + g * 16 + c];
#pragma unroll
          for (int s = 0; s < 4; ++s) { const int tl = sq * 4 + s; const float uu = ulw[tl * 16 + c]; const float yy = y[s] + dsk * uu;
              const float x3 = yy * yy * yy; const float gl = 0.5f * yy * (1.f + tanhf(0.7978845608028654f * (yy + 0.044715f * x3)));
              ybuf[tl * 512 + g * 16 + c] = gl; glT[(g * 16 + c) * 16 + tl] = gl; } }
        LDS_WAIT(); asm volatile("" ::: "memory");
    }
    __syncthreads();
    { const int c = F.tid; const __amdgpu_buffer_rsrc_t gw = make_rsrc(a->in[I_S5_GLU_W] + (size_t)layer * 512 * 512, 512 * 512 * 4); float acc[16];
#pragma unroll
      for (int s = 0; s < 16; ++s) acc[s] = 0.f;
#pragma unroll 1
      for (int k0 = 0; k0 < 512; k0 += 16) { float wv[16];
#pragma unroll
          for (int q = 0; q < 16; ++q) wv[q] = bload_f32(gw, c * 4, (k0 + q) * 2048);
#pragma unroll
          for (int kk = 0; kk < 16; ++kk) { const float w = wv[kk]; const LAS f32x4* gp = (const LAS f32x4*)(glT + (k0 + kk) * 16); const f32x4 g0 = gp[0], g1 = gp[1], g2 = gp[2], g3 = gp[3];
#pragma unroll
              for (int q = 0; q < 4; ++q) { acc[q] += g0[q] * w; acc[4 + q] += g1[q] * w; acc[8 + q] += g2[q] * w; acc[12 + q] += g3[q] * w; }
              if (kk & 1) asm volatile("" ::: "memory"); } }
      const float bias = a->in[I_S5_GLU_B][(size_t)layer * 512 + c];
      __syncthreads();
#pragma unroll
      for (int s = 0; s < 16; ++s) { const float gl = ybuf[s * 512 + c]; ybuf[s * 512 + c] = gl * sigmoidf_(acc[s] + bias); } }
    __syncthreads();
    { const float* gn = a->in[I_MIX_OUT_NORM] + ((size_t)layer * 2 + 1) * 512; bf16* MIX = (bf16*)(ws + WS_MIX);
#pragma unroll
      for (int q = 0; q < 2; ++q) { const int tl = F.wave * 2 + q; float v[8]; float s = 0.f;
#pragma unroll
          for (int j = 0; j < 8; ++j) { v[j] = ybuf[tl * 512 + j * 64 + F.lane]; s += v[j] * v[j]; }
          const float rstd = 1.f / sqrtf(wave_sum(s) * (1.f / 512.f) + RMS_EPS);
#pragma unroll
          for (int j = 0; j < 8; ++j) MIX[(size_t)(tok0 + tl) * DM + 1536 + j * 64 + F.lane] = f2bf(v[j] * rstd * gn[j * 64 + F.lane]); } }
}

template <int mask>
__device__ __forceinline__ void mix_phase(Frame& F, ArgsP a, int layer, const int rep) {
    const int qb_ = (rep * 2 + layer) * 8;
    constexpr int NB = 16, NA = BATCH * 4 * (SEQ / 128), NC = BATCH * 4 * 48, ND = BATCH * S5NCH;
    if (mask & 1) for (;;) { const int it = q_next(F, qb_ + 1); if (it >= NB) break; rwkv_scan_ring(F, it); }
    if (mask & 2) for (;;) { const int it = q_next(F, qb_ + 2); if (it >= NA) break;
        unsigned char* ws = F.ws; asm volatile("" : "+s"(ws)); const bf16* Z = (const bf16*)(ws + SC_Z);
        const int qb = it % (SEQ / 128), h = (it / (SEQ / 128)) % 4, b = it / (4 * (SEQ / 128));
        const bf16* zb = Z + (size_t)(b * SEQ) * ZLD + ZA;
        float lam, lam_init;
        { const float* lv = a->in[I_DIFF_LAMBDA] + (size_t)layer * 4 * 64; float d1 = 0.f, d2 = 0.f;
          for (int i = 0; i < 64; ++i) { d1 += lv[i] * lv[64 + i]; d2 += lv[128 + i] * lv[192 + i]; }
          lam_init = 0.8f - 0.6f * expf(-0.3f * (float)layer); lam = expf(d1) - expf(d2) + lam_init; }
        att::diff_attn_unit(zb + (size_t)(qb * 128) * ZLD + h * 128, zb + 512 + h * 128, zb + 1024 + h * 128, ZLD, SEQ,
                            (bf16*)(ws + WS_MIX) + (size_t)(b * SEQ + qb * 128) * DM + h * 128, DM, lam, 1.f - lam_init, a->in[I_DIFF_SUBLN] + (size_t)layer * 128, (char*)F.lds, F.wave); }
#ifdef DBG_RWCHK
    for (;;) { const int it = q_next(F, layer * 8 + 5); if (it >= 4) break; rwkv_scan_naive(F, it * 8 + F.wave); }
#endif
    if (mask & 4) for (;;) { const int it = q_next(F, qb_ + 3); if (it >= NC) break;
        unsigned char* ws = F.ws; asm volatile("" : "+s"(ws)); const bf16* Z = (const bf16*)(ws + SC_Z);
        const int r = it % 48, h = (it / 48) % 4, b = it / (48 * 4); const int p = r / 16, rr = r % 16;
        const int dil = p == 0 ? 1 : (p == 1 ? 4 : 16); const int L = SEQ / dil; const int nqb = L / 256; const int rho = rr / nqb, qb = rr % nqb;
        const bf16* zb = Z + (size_t)(b * SEQ) * ZLD + ZC;
        att::dil_attn_unit(zb + h * 128, zb + 512 + h * 128, zb + 1024 + h * 128, ZLD, dil, rho, qb * 256, L,
                           (float*)(ws + SC_OC) + ((size_t)p * NTOK + (size_t)b * SEQ) * 512 + h * 128, (float*)(ws + SC_LSE) + ((size_t)p * NTOK + (size_t)b * SEQ) * 4 + h, (char*)F.lds, F.wave); }
    if (mask & 8) for (;;) { const int it = q_next(F, qb_ + 4); if (it >= ND) break; s5_unit(F, a, layer, it); }
}

__device__ __forceinline__ void post_phase(Frame& F, ArgsP a, int layer) {
    unsigned char* ws = F.ws; bf16* MIX = (bf16*)(ws + WS_MIX);
    const int gw = F.bid * 8 + F.wave, NGW = F.G * 8;
    const float* RW = (const float*)(ws + SC_RW); const size_t N1 = (size_t)NTOK * 512; const float* YS = (const float*)(ws + SC_YS);
#ifdef DBG_RWCHK
    { const float* Y2 = (const float*)(ws + WS_HN); float e = 0.f, r2 = 0.f; int bad = 0;
      for (size_t i = (size_t)F.bid * 512 + F.tid; i < (size_t)2 * NTOK * 512; i += (size_t)F.G * 512) { const float a0 = ((const float*)(ws + SC_YS))[i], b0 = Y2[i]; const float d = fabsf(a0 - b0); if (!(d < 1e30f)) bad = 1; else e = fmaxf(e, d); r2 = fmaxf(r2, fabsf(a0)); }
      e = wave_max(e); r2 = wave_max(r2); bad = __any(bad) ? 1 : 0;
      if (F.lane == 0) { atomicMax(F.ctl + 32768 + layer * 64, __float_as_uint(e)); atomicMax(F.ctl + 32768 + layer * 64 + 1, __float_as_uint(r2)); if (bad) atomicMax(F.ctl + 32768 + layer * 64 + 2, 1u); } }
#endif
    for (int it = gw; it < NTOK * 8; it += NGW) { const int tok = it >> 3, h = it & 7; const size_t o = (size_t)tok * 512 + h * 64 + F.lane; const int c = h * 64 + F.lane;
        const float y = YS[o] + YS[N1 + o];
        const float mean = wave_sum(y) * (1.f / 64.f); const float d = y - mean; const float var = wave_sum(d * d) * (1.f / 64.f);
        const float yn = d * (1.f / sqrtf(var + 64e-5f)) * a->in[I_RWKV_LNX_W][(size_t)layer * 512 + c] + a->in[I_RWKV_LNX_B][(size_t)layer * 512 + c];
        const float r_ = RW[o], v_ = RW[N1 + o], kb = 0.5f * (RW[5 * N1 + o] + RW[6 * N1 + o]);
        const float bon = wave_sum(r_ * kb * a->in[I_RWKV_RK][(size_t)layer * 512 + c]) * v_;
        MIX[(size_t)tok * DM + 512 + c] = f2bf((yn + bon) * RW[9 * N1 + o]); }
    const float* OC = (const float*)(ws + SC_OC); const float* LSE = (const float*)(ws + SC_LSE); const float* gn = a->in[I_MIX_OUT_NORM] + ((size_t)layer * 2 + 0) * 512;
    for (int tok = gw; tok < NTOK; tok += NGW) { const int h = F.lane >> 4;
        const float l0 = LSE[((size_t)0 * NTOK + tok) * 4 + h], l1 = LSE[((size_t)1 * NTOK + tok) * 4 + h], l2 = LSE[((size_t)2 * NTOK + tok) * 4 + h];
        const float m = fmaxf(l0, fmaxf(l1, l2)); float w0 = __expf(l0 - m), w1 = __expf(l1 - m), w2 = __expf(l2 - m); const float inv = 1.f / (w0 + w1 + w2); w0 *= inv; w1 *= inv; w2 *= inv;
        float v[8]; float s = 0.f;
        const f32x4* p0 = (const f32x4*)(OC + ((size_t)0 * NTOK + tok) * 512) + F.lane * 2; const f32x4* p1 = (const f32x4*)(OC + ((size_t)1 * NTOK + tok) * 512) + F.lane * 2; const f32x4* p2 = (const f32x4*)(OC + ((size_t)2 * NTOK + tok) * 512) + F.lane * 2;
#pragma unroll
        for (int j = 0; j < 2; ++j) { const f32x4 a0 = p0[j], a1 = p1[j], a2 = p2[j];
#pragma unroll
            for (int e = 0; e < 4; ++e) { const float x = w0 * a0[e] + w1 * a1[e] + w2 * a2[e]; v[j * 4 + e] = x; s += x * x; } }
        const float rstd = 1.f / sqrtf(wave_sum(s) * (1.f / 512.f) + RMS_EPS);
        const f32x4 g0 = *((const f32x4*)gn + F.lane * 2), g1 = *((const f32x4*)gn + F.lane * 2 + 1);
        u32x4 w; w.x = pk2(v[0] * rstd * g0[0], v[1] * rstd * g0[1]); w.y = pk2(v[2] * rstd * g0[2], v[3] * rstd * g0[3]); w.z = pk2(v[4] * rstd * g1[0], v[5] * rstd * g1[1]); w.w = pk2(v[6] * rstd * g1[2], v[7] * rstd * g1[3]);
        *(u32x4*)(MIX + (size_t)tok * DM + 1024 + F.lane * 8) = w; }
}

#ifndef MK_FUSED
#define MK_FUSED 1
#endif
__global__ void __launch_bounds__(512, 2) enc_fwd(Args args_) {
    extern __shared__ __attribute__((aligned(16))) unsigned char lds_raw[];
    Frame F;
    F.lds = (LAS unsigned char*)lds_raw; F.MISC = (volatile LAS unsigned*)(F.lds + MISC_OFF);
    F.tid = threadIdx.x; F.lane = F.tid & 63; F.wave = __builtin_amdgcn_readfirstlane(F.tid >> 6); F.G = gridDim.x; F.bid = blockIdx.x;
    const int wave0 = F.wave;
    ArgsP ap = (ArgsP)__builtin_amdgcn_kernarg_segment_ptr();
    unsigned char* ws = ap->ws; F.ws = ws; F.ctl = (unsigned*)(ws + WS_CTL);
    for (int u = F.tid; u < (LDS_BYTES - MISC_OFF) / 4; u += 512) ((LAS unsigned*)(F.lds + MISC_OFF))[u] = 0u;
    __syncthreads();
    const int lo = ap->ph_lo, hi = ap->ph_hi;
    if (hi - lo > 1) (void)xcd_barrier_post(F.ctl + CW_BAR, F.MISC + 8);
#ifdef DBG_ONLY
#define IN(k) (((k) < PH_L0 ? (k) : ((k) == PH_FINAL ? 100 : 3 + ((k) - PH_L0) % NPH_L)) == DBG_ONLY && lo <= (k) && (k) < hi)
#else
#define IN(k) ({ int lo_ = lo, hi_ = hi; asm volatile("" : "+s"(lo_), "+s"(hi_)); lo_ <= (k) && (k) < hi_; })
#endif
#define args (*ap)
#define REFRESH() do { int wv_ = wave0, bi_ = blockIdx.x, gg_ = gridDim.x; asm volatile("" : "+s"(wv_), "+s"(bi_), "+s"(gg_)); const int t_ = tid_from_wave(wv_); F.tid = t_; F.lane = t_ & 63; F.wave = wv_; F.bid = bi_; F.G = gg_; ap = (ArgsP)__builtin_amdgcn_kernarg_segment_ptr(); asm volatile("" : "+s"(ap)); unsigned char* w_ = ap->ws; F.ws = w_; ws = w_; F.ctl = (unsigned*)(w_ + WS_CTL); } while (0)
#ifndef DBG_MIXMASK
#define DBG_MIXMASK 15
#endif
#ifndef DBG_REP_CODE
#define DBG_REP_CODE -1
#define DBG_REP_N 0
#endif
#define REPS(code) (((code) == DBG_REP_CODE && l_ == 0) ? 1 + DBG_REP_N : 1)
#ifdef DBG_TIME_A
#define STAMP(k) do { if (blockIdx.x == 0 && threadIdx.x == 0) { const unsigned long long t_ = wall_clock64(); F.MISC[192 + 2 * (k)] = (unsigned)t_; F.MISC[193 + 2 * (k)] = (unsigned)(t_ >> 32); } } while (0)
#else
#define STAMP(k) do {} while (0)
#endif
#define SEAM(k) do { if (IN(k) && IN((k) + 1)) { XcdBarrier b_; b_.bar = (unsigned*)(ap->ws + WS_CTL) + CW_BAR; b_.x = xb_xcc_id(); b_.st = F.MISC + 8; xcd_barrier(b_); } } while (0)

    { const int l_ = 0; STAMP(PH_P0); if (IN(PH_P0)) { REFRESH(); for (int rep = 0; rep < REPS(0); ++rep) p0_prologue(F, ap); } } SEAM(PH_P0);
    if (DBG_REP_CODE == 30 && hi - lo > 1) { for (int i = 0; i < 20; ++i) { XcdBarrier b_; b_.bar = (unsigned*)(ap->ws + WS_CTL) + CW_BAR; b_.x = xb_xcc_id(); b_.st = F.MISC + 8; xcd_barrier(b_); } }
    STAMP(PH_P1); if (IN(PH_P1)) { REFRESH();
        SchedBatch S{(const char*)(ws + SC_MEMN), (const char*)(ws + SC_WKVT), (char*)(ws + SC_KVB), (size_t)512 * DM * 2, (size_t)4096 * DM * 2, (size_t)512 * 4096 * 2, 2, 16, DEPTH, F.G, F.bid, DM, DM, 4096 * 2, 2, 512};
        { const int l_ = 0; for (int rep = 0; rep < REPS(1); ++rep) pg8::gemm_phase<pg8::EpiBf16, SchedBatch, false>(F.lds, pg8::GemmP{DM, DM, DM}, S, pg8::EpiBf16{4096}, F.wave); }
    } SEAM(PH_P1);
    STAMP(PH_P2); if (IN(PH_P2)) { REFRESH();
        { SchedXaPre S{ws, F.G, F.bid, 0}; pg8::gemm_phase<EpiBf16U, SchedXaPre, false>(F.lds, pg8::GemmP{512, 4096, DM}, S, EpiBf16U{}, F.wave); }
        { SchedXaPre S{ws, F.G, F.bid, 1}; pg8::gemm_phase<EpiBf16U, SchedXaPre, false>(F.lds, pg8::GemmP{512, DM, 4096}, S, EpiBf16U{}, F.wave); }
    } SEAM(PH_P2);

    for (int l = 0; l < DEPTH; ++l) {
        const int pb = PH_L0 + l * NPH_L; const int l_ = l;
        float* H = (float*)(ws + WS_H);
        STAMP(pb + LP_NORM1); if (IN(pb + LP_NORM1)) { REFRESH(); if (l == 0) { for (int rep = 0; rep < REPS(22); ++rep) norm_phase<0>(F, ap, args.in[I_X], args.in[I_NORM_MIX], l); } else norm_phase<1>(F, ap, H, args.in[I_NORM_MIX] + (size_t)l * DM, l); } SEAM(pb + LP_NORM1);
        STAMP(pb + LP_G1); if (IN(pb + LP_G1)) { REFRESH();
            SchedDense S{(const char*)(ws + WS_HN), (const char*)(ws + WS_WIN) + (size_t)l * ZLD * DM * 2, (char*)(ws + SC_Z), NTOK / 256, ZLD / 256, F.G, F.bid, DM, DM, ZLD * 2, 2};
            for (int rep = 0; rep < REPS(10); ++rep) pg8::gemm_phase<pg8::EpiBf16, SchedDense, false>(F.lds, pg8::GemmP{DM, DM, DM}, S, pg8::EpiBf16{ZLD}, F.wave);
        } SEAM(pb + LP_G1);
        STAMP(pb + LP_PREP); if (IN(pb + LP_PREP)) { REFRESH(); for (int rep = 0; rep < REPS(11); ++rep) prep_phase(F, ap, l, rep); } SEAM(pb + LP_PREP);
        STAMP(pb + LP_CPREP); if (IN(pb + LP_CPREP)) { REFRESH(); for (int rep = 0; rep < REPS(12); ++rep) cprep_phase(F, l); } SEAM(pb + LP_CPREP);
        STAMP(pb + LP_MIX); if (IN(pb + LP_MIX)) { REFRESH(); mix_phase<DBG_MIXMASK>(F, ap, l, 0); if (DBG_REP_CODE >= 13 && DBG_REP_CODE <= 16 && l_ == 0) { REFRESH(); mix_phase<(DBG_REP_CODE >= 13 && DBG_REP_CODE <= 16) ? (1 << (DBG_REP_CODE - 13)) : 1>(F, ap, l, 1); if (DBG_REP_N > 1) { REFRESH(); mix_phase<(DBG_REP_CODE >= 13 && DBG_REP_CODE <= 16) ? (1 << (DBG_REP_CODE - 13)) : 1>(F, ap, l, 2); } } } SEAM(pb + LP_MIX);
        STAMP(pb + LP_POST); if (IN(pb + LP_POST)) { REFRESH(); for (int rep = 0; rep < REPS(17); ++rep) post_phase(F, ap, l); } SEAM(pb + LP_POST);
        STAMP(pb + LP_G2); if (IN(pb + LP_G2)) { REFRESH();
            SchedDense S{(const char*)(ws + WS_MIX), (const char*)(ws + WS_WOUT) + (size_t)l * DM * DM * 2, (char*)H, NTOK / 256, DM / 256, F.G, F.bid, DM, DM, DM * 4, 4};
            for (int rep = 0; rep < REPS(23); ++rep) pg8::gemm_phase<pg8::EpiF32Res, SchedDense, false>(F.lds, pg8::GemmP{DM, DM, DM}, S, pg8::EpiF32Res{DM, l == 0 ? args.in[I_X] : (const float*)H, H}, F.wave);
        } SEAM(pb + LP_G2);
        STAMP(pb + LP_NORM2); if (IN(pb + LP_NORM2)) { REFRESH(); for (int rep = 0; rep < REPS(18); ++rep) norm_phase<0>(F, ap, H, args.in[I_NORM_CROSS] + (size_t)l * DM, l); } SEAM(pb + LP_NORM2);
        STAMP(pb + LP_GS); if (IN(pb + LP_GS)) { REFRESH();
            SchedBatch S{(const char*)(ws + WS_HN), (const char*)(ws + WS_WQK) + (size_t)l * 2 * 1024 * DM * 2, (char*)(ws + WS_P), (size_t)SEQ * DM * 2, (size_t)1024 * DM * 2, (size_t)SEQ * 1024 * 2, SEQ / 256, 4, BATCH, F.G, F.bid, DM, DM, 1024 * 2, 2, SEQ};
            for (int rep = 0; rep < REPS(19); ++rep) pg8::gemm_phase<pg8::EpiSoftmax, SchedBatch, false>(F.lds, pg8::GemmP{DM, DM, DM}, S, pg8::EpiSoftmax{1024, 0.044194173824159216f * 1.4426950408889634f}, F.wave);
        } SEAM(pb + LP_GS);
        STAMP(pb + LP_GO); if (IN(pb + LP_GO)) { REFRESH();
            SchedBatch S{(const char*)(ws + WS_P), (const char*)(ws + WS_VWO) + (size_t)l * 2 * DM * 1024 * 2, (char*)H, (size_t)SEQ * 1024 * 2, (size_t)DM * 1024 * 2, (size_t)SEQ * DM * 4, SEQ / 256, DM / 256, BATCH, F.G, F.bid, 1024, 1024, DM * 4, 4, SEQ};
            pg8::gemm_phase<pg8::EpiF32Res, SchedBatch, false>(F.lds, pg8::GemmP{1024, 1024, 1024}, S, pg8::EpiF32Res{DM, (const float*)H, H}, F.wave);
        } SEAM(pb + LP_GO);
        STAMP(pb + LP_NORM3); if (IN(pb + LP_NORM3)) { REFRESH(); norm_phase<2>(F, ap, H, args.in[I_NORM_MOE] + (size_t)l * DM, l); } SEAM(pb + LP_NORM3);
        STAMP(pb + LP_M1); if (IN(pb + LP_M1)) { REFRESH();
            volatile LAS int* tp = (volatile LAS int*)(F.lds + MISC_OFF + 256); volatile LAS int* cnt = tp + 40;
            moe_prefix(F, l, tp, cnt);
            SchedMoe S{ws, tp, cnt, l, F.G, F.bid, 0};
            for (int rep = 0; rep < REPS(20); ++rep) pg8::gemm_phase<pg8::EpiSwiGlu, SchedMoe, true>(F.lds, pg8::GemmP{DM, DM, DM}, S, pg8::EpiSwiGlu{DEXP}, F.wave);
        } SEAM(pb + LP_M1);
        STAMP(pb + LP_M2); if (IN(pb + LP_M2)) { REFRESH();
            volatile LAS int* tp = (volatile LAS int*)(F.lds + MISC_OFF + 256); volatile LAS int* cnt = tp + 40;
            moe_prefix(F, l, tp, cnt);
            SchedMoe S{ws, tp, cnt, l, F.G, F.bid, 1};
            for (int rep = 0; rep < REPS(21); ++rep) pg8::gemm_phase<pg8::EpiGate, SchedMoe, false>(F.lds, pg8::GemmP{DEXP, DEXP, DEXP}, S, pg8::EpiGate{DM, (const float*)(ws + WS_EGATE), nullptr}, F.wave);
        } SEAM(pb + LP_M2);
    }
#ifdef DBG_TIME_A
    STAMP(PH_FINAL);
    if (blockIdx.x == 0 && threadIdx.x == 0) { const unsigned long long ta = ((unsigned long long)F.MISC[193 + 2 * (DBG_TIME_A)] << 32) | F.MISC[192 + 2 * (DBG_TIME_A)], tb = ((unsigned long long)F.MISC[193 + 2 * (DBG_TIME_B)] << 32) | F.MISC[192 + 2 * (DBG_TIME_B)];
        __hip_atomic_store(F.ctl + 40000, (unsigned)((tb - ta + DBG_TIME_Q / 2) / DBG_TIME_Q), __ATOMIC_RELAXED, __HIP_MEMORY_SCOPE_AGENT); }
    if (hi - lo > 1) { XcdBarrier b_; b_.bar = (unsigned*)(ap->ws + WS_CTL) + CW_BAR; b_.x = xb_xcc_id(); b_.st = F.MISC + 8; xcd_barrier(b_); }
#endif
    STAMP(PH_FINAL); if (IN(PH_FINAL)) { REFRESH(); norm_phase<5>(F, ap, (const float*)(ws + WS_H), args.in[I_NORM_FINAL], DEPTH); }
#undef IN
#undef SEAM
#undef args
}

extern "C" void kernel_launch(void* const* d_in, const int* in_sizes, int n_in, void* d_out, int out_size, void* d_ws, size_t ws_size, hipStream_t stream) {
    static int grid = 0;
    if (grid == 0) {
        if (n_in != N_INPUTS || out_size != NTOK * DM || ws_size < cmax(WS_END, SC_MIX_END3)) { fprintf(stderr, "kernel_launch: built for %d inputs, out %d, ws >= %zu; got %d, %d, %zu\n", N_INPUTS, NTOK * DM, cmax(WS_END, SC_MIX_END3), n_in, out_size, ws_size); grid = -1; return; }
        int dev = 0, cus = 0, per_cu = 0;
        if (hipGetDevice(&dev) != hipSuccess || hipDeviceGetAttribute(&cus, hipDeviceAttributeMultiprocessorCount, dev) != hipSuccess) { fprintf(stderr, "kernel_launch: device query failed\n"); grid = -1; return; }
        if (hipFuncSetAttribute((const void*)enc_fwd, hipFuncAttributeMaxDynamicSharedMemorySize, LDS_BYTES) != hipSuccess) { fprintf(stderr, "kernel_launch: hipFuncSetAttribute failed\n"); grid = -1; return; }
        if (hipOccupancyMaxActiveBlocksPerMultiprocessor(&per_cu, (const void*)enc_fwd, 512, LDS_BYTES) != hipSuccess || per_cu < 1) fprintf(stderr, "kernel_launch: occupancy query says %d blocks per CU\n", per_cu);
        grid = cus;
    }
    if (grid < 0) return;
    hipMemsetAsync((char*)d_ws + WS_CTL, 0, CTL_BYTES, stream);
    Args a; memset(&a, 0, sizeof(a));
    for (int i = 0; i < N_INPUTS; ++i) a.in[i] = (const float*)d_in[i];
    a.out = (float*)d_out; a.ws = (unsigned char*)d_ws;
#if MK_FUSED
    a.ph_lo = 0; a.ph_hi = NPHASES;
    hipLaunchKernelGGL(enc_fwd, dim3(grid), dim3(512), LDS_BYTES, stream, a);
#else
    for (int p = 0; p < NPHASES; ++p) { a.ph_lo = p; a.ph_hi = p + 1; hipLaunchKernelGGL(enc_fwd, dim3(grid), dim3(512), LDS_BYTES, stream, a); }
#endif
    const hipError_t le = hipPeekAtLastError();
    if (le != hipSuccess) fprintf(stderr, "kernel_launch: launch failed: %s\n", hipGetErrorName(le));
}
```

```cpp
#include <hip/hip_runtime.h>
#include <cstdio>
#include <cstdint>
#include <cstring>

#define GAS __attribute__((address_space(1)))
#define LAS __attribute__((address_space(3)))
typedef unsigned short bf16;
typedef short bf16x8 __attribute__((ext_vector_type(8)));
typedef short s16x4 __attribute__((ext_vector_type(4)));
typedef float f32x2 __attribute__((ext_vector_type(2)));
typedef float f32x4 __attribute__((ext_vector_type(4)));
typedef float f32x16 __attribute__((ext_vector_type(16)));
typedef unsigned u32x2 __attribute__((ext_vector_type(2)));
typedef unsigned u32x4 __attribute__((ext_vector_type(4)));
typedef GAS unsigned gu32;

constexpr int DM = 2048, BATCH = 2, SEQ = 4096, NTOK = BATCH * SEQ, DEPTH = 2, NMEM = 256;
constexpr int IN_A = 1536, IN_B = 1920, IN_C = 1536, IN_D = 512, IN_TOTAL = 5504, ZLD = 5632;
constexpr int ZA = 0, ZB = 1536, ZC = 3456, ZD = 4992;
constexpr int NEXP = 32, DEXP = 512, ECAP = 8192;
constexpr int SLOT_CAP = 24576;
constexpr int S5CH = 16, S5NCH = SEQ / S5CH;
constexpr float RMS_EPS = 1e-6f;

enum { I_X = 0, I_MEM, I_NORM_MIX, I_W_IN, I_W_OUT, I_DIFF_LAMBDA, I_DIFF_SUBLN, I_RWKV_MU, I_RWKV_W0, I_RWKV_W2, I_RWKV_A0, I_RWKV_A2, I_RWKV_G2,
       I_RWKV_KK, I_RWKV_KA, I_RWKV_RK, I_RWKV_LNX_W, I_RWKV_LNX_B, I_S5_A_RE, I_S5_A_IM, I_S5_LOG_DT, I_S5_B_RE, I_S5_B_IM, I_S5_C_RE, I_S5_C_IM,
       I_S5_D, I_S5_GLU_W, I_S5_GLU_B, I_MIX_OUT_NORM, I_NORM_CROSS, I_NORM_MEM, I_XA_WQ, I_XA_WKV, I_XA_WO, I_NORM_MOE, I_ROUTER_GROUP,
       I_ROUTER_EXPERT, I_MOE_W1, I_MOE_W3, I_MOE_W2, I_NORM_FINAL, N_INPUTS };

constexpr size_t al256(size_t x) { return (x + 255) / 256 * 256; }
constexpr size_t WS_CTL = 0, CTL_BYTES = 1u << 20;
constexpr size_t WS_WIN  = WS_CTL + CTL_BYTES;
constexpr size_t WS_WOUT = WS_WIN + (size_t)DEPTH * ZLD * DM * 2;
constexpr size_t WS_WQK  = WS_WOUT + (size_t)DEPTH * DM * DM * 2;
constexpr size_t WS_VWO  = WS_WQK + (size_t)DEPTH * BATCH * 1024 * DM * 2;
constexpr size_t WS_W13  = WS_VWO + (size_t)DEPTH * BATCH * DM * 1024 * 2;
constexpr size_t WS_W2   = WS_W13 + (size_t)DEPTH * NEXP * 1024 * DM * 2;
constexpr size_t WS_ROPE = WS_W2 + (size_t)DEPTH * NEXP * DM * DEXP * 2;
constexpr size_t WS_S5P  = WS_ROPE + (size_t)SEQ * (32 + 32 + 64 + 64) * 4;
constexpr size_t S5P_LAYER = (size_t)(2 * 32 * 64 * 2 + 2 * 32 * 64 * 16 * 2 + 2 * 32 * 64 * 2) * 4;
constexpr size_t WS_LORA = al256(WS_S5P + DEPTH * S5P_LAYER);
constexpr size_t LORA_LAYER = (size_t)(2 * 512 * 64 * 2 + 512 * 128) * 2;
constexpr size_t WS_H    = al256(WS_LORA + DEPTH * LORA_LAYER);
constexpr size_t WS_HN   = WS_H + (size_t)NTOK * DM * 4;
constexpr size_t WS_MIX  = WS_HN + (size_t)NTOK * DM * 2;
constexpr size_t WS_P    = WS_MIX + (size_t)NTOK * DM * 2;
constexpr size_t WS_ETOK = WS_P + (size_t)NTOK * 1024 * 2;
constexpr size_t WS_EGATE= WS_ETOK + (size_t)NEXP * ECAP * 4;
constexpr size_t WS_TINFO= WS_EGATE + (size_t)NEXP * ECAP * 4;
constexpr size_t WS_SCR  = al256(WS_TINFO + (size_t)NTOK * 16);
constexpr size_t SC_WKVT = WS_SCR;
constexpr size_t SC_MEMN = SC_WKVT + (size_t)DEPTH * 4096 * DM * 2;
constexpr size_t SC_KVB  = SC_MEMN + (size_t)DEPTH * 512 * DM * 2;
constexpr size_t SC_WQB  = SC_KVB + (size_t)DEPTH * 512 * 4096 * 2;
constexpr size_t SC_WOT  = SC_WQB + (size_t)DEPTH * DM * DM * 2;
constexpr size_t SC_PRO_END = SC_WOT + (size_t)DEPTH * DM * DM * 2;
constexpr size_t SC_Z    = WS_SCR;
constexpr size_t SC_RW   = SC_Z + (size_t)NTOK * ZLD * 2;
constexpr size_t RWSZ    = (size_t)NTOK * 512 * 4;
constexpr size_t SC_YS   = SC_RW + 10 * RWSZ;
constexpr size_t SC_OC   = SC_YS + 2 * RWSZ;
constexpr size_t SC_LSE  = SC_OC + 3 * RWSZ;
constexpr size_t SC_CARRY= SC_LSE + (size_t)3 * NTOK * 4 * 4;
constexpr size_t SC_MIX_END = SC_CARRY + (size_t)2 * BATCH * S5NCH * 32 * 64 * 2 * 4;
constexpr size_t SC_HMID = WS_SCR;
constexpr size_t SC_YBUF = SC_HMID + (size_t)SLOT_CAP * DEXP * 2;
constexpr size_t SC_MOE_END = SC_YBUF + (size_t)SLOT_CAP * DM * 2;
constexpr size_t cmax(size_t a, size_t b) { return a > b ? a : b; }
constexpr size_t WS_END = cmax(cmax(SC_PRO_END, SC_MIX_END), SC_MOE_END);

constexpr int CW_BAR = 4096;
constexpr int CW_Q = 8192;
constexpr int CW_CNT = 16384;

constexpr int RING_BYTES = 131072;
constexpr int MISC_OFF = 147456 - 1024;
constexpr int LDS_BYTES = 147456;

__device__ __forceinline__ float bf2f(unsigned short b) { return __uint_as_float(((unsigned)b) << 16); }
typedef __bf16 bf16x2_t __attribute__((ext_vector_type(2)));
__device__ __forceinline__ unsigned pk2c(float lo, float hi) { bf16x2_t v = {(__bf16)lo, (__bf16)hi}; return __builtin_bit_cast(unsigned, v); }
__device__ __forceinline__ unsigned pk2(float lo, float hi) { unsigned r; asm volatile("v_cvt_pk_bf16_f32 %0, %1, %2" : "=v"(r) : "v"(lo), "v"(hi)); return r; }
__device__ __forceinline__ bf16 f2bf(float f) { return (bf16)(pk2(f, 0.f) & 0xffffu); }
template <int CTRL> __device__ __forceinline__ float dpp_mov(float v) { return __builtin_bit_cast(float, __builtin_amdgcn_update_dpp(0, __builtin_bit_cast(int, v), CTRL, 0xf, 0xf, true)); }
__device__ __forceinline__ float row_sum(float v) { v += dpp_mov<0xB1>(v); v += dpp_mov<0x4E>(v); v += dpp_mov<0x141>(v); v += dpp_mov<0x140>(v); return v; }
__device__ __forceinline__ float row_max(float v) { v = fmaxf(v, dpp_mov<0xB1>(v)); v = fmaxf(v, dpp_mov<0x4E>(v)); v = fmaxf(v, dpp_mov<0x141>(v)); v = fmaxf(v, dpp_mov<0x140>(v)); return v; }
__device__ __forceinline__ float rdlane(float v, int l) { return __builtin_bit_cast(float, __builtin_amdgcn_readlane(__builtin_bit_cast(int, v), l)); }
__device__ __forceinline__ float wave_sum(float v) { v = row_sum(v); return (rdlane(v, 0) + rdlane(v, 16)) + (rdlane(v, 32) + rdlane(v, 48)); }
__device__ __forceinline__ float wave_max(float v) { v = row_max(v); return fmaxf(fmaxf(rdlane(v, 0), rdlane(v, 16)), fmaxf(rdlane(v, 32), rdlane(v, 48))); }
__device__ __forceinline__ float sigmoidf_(float x) { return 1.f / (1.f + __expf(-x)); }
#define LDS_WAIT() asm volatile("s_waitcnt lgkmcnt(0)" ::: "memory")
#define VM_WAIT() asm volatile("s_waitcnt vmcnt(0)" ::: "memory")

__device__ __forceinline__ int tid_from_wave(int wave) { int ln; asm volatile("v_mbcnt_lo_u32_b32 %0, -1, 0\n\tv_mbcnt_hi_u32_b32 %0, -1, %0" : "=v"(ln)); return wave * 64 + ln; }

typedef __attribute__((address_space(8))) void* bufrsrc_t;
__device__ __forceinline__ __amdgpu_buffer_rsrc_t make_rsrc(const void* p, unsigned bytes) { return __builtin_amdgcn_make_buffer_rsrc((void*)p, 0, bytes, 0x00020000); }
__device__ __forceinline__ float bload_f32(__amdgpu_buffer_rsrc_t r, int voff, int soff) { return __builtin_bit_cast(float, __builtin_amdgcn_raw_buffer_load_b32(r, voff, soff, 0)); }

__device__ __forceinline__ float xor_lane(float v, int lane, int m) { return __builtin_bit_cast(float, __builtin_amdgcn_ds_bpermute((lane ^ m) << 2, __builtin_bit_cast(int, v))); }
#define XB_TMO      128
#define XB_XCNT(j)  (256  + 64 * (j))
#define XB_XSUB(j)  (1280 + 64 * (j))
#define XB_XGEN(j)  (2304 + 64 * (j))
#define XB_TOP      3328
#define XB_TOPGEN   3392
#define XCD_BAR_WORDS 3456
#define XB_SPIN_CAP (1u << 18)

__device__ __forceinline__ unsigned xb_ld(unsigned* p)              { return __hip_atomic_load(p, __ATOMIC_RELAXED, __HIP_MEMORY_SCOPE_AGENT); }
__device__ __forceinline__ unsigned xb_add(unsigned* p, unsigned v) { return __hip_atomic_fetch_add(p, v, __ATOMIC_RELAXED, __HIP_MEMORY_SCOPE_AGENT); }
__device__ __forceinline__ unsigned xb_xcc_id() { return (unsigned)__builtin_amdgcn_s_getreg((3 << 11) | 20) & 0xFu; }
#define XB_SPIN(cond, bar) do { unsigned _sp = 0; while (cond) { __builtin_amdgcn_s_sleep(1); \
    if ((++_sp & 255u) == 0u) { if (xb_ld(&(bar)[XB_TMO])) break; if (_sp > XB_SPIN_CAP) { atomicAdd(&(bar)[XB_TMO], 1u); break; } } } } while (0)

struct XcdBarrier {
    unsigned* bar; unsigned x;
    volatile LAS unsigned* st;
};

__device__ __forceinline__ XcdBarrier xcd_barrier_post(unsigned* bar, volatile LAS unsigned* st) {
    XcdBarrier b; b.bar = bar; b.x = xb_xcc_id(); b.st = st;
    if (threadIdx.x == 0) (void)xb_add(&bar[XB_XCNT(b.x)], 1u);
    return b;
}
__device__ __forceinline__ void xcd_barrier_complete(unsigned* bar, unsigned x, unsigned& nloc, unsigned& nx) {
    const unsigned G = gridDim.x * gridDim.y * gridDim.z;
    unsigned sum, cnt, mine, sp = 0u;
    for (;;) {
        sum = 0u; cnt = 0u; mine = 0u;
#pragma unroll
        for (unsigned j = 0; j < 16; ++j) { const unsigned c = xb_ld(&bar[XB_XCNT(j)]); sum += c; cnt += (c > 0u) ? 1u : 0u; mine = (j == x) ? c : mine; }
        if (sum == G) break;
        __builtin_amdgcn_s_sleep(1);
        if ((++sp & 255u) == 0u) { if (xb_ld(&bar[XB_TMO])) break; if (sp > XB_SPIN_CAP) { atomicAdd(&bar[XB_TMO], 1u); break; } }
    }
    nloc = mine > 0u ? mine : 1u; nx = cnt > 0u ? cnt : 1u;
}

__device__ __forceinline__ void xcd_barrier(const XcdBarrier& b) {
    asm volatile("s_waitcnt vmcnt(0)" ::: "memory");
    __syncthreads();
    if (threadIdx.x == 0) {
        unsigned* bar = b.bar;
        __builtin_amdgcn_s_waitcnt(0);
        unsigned nloc = b.st[0], nx = b.st[1];
        if (nloc == 0u) { xcd_barrier_complete(bar, b.x, nloc, nx); b.st[0] = nloc; b.st[1] = nx; }
        const unsigned old = xb_add(&bar[XB_XSUB(b.x)], 1u);
        const unsigned gen = old / nloc;
        if (old + 1u == (gen + 1u) * nloc) {
            __builtin_amdgcn_fence(__ATOMIC_RELEASE, "agent");
            asm volatile("s_waitcnt vmcnt(0)" ::: "memory");
            const unsigned og = xb_add(&bar[XB_TOP], 1u);
            const unsigned tg = og / nx;
            if (og + 1u == (tg + 1u) * nx) xb_add(&bar[XB_TOPGEN], 1u);
            else XB_SPIN(xb_ld(&bar[XB_TOPGEN]) == tg, bar);
            __builtin_amdgcn_fence(__ATOMIC_ACQUIRE, "agent");
            xb_add(&bar[XB_XGEN(b.x)], 1u);
            asm volatile("s_waitcnt vmcnt(0)" ::: "memory");
        } else {
            XB_SPIN(xb_ld(&bar[XB_XGEN(b.x)]) == gen, bar);
            __builtin_amdgcn_fence(__ATOMIC_ACQUIRE, "agent");
            asm volatile("s_waitcnt vmcnt(0)" ::: "memory");
        }
    }
    __syncthreads();
}


namespace pg8 {
constexpr int BM = 256, BK = 64, HALF = 128, HTB = HALF * BK * 2, STAGE_BYTES = 8 * HTB, NXCD = 8, WGM = 8;
__host__ __device__ __forceinline__ int lds_byte(int r, int c) { const int st = (r >> 4) * 2 + (c >> 5), rr = r & 15, cc = c & 31, ob = rr * 64 + cc * 2; return st * 1024 + (ob ^ (((ob >> 9) & 1) << 5)); }
__host__ __device__ __forceinline__ void stage_rc(int b, int& R, int& C) { const int st = b / 1024, sb = b % 1024, swz = sb ^ (((sb >> 9) & 1) << 5); R = (st >> 1) * 16 + swz / 64; C = (st & 1) * 32 + (swz % 64) / 2; }
__host__ __device__ __forceinline__ int perm32(int rho) { const int n = rho >> 4, i = rho & 15; return 8 * (i >> 2) + 4 * n + (i & 3); }

struct Unit { const char* A; const char* B; char* C; int row0, col0, aux; };
struct GemmP { int K, lda, ldb; };

__device__ __forceinline__ void xcd_tile(int L, int nM, int nN, int& pm, int& pn) {
    const int nwg = nM * nN; int wgid = L;
    { const int q = nwg / NXCD, r = nwg % NXCD, xcd = wgid % NXCD, off = wgid / NXCD; wgid = (xcd < r ? xcd * (q + 1) : r * (q + 1) + (xcd - r) * q) + off; }
    const int nig = WGM * nN, gid = wgid / nig, fm = gid * WGM, gsz = (nM - fm) < WGM ? (nM - fm) : WGM;
    pm = fm + ((wgid % nig) % gsz); pn = (wgid % nig) / gsz;
}

typedef f32x4 Acc[2][2][4][2];

template <class Epi, class Sched, bool GATHER>
__device__ __forceinline__ void gemm_phase(LAS unsigned char* lds, const GemmP g, const Sched& S, const Epi& E, const int wave_id) {
    const int tid = tid_from_wave(wave_id), wid = __builtin_amdgcn_readfirstlane(tid >> 6), lane = tid & 63, wr = wid >> 2, wc = wid & 3, fr = lane & 15, fq = lane >> 4;
    const int K = g.K, nt = K / BK;
    int Rr[2], Cc[2]; unsigned voffB[2];
#pragma unroll
    for (int i = 0; i < 2; ++i) { int R, C; stage_rc(tid * 16 + i * 8192, R, C); const int Rb = Epi::PERM ? ((R & ~31) + perm32(R & 31)) : R;
        Rr[i] = R; Cc[i] = C; voffB[i] = (unsigned)(Rb * g.ldb + C) * 2u; }
    const size_t kstep = (size_t)(BK * 2);
    const size_t hstepB = (size_t)HALF * g.ldb * 2;
    const unsigned ldsw = (unsigned)wid * 1024u;
    const int aoff = lds_byte(wr * 64 + fr, fq * 8), boff = lds_byte(wc * 32 + fr, fq * 8);
#define PG8_SA(b, h) (((b) * 2 + (h)) * HTB)
#define PG8_SB(b, h) ((4 + (b) * 2 + (h)) * HTB)
#define PG8_STAGE_B(bufoff, gbase) do { _Pragma("unroll") for (int _i = 0; _i < 2; ++_i) \
        __builtin_amdgcn_global_load_lds((const unsigned*)((const char*)(gbase) + voffB[_i]), (LAS unsigned*)(lds + (bufoff) + ldsw + _i * 8192), 16, 0, 0); } while (0)
#define PG8_STAGE_A(bufoff, gbase, OFF, h) do { _Pragma("unroll") for (int _i = 0; _i < 2; ++_i) \
        __builtin_amdgcn_global_load_lds((const unsigned*)((const char*)(gbase) + (OFF)[h][_i]), (LAS unsigned*)(lds + (bufoff) + ldsw + _i * 8192), 16, 0, 0); } while (0)
#define PG8_OFFS(u, OFF) do { _Pragma("unroll") for (int _h = 0; _h < 2; ++_h) _Pragma("unroll") for (int _i = 0; _i < 2; ++_i) { \
        const int _row = _h * HALF + Rr[_i]; const int _src = GATHER ? S.arow((u), _row) : _row; (OFF)[_h][_i] = (unsigned)(_src * g.lda + Cc[_i]) * 2u; } } while (0)
#define PG8_LDA(dst, b, h) do { _Pragma("unroll") for (int m = 0; m < 4; ++m) _Pragma("unroll") for (int k = 0; k < 2; ++k) dst[m][k] = *(const LAS bf16x8*)(lds + PG8_SA(b, h) + aoff + m * 2048 + k * 1024); } while (0)
#define PG8_LDB(dst, b, h) do { _Pragma("unroll") for (int n = 0; n < 2; ++n) _Pragma("unroll") for (int k = 0; k < 2; ++k) dst[n][k] = *(const LAS bf16x8*)(lds + PG8_SB(b, h) + boff + n * 2048 + k * 1024); } while (0)
#define PG8_MMA(ai, bj, At, Bt) do { __builtin_amdgcn_s_setprio(1); _Pragma("unroll") for (int m = 0; m < 4; ++m) _Pragma("unroll") for (int n = 0; n < 2; ++n) _Pragma("unroll") for (int k = 0; k < 2; ++k) \
        acc[ai][bj][m][n] = __builtin_amdgcn_mfma_f32_16x16x32_bf16(Bt[n][k], At[m][k], acc[ai][bj][m][n], 0, 0, 0); __builtin_amdgcn_s_setprio(0); } while (0)
#define PG8_WAIT_V(n) asm volatile("s_waitcnt vmcnt(" #n ")" ::: "memory")
#define PG8_WAIT_L(n) asm volatile("s_waitcnt lgkmcnt(" #n ")" ::: "memory")
#define PG8_BAR __builtin_amdgcn_s_barrier()
#define PG8_SCHED __builtin_amdgcn_sched_barrier(0)
    Unit cur, nxt; int ui = 0;
    if (!S.next(0, cur)) return;
    f32x4 acc[2][2][4][2];
#pragma unroll
    for (int a = 0; a < 2; ++a)
#pragma unroll
        for (int b = 0; b < 2; ++b)
#pragma unroll
            for (int m = 0; m < 4; ++m)
#pragma unroll
                for (int n = 0; n < 2; ++n) acc[a][b][m][n] = (f32x4){0.f, 0.f, 0.f, 0.f};
    bf16x8 At[4][2], B0[2][2], B1[2][2];
    const char* cA = cur.A; const char* cB = cur.B;
    unsigned coffA[2][2], noffA[2][2];
    PG8_OFFS(cur, coffA);
    PG8_STAGE_B(PG8_SB(0, 0), cB); PG8_STAGE_A(PG8_SA(0, 0), cA, coffA, 0); PG8_STAGE_B(PG8_SB(0, 1), cB + hstepB); PG8_STAGE_A(PG8_SA(0, 1), cA, coffA, 1);
    if (wr == 1) PG8_BAR;
    PG8_WAIT_V(4); PG8_BAR;
    PG8_STAGE_B(PG8_SB(1, 0), cB + kstep); PG8_STAGE_A(PG8_SA(1, 0), cA + kstep, coffA, 0); PG8_STAGE_B(PG8_SB(1, 1), cB + hstepB + kstep);
    PG8_WAIT_V(6); PG8_BAR;
    for (;;) {
        const bool has_next = S.next(ui + 1, nxt);
        const char* nA = has_next ? nxt.A : cA; const char* nB = has_next ? nxt.B : cB;
        if (has_next) { PG8_OFFS(nxt, noffA); }
        else {
#pragma unroll
            for (int _h = 0; _h < 2; ++_h)
#pragma unroll
                for (int _i = 0; _i < 2; ++_i) noffA[_h][_i] = coffA[_h][_i]; }
        for (int t = 0; t < nt; t += 2) {
            const bool last = (t == nt - 2);
            const char* a1 = cA + (size_t)(t + 1) * kstep;
            const char* a2 = last ? nA : cA + (size_t)(t + 2) * kstep; const char* b2 = last ? nB : cB + (size_t)(t + 2) * kstep;
            const char* a3 = a2 + kstep; const char* b3 = b2 + kstep;
            unsigned o2[2][2];
#pragma unroll
            for (int _h = 0; _h < 2; ++_h)
#pragma unroll
                for (int _i = 0; _i < 2; ++_i) o2[_h][_i] = last ? noffA[_h][_i] : coffA[_h][_i];
            PG8_LDB(B0, 0, 0); PG8_SCHED; PG8_LDA(At, 0, 0); PG8_STAGE_A(PG8_SA(1, 1), a1, coffA, 1);
            PG8_WAIT_L(8); PG8_BAR; PG8_WAIT_L(0); PG8_MMA(0, 0, At, B0); PG8_BAR; PG8_SCHED;
            PG8_LDB(B1, 0, 1); PG8_STAGE_B(PG8_SB(0, 0), b2);
            PG8_BAR; PG8_WAIT_L(0); PG8_MMA(0, 1, At, B1); PG8_BAR;
            PG8_LDA(At, 0, 1); PG8_STAGE_A(PG8_SA(0, 0), a2, o2, 0);
            PG8_BAR; PG8_WAIT_L(0); PG8_MMA(1, 0, At, B0); PG8_BAR; PG8_SCHED;
            PG8_STAGE_B(PG8_SB(0, 1), b2 + hstepB);
            PG8_WAIT_V(6); PG8_BAR; PG8_MMA(1, 1, At, B1); PG8_BAR;
            PG8_LDB(B0, 1, 0); PG8_SCHED; PG8_LDA(At, 1, 0); PG8_STAGE_A(PG8_SA(0, 1), a2, o2, 1);
            PG8_WAIT_L(8); PG8_BAR; PG8_WAIT_L(0); PG8_MMA(0, 0, At, B0); PG8_BAR; PG8_SCHED;
            PG8_LDB(B1, 1, 1); PG8_STAGE_B(PG8_SB(1, 0), b3);
            PG8_BAR; PG8_WAIT_L(0); PG8_MMA(0, 1, At, B1); PG8_BAR;
            PG8_LDA(At, 1, 1); PG8_STAGE_A(PG8_SA(1, 0), a3, o2, 0);
            PG8_BAR; PG8_WAIT_L(0); PG8_MMA(1, 0, At, B0); PG8_BAR; PG8_SCHED;
            PG8_STAGE_B(PG8_SB(1, 1), b3 + hstepB);
            PG8_WAIT_V(6); PG8_BAR; PG8_MMA(1, 1, At, B1); PG8_BAR;
        }
        if constexpr (!Epi::AFTER_DRAIN) { E(acc, cur, wr, wc, fr, fq); }
        if (!has_next) break;
#pragma unroll
        for (int a = 0; a < 2; ++a)
#pragma unroll
            for (int b = 0; b < 2; ++b)
#pragma unroll
                for (int m = 0; m < 4; ++m)
#pragma unroll
                    for (int n = 0; n < 2; ++n) acc[a][b][m][n] = (f32x4){0.f, 0.f, 0.f, 0.f};
        cur = nxt; cA = nA; cB = nB; ++ui;
#pragma unroll
        for (int _h = 0; _h < 2; ++_h)
#pragma unroll
            for (int _i = 0; _i < 2; ++_i) coffA[_h][_i] = noffA[_h][_i];
    }
    PG8_WAIT_V(0);
    if (wr == 0) PG8_BAR;
    PG8_BAR;
    if constexpr (Epi::AFTER_DRAIN) { E.fused(acc, cur, wr, wc, fr, fq, lds, wid, lane); }
#undef PG8_SA
#undef PG8_SB
#undef PG8_STAGE_A
#undef PG8_STAGE_B
#undef PG8_OFFS
#undef PG8_LDA
#undef PG8_LDB
#undef PG8_MMA
#undef PG8_WAIT_V
#undef PG8_WAIT_L
#undef PG8_BAR
#undef PG8_SCHED
}

struct EpiBf16 {
    static constexpr bool PERM = true, AFTER_DRAIN = false;
    int ldc;
    __device__ __forceinline__ void operator()(const Acc& acc, const Unit& u, int wr, int wc, int fr, int fq) const {
        bf16* base = (bf16*)u.C + (size_t)(wr * 64 + fr) * ldc + wc * 32 + 8 * fq;
#pragma unroll
        for (int ai = 0; ai < 2; ++ai)
#pragma unroll
            for (int m = 0; m < 4; ++m) { bf16* rowp = base + (size_t)(ai * HALF + m * 16) * ldc;
#pragma unroll
                for (int bj = 0; bj < 2; ++bj) { const f32x4 v0 = acc[ai][bj][m][0], v1 = acc[ai][bj][m][1];
                    u32x4 w; w.x = pk2(v0[0], v0[1]); w.y = pk2(v0[2], v0[3]); w.z = pk2(v1[0], v1[1]); w.w = pk2(v1[2], v1[3]);
                    *(u32x4*)(rowp + bj * HALF) = w; } }
    }
};
struct EpiF32Res {
    static constexpr bool PERM = false, AFTER_DRAIN = false;
    int ldc; const float* resid; float* out;
    __device__ __forceinline__ void operator()(const Acc& acc, const Unit& u, int wr, int wc, int fr, int fq) const {
        const size_t o0 = (size_t)(u.row0 + wr * 64 + fr) * ldc + u.col0 + wc * 32 + 4 * fq;
#pragma unroll
        for (int ai = 0; ai < 2; ++ai)
#pragma unroll
            for (int m = 0; m < 4; ++m) { const size_t ro = o0 + (size_t)(ai * HALF + m * 16) * ldc;
#pragma unroll
                for (int bj = 0; bj < 2; ++bj)
#pragma unroll
                    for (int n = 0; n < 2; ++n) { const size_t o = ro + bj * HALF + n * 16; const f32x4 b = *(const f32x4*)(resid + o); *(f32x4*)(out + o) = acc[ai][bj][m][n] + b; } }
    }
};
struct EpiSwiGlu {
    static constexpr bool PERM = true, AFTER_DRAIN = false;
    int ldc;
    __device__ __forceinline__ void operator()(const Acc& acc, const Unit& u, int wr, int wc, int fr, int fq) const {
        bf16* base = (bf16*)u.C + (size_t)(wr * 64 + fr) * ldc + wc * 32 + 8 * fq;
#pragma unroll
        for (int ai = 0; ai < 2; ++ai)
#pragma unroll
            for (int m = 0; m < 4; ++m) { bf16* rowp = base + (size_t)(ai * HALF + m * 16) * ldc;
                float h[8];
#pragma unroll
                for (int n = 0; n < 2; ++n)
#pragma unroll
                    for (int e = 0; e < 4; ++e) { const float a = acc[ai][0][m][n][e], b = acc[ai][1][m][n][e]; h[n * 4 + e] = a / (1.f + __expf(-a)) * b; }
                u32x4 w; w.x = pk2(h[0], h[1]); w.y = pk2(h[2], h[3]); w.z = pk2(h[4], h[5]); w.w = pk2(h[6], h[7]);
                *(u32x4*)rowp = w; }
    }
};
struct EpiGate {
    static constexpr bool PERM = true, AFTER_DRAIN = false;
    int ldc; const float* egate; const int* cnt_lds_unused;
    __device__ __forceinline__ void operator()(const Acc& acc, const Unit& u, int wr, int wc, int fr, int fq) const {
        bf16* base = (bf16*)u.C + (size_t)(wr * 64 + fr) * ldc + wc * 32 + 8 * fq;
        const int e = u.aux >> 16, nvalid = u.aux & 0xffff;
        const float* gp = egate + (size_t)e * ECAP + u.row0;
#pragma unroll
        for (int ai = 0; ai < 2; ++ai)
#pragma unroll
            for (int m = 0; m < 4; ++m) { const int r = ai * HALF + wr * 64 + m * 16 + fr; const float gt = (r < nvalid) ? gp[r] : 0.f;
                bf16* rowp = base + (size_t)(ai * HALF + m * 16) * ldc;
#pragma unroll
                for (int bj = 0; bj < 2; ++bj) { const f32x4 v0 = acc[ai][bj][m][0] * gt, v1 = acc[ai][bj][m][1] * gt;
                    u32x4 w; w.x = pk2(v0[0], v0[1]); w.y = pk2(v0[2], v0[3]); w.z = pk2(v1[0], v1[1]); w.w = pk2(v1[2], v1[3]);
                    *(u32x4*)(rowp + bj * HALF) = w; } }
    }
};
struct EpiSoftmax {
    static constexpr bool PERM = true, AFTER_DRAIN = true;
    int ldc; float scale_log2e;
    __device__ __forceinline__ void operator()(const Acc&, const Unit&, int, int, int, int) const {}
    __device__ __forceinline__ void fused(const Acc& acc, const Unit& u, int wr, int wc, int fr, int fq, LAS unsigned char* lds, int wid, int lane) const {
        LAS float* RM = (LAS float*)lds;
        LAS float* RS = (LAS float*)(lds + 4096);
        float mx[2][4];
#pragma unroll
        for (int ai = 0; ai < 2; ++ai)
#pragma unroll
            for (int m = 0; m < 4; ++m) { float v = -3.0e38f;
#pragma unroll
                for (int bj = 0; bj < 2; ++bj)
#pragma unroll
                    for (int n = 0; n < 2; ++n) { const f32x4 x = acc[ai][bj][m][n]; v = fmaxf(v, fmaxf(fmaxf(x[0], x[1]), fmaxf(x[2], x[3]))); }
                v = fmaxf(v, xor_lane(v, lane, 16)); v = fmaxf(v, xor_lane(v, lane, 32));
                if (fq == 0) RM[(ai * HALF + wr * 64 + m * 16 + fr) * 4 + wc] = v; }
        asm volatile("s_waitcnt lgkmcnt(0)" ::: "memory"); __builtin_amdgcn_s_barrier(); asm volatile("" ::: "memory");
#pragma unroll
        for (int ai = 0; ai < 2; ++ai)
#pragma unroll
            for (int m = 0; m < 4; ++m) { const int row = ai * HALF + wr * 64 + m * 16 + fr; const f32x4 q = *(const LAS f32x4*)(RM + row * 4);
                const float M = fmaxf(fmaxf(q[0], q[1]), fmaxf(q[2], q[3])); const float mc = -M * scale_log2e; float s = 0.f;
#pragma unroll
                for (int bj = 0; bj < 2; ++bj)
#pragma unroll
                    for (int n = 0; n < 2; ++n)
#pragma unroll
                        for (int e = 0; e < 4; ++e) s += __builtin_amdgcn_exp2f(fmaf(acc[ai][bj][m][n][e], scale_log2e, mc));
                s += xor_lane(s, lane, 16); s += xor_lane(s, lane, 32);
                if (fq == 0) RS[row * 4 + wc] = s; }
        asm volatile("s_waitcnt lgkmcnt(0)" ::: "memory"); __builtin_amdgcn_s_barrier(); asm volatile("" ::: "memory");
        bf16* base = (bf16*)u.C + (size_t)(wr * 64 + fr) * ldc + wc * 32 + 8 * fq;
#pragma unroll
        for (int ai = 0; ai < 2; ++ai)
#pragma unroll
            for (int m = 0; m < 4; ++m) { const int row = ai * HALF + wr * 64 + m * 16 + fr; const f32x4 q = *(const LAS f32x4*)(RS + row * 4); const f32x4 qm = *(const LAS f32x4*)(RM + row * 4);
                const float M = fmaxf(fmaxf(qm[0], qm[1]), fmaxf(qm[2], qm[3])); const float mc = -M * scale_log2e;
                const float inv = 1.f / ((q[0] + q[1]) + (q[2] + q[3])); bf16* rowp = base + (size_t)(ai * HALF + m * 16) * ldc;
#pragma unroll
                for (int bj = 0; bj < 2; ++bj) { float pp[8];
#pragma unroll
                    for (int n = 0; n < 2; ++n)
#pragma unroll
                        for (int e = 0; e < 4; ++e) pp[n * 4 + e] = __builtin_amdgcn_exp2f(fmaf(acc[ai][bj][m][n][e], scale_log2e, mc)) * inv;
                    u32x4 w; w.x = pk2(pp[0], pp[1]); w.y = pk2(pp[2], pp[3]); w.z = pk2(pp[4], pp[5]); w.w = pk2(pp[6], pp[7]);
                    *(u32x4*)(rowp + bj * HALF) = w; } }
        asm volatile("s_waitcnt lgkmcnt(0)" ::: "memory"); __builtin_amdgcn_s_barrier(); asm volatile("" ::: "memory");
    }
};
}

namespace att {
constexpr int KVBLK = 64;
constexpr size_t SHM_V = KVBLK * 128 * 2, SHM_K = KVBLK * 128 * 2;
#define KSWZ(row, colB) ((row) * 256 + ((colB) ^ (((row) & 7) << 4)))
#define SBAR() __builtin_amdgcn_sched_barrier(0)
__device__ __forceinline__ int crow(int r, int hi) { return (r & 3) + 8 * (r >> 2) + 4 * hi; }
__device__ __forceinline__ bf16x8 ld8(const bf16* p) { return *reinterpret_cast<const bf16x8*>(p); }

__device__ __forceinline__ void partialSM(f32x16& p0, f32x16& p1, float& m_reg, float& mn, float& alpha, const float SCALE, const float THR) {
  const float C = SCALE * 1.4426950408889634f;
  float pmax = p0[0];
#pragma unroll
  for (int r = 1; r < 16; ++r) pmax = fmaxf(pmax, p0[r]);
#pragma unroll
  for (int r = 0; r < 16; ++r) pmax = fmaxf(pmax, p1[r]);
  { auto rr = __builtin_amdgcn_permlane32_swap(__float_as_uint(pmax), __float_as_uint(pmax), false, false);
    pmax = fmaxf(__uint_as_float(rr[0]), __uint_as_float(rr[1])); }
  if (__builtin_expect(__all(pmax - m_reg <= THR / SCALE), 1)) { mn = m_reg; alpha = 1.f; }
  else { mn = fmaxf(m_reg, pmax); alpha = __builtin_amdgcn_exp2f((m_reg - mn) * C); m_reg = mn; }
  const float mnC = -mn * C;
#pragma unroll
  for (int r = 0; r < 16; ++r) p0[r] = fmaf(p0[r], C, mnC);
#pragma unroll
  for (int r = 0; r < 16; ++r) p1[r] = fmaf(p1[r], C, mnC);
#pragma unroll
  for (int r = 0; r < 16; ++r) p0[r] = __builtin_amdgcn_exp2f(p0[r]);
}
__device__ __forceinline__ void finishSM(f32x16& p0, f32x16& p1, float alpha, float& l_reg, bf16x8& pa0, bf16x8& pa1, bf16x8& pa2, bf16x8& pa3) {
#pragma unroll
  for (int r = 0; r < 16; ++r) p1[r] = __builtin_amdgcn_exp2f(p1[r]);
  float ps = 0;
#pragma unroll
  for (int r = 0; r < 16; ++r) ps += p0[r];
#pragma unroll
  for (int r = 0; r < 16; ++r) ps += p1[r];
  { auto rr = __builtin_amdgcn_permlane32_swap(__float_as_uint(ps), __float_as_uint(ps), false, false);
    ps = __uint_as_float(rr[0]) + __uint_as_float(rr[1]); }
  l_reg = l_reg * alpha + ps;
#define PK4(P, BASE, OUT) do { unsigned a0 = pk2(P[BASE + 0], P[BASE + 1]), a1 = pk2(P[BASE + 2], P[BASE + 3]);   \
    unsigned b0 = pk2(P[BASE + 4], P[BASE + 5]), b1 = pk2(P[BASE + 6], P[BASE + 7]);                              \
    auto r0 = __builtin_amdgcn_permlane32_swap(a0, b0, false, false); auto r1 = __builtin_amdgcn_permlane32_swap(a1, b1, false, false); \
    u32x4 w = {r0[0], r1[0], r0[1], r1[1]}; OUT = *reinterpret_cast<bf16x8*>(&w); } while (0)
  PK4(p0, 0, pa0); PK4(p0, 8, pa1); PK4(p1, 0, pa2); PK4(p1, 8, pa3);
#undef PK4
}
template <int ND0> __device__ __forceinline__ void qkt(f32x16& p0, f32x16& p1, const char* Ks, const bf16x8* qr, int r32, int hi, int c0) {
  p0 = f32x16{}; p1 = f32x16{};
#pragma unroll
  for (int d0 = 0; d0 < ND0; ++d0) { const int cb = (c0 + d0 * 16 + hi * 8) * 2;
    const bf16x8 b0 = *reinterpret_cast<const bf16x8*>(Ks + KSWZ(r32, cb));
    const bf16x8 b1 = *reinterpret_cast<const bf16x8*>(Ks + KSWZ(32 + r32, cb));
    p0 = __builtin_amdgcn_mfma_f32_32x32x16_bf16(b0, qr[d0], p0, 0, 0, 0);
    p1 = __builtin_amdgcn_mfma_f32_32x32x16_bf16(b1, qr[d0], p1, 0, 0, 0); }
}
__device__ __forceinline__ int v_st(int k, int c) { const int kk = (k & ~0xC) | ((k & 4) << 1) | ((k & 8) >> 1); return ((kk >> 3) * 4 + (c >> 5)) * 512 + ((kk & 7) * 32 + (c & 31)) * 2; }
__device__ __forceinline__ int v_rd_base(int lane) { return ((lane & 3) << 3) | (((lane >> 2) & 3) << 6) | (((lane >> 4) & 1) << 5) | (((lane >> 5) & 1) << 8); }
constexpr int v_rd_off(int d0, int ks, int half) { return d0 * 512 + ks * 4096 + half * 2048; }
template <int OFF> __device__ __forceinline__ s16x4 tr_read(int vb) {
  s16x4 r; asm volatile("ds_read_b64_tr_b16 %0, %1 offset:%2" : "=&v"(r) : "v"(vb), "i"(OFF) : "memory"); return r;
}
template <int D0> __device__ __forceinline__ void pv_one(f32x16& od, int vb, bf16x8 pa0, bf16x8 pa1, bf16x8 pa2, bf16x8 pa3) {
  const s16x4 l0 = tr_read<v_rd_off(D0, 0, 0)>(vb), h0 = tr_read<v_rd_off(D0, 0, 1)>(vb), l1 = tr_read<v_rd_off(D0, 1, 0)>(vb), h1 = tr_read<v_rd_off(D0, 1, 1)>(vb);
  const s16x4 l2 = tr_read<v_rd_off(D0, 2, 0)>(vb), h2 = tr_read<v_rd_off(D0, 2, 1)>(vb), l3 = tr_read<v_rd_off(D0, 3, 0)>(vb), h3 = tr_read<v_rd_off(D0, 3, 1)>(vb);
  asm volatile("s_waitcnt lgkmcnt(0)" ::: "memory"); SBAR();
#define PK(L, H) (bf16x8){L[0], L[1], L[2], L[3], H[0], H[1], H[2], H[3]}
  od = __builtin_amdgcn_mfma_f32_32x32x16_bf16(pa0, PK(l0, h0), od, 0, 0, 0);
  od = __builtin_amdgcn_mfma_f32_32x32x16_bf16(pa1, PK(l1, h1), od, 0, 0, 0);
  od = __builtin_amdgcn_mfma_f32_32x32x16_bf16(pa2, PK(l2, h2), od, 0, 0, 0);
  od = __builtin_amdgcn_mfma_f32_32x32x16_bf16(pa3, PK(l3, h3), od, 0, 0, 0);
#undef PK
}
__device__ __forceinline__ void pv_d0(f32x16* o, int vb, bf16x8 pa0, bf16x8 pa1, bf16x8 pa2, bf16x8 pa3) {
  pv_one<0>(o[0], vb, pa0, pa1, pa2, pa3); pv_one<1>(o[1], vb, pa0, pa1, pa2, pa3); pv_one<2>(o[2], vb, pa0, pa1, pa2, pa3); pv_one<3>(o[3], vb, pa0, pa1, pa2, pa3);
}

__device__ __forceinline__ void diff_attn_unit(const bf16* Qb, const bf16* Kh, const bf16* Vh, int ld, int seq, bf16* outb, int ldo,
                                               const float lam, const float post_scale, const float* subln_g, char* lds, const int wave_id) {
  constexpr float SCALE = 0.125f, THR = 8.f;
  const int tid = tid_from_wave(wave_id), wid = __builtin_amdgcn_readfirstlane(tid >> 6), lane = tid & 63, r32 = lane & 31, hi = lane >> 5;
  const int csel = wid >> 2, wq = wid & 3;
  char* V_lds = lds; char* K_lds = lds + 2 * SHM_V;
  float* ws = (float*)(lds + 2 * SHM_V + 2 * SHM_K) + wid * 64; float* li_l = ws; float* al_l = ws + 32;
  float m_reg = -1e30f, l_reg = 0; f32x16 o[4] = {}; bf16x8 qr[4];
  const bf16* Qw = Qb + (long)(wq * 32 + r32) * ld + csel * 64 + hi * 8;
#pragma unroll
  for (int d0 = 0; d0 < 4; ++d0) qr[d0] = ld8(Qw + d0 * 16);
  const int sr = tid >> 4, sc = (tid & 15) * 8, vst0 = v_st(sr, sc), vst1 = v_st(32 + sr, sc);
  const int vb0 = (int)(uintptr_t)V_lds + v_rd_base(lane);
  const int kc0 = csel * 64;
  struct { bf16x8 vs0, vs1, ks0, ks1; } sr_[2];
#define SLOAD(i, k0) do { sr_[i].vs0 = ld8(&Vh[(long)((k0) + sr) * ld + sc]); sr_[i].vs1 = ld8(&Vh[(long)((k0) + 32 + sr) * ld + sc]); \
    sr_[i].ks0 = ld8(&Kh[(long)((k0) + sr) * ld + sc]); sr_[i].ks1 = ld8(&Kh[(long)((k0) + 32 + sr) * ld + sc]); } while (0)
#define SWRITE(b, i) do { *(bf16x8*)(V_lds + (b) * SHM_V + vst0) = sr_[i].vs0;          \
    *(bf16x8*)(V_lds + (b) * SHM_V + vst1) = sr_[i].vs1; const int kc = sc * 2;               \
    *(bf16x8*)(K_lds + (b) * SHM_K + KSWZ(sr, kc)) = sr_[i].ks0;                       \
    *(bf16x8*)(K_lds + (b) * SHM_K + KSWZ(32 + sr, kc)) = sr_[i].ks1; } while (0)
#define SWAIT() asm volatile("s_waitcnt vmcnt(4)" ::: "memory")
#define RESC(a) do { if (__any((a) < 1.f)) { if (hi == 0) al_l[r32] = (a); asm volatile("s_waitcnt lgkmcnt(0)" ::: "memory"); \
    _Pragma("unroll") for (int d = 0; d < 4; ++d) _Pragma("unroll") for (int r = 0; r < 16; ++r) o[d][r] *= al_l[crow(r, hi)]; } } while (0)
  f32x16 pA0, pA1, pB0, pB1; float mnA, mnB, alA, alB; bf16x8 pa0, pa1, pa2, pa3; const int NT = seq / KVBLK;
  constexpr int SE = 0, SO = 1;
  __syncthreads();
  SLOAD(SE, 0); asm volatile("s_waitcnt vmcnt(0)" ::: "memory"); SWRITE(0, SE); __syncthreads();
  qkt<4>(pA0, pA1, K_lds, qr, r32, hi, kc0); partialSM(pA0, pA1, m_reg, mnA, alA, SCALE, THR);
  SLOAD(SO, KVBLK); if (2 < NT) SLOAD(SE, 2 * KVBLK);
  SWAIT(); SWRITE(1, SO); __syncthreads();
  for (int j = 1; j + 1 < NT; j += 2) {
    SBAR(); qkt<4>(pB0, pB1, K_lds + SHM_K, qr, r32, hi, kc0);
    finishSM(pA0, pA1, alA, l_reg, pa0, pa1, pa2, pa3); SBAR();
    SLOAD(SO, (j + 2) * KVBLK); SBAR();
    pv_d0(o, vb0, pa0, pa1, pa2, pa3); partialSM(pB0, pB1, m_reg, mnB, alB, SCALE, THR);
    __syncthreads(); SWAIT(); SWRITE(0, SE);
    RESC(alB); __syncthreads();
    SBAR(); qkt<4>(pA0, pA1, K_lds, qr, r32, hi, kc0);
    finishSM(pB0, pB1, alB, l_reg, pa0, pa1, pa2, pa3); SBAR();
    if (j + 3 < NT) SLOAD(SE, (j + 3) * KVBLK); SBAR();
    pv_d0(o, vb0 + (int)SHM_V, pa0, pa1, pa2, pa3); partialSM(pA0, pA1, m_reg, mnA, alA, SCALE, THR);
    __syncthreads(); SWAIT(); SWRITE(1, SO);
    RESC(alA); __syncthreads();
  }
  SBAR(); qkt<4>(pB0, pB1, K_lds + SHM_K, qr, r32, hi, kc0);
  finishSM(pA0, pA1, alA, l_reg, pa0, pa1, pa2, pa3); SBAR();
  pv_d0(o, vb0, pa0, pa1, pa2, pa3); partialSM(pB0, pB1, m_reg, mnB, alB, SCALE, THR);
  __syncthreads(); RESC(alB);
  finishSM(pB0, pB1, alB, l_reg, pa0, pa1, pa2, pa3); SBAR();
  pv_d0(o, vb0 + (int)SHM_V, pa0, pa1, pa2, pa3);
  asm volatile("s_waitcnt vmcnt(0)" ::: "memory");
  if (hi == 0) li_l[r32] = l_reg; asm volatile("s_waitcnt lgkmcnt(0)" ::: "memory");
  float rli[16];
#pragma unroll
  for (int r = 0; r < 16; ++r) rli[r] = __builtin_amdgcn_rcpf(li_l[crow(r, hi)]);
  __syncthreads();
  float* X = (float*)lds + (size_t)wq * 4096;
  if (csel == 1) {
#pragma unroll
    for (int d0 = 0; d0 < 4; ++d0)
#pragma unroll
      for (int r = 0; r < 16; ++r) X[(d0 * 16 + r) * 64 + lane] = o[d0][r] * rli[r];
  }
  __syncthreads();
  if (csel == 0) {
    float ss[16];
#pragma unroll
    for (int r = 0; r < 16; ++r) ss[r] = 0.f;
#pragma unroll
    for (int d0 = 0; d0 < 4; ++d0)
#pragma unroll
      for (int r = 0; r < 16; ++r) { const float v = o[d0][r] * rli[r] - lam * X[(d0 * 16 + r) * 64 + lane]; o[d0][r] = v; ss[r] += v * v; }
#pragma unroll
    for (int r = 0; r < 16; ++r) { float s = ss[r];
      s = row_sum(s); s += xor_lane(s, lane, 16);
      ss[r] = __builtin_amdgcn_rsqf(s * (1.f / 128.f) + RMS_EPS) * post_scale; }
    float gg[4];
#pragma unroll
    for (int d0 = 0; d0 < 4; ++d0) gg[d0] = subln_g[d0 * 32 + r32];
    bf16* Ow = outb + (long)(wq * 32) * ldo;
#pragma unroll
    for (int r = 0; r < 16; ++r) { const int orow = crow(r, hi);
#pragma unroll
      for (int d0 = 0; d0 < 4; ++d0) Ow[(long)orow * ldo + d0 * 32 + r32] = f2bf(o[d0][r] * ss[r] * gg[d0]); }
  }
#undef SLOAD
#undef SWRITE
#undef SWAIT
}

__device__ __forceinline__ void dil_attn_unit(const bf16* Qh, const bf16* Kh, const bf16* Vh, int ld, int dil, int rho, int u0, int L,
                                              float* Oc, float* lsep, char* lds, const int wave_id) {
  constexpr float SCALE = 0.08838834764831845f; constexpr float C = SCALE * 1.4426950408889634f;
  const int tid = tid_from_wave(wave_id), wid = __builtin_amdgcn_readfirstlane(tid >> 6), lane = tid & 63, r32 = lane & 31, hi = lane >> 5;
  char* V_lds = lds; char* K_lds = lds + 2 * SHM_V;
  float* ws = (float*)(lds + 2 * SHM_V + 2 * SHM_K) + wid * 64; float* li_l = ws; float* al_l = ws + 32;
  float m_reg = -1e30f, l_reg = 0; f32x16 o[4] = {}; bf16x8 qr[8];
  const int uq = u0 + wid * 32 + r32;
  const bf16* Qw = Qh + (long)(rho + dil * uq) * ld + hi * 8;
#pragma unroll
  for (int d0 = 0; d0 < 8; ++d0) qr[d0] = ld8(Qw + d0 * 16);
  const int sr = tid >> 4, sc = (tid & 15) * 8, vst0 = v_st(sr, sc), vst1 = v_st(32 + sr, sc);
  const int vb0 = (int)(uintptr_t)V_lds + v_rd_base(lane);
  const int tlo = wid >> 1;
  for (int t = 0; t < 6; ++t) {
    const int kt0 = u0 - 64 + 64 * t;
    __syncthreads();
    { int ua = kt0 + sr, ub = kt0 + 32 + sr; ua = ua < 0 ? 0 : (ua >= L ? L - 1 : ua); ub = ub < 0 ? 0 : (ub >= L ? L - 1 : ub);
      const long ra = (long)(rho + dil * ua) * ld + sc, rb = (long)(rho + dil * ub) * ld + sc;
      const bf16x8 va = ld8(Vh + ra), vb = ld8(Vh + rb), ka = ld8(Kh + ra), kb = ld8(Kh + rb);
      *(bf16x8*)(V_lds + vst0) = va; *(bf16x8*)(V_lds + vst1) = vb; const int kc = sc * 2;
      *(bf16x8*)(K_lds + KSWZ(sr, kc)) = ka; *(bf16x8*)(K_lds + KSWZ(32 + sr, kc)) = kb; }
    __syncthreads();
    if (t >= tlo && t <= tlo + 2) {
      f32x16 p0, p1;
      qkt<8>(p0, p1, K_lds, qr, r32, hi, 0);
#pragma unroll
      for (int r = 0; r < 16; ++r) { const int uk0 = kt0 + crow(r, hi), uk1 = uk0 + 32; const int d0 = uk0 - uq, d1 = uk1 - uq;
        const bool ok0 = (uk0 >= 0) && (uk0 < L) && (d0 >= -64) && (d0 <= 64), ok1 = (uk1 >= 0) && (uk1 < L) && (d1 >= -64) && (d1 <= 64);
        p0[r] = ok0 ? p0[r] : -1e30f; p1[r] = ok1 ? p1[r] : -1e30f; }
      float pmax = p0[0];
#pragma unroll
      for (int r = 1; r < 16; ++r) pmax = fmaxf(pmax, p0[r]);
#pragma unroll
      for (int r = 0; r < 16; ++r) pmax = fmaxf(pmax, p1[r]);
      { auto rr = __builtin_amdgcn_permlane32_swap(__float_as_uint(pmax), __float_as_uint(pmax), false, false);
        pmax = fmaxf(__uint_as_float(rr[0]), __uint_as_float(rr[1])); }
      const float mn = fmaxf(m_reg, pmax); const float alpha = __builtin_amdgcn_exp2f((m_reg - mn) * C); m_reg = mn;
      const float mnC = -mn * C;
#pragma unroll
      for (int r = 0; r < 16; ++r) { p0[r] = __builtin_amdgcn_exp2f(fmaf(p0[r], C, mnC)); p1[r] = fmaf(p1[r], C, mnC); }
      bf16x8 pa0, pa1, pa2, pa3;
      finishSM(p0, p1, alpha, l_reg, pa0, pa1, pa2, pa3);
      RESC(alpha);
      pv_d0(o, vb0, pa0, pa1, pa2, pa3);
    }
  }
  if (hi == 0) li_l[r32] = l_reg; asm volatile("s_waitcnt lgkmcnt(0)" ::: "memory");
  float rli[16];
#pragma unroll
  for (int r = 0; r < 16; ++r) rli[r] = __builtin_amdgcn_rcpf(li_l[crow(r, hi)]);
#pragma unroll
  for (int r = 0; r < 16; ++r) { const int uo = u0 + wid * 32 + crow(r, hi); float* orow = Oc + (long)(rho + dil * uo) * 512;
#pragma unroll
    for (int d0 = 0; d0 < 4; ++d0) orow[d0 * 32 + r32] = o[d0][r] * rli[r]; }
  if (hi == 0) lsep[(long)(rho + dil * uq) * 4] = m_reg * SCALE + __logf(l_reg);
}
#undef RESC
#undef KSWZ
#undef SBAR
}

struct Args { const float* in[N_INPUTS]; float* out; unsigned char* ws; int ph_lo, ph_hi; };
typedef const __attribute__((address_space(4))) Args* ArgsP;
struct Frame {
    LAS unsigned char* lds; volatile LAS unsigned* MISC; unsigned* ctl; unsigned char* ws;
    int tid, lane, wave, G, bid;
};
constexpr int PH_P0 = 0, PH_P1 = 1, PH_P2 = 2, PH_L0 = 3, NPH_L = 13, PH_FINAL = PH_L0 + DEPTH * NPH_L, NPHASES = PH_FINAL + 1;
enum { LP_NORM1 = 0, LP_G1, LP_PREP, LP_CPREP, LP_MIX, LP_POST, LP_G2, LP_NORM2, LP_GS, LP_GO, LP_NORM3, LP_M1, LP_M2 };

__device__ __forceinline__ int q_next(Frame& F, int q) {
    __syncthreads();
    if (F.tid == 0) F.MISC[0] = __hip_atomic_fetch_add(F.ctl + CW_Q + 64 * q, 1u, __ATOMIC_RELAXED, __HIP_MEMORY_SCOPE_AGENT);
    __syncthreads();
    return (int)F.MISC[0];
}

template <class RowMap>
__device__ __forceinline__ void transpose_item(const float* W, int ldn, bf16* WT, int ldt, RowMap rm, LAS float* scr, int k0, int n0, int lane) {
#pragma unroll 8
    for (int i = 0; i < 32; ++i) { const int kk = 2 * i + (lane >> 5); scr[kk * 33 + (lane & 31)] = W[(size_t)(k0 + kk) * ldn + n0 + (lane & 31)]; }
    LDS_WAIT(); asm volatile("" ::: "memory");
    const int c = lane & 7;
#pragma unroll
    for (int j = 0; j < 4; ++j) { const int n = (lane >> 3) + 8 * j; const LAS float* s = scr + (8 * c) * 33 + n;
        u32x4 o; o.x = pk2(s[0 * 33], s[1 * 33]); o.y = pk2(s[2 * 33], s[3 * 33]); o.z = pk2(s[4 * 33], s[5 * 33]); o.w = pk2(s[6 * 33], s[7 * 33]);
        *(u32x4*)(WT + (size_t)rm(n0 + n) * ldt + k0 + 8 * c) = o; }
    LDS_WAIT(); asm volatile("" ::: "memory");
}
struct RmId { __device__ __forceinline__ int operator()(int n) const { return n; } };
struct RmW13 { int off; __device__ __forceinline__ int operator()(int n) const { return 256 * (n >> 7) + off + (n & 127); } };

__device__ __forceinline__ void p0_prologue(Frame& F, ArgsP a) {
    unsigned char* ws = F.ws;
    LAS float* scr = (LAS float*)(F.lds + F.wave * 16384);
    const int gw = F.bid * 8 + F.wave, NGW = F.G * 8;
    constexpr int I_WIN = (DM / 64) * (IN_TOTAL / 32), I_SQ = (DM / 64) * (DM / 32), I_WKV = (DM / 64) * (4096 / 32), I_W1 = (DM / 64) * (DEXP / 32), I_W2 = (DEXP / 64) * (DM / 32);
    constexpr int PER_L = I_WIN + I_SQ + I_WKV + I_SQ + NEXP * (2 * I_W1 + I_W2);
    for (int it = gw; it < DEPTH * PER_L; it += NGW) {
        const int l = it / PER_L; int r = it % PER_L;
        if (r < I_WIN) { const int nb = IN_TOTAL / 32; transpose_item(a->in[I_W_IN] + (size_t)l * DM * IN_TOTAL, IN_TOTAL, (bf16*)(ws + WS_WIN) + (size_t)l * ZLD * DM, DM, RmId{}, scr, 64 * (r / nb), 32 * (r % nb), F.lane); continue; } r -= I_WIN;
        if (r < I_SQ) { const int nb = DM / 32; transpose_item(a->in[I_W_OUT] + (size_t)l * DM * DM, DM, (bf16*)(ws + WS_WOUT) + (size_t)l * DM * DM, DM, RmId{}, scr, 64 * (r / nb), 32 * (r % nb), F.lane); continue; } r -= I_SQ;
        if (r < I_WKV) { const int nb = 4096 / 32; transpose_item(a->in[I_XA_WKV] + (size_t)l * DM * 4096, 4096, (bf16*)(ws + SC_WKVT) + (size_t)l * 4096 * DM, DM, RmId{}, scr, 64 * (r / nb), 32 * (r % nb), F.lane); continue; } r -= I_WKV;
        if (r < I_SQ) { const int nb = DM / 32; transpose_item(a->in[I_XA_WO] + (size_t)l * DM * DM, DM, (bf16*)(ws + SC_WOT) + (size_t)l * DM * DM, DM, RmId{}, scr, 64 * (r / nb), 32 * (r % nb), F.lane); continue; } r -= I_SQ;
        const int e = r / (2 * I_W1 + I_W2); r = r % (2 * I_W1 + I_W2);
        const size_t le = (size_t)l * NEXP + e;
        if (r < I_W1) { const int nb = DEXP / 32; transpose_item(a->in[I_MOE_W1] + le * DM * DEXP, DEXP, (bf16*)(ws + WS_W13) + le * 1024 * DM, DM, RmW13{0}, scr, 64 * (r / nb), 32 * (r % nb), F.lane); continue; } r -= I_W1;
        if (r < I_W1) { const int nb = DEXP / 32; transpose_item(a->in[I_MOE_W3] + le * DM * DEXP, DEXP, (bf16*)(ws + WS_W13) + le * 1024 * DM, DM, RmW13{128}, scr, 64 * (r / nb), 32 * (r % nb), F.lane); continue; } r -= I_W1;
        { const int nb = DM / 32; transpose_item(a->in[I_MOE_W2] + le * DEXP * DM, DM, (bf16*)(ws + WS_W2) + le * DM * DEXP, DEXP, RmId{}, scr, 64 * (r / nb), 32 * (r % nb), F.lane); }
    }
    for (int it = gw; it < DEPTH * 96; it += NGW) { const int l = it / 96; int r = it % 96; bf16* base = (bf16*)(ws + WS_LORA + l * LORA_LAYER);
        if (r < 32) { const int d = r >> 4, nb = r & 15; transpose_item(a->in[I_RWKV_W2] + ((size_t)l * 2 + d) * 64 * 512, 512, base + (size_t)d * 512 * 64, 64, RmId{}, scr, 0, 32 * nb, F.lane); continue; } r -= 32;
        if (r < 32) { const int d = r >> 4, nb = r & 15; transpose_item(a->in[I_RWKV_A2] + ((size_t)l * 2 + d) * 64 * 512, 512, base + (size_t)(2 + d) * 512 * 64, 64, RmId{}, scr, 0, 32 * nb, F.lane); continue; } r -= 32;
        { const int kb = r >> 4, nb = r & 15; transpose_item(a->in[I_RWKV_G2] + (size_t)l * 128 * 512, 512, base + (size_t)4 * 512 * 64, 128, RmId{}, scr, 64 * kb, 32 * nb, F.lane); } }
    const int gt = F.bid * 512 + F.tid, NGT = F.G * 512;
    for (int i = gt; i < DEPTH * (ZLD - IN_TOTAL) * DM / 8; i += NGT) { const int l = i / ((ZLD - IN_TOTAL) * DM / 8), r = i % ((ZLD - IN_TOTAL) * DM / 8);
        *(u32x4*)((bf16*)(ws + WS_WIN) + (size_t)l * ZLD * DM + (size_t)IN_TOTAL * DM + (size_t)r * 8) = (u32x4){0u, 0u, 0u, 0u}; }
    for (int i = gt; i < DEPTH * DM * DM / 8; i += NGT) { const f32x4 x0 = *(const f32x4*)(a->in[I_XA_WQ] + (size_t)i * 8), x1 = *(const f32x4*)(a->in[I_XA_WQ] + (size_t)i * 8 + 4);
        u32x4 o; o.x = pk2(x0[0], x0[1]); o.y = pk2(x0[2], x0[3]); o.z = pk2(x1[0], x1[1]); o.w = pk2(x1[2], x1[3]); *(u32x4*)((bf16*)(ws + SC_WQB) + (size_t)i * 8) = o; }
    { float* cosA = (float*)(ws + WS_ROPE); float* sinA = cosA + SEQ * 32; float* cosC = sinA + SEQ * 32; float* sinC = cosC + SEQ * 64;
      for (int i = gt; i < SEQ * 96; i += NGT) { const int s = i / 96, j = i % 96; const bool isA = j < 32; const int jj = isA ? j : j - 32; const float dim = isA ? 64.f : 128.f;
          const float inv = 1.0f / powf(10000.0f, (float)(2 * jj) / dim); const float ang = (float)s * inv; float sn, cs; sincosf(ang, &sn, &cs);
          if (isA) { cosA[s * 32 + jj] = cs; sinA[s * 32 + jj] = sn; } else { cosC[s * 64 + jj] = cs; sinC[s * 64 + jj] = sn; } } }
    for (int i = gt; i < DEPTH * 2 * 32 * 64; i += NGT) { const int l = i / (2 * 32 * 64), r = i % (2 * 32 * 64), dir = r / (32 * 64), g = (r / 64) % 32, n = r % 64;
        float* ab = (float*)(ws + WS_S5P + l * S5P_LAYER); float* bb = ab + 2 * 32 * 64 * 2;
        const size_t pi = (((size_t)l * 2 + dir) * 32 + g) * 64 + n;
        const float lr = fminf(a->in[I_S5_A_RE][pi], -1e-4f), li = a->in[I_S5_A_IM][pi], dt = __expf(a->in[I_S5_LOG_DT][((size_t)l * 2 + dir) * 32 + g]);
        const float mag = __expf(dt * lr); float sn, cs; sincosf(dt * li, &sn, &cs); const float abr = mag * cs, abi = mag * sn;
        const float den = lr * lr + li * li; const float ir = lr / den, ii = -li / den;
        const float fr_ = (abr - 1.f) * ir - abi * ii, fi_ = (abr - 1.f) * ii + abi * ir;
        ab[(size_t)r * 2] = abr; ab[(size_t)r * 2 + 1] = abi;
        { float* ab256 = bb + 2 * 32 * 64 * 16 * 2; const float m256 = __expf(256.f * dt * lr); float s2, c2; sincosf(256.f * dt * li, &s2, &c2); ab256[(size_t)r * 2] = m256 * c2; ab256[(size_t)r * 2 + 1] = m256 * s2; }
        const size_t bi = (((size_t)l * 32 + g) * 64 + n) * 16;
#pragma unroll
        for (int c = 0; c < 16; ++c) { const float br = a->in[I_S5_B_RE][bi + c], bim = a->in[I_S5_B_IM][bi + c];
            bb[((size_t)r * 16 + c) * 2] = fr_ * br - fi_ * bim; bb[((size_t)r * 16 + c) * 2 + 1] = fr_ * bim + fi_ * br; } }
    for (int it = gw; it < DEPTH * BATCH * NMEM; it += NGW) { const int l = it / (BATCH * NMEM), row = it % (BATCH * NMEM);
        const f32x4* xr = (const f32x4*)(a->in[I_MEM] + (size_t)row * DM) + F.lane; const f32x4* gr = (const f32x4*)(a->in[I_NORM_MEM] + (size_t)l * DM) + F.lane;
        f32x4 v[8]; float s = 0.f;
#pragma unroll
        for (int j = 0; j < 8; ++j) { v[j] = xr[64 * j]; s += (v[j].x * v[j].x + v[j].y * v[j].y) + (v[j].z * v[j].z + v[j].w * v[j].w); }
        const float rstd = 1.f / sqrtf(wave_sum(s) * (1.f / DM) + RMS_EPS);
        u32x2* o8 = (u32x2*)((bf16*)(ws + SC_MEMN) + ((size_t)l * 512 + row) * DM) + F.lane;
#pragma unroll
        for (int j = 0; j < 8; ++j) { const f32x4 gv = gr[64 * j]; u32x2 w; w.x = pk2(v[j].x * rstd * gv.x, v[j].y * rstd * gv.y); w.y = pk2(v[j].z * rstd * gv.z, v[j].w * rstd * gv.w); o8[64 * j] = w; } }
}

struct SchedDense { const char* A; const char* B; char* C; int nM, nN, G, c, lda, ldb, ldcb  , cesz  ;
    __device__ __forceinline__ bool next(int i, pg8::Unit& u) const { const long L = (long)i * G + c; if (L >= (long)nM * nN) return false; int pm, pn; pg8::xcd_tile((int)L, nM, nN, pm, pn);
        u.A = A + (size_t)pm * 256 * lda * 2; u.B = B + (size_t)pn * 256 * ldb * 2; u.C = C + (size_t)pm * 256 * ldcb + (size_t)pn * 256 * cesz; u.row0 = pm * 256; u.col0 = pn * 256; u.aux = 0; return true; }
    __device__ __forceinline__ int arow(const pg8::Unit&, int r) const { return r; } };
struct SchedBatch { const char* A; const char* B; char* C; size_t sA, sB, sC; int nM, nN, nb, G, c, lda, ldb, ldcb, cesz, rowsPerBatch;
    __device__ __forceinline__ bool next(int i, pg8::Unit& u) const { const long L = (long)i * G + c; const int per = nM * nN; if (L >= (long)per * nb) return false; const int b = (int)(L / per), r = (int)(L % per), pm = r / nN, pn = r % nN;
        u.A = A + b * sA + (size_t)pm * 256 * lda * 2; u.B = B + b * sB + (size_t)pn * 256 * ldb * 2; u.C = C + b * sC + (size_t)pm * 256 * ldcb + (size_t)pn * 256 * cesz; u.row0 = b * rowsPerBatch + pm * 256; u.col0 = pn * 256; u.aux = b; return true; }
    __device__ __forceinline__ int arow(const pg8::Unit&, int r) const { return r; } };
struct SchedXaPre { unsigned char* ws; int G, c, kind;
    __device__ __forceinline__ bool next(int i, pg8::Unit& u) const { const long L = (long)i * G + c; if (L >= 128) return false; const int r = (int)L, p = r >> 3, t = r & 7, l = p >> 3, b = (p >> 2) & 1, h = p & 3;
        const bf16* kvb = (const bf16*)(ws + SC_KVB) + (size_t)l * 512 * 4096 + (size_t)(b * 256) * 4096;
        if (kind == 0) { u.A = (const char*)(kvb + h * 512); u.B = (const char*)((const bf16*)(ws + SC_WQB) + (size_t)l * DM * DM + (size_t)(t * 256) * DM + h * 512);
            u.C = (char*)((bf16*)(ws + WS_WQK) + ((size_t)(l * 2 + b) * 1024 + h * 256) * DM + t * 256); u.aux = DM; }
        else { u.A = (const char*)((const bf16*)(ws + SC_WOT) + (size_t)l * DM * DM + (size_t)(t * 256) * DM + h * 512); u.B = (const char*)(kvb + 2048 + h * 512);
            u.C = (char*)((bf16*)(ws + WS_VWO) + ((size_t)(l * 2 + b) * DM + t * 256) * 1024 + h * 256); u.aux = 1024; }
        u.row0 = 0; u.col0 = 0; return true; }
    __device__ __forceinline__ int arow(const pg8::Unit&, int r) const { return r; } };
struct EpiBf16U { static constexpr bool PERM = true, AFTER_DRAIN = false;
    __device__ __forceinline__ void operator()(const pg8::Acc& acc, const pg8::Unit& u, int wr, int wc, int fr, int fq) const { pg8::EpiBf16 e{u.aux}; e(acc, u, wr, wc, fr, fq); } };
struct SchedMoe { unsigned char* ws; const volatile LAS int* tp; const volatile LAS int* cnt; int layer, G, c, which;
    __device__ __forceinline__ bool next(int i, pg8::Unit& u) const {
        const int npn = which == 0 ? 4 : 8; const long L = (long)i * G + c; const int ntile = tp[32]; if (L >= (long)ntile * npn) return false;
        const int mt = (int)(L / npn), pn = (int)(L % npn); int e = 0;
#pragma unroll 1
        for (int k = 1; k < 32; ++k) e += (mt >= tp[k]) ? 1 : 0;
        const int lt = mt - tp[e]; const int nvalid = min(256, cnt[e] - lt * 256);
        u.row0 = lt * 256; u.col0 = pn * 256; u.aux = (e << 16) | nvalid;
        if (which == 0) { u.A = (const char*)(ws + WS_HN); u.B = (const char*)((const bf16*)(ws + WS_W13) + ((size_t)(layer * NEXP + e) * 1024 + pn * 256) * DM);
            u.C = (char*)((bf16*)(ws + SC_HMID) + (size_t)(mt * 256) * DEXP + pn * 128); }
        else { u.A = (const char*)((const bf16*)(ws + SC_HMID) + (size_t)(mt * 256) * DEXP); u.B = (const char*)((const bf16*)(ws + WS_W2) + ((size_t)(layer * NEXP + e) * DM + pn * 256) * DEXP);
            u.C = (char*)((bf16*)(ws + SC_YBUF) + (size_t)(mt * 256) * DM + pn * 256); }
        return true; }
    __device__ __forceinline__ int arow(const pg8::Unit& u, int r) const { const int e = u.aux >> 16, nvalid = u.aux & 0xffff; const int idx = (r < nvalid) ? (u.row0 + r) : u.row0;
        return ((const int*)(ws + WS_ETOK))[(size_t)e * ECAP + idx]; } };

__device__ __forceinline__ void moe_prefix(Frame& F, int layer, volatile LAS int* tp, volatile LAS int* cnt) {
    __syncthreads();
    if (F.tid < 32) cnt[F.tid] = (int)__hip_atomic_load(F.ctl + CW_CNT + layer * 64 + F.tid, __ATOMIC_RELAXED, __HIP_MEMORY_SCOPE_AGENT);
    __syncthreads();
    if (F.tid == 0) { int s = 0; for (int e = 0; e < 32; ++e) { tp[e] = s; s += (cnt[e] + 255) >> 8; } tp[32] = s; }
    __syncthreads();
}
template <int MODE>
__device__ __forceinline__ void norm_phase(Frame& F, ArgsP a, const float* src, const float* gain, int layer) {
    unsigned char* ws = F.ws; float* H = (float*)(ws + WS_H); bf16* HN = (bf16*)(ws + WS_HN);
    volatile LAS int* tp = (volatile LAS int*)(F.lds + 1024); volatile LAS int* cnt = tp + 40;
    if (MODE & 1) moe_prefix(F, layer - 1, tp, cnt);
    const int gw = F.bid * 8 + F.wave, NGW = F.G * 8;
    const f32x4* gr = (const f32x4*)gain + F.lane;
    for (int row = gw; row < NTOK; row += NGW) {
        const f32x4* xr = (const f32x4*)(src + (size_t)row * DM) + F.lane;
        f32x4 v[8];
#pragma unroll
        for (int j = 0; j < 8; ++j) v[j] = xr[64 * j];
        if (MODE & 1) {
            const int* ti = (const int*)(ws + WS_TINFO) + (size_t)row * 4;
            const int e0 = ti[0], p0 = ti[1], e1 = ti[2], p1 = ti[3];
            const size_t s0 = (size_t)tp[e0] * 256 + p0, s1 = (size_t)tp[e1] * 256 + p1;
            const u32x2* y0 = (const u32x2*)((const bf16*)(ws + SC_YBUF) + s0 * DM) + F.lane; const u32x2* y1 = (const u32x2*)((const bf16*)(ws + SC_YBUF) + s1 * DM) + F.lane;
#pragma unroll
            for (int j = 0; j < 8; ++j) { const u32x2 a0 = y0[64 * j], a1 = y1[64 * j];
                v[j].x += __uint_as_float(a0.x << 16) + __uint_as_float(a1.x << 16); v[j].y += __uint_as_float(a0.x & 0xffff0000u) + __uint_as_float(a1.x & 0xffff0000u);
                v[j].z += __uint_as_float(a0.y << 16) + __uint_as_float(a1.y << 16); v[j].w += __uint_as_float(a0.y & 0xffff0000u) + __uint_as_float(a1.y & 0xffff0000u); }
            if (!(MODE & 4)) { f32x4* hr = (f32x4*)(H + (size_t)row * DM) + F.lane;
#pragma unroll
                for (int j = 0; j < 8; ++j) hr[64 * j] = v[j]; }
        }
        float s = 0.f;
#pragma unroll
        for (int j = 0; j < 8; ++j) s += (v[j].x * v[j].x + v[j].y * v[j].y) + (v[j].z * v[j].z + v[j].w * v[j].w);
        const float rstd = 1.f / sqrtf(wave_sum(s) * (1.f / DM) + RMS_EPS);
#pragma unroll
        for (int j = 0; j < 8; ++j) { const f32x4 gv = gr[64 * j]; v[j].x *= rstd * gv.x; v[j].y *= rstd * gv.y; v[j].z *= rstd * gv.z; v[j].w *= rstd * gv.w; }
        if (MODE & 4) { f32x4* orow = (f32x4*)(a->out + (size_t)row * DM) + F.lane;
#ifdef DBG_TIME_A
            { const float sc = 1.f + (float)__hip_atomic_load(F.ctl + 40000, __ATOMIC_RELAXED, __HIP_MEMORY_SCOPE_AGENT) * (1.f / 20.f);
#pragma unroll
              for (int j = 0; j < 8; ++j) v[j] *= sc; }
#endif
#ifdef DBG_RWCHK
            { const float* cw = (const float*)(F.ctl + 32768); const unsigned* cu = (const unsigned*)cw; const float sc = cu[DBG_RWCHK * 64 + 2] ? 1001.f : 1.f + fminf(cw[DBG_RWCHK * 64] / cw[DBG_RWCHK * 64 + 1], 100.f);
#pragma unroll
              for (int j = 0; j < 8; ++j) v[j] *= sc; }
#endif
#pragma unroll
            for (int j = 0; j < 8; ++j) orow[64 * j] = v[j]; }
        else { u32x2* o8 = (u32x2*)(HN + (size_t)row * DM) + F.lane;
#pragma unroll
            for (int j = 0; j < 8; ++j) { u32x2 w; w.x = pk2(v[j].x, v[j].y); w.y = pk2(v[j].z, v[j].w); o8[64 * j] = w; } }
        if (MODE & 2) {
            const float* wg = a->in[I_ROUTER_GROUP] + (size_t)layer * DM * 4; const float* we = a->in[I_ROUTER_EXPERT] + (size_t)layer * DM * 32;
            float lg[4] = {0.f, 0.f, 0.f, 0.f};
#pragma unroll 2
            for (int j = 0; j < 8; ++j) { const int k0 = (64 * j + F.lane) * 4;
#pragma unroll
                for (int q = 0; q < 4; ++q) { const f32x4 w4 = *(const f32x4*)(wg + (size_t)(k0 + q) * 4); const float x = v[j][q]; lg[0] += x * w4.x; lg[1] += x * w4.y; lg[2] += x * w4.z; lg[3] += x * w4.w; } }
#pragma unroll
            for (int q = 0; q < 4; ++q) lg[q] = wave_sum(lg[q]);
            int gi = 0; float gm = lg[0];
#pragma unroll
            for (int q = 1; q < 4; ++q) if (lg[q] > gm) { gm = lg[q]; gi = q; }
            const float gw_ = 1.f / (__expf(lg[0] - gm) + __expf(lg[1] - gm) + __expf(lg[2] - gm) + __expf(lg[3] - gm));
            float le[8] = {0.f, 0.f, 0.f, 0.f, 0.f, 0.f, 0.f, 0.f};
#pragma unroll 2
            for (int j = 0; j < 8; ++j) { const int k0 = (64 * j + F.lane) * 4;
#pragma unroll
                for (int q = 0; q < 4; ++q) { const float* wp = we + (size_t)(k0 + q) * 32 + gi * 8; const f32x4 wa = *(const f32x4*)wp, wb = *(const f32x4*)(wp + 4); const float x = v[j][q];
                    le[0] += x * wa.x; le[1] += x * wa.y; le[2] += x * wa.z; le[3] += x * wa.w; le[4] += x * wb.x; le[5] += x * wb.y; le[6] += x * wb.z; le[7] += x * wb.w; } }
#pragma unroll
            for (int q = 0; q < 8; ++q) le[q] = wave_sum(le[q]);
            int i0 = 0; float m0 = le[0];
#pragma unroll
            for (int q = 1; q < 8; ++q) if (le[q] > m0) { m0 = le[q]; i0 = q; }
            int i1 = -1; float m1 = -3.0e38f;
#pragma unroll
            for (int q = 0; q < 8; ++q) if (q != i0 && le[q] > m1) { m1 = le[q]; i1 = q; }
            const float t = __expf(m1 - m0); const float w0 = 1.f / (1.f + t), w1 = t / (1.f + t);
            if (F.lane == 0) {
                const int e0 = gi * 8 + i0, e1 = gi * 8 + i1;
                const int p0 = (int)__hip_atomic_fetch_add(F.ctl + CW_CNT + layer * 64 + e0, 1u, __ATOMIC_RELAXED, __HIP_MEMORY_SCOPE_AGENT);
                const int p1 = (int)__hip_atomic_fetch_add(F.ctl + CW_CNT + layer * 64 + e1, 1u, __ATOMIC_RELAXED, __HIP_MEMORY_SCOPE_AGENT);
                int* et = (int*)(ws + WS_ETOK); float* eg = (float*)(ws + WS_EGATE); int* ti = (int*)(ws + WS_TINFO) + (size_t)row * 4;
                et[(size_t)e0 * ECAP + p0] = row; eg[(size_t)e0 * ECAP + p0] = gw_ * w0; et[(size_t)e1 * ECAP + p1] = row; eg[(size_t)e1 * ECAP + p1] = gw_ * w1;
                ti[0] = e0; ti[1] = p0; ti[2] = e1; ti[3] = p1;
            }
        }
    }
}

__device__ __forceinline__ void rope_token(Frame& F, bf16* zrow, int s) {
    const float* cosA = (const float*)(F.ws + WS_ROPE); const float* sinA = cosA + SEQ * 32; const float* cosC = sinA + SEQ * 32; const float* sinC = cosC + SEQ * 64;
    { const int i = F.lane & 31; const float cs = cosA[s * 32 + i], sn = sinA[s * 32 + i];
#pragma unroll
      for (int it = 0; it < 8; ++it) { bf16* p = zrow + ZA + (it * 2 + (F.lane >> 5)) * 64; const float x1 = bf2f(p[i]), x2 = bf2f(p[i + 32]); p[i] = f2bf(x1 * cs - x2 * sn); p[i + 32] = f2bf(x2 * cs + x1 * sn); } }
    { const int i = F.lane; const float cs = cosC[s * 64 + i], sn = sinC[s * 64 + i];
#pragma unroll
      for (int it = 0; it < 8; ++it) { bf16* p = zrow + ZC + it * 128; const float x1 = bf2f(p[i]), x2 = bf2f(p[i + 64]); p[i] = f2bf(x1 * cs - x2 * sn); p[i + 64] = f2bf(x2 * cs + x1 * sn); } }
}

constexpr int RWT = 16;
__device__ __forceinline__ float zs_ld(const LAS unsigned short* zr, const float* mu, int t, int col) {
    const float z0 = bf2f(zr[(t + 1) * IN_B + col]), zp = bf2f(zr[t * IN_B + col]), zn = bf2f(zr[(t + 2) * IN_B + col]);
    return z0 + mu[col] * (zp - z0) + mu[IN_B + col] * (zn - z0);
}
__device__ __forceinline__ void rwkv_prep_tile(Frame& F, ArgsP a, int layer, int tile) {
    unsigned char* ws = F.ws; const bf16* Z = (const bf16*)(ws + SC_Z);
    LAS unsigned short* zr = (LAS unsigned short*)F.lds; LAS unsigned short* act = zr + (RWT + 2) * IN_B;
    const int t0 = tile * RWT; const int b = t0 / SEQ, s0 = t0 % SEQ;
    __syncthreads();
#pragma unroll 1
    for (int i = F.tid; i < (RWT + 2) * (IN_B / 8); i += 512) { const int rr = i / (IN_B / 8), c8 = i % (IN_B / 8); const int s = s0 - 1 + rr;
        u32x4 w = {0u, 0u, 0u, 0u};
        if (s >= 0 && s < SEQ) w = *(const u32x4*)(Z + (size_t)(b * SEQ + s) * ZLD + ZB + c8 * 8);
        *(LAS u32x4*)(zr + rr * IN_B + c8 * 8) = w; }
    __syncthreads();
    const float* mu = a->in[I_RWKV_MU] + (size_t)layer * 2 * IN_B;
#pragma unroll 1
    for (int i = F.tid; i < RWT * 384; i += 512) { const int t = i / 384, j = i % 384; const float x = zs_ld(zr, mu, t, 1536 + j);
        act[t * 392 + j] = f2bf((j < 128) ? tanhf(x) : ((j < 256) ? x : sigmoidf_(x))); }
    __syncthreads();
    const int lane = F.lane, r = lane & 15, g = lane >> 4, hd = F.wave;
    const bf16* lw = (const bf16*)(ws + WS_LORA + layer * LORA_LAYER);
    bf16x8 af[12];
#pragma unroll
    for (int ks = 0; ks < 12; ++ks) af[ks] = *(const LAS bf16x8*)(act + r * 392 + ks * 32 + g * 8);
    float* RW = (float*)(ws + SC_RW); const size_t N1 = (size_t)NTOK * 512;
    f32x4 dw0[4], dw1[4], da0[4], da1[4], dg[4];
#pragma unroll
    for (int nt = 0; nt < 4; ++nt) { const int c = hd * 64 + nt * 16 + r;
        bf16x8 bw[12];
#pragma unroll
        for (int ks = 0; ks < 2; ++ks) { bw[ks] = *(const bf16x8*)(lw + ((size_t)0 * 512 + c) * 64 + ks * 32 + g * 8); bw[2 + ks] = *(const bf16x8*)(lw + ((size_t)1 * 512 + c) * 64 + ks * 32 + g * 8);
            bw[4 + ks] = *(const bf16x8*)(lw + ((size_t)2 * 512 + c) * 64 + ks * 32 + g * 8); bw[6 + ks] = *(const bf16x8*)(lw + ((size_t)3 * 512 + c) * 64 + ks * 32 + g * 8); }
#pragma unroll
        for (int ks = 0; ks < 4; ++ks) bw[8 + ks] = *(const bf16x8*)(lw + (size_t)4 * 512 * 64 + (size_t)c * 128 + ks * 32 + g * 8);
        f32x4 z4 = {0.f, 0.f, 0.f, 0.f};
        dw0[nt] = __builtin_amdgcn_mfma_f32_16x16x32_bf16(af[0], bw[0], z4, 0, 0, 0); dw0[nt] = __builtin_amdgcn_mfma_f32_16x16x32_bf16(af[1], bw[1], dw0[nt], 0, 0, 0);
        dw1[nt] = __builtin_amdgcn_mfma_f32_16x16x32_bf16(af[2], bw[2], z4, 0, 0, 0); dw1[nt] = __builtin_amdgcn_mfma_f32_16x16x32_bf16(af[3], bw[3], dw1[nt], 0, 0, 0);
        da0[nt] = __builtin_amdgcn_mfma_f32_16x16x32_bf16(af[4], bw[4], z4, 0, 0, 0); da0[nt] = __builtin_amdgcn_mfma_f32_16x16x32_bf16(af[5], bw[5], da0[nt], 0, 0, 0);
        da1[nt] = __builtin_amdgcn_mfma_f32_16x16x32_bf16(af[6], bw[6], z4, 0, 0, 0); da1[nt] = __builtin_amdgcn_mfma_f32_16x16x32_bf16(af[7], bw[7], da1[nt], 0, 0, 0);
        dg[nt] = __builtin_amdgcn_mfma_f32_16x16x32_bf16(af[8], bw[8], z4, 0, 0, 0); dg[nt] = __builtin_amdgcn_mfma_f32_16x16x32_bf16(af[9], bw[9], dg[nt], 0, 0, 0);
        dg[nt] = __builtin_amdgcn_mfma_f32_16x16x32_bf16(af[10], bw[10], dg[nt], 0, 0, 0); dg[nt] = __builtin_amdgcn_mfma_f32_16x16x32_bf16(af[11], bw[11], dg[nt], 0, 0, 0);
    }
    float w00[4], w01[4], a00[4], a01[4], kkw[4], kaw[4];
#pragma unroll
    for (int nt = 0; nt < 4; ++nt) { const int c = hd * 64 + nt * 16 + r;
        w00[nt] = a->in[I_RWKV_W0][(size_t)layer * 1024 + c]; w01[nt] = a->in[I_RWKV_W0][(size_t)layer * 1024 + 512 + c];
        a00[nt] = a->in[I_RWKV_A0][(size_t)layer * 1024 + c]; a01[nt] = a->in[I_RWKV_A0][(size_t)layer * 1024 + 512 + c];
        kkw[nt] = a->in[I_RWKV_KK][(size_t)layer * 512 + c]; kaw[nt] = a->in[I_RWKV_KA][(size_t)layer * 512 + c]; }
#pragma unroll
    for (int q = 0; q < 4; ++q) { const int t = 4 * g + q;
        float k_[4], kk[4]; float ssq = 0.f;
#pragma unroll
        for (int nt = 0; nt < 4; ++nt) { const int c = hd * 64 + nt * 16 + r; k_[nt] = zs_ld(zr, mu, t, 512 + c); kk[nt] = k_[nt] * kkw[nt]; ssq += kk[nt] * kk[nt]; }
        ssq = row_sum(ssq);
        const float rn = 1.f / sqrtf(ssq + 1e-12f);
#pragma unroll
        for (int nt = 0; nt < 4; ++nt) { const int c = hd * 64 + nt * 16 + r;
            const float r_ = zs_ld(zr, mu, t, c), v_ = zs_ld(zr, mu, t, 1024 + c);
            const float x0 = -(w00[nt] + dw0[nt][q]), x1 = -(w01[nt] + dw1[nt][q]);
            const float sp0 = fmaxf(x0, 0.f) + __logf(1.f + __expf(-fabsf(x0))), sp1 = fmaxf(x1, 0.f) + __logf(1.f + __expf(-fabsf(x1)));
            const float d0 = -__expf(-sp0 - 0.5f), d1 = -__expf(-sp1 - 0.5f);
            const float al0 = sigmoidf_(a00[nt] + da0[nt][q]), al1 = sigmoidf_(a01[nt] + da1[nt][q]);
            const float kn = kk[nt] * rn;
            const float km0 = k_[nt] * (1.f + (al0 - 1.f) * kaw[nt]), km1 = k_[nt] * (1.f + (al1 - 1.f) * kaw[nt]);
            const size_t o = (size_t)(t0 + t) * 512 + c;
            RW[0 * N1 + o] = r_; RW[1 * N1 + o] = v_; RW[2 * N1 + o] = kn; RW[3 * N1 + o] = d0; RW[4 * N1 + o] = d1;
            RW[5 * N1 + o] = km0; RW[6 * N1 + o] = km1; RW[7 * N1 + o] = kn * al0; RW[8 * N1 + o] = kn * al1; RW[9 * N1 + o] = dg[nt][q]; }
    }
}

constexpr size_t SC_S5E = SC_MIX_END + (size_t)32 * 256 * 11520;
constexpr size_t SC_MIX_END3 = SC_S5E + (size_t)2 * BATCH * 16 * 32 * 64 * 2 * 4;
template <int LEVEL>
__device__ __forceinline__ void s5_block_task(Frame& F, int layer, int task, LAS float* ul) {
    unsigned char* ws = F.ws; const bf16* Z = (const bf16*)(ws + SC_Z);
    const int blk = task & 15, dir = (task >> 4) & 1, g = (task >> 5) & 31, b = task >> 10; const int n = F.lane;
    const float* ab = (const float*)(ws + WS_S5P + layer * S5P_LAYER); const float* bb = ab + 2 * 32 * 64 * 2; const float* ab256 = bb + 2 * 32 * 64 * 16 * 2;
    const int pr = (dir * 32 + g) * 64 + n;
    const float abr = ab[pr * 2], abi = ab[pr * 2 + 1];
    float bbr[16], bbi[16];
#pragma unroll
    for (int c = 0; c < 16; ++c) { bbr[c] = bb[((size_t)pr * 16 + c) * 2]; bbi[c] = bb[((size_t)pr * 16 + c) * 2 + 1]; }
    float* E = (float*)(ws + SC_S5E);
    float xr = 0.f, xi = 0.f;
    if (LEVEL == 2) { const float pr_ = ab256[pr * 2], pi_ = ab256[pr * 2 + 1];
        for (int k = 0; k < blk; ++k) { const float* ep = E + ((((size_t)dir * BATCH + b) * 16 + k) * 32 + g) * 128 + n * 2; const float er = ep[0], ei = ep[1];
            const float nr = pr_ * xr - pi_ * xi + er, ni = pr_ * xi + pi_ * xr + ei; xr = nr; xi = ni; } }
    float* carry = (float*)(ws + SC_CARRY);
    for (int q4 = 0; q4 < 4; ++q4) {
        { const int st = blk * 256 + q4 * 64 + n; const int sl = dir ? (SEQ - 1 - st) : st; const bf16* zp = Z + (size_t)(b * SEQ + sl) * ZLD + ZD + g * 16;
          const u32x4 w0 = *(const u32x4*)zp, w1 = *(const u32x4*)(zp + 8);
          LAS f32x4* d = (LAS f32x4*)(ul + n * 16);
          d[0] = (f32x4){__uint_as_float(w0.x << 16), __uint_as_float(w0.x & 0xffff0000u), __uint_as_float(w0.y << 16), __uint_as_float(w0.y & 0xffff0000u)};
          d[1] = (f32x4){__uint_as_float(w0.z << 16), __uint_as_float(w0.z & 0xffff0000u), __uint_as_float(w0.w << 16), __uint_as_float(w0.w & 0xffff0000u)};
          d[2] = (f32x4){__uint_as_float(w1.x << 16), __uint_as_float(w1.x & 0xffff0000u), __uint_as_float(w1.y << 16), __uint_as_float(w1.y & 0xffff0000u)};
          d[3] = (f32x4){__uint_as_float(w1.z << 16), __uint_as_float(w1.z & 0xffff0000u), __uint_as_float(w1.w << 16), __uint_as_float(w1.w & 0xffff0000u)}; }
        LDS_WAIT(); asm volatile("" ::: "memory");
#pragma unroll 4
        for (int i = 0; i < 64; ++i) {
            const int step = blk * 256 + q4 * 64 + i;
            if (LEVEL == 2 && (step & (S5CH - 1)) == 0) { const int sl = dir ? (SEQ - 1 - step) : step; const int ch = sl / S5CH;
                float* cp = carry + ((((size_t)dir * BATCH + b) * S5NCH + ch) * 32 + g) * 128 + n * 2; cp[0] = xr; cp[1] = xi; }
            const f32x4 u0 = *(const LAS f32x4*)(ul + i * 16), u1 = *(const LAS f32x4*)(ul + i * 16 + 4), u2 = *(const LAS f32x4*)(ul + i * 16 + 8), u3 = *(const LAS f32x4*)(ul + i * 16 + 12);
            float br = 0.f, bi = 0.f;
#pragma unroll
            for (int c = 0; c < 4; ++c) { br += bbr[c] * u0[c] + bbr[4 + c] * u1[c] + bbr[8 + c] * u2[c] + bbr[12 + c] * u3[c]; bi += bbi[c] * u0[c] + bbi[4 + c] * u1[c] + bbi[8 + c] * u2[c] + bbi[12 + c] * u3[c]; }
            const float nr = abr * xr - abi * xi + br, ni = abr * xi + abi * xr + bi; xr = nr; xi = ni;
        }
        asm volatile("" ::: "memory");
    }
    if (LEVEL == 1) { float* ep = E + ((((size_t)dir * BATCH + b) * 16 + blk) * 32 + g) * 128 + n * 2; ep[0] = xr; ep[1] = xi; }
}

__device__ __forceinline__ void prep_phase(Frame& F, ArgsP a, int layer, const int rep) {
    const int qb_ = (rep * 2 + layer) * 8;
#ifndef DBG_PREPMASK
#define DBG_PREPMASK 7
#endif
    if (DBG_PREPMASK & 1) for (;;) { const int it = q_next(F, qb_ + 0); if (it >= 256) break; s5_block_task<1>(F, layer, it * 8 + F.wave, (LAS float*)(F.lds + F.wave * 4096)); }
    if (DBG_PREPMASK & 2) for (;;) { const int it = q_next(F, qb_ + 5); if (it >= NTOK / RWT) break; rwkv_prep_tile(F, a, layer, it); }
    if ((DBG_PREPMASK & 4) && rep == 0) for (;;) { const int r = q_next(F, qb_ + 6); if (r >= NTOK / 64) break;
        for (int k = 0; k < 8; ++k) { const int tok = r * 64 + F.wave * 8 + k; rope_token(F, (bf16*)(F.ws + SC_Z) + (size_t)tok * ZLD, tok % SEQ); } }
}

constexpr int CR_TA = 0, CR_GH = 2048, CR_WBK = 4096, CR_TM = 8192, CR_N = 8704, CR_V = 9216, CR_WL = 11264, CR_BYTES = 11520;
constexpr size_t SC_CREC = SC_MIX_END;
constexpr size_t SC_MIX_END2 = SC_CREC + (size_t)32 * 256 * CR_BYTES;
static_assert(SC_MIX_END2 <= 1140000000ull, "workspace budget");

__device__ __forceinline__ void mm16(const LAS float* A, const LAS float* B, int t, int sq, float (&out)[4]) {
    out[0] = out[1] = out[2] = out[3] = 0.f;
#pragma unroll
    for (int s4 = 0; s4 < 4; ++s4) { const f32x4 a4 = *(const LAS f32x4*)(A + t * 16 + s4 * 4);
#pragma unroll
        for (int q = 0; q < 4; ++q) { const f32x4 b4 = *(const LAS f32x4*)(B + (s4 * 4 + q) * 16 + sq * 4); const float av = a4[q];
            out[0] += av * b4[0]; out[1] += av * b4[1]; out[2] += av * b4[2]; out[3] += av * b4[3]; } }
}
__device__ __forceinline__ void st16(LAS float* M, int t, int sq, const float (&v)[4]) { *(LAS f32x4*)(M + t * 16 + sq * 4) = (f32x4){v[0], v[1], v[2], v[3]}; }

__device__ __forceinline__ void rwkv_cprep_item(Frame& F, int chain, int c, LAS float* Lw) {
    unsigned char* ws = F.ws; const float* RW = (const float*)(ws + SC_RW); const size_t N1 = (size_t)NTOK * 512;
    const int dir = chain & 1, h = (chain >> 1) & 7, b = chain >> 4; const int lane = F.lane;
    const float* Rp = RW; const float* Vp = RW + N1; const float* KKp = RW + 2 * N1; const float* LDp = RW + (3 + dir) * N1; const float* KMp = RW + (5 + dir) * N1; const float* BBp = RW + (7 + dir) * N1;
    constexpr int RS = 68;
    LAS float* At = Lw; LAS float* Bt = Lw + 16 * RS; LAS float* Kt = Lw + 32 * RS; LAS float* mat = Lw + 48 * RS;
    float at[16], rt[16], wb[16], wk[16];
    { float lw = 0.f, lwi[16], bb[16], km[16];
#pragma unroll
      for (int t = 0; t < 16; ++t) { const int pos = dir ? (SEQ - 1 - 16 * c - t) : (16 * c + t); const size_t idx = (size_t)(b * SEQ + pos) * 512 + h * 64 + lane;
          const float r_ = Rp[idx], ld = LDp[idx], a_ = -KKp[idx]; km[t] = KMp[idx]; bb[t] = BBp[idx];
          at[t] = a_ * __expf(lw); lw += ld; lwi[t] = lw; rt[t] = r_ * __expf(lw);
          const float iw = __expf(-lw); At[t * RS + lane] = at[t]; Bt[t * RS + lane] = bb[t] * iw; Kt[t * RS + lane] = km[t] * iw; }
#pragma unroll
      for (int t = 0; t < 16; ++t) { const float e = __expf(lw - lwi[t]); wb[t] = bb[t] * e; wk[t] = km[t] * e; }
      float* rec = (float*)(ws + SC_CREC + ((size_t)chain * 256 + c) * CR_BYTES + CR_WL); rec[lane] = __expf(lw); }
    LDS_WAIT(); asm volatile("" ::: "memory");
    const int t = lane >> 2, sq = lane & 3;
    float mab[4] = {0.f, 0.f, 0.f, 0.f}, mak[4] = {0.f, 0.f, 0.f, 0.f}, mrb[4] = {0.f, 0.f, 0.f, 0.f}, mrk[4] = {0.f, 0.f, 0.f, 0.f};
#pragma unroll 4
    for (int j = 0; j < 64; j += 4) { const f32x4 a4 = *(const LAS f32x4*)(At + t * RS + j);
#pragma unroll
        for (int e = 0; e < 4; ++e) { const f32x4 b4 = *(const LAS f32x4*)(Bt + (sq * 4 + e) * RS + j), k4 = *(const LAS f32x4*)(Kt + (sq * 4 + e) * RS + j);
            mab[e] += a4[0] * b4[0] + a4[1] * b4[1] + a4[2] * b4[2] + a4[3] * b4[3]; mak[e] += a4[0] * k4[0] + a4[1] * k4[1] + a4[2] * k4[2] + a4[3] * k4[3]; } }
    asm volatile("" ::: "memory");
#pragma unroll
    for (int tt = 0; tt < 16; ++tt) At[tt * RS + lane] = rt[tt];
    LDS_WAIT(); asm volatile("" ::: "memory");
#pragma unroll 4
    for (int j = 0; j < 64; j += 4) { const f32x4 a4 = *(const LAS f32x4*)(At + t * RS + j);
#pragma unroll
        for (int e = 0; e < 4; ++e) { const f32x4 b4 = *(const LAS f32x4*)(Bt + (sq * 4 + e) * RS + j), k4 = *(const LAS f32x4*)(Kt + (sq * 4 + e) * RS + j);
            mrb[e] += a4[0] * b4[0] + a4[1] * b4[1] + a4[2] * b4[2] + a4[3] * b4[3]; mrk[e] += a4[0] * k4[0] + a4[1] * k4[1] + a4[2] * k4[2] + a4[3] * k4[3]; } }
#pragma unroll
    for (int e = 0; e < 4; ++e) { const int s = sq * 4 + e; if (s >= t) { mab[e] = 0.f; mak[e] = 0.f; } if (s > t) { mrb[e] = 0.f; mrk[e] = 0.f; } }
    LAS float* m0 = mat; LAS float* m1 = mat + 256; LAS float* m2 = mat + 512; LAS float* m3 = mat + 768;
    float T[4], P[4], Q[4];
    st16(m0, t, sq, mab); LDS_WAIT(); asm volatile("" ::: "memory");
#pragma unroll
    for (int e = 0; e < 4; ++e) T[e] = mab[e] + ((sq * 4 + e) == t ? 1.f : 0.f);
    mm16(m0, m0, t, sq, P);
    st16(m1, t, sq, P); st16(m2, t, sq, T); LDS_WAIT(); asm volatile("" ::: "memory");
    mm16(m2, m1, t, sq, Q);
#pragma unroll
    for (int e = 0; e < 4; ++e) T[e] += Q[e];
    mm16(m1, m1, t, sq, P);
    asm volatile("" ::: "memory");
    st16(m0, t, sq, P); st16(m2, t, sq, T); LDS_WAIT(); asm volatile("" ::: "memory");
    mm16(m2, m0, t, sq, Q);
#pragma unroll
    for (int e = 0; e < 4; ++e) T[e] += Q[e];
    mm16(m0, m0, t, sq, P);
    asm volatile("" ::: "memory");
    st16(m1, t, sq, P); st16(m2, t, sq, T); LDS_WAIT(); asm volatile("" ::: "memory");
    mm16(m2, m1, t, sq, Q);
#pragma unroll
    for (int e = 0; e < 4; ++e) T[e] += Q[e];
    asm volatile("" ::: "memory");
    st16(m2, t, sq, T); st16(m0, t, sq, mrb); st16(m1, t, sq, mak); LDS_WAIT(); asm volatile("" ::: "memory");
    float P1[4], TM[4], Nn[4];
    mm16(m0, m2, t, sq, P1); mm16(m2, m1, t, sq, TM);
    st16(m3, t, sq, P1); LDS_WAIT(); asm volatile("" ::: "memory");
    mm16(m3, m1, t, sq, Nn);
#pragma unroll
    for (int e = 0; e < 4; ++e) Nn[e] += mrk[e];
    unsigned char* rec = ws + SC_CREC + ((size_t)chain * 256 + c) * CR_BYTES;
    { u32x2 w; w.x = pk2(TM[0], TM[1]); w.y = pk2(TM[2], TM[3]); *(u32x2*)(rec + CR_TM + (16 * sq + t) * 8) = w;
      w.x = pk2(Nn[0], Nn[1]); w.y = pk2(Nn[2], Nn[3]); *(u32x2*)(rec + CR_N + (16 * sq + t) * 8) = w; }
    LAS unsigned short* TAh = (LAS unsigned short*)Bt; LAS unsigned short* GHh = TAh + 1024;
#pragma unroll
    for (int tt = 0; tt < 16; ++tt) { float ta = 0.f, gh = rt[tt];
#pragma unroll
        for (int s4 = 0; s4 < 4; ++s4) { const f32x4 t4 = *(const LAS f32x4*)(m2 + tt * 16 + s4 * 4), p4 = *(const LAS f32x4*)(m3 + tt * 16 + s4 * 4);
            ta += t4[0] * at[s4 * 4] + t4[1] * at[s4 * 4 + 1] + t4[2] * at[s4 * 4 + 2] + t4[3] * at[s4 * 4 + 3];
            gh += p4[0] * at[s4 * 4] + p4[1] * at[s4 * 4 + 1] + p4[2] * at[s4 * 4 + 2] + p4[3] * at[s4 * 4 + 3]; }
        TAh[tt * 64 + lane] = f2bf(ta); GHh[tt * 64 + lane] = f2bf(gh); }
    LDS_WAIT(); asm volatile("" ::: "memory");
    { const int r = lane & 15, g = lane >> 4;
#pragma unroll
      for (int ks = 0; ks < 2; ++ks) { const u32x2 a0 = *(const LAS u32x2*)(TAh + r * 64 + 32 * ks + 4 * g), a1 = *(const LAS u32x2*)(TAh + r * 64 + 32 * ks + 16 + 4 * g);
          *(u32x4*)(rec + CR_TA + (ks * 64 + lane) * 16) = (u32x4){a0.x, a0.y, a1.x, a1.y};
          const u32x2 g0 = *(const LAS u32x2*)(GHh + r * 64 + 32 * ks + 4 * g), g1 = *(const LAS u32x2*)(GHh + r * 64 + 32 * ks + 16 + 4 * g);
          *(u32x4*)(rec + CR_GH + (ks * 64 + lane) * 16) = (u32x4){g0.x, g0.y, g1.x, g1.y}; } }
    { const int jb = lane >> 4, r = lane & 15; float vv[16];
#pragma unroll
      for (int tt = 0; tt < 16; ++tt) { const int pos = dir ? (SEQ - 1 - 16 * c - tt) : (16 * c + tt); vv[tt] = Vp[(size_t)(b * SEQ + pos) * 512 + h * 64 + lane]; }
#pragma unroll
      for (int g = 0; g < 4; ++g) { u32x4 w; w.x = pk2(wb[4 * g], wb[4 * g + 1]); w.y = pk2(wb[4 * g + 2], wb[4 * g + 3]); w.z = pk2(wk[4 * g], wk[4 * g + 1]); w.w = pk2(wk[4 * g + 2], wk[4 * g + 3]);
          *(u32x4*)(rec + CR_WBK + (jb * 64 + 16 * g + r) * 16) = w;
          u32x2 x; x.x = pk2(vv[4 * g], vv[4 * g + 1]); x.y = pk2(vv[4 * g + 2], vv[4 * g + 3]); *(u32x2*)(rec + CR_V + (jb * 64 + 16 * g + r) * 8) = x; } }
    LDS_WAIT(); asm volatile("" ::: "memory");
}

__device__ __forceinline__ void cprep_phase(Frame& F, int layer) {
    LAS float* Lw = (LAS float*)(F.lds + F.wave * 17408);
    for (int it = F.bid * 8 + F.wave; it < 32 * 256; it += F.G * 8) { const int c = it >> 5, chain = it & 31; rwkv_cprep_item(F, chain, c, Lw); }
    asm volatile("" ::: "memory");
    for (int it = F.bid * 8 + F.wave; it < 2048; it += F.G * 8) s5_block_task<2>(F, layer, it, Lw);
}

template <class P, class T> struct RwPtr { typedef const T* type; };
template <class T> struct RwPtr<const LAS unsigned char*, T> { typedef const LAS T* type; };
struct RwOps { bf16x8 ta[2], gh[2], wbk[4]; u32x2 tm, nn, vq[2]; f32x4 wl[4]; };
template <class P> __device__ __forceinline__ void rw_load(RwOps& o, P rec, int lane, int half) {
    const int g = lane >> 4;
#pragma unroll
    for (int ks = 0; ks < 2; ++ks) { o.ta[ks] = *(const typename RwPtr<P, bf16x8>::type)(rec + CR_TA + (ks * 64 + lane) * 16); o.gh[ks] = *(const typename RwPtr<P, bf16x8>::type)(rec + CR_GH + (ks * 64 + lane) * 16); }
#pragma unroll
    for (int jb = 0; jb < 4; ++jb) { o.wbk[jb] = *(const typename RwPtr<P, bf16x8>::type)(rec + CR_WBK + (jb * 64 + lane) * 16); o.wl[jb] = *(const typename RwPtr<P, f32x4>::type)(rec + CR_WL + (jb * 16 + g * 4) * 4); }
    o.tm = *(const typename RwPtr<P, u32x2>::type)(rec + CR_TM + lane * 8); o.nn = *(const typename RwPtr<P, u32x2>::type)(rec + CR_N + lane * 8);
#pragma unroll
    for (int it = 0; it < 2; ++it) o.vq[it] = *(const typename RwPtr<P, u32x2>::type)(rec + CR_V + ((half * 2 + it) * 64 + lane) * 8);
}
__device__ __forceinline__ bf16x8 mk8(unsigned a, unsigned b, unsigned c, unsigned d) { u32x4 w = {a, b, c, d}; return *reinterpret_cast<bf16x8*>(&w); }
__device__ __forceinline__ void rw_step(const RwOps& o, f32x4 (&X)[4][2], float* ysb, const long rs, int lane) {
    const int r = lane & 15, g = lane >> 4;
    const bf16x8 tmf = mk8(o.tm.x, o.tm.y, 0u, 0u), nf = mk8(o.nn.x, o.nn.y, 0u, 0u);
#pragma unroll
    for (int it = 0; it < 2; ++it) {
        bf16x8 xb[2];
#pragma unroll
        for (int ks = 0; ks < 2; ++ks) xb[ks] = mk8(pk2c(X[2 * ks][it][0], X[2 * ks][it][1]), pk2c(X[2 * ks][it][2], X[2 * ks][it][3]), pk2c(X[2 * ks + 1][it][0], X[2 * ks + 1][it][1]), pk2c(X[2 * ks + 1][it][2], X[2 * ks + 1][it][3]));
        const bf16x8 vb = mk8(o.vq[it].x, o.vq[it].y, 0u, 0u);
        f32x4 U = {0.f, 0.f, 0.f, 0.f}, Y = {0.f, 0.f, 0.f, 0.f};
        U = __builtin_amdgcn_mfma_f32_16x16x32_bf16(o.ta[0], xb[0], U, 0, 0, 0); Y = __builtin_amdgcn_mfma_f32_16x16x32_bf16(o.gh[0], xb[0], Y, 0, 0, 0);
        U = __builtin_amdgcn_mfma_f32_16x16x32_bf16(o.ta[1], xb[1], U, 0, 0, 0); Y = __builtin_amdgcn_mfma_f32_16x16x32_bf16(o.gh[1], xb[1], Y, 0, 0, 0);
        U = __builtin_amdgcn_mfma_f32_16x16x32_bf16(tmf, vb, U, 0, 0, 0);       Y = __builtin_amdgcn_mfma_f32_16x16x32_bf16(nf, vb, Y, 0, 0, 0);
        const bf16x8 uvb = mk8(pk2c(U[0], U[1]), pk2c(U[2], U[3]), o.vq[it].x, o.vq[it].y);
#pragma unroll
        for (int jb = 0; jb < 4; ++jb) X[jb][it] = __builtin_amdgcn_mfma_f32_16x16x32_bf16(o.wbk[jb], uvb, X[jb][it] * o.wl[jb], 0, 0, 0);
#pragma unroll
        for (int q = 0; q < 4; ++q) ysb[(long)(4 * g + q) * rs + 16 * it + r] = Y[q];
    }
}
__device__ __forceinline__ void rwkv_scan_chunked(Frame& F, int chain, int half) {
    unsigned char* ws = F.ws; asm volatile("" : "+s"(ws)); const int dir = chain & 1, h = (chain >> 1) & 7, b = chain >> 4; const int lane = F.lane;
    const unsigned char* rec0 = ws + SC_CREC + (size_t)chain * 256 * CR_BYTES;
#ifdef DBG_RWCHK
    float* YS = (float*)(ws + WS_HN) + (size_t)dir * NTOK * 512;
#else
    float* YS = (float*)(ws + SC_YS) + (size_t)dir * NTOK * 512;
#endif
    f32x4 X[4][2];
#pragma unroll
    for (int jb = 0; jb < 4; ++jb) { X[jb][0] = (f32x4){0.f, 0.f, 0.f, 0.f}; X[jb][1] = (f32x4){0.f, 0.f, 0.f, 0.f}; }
    RwOps oa, ob;
    rw_load(oa, rec0, lane, half);
    const long rs = dir ? -512 : 512;
    for (int c = 0; c < 256; c += 2) {
        rw_load(ob, rec0 + (size_t)(c + 1) * CR_BYTES, lane, half);
        { const int pos0 = dir ? (SEQ - 1 - 16 * c) : 16 * c; rw_step(oa, X, YS + (size_t)(b * SEQ + pos0) * 512 + h * 64 + half * 32, rs, lane); }
        if (c + 2 < 256) rw_load(oa, rec0 + (size_t)(c + 2) * CR_BYTES, lane, half);
        { const int pos0 = dir ? (SEQ - 1 - 16 * (c + 1)) : 16 * (c + 1); rw_step(ob, X, YS + (size_t)(b * SEQ + pos0) * 512 + h * 64 + half * 32, rs, lane); }
    }
}

__device__ __forceinline__ void rwkv_scan_ring(Frame& F, int pair) {
    unsigned char* ws = F.ws; asm volatile("" : "+s"(ws));
    const int w = F.wave, lane = F.lane;
    LAS unsigned char* ring = F.lds;
    __syncthreads();
    if (w < 4) {
        const int chain = pair * 2 + (w >> 1), half = w & 1; const int dir = chain & 1, h = (chain >> 1) & 7, b = chain >> 4;
        float* YS = (float*)(ws + SC_YS) + (size_t)dir * NTOK * 512;
        f32x4 X[4][2];
#pragma unroll
        for (int jb = 0; jb < 4; ++jb) { X[jb][0] = (f32x4){0.f, 0.f, 0.f, 0.f}; X[jb][1] = (f32x4){0.f, 0.f, 0.f, 0.f}; }
        const long rs = dir ? -512 : 512;
        __syncthreads();
#pragma unroll 1
        for (int c = 0; c < 256; ++c) {
            RwOps o; rw_load(o, (const LAS unsigned char*)(ring + ((w >> 1) * 2 + (c & 1)) * CR_BYTES), lane, half);
            const int pos0 = dir ? (SEQ - 1 - 16 * c) : 16 * c; rw_step(o, X, YS + (size_t)(b * SEQ + pos0) * 512 + h * 64 + half * 32, rs, lane);
            __syncthreads();
        }
    } else {
        const int k = (w - 4) >> 1, part = (w - 4) & 1; const int chain = pair * 2 + k;
        const unsigned char* rec0 = ws + SC_CREC + (size_t)chain * 256 * CR_BYTES;
        LAS unsigned char* dst0 = ring + (k * 2) * CR_BYTES;
        const int i0 = (part * 64 + lane) * 16;
        u32x4 R0[6], R1[6], R2[6];
#define RW_LD(R, cc) do { const unsigned char* p_ = rec0 + (size_t)(cc) * CR_BYTES + i0; _Pragma("unroll") for (int j = 0; j < 6; ++j) if (j < 5 || i0 + 2048 * 5 < CR_BYTES) R[j] = *(const u32x4*)(p_ + 2048 * j); } while (0)
#define RW_ST(R, cc) do { LAS unsigned char* d_ = dst0 + ((cc) & 1) * CR_BYTES + i0; _Pragma("unroll") for (int j = 0; j < 6; ++j) if (j < 5 || i0 + 2048 * 5 < CR_BYTES) *(LAS u32x4*)(d_ + 2048 * j) = R[j]; } while (0)
        RW_LD(R0, 0); RW_LD(R1, 1); RW_LD(R2, 2);
        RW_ST(R0, 0); RW_LD(R0, 3);
        __syncthreads();
#pragma unroll 1
        for (int c = 0; c < 255; c += 3) {
            RW_ST(R1, c + 1); if (c + 4 < 256) RW_LD(R1, c + 4); __syncthreads();
            RW_ST(R2, c + 2); if (c + 5 < 256) RW_LD(R2, c + 5); __syncthreads();
            RW_ST(R0, c + 3); if (c + 6 < 256) RW_LD(R0, c + 6); __syncthreads();
        }
        __syncthreads();
#undef RW_LD
#undef RW_ST
    }
}

__device__ __forceinline__ void rwkv_scan_naive(Frame& F, int chain) {
    unsigned char* ws = F.ws; const float* RW = (const float*)(ws + SC_RW); const size_t N1 = (size_t)NTOK * 512;
    const int dir = chain & 1, h = (chain >> 1) & 7, b = chain >> 4;
    const float* Rp = RW; const float* Vp = RW + N1; const float* KKp = RW + 2 * N1; const float* Wp = RW + (3 + dir) * N1; const float* KMp = RW + (5 + dir) * N1; const float* BBp = RW + (7 + dir) * N1;
    float* YS = (float*)(ws + SC_YS) + (size_t)dir * N1;
    LAS float* L = (LAS float*)(F.lds + F.wave * 2048);
    float st[64];
#pragma unroll
    for (int j = 0; j < 64; ++j) st[j] = 0.f;
    size_t idx = (size_t)(b * SEQ + (dir ? SEQ - 1 : 0)) * 512 + h * 64 + F.lane;
    float va = -KKp[idx], vw = __expf(Wp[idx]), vb = BBp[idx], vk = KMp[idx], vr = Rp[idx], vv = Vp[idx];
    for (int t = 0; t < SEQ; ++t) {
        L[F.lane] = va; L[64 + F.lane] = vw; L[128 + F.lane] = vb; L[192 + F.lane] = vk; L[256 + F.lane] = vr;
        const float v = vv; const size_t oidx = idx;
        if (t + 1 < SEQ) { idx = dir ? idx - 512 : idx + 512; va = -KKp[idx]; vw = __expf(Wp[idx]); vb = BBp[idx]; vk = KMp[idx]; vr = Rp[idx]; vv = Vp[idx]; }
        LDS_WAIT(); asm volatile("" ::: "memory");
        float sa0 = 0.f, sa1 = 0.f, sa2 = 0.f, sa3 = 0.f;
#pragma unroll
        for (int j = 0; j < 64; j += 4) { const f32x4 x = *(const LAS f32x4*)(L + j); sa0 += st[j] * x[0]; sa1 += st[j + 1] * x[1]; sa2 += st[j + 2] * x[2]; sa3 += st[j + 3] * x[3]; }
        const float sa = (sa0 + sa1) + (sa2 + sa3);
        float y0 = 0.f, y1 = 0.f, y2 = 0.f, y3 = 0.f;
#pragma unroll
        for (int j = 0; j < 64; j += 4) { const f32x4 w4 = *(const LAS f32x4*)(L + 64 + j), b4 = *(const LAS f32x4*)(L + 128 + j), k4 = *(const LAS f32x4*)(L + 192 + j), r4 = *(const LAS f32x4*)(L + 256 + j);
            st[j] = st[j] * w4[0] + (sa * b4[0] + v * k4[0]); st[j + 1] = st[j + 1] * w4[1] + (sa * b4[1] + v * k4[1]); st[j + 2] = st[j + 2] * w4[2] + (sa * b4[2] + v * k4[2]); st[j + 3] = st[j + 3] * w4[3] + (sa * b4[3] + v * k4[3]);
            y0 += st[j] * r4[0]; y1 += st[j + 1] * r4[1]; y2 += st[j + 2] * r4[2]; y3 += st[j + 3] * r4[3]; }
        YS[oidx] = (y0 + y1) + (y2 + y3);
        asm volatile("" ::: "memory");
    }
}

__device__ __forceinline__ void s5_unit(Frame& F, ArgsP a, int layer, int unit) {
    unsigned char* ws = F.ws; asm volatile("" : "+s"(ws)); const bf16* Z = (const bf16*)(ws + SC_Z);
    const int b = unit / S5NCH, ch = unit % S5NCH; const int tok0 = b * SEQ + ch * S5CH;
    LAS float* ybuf = (LAS float*)F.lds;
    LAS float* glT = (LAS float*)(F.lds + 32768);
    LAS float* xs = (LAS float*)(F.lds + 65536 + F.wave * 8192);
    const float* ab = (const float*)(ws + WS_S5P + layer * S5P_LAYER); const float* bb = ab + 2 * 32 * 64 * 2;
    const float* carry = (const float*)(ws + SC_CARRY);
    const int n = F.lane;
    __syncthreads();
    LAS float* ulw = (LAS float*)(F.lds + RING_BYTES + F.wave * 1024);
    for (int gi = 0; gi < 4; ++gi) {
        const int g = gi * 8 + F.wave;
        { const int tl = (n >> 1) & 15, hf = n & 1; const u32x4 w0 = *(const u32x4*)(Z + (size_t)(tok0 + tl) * ZLD + ZD + g * 16 + hf * 8);
          if (n < 32) { LAS f32x4* d = (LAS f32x4*)(ulw + tl * 16 + hf * 8);
            d[0] = (f32x4){__uint_as_float(w0.x << 16), __uint_as_float(w0.x & 0xffff0000u), __uint_as_float(w0.y << 16), __uint_as_float(w0.y & 0xffff0000u)};
            d[1] = (f32x4){__uint_as_float(w0.z << 16), __uint_as_float(w0.z & 0xffff0000u), __uint_as_float(w0.w << 16), __uint_as_float(w0.w & 0xffff0000u)}; } }
        float abr2[2], abi2[2], cr2[2], ci2[2];
#pragma unroll
        for (int dir = 0; dir < 2; ++dir) { const int pr = (dir * 32 + g) * 64 + n; abr2[dir] = ab[pr * 2]; abi2[dir] = ab[pr * 2 + 1];
            const float* cp = carry + ((((size_t)dir * BATCH + b) * S5NCH + ch) * 32 + g) * 128 + n * 2; cr2[dir] = cp[0]; ci2[dir] = cp[1]; }
        LDS_WAIT(); asm volatile("" ::: "memory");
#pragma unroll
        for (int dir = 0; dir < 2; ++dir) {
            const int pr = (dir * 32 + g) * 64 + n; const float abr = abr2[dir], abi = abi2[dir];
            float bbr[16], bbi[16];
            { const f32x4* bp = (const f32x4*)(bb + (size_t)pr * 32);
#pragma unroll
              for (int c4 = 0; c4 < 8; ++c4) { const f32x4 q = bp[c4]; bbr[c4 * 2] = q[0]; bbi[c4 * 2] = q[1]; bbr[c4 * 2 + 1] = q[2]; bbi[c4 * 2 + 1] = q[3]; } }
            float xr = cr2[dir], xi = ci2[dir];
#pragma unroll 2
            for (int i = 0; i < S5CH; ++i) { const int tl = dir ? (S5CH - 1 - i) : i;
                const f32x4 u0 = *(const LAS f32x4*)(ulw + tl * 16), u1 = *(const LAS f32x4*)(ulw + tl * 16 + 4), u2 = *(const LAS f32x4*)(ulw + tl * 16 + 8), u3 = *(const LAS f32x4*)(ulw + tl * 16 + 12);
                float br = 0.f, bi = 0.f;
#pragma unroll
                for (int c = 0; c < 4; ++c) { br += bbr[c] * u0[c] + bbr[4 + c] * u1[c] + bbr[8 + c] * u2[c] + bbr[12 + c] * u3[c]; bi += bbi[c] * u0[c] + bbi[4 + c] * u1[c] + bbi[8 + c] * u2[c] + bbi[12 + c] * u3[c]; }
                const float nr = abr * xr - abi * xi + br, ni = abr * xi + abi * xr + bi; xr = nr; xi = ni;
                LAS float* xp = xs + (tl * 64 + n) * 2;
                if (dir == 0) { xp[0] = xr; xp[1] = xi; } else { xp[0] += xr; xp[1] += xi; } }
        }
        LDS_WAIT(); asm volatile("" ::: "memory");
        { const int c = F.lane & 15, sq = F.lane >> 4; const float* cre = a->in[I_S5_C_RE] + (((size_t)layer * 32 + g) * 16 + c) * 64; const float* cim = a->in[I_S5_C_IM] + (((size_t)layer * 32 + g) * 16 + c) * 64;
          float y[4] = {0.f, 0.f, 0.f, 0.f};
#pragma unroll 4
          for (int nn = 0; nn < 64; nn += 4) { const f32x4 cr = *(const f32x4*)(cre + nn), ci = *(const f32x4*)(cim + nn);
#pragma unroll
              for (int s = 0; s < 4; ++s) { const LAS f32x4* xp = (const LAS f32x4*)(xs + ((sq * 4 + s) * 64 + nn) * 2); const f32x4 xa = xp[0], xb = xp[1];
                  y[s] += cr[0] * xa[0] - ci[0] * xa[1] + cr[1] * xa[2] - ci[1] * xa[3] + cr[2] * xb[0] - ci[2] * xb[1] + cr[3] * xb[2] - ci[3] * xb[3]; } }
          const float dsk = a->in[I_S5_D][(size_t)layer * 512 + g * 16 + c];
#pragma unroll
          for (int s = 0; s < 4; ++s) { const int tl = sq * 4 + s; const float uu = ulw[tl * 16 + c]; const float yy = y[s] + dsk * uu;
              const float x3 = yy * yy * yy; const float gl = 0.5f * yy * (1.f + tanhf(0.7978845608028654f * (yy + 0.044715f * x3)));
              ybuf[tl * 512 + g * 16 + c] = gl; glT[(g * 16 + c) * 16 + tl] = gl; } }
        LDS_WAIT(); asm volatile("" ::: "memory");
    }
    __syncthreads();
    { const int c = F.tid; const __amdgpu_buffer_rsrc_t gw = make_rsrc(a->in[I_S5_GLU_W] + (size_t)layer * 512 * 512, 512 * 512 * 4); float acc[16];
#pragma unroll
      for (int s = 0; s < 16; ++s) acc[s] = 0.f;
#pragma unroll 1
      for (int k0 = 0; k0 < 512; k0 += 16) { float wv[16];
#pragma unroll
          for (int q = 0; q < 16; ++q) wv[q] = bload_f32(gw, c * 4, (k0 + q) * 2048);
#pragma unroll
          for (int kk = 0; kk < 16; ++kk) { const float w = wv[kk]; const LAS f32x4* gp = (const LAS f32x4*)(glT + (k0 + kk) * 16); const f32x4 g0 = gp[0], g1 = gp[1], g2 = gp[2], g3 = gp[3];
#pragma unroll
              for (int q = 0; q < 4; ++q) { acc[q] += g0[q] * w; acc[4 + q] += g1[q] * w; acc[8 + q] += g2[q] * w; acc[12 + q] += g3[q] * w; }
              if (kk & 1) asm volatile("" ::: "memory"); } }
      int c2 = c; asm volatile("" : "+v"(c2));
      const float bias = a->in[I_S5_GLU_B][(size_t)layer * 512 + c2];
      __syncthreads();
#pragma unroll
      for (int s = 0; s < 16; ++s) { const float gl = ybuf[s * 512 + c]; ybuf[s * 512 + c] = gl * sigmoidf_(acc[s] + bias); } }
    __syncthreads();
    { const float* gn = a->in[I_MIX_OUT_NORM] + ((size_t)layer * 2 + 1) * 512; bf16* MIX = (bf16*)(ws + WS_MIX);
#pragma unroll
      for (int q = 0; q < 2; ++q) { const int tl = F.wave * 2 + q; float v[8]; float s = 0.f;
#pragma unroll
          for (int j = 0; j < 8; ++j) { v[j] = ybuf[tl * 512 + j * 64 + F.lane]; s += v[j] * v[j]; }
          const float rstd = 1.f / sqrtf(wave_sum(s) * (1.f / 512.f) + RMS_EPS);
#pragma unroll
          for (int j = 0; j < 8; ++j) MIX[(size_t)(tok0 + tl) * DM + 1536 + j * 64 + F.lane] = f2bf(v[j] * rstd * gn[j * 64 + F.lane]); } }
}

template <int mask>
__device__ __forceinline__ void mix_phase(Frame& F, ArgsP a, int layer, const int rep) {
    const int qb_ = (rep * 2 + layer) * 8;
    constexpr int NB = 16, NA = BATCH * 4 * (SEQ / 128), NC = BATCH * 4 * 48, ND = BATCH * S5NCH;
    if (mask & 1) for (;;) { const int it = q_next(F, qb_ + 1); if (it >= NB) break; rwkv_scan_ring(F, it); }
    if (mask & 2) for (;;) { const int it = q_next(F, qb_ + 2); if (it >= NA) break;
        unsigned char* ws = F.ws; asm volatile("" : "+s"(ws)); const bf16* Z = (const bf16*)(ws + SC_Z);
        const int qb = it % (SEQ / 128), h = (it / (SEQ / 128)) % 4, b = it / (4 * (SEQ / 128));
        const bf16* zb = Z + (size_t)(b * SEQ) * ZLD + ZA;
        float lam, lam_init;
        { const float* lv = a->in[I_DIFF_LAMBDA] + (size_t)layer * 4 * 64; float d1 = 0.f, d2 = 0.f;
          for (int i = 0; i < 64; ++i) { d1 += lv[i] * lv[64 + i]; d2 += lv[128 + i] * lv[192 + i]; }
          lam_init = 0.8f - 0.6f * expf(-0.3f * (float)layer); lam = expf(d1) - expf(d2) + lam_init; }
        att::diff_attn_unit(zb + (size_t)(qb * 128) * ZLD + h * 128, zb + 512 + h * 128, zb + 1024 + h * 128, ZLD, SEQ,
                            (bf16*)(ws + WS_MIX) + (size_t)(b * SEQ + qb * 128) * DM + h * 128, DM, lam, 1.f - lam_init, a->in[I_DIFF_SUBLN] + (size_t)layer * 128, (char*)F.lds, F.wave); }
#ifdef DBG_RWCHK
    for (;;) { const int it = q_next(F, layer * 8 + 5); if (it >= 4) break; rwkv_scan_naive(F, it * 8 + F.wave); }
#endif
    if (mask & 4) for (;;) { const int it = q_next(F, qb_ + 3); if (it >= NC) break;
        unsigned char* ws = F.ws; asm volatile("" : "+s"(ws)); const bf16* Z = (const bf16*)(ws + SC_Z);
        const int r = it % 48, h = (it / 48) % 4, b = it / (48 * 4); const int p = r / 16, rr = r % 16;
        const int dil = p == 0 ? 1 : (p == 1 ? 4 : 16); const int L = SEQ / dil; const int nqb = L / 256; const int rho = rr / nqb, qb = rr % nqb;
        const bf16* zb = Z + (size_t)(b * SEQ) * ZLD + ZC;
        att::dil_attn_unit(zb + h * 128, zb + 512 + h * 128, zb + 1024 + h * 128, ZLD, dil, rho, qb * 256, L,
                           (float*)(ws + SC_OC) + ((size_t)p * NTOK + (size_t)b * SEQ) * 512 + h * 128, (float*)(ws + SC_LSE) + ((size_t)p * NTOK + (size_t)b * SEQ) * 4 + h, (char*)F.lds, F.wave); }
    if (mask & 8) for (;;) { const int it = q_next(F, qb_ + 4); if (it >= ND) break; s5_unit(F, a, layer, it); }
}

__device__ __forceinline__ void post_phase(Frame& F, ArgsP a, int layer) {
    unsigned char* ws = F.ws; bf16* MIX = (bf16*)(ws + WS_MIX);
    const int gw = F.bid * 8 + F.wave, NGW = F.G * 8;
    const float* RW = (const float*)(ws + SC_RW); const size_t N1 = (size_t)NTOK * 512; const float* YS = (const float*)(ws + SC_YS);
#ifdef DBG_RWCHK
    { const float* Y2 = (const float*)(ws + WS_HN); float e = 0.f, r2 = 0.f; int bad = 0;
      for (size_t i = (size_t)F.bid * 512 + F.tid; i < (size_t)2 * NTOK * 512; i += (size_t)F.G * 512) { const float a0 = ((const float*)(ws + SC_YS))[i], b0 = Y2[i]; const float d = fabsf(a0 - b0); if (!(d < 1e30f)) bad = 1; else e = fmaxf(e, d); r2 = fmaxf(r2, fabsf(a0)); }
      e = wave_max(e); r2 = wave_max(r2); bad = __any(bad) ? 1 : 0;
      if (F.lane == 0) { atomicMax(F.ctl + 32768 + layer * 64, __float_as_uint(e)); atomicMax(F.ctl + 32768 + layer * 64 + 1, __float_as_uint(r2)); if (bad) atomicMax(F.ctl + 32768 + layer * 64 + 2, 1u); } }
#endif
    for (int it = gw; it < NTOK * 8; it += NGW) { const int tok = it >> 3, h = it & 7; const size_t o = (size_t)tok * 512 + h * 64 + F.lane; const int c = h * 64 + F.lane;
        const float y = YS[o] + YS[N1 + o];
        const float mean = wave_sum(y) * (1.f / 64.f); const float d = y - mean; const float var = wave_sum(d * d) * (1.f / 64.f);
        const float yn = d * (1.f / sqrtf(var + 64e-5f)) * a->in[I_RWKV_LNX_W][(size_t)layer * 512 + c] + a->in[I_RWKV_LNX_B][(size_t)layer * 512 + c];
        const float r_ = RW[o], v_ = RW[N1 + o], kb = 0.5f * (RW[5 * N1 + o] + RW[6 * N1 + o]);
        const float bon = wave_sum(r_ * kb * a->in[I_RWKV_RK][(size_t)layer * 512 + c]) * v_;
        MIX[(size_t)tok * DM + 512 + c] = f2bf((yn + bon) * RW[9 * N1 + o]); }
    const float* OC = (const float*)(ws + SC_OC); const float* LSE = (const float*)(ws + SC_LSE); const float* gn = a->in[I_MIX_OUT_NORM] + ((size_t)layer * 2 + 0) * 512;
    for (int tok = gw; tok < NTOK; tok += NGW) { const int h = F.lane >> 4;
        const float l0 = LSE[((size_t)0 * NTOK + tok) * 4 + h], l1 = LSE[((size_t)1 * NTOK + tok) * 4 + h], l2 = LSE[((size_t)2 * NTOK + tok) * 4 + h];
        const float m = fmaxf(l0, fmaxf(l1, l2)); float w0 = __expf(l0 - m), w1 = __expf(l1 - m), w2 = __expf(l2 - m); const float inv = 1.f / (w0 + w1 + w2); w0 *= inv; w1 *= inv; w2 *= inv;
        float v[8]; float s = 0.f;
        const f32x4* p0 = (const f32x4*)(OC + ((size_t)0 * NTOK + tok) * 512) + F.lane * 2; const f32x4* p1 = (const f32x4*)(OC + ((size_t)1 * NTOK + tok) * 512) + F.lane * 2; const f32x4* p2 = (const f32x4*)(OC + ((size_t)2 * NTOK + tok) * 512) + F.lane * 2;
#pragma unroll
        for (int j = 0; j < 2; ++j) { const f32x4 a0 = p0[j], a1 = p1[j], a2 = p2[j];
#pragma unroll
            for (int e = 0; e < 4; ++e) { const float x = w0 * a0[e] + w1 * a1[e] + w2 * a2[e]; v[j * 4 + e] = x; s += x * x; } }
        const float rstd = 1.f / sqrtf(wave_sum(s) * (1.f / 512.f) + RMS_EPS);
        const f32x4 g0 = *((const f32x4*)gn + F.lane * 2), g1 = *((const f32x4*)gn + F.lane * 2 + 1);
        u32x4 w; w.x = pk2(v[0] * rstd * g0[0], v[1] * rstd * g0[1]); w.y = pk2(v[2] * rstd * g0[2], v[3] * rstd * g0[3]); w.z = pk2(v[4] * rstd * g1[0], v[5] * rstd * g1[1]); w.w = pk2(v[6] * rstd * g1[2], v[7] * rstd * g1[3]);
        *(u32x4*)(MIX + (size_t)tok * DM + 1024 + F.lane * 8) = w; }
}

#ifndef MK_FUSED
#define MK_FUSED 1
#endif
__global__ void __launch_bounds__(512, 2) enc_fwd(Args args_) {
    extern __shared__ __attribute__((aligned(16))) unsigned char lds_raw[];
    Frame F;
    F.lds = (LAS unsigned char*)lds_raw; F.MISC = (volatile LAS unsigned*)(F.lds + MISC_OFF);
    F.tid = threadIdx.x; F.lane = F.tid & 63; F.wave = __builtin_amdgcn_readfirstlane(F.tid >> 6); F.G = gridDim.x; F.bid = blockIdx.x;
    const int wave0 = F.wave;
    ArgsP ap = (ArgsP)__builtin_amdgcn_kernarg_segment_ptr();
    unsigned char* ws = ap->ws; F.ws = ws; F.ctl = (unsigned*)(ws + WS_CTL);
    for (int u = F.tid; u < (LDS_BYTES - MISC_OFF) / 4; u += 512) ((LAS unsigned*)(F.lds + MISC_OFF))[u] = 0u;
    __syncthreads();
    const int lo = ap->ph_lo, hi = ap->ph_hi;
    if (hi - lo > 1) (void)xcd_barrier_post(F.ctl + CW_BAR, F.MISC + 8);
#ifdef DBG_ONLY
#define IN(k) (((k) < PH_L0 ? (k) : ((k) == PH_FINAL ? 100 : 3 + ((k) - PH_L0) % NPH_L)) == DBG_ONLY && lo <= (k) && (k) < hi)
#else
#define IN(k) ({ int lo_ = lo, hi_ = hi; asm volatile("" : "+s"(lo_), "+s"(hi_)); lo_ <= (k) && (k) < hi_; })
#endif
#define args (*ap)
#define REFRESH() do { int wv_ = wave0, bi_ = blockIdx.x, gg_ = gridDim.x; asm volatile("" : "+s"(wv_), "+s"(bi_), "+s"(gg_)); const int t_ = tid_from_wave(wv_); F.tid = t_; F.lane = t_ & 63; F.wave = wv_; F.bid = bi_; F.G = gg_; ap = (ArgsP)__builtin_amdgcn_kernarg_segment_ptr(); asm volatile("" : "+s"(ap)); unsigned char* w_ = ap->ws; F.ws = w_; ws = w_; F.ctl = (unsigned*)(w_ + WS_CTL); } while (0)
#ifndef DBG_MIXMASK
#define DBG_MIXMASK 15
#endif
#ifndef DBG_REP_CODE
#define DBG_REP_CODE -1
#define DBG_REP_N 0
#endif
#define REPS(code) (((code) == DBG_REP_CODE && l_ == 0) ? 1 + DBG_REP_N : 1)
#ifdef DBG_TIME_A
#define STAMP(k) do { if (blockIdx.x == 0 && threadIdx.x == 0) { const unsigned long long t_ = wall_clock64(); F.MISC[192 + 2 * (k)] = (unsigned)t_; F.MISC[193 + 2 * (k)] = (unsigned)(t_ >> 32); } } while (0)
#else
#define STAMP(k) do {} while (0)
#endif
#define SEAM(k) do { if (IN(k) && IN((k) + 1)) { XcdBarrier b_; b_.bar = (unsigned*)(ap->ws + WS_CTL) + CW_BAR; b_.x = xb_xcc_id(); b_.st = F.MISC + 8; xcd_barrier(b_); } } while (0)

    { const int l_ = 0; STAMP(PH_P0); if (IN(PH_P0)) { REFRESH(); for (int rep = 0; rep < REPS(0); ++rep) p0_prologue(F, ap); } } SEAM(PH_P0);
    if (DBG_REP_CODE == 30 && hi - lo > 1) { for (int i = 0; i < 20; ++i) { XcdBarrier b_; b_.bar = (unsigned*)(ap->ws + WS_CTL) + CW_BAR; b_.x = xb_xcc_id(); b_.st = F.MISC + 8; xcd_barrier(b_); } }
    STAMP(PH_P1); if (IN(PH_P1)) { REFRESH();
        SchedBatch S{(const char*)(ws + SC_MEMN), (const char*)(ws + SC_WKVT), (char*)(ws + SC_KVB), (size_t)512 * DM * 2, (size_t)4096 * DM * 2, (size_t)512 * 4096 * 2, 2, 16, DEPTH, F.G, F.bid, DM, DM, 4096 * 2, 2, 512};
        { const int l_ = 0; for (int rep = 0; rep < REPS(1); ++rep) pg8::gemm_phase<pg8::EpiBf16, SchedBatch, false>(F.lds, pg8::GemmP{DM, DM, DM}, S, pg8::EpiBf16{4096}, F.wave); }
    } SEAM(PH_P1);
    STAMP(PH_P2); if (IN(PH_P2)) { REFRESH();
        { SchedXaPre S{ws, F.G, F.bid, 0}; pg8::gemm_phase<EpiBf16U, SchedXaPre, false>(F.lds, pg8::GemmP{512, 4096, DM}, S, EpiBf16U{}, F.wave); }
        { SchedXaPre S{ws, F.G, F.bid, 1}; pg8::gemm_phase<EpiBf16U, SchedXaPre, false>(F.lds, pg8::GemmP{512, DM, 4096}, S, EpiBf16U{}, F.wave); }
    } SEAM(PH_P2);

    for (int l = 0; l < DEPTH; ++l) {
        const int pb = PH_L0 + l * NPH_L; const int l_ = l;
        float* H = (float*)(ws + WS_H);
        STAMP(pb + LP_NORM1); if (IN(pb + LP_NORM1)) { REFRESH(); if (l == 0) { for (int rep = 0; rep < REPS(22); ++rep) norm_phase<0>(F, ap, args.in[I_X], args.in[I_NORM_MIX], l); } else norm_phase<1>(F, ap, H, args.in[I_NORM_MIX] + (size_t)l * DM, l); } SEAM(pb + LP_NORM1);
        STAMP(pb + LP_G1); if (IN(pb + LP_G1)) { REFRESH();
            SchedDense S{(const char*)(ws + WS_HN), (const char*)(ws + WS_WIN) + (size_t)l * ZLD * DM * 2, (char*)(ws + SC_Z), NTOK / 256, ZLD / 256, F.G, F.bid, DM, DM, ZLD * 2, 2};
            for (int rep = 0; rep < REPS(10); ++rep) pg8::gemm_phase<pg8::EpiBf16, SchedDense, false>(F.lds, pg8::GemmP{DM, DM, DM}, S, pg8::EpiBf16{ZLD}, F.wave);
        } SEAM(pb + LP_G1);
        STAMP(pb + LP_PREP); if (IN(pb + LP_PREP)) { REFRESH(); for (int rep = 0; rep < REPS(11); ++rep) prep_phase(F, ap, l, rep); } SEAM(pb + LP_PREP);
        STAMP(pb + LP_CPREP); if (IN(pb + LP_CPREP)) { REFRESH(); for (int rep = 0; rep < REPS(12); ++rep) cprep_phase(F, l); } SEAM(pb + LP_CPREP);
        STAMP(pb + LP_MIX); if (IN(pb + LP_MIX)) { REFRESH(); mix_phase<DBG_MIXMASK>(F, ap, l, 0); if (DBG_REP_CODE >= 13 && DBG_REP_CODE <= 16 && l_ == 0) { REFRESH(); mix_phase<(DBG_REP_CODE >= 13 && DBG_REP_CODE <= 16) ? (1 << (DBG_REP_CODE - 13)) : 1>(F, ap, l, 1); if (DBG_REP_N > 1) { REFRESH(); mix_phase<(DBG_REP_CODE >= 13 && DBG_REP_CODE <= 16) ? (1 << (DBG_REP_CODE - 13)) : 1>(F, ap, l, 2); } } } SEAM(pb + LP_MIX);
        STAMP(pb + LP_POST); if (IN(pb + LP_POST)) { REFRESH(); for (int rep = 0; rep < REPS(17); ++rep) post_phase(F, ap, l); } SEAM(pb + LP_POST);
        STAMP(pb + LP_G2); if (IN(pb + LP_G2)) { REFRESH();
            SchedDense S{(const char*)(ws + WS_MIX), (const char*)(ws + WS_WOUT) + (size_t)l * DM * DM * 2, (char*)H, NTOK / 256, DM / 256, F.G, F.bid, DM, DM, DM * 4, 4};
            for (int rep = 0; rep < REPS(23); ++rep) pg8::gemm_phase<pg8::EpiF32Res, SchedDense, false>(F.lds, pg8::GemmP{DM, DM, DM}, S, pg8::EpiF32Res{DM, l == 0 ? args.in[I_X] : (const float*)H, H}, F.wave);
        } SEAM(pb + LP_G2);
        STAMP(pb + LP_NORM2); if (IN(pb + LP_NORM2)) { REFRESH(); for (int rep = 0; rep < REPS(18); ++rep) norm_phase<0>(F, ap, H, args.in[I_NORM_CROSS] + (size_t)l * DM, l); } SEAM(pb + LP_NORM2);
        STAMP(pb + LP_GS); if (IN(pb + LP_GS)) { REFRESH();
            SchedBatch S{(const char*)(ws + WS_HN), (const char*)(ws + WS_WQK) + (size_t)l * 2 * 1024 * DM * 2, (char*)(ws + WS_P), (size_t)SEQ * DM * 2, (size_t)1024 * DM * 2, (size_t)SEQ * 1024 * 2, SEQ / 256, 4, BATCH, F.G, F.bid, DM, DM, 1024 * 2, 2, SEQ};
            for (int rep = 0; rep < REPS(19); ++rep) pg8::gemm_phase<pg8::EpiSoftmax, SchedBatch, false>(F.lds, pg8::GemmP{DM, DM, DM}, S, pg8::EpiSoftmax{1024, 0.044194173824159216f * 1.4426950408889634f}, F.wave);
        } SEAM(pb + LP_GS);
        STAMP(pb + LP_GO); if (IN(pb + LP_GO)) { REFRESH();
            SchedBatch S{(const char*)(ws + WS_P), (const char*)(ws + WS_VWO) + (size_t)l * 2 * DM * 1024 * 2, (char*)H, (size_t)SEQ * 1024 * 2, (size_t)DM * 1024 * 2, (size_t)SEQ * DM * 4, SEQ / 256, DM / 256, BATCH, F.G, F.bid, 1024, 1024, DM * 4, 4, SEQ};
            pg8::gemm_phase<pg8::EpiF32Res, SchedBatch, false>(F.lds, pg8::GemmP{1024, 1024, 1024}, S, pg8::EpiF32Res{DM, (const float*)H, H}, F.wave);
        } SEAM(pb + LP_GO);
        STAMP(pb + LP_NORM3); if (IN(pb + LP_NORM3)) { REFRESH(); norm_phase<2>(F, ap, H, args.in[I_NORM_MOE] + (size_t)l * DM, l); } SEAM(pb + LP_NORM3);
        STAMP(pb + LP_M1); if (IN(pb + LP_M1)) { REFRESH();
            volatile LAS int* tp = (volatile LAS int*)(F.lds + MISC_OFF + 256); volatile LAS int* cnt = tp + 40;
            moe_prefix(F, l, tp, cnt);
            SchedMoe S{ws, tp, cnt, l, F.G, F.bid, 0};
            for (int rep = 0; rep < REPS(20); ++rep) pg8::gemm_phase<pg8::EpiSwiGlu, SchedMoe, true>(F.lds, pg8::GemmP{DM, DM, DM}, S, pg8::EpiSwiGlu{DEXP}, F.wave);
        } SEAM(pb + LP_M1);
        STAMP(pb + LP_M2); if (IN(pb + LP_M2)) { REFRESH();
            volatile LAS int* tp = (volatile LAS int*)(F.lds + MISC_OFF + 256); volatile LAS int* cnt = tp + 40;
            moe_prefix(F, l, tp, cnt);
            SchedMoe S{ws, tp, cnt, l, F.G, F.bid, 1};
            for (int rep = 0; rep < REPS(21); ++rep) pg8::gemm_phase<pg8::EpiGate, SchedMoe, false>(F.lds, pg8::GemmP{DEXP, DEXP, DEXP}, S, pg8::EpiGate{DM, (const float*)(ws + WS_EGATE), nullptr}, F.wave);
        } SEAM(pb + LP_M2);
    }
#ifdef DBG_TIME_A
    STAMP(PH_FINAL);
    if (blockIdx.x == 0 && threadIdx.x == 0) { const unsigned long long ta = ((unsigned long long)F.MISC[193 + 2 * (DBG_TIME_A)] << 32) | F.MISC[192 + 2 * (DBG_TIME_A)], tb = ((unsigned long long)F.MISC[193 + 2 * (DBG_TIME_B)] << 32) | F.MISC[192 + 2 * (DBG_TIME_B)];
        __hip_atomic_store(F.ctl + 40000, (unsigned)((tb - ta + DBG_TIME_Q / 2) / DBG_TIME_Q), __ATOMIC_RELAXED, __HIP_MEMORY_SCOPE_AGENT); }
    if (hi - lo > 1) { XcdBarrier b_; b_.bar = (unsigned*)(ap->ws + WS_CTL) + CW_BAR; b_.x = xb_xcc_id(); b_.st = F.MISC + 8; xcd_barrier(b_); }
#endif
    STAMP(PH_FINAL); if (IN(PH_FINAL)) { REFRESH(); norm_phase<5>(F, ap, (const float*)(ws + WS_H), args.in[I_NORM_FINAL], DEPTH); }
#undef IN
#undef SEAM
#undef args
}

extern "C" void kernel_launch(void* const* d_in, const int* in_sizes, int n_in, void* d_out, int out_size, void* d_ws, size_t ws_size, hipStream_t stream) {
    static int grid = 0;
    if (grid == 0) {
        if (n_in != N_INPUTS || out_size != NTOK * DM || ws_size < cmax(WS_END, SC_MIX_END3)) { fprintf(stderr, "kernel_launch: built for %d inputs, out %d, ws >= %zu; got %d, %d, %zu\n", N_INPUTS, NTOK * DM, cmax(WS_END, SC_MIX_END3), n_in, out_size, ws_size); grid = -1; return; }
        int dev = 0, cus = 0, per_cu = 0;
        if (hipGetDevice(&dev) != hipSuccess || hipDeviceGetAttribute(&cus, hipDeviceAttributeMultiprocessorCount, dev) != hipSuccess) { fprintf(stderr, "kernel_launch: device query failed\n"); grid = -1; return; }
        if (hipFuncSetAttribute((const void*)enc_fwd, hipFuncAttributeMaxDynamicSharedMemorySize, LDS_BYTES) != hipSuccess) { fprintf(stderr, "kernel_launch: hipFuncSetAttribute failed\n"); grid = -1; return; }
        if (hipOccupancyMaxActiveBlocksPerMultiprocessor(&per_cu, (const void*)enc_fwd, 512, LDS_BYTES) != hipSuccess || per_cu < 1) fprintf(stderr, "kernel_launch: occupancy query says %d blocks per CU\n", per_cu);
        grid = cus;
    }
    if (grid < 0) return;
    hipMemsetAsync((char*)d_ws + WS_CTL, 0, CTL_BYTES, stream);
    Args a; memset(&a, 0, sizeof(a));
    for (int i = 0; i < N_INPUTS; ++i) a.in[i] = (const float*)d_in[i];
    a.out = (float*)d_out; a.ws = (unsigned char*)d_ws;
#if MK_FUSED
    a.ph_lo = 0; a.ph_hi = NPHASES;
    hipLaunchKernelGGL(enc_fwd, dim3(grid), dim3(512), LDS_BYTES, stream, a);
#else
    for (int p = 0; p < NPHASES; ++p) { a.ph_lo = p; a.ph_hi = p + 1; hipLaunchKernelGGL(enc_fwd, dim3(grid), dim3(512), LDS_BYTES, stream, a); }
#endif
    const hipError_t le = hipPeekAtLastError();
    if (le != hipSuccess) fprintf(stderr, "kernel_launch: launch failed: %s\n", hipGetErrorName(le));
}
```

```cpp
#include <hip/hip_runtime.h>
#include <cstdio>
#include <cstdint>
#include <cstring>

#define GAS __attribute__((address_space(1)))
#define LAS __attribute__((address_space(3)))
typedef unsigned short bf16;
typedef short bf16x8 __attribute__((ext_vector_type(8)));
typedef short s16x4 __attribute__((ext_vector_type(4)));
typedef float f32x2 __attribute__((ext_vector_type(2)));
typedef float f32x4 __attribute__((ext_vector_type(4)));
typedef float f32x16 __attribute__((ext_vector_type(16)));
typedef unsigned u32x2 __attribute__((ext_vector_type(2)));
typedef unsigned u32x4 __attribute__((ext_vector_type(4)));
typedef GAS unsigned gu32;

constexpr int DM = 2048, BATCH = 2, SEQ = 4096, NTOK = BATCH * SEQ, DEPTH = 2, NMEM = 256;
constexpr int IN_A = 1536, IN_B = 1920, IN_C = 1536, IN_D = 512, IN_TOTAL = 5504, ZLD = 5632;
constexpr int ZA = 0, ZB = 1536, ZC = 3456, ZD = 4992;
constexpr int NEXP = 32, DEXP = 512, ECAP = 8192;
constexpr int SLOT_CAP = 24576;
constexpr int S5CH = 16, S5NCH = SEQ / S5CH;
constexpr float RMS_EPS = 1e-6f;

enum { I_X = 0, I_MEM, I_NORM_MIX, I_W_IN, I_W_OUT, I_DIFF_LAMBDA, I_DIFF_SUBLN, I_RWKV_MU, I_RWKV_W0, I_RWKV_W2, I_RWKV_A0, I_RWKV_A2, I_RWKV_G2,
       I_RWKV_KK, I_RWKV_KA, I_RWKV_RK, I_RWKV_LNX_W, I_RWKV_LNX_B, I_S5_A_RE, I_S5_A_IM, I_S5_LOG_DT, I_S5_B_RE, I_S5_B_IM, I_S5_C_RE, I_S5_C_IM,
       I_S5_D, I_S5_GLU_W, I_S5_GLU_B, I_MIX_OUT_NORM, I_NORM_CROSS, I_NORM_MEM, I_XA_WQ, I_XA_WKV, I_XA_WO, I_NORM_MOE, I_ROUTER_GROUP,
       I_ROUTER_EXPERT, I_MOE_W1, I_MOE_W3, I_MOE_W2, I_NORM_FINAL, N_INPUTS };

constexpr size_t al256(size_t x) { return (x + 255) / 256 * 256; }
constexpr size_t WS_CTL = 0, CTL_BYTES = 1u << 20;
constexpr size_t WS_WIN  = WS_CTL + CTL_BYTES;
constexpr size_t WS_WOUT = WS_WIN + (size_t)DEPTH * ZLD * DM * 2;
constexpr size_t WS_WQK  = WS_WOUT + (size_t)DEPTH * DM * DM * 2;
constexpr size_t WS_VWO  = WS_WQK + (size_t)DEPTH * BATCH * 1024 * DM * 2;
constexpr size_t WS_W13  = WS_VWO + (size_t)DEPTH * BATCH * DM * 1024 * 2;
constexpr size_t WS_W2   = WS_W13 + (size_t)DEPTH * NEXP * 1024 * DM * 2;
constexpr size_t WS_ROPE = WS_W2 + (size_t)DEPTH * NEXP * DM * DEXP * 2;
constexpr size_t WS_S5P  = WS_ROPE + (size_t)SEQ * (32 + 32 + 64 + 64) * 4;
constexpr size_t S5P_LAYER = (size_t)(2 * 32 * 64 * 2 + 2 * 32 * 64 * 16 * 2 + 2 * 32 * 64 * 2) * 4;
constexpr size_t WS_LORA = al256(WS_S5P + DEPTH * S5P_LAYER);
constexpr size_t LORA_LAYER = (size_t)(2 * 512 * 64 * 2 + 512 * 128) * 2;
constexpr size_t WS_GLUT = al256(WS_LORA + DEPTH * LORA_LAYER);
constexpr size_t WS_S5CW = WS_GLUT + (size_t)DEPTH * 512 * 512 * 2;
constexpr size_t WS_H    = al256(WS_S5CW + (size_t)DEPTH * 32 * 16 * 128 * 2);
constexpr size_t WS_HN   = WS_H + (size_t)NTOK * DM * 4;
constexpr size_t WS_MIX  = WS_HN + (size_t)NTOK * DM * 2;
constexpr size_t WS_P    = WS_MIX + (size_t)NTOK * DM * 2;
constexpr size_t WS_ETOK = WS_P + (size_t)NTOK * 1024 * 2;
constexpr size_t WS_EGATE= WS_ETOK + (size_t)NEXP * ECAP * 4;
constexpr size_t WS_TINFO= WS_EGATE + (size_t)NEXP * ECAP * 4;
constexpr size_t WS_SCR  = al256(WS_TINFO + (size_t)NTOK * 16);
constexpr size_t SC_WKVT = WS_SCR;
constexpr size_t SC_MEMN = SC_WKVT + (size_t)DEPTH * 4096 * DM * 2;
constexpr size_t SC_KVB  = SC_MEMN + (size_t)DEPTH * 512 * DM * 2;
constexpr size_t SC_WQB  = SC_KVB + (size_t)DEPTH * 512 * 4096 * 2;
constexpr size_t SC_WOT  = SC_WQB + (size_t)DEPTH * DM * DM * 2;
constexpr size_t SC_PRO_END = SC_WOT + (size_t)DEPTH * DM * DM * 2;
constexpr size_t SC_Z    = WS_SCR;
constexpr size_t SC_RW   = SC_Z + (size_t)NTOK * ZLD * 2;
constexpr size_t RWSZ    = (size_t)NTOK * 512 * 4;
constexpr size_t SC_YS   = SC_RW + 10 * RWSZ;
constexpr size_t SC_OC   = SC_YS + 2 * RWSZ;
constexpr size_t SC_LSE  = SC_OC + 3 * RWSZ;
constexpr size_t SC_CARRY= SC_LSE + (size_t)3 * NTOK * 4 * 4;
constexpr size_t SC_MIX_END = SC_CARRY + (size_t)2 * BATCH * S5NCH * 32 * 64 * 2 * 4;
constexpr size_t SC_HMID = WS_SCR;
constexpr size_t SC_YBUF = SC_HMID + (size_t)SLOT_CAP * DEXP * 2;
constexpr size_t SC_MOE_END = SC_YBUF + (size_t)SLOT_CAP * DM * 2;
constexpr size_t cmax(size_t a, size_t b) { return a > b ? a : b; }
constexpr size_t WS_END = cmax(cmax(SC_PRO_END, SC_MIX_END), SC_MOE_END);

constexpr int CW_BAR = 4096;
constexpr int CW_Q = 8192;
constexpr int CW_CNT = 16384;

constexpr int RING_BYTES = 131072;
constexpr int MISC_OFF = 147456 - 1024;
constexpr int LDS_BYTES = 147456;

__device__ __forceinline__ float bf2f(unsigned short b) { return __uint_as_float(((unsigned)b) << 16); }
typedef __bf16 bf16x2_t __attribute__((ext_vector_type(2)));
__device__ __forceinline__ unsigned pk2c(float lo, float hi) { bf16x2_t v = {(__bf16)lo, (__bf16)hi}; return __builtin_bit_cast(unsigned, v); }
__device__ __forceinline__ unsigned pk2(float lo, float hi) { unsigned r; asm volatile("v_cvt_pk_bf16_f32 %0, %1, %2" : "=v"(r) : "v"(lo), "v"(hi)); return r; }
__device__ __forceinline__ bf16 f2bf(float f) { return (bf16)(pk2(f, 0.f) & 0xffffu); }
template <int CTRL> __device__ __forceinline__ float dpp_mov(float v) { return __builtin_bit_cast(float, __builtin_amdgcn_update_dpp(0, __builtin_bit_cast(int, v), CTRL, 0xf, 0xf, true)); }
__device__ __forceinline__ float row_sum(float v) { v += dpp_mov<0xB1>(v); v += dpp_mov<0x4E>(v); v += dpp_mov<0x141>(v); v += dpp_mov<0x140>(v); return v; }
__device__ __forceinline__ float row_max(float v) { v = fmaxf(v, dpp_mov<0xB1>(v)); v = fmaxf(v, dpp_mov<0x4E>(v)); v = fmaxf(v, dpp_mov<0x141>(v)); v = fmaxf(v, dpp_mov<0x140>(v)); return v; }
__device__ __forceinline__ float rdlane(float v, int l) { return __builtin_bit_cast(float, __builtin_amdgcn_readlane(__builtin_bit_cast(int, v), l)); }
__device__ __forceinline__ float wave_sum(float v) { v = row_sum(v); return (rdlane(v, 0) + rdlane(v, 16)) + (rdlane(v, 32) + rdlane(v, 48)); }
__device__ __forceinline__ float wave_max(float v) { v = row_max(v); return fmaxf(fmaxf(rdlane(v, 0), rdlane(v, 16)), fmaxf(rdlane(v, 32), rdlane(v, 48))); }
__device__ __forceinline__ float sigmoidf_(float x) { return 1.f / (1.f + __expf(-x)); }
#define LDS_WAIT() asm volatile("s_waitcnt lgkmcnt(0)" ::: "memory")
#define VM_WAIT() asm volatile("s_waitcnt vmcnt(0)" ::: "memory")

__device__ __forceinline__ int tid_from_wave(int wave) { int ln; asm volatile("v_mbcnt_lo_u32_b32 %0, -1, 0\n\tv_mbcnt_hi_u32_b32 %0, -1, %0" : "=v"(ln)); return wave * 64 + ln; }

typedef __attribute__((address_space(8))) void* bufrsrc_t;
__device__ __forceinline__ __amdgpu_buffer_rsrc_t make_rsrc(const void* p, unsigned bytes) { return __builtin_amdgcn_make_buffer_rsrc((void*)p, 0, bytes, 0x00020000); }
__device__ __forceinline__ float bload_f32(__amdgpu_buffer_rsrc_t r, int voff, int soff) { return __builtin_bit_cast(float, __builtin_amdgcn_raw_buffer_load_b32(r, voff, soff, 0)); }

__device__ __forceinline__ float xor_lane(float v, int lane, int m) { return __builtin_bit_cast(float, __builtin_amdgcn_ds_bpermute((lane ^ m) << 2, __builtin_bit_cast(int, v))); }
#define XB_TMO      128
#define XB_XCNT(j)  (256  + 64 * (j))
#define XB_XSUB(j)  (1280 + 64 * (j))
#define XB_XGEN(j)  (2304 + 64 * (j))
#define XB_TOP      3328
#define XB_TOPGEN   3392
#define XCD_BAR_WORDS 3456
#define XB_SPIN_CAP (1u << 18)

__device__ __forceinline__ unsigned xb_ld(unsigned* p)              { return __hip_atomic_load(p, __ATOMIC_RELAXED, __HIP_MEMORY_SCOPE_AGENT); }
__device__ __forceinline__ unsigned xb_add(unsigned* p, unsigned v) { return __hip_atomic_fetch_add(p, v, __ATOMIC_RELAXED, __HIP_MEMORY_SCOPE_AGENT); }
__device__ __forceinline__ unsigned xb_xcc_id() { return (unsigned)__builtin_amdgcn_s_getreg((3 << 11) | 20) & 0xFu; }
#define XB_SPIN(cond, bar) do { unsigned _sp = 0; while (cond) { __builtin_amdgcn_s_sleep(1); \
    if ((++_sp & 255u) == 0u) { if (xb_ld(&(bar)[XB_TMO])) break; if (_sp > XB_SPIN_CAP) { atomicAdd(&(bar)[XB_TMO], 1u); break; } } } } while (0)

struct XcdBarrier {
    unsigned* bar; unsigned x;
    volatile LAS unsigned* st;
};

__device__ __forceinline__ XcdBarrier xcd_barrier_post(unsigned* bar, volatile LAS unsigned* st) {
    XcdBarrier b; b.bar = bar; b.x = xb_xcc_id(); b.st = st;
    if (threadIdx.x == 0) (void)xb_add(&bar[XB_XCNT(b.x)], 1u);
    return b;
}
__device__ __forceinline__ void xcd_barrier_complete(unsigned* bar, unsigned x, unsigned& nloc, unsigned& nx) {
    const unsigned G = gridDim.x * gridDim.y * gridDim.z;
    unsigned sum, cnt, mine, sp = 0u;
    for (;;) {
        sum = 0u; cnt = 0u; mine = 0u;
#pragma unroll
        for (unsigned j = 0; j < 16; ++j) { const unsigned c = xb_ld(&bar[XB_XCNT(j)]); sum += c; cnt += (c > 0u) ? 1u : 0u; mine = (j == x) ? c : mine; }
        if (sum == G) break;
        __builtin_amdgcn_s_sleep(1);
        if ((++sp & 255u) == 0u) { if (xb_ld(&bar[XB_TMO])) break; if (sp > XB_SPIN_CAP) { atomicAdd(&bar[XB_TMO], 1u); break; } }
    }
    nloc = mine > 0u ? mine : 1u; nx = cnt > 0u ? cnt : 1u;
}

__device__ __forceinline__ void xcd_barrier(const XcdBarrier& b) {
    asm volatile("s_waitcnt vmcnt(0)" ::: "memory");
    __syncthreads();
    if (threadIdx.x == 0) {
        unsigned* bar = b.bar;
        __builtin_amdgcn_s_waitcnt(0);
        unsigned nloc = b.st[0], nx = b.st[1];
        if (nloc == 0u) { xcd_barrier_complete(bar, b.x, nloc, nx); b.st[0] = nloc; b.st[1] = nx; }
        const unsigned old = xb_add(&bar[XB_XSUB(b.x)], 1u);
        const unsigned gen = old / nloc;
        if (old + 1u == (gen + 1u) * nloc) {
            __builtin_amdgcn_fence(__ATOMIC_RELEASE, "agent");
            asm volatile("s_waitcnt vmcnt(0)" ::: "memory");
            const unsigned og = xb_add(&bar[XB_TOP], 1u);
            const unsigned tg = og / nx;
            if (og + 1u == (tg + 1u) * nx) xb_add(&bar[XB_TOPGEN], 1u);
            else XB_SPIN(xb_ld(&bar[XB_TOPGEN]) == tg, bar);
            __builtin_amdgcn_fence(__ATOMIC_ACQUIRE, "agent");
            xb_add(&bar[XB_XGEN(b.x)], 1u);
            asm volatile("s_waitcnt vmcnt(0)" ::: "memory");
        } else {
            XB_SPIN(xb_ld(&bar[XB_XGEN(b.x)]) == gen, bar);
            __builtin_amdgcn_fence(__ATOMIC_ACQUIRE, "agent");
            asm volatile("s_waitcnt vmcnt(0)" ::: "memory");
        }
    }
    __syncthreads();
}


namespace pg8 {
constexpr int BM = 256, BK = 64, HALF = 128, HTB = HALF * BK * 2, STAGE_BYTES = 8 * HTB, NXCD = 8, WGM = 8;
__host__ __device__ __forceinline__ int lds_byte(int r, int c) { const int st = (r >> 4) * 2 + (c >> 5), rr = r & 15, cc = c & 31, ob = rr * 64 + cc * 2; return st * 1024 + (ob ^ (((ob >> 9) & 1) << 5)); }
__host__ __device__ __forceinline__ void stage_rc(int b, int& R, int& C) { const int st = b / 1024, sb = b % 1024, swz = sb ^ (((sb >> 9) & 1) << 5); R = (st >> 1) * 16 + swz / 64; C = (st & 1) * 32 + (swz % 64) / 2; }
__host__ __device__ __forceinline__ int perm32(int rho) { const int n = rho >> 4, i = rho & 15; return 8 * (i >> 2) + 4 * n + (i & 3); }

struct Unit { const char* A; const char* B; char* C; int row0, col0, aux; };
struct GemmP { int K, lda, ldb; };

__device__ __forceinline__ void xcd_tile(int L, int nM, int nN, int& pm, int& pn) {
    const int nwg = nM * nN; int wgid = L;
    { const int q = nwg / NXCD, r = nwg % NXCD, xcd = wgid % NXCD, off = wgid / NXCD; wgid = (xcd < r ? xcd * (q + 1) : r * (q + 1) + (xcd - r) * q) + off; }
    const int nig = WGM * nN, gid = wgid / nig, fm = gid * WGM, gsz = (nM - fm) < WGM ? (nM - fm) : WGM;
    pm = fm + ((wgid % nig) % gsz); pn = (wgid % nig) / gsz;
}

typedef f32x4 Acc[2][2][4][2];

template <class Epi, class Sched, bool GATHER>
__device__ __forceinline__ void gemm_phase(LAS unsigned char* lds, const GemmP g, const Sched& S, const Epi& E, const int wave_id) {
    const int tid = tid_from_wave(wave_id), wid = __builtin_amdgcn_readfirstlane(tid >> 6), lane = tid & 63, wr = wid >> 2, wc = wid & 3, fr = lane & 15, fq = lane >> 4;
    const int K = g.K, nt = K / BK;
    int Rr[2], Cc[2]; unsigned voffB[2];
#pragma unroll
    for (int i = 0; i < 2; ++i) { int R, C; stage_rc(tid * 16 + i * 8192, R, C); const int Rb = Epi::PERM ? ((R & ~31) + perm32(R & 31)) : R;
        Rr[i] = R; Cc[i] = C; voffB[i] = (unsigned)(Rb * g.ldb + C) * 2u; }
    const size_t kstep = (size_t)(BK * 2);
    const size_t hstepB = (size_t)HALF * g.ldb * 2;
    const unsigned ldsw = (unsigned)wid * 1024u;
    const int aoff = lds_byte(wr * 64 + fr, fq * 8), boff = lds_byte(wc * 32 + fr, fq * 8);
#define PG8_SA(b, h) (((b) * 2 + (h)) * HTB)
#define PG8_SB(b, h) ((4 + (b) * 2 + (h)) * HTB)
#define PG8_STAGE_B(bufoff, gbase) do { _Pragma("unroll") for (int _i = 0; _i < 2; ++_i) \
        __builtin_amdgcn_global_load_lds((const unsigned*)((const char*)(gbase) + voffB[_i]), (LAS unsigned*)(lds + (bufoff) + ldsw + _i * 8192), 16, 0, 0); } while (0)
#define PG8_STAGE_A(bufoff, gbase, OFF, h) do { _Pragma("unroll") for (int _i = 0; _i < 2; ++_i) \
        __builtin_amdgcn_global_load_lds((const unsigned*)((const char*)(gbase) + (OFF)[h][_i]), (LAS unsigned*)(lds + (bufoff) + ldsw + _i * 8192), 16, 0, 0); } while (0)
#define PG8_OFFS(u, OFF) do { _Pragma("unroll") for (int _h = 0; _h < 2; ++_h) _Pragma("unroll") for (int _i = 0; _i < 2; ++_i) { \
        const int _row = _h * HALF + Rr[_i]; const int _src = GATHER ? S.arow((u), _row) : _row; (OFF)[_h][_i] = (unsigned)(_src * g.lda + Cc[_i]) * 2u; } } while (0)
#define PG8_LDA(dst, b, h) do { _Pragma("unroll") for (int m = 0; m < 4; ++m) _Pragma("unroll") for (int k = 0; k < 2; ++k) dst[m][k] = *(const LAS bf16x8*)(lds + PG8_SA(b, h) + aoff + m * 2048 + k * 1024); } while (0)
#define PG8_LDB(dst, b, h) do { _Pragma("unroll") for (int n = 0; n < 2; ++n) _Pragma("unroll") for (int k = 0; k < 2; ++k) dst[n][k] = *(const LAS bf16x8*)(lds + PG8_SB(b, h) + boff + n * 2048 + k * 1024); } while (0)
#define PG8_MMA(ai, bj, At, Bt) do { __builtin_amdgcn_s_setprio(1); _Pragma("unroll") for (int m = 0; m < 4; ++m) _Pragma("unroll") for (int n = 0; n < 2; ++n) _Pragma("unroll") for (int k = 0; k < 2; ++k) \
        acc[ai][bj][m][n] = __builtin_amdgcn_mfma_f32_16x16x32_bf16(Bt[n][k], At[m][k], acc[ai][bj][m][n], 0, 0, 0); __builtin_amdgcn_s_setprio(0); } while (0)
#define PG8_WAIT_V(n) asm volatile("s_waitcnt vmcnt(" #n ")" ::: "memory")
#define PG8_WAIT_L(n) asm volatile("s_waitcnt lgkmcnt(" #n ")" ::: "memory")
#define PG8_BAR __builtin_amdgcn_s_barrier()
#define PG8_SCHED __builtin_amdgcn_sched_barrier(0)
    Unit cur, nxt; int ui = 0;
    if (!S.next(0, cur)) return;
    f32x4 acc[2][2][4][2];
#pragma unroll
    for (int a = 0; a < 2; ++a)
#pragma unroll
        for (int b = 0; b < 2; ++b)
#pragma unroll
            for (int m = 0; m < 4; ++m)
#pragma unroll
                for (int n = 0; n < 2; ++n) acc[a][b][m][n] = (f32x4){0.f, 0.f, 0.f, 0.f};
    bf16x8 At[4][2], B0[2][2], B1[2][2];
    const char* cA = cur.A; const char* cB = cur.B;
    unsigned coffA[2][2], noffA[2][2];
    PG8_OFFS(cur, coffA);
    PG8_STAGE_B(PG8_SB(0, 0), cB); PG8_STAGE_A(PG8_SA(0, 0), cA, coffA, 0); PG8_STAGE_B(PG8_SB(0, 1), cB + hstepB); PG8_STAGE_A(PG8_SA(0, 1), cA, coffA, 1);
    if (wr == 1) PG8_BAR;
    PG8_WAIT_V(4); PG8_BAR;
    PG8_STAGE_B(PG8_SB(1, 0), cB + kstep); PG8_STAGE_A(PG8_SA(1, 0), cA + kstep, coffA, 0); PG8_STAGE_B(PG8_SB(1, 1), cB + hstepB + kstep);
    PG8_WAIT_V(6); PG8_BAR;
    for (;;) {
        const bool has_next = S.next(ui + 1, nxt);
        const char* nA = has_next ? nxt.A : cA; const char* nB = has_next ? nxt.B : cB;
        if (has_next) { PG8_OFFS(nxt, noffA); }
        else {
#pragma unroll
            for (int _h = 0; _h < 2; ++_h)
#pragma unroll
                for (int _i = 0; _i < 2; ++_i) noffA[_h][_i] = coffA[_h][_i]; }
        for (int t = 0; t < nt; t += 2) {
            const bool last = (t == nt - 2);
            const char* a1 = cA + (size_t)(t + 1) * kstep;
            const char* a2 = last ? nA : cA + (size_t)(t + 2) * kstep; const char* b2 = last ? nB : cB + (size_t)(t + 2) * kstep;
            const char* a3 = a2 + kstep; const char* b3 = b2 + kstep;
            unsigned o2[2][2];
#pragma unroll
            for (int _h = 0; _h < 2; ++_h)
#pragma unroll
                for (int _i = 0; _i < 2; ++_i) o2[_h][_i] = last ? noffA[_h][_i] : coffA[_h][_i];
            PG8_LDB(B0, 0, 0); PG8_SCHED; PG8_LDA(At, 0, 0); PG8_STAGE_A(PG8_SA(1, 1), a1, coffA, 1);
            PG8_WAIT_L(8); PG8_BAR; PG8_WAIT_L(0); PG8_MMA(0, 0, At, B0); PG8_BAR; PG8_SCHED;
            PG8_LDB(B1, 0, 1); PG8_STAGE_B(PG8_SB(0, 0), b2);
            PG8_BAR; PG8_WAIT_L(0); PG8_MMA(0, 1, At, B1); PG8_BAR;
            PG8_LDA(At, 0, 1); PG8_STAGE_A(PG8_SA(0, 0), a2, o2, 0);
            PG8_BAR; PG8_WAIT_L(0); PG8_MMA(1, 0, At, B0); PG8_BAR; PG8_SCHED;
            PG8_STAGE_B(PG8_SB(0, 1), b2 + hstepB);
            PG8_WAIT_V(6); PG8_BAR; PG8_MMA(1, 1, At, B1); PG8_BAR;
            PG8_LDB(B0, 1, 0); PG8_SCHED; PG8_LDA(At, 1, 0); PG8_STAGE_A(PG8_SA(0, 1), a2, o2, 1);
            PG8_WAIT_L(8); PG8_BAR; PG8_WAIT_L(0); PG8_MMA(0, 0, At, B0); PG8_BAR; PG8_SCHED;
            PG8_LDB(B1, 1, 1); PG8_STAGE_B(PG8_SB(1, 0), b3);
            PG8_BAR; PG8_WAIT_L(0); PG8_MMA(0, 1, At, B1); PG8_BAR;
            PG8_LDA(At, 1, 1); PG8_STAGE_A(PG8_SA(1, 0), a3, o2, 0);
            PG8_BAR; PG8_WAIT_L(0); PG8_MMA(1, 0, At, B0); PG8_BAR; PG8_SCHED;
            PG8_STAGE_B(PG8_SB(1, 1), b3 + hstepB);
            PG8_WAIT_V(6); PG8_BAR; PG8_MMA(1, 1, At, B1); PG8_BAR;
        }
        if constexpr (!Epi::AFTER_DRAIN) { E(acc, cur, wr, wc, fr, fq); }
        if (!has_next) break;
#pragma unroll
        for (int a = 0; a < 2; ++a)
#pragma unroll
            for (int b = 0; b < 2; ++b)
#pragma unroll
                for (int m = 0; m < 4; ++m)
#pragma unroll
                    for (int n = 0; n < 2; ++n) acc[a][b][m][n] = (f32x4){0.f, 0.f, 0.f, 0.f};
        cur = nxt; cA = nA; cB = nB; ++ui;
#pragma unroll
        for (int _h = 0; _h < 2; ++_h)
#pragma unroll
            for (int _i = 0; _i < 2; ++_i) coffA[_h][_i] = noffA[_h][_i];
    }
    PG8_WAIT_V(0);
    if (wr == 0) PG8_BAR;
    PG8_BAR;
    if constexpr (Epi::AFTER_DRAIN) { E.fused(acc, cur, wr, wc, fr, fq, lds, wid, lane); }
#undef PG8_SA
#undef PG8_SB
#undef PG8_STAGE_A
#undef PG8_STAGE_B
#undef PG8_OFFS
#undef PG8_LDA
#undef PG8_LDB
#undef PG8_MMA
#undef PG8_WAIT_V
#undef PG8_WAIT_L
#undef PG8_BAR
#undef PG8_SCHED
}

struct EpiBf16 {
    static constexpr bool PERM = true, AFTER_DRAIN = false;
    int ldc;
    __device__ __forceinline__ void operator()(const Acc& acc, const Unit& u, int wr, int wc, int fr, int fq) const {
        bf16* base = (bf16*)u.C + (size_t)(wr * 64 + fr) * ldc + wc * 32 + 8 * fq;
#pragma unroll
        for (int ai = 0; ai < 2; ++ai)
#pragma unroll
            for (int m = 0; m < 4; ++m) { bf16* rowp = base + (size_t)(ai * HALF + m * 16) * ldc;
#pragma unroll
                for (int bj = 0; bj < 2; ++bj) { const f32x4 v0 = acc[ai][bj][m][0], v1 = acc[ai][bj][m][1];
                    u32x4 w; w.x = pk2(v0[0], v0[1]); w.y = pk2(v0[2], v0[3]); w.z = pk2(v1[0], v1[1]); w.w = pk2(v1[2], v1[3]);
                    *(u32x4*)(rowp + bj * HALF) = w; } }
    }
};
struct EpiF32Res {
    static constexpr bool PERM = false, AFTER_DRAIN = false;
    int ldc; const float* resid; float* out;
    __device__ __forceinline__ void operator()(const Acc& acc, const Unit& u, int wr, int wc, int fr, int fq) const {
        const size_t o0 = (size_t)(u.row0 + wr * 64 + fr) * ldc + u.col0 + wc * 32 + 4 * fq;
#pragma unroll
        for (int ai = 0; ai < 2; ++ai)
#pragma unroll
            for (int m = 0; m < 4; ++m) { const size_t ro = o0 + (size_t)(ai * HALF + m * 16) * ldc;
#pragma unroll
                for (int bj = 0; bj < 2; ++bj)
#pragma unroll
                    for (int n = 0; n < 2; ++n) { const size_t o = ro + bj * HALF + n * 16; const f32x4 b = *(const f32x4*)(resid + o); *(f32x4*)(out + o) = acc[ai][bj][m][n] + b; } }
    }
};
struct EpiSwiGlu {
    static constexpr bool PERM = true, AFTER_DRAIN = false;
    int ldc;
    __device__ __forceinline__ void operator()(const Acc& acc, const Unit& u, int wr, int wc, int fr, int fq) const {
        bf16* base = (bf16*)u.C + (size_t)(wr * 64 + fr) * ldc + wc * 32 + 8 * fq;
#pragma unroll
        for (int ai = 0; ai < 2; ++ai)
#pragma unroll
            for (int m = 0; m < 4; ++m) { bf16* rowp = base + (size_t)(ai * HALF + m * 16) * ldc;
                float h[8];
#pragma unroll
                for (int n = 0; n < 2; ++n)
#pragma unroll
                    for (int e = 0; e < 4; ++e) { const float a = acc[ai][0][m][n][e], b = acc[ai][1][m][n][e]; h[n * 4 + e] = a / (1.f + __expf(-a)) * b; }
                u32x4 w; w.x = pk2(h[0], h[1]); w.y = pk2(h[2], h[3]); w.z = pk2(h[4], h[5]); w.w = pk2(h[6], h[7]);
                *(u32x4*)rowp = w; }
    }
};
struct EpiGate {
    static constexpr bool PERM = true, AFTER_DRAIN = false;
    int ldc; const float* egate; const int* cnt_lds_unused;
    __device__ __forceinline__ void operator()(const Acc& acc, const Unit& u, int wr, int wc, int fr, int fq) const {
        bf16* base = (bf16*)u.C + (size_t)(wr * 64 + fr) * ldc + wc * 32 + 8 * fq;
        const int e = u.aux >> 16, nvalid = u.aux & 0xffff;
        const float* gp = egate + (size_t)e * ECAP + u.row0;
#pragma unroll
        for (int ai = 0; ai < 2; ++ai)
#pragma unroll
            for (int m = 0; m < 4; ++m) { const int r = ai * HALF + wr * 64 + m * 16 + fr; const float gt = (r < nvalid) ? gp[r] : 0.f;
                bf16* rowp = base + (size_t)(ai * HALF + m * 16) * ldc;
#pragma unroll
                for (int bj = 0; bj < 2; ++bj) { const f32x4 v0 = acc[ai][bj][m][0] * gt, v1 = acc[ai][bj][m][1] * gt;
                    u32x4 w; w.x = pk2(v0[0], v0[1]); w.y = pk2(v0[2], v0[3]); w.z = pk2(v1[0], v1[1]); w.w = pk2(v1[2], v1[3]);
                    *(u32x4*)(rowp + bj * HALF) = w; } }
    }
};
struct EpiSoftmax {
    static constexpr bool PERM = true, AFTER_DRAIN = true;
    int ldc; float scale_log2e;
    __device__ __forceinline__ void operator()(const Acc&, const Unit&, int, int, int, int) const {}
    __device__ __forceinline__ void fused(const Acc& acc, const Unit& u, int wr, int wc, int fr, int fq, LAS unsigned char* lds, int wid, int lane) const {
        LAS float* RM = (LAS float*)lds;
        LAS float* RS = (LAS float*)(lds + 4096);
        float mx[2][4];
#pragma unroll
        for (int ai = 0; ai < 2; ++ai)
#pragma unroll
            for (int m = 0; m < 4; ++m) { float v = -3.0e38f;
#pragma unroll
                for (int bj = 0; bj < 2; ++bj)
#pragma unroll
                    for (int n = 0; n < 2; ++n) { const f32x4 x = acc[ai][bj][m][n]; v = fmaxf(v, fmaxf(fmaxf(x[0], x[1]), fmaxf(x[2], x[3]))); }
                v = fmaxf(v, xor_lane(v, lane, 16)); v = fmaxf(v, xor_lane(v, lane, 32));
                if (fq == 0) RM[(ai * HALF + wr * 64 + m * 16 + fr) * 4 + wc] = v; }
        asm volatile("s_waitcnt lgkmcnt(0)" ::: "memory"); __builtin_amdgcn_s_barrier(); asm volatile("" ::: "memory");
#pragma unroll
        for (int ai = 0; ai < 2; ++ai)
#pragma unroll
            for (int m = 0; m < 4; ++m) { const int row = ai * HALF + wr * 64 + m * 16 + fr; const f32x4 q = *(const LAS f32x4*)(RM + row * 4);
                const float M = fmaxf(fmaxf(q[0], q[1]), fmaxf(q[2], q[3])); const float mc = -M * scale_log2e; float s = 0.f;
#pragma unroll
                for (int bj = 0; bj < 2; ++bj)
#pragma unroll
                    for (int n = 0; n < 2; ++n)
#pragma unroll
                        for (int e = 0; e < 4; ++e) s += __builtin_amdgcn_exp2f(fmaf(acc[ai][bj][m][n][e], scale_log2e, mc));
                s += xor_lane(s, lane, 16); s += xor_lane(s, lane, 32);
                if (fq == 0) RS[row * 4 + wc] = s; }
        asm volatile("s_waitcnt lgkmcnt(0)" ::: "memory"); __builtin_amdgcn_s_barrier(); asm volatile("" ::: "memory");
        bf16* base = (bf16*)u.C + (size_t)(wr * 64 + fr) * ldc + wc * 32 + 8 * fq;
#pragma unroll
        for (int ai = 0; ai < 2; ++ai)
#pragma unroll
            for (int m = 0; m < 4; ++m) { const int row = ai * HALF + wr * 64 + m * 16 + fr; const f32x4 q = *(const LAS f32x4*)(RS + row * 4); const f32x4 qm = *(const LAS f32x4*)(RM + row * 4);
                const float M = fmaxf(fmaxf(qm[0], qm[1]), fmaxf(qm[2], qm[3])); const float mc = -M * scale_log2e;
                const float inv = 1.f / ((q[0] + q[1]) + (q[2] + q[3])); bf16* rowp = base + (size_t)(ai * HALF + m * 16) * ldc;
#pragma unroll
                for (int bj = 0; bj < 2; ++bj) { float pp[8];
#pragma unroll
                    for (int n = 0; n < 2; ++n)
#pragma unroll
                        for (int e = 0; e < 4; ++e) pp[n * 4 + e] = __builtin_amdgcn_exp2f(fmaf(acc[ai][bj][m][n][e], scale_log2e, mc)) * inv;
                    u32x4 w; w.x = pk2(pp[0], pp[1]); w.y = pk2(pp[2], pp[3]); w.z = pk2(pp[4], pp[5]); w.w = pk2(pp[6], pp[7]);
                    *(u32x4*)(rowp + bj * HALF) = w; } }
        asm volatile("s_waitcnt lgkmcnt(0)" ::: "memory"); __builtin_amdgcn_s_barrier(); asm volatile("" ::: "memory");
    }
};
}

namespace att {
constexpr int KVBLK = 64;
constexpr size_t SHM_V = KVBLK * 128 * 2, SHM_K = KVBLK * 128 * 2;
#define KSWZ(row, colB) ((row) * 256 + ((colB) ^ (((row) & 7) << 4)))
#define SBAR() __builtin_amdgcn_sched_barrier(0)
__device__ __forceinline__ int crow(int r, int hi) { return (r & 3) + 8 * (r >> 2) + 4 * hi; }
__device__ __forceinline__ bf16x8 ld8(const bf16* p) { return *reinterpret_cast<const bf16x8*>(p); }

__device__ __forceinline__ void partialSM(f32x16& p0, f32x16& p1, float& m_reg, float& mn, float& alpha, const float SCALE, const float THR) {
  const float C = SCALE * 1.4426950408889634f;
  float pmax = p0[0];
#pragma unroll
  for (int r = 1; r < 16; ++r) pmax = fmaxf(pmax, p0[r]);
#pragma unroll
  for (int r = 0; r < 16; ++r) pmax = fmaxf(pmax, p1[r]);
  { auto rr = __builtin_amdgcn_permlane32_swap(__float_as_uint(pmax), __float_as_uint(pmax), false, false);
    pmax = fmaxf(__uint_as_float(rr[0]), __uint_as_float(rr[1])); }
  if (__builtin_expect(__all(pmax - m_reg <= THR / SCALE), 1)) { mn = m_reg; alpha = 1.f; }
  else { mn = fmaxf(m_reg, pmax); alpha = __builtin_amdgcn_exp2f((m_reg - mn) * C); m_reg = mn; }
  const float mnC = -mn * C;
#pragma unroll
  for (int r = 0; r < 16; ++r) p0[r] = fmaf(p0[r], C, mnC);
#pragma unroll
  for (int r = 0; r < 16; ++r) p1[r] = fmaf(p1[r], C, mnC);
#pragma unroll
  for (int r = 0; r < 16; ++r) p0[r] = __builtin_amdgcn_exp2f(p0[r]);
}
__device__ __forceinline__ void finishSM(f32x16& p0, f32x16& p1, float alpha, float& l_reg, bf16x8& pa0, bf16x8& pa1, bf16x8& pa2, bf16x8& pa3) {
#pragma unroll
  for (int r = 0; r < 16; ++r) p1[r] = __builtin_amdgcn_exp2f(p1[r]);
  float ps = 0;
#pragma unroll
  for (int r = 0; r < 16; ++r) ps += p0[r];
#pragma unroll
  for (int r = 0; r < 16; ++r) ps += p1[r];
  { auto rr = __builtin_amdgcn_permlane32_swap(__float_as_uint(ps), __float_as_uint(ps), false, false);
    ps = __uint_as_float(rr[0]) + __uint_as_float(rr[1]); }
  l_reg = l_reg * alpha + ps;
#define PK4(P, BASE, OUT) do { unsigned a0 = pk2(P[BASE + 0], P[BASE + 1]), a1 = pk2(P[BASE + 2], P[BASE + 3]);   \
    unsigned b0 = pk2(P[BASE + 4], P[BASE + 5]), b1 = pk2(P[BASE + 6], P[BASE + 7]);                              \
    auto r0 = __builtin_amdgcn_permlane32_swap(a0, b0, false, false); auto r1 = __builtin_amdgcn_permlane32_swap(a1, b1, false, false); \
    u32x4 w = {r0[0], r1[0], r0[1], r1[1]}; OUT = *reinterpret_cast<bf16x8*>(&w); } while (0)
  PK4(p0, 0, pa0); PK4(p0, 8, pa1); PK4(p1, 0, pa2); PK4(p1, 8, pa3);
#undef PK4
}
template <int ND0> __device__ __forceinline__ void qkt(f32x16& p0, f32x16& p1, const char* Ks, const bf16x8* qr, int r32, int hi, int c0) {
  p0 = f32x16{}; p1 = f32x16{};
#pragma unroll
  for (int d0 = 0; d0 < ND0; ++d0) { const int cb = (c0 + d0 * 16 + hi * 8) * 2;
    const bf16x8 b0 = *reinterpret_cast<const bf16x8*>(Ks + KSWZ(r32, cb));
    const bf16x8 b1 = *reinterpret_cast<const bf16x8*>(Ks + KSWZ(32 + r32, cb));
    p0 = __builtin_amdgcn_mfma_f32_32x32x16_bf16(b0, qr[d0], p0, 0, 0, 0);
    p1 = __builtin_amdgcn_mfma_f32_32x32x16_bf16(b1, qr[d0], p1, 0, 0, 0); }
}
__device__ __forceinline__ int v_st(int k, int c) { const int kk = (k & ~0xC) | ((k & 4) << 1) | ((k & 8) >> 1); return ((kk >> 3) * 4 + (c >> 5)) * 512 + ((kk & 7) * 32 + (c & 31)) * 2; }
__device__ __forceinline__ int v_rd_base(int lane) { return ((lane & 3) << 3) | (((lane >> 2) & 3) << 6) | (((lane >> 4) & 1) << 5) | (((lane >> 5) & 1) << 8); }
constexpr int v_rd_off(int d0, int ks, int half) { return d0 * 512 + ks * 4096 + half * 2048; }
template <int OFF> __device__ __forceinline__ s16x4 tr_read(int vb) {
  s16x4 r; asm volatile("ds_read_b64_tr_b16 %0, %1 offset:%2" : "=&v"(r) : "v"(vb), "i"(OFF) : "memory"); return r;
}
template <int D0> __device__ __forceinline__ void pv_one(f32x16& od, int vb, bf16x8 pa0, bf16x8 pa1, bf16x8 pa2, bf16x8 pa3) {
  const s16x4 l0 = tr_read<v_rd_off(D0, 0, 0)>(vb), h0 = tr_read<v_rd_off(D0, 0, 1)>(vb), l1 = tr_read<v_rd_off(D0, 1, 0)>(vb), h1 = tr_read<v_rd_off(D0, 1, 1)>(vb);
  const s16x4 l2 = tr_read<v_rd_off(D0, 2, 0)>(vb), h2 = tr_read<v_rd_off(D0, 2, 1)>(vb), l3 = tr_read<v_rd_off(D0, 3, 0)>(vb), h3 = tr_read<v_rd_off(D0, 3, 1)>(vb);
  asm volatile("s_waitcnt lgkmcnt(0)" ::: "memory"); SBAR();
#define PK(L, H) (bf16x8){L[0], L[1], L[2], L[3], H[0], H[1], H[2], H[3]}
  od = __builtin_amdgcn_mfma_f32_32x32x16_bf16(pa0, PK(l0, h0), od, 0, 0, 0);
  od = __builtin_amdgcn_mfma_f32_32x32x16_bf16(pa1, PK(l1, h1), od, 0, 0, 0);
  od = __builtin_amdgcn_mfma_f32_32x32x16_bf16(pa2, PK(l2, h2), od, 0, 0, 0);
  od = __builtin_amdgcn_mfma_f32_32x32x16_bf16(pa3, PK(l3, h3), od, 0, 0, 0);
#undef PK
}
__device__ __forceinline__ void pv_d0(f32x16* o, int vb, bf16x8 pa0, bf16x8 pa1, bf16x8 pa2, bf16x8 pa3) {
  pv_one<0>(o[0], vb, pa0, pa1, pa2, pa3); pv_one<1>(o[1], vb, pa0, pa1, pa2, pa3); pv_one<2>(o[2], vb, pa0, pa1, pa2, pa3); pv_one<3>(o[3], vb, pa0, pa1, pa2, pa3);
}

__device__ __forceinline__ void diff_attn_unit(const bf16* Qb, const bf16* Kh, const bf16* Vh, int ld, int seq, bf16* outb, int ldo,
                                               const float lam, const float post_scale, const float* subln_g, char* lds, const int wave_id) {
  constexpr float SCALE = 0.125f, THR = 8.f;
  const int tid = tid_from_wave(wave_id), wid = __builtin_amdgcn_readfirstlane(tid >> 6), lane = tid & 63, r32 = lane & 31, hi = lane >> 5;
  const int csel = wid >> 2, wq = wid & 3;
  char* V_lds = lds; char* K_lds = lds + 2 * SHM_V;
  float* ws = (float*)(lds + 2 * SHM_V + 2 * SHM_K) + wid * 64; float* li_l = ws; float* al_l = ws + 32;
  float m_reg = -1e30f, l_reg = 0; f32x16 o[4] = {}; bf16x8 qr[4];
  const bf16* Qw = Qb + (long)(wq * 32 + r32) * ld + csel * 64 + hi * 8;
#pragma unroll
  for (int d0 = 0; d0 < 4; ++d0) qr[d0] = ld8(Qw + d0 * 16);
  const int sr = tid >> 4, sc = (tid & 15) * 8, vst0 = v_st(sr, sc), vst1 = v_st(32 + sr, sc);
  const int vb0 = (int)(uintptr_t)V_lds + v_rd_base(lane);
  const int kc0 = csel * 64;
  struct { bf16x8 vs0, vs1, ks0, ks1; } sr_[2];
#define SLOAD(i, k0) do { sr_[i].vs0 = ld8(&Vh[(long)((k0) + sr) * ld + sc]); sr_[i].vs1 = ld8(&Vh[(long)((k0) + 32 + sr) * ld + sc]); \
    sr_[i].ks0 = ld8(&Kh[(long)((k0) + sr) * ld + sc]); sr_[i].ks1 = ld8(&Kh[(long)((k0) + 32 + sr) * ld + sc]); } while (0)
#define SWRITE(b, i) do { *(bf16x8*)(V_lds + (b) * SHM_V + vst0) = sr_[i].vs0;          \
    *(bf16x8*)(V_lds + (b) * SHM_V + vst1) = sr_[i].vs1; const int kc = sc * 2;               \
    *(bf16x8*)(K_lds + (b) * SHM_K + KSWZ(sr, kc)) = sr_[i].ks0;                       \
    *(bf16x8*)(K_lds + (b) * SHM_K + KSWZ(32 + sr, kc)) = sr_[i].ks1; } while (0)
#define SWAIT() asm volatile("s_waitcnt vmcnt(4)" ::: "memory")
#define RESC(a) do { if (__any((a) < 1.f)) { if (hi == 0) al_l[r32] = (a); asm volatile("s_waitcnt lgkmcnt(0)" ::: "memory"); \
    _Pragma("unroll") for (int d = 0; d < 4; ++d) _Pragma("unroll") for (int r = 0; r < 16; ++r) o[d][r] *= al_l[crow(r, hi)]; } } while (0)
  f32x16 pA0, pA1, pB0, pB1; float mnA, mnB, alA, alB; bf16x8 pa0, pa1, pa2, pa3; const int NT = seq / KVBLK;
  constexpr int SE = 0, SO = 1;
  __syncthreads();
  SLOAD(SE, 0); asm volatile("s_waitcnt vmcnt(0)" ::: "memory"); SWRITE(0, SE); __syncthreads();
  qkt<4>(pA0, pA1, K_lds, qr, r32, hi, kc0); partialSM(pA0, pA1, m_reg, mnA, alA, SCALE, THR);
  SLOAD(SO, KVBLK); if (2 < NT) SLOAD(SE, 2 * KVBLK);
  SWAIT(); SWRITE(1, SO); __syncthreads();
  for (int j = 1; j + 1 < NT; j += 2) {
    SBAR(); qkt<4>(pB0, pB1, K_lds + SHM_K, qr, r32, hi, kc0);
    finishSM(pA0, pA1, alA, l_reg, pa0, pa1, pa2, pa3); SBAR();
    SLOAD(SO, (j + 2) * KVBLK); SBAR();
    pv_d0(o, vb0, pa0, pa1, pa2, pa3); partialSM(pB0, pB1, m_reg, mnB, alB, SCALE, THR);
    __syncthreads(); SWAIT(); SWRITE(0, SE);
    RESC(alB); __syncthreads();
    SBAR(); qkt<4>(pA0, pA1, K_lds, qr, r32, hi, kc0);
    finishSM(pB0, pB1, alB, l_reg, pa0, pa1, pa2, pa3); SBAR();
    if (j + 3 < NT) SLOAD(SE, (j + 3) * KVBLK); SBAR();
    pv_d0(o, vb0 + (int)SHM_V, pa0, pa1, pa2, pa3); partialSM(pA0, pA1, m_reg, mnA, alA, SCALE, THR);
    __syncthreads(); SWAIT(); SWRITE(1, SO);
    RESC(alA); __syncthreads();
  }
  SBAR(); qkt<4>(pB0, pB1, K_lds + SHM_K, qr, r32, hi, kc0);
  finishSM(pA0, pA1, alA, l_reg, pa0, pa1, pa2, pa3); SBAR();
  pv_d0(o, vb0, pa0, pa1, pa2, pa3); partialSM(pB0, pB1, m_reg, mnB, alB, SCALE, THR);
  __syncthreads(); RESC(alB);
  finishSM(pB0, pB1, alB, l_reg, pa0, pa1, pa2, pa3); SBAR();
  pv_d0(o, vb0 + (int)SHM_V, pa0, pa1, pa2, pa3);
  asm volatile("s_waitcnt vmcnt(0)" ::: "memory");
  if (hi == 0) li_l[r32] = l_reg; asm volatile("s_waitcnt lgkmcnt(0)" ::: "memory");
  float rli[16];
#pragma unroll
  for (int r = 0; r < 16; ++r) rli[r] = __builtin_amdgcn_rcpf(li_l[crow(r, hi)]);
  __syncthreads();
  float* X = (float*)lds + (size_t)wq * 4096;
  if (csel == 1) {
#pragma unroll
    for (int d0 = 0; d0 < 4; ++d0)
#pragma unroll
      for (int r = 0; r < 16; ++r) X[(d0 * 16 + r) * 64 + lane] = o[d0][r] * rli[r];
  }
  __syncthreads();
  if (csel == 0) {
    float ss[16];
#pragma unroll
    for (int r = 0; r < 16; ++r) ss[r] = 0.f;
#pragma unroll
    for (int d0 = 0; d0 < 4; ++d0)
#pragma unroll
      for (int r = 0; r < 16; ++r) { const float v = o[d0][r] * rli[r] - lam * X[(d0 * 16 + r) * 64 + lane]; o[d0][r] = v; ss[r] += v * v; }
#pragma unroll
    for (int r = 0; r < 16; ++r) { float s = ss[r];
      s = row_sum(s); s += xor_lane(s, lane, 16);
      ss[r] = __builtin_amdgcn_rsqf(s * (1.f / 128.f) + RMS_EPS) * post_scale; }
    float gg[4];
#pragma unroll
    for (int d0 = 0; d0 < 4; ++d0) gg[d0] = subln_g[d0 * 32 + r32];
    bf16* Ow = outb + (long)(wq * 32) * ldo;
#pragma unroll
    for (int r = 0; r < 16; ++r) { const int orow = crow(r, hi);
#pragma unroll
      for (int d0 = 0; d0 < 4; ++d0) Ow[(long)orow * ldo + d0 * 32 + r32] = f2bf(o[d0][r] * ss[r] * gg[d0]); }
  }
#undef SLOAD
#undef SWRITE
#undef SWAIT
}

__device__ __forceinline__ void dil_attn_unit(const bf16* Qh, const bf16* Kh, const bf16* Vh, int ld, int dil, int rho, int u0, int L,
                                              float* Oc, float* lsep, char* lds, const int wave_id) {
  constexpr float SCALE = 0.08838834764831845f; constexpr float C = SCALE * 1.4426950408889634f;
  const int tid = tid_from_wave(wave_id), wid = __builtin_amdgcn_readfirstlane(tid >> 6), lane = tid & 63, r32 = lane & 31, hi = lane >> 5;
  char* V_lds = lds; char* K_lds = lds + 2 * SHM_V;
  float* ws = (float*)(lds + 2 * SHM_V + 2 * SHM_K) + wid * 64; float* li_l = ws; float* al_l = ws + 32;
  float m_reg = -1e30f, l_reg = 0; f32x16 o[4] = {}; bf16x8 qr[8];
  const int uq = u0 + wid * 32 + r32;
  const bf16* Qw = Qh + (long)(rho + dil * uq) * ld + hi * 8;
#pragma unroll
  for (int d0 = 0; d0 < 8; ++d0) qr[d0] = ld8(Qw + d0 * 16);
  const int sr = tid >> 4, sc = (tid & 15) * 8, vst0 = v_st(sr, sc), vst1 = v_st(32 + sr, sc);
  const int vb0 = (int)(uintptr_t)V_lds + v_rd_base(lane);
  const int tlo = wid >> 1;
  for (int t = 0; t < 6; ++t) {
    const int kt0 = u0 - 64 + 64 * t;
    __syncthreads();
    { int ua = kt0 + sr, ub = kt0 + 32 + sr; ua = ua < 0 ? 0 : (ua >= L ? L - 1 : ua); ub = ub < 0 ? 0 : (ub >= L ? L - 1 : ub);
      const long ra = (long)(rho + dil * ua) * ld + sc, rb = (long)(rho + dil * ub) * ld + sc;
      const bf16x8 va = ld8(Vh + ra), vb = ld8(Vh + rb), ka = ld8(Kh + ra), kb = ld8(Kh + rb);
      *(bf16x8*)(V_lds + vst0) = va; *(bf16x8*)(V_lds + vst1) = vb; const int kc = sc * 2;
      *(bf16x8*)(K_lds + KSWZ(sr, kc)) = ka; *(bf16x8*)(K_lds + KSWZ(32 + sr, kc)) = kb; }
    __syncthreads();
    if (t >= tlo && t <= tlo + 2) {
      f32x16 p0, p1;
      qkt<8>(p0, p1, K_lds, qr, r32, hi, 0);
#pragma unroll
      for (int r = 0; r < 16; ++r) { const int uk0 = kt0 + crow(r, hi), uk1 = uk0 + 32; const int d0 = uk0 - uq, d1 = uk1 - uq;
        const bool ok0 = (uk0 >= 0) && (uk0 < L) && (d0 >= -64) && (d0 <= 64), ok1 = (uk1 >= 0) && (uk1 < L) && (d1 >= -64) && (d1 <= 64);
        p0[r] = ok0 ? p0[r] : -1e30f; p1[r] = ok1 ? p1[r] : -1e30f; }
      float pmax = p0[0];
#pragma unroll
      for (int r = 1; r < 16; ++r) pmax = fmaxf(pmax, p0[r]);
#pragma unroll
      for (int r = 0; r < 16; ++r) pmax = fmaxf(pmax, p1[r]);
      { auto rr = __builtin_amdgcn_permlane32_swap(__float_as_uint(pmax), __float_as_uint(pmax), false, false);
        pmax = fmaxf(__uint_as_float(rr[0]), __uint_as_float(rr[1])); }
      const float mn = fmaxf(m_reg, pmax); const float alpha = __builtin_amdgcn_exp2f((m_reg - mn) * C); m_reg = mn;
      const float mnC = -mn * C;
#pragma unroll
      for (int r = 0; r < 16; ++r) { p0[r] = __builtin_amdgcn_exp2f(fmaf(p0[r], C, mnC)); p1[r] = fmaf(p1[r], C, mnC); }
      bf16x8 pa0, pa1, pa2, pa3;
      finishSM(p0, p1, alpha, l_reg, pa0, pa1, pa2, pa3);
      RESC(alpha);
      pv_d0(o, vb0, pa0, pa1, pa2, pa3);
    }
  }
  if (hi == 0) li_l[r32] = l_reg; asm volatile("s_waitcnt lgkmcnt(0)" ::: "memory");
  float rli[16];
#pragma unroll
  for (int r = 0; r < 16; ++r) rli[r] = __builtin_amdgcn_rcpf(li_l[crow(r, hi)]);
#pragma unroll
  for (int r = 0; r < 16; ++r) { const int uo = u0 + wid * 32 + crow(r, hi); float* orow = Oc + (long)(rho + dil * uo) * 512;
#pragma unroll
    for (int d0 = 0; d0 < 4; ++d0) orow[d0 * 32 + r32] = o[d0][r] * rli[r]; }
  if (hi == 0) lsep[(long)(rho + dil * uq) * 4] = m_reg * SCALE + __logf(l_reg);
}
#undef RESC
#undef KSWZ
#undef SBAR
}

struct Args { const float* in[N_INPUTS]; float* out; unsigned char* ws; int ph_lo, ph_hi; };
typedef const __attribute__((address_space(4))) Args* ArgsP;
struct Frame {
    LAS unsigned char* lds; volatile LAS unsigned* MISC; unsigned* ctl; unsigned char* ws;
    int tid, lane, wave, G, bid;
};
constexpr int PH_P0 = 0, PH_P1 = 1, PH_P2 = 2, PH_L0 = 3, NPH_L = 13, PH_FINAL = PH_L0 + DEPTH * NPH_L, NPHASES = PH_FINAL + 1;
enum { LP_NORM1 = 0, LP_G1, LP_PREP, LP_CPREP, LP_MIX, LP_POST, LP_G2, LP_NORM2, LP_GS, LP_GO, LP_NORM3, LP_M1, LP_M2 };

__device__ __forceinline__ int q_next(Frame& F, int q) {
    __syncthreads();
    if (F.tid == 0) F.MISC[0] = __hip_atomic_fetch_add(F.ctl + CW_Q + 64 * q, 1u, __ATOMIC_RELAXED, __HIP_MEMORY_SCOPE_AGENT);
    __syncthreads();
    return (int)F.MISC[0];
}

template <class RowMap>
__device__ __forceinline__ void transpose_item(const float* W, int ldn, bf16* WT, int ldt, RowMap rm, LAS float* scr, int k0, int n0, int lane) {
#pragma unroll 8
    for (int i = 0; i < 32; ++i) { const int kk = 2 * i + (lane >> 5); scr[kk * 33 + (lane & 31)] = W[(size_t)(k0 + kk) * ldn + n0 + (lane & 31)]; }
    LDS_WAIT(); asm volatile("" ::: "memory");
    const int c = lane & 7;
#pragma unroll
    for (int j = 0; j < 4; ++j) { const int n = (lane >> 3) + 8 * j; const LAS float* s = scr + (8 * c) * 33 + n;
        u32x4 o; o.x = pk2(s[0 * 33], s[1 * 33]); o.y = pk2(s[2 * 33], s[3 * 33]); o.z = pk2(s[4 * 33], s[5 * 33]); o.w = pk2(s[6 * 33], s[7 * 33]);
        *(u32x4*)(WT + (size_t)rm(n0 + n) * ldt + k0 + 8 * c) = o; }
    LDS_WAIT(); asm volatile("" ::: "memory");
}
struct RmId { __device__ __forceinline__ int operator()(int n) const { return n; } };
struct RmW13 { int off; __device__ __forceinline__ int operator()(int n) const { return 256 * (n >> 7) + off + (n & 127); } };

__device__ __forceinline__ void p0_prologue(Frame& F, ArgsP a) {
    unsigned char* ws = F.ws;
    LAS float* scr = (LAS float*)(F.lds + F.wave * 16384);
    const int gw = F.bid * 8 + F.wave, NGW = F.G * 8;
    constexpr int I_WIN = (DM / 64) * (IN_TOTAL / 32), I_SQ = (DM / 64) * (DM / 32), I_WKV = (DM / 64) * (4096 / 32), I_W1 = (DM / 64) * (DEXP / 32), I_W2 = (DEXP / 64) * (DM / 32);
    constexpr int PER_L = I_WIN + I_SQ + I_WKV + I_SQ + NEXP * (2 * I_W1 + I_W2);
    for (int it = gw; it < DEPTH * PER_L; it += NGW) {
        const int l = it / PER_L; int r = it % PER_L;
        if (r < I_WIN) { const int nb = IN_TOTAL / 32; transpose_item(a->in[I_W_IN] + (size_t)l * DM * IN_TOTAL, IN_TOTAL, (bf16*)(ws + WS_WIN) + (size_t)l * ZLD * DM, DM, RmId{}, scr, 64 * (r / nb), 32 * (r % nb), F.lane); continue; } r -= I_WIN;
        if (r < I_SQ) { const int nb = DM / 32; transpose_item(a->in[I_W_OUT] + (size_t)l * DM * DM, DM, (bf16*)(ws + WS_WOUT) + (size_t)l * DM * DM, DM, RmId{}, scr, 64 * (r / nb), 32 * (r % nb), F.lane); continue; } r -= I_SQ;
        if (r < I_WKV) { const int nb = 4096 / 32; transpose_item(a->in[I_XA_WKV] + (size_t)l * DM * 4096, 4096, (bf16*)(ws + SC_WKVT) + (size_t)l * 4096 * DM, DM, RmId{}, scr, 64 * (r / nb), 32 * (r % nb), F.lane); continue; } r -= I_WKV;
        if (r < I_SQ) { const int nb = DM / 32; transpose_item(a->in[I_XA_WO] + (size_t)l * DM * DM, DM, (bf16*)(ws + SC_WOT) + (size_t)l * DM * DM, DM, RmId{}, scr, 64 * (r / nb), 32 * (r % nb), F.lane); continue; } r -= I_SQ;
        const int e = r / (2 * I_W1 + I_W2); r = r % (2 * I_W1 + I_W2);
        const size_t le = (size_t)l * NEXP + e;
        if (r < I_W1) { const int nb = DEXP / 32; transpose_item(a->in[I_MOE_W1] + le * DM * DEXP, DEXP, (bf16*)(ws + WS_W13) + le * 1024 * DM, DM, RmW13{0}, scr, 64 * (r / nb), 32 * (r % nb), F.lane); continue; } r -= I_W1;
        if (r < I_W1) { const int nb = DEXP / 32; transpose_item(a->in[I_MOE_W3] + le * DM * DEXP, DEXP, (bf16*)(ws + WS_W13) + le * 1024 * DM, DM, RmW13{128}, scr, 64 * (r / nb), 32 * (r % nb), F.lane); continue; } r -= I_W1;
        { const int nb = DM / 32; transpose_item(a->in[I_MOE_W2] + le * DEXP * DM, DM, (bf16*)(ws + WS_W2) + le * DM * DEXP, DEXP, RmId{}, scr, 64 * (r / nb), 32 * (r % nb), F.lane); }
    }
    for (int it = gw; it < DEPTH * 96; it += NGW) { const int l = it / 96; int r = it % 96; bf16* base = (bf16*)(ws + WS_LORA + l * LORA_LAYER);
        if (r < 32) { const int d = r >> 4, nb = r & 15; transpose_item(a->in[I_RWKV_W2] + ((size_t)l * 2 + d) * 64 * 512, 512, base + (size_t)d * 512 * 64, 64, RmId{}, scr, 0, 32 * nb, F.lane); continue; } r -= 32;
        if (r < 32) { const int d = r >> 4, nb = r & 15; transpose_item(a->in[I_RWKV_A2] + ((size_t)l * 2 + d) * 64 * 512, 512, base + (size_t)(2 + d) * 512 * 64, 64, RmId{}, scr, 0, 32 * nb, F.lane); continue; } r -= 32;
        { const int kb = r >> 4, nb = r & 15; transpose_item(a->in[I_RWKV_G2] + (size_t)l * 128 * 512, 512, base + (size_t)4 * 512 * 64, 128, RmId{}, scr, 64 * kb, 32 * nb, F.lane); } }
    for (int it = gw; it < DEPTH * 128; it += NGW) { const int l = it / 128, r = it % 128, kb = r >> 4, nb = r & 15;
        transpose_item(a->in[I_S5_GLU_W] + (size_t)l * 512 * 512, 512, (bf16*)(ws + WS_GLUT) + (size_t)l * 512 * 512, 512, RmId{}, scr, 64 * kb, 32 * nb, F.lane); }
    const int gt = F.bid * 512 + F.tid, NGT = F.G * 512;
    for (int i = gt; i < DEPTH * 32 * 16 * 64; i += NGT) { const int n = i & 63, row = i >> 6;
        bf16* cw = (bf16*)(ws + WS_S5CW) + (size_t)row * 128; cw[n] = f2bf(a->in[I_S5_C_RE][i]); cw[64 + n] = f2bf(-a->in[I_S5_C_IM][i]); }
    for (int i = gt; i < DEPTH * (ZLD - IN_TOTAL) * DM / 8; i += NGT) { const int l = i / ((ZLD - IN_TOTAL) * DM / 8), r = i % ((ZLD - IN_TOTAL) * DM / 8);
        *(u32x4*)((bf16*)(ws + WS_WIN) + (size_t)l * ZLD * DM + (size_t)IN_TOTAL * DM + (size_t)r * 8) = (u32x4){0u, 0u, 0u, 0u}; }
    for (int i = gt; i < DEPTH * DM * DM / 8; i += NGT) { const f32x4 x0 = *(const f32x4*)(a->in[I_XA_WQ] + (size_t)i * 8), x1 = *(const f32x4*)(a->in[I_XA_WQ] + (size_t)i * 8 + 4);
        u32x4 o; o.x = pk2(x0[0], x0[1]); o.y = pk2(x0[2], x0[3]); o.z = pk2(x1[0], x1[1]); o.w = pk2(x1[2], x1[3]); *(u32x4*)((bf16*)(ws + SC_WQB) + (size_t)i * 8) = o; }
    { float* cosA = (float*)(ws + WS_ROPE); float* sinA = cosA + SEQ * 32; float* cosC = sinA + SEQ * 32; float* sinC = cosC + SEQ * 64;
      for (int i = gt; i < SEQ * 96; i += NGT) { const int s = i / 96, j = i % 96; const bool isA = j < 32; const int jj = isA ? j : j - 32; const float dim = isA ? 64.f : 128.f;
          const float inv = 1.0f / powf(10000.0f, (float)(2 * jj) / dim); const float ang = (float)s * inv; float sn, cs; sincosf(ang, &sn, &cs);
          if (isA) { cosA[s * 32 + jj] = cs; sinA[s * 32 + jj] = sn; } else { cosC[s * 64 + jj] = cs; sinC[s * 64 + jj] = sn; } } }
    for (int i = gt; i < DEPTH * 2 * 32 * 64; i += NGT) { const int l = i / (2 * 32 * 64), r = i % (2 * 32 * 64), dir = r / (32 * 64), g = (r / 64) % 32, n = r % 64;
        float* ab = (float*)(ws + WS_S5P + l * S5P_LAYER); float* bb = ab + 2 * 32 * 64 * 2;
        const size_t pi = (((size_t)l * 2 + dir) * 32 + g) * 64 + n;
        const float lr = fminf(a->in[I_S5_A_RE][pi], -1e-4f), li = a->in[I_S5_A_IM][pi], dt = __expf(a->in[I_S5_LOG_DT][((size_t)l * 2 + dir) * 32 + g]);
        const float mag = __expf(dt * lr); float sn, cs; sincosf(dt * li, &sn, &cs); const float abr = mag * cs, abi = mag * sn;
        const float den = lr * lr + li * li; const float ir = lr / den, ii = -li / den;
        const float fr_ = (abr - 1.f) * ir - abi * ii, fi_ = (abr - 1.f) * ii + abi * ir;
        ab[(size_t)r * 2] = abr; ab[(size_t)r * 2 + 1] = abi;
        { float* ab256 = bb + 2 * 32 * 64 * 16 * 2; const float m256 = __expf(256.f * dt * lr); float s2, c2; sincosf(256.f * dt * li, &s2, &c2); ab256[(size_t)r * 2] = m256 * c2; ab256[(size_t)r * 2 + 1] = m256 * s2; }
        const size_t bi = (((size_t)l * 32 + g) * 64 + n) * 16;
#pragma unroll
        for (int c = 0; c < 16; ++c) { const float br = a->in[I_S5_B_RE][bi + c], bim = a->in[I_S5_B_IM][bi + c];
            bb[((size_t)r * 16 + c) * 2] = fr_ * br - fi_ * bim; bb[((size_t)r * 16 + c) * 2 + 1] = fr_ * bim + fi_ * br; } }
    for (int it = gw; it < DEPTH * BATCH * NMEM; it += NGW) { const int l = it / (BATCH * NMEM), row = it % (BATCH * NMEM);
        const f32x4* xr = (const f32x4*)(a->in[I_MEM] + (size_t)row * DM) + F.lane; const f32x4* gr = (const f32x4*)(a->in[I_NORM_MEM] + (size_t)l * DM) + F.lane;
        f32x4 v[8]; float s = 0.f;
#pragma unroll
        for (int j = 0; j < 8; ++j) { v[j] = xr[64 * j]; s += (v[j].x * v[j].x + v[j].y * v[j].y) + (v[j].z * v[j].z + v[j].w * v[j].w); }
        const float rstd = 1.f / sqrtf(wave_sum(s) * (1.f / DM) + RMS_EPS);
        u32x2* o8 = (u32x2*)((bf16*)(ws + SC_MEMN) + ((size_t)l * 512 + row) * DM) + F.lane;
#pragma unroll
        for (int j = 0; j < 8; ++j) { const f32x4 gv = gr[64 * j]; u32x2 w; w.x = pk2(v[j].x * rstd * gv.x, v[j].y * rstd * gv.y); w.y = pk2(v[j].z * rstd * gv.z, v[j].w * rstd * gv.w); o8[64 * j] = w; } }
}

struct SchedDense { const char* A; const char* B; char* C; int nM, nN, G, c, lda, ldb, ldcb  , cesz  ;
    __device__ __forceinline__ bool next(int i, pg8::Unit& u) const { const long L = (long)i * G + c; if (L >= (long)nM * nN) return false; int pm, pn; pg8::xcd_tile((int)L, nM, nN, pm, pn);
        u.A = A + (size_t)pm * 256 * lda * 2; u.B = B + (size_t)pn * 256 * ldb * 2; u.C = C + (size_t)pm * 256 * ldcb + (size_t)pn * 256 * cesz; u.row0 = pm * 256; u.col0 = pn * 256; u.aux = 0; return true; }
    __device__ __forceinline__ int arow(const pg8::Unit&, int r) const { return r; } };
struct SchedBatch { const char* A; const char* B; char* C; size_t sA, sB, sC; int nM, nN, nb, G, c, lda, ldb, ldcb, cesz, rowsPerBatch;
    __device__ __forceinline__ bool next(int i, pg8::Unit& u) const { const long L = (long)i * G + c; const int per = nM * nN; if (L >= (long)per * nb) return false; const int b = (int)(L / per), r = (int)(L % per), pm = r / nN, pn = r % nN;
        u.A = A + b * sA + (size_t)pm * 256 * lda * 2; u.B = B + b * sB + (size_t)pn * 256 * ldb * 2; u.C = C + b * sC + (size_t)pm * 256 * ldcb + (size_t)pn * 256 * cesz; u.row0 = b * rowsPerBatch + pm * 256; u.col0 = pn * 256; u.aux = b; return true; }
    __device__ __forceinline__ int arow(const pg8::Unit&, int r) const { return r; } };
struct SchedXaPre { unsigned char* ws; int G, c, kind;
    __device__ __forceinline__ bool next(int i, pg8::Unit& u) const { const long L = (long)i * G + c; if (L >= 128) return false; const int r = (int)L, p = r >> 3, t = r & 7, l = p >> 3, b = (p >> 2) & 1, h = p & 3;
        const bf16* kvb = (const bf16*)(ws + SC_KVB) + (size_t)l * 512 * 4096 + (size_t)(b * 256) * 4096;
        if (kind == 0) { u.A = (const char*)(kvb + h * 512); u.B = (const char*)((const bf16*)(ws + SC_WQB) + (size_t)l * DM * DM + (size_t)(t * 256) * DM + h * 512);
            u.C = (char*)((bf16*)(ws + WS_WQK) + ((size_t)(l * 2 + b) * 1024 + h * 256) * DM + t * 256); u.aux = DM; }
        else { u.A = (const char*)((const bf16*)(ws + SC_WOT) + (size_t)l * DM * DM + (size_t)(t * 256) * DM + h * 512); u.B = (const char*)(kvb + 2048 + h * 512);
            u.C = (char*)((bf16*)(ws + WS_VWO) + ((size_t)(l * 2 + b) * DM + t * 256) * 1024 + h * 256); u.aux = 1024; }
        u.row0 = 0; u.col0 = 0; return true; }
    __device__ __forceinline__ int arow(const pg8::Unit&, int r) const { return r; } };
struct EpiBf16U { static constexpr bool PERM = true, AFTER_DRAIN = false;
    __device__ __forceinline__ void operator()(const pg8::Acc& acc, const pg8::Unit& u, int wr, int wc, int fr, int fq) const { pg8::EpiBf16 e{u.aux}; e(acc, u, wr, wc, fr, fq); } };
struct SchedMoe { unsigned char* ws; const volatile LAS int* tp; const volatile LAS int* cnt; int layer, G, c, which;
    __device__ __forceinline__ bool next(int i, pg8::Unit& u) const {
        const int npn = which == 0 ? 4 : 8; const long L = (long)i * G + c; const int ntile = tp[32]; if (L >= (long)ntile * npn) return false;
        const int mt = (int)(L / npn), pn = (int)(L % npn); int e = 0;
#pragma unroll 1
        for (int k = 1; k < 32; ++k) e += (mt >= tp[k]) ? 1 : 0;
        const int lt = mt - tp[e]; const int nvalid = min(256, cnt[e] - lt * 256);
        u.row0 = lt * 256; u.col0 = pn * 256; u.aux = (e << 16) | nvalid;
        if (which == 0) { u.A = (const char*)(ws + WS_HN); u.B = (const char*)((const bf16*)(ws + WS_W13) + ((size_t)(layer * NEXP + e) * 1024 + pn * 256) * DM);
            u.C = (char*)((bf16*)(ws + SC_HMID) + (size_t)(mt * 256) * DEXP + pn * 128); }
        else { u.A = (const char*)((const bf16*)(ws + SC_HMID) + (size_t)(mt * 256) * DEXP); u.B = (const char*)((const bf16*)(ws + WS_W2) + ((size_t)(layer * NEXP + e) * DM + pn * 256) * DEXP);
            u.C = (char*)((bf16*)(ws + SC_YBUF) + (size_t)(mt * 256) * DM + pn * 256); }
        return true; }
    __device__ __forceinline__ int arow(const pg8::Unit& u, int r) const { const int e = u.aux >> 16, nvalid = u.aux & 0xffff; const int idx = (r < nvalid) ? (u.row0 + r) : u.row0;
        return ((const int*)(ws + WS_ETOK))[(size_t)e * ECAP + idx]; } };

__device__ __forceinline__ void moe_prefix(Frame& F, int layer, volatile LAS int* tp, volatile LAS int* cnt) {
    __syncthreads();
    if (F.tid < 32) cnt[F.tid] = (int)__hip_atomic_load(F.ctl + CW_CNT + layer * 64 + F.tid, __ATOMIC_RELAXED, __HIP_MEMORY_SCOPE_AGENT);
    __syncthreads();
    if (F.tid == 0) { int s = 0; for (int e = 0; e < 32; ++e) { tp[e] = s; s += (cnt[e] + 255) >> 8; } tp[32] = s; }
    __syncthreads();
}
template <int MODE>
__device__ __forceinline__ void norm_phase(Frame& F, ArgsP a, const float* src, const float* gain, int layer) {
    unsigned char* ws = F.ws; float* H = (float*)(ws + WS_H); bf16* HN = (bf16*)(ws + WS_HN);
    volatile LAS int* tp = (volatile LAS int*)(F.lds + 1024); volatile LAS int* cnt = tp + 40;
    if (MODE & 1) moe_prefix(F, layer - 1, tp, cnt);
    const int gw = F.bid * 8 + F.wave, NGW = F.G * 8;
    const f32x4* gr = (const f32x4*)gain + F.lane;
    for (int row = gw; row < NTOK; row += NGW) {
        const f32x4* xr = (const f32x4*)(src + (size_t)row * DM) + F.lane;
        f32x4 v[8];
#pragma unroll
        for (int j = 0; j < 8; ++j) v[j] = xr[64 * j];
        if (MODE & 1) {
            const int* ti = (const int*)(ws + WS_TINFO) + (size_t)row * 4;
            const int e0 = ti[0], p0 = ti[1], e1 = ti[2], p1 = ti[3];
            const size_t s0 = (size_t)tp[e0] * 256 + p0, s1 = (size_t)tp[e1] * 256 + p1;
            const u32x2* y0 = (const u32x2*)((const bf16*)(ws + SC_YBUF) + s0 * DM) + F.lane; const u32x2* y1 = (const u32x2*)((const bf16*)(ws + SC_YBUF) + s1 * DM) + F.lane;
#pragma unroll
            for (int j = 0; j < 8; ++j) { const u32x2 a0 = y0[64 * j], a1 = y1[64 * j];
                v[j].x += __uint_as_float(a0.x << 16) + __uint_as_float(a1.x << 16); v[j].y += __uint_as_float(a0.x & 0xffff0000u) + __uint_as_float(a1.x & 0xffff0000u);
                v[j].z += __uint_as_float(a0.y << 16) + __uint_as_float(a1.y << 16); v[j].w += __uint_as_float(a0.y & 0xffff0000u) + __uint_as_float(a1.y & 0xffff0000u); }
            if (!(MODE & 4)) { f32x4* hr = (f32x4*)(H + (size_t)row * DM) + F.lane;
#pragma unroll
                for (int j = 0; j < 8; ++j) hr[64 * j] = v[j]; }
        }
        float s = 0.f;
#pragma unroll
        for (int j = 0; j < 8; ++j) s += (v[j].x * v[j].x + v[j].y * v[j].y) + (v[j].z * v[j].z + v[j].w * v[j].w);
        const float rstd = 1.f / sqrtf(wave_sum(s) * (1.f / DM) + RMS_EPS);
#pragma unroll
        for (int j = 0; j < 8; ++j) { const f32x4 gv = gr[64 * j]; v[j].x *= rstd * gv.x; v[j].y *= rstd * gv.y; v[j].z *= rstd * gv.z; v[j].w *= rstd * gv.w; }
        if (MODE & 4) { f32x4* orow = (f32x4*)(a->out + (size_t)row * DM) + F.lane;
#ifdef DBG_TIME_A
            { const float sc = 1.f + (float)__hip_atomic_load(F.ctl + 40000, __ATOMIC_RELAXED, __HIP_MEMORY_SCOPE_AGENT) * (1.f / 20.f);
#pragma unroll
              for (int j = 0; j < 8; ++j) v[j] *= sc; }
#endif
#ifdef DBG_RWCHK
            { const float* cw = (const float*)(F.ctl + 32768); const unsigned* cu = (const unsigned*)cw; const float sc = cu[DBG_RWCHK * 64 + 2] ? 1001.f : 1.f + fminf(cw[DBG_RWCHK * 64] / cw[DBG_RWCHK * 64 + 1], 100.f);
#pragma unroll
              for (int j = 0; j < 8; ++j) v[j] *= sc; }
#endif
#pragma unroll
            for (int j = 0; j < 8; ++j) orow[64 * j] = v[j]; }
        else { u32x2* o8 = (u32x2*)(HN + (size_t)row * DM) + F.lane;
#pragma unroll
            for (int j = 0; j < 8; ++j) { u32x2 w; w.x = pk2(v[j].x, v[j].y); w.y = pk2(v[j].z, v[j].w); o8[64 * j] = w; } }
        if (MODE & 2) {
            const float* wg = a->in[I_ROUTER_GROUP] + (size_t)layer * DM * 4; const float* we = a->in[I_ROUTER_EXPERT] + (size_t)layer * DM * 32;
            float lg[4] = {0.f, 0.f, 0.f, 0.f};
#pragma unroll 2
            for (int j = 0; j < 8; ++j) { const int k0 = (64 * j + F.lane) * 4;
#pragma unroll
                for (int q = 0; q < 4; ++q) { const f32x4 w4 = *(const f32x4*)(wg + (size_t)(k0 + q) * 4); const float x = v[j][q]; lg[0] += x * w4.x; lg[1] += x * w4.y; lg[2] += x * w4.z; lg[3] += x * w4.w; } }
#pragma unroll
            for (int q = 0; q < 4; ++q) lg[q] = wave_sum(lg[q]);
            int gi = 0; float gm = lg[0];
#pragma unroll
            for (int q = 1; q < 4; ++q) if (lg[q] > gm) { gm = lg[q]; gi = q; }
            const float gw_ = 1.f / (__expf(lg[0] - gm) + __expf(lg[1] - gm) + __expf(lg[2] - gm) + __expf(lg[3] - gm));
            float le[8] = {0.f, 0.f, 0.f, 0.f, 0.f, 0.f, 0.f, 0.f};
#pragma unroll 2
            for (int j = 0; j < 8; ++j) { const int k0 = (64 * j + F.lane) * 4;
#pragma unroll
                for (int q = 0; q < 4; ++q) { const float* wp = we + (size_t)(k0 + q) * 32 + gi * 8; const f32x4 wa = *(const f32x4*)wp, wb = *(const f32x4*)(wp + 4); const float x = v[j][q];
                    le[0] += x * wa.x; le[1] += x * wa.y; le[2] += x * wa.z; le[3] += x * wa.w; le[4] += x * wb.x; le[5] += x * wb.y; le[6] += x * wb.z; le[7] += x * wb.w; } }
#pragma unroll
            for (int q = 0; q < 8; ++q) le[q] = wave_sum(le[q]);
            int i0 = 0; float m0 = le[0];
#pragma unroll
            for (int q = 1; q < 8; ++q) if (le[q] > m0) { m0 = le[q]; i0 = q; }
            int i1 = -1; float m1 = -3.0e38f;
#pragma unroll
            for (int q = 0; q < 8; ++q) if (q != i0 && le[q] > m1) { m1 = le[q]; i1 = q; }
            const float t = __expf(m1 - m0); const float w0 = 1.f / (1.f + t), w1 = t / (1.f + t);
            if (F.lane == 0) {
                const int e0 = gi * 8 + i0, e1 = gi * 8 + i1;
                const int p0 = (int)__hip_atomic_fetch_add(F.ctl + CW_CNT + layer * 64 + e0, 1u, __ATOMIC_RELAXED, __HIP_MEMORY_SCOPE_AGENT);
                const int p1 = (int)__hip_atomic_fetch_add(F.ctl + CW_CNT + layer * 64 + e1, 1u, __ATOMIC_RELAXED, __HIP_MEMORY_SCOPE_AGENT);
                int* et = (int*)(ws + WS_ETOK); float* eg = (float*)(ws + WS_EGATE); int* ti = (int*)(ws + WS_TINFO) + (size_t)row * 4;
                et[(size_t)e0 * ECAP + p0] = row; eg[(size_t)e0 * ECAP + p0] = gw_ * w0; et[(size_t)e1 * ECAP + p1] = row; eg[(size_t)e1 * ECAP + p1] = gw_ * w1;
                ti[0] = e0; ti[1] = p0; ti[2] = e1; ti[3] = p1;
            }
        }
    }
}

__device__ __forceinline__ void rope_token(Frame& F, bf16* zrow, int s) {
    const float* cosA = (const float*)(F.ws + WS_ROPE); const float* sinA = cosA + SEQ * 32; const float* cosC = sinA + SEQ * 32; const float* sinC = cosC + SEQ * 64;
    { const int i = F.lane & 31; const float cs = cosA[s * 32 + i], sn = sinA[s * 32 + i];
#pragma unroll
      for (int it = 0; it < 8; ++it) { bf16* p = zrow + ZA + (it * 2 + (F.lane >> 5)) * 64; const float x1 = bf2f(p[i]), x2 = bf2f(p[i + 32]); p[i] = f2bf(x1 * cs - x2 * sn); p[i + 32] = f2bf(x2 * cs + x1 * sn); } }
    { const int i = F.lane; const float cs = cosC[s * 64 + i], sn = sinC[s * 64 + i];
#pragma unroll
      for (int it = 0; it < 8; ++it) { bf16* p = zrow + ZC + it * 128; const float x1 = bf2f(p[i]), x2 = bf2f(p[i + 64]); p[i] = f2bf(x1 * cs - x2 * sn); p[i + 64] = f2bf(x2 * cs + x1 * sn); } }
}

constexpr int RWT = 16;
__device__ __forceinline__ float zs_ld(const LAS unsigned short* zr, const float* mu, int t, int col) {
    const float z0 = bf2f(zr[(t + 1) * IN_B + col]), zp = bf2f(zr[t * IN_B + col]), zn = bf2f(zr[(t + 2) * IN_B + col]);
    return z0 + mu[col] * (zp - z0) + mu[IN_B + col] * (zn - z0);
}
__device__ __forceinline__ void rwkv_prep_tile(Frame& F, ArgsP a, int layer, int tile) {
    unsigned char* ws = F.ws; const bf16* Z = (const bf16*)(ws + SC_Z);
    LAS unsigned short* zr = (LAS unsigned short*)F.lds; LAS unsigned short* act = zr + (RWT + 2) * IN_B;
    const int t0 = tile * RWT; const int b = t0 / SEQ, s0 = t0 % SEQ;
    __syncthreads();
#pragma unroll 1
    for (int i = F.tid; i < (RWT + 2) * (IN_B / 8); i += 512) { const int rr = i / (IN_B / 8), c8 = i % (IN_B / 8); const int s = s0 - 1 + rr;
        u32x4 w = {0u, 0u, 0u, 0u};
        if (s >= 0 && s < SEQ) w = *(const u32x4*)(Z + (size_t)(b * SEQ + s) * ZLD + ZB + c8 * 8);
        *(LAS u32x4*)(zr + rr * IN_B + c8 * 8) = w; }
    __syncthreads();
    const float* mu = a->in[I_RWKV_MU] + (size_t)layer * 2 * IN_B;
#pragma unroll 1
    for (int i = F.tid; i < RWT * 384; i += 512) { const int t = i / 384, j = i % 384; const float x = zs_ld(zr, mu, t, 1536 + j);
        act[t * 392 + j] = f2bf((j < 128) ? tanhf(x) : ((j < 256) ? x : sigmoidf_(x))); }
    __syncthreads();
    const int lane = F.lane, r = lane & 15, g = lane >> 4, hd = F.wave;
    const bf16* lw = (const bf16*)(ws + WS_LORA + layer * LORA_LAYER);
    bf16x8 af[12];
#pragma unroll
    for (int ks = 0; ks < 12; ++ks) af[ks] = *(const LAS bf16x8*)(act + r * 392 + ks * 32 + g * 8);
    float* RW = (float*)(ws + SC_RW); const size_t N1 = (size_t)NTOK * 512;
    f32x4 dw0[4], dw1[4], da0[4], da1[4], dg[4];
#pragma unroll
    for (int nt = 0; nt < 4; ++nt) { const int c = hd * 64 + nt * 16 + r;
        bf16x8 bw[12];
#pragma unroll
        for (int ks = 0; ks < 2; ++ks) { bw[ks] = *(const bf16x8*)(lw + ((size_t)0 * 512 + c) * 64 + ks * 32 + g * 8); bw[2 + ks] = *(const bf16x8*)(lw + ((size_t)1 * 512 + c) * 64 + ks * 32 + g * 8);
            bw[4 + ks] = *(const bf16x8*)(lw + ((size_t)2 * 512 + c) * 64 + ks * 32 + g * 8); bw[6 + ks] = *(const bf16x8*)(lw + ((size_t)3 * 512 + c) * 64 + ks * 32 + g * 8); }
#pragma unroll
        for (int ks = 0; ks < 4; ++ks) bw[8 + ks] = *(const bf16x8*)(lw + (size_t)4 * 512 * 64 + (size_t)c * 128 + ks * 32 + g * 8);
        f32x4 z4 = {0.f, 0.f, 0.f, 0.f};
        dw0[nt] = __builtin_amdgcn_mfma_f32_16x16x32_bf16(af[0], bw[0], z4, 0, 0, 0); dw0[nt] = __builtin_amdgcn_mfma_f32_16x16x32_bf16(af[1], bw[1], dw0[nt], 0, 0, 0);
        dw1[nt] = __builtin_amdgcn_mfma_f32_16x16x32_bf16(af[2], bw[2], z4, 0, 0, 0); dw1[nt] = __builtin_amdgcn_mfma_f32_16x16x32_bf16(af[3], bw[3], dw1[nt], 0, 0, 0);
        da0[nt] = __builtin_amdgcn_mfma_f32_16x16x32_bf16(af[4], bw[4], z4, 0, 0, 0); da0[nt] = __builtin_amdgcn_mfma_f32_16x16x32_bf16(af[5], bw[5], da0[nt], 0, 0, 0);
        da1[nt] = __builtin_amdgcn_mfma_f32_16x16x32_bf16(af[6], bw[6], z4, 0, 0, 0); da1[nt] = __builtin_amdgcn_mfma_f32_16x16x32_bf16(af[7], bw[7], da1[nt], 0, 0, 0);
        dg[nt] = __builtin_amdgcn_mfma_f32_16x16x32_bf16(af[8], bw[8], z4, 0, 0, 0); dg[nt] = __builtin_amdgcn_mfma_f32_16x16x32_bf16(af[9], bw[9], dg[nt], 0, 0, 0);
        dg[nt] = __builtin_amdgcn_mfma_f32_16x16x32_bf16(af[10], bw[10], dg[nt], 0, 0, 0); dg[nt] = __builtin_amdgcn_mfma_f32_16x16x32_bf16(af[11], bw[11], dg[nt], 0, 0, 0);
    }
    float w00[4], w01[4], a00[4], a01[4], kkw[4], kaw[4];
#pragma unroll
    for (int nt = 0; nt < 4; ++nt) { const int c = hd * 64 + nt * 16 + r;
        w00[nt] = a->in[I_RWKV_W0][(size_t)layer * 1024 + c]; w01[nt] = a->in[I_RWKV_W0][(size_t)layer * 1024 + 512 + c];
        a00[nt] = a->in[I_RWKV_A0][(size_t)layer * 1024 + c]; a01[nt] = a->in[I_RWKV_A0][(size_t)layer * 1024 + 512 + c];
        kkw[nt] = a->in[I_RWKV_KK][(size_t)layer * 512 + c]; kaw[nt] = a->in[I_RWKV_KA][(size_t)layer * 512 + c]; }
#pragma unroll
    for (int q = 0; q < 4; ++q) { const int t = 4 * g + q;
        float k_[4], kk[4]; float ssq = 0.f;
#pragma unroll
        for (int nt = 0; nt < 4; ++nt) { const int c = hd * 64 + nt * 16 + r; k_[nt] = zs_ld(zr, mu, t, 512 + c); kk[nt] = k_[nt] * kkw[nt]; ssq += kk[nt] * kk[nt]; }
        ssq = row_sum(ssq);
        const float rn = 1.f / sqrtf(ssq + 1e-12f);
#pragma unroll
        for (int nt = 0; nt < 4; ++nt) { const int c = hd * 64 + nt * 16 + r;
            const float r_ = zs_ld(zr, mu, t, c), v_ = zs_ld(zr, mu, t, 1024 + c);
            const float x0 = -(w00[nt] + dw0[nt][q]), x1 = -(w01[nt] + dw1[nt][q]);
            const float sp0 = fmaxf(x0, 0.f) + __logf(1.f + __expf(-fabsf(x0))), sp1 = fmaxf(x1, 0.f) + __logf(1.f + __expf(-fabsf(x1)));
            const float d0 = -__expf(-sp0 - 0.5f), d1 = -__expf(-sp1 - 0.5f);
            const float al0 = sigmoidf_(a00[nt] + da0[nt][q]), al1 = sigmoidf_(a01[nt] + da1[nt][q]);
            const float kn = kk[nt] * rn;
            const float km0 = k_[nt] * (1.f + (al0 - 1.f) * kaw[nt]), km1 = k_[nt] * (1.f + (al1 - 1.f) * kaw[nt]);
            const size_t o = (size_t)(t0 + t) * 512 + c;
            RW[0 * N1 + o] = r_; RW[1 * N1 + o] = v_; RW[2 * N1 + o] = kn; RW[3 * N1 + o] = d0; RW[4 * N1 + o] = d1;
            RW[5 * N1 + o] = km0; RW[6 * N1 + o] = km1; RW[7 * N1 + o] = kn * al0; RW[8 * N1 + o] = kn * al1; RW[9 * N1 + o] = dg[nt][q]; }
    }
}

constexpr size_t SC_S5E = SC_MIX_END + (size_t)32 * 256 * 11520;
constexpr size_t SC_MIX_END3 = SC_S5E + (size_t)2 * BATCH * 16 * 32 * 64 * 2 * 4;
template <int LEVEL>
__device__ __forceinline__ void s5_block_task(Frame& F, int layer, int task, LAS float* ul) {
    unsigned char* ws = F.ws; const bf16* Z = (const bf16*)(ws + SC_Z);
    const int blk = task & 15, dir = (task >> 4) & 1, g = (task >> 5) & 31, b = task >> 10; const int n = F.lane;
    const float* ab = (const float*)(ws + WS_S5P + layer * S5P_LAYER); const float* bb = ab + 2 * 32 * 64 * 2; const float* ab256 = bb + 2 * 32 * 64 * 16 * 2;
    const int pr = (dir * 32 + g) * 64 + n;
    const float abr = ab[pr * 2], abi = ab[pr * 2 + 1];
    float bbr[16], bbi[16];
#pragma unroll
    for (int c = 0; c < 16; ++c) { bbr[c] = bb[((size_t)pr * 16 + c) * 2]; bbi[c] = bb[((size_t)pr * 16 + c) * 2 + 1]; }
    float* E = (float*)(ws + SC_S5E);
    float xr = 0.f, xi = 0.f;
    if (LEVEL == 2) { const float pr_ = ab256[pr * 2], pi_ = ab256[pr * 2 + 1];
        for (int k = 0; k < blk; ++k) { const float* ep = E + ((((size_t)dir * BATCH + b) * 16 + k) * 32 + g) * 128 + n * 2; const float er = ep[0], ei = ep[1];
            const float nr = pr_ * xr - pi_ * xi + er, ni = pr_ * xi + pi_ * xr + ei; xr = nr; xi = ni; } }
    float* carry = (float*)(ws + SC_CARRY);
    for (int q4 = 0; q4 < 4; ++q4) {
        { const int st = blk * 256 + q4 * 64 + n; const int sl = dir ? (SEQ - 1 - st) : st; const bf16* zp = Z + (size_t)(b * SEQ + sl) * ZLD + ZD + g * 16;
          const u32x4 w0 = *(const u32x4*)zp, w1 = *(const u32x4*)(zp + 8);
          LAS f32x4* d = (LAS f32x4*)(ul + n * 16);
          d[0] = (f32x4){__uint_as_float(w0.x << 16), __uint_as_float(w0.x & 0xffff0000u), __uint_as_float(w0.y << 16), __uint_as_float(w0.y & 0xffff0000u)};
          d[1] = (f32x4){__uint_as_float(w0.z << 16), __uint_as_float(w0.z & 0xffff0000u), __uint_as_float(w0.w << 16), __uint_as_float(w0.w & 0xffff0000u)};
          d[2] = (f32x4){__uint_as_float(w1.x << 16), __uint_as_float(w1.x & 0xffff0000u), __uint_as_float(w1.y << 16), __uint_as_float(w1.y & 0xffff0000u)};
          d[3] = (f32x4){__uint_as_float(w1.z << 16), __uint_as_float(w1.z & 0xffff0000u), __uint_as_float(w1.w << 16), __uint_as_float(w1.w & 0xffff0000u)}; }
        LDS_WAIT(); asm volatile("" ::: "memory");
#pragma unroll 4
        for (int i = 0; i < 64; ++i) {
            const int step = blk * 256 + q4 * 64 + i;
            if (LEVEL == 2 && (step & (S5CH - 1)) == 0) { const int sl = dir ? (SEQ - 1 - step) : step; const int ch = sl / S5CH;
                float* cp = carry + ((((size_t)dir * BATCH + b) * S5NCH + ch) * 32 + g) * 128 + n * 2; cp[0] = xr; cp[1] = xi; }
            const f32x4 u0 = *(const LAS f32x4*)(ul + i * 16), u1 = *(const LAS f32x4*)(ul + i * 16 + 4), u2 = *(const LAS f32x4*)(ul + i * 16 + 8), u3 = *(const LAS f32x4*)(ul + i * 16 + 12);
            float br = 0.f, bi = 0.f;
#pragma unroll
            for (int c = 0; c < 4; ++c) { br += bbr[c] * u0[c] + bbr[4 + c] * u1[c] + bbr[8 + c] * u2[c] + bbr[12 + c] * u3[c]; bi += bbi[c] * u0[c] + bbi[4 + c] * u1[c] + bbi[8 + c] * u2[c] + bbi[12 + c] * u3[c]; }
            const float nr = abr * xr - abi * xi + br, ni = abr * xi + abi * xr + bi; xr = nr; xi = ni;
        }
        asm volatile("" ::: "memory");
    }
    if (LEVEL == 1) { float* ep = E + ((((size_t)dir * BATCH + b) * 16 + blk) * 32 + g) * 128 + n * 2; ep[0] = xr; ep[1] = xi; }
}

__device__ __forceinline__ void prep_phase(Frame& F, ArgsP a, int layer, const int rep) {
    const int qb_ = (rep * 2 + layer) * 8;
#ifndef DBG_PREPMASK
#define DBG_PREPMASK 7
#endif
    if (DBG_PREPMASK & 1) for (;;) { const int it = q_next(F, qb_ + 0); if (it >= 256) break; s5_block_task<1>(F, layer, it * 8 + F.wave, (LAS float*)(F.lds + F.wave * 4096)); }
    if (DBG_PREPMASK & 2) for (;;) { const int it = q_next(F, qb_ + 5); if (it >= NTOK / RWT) break; rwkv_prep_tile(F, a, layer, it); }
    if ((DBG_PREPMASK & 4) && rep == 0) for (;;) { const int r = q_next(F, qb_ + 6); if (r >= NTOK / 64) break;
        for (int k = 0; k < 8; ++k) { const int tok = r * 64 + F.wave * 8 + k; rope_token(F, (bf16*)(F.ws + SC_Z) + (size_t)tok * ZLD, tok % SEQ); } }
}

constexpr int CR_TA = 0, CR_GH = 2048, CR_WBK = 4096, CR_TM = 8192, CR_N = 8704, CR_V = 9216, CR_WL = 11264, CR_BYTES = 11520;
constexpr size_t SC_CREC = SC_MIX_END;
constexpr size_t SC_MIX_END2 = SC_CREC + (size_t)32 * 256 * CR_BYTES;
static_assert(SC_MIX_END2 <= 1140000000ull, "workspace budget");

__device__ __forceinline__ void mm16(const LAS float* A, const LAS float* B, int t, int sq, float (&out)[4]) {
    out[0] = out[1] = out[2] = out[3] = 0.f;
#pragma unroll
    for (int s4 = 0; s4 < 4; ++s4) { const f32x4 a4 = *(const LAS f32x4*)(A + t * 16 + s4 * 4);
#pragma unroll
        for (int q = 0; q < 4; ++q) { const f32x4 b4 = *(const LAS f32x4*)(B + (s4 * 4 + q) * 16 + sq * 4); const float av = a4[q];
            out[0] += av * b4[0]; out[1] += av * b4[1]; out[2] += av * b4[2]; out[3] += av * b4[3]; } }
}
__device__ __forceinline__ void st16(LAS float* M, int t, int sq, const float (&v)[4]) { *(LAS f32x4*)(M + t * 16 + sq * 4) = (f32x4){v[0], v[1], v[2], v[3]}; }

__device__ __forceinline__ void rwkv_cprep_item(Frame& F, int chain, int c, LAS float* Lw) {
    unsigned char* ws = F.ws; const float* RW = (const float*)(ws + SC_RW); const size_t N1 = (size_t)NTOK * 512;
    const int dir = chain & 1, h = (chain >> 1) & 7, b = chain >> 4; const int lane = F.lane;
    const float* Rp = RW; const float* Vp = RW + N1; const float* KKp = RW + 2 * N1; const float* LDp = RW + (3 + dir) * N1; const float* KMp = RW + (5 + dir) * N1; const float* BBp = RW + (7 + dir) * N1;
    constexpr int RS = 68;
    LAS float* At = Lw; LAS float* Bt = Lw + 16 * RS; LAS float* Kt = Lw + 32 * RS; LAS float* mat = Lw + 48 * RS;
    float at[16], rt[16], wb[16], wk[16];
    { float lw = 0.f, lwi[16], bb[16], km[16];
#pragma unroll
      for (int t = 0; t < 16; ++t) { const int pos = dir ? (SEQ - 1 - 16 * c - t) : (16 * c + t); const size_t idx = (size_t)(b * SEQ + pos) * 512 + h * 64 + lane;
          const float r_ = Rp[idx], ld = LDp[idx], a_ = -KKp[idx]; km[t] = KMp[idx]; bb[t] = BBp[idx];
          at[t] = a_ * __expf(lw); lw += ld; lwi[t] = lw; rt[t] = r_ * __expf(lw);
          const float iw = __expf(-lw); At[t * RS + lane] = at[t]; Bt[t * RS + lane] = bb[t] * iw; Kt[t * RS + lane] = km[t] * iw; }
#pragma unroll
      for (int t = 0; t < 16; ++t) { const float e = __expf(lw - lwi[t]); wb[t] = bb[t] * e; wk[t] = km[t] * e; }
      float* rec = (float*)(ws + SC_CREC + ((size_t)chain * 256 + c) * CR_BYTES + CR_WL); rec[lane] = __expf(lw); }
    LDS_WAIT(); asm volatile("" ::: "memory");
    const int t = lane >> 2, sq = lane & 3;
    float mab[4] = {0.f, 0.f, 0.f, 0.f}, mak[4] = {0.f, 0.f, 0.f, 0.f}, mrb[4] = {0.f, 0.f, 0.f, 0.f}, mrk[4] = {0.f, 0.f, 0.f, 0.f};
#pragma unroll 4
    for (int j = 0; j < 64; j += 4) { const f32x4 a4 = *(const LAS f32x4*)(At + t * RS + j);
#pragma unroll
        for (int e = 0; e < 4; ++e) { const f32x4 b4 = *(const LAS f32x4*)(Bt + (sq * 4 + e) * RS + j), k4 = *(const LAS f32x4*)(Kt + (sq * 4 + e) * RS + j);
            mab[e] += a4[0] * b4[0] + a4[1] * b4[1] + a4[2] * b4[2] + a4[3] * b4[3]; mak[e] += a4[0] * k4[0] + a4[1] * k4[1] + a4[2] * k4[2] + a4[3] * k4[3]; } }
    asm volatile("" ::: "memory");
#pragma unroll
    for (int tt = 0; tt < 16; ++tt) At[tt * RS + lane] = rt[tt];
    LDS_WAIT(); asm volatile("" ::: "memory");
#pragma unroll 4
    for (int j = 0; j < 64; j += 4) { const f32x4 a4 = *(const LAS f32x4*)(At + t * RS + j);
#pragma unroll
        for (int e = 0; e < 4; ++e) { const f32x4 b4 = *(const LAS f32x4*)(Bt + (sq * 4 + e) * RS + j), k4 = *(const LAS f32x4*)(Kt + (sq * 4 + e) * RS + j);
            mrb[e] += a4[0] * b4[0] + a4[1] * b4[1] + a4[2] * b4[2] + a4[3] * b4[3]; mrk[e] += a4[0] * k4[0] + a4[1] * k4[1] + a4[2] * k4[2] + a4[3] * k4[3]; } }
#pragma unroll
    for (int e = 0; e < 4; ++e) { const int s = sq * 4 + e; if (s >= t) { mab[e] = 0.f; mak[e] = 0.f; } if (s > t) { mrb[e] = 0.f; mrk[e] = 0.f; } }
    LAS float* m0 = mat; LAS float* m1 = mat + 256; LAS float* m2 = mat + 512; LAS float* m3 = mat + 768;
    float T[4], P[4], Q[4];
    st16(m0, t, sq, mab); LDS_WAIT(); asm volatile("" ::: "memory");
#pragma unroll
    for (int e = 0; e < 4; ++e) T[e] = mab[e] + ((sq * 4 + e) == t ? 1.f : 0.f);
    mm16(m0, m0, t, sq, P);
    st16(m1, t, sq, P); st16(m2, t, sq, T); LDS_WAIT(); asm volatile("" ::: "memory");
    mm16(m2, m1, t, sq, Q);
#pragma unroll
    for (int e = 0; e < 4; ++e) T[e] += Q[e];
    mm16(m1, m1, t, sq, P);
    asm volatile("" ::: "memory");
    st16(m0, t, sq, P); st16(m2, t, sq, T); LDS_WAIT(); asm volatile("" ::: "memory");
    mm16(m2, m0, t, sq, Q);
#pragma unroll
    for (int e = 0; e < 4; ++e) T[e] += Q[e];
    mm16(m0, m0, t, sq, P);
    asm volatile("" ::: "memory");
    st16(m1, t, sq, P); st16(m2, t, sq, T); LDS_WAIT(); asm volatile("" ::: "memory");
    mm16(m2, m1, t, sq, Q);
#pragma unroll
    for (int e = 0; e < 4; ++e) T[e] += Q[e];
    asm volatile("" ::: "memory");
    st16(m2, t, sq, T); st16(m0, t, sq, mrb); st16(m1, t, sq, mak); LDS_WAIT(); asm volatile("" ::: "memory");
    float P1[4], TM[4], Nn[4];
    mm16(m0, m2, t, sq, P1); mm16(m2, m1, t, sq, TM);
    st16(m3, t, sq, P1); LDS_WAIT(); asm volatile("" ::: "memory");
    mm16(m3, m1, t, sq, Nn);
#pragma unroll
    for (int e = 0; e < 4; ++e) Nn[e] += mrk[e];
    unsigned char* rec = ws + SC_CREC + ((size_t)chain * 256 + c) * CR_BYTES;
    { u32x2 w; w.x = pk2(TM[0], TM[1]); w.y = pk2(TM[2], TM[3]); *(u32x2*)(rec + CR_TM + (16 * sq + t) * 8) = w;
      w.x = pk2(Nn[0], Nn[1]); w.y = pk2(Nn[2], Nn[3]); *(u32x2*)(rec + CR_N + (16 * sq + t) * 8) = w; }
    LAS unsigned short* TAh = (LAS unsigned short*)Bt; LAS unsigned short* GHh = TAh + 1024;
#pragma unroll
    for (int tt = 0; tt < 16; ++tt) { float ta = 0.f, gh = rt[tt];
#pragma unroll
        for (int s4 = 0; s4 < 4; ++s4) { const f32x4 t4 = *(const LAS f32x4*)(m2 + tt * 16 + s4 * 4), p4 = *(const LAS f32x4*)(m3 + tt * 16 + s4 * 4);
            ta += t4[0] * at[s4 * 4] + t4[1] * at[s4 * 4 + 1] + t4[2] * at[s4 * 4 + 2] + t4[3] * at[s4 * 4 + 3];
            gh += p4[0] * at[s4 * 4] + p4[1] * at[s4 * 4 + 1] + p4[2] * at[s4 * 4 + 2] + p4[3] * at[s4 * 4 + 3]; }
        TAh[tt * 64 + lane] = f2bf(ta); GHh[tt * 64 + lane] = f2bf(gh); }
    LDS_WAIT(); asm volatile("" ::: "memory");
    { const int r = lane & 15, g = lane >> 4;
#pragma unroll
      for (int ks = 0; ks < 2; ++ks) { const u32x2 a0 = *(const LAS u32x2*)(TAh + r * 64 + 32 * ks + 4 * g), a1 = *(const LAS u32x2*)(TAh + r * 64 + 32 * ks + 16 + 4 * g);
          *(u32x4*)(rec + CR_TA + (ks * 64 + lane) * 16) = (u32x4){a0.x, a0.y, a1.x, a1.y};
          const u32x2 g0 = *(const LAS u32x2*)(GHh + r * 64 + 32 * ks + 4 * g), g1 = *(const LAS u32x2*)(GHh + r * 64 + 32 * ks + 16 + 4 * g);
          *(u32x4*)(rec + CR_GH + (ks * 64 + lane) * 16) = (u32x4){g0.x, g0.y, g1.x, g1.y}; } }
    { const int jb = lane >> 4, r = lane & 15; float vv[16];
#pragma unroll
      for (int tt = 0; tt < 16; ++tt) { const int pos = dir ? (SEQ - 1 - 16 * c - tt) : (16 * c + tt); vv[tt] = Vp[(size_t)(b * SEQ + pos) * 512 + h * 64 + lane]; }
#pragma unroll
      for (int g = 0; g < 4; ++g) { u32x4 w; w.x = pk2(wb[4 * g], wb[4 * g + 1]); w.y = pk2(wb[4 * g + 2], wb[4 * g + 3]); w.z = pk2(wk[4 * g], wk[4 * g + 1]); w.w = pk2(wk[4 * g + 2], wk[4 * g + 3]);
          *(u32x4*)(rec + CR_WBK + (jb * 64 + 16 * g + r) * 16) = w;
          u32x2 x; x.x = pk2(vv[4 * g], vv[4 * g + 1]); x.y = pk2(vv[4 * g + 2], vv[4 * g + 3]); *(u32x2*)(rec + CR_V + (jb * 64 + 16 * g + r) * 8) = x; } }
    LDS_WAIT(); asm volatile("" ::: "memory");
}

__device__ __forceinline__ void cprep_phase(Frame& F, int layer) {
    LAS float* Lw = (LAS float*)(F.lds + F.wave * 17408);
    for (int it = F.bid * 8 + F.wave; it < 32 * 256; it += F.G * 8) { const int c = it >> 5, chain = it & 31; rwkv_cprep_item(F, chain, c, Lw); }
    asm volatile("" ::: "memory");
    for (int it = F.bid * 8 + F.wave; it < 2048; it += F.G * 8) s5_block_task<2>(F, layer, it, Lw);
}

template <class P, class T> struct RwPtr { typedef const T* type; };
template <class T> struct RwPtr<const LAS unsigned char*, T> { typedef const LAS T* type; };
struct RwOps { bf16x8 ta[2], gh[2], wbk[4]; u32x2 tm, nn, vq[2]; f32x4 wl[4]; };
template <class P> __device__ __forceinline__ void rw_load(RwOps& o, P rec, int lane, int half) {
    const int g = lane >> 4;
#pragma unroll
    for (int ks = 0; ks < 2; ++ks) { o.ta[ks] = *(const typename RwPtr<P, bf16x8>::type)(rec + CR_TA + (ks * 64 + lane) * 16); o.gh[ks] = *(const typename RwPtr<P, bf16x8>::type)(rec + CR_GH + (ks * 64 + lane) * 16); }
#pragma unroll
    for (int jb = 0; jb < 4; ++jb) { o.wbk[jb] = *(const typename RwPtr<P, bf16x8>::type)(rec + CR_WBK + (jb * 64 + lane) * 16); o.wl[jb] = *(const typename RwPtr<P, f32x4>::type)(rec + CR_WL + (jb * 16 + g * 4) * 4); }
    o.tm = *(const typename RwPtr<P, u32x2>::type)(rec + CR_TM + lane * 8); o.nn = *(const typename RwPtr<P, u32x2>::type)(rec + CR_N + lane * 8);
#pragma unroll
    for (int it = 0; it < 2; ++it) o.vq[it] = *(const typename RwPtr<P, u32x2>::type)(rec + CR_V + ((half * 2 + it) * 64 + lane) * 8);
}
__device__ __forceinline__ bf16x8 mk8(unsigned a, unsigned b, unsigned c, unsigned d) { u32x4 w = {a, b, c, d}; return *reinterpret_cast<bf16x8*>(&w); }
__device__ __forceinline__ void rw_step(const RwOps& o, f32x4 (&X)[4][2], float* ysb, const long rs, int lane) {
    const int r = lane & 15, g = lane >> 4;
    const bf16x8 tmf = mk8(o.tm.x, o.tm.y, 0u, 0u), nf = mk8(o.nn.x, o.nn.y, 0u, 0u);
#pragma unroll
    for (int it = 0; it < 2; ++it) {
        bf16x8 xb[2];
#pragma unroll
        for (int ks = 0; ks < 2; ++ks) xb[ks] = mk8(pk2c(X[2 * ks][it][0], X[2 * ks][it][1]), pk2c(X[2 * ks][it][2], X[2 * ks][it][3]), pk2c(X[2 * ks + 1][it][0], X[2 * ks + 1][it][1]), pk2c(X[2 * ks + 1][it][2], X[2 * ks + 1][it][3]));
        const bf16x8 vb = mk8(o.vq[it].x, o.vq[it].y, 0u, 0u);
        f32x4 U = {0.f, 0.f, 0.f, 0.f}, Y = {0.f, 0.f, 0.f, 0.f};
        U = __builtin_amdgcn_mfma_f32_16x16x32_bf16(o.ta[0], xb[0], U, 0, 0, 0); Y = __builtin_amdgcn_mfma_f32_16x16x32_bf16(o.gh[0], xb[0], Y, 0, 0, 0);
        U = __builtin_amdgcn_mfma_f32_16x16x32_bf16(o.ta[1], xb[1], U, 0, 0, 0); Y = __builtin_amdgcn_mfma_f32_16x16x32_bf16(o.gh[1], xb[1], Y, 0, 0, 0);
        U = __builtin_amdgcn_mfma_f32_16x16x32_bf16(tmf, vb, U, 0, 0, 0);       Y = __builtin_amdgcn_mfma_f32_16x16x32_bf16(nf, vb, Y, 0, 0, 0);
        const bf16x8 uvb = mk8(pk2c(U[0], U[1]), pk2c(U[2], U[3]), o.vq[it].x, o.vq[it].y);
#pragma unroll
        for (int jb = 0; jb < 4; ++jb) X[jb][it] = __builtin_amdgcn_mfma_f32_16x16x32_bf16(o.wbk[jb], uvb, X[jb][it] * o.wl[jb], 0, 0, 0);
#pragma unroll
        for (int q = 0; q < 4; ++q) ysb[(long)(4 * g + q) * rs + 16 * it + r] = Y[q];
    }
}
__device__ __forceinline__ void rwkv_scan_chunked(Frame& F, int chain, int half) {
    unsigned char* ws = F.ws; asm volatile("" : "+s"(ws)); const int dir = chain & 1, h = (chain >> 1) & 7, b = chain >> 4; const int lane = F.lane;
    const unsigned char* rec0 = ws + SC_CREC + (size_t)chain * 256 * CR_BYTES;
#ifdef DBG_RWCHK
    float* YS = (float*)(ws + WS_HN) + (size_t)dir * NTOK * 512;
#else
    float* YS = (float*)(ws + SC_YS) + (size_t)dir * NTOK * 512;
#endif
    f32x4 X[4][2];
#pragma unroll
    for (int jb = 0; jb < 4; ++jb) { X[jb][0] = (f32x4){0.f, 0.f, 0.f, 0.f}; X[jb][1] = (f32x4){0.f, 0.f, 0.f, 0.f}; }
    RwOps oa, ob;
    rw_load(oa, rec0, lane, half);
    const long rs = dir ? -512 : 512;
    for (int c = 0; c < 256; c += 2) {
        rw_load(ob, rec0 + (size_t)(c + 1) * CR_BYTES, lane, half);
        { const int pos0 = dir ? (SEQ - 1 - 16 * c) : 16 * c; rw_step(oa, X, YS + (size_t)(b * SEQ + pos0) * 512 + h * 64 + half * 32, rs, lane); }
        if (c + 2 < 256) rw_load(oa, rec0 + (size_t)(c + 2) * CR_BYTES, lane, half);
        { const int pos0 = dir ? (SEQ - 1 - 16 * (c + 1)) : 16 * (c + 1); rw_step(ob, X, YS + (size_t)(b * SEQ + pos0) * 512 + h * 64 + half * 32, rs, lane); }
    }
}

__device__ __forceinline__ void rwkv_scan_ring(Frame& F, int pair) {
    unsigned char* ws = F.ws; asm volatile("" : "+s"(ws));
    const int w = F.wave, lane = F.lane;
    LAS unsigned char* ring = F.lds;
    __syncthreads();
    if (w < 4) {
        const int chain = pair * 2 + (w >> 1), half = w & 1; const int dir = chain & 1, h = (chain >> 1) & 7, b = chain >> 4;
        float* YS = (float*)(ws + SC_YS) + (size_t)dir * NTOK * 512;
        f32x4 X[4][2];
#pragma unroll
        for (int jb = 0; jb < 4; ++jb) { X[jb][0] = (f32x4){0.f, 0.f, 0.f, 0.f}; X[jb][1] = (f32x4){0.f, 0.f, 0.f, 0.f}; }
        const long rs = dir ? -512 : 512;
        __syncthreads();
#pragma unroll 1
        for (int c = 0; c < 256; ++c) {
            RwOps o; rw_load(o, (const LAS unsigned char*)(ring + ((w >> 1) * 2 + (c & 1)) * CR_BYTES), lane, half);
            const int pos0 = dir ? (SEQ - 1 - 16 * c) : 16 * c; rw_step(o, X, YS + (size_t)(b * SEQ + pos0) * 512 + h * 64 + half * 32, rs, lane);
            __syncthreads();
        }
    } else {
        const int k = (w - 4) >> 1, part = (w - 4) & 1; const int chain = pair * 2 + k;
        const unsigned char* rec0 = ws + SC_CREC + (size_t)chain * 256 * CR_BYTES;
        LAS unsigned char* dst0 = ring + (k * 2) * CR_BYTES;
        const int i0 = (part * 64 + lane) * 16;
        u32x4 R0[6], R1[6], R2[6];
#define RW_LD(R, cc) do { const unsigned char* p_ = rec0 + (size_t)(cc) * CR_BYTES + i0; _Pragma("unroll") for (int j = 0; j < 6; ++j) if (j < 5 || i0 + 2048 * 5 < CR_BYTES) R[j] = *(const u32x4*)(p_ + 2048 * j); } while (0)
#define RW_ST(R, cc) do { LAS unsigned char* d_ = dst0 + ((cc) & 1) * CR_BYTES + i0; _Pragma("unroll") for (int j = 0; j < 6; ++j) if (j < 5 || i0 + 2048 * 5 < CR_BYTES) *(LAS u32x4*)(d_ + 2048 * j) = R[j]; } while (0)
        RW_LD(R0, 0); RW_LD(R1, 1); RW_LD(R2, 2);
        RW_ST(R0, 0); RW_LD(R0, 3);
        __syncthreads();
#pragma unroll 1
        for (int c = 0; c < 255; c += 3) {
            RW_ST(R1, c + 1); if (c + 4 < 256) RW_LD(R1, c + 4); __syncthreads();
            RW_ST(R2, c + 2); if (c + 5 < 256) RW_LD(R2, c + 5); __syncthreads();
            RW_ST(R0, c + 3); if (c + 6 < 256) RW_LD(R0, c + 6); __syncthreads();
        }
        __syncthreads();
#undef RW_LD
#undef RW_ST
    }
}

__device__ __forceinline__ void rwkv_scan_naive(Frame& F, int chain) {
    unsigned char* ws = F.ws; const float* RW = (const float*)(ws + SC_RW); const size_t N1 = (size_t)NTOK * 512;
    const int dir = chain & 1, h = (chain >> 1) & 7, b = chain >> 4;
    const float* Rp = RW; const float* Vp = RW + N1; const float* KKp = RW + 2 * N1; const float* Wp = RW + (3 + dir) * N1; const float* KMp = RW + (5 + dir) * N1; const float* BBp = RW + (7 + dir) * N1;
    float* YS = (float*)(ws + SC_YS) + (size_t)dir * N1;
    LAS float* L = (LAS float*)(F.lds + F.wave * 2048);
    float st[64];
#pragma unroll
    for (int j = 0; j < 64; ++j) st[j] = 0.f;
    size_t idx = (size_t)(b * SEQ + (dir ? SEQ - 1 : 0)) * 512 + h * 64 + F.lane;
    float va = -KKp[idx], vw = __expf(Wp[idx]), vb = BBp[idx], vk = KMp[idx], vr = Rp[idx], vv = Vp[idx];
    for (int t = 0; t < SEQ; ++t) {
        L[F.lane] = va; L[64 + F.lane] = vw; L[128 + F.lane] = vb; L[192 + F.lane] = vk; L[256 + F.lane] = vr;
        const float v = vv; const size_t oidx = idx;
        if (t + 1 < SEQ) { idx = dir ? idx - 512 : idx + 512; va = -KKp[idx]; vw = __expf(Wp[idx]); vb = BBp[idx]; vk = KMp[idx]; vr = Rp[idx]; vv = Vp[idx]; }
        LDS_WAIT(); asm volatile("" ::: "memory");
        float sa0 = 0.f, sa1 = 0.f, sa2 = 0.f, sa3 = 0.f;
#pragma unroll
        for (int j = 0; j < 64; j += 4) { const f32x4 x = *(const LAS f32x4*)(L + j); sa0 += st[j] * x[0]; sa1 += st[j + 1] * x[1]; sa2 += st[j + 2] * x[2]; sa3 += st[j + 3] * x[3]; }
        const float sa = (sa0 + sa1) + (sa2 + sa3);
        float y0 = 0.f, y1 = 0.f, y2 = 0.f, y3 = 0.f;
#pragma unroll
        for (int j = 0; j < 64; j += 4) { const f32x4 w4 = *(const LAS f32x4*)(L + 64 + j), b4 = *(const LAS f32x4*)(L + 128 + j), k4 = *(const LAS f32x4*)(L + 192 + j), r4 = *(const LAS f32x4*)(L + 256 + j);
            st[j] = st[j] * w4[0] + (sa * b4[0] + v * k4[0]); st[j + 1] = st[j + 1] * w4[1] + (sa * b4[1] + v * k4[1]); st[j + 2] = st[j + 2] * w4[2] + (sa * b4[2] + v * k4[2]); st[j + 3] = st[j + 3] * w4[3] + (sa * b4[3] + v * k4[3]);
            y0 += st[j] * r4[0]; y1 += st[j + 1] * r4[1]; y2 += st[j + 2] * r4[2]; y3 += st[j + 3] * r4[3]; }
        YS[oidx] = (y0 + y1) + (y2 + y3);
        asm volatile("" ::: "memory");
    }
}

__device__ __forceinline__ void s5_unit(Frame& F, ArgsP a, int layer, int unit) {
    unsigned char* ws = F.ws; asm volatile("" : "+s"(ws)); const bf16* Z = (const bf16*)(ws + SC_Z);
    const int b = unit / S5NCH, ch = unit % S5NCH; const int tok0 = b * SEQ + ch * S5CH;
    LAS float* ybuf = (LAS float*)F.lds;
    LAS unsigned short* gla = (LAS unsigned short*)(F.lds + 32768);
    LAS unsigned short* xa = (LAS unsigned short*)(F.lds + 49408 + F.wave * 4352);
    LAS float* ulw = (LAS float*)(F.lds + RING_BYTES + F.wave * 1024);
    const float* ab = (const float*)(ws + WS_S5P + layer * S5P_LAYER); const float* bb = ab + 2 * 32 * 64 * 2;
    const float* carry = (const float*)(ws + SC_CARRY);
    const int n = F.lane, r = n & 15, g4 = n >> 4;
    __syncthreads();
    for (int gi = 0; gi < 4; ++gi) {
        const int g = gi * 8 + F.wave;
        { const int tl = (n >> 1) & 15, hf = n & 1; const u32x4 w0 = *(const u32x4*)(Z + (size_t)(tok0 + tl) * ZLD + ZD + g * 16 + hf * 8);
          if (n < 32) { LAS f32x4* d = (LAS f32x4*)(ulw + tl * 16 + hf * 8);
            d[0] = (f32x4){__uint_as_float(w0.x << 16), __uint_as_float(w0.x & 0xffff0000u), __uint_as_float(w0.y << 16), __uint_as_float(w0.y & 0xffff0000u)};
            d[1] = (f32x4){__uint_as_float(w0.z << 16), __uint_as_float(w0.z & 0xffff0000u), __uint_as_float(w0.w << 16), __uint_as_float(w0.w & 0xffff0000u)}; } }
        float abr2[2], abi2[2], cr2[2], ci2[2];
#pragma unroll
        for (int dir = 0; dir < 2; ++dir) { const int pr = (dir * 32 + g) * 64 + n; abr2[dir] = ab[pr * 2]; abi2[dir] = ab[pr * 2 + 1];
            const float* cp = carry + ((((size_t)dir * BATCH + b) * S5NCH + ch) * 32 + g) * 128 + n * 2; cr2[dir] = cp[0]; ci2[dir] = cp[1]; }
        bf16x8 cwf[4];
        { const bf16* cw = (const bf16*)(ws + WS_S5CW) + ((size_t)(layer * 32 + g) * 16 + r) * 128 + g4 * 8;
#pragma unroll
          for (int ks = 0; ks < 4; ++ks) cwf[ks] = *(const bf16x8*)(cw + ks * 32); }
        LDS_WAIT(); asm volatile("" ::: "memory");
        float xfr[16], xfi[16];
#pragma unroll
        for (int dir = 0; dir < 2; ++dir) {
            const int pr = (dir * 32 + g) * 64 + n; const float abr = abr2[dir], abi = abi2[dir];
            float bbr[16], bbi[16];
            { const f32x4* bp = (const f32x4*)(bb + (size_t)pr * 32);
#pragma unroll
              for (int c4 = 0; c4 < 8; ++c4) { const f32x4 q = bp[c4]; bbr[c4 * 2] = q[0]; bbi[c4 * 2] = q[1]; bbr[c4 * 2 + 1] = q[2]; bbi[c4 * 2 + 1] = q[3]; } }
            float xr = cr2[dir], xi = ci2[dir];
#pragma unroll
            for (int i = 0; i < S5CH; ++i) { const int tl = dir ? (S5CH - 1 - i) : i;
                const f32x4 u0 = *(const LAS f32x4*)(ulw + tl * 16), u1 = *(const LAS f32x4*)(ulw + tl * 16 + 4), u2 = *(const LAS f32x4*)(ulw + tl * 16 + 8), u3 = *(const LAS f32x4*)(ulw + tl * 16 + 12);
                float br = 0.f, bi = 0.f;
#pragma unroll
                for (int c = 0; c < 4; ++c) { br += bbr[c] * u0[c] + bbr[4 + c] * u1[c] + bbr[8 + c] * u2[c] + bbr[12 + c] * u3[c]; bi += bbi[c] * u0[c] + bbi[4 + c] * u1[c] + bbi[8 + c] * u2[c] + bbi[12 + c] * u3[c]; }
                const float nr = abr * xr - abi * xi + br, ni = abr * xi + abi * xr + bi; xr = nr; xi = ni;
                if (dir == 0) { xfr[tl] = xr; xfi[tl] = xi; }
                else { xa[tl * 136 + n] = f2bf(xfr[tl] + xr); xa[tl * 136 + 64 + n] = f2bf(xfi[tl] + xi); }
                if ((i & 3) == 3) asm volatile("" ::: "memory"); }
        }
        LDS_WAIT(); asm volatile("" ::: "memory");
        { f32x4 y = {0.f, 0.f, 0.f, 0.f};
#pragma unroll
          for (int ks = 0; ks < 4; ++ks) { const bf16x8 af = *(const LAS bf16x8*)(xa + r * 136 + ks * 32 + g4 * 8); y = __builtin_amdgcn_mfma_f32_16x16x32_bf16(af, cwf[ks], y, 0, 0, 0); }
          const float dsk = a->in[I_S5_D][(size_t)layer * 512 + g * 16 + r];
#pragma unroll
          for (int q = 0; q < 4; ++q) { const int tl = 4 * g4 + q; const float yy = y[q] + dsk * ulw[tl * 16 + r];
              const float x3 = yy * yy * yy; const float gl = 0.5f * yy * (1.f + tanhf(0.7978845608028654f * (yy + 0.044715f * x3)));
              ybuf[tl * 512 + g * 16 + r] = gl; gla[tl * 520 + g * 16 + r] = f2bf(gl); } }
        LDS_WAIT(); asm volatile("" ::: "memory");
    }
    __syncthreads();
    { f32x4 acc[4];
#pragma unroll
      for (int j = 0; j < 4; ++j) acc[j] = (f32x4){0.f, 0.f, 0.f, 0.f};
      const bf16* wt = (const bf16*)(ws + WS_GLUT) + (size_t)layer * 512 * 512 + (size_t)(F.wave * 64 + r) * 512 + g4 * 8;
#pragma unroll 1
      for (int k0 = 0; k0 < 16; k0 += 4) { bf16x8 bf_[4][4];
#pragma unroll
          for (int kk = 0; kk < 4; ++kk)
#pragma unroll
              for (int j = 0; j < 4; ++j) bf_[kk][j] = *(const bf16x8*)(wt + (size_t)j * 16 * 512 + (k0 + kk) * 32);
#pragma unroll
          for (int kk = 0; kk < 4; ++kk) { const bf16x8 af = *(const LAS bf16x8*)(gla + r * 520 + (k0 + kk) * 32 + g4 * 8);
#pragma unroll
              for (int j = 0; j < 4; ++j) acc[j] = __builtin_amdgcn_mfma_f32_16x16x32_bf16(af, bf_[kk][j], acc[j], 0, 0, 0); } }
#pragma unroll
      for (int j = 0; j < 4; ++j) { const int c = F.wave * 64 + j * 16 + r; const float bias = a->in[I_S5_GLU_B][(size_t)layer * 512 + c];
#pragma unroll
          for (int q = 0; q < 4; ++q) { const int tl = 4 * g4 + q; const float gl = ybuf[tl * 512 + c]; ybuf[tl * 512 + c] = gl * sigmoidf_(acc[j][q] + bias); } } }
    __syncthreads();
    { const float* gn = a->in[I_MIX_OUT_NORM] + ((size_t)layer * 2 + 1) * 512; bf16* MIX = (bf16*)(ws + WS_MIX);
#pragma unroll
      for (int q = 0; q < 2; ++q) { const int tl = F.wave * 2 + q; float v[8]; float s = 0.f;
#pragma unroll
          for (int j = 0; j < 8; ++j) { v[j] = ybuf[tl * 512 + j * 64 + F.lane]; s += v[j] * v[j]; }
          const float rstd = 1.f / sqrtf(wave_sum(s) * (1.f / 512.f) + RMS_EPS);
#pragma unroll
          for (int j = 0; j < 8; ++j) MIX[(size_t)(tok0 + tl) * DM + 1536 + j * 64 + F.lane] = f2bf(v[j] * rstd * gn[j * 64 + F.lane]); } }
}

template <int mask>
__device__ __forceinline__ void mix_phase(Frame& F, ArgsP a, int layer, const int rep) {
    const int qb_ = (rep * 2 + layer) * 8;
    constexpr int NB = 16, NA = BATCH * 4 * (SEQ / 128), NC = BATCH * 4 * 48, ND = BATCH * S5NCH;
    if (mask & 1) for (;;) { const int it = q_next(F, qb_ + 1); if (it >= NB) break; rwkv_scan_ring(F, it); }
    if (mask & 2) for (;;) { const int it = q_next(F, qb_ + 2); if (it >= NA) break;
        unsigned char* ws = F.ws; asm volatile("" : "+s"(ws)); const bf16* Z = (const bf16*)(ws + SC_Z);
        const int qb = it % (SEQ / 128), h = (it / (SEQ / 128)) % 4, b = it / (4 * (SEQ / 128));
        const bf16* zb = Z + (size_t)(b * SEQ) * ZLD + ZA;
        float lam, lam_init;
        { const float* lv = a->in[I_DIFF_LAMBDA] + (size_t)layer * 4 * 64; float d1 = 0.f, d2 = 0.f;
          for (int i = 0; i < 64; ++i) { d1 += lv[i] * lv[64 + i]; d2 += lv[128 + i] * lv[192 + i]; }
          lam_init = 0.8f - 0.6f * expf(-0.3f * (float)layer); lam = expf(d1) - expf(d2) + lam_init; }
        att::diff_attn_unit(zb + (size_t)(qb * 128) * ZLD + h * 128, zb + 512 + h * 128, zb + 1024 + h * 128, ZLD, SEQ,
                            (bf16*)(ws + WS_MIX) + (size_t)(b * SEQ + qb * 128) * DM + h * 128, DM, lam, 1.f - lam_init, a->in[I_DIFF_SUBLN] + (size_t)layer * 128, (char*)F.lds, F.wave); }
#ifdef DBG_RWCHK
    for (;;) { const int it = q_next(F, layer * 8 + 5); if (it >= 4) break; rwkv_scan_naive(F, it * 8 + F.wave); }
#endif
    if (mask & 4) for (;;) { const int it = q_next(F, qb_ + 3); if (it >= NC) break;
        unsigned char* ws = F.ws; asm volatile("" : "+s"(ws)); const bf16* Z = (const bf16*)(ws + SC_Z);
        const int r = it % 48, h = (it / 48) % 4, b = it / (48 * 4); const int p = r / 16, rr = r % 16;
        const int dil = p == 0 ? 1 : (p == 1 ? 4 : 16); const int L = SEQ / dil; const int nqb = L / 256; const int rho = rr / nqb, qb = rr % nqb;
        const bf16* zb = Z + (size_t)(b * SEQ) * ZLD + ZC;
        att::dil_attn_unit(zb + h * 128, zb + 512 + h * 128, zb + 1024 + h * 128, ZLD, dil, rho, qb * 256, L,
                           (float*)(ws + SC_OC) + ((size_t)p * NTOK + (size_t)b * SEQ) * 512 + h * 128, (float*)(ws + SC_LSE) + ((size_t)p * NTOK + (size_t)b * SEQ) * 4 + h, (char*)F.lds, F.wave); }
    if (mask & 8) for (;;) { const int it = q_next(F, qb_ + 4); if (it >= ND) break; s5_unit(F, a, layer, it); }
}

__device__ __forceinline__ void post_phase(Frame& F, ArgsP a, int layer) {
    unsigned char* ws = F.ws; bf16* MIX = (bf16*)(ws + WS_MIX);
    const int gw = F.bid * 8 + F.wave, NGW = F.G * 8;
    const float* RW = (const float*)(ws + SC_RW); const size_t N1 = (size_t)NTOK * 512; const float* YS = (const float*)(ws + SC_YS);
#ifdef DBG_RWCHK
    { const float* Y2 = (const float*)(ws + WS_HN); float e = 0.f, r2 = 0.f; int bad = 0;
      for (size_t i = (size_t)F.bid * 512 + F.tid; i < (size_t)2 * NTOK * 512; i += (size_t)F.G * 512) { const float a0 = ((const float*)(ws + SC_YS))[i], b0 = Y2[i]; const float d = fabsf(a0 - b0); if (!(d < 1e30f)) bad = 1; else e = fmaxf(e, d); r2 = fmaxf(r2, fabsf(a0)); }
      e = wave_max(e); r2 = wave_max(r2); bad = __any(bad) ? 1 : 0;
      if (F.lane == 0) { atomicMax(F.ctl + 32768 + layer * 64, __float_as_uint(e)); atomicMax(F.ctl + 32768 + layer * 64 + 1, __float_as_uint(r2)); if (bad) atomicMax(F.ctl + 32768 + layer * 64 + 2, 1u); } }
#endif
    for (int it = gw; it < NTOK * 8; it += NGW) { const int tok = it >> 3, h = it & 7; const size_t o = (size_t)tok * 512 + h * 64 + F.lane; const int c = h * 64 + F.lane;
        const float y = YS[o] + YS[N1 + o];
        const float mean = wave_sum(y) * (1.f / 64.f); const float d = y - mean; const float var = wave_sum(d * d) * (1.f / 64.f);
        const float yn = d * (1.f / sqrtf(var + 64e-5f)) * a->in[I_RWKV_LNX_W][(size_t)layer * 512 + c] + a->in[I_RWKV_LNX_B][(size_t)layer * 512 + c];
        const float r_ = RW[o], v_ = RW[N1 + o], kb = 0.5f * (RW[5 * N1 + o] + RW[6 * N1 + o]);
        const float bon = wave_sum(r_ * kb * a->in[I_RWKV_RK][(size_t)layer * 512 + c]) * v_;
        MIX[(size_t)tok * DM + 512 + c] = f2bf((yn + bon) * RW[9 * N1 + o]); }
    const float* OC = (const float*)(ws + SC_OC); const float* LSE = (const float*)(ws + SC_LSE); const float* gn = a->in[I_MIX_OUT_NORM] + ((size_t)layer * 2 + 0) * 512;
    for (int tok = gw; tok < NTOK; tok += NGW) { const int h = F.lane >> 4;
        const float l0 = LSE[((size_t)0 * NTOK + tok) * 4 + h], l1 = LSE[((size_t)1 * NTOK + tok) * 4 + h], l2 = LSE[((size_t)2 * NTOK + tok) * 4 + h];
        const float m = fmaxf(l0, fmaxf(l1, l2)); float w0 = __expf(l0 - m), w1 = __expf(l1 - m), w2 = __expf(l2 - m); const float inv = 1.f / (w0 + w1 + w2); w0 *= inv; w1 *= inv; w2 *= inv;
        float v[8]; float s = 0.f;
        const f32x4* p0 = (const f32x4*)(OC + ((size_t)0 * NTOK + tok) * 512) + F.lane * 2; const f32x4* p1 = (const f32x4*)(OC + ((size_t)1 * NTOK + tok) * 512) + F.lane * 2; const f32x4* p2 = (const f32x4*)(OC + ((size_t)2 * NTOK + tok) * 512) + F.lane * 2;
#pragma unroll
        for (int j = 0; j < 2; ++j) { const f32x4 a0 = p0[j], a1 = p1[j], a2 = p2[j];
#pragma unroll
            for (int e = 0; e < 4; ++e) { const float x = w0 * a0[e] + w1 * a1[e] + w2 * a2[e]; v[j * 4 + e] = x; s += x * x; } }
        const float rstd = 1.f / sqrtf(wave_sum(s) * (1.f / 512.f) + RMS_EPS);
        const f32x4 g0 = *((const f32x4*)gn + F.lane * 2), g1 = *((const f32x4*)gn + F.lane * 2 + 1);
        u32x4 w; w.x = pk2(v[0] * rstd * g0[0], v[1] * rstd * g0[1]); w.y = pk2(v[2] * rstd * g0[2], v[3] * rstd * g0[3]); w.z = pk2(v[4] * rstd * g1[0], v[5] * rstd * g1[1]); w.w = pk2(v[6] * rstd * g1[2], v[7] * rstd * g1[3]);
        *(u32x4*)(MIX + (size_t)tok * DM + 1024 + F.lane * 8) = w; }
}

#ifndef MK_FUSED
#define MK_FUSED 1
#endif
__global__ void __launch_bounds__(512, 2) enc_fwd(Args args_) {
    extern __shared__ __attribute__((aligned(16))) unsigned char lds_raw[];
    Frame F;
    F.lds = (LAS unsigned char*)lds_raw; F.MISC = (volatile LAS unsigned*)(F.lds + MISC_OFF);
    F.tid = threadIdx.x; F.lane = F.tid & 63; F.wave = __builtin_amdgcn_readfirstlane(F.tid >> 6); F.G = gridDim.x; F.bid = blockIdx.x;
    const int wave0 = F.wave;
    ArgsP ap = (ArgsP)__builtin_amdgcn_kernarg_segment_ptr();
    unsigned char* ws = ap->ws; F.ws = ws; F.ctl = (unsigned*)(ws + WS_CTL);
    for (int u = F.tid; u < (LDS_BYTES - MISC_OFF) / 4; u += 512) ((LAS unsigned*)(F.lds + MISC_OFF))[u] = 0u;
    __syncthreads();
    const int lo = ap->ph_lo, hi = ap->ph_hi;
    if (hi - lo > 1) (void)xcd_barrier_post(F.ctl + CW_BAR, F.MISC + 8);
#ifdef DBG_ONLY
#define IN(k) (((k) < PH_L0 ? (k) : ((k) == PH_FINAL ? 100 : 3 + ((k) - PH_L0) % NPH_L)) == DBG_ONLY && lo <= (k) && (k) < hi)
#else
#define IN(k) ({ int lo_ = lo, hi_ = hi; asm volatile("" : "+s"(lo_), "+s"(hi_)); lo_ <= (k) && (k) < hi_; })
#endif
#define args (*ap)
#define REFRESH() do { int wv_ = wave0, bi_ = blockIdx.x, gg_ = gridDim.x; asm volatile("" : "+s"(wv_), "+s"(bi_), "+s"(gg_)); const int t_ = tid_from_wave(wv_); F.tid = t_; F.lane = t_ & 63; F.wave = wv_; F.bid = bi_; F.G = gg_; ap = (ArgsP)__builtin_amdgcn_kernarg_segment_ptr(); asm volatile("" : "+s"(ap)); unsigned char* w_ = ap->ws; F.ws = w_; ws = w_; F.ctl = (unsigned*)(w_ + WS_CTL); } while (0)
#ifndef DBG_MIXMASK
#define DBG_MIXMASK 15
#endif
#ifndef DBG_REP_CODE
#define DBG_REP_CODE -1
#define DBG_REP_N 0
#endif
#define REPS(code) (((code) == DBG_REP_CODE && l_ == 0) ? 1 + DBG_REP_N : 1)
#ifdef DBG_TIME_A
#define STAMP(k) do { if (blockIdx.x == 0 && threadIdx.x == 0) { const unsigned long long t_ = wall_clock64(); F.MISC[192 + 2 * (k)] = (unsigned)t_; F.MISC[193 + 2 * (k)] = (unsigned)(t_ >> 32); } } while (0)
#else
#define STAMP(k) do {} while (0)
#endif
#define SEAM(k) do { if (IN(k) && IN((k) + 1)) { XcdBarrier b_; b_.bar = (unsigned*)(ap->ws + WS_CTL) + CW_BAR; b_.x = xb_xcc_id(); b_.st = F.MISC + 8; xcd_barrier(b_); } } while (0)

    { const int l_ = 0; STAMP(PH_P0); if (IN(PH_P0)) { REFRESH(); for (int rep = 0; rep < REPS(0); ++rep) p0_prologue(F, ap); } } SEAM(PH_P0);
    if (DBG_REP_CODE == 30 && hi - lo > 1) { for (int i = 0; i < 20; ++i) { XcdBarrier b_; b_.bar = (unsigned*)(ap->ws + WS_CTL) + CW_BAR; b_.x = xb_xcc_id(); b_.st = F.MISC + 8; xcd_barrier(b_); } }
    STAMP(PH_P1); if (IN(PH_P1)) { REFRESH();
        SchedBatch S{(const char*)(ws + SC_MEMN), (const char*)(ws + SC_WKVT), (char*)(ws + SC_KVB), (size_t)512 * DM * 2, (size_t)4096 * DM * 2, (size_t)512 * 4096 * 2, 2, 16, DEPTH, F.G, F.bid, DM, DM, 4096 * 2, 2, 512};
        { const int l_ = 0; for (int rep = 0; rep < REPS(1); ++rep) pg8::gemm_phase<pg8::EpiBf16, SchedBatch, false>(F.lds, pg8::GemmP{DM, DM, DM}, S, pg8::EpiBf16{4096}, F.wave); }
    } SEAM(PH_P1);
    STAMP(PH_P2); if (IN(PH_P2)) { REFRESH();
        { SchedXaPre S{ws, F.G, F.bid, 0}; pg8::gemm_phase<EpiBf16U, SchedXaPre, false>(F.lds, pg8::GemmP{512, 4096, DM}, S, EpiBf16U{}, F.wave); }
        { SchedXaPre S{ws, F.G, F.bid, 1}; pg8::gemm_phase<EpiBf16U, SchedXaPre, false>(F.lds, pg8::GemmP{512, DM, 4096}, S, EpiBf16U{}, F.wave); }
    } SEAM(PH_P2);

    for (int l = 0; l < DEPTH; ++l) {
        const int pb = PH_L0 + l * NPH_L; const int l_ = l;
        float* H = (float*)(ws + WS_H);
        STAMP(pb + LP_NORM1); if (IN(pb + LP_NORM1)) { REFRESH(); if (l == 0) { for (int rep = 0; rep < REPS(22); ++rep) norm_phase<0>(F, ap, args.in[I_X], args.in[I_NORM_MIX], l); } else norm_phase<1>(F, ap, H, args.in[I_NORM_MIX] + (size_t)l * DM, l); } SEAM(pb + LP_NORM1);
        STAMP(pb + LP_G1); if (IN(pb + LP_G1)) { REFRESH();
            SchedDense S{(const char*)(ws + WS_HN), (const char*)(ws + WS_WIN) + (size_t)l * ZLD * DM * 2, (char*)(ws + SC_Z), NTOK / 256, ZLD / 256, F.G, F.bid, DM, DM, ZLD * 2, 2};
            for (int rep = 0; rep < REPS(10); ++rep) pg8::gemm_phase<pg8::EpiBf16, SchedDense, false>(F.lds, pg8::GemmP{DM, DM, DM}, S, pg8::EpiBf16{ZLD}, F.wave);
        } SEAM(pb + LP_G1);
        STAMP(pb + LP_PREP); if (IN(pb + LP_PREP)) { REFRESH(); for (int rep = 0; rep < REPS(11); ++rep) prep_phase(F, ap, l, rep); } SEAM(pb + LP_PREP);
        STAMP(pb + LP_CPREP); if (IN(pb + LP_CPREP)) { REFRESH(); for (int rep = 0; rep < REPS(12); ++rep) cprep_phase(F, l); } SEAM(pb + LP_CPREP);
        STAMP(pb + LP_MIX); if (IN(pb + LP_MIX)) { REFRESH(); mix_phase<DBG_MIXMASK>(F, ap, l, 0); if (DBG_REP_CODE >= 13 && DBG_REP_CODE <= 16 && l_ == 0) { REFRESH(); mix_phase<(DBG_REP_CODE >= 13 && DBG_REP_CODE <= 16) ? (1 << (DBG_REP_CODE - 13)) : 1>(F, ap, l, 1); if (DBG_REP_N > 1) { REFRESH(); mix_phase<(DBG_REP_CODE >= 13 && DBG_REP_CODE <= 16) ? (1 << (DBG_REP_CODE - 13)) : 1>(F, ap, l, 2); } } } SEAM(pb + LP_MIX);
        STAMP(pb + LP_POST); if (IN(pb + LP_POST)) { REFRESH(); for (int rep = 0; rep < REPS(17); ++rep) post_phase(F, ap, l); } SEAM(pb + LP_POST);
        STAMP(pb + LP_G2); if (IN(pb + LP_G2)) { REFRESH();
            SchedDense S{(const char*)(ws + WS_MIX), (const char*)(ws + WS_WOUT) + (size_t)l * DM * DM * 2, (char*)H, NTOK / 256, DM / 256, F.G, F.bid, DM, DM, DM * 4, 4};
            for (int rep = 0; rep < REPS(23); ++rep) pg8::gemm_phase<pg8::EpiF32Res, SchedDense, false>(F.lds, pg8::GemmP{DM, DM, DM}, S, pg8::EpiF32Res{DM, l == 0 ? args.in[I_X] : (const float*)H, H}, F.wave);
        } SEAM(pb + LP_G2);
        STAMP(pb + LP_NORM2); if (IN(pb + LP_NORM2)) { REFRESH(); for (int rep = 0; rep < REPS(18); ++rep) norm_phase<0>(F, ap, H, args.in[I_NORM_CROSS] + (size_t)l * DM, l); } SEAM(pb + LP_NORM2);
        STAMP(pb + LP_GS); if (IN(pb + LP_GS)) { REFRESH();
            SchedBatch S{(const char*)(ws + WS_HN), (const char*)(ws + WS_WQK) + (size_t)l * 2 * 1024 * DM * 2, (char*)(ws + WS_P), (size_t)SEQ * DM * 2, (size_t)1024 * DM * 2, (size_t)SEQ * 1024 * 2, SEQ / 256, 4, BATCH, F.G, F.bid, DM, DM, 1024 * 2, 2, SEQ};
            for (int rep = 0; rep < REPS(19); ++rep) pg8::gemm_phase<pg8::EpiSoftmax, SchedBatch, false>(F.lds, pg8::GemmP{DM, DM, DM}, S, pg8::EpiSoftmax{1024, 0.044194173824159216f * 1.4426950408889634f}, F.wave);
        } SEAM(pb + LP_GS);
        STAMP(pb + LP_GO); if (IN(pb + LP_GO)) { REFRESH();
            SchedBatch S{(const char*)(ws + WS_P), (const char*)(ws + WS_VWO) + (size_t)l * 2 * DM * 1024 * 2, (char*)H, (size_t)SEQ * 1024 * 2, (size_t)DM * 1024 * 2, (size_t)SEQ * DM * 4, SEQ / 256, DM / 256, BATCH, F.G, F.bid, 1024, 1024, DM * 4, 4, SEQ};
            pg8::gemm_phase<pg8::EpiF32Res, SchedBatch, false>(F.lds, pg8::GemmP{1024, 1024, 1024}, S, pg8::EpiF32Res{DM, (const float*)H, H}, F.wave);
        } SEAM(pb + LP_GO);
        STAMP(pb + LP_NORM3); if (IN(pb + LP_NORM3)) { REFRESH(); norm_phase<2>(F, ap, H, args.in[I_NORM_MOE] + (size_t)l * DM, l); } SEAM(pb + LP_NORM3);
        STAMP(pb + LP_M1); if (IN(pb + LP_M1)) { REFRESH();
            volatile LAS int* tp = (volatile LAS int*)(F.lds + MISC_OFF + 256); volatile LAS int* cnt = tp + 40;
            moe_prefix(F, l, tp, cnt);
            SchedMoe S{ws, tp, cnt, l, F.G, F.bid, 0};
            for (int rep = 0; rep < REPS(20); ++rep) pg8::gemm_phase<pg8::EpiSwiGlu, SchedMoe, true>(F.lds, pg8::GemmP{DM, DM, DM}, S, pg8::EpiSwiGlu{DEXP}, F.wave);
        } SEAM(pb + LP_M1);
        STAMP(pb + LP_M2); if (IN(pb + LP_M2)) { REFRESH();
            volatile LAS int* tp = (volatile LAS int*)(F.lds + MISC_OFF + 256); volatile LAS int* cnt = tp + 40;
            moe_prefix(F, l, tp, cnt);
            SchedMoe S{ws, tp, cnt, l, F.G, F.bid, 1};
            for (int rep = 0; rep < REPS(21); ++rep) pg8::gemm_phase<pg8::EpiGate, SchedMoe, false>(F.lds, pg8::GemmP{DEXP, DEXP, DEXP}, S, pg8::EpiGate{DM, (const float*)(ws + WS_EGATE), nullptr}, F.wave);
        } SEAM(pb + LP_M2);
    }
#ifdef DBG_TIME_A
    STAMP(PH_FINAL);
    if (blockIdx.x == 0 && threadIdx.x == 0) { const unsigned long long ta = ((unsigned long long)F.MISC[193 + 2 * (DBG_TIME_A)] << 32) | F.MISC[192 + 2 * (DBG_TIME_A)], tb = ((unsigned long long)F.MISC[193 + 2 * (DBG_TIME_B)] << 32) | F.MISC[192 + 2 * (DBG_TIME_B)];
        __hip_atomic_store(F.ctl + 40000, (unsigned)((tb - ta + DBG_TIME_Q / 2) / DBG_TIME_Q), __ATOMIC_RELAXED, __HIP_MEMORY_SCOPE_AGENT); }
    if (hi - lo > 1) { XcdBarrier b_; b_.bar = (unsigned*)(ap->ws + WS_CTL) + CW_BAR; b_.x = xb_xcc_id(); b_.st = F.MISC + 8; xcd_barrier(b_); }
#endif
    STAMP(PH_FINAL); if (IN(PH_FINAL)) { REFRESH(); norm_phase<5>(F, ap, (const float*)(ws + WS_H), args.in[I_NORM_FINAL], DEPTH); }
#undef IN
#undef SEAM
#undef args
}

extern "C" void kernel_launch(void* const* d_in, const int* in_sizes, int n_in, void* d_out, int out_size, void* d_ws, size_t ws_size, hipStream_t stream) {
    static int grid = 0;
    if (grid == 0) {
        if (n_in != N_INPUTS || out_size != NTOK * DM || ws_size < cmax(WS_END, SC_MIX_END3)) { fprintf(stderr, "kernel_launch: built for %d inputs, out %d, ws >= %zu; got %d, %d, %zu\n", N_INPUTS, NTOK * DM, cmax(WS_END, SC_MIX_END3), n_in, out_size, ws_size); grid = -1; return; }
        int dev = 0, cus = 0, per_cu = 0;
        if (hipGetDevice(&dev) != hipSuccess || hipDeviceGetAttribute(&cus, hipDeviceAttributeMultiprocessorCount, dev) != hipSuccess) { fprintf(stderr, "kernel_launch: device query failed\n"); grid = -1; return; }
        if (hipFuncSetAttribute((const void*)enc_fwd, hipFuncAttributeMaxDynamicSharedMemorySize, LDS_BYTES) != hipSuccess) { fprintf(stderr, "kernel_launch: hipFuncSetAttribute failed\n"); grid = -1; return; }
        if (hipOccupancyMaxActiveBlocksPerMultiprocessor(&per_cu, (const void*)enc_fwd, 512, LDS_BYTES) != hipSuccess || per_cu < 1) fprintf(stderr, "kernel_launch: occupancy query says %d blocks per CU\n", per_cu);
        grid = cus;
    }
    if (grid < 0) return;
    hipMemsetAsync((char*)d_ws + WS_CTL, 0, CTL_BYTES, stream);
    Args a; memset(&a, 0, sizeof(a));
    for (int i = 0; i < N_INPUTS; ++i) a.in[i] = (const float*)d_in[i];
    a.out = (float*)d_out; a.ws = (unsigned char*)d_ws;
#if MK_FUSED
    a.ph_lo = 0; a.ph_hi = NPHASES;
    hipLaunchKernelGGL(enc_fwd, dim3(grid), dim3(512), LDS_BYTES, stream, a);
#else
    for (int p = 0; p < NPHASES; ++p) { a.ph_lo = p; a.ph_hi = p + 1; hipLaunchKernelGGL(enc_fwd, dim3(grid), dim3(512), LDS_BYTES, stream, a); }
#endif
    const hipError_t le = hipPeekAtLastError();
    if (le != hipSuccess) fprintf(stderr, "kernel_launch: launch failed: %s\n", hipGetErrorName(le));
}
```

```cpp
#include <hip/hip_runtime.h>
#include <cstdio>
#include <cstdint>
#include <cstring>

#define GAS __attribute__((address_space(1)))
#define LAS __attribute__((address_space(3)))
typedef unsigned short bf16;
typedef short bf16x8 __attribute__((ext_vector_type(8)));
typedef short s16x4 __attribute__((ext_vector_type(4)));
typedef float f32x2 __attribute__((ext_vector_type(2)));
typedef float f32x4 __attribute__((ext_vector_type(4)));
typedef float f32x16 __attribute__((ext_vector_type(16)));
typedef unsigned u32x2 __attribute__((ext_vector_type(2)));
typedef unsigned u32x4 __attribute__((ext_vector_type(4)));
typedef GAS unsigned gu32;

constexpr int DM = 2048, BATCH = 2, SEQ = 4096, NTOK = BATCH * SEQ, DEPTH = 2, NMEM = 256;
constexpr int IN_A = 1536, IN_B = 1920, IN_C = 1536, IN_D = 512, IN_TOTAL = 5504, ZLD = 5632;
constexpr int ZA = 0, ZB = 1536, ZC = 3456, ZD = 4992;
constexpr int NEXP = 32, DEXP = 512, ECAP = 8192;
constexpr int SLOT_CAP = 24576;
constexpr int S5CH = 16, S5NCH = SEQ / S5CH;
constexpr float RMS_EPS = 1e-6f;

enum { I_X = 0, I_MEM, I_NORM_MIX, I_W_IN, I_W_OUT, I_DIFF_LAMBDA, I_DIFF_SUBLN, I_RWKV_MU, I_RWKV_W0, I_RWKV_W2, I_RWKV_A0, I_RWKV_A2, I_RWKV_G2,
       I_RWKV_KK, I_RWKV_KA, I_RWKV_RK, I_RWKV_LNX_W, I_RWKV_LNX_B, I_S5_A_RE, I_S5_A_IM, I_S5_LOG_DT, I_S5_B_RE, I_S5_B_IM, I_S5_C_RE, I_S5_C_IM,
       I_S5_D, I_S5_GLU_W, I_S5_GLU_B, I_MIX_OUT_NORM, I_NORM_CROSS, I_NORM_MEM, I_XA_WQ, I_XA_WKV, I_XA_WO, I_NORM_MOE, I_ROUTER_GROUP,
       I_ROUTER_EXPERT, I_MOE_W1, I_MOE_W3, I_MOE_W2, I_NORM_FINAL, N_INPUTS };

constexpr size_t al256(size_t x) { return (x + 255) / 256 * 256; }
constexpr size_t WS_CTL = 0, CTL_BYTES = 1u << 20;
constexpr size_t WS_WIN  = WS_CTL + CTL_BYTES;
constexpr size_t WS_WOUT = WS_WIN + (size_t)DEPTH * ZLD * DM * 2;
constexpr size_t WS_WQK  = WS_WOUT + (size_t)DEPTH * DM * DM * 2;
constexpr size_t WS_VWO  = WS_WQK + (size_t)DEPTH * BATCH * 1024 * DM * 2;
constexpr size_t WS_W13  = WS_VWO + (size_t)DEPTH * BATCH * DM * 1024 * 2;
constexpr size_t WS_W2   = WS_W13 + (size_t)DEPTH * NEXP * 1024 * DM * 2;
constexpr size_t WS_ROPE = WS_W2 + (size_t)DEPTH * NEXP * DM * DEXP * 2;
constexpr size_t WS_S5P  = WS_ROPE + (size_t)SEQ * (32 + 32 + 64 + 64) * 4;
constexpr size_t S5P_LAYER = (size_t)(2 * 32 * 64 * 2 + 2 * 32 * 64 * 16 * 2 + 2 * 32 * 64 * 2) * 4;
constexpr size_t WS_LORA = al256(WS_S5P + DEPTH * S5P_LAYER);
constexpr size_t LORA_LAYER = (size_t)(2 * 512 * 64 * 2 + 512 * 128) * 2;
constexpr size_t WS_GLUT = al256(WS_LORA + DEPTH * LORA_LAYER);
constexpr size_t WS_S5CW = WS_GLUT + (size_t)DEPTH * 512 * 512 * 2;
constexpr size_t WS_RTE  = al256(WS_S5CW + (size_t)DEPTH * 32 * 16 * 128 * 2);
constexpr size_t WS_H    = al256(WS_RTE + (size_t)DEPTH * 4 * DM * 8 * 4);
constexpr size_t WS_HN   = WS_H + (size_t)NTOK * DM * 4;
constexpr size_t WS_MIX  = WS_HN + (size_t)NTOK * DM * 2;
constexpr size_t WS_P    = WS_MIX + (size_t)NTOK * DM * 2;
constexpr size_t WS_ETOK = WS_P + (size_t)NTOK * 1024 * 2;
constexpr size_t WS_EGATE= WS_ETOK + (size_t)NEXP * ECAP * 4;
constexpr size_t WS_TINFO= WS_EGATE + (size_t)NEXP * ECAP * 4;
constexpr size_t WS_SCR  = al256(WS_TINFO + (size_t)NTOK * 16);
constexpr size_t SC_WKVT = WS_SCR;
constexpr size_t SC_MEMN = SC_WKVT + (size_t)DEPTH * 4096 * DM * 2;
constexpr size_t SC_KVB  = SC_MEMN + (size_t)DEPTH * 512 * DM * 2;
constexpr size_t SC_WQB  = SC_KVB + (size_t)DEPTH * 512 * 4096 * 2;
constexpr size_t SC_WOT  = SC_WQB + (size_t)DEPTH * DM * DM * 2;
constexpr size_t SC_PRO_END = SC_WOT + (size_t)DEPTH * DM * DM * 2;
constexpr size_t SC_Z    = WS_SCR;
constexpr size_t SC_RW   = SC_Z + (size_t)NTOK * ZLD * 2;
constexpr size_t RWSZ    = (size_t)NTOK * 512 * 4;
constexpr size_t SC_YS   = SC_RW + 10 * RWSZ;
constexpr size_t SC_OC   = SC_YS + 2 * RWSZ;
constexpr size_t SC_LSE  = SC_OC + 3 * RWSZ;
constexpr size_t SC_CARRY= SC_LSE + (size_t)3 * NTOK * 4 * 4;
constexpr size_t SC_MIX_END = SC_CARRY + (size_t)2 * BATCH * S5NCH * 32 * 64 * 2 * 4;
constexpr size_t SC_HMID = WS_SCR;
constexpr size_t SC_YBUF = SC_HMID + (size_t)SLOT_CAP * DEXP * 2;
constexpr size_t SC_MOE_END = SC_YBUF + (size_t)SLOT_CAP * DM * 2;
constexpr size_t cmax(size_t a, size_t b) { return a > b ? a : b; }
constexpr size_t WS_END = cmax(cmax(SC_PRO_END, SC_MIX_END), SC_MOE_END);

constexpr int CW_BAR = 4096;
constexpr int CW_Q = 8192;
constexpr int CW_CNT = 16384;

constexpr int RING_BYTES = 131072;
constexpr int MISC_OFF = 147456 - 1024;
constexpr int LDS_BYTES = 147456;

__device__ __forceinline__ float bf2f(unsigned short b) { return __uint_as_float(((unsigned)b) << 16); }
typedef __bf16 bf16x2_t __attribute__((ext_vector_type(2)));
__device__ __forceinline__ unsigned pk2c(float lo, float hi) { bf16x2_t v = {(__bf16)lo, (__bf16)hi}; return __builtin_bit_cast(unsigned, v); }
__device__ __forceinline__ unsigned pk2(float lo, float hi) { unsigned r; asm volatile("v_cvt_pk_bf16_f32 %0, %1, %2" : "=v"(r) : "v"(lo), "v"(hi)); return r; }
__device__ __forceinline__ bf16 f2bf(float f) { return (bf16)(pk2(f, 0.f) & 0xffffu); }
template <int CTRL> __device__ __forceinline__ float dpp_mov(float v) { return __builtin_bit_cast(float, __builtin_amdgcn_update_dpp(0, __builtin_bit_cast(int, v), CTRL, 0xf, 0xf, true)); }
__device__ __forceinline__ float row_sum(float v) { v += dpp_mov<0xB1>(v); v += dpp_mov<0x4E>(v); v += dpp_mov<0x141>(v); v += dpp_mov<0x140>(v); return v; }
__device__ __forceinline__ float row_max(float v) { v = fmaxf(v, dpp_mov<0xB1>(v)); v = fmaxf(v, dpp_mov<0x4E>(v)); v = fmaxf(v, dpp_mov<0x141>(v)); v = fmaxf(v, dpp_mov<0x140>(v)); return v; }
__device__ __forceinline__ float rdlane(float v, int l) { return __builtin_bit_cast(float, __builtin_amdgcn_readlane(__builtin_bit_cast(int, v), l)); }
__device__ __forceinline__ float wave_sum(float v) { v = row_sum(v); return (rdlane(v, 0) + rdlane(v, 16)) + (rdlane(v, 32) + rdlane(v, 48)); }
__device__ __forceinline__ float wave_max(float v) { v = row_max(v); return fmaxf(fmaxf(rdlane(v, 0), rdlane(v, 16)), fmaxf(rdlane(v, 32), rdlane(v, 48))); }
__device__ __forceinline__ float sigmoidf_(float x) { return 1.f / (1.f + __expf(-x)); }
#define LDS_WAIT() asm volatile("s_waitcnt lgkmcnt(0)" ::: "memory")
#define VM_WAIT() asm volatile("s_waitcnt vmcnt(0)" ::: "memory")

__device__ __forceinline__ int tid_from_wave(int wave) { int ln; asm volatile("v_mbcnt_lo_u32_b32 %0, -1, 0\n\tv_mbcnt_hi_u32_b32 %0, -1, %0" : "=v"(ln)); return wave * 64 + ln; }

typedef __attribute__((address_space(8))) void* bufrsrc_t;
__device__ __forceinline__ __amdgpu_buffer_rsrc_t make_rsrc(const void* p, unsigned bytes) { return __builtin_amdgcn_make_buffer_rsrc((void*)p, 0, bytes, 0x00020000); }
__device__ __forceinline__ float bload_f32(__amdgpu_buffer_rsrc_t r, int voff, int soff) { return __builtin_bit_cast(float, __builtin_amdgcn_raw_buffer_load_b32(r, voff, soff, 0)); }

__device__ __forceinline__ float xor_lane(float v, int lane, int m) { return __builtin_bit_cast(float, __builtin_amdgcn_ds_bpermute((lane ^ m) << 2, __builtin_bit_cast(int, v))); }
#define XB_TMO      128
#define XB_XCNT(j)  (256  + 64 * (j))
#define XB_XSUB(j)  (1280 + 64 * (j))
#define XB_XGEN(j)  (2304 + 64 * (j))
#define XB_TOP      3328
#define XB_TOPGEN   3392
#define XCD_BAR_WORDS 3456
#define XB_SPIN_CAP (1u << 18)

__device__ __forceinline__ unsigned xb_ld(unsigned* p)              { return __hip_atomic_load(p, __ATOMIC_RELAXED, __HIP_MEMORY_SCOPE_AGENT); }
__device__ __forceinline__ unsigned xb_add(unsigned* p, unsigned v) { return __hip_atomic_fetch_add(p, v, __ATOMIC_RELAXED, __HIP_MEMORY_SCOPE_AGENT); }
__device__ __forceinline__ unsigned xb_xcc_id() { return (unsigned)__builtin_amdgcn_s_getreg((3 << 11) | 20) & 0xFu; }
#define XB_SPIN(cond, bar) do { unsigned _sp = 0; while (cond) { __builtin_amdgcn_s_sleep(1); \
    if ((++_sp & 255u) == 0u) { if (xb_ld(&(bar)[XB_TMO])) break; if (_sp > XB_SPIN_CAP) { atomicAdd(&(bar)[XB_TMO], 1u); break; } } } } while (0)

struct XcdBarrier {
    unsigned* bar; unsigned x;
    volatile LAS unsigned* st;
};

__device__ __forceinline__ XcdBarrier xcd_barrier_post(unsigned* bar, volatile LAS unsigned* st) {
    XcdBarrier b; b.bar = bar; b.x = xb_xcc_id(); b.st = st;
    if (threadIdx.x == 0) (void)xb_add(&bar[XB_XCNT(b.x)], 1u);
    return b;
}
__device__ __forceinline__ void xcd_barrier_complete(unsigned* bar, unsigned x, unsigned& nloc, unsigned& nx) {
    const unsigned G = gridDim.x * gridDim.y * gridDim.z;
    unsigned sum, cnt, mine, sp = 0u;
    for (;;) {
        sum = 0u; cnt = 0u; mine = 0u;
#pragma unroll
        for (unsigned j = 0; j < 16; ++j) { const unsigned c = xb_ld(&bar[XB_XCNT(j)]); sum += c; cnt += (c > 0u) ? 1u : 0u; mine = (j == x) ? c : mine; }
        if (sum == G) break;
        __builtin_amdgcn_s_sleep(1);
        if ((++sp & 255u) == 0u) { if (xb_ld(&bar[XB_TMO])) break; if (sp > XB_SPIN_CAP) { atomicAdd(&bar[XB_TMO], 1u); break; } }
    }
    nloc = mine > 0u ? mine : 1u; nx = cnt > 0u ? cnt : 1u;
}

__device__ __forceinline__ void xcd_barrier(const XcdBarrier& b) {
    asm volatile("s_waitcnt vmcnt(0)" ::: "memory");
    __syncthreads();
    if (threadIdx.x == 0) {
        unsigned* bar = b.bar;
        __builtin_amdgcn_s_waitcnt(0);
        unsigned nloc = b.st[0], nx = b.st[1];
        if (nloc == 0u) { xcd_barrier_complete(bar, b.x, nloc, nx); b.st[0] = nloc; b.st[1] = nx; }
        const unsigned old = xb_add(&bar[XB_XSUB(b.x)], 1u);
        const unsigned gen = old / nloc;
        if (old + 1u == (gen + 1u) * nloc) {
            __builtin_amdgcn_fence(__ATOMIC_RELEASE, "agent");
            asm volatile("s_waitcnt vmcnt(0)" ::: "memory");
            const unsigned og = xb_add(&bar[XB_TOP], 1u);
            const unsigned tg = og / nx;
            if (og + 1u == (tg + 1u) * nx) xb_add(&bar[XB_TOPGEN], 1u);
            else XB_SPIN(xb_ld(&bar[XB_TOPGEN]) == tg, bar);
            __builtin_amdgcn_fence(__ATOMIC_ACQUIRE, "agent");
            xb_add(&bar[XB_XGEN(b.x)], 1u);
            asm volatile("s_waitcnt vmcnt(0)" ::: "memory");
        } else {
            XB_SPIN(xb_ld(&bar[XB_XGEN(b.x)]) == gen, bar);
            __builtin_amdgcn_fence(__ATOMIC_ACQUIRE, "agent");
            asm volatile("s_waitcnt vmcnt(0)" ::: "memory");
        }
    }
    __syncthreads();
}


namespace pg8 {
constexpr int BM = 256, BK = 64, HALF = 128, HTB = HALF * BK * 2, STAGE_BYTES = 8 * HTB, NXCD = 8, WGM = 8;
__host__ __device__ __forceinline__ int lds_byte(int r, int c) { const int st = (r >> 4) * 2 + (c >> 5), rr = r & 15, cc = c & 31, ob = rr * 64 + cc * 2; return st * 1024 + (ob ^ (((ob >> 9) & 1) << 5)); }
__host__ __device__ __forceinline__ void stage_rc(int b, int& R, int& C) { const int st = b / 1024, sb = b % 1024, swz = sb ^ (((sb >> 9) & 1) << 5); R = (st >> 1) * 16 + swz / 64; C = (st & 1) * 32 + (swz % 64) / 2; }
__host__ __device__ __forceinline__ int perm32(int rho) { const int n = rho >> 4, i = rho & 15; return 8 * (i >> 2) + 4 * n + (i & 3); }

struct Unit { const char* A; const char* B; char* C; int row0, col0, aux; };
struct GemmP { int K, lda, ldb; };

__device__ __forceinline__ void xcd_tile(int L, int nM, int nN, int& pm, int& pn) {
    const int nwg = nM * nN; int wgid = L;
    { const int q = nwg / NXCD, r = nwg % NXCD, xcd = wgid % NXCD, off = wgid / NXCD; wgid = (xcd < r ? xcd * (q + 1) : r * (q + 1) + (xcd - r) * q) + off; }
    const int nig = WGM * nN, gid = wgid / nig, fm = gid * WGM, gsz = (nM - fm) < WGM ? (nM - fm) : WGM;
    pm = fm + ((wgid % nig) % gsz); pn = (wgid % nig) / gsz;
}

typedef f32x4 Acc[2][2][4][2];

template <class Epi, class Sched, bool GATHER>
__device__ __forceinline__ void gemm_phase(LAS unsigned char* lds, const GemmP g, const Sched& S, const Epi& E, const int wave_id) {
    const int tid = tid_from_wave(wave_id), wid = __builtin_amdgcn_readfirstlane(tid >> 6), lane = tid & 63, wr = wid >> 2, wc = wid & 3, fr = lane & 15, fq = lane >> 4;
    const int K = g.K, nt = K / BK;
    int Rr[2], Cc[2]; unsigned voffB[2];
#pragma unroll
    for (int i = 0; i < 2; ++i) { int R, C; stage_rc(tid * 16 + i * 8192, R, C); const int Rb = Epi::PERM ? ((R & ~31) + perm32(R & 31)) : R;
        Rr[i] = R; Cc[i] = C; voffB[i] = (unsigned)(Rb * g.ldb + C) * 2u; }
    const size_t kstep = (size_t)(BK * 2);
    const size_t hstepB = (size_t)HALF * g.ldb * 2;
    const unsigned ldsw = (unsigned)wid * 1024u;
    const int aoff = lds_byte(wr * 64 + fr, fq * 8), boff = lds_byte(wc * 32 + fr, fq * 8);
#define PG8_SA(b, h) (((b) * 2 + (h)) * HTB)
#define PG8_SB(b, h) ((4 + (b) * 2 + (h)) * HTB)
#define PG8_STAGE_B(bufoff, gbase) do { _Pragma("unroll") for (int _i = 0; _i < 2; ++_i) \
        __builtin_amdgcn_global_load_lds((const unsigned*)((const char*)(gbase) + voffB[_i]), (LAS unsigned*)(lds + (bufoff) + ldsw + _i * 8192), 16, 0, 0); } while (0)
#define PG8_STAGE_A(bufoff, gbase, OFF, h) do { _Pragma("unroll") for (int _i = 0; _i < 2; ++_i) \
        __builtin_amdgcn_global_load_lds((const unsigned*)((const char*)(gbase) + (OFF)[h][_i]), (LAS unsigned*)(lds + (bufoff) + ldsw + _i * 8192), 16, 0, 0); } while (0)
#define PG8_OFFS(u, OFF) do { _Pragma("unroll") for (int _h = 0; _h < 2; ++_h) _Pragma("unroll") for (int _i = 0; _i < 2; ++_i) { \
        const int _row = _h * HALF + Rr[_i]; const int _src = GATHER ? S.arow((u), _row) : _row; (OFF)[_h][_i] = (unsigned)(_src * g.lda + Cc[_i]) * 2u; } } while (0)
#define PG8_LDA(dst, b, h) do { _Pragma("unroll") for (int m = 0; m < 4; ++m) _Pragma("unroll") for (int k = 0; k < 2; ++k) dst[m][k] = *(const LAS bf16x8*)(lds + PG8_SA(b, h) + aoff + m * 2048 + k * 1024); } while (0)
#define PG8_LDB(dst, b, h) do { _Pragma("unroll") for (int n = 0; n < 2; ++n) _Pragma("unroll") for (int k = 0; k < 2; ++k) dst[n][k] = *(const LAS bf16x8*)(lds + PG8_SB(b, h) + boff + n * 2048 + k * 1024); } while (0)
#define PG8_MMA(ai, bj, At, Bt) do { __builtin_amdgcn_s_setprio(1); _Pragma("unroll") for (int m = 0; m < 4; ++m) _Pragma("unroll") for (int n = 0; n < 2; ++n) _Pragma("unroll") for (int k = 0; k < 2; ++k) \
        acc[ai][bj][m][n] = __builtin_amdgcn_mfma_f32_16x16x32_bf16(Bt[n][k], At[m][k], acc[ai][bj][m][n], 0, 0, 0); __builtin_amdgcn_s_setprio(0); } while (0)
#define PG8_WAIT_V(n) asm volatile("s_waitcnt vmcnt(" #n ")" ::: "memory")
#define PG8_WAIT_L(n) asm volatile("s_waitcnt lgkmcnt(" #n ")" ::: "memory")
#define PG8_BAR __builtin_amdgcn_s_barrier()
#define PG8_SCHED __builtin_amdgcn_sched_barrier(0)
    Unit cur, nxt; int ui = 0;
    if (!S.next(0, cur)) return;
    f32x4 acc[2][2][4][2];
#pragma unroll
    for (int a = 0; a < 2; ++a)
#pragma unroll
        for (int b = 0; b < 2; ++b)
#pragma unroll
            for (int m = 0; m < 4; ++m)
#pragma unroll
                for (int n = 0; n < 2; ++n) acc[a][b][m][n] = (f32x4){0.f, 0.f, 0.f, 0.f};
    bf16x8 At[4][2], B0[2][2], B1[2][2];
    const char* cA = cur.A; const char* cB = cur.B;
    unsigned coffA[2][2], noffA[2][2];
    PG8_OFFS(cur, coffA);
    PG8_STAGE_B(PG8_SB(0, 0), cB); PG8_STAGE_A(PG8_SA(0, 0), cA, coffA, 0); PG8_STAGE_B(PG8_SB(0, 1), cB + hstepB); PG8_STAGE_A(PG8_SA(0, 1), cA, coffA, 1);
    if (wr == 1) PG8_BAR;
    PG8_WAIT_V(4); PG8_BAR;
    PG8_STAGE_B(PG8_SB(1, 0), cB + kstep); PG8_STAGE_A(PG8_SA(1, 0), cA + kstep, coffA, 0); PG8_STAGE_B(PG8_SB(1, 1), cB + hstepB + kstep);
    PG8_WAIT_V(6); PG8_BAR;
    for (;;) {
        const bool has_next = S.next(ui + 1, nxt);
        const char* nA = has_next ? nxt.A : cA; const char* nB = has_next ? nxt.B : cB;
        if (has_next) { PG8_OFFS(nxt, noffA); }
        else {
#pragma unroll
            for (int _h = 0; _h < 2; ++_h)
#pragma unroll
                for (int _i = 0; _i < 2; ++_i) noffA[_h][_i] = coffA[_h][_i]; }
        for (int t = 0; t < nt; t += 2) {
            const bool last = (t == nt - 2);
            const char* a1 = cA + (size_t)(t + 1) * kstep;
            const char* a2 = last ? nA : cA + (size_t)(t + 2) * kstep; const char* b2 = last ? nB : cB + (size_t)(t + 2) * kstep;
            const char* a3 = a2 + kstep; const char* b3 = b2 + kstep;
            unsigned o2[2][2];
#pragma unroll
            for (int _h = 0; _h < 2; ++_h)
#pragma unroll
                for (int _i = 0; _i < 2; ++_i) o2[_h][_i] = last ? noffA[_h][_i] : coffA[_h][_i];
            PG8_LDB(B0, 0, 0); PG8_SCHED; PG8_LDA(At, 0, 0); PG8_STAGE_A(PG8_SA(1, 1), a1, coffA, 1);
            PG8_WAIT_L(8); PG8_BAR; PG8_WAIT_L(0); PG8_MMA(0, 0, At, B0); PG8_BAR; PG8_SCHED;
            PG8_LDB(B1, 0, 1); PG8_STAGE_B(PG8_SB(0, 0), b2);
            PG8_BAR; PG8_WAIT_L(0); PG8_MMA(0, 1, At, B1); PG8_BAR;
            PG8_LDA(At, 0, 1); PG8_STAGE_A(PG8_SA(0, 0), a2, o2, 0);
            PG8_BAR; PG8_WAIT_L(0); PG8_MMA(1, 0, At, B0); PG8_BAR; PG8_SCHED;
            PG8_STAGE_B(PG8_SB(0, 1), b2 + hstepB);
            PG8_WAIT_V(6); PG8_BAR; PG8_MMA(1, 1, At, B1); PG8_BAR;
            PG8_LDB(B0, 1, 0); PG8_SCHED; PG8_LDA(At, 1, 0); PG8_STAGE_A(PG8_SA(0, 1), a2, o2, 1);
            PG8_WAIT_L(8); PG8_BAR; PG8_WAIT_L(0); PG8_MMA(0, 0, At, B0); PG8_BAR; PG8_SCHED;
            PG8_LDB(B1, 1, 1); PG8_STAGE_B(PG8_SB(1, 0), b3);
            PG8_BAR; PG8_WAIT_L(0); PG8_MMA(0, 1, At, B1); PG8_BAR;
            PG8_LDA(At, 1, 1); PG8_STAGE_A(PG8_SA(1, 0), a3, o2, 0);
            PG8_BAR; PG8_WAIT_L(0); PG8_MMA(1, 0, At, B0); PG8_BAR; PG8_SCHED;
            PG8_STAGE_B(PG8_SB(1, 1), b3 + hstepB);
            PG8_WAIT_V(6); PG8_BAR; PG8_MMA(1, 1, At, B1); PG8_BAR;
        }
        if constexpr (!Epi::AFTER_DRAIN) { E(acc, cur, wr, wc, fr, fq); }
        if (!has_next) break;
#pragma unroll
        for (int a = 0; a < 2; ++a)
#pragma unroll
            for (int b = 0; b < 2; ++b)
#pragma unroll
                for (int m = 0; m < 4; ++m)
#pragma unroll
                    for (int n = 0; n < 2; ++n) acc[a][b][m][n] = (f32x4){0.f, 0.f, 0.f, 0.f};
        cur = nxt; cA = nA; cB = nB; ++ui;
#pragma unroll
        for (int _h = 0; _h < 2; ++_h)
#pragma unroll
            for (int _i = 0; _i < 2; ++_i) coffA[_h][_i] = noffA[_h][_i];
    }
    PG8_WAIT_V(0);
    if (wr == 0) PG8_BAR;
    PG8_BAR;
    if constexpr (Epi::AFTER_DRAIN) { E.fused(acc, cur, wr, wc, fr, fq, lds, wid, lane); }
#undef PG8_SA
#undef PG8_SB
#undef PG8_STAGE_A
#undef PG8_STAGE_B
#undef PG8_OFFS
#undef PG8_LDA
#undef PG8_LDB
#undef PG8_MMA
#undef PG8_WAIT_V
#undef PG8_WAIT_L
#undef PG8_BAR
#undef PG8_SCHED
}

struct EpiBf16 {
    static constexpr bool PERM = true, AFTER_DRAIN = false;
    int ldc;
    __device__ __forceinline__ void operator()(const Acc& acc, const Unit& u, int wr, int wc, int fr, int fq) const {
        bf16* base = (bf16*)u.C + (size_t)(wr * 64 + fr) * ldc + wc * 32 + 8 * fq;
#pragma unroll
        for (int ai = 0; ai < 2; ++ai)
#pragma unroll
            for (int m = 0; m < 4; ++m) { bf16* rowp = base + (size_t)(ai * HALF + m * 16) * ldc;
#pragma unroll
                for (int bj = 0; bj < 2; ++bj) { const f32x4 v0 = acc[ai][bj][m][0], v1 = acc[ai][bj][m][1];
                    u32x4 w; w.x = pk2(v0[0], v0[1]); w.y = pk2(v0[2], v0[3]); w.z = pk2(v1[0], v1[1]); w.w = pk2(v1[2], v1[3]);
                    *(u32x4*)(rowp + bj * HALF) = w; } }
    }
};
struct EpiF32Res {
    static constexpr bool PERM = false, AFTER_DRAIN = false;
    int ldc; const float* resid; float* out;
    __device__ __forceinline__ void operator()(const Acc& acc, const Unit& u, int wr, int wc, int fr, int fq) const {
        const size_t o0 = (size_t)(u.row0 + wr * 64 + fr) * ldc + u.col0 + wc * 32 + 4 * fq;
#pragma unroll
        for (int ai = 0; ai < 2; ++ai)
#pragma unroll
            for (int m = 0; m < 4; ++m) { const size_t ro = o0 + (size_t)(ai * HALF + m * 16) * ldc;
#pragma unroll
                for (int bj = 0; bj < 2; ++bj)
#pragma unroll
                    for (int n = 0; n < 2; ++n) { const size_t o = ro + bj * HALF + n * 16; const f32x4 b = *(const f32x4*)(resid + o); *(f32x4*)(out + o) = acc[ai][bj][m][n] + b; } }
    }
};
struct EpiSwiGlu {
    static constexpr bool PERM = true, AFTER_DRAIN = false;
    int ldc;
    __device__ __forceinline__ void operator()(const Acc& acc, const Unit& u, int wr, int wc, int fr, int fq) const {
        bf16* base = (bf16*)u.C + (size_t)(wr * 64 + fr) * ldc + wc * 32 + 8 * fq;
#pragma unroll
        for (int ai = 0; ai < 2; ++ai)
#pragma unroll
            for (int m = 0; m < 4; ++m) { bf16* rowp = base + (size_t)(ai * HALF + m * 16) * ldc;
                float h[8];
#pragma unroll
                for (int n = 0; n < 2; ++n)
#pragma unroll
                    for (int e = 0; e < 4; ++e) { const float a = acc[ai][0][m][n][e], b = acc[ai][1][m][n][e]; h[n * 4 + e] = a / (1.f + __expf(-a)) * b; }
                u32x4 w; w.x = pk2(h[0], h[1]); w.y = pk2(h[2], h[3]); w.z = pk2(h[4], h[5]); w.w = pk2(h[6], h[7]);
                *(u32x4*)rowp = w; }
    }
};
struct EpiGate {
    static constexpr bool PERM = true, AFTER_DRAIN = false;
    int ldc; const float* egate; const int* cnt_lds_unused;
    __device__ __forceinline__ void operator()(const Acc& acc, const Unit& u, int wr, int wc, int fr, int fq) const {
        bf16* base = (bf16*)u.C + (size_t)(wr * 64 + fr) * ldc + wc * 32 + 8 * fq;
        const int e = u.aux >> 16, nvalid = u.aux & 0xffff;
        const float* gp = egate + (size_t)e * ECAP + u.row0;
#pragma unroll
        for (int ai = 0; ai < 2; ++ai)
#pragma unroll
            for (int m = 0; m < 4; ++m) { const int r = ai * HALF + wr * 64 + m * 16 + fr; const float gt = (r < nvalid) ? gp[r] : 0.f;
                bf16* rowp = base + (size_t)(ai * HALF + m * 16) * ldc;
#pragma unroll
                for (int bj = 0; bj < 2; ++bj) { const f32x4 v0 = acc[ai][bj][m][0] * gt, v1 = acc[ai][bj][m][1] * gt;
                    u32x4 w; w.x = pk2(v0[0], v0[1]); w.y = pk2(v0[2], v0[3]); w.z = pk2(v1[0], v1[1]); w.w = pk2(v1[2], v1[3]);
                    *(u32x4*)(rowp + bj * HALF) = w; } }
    }
};
struct EpiSoftmax {
    static constexpr bool PERM = true, AFTER_DRAIN = true;
    int ldc; float scale_log2e;
    __device__ __forceinline__ void operator()(const Acc&, const Unit&, int, int, int, int) const {}
    __device__ __forceinline__ void fused(const Acc& acc, const Unit& u, int wr, int wc, int fr, int fq, LAS unsigned char* lds, int wid, int lane) const {
        LAS float* RM = (LAS float*)lds;
        LAS float* RS = (LAS float*)(lds + 4096);
        float mx[2][4];
#pragma unroll
        for (int ai = 0; ai < 2; ++ai)
#pragma unroll
            for (int m = 0; m < 4; ++m) { float v = -3.0e38f;
#pragma unroll
                for (int bj = 0; bj < 2; ++bj)
#pragma unroll
                    for (int n = 0; n < 2; ++n) { const f32x4 x = acc[ai][bj][m][n]; v = fmaxf(v, fmaxf(fmaxf(x[0], x[1]), fmaxf(x[2], x[3]))); }
                v = fmaxf(v, xor_lane(v, lane, 16)); v = fmaxf(v, xor_lane(v, lane, 32));
                if (fq == 0) RM[(ai * HALF + wr * 64 + m * 16 + fr) * 4 + wc] = v; }
        asm volatile("s_waitcnt lgkmcnt(0)" ::: "memory"); __builtin_amdgcn_s_barrier(); asm volatile("" ::: "memory");
#pragma unroll
        for (int ai = 0; ai < 2; ++ai)
#pragma unroll
            for (int m = 0; m < 4; ++m) { const int row = ai * HALF + wr * 64 + m * 16 + fr; const f32x4 q = *(const LAS f32x4*)(RM + row * 4);
                const float M = fmaxf(fmaxf(q[0], q[1]), fmaxf(q[2], q[3])); const float mc = -M * scale_log2e; float s = 0.f;
#pragma unroll
                for (int bj = 0; bj < 2; ++bj)
#pragma unroll
                    for (int n = 0; n < 2; ++n)
#pragma unroll
                        for (int e = 0; e < 4; ++e) s += __builtin_amdgcn_exp2f(fmaf(acc[ai][bj][m][n][e], scale_log2e, mc));
                s += xor_lane(s, lane, 16); s += xor_lane(s, lane, 32);
                if (fq == 0) RS[row * 4 + wc] = s; }
        asm volatile("s_waitcnt lgkmcnt(0)" ::: "memory"); __builtin_amdgcn_s_barrier(); asm volatile("" ::: "memory");
        bf16* base = (bf16*)u.C + (size_t)(wr * 64 + fr) * ldc + wc * 32 + 8 * fq;
#pragma unroll
        for (int ai = 0; ai < 2; ++ai)
#pragma unroll
            for (int m = 0; m < 4; ++m) { const int row = ai * HALF + wr * 64 + m * 16 + fr; const f32x4 q = *(const LAS f32x4*)(RS + row * 4); const f32x4 qm = *(const LAS f32x4*)(RM + row * 4);
                const float M = fmaxf(fmaxf(qm[0], qm[1]), fmaxf(qm[2], qm[3])); const float mc = -M * scale_log2e;
                const float inv = 1.f / ((q[0] + q[1]) + (q[2] + q[3])); bf16* rowp = base + (size_t)(ai * HALF + m * 16) * ldc;
#pragma unroll
                for (int bj = 0; bj < 2; ++bj) { float pp[8];
#pragma unroll
                    for (int n = 0; n < 2; ++n)
#pragma unroll
                        for (int e = 0; e < 4; ++e) pp[n * 4 + e] = __builtin_amdgcn_exp2f(fmaf(acc[ai][bj][m][n][e], scale_log2e, mc)) * inv;
                    u32x4 w; w.x = pk2(pp[0], pp[1]); w.y = pk2(pp[2], pp[3]); w.z = pk2(pp[4], pp[5]); w.w = pk2(pp[6], pp[7]);
                    *(u32x4*)(rowp + bj * HALF) = w; } }
        asm volatile("s_waitcnt lgkmcnt(0)" ::: "memory"); __builtin_amdgcn_s_barrier(); asm volatile("" ::: "memory");
    }
};
}

namespace att {
constexpr int KVBLK = 64;
constexpr size_t SHM_V = KVBLK * 128 * 2, SHM_K = KVBLK * 128 * 2;
#define KSWZ(row, colB) ((row) * 256 + ((colB) ^ (((row) & 7) << 4)))
#define SBAR() __builtin_amdgcn_sched_barrier(0)
__device__ __forceinline__ int crow(int r, int hi) { return (r & 3) + 8 * (r >> 2) + 4 * hi; }
__device__ __forceinline__ bf16x8 ld8(const bf16* p) { return *reinterpret_cast<const bf16x8*>(p); }

__device__ __forceinline__ void partialSM(f32x16& p0, f32x16& p1, float& m_reg, float& mn, float& alpha, const float SCALE, const float THR) {
  const float C = SCALE * 1.4426950408889634f;
  float pmax = p0[0];
#pragma unroll
  for (int r = 1; r < 16; ++r) pmax = fmaxf(pmax, p0[r]);
#pragma unroll
  for (int r = 0; r < 16; ++r) pmax = fmaxf(pmax, p1[r]);
  { auto rr = __builtin_amdgcn_permlane32_swap(__float_as_uint(pmax), __float_as_uint(pmax), false, false);
    pmax = fmaxf(__uint_as_float(rr[0]), __uint_as_float(rr[1])); }
  if (__builtin_expect(__all(pmax - m_reg <= THR / SCALE), 1)) { mn = m_reg; alpha = 1.f; }
  else { mn = fmaxf(m_reg, pmax); alpha = __builtin_amdgcn_exp2f((m_reg - mn) * C); m_reg = mn; }
  const float mnC = -mn * C;
#pragma unroll
  for (int r = 0; r < 16; ++r) p0[r] = fmaf(p0[r], C, mnC);
#pragma unroll
  for (int r = 0; r < 16; ++r) p1[r] = fmaf(p1[r], C, mnC);
#pragma unroll
  for (int r = 0; r < 16; ++r) p0[r] = __builtin_amdgcn_exp2f(p0[r]);
}
__device__ __forceinline__ void finishSM(f32x16& p0, f32x16& p1, float alpha, float& l_reg, bf16x8& pa0, bf16x8& pa1, bf16x8& pa2, bf16x8& pa3) {
#pragma unroll
  for (int r = 0; r < 16; ++r) p1[r] = __builtin_amdgcn_exp2f(p1[r]);
  float ps = 0;
#pragma unroll
  for (int r = 0; r < 16; ++r) ps += p0[r];
#pragma unroll
  for (int r = 0; r < 16; ++r) ps += p1[r];
  { auto rr = __builtin_amdgcn_permlane32_swap(__float_as_uint(ps), __float_as_uint(ps), false, false);
    ps = __uint_as_float(rr[0]) + __uint_as_float(rr[1]); }
  l_reg = l_reg * alpha + ps;
#define PK4(P, BASE, OUT) do { unsigned a0 = pk2(P[BASE + 0], P[BASE + 1]), a1 = pk2(P[BASE + 2], P[BASE + 3]);   \
    unsigned b0 = pk2(P[BASE + 4], P[BASE + 5]), b1 = pk2(P[BASE + 6], P[BASE + 7]);                              \
    auto r0 = __builtin_amdgcn_permlane32_swap(a0, b0, false, false); auto r1 = __builtin_amdgcn_permlane32_swap(a1, b1, false, false); \
    u32x4 w = {r0[0], r1[0], r0[1], r1[1]}; OUT = *reinterpret_cast<bf16x8*>(&w); } while (0)
  PK4(p0, 0, pa0); PK4(p0, 8, pa1); PK4(p1, 0, pa2); PK4(p1, 8, pa3);
#undef PK4
}
template <int ND0> __device__ __forceinline__ void qkt(f32x16& p0, f32x16& p1, const char* Ks, const bf16x8* qr, int r32, int hi, int c0) {
  p0 = f32x16{}; p1 = f32x16{};
#pragma unroll
  for (int d0 = 0; d0 < ND0; ++d0) { const int cb = (c0 + d0 * 16 + hi * 8) * 2;
    const bf16x8 b0 = *reinterpret_cast<const bf16x8*>(Ks + KSWZ(r32, cb));
    const bf16x8 b1 = *reinterpret_cast<const bf16x8*>(Ks + KSWZ(32 + r32, cb));
    p0 = __builtin_amdgcn_mfma_f32_32x32x16_bf16(b0, qr[d0], p0, 0, 0, 0);
    p1 = __builtin_amdgcn_mfma_f32_32x32x16_bf16(b1, qr[d0], p1, 0, 0, 0); }
}
__device__ __forceinline__ int v_st(int k, int c) { const int kk = (k & ~0xC) | ((k & 4) << 1) | ((k & 8) >> 1); return ((kk >> 3) * 4 + (c >> 5)) * 512 + ((kk & 7) * 32 + (c & 31)) * 2; }
__device__ __forceinline__ int v_rd_base(int lane) { return ((lane & 3) << 3) | (((lane >> 2) & 3) << 6) | (((lane >> 4) & 1) << 5) | (((lane >> 5) & 1) << 8); }
constexpr int v_rd_off(int d0, int ks, int half) { return d0 * 512 + ks * 4096 + half * 2048; }
template <int OFF> __device__ __forceinline__ s16x4 tr_read(int vb) {
  s16x4 r; asm volatile("ds_read_b64_tr_b16 %0, %1 offset:%2" : "=&v"(r) : "v"(vb), "i"(OFF) : "memory"); return r;
}
template <int D0> __device__ __forceinline__ void pv_one(f32x16& od, int vb, bf16x8 pa0, bf16x8 pa1, bf16x8 pa2, bf16x8 pa3) {
  const s16x4 l0 = tr_read<v_rd_off(D0, 0, 0)>(vb), h0 = tr_read<v_rd_off(D0, 0, 1)>(vb), l1 = tr_read<v_rd_off(D0, 1, 0)>(vb), h1 = tr_read<v_rd_off(D0, 1, 1)>(vb);
  const s16x4 l2 = tr_read<v_rd_off(D0, 2, 0)>(vb), h2 = tr_read<v_rd_off(D0, 2, 1)>(vb), l3 = tr_read<v_rd_off(D0, 3, 0)>(vb), h3 = tr_read<v_rd_off(D0, 3, 1)>(vb);
  asm volatile("s_waitcnt lgkmcnt(0)" ::: "memory"); SBAR();
#define PK(L, H) (bf16x8){L[0], L[1], L[2], L[3], H[0], H[1], H[2], H[3]}
  od = __builtin_amdgcn_mfma_f32_32x32x16_bf16(pa0, PK(l0, h0), od, 0, 0, 0);
  od = __builtin_amdgcn_mfma_f32_32x32x16_bf16(pa1, PK(l1, h1), od, 0, 0, 0);
  od = __builtin_amdgcn_mfma_f32_32x32x16_bf16(pa2, PK(l2, h2), od, 0, 0, 0);
  od = __builtin_amdgcn_mfma_f32_32x32x16_bf16(pa3, PK(l3, h3), od, 0, 0, 0);
#undef PK
}
__device__ __forceinline__ void pv_d0(f32x16* o, int vb, bf16x8 pa0, bf16x8 pa1, bf16x8 pa2, bf16x8 pa3) {
  pv_one<0>(o[0], vb, pa0, pa1, pa2, pa3); pv_one<1>(o[1], vb, pa0, pa1, pa2, pa3); pv_one<2>(o[2], vb, pa0, pa1, pa2, pa3); pv_one<3>(o[3], vb, pa0, pa1, pa2, pa3);
}

__device__ __forceinline__ void diff_attn_unit(const bf16* Qb, const bf16* Kh, const bf16* Vh, int ld, int seq, bf16* outb, int ldo,
                                               const float lam, const float post_scale, const float* subln_g, char* lds, const int wave_id) {
  constexpr float SCALE = 0.125f, THR = 8.f;
  const int tid = tid_from_wave(wave_id), wid = __builtin_amdgcn_readfirstlane(tid >> 6), lane = tid & 63, r32 = lane & 31, hi = lane >> 5;
  const int csel = wid >> 2, wq = wid & 3;
  char* V_lds = lds; char* K_lds = lds + 2 * SHM_V;
  float* ws = (float*)(lds + 2 * SHM_V + 2 * SHM_K) + wid * 64; float* li_l = ws; float* al_l = ws + 32;
  float m_reg = -1e30f, l_reg = 0; f32x16 o[4] = {}; bf16x8 qr[4];
  const bf16* Qw = Qb + (long)(wq * 32 + r32) * ld + csel * 64 + hi * 8;
#pragma unroll
  for (int d0 = 0; d0 < 4; ++d0) qr[d0] = ld8(Qw + d0 * 16);
  const int sr = tid >> 4, sc = (tid & 15) * 8, vst0 = v_st(sr, sc), vst1 = v_st(32 + sr, sc);
  const int vb0 = (int)(uintptr_t)V_lds + v_rd_base(lane);
  const int kc0 = csel * 64;
  struct { bf16x8 vs0, vs1, ks0, ks1; } sr_[2];
#define SLOAD(i, k0) do { sr_[i].vs0 = ld8(&Vh[(long)((k0) + sr) * ld + sc]); sr_[i].vs1 = ld8(&Vh[(long)((k0) + 32 + sr) * ld + sc]); \
    sr_[i].ks0 = ld8(&Kh[(long)((k0) + sr) * ld + sc]); sr_[i].ks1 = ld8(&Kh[(long)((k0) + 32 + sr) * ld + sc]); } while (0)
#define SWRITE(b, i) do { *(bf16x8*)(V_lds + (b) * SHM_V + vst0) = sr_[i].vs0;          \
    *(bf16x8*)(V_lds + (b) * SHM_V + vst1) = sr_[i].vs1; const int kc = sc * 2;               \
    *(bf16x8*)(K_lds + (b) * SHM_K + KSWZ(sr, kc)) = sr_[i].ks0;                       \
    *(bf16x8*)(K_lds + (b) * SHM_K + KSWZ(32 + sr, kc)) = sr_[i].ks1; } while (0)
#define SWAIT() asm volatile("s_waitcnt vmcnt(4)" ::: "memory")
#define RESC(a) do { if (__any((a) < 1.f)) { if (hi == 0) al_l[r32] = (a); asm volatile("s_waitcnt lgkmcnt(0)" ::: "memory"); \
    _Pragma("unroll") for (int d = 0; d < 4; ++d) _Pragma("unroll") for (int r = 0; r < 16; ++r) o[d][r] *= al_l[crow(r, hi)]; } } while (0)
  f32x16 pA0, pA1, pB0, pB1; float mnA, mnB, alA, alB; bf16x8 pa0, pa1, pa2, pa3; const int NT = seq / KVBLK;
  constexpr int SE = 0, SO = 1;
  __syncthreads();
  SLOAD(SE, 0); asm volatile("s_waitcnt vmcnt(0)" ::: "memory"); SWRITE(0, SE); __syncthreads();
  qkt<4>(pA0, pA1, K_lds, qr, r32, hi, kc0); partialSM(pA0, pA1, m_reg, mnA, alA, SCALE, THR);
  SLOAD(SO, KVBLK); if (2 < NT) SLOAD(SE, 2 * KVBLK);
  SWAIT(); SWRITE(1, SO); __syncthreads();
  for (int j = 1; j + 1 < NT; j += 2) {
    SBAR(); qkt<4>(pB0, pB1, K_lds + SHM_K, qr, r32, hi, kc0);
    finishSM(pA0, pA1, alA, l_reg, pa0, pa1, pa2, pa3); SBAR();
    SLOAD(SO, (j + 2) * KVBLK); SBAR();
    pv_d0(o, vb0, pa0, pa1, pa2, pa3); partialSM(pB0, pB1, m_reg, mnB, alB, SCALE, THR);
    __syncthreads(); SWAIT(); SWRITE(0, SE);
    RESC(alB); __syncthreads();
    SBAR(); qkt<4>(pA0, pA1, K_lds, qr, r32, hi, kc0);
    finishSM(pB0, pB1, alB, l_reg, pa0, pa1, pa2, pa3); SBAR();
    if (j + 3 < NT) SLOAD(SE, (j + 3) * KVBLK); SBAR();
    pv_d0(o, vb0 + (int)SHM_V, pa0, pa1, pa2, pa3); partialSM(pA0, pA1, m_reg, mnA, alA, SCALE, THR);
    __syncthreads(); SWAIT(); SWRITE(1, SO);
    RESC(alA); __syncthreads();
  }
  SBAR(); qkt<4>(pB0, pB1, K_lds + SHM_K, qr, r32, hi, kc0);
  finishSM(pA0, pA1, alA, l_reg, pa0, pa1, pa2, pa3); SBAR();
  pv_d0(o, vb0, pa0, pa1, pa2, pa3); partialSM(pB0, pB1, m_reg, mnB, alB, SCALE, THR);
  __syncthreads(); RESC(alB);
  finishSM(pB0, pB1, alB, l_reg, pa0, pa1, pa2, pa3); SBAR();
  pv_d0(o, vb0 + (int)SHM_V, pa0, pa1, pa2, pa3);
  asm volatile("s_waitcnt vmcnt(0)" ::: "memory");
  if (hi == 0) li_l[r32] = l_reg; asm volatile("s_waitcnt lgkmcnt(0)" ::: "memory");
  float rli[16];
#pragma unroll
  for (int r = 0; r < 16; ++r) rli[r] = __builtin_amdgcn_rcpf(li_l[crow(r, hi)]);
  __syncthreads();
  float* X = (float*)lds + (size_t)wq * 4096;
  if (csel == 1) {
#pragma unroll
    for (int d0 = 0; d0 < 4; ++d0)
#pragma unroll
      for (int r = 0; r < 16; ++r) X[(d0 * 16 + r) * 64 + lane] = o[d0][r] * rli[r];
  }
  __syncthreads();
  if (csel == 0) {
    float ss[16];
#pragma unroll
    for (int r = 0; r < 16; ++r) ss[r] = 0.f;
#pragma unroll
    for (int d0 = 0; d0 < 4; ++d0)
#pragma unroll
      for (int r = 0; r < 16; ++r) { const float v = o[d0][r] * rli[r] - lam * X[(d0 * 16 + r) * 64 + lane]; o[d0][r] = v; ss[r] += v * v; }
#pragma unroll
    for (int r = 0; r < 16; ++r) { float s = ss[r];
      s = row_sum(s); s += xor_lane(s, lane, 16);
      ss[r] = __builtin_amdgcn_rsqf(s * (1.f / 128.f) + RMS_EPS) * post_scale; }
    float gg[4];
#pragma unroll
    for (int d0 = 0; d0 < 4; ++d0) gg[d0] = subln_g[d0 * 32 + r32];
    bf16* Ow = outb + (long)(wq * 32) * ldo;
#pragma unroll
    for (int r = 0; r < 16; ++r) { const int orow = crow(r, hi);
#pragma unroll
      for (int d0 = 0; d0 < 4; ++d0) Ow[(long)orow * ldo + d0 * 32 + r32] = f2bf(o[d0][r] * ss[r] * gg[d0]); }
  }
#undef SLOAD
#undef SWRITE
#undef SWAIT
}

__device__ __forceinline__ void dil_attn_unit(const bf16* Qh, const bf16* Kh, const bf16* Vh, int ld, int dil, int rho, int u0, int L,
                                              float* Oc, float* lsep, char* lds, const int wave_id) {
  constexpr float SCALE = 0.08838834764831845f; constexpr float C = SCALE * 1.4426950408889634f;
  const int tid = tid_from_wave(wave_id), wid = __builtin_amdgcn_readfirstlane(tid >> 6), lane = tid & 63, r32 = lane & 31, hi = lane >> 5;
  char* V_lds = lds; char* K_lds = lds + 2 * SHM_V;
  float* ws = (float*)(lds + 2 * SHM_V + 2 * SHM_K) + wid * 64; float* li_l = ws; float* al_l = ws + 32;
  float m_reg = -1e30f, l_reg = 0; f32x16 o[4] = {}; bf16x8 qr[8];
  const int uq = u0 + wid * 32 + r32;
  const bf16* Qw = Qh + (long)(rho + dil * uq) * ld + hi * 8;
#pragma unroll
  for (int d0 = 0; d0 < 8; ++d0) qr[d0] = ld8(Qw + d0 * 16);
  const int sr = tid >> 4, sc = (tid & 15) * 8, vst0 = v_st(sr, sc), vst1 = v_st(32 + sr, sc);
  const int vb0 = (int)(uintptr_t)V_lds + v_rd_base(lane);
  const int tlo = wid >> 1;
  for (int t = 0; t < 6; ++t) {
    const int kt0 = u0 - 64 + 64 * t;
    __syncthreads();
    { int ua = kt0 + sr, ub = kt0 + 32 + sr; ua = ua < 0 ? 0 : (ua >= L ? L - 1 : ua); ub = ub < 0 ? 0 : (ub >= L ? L - 1 : ub);
      const long ra = (long)(rho + dil * ua) * ld + sc, rb = (long)(rho + dil * ub) * ld + sc;
      const bf16x8 va = ld8(Vh + ra), vb = ld8(Vh + rb), ka = ld8(Kh + ra), kb = ld8(Kh + rb);
      *(bf16x8*)(V_lds + vst0) = va; *(bf16x8*)(V_lds + vst1) = vb; const int kc = sc * 2;
      *(bf16x8*)(K_lds + KSWZ(sr, kc)) = ka; *(bf16x8*)(K_lds + KSWZ(32 + sr, kc)) = kb; }
    __syncthreads();
    if (t >= tlo && t <= tlo + 2) {
      f32x16 p0, p1;
      qkt<8>(p0, p1, K_lds, qr, r32, hi, 0);
#pragma unroll
      for (int r = 0; r < 16; ++r) { const int uk0 = kt0 + crow(r, hi), uk1 = uk0 + 32; const int d0 = uk0 - uq, d1 = uk1 - uq;
        const bool ok0 = (uk0 >= 0) && (uk0 < L) && (d0 >= -64) && (d0 <= 64), ok1 = (uk1 >= 0) && (uk1 < L) && (d1 >= -64) && (d1 <= 64);
        p0[r] = ok0 ? p0[r] : -1e30f; p1[r] = ok1 ? p1[r] : -1e30f; }
      float pmax = p0[0];
#pragma unroll
      for (int r = 1; r < 16; ++r) pmax = fmaxf(pmax, p0[r]);
#pragma unroll
      for (int r = 0; r < 16; ++r) pmax = fmaxf(pmax, p1[r]);
      { auto rr = __builtin_amdgcn_permlane32_swap(__float_as_uint(pmax), __float_as_uint(pmax), false, false);
        pmax = fmaxf(__uint_as_float(rr[0]), __uint_as_float(rr[1])); }
      const float mn = fmaxf(m_reg, pmax); const float alpha = __builtin_amdgcn_exp2f((m_reg - mn) * C); m_reg = mn;
      const float mnC = -mn * C;
#pragma unroll
      for (int r = 0; r < 16; ++r) { p0[r] = __builtin_amdgcn_exp2f(fmaf(p0[r], C, mnC)); p1[r] = fmaf(p1[r], C, mnC); }
      bf16x8 pa0, pa1, pa2, pa3;
      finishSM(p0, p1, alpha, l_reg, pa0, pa1, pa2, pa3);
      RESC(alpha);
      pv_d0(o, vb0, pa0, pa1, pa2, pa3);
    }
  }
  if (hi == 0) li_l[r32] = l_reg; asm volatile("s_waitcnt lgkmcnt(0)" ::: "memory");
  float rli[16];
#pragma unroll
  for (int r = 0; r < 16; ++r) rli[r] = __builtin_amdgcn_rcpf(li_l[crow(r, hi)]);
#pragma unroll
  for (int r = 0; r < 16; ++r) { const int uo = u0 + wid * 32 + crow(r, hi); float* orow = Oc + (long)(rho + dil * uo) * 512;
#pragma unroll
    for (int d0 = 0; d0 < 4; ++d0) orow[d0 * 32 + r32] = o[d0][r] * rli[r]; }
  if (hi == 0) lsep[(long)(rho + dil * uq) * 4] = m_reg * SCALE + __logf(l_reg);
}
#undef RESC
#undef KSWZ
#undef SBAR
}

struct Args { const float* in[N_INPUTS]; float* out; unsigned char* ws; int ph_lo, ph_hi; };
typedef const __attribute__((address_space(4))) Args* ArgsP;
struct Frame {
    LAS unsigned char* lds; volatile LAS unsigned* MISC; unsigned* ctl; unsigned char* ws;
    int tid, lane, wave, G, bid;
};
constexpr int PH_P0 = 0, PH_P1 = 1, PH_P2 = 2, PH_L0 = 3, NPH_L = 13, PH_FINAL = PH_L0 + DEPTH * NPH_L, NPHASES = PH_FINAL + 1;
enum { LP_NORM1 = 0, LP_G1, LP_PREP, LP_CPREP, LP_MIX, LP_POST, LP_G2, LP_NORM2, LP_GS, LP_GO, LP_NORM3, LP_M1, LP_M2 };

__device__ __forceinline__ int q_next(Frame& F, int q) {
    __syncthreads();
    if (F.tid == 0) F.MISC[0] = __hip_atomic_fetch_add(F.ctl + CW_Q + 64 * q, 1u, __ATOMIC_RELAXED, __HIP_MEMORY_SCOPE_AGENT);
    __syncthreads();
    return (int)F.MISC[0];
}

template <class RowMap>
__device__ __forceinline__ void transpose_item(const float* W, int ldn, bf16* WT, int ldt, RowMap rm, LAS float* scr, int k0, int n0, int lane) {
#pragma unroll 8
    for (int i = 0; i < 32; ++i) { const int kk = 2 * i + (lane >> 5); scr[kk * 33 + (lane & 31)] = W[(size_t)(k0 + kk) * ldn + n0 + (lane & 31)]; }
    LDS_WAIT(); asm volatile("" ::: "memory");
    const int c = lane & 7;
#pragma unroll
    for (int j = 0; j < 4; ++j) { const int n = (lane >> 3) + 8 * j; const LAS float* s = scr + (8 * c) * 33 + n;
        u32x4 o; o.x = pk2(s[0 * 33], s[1 * 33]); o.y = pk2(s[2 * 33], s[3 * 33]); o.z = pk2(s[4 * 33], s[5 * 33]); o.w = pk2(s[6 * 33], s[7 * 33]);
        *(u32x4*)(WT + (size_t)rm(n0 + n) * ldt + k0 + 8 * c) = o; }
    LDS_WAIT(); asm volatile("" ::: "memory");
}
struct RmId { __device__ __forceinline__ int operator()(int n) const { return n; } };
struct RmW13 { int off; __device__ __forceinline__ int operator()(int n) const { return 256 * (n >> 7) + off + (n & 127); } };

__device__ __forceinline__ void p0_prologue(Frame& F, ArgsP a) {
    unsigned char* ws = F.ws;
    LAS float* scr = (LAS float*)(F.lds + F.wave * 16384);
    const int gw = F.bid * 8 + F.wave, NGW = F.G * 8;
    constexpr int I_WIN = (DM / 64) * (IN_TOTAL / 32), I_SQ = (DM / 64) * (DM / 32), I_WKV = (DM / 64) * (4096 / 32), I_W1 = (DM / 64) * (DEXP / 32), I_W2 = (DEXP / 64) * (DM / 32);
    constexpr int PER_L = I_WIN + I_SQ + I_WKV + I_SQ + NEXP * (2 * I_W1 + I_W2);
    for (int it = gw; it < DEPTH * PER_L; it += NGW) {
        const int l = it / PER_L; int r = it % PER_L;
        if (r < I_WIN) { const int nb = IN_TOTAL / 32; transpose_item(a->in[I_W_IN] + (size_t)l * DM * IN_TOTAL, IN_TOTAL, (bf16*)(ws + WS_WIN) + (size_t)l * ZLD * DM, DM, RmId{}, scr, 64 * (r / nb), 32 * (r % nb), F.lane); continue; } r -= I_WIN;
        if (r < I_SQ) { const int nb = DM / 32; transpose_item(a->in[I_W_OUT] + (size_t)l * DM * DM, DM, (bf16*)(ws + WS_WOUT) + (size_t)l * DM * DM, DM, RmId{}, scr, 64 * (r / nb), 32 * (r % nb), F.lane); continue; } r -= I_SQ;
        if (r < I_WKV) { const int nb = 4096 / 32; transpose_item(a->in[I_XA_WKV] + (size_t)l * DM * 4096, 4096, (bf16*)(ws + SC_WKVT) + (size_t)l * 4096 * DM, DM, RmId{}, scr, 64 * (r / nb), 32 * (r % nb), F.lane); continue; } r -= I_WKV;
        if (r < I_SQ) { const int nb = DM / 32; transpose_item(a->in[I_XA_WO] + (size_t)l * DM * DM, DM, (bf16*)(ws + SC_WOT) + (size_t)l * DM * DM, DM, RmId{}, scr, 64 * (r / nb), 32 * (r % nb), F.lane); continue; } r -= I_SQ;
        const int e = r / (2 * I_W1 + I_W2); r = r % (2 * I_W1 + I_W2);
        const size_t le = (size_t)l * NEXP + e;
        if (r < I_W1) { const int nb = DEXP / 32; transpose_item(a->in[I_MOE_W1] + le * DM * DEXP, DEXP, (bf16*)(ws + WS_W13) + le * 1024 * DM, DM, RmW13{0}, scr, 64 * (r / nb), 32 * (r % nb), F.lane); continue; } r -= I_W1;
        if (r < I_W1) { const int nb = DEXP / 32; transpose_item(a->in[I_MOE_W3] + le * DM * DEXP, DEXP, (bf16*)(ws + WS_W13) + le * 1024 * DM, DM, RmW13{128}, scr, 64 * (r / nb), 32 * (r % nb), F.lane); continue; } r -= I_W1;
        { const int nb = DM / 32; transpose_item(a->in[I_MOE_W2] + le * DEXP * DM, DM, (bf16*)(ws + WS_W2) + le * DM * DEXP, DEXP, RmId{}, scr, 64 * (r / nb), 32 * (r % nb), F.lane); }
    }
    for (int it = gw; it < DEPTH * 96; it += NGW) { const int l = it / 96; int r = it % 96; bf16* base = (bf16*)(ws + WS_LORA + l * LORA_LAYER);
        if (r < 32) { const int d = r >> 4, nb = r & 15; transpose_item(a->in[I_RWKV_W2] + ((size_t)l * 2 + d) * 64 * 512, 512, base + (size_t)d * 512 * 64, 64, RmId{}, scr, 0, 32 * nb, F.lane); continue; } r -= 32;
        if (r < 32) { const int d = r >> 4, nb = r & 15; transpose_item(a->in[I_RWKV_A2] + ((size_t)l * 2 + d) * 64 * 512, 512, base + (size_t)(2 + d) * 512 * 64, 64, RmId{}, scr, 0, 32 * nb, F.lane); continue; } r -= 32;
        { const int kb = r >> 4, nb = r & 15; transpose_item(a->in[I_RWKV_G2] + (size_t)l * 128 * 512, 512, base + (size_t)4 * 512 * 64, 128, RmId{}, scr, 64 * kb, 32 * nb, F.lane); } }
    for (int it = gw; it < DEPTH * 128; it += NGW) { const int l = it / 128, r = it % 128, kb = r >> 4, nb = r & 15;
        transpose_item(a->in[I_S5_GLU_W] + (size_t)l * 512 * 512, 512, (bf16*)(ws + WS_GLUT) + (size_t)l * 512 * 512, 512, RmId{}, scr, 64 * kb, 32 * nb, F.lane); }
    const int gt = F.bid * 512 + F.tid, NGT = F.G * 512;
    for (int i = gt; i < DEPTH * 32 * 16 * 64; i += NGT) { const int n = i & 63, row = i >> 6;
        bf16* cw = (bf16*)(ws + WS_S5CW) + (size_t)row * 128; cw[n] = f2bf(a->in[I_S5_C_RE][i]); cw[64 + n] = f2bf(-a->in[I_S5_C_IM][i]); }
    for (int i = gt; i < DEPTH * DM * 32; i += NGT) { const int l = i / (DM * 32), r = i % (DM * 32), k = r >> 5, e = r & 31;
        ((float*)(ws + WS_RTE))[(((size_t)l * 4 + (e >> 3)) * DM + k) * 8 + (e & 7)] = a->in[I_ROUTER_EXPERT][i]; }
    for (int i = gt; i < DEPTH * (ZLD - IN_TOTAL) * DM / 8; i += NGT) { const int l = i / ((ZLD - IN_TOTAL) * DM / 8), r = i % ((ZLD - IN_TOTAL) * DM / 8);
        *(u32x4*)((bf16*)(ws + WS_WIN) + (size_t)l * ZLD * DM + (size_t)IN_TOTAL * DM + (size_t)r * 8) = (u32x4){0u, 0u, 0u, 0u}; }
    for (int i = gt; i < DEPTH * DM * DM / 8; i += NGT) { const f32x4 x0 = *(const f32x4*)(a->in[I_XA_WQ] + (size_t)i * 8), x1 = *(const f32x4*)(a->in[I_XA_WQ] + (size_t)i * 8 + 4);
        u32x4 o; o.x = pk2(x0[0], x0[1]); o.y = pk2(x0[2], x0[3]); o.z = pk2(x1[0], x1[1]); o.w = pk2(x1[2], x1[3]); *(u32x4*)((bf16*)(ws + SC_WQB) + (size_t)i * 8) = o; }
    { float* cosA = (float*)(ws + WS_ROPE); float* sinA = cosA + SEQ * 32; float* cosC = sinA + SEQ * 32; float* sinC = cosC + SEQ * 64;
      for (int i = gt; i < SEQ * 96; i += NGT) { const int s = i / 96, j = i % 96; const bool isA = j < 32; const int jj = isA ? j : j - 32; const float dim = isA ? 64.f : 128.f;
          const float inv = 1.0f / powf(10000.0f, (float)(2 * jj) / dim); const float ang = (float)s * inv; float sn, cs; sincosf(ang, &sn, &cs);
          if (isA) { cosA[s * 32 + jj] = cs; sinA[s * 32 + jj] = sn; } else { cosC[s * 64 + jj] = cs; sinC[s * 64 + jj] = sn; } } }
    for (int i = gt; i < DEPTH * 2 * 32 * 64; i += NGT) { const int l = i / (2 * 32 * 64), r = i % (2 * 32 * 64), dir = r / (32 * 64), g = (r / 64) % 32, n = r % 64;
        float* ab = (float*)(ws + WS_S5P + l * S5P_LAYER); float* bb = ab + 2 * 32 * 64 * 2;
        const size_t pi = (((size_t)l * 2 + dir) * 32 + g) * 64 + n;
        const float lr = fminf(a->in[I_S5_A_RE][pi], -1e-4f), li = a->in[I_S5_A_IM][pi], dt = __expf(a->in[I_S5_LOG_DT][((size_t)l * 2 + dir) * 32 + g]);
        const float mag = __expf(dt * lr); float sn, cs; sincosf(dt * li, &sn, &cs); const float abr = mag * cs, abi = mag * sn;
        const float den = lr * lr + li * li; const float ir = lr / den, ii = -li / den;
        const float fr_ = (abr - 1.f) * ir - abi * ii, fi_ = (abr - 1.f) * ii + abi * ir;
        ab[(size_t)r * 2] = abr; ab[(size_t)r * 2 + 1] = abi;
        { float* ab256 = bb + 2 * 32 * 64 * 16 * 2; const float m256 = __expf(256.f * dt * lr); float s2, c2; sincosf(256.f * dt * li, &s2, &c2); ab256[(size_t)r * 2] = m256 * c2; ab256[(size_t)r * 2 + 1] = m256 * s2; }
        const size_t bi = (((size_t)l * 32 + g) * 64 + n) * 16;
#pragma unroll
        for (int c = 0; c < 16; ++c) { const float br = a->in[I_S5_B_RE][bi + c], bim = a->in[I_S5_B_IM][bi + c];
            bb[((size_t)r * 16 + c) * 2] = fr_ * br - fi_ * bim; bb[((size_t)r * 16 + c) * 2 + 1] = fr_ * bim + fi_ * br; } }
    for (int it = gw; it < DEPTH * BATCH * NMEM; it += NGW) { const int l = it / (BATCH * NMEM), row = it % (BATCH * NMEM);
        const f32x4* xr = (const f32x4*)(a->in[I_MEM] + (size_t)row * DM) + F.lane; const f32x4* gr = (const f32x4*)(a->in[I_NORM_MEM] + (size_t)l * DM) + F.lane;
        f32x4 v[8]; float s = 0.f;
#pragma unroll
        for (int j = 0; j < 8; ++j) { v[j] = xr[64 * j]; s += (v[j].x * v[j].x + v[j].y * v[j].y) + (v[j].z * v[j].z + v[j].w * v[j].w); }
        const float rstd = 1.f / sqrtf(wave_sum(s) * (1.f / DM) + RMS_EPS);
        u32x2* o8 = (u32x2*)((bf16*)(ws + SC_MEMN) + ((size_t)l * 512 + row) * DM) + F.lane;
#pragma unroll
        for (int j = 0; j < 8; ++j) { const f32x4 gv = gr[64 * j]; u32x2 w; w.x = pk2(v[j].x * rstd * gv.x, v[j].y * rstd * gv.y); w.y = pk2(v[j].z * rstd * gv.z, v[j].w * rstd * gv.w); o8[64 * j] = w; } }
}

struct SchedDense { const char* A; const char* B; char* C; int nM, nN, G, c, lda, ldb, ldcb  , cesz  ;
    __device__ __forceinline__ bool next(int i, pg8::Unit& u) const { const long L = (long)i * G + c; if (L >= (long)nM * nN) return false; int pm, pn; pg8::xcd_tile((int)L, nM, nN, pm, pn);
        u.A = A + (size_t)pm * 256 * lda * 2; u.B = B + (size_t)pn * 256 * ldb * 2; u.C = C + (size_t)pm * 256 * ldcb + (size_t)pn * 256 * cesz; u.row0 = pm * 256; u.col0 = pn * 256; u.aux = 0; return true; }
    __device__ __forceinline__ int arow(const pg8::Unit&, int r) const { return r; } };
struct SchedBatch { const char* A; const char* B; char* C; size_t sA, sB, sC; int nM, nN, nb, G, c, lda, ldb, ldcb, cesz, rowsPerBatch;
    __device__ __forceinline__ bool next(int i, pg8::Unit& u) const { const long L = (long)i * G + c; const int per = nM * nN; if (L >= (long)per * nb) return false; const int b = (int)(L / per), r = (int)(L % per), pm = r / nN, pn = r % nN;
        u.A = A + b * sA + (size_t)pm * 256 * lda * 2; u.B = B + b * sB + (size_t)pn * 256 * ldb * 2; u.C = C + b * sC + (size_t)pm * 256 * ldcb + (size_t)pn * 256 * cesz; u.row0 = b * rowsPerBatch + pm * 256; u.col0 = pn * 256; u.aux = b; return true; }
    __device__ __forceinline__ int arow(const pg8::Unit&, int r) const { return r; } };
struct SchedXaPre { unsigned char* ws; int G, c, kind;
    __device__ __forceinline__ bool next(int i, pg8::Unit& u) const { const long L = (long)i * G + c; if (L >= 128) return false; const int r = (int)L, p = r >> 3, t = r & 7, l = p >> 3, b = (p >> 2) & 1, h = p & 3;
        const bf16* kvb = (const bf16*)(ws + SC_KVB) + (size_t)l * 512 * 4096 + (size_t)(b * 256) * 4096;
        if (kind == 0) { u.A = (const char*)(kvb + h * 512); u.B = (const char*)((const bf16*)(ws + SC_WQB) + (size_t)l * DM * DM + (size_t)(t * 256) * DM + h * 512);
            u.C = (char*)((bf16*)(ws + WS_WQK) + ((size_t)(l * 2 + b) * 1024 + h * 256) * DM + t * 256); u.aux = DM; }
        else { u.A = (const char*)((const bf16*)(ws + SC_WOT) + (size_t)l * DM * DM + (size_t)(t * 256) * DM + h * 512); u.B = (const char*)(kvb + 2048 + h * 512);
            u.C = (char*)((bf16*)(ws + WS_VWO) + ((size_t)(l * 2 + b) * DM + t * 256) * 1024 + h * 256); u.aux = 1024; }
        u.row0 = 0; u.col0 = 0; return true; }
    __device__ __forceinline__ int arow(const pg8::Unit&, int r) const { return r; } };
struct EpiBf16U { static constexpr bool PERM = true, AFTER_DRAIN = false;
    __device__ __forceinline__ void operator()(const pg8::Acc& acc, const pg8::Unit& u, int wr, int wc, int fr, int fq) const { pg8::EpiBf16 e{u.aux}; e(acc, u, wr, wc, fr, fq); } };
struct SchedMoe { unsigned char* ws; const volatile LAS int* tp; const volatile LAS int* cnt; int layer, G, c, which;
    __device__ __forceinline__ bool next(int i, pg8::Unit& u) const {
        const int npn = which == 0 ? 4 : 8; const long L = (long)i * G + c; const int ntile = tp[32]; if (L >= (long)ntile * npn) return false;
        const int mt = (int)(L / npn), pn = (int)(L % npn); int e = 0;
#pragma unroll 1
        for (int k = 1; k < 32; ++k) e += (mt >= tp[k]) ? 1 : 0;
        const int lt = mt - tp[e]; const int nvalid = min(256, cnt[e] - lt * 256);
        u.row0 = lt * 256; u.col0 = pn * 256; u.aux = (e << 16) | nvalid;
        if (which == 0) { u.A = (const char*)(ws + WS_HN); u.B = (const char*)((const bf16*)(ws + WS_W13) + ((size_t)(layer * NEXP + e) * 1024 + pn * 256) * DM);
            u.C = (char*)((bf16*)(ws + SC_HMID) + (size_t)(mt * 256) * DEXP + pn * 128); }
        else { u.A = (const char*)((const bf16*)(ws + SC_HMID) + (size_t)(mt * 256) * DEXP); u.B = (const char*)((const bf16*)(ws + WS_W2) + ((size_t)(layer * NEXP + e) * DM + pn * 256) * DEXP);
            u.C = (char*)((bf16*)(ws + SC_YBUF) + (size_t)(mt * 256) * DM + pn * 256); }
        return true; }
    __device__ __forceinline__ int arow(const pg8::Unit& u, int r) const { const int e = u.aux >> 16, nvalid = u.aux & 0xffff; const int idx = (r < nvalid) ? (u.row0 + r) : u.row0;
        return ((const int*)(ws + WS_ETOK))[(size_t)e * ECAP + idx]; } };

__device__ __forceinline__ void moe_prefix(Frame& F, int layer, volatile LAS int* tp, volatile LAS int* cnt) {
    __syncthreads();
    if (F.tid < 32) cnt[F.tid] = (int)__hip_atomic_load(F.ctl + CW_CNT + layer * 64 + F.tid, __ATOMIC_RELAXED, __HIP_MEMORY_SCOPE_AGENT);
    __syncthreads();
    if (F.tid == 0) { int s = 0; for (int e = 0; e < 32; ++e) { tp[e] = s; s += (cnt[e] + 255) >> 8; } tp[32] = s; }
    __syncthreads();
}
template <int MODE>
__device__ __forceinline__ void norm_phase(Frame& F, ArgsP a, const float* src, const float* gain, int layer) {
    unsigned char* ws = F.ws; float* H = (float*)(ws + WS_H); bf16* HN = (bf16*)(ws + WS_HN);
    volatile LAS int* tp = (volatile LAS int*)(F.lds + 1024); volatile LAS int* cnt = tp + 40;
    if (MODE & 1) moe_prefix(F, layer - 1, tp, cnt);
    const int gw = F.bid * 8 + F.wave, NGW = F.G * 8;
    const f32x4* gr = (const f32x4*)gain + F.lane;
    for (int row = gw; row < NTOK; row += NGW) {
        const f32x4* xr = (const f32x4*)(src + (size_t)row * DM) + F.lane;
        f32x4 v[8];
#pragma unroll
        for (int j = 0; j < 8; ++j) v[j] = xr[64 * j];
        if (MODE & 1) {
            const int* ti = (const int*)(ws + WS_TINFO) + (size_t)row * 4;
            const int e0 = ti[0], p0 = ti[1], e1 = ti[2], p1 = ti[3];
            const size_t s0 = (size_t)tp[e0] * 256 + p0, s1 = (size_t)tp[e1] * 256 + p1;
            const u32x2* y0 = (const u32x2*)((const bf16*)(ws + SC_YBUF) + s0 * DM) + F.lane; const u32x2* y1 = (const u32x2*)((const bf16*)(ws + SC_YBUF) + s1 * DM) + F.lane;
#pragma unroll
            for (int j = 0; j < 8; ++j) { const u32x2 a0 = y0[64 * j], a1 = y1[64 * j];
                v[j].x += __uint_as_float(a0.x << 16) + __uint_as_float(a1.x << 16); v[j].y += __uint_as_float(a0.x & 0xffff0000u) + __uint_as_float(a1.x & 0xffff0000u);
                v[j].z += __uint_as_float(a0.y << 16) + __uint_as_float(a1.y << 16); v[j].w += __uint_as_float(a0.y & 0xffff0000u) + __uint_as_float(a1.y & 0xffff0000u); }
            if (!(MODE & 4)) { f32x4* hr = (f32x4*)(H + (size_t)row * DM) + F.lane;
#pragma unroll
                for (int j = 0; j < 8; ++j) hr[64 * j] = v[j]; }
        }
        float s = 0.f;
#pragma unroll
        for (int j = 0; j < 8; ++j) s += (v[j].x * v[j].x + v[j].y * v[j].y) + (v[j].z * v[j].z + v[j].w * v[j].w);
        const float rstd = 1.f / sqrtf(wave_sum(s) * (1.f / DM) + RMS_EPS);
#pragma unroll
        for (int j = 0; j < 8; ++j) { const f32x4 gv = gr[64 * j]; v[j].x *= rstd * gv.x; v[j].y *= rstd * gv.y; v[j].z *= rstd * gv.z; v[j].w *= rstd * gv.w; }
        if (MODE & 4) { f32x4* orow = (f32x4*)(a->out + (size_t)row * DM) + F.lane;
#ifdef DBG_RWCHK
            { const float* cw = (const float*)(F.ctl + 32768); const unsigned* cu = (const unsigned*)cw; const float sc = cu[DBG_RWCHK * 64 + 2] ? 1001.f : 1.f + fminf(cw[DBG_RWCHK * 64] / cw[DBG_RWCHK * 64 + 1], 100.f);
#pragma unroll
              for (int j = 0; j < 8; ++j) v[j] *= sc; }
#endif
#pragma unroll
            for (int j = 0; j < 8; ++j) orow[64 * j] = v[j]; }
        else { u32x2* o8 = (u32x2*)(HN + (size_t)row * DM) + F.lane;
#pragma unroll
            for (int j = 0; j < 8; ++j) { u32x2 w; w.x = pk2(v[j].x, v[j].y); w.y = pk2(v[j].z, v[j].w); o8[64 * j] = w; } }
        if (MODE & 2) {
            const float* wg = a->in[I_ROUTER_GROUP] + (size_t)layer * DM * 4;
            float lg[4] = {0.f, 0.f, 0.f, 0.f};
#pragma unroll
            for (int j = 0; j < 8; ++j) { const int k0 = (64 * j + F.lane) * 4;
#pragma unroll
                for (int q = 0; q < 4; ++q) { const f32x4 w4 = *(const f32x4*)(wg + (size_t)(k0 + q) * 4); const float x = v[j][q]; lg[0] += x * w4.x; lg[1] += x * w4.y; lg[2] += x * w4.z; lg[3] += x * w4.w; } }
#pragma unroll
            for (int q = 0; q < 4; ++q) lg[q] = wave_sum(lg[q]);
            int gi = 0; float gm = lg[0];
#pragma unroll
            for (int q = 1; q < 4; ++q) if (lg[q] > gm) { gm = lg[q]; gi = q; }
            const float gw_ = 1.f / (__expf(lg[0] - gm) + __expf(lg[1] - gm) + __expf(lg[2] - gm) + __expf(lg[3] - gm));
            float le[8] = {0.f, 0.f, 0.f, 0.f, 0.f, 0.f, 0.f, 0.f};
            const float* we = (const float*)(ws + WS_RTE) + ((size_t)layer * 4 + gi) * DM * 8;
#pragma unroll 4
            for (int j = 0; j < 8; ++j) { const int k0 = (64 * j + F.lane) * 4;
#pragma unroll
                for (int q = 0; q < 4; ++q) { const float* wp = we + (size_t)(k0 + q) * 8; const f32x4 wa = *(const f32x4*)wp, wb = *(const f32x4*)(wp + 4); const float x = v[j][q];
                    le[0] += x * wa.x; le[1] += x * wa.y; le[2] += x * wa.z; le[3] += x * wa.w; le[4] += x * wb.x; le[5] += x * wb.y; le[6] += x * wb.z; le[7] += x * wb.w; } }
#pragma unroll
            for (int q = 0; q < 8; ++q) le[q] = wave_sum(le[q]);
            int i0 = 0; float m0 = le[0];
#pragma unroll
            for (int q = 1; q < 8; ++q) if (le[q] > m0) { m0 = le[q]; i0 = q; }
            int i1 = -1; float m1 = -3.0e38f;
#pragma unroll
            for (int q = 0; q < 8; ++q) if (q != i0 && le[q] > m1) { m1 = le[q]; i1 = q; }
            const float t = __expf(m1 - m0); const float w0 = 1.f / (1.f + t), w1 = t / (1.f + t);
            if (F.lane == 0) {
                const int e0 = gi * 8 + i0, e1 = gi * 8 + i1;
                const int p0 = (int)__hip_atomic_fetch_add(F.ctl + CW_CNT + layer * 64 + e0, 1u, __ATOMIC_RELAXED, __HIP_MEMORY_SCOPE_AGENT);
                const int p1 = (int)__hip_atomic_fetch_add(F.ctl + CW_CNT + layer * 64 + e1, 1u, __ATOMIC_RELAXED, __HIP_MEMORY_SCOPE_AGENT);
                int* et = (int*)(ws + WS_ETOK); float* eg = (float*)(ws + WS_EGATE); int* ti = (int*)(ws + WS_TINFO) + (size_t)row * 4;
                et[(size_t)e0 * ECAP + p0] = row; eg[(size_t)e0 * ECAP + p0] = gw_ * w0; et[(size_t)e1 * ECAP + p1] = row; eg[(size_t)e1 * ECAP + p1] = gw_ * w1;
                ti[0] = e0; ti[1] = p0; ti[2] = e1; ti[3] = p1;
            }
        }
    }
}

__device__ __forceinline__ void rope8(bf16* p1, bf16* p2, const float* cs, const float* sn) {
    const u32x4 a = *(const u32x4*)p1, b = *(const u32x4*)p2; const f32x4 c0 = *(const f32x4*)cs, c1 = *(const f32x4*)(cs + 4), s0 = *(const f32x4*)sn, s1 = *(const f32x4*)(sn + 4);
    const float x1[8] = {__uint_as_float(a.x << 16), __uint_as_float(a.x & 0xffff0000u), __uint_as_float(a.y << 16), __uint_as_float(a.y & 0xffff0000u), __uint_as_float(a.z << 16), __uint_as_float(a.z & 0xffff0000u), __uint_as_float(a.w << 16), __uint_as_float(a.w & 0xffff0000u)};
    const float x2[8] = {__uint_as_float(b.x << 16), __uint_as_float(b.x & 0xffff0000u), __uint_as_float(b.y << 16), __uint_as_float(b.y & 0xffff0000u), __uint_as_float(b.z << 16), __uint_as_float(b.z & 0xffff0000u), __uint_as_float(b.w << 16), __uint_as_float(b.w & 0xffff0000u)};
    const float cc[8] = {c0[0], c0[1], c0[2], c0[3], c1[0], c1[1], c1[2], c1[3]}, ss[8] = {s0[0], s0[1], s0[2], s0[3], s1[0], s1[1], s1[2], s1[3]};
    float o1[8], o2[8];
#pragma unroll
    for (int i = 0; i < 8; ++i) { o1[i] = x1[i] * cc[i] - x2[i] * ss[i]; o2[i] = x2[i] * cc[i] + x1[i] * ss[i]; }
    *(u32x4*)p1 = (u32x4){pk2(o1[0], o1[1]), pk2(o1[2], o1[3]), pk2(o1[4], o1[5]), pk2(o1[6], o1[7])};
    *(u32x4*)p2 = (u32x4){pk2(o2[0], o2[1]), pk2(o2[2], o2[3]), pk2(o2[4], o2[5]), pk2(o2[6], o2[7])};
}
__device__ __forceinline__ void rope_token(Frame& F, bf16* zrow, int s) {
    const float* cosA = (const float*)(F.ws + WS_ROPE); const float* sinA = cosA + SEQ * 32; const float* cosC = sinA + SEQ * 32; const float* sinC = cosC + SEQ * 64;
    { const int blk = F.lane >> 2, pc = F.lane & 3; bf16* p = zrow + ZA + blk * 64 + pc * 8; rope8(p, p + 32, cosA + s * 32 + pc * 8, sinA + s * 32 + pc * 8); }
    { const int blk = F.lane >> 3, pc = F.lane & 7; bf16* p = zrow + ZC + blk * 128 + pc * 8; rope8(p, p + 64, cosC + s * 64 + pc * 8, sinC + s * 64 + pc * 8); }
}

constexpr int RWT = 16;
__device__ __forceinline__ float zs_ld(const LAS unsigned short* zr, const float* mu, int t, int col) {
    const float z0 = bf2f(zr[(t + 1) * IN_B + col]), zp = bf2f(zr[t * IN_B + col]), zn = bf2f(zr[(t + 2) * IN_B + col]);
    return z0 + mu[col] * (zp - z0) + mu[IN_B + col] * (zn - z0);
}
__device__ __forceinline__ void rwkv_prep_tile(Frame& F, ArgsP a, int layer, int tile) {
    unsigned char* ws = F.ws; const bf16* Z = (const bf16*)(ws + SC_Z);
    LAS unsigned short* zr = (LAS unsigned short*)F.lds; LAS unsigned short* act = zr + (RWT + 2) * IN_B;
    const int t0 = tile * RWT; const int b = t0 / SEQ, s0 = t0 % SEQ;
    __syncthreads();
#pragma unroll 1
    for (int i = F.tid; i < (RWT + 2) * (IN_B / 8); i += 512) { const int rr = i / (IN_B / 8), c8 = i % (IN_B / 8); const int s = s0 - 1 + rr;
        u32x4 w = {0u, 0u, 0u, 0u};
        if (s >= 0 && s < SEQ) w = *(const u32x4*)(Z + (size_t)(b * SEQ + s) * ZLD + ZB + c8 * 8);
        *(LAS u32x4*)(zr + rr * IN_B + c8 * 8) = w; }
    __syncthreads();
    const float* mu = a->in[I_RWKV_MU] + (size_t)layer * 2 * IN_B;
#pragma unroll 1
    for (int i = F.tid; i < RWT * 384; i += 512) { const int t = i / 384, j = i % 384; const float x = zs_ld(zr, mu, t, 1536 + j);
        act[t * 392 + j] = f2bf((j < 128) ? tanhf(x) : ((j < 256) ? x : sigmoidf_(x))); }
    __syncthreads();
    const int lane = F.lane, r = lane & 15, g = lane >> 4, hd = F.wave;
    const bf16* lw = (const bf16*)(ws + WS_LORA + layer * LORA_LAYER);
    bf16x8 af[12];
#pragma unroll
    for (int ks = 0; ks < 12; ++ks) af[ks] = *(const LAS bf16x8*)(act + r * 392 + ks * 32 + g * 8);
    float* RW = (float*)(ws + SC_RW); const size_t N1 = (size_t)NTOK * 512;
    f32x4 dw0[4], dw1[4], da0[4], da1[4], dg[4];
#pragma unroll
    for (int nt = 0; nt < 4; ++nt) { const int c = hd * 64 + nt * 16 + r;
        bf16x8 bw[12];
#pragma unroll
        for (int ks = 0; ks < 2; ++ks) { bw[ks] = *(const bf16x8*)(lw + ((size_t)0 * 512 + c) * 64 + ks * 32 + g * 8); bw[2 + ks] = *(const bf16x8*)(lw + ((size_t)1 * 512 + c) * 64 + ks * 32 + g * 8);
            bw[4 + ks] = *(const bf16x8*)(lw + ((size_t)2 * 512 + c) * 64 + ks * 32 + g * 8); bw[6 + ks] = *(const bf16x8*)(lw + ((size_t)3 * 512 + c) * 64 + ks * 32 + g * 8); }
#pragma unroll
        for (int ks = 0; ks < 4; ++ks) bw[8 + ks] = *(const bf16x8*)(lw + (size_t)4 * 512 * 64 + (size_t)c * 128 + ks * 32 + g * 8);
        f32x4 z4 = {0.f, 0.f, 0.f, 0.f};
        dw0[nt] = __builtin_amdgcn_mfma_f32_16x16x32_bf16(af[0], bw[0], z4, 0, 0, 0); dw0[nt] = __builtin_amdgcn_mfma_f32_16x16x32_bf16(af[1], bw[1], dw0[nt], 0, 0, 0);
        dw1[nt] = __builtin_amdgcn_mfma_f32_16x16x32_bf16(af[2], bw[2], z4, 0, 0, 0); dw1[nt] = __builtin_amdgcn_mfma_f32_16x16x32_bf16(af[3], bw[3], dw1[nt], 0, 0, 0);
        da0[nt] = __builtin_amdgcn_mfma_f32_16x16x32_bf16(af[4], bw[4], z4, 0, 0, 0); da0[nt] = __builtin_amdgcn_mfma_f32_16x16x32_bf16(af[5], bw[5], da0[nt], 0, 0, 0);
        da1[nt] = __builtin_amdgcn_mfma_f32_16x16x32_bf16(af[6], bw[6], z4, 0, 0, 0); da1[nt] = __builtin_amdgcn_mfma_f32_16x16x32_bf16(af[7], bw[7], da1[nt], 0, 0, 0);
        dg[nt] = __builtin_amdgcn_mfma_f32_16x16x32_bf16(af[8], bw[8], z4, 0, 0, 0); dg[nt] = __builtin_amdgcn_mfma_f32_16x16x32_bf16(af[9], bw[9], dg[nt], 0, 0, 0);
        dg[nt] = __builtin_amdgcn_mfma_f32_16x16x32_bf16(af[10], bw[10], dg[nt], 0, 0, 0); dg[nt] = __builtin_amdgcn_mfma_f32_16x16x32_bf16(af[11], bw[11], dg[nt], 0, 0, 0);
    }
    float w00[4], w01[4], a00[4], a01[4], kkw[4], kaw[4];
#pragma unroll
    for (int nt = 0; nt < 4; ++nt) { const int c = hd * 64 + nt * 16 + r;
        w00[nt] = a->in[I_RWKV_W0][(size_t)layer * 1024 + c]; w01[nt] = a->in[I_RWKV_W0][(size_t)layer * 1024 + 512 + c];
        a00[nt] = a->in[I_RWKV_A0][(size_t)layer * 1024 + c]; a01[nt] = a->in[I_RWKV_A0][(size_t)layer * 1024 + 512 + c];
        kkw[nt] = a->in[I_RWKV_KK][(size_t)layer * 512 + c]; kaw[nt] = a->in[I_RWKV_KA][(size_t)layer * 512 + c]; }
#pragma unroll
    for (int q = 0; q < 4; ++q) { const int t = 4 * g + q;
        float k_[4], kk[4]; float ssq = 0.f;
#pragma unroll
        for (int nt = 0; nt < 4; ++nt) { const int c = hd * 64 + nt * 16 + r; k_[nt] = zs_ld(zr, mu, t, 512 + c); kk[nt] = k_[nt] * kkw[nt]; ssq += kk[nt] * kk[nt]; }
        ssq = row_sum(ssq);
        const float rn = 1.f / sqrtf(ssq + 1e-12f);
#pragma unroll
        for (int nt = 0; nt < 4; ++nt) { const int c = hd * 64 + nt * 16 + r;
            const float r_ = zs_ld(zr, mu, t, c), v_ = zs_ld(zr, mu, t, 1024 + c);
            const float x0 = -(w00[nt] + dw0[nt][q]), x1 = -(w01[nt] + dw1[nt][q]);
            const float sp0 = fmaxf(x0, 0.f) + __logf(1.f + __expf(-fabsf(x0))), sp1 = fmaxf(x1, 0.f) + __logf(1.f + __expf(-fabsf(x1)));
            const float d0 = -__expf(-sp0 - 0.5f), d1 = -__expf(-sp1 - 0.5f);
            const float al0 = sigmoidf_(a00[nt] + da0[nt][q]), al1 = sigmoidf_(a01[nt] + da1[nt][q]);
            const float kn = kk[nt] * rn;
            const float km0 = k_[nt] * (1.f + (al0 - 1.f) * kaw[nt]), km1 = k_[nt] * (1.f + (al1 - 1.f) * kaw[nt]);
            const size_t o = (size_t)(t0 + t) * 512 + c;
            RW[0 * N1 + o] = r_; RW[1 * N1 + o] = v_; RW[2 * N1 + o] = kn; RW[3 * N1 + o] = d0; RW[4 * N1 + o] = d1;
            RW[5 * N1 + o] = km0; RW[6 * N1 + o] = km1; RW[7 * N1 + o] = kn * al0; RW[8 * N1 + o] = kn * al1; RW[9 * N1 + o] = dg[nt][q]; }
    }
}

constexpr size_t SC_S5E = SC_MIX_END + (size_t)32 * 256 * 11520;
constexpr size_t SC_MIX_END3 = SC_S5E + (size_t)2 * BATCH * 16 * 32 * 64 * 2 * 4;
template <int LEVEL>
__device__ __forceinline__ void s5_block_task(Frame& F, int layer, int task, LAS float* ul) {
    unsigned char* ws = F.ws; const bf16* Z = (const bf16*)(ws + SC_Z);
    const int blk = task & 15, dir = (task >> 4) & 1, g = (task >> 5) & 31, b = task >> 10; const int n = F.lane;
    const float* ab = (const float*)(ws + WS_S5P + layer * S5P_LAYER); const float* bb = ab + 2 * 32 * 64 * 2; const float* ab256 = bb + 2 * 32 * 64 * 16 * 2;
    const int pr = (dir * 32 + g) * 64 + n;
    const float abr = ab[pr * 2], abi = ab[pr * 2 + 1];
    float bbr[16], bbi[16];
#pragma unroll
    for (int c = 0; c < 16; ++c) { bbr[c] = bb[((size_t)pr * 16 + c) * 2]; bbi[c] = bb[((size_t)pr * 16 + c) * 2 + 1]; }
    float* E = (float*)(ws + SC_S5E);
    float xr = 0.f, xi = 0.f;
    if (LEVEL == 2) { const float pr_ = ab256[pr * 2], pi_ = ab256[pr * 2 + 1];
        for (int k = 0; k < blk; ++k) { const float* ep = E + ((((size_t)dir * BATCH + b) * 16 + k) * 32 + g) * 128 + n * 2; const float er = ep[0], ei = ep[1];
            const float nr = pr_ * xr - pi_ * xi + er, ni = pr_ * xi + pi_ * xr + ei; xr = nr; xi = ni; } }
    float* carry = (float*)(ws + SC_CARRY);
    for (int q4 = 0; q4 < 4; ++q4) {
        { const int st = blk * 256 + q4 * 64 + n; const int sl = dir ? (SEQ - 1 - st) : st; const bf16* zp = Z + (size_t)(b * SEQ + sl) * ZLD + ZD + g * 16;
          const u32x4 w0 = *(const u32x4*)zp, w1 = *(const u32x4*)(zp + 8);
          LAS f32x4* d = (LAS f32x4*)(ul + n * 16);
          d[0] = (f32x4){__uint_as_float(w0.x << 16), __uint_as_float(w0.x & 0xffff0000u), __uint_as_float(w0.y << 16), __uint_as_float(w0.y & 0xffff0000u)};
          d[1] = (f32x4){__uint_as_float(w0.z << 16), __uint_as_float(w0.z & 0xffff0000u), __uint_as_float(w0.w << 16), __uint_as_float(w0.w & 0xffff0000u)};
          d[2] = (f32x4){__uint_as_float(w1.x << 16), __uint_as_float(w1.x & 0xffff0000u), __uint_as_float(w1.y << 16), __uint_as_float(w1.y & 0xffff0000u)};
          d[3] = (f32x4){__uint_as_float(w1.z << 16), __uint_as_float(w1.z & 0xffff0000u), __uint_as_float(w1.w << 16), __uint_as_float(w1.w & 0xffff0000u)}; }
        LDS_WAIT(); asm volatile("" ::: "memory");
#pragma unroll 4
        for (int i = 0; i < 64; ++i) {
            const int step = blk * 256 + q4 * 64 + i;
            if (LEVEL == 2 && (step & (S5CH - 1)) == 0) { const int sl = dir ? (SEQ - 1 - step) : step; const int ch = sl / S5CH;
                float* cp = carry + ((((size_t)dir * BATCH + b) * S5NCH + ch) * 32 + g) * 128 + n * 2; cp[0] = xr; cp[1] = xi; }
            const f32x4 u0 = *(const LAS f32x4*)(ul + i * 16), u1 = *(const LAS f32x4*)(ul + i * 16 + 4), u2 = *(const LAS f32x4*)(ul + i * 16 + 8), u3 = *(const LAS f32x4*)(ul + i * 16 + 12);
            float br = 0.f, bi = 0.f;
#pragma unroll
            for (int c = 0; c < 4; ++c) { br += bbr[c] * u0[c] + bbr[4 + c] * u1[c] + bbr[8 + c] * u2[c] + bbr[12 + c] * u3[c]; bi += bbi[c] * u0[c] + bbi[4 + c] * u1[c] + bbi[8 + c] * u2[c] + bbi[12 + c] * u3[c]; }
            const float nr = abr * xr - abi * xi + br, ni = abr * xi + abi * xr + bi; xr = nr; xi = ni;
        }
        asm volatile("" ::: "memory");
    }
    if (LEVEL == 1) { float* ep = E + ((((size_t)dir * BATCH + b) * 16 + blk) * 32 + g) * 128 + n * 2; ep[0] = xr; ep[1] = xi; }
}

__device__ __forceinline__ void prep_phase(Frame& F, ArgsP a, int layer, const int rep) {
    const int qb_ = (rep * 2 + layer) * 8;
#ifndef DBG_PREPMASK
#define DBG_PREPMASK 7
#endif
    if (DBG_PREPMASK & 1) for (;;) { const int it = q_next(F, qb_ + 0); if (it >= 256) break; s5_block_task<1>(F, layer, it * 8 + F.wave, (LAS float*)(F.lds + F.wave * 4096)); }
    if (DBG_PREPMASK & 2) for (;;) { const int it = q_next(F, qb_ + 5); if (it >= NTOK / RWT) break; rwkv_prep_tile(F, a, layer, it); }
    if ((DBG_PREPMASK & 4) && rep == 0) for (;;) { const int r = q_next(F, qb_ + 6); if (r >= NTOK / 64) break;
        for (int k = 0; k < 8; ++k) { const int tok = r * 64 + F.wave * 8 + k; rope_token(F, (bf16*)(F.ws + SC_Z) + (size_t)tok * ZLD, tok % SEQ); } }
}

constexpr int CR_TA = 0, CR_GH = 2048, CR_WBK = 4096, CR_TM = 8192, CR_N = 8704, CR_V = 9216, CR_WL = 11264, CR_BYTES = 11520;
constexpr size_t SC_CREC = SC_MIX_END;
constexpr size_t SC_MIX_END2 = SC_CREC + (size_t)32 * 256 * CR_BYTES;
static_assert(SC_MIX_END2 <= 1140000000ull, "workspace budget");

__device__ __forceinline__ void mm16(const LAS float* A, const LAS float* B, int t, int sq, float (&out)[4]) {
    out[0] = out[1] = out[2] = out[3] = 0.f;
#pragma unroll
    for (int s4 = 0; s4 < 4; ++s4) { const f32x4 a4 = *(const LAS f32x4*)(A + t * 16 + s4 * 4);
#pragma unroll
        for (int q = 0; q < 4; ++q) { const f32x4 b4 = *(const LAS f32x4*)(B + (s4 * 4 + q) * 16 + sq * 4); const float av = a4[q];
            out[0] += av * b4[0]; out[1] += av * b4[1]; out[2] += av * b4[2]; out[3] += av * b4[3]; } }
}
__device__ __forceinline__ void st16(LAS float* M, int t, int sq, const float (&v)[4]) { *(LAS f32x4*)(M + t * 16 + sq * 4) = (f32x4){v[0], v[1], v[2], v[3]}; }

__device__ __forceinline__ void rwkv_cprep_item(Frame& F, int chain, int c, LAS float* Lw) {
    unsigned char* ws = F.ws; const float* RW = (const float*)(ws + SC_RW); const size_t N1 = (size_t)NTOK * 512;
    const int dir = chain & 1, h = (chain >> 1) & 7, b = chain >> 4; const int lane = F.lane;
    const float* Rp = RW; const float* Vp = RW + N1; const float* KKp = RW + 2 * N1; const float* LDp = RW + (3 + dir) * N1; const float* KMp = RW + (5 + dir) * N1; const float* BBp = RW + (7 + dir) * N1;
    constexpr int RS = 68;
    LAS float* At = Lw; LAS float* Bt = Lw + 16 * RS; LAS float* Kt = Lw + 32 * RS; LAS float* mat = Lw + 48 * RS;
    float at[16], rt[16], wb[16], wk[16];
    { float lw = 0.f, lwi[16], bb[16], km[16];
#pragma unroll
      for (int t = 0; t < 16; ++t) { const int pos = dir ? (SEQ - 1 - 16 * c - t) : (16 * c + t); const size_t idx = (size_t)(b * SEQ + pos) * 512 + h * 64 + lane;
          const float r_ = Rp[idx], ld = LDp[idx], a_ = -KKp[idx]; km[t] = KMp[idx]; bb[t] = BBp[idx];
          at[t] = a_ * __expf(lw); lw += ld; lwi[t] = lw; rt[t] = r_ * __expf(lw);
          const float iw = __expf(-lw); At[t * RS + lane] = at[t]; Bt[t * RS + lane] = bb[t] * iw; Kt[t * RS + lane] = km[t] * iw; }
#pragma unroll
      for (int t = 0; t < 16; ++t) { const float e = __expf(lw - lwi[t]); wb[t] = bb[t] * e; wk[t] = km[t] * e; }
      float* rec = (float*)(ws + SC_CREC + ((size_t)chain * 256 + c) * CR_BYTES + CR_WL); rec[lane] = __expf(lw); }
    LDS_WAIT(); asm volatile("" ::: "memory");
    const int t = lane >> 2, sq = lane & 3;
    float mab[4] = {0.f, 0.f, 0.f, 0.f}, mak[4] = {0.f, 0.f, 0.f, 0.f}, mrb[4] = {0.f, 0.f, 0.f, 0.f}, mrk[4] = {0.f, 0.f, 0.f, 0.f};
#pragma unroll 4
    for (int j = 0; j < 64; j += 4) { const f32x4 a4 = *(const LAS f32x4*)(At + t * RS + j);
#pragma unroll
        for (int e = 0; e < 4; ++e) { const f32x4 b4 = *(const LAS f32x4*)(Bt + (sq * 4 + e) * RS + j), k4 = *(const LAS f32x4*)(Kt + (sq * 4 + e) * RS + j);
            mab[e] += a4[0] * b4[0] + a4[1] * b4[1] + a4[2] * b4[2] + a4[3] * b4[3]; mak[e] += a4[0] * k4[0] + a4[1] * k4[1] + a4[2] * k4[2] + a4[3] * k4[3]; } }
    asm volatile("" ::: "memory");
#pragma unroll
    for (int tt = 0; tt < 16; ++tt) At[tt * RS + lane] = rt[tt];
    LDS_WAIT(); asm volatile("" ::: "memory");
#pragma unroll 4
    for (int j = 0; j < 64; j += 4) { const f32x4 a4 = *(const LAS f32x4*)(At + t * RS + j);
#pragma unroll
        for (int e = 0; e < 4; ++e) { const f32x4 b4 = *(const LAS f32x4*)(Bt + (sq * 4 + e) * RS + j), k4 = *(const LAS f32x4*)(Kt + (sq * 4 + e) * RS + j);
            mrb[e] += a4[0] * b4[0] + a4[1] * b4[1] + a4[2] * b4[2] + a4[3] * b4[3]; mrk[e] += a4[0] * k4[0] + a4[1] * k4[1] + a4[2] * k4[2] + a4[3] * k4[3]; } }
#pragma unroll
    for (int e = 0; e < 4; ++e) { const int s = sq * 4 + e; if (s >= t) { mab[e] = 0.f; mak[e] = 0.f; } if (s > t) { mrb[e] = 0.f; mrk[e] = 0.f; } }
    LAS float* m0 = mat; LAS float* m1 = mat + 256; LAS float* m2 = mat + 512; LAS float* m3 = mat + 768;
    float T[4], P[4], Q[4];
    st16(m0, t, sq, mab); LDS_WAIT(); asm volatile("" ::: "memory");
#pragma unroll
    for (int e = 0; e < 4; ++e) T[e] = mab[e] + ((sq * 4 + e) == t ? 1.f : 0.f);
    mm16(m0, m0, t, sq, P);
    st16(m1, t, sq, P); st16(m2, t, sq, T); LDS_WAIT(); asm volatile("" ::: "memory");
    mm16(m2, m1, t, sq, Q);
#pragma unroll
    for (int e = 0; e < 4; ++e) T[e] += Q[e];
    mm16(m1, m1, t, sq, P);
    asm volatile("" ::: "memory");
    st16(m0, t, sq, P); st16(m2, t, sq, T); LDS_WAIT(); asm volatile("" ::: "memory");
    mm16(m2, m0, t, sq, Q);
#pragma unroll
    for (int e = 0; e < 4; ++e) T[e] += Q[e];
    mm16(m0, m0, t, sq, P);
    asm volatile("" ::: "memory");
    st16(m1, t, sq, P); st16(m2, t, sq, T); LDS_WAIT(); asm volatile("" ::: "memory");
    mm16(m2, m1, t, sq, Q);
#pragma unroll
    for (int e = 0; e < 4; ++e) T[e] += Q[e];
    asm volatile("" ::: "memory");
    st16(m2, t, sq, T); st16(m0, t, sq, mrb); st16(m1, t, sq, mak); LDS_WAIT(); asm volatile("" ::: "memory");
    float P1[4], TM[4], Nn[4];
    mm16(m0, m2, t, sq, P1); mm16(m2, m1, t, sq, TM);
    st16(m3, t, sq, P1); LDS_WAIT(); asm volatile("" ::: "memory");
    mm16(m3, m1, t, sq, Nn);
#pragma unroll
    for (int e = 0; e < 4; ++e) Nn[e] += mrk[e];
    unsigned char* rec = ws + SC_CREC + ((size_t)chain * 256 + c) * CR_BYTES;
    { u32x2 w; w.x = pk2(TM[0], TM[1]); w.y = pk2(TM[2], TM[3]); *(u32x2*)(rec + CR_TM + (16 * sq + t) * 8) = w;
      w.x = pk2(Nn[0], Nn[1]); w.y = pk2(Nn[2], Nn[3]); *(u32x2*)(rec + CR_N + (16 * sq + t) * 8) = w; }
    LAS unsigned short* TAh = (LAS unsigned short*)Bt; LAS unsigned short* GHh = TAh + 1024;
#pragma unroll
    for (int tt = 0; tt < 16; ++tt) { float ta = 0.f, gh = rt[tt];
#pragma unroll
        for (int s4 = 0; s4 < 4; ++s4) { const f32x4 t4 = *(const LAS f32x4*)(m2 + tt * 16 + s4 * 4), p4 = *(const LAS f32x4*)(m3 + tt * 16 + s4 * 4);
            ta += t4[0] * at[s4 * 4] + t4[1] * at[s4 * 4 + 1] + t4[2] * at[s4 * 4 + 2] + t4[3] * at[s4 * 4 + 3];
            gh += p4[0] * at[s4 * 4] + p4[1] * at[s4 * 4 + 1] + p4[2] * at[s4 * 4 + 2] + p4[3] * at[s4 * 4 + 3]; }
        TAh[tt * 64 + lane] = f2bf(ta); GHh[tt * 64 + lane] = f2bf(gh); }
    LDS_WAIT(); asm volatile("" ::: "memory");
    { const int r = lane & 15, g = lane >> 4;
#pragma unroll
      for (int ks = 0; ks < 2; ++ks) { const u32x2 a0 = *(const LAS u32x2*)(TAh + r * 64 + 32 * ks + 4 * g), a1 = *(const LAS u32x2*)(TAh + r * 64 + 32 * ks + 16 + 4 * g);
          *(u32x4*)(rec + CR_TA + (ks * 64 + lane) * 16) = (u32x4){a0.x, a0.y, a1.x, a1.y};
          const u32x2 g0 = *(const LAS u32x2*)(GHh + r * 64 + 32 * ks + 4 * g), g1 = *(const LAS u32x2*)(GHh + r * 64 + 32 * ks + 16 + 4 * g);
          *(u32x4*)(rec + CR_GH + (ks * 64 + lane) * 16) = (u32x4){g0.x, g0.y, g1.x, g1.y}; } }
    { const int jb = lane >> 4, r = lane & 15; float vv[16];
#pragma unroll
      for (int tt = 0; tt < 16; ++tt) { const int pos = dir ? (SEQ - 1 - 16 * c - tt) : (16 * c + tt); vv[tt] = Vp[(size_t)(b * SEQ + pos) * 512 + h * 64 + lane]; }
#pragma unroll
      for (int g = 0; g < 4; ++g) { u32x4 w; w.x = pk2(wb[4 * g], wb[4 * g + 1]); w.y = pk2(wb[4 * g + 2], wb[4 * g + 3]); w.z = pk2(wk[4 * g], wk[4 * g + 1]); w.w = pk2(wk[4 * g + 2], wk[4 * g + 3]);
          *(u32x4*)(rec + CR_WBK + (jb * 64 + 16 * g + r) * 16) = w;
          u32x2 x; x.x = pk2(vv[4 * g], vv[4 * g + 1]); x.y = pk2(vv[4 * g + 2], vv[4 * g + 3]); *(u32x2*)(rec + CR_V + (jb * 64 + 16 * g + r) * 8) = x; } }
    LDS_WAIT(); asm volatile("" ::: "memory");
}

__device__ __forceinline__ void cprep_phase(Frame& F, int layer) {
    LAS float* Lw = (LAS float*)(F.lds + F.wave * 17408);
    for (int it = F.bid * 8 + F.wave; it < 32 * 256; it += F.G * 8) { const int c = it >> 5, chain = it & 31; rwkv_cprep_item(F, chain, c, Lw); }
    asm volatile("" ::: "memory");
    for (int it = F.bid * 8 + F.wave; it < 2048; it += F.G * 8) s5_block_task<2>(F, layer, it, Lw);
}

template <class P, class T> struct RwPtr { typedef const T* type; };
template <class T> struct RwPtr<const LAS unsigned char*, T> { typedef const LAS T* type; };
struct RwOps { bf16x8 ta[2], gh[2], wbk[4]; u32x2 tm, nn, vq[2]; f32x4 wl[4]; };
template <class P> __device__ __forceinline__ void rw_load(RwOps& o, P rec, int lane, int half) {
    const int g = lane >> 4;
#pragma unroll
    for (int ks = 0; ks < 2; ++ks) { o.ta[ks] = *(const typename RwPtr<P, bf16x8>::type)(rec + CR_TA + (ks * 64 + lane) * 16); o.gh[ks] = *(const typename RwPtr<P, bf16x8>::type)(rec + CR_GH + (ks * 64 + lane) * 16); }
#pragma unroll
    for (int jb = 0; jb < 4; ++jb) { o.wbk[jb] = *(const typename RwPtr<P, bf16x8>::type)(rec + CR_WBK + (jb * 64 + lane) * 16); o.wl[jb] = *(const typename RwPtr<P, f32x4>::type)(rec + CR_WL + (jb * 16 + g * 4) * 4); }
    o.tm = *(const typename RwPtr<P, u32x2>::type)(rec + CR_TM + lane * 8); o.nn = *(const typename RwPtr<P, u32x2>::type)(rec + CR_N + lane * 8);
#pragma unroll
    for (int it = 0; it < 2; ++it) o.vq[it] = *(const typename RwPtr<P, u32x2>::type)(rec + CR_V + ((half * 2 + it) * 64 + lane) * 8);
}
__device__ __forceinline__ bf16x8 mk8(unsigned a, unsigned b, unsigned c, unsigned d) { u32x4 w = {a, b, c, d}; return *reinterpret_cast<bf16x8*>(&w); }
__device__ __forceinline__ void rw_step(const RwOps& o, f32x4 (&X)[4][2], float* ysb, const long rs, int lane) {
    const int r = lane & 15, g = lane >> 4;
    const bf16x8 tmf = mk8(o.tm.x, o.tm.y, 0u, 0u), nf = mk8(o.nn.x, o.nn.y, 0u, 0u);
#pragma unroll
    for (int it = 0; it < 2; ++it) {
        bf16x8 xb[2];
#pragma unroll
        for (int ks = 0; ks < 2; ++ks) xb[ks] = mk8(pk2c(X[2 * ks][it][0], X[2 * ks][it][1]), pk2c(X[2 * ks][it][2], X[2 * ks][it][3]), pk2c(X[2 * ks + 1][it][0], X[2 * ks + 1][it][1]), pk2c(X[2 * ks + 1][it][2], X[2 * ks + 1][it][3]));
        const bf16x8 vb = mk8(o.vq[it].x, o.vq[it].y, 0u, 0u);
        f32x4 U = {0.f, 0.f, 0.f, 0.f}, Y = {0.f, 0.f, 0.f, 0.f};
        U = __builtin_amdgcn_mfma_f32_16x16x32_bf16(o.ta[0], xb[0], U, 0, 0, 0); Y = __builtin_amdgcn_mfma_f32_16x16x32_bf16(o.gh[0], xb[0], Y, 0, 0, 0);
        U = __builtin_amdgcn_mfma_f32_16x16x32_bf16(o.ta[1], xb[1], U, 0, 0, 0); Y = __builtin_amdgcn_mfma_f32_16x16x32_bf16(o.gh[1], xb[1], Y, 0, 0, 0);
        U = __builtin_amdgcn_mfma_f32_16x16x32_bf16(tmf, vb, U, 0, 0, 0);       Y = __builtin_amdgcn_mfma_f32_16x16x32_bf16(nf, vb, Y, 0, 0, 0);
        const bf16x8 uvb = mk8(pk2c(U[0], U[1]), pk2c(U[2], U[3]), o.vq[it].x, o.vq[it].y);
#pragma unroll
        for (int jb = 0; jb < 4; ++jb) X[jb][it] = __builtin_amdgcn_mfma_f32_16x16x32_bf16(o.wbk[jb], uvb, X[jb][it] * o.wl[jb], 0, 0, 0);
#pragma unroll
        for (int q = 0; q < 4; ++q) ysb[(long)(4 * g + q) * rs + 16 * it + r] = Y[q];
    }
}
__device__ __forceinline__ void rwkv_scan_chunked(Frame& F, int chain, int half) {
    unsigned char* ws = F.ws; asm volatile("" : "+s"(ws)); const int dir = chain & 1, h = (chain >> 1) & 7, b = chain >> 4; const int lane = F.lane;
    const unsigned char* rec0 = ws + SC_CREC + (size_t)chain * 256 * CR_BYTES;
#ifdef DBG_RWCHK
    float* YS = (float*)(ws + WS_HN) + (size_t)dir * NTOK * 512;
#else
    float* YS = (float*)(ws + SC_YS) + (size_t)dir * NTOK * 512;
#endif
    f32x4 X[4][2];
#pragma unroll
    for (int jb = 0; jb < 4; ++jb) { X[jb][0] = (f32x4){0.f, 0.f, 0.f, 0.f}; X[jb][1] = (f32x4){0.f, 0.f, 0.f, 0.f}; }
    RwOps oa, ob;
    rw_load(oa, rec0, lane, half);
    const long rs = dir ? -512 : 512;
    for (int c = 0; c < 256; c += 2) {
        rw_load(ob, rec0 + (size_t)(c + 1) * CR_BYTES, lane, half);
        { const int pos0 = dir ? (SEQ - 1 - 16 * c) : 16 * c; rw_step(oa, X, YS + (size_t)(b * SEQ + pos0) * 512 + h * 64 + half * 32, rs, lane); }
        if (c + 2 < 256) rw_load(oa, rec0 + (size_t)(c + 2) * CR_BYTES, lane, half);
        { const int pos0 = dir ? (SEQ - 1 - 16 * (c + 1)) : 16 * (c + 1); rw_step(ob, X, YS + (size_t)(b * SEQ + pos0) * 512 + h * 64 + half * 32, rs, lane); }
    }
}

__device__ __forceinline__ void rwkv_scan_ring(Frame& F, int pair) {
    unsigned char* ws = F.ws; asm volatile("" : "+s"(ws));
    const int w = F.wave, lane = F.lane;
    LAS unsigned char* ring = F.lds;
    __syncthreads();
    if (w < 4) {
        const int chain = pair * 2 + (w >> 1), half = w & 1; const int dir = chain & 1, h = (chain >> 1) & 7, b = chain >> 4;
        float* YS = (float*)(ws + SC_YS) + (size_t)dir * NTOK * 512;
        f32x4 X[4][2];
#pragma unroll
        for (int jb = 0; jb < 4; ++jb) { X[jb][0] = (f32x4){0.f, 0.f, 0.f, 0.f}; X[jb][1] = (f32x4){0.f, 0.f, 0.f, 0.f}; }
        const long rs = dir ? -512 : 512;
        __syncthreads();
#pragma unroll 1
        for (int c = 0; c < 256; ++c) {
            RwOps o; rw_load(o, (const LAS unsigned char*)(ring + ((w >> 1) * 2 + (c & 1)) * CR_BYTES), lane, half);
            const int pos0 = dir ? (SEQ - 1 - 16 * c) : 16 * c; rw_step(o, X, YS + (size_t)(b * SEQ + pos0) * 512 + h * 64 + half * 32, rs, lane);
            __syncthreads();
        }
    } else {
        const int k = (w - 4) >> 1, part = (w - 4) & 1; const int chain = pair * 2 + k;
        const unsigned char* rec0 = ws + SC_CREC + (size_t)chain * 256 * CR_BYTES;
        LAS unsigned char* dst0 = ring + (k * 2) * CR_BYTES;
        const int i0 = (part * 64 + lane) * 16;
        u32x4 R0[6], R1[6], R2[6];
#define RW_LD(R, cc) do { const unsigned char* p_ = rec0 + (size_t)(cc) * CR_BYTES + i0; _Pragma("unroll") for (int j = 0; j < 6; ++j) if (j < 5 || i0 + 2048 * 5 < CR_BYTES) R[j] = *(const u32x4*)(p_ + 2048 * j); } while (0)
#define RW_ST(R, cc) do { LAS unsigned char* d_ = dst0 + ((cc) & 1) * CR_BYTES + i0; _Pragma("unroll") for (int j = 0; j < 6; ++j) if (j < 5 || i0 + 2048 * 5 < CR_BYTES) *(LAS u32x4*)(d_ + 2048 * j) = R[j]; } while (0)
        RW_LD(R0, 0); RW_LD(R1, 1); RW_LD(R2, 2);
        RW_ST(R0, 0); RW_LD(R0, 3);
        __syncthreads();
#pragma unroll 1
        for (int c = 0; c < 255; c += 3) {
            RW_ST(R1, c + 1); if (c + 4 < 256) RW_LD(R1, c + 4); __syncthreads();
            RW_ST(R2, c + 2); if (c + 5 < 256) RW_LD(R2, c + 5); __syncthreads();
            RW_ST(R0, c + 3); if (c + 6 < 256) RW_LD(R0, c + 6); __syncthreads();
        }
        __syncthreads();
#undef RW_LD
#undef RW_ST
    }
}

__device__ __forceinline__ void rwkv_scan_naive(Frame& F, int chain) {
    unsigned char* ws = F.ws; const float* RW = (const float*)(ws + SC_RW); const size_t N1 = (size_t)NTOK * 512;
    const int dir = chain & 1, h = (chain >> 1) & 7, b = chain >> 4;
    const float* Rp = RW; const float* Vp = RW + N1; const float* KKp = RW + 2 * N1; const float* Wp = RW + (3 + dir) * N1; const float* KMp = RW + (5 + dir) * N1; const float* BBp = RW + (7 + dir) * N1;
    float* YS = (float*)(ws + SC_YS) + (size_t)dir * N1;
    LAS float* L = (LAS float*)(F.lds + F.wave * 2048);
    float st[64];
#pragma unroll
    for (int j = 0; j < 64; ++j) st[j] = 0.f;
    size_t idx = (size_t)(b * SEQ + (dir ? SEQ - 1 : 0)) * 512 + h * 64 + F.lane;
    float va = -KKp[idx], vw = __expf(Wp[idx]), vb = BBp[idx], vk = KMp[idx], vr = Rp[idx], vv = Vp[idx];
    for (int t = 0; t < SEQ; ++t) {
        L[F.lane] = va; L[64 + F.lane] = vw; L[128 + F.lane] = vb; L[192 + F.lane] = vk; L[256 + F.lane] = vr;
        const float v = vv; const size_t oidx = idx;
        if (t + 1 < SEQ) { idx = dir ? idx - 512 : idx + 512; va = -KKp[idx]; vw = __expf(Wp[idx]); vb = BBp[idx]; vk = KMp[idx]; vr = Rp[idx]; vv = Vp[idx]; }
        LDS_WAIT(); asm volatile("" ::: "memory");
        float sa0 = 0.f, sa1 = 0.f, sa2 = 0.f, sa3 = 0.f;
#pragma unroll
        for (int j = 0; j < 64; j += 4) { const f32x4 x = *(const LAS f32x4*)(L + j); sa0 += st[j] * x[0]; sa1 += st[j + 1] * x[1]; sa2 += st[j + 2] * x[2]; sa3 += st[j + 3] * x[3]; }
        const float sa = (sa0 + sa1) + (sa2 + sa3);
        float y0 = 0.f, y1 = 0.f, y2 = 0.f, y3 = 0.f;
#pragma unroll
        for (int j = 0; j < 64; j += 4) { const f32x4 w4 = *(const LAS f32x4*)(L + 64 + j), b4 = *(const LAS f32x4*)(L + 128 + j), k4 = *(const LAS f32x4*)(L + 192 + j), r4 = *(const LAS f32x4*)(L + 256 + j);
            st[j] = st[j] * w4[0] + (sa * b4[0] + v * k4[0]); st[j + 1] = st[j + 1] * w4[1] + (sa * b4[1] + v * k4[1]); st[j + 2] = st[j + 2] * w4[2] + (sa * b4[2] + v * k4[2]); st[j + 3] = st[j + 3] * w4[3] + (sa * b4[3] + v * k4[3]);
            y0 += st[j] * r4[0]; y1 += st[j + 1] * r4[1]; y2 += st[j + 2] * r4[2]; y3 += st[j + 3] * r4[3]; }
        YS[oidx] = (y0 + y1) + (y2 + y3);
        asm volatile("" ::: "memory");
    }
}

__device__ __forceinline__ void s5_unit(Frame& F, ArgsP a, int layer, int unit) {
    unsigned char* ws = F.ws; asm volatile("" : "+s"(ws)); const bf16* Z = (const bf16*)(ws + SC_Z);
    const int b = unit / S5NCH, ch = unit % S5NCH; const int tok0 = b * SEQ + ch * S5CH;
    LAS float* ybuf = (LAS float*)F.lds;
    LAS unsigned short* gla = (LAS unsigned short*)(F.lds + 32768);
    LAS unsigned short* xa = (LAS unsigned short*)(F.lds + 49408 + F.wave * 4352);
    LAS float* ulw = (LAS float*)(F.lds + RING_BYTES + F.wave * 1024);
    const float* ab = (const float*)(ws + WS_S5P + layer * S5P_LAYER); const float* bb = ab + 2 * 32 * 64 * 2;
    const float* carry = (const float*)(ws + SC_CARRY);
    const int n = F.lane, r = n & 15, g4 = n >> 4;
    __syncthreads();
    for (int gi = 0; gi < 4; ++gi) {
        const int g = gi * 8 + F.wave;
        { const int tl = (n >> 1) & 15, hf = n & 1; const u32x4 w0 = *(const u32x4*)(Z + (size_t)(tok0 + tl) * ZLD + ZD + g * 16 + hf * 8);
          if (n < 32) { LAS f32x4* d = (LAS f32x4*)(ulw + tl * 16 + hf * 8);
            d[0] = (f32x4){__uint_as_float(w0.x << 16), __uint_as_float(w0.x & 0xffff0000u), __uint_as_float(w0.y << 16), __uint_as_float(w0.y & 0xffff0000u)};
            d[1] = (f32x4){__uint_as_float(w0.z << 16), __uint_as_float(w0.z & 0xffff0000u), __uint_as_float(w0.w << 16), __uint_as_float(w0.w & 0xffff0000u)}; } }
        float abr2[2], abi2[2], cr2[2], ci2[2];
#pragma unroll
        for (int dir = 0; dir < 2; ++dir) { const int pr = (dir * 32 + g) * 64 + n; abr2[dir] = ab[pr * 2]; abi2[dir] = ab[pr * 2 + 1];
            const float* cp = carry + ((((size_t)dir * BATCH + b) * S5NCH + ch) * 32 + g) * 128 + n * 2; cr2[dir] = cp[0]; ci2[dir] = cp[1]; }
        bf16x8 cwf[4];
        { const bf16* cw = (const bf16*)(ws + WS_S5CW) + ((size_t)(layer * 32 + g) * 16 + r) * 128 + g4 * 8;
#pragma unroll
          for (int ks = 0; ks < 4; ++ks) cwf[ks] = *(const bf16x8*)(cw + ks * 32); }
        LDS_WAIT(); asm volatile("" ::: "memory");
        float xfr[16], xfi[16];
#pragma unroll
        for (int dir = 0; dir < 2; ++dir) {
            const int pr = (dir * 32 + g) * 64 + n; const float abr = abr2[dir], abi = abi2[dir];
            float bbr[16], bbi[16];
            { const f32x4* bp = (const f32x4*)(bb + (size_t)pr * 32);
#pragma unroll
              for (int c4 = 0; c4 < 8; ++c4) { const f32x4 q = bp[c4]; bbr[c4 * 2] = q[0]; bbi[c4 * 2] = q[1]; bbr[c4 * 2 + 1] = q[2]; bbi[c4 * 2 + 1] = q[3]; } }
            float xr = cr2[dir], xi = ci2[dir];
#pragma unroll
            for (int i = 0; i < S5CH; ++i) { const int tl = dir ? (S5CH - 1 - i) : i;
                const f32x4 u0 = *(const LAS f32x4*)(ulw + tl * 16), u1 = *(const LAS f32x4*)(ulw + tl * 16 + 4), u2 = *(const LAS f32x4*)(ulw + tl * 16 + 8), u3 = *(const LAS f32x4*)(ulw + tl * 16 + 12);
                float br = 0.f, bi = 0.f;
#pragma unroll
                for (int c = 0; c < 4; ++c) { br += bbr[c] * u0[c] + bbr[4 + c] * u1[c] + bbr[8 + c] * u2[c] + bbr[12 + c] * u3[c]; bi += bbi[c] * u0[c] + bbi[4 + c] * u1[c] + bbi[8 + c] * u2[c] + bbi[12 + c] * u3[c]; }
                const float nr = abr * xr - abi * xi + br, ni = abr * xi + abi * xr + bi; xr = nr; xi = ni;
                if (dir == 0) { xfr[tl] = xr; xfi[tl] = xi; }
                else { xa[tl * 136 + n] = f2bf(xfr[tl] + xr); xa[tl * 136 + 64 + n] = f2bf(xfi[tl] + xi); }
                if ((i & 3) == 3) asm volatile("" ::: "memory"); }
        }
        LDS_WAIT(); asm volatile("" ::: "memory");
        { f32x4 y = {0.f, 0.f, 0.f, 0.f};
#pragma unroll
          for (int ks = 0; ks < 4; ++ks) { const bf16x8 af = *(const LAS bf16x8*)(xa + r * 136 + ks * 32 + g4 * 8); y = __builtin_amdgcn_mfma_f32_16x16x32_bf16(af, cwf[ks], y, 0, 0, 0); }
          const float dsk = a->in[I_S5_D][(size_t)layer * 512 + g * 16 + r];
#pragma unroll
          for (int q = 0; q < 4; ++q) { const int tl = 4 * g4 + q; const float yy = y[q] + dsk * ulw[tl * 16 + r];
              const float x3 = yy * yy * yy; const float gl = 0.5f * yy * (1.f + tanhf(0.7978845608028654f * (yy + 0.044715f * x3)));
              ybuf[tl * 512 + g * 16 + r] = gl; gla[tl * 520 + g * 16 + r] = f2bf(gl); } }
        LDS_WAIT(); asm volatile("" ::: "memory");
    }
    __syncthreads();
    { f32x4 acc[4];
#pragma unroll
      for (int j = 0; j < 4; ++j) acc[j] = (f32x4){0.f, 0.f, 0.f, 0.f};
      const bf16* wt = (const bf16*)(ws + WS_GLUT) + (size_t)layer * 512 * 512 + (size_t)(F.wave * 64 + r) * 512 + g4 * 8;
#pragma unroll 1
      for (int k0 = 0; k0 < 16; k0 += 4) { bf16x8 bf_[4][4];
#pragma unroll
          for (int kk = 0; kk < 4; ++kk)
#pragma unroll
              for (int j = 0; j < 4; ++j) bf_[kk][j] = *(const bf16x8*)(wt + (size_t)j * 16 * 512 + (k0 + kk) * 32);
#pragma unroll
          for (int kk = 0; kk < 4; ++kk) { const bf16x8 af = *(const LAS bf16x8*)(gla + r * 520 + (k0 + kk) * 32 + g4 * 8);
#pragma unroll
              for (int j = 0; j < 4; ++j) acc[j] = __builtin_amdgcn_mfma_f32_16x16x32_bf16(af, bf_[kk][j], acc[j], 0, 0, 0); } }
#pragma unroll
      for (int j = 0; j < 4; ++j) { const int c = F.wave * 64 + j * 16 + r; const float bias = a->in[I_S5_GLU_B][(size_t)layer * 512 + c];
#pragma unroll
          for (int q = 0; q < 4; ++q) { const int tl = 4 * g4 + q; const float gl = ybuf[tl * 512 + c]; ybuf[tl * 512 + c] = gl * sigmoidf_(acc[j][q] + bias); } } }
    __syncthreads();
    { const float* gn = a->in[I_MIX_OUT_NORM] + ((size_t)layer * 2 + 1) * 512; bf16* MIX = (bf16*)(ws + WS_MIX);
#pragma unroll
      for (int q = 0; q < 2; ++q) { const int tl = F.wave * 2 + q; float v[8]; float s = 0.f;
#pragma unroll
          for (int j = 0; j < 8; ++j) { v[j] = ybuf[tl * 512 + j * 64 + F.lane]; s += v[j] * v[j]; }
          const float rstd = 1.f / sqrtf(wave_sum(s) * (1.f / 512.f) + RMS_EPS);
#pragma unroll
          for (int j = 0; j < 8; ++j) MIX[(size_t)(tok0 + tl) * DM + 1536 + j * 64 + F.lane] = f2bf(v[j] * rstd * gn[j * 64 + F.lane]); } }
}

template <int mask>
__device__ __forceinline__ void mix_phase(Frame& F, ArgsP a, int layer, const int rep) {
    const int qb_ = (rep * 2 + layer) * 8;
    constexpr int NB = 16, NA = BATCH * 4 * (SEQ / 128), NC = BATCH * 4 * 48, ND = BATCH * S5NCH;
    if (mask & 1) for (;;) { const int it = q_next(F, qb_ + 1); if (it >= NB) break; rwkv_scan_ring(F, it); }
    if (mask & 2) for (;;) { const int it = q_next(F, qb_ + 2); if (it >= NA) break;
        unsigned char* ws = F.ws; asm volatile("" : "+s"(ws)); const bf16* Z = (const bf16*)(ws + SC_Z);
        const int qb = it % (SEQ / 128), h = (it / (SEQ / 128)) % 4, b = it / (4 * (SEQ / 128));
        const bf16* zb = Z + (size_t)(b * SEQ) * ZLD + ZA;
        float lam, lam_init;
        { const float* lv = a->in[I_DIFF_LAMBDA] + (size_t)layer * 4 * 64; float d1 = 0.f, d2 = 0.f;
          for (int i = 0; i < 64; ++i) { d1 += lv[i] * lv[64 + i]; d2 += lv[128 + i] * lv[192 + i]; }
          lam_init = 0.8f - 0.6f * expf(-0.3f * (float)layer); lam = expf(d1) - expf(d2) + lam_init; }
        att::diff_attn_unit(zb + (size_t)(qb * 128) * ZLD + h * 128, zb + 512 + h * 128, zb + 1024 + h * 128, ZLD, SEQ,
                            (bf16*)(ws + WS_MIX) + (size_t)(b * SEQ + qb * 128) * DM + h * 128, DM, lam, 1.f - lam_init, a->in[I_DIFF_SUBLN] + (size_t)layer * 128, (char*)F.lds, F.wave); }
#ifdef DBG_RWCHK
    for (;;) { const int it = q_next(F, layer * 8 + 5); if (it >= 4) break; rwkv_scan_naive(F, it * 8 + F.wave); }
#endif
    if (mask & 4) for (;;) { const int it = q_next(F, qb_ + 3); if (it >= NC) break;
        unsigned char* ws = F.ws; asm volatile("" : "+s"(ws)); const bf16* Z = (const bf16*)(ws + SC_Z);
        const int r = it % 48, h = (it / 48) % 4, b = it / (48 * 4); const int p = r / 16, rr = r % 16;
        const int dil = p == 0 ? 1 : (p == 1 ? 4 : 16); const int L = SEQ / dil; const int nqb = L / 256; const int rho = rr / nqb, qb = rr % nqb;
        const bf16* zb = Z + (size_t)(b * SEQ) * ZLD + ZC;
        att::dil_attn_unit(zb + h * 128, zb + 512 + h * 128, zb + 1024 + h * 128, ZLD, dil, rho, qb * 256, L,
                           (float*)(ws + SC_OC) + ((size_t)p * NTOK + (size_t)b * SEQ) * 512 + h * 128, (float*)(ws + SC_LSE) + ((size_t)p * NTOK + (size_t)b * SEQ) * 4 + h, (char*)F.lds, F.wave); }
    if (mask & 8) for (;;) { const int it = q_next(F, qb_ + 4); if (it >= ND) break; s5_unit(F, a, layer, it); }
}

__device__ __forceinline__ void post_phase(Frame& F, ArgsP a, int layer) {
    unsigned char* ws = F.ws; bf16* MIX = (bf16*)(ws + WS_MIX);
    const int gw = F.bid * 8 + F.wave, NGW = F.G * 8;
    const float* RW = (const float*)(ws + SC_RW); const size_t N1 = (size_t)NTOK * 512; const float* YS = (const float*)(ws + SC_YS);
#ifdef DBG_RWCHK
    { const float* Y2 = (const float*)(ws + WS_HN); float e = 0.f, r2 = 0.f; int bad = 0;
      for (size_t i = (size_t)F.bid * 512 + F.tid; i < (size_t)2 * NTOK * 512; i += (size_t)F.G * 512) { const float a0 = ((const float*)(ws + SC_YS))[i], b0 = Y2[i]; const float d = fabsf(a0 - b0); if (!(d < 1e30f)) bad = 1; else e = fmaxf(e, d); r2 = fmaxf(r2, fabsf(a0)); }
      e = wave_max(e); r2 = wave_max(r2); bad = __any(bad) ? 1 : 0;
      if (F.lane == 0) { atomicMax(F.ctl + 32768 + layer * 64, __float_as_uint(e)); atomicMax(F.ctl + 32768 + layer * 64 + 1, __float_as_uint(r2)); if (bad) atomicMax(F.ctl + 32768 + layer * 64 + 2, 1u); } }
#endif
    for (int tok = gw; tok < NTOK; tok += NGW) {
        float y[8], r_[8], v_[8], kb[8], gg[8];
#pragma unroll
        for (int h = 0; h < 8; ++h) { const size_t o = (size_t)tok * 512 + h * 64 + F.lane; y[h] = YS[o] + YS[N1 + o]; r_[h] = RW[o]; v_[h] = RW[N1 + o]; kb[h] = 0.5f * (RW[5 * N1 + o] + RW[6 * N1 + o]); gg[h] = RW[9 * N1 + o]; }
#pragma unroll
        for (int h = 0; h < 8; ++h) { const int c = h * 64 + F.lane;
            const float mean = wave_sum(y[h]) * (1.f / 64.f); const float d = y[h] - mean; const float var = wave_sum(d * d) * (1.f / 64.f);
            const float yn = d * (1.f / sqrtf(var + 64e-5f)) * a->in[I_RWKV_LNX_W][(size_t)layer * 512 + c] + a->in[I_RWKV_LNX_B][(size_t)layer * 512 + c];
            const float bon = wave_sum(r_[h] * kb[h] * a->in[I_RWKV_RK][(size_t)layer * 512 + c]) * v_[h];
            MIX[(size_t)tok * DM + 512 + c] = f2bf((yn + bon) * gg[h]); } }
    const float* OC = (const float*)(ws + SC_OC); const float* LSE = (const float*)(ws + SC_LSE); const float* gn = a->in[I_MIX_OUT_NORM] + ((size_t)layer * 2 + 0) * 512;
    for (int tok = gw; tok < NTOK; tok += NGW) { const int h = F.lane >> 4;
        const float l0 = LSE[((size_t)0 * NTOK + tok) * 4 + h], l1 = LSE[((size_t)1 * NTOK + tok) * 4 + h], l2 = LSE[((size_t)2 * NTOK + tok) * 4 + h];
        const float m = fmaxf(l0, fmaxf(l1, l2)); float w0 = __expf(l0 - m), w1 = __expf(l1 - m), w2 = __expf(l2 - m); const float inv = 1.f / (w0 + w1 + w2); w0 *= inv; w1 *= inv; w2 *= inv;
        float v[8]; float s = 0.f;
        const f32x4* p0 = (const f32x4*)(OC + ((size_t)0 * NTOK + tok) * 512) + F.lane * 2; const f32x4* p1 = (const f32x4*)(OC + ((size_t)1 * NTOK + tok) * 512) + F.lane * 2; const f32x4* p2 = (const f32x4*)(OC + ((size_t)2 * NTOK + tok) * 512) + F.lane * 2;
#pragma unroll
        for (int j = 0; j < 2; ++j) { const f32x4 a0 = p0[j], a1 = p1[j], a2 = p2[j];
#pragma unroll
            for (int e = 0; e < 4; ++e) { const float x = w0 * a0[e] + w1 * a1[e] + w2 * a2[e]; v[j * 4 + e] = x; s += x * x; } }
        const float rstd = 1.f / sqrtf(wave_sum(s) * (1.f / 512.f) + RMS_EPS);
        const f32x4 g0 = *((const f32x4*)gn + F.lane * 2), g1 = *((const f32x4*)gn + F.lane * 2 + 1);
        u32x4 w; w.x = pk2(v[0] * rstd * g0[0], v[1] * rstd * g0[1]); w.y = pk2(v[2] * rstd * g0[2], v[3] * rstd * g0[3]); w.z = pk2(v[4] * rstd * g1[0], v[5] * rstd * g1[1]); w.w = pk2(v[6] * rstd * g1[2], v[7] * rstd * g1[3]);
        *(u32x4*)(MIX + (size_t)tok * DM + 1024 + F.lane * 8) = w; }
}

#ifndef MK_FUSED
#define MK_FUSED 1
#endif
__global__ void __launch_bounds__(512, 2) enc_fwd(Args args_) {
    extern __shared__ __attribute__((aligned(16))) unsigned char lds_raw[];
    Frame F;
    F.lds = (LAS unsigned char*)lds_raw; F.MISC = (volatile LAS unsigned*)(F.lds + MISC_OFF);
    F.tid = threadIdx.x; F.lane = F.tid & 63; F.wave = __builtin_amdgcn_readfirstlane(F.tid >> 6); F.G = gridDim.x; F.bid = blockIdx.x;
    const int wave0 = F.wave;
    ArgsP ap = (ArgsP)__builtin_amdgcn_kernarg_segment_ptr();
    unsigned char* ws = ap->ws; F.ws = ws; F.ctl = (unsigned*)(ws + WS_CTL);
    for (int u = F.tid; u < (LDS_BYTES - MISC_OFF) / 4; u += 512) ((LAS unsigned*)(F.lds + MISC_OFF))[u] = 0u;
    __syncthreads();
    const int lo = ap->ph_lo, hi = ap->ph_hi;
    if (hi - lo > 1) (void)xcd_barrier_post(F.ctl + CW_BAR, F.MISC + 8);
#ifdef DBG_ONLY
#define IN(k) (((k) < PH_L0 ? (k) : ((k) == PH_FINAL ? 100 : 3 + ((k) - PH_L0) % NPH_L)) == DBG_ONLY && lo <= (k) && (k) < hi)
#else
#define IN(k) ({ int lo_ = lo, hi_ = hi; asm volatile("" : "+s"(lo_), "+s"(hi_)); lo_ <= (k) && (k) < hi_; })
#endif
#define args (*ap)
#define REFRESH() do { int wv_ = wave0, bi_ = blockIdx.x, gg_ = gridDim.x; asm volatile("" : "+s"(wv_), "+s"(bi_), "+s"(gg_)); const int t_ = tid_from_wave(wv_); F.tid = t_; F.lane = t_ & 63; F.wave = wv_; F.bid = bi_; F.G = gg_; ap = (ArgsP)__builtin_amdgcn_kernarg_segment_ptr(); asm volatile("" : "+s"(ap)); unsigned char* w_ = ap->ws; F.ws = w_; ws = w_; F.ctl = (unsigned*)(w_ + WS_CTL); } while (0)
#ifndef DBG_MIXMASK
#define DBG_MIXMASK 15
#endif
#ifndef DBG_REP_CODE
#define DBG_REP_CODE -1
#define DBG_REP_N 0
#endif
#define REPS(code) (((code) == DBG_REP_CODE && l_ == 0) ? 1 + DBG_REP_N : 1)
#ifdef DBG_TIME_A
#define STAMP(k) do { if (blockIdx.x == 0 && threadIdx.x == 0) { const unsigned long long t_ = wall_clock64(); F.MISC[192 + 2 * (k)] = (unsigned)t_; F.MISC[193 + 2 * (k)] = (unsigned)(t_ >> 32); } } while (0)
#else
#define STAMP(k) do {} while (0)
#endif
#define SEAM(k) do { if (IN(k) && IN((k) + 1)) { XcdBarrier b_; b_.bar = (unsigned*)(ap->ws + WS_CTL) + CW_BAR; b_.x = xb_xcc_id(); b_.st = F.MISC + 8; xcd_barrier(b_); } } while (0)

    { const int l_ = 0; STAMP(PH_P0); if (IN(PH_P0)) { REFRESH(); for (int rep = 0; rep < REPS(0); ++rep) p0_prologue(F, ap); } } SEAM(PH_P0);
    if (DBG_REP_CODE == 30 && hi - lo > 1) { for (int i = 0; i < 20; ++i) { XcdBarrier b_; b_.bar = (unsigned*)(ap->ws + WS_CTL) + CW_BAR; b_.x = xb_xcc_id(); b_.st = F.MISC + 8; xcd_barrier(b_); } }
    STAMP(PH_P1); if (IN(PH_P1)) { REFRESH();
        SchedBatch S{(const char*)(ws + SC_MEMN), (const char*)(ws + SC_WKVT), (char*)(ws + SC_KVB), (size_t)512 * DM * 2, (size_t)4096 * DM * 2, (size_t)512 * 4096 * 2, 2, 16, DEPTH, F.G, F.bid, DM, DM, 4096 * 2, 2, 512};
        { const int l_ = 0; for (int rep = 0; rep < REPS(1); ++rep) pg8::gemm_phase<pg8::EpiBf16, SchedBatch, false>(F.lds, pg8::GemmP{DM, DM, DM}, S, pg8::EpiBf16{4096}, F.wave); }
    } SEAM(PH_P1);
    STAMP(PH_P2); if (IN(PH_P2)) { REFRESH();
        { SchedXaPre S{ws, F.G, F.bid, 0}; pg8::gemm_phase<EpiBf16U, SchedXaPre, false>(F.lds, pg8::GemmP{512, 4096, DM}, S, EpiBf16U{}, F.wave); }
        { SchedXaPre S{ws, F.G, F.bid, 1}; pg8::gemm_phase<EpiBf16U, SchedXaPre, false>(F.lds, pg8::GemmP{512, DM, 4096}, S, EpiBf16U{}, F.wave); }
    } SEAM(PH_P2);

    for (int l = 0; l < DEPTH; ++l) {
        const int pb = PH_L0 + l * NPH_L; const int l_ = l;
        float* H = (float*)(ws + WS_H);
        STAMP(pb + LP_NORM1); if (IN(pb + LP_NORM1)) { REFRESH(); if (l == 0) { for (int rep = 0; rep < REPS(22); ++rep) norm_phase<0>(F, ap, args.in[I_X], args.in[I_NORM_MIX], l); } else norm_phase<1>(F, ap, H, args.in[I_NORM_MIX] + (size_t)l * DM, l); } SEAM(pb + LP_NORM1);
        STAMP(pb + LP_G1); if (IN(pb + LP_G1)) { REFRESH();
            SchedDense S{(const char*)(ws + WS_HN), (const char*)(ws + WS_WIN) + (size_t)l * ZLD * DM * 2, (char*)(ws + SC_Z), NTOK / 256, ZLD / 256, F.G, F.bid, DM, DM, ZLD * 2, 2};
            for (int rep = 0; rep < REPS(10); ++rep) pg8::gemm_phase<pg8::EpiBf16, SchedDense, false>(F.lds, pg8::GemmP{DM, DM, DM}, S, pg8::EpiBf16{ZLD}, F.wave);
        } SEAM(pb + LP_G1);
        STAMP(pb + LP_PREP); if (IN(pb + LP_PREP)) { REFRESH(); for (int rep = 0; rep < REPS(11); ++rep) prep_phase(F, ap, l, rep); } SEAM(pb + LP_PREP);
        STAMP(pb + LP_CPREP); if (IN(pb + LP_CPREP)) { REFRESH(); for (int rep = 0; rep < REPS(12); ++rep) cprep_phase(F, l); } SEAM(pb + LP_CPREP);
        STAMP(pb + LP_MIX); if (IN(pb + LP_MIX)) { REFRESH(); mix_phase<DBG_MIXMASK>(F, ap, l, 0); if (DBG_REP_CODE >= 13 && DBG_REP_CODE <= 16 && l_ == 0) { REFRESH(); mix_phase<(DBG_REP_CODE >= 13 && DBG_REP_CODE <= 16) ? (1 << (DBG_REP_CODE - 13)) : 1>(F, ap, l, 1); if (DBG_REP_N > 1) { REFRESH(); mix_phase<(DBG_REP_CODE >= 13 && DBG_REP_CODE <= 16) ? (1 << (DBG_REP_CODE - 13)) : 1>(F, ap, l, 2); } } } SEAM(pb + LP_MIX);
        STAMP(pb + LP_POST); if (IN(pb + LP_POST)) { REFRESH(); for (int rep = 0; rep < REPS(17); ++rep) post_phase(F, ap, l); } SEAM(pb + LP_POST);
        STAMP(pb + LP_G2); if (IN(pb + LP_G2)) { REFRESH();
            SchedDense S{(const char*)(ws + WS_MIX), (const char*)(ws + WS_WOUT) + (size_t)l * DM * DM * 2, (char*)H, NTOK / 256, DM / 256, F.G, F.bid, DM, DM, DM * 4, 4};
            for (int rep = 0; rep < REPS(23); ++rep) pg8::gemm_phase<pg8::EpiF32Res, SchedDense, false>(F.lds, pg8::GemmP{DM, DM, DM}, S, pg8::EpiF32Res{DM, l == 0 ? args.in[I_X] : (const float*)H, H}, F.wave);
        } SEAM(pb + LP_G2);
        STAMP(pb + LP_NORM2); if (IN(pb + LP_NORM2)) { REFRESH(); for (int rep = 0; rep < REPS(18); ++rep) norm_phase<0>(F, ap, H, args.in[I_NORM_CROSS] + (size_t)l * DM, l); } SEAM(pb + LP_NORM2);
        STAMP(pb + LP_GS); if (IN(pb + LP_GS)) { REFRESH();
            SchedBatch S{(const char*)(ws + WS_HN), (const char*)(ws + WS_WQK) + (size_t)l * 2 * 1024 * DM * 2, (char*)(ws + WS_P), (size_t)SEQ * DM * 2, (size_t)1024 * DM * 2, (size_t)SEQ * 1024 * 2, SEQ / 256, 4, BATCH, F.G, F.bid, DM, DM, 1024 * 2, 2, SEQ};
            for (int rep = 0; rep < REPS(19); ++rep) pg8::gemm_phase<pg8::EpiSoftmax, SchedBatch, false>(F.lds, pg8::GemmP{DM, DM, DM}, S, pg8::EpiSoftmax{1024, 0.044194173824159216f * 1.4426950408889634f}, F.wave);
        } SEAM(pb + LP_GS);
        STAMP(pb + LP_GO); if (IN(pb + LP_GO)) { REFRESH();
            SchedBatch S{(const char*)(ws + WS_P), (const char*)(ws + WS_VWO) + (size_t)l * 2 * DM * 1024 * 2, (char*)H, (size_t)SEQ * 1024 * 2, (size_t)DM * 1024 * 2, (size_t)SEQ * DM * 4, SEQ / 256, DM / 256, BATCH, F.G, F.bid, 1024, 1024, DM * 4, 4, SEQ};
            pg8::gemm_phase<pg8::EpiF32Res, SchedBatch, false>(F.lds, pg8::GemmP{1024, 1024, 1024}, S, pg8::EpiF32Res{DM, (const float*)H, H}, F.wave);
        } SEAM(pb + LP_GO);
        STAMP(pb + LP_NORM3); if (IN(pb + LP_NORM3)) { REFRESH(); norm_phase<2>(F, ap, H, args.in[I_NORM_MOE] + (size_t)l * DM, l); } SEAM(pb + LP_NORM3);
        STAMP(pb + LP_M1); if (IN(pb + LP_M1)) { REFRESH();
            volatile LAS int* tp = (volatile LAS int*)(F.lds + MISC_OFF + 256); volatile LAS int* cnt = tp + 40;
            moe_prefix(F, l, tp, cnt);
            SchedMoe S{ws, tp, cnt, l, F.G, F.bid, 0};
            for (int rep = 0; rep < REPS(20); ++rep) pg8::gemm_phase<pg8::EpiSwiGlu, SchedMoe, true>(F.lds, pg8::GemmP{DM, DM, DM}, S, pg8::EpiSwiGlu{DEXP}, F.wave);
        } SEAM(pb + LP_M1);
        STAMP(pb + LP_M2); if (IN(pb + LP_M2)) { REFRESH();
            volatile LAS int* tp = (volatile LAS int*)(F.lds + MISC_OFF + 256); volatile LAS int* cnt = tp + 40;
            moe_prefix(F, l, tp, cnt);
            SchedMoe S{ws, tp, cnt, l, F.G, F.bid, 1};
            for (int rep = 0; rep < REPS(21); ++rep) pg8::gemm_phase<pg8::EpiGate, SchedMoe, false>(F.lds, pg8::GemmP{DEXP, DEXP, DEXP}, S, pg8::EpiGate{DM, (const float*)(ws + WS_EGATE), nullptr}, F.wave);
        } SEAM(pb + LP_M2);
    }
#ifdef DBG_TIME_A
    STAMP(PH_FINAL);
    if (blockIdx.x == 0 && threadIdx.x == 0) { const unsigned long long ta = ((unsigned long long)F.MISC[193 + 2 * (DBG_TIME_A)] << 32) | F.MISC[192 + 2 * (DBG_TIME_A)], tb = ((unsigned long long)F.MISC[193 + 2 * (DBG_TIME_B)] << 32) | F.MISC[192 + 2 * (DBG_TIME_B)];
        const unsigned long long dl = (tb - ta) * DBG_TIME_K; const unsigned long long t0_ = wall_clock64(); while (wall_clock64() - t0_ < dl) __builtin_amdgcn_s_sleep(8); }
    if (hi - lo > 1) { XcdBarrier b_; b_.bar = (unsigned*)(ap->ws + WS_CTL) + CW_BAR; b_.x = xb_xcc_id(); b_.st = F.MISC + 8; xcd_barrier(b_); }
#endif
    STAMP(PH_FINAL); if (IN(PH_FINAL)) { REFRESH(); norm_phase<5>(F, ap, (const float*)(ws + WS_H), args.in[I_NORM_FINAL], DEPTH); }
#undef IN
#undef SEAM
#undef args
}

extern "C" void kernel_launch(void* const* d_in, const int* in_sizes, int n_in, void* d_out, int out_size, void* d_ws, size_t ws_size, hipStream_t stream) {
    static int grid = 0;
    if (grid == 0) {
        if (n_in != N_INPUTS || out_size != NTOK * DM || ws_size < cmax(WS_END, SC_MIX_END3)) { fprintf(stderr, "kernel_launch: built for %d inputs, out %d, ws >= %zu; got %d, %d, %zu\n", N_INPUTS, NTOK * DM, cmax(WS_END, SC_MIX_END3), n_in, out_size, ws_size); grid = -1; return; }
        int dev = 0, cus = 0, per_cu = 0;
        if (hipGetDevice(&dev) != hipSuccess || hipDeviceGetAttribute(&cus, hipDeviceAttributeMultiprocessorCount, dev) != hipSuccess) { fprintf(stderr, "kernel_launch: device query failed\n"); grid = -1; return; }
        if (hipFuncSetAttribute((const void*)enc_fwd, hipFuncAttributeMaxDynamicSharedMemorySize, LDS_BYTES) != hipSuccess) { fprintf(stderr, "kernel_launch: hipFuncSetAttribute failed\n"); grid = -1; return; }
        if (hipOccupancyMaxActiveBlocksPerMultiprocessor(&per_cu, (const void*)enc_fwd, 512, LDS_BYTES) != hipSuccess || per_cu < 1) fprintf(stderr, "kernel_launch: occupancy query says %d blocks per CU\n", per_cu);
        grid = cus;
    }
    if (grid < 0) return;
    hipMemsetAsync((char*)d_ws + WS_CTL, 0, CTL_BYTES, stream);
    Args a; memset(&a, 0, sizeof(a));
    for (int i = 0; i < N_INPUTS; ++i) a.in[i] = (const float*)d_in[i];
    a.out = (float*)d_out; a.ws = (unsigned char*)d_ws;
#if MK_FUSED
    a.ph_lo = 0; a.ph_hi = NPHASES;
    hipLaunchKernelGGL(enc_fwd, dim3(grid), dim3(512), LDS_BYTES, stream, a);
#else
    for (int p = 0; p < NPHASES; ++p) { a.ph_lo = p; a.ph_hi = p + 1; hipLaunchKernelGGL(enc_fwd, dim3(grid), dim3(512), LDS_BYTES, stream, a); }
#endif
    const hipError_t le = hipPeekAtLastError();
    if (le != hipSuccess) fprintf(stderr, "kernel_launch: launch failed: %s\n", hipGetErrorName(le));
}
```

```cpp
#include <hip/hip_runtime.h>
#include <cstdio>
#include <cstdint>
#include <cstring>

#define GAS __attribute__((address_space(1)))
#define LAS __attribute__((address_space(3)))
typedef unsigned short bf16;
typedef short bf16x8 __attribute__((ext_vector_type(8)));
typedef short s16x4 __attribute__((ext_vector_type(4)));
typedef float f32x2 __attribute__((ext_vector_type(2)));
typedef float f32x4 __attribute__((ext_vector_type(4)));
typedef float f32x16 __attribute__((ext_vector_type(16)));
typedef unsigned u32x2 __attribute__((ext_vector_type(2)));
typedef unsigned u32x4 __attribute__((ext_vector_type(4)));
typedef GAS unsigned gu32;

constexpr int DM = 2048, BATCH = 2, SEQ = 4096, NTOK = BATCH * SEQ, DEPTH = 2, NMEM = 256;
constexpr int IN_A = 1536, IN_B = 1920, IN_C = 1536, IN_D = 512, IN_TOTAL = 5504, ZLD = 5632;
constexpr int ZA = 0, ZB = 1536, ZC = 3456, ZD = 4992;
constexpr int NEXP = 32, DEXP = 512, ECAP = 8192;
constexpr int SLOT_CAP = 24576;
constexpr int S5CH = 16, S5NCH = SEQ / S5CH;
constexpr float RMS_EPS = 1e-6f;

enum { I_X = 0, I_MEM, I_NORM_MIX, I_W_IN, I_W_OUT, I_DIFF_LAMBDA, I_DIFF_SUBLN, I_RWKV_MU, I_RWKV_W0, I_RWKV_W2, I_RWKV_A0, I_RWKV_A2, I_RWKV_G2,
       I_RWKV_KK, I_RWKV_KA, I_RWKV_RK, I_RWKV_LNX_W, I_RWKV_LNX_B, I_S5_A_RE, I_S5_A_IM, I_S5_LOG_DT, I_S5_B_RE, I_S5_B_IM, I_S5_C_RE, I_S5_C_IM,
       I_S5_D, I_S5_GLU_W, I_S5_GLU_B, I_MIX_OUT_NORM, I_NORM_CROSS, I_NORM_MEM, I_XA_WQ, I_XA_WKV, I_XA_WO, I_NORM_MOE, I_ROUTER_GROUP,
       I_ROUTER_EXPERT, I_MOE_W1, I_MOE_W3, I_MOE_W2, I_NORM_FINAL, N_INPUTS };

constexpr size_t al256(size_t x) { return (x + 255) / 256 * 256; }
constexpr size_t WS_CTL = 0, CTL_BYTES = 1u << 20;
constexpr size_t WS_WIN  = WS_CTL + CTL_BYTES;
constexpr size_t WS_WOUT = WS_WIN + (size_t)DEPTH * ZLD * DM * 2;
constexpr size_t WS_WQK  = WS_WOUT + (size_t)DEPTH * DM * DM * 2;
constexpr size_t WS_VWO  = WS_WQK + (size_t)DEPTH * BATCH * 1024 * DM * 2;
constexpr size_t WS_W13  = WS_VWO + (size_t)DEPTH * BATCH * DM * 1024 * 2;
constexpr size_t WS_W2   = WS_W13 + (size_t)DEPTH * NEXP * 1024 * DM * 2;
constexpr size_t WS_ROPE = WS_W2 + (size_t)DEPTH * NEXP * DM * DEXP * 2;
constexpr size_t WS_S5P  = WS_ROPE + (size_t)SEQ * (32 + 32 + 64 + 64) * 4;
constexpr size_t S5P_LAYER = (size_t)(2 * 32 * 64 * 2 + 2 * 32 * 64 * 16 * 2 + 2 * 32 * 64 * 2) * 4;
constexpr size_t WS_LORA = al256(WS_S5P + DEPTH * S5P_LAYER);
constexpr size_t LORA_LAYER = (size_t)(2 * 512 * 64 * 2 + 512 * 128) * 2;
constexpr size_t WS_GLUT = al256(WS_LORA + DEPTH * LORA_LAYER);
constexpr size_t WS_S5CW = WS_GLUT + (size_t)DEPTH * 512 * 512 * 2;
constexpr size_t WS_RTE  = al256(WS_S5CW + (size_t)DEPTH * 32 * 16 * 128 * 2);
constexpr size_t WS_H    = al256(WS_RTE + (size_t)DEPTH * 4 * DM * 8 * 4);
constexpr size_t WS_HN   = WS_H + (size_t)NTOK * DM * 4;
constexpr size_t WS_MIX  = WS_HN + (size_t)NTOK * DM * 2;
constexpr size_t WS_P    = WS_MIX + (size_t)NTOK * DM * 2;
constexpr size_t WS_ETOK = WS_P + (size_t)NTOK * 1024 * 2;
constexpr size_t WS_EGATE= WS_ETOK + (size_t)NEXP * ECAP * 4;
constexpr size_t WS_TINFO= WS_EGATE + (size_t)NEXP * ECAP * 4;
constexpr size_t WS_SCR  = al256(WS_TINFO + (size_t)NTOK * 16);
constexpr size_t SC_WKVT = WS_SCR;
constexpr size_t SC_MEMN = SC_WKVT + (size_t)DEPTH * 4096 * DM * 2;
constexpr size_t SC_KVB  = SC_MEMN + (size_t)DEPTH * 512 * DM * 2;
constexpr size_t SC_WQB  = SC_KVB + (size_t)DEPTH * 512 * 4096 * 2;
constexpr size_t SC_WOT  = SC_WQB + (size_t)DEPTH * DM * DM * 2;
constexpr size_t SC_PRO_END = SC_WOT + (size_t)DEPTH * DM * DM * 2;
constexpr size_t SC_Z    = WS_SCR;
constexpr size_t SC_RW   = SC_Z + (size_t)NTOK * ZLD * 2;
constexpr size_t RWSZ    = (size_t)NTOK * 512 * 4;
constexpr size_t SC_YS   = SC_RW + 10 * RWSZ;
constexpr size_t SC_OC   = SC_YS + 2 * RWSZ;
constexpr size_t SC_LSE  = SC_OC + 3 * RWSZ;
constexpr size_t SC_CARRY= SC_LSE + (size_t)3 * NTOK * 4 * 4;
constexpr size_t SC_MIX_END = SC_CARRY + (size_t)2 * BATCH * S5NCH * 32 * 64 * 2 * 4;
constexpr size_t SC_HMID = WS_SCR;
constexpr size_t SC_YBUF = SC_HMID + (size_t)SLOT_CAP * DEXP * 2;
constexpr size_t SC_MOE_END = SC_YBUF + (size_t)SLOT_CAP * DM * 2;
constexpr size_t cmax(size_t a, size_t b) { return a > b ? a : b; }
constexpr size_t WS_END = cmax(cmax(SC_PRO_END, SC_MIX_END), SC_MOE_END);

constexpr int CW_BAR = 4096;
constexpr int CW_Q = 8192;
constexpr int CW_CNT = 16384;

constexpr int RING_BYTES = 131072;
constexpr int MISC_OFF = 147456 - 1024;
constexpr int LDS_BYTES = 147456;

__device__ __forceinline__ float bf2f(unsigned short b) { return __uint_as_float(((unsigned)b) << 16); }
typedef __bf16 bf16x2_t __attribute__((ext_vector_type(2)));
__device__ __forceinline__ unsigned pk2c(float lo, float hi) { bf16x2_t v = {(__bf16)lo, (__bf16)hi}; return __builtin_bit_cast(unsigned, v); }
__device__ __forceinline__ unsigned pk2(float lo, float hi) { unsigned r; asm volatile("v_cvt_pk_bf16_f32 %0, %1, %2" : "=v"(r) : "v"(lo), "v"(hi)); return r; }
__device__ __forceinline__ bf16 f2bf(float f) { return (bf16)(pk2(f, 0.f) & 0xffffu); }
template <int CTRL> __device__ __forceinline__ float dpp_mov(float v) { return __builtin_bit_cast(float, __builtin_amdgcn_update_dpp(0, __builtin_bit_cast(int, v), CTRL, 0xf, 0xf, true)); }
__device__ __forceinline__ float row_sum(float v) { v += dpp_mov<0xB1>(v); v += dpp_mov<0x4E>(v); v += dpp_mov<0x141>(v); v += dpp_mov<0x140>(v); return v; }
__device__ __forceinline__ float row_max(float v) { v = fmaxf(v, dpp_mov<0xB1>(v)); v = fmaxf(v, dpp_mov<0x4E>(v)); v = fmaxf(v, dpp_mov<0x141>(v)); v = fmaxf(v, dpp_mov<0x140>(v)); return v; }
__device__ __forceinline__ float rdlane(float v, int l) { return __builtin_bit_cast(float, __builtin_amdgcn_readlane(__builtin_bit_cast(int, v), l)); }
__device__ __forceinline__ float wave_sum(float v) { v = row_sum(v); return (rdlane(v, 0) + rdlane(v, 16)) + (rdlane(v, 32) + rdlane(v, 48)); }
__device__ __forceinline__ float wave_max(float v) { v = row_max(v); return fmaxf(fmaxf(rdlane(v, 0), rdlane(v, 16)), fmaxf(rdlane(v, 32), rdlane(v, 48))); }
__device__ __forceinline__ float sigmoidf_(float x) { return 1.f / (1.f + __expf(-x)); }
#define LDS_WAIT() asm volatile("s_waitcnt lgkmcnt(0)" ::: "memory")
#define VM_WAIT() asm volatile("s_waitcnt vmcnt(0)" ::: "memory")

__device__ __forceinline__ int tid_from_wave(int wave) { int ln; asm volatile("v_mbcnt_lo_u32_b32 %0, -1, 0\n\tv_mbcnt_hi_u32_b32 %0, -1, %0" : "=v"(ln)); return wave * 64 + ln; }

typedef __attribute__((address_space(8))) void* bufrsrc_t;
__device__ __forceinline__ __amdgpu_buffer_rsrc_t make_rsrc(const void* p, unsigned bytes) { return __builtin_amdgcn_make_buffer_rsrc((void*)p, 0, bytes, 0x00020000); }
__device__ __forceinline__ float bload_f32(__amdgpu_buffer_rsrc_t r, int voff, int soff) { return __builtin_bit_cast(float, __builtin_amdgcn_raw_buffer_load_b32(r, voff, soff, 0)); }

__device__ __forceinline__ float xor_lane(float v, int lane, int m) { return __builtin_bit_cast(float, __builtin_amdgcn_ds_bpermute((lane ^ m) << 2, __builtin_bit_cast(int, v))); }
#define XB_TMO      128
#define XB_XCNT(j)  (256  + 64 * (j))
#define XB_XSUB(j)  (1280 + 64 * (j))
#define XB_XGEN(j)  (2304 + 64 * (j))
#define XB_TOP      3328
#define XB_TOPGEN   3392
#define XCD_BAR_WORDS 3456
#define XB_SPIN_CAP (1u << 18)

__device__ __forceinline__ unsigned xb_ld(unsigned* p)              { return __hip_atomic_load(p, __ATOMIC_RELAXED, __HIP_MEMORY_SCOPE_AGENT); }
__device__ __forceinline__ unsigned xb_add(unsigned* p, unsigned v) { return __hip_atomic_fetch_add(p, v, __ATOMIC_RELAXED, __HIP_MEMORY_SCOPE_AGENT); }
__device__ __forceinline__ unsigned xb_xcc_id() { return (unsigned)__builtin_amdgcn_s_getreg((3 << 11) | 20) & 0xFu; }
#define XB_SPIN(cond, bar) do { unsigned _sp = 0; while (cond) { __builtin_amdgcn_s_sleep(1); \
    if ((++_sp & 255u) == 0u) { if (xb_ld(&(bar)[XB_TMO])) break; if (_sp > XB_SPIN_CAP) { atomicAdd(&(bar)[XB_TMO], 1u); break; } } } } while (0)

struct XcdBarrier {
    unsigned* bar; unsigned x;
    volatile LAS unsigned* st;
};

__device__ __forceinline__ XcdBarrier xcd_barrier_post(unsigned* bar, volatile LAS unsigned* st) {
    XcdBarrier b; b.bar = bar; b.x = xb_xcc_id(); b.st = st;
    if (threadIdx.x == 0) (void)xb_add(&bar[XB_XCNT(b.x)], 1u);
    return b;
}
__device__ __forceinline__ void xcd_barrier_complete(unsigned* bar, unsigned x, unsigned& nloc, unsigned& nx) {
    const unsigned G = gridDim.x * gridDim.y * gridDim.z;
    unsigned sum, cnt, mine, sp = 0u;
    for (;;) {
        sum = 0u; cnt = 0u; mine = 0u;
#pragma unroll
        for (unsigned j = 0; j < 16; ++j) { const unsigned c = xb_ld(&bar[XB_XCNT(j)]); sum += c; cnt += (c > 0u) ? 1u : 0u; mine = (j == x) ? c : mine; }
        if (sum == G) break;
        __builtin_amdgcn_s_sleep(1);
        if ((++sp & 255u) == 0u) { if (xb_ld(&bar[XB_TMO])) break; if (sp > XB_SPIN_CAP) { atomicAdd(&bar[XB_TMO], 1u); break; } }
    }
    nloc = mine > 0u ? mine : 1u; nx = cnt > 0u ? cnt : 1u;
}

__device__ __forceinline__ void xcd_barrier(const XcdBarrier& b) {
    asm volatile("s_waitcnt vmcnt(0)" ::: "memory");
    __syncthreads();
    if (threadIdx.x == 0) {
        unsigned* bar = b.bar;
        __builtin_amdgcn_s_waitcnt(0);
        unsigned nloc = b.st[0], nx = b.st[1];
        if (nloc == 0u) { xcd_barrier_complete(bar, b.x, nloc, nx); b.st[0] = nloc; b.st[1] = nx; }
        const unsigned old = xb_add(&bar[XB_XSUB(b.x)], 1u);
        const unsigned gen = old / nloc;
        if (old + 1u == (gen + 1u) * nloc) {
            __builtin_amdgcn_fence(__ATOMIC_RELEASE, "agent");
            asm volatile("s_waitcnt vmcnt(0)" ::: "memory");
            const unsigned og = xb_add(&bar[XB_TOP], 1u);
            const unsigned tg = og / nx;
            if (og + 1u == (tg + 1u) * nx) xb_add(&bar[XB_TOPGEN], 1u);
            else XB_SPIN(xb_ld(&bar[XB_TOPGEN]) == tg, bar);
            __builtin_amdgcn_fence(__ATOMIC_ACQUIRE, "agent");
            xb_add(&bar[XB_XGEN(b.x)], 1u);
            asm volatile("s_waitcnt vmcnt(0)" ::: "memory");
        } else {
            XB_SPIN(xb_ld(&bar[XB_XGEN(b.x)]) == gen, bar);
            __builtin_amdgcn_fence(__ATOMIC_ACQUIRE, "agent");
            asm volatile("s_waitcnt vmcnt(0)" ::: "memory");
        }
    }
    __syncthreads();
}


namespace pg8 {
constexpr int BM = 256, BK = 64, HALF = 128, HTB = HALF * BK * 2, STAGE_BYTES = 8 * HTB, NXCD = 8, WGM = 8;
__host__ __device__ __forceinline__ int lds_byte(int r, int c) { const int st = (r >> 4) * 2 + (c >> 5), rr = r & 15, cc = c & 31, ob = rr * 64 + cc * 2; return st * 1024 + (ob ^ (((ob >> 9) & 1) << 5)); }
__host__ __device__ __forceinline__ void stage_rc(int b, int& R, int& C) { const int st = b / 1024, sb = b % 1024, swz = sb ^ (((sb >> 9) & 1) << 5); R = (st >> 1) * 16 + swz / 64; C = (st & 1) * 32 + (swz % 64) / 2; }
__host__ __device__ __forceinline__ int perm32(int rho) { const int n = rho >> 4, i = rho & 15; return 8 * (i >> 2) + 4 * n + (i & 3); }

struct Unit { const char* A; const char* B; char* C; int row0, col0, aux; };
struct GemmP { int K, lda, ldb; };

__device__ __forceinline__ void xcd_tile(int L, int nM, int nN, int& pm, int& pn) {
    const int nwg = nM * nN; int wgid = L;
    { const int q = nwg / NXCD, r = nwg % NXCD, xcd = wgid % NXCD, off = wgid / NXCD; wgid = (xcd < r ? xcd * (q + 1) : r * (q + 1) + (xcd - r) * q) + off; }
    const int nig = WGM * nN, gid = wgid / nig, fm = gid * WGM, gsz = (nM - fm) < WGM ? (nM - fm) : WGM;
    pm = fm + ((wgid % nig) % gsz); pn = (wgid % nig) / gsz;
}

typedef f32x4 Acc[2][2][4][2];

template <class Epi, class Sched, bool GATHER>
__device__ __forceinline__ void gemm_phase(LAS unsigned char* lds, const GemmP g, const Sched& S, const Epi& E, const int wave_id) {
    const int tid = tid_from_wave(wave_id), wid = __builtin_amdgcn_readfirstlane(tid >> 6), lane = tid & 63, wr = wid >> 2, wc = wid & 3, fr = lane & 15, fq = lane >> 4;
    const int K = g.K, nt = K / BK;
    int Rr[2], Cc[2]; unsigned voffB[2];
#pragma unroll
    for (int i = 0; i < 2; ++i) { int R, C; stage_rc(tid * 16 + i * 8192, R, C); const int Rb = Epi::PERM ? ((R & ~31) + perm32(R & 31)) : R;
        Rr[i] = R; Cc[i] = C; voffB[i] = (unsigned)(Rb * g.ldb + C) * 2u; }
    const size_t kstep = (size_t)(BK * 2);
    const size_t hstepB = (size_t)HALF * g.ldb * 2;
    const unsigned ldsw = (unsigned)wid * 1024u;
    const int aoff = lds_byte(wr * 64 + fr, fq * 8), boff = lds_byte(wc * 32 + fr, fq * 8);
#define PG8_SA(b, h) (((b) * 2 + (h)) * HTB)
#define PG8_SB(b, h) ((4 + (b) * 2 + (h)) * HTB)
#define PG8_STAGE_B(bufoff, gbase) do { _Pragma("unroll") for (int _i = 0; _i < 2; ++_i) \
        __builtin_amdgcn_global_load_lds((const unsigned*)((const char*)(gbase) + voffB[_i]), (LAS unsigned*)(lds + (bufoff) + ldsw + _i * 8192), 16, 0, 0); } while (0)
#define PG8_STAGE_A(bufoff, gbase, OFF, h) do { _Pragma("unroll") for (int _i = 0; _i < 2; ++_i) \
        __builtin_amdgcn_global_load_lds((const unsigned*)((const char*)(gbase) + (OFF)[h][_i]), (LAS unsigned*)(lds + (bufoff) + ldsw + _i * 8192), 16, 0, 0); } while (0)
#define PG8_OFFS(u, OFF) do { _Pragma("unroll") for (int _h = 0; _h < 2; ++_h) _Pragma("unroll") for (int _i = 0; _i < 2; ++_i) { \
        const int _row = _h * HALF + Rr[_i]; const int _src = GATHER ? S.arow((u), _row) : _row; (OFF)[_h][_i] = (unsigned)(_src * g.lda + Cc[_i]) * 2u; } } while (0)
#define PG8_LDA(dst, b, h) do { _Pragma("unroll") for (int m = 0; m < 4; ++m) _Pragma("unroll") for (int k = 0; k < 2; ++k) dst[m][k] = *(const LAS bf16x8*)(lds + PG8_SA(b, h) + aoff + m * 2048 + k * 1024); } while (0)
#define PG8_LDB(dst, b, h) do { _Pragma("unroll") for (int n = 0; n < 2; ++n) _Pragma("unroll") for (int k = 0; k < 2; ++k) dst[n][k] = *(const LAS bf16x8*)(lds + PG8_SB(b, h) + boff + n * 2048 + k * 1024); } while (0)
#define PG8_MMA(ai, bj, At, Bt) do { __builtin_amdgcn_s_setprio(1); _Pragma("unroll") for (int m = 0; m < 4; ++m) _Pragma("unroll") for (int n = 0; n < 2; ++n) _Pragma("unroll") for (int k = 0; k < 2; ++k) \
        acc[ai][bj][m][n] = __builtin_amdgcn_mfma_f32_16x16x32_bf16(Bt[n][k], At[m][k], acc[ai][bj][m][n], 0, 0, 0); __builtin_amdgcn_s_setprio(0); } while (0)
#define PG8_WAIT_V(n) asm volatile("s_waitcnt vmcnt(" #n ")" ::: "memory")
#define PG8_WAIT_L(n) asm volatile("s_waitcnt lgkmcnt(" #n ")" ::: "memory")
#define PG8_BAR __builtin_amdgcn_s_barrier()
#define PG8_SCHED __builtin_amdgcn_sched_barrier(0)
    Unit cur, nxt; int ui = 0;
    if (!S.next(0, cur)) return;
    f32x4 acc[2][2][4][2];
#pragma unroll
    for (int a = 0; a < 2; ++a)
#pragma unroll
        for (int b = 0; b < 2; ++b)
#pragma unroll
            for (int m = 0; m < 4; ++m)
#pragma unroll
                for (int n = 0; n < 2; ++n) acc[a][b][m][n] = (f32x4){0.f, 0.f, 0.f, 0.f};
    bf16x8 At[4][2], B0[2][2], B1[2][2];
    const char* cA = cur.A; const char* cB = cur.B;
    unsigned coffA[2][2], noffA[2][2];
    PG8_OFFS(cur, coffA);
    PG8_STAGE_B(PG8_SB(0, 0), cB); PG8_STAGE_A(PG8_SA(0, 0), cA, coffA, 0); PG8_STAGE_B(PG8_SB(0, 1), cB + hstepB); PG8_STAGE_A(PG8_SA(0, 1), cA, coffA, 1);
    if (wr == 1) PG8_BAR;
    PG8_WAIT_V(4); PG8_BAR;
    PG8_STAGE_B(PG8_SB(1, 0), cB + kstep); PG8_STAGE_A(PG8_SA(1, 0), cA + kstep, coffA, 0); PG8_STAGE_B(PG8_SB(1, 1), cB + hstepB + kstep);
    PG8_WAIT_V(6); PG8_BAR;
    for (;;) {
        const bool has_next = S.next(ui + 1, nxt);
        const char* nA = has_next ? nxt.A : cA; const char* nB = has_next ? nxt.B : cB;
        if (has_next) { PG8_OFFS(nxt, noffA); }
        else {
#pragma unroll
            for (int _h = 0; _h < 2; ++_h)
#pragma unroll
                for (int _i = 0; _i < 2; ++_i) noffA[_h][_i] = coffA[_h][_i]; }
        for (int t = 0; t < nt; t += 2) {
            const bool last = (t == nt - 2);
            const char* a1 = cA + (size_t)(t + 1) * kstep;
            const char* a2 = last ? nA : cA + (size_t)(t + 2) * kstep; const char* b2 = last ? nB : cB + (size_t)(t + 2) * kstep;
            const char* a3 = a2 + kstep; const char* b3 = b2 + kstep;
            unsigned o2[2][2];
#pragma unroll
            for (int _h = 0; _h < 2; ++_h)
#pragma unroll
                for (int _i = 0; _i < 2; ++_i) o2[_h][_i] = last ? noffA[_h][_i] : coffA[_h][_i];
            PG8_LDB(B0, 0, 0); PG8_SCHED; PG8_LDA(At, 0, 0); PG8_STAGE_A(PG8_SA(1, 1), a1, coffA, 1);
            PG8_WAIT_L(8); PG8_BAR; PG8_WAIT_L(0); PG8_MMA(0, 0, At, B0); PG8_BAR; PG8_SCHED;
            PG8_LDB(B1, 0, 1); PG8_STAGE_B(PG8_SB(0, 0), b2);
            PG8_BAR; PG8_WAIT_L(0); PG8_MMA(0, 1, At, B1); PG8_BAR;
            PG8_LDA(At, 0, 1); PG8_STAGE_A(PG8_SA(0, 0), a2, o2, 0);
            PG8_BAR; PG8_WAIT_L(0); PG8_MMA(1, 0, At, B0); PG8_BAR; PG8_SCHED;
            PG8_STAGE_B(PG8_SB(0, 1), b2 + hstepB);
            PG8_WAIT_V(6); PG8_BAR; PG8_MMA(1, 1, At, B1); PG8_BAR;
            PG8_LDB(B0, 1, 0); PG8_SCHED; PG8_LDA(At, 1, 0); PG8_STAGE_A(PG8_SA(0, 1), a2, o2, 1);
            PG8_WAIT_L(8); PG8_BAR; PG8_WAIT_L(0); PG8_MMA(0, 0, At, B0); PG8_BAR; PG8_SCHED;
            PG8_LDB(B1, 1, 1); PG8_STAGE_B(PG8_SB(1, 0), b3);
            PG8_BAR; PG8_WAIT_L(0); PG8_MMA(0, 1, At, B1); PG8_BAR;
            PG8_LDA(At, 1, 1); PG8_STAGE_A(PG8_SA(1, 0), a3, o2, 0);
            PG8_BAR; PG8_WAIT_L(0); PG8_MMA(1, 0, At, B0); PG8_BAR; PG8_SCHED;
            PG8_STAGE_B(PG8_SB(1, 1), b3 + hstepB);
            PG8_WAIT_V(6); PG8_BAR; PG8_MMA(1, 1, At, B1); PG8_BAR;
        }
        if constexpr (!Epi::AFTER_DRAIN) { E(acc, cur, wr, wc, fr, fq); }
        if (!has_next) break;
#pragma unroll
        for (int a = 0; a < 2; ++a)
#pragma unroll
            for (int b = 0; b < 2; ++b)
#pragma unroll
                for (int m = 0; m < 4; ++m)
#pragma unroll
                    for (int n = 0; n < 2; ++n) acc[a][b][m][n] = (f32x4){0.f, 0.f, 0.f, 0.f};
        cur = nxt; cA = nA; cB = nB; ++ui;
#pragma unroll
        for (int _h = 0; _h < 2; ++_h)
#pragma unroll
            for (int _i = 0; _i < 2; ++_i) coffA[_h][_i] = noffA[_h][_i];
    }
    PG8_WAIT_V(0);
    if (wr == 0) PG8_BAR;
    PG8_BAR;
    if constexpr (Epi::AFTER_DRAIN) { E.fused(acc, cur, wr, wc, fr, fq, lds, wid, lane); }
#undef PG8_SA
#undef PG8_SB
#undef PG8_STAGE_A
#undef PG8_STAGE_B
#undef PG8_OFFS
#undef PG8_LDA
#undef PG8_LDB
#undef PG8_MMA
#undef PG8_WAIT_V
#undef PG8_WAIT_L
#undef PG8_BAR
#undef PG8_SCHED
}

struct EpiBf16 {
    static constexpr bool PERM = true, AFTER_DRAIN = false;
    int ldc;
    __device__ __forceinline__ void operator()(const Acc& acc, const Unit& u, int wr, int wc, int fr, int fq) const {
        bf16* base = (bf16*)u.C + (size_t)(wr * 64 + fr) * ldc + wc * 32 + 8 * fq;
#pragma unroll
        for (int ai = 0; ai < 2; ++ai)
#pragma unroll
            for (int m = 0; m < 4; ++m) { bf16* rowp = base + (size_t)(ai * HALF + m * 16) * ldc;
#pragma unroll
                for (int bj = 0; bj < 2; ++bj) { const f32x4 v0 = acc[ai][bj][m][0], v1 = acc[ai][bj][m][1];
                    u32x4 w; w.x = pk2(v0[0], v0[1]); w.y = pk2(v0[2], v0[3]); w.z = pk2(v1[0], v1[1]); w.w = pk2(v1[2], v1[3]);
                    *(u32x4*)(rowp + bj * HALF) = w; } }
    }
};
struct EpiF32Res {
    static constexpr bool PERM = false, AFTER_DRAIN = false;
    int ldc; const float* resid; float* out;
    __device__ __forceinline__ void operator()(const Acc& acc, const Unit& u, int wr, int wc, int fr, int fq) const {
        const size_t o0 = (size_t)(u.row0 + wr * 64 + fr) * ldc + u.col0 + wc * 32 + 4 * fq;
#pragma unroll
        for (int ai = 0; ai < 2; ++ai)
#pragma unroll
            for (int m = 0; m < 4; ++m) { const size_t ro = o0 + (size_t)(ai * HALF + m * 16) * ldc;
#pragma unroll
                for (int bj = 0; bj < 2; ++bj)
#pragma unroll
                    for (int n = 0; n < 2; ++n) { const size_t o = ro + bj * HALF + n * 16; const f32x4 b = *(const f32x4*)(resid + o); *(f32x4*)(out + o) = acc[ai][bj][m][n] + b; } }
    }
};
struct EpiSwiGlu {
    static constexpr bool PERM = true, AFTER_DRAIN = false;
    int ldc;
    __device__ __forceinline__ void operator()(const Acc& acc, const Unit& u, int wr, int wc, int fr, int fq) const {
        bf16* base = (bf16*)u.C + (size_t)(wr * 64 + fr) * ldc + wc * 32 + 8 * fq;
#pragma unroll
        for (int ai = 0; ai < 2; ++ai)
#pragma unroll
            for (int m = 0; m < 4; ++m) { bf16* rowp = base + (size_t)(ai * HALF + m * 16) * ldc;
                float h[8];
#pragma unroll
                for (int n = 0; n < 2; ++n)
#pragma unroll
                    for (int e = 0; e < 4; ++e) { const float a = acc[ai][0][m][n][e], b = acc[ai][1][m][n][e]; h[n * 4 + e] = a / (1.f + __expf(-a)) * b; }
                u32x4 w; w.x = pk2(h[0], h[1]); w.y = pk2(h[2], h[3]); w.z = pk2(h[4], h[5]); w.w = pk2(h[6], h[7]);
                *(u32x4*)rowp = w; }
    }
};
struct EpiGate {
    static constexpr bool PERM = true, AFTER_DRAIN = false;
    int ldc; const float* egate; const int* cnt_lds_unused;
    __device__ __forceinline__ void operator()(const Acc& acc, const Unit& u, int wr, int wc, int fr, int fq) const {
        bf16* base = (bf16*)u.C + (size_t)(wr * 64 + fr) * ldc + wc * 32 + 8 * fq;
        const int e = u.aux >> 16, nvalid = u.aux & 0xffff;
        const float* gp = egate + (size_t)e * ECAP + u.row0;
#pragma unroll
        for (int ai = 0; ai < 2; ++ai)
#pragma unroll
            for (int m = 0; m < 4; ++m) { const int r = ai * HALF + wr * 64 + m * 16 + fr; const float gt = (r < nvalid) ? gp[r] : 0.f;
                bf16* rowp = base + (size_t)(ai * HALF + m * 16) * ldc;
#pragma unroll
                for (int bj = 0; bj < 2; ++bj) { const f32x4 v0 = acc[ai][bj][m][0] * gt, v1 = acc[ai][bj][m][1] * gt;
                    u32x4 w; w.x = pk2(v0[0], v0[1]); w.y = pk2(v0[2], v0[3]); w.z = pk2(v1[0], v1[1]); w.w = pk2(v1[2], v1[3]);
                    *(u32x4*)(rowp + bj * HALF) = w; } }
    }
};
struct EpiSoftmax {
    static constexpr bool PERM = true, AFTER_DRAIN = true;
    int ldc; float scale_log2e;
    __device__ __forceinline__ void operator()(const Acc&, const Unit&, int, int, int, int) const {}
    __device__ __forceinline__ void fused(const Acc& acc, const Unit& u, int wr, int wc, int fr, int fq, LAS unsigned char* lds, int wid, int lane) const {
        LAS float* RM = (LAS float*)lds;
        LAS float* RS = (LAS float*)(lds + 4096);
        float mx[2][4];
#pragma unroll
        for (int ai = 0; ai < 2; ++ai)
#pragma unroll
            for (int m = 0; m < 4; ++m) { float v = -3.0e38f;
#pragma unroll
                for (int bj = 0; bj < 2; ++bj)
#pragma unroll
                    for (int n = 0; n < 2; ++n) { const f32x4 x = acc[ai][bj][m][n]; v = fmaxf(v, fmaxf(fmaxf(x[0], x[1]), fmaxf(x[2], x[3]))); }
                v = fmaxf(v, xor_lane(v, lane, 16)); v = fmaxf(v, xor_lane(v, lane, 32));
                if (fq == 0) RM[(ai * HALF + wr * 64 + m * 16 + fr) * 4 + wc] = v; }
        asm volatile("s_waitcnt lgkmcnt(0)" ::: "memory"); __builtin_amdgcn_s_barrier(); asm volatile("" ::: "memory");
#pragma unroll
        for (int ai = 0; ai < 2; ++ai)
#pragma unroll
            for (int m = 0; m < 4; ++m) { const int row = ai * HALF + wr * 64 + m * 16 + fr; const f32x4 q = *(const LAS f32x4*)(RM + row * 4);
                const float M = fmaxf(fmaxf(q[0], q[1]), fmaxf(q[2], q[3])); const float mc = -M * scale_log2e; float s = 0.f;
#pragma unroll
                for (int bj = 0; bj < 2; ++bj)
#pragma unroll
                    for (int n = 0; n < 2; ++n)
#pragma unroll
                        for (int e = 0; e < 4; ++e) s += __builtin_amdgcn_exp2f(fmaf(acc[ai][bj][m][n][e], scale_log2e, mc));
                s += xor_lane(s, lane, 16); s += xor_lane(s, lane, 32);
                if (fq == 0) RS[row * 4 + wc] = s; }
        asm volatile("s_waitcnt lgkmcnt(0)" ::: "memory"); __builtin_amdgcn_s_barrier(); asm volatile("" ::: "memory");
        bf16* base = (bf16*)u.C + (size_t)(wr * 64 + fr) * ldc + wc * 32 + 8 * fq;
#pragma unroll
        for (int ai = 0; ai < 2; ++ai)
#pragma unroll
            for (int m = 0; m < 4; ++m) { const int row = ai * HALF + wr * 64 + m * 16 + fr; const f32x4 q = *(const LAS f32x4*)(RS + row * 4); const f32x4 qm = *(const LAS f32x4*)(RM + row * 4);
                const float M = fmaxf(fmaxf(qm[0], qm[1]), fmaxf(qm[2], qm[3])); const float mc = -M * scale_log2e;
                const float inv = 1.f / ((q[0] + q[1]) + (q[2] + q[3])); bf16* rowp = base + (size_t)(ai * HALF + m * 16) * ldc;
#pragma unroll
                for (int bj = 0; bj < 2; ++bj) { float pp[8];
#pragma unroll
                    for (int n = 0; n < 2; ++n)
#pragma unroll
                        for (int e = 0; e < 4; ++e) pp[n * 4 + e] = __builtin_amdgcn_exp2f(fmaf(acc[ai][bj][m][n][e], scale_log2e, mc)) * inv;
                    u32x4 w; w.x = pk2(pp[0], pp[1]); w.y = pk2(pp[2], pp[3]); w.z = pk2(pp[4], pp[5]); w.w = pk2(pp[6], pp[7]);
                    *(u32x4*)(rowp + bj * HALF) = w; } }
        asm volatile("s_waitcnt lgkmcnt(0)" ::: "memory"); __builtin_amdgcn_s_barrier(); asm volatile("" ::: "memory");
    }
};
}

namespace att {
constexpr int KVBLK = 64;
constexpr size_t SHM_V = KVBLK * 128 * 2, SHM_K = KVBLK * 128 * 2;
#define KSWZ(row, colB) ((row) * 256 + ((colB) ^ (((row) & 7) << 4)))
#define SBAR() __builtin_amdgcn_sched_barrier(0)
__device__ __forceinline__ int crow(int r, int hi) { return (r & 3) + 8 * (r >> 2) + 4 * hi; }
__device__ __forceinline__ bf16x8 ld8(const bf16* p) { return *reinterpret_cast<const bf16x8*>(p); }

__device__ __forceinline__ void partialSM(f32x16& p0, f32x16& p1, float& m_reg, float& mn, float& alpha, const float SCALE, const float THR) {
  const float C = SCALE * 1.4426950408889634f;
  float pmax = p0[0];
#pragma unroll
  for (int r = 1; r < 16; ++r) pmax = fmaxf(pmax, p0[r]);
#pragma unroll
  for (int r = 0; r < 16; ++r) pmax = fmaxf(pmax, p1[r]);
  { auto rr = __builtin_amdgcn_permlane32_swap(__float_as_uint(pmax), __float_as_uint(pmax), false, false);
    pmax = fmaxf(__uint_as_float(rr[0]), __uint_as_float(rr[1])); }
  if (__builtin_expect(__all(pmax - m_reg <= THR / SCALE), 1)) { mn = m_reg; alpha = 1.f; }
  else { mn = fmaxf(m_reg, pmax); alpha = __builtin_amdgcn_exp2f((m_reg - mn) * C); m_reg = mn; }
  const float mnC = -mn * C;
#pragma unroll
  for (int r = 0; r < 16; ++r) p0[r] = fmaf(p0[r], C, mnC);
#pragma unroll
  for (int r = 0; r < 16; ++r) p1[r] = fmaf(p1[r], C, mnC);
#pragma unroll
  for (int r = 0; r < 16; ++r) p0[r] = __builtin_amdgcn_exp2f(p0[r]);
}
__device__ __forceinline__ void finishSM(f32x16& p0, f32x16& p1, float alpha, float& l_reg, bf16x8& pa0, bf16x8& pa1, bf16x8& pa2, bf16x8& pa3) {
#pragma unroll
  for (int r = 0; r < 16; ++r) p1[r] = __builtin_amdgcn_exp2f(p1[r]);
  float ps = 0;
#pragma unroll
  for (int r = 0; r < 16; ++r) ps += p0[r];
#pragma unroll
  for (int r = 0; r < 16; ++r) ps += p1[r];
  { auto rr = __builtin_amdgcn_permlane32_swap(__float_as_uint(ps), __float_as_uint(ps), false, false);
    ps = __uint_as_float(rr[0]) + __uint_as_float(rr[1]); }
  l_reg = l_reg * alpha + ps;
#define PK4(P, BASE, OUT) do { unsigned a0 = pk2(P[BASE + 0], P[BASE + 1]), a1 = pk2(P[BASE + 2], P[BASE + 3]);   \
    unsigned b0 = pk2(P[BASE + 4], P[BASE + 5]), b1 = pk2(P[BASE + 6], P[BASE + 7]);                              \
    auto r0 = __builtin_amdgcn_permlane32_swap(a0, b0, false, false); auto r1 = __builtin_amdgcn_permlane32_swap(a1, b1, false, false); \
    u32x4 w = {r0[0], r1[0], r0[1], r1[1]}; OUT = *reinterpret_cast<bf16x8*>(&w); } while (0)
  PK4(p0, 0, pa0); PK4(p0, 8, pa1); PK4(p1, 0, pa2); PK4(p1, 8, pa3);
#undef PK4
}
template <int ND0> __device__ __forceinline__ void qkt(f32x16& p0, f32x16& p1, const char* Ks, const bf16x8* qr, int r32, int hi, int c0) {
  p0 = f32x16{}; p1 = f32x16{};
#pragma unroll
  for (int d0 = 0; d0 < ND0; ++d0) { const int cb = (c0 + d0 * 16 + hi * 8) * 2;
    const bf16x8 b0 = *reinterpret_cast<const bf16x8*>(Ks + KSWZ(r32, cb));
    const bf16x8 b1 = *reinterpret_cast<const bf16x8*>(Ks + KSWZ(32 + r32, cb));
    p0 = __builtin_amdgcn_mfma_f32_32x32x16_bf16(b0, qr[d0], p0, 0, 0, 0);
    p1 = __builtin_amdgcn_mfma_f32_32x32x16_bf16(b1, qr[d0], p1, 0, 0, 0); }
}
__device__ __forceinline__ int v_st(int k, int c) { const int kk = (k & ~0xC) | ((k & 4) << 1) | ((k & 8) >> 1); return ((kk >> 3) * 4 + (c >> 5)) * 512 + ((kk & 7) * 32 + (c & 31)) * 2; }
__device__ __forceinline__ int v_rd_base(int lane) { return ((lane & 3) << 3) | (((lane >> 2) & 3) << 6) | (((lane >> 4) & 1) << 5) | (((lane >> 5) & 1) << 8); }
constexpr int v_rd_off(int d0, int ks, int half) { return d0 * 512 + ks * 4096 + half * 2048; }
template <int OFF> __device__ __forceinline__ s16x4 tr_read(int vb) {
  s16x4 r; asm volatile("ds_read_b64_tr_b16 %0, %1 offset:%2" : "=&v"(r) : "v"(vb), "i"(OFF) : "memory"); return r;
}
template <int D0> __device__ __forceinline__ void pv_one(f32x16& od, int vb, bf16x8 pa0, bf16x8 pa1, bf16x8 pa2, bf16x8 pa3) {
  const s16x4 l0 = tr_read<v_rd_off(D0, 0, 0)>(vb), h0 = tr_read<v_rd_off(D0, 0, 1)>(vb), l1 = tr_read<v_rd_off(D0, 1, 0)>(vb), h1 = tr_read<v_rd_off(D0, 1, 1)>(vb);
  const s16x4 l2 = tr_read<v_rd_off(D0, 2, 0)>(vb), h2 = tr_read<v_rd_off(D0, 2, 1)>(vb), l3 = tr_read<v_rd_off(D0, 3, 0)>(vb), h3 = tr_read<v_rd_off(D0, 3, 1)>(vb);
  asm volatile("s_waitcnt lgkmcnt(0)" ::: "memory"); SBAR();
#define PK(L, H) (bf16x8){L[0], L[1], L[2], L[3], H[0], H[1], H[2], H[3]}
  od = __builtin_amdgcn_mfma_f32_32x32x16_bf16(pa0, PK(l0, h0), od, 0, 0, 0);
  od = __builtin_amdgcn_mfma_f32_32x32x16_bf16(pa1, PK(l1, h1), od, 0, 0, 0);
  od = __builtin_amdgcn_mfma_f32_32x32x16_bf16(pa2, PK(l2, h2), od, 0, 0, 0);
  od = __builtin_amdgcn_mfma_f32_32x32x16_bf16(pa3, PK(l3, h3), od, 0, 0, 0);
#undef PK
}
__device__ __forceinline__ void pv_d0(f32x16* o, int vb, bf16x8 pa0, bf16x8 pa1, bf16x8 pa2, bf16x8 pa3) {
  pv_one<0>(o[0], vb, pa0, pa1, pa2, pa3); pv_one<1>(o[1], vb, pa0, pa1, pa2, pa3); pv_one<2>(o[2], vb, pa0, pa1, pa2, pa3); pv_one<3>(o[3], vb, pa0, pa1, pa2, pa3);
}

__device__ __forceinline__ void diff_attn_unit(const bf16* Qb, const bf16* Kh, const bf16* Vh, int ld, int seq, bf16* outb, int ldo,
                                               const float lam, const float post_scale, const float* subln_g, char* lds, const int wave_id) {
  constexpr float SCALE = 0.125f, THR = 8.f;
  const int tid = tid_from_wave(wave_id), wid = __builtin_amdgcn_readfirstlane(tid >> 6), lane = tid & 63, r32 = lane & 31, hi = lane >> 5;
  const int csel = wid >> 2, wq = wid & 3;
  char* V_lds = lds; char* K_lds = lds + 2 * SHM_V;
  float* ws = (float*)(lds + 2 * SHM_V + 2 * SHM_K) + wid * 64; float* li_l = ws; float* al_l = ws + 32;
  float m_reg = -1e30f, l_reg = 0; f32x16 o[4] = {}; bf16x8 qr[4];
  const bf16* Qw = Qb + (long)(wq * 32 + r32) * ld + csel * 64 + hi * 8;
#pragma unroll
  for (int d0 = 0; d0 < 4; ++d0) qr[d0] = ld8(Qw + d0 * 16);
  const int sr = tid >> 4, sc = (tid & 15) * 8, vst0 = v_st(sr, sc), vst1 = v_st(32 + sr, sc);
  const int vb0 = (int)(uintptr_t)V_lds + v_rd_base(lane);
  const int kc0 = csel * 64;
  struct { bf16x8 vs0, vs1, ks0, ks1; } sr_[2];
#define SLOAD(i, k0) do { sr_[i].vs0 = ld8(&Vh[(long)((k0) + sr) * ld + sc]); sr_[i].vs1 = ld8(&Vh[(long)((k0) + 32 + sr) * ld + sc]); \
    sr_[i].ks0 = ld8(&Kh[(long)((k0) + sr) * ld + sc]); sr_[i].ks1 = ld8(&Kh[(long)((k0) + 32 + sr) * ld + sc]); } while (0)
#define SWRITE(b, i) do { *(bf16x8*)(V_lds + (b) * SHM_V + vst0) = sr_[i].vs0;          \
    *(bf16x8*)(V_lds + (b) * SHM_V + vst1) = sr_[i].vs1; const int kc = sc * 2;               \
    *(bf16x8*)(K_lds + (b) * SHM_K + KSWZ(sr, kc)) = sr_[i].ks0;                       \
    *(bf16x8*)(K_lds + (b) * SHM_K + KSWZ(32 + sr, kc)) = sr_[i].ks1; } while (0)
#define SWAIT() asm volatile("s_waitcnt vmcnt(4)" ::: "memory")
#define RESC(a) do { if (__any((a) < 1.f)) { if (hi == 0) al_l[r32] = (a); asm volatile("s_waitcnt lgkmcnt(0)" ::: "memory"); \
    _Pragma("unroll") for (int d = 0; d < 4; ++d) _Pragma("unroll") for (int r = 0; r < 16; ++r) o[d][r] *= al_l[crow(r, hi)]; } } while (0)
  f32x16 pA0, pA1, pB0, pB1; float mnA, mnB, alA, alB; bf16x8 pa0, pa1, pa2, pa3; const int NT = seq / KVBLK;
  constexpr int SE = 0, SO = 1;
  __syncthreads();
  SLOAD(SE, 0); asm volatile("s_waitcnt vmcnt(0)" ::: "memory"); SWRITE(0, SE); __syncthreads();
  qkt<4>(pA0, pA1, K_lds, qr, r32, hi, kc0); partialSM(pA0, pA1, m_reg, mnA, alA, SCALE, THR);
  SLOAD(SO, KVBLK); if (2 < NT) SLOAD(SE, 2 * KVBLK);
  SWAIT(); SWRITE(1, SO); __syncthreads();
  for (int j = 1; j + 1 < NT; j += 2) {
    SBAR(); qkt<4>(pB0, pB1, K_lds + SHM_K, qr, r32, hi, kc0);
    finishSM(pA0, pA1, alA, l_reg, pa0, pa1, pa2, pa3); SBAR();
    SLOAD(SO, (j + 2) * KVBLK); SBAR();
    pv_d0(o, vb0, pa0, pa1, pa2, pa3); partialSM(pB0, pB1, m_reg, mnB, alB, SCALE, THR);
    __syncthreads(); SWAIT(); SWRITE(0, SE);
    RESC(alB); __syncthreads();
    SBAR(); qkt<4>(pA0, pA1, K_lds, qr, r32, hi, kc0);
    finishSM(pB0, pB1, alB, l_reg, pa0, pa1, pa2, pa3); SBAR();
    if (j + 3 < NT) SLOAD(SE, (j + 3) * KVBLK); SBAR();
    pv_d0(o, vb0 + (int)SHM_V, pa0, pa1, pa2, pa3); partialSM(pA0, pA1, m_reg, mnA, alA, SCALE, THR);
    __syncthreads(); SWAIT(); SWRITE(1, SO);
    RESC(alA); __syncthreads();
  }
  SBAR(); qkt<4>(pB0, pB1, K_lds + SHM_K, qr, r32, hi, kc0);
  finishSM(pA0, pA1, alA, l_reg, pa0, pa1, pa2, pa3); SBAR();
  pv_d0(o, vb0, pa0, pa1, pa2, pa3); partialSM(pB0, pB1, m_reg, mnB, alB, SCALE, THR);
  __syncthreads(); RESC(alB);
  finishSM(pB0, pB1, alB, l_reg, pa0, pa1, pa2, pa3); SBAR();
  pv_d0(o, vb0 + (int)SHM_V, pa0, pa1, pa2, pa3);
  asm volatile("s_waitcnt vmcnt(0)" ::: "memory");
  if (hi == 0) li_l[r32] = l_reg; asm volatile("s_waitcnt lgkmcnt(0)" ::: "memory");
  float rli[16];
#pragma unroll
  for (int r = 0; r < 16; ++r) rli[r] = __builtin_amdgcn_rcpf(li_l[crow(r, hi)]);
  __syncthreads();
  float* X = (float*)lds + (size_t)wq * 4096;
  if (csel == 1) {
#pragma unroll
    for (int d0 = 0; d0 < 4; ++d0)
#pragma unroll
      for (int r = 0; r < 16; ++r) X[(d0 * 16 + r) * 64 + lane] = o[d0][r] * rli[r];
  }
  __syncthreads();
  if (csel == 0) {
    float ss[16];
#pragma unroll
    for (int r = 0; r < 16; ++r) ss[r] = 0.f;
#pragma unroll
    for (int d0 = 0; d0 < 4; ++d0)
#pragma unroll
      for (int r = 0; r < 16; ++r) { const float v = o[d0][r] * rli[r] - lam * X[(d0 * 16 + r) * 64 + lane]; o[d0][r] = v; ss[r] += v * v; }
#pragma unroll
    for (int r = 0; r < 16; ++r) { float s = ss[r];
      s = row_sum(s); s += xor_lane(s, lane, 16);
      ss[r] = __builtin_amdgcn_rsqf(s * (1.f / 128.f) + RMS_EPS) * post_scale; }
    float gg[4];
#pragma unroll
    for (int d0 = 0; d0 < 4; ++d0) gg[d0] = subln_g[d0 * 32 + r32];
    bf16* Ow = outb + (long)(wq * 32) * ldo;
#pragma unroll
    for (int r = 0; r < 16; ++r) { const int orow = crow(r, hi);
#pragma unroll
      for (int d0 = 0; d0 < 4; ++d0) Ow[(long)orow * ldo + d0 * 32 + r32] = f2bf(o[d0][r] * ss[r] * gg[d0]); }
  }
#undef SLOAD
#undef SWRITE
#undef SWAIT
}

__device__ __forceinline__ void dil_attn_unit(const bf16* Qh, const bf16* Kh, const bf16* Vh, int ld, int dil, int rho, int u0, int L,
                                              float* Oc, float* lsep, char* lds, const int wave_id) {
  constexpr float SCALE = 0.08838834764831845f; constexpr float C = SCALE * 1.4426950408889634f;
  const int tid = tid_from_wave(wave_id), wid = __builtin_amdgcn_readfirstlane(tid >> 6), lane = tid & 63, r32 = lane & 31, hi = lane >> 5;
  char* V_lds = lds; char* K_lds = lds + 2 * SHM_V;
  float* ws = (float*)(lds + 2 * SHM_V + 2 * SHM_K) + wid * 64; float* li_l = ws; float* al_l = ws + 32;
  float m_reg = -1e30f, l_reg = 0; f32x16 o[4] = {}; bf16x8 qr[8];
  const int uq = u0 + wid * 32 + r32;
  const bf16* Qw = Qh + (long)(rho + dil * uq) * ld + hi * 8;
#pragma unroll
  for (int d0 = 0; d0 < 8; ++d0) qr[d0] = ld8(Qw + d0 * 16);
  const int sr = tid >> 4, sc = (tid & 15) * 8, vst0 = v_st(sr, sc), vst1 = v_st(32 + sr, sc);
  const int vb0 = (int)(uintptr_t)V_lds + v_rd_base(lane);
  const int tlo = wid >> 1;
  for (int t = 0; t < 6; ++t) {
    const int kt0 = u0 - 64 + 64 * t;
    __syncthreads();
    { int ua = kt0 + sr, ub = kt0 + 32 + sr; ua = ua < 0 ? 0 : (ua >= L ? L - 1 : ua); ub = ub < 0 ? 0 : (ub >= L ? L - 1 : ub);
      const long ra = (long)(rho + dil * ua) * ld + sc, rb = (long)(rho + dil * ub) * ld + sc;
      const bf16x8 va = ld8(Vh + ra), vb = ld8(Vh + rb), ka = ld8(Kh + ra), kb = ld8(Kh + rb);
      *(bf16x8*)(V_lds + vst0) = va; *(bf16x8*)(V_lds + vst1) = vb; const int kc = sc * 2;
      *(bf16x8*)(K_lds + KSWZ(sr, kc)) = ka; *(bf16x8*)(K_lds + KSWZ(32 + sr, kc)) = kb; }
    __syncthreads();
    if (t >= tlo && t <= tlo + 2) {
      f32x16 p0, p1;
      qkt<8>(p0, p1, K_lds, qr, r32, hi, 0);
#pragma unroll
      for (int r = 0; r < 16; ++r) { const int uk0 = kt0 + crow(r, hi), uk1 = uk0 + 32; const int d0 = uk0 - uq, d1 = uk1 - uq;
        const bool ok0 = (uk0 >= 0) && (uk0 < L) && (d0 >= -64) && (d0 <= 64), ok1 = (uk1 >= 0) && (uk1 < L) && (d1 >= -64) && (d1 <= 64);
        p0[r] = ok0 ? p0[r] : -1e30f; p1[r] = ok1 ? p1[r] : -1e30f; }
      float pmax = p0[0];
#pragma unroll
      for (int r = 1; r < 16; ++r) pmax = fmaxf(pmax, p0[r]);
#pragma unroll
      for (int r = 0; r < 16; ++r) pmax = fmaxf(pmax, p1[r]);
      { auto rr = __builtin_amdgcn_permlane32_swap(__float_as_uint(pmax), __float_as_uint(pmax), false, false);
        pmax = fmaxf(__uint_as_float(rr[0]), __uint_as_float(rr[1])); }
      const float mn = fmaxf(m_reg, pmax); const float alpha = __builtin_amdgcn_exp2f((m_reg - mn) * C); m_reg = mn;
      const float mnC = -mn * C;
#pragma unroll
      for (int r = 0; r < 16; ++r) { p0[r] = __builtin_amdgcn_exp2f(fmaf(p0[r], C, mnC)); p1[r] = fmaf(p1[r], C, mnC); }
      bf16x8 pa0, pa1, pa2, pa3;
      finishSM(p0, p1, alpha, l_reg, pa0, pa1, pa2, pa3);
      RESC(alpha);
      pv_d0(o, vb0, pa0, pa1, pa2, pa3);
    }
  }
  if (hi == 0) li_l[r32] = l_reg; asm volatile("s_waitcnt lgkmcnt(0)" ::: "memory");
  float rli[16];
#pragma unroll
  for (int r = 0; r < 16; ++r) rli[r] = __builtin_amdgcn_rcpf(li_l[crow(r, hi)]);
#pragma unroll
  for (int r = 0; r < 16; ++r) { const int uo = u0 + wid * 32 + crow(r, hi); float* orow = Oc + (long)(rho + dil * uo) * 512;
#pragma unroll
    for (int d0 = 0; d0 < 4; ++d0) orow[d0 * 32 + r32] = o[d0][r] * rli[r]; }
  if (hi == 0) lsep[(long)(rho + dil * uq) * 4] = m_reg * SCALE + __logf(l_reg);
}
#undef RESC
#undef KSWZ
#undef SBAR
}

struct Args { const float* in[N_INPUTS]; float* out; unsigned char* ws; int ph_lo, ph_hi; };
typedef const __attribute__((address_space(4))) Args* ArgsP;
struct Frame {
    LAS unsigned char* lds; volatile LAS unsigned* MISC; unsigned* ctl; unsigned char* ws;
    int tid, lane, wave, G, bid;
};
constexpr int PH_P0 = 0, PH_P1 = 1, PH_P2 = 2, PH_L0 = 3, NPH_L = 13, PH_FINAL = PH_L0 + DEPTH * NPH_L, NPHASES = PH_FINAL + 1;
enum { LP_NORM1 = 0, LP_G1, LP_PREP, LP_CPREP, LP_MIX, LP_POST, LP_G2, LP_NORM2, LP_GS, LP_GO, LP_NORM3, LP_M1, LP_M2 };

__device__ __forceinline__ int q_next(Frame& F, int q) {
    __syncthreads();
    if (F.tid == 0) F.MISC[0] = __hip_atomic_fetch_add(F.ctl + CW_Q + 64 * q, 1u, __ATOMIC_RELAXED, __HIP_MEMORY_SCOPE_AGENT);
    __syncthreads();
    return (int)F.MISC[0];
}

template <class RowMap>
__device__ __forceinline__ void transpose_item(const float* W, int ldn, bf16* WT, int ldt, RowMap rm, LAS float* scr, int k0, int n0, int lane) {
#pragma unroll 8
    for (int i = 0; i < 32; ++i) { const int kk = 2 * i + (lane >> 5); scr[kk * 33 + (lane & 31)] = W[(size_t)(k0 + kk) * ldn + n0 + (lane & 31)]; }
    LDS_WAIT(); asm volatile("" ::: "memory");
    const int c = lane & 7;
#pragma unroll
    for (int j = 0; j < 4; ++j) { const int n = (lane >> 3) + 8 * j; const LAS float* s = scr + (8 * c) * 33 + n;
        u32x4 o; o.x = pk2(s[0 * 33], s[1 * 33]); o.y = pk2(s[2 * 33], s[3 * 33]); o.z = pk2(s[4 * 33], s[5 * 33]); o.w = pk2(s[6 * 33], s[7 * 33]);
        *(u32x4*)(WT + (size_t)rm(n0 + n) * ldt + k0 + 8 * c) = o; }
    LDS_WAIT(); asm volatile("" ::: "memory");
}
struct RmId { __device__ __forceinline__ int operator()(int n) const { return n; } };
struct RmW13 { int off; __device__ __forceinline__ int operator()(int n) const { return 256 * (n >> 7) + off + (n & 127); } };

__device__ __forceinline__ void p0_prologue(Frame& F, ArgsP a) {
    unsigned char* ws = F.ws;
    LAS float* scr = (LAS float*)(F.lds + F.wave * 16384);
    const int gw = F.bid * 8 + F.wave, NGW = F.G * 8;
    constexpr int I_WIN = (DM / 64) * (IN_TOTAL / 32), I_SQ = (DM / 64) * (DM / 32), I_WKV = (DM / 64) * (4096 / 32), I_W1 = (DM / 64) * (DEXP / 32), I_W2 = (DEXP / 64) * (DM / 32);
    constexpr int PER_L = I_WIN + I_SQ + I_WKV + I_SQ + NEXP * (2 * I_W1 + I_W2);
    for (int it = gw; it < DEPTH * PER_L; it += NGW) {
        const int l = it / PER_L; int r = it % PER_L;
        if (r < I_WIN) { const int nb = IN_TOTAL / 32; transpose_item(a->in[I_W_IN] + (size_t)l * DM * IN_TOTAL, IN_TOTAL, (bf16*)(ws + WS_WIN) + (size_t)l * ZLD * DM, DM, RmId{}, scr, 64 * (r / nb), 32 * (r % nb), F.lane); continue; } r -= I_WIN;
        if (r < I_SQ) { const int nb = DM / 32; transpose_item(a->in[I_W_OUT] + (size_t)l * DM * DM, DM, (bf16*)(ws + WS_WOUT) + (size_t)l * DM * DM, DM, RmId{}, scr, 64 * (r / nb), 32 * (r % nb), F.lane); continue; } r -= I_SQ;
        if (r < I_WKV) { const int nb = 4096 / 32; transpose_item(a->in[I_XA_WKV] + (size_t)l * DM * 4096, 4096, (bf16*)(ws + SC_WKVT) + (size_t)l * 4096 * DM, DM, RmId{}, scr, 64 * (r / nb), 32 * (r % nb), F.lane); continue; } r -= I_WKV;
        if (r < I_SQ) { const int nb = DM / 32; transpose_item(a->in[I_XA_WO] + (size_t)l * DM * DM, DM, (bf16*)(ws + SC_WOT) + (size_t)l * DM * DM, DM, RmId{}, scr, 64 * (r / nb), 32 * (r % nb), F.lane); continue; } r -= I_SQ;
        const int e = r / (2 * I_W1 + I_W2); r = r % (2 * I_W1 + I_W2);
        const size_t le = (size_t)l * NEXP + e;
        if (r < I_W1) { const int nb = DEXP / 32; transpose_item(a->in[I_MOE_W1] + le * DM * DEXP, DEXP, (bf16*)(ws + WS_W13) + le * 1024 * DM, DM, RmW13{0}, scr, 64 * (r / nb), 32 * (r % nb), F.lane); continue; } r -= I_W1;
        if (r < I_W1) { const int nb = DEXP / 32; transpose_item(a->in[I_MOE_W3] + le * DM * DEXP, DEXP, (bf16*)(ws + WS_W13) + le * 1024 * DM, DM, RmW13{128}, scr, 64 * (r / nb), 32 * (r % nb), F.lane); continue; } r -= I_W1;
        { const int nb = DM / 32; transpose_item(a->in[I_MOE_W2] + le * DEXP * DM, DM, (bf16*)(ws + WS_W2) + le * DM * DEXP, DEXP, RmId{}, scr, 64 * (r / nb), 32 * (r % nb), F.lane); }
    }
    for (int it = gw; it < DEPTH * 96; it += NGW) { const int l = it / 96; int r = it % 96; bf16* base = (bf16*)(ws + WS_LORA + l * LORA_LAYER);
        if (r < 32) { const int d = r >> 4, nb = r & 15; transpose_item(a->in[I_RWKV_W2] + ((size_t)l * 2 + d) * 64 * 512, 512, base + (size_t)d * 512 * 64, 64, RmId{}, scr, 0, 32 * nb, F.lane); continue; } r -= 32;
        if (r < 32) { const int d = r >> 4, nb = r & 15; transpose_item(a->in[I_RWKV_A2] + ((size_t)l * 2 + d) * 64 * 512, 512, base + (size_t)(2 + d) * 512 * 64, 64, RmId{}, scr, 0, 32 * nb, F.lane); continue; } r -= 32;
        { const int kb = r >> 4, nb = r & 15; transpose_item(a->in[I_RWKV_G2] + (size_t)l * 128 * 512, 512, base + (size_t)4 * 512 * 64, 128, RmId{}, scr, 64 * kb, 32 * nb, F.lane); } }
    for (int it = gw; it < DEPTH * 128; it += NGW) { const int l = it / 128, r = it % 128, kb = r >> 4, nb = r & 15;
        transpose_item(a->in[I_S5_GLU_W] + (size_t)l * 512 * 512, 512, (bf16*)(ws + WS_GLUT) + (size_t)l * 512 * 512, 512, RmId{}, scr, 64 * kb, 32 * nb, F.lane); }
    const int gt = F.bid * 512 + F.tid, NGT = F.G * 512;
    for (int i = gt; i < DEPTH * 32 * 16 * 64; i += NGT) { const int n = i & 63, row = i >> 6;
        bf16* cw = (bf16*)(ws + WS_S5CW) + (size_t)row * 128; cw[n] = f2bf(a->in[I_S5_C_RE][i]); cw[64 + n] = f2bf(-a->in[I_S5_C_IM][i]); }
    for (int i = gt; i < DEPTH * DM * 32; i += NGT) { const int l = i / (DM * 32), r = i % (DM * 32), k = r >> 5, e = r & 31;
        ((float*)(ws + WS_RTE))[(((size_t)l * 4 + (e >> 3)) * DM + k) * 8 + (e & 7)] = a->in[I_ROUTER_EXPERT][i]; }
    for (int i = gt; i < DEPTH * (ZLD - IN_TOTAL) * DM / 8; i += NGT) { const int l = i / ((ZLD - IN_TOTAL) * DM / 8), r = i % ((ZLD - IN_TOTAL) * DM / 8);
        *(u32x4*)((bf16*)(ws + WS_WIN) + (size_t)l * ZLD * DM + (size_t)IN_TOTAL * DM + (size_t)r * 8) = (u32x4){0u, 0u, 0u, 0u}; }
    for (int i = gt; i < DEPTH * DM * DM / 8; i += NGT) { const f32x4 x0 = *(const f32x4*)(a->in[I_XA_WQ] + (size_t)i * 8), x1 = *(const f32x4*)(a->in[I_XA_WQ] + (size_t)i * 8 + 4);
        u32x4 o; o.x = pk2(x0[0], x0[1]); o.y = pk2(x0[2], x0[3]); o.z = pk2(x1[0], x1[1]); o.w = pk2(x1[2], x1[3]); *(u32x4*)((bf16*)(ws + SC_WQB) + (size_t)i * 8) = o; }
    { float* cosA = (float*)(ws + WS_ROPE); float* sinA = cosA + SEQ * 32; float* cosC = sinA + SEQ * 32; float* sinC = cosC + SEQ * 64;
      for (int i = gt; i < SEQ * 96; i += NGT) { const int s = i / 96, j = i % 96; const bool isA = j < 32; const int jj = isA ? j : j - 32; const float dim = isA ? 64.f : 128.f;
          const float inv = 1.0f / powf(10000.0f, (float)(2 * jj) / dim); const float ang = (float)s * inv; float sn, cs; sincosf(ang, &sn, &cs);
          if (isA) { cosA[s * 32 + jj] = cs; sinA[s * 32 + jj] = sn; } else { cosC[s * 64 + jj] = cs; sinC[s * 64 + jj] = sn; } } }
    for (int i = gt; i < DEPTH * 2 * 32 * 64; i += NGT) { const int l = i / (2 * 32 * 64), r = i % (2 * 32 * 64), dir = r / (32 * 64), g = (r / 64) % 32, n = r % 64;
        float* ab = (float*)(ws + WS_S5P + l * S5P_LAYER); float* bb = ab + 2 * 32 * 64 * 2;
        const size_t pi = (((size_t)l * 2 + dir) * 32 + g) * 64 + n;
        const float lr = fminf(a->in[I_S5_A_RE][pi], -1e-4f), li = a->in[I_S5_A_IM][pi], dt = __expf(a->in[I_S5_LOG_DT][((size_t)l * 2 + dir) * 32 + g]);
        const float mag = __expf(dt * lr); float sn, cs; sincosf(dt * li, &sn, &cs); const float abr = mag * cs, abi = mag * sn;
        const float den = lr * lr + li * li; const float ir = lr / den, ii = -li / den;
        const float fr_ = (abr - 1.f) * ir - abi * ii, fi_ = (abr - 1.f) * ii + abi * ir;
        ab[(size_t)r * 2] = abr; ab[(size_t)r * 2 + 1] = abi;
        { float* ab256 = bb + 2 * 32 * 64 * 16 * 2; const float m256 = __expf(256.f * dt * lr); float s2, c2; sincosf(256.f * dt * li, &s2, &c2); ab256[(size_t)r * 2] = m256 * c2; ab256[(size_t)r * 2 + 1] = m256 * s2; }
        const size_t bi = (((size_t)l * 32 + g) * 64 + n) * 16;
#pragma unroll
        for (int c = 0; c < 16; ++c) { const float br = a->in[I_S5_B_RE][bi + c], bim = a->in[I_S5_B_IM][bi + c];
            bb[((size_t)r * 16 + c) * 2] = fr_ * br - fi_ * bim; bb[((size_t)r * 16 + c) * 2 + 1] = fr_ * bim + fi_ * br; } }
    for (int it = gw; it < DEPTH * BATCH * NMEM; it += NGW) { const int l = it / (BATCH * NMEM), row = it % (BATCH * NMEM);
        const f32x4* xr = (const f32x4*)(a->in[I_MEM] + (size_t)row * DM) + F.lane; const f32x4* gr = (const f32x4*)(a->in[I_NORM_MEM] + (size_t)l * DM) + F.lane;
        f32x4 v[8]; float s = 0.f;
#pragma unroll
        for (int j = 0; j < 8; ++j) { v[j] = xr[64 * j]; s += (v[j].x * v[j].x + v[j].y * v[j].y) + (v[j].z * v[j].z + v[j].w * v[j].w); }
        const float rstd = 1.f / sqrtf(wave_sum(s) * (1.f / DM) + RMS_EPS);
        u32x2* o8 = (u32x2*)((bf16*)(ws + SC_MEMN) + ((size_t)l * 512 + row) * DM) + F.lane;
#pragma unroll
        for (int j = 0; j < 8; ++j) { const f32x4 gv = gr[64 * j]; u32x2 w; w.x = pk2(v[j].x * rstd * gv.x, v[j].y * rstd * gv.y); w.y = pk2(v[j].z * rstd * gv.z, v[j].w * rstd * gv.w); o8[64 * j] = w; } }
}

struct SchedDense { const char* A; const char* B; char* C; int nM, nN, G, c, lda, ldb, ldcb  , cesz  ;
    __device__ __forceinline__ bool next(int i, pg8::Unit& u) const { const long L = (long)i * G + c; if (L >= (long)nM * nN) return false; int pm, pn; pg8::xcd_tile((int)L, nM, nN, pm, pn);
        u.A = A + (size_t)pm * 256 * lda * 2; u.B = B + (size_t)pn * 256 * ldb * 2; u.C = C + (size_t)pm * 256 * ldcb + (size_t)pn * 256 * cesz; u.row0 = pm * 256; u.col0 = pn * 256; u.aux = 0; return true; }
    __device__ __forceinline__ int arow(const pg8::Unit&, int r) const { return r; } };
struct SchedBatch { const char* A; const char* B; char* C; size_t sA, sB, sC; int nM, nN, nb, G, c, lda, ldb, ldcb, cesz, rowsPerBatch;
    __device__ __forceinline__ bool next(int i, pg8::Unit& u) const { const long L = (long)i * G + c; const int per = nM * nN; if (L >= (long)per * nb) return false; const int b = (int)(L / per), r = (int)(L % per), pm = r / nN, pn = r % nN;
        u.A = A + b * sA + (size_t)pm * 256 * lda * 2; u.B = B + b * sB + (size_t)pn * 256 * ldb * 2; u.C = C + b * sC + (size_t)pm * 256 * ldcb + (size_t)pn * 256 * cesz; u.row0 = b * rowsPerBatch + pm * 256; u.col0 = pn * 256; u.aux = b; return true; }
    __device__ __forceinline__ int arow(const pg8::Unit&, int r) const { return r; } };
struct SchedXaPre { unsigned char* ws; int G, c, kind;
    __device__ __forceinline__ bool next(int i, pg8::Unit& u) const { const long L = (long)i * G + c; if (L >= 128) return false; const int r = (int)L, p = r >> 3, t = r & 7, l = p >> 3, b = (p >> 2) & 1, h = p & 3;
        const bf16* kvb = (const bf16*)(ws + SC_KVB) + (size_t)l * 512 * 4096 + (size_t)(b * 256) * 4096;
        if (kind == 0) { u.A = (const char*)(kvb + h * 512); u.B = (const char*)((const bf16*)(ws + SC_WQB) + (size_t)l * DM * DM + (size_t)(t * 256) * DM + h * 512);
            u.C = (char*)((bf16*)(ws + WS_WQK) + ((size_t)(l * 2 + b) * 1024 + h * 256) * DM + t * 256); u.aux = DM; }
        else { u.A = (const char*)((const bf16*)(ws + SC_WOT) + (size_t)l * DM * DM + (size_t)(t * 256) * DM + h * 512); u.B = (const char*)(kvb + 2048 + h * 512);
            u.C = (char*)((bf16*)(ws + WS_VWO) + ((size_t)(l * 2 + b) * DM + t * 256) * 1024 + h * 256); u.aux = 1024; }
        u.row0 = 0; u.col0 = 0; return true; }
    __device__ __forceinline__ int arow(const pg8::Unit&, int r) const { return r; } };
struct EpiBf16U { static constexpr bool PERM = true, AFTER_DRAIN = false;
    __device__ __forceinline__ void operator()(const pg8::Acc& acc, const pg8::Unit& u, int wr, int wc, int fr, int fq) const { pg8::EpiBf16 e{u.aux}; e(acc, u, wr, wc, fr, fq); } };
struct SchedMoe { unsigned char* ws; const volatile LAS int* tp; const volatile LAS int* cnt; int layer, G, c, which;
    __device__ __forceinline__ bool next(int i, pg8::Unit& u) const {
        const int npn = which == 0 ? 4 : 8; const long L = (long)i * G + c; const int ntile = tp[32]; if (L >= (long)ntile * npn) return false;
        const int mt = (int)(L / npn), pn = (int)(L % npn); int e = 0;
#pragma unroll 1
        for (int k = 1; k < 32; ++k) e += (mt >= tp[k]) ? 1 : 0;
        const int lt = mt - tp[e]; const int nvalid = min(256, cnt[e] - lt * 256);
        u.row0 = lt * 256; u.col0 = pn * 256; u.aux = (e << 16) | nvalid;
        if (which == 0) { u.A = (const char*)(ws + WS_HN); u.B = (const char*)((const bf16*)(ws + WS_W13) + ((size_t)(layer * NEXP + e) * 1024 + pn * 256) * DM);
            u.C = (char*)((bf16*)(ws + SC_HMID) + (size_t)(mt * 256) * DEXP + pn * 128); }
        else { u.A = (const char*)((const bf16*)(ws + SC_HMID) + (size_t)(mt * 256) * DEXP); u.B = (const char*)((const bf16*)(ws + WS_W2) + ((size_t)(layer * NEXP + e) * DM + pn * 256) * DEXP);
            u.C = (char*)((bf16*)(ws + SC_YBUF) + (size_t)(mt * 256) * DM + pn * 256); }
        return true; }
    __device__ __forceinline__ int arow(const pg8::Unit& u, int r) const { const int e = u.aux >> 16, nvalid = u.aux & 0xffff; const int idx = (r < nvalid) ? (u.row0 + r) : u.row0;
        return ((const int*)(ws + WS_ETOK))[(size_t)e * ECAP + idx]; } };

__device__ __forceinline__ void moe_prefix(Frame& F, int layer, volatile LAS int* tp, volatile LAS int* cnt) {
    __syncthreads();
    if (F.tid < 32) cnt[F.tid] = (int)__hip_atomic_load(F.ctl + CW_CNT + (layer * 32 + F.tid) * 64, __ATOMIC_RELAXED, __HIP_MEMORY_SCOPE_AGENT);
    __syncthreads();
    if (F.tid == 0) { int s = 0; for (int e = 0; e < 32; ++e) { tp[e] = s; s += (cnt[e] + 255) >> 8; } tp[32] = s; }
    __syncthreads();
}
template <int MODE>
__device__ __forceinline__ void norm_phase(Frame& F, ArgsP a, const float* src, const float* gain, int layer) {
    unsigned char* ws = F.ws; float* H = (float*)(ws + WS_H); bf16* HN = (bf16*)(ws + WS_HN);
    volatile LAS int* tp = (volatile LAS int*)(F.lds + 1024); volatile LAS int* cnt = tp + 40;
    if (MODE & 1) moe_prefix(F, layer - 1, tp, cnt);
    const int gw = F.bid * 8 + F.wave, NGW = F.G * 8;
    const f32x4* gr = (const f32x4*)gain + F.lane;
    for (int row = gw; row < NTOK; row += NGW) {
        const f32x4* xr = (const f32x4*)(src + (size_t)row * DM) + F.lane;
        f32x4 v[8];
#pragma unroll
        for (int j = 0; j < 8; ++j) v[j] = xr[64 * j];
        if (MODE & 1) {
            const int* ti = (const int*)(ws + WS_TINFO) + (size_t)row * 4;
            const int e0 = ti[0], p0 = ti[1], e1 = ti[2], p1 = ti[3];
            const size_t s0 = (size_t)tp[e0] * 256 + p0, s1 = (size_t)tp[e1] * 256 + p1;
            const u32x2* y0 = (const u32x2*)((const bf16*)(ws + SC_YBUF) + s0 * DM) + F.lane; const u32x2* y1 = (const u32x2*)((const bf16*)(ws + SC_YBUF) + s1 * DM) + F.lane;
#pragma unroll
            for (int j = 0; j < 8; ++j) { const u32x2 a0 = y0[64 * j], a1 = y1[64 * j];
                v[j].x += __uint_as_float(a0.x << 16) + __uint_as_float(a1.x << 16); v[j].y += __uint_as_float(a0.x & 0xffff0000u) + __uint_as_float(a1.x & 0xffff0000u);
                v[j].z += __uint_as_float(a0.y << 16) + __uint_as_float(a1.y << 16); v[j].w += __uint_as_float(a0.y & 0xffff0000u) + __uint_as_float(a1.y & 0xffff0000u); }
            if (!(MODE & 4)) { f32x4* hr = (f32x4*)(H + (size_t)row * DM) + F.lane;
#pragma unroll
                for (int j = 0; j < 8; ++j) hr[64 * j] = v[j]; }
        }
        float s = 0.f;
#pragma unroll
        for (int j = 0; j < 8; ++j) s += (v[j].x * v[j].x + v[j].y * v[j].y) + (v[j].z * v[j].z + v[j].w * v[j].w);
        const float rstd = 1.f / sqrtf(wave_sum(s) * (1.f / DM) + RMS_EPS);
#pragma unroll
        for (int j = 0; j < 8; ++j) { const f32x4 gv = gr[64 * j]; v[j].x *= rstd * gv.x; v[j].y *= rstd * gv.y; v[j].z *= rstd * gv.z; v[j].w *= rstd * gv.w; }
        if (MODE & 4) { f32x4* orow = (f32x4*)(a->out + (size_t)row * DM) + F.lane;
#ifdef DBG_RWCHK
            { const float* cw = (const float*)(F.ctl + 32768); const unsigned* cu = (const unsigned*)cw; const float sc = cu[DBG_RWCHK * 64 + 2] ? 1001.f : 1.f + fminf(cw[DBG_RWCHK * 64] / cw[DBG_RWCHK * 64 + 1], 100.f);
#pragma unroll
              for (int j = 0; j < 8; ++j) v[j] *= sc; }
#endif
#pragma unroll
            for (int j = 0; j < 8; ++j) orow[64 * j] = v[j]; }
        else { u32x2* o8 = (u32x2*)(HN + (size_t)row * DM) + F.lane;
#pragma unroll
            for (int j = 0; j < 8; ++j) { u32x2 w; w.x = pk2(v[j].x, v[j].y); w.y = pk2(v[j].z, v[j].w); o8[64 * j] = w; } }
        if (MODE & 2) {
            const float* wg = a->in[I_ROUTER_GROUP] + (size_t)layer * DM * 4;
            float lg[4] = {0.f, 0.f, 0.f, 0.f};
#pragma unroll
            for (int j = 0; j < 8; ++j) { const int k0 = (64 * j + F.lane) * 4;
#pragma unroll
                for (int q = 0; q < 4; ++q) { const f32x4 w4 = *(const f32x4*)(wg + (size_t)(k0 + q) * 4); const float x = v[j][q]; lg[0] += x * w4.x; lg[1] += x * w4.y; lg[2] += x * w4.z; lg[3] += x * w4.w; } }
#pragma unroll
            for (int q = 0; q < 4; ++q) lg[q] = wave_sum(lg[q]);
            int gi = 0; float gm = lg[0];
#pragma unroll
            for (int q = 1; q < 4; ++q) if (lg[q] > gm) { gm = lg[q]; gi = q; }
            const float gw_ = 1.f / (__expf(lg[0] - gm) + __expf(lg[1] - gm) + __expf(lg[2] - gm) + __expf(lg[3] - gm));
            float le[8] = {0.f, 0.f, 0.f, 0.f, 0.f, 0.f, 0.f, 0.f};
            const float* we = (const float*)(ws + WS_RTE) + ((size_t)layer * 4 + gi) * DM * 8;
#pragma unroll 4
            for (int j = 0; j < 8; ++j) { const int k0 = (64 * j + F.lane) * 4;
#pragma unroll
                for (int q = 0; q < 4; ++q) { const float* wp = we + (size_t)(k0 + q) * 8; const f32x4 wa = *(const f32x4*)wp, wb = *(const f32x4*)(wp + 4); const float x = v[j][q];
                    le[0] += x * wa.x; le[1] += x * wa.y; le[2] += x * wa.z; le[3] += x * wa.w; le[4] += x * wb.x; le[5] += x * wb.y; le[6] += x * wb.z; le[7] += x * wb.w; } }
#pragma unroll
            for (int q = 0; q < 8; ++q) le[q] = wave_sum(le[q]);
            int i0 = 0; float m0 = le[0];
#pragma unroll
            for (int q = 1; q < 8; ++q) if (le[q] > m0) { m0 = le[q]; i0 = q; }
            int i1 = -1; float m1 = -3.0e38f;
#pragma unroll
            for (int q = 0; q < 8; ++q) if (q != i0 && le[q] > m1) { m1 = le[q]; i1 = q; }
            const float t = __expf(m1 - m0); const float w0 = 1.f / (1.f + t), w1 = t / (1.f + t);
            if (F.lane == 0) {
                const int e0 = gi * 8 + i0, e1 = gi * 8 + i1;
                const int p0 = (int)__hip_atomic_fetch_add(F.ctl + CW_CNT + (layer * 32 + e0) * 64, 1u, __ATOMIC_RELAXED, __HIP_MEMORY_SCOPE_AGENT);
                const int p1 = (int)__hip_atomic_fetch_add(F.ctl + CW_CNT + (layer * 32 + e1) * 64, 1u, __ATOMIC_RELAXED, __HIP_MEMORY_SCOPE_AGENT);
                int* et = (int*)(ws + WS_ETOK); float* eg = (float*)(ws + WS_EGATE); int* ti = (int*)(ws + WS_TINFO) + (size_t)row * 4;
                et[(size_t)e0 * ECAP + p0] = row; eg[(size_t)e0 * ECAP + p0] = gw_ * w0; et[(size_t)e1 * ECAP + p1] = row; eg[(size_t)e1 * ECAP + p1] = gw_ * w1;
                ti[0] = e0; ti[1] = p0; ti[2] = e1; ti[3] = p1;
            }
        }
    }
}

__device__ __forceinline__ void rope8(bf16* p1, bf16* p2, const float* cs, const float* sn) {
    const u32x4 a = *(const u32x4*)p1, b = *(const u32x4*)p2; const f32x4 c0 = *(const f32x4*)cs, c1 = *(const f32x4*)(cs + 4), s0 = *(const f32x4*)sn, s1 = *(const f32x4*)(sn + 4);
    const float x1[8] = {__uint_as_float(a.x << 16), __uint_as_float(a.x & 0xffff0000u), __uint_as_float(a.y << 16), __uint_as_float(a.y & 0xffff0000u), __uint_as_float(a.z << 16), __uint_as_float(a.z & 0xffff0000u), __uint_as_float(a.w << 16), __uint_as_float(a.w & 0xffff0000u)};
    const float x2[8] = {__uint_as_float(b.x << 16), __uint_as_float(b.x & 0xffff0000u), __uint_as_float(b.y << 16), __uint_as_float(b.y & 0xffff0000u), __uint_as_float(b.z << 16), __uint_as_float(b.z & 0xffff0000u), __uint_as_float(b.w << 16), __uint_as_float(b.w & 0xffff0000u)};
    const float cc[8] = {c0[0], c0[1], c0[2], c0[3], c1[0], c1[1], c1[2], c1[3]}, ss[8] = {s0[0], s0[1], s0[2], s0[3], s1[0], s1[1], s1[2], s1[3]};
    float o1[8], o2[8];
#pragma unroll
    for (int i = 0; i < 8; ++i) { o1[i] = x1[i] * cc[i] - x2[i] * ss[i]; o2[i] = x2[i] * cc[i] + x1[i] * ss[i]; }
    *(u32x4*)p1 = (u32x4){pk2(o1[0], o1[1]), pk2(o1[2], o1[3]), pk2(o1[4], o1[5]), pk2(o1[6], o1[7])};
    *(u32x4*)p2 = (u32x4){pk2(o2[0], o2[1]), pk2(o2[2], o2[3]), pk2(o2[4], o2[5]), pk2(o2[6], o2[7])};
}
__device__ __forceinline__ void rope_token(Frame& F, bf16* zrow, int s) {
    const float* cosA = (const float*)(F.ws + WS_ROPE); const float* sinA = cosA + SEQ * 32; const float* cosC = sinA + SEQ * 32; const float* sinC = cosC + SEQ * 64;
    { const int blk = F.lane >> 2, pc = F.lane & 3; bf16* p = zrow + ZA + blk * 64 + pc * 8; rope8(p, p + 32, cosA + s * 32 + pc * 8, sinA + s * 32 + pc * 8); }
    { const int blk = F.lane >> 3, pc = F.lane & 7; bf16* p = zrow + ZC + blk * 128 + pc * 8; rope8(p, p + 64, cosC + s * 64 + pc * 8, sinC + s * 64 + pc * 8); }
}

constexpr int RWT = 16;
__device__ __forceinline__ float zs_ld(const LAS unsigned short* zr, const float* mu, int t, int col) {
    const float z0 = bf2f(zr[(t + 1) * IN_B + col]), zp = bf2f(zr[t * IN_B + col]), zn = bf2f(zr[(t + 2) * IN_B + col]);
    return z0 + mu[col] * (zp - z0) + mu[IN_B + col] * (zn - z0);
}
__device__ __forceinline__ void rwkv_prep_tile(Frame& F, ArgsP a, int layer, int tile) {
    unsigned char* ws = F.ws; const bf16* Z = (const bf16*)(ws + SC_Z);
    LAS unsigned short* zr = (LAS unsigned short*)F.lds; LAS unsigned short* act = zr + (RWT + 2) * IN_B;
    const int t0 = tile * RWT; const int b = t0 / SEQ, s0 = t0 % SEQ;
    __syncthreads();
#pragma unroll 1
    for (int i = F.tid; i < (RWT + 2) * (IN_B / 8); i += 512) { const int rr = i / (IN_B / 8), c8 = i % (IN_B / 8); const int s = s0 - 1 + rr;
        u32x4 w = {0u, 0u, 0u, 0u};
        if (s >= 0 && s < SEQ) w = *(const u32x4*)(Z + (size_t)(b * SEQ + s) * ZLD + ZB + c8 * 8);
        *(LAS u32x4*)(zr + rr * IN_B + c8 * 8) = w; }
    __syncthreads();
    const float* mu = a->in[I_RWKV_MU] + (size_t)layer * 2 * IN_B;
#pragma unroll 1
    for (int i = F.tid; i < RWT * 384; i += 512) { const int t = i / 384, j = i % 384; const float x = zs_ld(zr, mu, t, 1536 + j);
        act[t * 392 + j] = f2bf((j < 128) ? tanhf(x) : ((j < 256) ? x : sigmoidf_(x))); }
    __syncthreads();
    const int lane = F.lane, r = lane & 15, g = lane >> 4, hd = F.wave;
    const bf16* lw = (const bf16*)(ws + WS_LORA + layer * LORA_LAYER);
    bf16x8 af[12];
#pragma unroll
    for (int ks = 0; ks < 12; ++ks) af[ks] = *(const LAS bf16x8*)(act + r * 392 + ks * 32 + g * 8);
    float* RW = (float*)(ws + SC_RW); const size_t N1 = (size_t)NTOK * 512;
    f32x4 dw0[4], dw1[4], da0[4], da1[4], dg[4];
#pragma unroll
    for (int nt = 0; nt < 4; ++nt) { const int c = hd * 64 + nt * 16 + r;
        bf16x8 bw[12];
#pragma unroll
        for (int ks = 0; ks < 2; ++ks) { bw[ks] = *(const bf16x8*)(lw + ((size_t)0 * 512 + c) * 64 + ks * 32 + g * 8); bw[2 + ks] = *(const bf16x8*)(lw + ((size_t)1 * 512 + c) * 64 + ks * 32 + g * 8);
            bw[4 + ks] = *(const bf16x8*)(lw + ((size_t)2 * 512 + c) * 64 + ks * 32 + g * 8); bw[6 + ks] = *(const bf16x8*)(lw + ((size_t)3 * 512 + c) * 64 + ks * 32 + g * 8); }
#pragma unroll
        for (int ks = 0; ks < 4; ++ks) bw[8 + ks] = *(const bf16x8*)(lw + (size_t)4 * 512 * 64 + (size_t)c * 128 + ks * 32 + g * 8);
        f32x4 z4 = {0.f, 0.f, 0.f, 0.f};
        dw0[nt] = __builtin_amdgcn_mfma_f32_16x16x32_bf16(af[0], bw[0], z4, 0, 0, 0); dw0[nt] = __builtin_amdgcn_mfma_f32_16x16x32_bf16(af[1], bw[1], dw0[nt], 0, 0, 0);
        dw1[nt] = __builtin_amdgcn_mfma_f32_16x16x32_bf16(af[2], bw[2], z4, 0, 0, 0); dw1[nt] = __builtin_amdgcn_mfma_f32_16x16x32_bf16(af[3], bw[3], dw1[nt], 0, 0, 0);
        da0[nt] = __builtin_amdgcn_mfma_f32_16x16x32_bf16(af[4], bw[4], z4, 0, 0, 0); da0[nt] = __builtin_amdgcn_mfma_f32_16x16x32_bf16(af[5], bw[5], da0[nt], 0, 0, 0);
        da1[nt] = __builtin_amdgcn_mfma_f32_16x16x32_bf16(af[6], bw[6], z4, 0, 0, 0); da1[nt] = __builtin_amdgcn_mfma_f32_16x16x32_bf16(af[7], bw[7], da1[nt], 0, 0, 0);
        dg[nt] = __builtin_amdgcn_mfma_f32_16x16x32_bf16(af[8], bw[8], z4, 0, 0, 0); dg[nt] = __builtin_amdgcn_mfma_f32_16x16x32_bf16(af[9], bw[9], dg[nt], 0, 0, 0);
        dg[nt] = __builtin_amdgcn_mfma_f32_16x16x32_bf16(af[10], bw[10], dg[nt], 0, 0, 0); dg[nt] = __builtin_amdgcn_mfma_f32_16x16x32_bf16(af[11], bw[11], dg[nt], 0, 0, 0);
    }
    float w00[4], w01[4], a00[4], a01[4], kkw[4], kaw[4];
#pragma unroll
    for (int nt = 0; nt < 4; ++nt) { const int c = hd * 64 + nt * 16 + r;
        w00[nt] = a->in[I_RWKV_W0][(size_t)layer * 1024 + c]; w01[nt] = a->in[I_RWKV_W0][(size_t)layer * 1024 + 512 + c];
        a00[nt] = a->in[I_RWKV_A0][(size_t)layer * 1024 + c]; a01[nt] = a->in[I_RWKV_A0][(size_t)layer * 1024 + 512 + c];
        kkw[nt] = a->in[I_RWKV_KK][(size_t)layer * 512 + c]; kaw[nt] = a->in[I_RWKV_KA][(size_t)layer * 512 + c]; }
#pragma unroll
    for (int q = 0; q < 4; ++q) { const int t = 4 * g + q;
        float k_[4], kk[4]; float ssq = 0.f;
#pragma unroll
        for (int nt = 0; nt < 4; ++nt) { const int c = hd * 64 + nt * 16 + r; k_[nt] = zs_ld(zr, mu, t, 512 + c); kk[nt] = k_[nt] * kkw[nt]; ssq += kk[nt] * kk[nt]; }
        ssq = row_sum(ssq);
        const float rn = 1.f / sqrtf(ssq + 1e-12f);
#pragma unroll
        for (int nt = 0; nt < 4; ++nt) { const int c = hd * 64 + nt * 16 + r;
            const float r_ = zs_ld(zr, mu, t, c), v_ = zs_ld(zr, mu, t, 1024 + c);
            const float x0 = -(w00[nt] + dw0[nt][q]), x1 = -(w01[nt] + dw1[nt][q]);
            const float sp0 = fmaxf(x0, 0.f) + __logf(1.f + __expf(-fabsf(x0))), sp1 = fmaxf(x1, 0.f) + __logf(1.f + __expf(-fabsf(x1)));
            const float d0 = -__expf(-sp0 - 0.5f), d1 = -__expf(-sp1 - 0.5f);
            const float al0 = sigmoidf_(a00[nt] + da0[nt][q]), al1 = sigmoidf_(a01[nt] + da1[nt][q]);
            const float kn = kk[nt] * rn;
            const float km0 = k_[nt] * (1.f + (al0 - 1.f) * kaw[nt]), km1 = k_[nt] * (1.f + (al1 - 1.f) * kaw[nt]);
            const size_t o = (size_t)(t0 + t) * 512 + c;
            RW[0 * N1 + o] = r_; RW[1 * N1 + o] = v_; RW[2 * N1 + o] = kn; RW[3 * N1 + o] = d0; RW[4 * N1 + o] = d1;
            RW[5 * N1 + o] = km0; RW[6 * N1 + o] = km1; RW[7 * N1 + o] = kn * al0; RW[8 * N1 + o] = kn * al1; RW[9 * N1 + o] = dg[nt][q]; }
    }
}

constexpr size_t SC_S5E = SC_MIX_END + (size_t)32 * 256 * 11520;
constexpr size_t SC_MIX_END3 = SC_S5E + (size_t)2 * BATCH * 16 * 32 * 64 * 2 * 4;
template <int LEVEL>
__device__ __forceinline__ void s5_block_task(Frame& F, int layer, int task, LAS float* ul) {
    unsigned char* ws = F.ws; const bf16* Z = (const bf16*)(ws + SC_Z);
    const int blk = task & 15, dir = (task >> 4) & 1, g = (task >> 5) & 31, b = task >> 10; const int n = F.lane;
    const float* ab = (const float*)(ws + WS_S5P + layer * S5P_LAYER); const float* bb = ab + 2 * 32 * 64 * 2; const float* ab256 = bb + 2 * 32 * 64 * 16 * 2;
    const int pr = (dir * 32 + g) * 64 + n;
    const float abr = ab[pr * 2], abi = ab[pr * 2 + 1];
    float bbr[16], bbi[16];
#pragma unroll
    for (int c = 0; c < 16; ++c) { bbr[c] = bb[((size_t)pr * 16 + c) * 2]; bbi[c] = bb[((size_t)pr * 16 + c) * 2 + 1]; }
    float* E = (float*)(ws + SC_S5E);
    float xr = 0.f, xi = 0.f;
    if (LEVEL == 2) { const float pr_ = ab256[pr * 2], pi_ = ab256[pr * 2 + 1];
        for (int k = 0; k < blk; ++k) { const float* ep = E + ((((size_t)dir * BATCH + b) * 16 + k) * 32 + g) * 128 + n * 2; const float er = ep[0], ei = ep[1];
            const float nr = pr_ * xr - pi_ * xi + er, ni = pr_ * xi + pi_ * xr + ei; xr = nr; xi = ni; } }
    float* carry = (float*)(ws + SC_CARRY);
    for (int q4 = 0; q4 < 4; ++q4) {
        { const int st = blk * 256 + q4 * 64 + n; const int sl = dir ? (SEQ - 1 - st) : st; const bf16* zp = Z + (size_t)(b * SEQ + sl) * ZLD + ZD + g * 16;
          const u32x4 w0 = *(const u32x4*)zp, w1 = *(const u32x4*)(zp + 8);
          LAS f32x4* d = (LAS f32x4*)(ul + n * 16);
          d[0] = (f32x4){__uint_as_float(w0.x << 16), __uint_as_float(w0.x & 0xffff0000u), __uint_as_float(w0.y << 16), __uint_as_float(w0.y & 0xffff0000u)};
          d[1] = (f32x4){__uint_as_float(w0.z << 16), __uint_as_float(w0.z & 0xffff0000u), __uint_as_float(w0.w << 16), __uint_as_float(w0.w & 0xffff0000u)};
          d[2] = (f32x4){__uint_as_float(w1.x << 16), __uint_as_float(w1.x & 0xffff0000u), __uint_as_float(w1.y << 16), __uint_as_float(w1.y & 0xffff0000u)};
          d[3] = (f32x4){__uint_as_float(w1.z << 16), __uint_as_float(w1.z & 0xffff0000u), __uint_as_float(w1.w << 16), __uint_as_float(w1.w & 0xffff0000u)}; }
        LDS_WAIT(); asm volatile("" ::: "memory");
#pragma unroll 4
        for (int i = 0; i < 64; ++i) {
            const int step = blk * 256 + q4 * 64 + i;
            if (LEVEL == 2 && (step & (S5CH - 1)) == 0) { const int sl = dir ? (SEQ - 1 - step) : step; const int ch = sl / S5CH;
                float* cp = carry + ((((size_t)dir * BATCH + b) * S5NCH + ch) * 32 + g) * 128 + n * 2; cp[0] = xr; cp[1] = xi; }
            const f32x4 u0 = *(const LAS f32x4*)(ul + i * 16), u1 = *(const LAS f32x4*)(ul + i * 16 + 4), u2 = *(const LAS f32x4*)(ul + i * 16 + 8), u3 = *(const LAS f32x4*)(ul + i * 16 + 12);
            float br = 0.f, bi = 0.f;
#pragma unroll
            for (int c = 0; c < 4; ++c) { br += bbr[c] * u0[c] + bbr[4 + c] * u1[c] + bbr[8 + c] * u2[c] + bbr[12 + c] * u3[c]; bi += bbi[c] * u0[c] + bbi[4 + c] * u1[c] + bbi[8 + c] * u2[c] + bbi[12 + c] * u3[c]; }
            const float nr = abr * xr - abi * xi + br, ni = abr * xi + abi * xr + bi; xr = nr; xi = ni;
        }
        asm volatile("" ::: "memory");
    }
    if (LEVEL == 1) { float* ep = E + ((((size_t)dir * BATCH + b) * 16 + blk) * 32 + g) * 128 + n * 2; ep[0] = xr; ep[1] = xi; }
}

__device__ __forceinline__ void prep_phase(Frame& F, ArgsP a, int layer, const int rep) {
    const int qb_ = (rep * 2 + layer) * 8;
#ifndef DBG_PREPMASK
#define DBG_PREPMASK 7
#endif
    if (DBG_PREPMASK & 1) for (;;) { const int it = q_next(F, qb_ + 0); if (it >= 256) break; s5_block_task<1>(F, layer, it * 8 + F.wave, (LAS float*)(F.lds + F.wave * 4096)); }
    if (DBG_PREPMASK & 2) for (;;) { const int it = q_next(F, qb_ + 5); if (it >= NTOK / RWT) break; rwkv_prep_tile(F, a, layer, it); }
    if ((DBG_PREPMASK & 4) && rep == 0) for (;;) { const int r = q_next(F, qb_ + 6); if (r >= NTOK / 64) break;
        for (int k = 0; k < 8; ++k) { const int tok = r * 64 + F.wave * 8 + k; rope_token(F, (bf16*)(F.ws + SC_Z) + (size_t)tok * ZLD, tok % SEQ); } }
}

constexpr int CR_TA = 0, CR_GH = 2048, CR_WBK = 4096, CR_TM = 8192, CR_N = 8704, CR_V = 9216, CR_WL = 11264, CR_BYTES = 11520;
constexpr size_t SC_CREC = SC_MIX_END;
constexpr size_t SC_MIX_END2 = SC_CREC + (size_t)32 * 256 * CR_BYTES;
static_assert(SC_MIX_END2 <= 1140000000ull, "workspace budget");

__device__ __forceinline__ void mm16(const LAS float* A, const LAS float* B, int t, int sq, float (&out)[4]) {
    out[0] = out[1] = out[2] = out[3] = 0.f;
#pragma unroll
    for (int s4 = 0; s4 < 4; ++s4) { const f32x4 a4 = *(const LAS f32x4*)(A + t * 16 + s4 * 4);
#pragma unroll
        for (int q = 0; q < 4; ++q) { const f32x4 b4 = *(const LAS f32x4*)(B + (s4 * 4 + q) * 16 + sq * 4); const float av = a4[q];
            out[0] += av * b4[0]; out[1] += av * b4[1]; out[2] += av * b4[2]; out[3] += av * b4[3]; } }
}
__device__ __forceinline__ void st16(LAS float* M, int t, int sq, const float (&v)[4]) { *(LAS f32x4*)(M + t * 16 + sq * 4) = (f32x4){v[0], v[1], v[2], v[3]}; }

__device__ __forceinline__ void rwkv_cprep_item(Frame& F, int chain, int c, LAS float* Lw) {
    unsigned char* ws = F.ws; const float* RW = (const float*)(ws + SC_RW); const size_t N1 = (size_t)NTOK * 512;
    const int dir = chain & 1, h = (chain >> 1) & 7, b = chain >> 4; const int lane = F.lane;
    const float* Rp = RW; const float* Vp = RW + N1; const float* KKp = RW + 2 * N1; const float* LDp = RW + (3 + dir) * N1; const float* KMp = RW + (5 + dir) * N1; const float* BBp = RW + (7 + dir) * N1;
    constexpr int RS = 68;
    LAS float* At = Lw; LAS float* Bt = Lw + 16 * RS; LAS float* Kt = Lw + 32 * RS; LAS float* mat = Lw + 48 * RS;
    float at[16], rt[16], wb[16], wk[16];
    { float lw = 0.f, lwi[16], bb[16], km[16];
#pragma unroll
      for (int t = 0; t < 16; ++t) { const int pos = dir ? (SEQ - 1 - 16 * c - t) : (16 * c + t); const size_t idx = (size_t)(b * SEQ + pos) * 512 + h * 64 + lane;
          const float r_ = Rp[idx], ld = LDp[idx], a_ = -KKp[idx]; km[t] = KMp[idx]; bb[t] = BBp[idx];
          at[t] = a_ * __expf(lw); lw += ld; lwi[t] = lw; rt[t] = r_ * __expf(lw);
          const float iw = __expf(-lw); At[t * RS + lane] = at[t]; Bt[t * RS + lane] = bb[t] * iw; Kt[t * RS + lane] = km[t] * iw; }
#pragma unroll
      for (int t = 0; t < 16; ++t) { const float e = __expf(lw - lwi[t]); wb[t] = bb[t] * e; wk[t] = km[t] * e; }
      float* rec = (float*)(ws + SC_CREC + ((size_t)chain * 256 + c) * CR_BYTES + CR_WL); rec[lane] = __expf(lw); }
    LDS_WAIT(); asm volatile("" ::: "memory");
    const int t = lane >> 2, sq = lane & 3;
    float mab[4] = {0.f, 0.f, 0.f, 0.f}, mak[4] = {0.f, 0.f, 0.f, 0.f}, mrb[4] = {0.f, 0.f, 0.f, 0.f}, mrk[4] = {0.f, 0.f, 0.f, 0.f};
#pragma unroll 4
    for (int j = 0; j < 64; j += 4) { const f32x4 a4 = *(const LAS f32x4*)(At + t * RS + j);
#pragma unroll
        for (int e = 0; e < 4; ++e) { const f32x4 b4 = *(const LAS f32x4*)(Bt + (sq * 4 + e) * RS + j), k4 = *(const LAS f32x4*)(Kt + (sq * 4 + e) * RS + j);
            mab[e] += a4[0] * b4[0] + a4[1] * b4[1] + a4[2] * b4[2] + a4[3] * b4[3]; mak[e] += a4[0] * k4[0] + a4[1] * k4[1] + a4[2] * k4[2] + a4[3] * k4[3]; } }
    asm volatile("" ::: "memory");
#pragma unroll
    for (int tt = 0; tt < 16; ++tt) At[tt * RS + lane] = rt[tt];
    LDS_WAIT(); asm volatile("" ::: "memory");
#pragma unroll 4
    for (int j = 0; j < 64; j += 4) { const f32x4 a4 = *(const LAS f32x4*)(At + t * RS + j);
#pragma unroll
        for (int e = 0; e < 4; ++e) { const f32x4 b4 = *(const LAS f32x4*)(Bt + (sq * 4 + e) * RS + j), k4 = *(const LAS f32x4*)(Kt + (sq * 4 + e) * RS + j);
            mrb[e] += a4[0] * b4[0] + a4[1] * b4[1] + a4[2] * b4[2] + a4[3] * b4[3]; mrk[e] += a4[0] * k4[0] + a4[1] * k4[1] + a4[2] * k4[2] + a4[3] * k4[3]; } }
#pragma unroll
    for (int e = 0; e < 4; ++e) { const int s = sq * 4 + e; if (s >= t) { mab[e] = 0.f; mak[e] = 0.f; } if (s > t) { mrb[e] = 0.f; mrk[e] = 0.f; } }
    LAS float* m0 = mat; LAS float* m1 = mat + 256; LAS float* m2 = mat + 512; LAS float* m3 = mat + 768;
    float T[4], P[4], Q[4];
    st16(m0, t, sq, mab); LDS_WAIT(); asm volatile("" ::: "memory");
#pragma unroll
    for (int e = 0; e < 4; ++e) T[e] = mab[e] + ((sq * 4 + e) == t ? 1.f : 0.f);
    mm16(m0, m0, t, sq, P);
    st16(m1, t, sq, P); st16(m2, t, sq, T); LDS_WAIT(); asm volatile("" ::: "memory");
    mm16(m2, m1, t, sq, Q);
#pragma unroll
    for (int e = 0; e < 4; ++e) T[e] += Q[e];
    mm16(m1, m1, t, sq, P);
    asm volatile("" ::: "memory");
    st16(m0, t, sq, P); st16(m2, t, sq, T); LDS_WAIT(); asm volatile("" ::: "memory");
    mm16(m2, m0, t, sq, Q);
#pragma unroll
    for (int e = 0; e < 4; ++e) T[e] += Q[e];
    mm16(m0, m0, t, sq, P);
    asm volatile("" ::: "memory");
    st16(m1, t, sq, P); st16(m2, t, sq, T); LDS_WAIT(); asm volatile("" ::: "memory");
    mm16(m2, m1, t, sq, Q);
#pragma unroll
    for (int e = 0; e < 4; ++e) T[e] += Q[e];
    asm volatile("" ::: "memory");
    st16(m2, t, sq, T); st16(m0, t, sq, mrb); st16(m1, t, sq, mak); LDS_WAIT(); asm volatile("" ::: "memory");
    float P1[4], TM[4], Nn[4];
    mm16(m0, m2, t, sq, P1); mm16(m2, m1, t, sq, TM);
    st16(m3, t, sq, P1); LDS_WAIT(); asm volatile("" ::: "memory");
    mm16(m3, m1, t, sq, Nn);
#pragma unroll
    for (int e = 0; e < 4; ++e) Nn[e] += mrk[e];
    unsigned char* rec = ws + SC_CREC + ((size_t)chain * 256 + c) * CR_BYTES;
    { u32x2 w; w.x = pk2(TM[0], TM[1]); w.y = pk2(TM[2], TM[3]); *(u32x2*)(rec + CR_TM + (16 * sq + t) * 8) = w;
      w.x = pk2(Nn[0], Nn[1]); w.y = pk2(Nn[2], Nn[3]); *(u32x2*)(rec + CR_N + (16 * sq + t) * 8) = w; }
    LAS unsigned short* TAh = (LAS unsigned short*)Bt; LAS unsigned short* GHh = TAh + 1024;
#pragma unroll
    for (int tt = 0; tt < 16; ++tt) { float ta = 0.f, gh = rt[tt];
#pragma unroll
        for (int s4 = 0; s4 < 4; ++s4) { const f32x4 t4 = *(const LAS f32x4*)(m2 + tt * 16 + s4 * 4), p4 = *(const LAS f32x4*)(m3 + tt * 16 + s4 * 4);
            ta += t4[0] * at[s4 * 4] + t4[1] * at[s4 * 4 + 1] + t4[2] * at[s4 * 4 + 2] + t4[3] * at[s4 * 4 + 3];
            gh += p4[0] * at[s4 * 4] + p4[1] * at[s4 * 4 + 1] + p4[2] * at[s4 * 4 + 2] + p4[3] * at[s4 * 4 + 3]; }
        TAh[tt * 64 + lane] = f2bf(ta); GHh[tt * 64 + lane] = f2bf(gh); }
    LDS_WAIT(); asm volatile("" ::: "memory");
    { const int r = lane & 15, g = lane >> 4;
#pragma unroll
      for (int ks = 0; ks < 2; ++ks) { const u32x2 a0 = *(const LAS u32x2*)(TAh + r * 64 + 32 * ks + 4 * g), a1 = *(const LAS u32x2*)(TAh + r * 64 + 32 * ks + 16 + 4 * g);
          *(u32x4*)(rec + CR_TA + (ks * 64 + lane) * 16) = (u32x4){a0.x, a0.y, a1.x, a1.y};
          const u32x2 g0 = *(const LAS u32x2*)(GHh + r * 64 + 32 * ks + 4 * g), g1 = *(const LAS u32x2*)(GHh + r * 64 + 32 * ks + 16 + 4 * g);
          *(u32x4*)(rec + CR_GH + (ks * 64 + lane) * 16) = (u32x4){g0.x, g0.y, g1.x, g1.y}; } }
    { const int jb = lane >> 4, r = lane & 15; float vv[16];
#pragma unroll
      for (int tt = 0; tt < 16; ++tt) { const int pos = dir ? (SEQ - 1 - 16 * c - tt) : (16 * c + tt); vv[tt] = Vp[(size_t)(b * SEQ + pos) * 512 + h * 64 + lane]; }
#pragma unroll
      for (int g = 0; g < 4; ++g) { u32x4 w; w.x = pk2(wb[4 * g], wb[4 * g + 1]); w.y = pk2(wb[4 * g + 2], wb[4 * g + 3]); w.z = pk2(wk[4 * g], wk[4 * g + 1]); w.w = pk2(wk[4 * g + 2], wk[4 * g + 3]);
          *(u32x4*)(rec + CR_WBK + (jb * 64 + 16 * g + r) * 16) = w;
          u32x2 x; x.x = pk2(vv[4 * g], vv[4 * g + 1]); x.y = pk2(vv[4 * g + 2], vv[4 * g + 3]); *(u32x2*)(rec + CR_V + (jb * 64 + 16 * g + r) * 8) = x; } }
    LDS_WAIT(); asm volatile("" ::: "memory");
}

__device__ __forceinline__ void cprep_phase(Frame& F, int layer) {
    LAS float* Lw = (LAS float*)(F.lds + F.wave * 17408);
    for (int it = F.bid * 8 + F.wave; it < 32 * 256; it += F.G * 8) { const int c = it >> 5, chain = it & 31; rwkv_cprep_item(F, chain, c, Lw); }
    asm volatile("" ::: "memory");
    for (int it = F.bid * 8 + F.wave; it < 2048; it += F.G * 8) s5_block_task<2>(F, layer, it, Lw);
}

template <class P, class T> struct RwPtr { typedef const T* type; };
template <class T> struct RwPtr<const LAS unsigned char*, T> { typedef const LAS T* type; };
struct RwOps { bf16x8 ta[2], gh[2], wbk[4]; u32x2 tm, nn, vq[2]; f32x4 wl[4]; };
template <class P> __device__ __forceinline__ void rw_load(RwOps& o, P rec, int lane, int half) {
    const int g = lane >> 4;
#pragma unroll
    for (int ks = 0; ks < 2; ++ks) { o.ta[ks] = *(const typename RwPtr<P, bf16x8>::type)(rec + CR_TA + (ks * 64 + lane) * 16); o.gh[ks] = *(const typename RwPtr<P, bf16x8>::type)(rec + CR_GH + (ks * 64 + lane) * 16); }
#pragma unroll
    for (int jb = 0; jb < 4; ++jb) { o.wbk[jb] = *(const typename RwPtr<P, bf16x8>::type)(rec + CR_WBK + (jb * 64 + lane) * 16); o.wl[jb] = *(const typename RwPtr<P, f32x4>::type)(rec + CR_WL + (jb * 16 + g * 4) * 4); }
    o.tm = *(const typename RwPtr<P, u32x2>::type)(rec + CR_TM + lane * 8); o.nn = *(const typename RwPtr<P, u32x2>::type)(rec + CR_N + lane * 8);
#pragma unroll
    for (int it = 0; it < 2; ++it) o.vq[it] = *(const typename RwPtr<P, u32x2>::type)(rec + CR_V + ((half * 2 + it) * 64 + lane) * 8);
}
__device__ __forceinline__ bf16x8 mk8(unsigned a, unsigned b, unsigned c, unsigned d) { u32x4 w = {a, b, c, d}; return *reinterpret_cast<bf16x8*>(&w); }
__device__ __forceinline__ void rw_step(const RwOps& o, f32x4 (&X)[4][2], float* ysb, const long rs, int lane) {
    const int r = lane & 15, g = lane >> 4;
    const bf16x8 tmf = mk8(o.tm.x, o.tm.y, 0u, 0u), nf = mk8(o.nn.x, o.nn.y, 0u, 0u);
#pragma unroll
    for (int it = 0; it < 2; ++it) {
        bf16x8 xb[2];
#pragma unroll
        for (int ks = 0; ks < 2; ++ks) xb[ks] = mk8(pk2c(X[2 * ks][it][0], X[2 * ks][it][1]), pk2c(X[2 * ks][it][2], X[2 * ks][it][3]), pk2c(X[2 * ks + 1][it][0], X[2 * ks + 1][it][1]), pk2c(X[2 * ks + 1][it][2], X[2 * ks + 1][it][3]));
        const bf16x8 vb = mk8(o.vq[it].x, o.vq[it].y, 0u, 0u);
        f32x4 U = {0.f, 0.f, 0.f, 0.f}, Y = {0.f, 0.f, 0.f, 0.f};
        U = __builtin_amdgcn_mfma_f32_16x16x32_bf16(o.ta[0], xb[0], U, 0, 0, 0); Y = __builtin_amdgcn_mfma_f32_16x16x32_bf16(o.gh[0], xb[0], Y, 0, 0, 0);
        U = __builtin_amdgcn_mfma_f32_16x16x32_bf16(o.ta[1], xb[1], U, 0, 0, 0); Y = __builtin_amdgcn_mfma_f32_16x16x32_bf16(o.gh[1], xb[1], Y, 0, 0, 0);
        U = __builtin_amdgcn_mfma_f32_16x16x32_bf16(tmf, vb, U, 0, 0, 0);       Y = __builtin_amdgcn_mfma_f32_16x16x32_bf16(nf, vb, Y, 0, 0, 0);
        const bf16x8 uvb = mk8(pk2c(U[0], U[1]), pk2c(U[2], U[3]), o.vq[it].x, o.vq[it].y);
#pragma unroll
        for (int jb = 0; jb < 4; ++jb) X[jb][it] = __builtin_amdgcn_mfma_f32_16x16x32_bf16(o.wbk[jb], uvb, X[jb][it] * o.wl[jb], 0, 0, 0);
#pragma unroll
        for (int q = 0; q < 4; ++q) ysb[(long)(4 * g + q) * rs + 16 * it + r] = Y[q];
    }
}
__device__ __forceinline__ void rwkv_scan_chunked(Frame& F, int chain, int half) {
    unsigned char* ws = F.ws; asm volatile("" : "+s"(ws)); const int dir = chain & 1, h = (chain >> 1) & 7, b = chain >> 4; const int lane = F.lane;
    const unsigned char* rec0 = ws + SC_CREC + (size_t)chain * 256 * CR_BYTES;
#ifdef DBG_RWCHK
    float* YS = (float*)(ws + WS_HN) + (size_t)dir * NTOK * 512;
#else
    float* YS = (float*)(ws + SC_YS) + (size_t)dir * NTOK * 512;
#endif
    f32x4 X[4][2];
#pragma unroll
    for (int jb = 0; jb < 4; ++jb) { X[jb][0] = (f32x4){0.f, 0.f, 0.f, 0.f}; X[jb][1] = (f32x4){0.f, 0.f, 0.f, 0.f}; }
    RwOps oa, ob;
    rw_load(oa, rec0, lane, half);
    const long rs = dir ? -512 : 512;
    for (int c = 0; c < 256; c += 2) {
        rw_load(ob, rec0 + (size_t)(c + 1) * CR_BYTES, lane, half);
        { const int pos0 = dir ? (SEQ - 1 - 16 * c) : 16 * c; rw_step(oa, X, YS + (size_t)(b * SEQ + pos0) * 512 + h * 64 + half * 32, rs, lane); }
        if (c + 2 < 256) rw_load(oa, rec0 + (size_t)(c + 2) * CR_BYTES, lane, half);
        { const int pos0 = dir ? (SEQ - 1 - 16 * (c + 1)) : 16 * (c + 1); rw_step(ob, X, YS + (size_t)(b * SEQ + pos0) * 512 + h * 64 + half * 32, rs, lane); }
    }
}

__device__ __forceinline__ void rwkv_scan_ring(Frame& F, int pair) {
    unsigned char* ws = F.ws; asm volatile("" : "+s"(ws));
    const int w = F.wave, lane = F.lane;
    LAS unsigned char* ring = F.lds;
    __syncthreads();
    if (w < 4) {
        const int chain = pair * 2 + (w >> 1), half = w & 1; const int dir = chain & 1, h = (chain >> 1) & 7, b = chain >> 4;
        float* YS = (float*)(ws + SC_YS) + (size_t)dir * NTOK * 512;
        f32x4 X[4][2];
#pragma unroll
        for (int jb = 0; jb < 4; ++jb) { X[jb][0] = (f32x4){0.f, 0.f, 0.f, 0.f}; X[jb][1] = (f32x4){0.f, 0.f, 0.f, 0.f}; }
        const long rs = dir ? -512 : 512;
        __syncthreads();
#pragma unroll 1
        for (int c = 0; c < 256; ++c) {
            RwOps o; rw_load(o, (const LAS unsigned char*)(ring + ((w >> 1) * 2 + (c & 1)) * CR_BYTES), lane, half);
            const int pos0 = dir ? (SEQ - 1 - 16 * c) : 16 * c; rw_step(o, X, YS + (size_t)(b * SEQ + pos0) * 512 + h * 64 + half * 32, rs, lane);
            __syncthreads();
        }
    } else {
        const int k = (w - 4) >> 1, part = (w - 4) & 1; const int chain = pair * 2 + k;
        const unsigned char* rec0 = ws + SC_CREC + (size_t)chain * 256 * CR_BYTES;
        LAS unsigned char* dst0 = ring + (k * 2) * CR_BYTES;
        const int i0 = (part * 64 + lane) * 16;
        u32x4 R0[6], R1[6], R2[6];
#define RW_LD(R, cc) do { const unsigned char* p_ = rec0 + (size_t)(cc) * CR_BYTES + i0; _Pragma("unroll") for (int j = 0; j < 6; ++j) if (j < 5 || i0 + 2048 * 5 < CR_BYTES) R[j] = *(const u32x4*)(p_ + 2048 * j); } while (0)
#define RW_ST(R, cc) do { LAS unsigned char* d_ = dst0 + ((cc) & 1) * CR_BYTES + i0; _Pragma("unroll") for (int j = 0; j < 6; ++j) if (j < 5 || i0 + 2048 * 5 < CR_BYTES) *(LAS u32x4*)(d_ + 2048 * j) = R[j]; } while (0)
        RW_LD(R0, 0); RW_LD(R1, 1); RW_LD(R2, 2);
        RW_ST(R0, 0); RW_LD(R0, 3);
        __syncthreads();
#pragma unroll 1
        for (int c = 0; c < 255; c += 3) {
            RW_ST(R1, c + 1); if (c + 4 < 256) RW_LD(R1, c + 4); __syncthreads();
            RW_ST(R2, c + 2); if (c + 5 < 256) RW_LD(R2, c + 5); __syncthreads();
            RW_ST(R0, c + 3); if (c + 6 < 256) RW_LD(R0, c + 6); __syncthreads();
        }
        __syncthreads();
#undef RW_LD
#undef RW_ST
    }
}

__device__ __forceinline__ void rwkv_scan_naive(Frame& F, int chain) {
    unsigned char* ws = F.ws; const float* RW = (const float*)(ws + SC_RW); const size_t N1 = (size_t)NTOK * 512;
    const int dir = chain & 1, h = (chain >> 1) & 7, b = chain >> 4;
    const float* Rp = RW; const float* Vp = RW + N1; const float* KKp = RW + 2 * N1; const float* Wp = RW + (3 + dir) * N1; const float* KMp = RW + (5 + dir) * N1; const float* BBp = RW + (7 + dir) * N1;
    float* YS = (float*)(ws + SC_YS) + (size_t)dir * N1;
    LAS float* L = (LAS float*)(F.lds + F.wave * 2048);
    float st[64];
#pragma unroll
    for (int j = 0; j < 64; ++j) st[j] = 0.f;
    size_t idx = (size_t)(b * SEQ + (dir ? SEQ - 1 : 0)) * 512 + h * 64 + F.lane;
    float va = -KKp[idx], vw = __expf(Wp[idx]), vb = BBp[idx], vk = KMp[idx], vr = Rp[idx], vv = Vp[idx];
    for (int t = 0; t < SEQ; ++t) {
        L[F.lane] = va; L[64 + F.lane] = vw; L[128 + F.lane] = vb; L[192 + F.lane] = vk; L[256 + F.lane] = vr;
        const float v = vv; const size_t oidx = idx;
        if (t + 1 < SEQ) { idx = dir ? idx - 512 : idx + 512; va = -KKp[idx]; vw = __expf(Wp[idx]); vb = BBp[idx]; vk = KMp[idx]; vr = Rp[idx]; vv = Vp[idx]; }
        LDS_WAIT(); asm volatile("" ::: "memory");
        float sa0 = 0.f, sa1 = 0.f, sa2 = 0.f, sa3 = 0.f;
#pragma unroll
        for (int j = 0; j < 64; j += 4) { const f32x4 x = *(const LAS f32x4*)(L + j); sa0 += st[j] * x[0]; sa1 += st[j + 1] * x[1]; sa2 += st[j + 2] * x[2]; sa3 += st[j + 3] * x[3]; }
        const float sa = (sa0 + sa1) + (sa2 + sa3);
        float y0 = 0.f, y1 = 0.f, y2 = 0.f, y3 = 0.f;
#pragma unroll
        for (int j = 0; j < 64; j += 4) { const f32x4 w4 = *(const LAS f32x4*)(L + 64 + j), b4 = *(const LAS f32x4*)(L + 128 + j), k4 = *(const LAS f32x4*)(L + 192 + j), r4 = *(const LAS f32x4*)(L + 256 + j);
            st[j] = st[j] * w4[0] + (sa * b4[0] + v * k4[0]); st[j + 1] = st[j + 1] * w4[1] + (sa * b4[1] + v * k4[1]); st[j + 2] = st[j + 2] * w4[2] + (sa * b4[2] + v * k4[2]); st[j + 3] = st[j + 3] * w4[3] + (sa * b4[3] + v * k4[3]);
            y0 += st[j] * r4[0]; y1 += st[j + 1] * r4[1]; y2 += st[j + 2] * r4[2]; y3 += st[j + 3] * r4[3]; }
        YS[oidx] = (y0 + y1) + (y2 + y3);
        asm volatile("" ::: "memory");
    }
}

__device__ __forceinline__ void s5_unit(Frame& F, ArgsP a, int layer, int unit) {
    unsigned char* ws = F.ws; asm volatile("" : "+s"(ws)); const bf16* Z = (const bf16*)(ws + SC_Z);
    const int b = unit / S5NCH, ch = unit % S5NCH; const int tok0 = b * SEQ + ch * S5CH;
    LAS float* ybuf = (LAS float*)F.lds;
    LAS unsigned short* gla = (LAS unsigned short*)(F.lds + 32768);
    LAS unsigned short* xa = (LAS unsigned short*)(F.lds + 49408 + F.wave * 4352);
    LAS float* ulw = (LAS float*)(F.lds + RING_BYTES + F.wave * 1024);
    const float* ab = (const float*)(ws + WS_S5P + layer * S5P_LAYER); const float* bb = ab + 2 * 32 * 64 * 2;
    const float* carry = (const float*)(ws + SC_CARRY);
    const int n = F.lane, r = n & 15, g4 = n >> 4;
    __syncthreads();
    for (int gi = 0; gi < 4; ++gi) {
        const int g = gi * 8 + F.wave;
        { const int tl = (n >> 1) & 15, hf = n & 1; const u32x4 w0 = *(const u32x4*)(Z + (size_t)(tok0 + tl) * ZLD + ZD + g * 16 + hf * 8);
          if (n < 32) { LAS f32x4* d = (LAS f32x4*)(ulw + tl * 16 + hf * 8);
            d[0] = (f32x4){__uint_as_float(w0.x << 16), __uint_as_float(w0.x & 0xffff0000u), __uint_as_float(w0.y << 16), __uint_as_float(w0.y & 0xffff0000u)};
            d[1] = (f32x4){__uint_as_float(w0.z << 16), __uint_as_float(w0.z & 0xffff0000u), __uint_as_float(w0.w << 16), __uint_as_float(w0.w & 0xffff0000u)}; } }
        float abr2[2], abi2[2], cr2[2], ci2[2];
#pragma unroll
        for (int dir = 0; dir < 2; ++dir) { const int pr = (dir * 32 + g) * 64 + n; abr2[dir] = ab[pr * 2]; abi2[dir] = ab[pr * 2 + 1];
            const float* cp = carry + ((((size_t)dir * BATCH + b) * S5NCH + ch) * 32 + g) * 128 + n * 2; cr2[dir] = cp[0]; ci2[dir] = cp[1]; }
        bf16x8 cwf[4];
        { const bf16* cw = (const bf16*)(ws + WS_S5CW) + ((size_t)(layer * 32 + g) * 16 + r) * 128 + g4 * 8;
#pragma unroll
          for (int ks = 0; ks < 4; ++ks) cwf[ks] = *(const bf16x8*)(cw + ks * 32); }
        LDS_WAIT(); asm volatile("" ::: "memory");
        float xfr[16], xfi[16];
#pragma unroll
        for (int dir = 0; dir < 2; ++dir) {
            const int pr = (dir * 32 + g) * 64 + n; const float abr = abr2[dir], abi = abi2[dir];
            float bbr[16], bbi[16];
            { const f32x4* bp = (const f32x4*)(bb + (size_t)pr * 32);
#pragma unroll
              for (int c4 = 0; c4 < 8; ++c4) { const f32x4 q = bp[c4]; bbr[c4 * 2] = q[0]; bbi[c4 * 2] = q[1]; bbr[c4 * 2 + 1] = q[2]; bbi[c4 * 2 + 1] = q[3]; } }
            float xr = cr2[dir], xi = ci2[dir];
#pragma unroll
            for (int i = 0; i < S5CH; ++i) { const int tl = dir ? (S5CH - 1 - i) : i;
                const f32x4 u0 = *(const LAS f32x4*)(ulw + tl * 16), u1 = *(const LAS f32x4*)(ulw + tl * 16 + 4), u2 = *(const LAS f32x4*)(ulw + tl * 16 + 8), u3 = *(const LAS f32x4*)(ulw + tl * 16 + 12);
                float br = 0.f, bi = 0.f;
#pragma unroll
                for (int c = 0; c < 4; ++c) { br += bbr[c] * u0[c] + bbr[4 + c] * u1[c] + bbr[8 + c] * u2[c] + bbr[12 + c] * u3[c]; bi += bbi[c] * u0[c] + bbi[4 + c] * u1[c] + bbi[8 + c] * u2[c] + bbi[12 + c] * u3[c]; }
                const float nr = abr * xr - abi * xi + br, ni = abr * xi + abi * xr + bi; xr = nr; xi = ni;
                if (dir == 0) { xfr[tl] = xr; xfi[tl] = xi; }
                else { xa[tl * 136 + n] = f2bf(xfr[tl] + xr); xa[tl * 136 + 64 + n] = f2bf(xfi[tl] + xi); }
                if ((i & 3) == 3) asm volatile("" ::: "memory"); }
        }
        LDS_WAIT(); asm volatile("" ::: "memory");
        { f32x4 y = {0.f, 0.f, 0.f, 0.f};
#pragma unroll
          for (int ks = 0; ks < 4; ++ks) { const bf16x8 af = *(const LAS bf16x8*)(xa + r * 136 + ks * 32 + g4 * 8); y = __builtin_amdgcn_mfma_f32_16x16x32_bf16(af, cwf[ks], y, 0, 0, 0); }
          const float dsk = a->in[I_S5_D][(size_t)layer * 512 + g * 16 + r];
#pragma unroll
          for (int q = 0; q < 4; ++q) { const int tl = 4 * g4 + q; const float yy = y[q] + dsk * ulw[tl * 16 + r];
              const float x3 = yy * yy * yy; const float gl = 0.5f * yy * (1.f + tanhf(0.7978845608028654f * (yy + 0.044715f * x3)));
              ybuf[tl * 512 + g * 16 + r] = gl; gla[tl * 520 + g * 16 + r] = f2bf(gl); } }
        LDS_WAIT(); asm volatile("" ::: "memory");
    }
    __syncthreads();
    { f32x4 acc[4];
#pragma unroll
      for (int j = 0; j < 4; ++j) acc[j] = (f32x4){0.f, 0.f, 0.f, 0.f};
      const bf16* wt = (const bf16*)(ws + WS_GLUT) + (size_t)layer * 512 * 512 + (size_t)(F.wave * 64 + r) * 512 + g4 * 8;
#pragma unroll 1
      for (int k0 = 0; k0 < 16; k0 += 4) { bf16x8 bf_[4][4];
#pragma unroll
          for (int kk = 0; kk < 4; ++kk)
#pragma unroll
              for (int j = 0; j < 4; ++j) bf_[kk][j] = *(const bf16x8*)(wt + (size_t)j * 16 * 512 + (k0 + kk) * 32);
#pragma unroll
          for (int kk = 0; kk < 4; ++kk) { const bf16x8 af = *(const LAS bf16x8*)(gla + r * 520 + (k0 + kk) * 32 + g4 * 8);
#pragma unroll
              for (int j = 0; j < 4; ++j) acc[j] = __builtin_amdgcn_mfma_f32_16x16x32_bf16(af, bf_[kk][j], acc[j], 0, 0, 0); } }
#pragma unroll
      for (int j = 0; j < 4; ++j) { const int c = F.wave * 64 + j * 16 + r; const float bias = a->in[I_S5_GLU_B][(size_t)layer * 512 + c];
#pragma unroll
          for (int q = 0; q < 4; ++q) { const int tl = 4 * g4 + q; const float gl = ybuf[tl * 512 + c]; ybuf[tl * 512 + c] = gl * sigmoidf_(acc[j][q] + bias); } } }
    __syncthreads();
    { const float* gn = a->in[I_MIX_OUT_NORM] + ((size_t)layer * 2 + 1) * 512; bf16* MIX = (bf16*)(ws + WS_MIX);
#pragma unroll
      for (int q = 0; q < 2; ++q) { const int tl = F.wave * 2 + q; float v[8]; float s = 0.f;
#pragma unroll
          for (int j = 0; j < 8; ++j) { v[j] = ybuf[tl * 512 + j * 64 + F.lane]; s += v[j] * v[j]; }
          const float rstd = 1.f / sqrtf(wave_sum(s) * (1.f / 512.f) + RMS_EPS);
#pragma unroll
          for (int j = 0; j < 8; ++j) MIX[(size_t)(tok0 + tl) * DM + 1536 + j * 64 + F.lane] = f2bf(v[j] * rstd * gn[j * 64 + F.lane]); } }
}

template <int mask>
__device__ __forceinline__ void mix_phase(Frame& F, ArgsP a, int layer, const int rep) {
    const int qb_ = (rep * 2 + layer) * 8;
    constexpr int NB = 16, NA = BATCH * 4 * (SEQ / 128), NC = BATCH * 4 * 48, ND = BATCH * S5NCH;
    if (mask & 1) for (;;) { const int it = q_next(F, qb_ + 1); if (it >= NB) break; rwkv_scan_ring(F, it); }
    if (mask & 2) for (;;) { const int it = q_next(F, qb_ + 2); if (it >= NA) break;
        unsigned char* ws = F.ws; asm volatile("" : "+s"(ws)); const bf16* Z = (const bf16*)(ws + SC_Z);
        const int qb = it % (SEQ / 128), h = (it / (SEQ / 128)) % 4, b = it / (4 * (SEQ / 128));
        const bf16* zb = Z + (size_t)(b * SEQ) * ZLD + ZA;
        float lam, lam_init;
        { const float* lv = a->in[I_DIFF_LAMBDA] + (size_t)layer * 4 * 64; float d1 = 0.f, d2 = 0.f;
          for (int i = 0; i < 64; ++i) { d1 += lv[i] * lv[64 + i]; d2 += lv[128 + i] * lv[192 + i]; }
          lam_init = 0.8f - 0.6f * expf(-0.3f * (float)layer); lam = expf(d1) - expf(d2) + lam_init; }
        att::diff_attn_unit(zb + (size_t)(qb * 128) * ZLD + h * 128, zb + 512 + h * 128, zb + 1024 + h * 128, ZLD, SEQ,
                            (bf16*)(ws + WS_MIX) + (size_t)(b * SEQ + qb * 128) * DM + h * 128, DM, lam, 1.f - lam_init, a->in[I_DIFF_SUBLN] + (size_t)layer * 128, (char*)F.lds, F.wave); }
#ifdef DBG_RWCHK
    for (;;) { const int it = q_next(F, layer * 8 + 5); if (it >= 4) break; rwkv_scan_naive(F, it * 8 + F.wave); }
#endif
    if (mask & 4) for (;;) { const int it = q_next(F, qb_ + 3); if (it >= NC) break;
        unsigned char* ws = F.ws; asm volatile("" : "+s"(ws)); const bf16* Z = (const bf16*)(ws + SC_Z);
        const int r = it % 48, h = (it / 48) % 4, b = it / (48 * 4); const int p = r / 16, rr = r % 16;
        const int dil = p == 0 ? 1 : (p == 1 ? 4 : 16); const int L = SEQ / dil; const int nqb = L / 256; const int rho = rr / nqb, qb = rr % nqb;
        const bf16* zb = Z + (size_t)(b * SEQ) * ZLD + ZC;
        att::dil_attn_unit(zb + h * 128, zb + 512 + h * 128, zb + 1024 + h * 128, ZLD, dil, rho, qb * 256, L,
                           (float*)(ws + SC_OC) + ((size_t)p * NTOK + (size_t)b * SEQ) * 512 + h * 128, (float*)(ws + SC_LSE) + ((size_t)p * NTOK + (size_t)b * SEQ) * 4 + h, (char*)F.lds, F.wave); }
    if (mask & 8) for (;;) { const int it = q_next(F, qb_ + 4); if (it >= ND) break; s5_unit(F, a, layer, it); }
}

__device__ __forceinline__ void post_phase(Frame& F, ArgsP a, int layer) {
    unsigned char* ws = F.ws; bf16* MIX = (bf16*)(ws + WS_MIX);
    const int gw = F.bid * 8 + F.wave, NGW = F.G * 8;
    const float* RW = (const float*)(ws + SC_RW); const size_t N1 = (size_t)NTOK * 512; const float* YS = (const float*)(ws + SC_YS);
#ifdef DBG_RWCHK
    { const float* Y2 = (const float*)(ws + WS_HN); float e = 0.f, r2 = 0.f; int bad = 0;
      for (size_t i = (size_t)F.bid * 512 + F.tid; i < (size_t)2 * NTOK * 512; i += (size_t)F.G * 512) { const float a0 = ((const float*)(ws + SC_YS))[i], b0 = Y2[i]; const float d = fabsf(a0 - b0); if (!(d < 1e30f)) bad = 1; else e = fmaxf(e, d); r2 = fmaxf(r2, fabsf(a0)); }
      e = wave_max(e); r2 = wave_max(r2); bad = __any(bad) ? 1 : 0;
      if (F.lane == 0) { atomicMax(F.ctl + 32768 + layer * 64, __float_as_uint(e)); atomicMax(F.ctl + 32768 + layer * 64 + 1, __float_as_uint(r2)); if (bad) atomicMax(F.ctl + 32768 + layer * 64 + 2, 1u); } }
#endif
    for (int tok = gw; tok < NTOK; tok += NGW) {
        float y[8], r_[8], v_[8], kb[8], gg[8];
#pragma unroll
        for (int h = 0; h < 8; ++h) { const size_t o = (size_t)tok * 512 + h * 64 + F.lane; y[h] = YS[o] + YS[N1 + o]; r_[h] = RW[o]; v_[h] = RW[N1 + o]; kb[h] = 0.5f * (RW[5 * N1 + o] + RW[6 * N1 + o]); gg[h] = RW[9 * N1 + o]; }
#pragma unroll
        for (int h = 0; h < 8; ++h) { const int c = h * 64 + F.lane;
            const float mean = wave_sum(y[h]) * (1.f / 64.f); const float d = y[h] - mean; const float var = wave_sum(d * d) * (1.f / 64.f);
            const float yn = d * (1.f / sqrtf(var + 64e-5f)) * a->in[I_RWKV_LNX_W][(size_t)layer * 512 + c] + a->in[I_RWKV_LNX_B][(size_t)layer * 512 + c];
            const float bon = wave_sum(r_[h] * kb[h] * a->in[I_RWKV_RK][(size_t)layer * 512 + c]) * v_[h];
            MIX[(size_t)tok * DM + 512 + c] = f2bf((yn + bon) * gg[h]); } }
    const float* OC = (const float*)(ws + SC_OC); const float* LSE = (const float*)(ws + SC_LSE); const float* gn = a->in[I_MIX_OUT_NORM] + ((size_t)layer * 2 + 0) * 512;
    for (int tok = gw; tok < NTOK; tok += NGW) { const int h = F.lane >> 4;
        const float l0 = LSE[((size_t)0 * NTOK + tok) * 4 + h], l1 = LSE[((size_t)1 * NTOK + tok) * 4 + h], l2 = LSE[((size_t)2 * NTOK + tok) * 4 + h];
        const float m = fmaxf(l0, fmaxf(l1, l2)); float w0 = __expf(l0 - m), w1 = __expf(l1 - m), w2 = __expf(l2 - m); const float inv = 1.f / (w0 + w1 + w2); w0 *= inv; w1 *= inv; w2 *= inv;
        float v[8]; float s = 0.f;
        const f32x4* p0 = (const f32x4*)(OC + ((size_t)0 * NTOK + tok) * 512) + F.lane * 2; const f32x4* p1 = (const f32x4*)(OC + ((size_t)1 * NTOK + tok) * 512) + F.lane * 2; const f32x4* p2 = (const f32x4*)(OC + ((size_t)2 * NTOK + tok) * 512) + F.lane * 2;
#pragma unroll
        for (int j = 0; j < 2; ++j) { const f32x4 a0 = p0[j], a1 = p1[j], a2 = p2[j];
#pragma unroll
            for (int e = 0; e < 4; ++e) { const float x = w0 * a0[e] + w1 * a1[e] + w2 * a2[e]; v[j * 4 + e] = x; s += x * x; } }
        const float rstd = 1.f / sqrtf(wave_sum(s) * (1.f / 512.f) + RMS_EPS);
        const f32x4 g0 = *((const f32x4*)gn + F.lane * 2), g1 = *((const f32x4*)gn + F.lane * 2 + 1);
        u32x4 w; w.x = pk2(v[0] * rstd * g0[0], v[1] * rstd * g0[1]); w.y = pk2(v[2] * rstd * g0[2], v[3] * rstd * g0[3]); w.z = pk2(v[4] * rstd * g1[0], v[5] * rstd * g1[1]); w.w = pk2(v[6] * rstd * g1[2], v[7] * rstd * g1[3]);
        *(u32x4*)(MIX + (size_t)tok * DM + 1024 + F.lane * 8) = w; }
}

#ifndef MK_FUSED
#define MK_FUSED 1
#endif
__global__ void __launch_bounds__(512, 2) enc_fwd(Args args_) {
    extern __shared__ __attribute__((aligned(16))) unsigned char lds_raw[];
    Frame F;
    F.lds = (LAS unsigned char*)lds_raw; F.MISC = (volatile LAS unsigned*)(F.lds + MISC_OFF);
    F.tid = threadIdx.x; F.lane = F.tid & 63; F.wave = __builtin_amdgcn_readfirstlane(F.tid >> 6); F.G = gridDim.x; F.bid = blockIdx.x;
    const int wave0 = F.wave;
    ArgsP ap = (ArgsP)__builtin_amdgcn_kernarg_segment_ptr();
    unsigned char* ws = ap->ws; F.ws = ws; F.ctl = (unsigned*)(ws + WS_CTL);
    for (int u = F.tid; u < (LDS_BYTES - MISC_OFF) / 4; u += 512) ((LAS unsigned*)(F.lds + MISC_OFF))[u] = 0u;
    __syncthreads();
    const int lo = ap->ph_lo, hi = ap->ph_hi;
    if (hi - lo > 1) (void)xcd_barrier_post(F.ctl + CW_BAR, F.MISC + 8);
#ifdef DBG_ONLY
#define IN(k) (((k) < PH_L0 ? (k) : ((k) == PH_FINAL ? 100 : 3 + ((k) - PH_L0) % NPH_L)) == DBG_ONLY && lo <= (k) && (k) < hi)
#else
#define IN(k) ({ int lo_ = lo, hi_ = hi; asm volatile("" : "+s"(lo_), "+s"(hi_)); lo_ <= (k) && (k) < hi_; })
#endif
#define args (*ap)
#define REFRESH() do { int wv_ = wave0, bi_ = blockIdx.x, gg_ = gridDim.x; asm volatile("" : "+s"(wv_), "+s"(bi_), "+s"(gg_)); const int t_ = tid_from_wave(wv_); F.tid = t_; F.lane = t_ & 63; F.wave = wv_; F.bid = bi_; F.G = gg_; ap = (ArgsP)__builtin_amdgcn_kernarg_segment_ptr(); asm volatile("" : "+s"(ap)); unsigned char* w_ = ap->ws; F.ws = w_; ws = w_; F.ctl = (unsigned*)(w_ + WS_CTL); } while (0)
#ifndef DBG_MIXMASK
#define DBG_MIXMASK 15
#endif
#ifndef DBG_REP_CODE
#define DBG_REP_CODE -1
#define DBG_REP_N 0
#endif
#define REPS(code) (((code) == DBG_REP_CODE && l_ == 0) ? 1 + DBG_REP_N : 1)
#ifdef DBG_TIME_A
#define STAMP(k) do { if (blockIdx.x == 0 && threadIdx.x == 0) { const unsigned long long t_ = wall_clock64(); F.MISC[192 + 2 * (k)] = (unsigned)t_; F.MISC[193 + 2 * (k)] = (unsigned)(t_ >> 32); } } while (0)
#else
#define STAMP(k) do {} while (0)
#endif
#define SEAM(k) do { if (IN(k) && IN((k) + 1)) { XcdBarrier b_; b_.bar = (unsigned*)(ap->ws + WS_CTL) + CW_BAR; b_.x = xb_xcc_id(); b_.st = F.MISC + 8; xcd_barrier(b_); } } while (0)

    { const int l_ = 0; STAMP(PH_P0); if (IN(PH_P0)) { REFRESH(); for (int rep = 0; rep < REPS(0); ++rep) p0_prologue(F, ap); } } SEAM(PH_P0);
    if (DBG_REP_CODE == 30 && hi - lo > 1) { for (int i = 0; i < 20; ++i) { XcdBarrier b_; b_.bar = (unsigned*)(ap->ws + WS_CTL) + CW_BAR; b_.x = xb_xcc_id(); b_.st = F.MISC + 8; xcd_barrier(b_); } }
    STAMP(PH_P1); if (IN(PH_P1)) { REFRESH();
        SchedBatch S{(const char*)(ws + SC_MEMN), (const char*)(ws + SC_WKVT), (char*)(ws + SC_KVB), (size_t)512 * DM * 2, (size_t)4096 * DM * 2, (size_t)512 * 4096 * 2, 2, 16, DEPTH, F.G, F.bid, DM, DM, 4096 * 2, 2, 512};
        { const int l_ = 0; for (int rep = 0; rep < REPS(1); ++rep) pg8::gemm_phase<pg8::EpiBf16, SchedBatch, false>(F.lds, pg8::GemmP{DM, DM, DM}, S, pg8::EpiBf16{4096}, F.wave); }
    } SEAM(PH_P1);
    STAMP(PH_P2); if (IN(PH_P2)) { REFRESH();
        { SchedXaPre S{ws, F.G, F.bid, 0}; pg8::gemm_phase<EpiBf16U, SchedXaPre, false>(F.lds, pg8::GemmP{512, 4096, DM}, S, EpiBf16U{}, F.wave); }
        { SchedXaPre S{ws, F.G, F.bid, 1}; pg8::gemm_phase<EpiBf16U, SchedXaPre, false>(F.lds, pg8::GemmP{512, DM, 4096}, S, EpiBf16U{}, F.wave); }
    } SEAM(PH_P2);

    for (int l = 0; l < DEPTH; ++l) {
        const int pb = PH_L0 + l * NPH_L; const int l_ = l;
        float* H = (float*)(ws + WS_H);
        STAMP(pb + LP_NORM1); if (IN(pb + LP_NORM1)) { REFRESH(); if (l == 0) { for (int rep = 0; rep < REPS(22); ++rep) norm_phase<0>(F, ap, args.in[I_X], args.in[I_NORM_MIX], l); } else norm_phase<1>(F, ap, H, args.in[I_NORM_MIX] + (size_t)l * DM, l); } SEAM(pb + LP_NORM1);
        STAMP(pb + LP_G1); if (IN(pb + LP_G1)) { REFRESH();
            SchedDense S{(const char*)(ws + WS_HN), (const char*)(ws + WS_WIN) + (size_t)l * ZLD * DM * 2, (char*)(ws + SC_Z), NTOK / 256, ZLD / 256, F.G, F.bid, DM, DM, ZLD * 2, 2};
            for (int rep = 0; rep < REPS(10); ++rep) pg8::gemm_phase<pg8::EpiBf16, SchedDense, false>(F.lds, pg8::GemmP{DM, DM, DM}, S, pg8::EpiBf16{ZLD}, F.wave);
        } SEAM(pb + LP_G1);
        STAMP(pb + LP_PREP); if (IN(pb + LP_PREP)) { REFRESH(); for (int rep = 0; rep < REPS(11); ++rep) prep_phase(F, ap, l, rep); } SEAM(pb + LP_PREP);
        STAMP(pb + LP_CPREP); if (IN(pb + LP_CPREP)) { REFRESH(); for (int rep = 0; rep < REPS(12); ++rep) cprep_phase(F, l); } SEAM(pb + LP_CPREP);
        STAMP(pb + LP_MIX); if (IN(pb + LP_MIX)) { REFRESH(); mix_phase<DBG_MIXMASK>(F, ap, l, 0); if (DBG_REP_CODE >= 13 && DBG_REP_CODE <= 16 && l_ == 0) { REFRESH(); mix_phase<(DBG_REP_CODE >= 13 && DBG_REP_CODE <= 16) ? (1 << (DBG_REP_CODE - 13)) : 1>(F, ap, l, 1); if (DBG_REP_N > 1) { REFRESH(); mix_phase<(DBG_REP_CODE >= 13 && DBG_REP_CODE <= 16) ? (1 << (DBG_REP_CODE - 13)) : 1>(F, ap, l, 2); } } } SEAM(pb + LP_MIX);
        STAMP(pb + LP_POST); if (IN(pb + LP_POST)) { REFRESH(); for (int rep = 0; rep < REPS(17); ++rep) post_phase(F, ap, l); } SEAM(pb + LP_POST);
        STAMP(pb + LP_G2); if (IN(pb + LP_G2)) { REFRESH();
            SchedDense S{(const char*)(ws + WS_MIX), (const char*)(ws + WS_WOUT) + (size_t)l * DM * DM * 2, (char*)H, NTOK / 256, DM / 256, F.G, F.bid, DM, DM, DM * 4, 4};
            for (int rep = 0; rep < REPS(23); ++rep) pg8::gemm_phase<pg8::EpiF32Res, SchedDense, false>(F.lds, pg8::GemmP{DM, DM, DM}, S, pg8::EpiF32Res{DM, l == 0 ? args.in[I_X] : (const float*)H, H}, F.wave);
        } SEAM(pb + LP_G2);
        STAMP(pb + LP_NORM2); if (IN(pb + LP_NORM2)) { REFRESH(); for (int rep = 0; rep < REPS(18); ++rep) norm_phase<0>(F, ap, H, args.in[I_NORM_CROSS] + (size_t)l * DM, l); } SEAM(pb + LP_NORM2);
        STAMP(pb + LP_GS); if (IN(pb + LP_GS)) { REFRESH();
            SchedBatch S{(const char*)(ws + WS_HN), (const char*)(ws + WS_WQK) + (size_t)l * 2 * 1024 * DM * 2, (char*)(ws + WS_P), (size_t)SEQ * DM * 2, (size_t)1024 * DM * 2, (size_t)SEQ * 1024 * 2, SEQ / 256, 4, BATCH, F.G, F.bid, DM, DM, 1024 * 2, 2, SEQ};
            for (int rep = 0; rep < REPS(19); ++rep) pg8::gemm_phase<pg8::EpiSoftmax, SchedBatch, false>(F.lds, pg8::GemmP{DM, DM, DM}, S, pg8::EpiSoftmax{1024, 0.044194173824159216f * 1.4426950408889634f}, F.wave);
        } SEAM(pb + LP_GS);
        STAMP(pb + LP_GO); if (IN(pb + LP_GO)) { REFRESH();
            SchedBatch S{(const char*)(ws + WS_P), (const char*)(ws + WS_VWO) + (size_t)l * 2 * DM * 1024 * 2, (char*)H, (size_t)SEQ * 1024 * 2, (size_t)DM * 1024 * 2, (size_t)SEQ * DM * 4, SEQ / 256, DM / 256, BATCH, F.G, F.bid, 1024, 1024, DM * 4, 4, SEQ};
            pg8::gemm_phase<pg8::EpiF32Res, SchedBatch, false>(F.lds, pg8::GemmP{1024, 1024, 1024}, S, pg8::EpiF32Res{DM, (const float*)H, H}, F.wave);
        } SEAM(pb + LP_GO);
        STAMP(pb + LP_NORM3); if (IN(pb + LP_NORM3)) { REFRESH(); norm_phase<2>(F, ap, H, args.in[I_NORM_MOE] + (size_t)l * DM, l); } SEAM(pb + LP_NORM3);
        STAMP(pb + LP_M1); if (IN(pb + LP_M1)) { REFRESH();
            volatile LAS int* tp = (volatile LAS int*)(F.lds + MISC_OFF + 256); volatile LAS int* cnt = tp + 40;
            moe_prefix(F, l, tp, cnt);
            SchedMoe S{ws, tp, cnt, l, F.G, F.bid, 0};
            for (int rep = 0; rep < REPS(20); ++rep) pg8::gemm_phase<pg8::EpiSwiGlu, SchedMoe, true>(F.lds, pg8::GemmP{DM, DM, DM}, S, pg8::EpiSwiGlu{DEXP}, F.wave);
        } SEAM(pb + LP_M1);
        STAMP(pb + LP_M2); if (IN(pb + LP_M2)) { REFRESH();
            volatile LAS int* tp = (volatile LAS int*)(F.lds + MISC_OFF + 256); volatile LAS int* cnt = tp + 40;
            moe_prefix(F, l, tp, cnt);
            SchedMoe S{ws, tp, cnt, l, F.G, F.bid, 1};
            for (int rep = 0; rep < REPS(21); ++rep) pg8::gemm_phase<pg8::EpiGate, SchedMoe, false>(F.lds, pg8::GemmP{DEXP, DEXP, DEXP}, S, pg8::EpiGate{DM, (const float*)(ws + WS_EGATE), nullptr}, F.wave);
        } SEAM(pb + LP_M2);
    }
#ifdef DBG_TIME_A
    STAMP(PH_FINAL);
    if (blockIdx.x == 0 && threadIdx.x == 0) { const unsigned long long ta = ((unsigned long long)F.MISC[193 + 2 * (DBG_TIME_A)] << 32) | F.MISC[192 + 2 * (DBG_TIME_A)], tb = ((unsigned long long)F.MISC[193 + 2 * (DBG_TIME_B)] << 32) | F.MISC[192 + 2 * (DBG_TIME_B)];
        const unsigned long long dl = (tb - ta) * DBG_TIME_K; const unsigned long long t0_ = wall_clock64(); while (wall_clock64() - t0_ < dl) __builtin_amdgcn_s_sleep(8); }
    if (hi - lo > 1) { XcdBarrier b_; b_.bar = (unsigned*)(ap->ws + WS_CTL) + CW_BAR; b_.x = xb_xcc_id(); b_.st = F.MISC + 8; xcd_barrier(b_); }
#endif
    STAMP(PH_FINAL); if (IN(PH_FINAL)) { REFRESH(); norm_phase<5>(F, ap, (const float*)(ws + WS_H), args.in[I_NORM_FINAL], DEPTH); }
#undef IN
#undef SEAM
#undef args
}

extern "C" void kernel_launch(void* const* d_in, const int* in_sizes, int n_in, void* d_out, int out_size, void* d_ws, size_t ws_size, hipStream_t stream) {
    static int grid = 0;
    if (grid == 0) {
        if (n_in != N_INPUTS || out_size != NTOK * DM || ws_size < cmax(WS_END, SC_MIX_END3)) { fprintf(stderr, "kernel_launch: built for %d inputs, out %d, ws >= %zu; got %d, %d, %zu\n", N_INPUTS, NTOK * DM, cmax(WS_END, SC_MIX_END3), n_in, out_size, ws_size); grid = -1; return; }
        int dev = 0, cus = 0, per_cu = 0;
        if (hipGetDevice(&dev) != hipSuccess || hipDeviceGetAttribute(&cus, hipDeviceAttributeMultiprocessorCount, dev) != hipSuccess) { fprintf(stderr, "kernel_launch: device query failed\n"); grid = -1; return; }
        if (hipFuncSetAttribute((const void*)enc_fwd, hipFuncAttributeMaxDynamicSharedMemorySize, LDS_BYTES) != hipSuccess) { fprintf(stderr, "kernel_launch: hipFuncSetAttribute failed\n"); grid = -1; return; }
        if (hipOccupancyMaxActiveBlocksPerMultiprocessor(&per_cu, (const void*)enc_fwd, 512, LDS_BYTES) != hipSuccess || per_cu < 1) fprintf(stderr, "kernel_launch: occupancy query says %d blocks per CU\n", per_cu);
        grid = cus;
    }
    if (grid < 0) return;
    hipMemsetAsync((char*)d_ws + WS_CTL, 0, CTL_BYTES, stream);
    Args a; memset(&a, 0, sizeof(a));
    for (int i = 0; i < N_INPUTS; ++i) a.in[i] = (const float*)d_in[i];
    a.out = (float*)d_out; a.ws = (unsigned char*)d_ws;
#if MK_FUSED
    a.ph_lo = 0; a.ph_hi = NPHASES;
    hipLaunchKernelGGL(enc_fwd, dim3(grid), dim3(512), LDS_BYTES, stream, a);
#else
    for (int p = 0; p < NPHASES; ++p) { a.ph_lo = p; a.ph_hi = p + 1; hipLaunchKernelGGL(enc_fwd, dim3(grid), dim3(512), LDS_BYTES, stream, a); }
#endif
    const hipError_t le = hipPeekAtLastError();
    if (le != hipSuccess) fprintf(stderr, "kernel_launch: launch failed: %s\n", hipGetErrorName(le));
}
```

```cpp
#include <hip/hip_runtime.h>
#include <cstdio>
#include <cstdint>
#include <cstring>

#define GAS __attribute__((address_space(1)))
#define LAS __attribute__((address_space(3)))
typedef unsigned short bf16;
typedef short bf16x8 __attribute__((ext_vector_type(8)));
typedef short s16x4 __attribute__((ext_vector_type(4)));
typedef float f32x2 __attribute__((ext_vector_type(2)));
typedef float f32x4 __attribute__((ext_vector_type(4)));
typedef float f32x16 __attribute__((ext_vector_type(16)));
typedef unsigned u32x2 __attribute__((ext_vector_type(2)));
typedef unsigned u32x4 __attribute__((ext_vector_type(4)));
typedef GAS unsigned gu32;

constexpr int DM = 2048, BATCH = 2, SEQ = 4096, NTOK = BATCH * SEQ, DEPTH = 2, NMEM = 256;
constexpr int IN_A = 1536, IN_B = 1920, IN_C = 1536, IN_D = 512, IN_TOTAL = 5504, ZLD = 5632;
constexpr int ZA = 0, ZB = 1536, ZC = 3456, ZD = 4992;
constexpr int NEXP = 32, DEXP = 512, ECAP = 8192;
constexpr int SLOT_CAP = 24576;
constexpr int S5CH = 16, S5NCH = SEQ / S5CH;
constexpr float RMS_EPS = 1e-6f;

enum { I_X = 0, I_MEM, I_NORM_MIX, I_W_IN, I_W_OUT, I_DIFF_LAMBDA, I_DIFF_SUBLN, I_RWKV_MU, I_RWKV_W0, I_RWKV_W2, I_RWKV_A0, I_RWKV_A2, I_RWKV_G2,
       I_RWKV_KK, I_RWKV_KA, I_RWKV_RK, I_RWKV_LNX_W, I_RWKV_LNX_B, I_S5_A_RE, I_S5_A_IM, I_S5_LOG_DT, I_S5_B_RE, I_S5_B_IM, I_S5_C_RE, I_S5_C_IM,
       I_S5_D, I_S5_GLU_W, I_S5_GLU_B, I_MIX_OUT_NORM, I_NORM_CROSS, I_NORM_MEM, I_XA_WQ, I_XA_WKV, I_XA_WO, I_NORM_MOE, I_ROUTER_GROUP,
       I_ROUTER_EXPERT, I_MOE_W1, I_MOE_W3, I_MOE_W2, I_NORM_FINAL, N_INPUTS };

constexpr size_t al256(size_t x) { return (x + 255) / 256 * 256; }
constexpr size_t WS_CTL = 0, CTL_BYTES = 1u << 20;
constexpr size_t WS_WIN  = WS_CTL + CTL_BYTES;
constexpr size_t WS_WOUT = WS_WIN + (size_t)DEPTH * ZLD * DM * 2;
constexpr size_t WS_WQK  = WS_WOUT + (size_t)DEPTH * DM * DM * 2;
constexpr size_t WS_VWO  = WS_WQK + (size_t)DEPTH * BATCH * 1024 * DM * 2;
constexpr size_t WS_W13  = WS_VWO + (size_t)DEPTH * BATCH * DM * 1024 * 2;
constexpr size_t WS_W2   = WS_W13 + (size_t)DEPTH * NEXP * 1024 * DM * 2;
constexpr size_t WS_ROPE = WS_W2 + (size_t)DEPTH * NEXP * DM * DEXP * 2;
constexpr size_t WS_S5P  = WS_ROPE + (size_t)SEQ * (32 + 32 + 64 + 64) * 4;
constexpr size_t S5P_LAYER = (size_t)(2 * 32 * 64 * 2 + 2 * 32 * 64 * 16 * 2 + 2 * 32 * 64 * 2) * 4;
constexpr size_t WS_LORA = al256(WS_S5P + DEPTH * S5P_LAYER);
constexpr size_t LORA_LAYER = (size_t)(2 * 512 * 64 * 2 + 512 * 128) * 2;
constexpr size_t WS_GLUT = al256(WS_LORA + DEPTH * LORA_LAYER);
constexpr size_t WS_S5CW = WS_GLUT + (size_t)DEPTH * 512 * 512 * 2;
constexpr size_t WS_RTE  = al256(WS_S5CW + (size_t)DEPTH * 32 * 16 * 128 * 2);
constexpr size_t WS_H    = al256(WS_RTE + (size_t)DEPTH * 4 * DM * 8 * 4);
constexpr size_t WS_HN   = WS_H + (size_t)NTOK * DM * 4;
constexpr size_t WS_MIX  = WS_HN + (size_t)NTOK * DM * 2;
constexpr size_t WS_P    = WS_MIX + (size_t)NTOK * DM * 2;
constexpr size_t WS_ETOK = WS_P + (size_t)NTOK * 1024 * 2;
constexpr size_t WS_EGATE= WS_ETOK + (size_t)NEXP * ECAP * 4;
constexpr size_t WS_TINFO= WS_EGATE + (size_t)NEXP * ECAP * 4;
constexpr size_t WS_SCR  = al256(WS_TINFO + (size_t)NTOK * 16);
constexpr size_t SC_WKVT = WS_SCR;
constexpr size_t SC_MEMN = SC_WKVT + (size_t)DEPTH * 4096 * DM * 2;
constexpr size_t SC_KVB  = SC_MEMN + (size_t)DEPTH * 512 * DM * 2;
constexpr size_t SC_WQB  = SC_KVB + (size_t)DEPTH * 512 * 4096 * 2;
constexpr size_t SC_WOT  = SC_WQB + (size_t)DEPTH * DM * DM * 2;
constexpr size_t SC_PRO_END = SC_WOT + (size_t)DEPTH * DM * DM * 2;
constexpr size_t SC_Z    = WS_SCR;
constexpr size_t SC_RW   = SC_Z + (size_t)NTOK * ZLD * 2;
constexpr size_t RWSZ    = (size_t)NTOK * 512 * 4;
constexpr size_t SC_YS   = SC_RW + 10 * RWSZ;
constexpr size_t SC_OC   = SC_YS + 2 * RWSZ;
constexpr size_t SC_LSE  = SC_OC + 3 * RWSZ;
constexpr size_t SC_CARRY= SC_LSE + (size_t)3 * NTOK * 4 * 4;
constexpr size_t SC_MIX_END = SC_CARRY + (size_t)2 * BATCH * S5NCH * 32 * 64 * 2 * 4;
constexpr size_t SC_HMID = WS_SCR;
constexpr size_t SC_YBUF = SC_HMID + (size_t)SLOT_CAP * DEXP * 2;
constexpr size_t SC_MOE_END = SC_YBUF + (size_t)SLOT_CAP * DM * 2;
constexpr size_t cmax(size_t a, size_t b) { return a > b ? a : b; }
constexpr size_t WS_END = cmax(cmax(SC_PRO_END, SC_MIX_END), SC_MOE_END);

constexpr int CW_BAR = 4096;
constexpr int CW_Q = 8192;
constexpr int CW_CNT = 16384;

constexpr int RING_BYTES = 131072;
constexpr int MISC_OFF = 147456 - 1024;
constexpr int LDS_BYTES = 147456;

__device__ __forceinline__ float bf2f(unsigned short b) { return __uint_as_float(((unsigned)b) << 16); }
typedef __bf16 bf16x2_t __attribute__((ext_vector_type(2)));
__device__ __forceinline__ unsigned pk2c(float lo, float hi) { bf16x2_t v = {(__bf16)lo, (__bf16)hi}; return __builtin_bit_cast(unsigned, v); }
__device__ __forceinline__ unsigned pk2(float lo, float hi) { unsigned r; asm volatile("v_cvt_pk_bf16_f32 %0, %1, %2" : "=v"(r) : "v"(lo), "v"(hi)); return r; }
__device__ __forceinline__ bf16 f2bf(float f) { return (bf16)(pk2(f, 0.f) & 0xffffu); }
template <int CTRL> __device__ __forceinline__ float dpp_mov(float v) { return __builtin_bit_cast(float, __builtin_amdgcn_update_dpp(0, __builtin_bit_cast(int, v), CTRL, 0xf, 0xf, true)); }
__device__ __forceinline__ float row_sum(float v) { v += dpp_mov<0xB1>(v); v += dpp_mov<0x4E>(v); v += dpp_mov<0x141>(v); v += dpp_mov<0x140>(v); return v; }
__device__ __forceinline__ float row_max(float v) { v = fmaxf(v, dpp_mov<0xB1>(v)); v = fmaxf(v, dpp_mov<0x4E>(v)); v = fmaxf(v, dpp_mov<0x141>(v)); v = fmaxf(v, dpp_mov<0x140>(v)); return v; }
__device__ __forceinline__ float rdlane(float v, int l) { return __builtin_bit_cast(float, __builtin_amdgcn_readlane(__builtin_bit_cast(int, v), l)); }
__device__ __forceinline__ float wave_sum(float v) { v = row_sum(v); return (rdlane(v, 0) + rdlane(v, 16)) + (rdlane(v, 32) + rdlane(v, 48)); }
__device__ __forceinline__ float wave_max(float v) { v = row_max(v); return fmaxf(fmaxf(rdlane(v, 0), rdlane(v, 16)), fmaxf(rdlane(v, 32), rdlane(v, 48))); }
__device__ __forceinline__ float sigmoidf_(float x) { return 1.f / (1.f + __expf(-x)); }
#define LDS_WAIT() asm volatile("s_waitcnt lgkmcnt(0)" ::: "memory")
#define VM_WAIT() asm volatile("s_waitcnt vmcnt(0)" ::: "memory")

__device__ __forceinline__ int tid_from_wave(int wave) { int ln; asm volatile("v_mbcnt_lo_u32_b32 %0, -1, 0\n\tv_mbcnt_hi_u32_b32 %0, -1, %0" : "=v"(ln)); return wave * 64 + ln; }

typedef __attribute__((address_space(8))) void* bufrsrc_t;
__device__ __forceinline__ __amdgpu_buffer_rsrc_t make_rsrc(const void* p, unsigned bytes) { return __builtin_amdgcn_make_buffer_rsrc((void*)p, 0, bytes, 0x00020000); }
__device__ __forceinline__ float bload_f32(__amdgpu_buffer_rsrc_t r, int voff, int soff) { return __builtin_bit_cast(float, __builtin_amdgcn_raw_buffer_load_b32(r, voff, soff, 0)); }

__device__ __forceinline__ float xor_lane(float v, int lane, int m) { return __builtin_bit_cast(float, __builtin_amdgcn_ds_bpermute((lane ^ m) << 2, __builtin_bit_cast(int, v))); }
#define XB_TMO      128
#define XB_XCNT(j)  (256  + 64 * (j))
#define XB_XSUB(j)  (1280 + 64 * (j))
#define XB_XGEN(j)  (2304 + 64 * (j))
#define XB_TOP      3328
#define XB_TOPGEN   3392
#define XCD_BAR_WORDS 3456
#define XB_SPIN_CAP (1u << 18)

__device__ __forceinline__ unsigned xb_ld(unsigned* p)              { return __hip_atomic_load(p, __ATOMIC_RELAXED, __HIP_MEMORY_SCOPE_AGENT); }
__device__ __forceinline__ unsigned xb_add(unsigned* p, unsigned v) { return __hip_atomic_fetch_add(p, v, __ATOMIC_RELAXED, __HIP_MEMORY_SCOPE_AGENT); }
__device__ __forceinline__ unsigned xb_xcc_id() { return (unsigned)__builtin_amdgcn_s_getreg((3 << 11) | 20) & 0xFu; }
#define XB_SPIN(cond, bar) do { unsigned _sp = 0; while (cond) { __builtin_amdgcn_s_sleep(1); \
    if ((++_sp & 255u) == 0u) { if (xb_ld(&(bar)[XB_TMO])) break; if (_sp > XB_SPIN_CAP) { atomicAdd(&(bar)[XB_TMO], 1u); break; } } } } while (0)

struct XcdBarrier {
    unsigned* bar; unsigned x;
    volatile LAS unsigned* st;
};

__device__ __forceinline__ XcdBarrier xcd_barrier_post(unsigned* bar, volatile LAS unsigned* st) {
    XcdBarrier b; b.bar = bar; b.x = xb_xcc_id(); b.st = st;
    if (threadIdx.x == 0) (void)xb_add(&bar[XB_XCNT(b.x)], 1u);
    return b;
}
__device__ __forceinline__ void xcd_barrier_complete(unsigned* bar, unsigned x, unsigned& nloc, unsigned& nx) {
    const unsigned G = gridDim.x * gridDim.y * gridDim.z;
    unsigned sum, cnt, mine, sp = 0u;
    for (;;) {
        sum = 0u; cnt = 0u; mine = 0u;
#pragma unroll
        for (unsigned j = 0; j < 16; ++j) { const unsigned c = xb_ld(&bar[XB_XCNT(j)]); sum += c; cnt += (c > 0u) ? 1u : 0u; mine = (j == x) ? c : mine; }
        if (sum == G) break;
        __builtin_amdgcn_s_sleep(1);
        if ((++sp & 255u) == 0u) { if (xb_ld(&bar[XB_TMO])) break; if (sp > XB_SPIN_CAP) { atomicAdd(&bar[XB_TMO], 1u); break; } }
    }
    nloc = mine > 0u ? mine : 1u; nx = cnt > 0u ? cnt : 1u;
}

__device__ __forceinline__ void xcd_barrier(const XcdBarrier& b) {
    asm volatile("s_waitcnt vmcnt(0)" ::: "memory");
    __syncthreads();
    if (threadIdx.x == 0) {
        unsigned* bar = b.bar;
        __builtin_amdgcn_s_waitcnt(0);
        unsigned nloc = b.st[0], nx = b.st[1];
        if (nloc == 0u) { xcd_barrier_complete(bar, b.x, nloc, nx); b.st[0] = nloc; b.st[1] = nx; }
        const unsigned old = xb_add(&bar[XB_XSUB(b.x)], 1u);
        const unsigned gen = old / nloc;
        if (old + 1u == (gen + 1u) * nloc) {
            __builtin_amdgcn_fence(__ATOMIC_RELEASE, "agent");
            asm volatile("s_waitcnt vmcnt(0)" ::: "memory");
            const unsigned og = xb_add(&bar[XB_TOP], 1u);
            const unsigned tg = og / nx;
            if (og + 1u == (tg + 1u) * nx) xb_add(&bar[XB_TOPGEN], 1u);
            else XB_SPIN(xb_ld(&bar[XB_TOPGEN]) == tg, bar);
            __builtin_amdgcn_fence(__ATOMIC_ACQUIRE, "agent");
            xb_add(&bar[XB_XGEN(b.x)], 1u);
            asm volatile("s_waitcnt vmcnt(0)" ::: "memory");
        } else {
            XB_SPIN(xb_ld(&bar[XB_XGEN(b.x)]) == gen, bar);
            __builtin_amdgcn_fence(__ATOMIC_ACQUIRE, "agent");
            asm volatile("s_waitcnt vmcnt(0)" ::: "memory");
        }
    }
    __syncthreads();
}


namespace pg8 {
constexpr int BM = 256, BK = 64, HALF = 128, HTB = HALF * BK * 2, STAGE_BYTES = 8 * HTB, NXCD = 8, WGM = 8;
__host__ __device__ __forceinline__ int lds_byte(int r, int c) { const int st = (r >> 4) * 2 + (c >> 5), rr = r & 15, cc = c & 31, ob = rr * 64 + cc * 2; return st * 1024 + (ob ^ (((ob >> 9) & 1) << 5)); }
__host__ __device__ __forceinline__ void stage_rc(int b, int& R, int& C) { const int st = b / 1024, sb = b % 1024, swz = sb ^ (((sb >> 9) & 1) << 5); R = (st >> 1) * 16 + swz / 64; C = (st & 1) * 32 + (swz % 64) / 2; }
__host__ __device__ __forceinline__ int perm32(int rho) { const int n = rho >> 4, i = rho & 15; return 8 * (i >> 2) + 4 * n + (i & 3); }

struct Unit { const char* A; const char* B; char* C; int row0, col0, aux; };
struct GemmP { int K, lda, ldb; };

__device__ __forceinline__ void xcd_tile(int L, int nM, int nN, int& pm, int& pn) {
    const int nwg = nM * nN; int wgid = L;
    { const int q = nwg / NXCD, r = nwg % NXCD, xcd = wgid % NXCD, off = wgid / NXCD; wgid = (xcd < r ? xcd * (q + 1) : r * (q + 1) + (xcd - r) * q) + off; }
    const int nig = WGM * nN, gid = wgid / nig, fm = gid * WGM, gsz = (nM - fm) < WGM ? (nM - fm) : WGM;
    pm = fm + ((wgid % nig) % gsz); pn = (wgid % nig) / gsz;
}

typedef f32x4 Acc[2][2][4][2];

template <class Epi, class Sched, bool GATHER>
__device__ __forceinline__ void gemm_phase(LAS unsigned char* lds, const GemmP g, const Sched& S, const Epi& E, const int wave_id) {
    const int tid = tid_from_wave(wave_id), wid = __builtin_amdgcn_readfirstlane(tid >> 6), lane = tid & 63, wr = wid >> 2, wc = wid & 3, fr = lane & 15, fq = lane >> 4;
    const int K = g.K, nt = K / BK;
    int Rr[2], Cc[2]; unsigned voffB[2];
#pragma unroll
    for (int i = 0; i < 2; ++i) { int R, C; stage_rc(tid * 16 + i * 8192, R, C); const int Rb = Epi::PERM ? ((R & ~31) + perm32(R & 31)) : R;
        Rr[i] = R; Cc[i] = C; voffB[i] = (unsigned)(Rb * g.ldb + C) * 2u; }
    const size_t kstep = (size_t)(BK * 2);
    const size_t hstepB = (size_t)HALF * g.ldb * 2;
    const unsigned ldsw = (unsigned)wid * 1024u;
    const int aoff = lds_byte(wr * 64 + fr, fq * 8), boff = lds_byte(wc * 32 + fr, fq * 8);
#define PG8_SA(b, h) (((b) * 2 + (h)) * HTB)
#define PG8_SB(b, h) ((4 + (b) * 2 + (h)) * HTB)
#define PG8_STAGE_B(bufoff, gbase) do { _Pragma("unroll") for (int _i = 0; _i < 2; ++_i) \
        __builtin_amdgcn_global_load_lds((const unsigned*)((const char*)(gbase) + voffB[_i]), (LAS unsigned*)(lds + (bufoff) + ldsw + _i * 8192), 16, 0, 0); } while (0)
#define PG8_STAGE_A(bufoff, gbase, OFF, h) do { _Pragma("unroll") for (int _i = 0; _i < 2; ++_i) \
        __builtin_amdgcn_global_load_lds((const unsigned*)((const char*)(gbase) + (OFF)[h][_i]), (LAS unsigned*)(lds + (bufoff) + ldsw + _i * 8192), 16, 0, 0); } while (0)
#define PG8_OFFS(u, OFF) do { _Pragma("unroll") for (int _h = 0; _h < 2; ++_h) _Pragma("unroll") for (int _i = 0; _i < 2; ++_i) { \
        const int _row = _h * HALF + Rr[_i]; const int _src = GATHER ? S.arow((u), _row) : _row; (OFF)[_h][_i] = (unsigned)(_src * g.lda + Cc[_i]) * 2u; } } while (0)
#define PG8_LDA(dst, b, h) do { _Pragma("unroll") for (int m = 0; m < 4; ++m) _Pragma("unroll") for (int k = 0; k < 2; ++k) dst[m][k] = *(const LAS bf16x8*)(lds + PG8_SA(b, h) + aoff + m * 2048 + k * 1024); } while (0)
#define PG8_LDB(dst, b, h) do { _Pragma("unroll") for (int n = 0; n < 2; ++n) _Pragma("unroll") for (int k = 0; k < 2; ++k) dst[n][k] = *(const LAS bf16x8*)(lds + PG8_SB(b, h) + boff + n * 2048 + k * 1024); } while (0)
#define PG8_MMA(ai, bj, At, Bt) do { __builtin_amdgcn_s_setprio(1); _Pragma("unroll") for (int m = 0; m < 4; ++m) _Pragma("unroll") for (int n = 0; n < 2; ++n) _Pragma("unroll") for (int k = 0; k < 2; ++k) \
        acc[ai][bj][m][n] = __builtin_amdgcn_mfma_f32_16x16x32_bf16(Bt[n][k], At[m][k], acc[ai][bj][m][n], 0, 0, 0); __builtin_amdgcn_s_setprio(0); } while (0)
#define PG8_WAIT_V(n) asm volatile("s_waitcnt vmcnt(" #n ")" ::: "memory")
#define PG8_WAIT_L(n) asm volatile("s_waitcnt lgkmcnt(" #n ")" ::: "memory")
#define PG8_BAR __builtin_amdgcn_s_barrier()
#define PG8_SCHED __builtin_amdgcn_sched_barrier(0)
    Unit cur, nxt; int ui = 0;
    if (!S.next(0, cur)) return;
    f32x4 acc[2][2][4][2];
#pragma unroll
    for (int a = 0; a < 2; ++a)
#pragma unroll
        for (int b = 0; b < 2; ++b)
#pragma unroll
            for (int m = 0; m < 4; ++m)
#pragma unroll
                for (int n = 0; n < 2; ++n) acc[a][b][m][n] = (f32x4){0.f, 0.f, 0.f, 0.f};
    bf16x8 At[4][2], B0[2][2], B1[2][2];
    const char* cA = cur.A; const char* cB = cur.B;
    unsigned coffA[2][2], noffA[2][2];
    PG8_OFFS(cur, coffA);
    PG8_STAGE_B(PG8_SB(0, 0), cB); PG8_STAGE_A(PG8_SA(0, 0), cA, coffA, 0); PG8_STAGE_B(PG8_SB(0, 1), cB + hstepB); PG8_STAGE_A(PG8_SA(0, 1), cA, coffA, 1);
    if (wr == 1) PG8_BAR;
    PG8_WAIT_V(4); PG8_BAR;
    PG8_STAGE_B(PG8_SB(1, 0), cB + kstep); PG8_STAGE_A(PG8_SA(1, 0), cA + kstep, coffA, 0); PG8_STAGE_B(PG8_SB(1, 1), cB + hstepB + kstep);
    PG8_WAIT_V(6); PG8_BAR;
    for (;;) {
        const bool has_next = S.next(ui + 1, nxt);
        const char* nA = has_next ? nxt.A : cA; const char* nB = has_next ? nxt.B : cB;
        if (has_next) { PG8_OFFS(nxt, noffA); }
        else {
#pragma unroll
            for (int _h = 0; _h < 2; ++_h)
#pragma unroll
                for (int _i = 0; _i < 2; ++_i) noffA[_h][_i] = coffA[_h][_i]; }
        for (int t = 0; t < nt; t += 2) {
            const bool last = (t == nt - 2);
            const char* a1 = cA + (size_t)(t + 1) * kstep;
            const char* a2 = last ? nA : cA + (size_t)(t + 2) * kstep; const char* b2 = last ? nB : cB + (size_t)(t + 2) * kstep;
            const char* a3 = a2 + kstep; const char* b3 = b2 + kstep;
            unsigned o2[2][2];
#pragma unroll
            for (int _h = 0; _h < 2; ++_h)
#pragma unroll
                for (int _i = 0; _i < 2; ++_i) o2[_h][_i] = last ? noffA[_h][_i] : coffA[_h][_i];
            PG8_LDB(B0, 0, 0); PG8_SCHED; PG8_LDA(At, 0, 0); PG8_STAGE_A(PG8_SA(1, 1), a1, coffA, 1);
            PG8_WAIT_L(8); PG8_BAR; PG8_WAIT_L(0); PG8_MMA(0, 0, At, B0); PG8_BAR; PG8_SCHED;
            PG8_LDB(B1, 0, 1); PG8_STAGE_B(PG8_SB(0, 0), b2);
            PG8_BAR; PG8_WAIT_L(0); PG8_MMA(0, 1, At, B1); PG8_BAR;
            PG8_LDA(At, 0, 1); PG8_STAGE_A(PG8_SA(0, 0), a2, o2, 0);
            PG8_BAR; PG8_WAIT_L(0); PG8_MMA(1, 0, At, B0); PG8_BAR; PG8_SCHED;
            PG8_STAGE_B(PG8_SB(0, 1), b2 + hstepB);
            PG8_WAIT_V(6); PG8_BAR; PG8_MMA(1, 1, At, B1); PG8_BAR;
            PG8_LDB(B0, 1, 0); PG8_SCHED; PG8_LDA(At, 1, 0); PG8_STAGE_A(PG8_SA(0, 1), a2, o2, 1);
            PG8_WAIT_L(8); PG8_BAR; PG8_WAIT_L(0); PG8_MMA(0, 0, At, B0); PG8_BAR; PG8_SCHED;
            PG8_LDB(B1, 1, 1); PG8_STAGE_B(PG8_SB(1, 0), b3);
            PG8_BAR; PG8_WAIT_L(0); PG8_MMA(0, 1, At, B1); PG8_BAR;
            PG8_LDA(At, 1, 1); PG8_STAGE_A(PG8_SA(1, 0), a3, o2, 0);
            PG8_BAR; PG8_WAIT_L(0); PG8_MMA(1, 0, At, B0); PG8_BAR; PG8_SCHED;
            PG8_STAGE_B(PG8_SB(1, 1), b3 + hstepB);
            PG8_WAIT_V(6); PG8_BAR; PG8_MMA(1, 1, At, B1); PG8_BAR;
        }
        if constexpr (!Epi::AFTER_DRAIN) { E(acc, cur, wr, wc, fr, fq); }
        if (!has_next) break;
#pragma unroll
        for (int a = 0; a < 2; ++a)
#pragma unroll
            for (int b = 0; b < 2; ++b)
#pragma unroll
                for (int m = 0; m < 4; ++m)
#pragma unroll
                    for (int n = 0; n < 2; ++n) acc[a][b][m][n] = (f32x4){0.f, 0.f, 0.f, 0.f};
        cur = nxt; cA = nA; cB = nB; ++ui;
#pragma unroll
        for (int _h = 0; _h < 2; ++_h)
#pragma unroll
            for (int _i = 0; _i < 2; ++_i) coffA[_h][_i] = noffA[_h][_i];
    }
    PG8_WAIT_V(0);
    if (wr == 0) PG8_BAR;
    PG8_BAR;
    if constexpr (Epi::AFTER_DRAIN) { E.fused(acc, cur, wr, wc, fr, fq, lds, wid, lane); }
#undef PG8_SA
#undef PG8_SB
#undef PG8_STAGE_A
#undef PG8_STAGE_B
#undef PG8_OFFS
#undef PG8_LDA
#undef PG8_LDB
#undef PG8_MMA
#undef PG8_WAIT_V
#undef PG8_WAIT_L
#undef PG8_BAR
#undef PG8_SCHED
}

struct EpiBf16 {
    static constexpr bool PERM = true, AFTER_DRAIN = false;
    int ldc;
    __device__ __forceinline__ void operator()(const Acc& acc, const Unit& u, int wr, int wc, int fr, int fq) const {
        bf16* base = (bf16*)u.C + (size_t)(wr * 64 + fr) * ldc + wc * 32 + 8 * fq;
#pragma unroll
        for (int ai = 0; ai < 2; ++ai)
#pragma unroll
            for (int m = 0; m < 4; ++m) { bf16* rowp = base + (size_t)(ai * HALF + m * 16) * ldc;
#pragma unroll
                for (int bj = 0; bj < 2; ++bj) { const f32x4 v0 = acc[ai][bj][m][0], v1 = acc[ai][bj][m][1];
                    u32x4 w; w.x = pk2(v0[0], v0[1]); w.y = pk2(v0[2], v0[3]); w.z = pk2(v1[0], v1[1]); w.w = pk2(v1[2], v1[3]);
                    *(u32x4*)(rowp + bj * HALF) = w; } }
    }
};
struct EpiF32Res {
    static constexpr bool PERM = false, AFTER_DRAIN = false;
    int ldc; const float* resid; float* out;
    __device__ __forceinline__ void operator()(const Acc& acc, const Unit& u, int wr, int wc, int fr, int fq) const {
        const size_t o0 = (size_t)(u.row0 + wr * 64 + fr) * ldc + u.col0 + wc * 32 + 4 * fq;
#pragma unroll
        for (int ai = 0; ai < 2; ++ai)
#pragma unroll
            for (int m = 0; m < 4; ++m) { const size_t ro = o0 + (size_t)(ai * HALF + m * 16) * ldc;
#pragma unroll
                for (int bj = 0; bj < 2; ++bj)
#pragma unroll
                    for (int n = 0; n < 2; ++n) { const size_t o = ro + bj * HALF + n * 16; const f32x4 b = *(const f32x4*)(resid + o); *(f32x4*)(out + o) = acc[ai][bj][m][n] + b; } }
    }
};
struct EpiSwiGlu {
    static constexpr bool PERM = true, AFTER_DRAIN = false;
    int ldc;
    __device__ __forceinline__ void operator()(const Acc& acc, const Unit& u, int wr, int wc, int fr, int fq) const {
        bf16* base = (bf16*)u.C + (size_t)(wr * 64 + fr) * ldc + wc * 32 + 8 * fq;
#pragma unroll
        for (int ai = 0; ai < 2; ++ai)
#pragma unroll
            for (int m = 0; m < 4; ++m) { bf16* rowp = base + (size_t)(ai * HALF + m * 16) * ldc;
                float h[8];
#pragma unroll
                for (int n = 0; n < 2; ++n)
#pragma unroll
                    for (int e = 0; e < 4; ++e) { const float a = acc[ai][0][m][n][e], b = acc[ai][1][m][n][e]; h[n * 4 + e] = a / (1.f + __expf(-a)) * b; }
                u32x4 w; w.x = pk2(h[0], h[1]); w.y = pk2(h[2], h[3]); w.z = pk2(h[4], h[5]); w.w = pk2(h[6], h[7]);
                *(u32x4*)rowp = w; }
    }
};
struct EpiGate {
    static constexpr bool PERM = true, AFTER_DRAIN = false;
    int ldc; const float* egate; const int* cnt_lds_unused;
    __device__ __forceinline__ void operator()(const Acc& acc, const Unit& u, int wr, int wc, int fr, int fq) const {
        bf16* base = (bf16*)u.C + (size_t)(wr * 64 + fr) * ldc + wc * 32 + 8 * fq;
        const int e = u.aux >> 16, nvalid = u.aux & 0xffff;
        const float* gp = egate + (size_t)e * ECAP + u.row0;
#pragma unroll
        for (int ai = 0; ai < 2; ++ai)
#pragma unroll
            for (int m = 0; m < 4; ++m) { const int r = ai * HALF + wr * 64 + m * 16 + fr; const float gt = (r < nvalid) ? gp[r] : 0.f;
                bf16* rowp = base + (size_t)(ai * HALF + m * 16) * ldc;
#pragma unroll
                for (int bj = 0; bj < 2; ++bj) { const f32x4 v0 = acc[ai][bj][m][0] * gt, v1 = acc[ai][bj][m][1] * gt;
                    u32x4 w; w.x = pk2(v0[0], v0[1]); w.y = pk2(v0[2], v0[3]); w.z = pk2(v1[0], v1[1]); w.w = pk2(v1[2], v1[3]);
                    *(u32x4*)(rowp + bj * HALF) = w; } }
    }
};
struct EpiSoftmax {
    static constexpr bool PERM = true, AFTER_DRAIN = true;
    int ldc; float scale_log2e;
    __device__ __forceinline__ void operator()(const Acc&, const Unit&, int, int, int, int) const {}
    __device__ __forceinline__ void fused(const Acc& acc, const Unit& u, int wr, int wc, int fr, int fq, LAS unsigned char* lds, int wid, int lane) const {
        LAS float* RM = (LAS float*)lds;
        LAS float* RS = (LAS float*)(lds + 4096);
        float mx[2][4];
#pragma unroll
        for (int ai = 0; ai < 2; ++ai)
#pragma unroll
            for (int m = 0; m < 4; ++m) { float v = -3.0e38f;
#pragma unroll
                for (int bj = 0; bj < 2; ++bj)
#pragma unroll
                    for (int n = 0; n < 2; ++n) { const f32x4 x = acc[ai][bj][m][n]; v = fmaxf(v, fmaxf(fmaxf(x[0], x[1]), fmaxf(x[2], x[3]))); }
                v = fmaxf(v, xor_lane(v, lane, 16)); v = fmaxf(v, xor_lane(v, lane, 32));
                if (fq == 0) RM[(ai * HALF + wr * 64 + m * 16 + fr) * 4 + wc] = v; }
        asm volatile("s_waitcnt lgkmcnt(0)" ::: "memory"); __builtin_amdgcn_s_barrier(); asm volatile("" ::: "memory");
#pragma unroll
        for (int ai = 0; ai < 2; ++ai)
#pragma unroll
            for (int m = 0; m < 4; ++m) { const int row = ai * HALF + wr * 64 + m * 16 + fr; const f32x4 q = *(const LAS f32x4*)(RM + row * 4);
                const float M = fmaxf(fmaxf(q[0], q[1]), fmaxf(q[2], q[3])); const float mc = -M * scale_log2e; float s = 0.f;
#pragma unroll
                for (int bj = 0; bj < 2; ++bj)
#pragma unroll
                    for (int n = 0; n < 2; ++n)
#pragma unroll
                        for (int e = 0; e < 4; ++e) s += __builtin_amdgcn_exp2f(fmaf(acc[ai][bj][m][n][e], scale_log2e, mc));
                s += xor_lane(s, lane, 16); s += xor_lane(s, lane, 32);
                if (fq == 0) RS[row * 4 + wc] = s; }
        asm volatile("s_waitcnt lgkmcnt(0)" ::: "memory"); __builtin_amdgcn_s_barrier(); asm volatile("" ::: "memory");
        bf16* base = (bf16*)u.C + (size_t)(wr * 64 + fr) * ldc + wc * 32 + 8 * fq;
#pragma unroll
        for (int ai = 0; ai < 2; ++ai)
#pragma unroll
            for (int m = 0; m < 4; ++m) { const int row = ai * HALF + wr * 64 + m * 16 + fr; const f32x4 q = *(const LAS f32x4*)(RS + row * 4); const f32x4 qm = *(const LAS f32x4*)(RM + row * 4);
                const float M = fmaxf(fmaxf(qm[0], qm[1]), fmaxf(qm[2], qm[3])); const float mc = -M * scale_log2e;
                const float inv = 1.f / ((q[0] + q[1]) + (q[2] + q[3])); bf16* rowp = base + (size_t)(ai * HALF + m * 16) * ldc;
#pragma unroll
                for (int bj = 0; bj < 2; ++bj) { float pp[8];
#pragma unroll
                    for (int n = 0; n < 2; ++n)
#pragma unroll
                        for (int e = 0; e < 4; ++e) pp[n * 4 + e] = __builtin_amdgcn_exp2f(fmaf(acc[ai][bj][m][n][e], scale_log2e, mc)) * inv;
                    u32x4 w; w.x = pk2(pp[0], pp[1]); w.y = pk2(pp[2], pp[3]); w.z = pk2(pp[4], pp[5]); w.w = pk2(pp[6], pp[7]);
                    *(u32x4*)(rowp + bj * HALF) = w; } }
        asm volatile("s_waitcnt lgkmcnt(0)" ::: "memory"); __builtin_amdgcn_s_barrier(); asm volatile("" ::: "memory");
    }
};
}

namespace att {
constexpr int KVBLK = 64;
constexpr size_t SHM_V = KVBLK * 128 * 2, SHM_K = KVBLK * 128 * 2;
#define KSWZ(row, colB) ((row) * 256 + ((colB) ^ (((row) & 7) << 4)))
#define SBAR() __builtin_amdgcn_sched_barrier(0)
__device__ __forceinline__ int crow(int r, int hi) { return (r & 3) + 8 * (r >> 2) + 4 * hi; }
__device__ __forceinline__ bf16x8 ld8(const bf16* p) { return *reinterpret_cast<const bf16x8*>(p); }

__device__ __forceinline__ void partialSM(f32x16& p0, f32x16& p1, float& m_reg, float& mn, float& alpha, const float SCALE, const float THR) {
  const float C = SCALE * 1.4426950408889634f;
  float pmax = p0[0];
#pragma unroll
  for (int r = 1; r < 16; ++r) pmax = fmaxf(pmax, p0[r]);
#pragma unroll
  for (int r = 0; r < 16; ++r) pmax = fmaxf(pmax, p1[r]);
  { auto rr = __builtin_amdgcn_permlane32_swap(__float_as_uint(pmax), __float_as_uint(pmax), false, false);
    pmax = fmaxf(__uint_as_float(rr[0]), __uint_as_float(rr[1])); }
  if (__builtin_expect(__all(pmax - m_reg <= THR / SCALE), 1)) { mn = m_reg; alpha = 1.f; }
  else { mn = fmaxf(m_reg, pmax); alpha = __builtin_amdgcn_exp2f((m_reg - mn) * C); m_reg = mn; }
  const float mnC = -mn * C;
#pragma unroll
  for (int r = 0; r < 16; ++r) p0[r] = fmaf(p0[r], C, mnC);
#pragma unroll
  for (int r = 0; r < 16; ++r) p1[r] = fmaf(p1[r], C, mnC);
#pragma unroll
  for (int r = 0; r < 16; ++r) p0[r] = __builtin_amdgcn_exp2f(p0[r]);
}
__device__ __forceinline__ void finishSM(f32x16& p0, f32x16& p1, float alpha, float& l_reg, bf16x8& pa0, bf16x8& pa1, bf16x8& pa2, bf16x8& pa3) {
#pragma unroll
  for (int r = 0; r < 16; ++r) p1[r] = __builtin_amdgcn_exp2f(p1[r]);
  float ps = 0;
#pragma unroll
  for (int r = 0; r < 16; ++r) ps += p0[r];
#pragma unroll
  for (int r = 0; r < 16; ++r) ps += p1[r];
  { auto rr = __builtin_amdgcn_permlane32_swap(__float_as_uint(ps), __float_as_uint(ps), false, false);
    ps = __uint_as_float(rr[0]) + __uint_as_float(rr[1]); }
  l_reg = l_reg * alpha + ps;
#define PK4(P, BASE, OUT) do { unsigned a0 = pk2(P[BASE + 0], P[BASE + 1]), a1 = pk2(P[BASE + 2], P[BASE + 3]);   \
    unsigned b0 = pk2(P[BASE + 4], P[BASE + 5]), b1 = pk2(P[BASE + 6], P[BASE + 7]);                              \
    auto r0 = __builtin_amdgcn_permlane32_swap(a0, b0, false, false); auto r1 = __builtin_amdgcn_permlane32_swap(a1, b1, false, false); \
    u32x4 w = {r0[0], r1[0], r0[1], r1[1]}; OUT = *reinterpret_cast<bf16x8*>(&w); } while (0)
  PK4(p0, 0, pa0); PK4(p0, 8, pa1); PK4(p1, 0, pa2); PK4(p1, 8, pa3);
#undef PK4
}
template <int ND0> __device__ __forceinline__ void qkt(f32x16& p0, f32x16& p1, const char* Ks, const bf16x8* qr, int r32, int hi, int c0) {
  p0 = f32x16{}; p1 = f32x16{};
#pragma unroll
  for (int d0 = 0; d0 < ND0; ++d0) { const int cb = (c0 + d0 * 16 + hi * 8) * 2;
    const bf16x8 b0 = *reinterpret_cast<const bf16x8*>(Ks + KSWZ(r32, cb));
    const bf16x8 b1 = *reinterpret_cast<const bf16x8*>(Ks + KSWZ(32 + r32, cb));
    p0 = __builtin_amdgcn_mfma_f32_32x32x16_bf16(b0, qr[d0], p0, 0, 0, 0);
    p1 = __builtin_amdgcn_mfma_f32_32x32x16_bf16(b1, qr[d0], p1, 0, 0, 0); }
}
__device__ __forceinline__ int v_st(int k, int c) { const int kk = (k & ~0xC) | ((k & 4) << 1) | ((k & 8) >> 1); return ((kk >> 3) * 4 + (c >> 5)) * 512 + ((kk & 7) * 32 + (c & 31)) * 2; }
__device__ __forceinline__ int v_rd_base(int lane) { return ((lane & 3) << 3) | (((lane >> 2) & 3) << 6) | (((lane >> 4) & 1) << 5) | (((lane >> 5) & 1) << 8); }
constexpr int v_rd_off(int d0, int ks, int half) { return d0 * 512 + ks * 4096 + half * 2048; }
template <int OFF> __device__ __forceinline__ s16x4 tr_read(int vb) {
  s16x4 r; asm volatile("ds_read_b64_tr_b16 %0, %1 offset:%2" : "=&v"(r) : "v"(vb), "i"(OFF) : "memory"); return r;
}
template <int D0> __device__ __forceinline__ void pv_one(f32x16& od, int vb, bf16x8 pa0, bf16x8 pa1, bf16x8 pa2, bf16x8 pa3) {
  const s16x4 l0 = tr_read<v_rd_off(D0, 0, 0)>(vb), h0 = tr_read<v_rd_off(D0, 0, 1)>(vb), l1 = tr_read<v_rd_off(D0, 1, 0)>(vb), h1 = tr_read<v_rd_off(D0, 1, 1)>(vb);
  const s16x4 l2 = tr_read<v_rd_off(D0, 2, 0)>(vb), h2 = tr_read<v_rd_off(D0, 2, 1)>(vb), l3 = tr_read<v_rd_off(D0, 3, 0)>(vb), h3 = tr_read<v_rd_off(D0, 3, 1)>(vb);
  asm volatile("s_waitcnt lgkmcnt(0)" ::: "memory"); SBAR();
#define PK(L, H) (bf16x8){L[0], L[1], L[2], L[3], H[0], H[1], H[2], H[3]}
  od = __builtin_amdgcn_mfma_f32_32x32x16_bf16(pa0, PK(l0, h0), od, 0, 0, 0);
  od = __builtin_amdgcn_mfma_f32_32x32x16_bf16(pa1, PK(l1, h1), od, 0, 0, 0);
  od = __builtin_amdgcn_mfma_f32_32x32x16_bf16(pa2, PK(l2, h2), od, 0, 0, 0);
  od = __builtin_amdgcn_mfma_f32_32x32x16_bf16(pa3, PK(l3, h3), od, 0, 0, 0);
#undef PK
}
__device__ __forceinline__ void pv_d0(f32x16* o, int vb, bf16x8 pa0, bf16x8 pa1, bf16x8 pa2, bf16x8 pa3) {
  pv_one<0>(o[0], vb, pa0, pa1, pa2, pa3); pv_one<1>(o[1], vb, pa0, pa1, pa2, pa3); pv_one<2>(o[2], vb, pa0, pa1, pa2, pa3); pv_one<3>(o[3], vb, pa0, pa1, pa2, pa3);
}

__device__ __forceinline__ void diff_attn_unit(const bf16* Qb, const bf16* Kh, const bf16* Vh, int ld, int seq, bf16* outb, int ldo,
                                               const float lam, const float post_scale, const float* subln_g, char* lds, const int wave_id) {
  constexpr float SCALE = 0.125f, THR = 8.f;
  const int tid = tid_from_wave(wave_id), wid = __builtin_amdgcn_readfirstlane(tid >> 6), lane = tid & 63, r32 = lane & 31, hi = lane >> 5;
  const int csel = wid >> 2, wq = wid & 3;
  char* V_lds = lds; char* K_lds = lds + 2 * SHM_V;
  float* ws = (float*)(lds + 2 * SHM_V + 2 * SHM_K) + wid * 64; float* li_l = ws; float* al_l = ws + 32;
  float m_reg = -1e30f, l_reg = 0; f32x16 o[4] = {}; bf16x8 qr[4];
  const bf16* Qw = Qb + (long)(wq * 32 + r32) * ld + csel * 64 + hi * 8;
#pragma unroll
  for (int d0 = 0; d0 < 4; ++d0) qr[d0] = ld8(Qw + d0 * 16);
  const int sr = tid >> 4, sc = (tid & 15) * 8, vst0 = v_st(sr, sc), vst1 = v_st(32 + sr, sc);
  const int vb0 = (int)(uintptr_t)V_lds + v_rd_base(lane);
  const int kc0 = csel * 64;
  struct { bf16x8 vs0, vs1, ks0, ks1; } sr_[2];
#define SLOAD(i, k0) do { sr_[i].vs0 = ld8(&Vh[(long)((k0) + sr) * ld + sc]); sr_[i].vs1 = ld8(&Vh[(long)((k0) + 32 + sr) * ld + sc]); \
    sr_[i].ks0 = ld8(&Kh[(long)((k0) + sr) * ld + sc]); sr_[i].ks1 = ld8(&Kh[(long)((k0) + 32 + sr) * ld + sc]); } while (0)
#define SWRITE(b, i) do { *(bf16x8*)(V_lds + (b) * SHM_V + vst0) = sr_[i].vs0;          \
    *(bf16x8*)(V_lds + (b) * SHM_V + vst1) = sr_[i].vs1; const int kc = sc * 2;               \
    *(bf16x8*)(K_lds + (b) * SHM_K + KSWZ(sr, kc)) = sr_[i].ks0;                       \
    *(bf16x8*)(K_lds + (b) * SHM_K + KSWZ(32 + sr, kc)) = sr_[i].ks1; } while (0)
#define SWAIT() asm volatile("s_waitcnt vmcnt(4)" ::: "memory")
#define RESC(a) do { if (__any((a) < 1.f)) { if (hi == 0) al_l[r32] = (a); asm volatile("s_waitcnt lgkmcnt(0)" ::: "memory"); \
    _Pragma("unroll") for (int d = 0; d < 4; ++d) _Pragma("unroll") for (int r = 0; r < 16; ++r) o[d][r] *= al_l[crow(r, hi)]; } } while (0)
  f32x16 pA0, pA1, pB0, pB1; float mnA, mnB, alA, alB; bf16x8 pa0, pa1, pa2, pa3; const int NT = seq / KVBLK;
  constexpr int SE = 0, SO = 1;
  __syncthreads();
  SLOAD(SE, 0); asm volatile("s_waitcnt vmcnt(0)" ::: "memory"); SWRITE(0, SE); __syncthreads();
  qkt<4>(pA0, pA1, K_lds, qr, r32, hi, kc0); partialSM(pA0, pA1, m_reg, mnA, alA, SCALE, THR);
  SLOAD(SO, KVBLK); if (2 < NT) SLOAD(SE, 2 * KVBLK);
  SWAIT(); SWRITE(1, SO); __syncthreads();
  for (int j = 1; j + 1 < NT; j += 2) {
    SBAR(); qkt<4>(pB0, pB1, K_lds + SHM_K, qr, r32, hi, kc0);
    finishSM(pA0, pA1, alA, l_reg, pa0, pa1, pa2, pa3); SBAR();
    SLOAD(SO, (j + 2) * KVBLK); SBAR();
    pv_d0(o, vb0, pa0, pa1, pa2, pa3); partialSM(pB0, pB1, m_reg, mnB, alB, SCALE, THR);
    __syncthreads(); SWAIT(); SWRITE(0, SE);
    RESC(alB); __syncthreads();
    SBAR(); qkt<4>(pA0, pA1, K_lds, qr, r32, hi, kc0);
    finishSM(pB0, pB1, alB, l_reg, pa0, pa1, pa2, pa3); SBAR();
    if (j + 3 < NT) SLOAD(SE, (j + 3) * KVBLK); SBAR();
    pv_d0(o, vb0 + (int)SHM_V, pa0, pa1, pa2, pa3); partialSM(pA0, pA1, m_reg, mnA, alA, SCALE, THR);
    __syncthreads(); SWAIT(); SWRITE(1, SO);
    RESC(alA); __syncthreads();
  }
  SBAR(); qkt<4>(pB0, pB1, K_lds + SHM_K, qr, r32, hi, kc0);
  finishSM(pA0, pA1, alA, l_reg, pa0, pa1, pa2, pa3); SBAR();
  pv_d0(o, vb0, pa0, pa1, pa2, pa3); partialSM(pB0, pB1, m_reg, mnB, alB, SCALE, THR);
  __syncthreads(); RESC(alB);
  finishSM(pB0, pB1, alB, l_reg, pa0, pa1, pa2, pa3); SBAR();
  pv_d0(o, vb0 + (int)SHM_V, pa0, pa1, pa2, pa3);
  asm volatile("s_waitcnt vmcnt(0)" ::: "memory");
  if (hi == 0) li_l[r32] = l_reg; asm volatile("s_waitcnt lgkmcnt(0)" ::: "memory");
  float rli[16];
#pragma unroll
  for (int r = 0; r < 16; ++r) rli[r] = __builtin_amdgcn_rcpf(li_l[crow(r, hi)]);
  __syncthreads();
  float* X = (float*)lds + (size_t)wq * 4096;
  if (csel == 1) {
#pragma unroll
    for (int d0 = 0; d0 < 4; ++d0)
#pragma unroll
      for (int r = 0; r < 16; ++r) X[(d0 * 16 + r) * 64 + lane] = o[d0][r] * rli[r];
  }
  __syncthreads();
  if (csel == 0) {
    float ss[16];
#pragma unroll
    for (int r = 0; r < 16; ++r) ss[r] = 0.f;
#pragma unroll
    for (int d0 = 0; d0 < 4; ++d0)
#pragma unroll
      for (int r = 0; r < 16; ++r) { const float v = o[d0][r] * rli[r] - lam * X[(d0 * 16 + r) * 64 + lane]; o[d0][r] = v; ss[r] += v * v; }
#pragma unroll
    for (int r = 0; r < 16; ++r) { float s = ss[r];
      s = row_sum(s); s += xor_lane(s, lane, 16);
      ss[r] = __builtin_amdgcn_rsqf(s * (1.f / 128.f) + RMS_EPS) * post_scale; }
    float gg[4];
#pragma unroll
    for (int d0 = 0; d0 < 4; ++d0) gg[d0] = subln_g[d0 * 32 + r32];
    bf16* Ow = outb + (long)(wq * 32) * ldo;
#pragma unroll
    for (int r = 0; r < 16; ++r) { const int orow = crow(r, hi);
#pragma unroll
      for (int d0 = 0; d0 < 4; ++d0) Ow[(long)orow * ldo + d0 * 32 + r32] = f2bf(o[d0][r] * ss[r] * gg[d0]); }
  }
#undef SLOAD
#undef SWRITE
#undef SWAIT
}

__device__ __forceinline__ void dil_attn_unit(const bf16* Qh, const bf16* Kh, const bf16* Vh, int ld, int dil, int rho, int u0, int L,
                                              float* Oc, float* lsep, char* lds, const int wave_id) {
  constexpr float SCALE = 0.08838834764831845f; constexpr float C = SCALE * 1.4426950408889634f;
  const int tid = tid_from_wave(wave_id), wid = __builtin_amdgcn_readfirstlane(tid >> 6), lane = tid & 63, r32 = lane & 31, hi = lane >> 5;
  char* V_lds = lds; char* K_lds = lds + 2 * SHM_V;
  float* ws = (float*)(lds + 2 * SHM_V + 2 * SHM_K) + wid * 64; float* li_l = ws; float* al_l = ws + 32;
  float m_reg = -1e30f, l_reg = 0; f32x16 o[4] = {}; bf16x8 qr[8];
  const int uq = u0 + wid * 32 + r32;
  const bf16* Qw = Qh + (long)(rho + dil * uq) * ld + hi * 8;
#pragma unroll
  for (int d0 = 0; d0 < 8; ++d0) qr[d0] = ld8(Qw + d0 * 16);
  const int sr = tid >> 4, sc = (tid & 15) * 8, vst0 = v_st(sr, sc), vst1 = v_st(32 + sr, sc);
  const int vb0 = (int)(uintptr_t)V_lds + v_rd_base(lane);
  const int tlo = wid >> 1;
  for (int t = 0; t < 6; ++t) {
    const int kt0 = u0 - 64 + 64 * t;
    __syncthreads();
    { int ua = kt0 + sr, ub = kt0 + 32 + sr; ua = ua < 0 ? 0 : (ua >= L ? L - 1 : ua); ub = ub < 0 ? 0 : (ub >= L ? L - 1 : ub);
      const long ra = (long)(rho + dil * ua) * ld + sc, rb = (long)(rho + dil * ub) * ld + sc;
      const bf16x8 va = ld8(Vh + ra), vb = ld8(Vh + rb), ka = ld8(Kh + ra), kb = ld8(Kh + rb);
      *(bf16x8*)(V_lds + vst0) = va; *(bf16x8*)(V_lds + vst1) = vb; const int kc = sc * 2;
      *(bf16x8*)(K_lds + KSWZ(sr, kc)) = ka; *(bf16x8*)(K_lds + KSWZ(32 + sr, kc)) = kb; }
    __syncthreads();
    if (t >= tlo && t <= tlo + 2) {
      f32x16 p0, p1;
      qkt<8>(p0, p1, K_lds, qr, r32, hi, 0);
#pragma unroll
      for (int r = 0; r < 16; ++r) { const int uk0 = kt0 + crow(r, hi), uk1 = uk0 + 32; const int d0 = uk0 - uq, d1 = uk1 - uq;
        const bool ok0 = (uk0 >= 0) && (uk0 < L) && (d0 >= -64) && (d0 <= 64), ok1 = (uk1 >= 0) && (uk1 < L) && (d1 >= -64) && (d1 <= 64);
        p0[r] = ok0 ? p0[r] : -1e30f; p1[r] = ok1 ? p1[r] : -1e30f; }
      float pmax = p0[0];
#pragma unroll
      for (int r = 1; r < 16; ++r) pmax = fmaxf(pmax, p0[r]);
#pragma unroll
      for (int r = 0; r < 16; ++r) pmax = fmaxf(pmax, p1[r]);
      { auto rr = __builtin_amdgcn_permlane32_swap(__float_as_uint(pmax), __float_as_uint(pmax), false, false);
        pmax = fmaxf(__uint_as_float(rr[0]), __uint_as_float(rr[1])); }
      const float mn = fmaxf(m_reg, pmax); const float alpha = __builtin_amdgcn_exp2f((m_reg - mn) * C); m_reg = mn;
      const float mnC = -mn * C;
#pragma unroll
      for (int r = 0; r < 16; ++r) { p0[r] = __builtin_amdgcn_exp2f(fmaf(p0[r], C, mnC)); p1[r] = fmaf(p1[r], C, mnC); }
      bf16x8 pa0, pa1, pa2, pa3;
      finishSM(p0, p1, alpha, l_reg, pa0, pa1, pa2, pa3);
      RESC(alpha);
      pv_d0(o, vb0, pa0, pa1, pa2, pa3);
    }
  }
  if (hi == 0) li_l[r32] = l_reg; asm volatile("s_waitcnt lgkmcnt(0)" ::: "memory");
  float rli[16];
#pragma unroll
  for (int r = 0; r < 16; ++r) rli[r] = __builtin_amdgcn_rcpf(li_l[crow(r, hi)]);
#pragma unroll
  for (int r = 0; r < 16; ++r) { const int uo = u0 + wid * 32 + crow(r, hi); float* orow = Oc + (long)(rho + dil * uo) * 512;
#pragma unroll
    for (int d0 = 0; d0 < 4; ++d0) orow[d0 * 32 + r32] = o[d0][r] * rli[r]; }
  if (hi == 0) lsep[(long)(rho + dil * uq) * 4] = m_reg * SCALE + __logf(l_reg);
}
#undef RESC
#undef KSWZ
#undef SBAR
}

struct Args { const float* in[N_INPUTS]; float* out; unsigned char* ws; int ph_lo, ph_hi; };
typedef const __attribute__((address_space(4))) Args* ArgsP;
struct Frame {
    LAS unsigned char* lds; volatile LAS unsigned* MISC; unsigned* ctl; unsigned char* ws;
    int tid, lane, wave, G, bid;
};
constexpr int PH_P0 = 0, PH_P1 = 1, PH_P2 = 2, PH_L0 = 3, NPH_L = 13, PH_FINAL = PH_L0 + DEPTH * NPH_L, NPHASES = PH_FINAL + 1;
enum { LP_NORM1 = 0, LP_G1, LP_PREP, LP_CPREP, LP_MIX, LP_POST, LP_G2, LP_NORM2, LP_GS, LP_GO, LP_NORM3, LP_M1, LP_M2 };

__device__ __forceinline__ int q_next(Frame& F, int q) {
    __syncthreads();
    if (F.tid == 0) F.MISC[0] = __hip_atomic_fetch_add(F.ctl + CW_Q + 64 * q, 1u, __ATOMIC_RELAXED, __HIP_MEMORY_SCOPE_AGENT);
    __syncthreads();
    return (int)F.MISC[0];
}

template <class RowMap>
__device__ __forceinline__ void transpose_item(const float* W, int ldn, bf16* WT, int ldt, RowMap rm, LAS float* scr, int k0, int n0, int lane) {
#pragma unroll 8
    for (int i = 0; i < 32; ++i) { const int kk = 2 * i + (lane >> 5); scr[kk * 33 + (lane & 31)] = W[(size_t)(k0 + kk) * ldn + n0 + (lane & 31)]; }
    LDS_WAIT(); asm volatile("" ::: "memory");
    const int c = lane & 7;
#pragma unroll
    for (int j = 0; j < 4; ++j) { const int n = (lane >> 3) + 8 * j; const LAS float* s = scr + (8 * c) * 33 + n;
        u32x4 o; o.x = pk2(s[0 * 33], s[1 * 33]); o.y = pk2(s[2 * 33], s[3 * 33]); o.z = pk2(s[4 * 33], s[5 * 33]); o.w = pk2(s[6 * 33], s[7 * 33]);
        *(u32x4*)(WT + (size_t)rm(n0 + n) * ldt + k0 + 8 * c) = o; }
    LDS_WAIT(); asm volatile("" ::: "memory");
}
struct RmId { __device__ __forceinline__ int operator()(int n) const { return n; } };
struct RmW13 { int off; __device__ __forceinline__ int operator()(int n) const { return 256 * (n >> 7) + off + (n & 127); } };

__device__ __forceinline__ void p0_prologue(Frame& F, ArgsP a) {
    unsigned char* ws = F.ws;
    LAS float* scr = (LAS float*)(F.lds + F.wave * 16384);
    const int gw = F.bid * 8 + F.wave, NGW = F.G * 8;
    constexpr int I_WIN = (DM / 64) * (IN_TOTAL / 32), I_SQ = (DM / 64) * (DM / 32), I_WKV = (DM / 64) * (4096 / 32), I_W1 = (DM / 64) * (DEXP / 32), I_W2 = (DEXP / 64) * (DM / 32);
    constexpr int PER_L = I_WIN + I_SQ + I_WKV + I_SQ + NEXP * (2 * I_W1 + I_W2);
    for (int it = gw; it < DEPTH * PER_L; it += NGW) {
        const int l = it / PER_L; int r = it % PER_L;
        if (r < I_WIN) { const int nb = IN_TOTAL / 32; transpose_item(a->in[I_W_IN] + (size_t)l * DM * IN_TOTAL, IN_TOTAL, (bf16*)(ws + WS_WIN) + (size_t)l * ZLD * DM, DM, RmId{}, scr, 64 * (r / nb), 32 * (r % nb), F.lane); continue; } r -= I_WIN;
        if (r < I_SQ) { const int nb = DM / 32; transpose_item(a->in[I_W_OUT] + (size_t)l * DM * DM, DM, (bf16*)(ws + WS_WOUT) + (size_t)l * DM * DM, DM, RmId{}, scr, 64 * (r / nb), 32 * (r % nb), F.lane); continue; } r -= I_SQ;
        if (r < I_WKV) { const int nb = 4096 / 32; transpose_item(a->in[I_XA_WKV] + (size_t)l * DM * 4096, 4096, (bf16*)(ws + SC_WKVT) + (size_t)l * 4096 * DM, DM, RmId{}, scr, 64 * (r / nb), 32 * (r % nb), F.lane); continue; } r -= I_WKV;
        if (r < I_SQ) { const int nb = DM / 32; transpose_item(a->in[I_XA_WO] + (size_t)l * DM * DM, DM, (bf16*)(ws + SC_WOT) + (size_t)l * DM * DM, DM, RmId{}, scr, 64 * (r / nb), 32 * (r % nb), F.lane); continue; } r -= I_SQ;
        const int e = r / (2 * I_W1 + I_W2); r = r % (2 * I_W1 + I_W2);
        const size_t le = (size_t)l * NEXP + e;
        if (r < I_W1) { const int nb = DEXP / 32; transpose_item(a->in[I_MOE_W1] + le * DM * DEXP, DEXP, (bf16*)(ws + WS_W13) + le * 1024 * DM, DM, RmW13{0}, scr, 64 * (r / nb), 32 * (r % nb), F.lane); continue; } r -= I_W1;
        if (r < I_W1) { const int nb = DEXP / 32; transpose_item(a->in[I_MOE_W3] + le * DM * DEXP, DEXP, (bf16*)(ws + WS_W13) + le * 1024 * DM, DM, RmW13{128}, scr, 64 * (r / nb), 32 * (r % nb), F.lane); continue; } r -= I_W1;
        { const int nb = DM / 32; transpose_item(a->in[I_MOE_W2] + le * DEXP * DM, DM, (bf16*)(ws + WS_W2) + le * DM * DEXP, DEXP, RmId{}, scr, 64 * (r / nb), 32 * (r % nb), F.lane); }
    }
    for (int it = gw; it < DEPTH * 96; it += NGW) { const int l = it / 96; int r = it % 96; bf16* base = (bf16*)(ws + WS_LORA + l * LORA_LAYER);
        if (r < 32) { const int d = r >> 4, nb = r & 15; transpose_item(a->in[I_RWKV_W2] + ((size_t)l * 2 + d) * 64 * 512, 512, base + (size_t)d * 512 * 64, 64, RmId{}, scr, 0, 32 * nb, F.lane); continue; } r -= 32;
        if (r < 32) { const int d = r >> 4, nb = r & 15; transpose_item(a->in[I_RWKV_A2] + ((size_t)l * 2 + d) * 64 * 512, 512, base + (size_t)(2 + d) * 512 * 64, 64, RmId{}, scr, 0, 32 * nb, F.lane); continue; } r -= 32;
        { const int kb = r >> 4, nb = r & 15; transpose_item(a->in[I_RWKV_G2] + (size_t)l * 128 * 512, 512, base + (size_t)4 * 512 * 64, 128, RmId{}, scr, 64 * kb, 32 * nb, F.lane); } }
    for (int it = gw; it < DEPTH * 128; it += NGW) { const int l = it / 128, r = it % 128, kb = r >> 4, nb = r & 15;
        transpose_item(a->in[I_S5_GLU_W] + (size_t)l * 512 * 512, 512, (bf16*)(ws + WS_GLUT) + (size_t)l * 512 * 512, 512, RmId{}, scr, 64 * kb, 32 * nb, F.lane); }
    const int gt = F.bid * 512 + F.tid, NGT = F.G * 512;
    for (int i = gt; i < DEPTH * 32 * 16 * 64; i += NGT) { const int n = i & 63, row = i >> 6;
        bf16* cw = (bf16*)(ws + WS_S5CW) + (size_t)row * 128; cw[n] = f2bf(a->in[I_S5_C_RE][i]); cw[64 + n] = f2bf(-a->in[I_S5_C_IM][i]); }
    for (int i = gt; i < DEPTH * DM * 32; i += NGT) { const int l = i / (DM * 32), r = i % (DM * 32), k = r >> 5, e = r & 31;
        ((float*)(ws + WS_RTE))[(((size_t)l * 4 + (e >> 3)) * DM + k) * 8 + (e & 7)] = a->in[I_ROUTER_EXPERT][i]; }
    for (int i = gt; i < DEPTH * (ZLD - IN_TOTAL) * DM / 8; i += NGT) { const int l = i / ((ZLD - IN_TOTAL) * DM / 8), r = i % ((ZLD - IN_TOTAL) * DM / 8);
        *(u32x4*)((bf16*)(ws + WS_WIN) + (size_t)l * ZLD * DM + (size_t)IN_TOTAL * DM + (size_t)r * 8) = (u32x4){0u, 0u, 0u, 0u}; }
    for (int i = gt; i < DEPTH * DM * DM / 8; i += NGT) { const f32x4 x0 = *(const f32x4*)(a->in[I_XA_WQ] + (size_t)i * 8), x1 = *(const f32x4*)(a->in[I_XA_WQ] + (size_t)i * 8 + 4);
        u32x4 o; o.x = pk2(x0[0], x0[1]); o.y = pk2(x0[2], x0[3]); o.z = pk2(x1[0], x1[1]); o.w = pk2(x1[2], x1[3]); *(u32x4*)((bf16*)(ws + SC_WQB) + (size_t)i * 8) = o; }
    { float* cosA = (float*)(ws + WS_ROPE); float* sinA = cosA + SEQ * 32; float* cosC = sinA + SEQ * 32; float* sinC = cosC + SEQ * 64;
      for (int i = gt; i < SEQ * 96; i += NGT) { const int s = i / 96, j = i % 96; const bool isA = j < 32; const int jj = isA ? j : j - 32; const float dim = isA ? 64.f : 128.f;
          const float inv = 1.0f / powf(10000.0f, (float)(2 * jj) / dim); const float ang = (float)s * inv; float sn, cs; sincosf(ang, &sn, &cs);
          if (isA) { cosA[s * 32 + jj] = cs; sinA[s * 32 + jj] = sn; } else { cosC[s * 64 + jj] = cs; sinC[s * 64 + jj] = sn; } } }
    for (int i = gt; i < DEPTH * 2 * 32 * 64; i += NGT) { const int l = i / (2 * 32 * 64), r = i % (2 * 32 * 64), dir = r / (32 * 64), g = (r / 64) % 32, n = r % 64;
        float* ab = (float*)(ws + WS_S5P + l * S5P_LAYER); float* bb = ab + 2 * 32 * 64 * 2;
        const size_t pi = (((size_t)l * 2 + dir) * 32 + g) * 64 + n;
        const float lr = fminf(a->in[I_S5_A_RE][pi], -1e-4f), li = a->in[I_S5_A_IM][pi], dt = __expf(a->in[I_S5_LOG_DT][((size_t)l * 2 + dir) * 32 + g]);
        const float mag = __expf(dt * lr); float sn, cs; sincosf(dt * li, &sn, &cs); const float abr = mag * cs, abi = mag * sn;
        const float den = lr * lr + li * li; const float ir = lr / den, ii = -li / den;
        const float fr_ = (abr - 1.f) * ir - abi * ii, fi_ = (abr - 1.f) * ii + abi * ir;
        ab[(size_t)r * 2] = abr; ab[(size_t)r * 2 + 1] = abi;
        { float* ab256 = bb + 2 * 32 * 64 * 16 * 2; const float m256 = __expf(256.f * dt * lr); float s2, c2; sincosf(256.f * dt * li, &s2, &c2); ab256[(size_t)r * 2] = m256 * c2; ab256[(size_t)r * 2 + 1] = m256 * s2; }
        const size_t bi = (((size_t)l * 32 + g) * 64 + n) * 16;
#pragma unroll
        for (int c = 0; c < 16; ++c) { const float br = a->in[I_S5_B_RE][bi + c], bim = a->in[I_S5_B_IM][bi + c];
            bb[((size_t)r * 16 + c) * 2] = fr_ * br - fi_ * bim; bb[((size_t)r * 16 + c) * 2 + 1] = fr_ * bim + fi_ * br; } }
    for (int it = gw; it < DEPTH * BATCH * NMEM; it += NGW) { const int l = it / (BATCH * NMEM), row = it % (BATCH * NMEM);
        const f32x4* xr = (const f32x4*)(a->in[I_MEM] + (size_t)row * DM) + F.lane; const f32x4* gr = (const f32x4*)(a->in[I_NORM_MEM] + (size_t)l * DM) + F.lane;
        f32x4 v[8]; float s = 0.f;
#pragma unroll
        for (int j = 0; j < 8; ++j) { v[j] = xr[64 * j]; s += (v[j].x * v[j].x + v[j].y * v[j].y) + (v[j].z * v[j].z + v[j].w * v[j].w); }
        const float rstd = 1.f / sqrtf(wave_sum(s) * (1.f / DM) + RMS_EPS);
        u32x2* o8 = (u32x2*)((bf16*)(ws + SC_MEMN) + ((size_t)l * 512 + row) * DM) + F.lane;
#pragma unroll
        for (int j = 0; j < 8; ++j) { const f32x4 gv = gr[64 * j]; u32x2 w; w.x = pk2(v[j].x * rstd * gv.x, v[j].y * rstd * gv.y); w.y = pk2(v[j].z * rstd * gv.z, v[j].w * rstd * gv.w); o8[64 * j] = w; } }
}

struct SchedDense { const char* A; const char* B; char* C; int nM, nN, G, c, lda, ldb, ldcb  , cesz  ;
    __device__ __forceinline__ bool next(int i, pg8::Unit& u) const { const long L = (long)i * G + c; if (L >= (long)nM * nN) return false; int pm, pn; pg8::xcd_tile((int)L, nM, nN, pm, pn);
        u.A = A + (size_t)pm * 256 * lda * 2; u.B = B + (size_t)pn * 256 * ldb * 2; u.C = C + (size_t)pm * 256 * ldcb + (size_t)pn * 256 * cesz; u.row0 = pm * 256; u.col0 = pn * 256; u.aux = 0; return true; }
    __device__ __forceinline__ int arow(const pg8::Unit&, int r) const { return r; } };
struct SchedBatch { const char* A; const char* B; char* C; size_t sA, sB, sC; int nM, nN, nb, G, c, lda, ldb, ldcb, cesz, rowsPerBatch;
    __device__ __forceinline__ bool next(int i, pg8::Unit& u) const { const long L = (long)i * G + c; const int per = nM * nN; if (L >= (long)per * nb) return false; const int b = (int)(L / per), r = (int)(L % per), pm = r / nN, pn = r % nN;
        u.A = A + b * sA + (size_t)pm * 256 * lda * 2; u.B = B + b * sB + (size_t)pn * 256 * ldb * 2; u.C = C + b * sC + (size_t)pm * 256 * ldcb + (size_t)pn * 256 * cesz; u.row0 = b * rowsPerBatch + pm * 256; u.col0 = pn * 256; u.aux = b; return true; }
    __device__ __forceinline__ int arow(const pg8::Unit&, int r) const { return r; } };
struct SchedXaPre { unsigned char* ws; int G, c, kind;
    __device__ __forceinline__ bool next(int i, pg8::Unit& u) const { const long L = (long)i * G + c; if (L >= 128) return false; const int r = (int)L, p = r >> 3, t = r & 7, l = p >> 3, b = (p >> 2) & 1, h = p & 3;
        const bf16* kvb = (const bf16*)(ws + SC_KVB) + (size_t)l * 512 * 4096 + (size_t)(b * 256) * 4096;
        if (kind == 0) { u.A = (const char*)(kvb + h * 512); u.B = (const char*)((const bf16*)(ws + SC_WQB) + (size_t)l * DM * DM + (size_t)(t * 256) * DM + h * 512);
            u.C = (char*)((bf16*)(ws + WS_WQK) + ((size_t)(l * 2 + b) * 1024 + h * 256) * DM + t * 256); u.aux = DM; }
        else { u.A = (const char*)((const bf16*)(ws + SC_WOT) + (size_t)l * DM * DM + (size_t)(t * 256) * DM + h * 512); u.B = (const char*)(kvb + 2048 + h * 512);
            u.C = (char*)((bf16*)(ws + WS_VWO) + ((size_t)(l * 2 + b) * DM + t * 256) * 1024 + h * 256); u.aux = 1024; }
        u.row0 = 0; u.col0 = 0; return true; }
    __device__ __forceinline__ int arow(const pg8::Unit&, int r) const { return r; } };
struct EpiBf16U { static constexpr bool PERM = true, AFTER_DRAIN = false;
    __device__ __forceinline__ void operator()(const pg8::Acc& acc, const pg8::Unit& u, int wr, int wc, int fr, int fq) const { pg8::EpiBf16 e{u.aux}; e(acc, u, wr, wc, fr, fq); } };
struct SchedMoe { unsigned char* ws; const volatile LAS int* tp; const volatile LAS int* cnt; int layer, G, c, which;
    __device__ __forceinline__ bool next(int i, pg8::Unit& u) const {
        const int npn = which == 0 ? 4 : 8; const long L = (long)i * G + c; const int ntile = tp[32]; if (L >= (long)ntile * npn) return false;
        const int mt = (int)(L / npn), pn = (int)(L % npn); int e = 0;
#pragma unroll 1
        for (int k = 1; k < 32; ++k) e += (mt >= tp[k]) ? 1 : 0;
        const int lt = mt - tp[e]; const int nvalid = min(256, cnt[e] - lt * 256);
        u.row0 = lt * 256; u.col0 = pn * 256; u.aux = (e << 16) | nvalid;
        if (which == 0) { u.A = (const char*)(ws + WS_HN); u.B = (const char*)((const bf16*)(ws + WS_W13) + ((size_t)(layer * NEXP + e) * 1024 + pn * 256) * DM);
            u.C = (char*)((bf16*)(ws + SC_HMID) + (size_t)(mt * 256) * DEXP + pn * 128); }
        else { u.A = (const char*)((const bf16*)(ws + SC_HMID) + (size_t)(mt * 256) * DEXP); u.B = (const char*)((const bf16*)(ws + WS_W2) + ((size_t)(layer * NEXP + e) * DM + pn * 256) * DEXP);
            u.C = (char*)((bf16*)(ws + SC_YBUF) + (size_t)(mt * 256) * DM + pn * 256); }
        return true; }
    __device__ __forceinline__ int arow(const pg8::Unit& u, int r) const { const int e = u.aux >> 16, nvalid = u.aux & 0xffff; const int idx = (r < nvalid) ? (u.row0 + r) : u.row0;
        return ((const int*)(ws + WS_ETOK))[(size_t)e * ECAP + idx]; } };

__device__ __forceinline__ void moe_prefix(Frame& F, int layer, volatile LAS int* tp, volatile LAS int* cnt) {
    __syncthreads();
    if (F.tid < 32) cnt[F.tid] = (int)__hip_atomic_load(F.ctl + CW_CNT + (layer * 32 + F.tid) * 64, __ATOMIC_RELAXED, __HIP_MEMORY_SCOPE_AGENT);
    __syncthreads();
    if (F.tid == 0) { int s = 0; for (int e = 0; e < 32; ++e) { tp[e] = s; s += (cnt[e] + 255) >> 8; } tp[32] = s; }
    __syncthreads();
}
template <int MODE>
__device__ __forceinline__ void norm_phase(Frame& F, ArgsP a, const float* src, const float* gain, int layer) {
    unsigned char* ws = F.ws; float* H = (float*)(ws + WS_H); bf16* HN = (bf16*)(ws + WS_HN);
    volatile LAS int* tp = (volatile LAS int*)(F.lds + 1024); volatile LAS int* cnt = tp + 40;
    if (MODE & 1) moe_prefix(F, layer - 1, tp, cnt);
    const int gw = F.bid * 8 + F.wave, NGW = F.G * 8;
    const f32x4* gr = (const f32x4*)gain + F.lane;
    for (int row = gw; row < NTOK; row += NGW) {
        const f32x4* xr = (const f32x4*)(src + (size_t)row * DM) + F.lane;
        f32x4 v[8];
#pragma unroll
        for (int j = 0; j < 8; ++j) v[j] = xr[64 * j];
        if (MODE & 1) {
            const int* ti = (const int*)(ws + WS_TINFO) + (size_t)row * 4;
            const int e0 = ti[0], p0 = ti[1], e1 = ti[2], p1 = ti[3];
            const size_t s0 = (size_t)tp[e0] * 256 + p0, s1 = (size_t)tp[e1] * 256 + p1;
            const u32x2* y0 = (const u32x2*)((const bf16*)(ws + SC_YBUF) + s0 * DM) + F.lane; const u32x2* y1 = (const u32x2*)((const bf16*)(ws + SC_YBUF) + s1 * DM) + F.lane;
#pragma unroll
            for (int j = 0; j < 8; ++j) { const u32x2 a0 = y0[64 * j], a1 = y1[64 * j];
                v[j].x += __uint_as_float(a0.x << 16) + __uint_as_float(a1.x << 16); v[j].y += __uint_as_float(a0.x & 0xffff0000u) + __uint_as_float(a1.x & 0xffff0000u);
                v[j].z += __uint_as_float(a0.y << 16) + __uint_as_float(a1.y << 16); v[j].w += __uint_as_float(a0.y & 0xffff0000u) + __uint_as_float(a1.y & 0xffff0000u); }
            if (!(MODE & 4)) { f32x4* hr = (f32x4*)(H + (size_t)row * DM) + F.lane;
#pragma unroll
                for (int j = 0; j < 8; ++j) hr[64 * j] = v[j]; }
        }
        float s = 0.f;
#pragma unroll
        for (int j = 0; j < 8; ++j) s += (v[j].x * v[j].x + v[j].y * v[j].y) + (v[j].z * v[j].z + v[j].w * v[j].w);
        const float rstd = 1.f / sqrtf(wave_sum(s) * (1.f / DM) + RMS_EPS);
#pragma unroll
        for (int j = 0; j < 8; ++j) { const f32x4 gv = gr[64 * j]; v[j].x *= rstd * gv.x; v[j].y *= rstd * gv.y; v[j].z *= rstd * gv.z; v[j].w *= rstd * gv.w; }
        if (MODE & 4) { f32x4* orow = (f32x4*)(a->out + (size_t)row * DM) + F.lane;
#ifdef DBG_RWCHK
            { const float* cw = (const float*)(F.ctl + 32768); const unsigned* cu = (const unsigned*)cw; const float sc = cu[DBG_RWCHK * 64 + 2] ? 1001.f : 1.f + fminf(cw[DBG_RWCHK * 64] / cw[DBG_RWCHK * 64 + 1], 100.f);
#pragma unroll
              for (int j = 0; j < 8; ++j) v[j] *= sc; }
#endif
#pragma unroll
            for (int j = 0; j < 8; ++j) orow[64 * j] = v[j]; }
        else { u32x2* o8 = (u32x2*)(HN + (size_t)row * DM) + F.lane;
#pragma unroll
            for (int j = 0; j < 8; ++j) { u32x2 w; w.x = pk2(v[j].x, v[j].y); w.y = pk2(v[j].z, v[j].w); o8[64 * j] = w; } }
        if (MODE & 2) {
            const float* wg = a->in[I_ROUTER_GROUP] + (size_t)layer * DM * 4;
            float lg[4] = {0.f, 0.f, 0.f, 0.f};
#pragma unroll
            for (int j = 0; j < 8; ++j) { const int k0 = (64 * j + F.lane) * 4;
#pragma unroll
                for (int q = 0; q < 4; ++q) { const f32x4 w4 = *(const f32x4*)(wg + (size_t)(k0 + q) * 4); const float x = v[j][q]; lg[0] += x * w4.x; lg[1] += x * w4.y; lg[2] += x * w4.z; lg[3] += x * w4.w; } }
#pragma unroll
            for (int q = 0; q < 4; ++q) lg[q] = wave_sum(lg[q]);
            int gi = 0; float gm = lg[0];
#pragma unroll
            for (int q = 1; q < 4; ++q) if (lg[q] > gm) { gm = lg[q]; gi = q; }
            const float gw_ = 1.f / (__expf(lg[0] - gm) + __expf(lg[1] - gm) + __expf(lg[2] - gm) + __expf(lg[3] - gm));
            float le[8] = {0.f, 0.f, 0.f, 0.f, 0.f, 0.f, 0.f, 0.f};
            const float* we = (const float*)(ws + WS_RTE) + ((size_t)layer * 4 + gi) * DM * 8;
#pragma unroll 4
            for (int j = 0; j < 8; ++j) { const int k0 = (64 * j + F.lane) * 4;
#pragma unroll
                for (int q = 0; q < 4; ++q) { const float* wp = we + (size_t)(k0 + q) * 8; const f32x4 wa = *(const f32x4*)wp, wb = *(const f32x4*)(wp + 4); const float x = v[j][q];
                    le[0] += x * wa.x; le[1] += x * wa.y; le[2] += x * wa.z; le[3] += x * wa.w; le[4] += x * wb.x; le[5] += x * wb.y; le[6] += x * wb.z; le[7] += x * wb.w; } }
#pragma unroll
            for (int q = 0; q < 8; ++q) le[q] = wave_sum(le[q]);
            int i0 = 0; float m0 = le[0];
#pragma unroll
            for (int q = 1; q < 8; ++q) if (le[q] > m0) { m0 = le[q]; i0 = q; }
            int i1 = -1; float m1 = -3.0e38f;
#pragma unroll
            for (int q = 0; q < 8; ++q) if (q != i0 && le[q] > m1) { m1 = le[q]; i1 = q; }
            const float t = __expf(m1 - m0); const float w0 = 1.f / (1.f + t), w1 = t / (1.f + t);
            if (F.lane == 0) {
                const int e0 = gi * 8 + i0, e1 = gi * 8 + i1;
                const int p0 = (int)__hip_atomic_fetch_add(F.ctl + CW_CNT + (layer * 32 + e0) * 64, 1u, __ATOMIC_RELAXED, __HIP_MEMORY_SCOPE_AGENT);
                const int p1 = (int)__hip_atomic_fetch_add(F.ctl + CW_CNT + (layer * 32 + e1) * 64, 1u, __ATOMIC_RELAXED, __HIP_MEMORY_SCOPE_AGENT);
                int* et = (int*)(ws + WS_ETOK); float* eg = (float*)(ws + WS_EGATE); int* ti = (int*)(ws + WS_TINFO) + (size_t)row * 4;
                et[(size_t)e0 * ECAP + p0] = row; eg[(size_t)e0 * ECAP + p0] = gw_ * w0; et[(size_t)e1 * ECAP + p1] = row; eg[(size_t)e1 * ECAP + p1] = gw_ * w1;
                ti[0] = e0; ti[1] = p0; ti[2] = e1; ti[3] = p1;
            }
        }
    }
}

__device__ __forceinline__ void rope8(bf16* p1, bf16* p2, const float* cs, const float* sn) {
    const u32x4 a = *(const u32x4*)p1, b = *(const u32x4*)p2; const f32x4 c0 = *(const f32x4*)cs, c1 = *(const f32x4*)(cs + 4), s0 = *(const f32x4*)sn, s1 = *(const f32x4*)(sn + 4);
    const float x1[8] = {__uint_as_float(a.x << 16), __uint_as_float(a.x & 0xffff0000u), __uint_as_float(a.y << 16), __uint_as_float(a.y & 0xffff0000u), __uint_as_float(a.z << 16), __uint_as_float(a.z & 0xffff0000u), __uint_as_float(a.w << 16), __uint_as_float(a.w & 0xffff0000u)};
    const float x2[8] = {__uint_as_float(b.x << 16), __uint_as_float(b.x & 0xffff0000u), __uint_as_float(b.y << 16), __uint_as_float(b.y & 0xffff0000u), __uint_as_float(b.z << 16), __uint_as_float(b.z & 0xffff0000u), __uint_as_float(b.w << 16), __uint_as_float(b.w & 0xffff0000u)};
    const float cc[8] = {c0[0], c0[1], c0[2], c0[3], c1[0], c1[1], c1[2], c1[3]}, ss[8] = {s0[0], s0[1], s0[2], s0[3], s1[0], s1[1], s1[2], s1[3]};
    float o1[8], o2[8];
#pragma unroll
    for (int i = 0; i < 8; ++i) { o1[i] = x1[i] * cc[i] - x2[i] * ss[i]; o2[i] = x2[i] * cc[i] + x1[i] * ss[i]; }
    *(u32x4*)p1 = (u32x4){pk2(o1[0], o1[1]), pk2(o1[2], o1[3]), pk2(o1[4], o1[5]), pk2(o1[6], o1[7])};
    *(u32x4*)p2 = (u32x4){pk2(o2[0], o2[1]), pk2(o2[2], o2[3]), pk2(o2[4], o2[5]), pk2(o2[6], o2[7])};
}
__device__ __forceinline__ void rope_token(Frame& F, bf16* zrow, int s) {
    const float* cosA = (const float*)(F.ws + WS_ROPE); const float* sinA = cosA + SEQ * 32; const float* cosC = sinA + SEQ * 32; const float* sinC = cosC + SEQ * 64;
    { const int blk = F.lane >> 2, pc = F.lane & 3; bf16* p = zrow + ZA + blk * 64 + pc * 8; rope8(p, p + 32, cosA + s * 32 + pc * 8, sinA + s * 32 + pc * 8); }
    { const int blk = F.lane >> 3, pc = F.lane & 7; bf16* p = zrow + ZC + blk * 128 + pc * 8; rope8(p, p + 64, cosC + s * 64 + pc * 8, sinC + s * 64 + pc * 8); }
}

constexpr int RWT = 16;
__device__ __forceinline__ float zs_ld(const LAS unsigned short* zr, const float* mu, int t, int col) {
    const float z0 = bf2f(zr[(t + 1) * IN_B + col]), zp = bf2f(zr[t * IN_B + col]), zn = bf2f(zr[(t + 2) * IN_B + col]);
    return z0 + mu[col] * (zp - z0) + mu[IN_B + col] * (zn - z0);
}
__device__ __forceinline__ void rwkv_prep_tile(Frame& F, ArgsP a, int layer, int tile) {
    unsigned char* ws = F.ws; const bf16* Z = (const bf16*)(ws + SC_Z);
    LAS unsigned short* zr = (LAS unsigned short*)F.lds; LAS unsigned short* act = zr + (RWT + 2) * IN_B;
    const int t0 = tile * RWT; const int b = t0 / SEQ, s0 = t0 % SEQ;
    __syncthreads();
#pragma unroll 1
    for (int i = F.tid; i < (RWT + 2) * (IN_B / 8); i += 512) { const int rr = i / (IN_B / 8), c8 = i % (IN_B / 8); const int s = s0 - 1 + rr;
        u32x4 w = {0u, 0u, 0u, 0u};
        if (s >= 0 && s < SEQ) w = *(const u32x4*)(Z + (size_t)(b * SEQ + s) * ZLD + ZB + c8 * 8);
        *(LAS u32x4*)(zr + rr * IN_B + c8 * 8) = w; }
    __syncthreads();
    const float* mu = a->in[I_RWKV_MU] + (size_t)layer * 2 * IN_B;
#pragma unroll 1
    for (int i = F.tid; i < RWT * 384; i += 512) { const int t = i / 384, j = i % 384; const float x = zs_ld(zr, mu, t, 1536 + j);
        act[t * 392 + j] = f2bf((j < 128) ? tanhf(x) : ((j < 256) ? x : sigmoidf_(x))); }
    __syncthreads();
    const int lane = F.lane, r = lane & 15, g = lane >> 4, hd = F.wave;
    const bf16* lw = (const bf16*)(ws + WS_LORA + layer * LORA_LAYER);
    bf16x8 af[12];
#pragma unroll
    for (int ks = 0; ks < 12; ++ks) af[ks] = *(const LAS bf16x8*)(act + r * 392 + ks * 32 + g * 8);
    float* RW = (float*)(ws + SC_RW); const size_t N1 = (size_t)NTOK * 512;
    f32x4 dw0[4], dw1[4], da0[4], da1[4], dg[4];
#pragma unroll
    for (int nt = 0; nt < 4; ++nt) { const int c = hd * 64 + nt * 16 + r;
        bf16x8 bw[12];
#pragma unroll
        for (int ks = 0; ks < 2; ++ks) { bw[ks] = *(const bf16x8*)(lw + ((size_t)0 * 512 + c) * 64 + ks * 32 + g * 8); bw[2 + ks] = *(const bf16x8*)(lw + ((size_t)1 * 512 + c) * 64 + ks * 32 + g * 8);
            bw[4 + ks] = *(const bf16x8*)(lw + ((size_t)2 * 512 + c) * 64 + ks * 32 + g * 8); bw[6 + ks] = *(const bf16x8*)(lw + ((size_t)3 * 512 + c) * 64 + ks * 32 + g * 8); }
#pragma unroll
        for (int ks = 0; ks < 4; ++ks) bw[8 + ks] = *(const bf16x8*)(lw + (size_t)4 * 512 * 64 + (size_t)c * 128 + ks * 32 + g * 8);
        f32x4 z4 = {0.f, 0.f, 0.f, 0.f};
        dw0[nt] = __builtin_amdgcn_mfma_f32_16x16x32_bf16(af[0], bw[0], z4, 0, 0, 0); dw0[nt] = __builtin_amdgcn_mfma_f32_16x16x32_bf16(af[1], bw[1], dw0[nt], 0, 0, 0);
        dw1[nt] = __builtin_amdgcn_mfma_f32_16x16x32_bf16(af[2], bw[2], z4, 0, 0, 0); dw1[nt] = __builtin_amdgcn_mfma_f32_16x16x32_bf16(af[3], bw[3], dw1[nt], 0, 0, 0);
        da0[nt] = __builtin_amdgcn_mfma_f32_16x16x32_bf16(af[4], bw[4], z4, 0, 0, 0); da0[nt] = __builtin_amdgcn_mfma_f32_16x16x32_bf16(af[5], bw[5], da0[nt], 0, 0, 0);
        da1[nt] = __builtin_amdgcn_mfma_f32_16x16x32_bf16(af[6], bw[6], z4, 0, 0, 0); da1[nt] = __builtin_amdgcn_mfma_f32_16x16x32_bf16(af[7], bw[7], da1[nt], 0, 0, 0);
        dg[nt] = __builtin_amdgcn_mfma_f32_16x16x32_bf16(af[8], bw[8], z4, 0, 0, 0); dg[nt] = __builtin_amdgcn_mfma_f32_16x16x32_bf16(af[9], bw[9], dg[nt], 0, 0, 0);
        dg[nt] = __builtin_amdgcn_mfma_f32_16x16x32_bf16(af[10], bw[10], dg[nt], 0, 0, 0); dg[nt] = __builtin_amdgcn_mfma_f32_16x16x32_bf16(af[11], bw[11], dg[nt], 0, 0, 0);
    }
    float w00[4], w01[4], a00[4], a01[4], kkw[4], kaw[4];
#pragma unroll
    for (int nt = 0; nt < 4; ++nt) { const int c = hd * 64 + nt * 16 + r;
        w00[nt] = a->in[I_RWKV_W0][(size_t)layer * 1024 + c]; w01[nt] = a->in[I_RWKV_W0][(size_t)layer * 1024 + 512 + c];
        a00[nt] = a->in[I_RWKV_A0][(size_t)layer * 1024 + c]; a01[nt] = a->in[I_RWKV_A0][(size_t)layer * 1024 + 512 + c];
        kkw[nt] = a->in[I_RWKV_KK][(size_t)layer * 512 + c]; kaw[nt] = a->in[I_RWKV_KA][(size_t)layer * 512 + c]; }
#pragma unroll
    for (int q = 0; q < 4; ++q) { const int t = 4 * g + q;
        float k_[4], kk[4]; float ssq = 0.f;
#pragma unroll
        for (int nt = 0; nt < 4; ++nt) { const int c = hd * 64 + nt * 16 + r; k_[nt] = zs_ld(zr, mu, t, 512 + c); kk[nt] = k_[nt] * kkw[nt]; ssq += kk[nt] * kk[nt]; }
        ssq = row_sum(ssq);
        const float rn = 1.f / sqrtf(ssq + 1e-12f);
#pragma unroll
        for (int nt = 0; nt < 4; ++nt) { const int c = hd * 64 + nt * 16 + r;
            const float r_ = zs_ld(zr, mu, t, c), v_ = zs_ld(zr, mu, t, 1024 + c);
            const float x0 = -(w00[nt] + dw0[nt][q]), x1 = -(w01[nt] + dw1[nt][q]);
            const float sp0 = fmaxf(x0, 0.f) + __logf(1.f + __expf(-fabsf(x0))), sp1 = fmaxf(x1, 0.f) + __logf(1.f + __expf(-fabsf(x1)));
            const float d0 = -__expf(-sp0 - 0.5f), d1 = -__expf(-sp1 - 0.5f);
            const float al0 = sigmoidf_(a00[nt] + da0[nt][q]), al1 = sigmoidf_(a01[nt] + da1[nt][q]);
            const float kn = kk[nt] * rn;
            const float km0 = k_[nt] * (1.f + (al0 - 1.f) * kaw[nt]), km1 = k_[nt] * (1.f + (al1 - 1.f) * kaw[nt]);
            const size_t o = (size_t)(t0 + t) * 512 + c;
            RW[0 * N1 + o] = r_; RW[1 * N1 + o] = v_; RW[2 * N1 + o] = kn; RW[3 * N1 + o] = d0; RW[4 * N1 + o] = d1;
            RW[5 * N1 + o] = km0; RW[6 * N1 + o] = km1; RW[7 * N1 + o] = kn * al0; RW[8 * N1 + o] = kn * al1; RW[9 * N1 + o] = dg[nt][q]; }
    }
}

constexpr size_t SC_S5E = SC_MIX_END + (size_t)32 * 256 * 11520;
constexpr size_t SC_MIX_END3 = SC_S5E + (size_t)2 * BATCH * 16 * 32 * 64 * 2 * 4;
template <int LEVEL>
__device__ __forceinline__ void s5_block_task(Frame& F, int layer, int task, LAS float* ul) {
    unsigned char* ws = F.ws; const bf16* Z = (const bf16*)(ws + SC_Z);
    const int blk = task & 15, dir = (task >> 4) & 1, g = (task >> 5) & 31, b = task >> 10; const int n = F.lane;
    const float* ab = (const float*)(ws + WS_S5P + layer * S5P_LAYER); const float* bb = ab + 2 * 32 * 64 * 2; const float* ab256 = bb + 2 * 32 * 64 * 16 * 2;
    const int pr = (dir * 32 + g) * 64 + n;
    const float abr = ab[pr * 2], abi = ab[pr * 2 + 1];
    float bbr[16], bbi[16];
#pragma unroll
    for (int c = 0; c < 16; ++c) { bbr[c] = bb[((size_t)pr * 16 + c) * 2]; bbi[c] = bb[((size_t)pr * 16 + c) * 2 + 1]; }
    float* E = (float*)(ws + SC_S5E);
    float xr = 0.f, xi = 0.f;
    if (LEVEL == 2) { const float pr_ = ab256[pr * 2], pi_ = ab256[pr * 2 + 1];
        for (int k = 0; k < blk; ++k) { const float* ep = E + ((((size_t)dir * BATCH + b) * 16 + k) * 32 + g) * 128 + n * 2; const float er = ep[0], ei = ep[1];
            const float nr = pr_ * xr - pi_ * xi + er, ni = pr_ * xi + pi_ * xr + ei; xr = nr; xi = ni; } }
    float* carry = (float*)(ws + SC_CARRY);
    for (int q4 = 0; q4 < 4; ++q4) {
        { const int st = blk * 256 + q4 * 64 + n; const int sl = dir ? (SEQ - 1 - st) : st; const bf16* zp = Z + (size_t)(b * SEQ + sl) * ZLD + ZD + g * 16;
          const u32x4 w0 = *(const u32x4*)zp, w1 = *(const u32x4*)(zp + 8);
          LAS f32x4* d = (LAS f32x4*)(ul + n * 16);
          d[0] = (f32x4){__uint_as_float(w0.x << 16), __uint_as_float(w0.x & 0xffff0000u), __uint_as_float(w0.y << 16), __uint_as_float(w0.y & 0xffff0000u)};
          d[1] = (f32x4){__uint_as_float(w0.z << 16), __uint_as_float(w0.z & 0xffff0000u), __uint_as_float(w0.w << 16), __uint_as_float(w0.w & 0xffff0000u)};
          d[2] = (f32x4){__uint_as_float(w1.x << 16), __uint_as_float(w1.x & 0xffff0000u), __uint_as_float(w1.y << 16), __uint_as_float(w1.y & 0xffff0000u)};
          d[3] = (f32x4){__uint_as_float(w1.z << 16), __uint_as_float(w1.z & 0xffff0000u), __uint_as_float(w1.w << 16), __uint_as_float(w1.w & 0xffff0000u)}; }
        LDS_WAIT(); asm volatile("" ::: "memory");
#pragma unroll 4
        for (int i = 0; i < 64; ++i) {
            const int step = blk * 256 + q4 * 64 + i;
            if (LEVEL == 2 && (step & (S5CH - 1)) == 0) { const int sl = dir ? (SEQ - 1 - step) : step; const int ch = sl / S5CH;
                float* cp = carry + ((((size_t)dir * BATCH + b) * S5NCH + ch) * 32 + g) * 128 + n * 2; cp[0] = xr; cp[1] = xi; }
            const f32x4 u0 = *(const LAS f32x4*)(ul + i * 16), u1 = *(const LAS f32x4*)(ul + i * 16 + 4), u2 = *(const LAS f32x4*)(ul + i * 16 + 8), u3 = *(const LAS f32x4*)(ul + i * 16 + 12);
            float br = 0.f, bi = 0.f;
#pragma unroll
            for (int c = 0; c < 4; ++c) { br += bbr[c] * u0[c] + bbr[4 + c] * u1[c] + bbr[8 + c] * u2[c] + bbr[12 + c] * u3[c]; bi += bbi[c] * u0[c] + bbi[4 + c] * u1[c] + bbi[8 + c] * u2[c] + bbi[12 + c] * u3[c]; }
            const float nr = abr * xr - abi * xi + br, ni = abr * xi + abi * xr + bi; xr = nr; xi = ni;
        }
        asm volatile("" ::: "memory");
    }
    if (LEVEL == 1) { float* ep = E + ((((size_t)dir * BATCH + b) * 16 + blk) * 32 + g) * 128 + n * 2; ep[0] = xr; ep[1] = xi; }
}

__device__ __forceinline__ void prep_phase(Frame& F, ArgsP a, int layer, const int rep) {
    const int qb_ = (rep * 2 + layer) * 8;
#ifndef DBG_PREPMASK
#define DBG_PREPMASK 7
#endif
    if (DBG_PREPMASK & 1) for (;;) { const int it = q_next(F, qb_ + 0); if (it >= 256) break; s5_block_task<1>(F, layer, it * 8 + F.wave, (LAS float*)(F.lds + F.wave * 4096)); }
    if (DBG_PREPMASK & 2) for (;;) { const int it = q_next(F, qb_ + 5); if (it >= NTOK / RWT) break; rwkv_prep_tile(F, a, layer, it); }
    if ((DBG_PREPMASK & 4) && rep == 0) for (;;) { const int r = q_next(F, qb_ + 6); if (r >= NTOK / 64) break;
        for (int k = 0; k < 8; ++k) { const int tok = r * 64 + F.wave * 8 + k; rope_token(F, (bf16*)(F.ws + SC_Z) + (size_t)tok * ZLD, tok % SEQ); } }
}

constexpr int CR_TA = 0, CR_GH = 2048, CR_WBK = 4096, CR_TM = 8192, CR_N = 8704, CR_V = 9216, CR_WL = 11264, CR_BYTES = 11520;
constexpr size_t SC_CREC = SC_MIX_END;
constexpr size_t SC_MIX_END2 = SC_CREC + (size_t)32 * 256 * CR_BYTES;
static_assert(SC_MIX_END2 <= 1140000000ull, "workspace budget");

__device__ __forceinline__ void mm16(const LAS float* A, const LAS float* B, int t, int sq, float (&out)[4]) {
    out[0] = out[1] = out[2] = out[3] = 0.f;
#pragma unroll
    for (int s4 = 0; s4 < 4; ++s4) { const f32x4 a4 = *(const LAS f32x4*)(A + t * 16 + s4 * 4);
#pragma unroll
        for (int q = 0; q < 4; ++q) { const f32x4 b4 = *(const LAS f32x4*)(B + (s4 * 4 + q) * 16 + sq * 4); const float av = a4[q];
            out[0] += av * b4[0]; out[1] += av * b4[1]; out[2] += av * b4[2]; out[3] += av * b4[3]; } }
}
__device__ __forceinline__ void st16(LAS float* M, int t, int sq, const float (&v)[4]) { *(LAS f32x4*)(M + t * 16 + sq * 4) = (f32x4){v[0], v[1], v[2], v[3]}; }

__device__ __forceinline__ void rwkv_cprep_item(Frame& F, int chain, int c, LAS float* Lw) {
    unsigned char* ws = F.ws; const float* RW = (const float*)(ws + SC_RW); const size_t N1 = (size_t)NTOK * 512;
    const int dir = chain & 1, h = (chain >> 1) & 7, b = chain >> 4; const int lane = F.lane;
    const float* Rp = RW; const float* Vp = RW + N1; const float* KKp = RW + 2 * N1; const float* LDp = RW + (3 + dir) * N1; const float* KMp = RW + (5 + dir) * N1; const float* BBp = RW + (7 + dir) * N1;
    constexpr int RS = 68;
    LAS float* At = Lw; LAS float* Bt = Lw + 16 * RS; LAS float* Kt = Lw + 32 * RS; LAS float* mat = Lw + 48 * RS;
    float at[16], rt[16], wb[16], wk[16];
    { float lw = 0.f, lwi[16], bb[16], km[16];
#pragma unroll
      for (int t = 0; t < 16; ++t) { const int pos = dir ? (SEQ - 1 - 16 * c - t) : (16 * c + t); const size_t idx = (size_t)(b * SEQ + pos) * 512 + h * 64 + lane;
          const float r_ = Rp[idx], ld = LDp[idx], a_ = -KKp[idx]; km[t] = KMp[idx]; bb[t] = BBp[idx];
          at[t] = a_ * __expf(lw); lw += ld; lwi[t] = lw; rt[t] = r_ * __expf(lw);
          const float iw = __expf(-lw); At[t * RS + lane] = at[t]; Bt[t * RS + lane] = bb[t] * iw; Kt[t * RS + lane] = km[t] * iw; }
#pragma unroll
      for (int t = 0; t < 16; ++t) { const float e = __expf(lw - lwi[t]); wb[t] = bb[t] * e; wk[t] = km[t] * e; }
      float* rec = (float*)(ws + SC_CREC + ((size_t)chain * 256 + c) * CR_BYTES + CR_WL); rec[lane] = __expf(lw); }
    LDS_WAIT(); asm volatile("" ::: "memory");
    const int t = lane >> 2, sq = lane & 3;
    float mab[4] = {0.f, 0.f, 0.f, 0.f}, mak[4] = {0.f, 0.f, 0.f, 0.f}, mrb[4] = {0.f, 0.f, 0.f, 0.f}, mrk[4] = {0.f, 0.f, 0.f, 0.f};
#pragma unroll 4
    for (int j = 0; j < 64; j += 4) { const f32x4 a4 = *(const LAS f32x4*)(At + t * RS + j);
#pragma unroll
        for (int e = 0; e < 4; ++e) { const f32x4 b4 = *(const LAS f32x4*)(Bt + (sq * 4 + e) * RS + j), k4 = *(const LAS f32x4*)(Kt + (sq * 4 + e) * RS + j);
            mab[e] += a4[0] * b4[0] + a4[1] * b4[1] + a4[2] * b4[2] + a4[3] * b4[3]; mak[e] += a4[0] * k4[0] + a4[1] * k4[1] + a4[2] * k4[2] + a4[3] * k4[3]; } }
    asm volatile("" ::: "memory");
#pragma unroll
    for (int tt = 0; tt < 16; ++tt) At[tt * RS + lane] = rt[tt];
    LDS_WAIT(); asm volatile("" ::: "memory");
#pragma unroll 4
    for (int j = 0; j < 64; j += 4) { const f32x4 a4 = *(const LAS f32x4*)(At + t * RS + j);
#pragma unroll
        for (int e = 0; e < 4; ++e) { const f32x4 b4 = *(const LAS f32x4*)(Bt + (sq * 4 + e) * RS + j), k4 = *(const LAS f32x4*)(Kt + (sq * 4 + e) * RS + j);
            mrb[e] += a4[0] * b4[0] + a4[1] * b4[1] + a4[2] * b4[2] + a4[3] * b4[3]; mrk[e] += a4[0] * k4[0] + a4[1] * k4[1] + a4[2] * k4[2] + a4[3] * k4[3]; } }
#pragma unroll
    for (int e = 0; e < 4; ++e) { const int s = sq * 4 + e; if (s >= t) { mab[e] = 0.f; mak[e] = 0.f; } if (s > t) { mrb[e] = 0.f; mrk[e] = 0.f; } }
    LAS float* m0 = mat; LAS float* m1 = mat + 256; LAS float* m2 = mat + 512; LAS float* m3 = mat + 768;
    float T[4], P[4], Q[4];
    st16(m0, t, sq, mab); LDS_WAIT(); asm volatile("" ::: "memory");
#pragma unroll
    for (int e = 0; e < 4; ++e) T[e] = mab[e] + ((sq * 4 + e) == t ? 1.f : 0.f);
    mm16(m0, m0, t, sq, P);
    st16(m1, t, sq, P); st16(m2, t, sq, T); LDS_WAIT(); asm volatile("" ::: "memory");
    mm16(m2, m1, t, sq, Q);
#pragma unroll
    for (int e = 0; e < 4; ++e) T[e] += Q[e];
    mm16(m1, m1, t, sq, P);
    asm volatile("" ::: "memory");
    st16(m0, t, sq, P); st16(m2, t, sq, T); LDS_WAIT(); asm volatile("" ::: "memory");
    mm16(m2, m0, t, sq, Q);
#pragma unroll
    for (int e = 0; e < 4; ++e) T[e] += Q[e];
    mm16(m0, m0, t, sq, P);
    asm volatile("" ::: "memory");
    st16(m1, t, sq, P); st16(m2, t, sq, T); LDS_WAIT(); asm volatile("" ::: "memory");
    mm16(m2, m1, t, sq, Q);
#pragma unroll
    for (int e = 0; e < 4; ++e) T[e] += Q[e];
    asm volatile("" ::: "memory");
    st16(m2, t, sq, T); st16(m0, t, sq, mrb); st16(m1, t, sq, mak); LDS_WAIT(); asm volatile("" ::: "memory");
    float P1[4], TM[4], Nn[4];
    mm16(m0, m2, t, sq, P1); mm16(m2, m1, t, sq, TM);
    st16(m3, t, sq, P1); LDS_WAIT(); asm volatile("" ::: "memory");
    mm16(m3, m1, t, sq, Nn);
#pragma unroll
    for (int e = 0; e < 4; ++e) Nn[e] += mrk[e];
    unsigned char* rec = ws + SC_CREC + ((size_t)chain * 256 + c) * CR_BYTES;
    { u32x2 w; w.x = pk2(TM[0], TM[1]); w.y = pk2(TM[2], TM[3]); *(u32x2*)(rec + CR_TM + (16 * sq + t) * 8) = w;
      w.x = pk2(Nn[0], Nn[1]); w.y = pk2(Nn[2], Nn[3]); *(u32x2*)(rec + CR_N + (16 * sq + t) * 8) = w; }
    LAS unsigned short* TAh = (LAS unsigned short*)Bt; LAS unsigned short* GHh = TAh + 1024;
#pragma unroll
    for (int tt = 0; tt < 16; ++tt) { float ta = 0.f, gh = rt[tt];
#pragma unroll
        for (int s4 = 0; s4 < 4; ++s4) { const f32x4 t4 = *(const LAS f32x4*)(m2 + tt * 16 + s4 * 4), p4 = *(const LAS f32x4*)(m3 + tt * 16 + s4 * 4);
            ta += t4[0] * at[s4 * 4] + t4[1] * at[s4 * 4 + 1] + t4[2] * at[s4 * 4 + 2] + t4[3] * at[s4 * 4 + 3];
            gh += p4[0] * at[s4 * 4] + p4[1] * at[s4 * 4 + 1] + p4[2] * at[s4 * 4 + 2] + p4[3] * at[s4 * 4 + 3]; }
        TAh[tt * 64 + lane] = f2bf(ta); GHh[tt * 64 + lane] = f2bf(gh); }
    LDS_WAIT(); asm volatile("" ::: "memory");
    { const int r = lane & 15, g = lane >> 4;
#pragma unroll
      for (int ks = 0; ks < 2; ++ks) { const u32x2 a0 = *(const LAS u32x2*)(TAh + r * 64 + 32 * ks + 4 * g), a1 = *(const LAS u32x2*)(TAh + r * 64 + 32 * ks + 16 + 4 * g);
          *(u32x4*)(rec + CR_TA + (ks * 64 + lane) * 16) = (u32x4){a0.x, a0.y, a1.x, a1.y};
          const u32x2 g0 = *(const LAS u32x2*)(GHh + r * 64 + 32 * ks + 4 * g), g1 = *(const LAS u32x2*)(GHh + r * 64 + 32 * ks + 16 + 4 * g);
          *(u32x4*)(rec + CR_GH + (ks * 64 + lane) * 16) = (u32x4){g0.x, g0.y, g1.x, g1.y}; } }
    { const int jb = lane >> 4, r = lane & 15; float vv[16];
#pragma unroll
      for (int tt = 0; tt < 16; ++tt) { const int pos = dir ? (SEQ - 1 - 16 * c - tt) : (16 * c + tt); vv[tt] = Vp[(size_t)(b * SEQ + pos) * 512 + h * 64 + lane]; }
#pragma unroll
      for (int g = 0; g < 4; ++g) { u32x4 w; w.x = pk2(wb[4 * g], wb[4 * g + 1]); w.y = pk2(wb[4 * g + 2], wb[4 * g + 3]); w.z = pk2(wk[4 * g], wk[4 * g + 1]); w.w = pk2(wk[4 * g + 2], wk[4 * g + 3]);
          *(u32x4*)(rec + CR_WBK + (jb * 64 + 16 * g + r) * 16) = w;
          u32x2 x; x.x = pk2(vv[4 * g], vv[4 * g + 1]); x.y = pk2(vv[4 * g + 2], vv[4 * g + 3]); *(u32x2*)(rec + CR_V + (jb * 64 + 16 * g + r) * 8) = x; } }
    LDS_WAIT(); asm volatile("" ::: "memory");
}

__device__ __forceinline__ void cprep_phase(Frame& F, int layer) {
    LAS float* Lw = (LAS float*)(F.lds + F.wave * 17408);
    for (int it = F.bid * 8 + F.wave; it < 32 * 256; it += F.G * 8) { const int c = it >> 5, chain = it & 31; rwkv_cprep_item(F, chain, c, Lw); }
    asm volatile("" ::: "memory");
    for (int it = F.bid * 8 + F.wave; it < 2048; it += F.G * 8) s5_block_task<2>(F, layer, it, Lw);
}

template <class P, class T> struct RwPtr { typedef const T* type; };
template <class T> struct RwPtr<const LAS unsigned char*, T> { typedef const LAS T* type; };
struct RwOps { bf16x8 ta[2], gh[2], wbk[4]; u32x2 tm, nn, vq[2]; f32x4 wl[4]; };
template <class P> __device__ __forceinline__ void rw_load(RwOps& o, P rec, int lane, int half) {
    const int g = lane >> 4;
#pragma unroll
    for (int ks = 0; ks < 2; ++ks) { o.ta[ks] = *(const typename RwPtr<P, bf16x8>::type)(rec + CR_TA + (ks * 64 + lane) * 16); o.gh[ks] = *(const typename RwPtr<P, bf16x8>::type)(rec + CR_GH + (ks * 64 + lane) * 16); }
#pragma unroll
    for (int jb = 0; jb < 4; ++jb) { o.wbk[jb] = *(const typename RwPtr<P, bf16x8>::type)(rec + CR_WBK + (jb * 64 + lane) * 16); o.wl[jb] = *(const typename RwPtr<P, f32x4>::type)(rec + CR_WL + (jb * 16 + g * 4) * 4); }
    o.tm = *(const typename RwPtr<P, u32x2>::type)(rec + CR_TM + lane * 8); o.nn = *(const typename RwPtr<P, u32x2>::type)(rec + CR_N + lane * 8);
#pragma unroll
    for (int it = 0; it < 2; ++it) o.vq[it] = *(const typename RwPtr<P, u32x2>::type)(rec + CR_V + ((half * 2 + it) * 64 + lane) * 8);
}
__device__ __forceinline__ bf16x8 mk8(unsigned a, unsigned b, unsigned c, unsigned d) { u32x4 w = {a, b, c, d}; return *reinterpret_cast<bf16x8*>(&w); }
__device__ __forceinline__ void rw_step(const RwOps& o, f32x4 (&X)[4][2], float* ysb, const long rs, int lane) {
    const int r = lane & 15, g = lane >> 4;
    const bf16x8 tmf = mk8(o.tm.x, o.tm.y, 0u, 0u), nf = mk8(o.nn.x, o.nn.y, 0u, 0u);
#pragma unroll
    for (int it = 0; it < 2; ++it) {
        bf16x8 xb[2];
#pragma unroll
        for (int ks = 0; ks < 2; ++ks) xb[ks] = mk8(pk2c(X[2 * ks][it][0], X[2 * ks][it][1]), pk2c(X[2 * ks][it][2], X[2 * ks][it][3]), pk2c(X[2 * ks + 1][it][0], X[2 * ks + 1][it][1]), pk2c(X[2 * ks + 1][it][2], X[2 * ks + 1][it][3]));
        const bf16x8 vb = mk8(o.vq[it].x, o.vq[it].y, 0u, 0u);
        f32x4 U = {0.f, 0.f, 0.f, 0.f}, Y = {0.f, 0.f, 0.f, 0.f};
        U = __builtin_amdgcn_mfma_f32_16x16x32_bf16(o.ta[0], xb[0], U, 0, 0, 0); Y = __builtin_amdgcn_mfma_f32_16x16x32_bf16(o.gh[0], xb[0], Y, 0, 0, 0);
        U = __builtin_amdgcn_mfma_f32_16x16x32_bf16(o.ta[1], xb[1], U, 0, 0, 0); Y = __builtin_amdgcn_mfma_f32_16x16x32_bf16(o.gh[1], xb[1], Y, 0, 0, 0);
        U = __builtin_amdgcn_mfma_f32_16x16x32_bf16(tmf, vb, U, 0, 0, 0);       Y = __builtin_amdgcn_mfma_f32_16x16x32_bf16(nf, vb, Y, 0, 0, 0);
        const bf16x8 uvb = mk8(pk2c(U[0], U[1]), pk2c(U[2], U[3]), o.vq[it].x, o.vq[it].y);
#pragma unroll
        for (int jb = 0; jb < 4; ++jb) X[jb][it] = __builtin_amdgcn_mfma_f32_16x16x32_bf16(o.wbk[jb], uvb, X[jb][it] * o.wl[jb], 0, 0, 0);
#pragma unroll
        for (int q = 0; q < 4; ++q) ysb[(long)(4 * g + q) * rs + 16 * it + r] = Y[q];
    }
}
__device__ __forceinline__ void rwkv_scan_chunked(Frame& F, int chain, int half) {
    unsigned char* ws = F.ws; asm volatile("" : "+s"(ws)); const int dir = chain & 1, h = (chain >> 1) & 7, b = chain >> 4; const int lane = F.lane;
    const unsigned char* rec0 = ws + SC_CREC + (size_t)chain * 256 * CR_BYTES;
#ifdef DBG_RWCHK
    float* YS = (float*)(ws + WS_HN) + (size_t)dir * NTOK * 512;
#else
    float* YS = (float*)(ws + SC_YS) + (size_t)dir * NTOK * 512;
#endif
    f32x4 X[4][2];
#pragma unroll
    for (int jb = 0; jb < 4; ++jb) { X[jb][0] = (f32x4){0.f, 0.f, 0.f, 0.f}; X[jb][1] = (f32x4){0.f, 0.f, 0.f, 0.f}; }
    RwOps oa, ob;
    rw_load(oa, rec0, lane, half);
    const long rs = dir ? -512 : 512;
    for (int c = 0; c < 256; c += 2) {
        rw_load(ob, rec0 + (size_t)(c + 1) * CR_BYTES, lane, half);
        { const int pos0 = dir ? (SEQ - 1 - 16 * c) : 16 * c; rw_step(oa, X, YS + (size_t)(b * SEQ + pos0) * 512 + h * 64 + half * 32, rs, lane); }
        if (c + 2 < 256) rw_load(oa, rec0 + (size_t)(c + 2) * CR_BYTES, lane, half);
        { const int pos0 = dir ? (SEQ - 1 - 16 * (c + 1)) : 16 * (c + 1); rw_step(ob, X, YS + (size_t)(b * SEQ + pos0) * 512 + h * 64 + half * 32, rs, lane); }
    }
}

__device__ __forceinline__ void rwkv_scan_ring(Frame& F, int pair) {
    unsigned char* ws = F.ws; asm volatile("" : "+s"(ws));
    const int w = F.wave, lane = F.lane;
    LAS unsigned char* ring = F.lds;
    __syncthreads();
    if (w < 4) {
        const int chain = pair * 2 + (w >> 1), half = w & 1; const int dir = chain & 1, h = (chain >> 1) & 7, b = chain >> 4;
        float* YS = (float*)(ws + SC_YS) + (size_t)dir * NTOK * 512;
        f32x4 X[4][2];
#pragma unroll
        for (int jb = 0; jb < 4; ++jb) { X[jb][0] = (f32x4){0.f, 0.f, 0.f, 0.f}; X[jb][1] = (f32x4){0.f, 0.f, 0.f, 0.f}; }
        const long rs = dir ? -512 : 512;
        __syncthreads();
#pragma unroll 1
        for (int c = 0; c < 256; ++c) {
            RwOps o; rw_load(o, (const LAS unsigned char*)(ring + ((w >> 1) * 2 + (c & 1)) * CR_BYTES), lane, half);
            const int pos0 = dir ? (SEQ - 1 - 16 * c) : 16 * c; rw_step(o, X, YS + (size_t)(b * SEQ + pos0) * 512 + h * 64 + half * 32, rs, lane);
            __syncthreads();
        }
    } else {
        const int k = (w - 4) >> 1, part = (w - 4) & 1; const int chain = pair * 2 + k;
        const unsigned char* rec0 = ws + SC_CREC + (size_t)chain * 256 * CR_BYTES;
        LAS unsigned char* dst0 = ring + (k * 2) * CR_BYTES;
        const int i0 = (part * 64 + lane) * 16;
        u32x4 R0[6], R1[6], R2[6], R3[6], R4[6], R5[6];
#define RW_LD(R, cc) do { const unsigned char* p_ = rec0 + (size_t)(cc) * CR_BYTES + i0; _Pragma("unroll") for (int j = 0; j < 6; ++j) if (j < 5 || i0 + 2048 * 5 < CR_BYTES) R[j] = *(const u32x4*)(p_ + 2048 * j); } while (0)
#define RW_ST(R, cc) do { LAS unsigned char* d_ = dst0 + ((cc) & 1) * CR_BYTES + i0; _Pragma("unroll") for (int j = 0; j < 6; ++j) if (j < 5 || i0 + 2048 * 5 < CR_BYTES) *(LAS u32x4*)(d_ + 2048 * j) = R[j]; } while (0)
#define RW_STEP(R, cc) do { RW_ST(R, cc); if ((cc) + 6 < 256) RW_LD(R, (cc) + 6); __syncthreads(); } while (0)
        RW_LD(R0, 0); RW_LD(R1, 1); RW_LD(R2, 2); RW_LD(R3, 3); RW_LD(R4, 4); RW_LD(R5, 5);
        RW_ST(R0, 0); RW_LD(R0, 6);
        __syncthreads();
#pragma unroll 1
        for (int c = 1; c < 253; c += 6) { RW_STEP(R1, c); RW_STEP(R2, c + 1); RW_STEP(R3, c + 2); RW_STEP(R4, c + 3); RW_STEP(R5, c + 4); RW_STEP(R0, c + 5); }
        RW_STEP(R1, 253); RW_STEP(R2, 254); RW_STEP(R3, 255);
        __syncthreads();
#undef RW_STEP
#undef RW_LD
#undef RW_ST
    }
}

__device__ __forceinline__ void rwkv_scan_naive(Frame& F, int chain) {
    unsigned char* ws = F.ws; const float* RW = (const float*)(ws + SC_RW); const size_t N1 = (size_t)NTOK * 512;
    const int dir = chain & 1, h = (chain >> 1) & 7, b = chain >> 4;
    const float* Rp = RW; const float* Vp = RW + N1; const float* KKp = RW + 2 * N1; const float* Wp = RW + (3 + dir) * N1; const float* KMp = RW + (5 + dir) * N1; const float* BBp = RW + (7 + dir) * N1;
    float* YS = (float*)(ws + SC_YS) + (size_t)dir * N1;
    LAS float* L = (LAS float*)(F.lds + F.wave * 2048);
    float st[64];
#pragma unroll
    for (int j = 0; j < 64; ++j) st[j] = 0.f;
    size_t idx = (size_t)(b * SEQ + (dir ? SEQ - 1 : 0)) * 512 + h * 64 + F.lane;
    float va = -KKp[idx], vw = __expf(Wp[idx]), vb = BBp[idx], vk = KMp[idx], vr = Rp[idx], vv = Vp[idx];
    for (int t = 0; t < SEQ; ++t) {
        L[F.lane] = va; L[64 + F.lane] = vw; L[128 + F.lane] = vb; L[192 + F.lane] = vk; L[256 + F.lane] = vr;
        const float v = vv; const size_t oidx = idx;
        if (t + 1 < SEQ) { idx = dir ? idx - 512 : idx + 512; va = -KKp[idx]; vw = __expf(Wp[idx]); vb = BBp[idx]; vk = KMp[idx]; vr = Rp[idx]; vv = Vp[idx]; }
        LDS_WAIT(); asm volatile("" ::: "memory");
        float sa0 = 0.f, sa1 = 0.f, sa2 = 0.f, sa3 = 0.f;
#pragma unroll
        for (int j = 0; j < 64; j += 4) { const f32x4 x = *(const LAS f32x4*)(L + j); sa0 += st[j] * x[0]; sa1 += st[j + 1] * x[1]; sa2 += st[j + 2] * x[2]; sa3 += st[j + 3] * x[3]; }
        const float sa = (sa0 + sa1) + (sa2 + sa3);
        float y0 = 0.f, y1 = 0.f, y2 = 0.f, y3 = 0.f;
#pragma unroll
        for (int j = 0; j < 64; j += 4) { const f32x4 w4 = *(const LAS f32x4*)(L + 64 + j), b4 = *(const LAS f32x4*)(L + 128 + j), k4 = *(const LAS f32x4*)(L + 192 + j), r4 = *(const LAS f32x4*)(L + 256 + j);
            st[j] = st[j] * w4[0] + (sa * b4[0] + v * k4[0]); st[j + 1] = st[j + 1] * w4[1] + (sa * b4[1] + v * k4[1]); st[j + 2] = st[j + 2] * w4[2] + (sa * b4[2] + v * k4[2]); st[j + 3] = st[j + 3] * w4[3] + (sa * b4[3] + v * k4[3]);
            y0 += st[j] * r4[0]; y1 += st[j + 1] * r4[1]; y2 += st[j + 2] * r4[2]; y3 += st[j + 3] * r4[3]; }
        YS[oidx] = (y0 + y1) + (y2 + y3);
        asm volatile("" ::: "memory");
    }
}

__device__ __forceinline__ void s5_unit(Frame& F, ArgsP a, int layer, int unit) {
    unsigned char* ws = F.ws; asm volatile("" : "+s"(ws)); const bf16* Z = (const bf16*)(ws + SC_Z);
    const int b = unit / S5NCH, ch = unit % S5NCH; const int tok0 = b * SEQ + ch * S5CH;
    LAS float* ybuf = (LAS float*)F.lds;
    LAS unsigned short* gla = (LAS unsigned short*)(F.lds + 32768);
    LAS unsigned short* xa = (LAS unsigned short*)(F.lds + 49408 + F.wave * 4352);
    LAS float* ulw = (LAS float*)(F.lds + RING_BYTES + F.wave * 1024);
    const float* ab = (const float*)(ws + WS_S5P + layer * S5P_LAYER); const float* bb = ab + 2 * 32 * 64 * 2;
    const float* carry = (const float*)(ws + SC_CARRY);
    const int n = F.lane, r = n & 15, g4 = n >> 4;
    __syncthreads();
    for (int gi = 0; gi < 4; ++gi) {
        const int g = gi * 8 + F.wave;
        { const int tl = (n >> 1) & 15, hf = n & 1; const u32x4 w0 = *(const u32x4*)(Z + (size_t)(tok0 + tl) * ZLD + ZD + g * 16 + hf * 8);
          if (n < 32) { LAS f32x4* d = (LAS f32x4*)(ulw + tl * 16 + hf * 8);
            d[0] = (f32x4){__uint_as_float(w0.x << 16), __uint_as_float(w0.x & 0xffff0000u), __uint_as_float(w0.y << 16), __uint_as_float(w0.y & 0xffff0000u)};
            d[1] = (f32x4){__uint_as_float(w0.z << 16), __uint_as_float(w0.z & 0xffff0000u), __uint_as_float(w0.w << 16), __uint_as_float(w0.w & 0xffff0000u)}; } }
        float abr2[2], abi2[2], cr2[2], ci2[2];
#pragma unroll
        for (int dir = 0; dir < 2; ++dir) { const int pr = (dir * 32 + g) * 64 + n; abr2[dir] = ab[pr * 2]; abi2[dir] = ab[pr * 2 + 1];
            const float* cp = carry + ((((size_t)dir * BATCH + b) * S5NCH + ch) * 32 + g) * 128 + n * 2; cr2[dir] = cp[0]; ci2[dir] = cp[1]; }
        bf16x8 cwf[4];
        { const bf16* cw = (const bf16*)(ws + WS_S5CW) + ((size_t)(layer * 32 + g) * 16 + r) * 128 + g4 * 8;
#pragma unroll
          for (int ks = 0; ks < 4; ++ks) cwf[ks] = *(const bf16x8*)(cw + ks * 32); }
        LDS_WAIT(); asm volatile("" ::: "memory");
        float xfr[16], xfi[16];
#pragma unroll
        for (int dir = 0; dir < 2; ++dir) {
            const int pr = (dir * 32 + g) * 64 + n; const float abr = abr2[dir], abi = abi2[dir];
            float bbr[16], bbi[16];
            { const f32x4* bp = (const f32x4*)(bb + (size_t)pr * 32);
#pragma unroll
              for (int c4 = 0; c4 < 8; ++c4) { const f32x4 q = bp[c4]; bbr[c4 * 2] = q[0]; bbi[c4 * 2] = q[1]; bbr[c4 * 2 + 1] = q[2]; bbi[c4 * 2 + 1] = q[3]; } }
            float xr = cr2[dir], xi = ci2[dir];
#pragma unroll
            for (int i = 0; i < S5CH; ++i) { const int tl = dir ? (S5CH - 1 - i) : i;
                const f32x4 u0 = *(const LAS f32x4*)(ulw + tl * 16), u1 = *(const LAS f32x4*)(ulw + tl * 16 + 4), u2 = *(const LAS f32x4*)(ulw + tl * 16 + 8), u3 = *(const LAS f32x4*)(ulw + tl * 16 + 12);
                float br = 0.f, bi = 0.f;
#pragma unroll
                for (int c = 0; c < 4; ++c) { br += bbr[c] * u0[c] + bbr[4 + c] * u1[c] + bbr[8 + c] * u2[c] + bbr[12 + c] * u3[c]; bi += bbi[c] * u0[c] + bbi[4 + c] * u1[c] + bbi[8 + c] * u2[c] + bbi[12 + c] * u3[c]; }
                const float nr = abr * xr - abi * xi + br, ni = abr * xi + abi * xr + bi; xr = nr; xi = ni;
                if (dir == 0) { xfr[tl] = xr; xfi[tl] = xi; }
                else { xa[tl * 136 + n] = f2bf(xfr[tl] + xr); xa[tl * 136 + 64 + n] = f2bf(xfi[tl] + xi); }
                if ((i & 3) == 3) asm volatile("" ::: "memory"); }
        }
        LDS_WAIT(); asm volatile("" ::: "memory");
        { f32x4 y = {0.f, 0.f, 0.f, 0.f};
#pragma unroll
          for (int ks = 0; ks < 4; ++ks) { const bf16x8 af = *(const LAS bf16x8*)(xa + r * 136 + ks * 32 + g4 * 8); y = __builtin_amdgcn_mfma_f32_16x16x32_bf16(af, cwf[ks], y, 0, 0, 0); }
          const float dsk = a->in[I_S5_D][(size_t)layer * 512 + g * 16 + r];
#pragma unroll
          for (int q = 0; q < 4; ++q) { const int tl = 4 * g4 + q; const float yy = y[q] + dsk * ulw[tl * 16 + r];
              const float x3 = yy * yy * yy; const float gl = 0.5f * yy * (1.f + tanhf(0.7978845608028654f * (yy + 0.044715f * x3)));
              ybuf[tl * 512 + g * 16 + r] = gl; gla[tl * 520 + g * 16 + r] = f2bf(gl); } }
        LDS_WAIT(); asm volatile("" ::: "memory");
    }
    __syncthreads();
    { f32x4 acc[4];
#pragma unroll
      for (int j = 0; j < 4; ++j) acc[j] = (f32x4){0.f, 0.f, 0.f, 0.f};
      const bf16* wt = (const bf16*)(ws + WS_GLUT) + (size_t)layer * 512 * 512 + (size_t)(F.wave * 64 + r) * 512 + g4 * 8;
#pragma unroll 1
      for (int k0 = 0; k0 < 16; k0 += 4) { bf16x8 bf_[4][4];
#pragma unroll
          for (int kk = 0; kk < 4; ++kk)
#pragma unroll
              for (int j = 0; j < 4; ++j) bf_[kk][j] = *(const bf16x8*)(wt + (size_t)j * 16 * 512 + (k0 + kk) * 32);
#pragma unroll
          for (int kk = 0; kk < 4; ++kk) { const bf16x8 af = *(const LAS bf16x8*)(gla + r * 520 + (k0 + kk) * 32 + g4 * 8);
#pragma unroll
              for (int j = 0; j < 4; ++j) acc[j] = __builtin_amdgcn_mfma_f32_16x16x32_bf16(af, bf_[kk][j], acc[j], 0, 0, 0); } }
#pragma unroll
      for (int j = 0; j < 4; ++j) { const int c = F.wave * 64 + j * 16 + r; const float bias = a->in[I_S5_GLU_B][(size_t)layer * 512 + c];
#pragma unroll
          for (int q = 0; q < 4; ++q) { const int tl = 4 * g4 + q; const float gl = ybuf[tl * 512 + c]; ybuf[tl * 512 + c] = gl * sigmoidf_(acc[j][q] + bias); } } }
    __syncthreads();
    { const float* gn = a->in[I_MIX_OUT_NORM] + ((size_t)layer * 2 + 1) * 512; bf16* MIX = (bf16*)(ws + WS_MIX);
#pragma unroll
      for (int q = 0; q < 2; ++q) { const int tl = F.wave * 2 + q; float v[8]; float s = 0.f;
#pragma unroll
          for (int j = 0; j < 8; ++j) { v[j] = ybuf[tl * 512 + j * 64 + F.lane]; s += v[j] * v[j]; }
          const float rstd = 1.f / sqrtf(wave_sum(s) * (1.f / 512.f) + RMS_EPS);
#pragma unroll
          for (int j = 0; j < 8; ++j) MIX[(size_t)(tok0 + tl) * DM + 1536 + j * 64 + F.lane] = f2bf(v[j] * rstd * gn[j * 64 + F.lane]); } }
}

template <int mask>
__device__ __forceinline__ void mix_phase(Frame& F, ArgsP a, int layer, const int rep) {
    const int qb_ = (rep * 2 + layer) * 8;
    constexpr int NB = 16, NA = BATCH * 4 * (SEQ / 128), NC = BATCH * 4 * 48, ND = BATCH * S5NCH;
    if (mask & 1) for (;;) { const int it = q_next(F, qb_ + 1); if (it >= NB) break; rwkv_scan_ring(F, it); }
    if (mask & 2) for (;;) { const int it = q_next(F, qb_ + 2); if (it >= NA) break;
        unsigned char* ws = F.ws; asm volatile("" : "+s"(ws)); const bf16* Z = (const bf16*)(ws + SC_Z);
        const int qb = it % (SEQ / 128), h = (it / (SEQ / 128)) % 4, b = it / (4 * (SEQ / 128));
        const bf16* zb = Z + (size_t)(b * SEQ) * ZLD + ZA;
        float lam, lam_init;
        { const float* lv = a->in[I_DIFF_LAMBDA] + (size_t)layer * 4 * 64; float d1 = 0.f, d2 = 0.f;
          for (int i = 0; i < 64; ++i) { d1 += lv[i] * lv[64 + i]; d2 += lv[128 + i] * lv[192 + i]; }
          lam_init = 0.8f - 0.6f * expf(-0.3f * (float)layer); lam = expf(d1) - expf(d2) + lam_init; }
        att::diff_attn_unit(zb + (size_t)(qb * 128) * ZLD + h * 128, zb + 512 + h * 128, zb + 1024 + h * 128, ZLD, SEQ,
                            (bf16*)(ws + WS_MIX) + (size_t)(b * SEQ + qb * 128) * DM + h * 128, DM, lam, 1.f - lam_init, a->in[I_DIFF_SUBLN] + (size_t)layer * 128, (char*)F.lds, F.wave); }
#ifdef DBG_RWCHK
    for (;;) { const int it = q_next(F, layer * 8 + 5); if (it >= 4) break; rwkv_scan_naive(F, it * 8 + F.wave); }
#endif
    if (mask & 8) for (;;) { const int it = q_next(F, qb_ + 4); if (it >= ND) break; s5_unit(F, a, layer, it); }
    if (mask & 4) for (;;) { const int it = q_next(F, qb_ + 3); if (it >= NC) break;
        unsigned char* ws = F.ws; asm volatile("" : "+s"(ws)); const bf16* Z = (const bf16*)(ws + SC_Z);
        const int r = it % 48, h = (it / 48) % 4, b = it / (48 * 4); const int p = r / 16, rr = r % 16;
        const int dil = p == 0 ? 1 : (p == 1 ? 4 : 16); const int L = SEQ / dil; const int nqb = L / 256; const int rho = rr / nqb, qb = rr % nqb;
        const bf16* zb = Z + (size_t)(b * SEQ) * ZLD + ZC;
        att::dil_attn_unit(zb + h * 128, zb + 512 + h * 128, zb + 1024 + h * 128, ZLD, dil, rho, qb * 256, L,
                           (float*)(ws + SC_OC) + ((size_t)p * NTOK + (size_t)b * SEQ) * 512 + h * 128, (float*)(ws + SC_LSE) + ((size_t)p * NTOK + (size_t)b * SEQ) * 4 + h, (char*)F.lds, F.wave); }
}

__device__ __forceinline__ void post_phase(Frame& F, ArgsP a, int layer) {
    unsigned char* ws = F.ws; bf16* MIX = (bf16*)(ws + WS_MIX);
    const int gw = F.bid * 8 + F.wave, NGW = F.G * 8;
    const float* RW = (const float*)(ws + SC_RW); const size_t N1 = (size_t)NTOK * 512; const float* YS = (const float*)(ws + SC_YS);
#ifdef DBG_RWCHK
    { const float* Y2 = (const float*)(ws + WS_HN); float e = 0.f, r2 = 0.f; int bad = 0;
      for (size_t i = (size_t)F.bid * 512 + F.tid; i < (size_t)2 * NTOK * 512; i += (size_t)F.G * 512) { const float a0 = ((const float*)(ws + SC_YS))[i], b0 = Y2[i]; const float d = fabsf(a0 - b0); if (!(d < 1e30f)) bad = 1; else e = fmaxf(e, d); r2 = fmaxf(r2, fabsf(a0)); }
      e = wave_max(e); r2 = wave_max(r2); bad = __any(bad) ? 1 : 0;
      if (F.lane == 0) { atomicMax(F.ctl + 32768 + layer * 64, __float_as_uint(e)); atomicMax(F.ctl + 32768 + layer * 64 + 1, __float_as_uint(r2)); if (bad) atomicMax(F.ctl + 32768 + layer * 64 + 2, 1u); } }
#endif
    for (int tok = gw; tok < NTOK; tok += NGW) {
        float y[8], r_[8], v_[8], kb[8], gg[8];
#pragma unroll
        for (int h = 0; h < 8; ++h) { const size_t o = (size_t)tok * 512 + h * 64 + F.lane; y[h] = YS[o] + YS[N1 + o]; r_[h] = RW[o]; v_[h] = RW[N1 + o]; kb[h] = 0.5f * (RW[5 * N1 + o] + RW[6 * N1 + o]); gg[h] = RW[9 * N1 + o]; }
#pragma unroll
        for (int h = 0; h < 8; ++h) { const int c = h * 64 + F.lane;
            const float mean = wave_sum(y[h]) * (1.f / 64.f); const float d = y[h] - mean; const float var = wave_sum(d * d) * (1.f / 64.f);
            const float yn = d * (1.f / sqrtf(var + 64e-5f)) * a->in[I_RWKV_LNX_W][(size_t)layer * 512 + c] + a->in[I_RWKV_LNX_B][(size_t)layer * 512 + c];
            const float bon = wave_sum(r_[h] * kb[h] * a->in[I_RWKV_RK][(size_t)layer * 512 + c]) * v_[h];
            MIX[(size_t)tok * DM + 512 + c] = f2bf((yn + bon) * gg[h]); } }
    const float* OC = (const float*)(ws + SC_OC); const float* LSE = (const float*)(ws + SC_LSE); const float* gn = a->in[I_MIX_OUT_NORM] + ((size_t)layer * 2 + 0) * 512;
    for (int tok = gw; tok < NTOK; tok += NGW) { const int h = F.lane >> 4;
        const float l0 = LSE[((size_t)0 * NTOK + tok) * 4 + h], l1 = LSE[((size_t)1 * NTOK + tok) * 4 + h], l2 = LSE[((size_t)2 * NTOK + tok) * 4 + h];
        const float m = fmaxf(l0, fmaxf(l1, l2)); float w0 = __expf(l0 - m), w1 = __expf(l1 - m), w2 = __expf(l2 - m); const float inv = 1.f / (w0 + w1 + w2); w0 *= inv; w1 *= inv; w2 *= inv;
        float v[8]; float s = 0.f;
        const f32x4* p0 = (const f32x4*)(OC + ((size_t)0 * NTOK + tok) * 512) + F.lane * 2; const f32x4* p1 = (const f32x4*)(OC + ((size_t)1 * NTOK + tok) * 512) + F.lane * 2; const f32x4* p2 = (const f32x4*)(OC + ((size_t)2 * NTOK + tok) * 512) + F.lane * 2;
#pragma unroll
        for (int j = 0; j < 2; ++j) { const f32x4 a0 = p0[j], a1 = p1[j], a2 = p2[j];
#pragma unroll
            for (int e = 0; e < 4; ++e) { const float x = w0 * a0[e] + w1 * a1[e] + w2 * a2[e]; v[j * 4 + e] = x; s += x * x; } }
        const float rstd = 1.f / sqrtf(wave_sum(s) * (1.f / 512.f) + RMS_EPS);
        const f32x4 g0 = *((const f32x4*)gn + F.lane * 2), g1 = *((const f32x4*)gn + F.lane * 2 + 1);
        u32x4 w; w.x = pk2(v[0] * rstd * g0[0], v[1] * rstd * g0[1]); w.y = pk2(v[2] * rstd * g0[2], v[3] * rstd * g0[3]); w.z = pk2(v[4] * rstd * g1[0], v[5] * rstd * g1[1]); w.w = pk2(v[6] * rstd * g1[2], v[7] * rstd * g1[3]);
        *(u32x4*)(MIX + (size_t)tok * DM + 1024 + F.lane * 8) = w; }
}

#ifndef MK_FUSED
#define MK_FUSED 1
#endif
__global__ void __launch_bounds__(512, 2) enc_fwd(Args args_) {
    extern __shared__ __attribute__((aligned(16))) unsigned char lds_raw[];
    Frame F;
    F.lds = (LAS unsigned char*)lds_raw; F.MISC = (volatile LAS unsigned*)(F.lds + MISC_OFF);
    F.tid = threadIdx.x; F.lane = F.tid & 63; F.wave = __builtin_amdgcn_readfirstlane(F.tid >> 6); F.G = gridDim.x; F.bid = blockIdx.x;
    const int wave0 = F.wave;
    ArgsP ap = (ArgsP)__builtin_amdgcn_kernarg_segment_ptr();
    unsigned char* ws = ap->ws; F.ws = ws; F.ctl = (unsigned*)(ws + WS_CTL);
    for (int u = F.tid; u < (LDS_BYTES - MISC_OFF) / 4; u += 512) ((LAS unsigned*)(F.lds + MISC_OFF))[u] = 0u;
    __syncthreads();
    const int lo = ap->ph_lo, hi = ap->ph_hi;
    if (hi - lo > 1) (void)xcd_barrier_post(F.ctl + CW_BAR, F.MISC + 8);
#ifdef DBG_ONLY
#define IN(k) (((k) < PH_L0 ? (k) : ((k) == PH_FINAL ? 100 : 3 + ((k) - PH_L0) % NPH_L)) == DBG_ONLY && lo <= (k) && (k) < hi)
#else
#define IN(k) ({ int lo_ = lo, hi_ = hi; asm volatile("" : "+s"(lo_), "+s"(hi_)); lo_ <= (k) && (k) < hi_; })
#endif
#define args (*ap)
#define REFRESH() do { int wv_ = wave0, bi_ = blockIdx.x, gg_ = gridDim.x; asm volatile("" : "+s"(wv_), "+s"(bi_), "+s"(gg_)); const int t_ = tid_from_wave(wv_); F.tid = t_; F.lane = t_ & 63; F.wave = wv_; F.bid = bi_; F.G = gg_; ap = (ArgsP)__builtin_amdgcn_kernarg_segment_ptr(); asm volatile("" : "+s"(ap)); unsigned char* w_ = ap->ws; F.ws = w_; ws = w_; F.ctl = (unsigned*)(w_ + WS_CTL); } while (0)
#ifndef DBG_MIXMASK
#define DBG_MIXMASK 15
#endif
#ifndef DBG_REP_CODE
#define DBG_REP_CODE -1
#define DBG_REP_N 0
#endif
#define REPS(code) (((code) == DBG_REP_CODE && l_ == 0) ? 1 + DBG_REP_N : 1)
#ifdef DBG_TIME_A
#define STAMP(k) do { if (blockIdx.x == 0 && threadIdx.x == 0) { const unsigned long long t_ = wall_clock64(); F.MISC[192 + 2 * (k)] = (unsigned)t_; F.MISC[193 + 2 * (k)] = (unsigned)(t_ >> 32); } } while (0)
#else
#define STAMP(k) do {} while (0)
#endif
#define SEAM(k) do { if (IN(k) && IN((k) + 1)) { XcdBarrier b_; b_.bar = (unsigned*)(ap->ws + WS_CTL) + CW_BAR; b_.x = xb_xcc_id(); b_.st = F.MISC + 8; xcd_barrier(b_); } } while (0)

    { const int l_ = 0; STAMP(PH_P0); if (IN(PH_P0)) { REFRESH(); for (int rep = 0; rep < REPS(0); ++rep) p0_prologue(F, ap); } } SEAM(PH_P0);
    if (DBG_REP_CODE == 30 && hi - lo > 1) { for (int i = 0; i < 20; ++i) { XcdBarrier b_; b_.bar = (unsigned*)(ap->ws + WS_CTL) + CW_BAR; b_.x = xb_xcc_id(); b_.st = F.MISC + 8; xcd_barrier(b_); } }
    STAMP(PH_P1); if (IN(PH_P1)) { REFRESH();
        SchedBatch S{(const char*)(ws + SC_MEMN), (const char*)(ws + SC_WKVT), (char*)(ws + SC_KVB), (size_t)512 * DM * 2, (size_t)4096 * DM * 2, (size_t)512 * 4096 * 2, 2, 16, DEPTH, F.G, F.bid, DM, DM, 4096 * 2, 2, 512};
        { const int l_ = 0; for (int rep = 0; rep < REPS(1); ++rep) pg8::gemm_phase<pg8::EpiBf16, SchedBatch, false>(F.lds, pg8::GemmP{DM, DM, DM}, S, pg8::EpiBf16{4096}, F.wave); }
    } SEAM(PH_P1);
    STAMP(PH_P2); if (IN(PH_P2)) { REFRESH();
        { SchedXaPre S{ws, F.G, F.bid, 0}; pg8::gemm_phase<EpiBf16U, SchedXaPre, false>(F.lds, pg8::GemmP{512, 4096, DM}, S, EpiBf16U{}, F.wave); }
        { SchedXaPre S{ws, F.G, F.bid, 1}; pg8::gemm_phase<EpiBf16U, SchedXaPre, false>(F.lds, pg8::GemmP{512, DM, 4096}, S, EpiBf16U{}, F.wave); }
    } SEAM(PH_P2);

    for (int l = 0; l < DEPTH; ++l) {
        const int pb = PH_L0 + l * NPH_L; const int l_ = l;
        float* H = (float*)(ws + WS_H);
        STAMP(pb + LP_NORM1); if (IN(pb + LP_NORM1)) { REFRESH(); if (l == 0) { for (int rep = 0; rep < REPS(22); ++rep) norm_phase<0>(F, ap, args.in[I_X], args.in[I_NORM_MIX], l); } else norm_phase<1>(F, ap, H, args.in[I_NORM_MIX] + (size_t)l * DM, l); } SEAM(pb + LP_NORM1);
        STAMP(pb + LP_G1); if (IN(pb + LP_G1)) { REFRESH();
            SchedDense S{(const char*)(ws + WS_HN), (const char*)(ws + WS_WIN) + (size_t)l * ZLD * DM * 2, (char*)(ws + SC_Z), NTOK / 256, ZLD / 256, F.G, F.bid, DM, DM, ZLD * 2, 2};
            for (int rep = 0; rep < REPS(10); ++rep) pg8::gemm_phase<pg8::EpiBf16, SchedDense, false>(F.lds, pg8::GemmP{DM, DM, DM}, S, pg8::EpiBf16{ZLD}, F.wave);
        } SEAM(pb + LP_G1);
        STAMP(pb + LP_PREP); if (IN(pb + LP_PREP)) { REFRESH(); for (int rep = 0; rep < REPS(11); ++rep) prep_phase(F, ap, l, rep); } SEAM(pb + LP_PREP);
        STAMP(pb + LP_CPREP); if (IN(pb + LP_CPREP)) { REFRESH(); for (int rep = 0; rep < REPS(12); ++rep) cprep_phase(F, l); } SEAM(pb + LP_CPREP);
        STAMP(pb + LP_MIX); if (IN(pb + LP_MIX)) { REFRESH(); mix_phase<DBG_MIXMASK>(F, ap, l, 0); if (DBG_REP_CODE >= 13 && DBG_REP_CODE <= 16 && l_ == 0) { REFRESH(); mix_phase<(DBG_REP_CODE >= 13 && DBG_REP_CODE <= 16) ? (1 << (DBG_REP_CODE - 13)) : 1>(F, ap, l, 1); if (DBG_REP_N > 1) { REFRESH(); mix_phase<(DBG_REP_CODE >= 13 && DBG_REP_CODE <= 16) ? (1 << (DBG_REP_CODE - 13)) : 1>(F, ap, l, 2); } } } SEAM(pb + LP_MIX);
        STAMP(pb + LP_POST); if (IN(pb + LP_POST)) { REFRESH(); for (int rep = 0; rep < REPS(17); ++rep) post_phase(F, ap, l); } SEAM(pb + LP_POST);
        STAMP(pb + LP_G2); if (IN(pb + LP_G2)) { REFRESH();
            SchedDense S{(const char*)(ws + WS_MIX), (const char*)(ws + WS_WOUT) + (size_t)l * DM * DM * 2, (char*)H, NTOK / 256, DM / 256, F.G, F.bid, DM, DM, DM * 4, 4};
            for (int rep = 0; rep < REPS(23); ++rep) pg8::gemm_phase<pg8::EpiF32Res, SchedDense, false>(F.lds, pg8::GemmP{DM, DM, DM}, S, pg8::EpiF32Res{DM, l == 0 ? args.in[I_X] : (const float*)H, H}, F.wave);
        } SEAM(pb + LP_G2);
        STAMP(pb + LP_NORM2); if (IN(pb + LP_NORM2)) { REFRESH(); for (int rep = 0; rep < REPS(18); ++rep) norm_phase<0>(F, ap, H, args.in[I_NORM_CROSS] + (size_t)l * DM, l); } SEAM(pb + LP_NORM2);
        STAMP(pb + LP_GS); if (IN(pb + LP_GS)) { REFRESH();
            SchedBatch S{(const char*)(ws + WS_HN), (const char*)(ws + WS_WQK) + (size_t)l * 2 * 1024 * DM * 2, (char*)(ws + WS_P), (size_t)SEQ * DM * 2, (size_t)1024 * DM * 2, (size_t)SEQ * 1024 * 2, SEQ / 256, 4, BATCH, F.G, F.bid, DM, DM, 1024 * 2, 2, SEQ};
            for (int rep = 0; rep < REPS(19); ++rep) pg8::gemm_phase<pg8::EpiSoftmax, SchedBatch, false>(F.lds, pg8::GemmP{DM, DM, DM}, S, pg8::EpiSoftmax{1024, 0.044194173824159216f * 1.4426950408889634f}, F.wave);
        } SEAM(pb + LP_GS);
        STAMP(pb + LP_GO); if (IN(pb + LP_GO)) { REFRESH();
            SchedBatch S{(const char*)(ws + WS_P), (const char*)(ws + WS_VWO) + (size_t)l * 2 * DM * 1024 * 2, (char*)H, (size_t)SEQ * 1024 * 2, (size_t)DM * 1024 * 2, (size_t)SEQ * DM * 4, SEQ / 256, DM / 256, BATCH, F.G, F.bid, 1024, 1024, DM * 4, 4, SEQ};
            pg8::gemm_phase<pg8::EpiF32Res, SchedBatch, false>(F.lds, pg8::GemmP{1024, 1024, 1024}, S, pg8::EpiF32Res{DM, (const float*)H, H}, F.wave);
        } SEAM(pb + LP_GO);
        STAMP(pb + LP_NORM3); if (IN(pb + LP_NORM3)) { REFRESH(); norm_phase<2>(F, ap, H, args.in[I_NORM_MOE] + (size_t)l * DM, l); } SEAM(pb + LP_NORM3);
        STAMP(pb + LP_M1); if (IN(pb + LP_M1)) { REFRESH();
            volatile LAS int* tp = (volatile LAS int*)(F.lds + MISC_OFF + 256); volatile LAS int* cnt = tp + 40;
            moe_prefix(F, l, tp, cnt);
            SchedMoe S{ws, tp, cnt, l, F.G, F.bid, 0};
            for (int rep = 0; rep < REPS(20); ++rep) pg8::gemm_phase<pg8::EpiSwiGlu, SchedMoe, true>(F.lds, pg8::GemmP{DM, DM, DM}, S, pg8::EpiSwiGlu{DEXP}, F.wave);
        } SEAM(pb + LP_M1);
        STAMP(pb + LP_M2); if (IN(pb + LP_M2)) { REFRESH();
            volatile LAS int* tp = (volatile LAS int*)(F.lds + MISC_OFF + 256); volatile LAS int* cnt = tp + 40;
            moe_prefix(F, l, tp, cnt);
            SchedMoe S{ws, tp, cnt, l, F.G, F.bid, 1};
            for (int rep = 0; rep < REPS(21); ++rep) pg8::gemm_phase<pg8::EpiGate, SchedMoe, false>(F.lds, pg8::GemmP{DEXP, DEXP, DEXP}, S, pg8::EpiGate{DM, (const float*)(ws + WS_EGATE), nullptr}, F.wave);
        } SEAM(pb + LP_M2);
    }
#ifdef DBG_TIME_A
    STAMP(PH_FINAL);
    if (blockIdx.x == 0 && threadIdx.x == 0) { const unsigned long long ta = ((unsigned long long)F.MISC[193 + 2 * (DBG_TIME_A)] << 32) | F.MISC[192 + 2 * (DBG_TIME_A)], tb = ((unsigned long long)F.MISC[193 + 2 * (DBG_TIME_B)] << 32) | F.MISC[192 + 2 * (DBG_TIME_B)];
        const unsigned long long dl = (tb - ta) * DBG_TIME_K; const unsigned long long t0_ = wall_clock64(); while (wall_clock64() - t0_ < dl) __builtin_amdgcn_s_sleep(8); }
    if (hi - lo > 1) { XcdBarrier b_; b_.bar = (unsigned*)(ap->ws + WS_CTL) + CW_BAR; b_.x = xb_xcc_id(); b_.st = F.MISC + 8; xcd_barrier(b_); }
#endif
    STAMP(PH_FINAL); if (IN(PH_FINAL)) { REFRESH(); norm_phase<5>(F, ap, (const float*)(ws + WS_H), args.in[I_NORM_FINAL], DEPTH); }
#undef IN
#undef SEAM
#undef args
}

extern "C" void kernel_launch(void* const* d_in, const int* in_sizes, int n_in, void* d_out, int out_size, void* d_ws, size_t ws_size, hipStream_t stream) {
    static int grid = 0;
    if (grid == 0) {
        if (n_in != N_INPUTS || out_size != NTOK * DM || ws_size < cmax(WS_END, SC_MIX_END3)) { fprintf(stderr, "kernel_launch: built for %d inputs, out %d, ws >= %zu; got %d, %d, %zu\n", N_INPUTS, NTOK * DM, cmax(WS_END, SC_MIX_END3), n_in, out_size, ws_size); grid = -1; return; }
        int dev = 0, cus = 0, per_cu = 0;
        if (hipGetDevice(&dev) != hipSuccess || hipDeviceGetAttribute(&cus, hipDeviceAttributeMultiprocessorCount, dev) != hipSuccess) { fprintf(stderr, "kernel_launch: device query failed\n"); grid = -1; return; }
        if (hipFuncSetAttribute((const void*)enc_fwd, hipFuncAttributeMaxDynamicSharedMemorySize, LDS_BYTES) != hipSuccess) { fprintf(stderr, "kernel_launch: hipFuncSetAttribute failed\n"); grid = -1; return; }
        if (hipOccupancyMaxActiveBlocksPerMultiprocessor(&per_cu, (const void*)enc_fwd, 512, LDS_BYTES) != hipSuccess || per_cu < 1) fprintf(stderr, "kernel_launch: occupancy query says %d blocks per CU\n", per_cu);
        grid = cus;
    }
    if (grid < 0) return;
    hipMemsetAsync((char*)d_ws + WS_CTL, 0, CTL_BYTES, stream);
    Args a; memset(&a, 0, sizeof(a));
    for (int i = 0; i < N_INPUTS; ++i) a.in[i] = (const float*)d_in[i];
    a.out = (float*)d_out; a.ws = (unsigned char*)d_ws;
#if MK_FUSED
    a.ph_lo = 0; a.ph_hi = NPHASES;
    hipLaunchKernelGGL(enc_fwd, dim3(grid), dim3(512), LDS_BYTES, stream, a);
#else
    for (int p = 0; p < NPHASES; ++p) { a.ph_lo = p; a.ph_hi = p + 1; hipLaunchKernelGGL(enc_fwd, dim3(grid), dim3(512), LDS_BYTES, stream, a); }
#endif
    const hipError_t le = hipPeekAtLastError();
    if (le != hipSuccess) fprintf(stderr, "kernel_launch: launch failed: %s\n", hipGetErrorName(le));
}
```

```cpp
#include <hip/hip_runtime.h>
#include <cstdio>
#include <cstdint>
#include <cstring>

#define GAS __attribute__((address_space(1)))
#define LAS __attribute__((address_space(3)))
typedef unsigned short bf16;
typedef short bf16x8 __attribute__((ext_vector_type(8)));
typedef short s16x4 __attribute__((ext_vector_type(4)));
typedef float f32x2 __attribute__((ext_vector_type(2)));
typedef float f32x4 __attribute__((ext_vector_type(4)));
typedef float f32x16 __attribute__((ext_vector_type(16)));
typedef unsigned u32x2 __attribute__((ext_vector_type(2)));
typedef unsigned u32x4 __attribute__((ext_vector_type(4)));
typedef GAS unsigned gu32;

constexpr int DM = 2048, BATCH = 2, SEQ = 4096, NTOK = BATCH * SEQ, DEPTH = 2, NMEM = 256;
constexpr int IN_A = 1536, IN_B = 1920, IN_C = 1536, IN_D = 512, IN_TOTAL = 5504, ZLD = 5632;
constexpr int ZA = 0, ZB = 1536, ZC = 3456, ZD = 4992;
constexpr int NEXP = 32, DEXP = 512, ECAP = 8192;
constexpr int SLOT_CAP = 24576;
constexpr int S5CH = 16, S5NCH = SEQ / S5CH;
constexpr float RMS_EPS = 1e-6f;

enum { I_X = 0, I_MEM, I_NORM_MIX, I_W_IN, I_W_OUT, I_DIFF_LAMBDA, I_DIFF_SUBLN, I_RWKV_MU, I_RWKV_W0, I_RWKV_W2, I_RWKV_A0, I_RWKV_A2, I_RWKV_G2,
       I_RWKV_KK, I_RWKV_KA, I_RWKV_RK, I_RWKV_LNX_W, I_RWKV_LNX_B, I_S5_A_RE, I_S5_A_IM, I_S5_LOG_DT, I_S5_B_RE, I_S5_B_IM, I_S5_C_RE, I_S5_C_IM,
       I_S5_D, I_S5_GLU_W, I_S5_GLU_B, I_MIX_OUT_NORM, I_NORM_CROSS, I_NORM_MEM, I_XA_WQ, I_XA_WKV, I_XA_WO, I_NORM_MOE, I_ROUTER_GROUP,
       I_ROUTER_EXPERT, I_MOE_W1, I_MOE_W3, I_MOE_W2, I_NORM_FINAL, N_INPUTS };

constexpr size_t al256(size_t x) { return (x + 255) / 256 * 256; }
constexpr size_t WS_CTL = 0, CTL_BYTES = 1u << 20;
constexpr size_t WS_WIN  = WS_CTL + CTL_BYTES;
constexpr size_t WS_WOUT = WS_WIN + (size_t)DEPTH * ZLD * DM * 2;
constexpr size_t WS_WQK  = WS_WOUT + (size_t)DEPTH * DM * DM * 2;
constexpr size_t WS_VWO  = WS_WQK + (size_t)DEPTH * BATCH * 1024 * DM * 2;
constexpr size_t WS_W13  = WS_VWO + (size_t)DEPTH * BATCH * DM * 1024 * 2;
constexpr size_t WS_W2   = WS_W13 + (size_t)DEPTH * NEXP * 1024 * DM * 2;
constexpr size_t WS_ROPE = WS_W2 + (size_t)DEPTH * NEXP * DM * DEXP * 2;
constexpr size_t WS_S5P  = WS_ROPE + (size_t)SEQ * (32 + 32 + 64 + 64) * 4;
constexpr size_t S5P_LAYER = (size_t)(2 * 32 * 64 * 2 + 2 * 32 * 64 * 16 * 2 + 2 * 32 * 64 * 2) * 4;
constexpr size_t WS_LORA = al256(WS_S5P + DEPTH * S5P_LAYER);
constexpr size_t LORA_LAYER = (size_t)(2 * 512 * 64 * 2 + 512 * 128) * 2;
constexpr size_t WS_GLUT = al256(WS_LORA + DEPTH * LORA_LAYER);
constexpr size_t WS_S5CW = WS_GLUT + (size_t)DEPTH * 512 * 512 * 2;
constexpr size_t WS_RTE  = al256(WS_S5CW + (size_t)DEPTH * 32 * 16 * 128 * 2);
constexpr size_t WS_H    = al256(WS_RTE + (size_t)DEPTH * 4 * DM * 8 * 4);
constexpr size_t WS_HN   = WS_H + (size_t)NTOK * DM * 4;
constexpr size_t WS_MIX  = WS_HN + (size_t)NTOK * DM * 2;
constexpr size_t WS_P    = WS_MIX + (size_t)NTOK * DM * 2;
constexpr size_t WS_ETOK = WS_P + (size_t)NTOK * 1024 * 2;
constexpr size_t WS_EGATE= WS_ETOK + (size_t)NEXP * ECAP * 4;
constexpr size_t WS_TINFO= WS_EGATE + (size_t)NEXP * ECAP * 4;
constexpr size_t WS_SCR  = al256(WS_TINFO + (size_t)NTOK * 16);
constexpr size_t SC_Z    = WS_SCR;
constexpr size_t SC_RW   = SC_Z + (size_t)NTOK * ZLD * 2;
constexpr size_t RWSZ    = (size_t)NTOK * 512 * 4;
constexpr size_t SC_YS   = SC_RW + 10 * RWSZ;
constexpr size_t SC_OC   = SC_YS + 2 * RWSZ;
constexpr size_t SC_WKVT = SC_YS;
constexpr size_t SC_MEMN = SC_WKVT + (size_t)DEPTH * 4096 * DM * 2;
constexpr size_t SC_KVB  = SC_MEMN + (size_t)DEPTH * 512 * DM * 2;
constexpr size_t SC_WQB  = SC_KVB + (size_t)DEPTH * 512 * 4096 * 2;
constexpr size_t SC_WOT  = SC_WQB + (size_t)DEPTH * DM * DM * 2;
constexpr size_t SC_PRO_END = SC_WOT + (size_t)DEPTH * DM * DM * 2;
static_assert(SC_PRO_END <= SC_OC + 3 * RWSZ, "prologue buffers must fit in YS|OC");
constexpr size_t SC_LSE  = SC_OC + 3 * RWSZ;
constexpr size_t SC_CARRY= SC_LSE + (size_t)3 * NTOK * 4 * 4;
constexpr size_t SC_MIX_END = SC_CARRY + (size_t)2 * BATCH * S5NCH * 32 * 64 * 2 * 4;
constexpr size_t SC_HMID = WS_SCR;
constexpr size_t SC_YBUF = SC_HMID + (size_t)SLOT_CAP * DEXP * 2;
constexpr size_t SC_MOE_END = SC_YBUF + (size_t)SLOT_CAP * DM * 2;
constexpr size_t cmax(size_t a, size_t b) { return a > b ? a : b; }
constexpr size_t WS_END = cmax(cmax(SC_PRO_END, SC_MIX_END), SC_MOE_END);

constexpr int CW_BAR = 4096;
constexpr int CW_Q = 8192;
constexpr int CW_CNT = 16384;

constexpr int RING_BYTES = 131072;
constexpr int MISC_OFF = 147456 - 1024;
constexpr int LDS_BYTES = 147456;

__device__ __forceinline__ float bf2f(unsigned short b) { return __uint_as_float(((unsigned)b) << 16); }
typedef __bf16 bf16x2_t __attribute__((ext_vector_type(2)));
__device__ __forceinline__ unsigned pk2c(float lo, float hi) { bf16x2_t v = {(__bf16)lo, (__bf16)hi}; return __builtin_bit_cast(unsigned, v); }
__device__ __forceinline__ unsigned pk2(float lo, float hi) { unsigned r; asm volatile("v_cvt_pk_bf16_f32 %0, %1, %2" : "=v"(r) : "v"(lo), "v"(hi)); return r; }
__device__ __forceinline__ bf16 f2bf(float f) { return (bf16)(pk2(f, 0.f) & 0xffffu); }
template <int CTRL> __device__ __forceinline__ float dpp_mov(float v) { return __builtin_bit_cast(float, __builtin_amdgcn_update_dpp(0, __builtin_bit_cast(int, v), CTRL, 0xf, 0xf, true)); }
__device__ __forceinline__ float row_sum(float v) { v += dpp_mov<0xB1>(v); v += dpp_mov<0x4E>(v); v += dpp_mov<0x141>(v); v += dpp_mov<0x140>(v); return v; }
__device__ __forceinline__ float row_max(float v) { v = fmaxf(v, dpp_mov<0xB1>(v)); v = fmaxf(v, dpp_mov<0x4E>(v)); v = fmaxf(v, dpp_mov<0x141>(v)); v = fmaxf(v, dpp_mov<0x140>(v)); return v; }
__device__ __forceinline__ float rdlane(float v, int l) { return __builtin_bit_cast(float, __builtin_amdgcn_readlane(__builtin_bit_cast(int, v), l)); }
__device__ __forceinline__ float wave_sum(float v) { v = row_sum(v); return (rdlane(v, 0) + rdlane(v, 16)) + (rdlane(v, 32) + rdlane(v, 48)); }
__device__ __forceinline__ float wave_max(float v) { v = row_max(v); return fmaxf(fmaxf(rdlane(v, 0), rdlane(v, 16)), fmaxf(rdlane(v, 32), rdlane(v, 48))); }
__device__ __forceinline__ float sigmoidf_(float x) { return 1.f / (1.f + __expf(-x)); }
#define LDS_WAIT() asm volatile("s_waitcnt lgkmcnt(0)" ::: "memory")
#define VM_WAIT() asm volatile("s_waitcnt vmcnt(0)" ::: "memory")

__device__ __forceinline__ int tid_from_wave(int wave) { int ln; asm volatile("v_mbcnt_lo_u32_b32 %0, -1, 0\n\tv_mbcnt_hi_u32_b32 %0, -1, %0" : "=v"(ln)); return wave * 64 + ln; }

typedef __attribute__((address_space(8))) void* bufrsrc_t;
__device__ __forceinline__ __amdgpu_buffer_rsrc_t make_rsrc(const void* p, unsigned bytes) { return __builtin_amdgcn_make_buffer_rsrc((void*)p, 0, bytes, 0x00020000); }
__device__ __forceinline__ float bload_f32(__amdgpu_buffer_rsrc_t r, int voff, int soff) { return __builtin_bit_cast(float, __builtin_amdgcn_raw_buffer_load_b32(r, voff, soff, 0)); }

__device__ __forceinline__ float xor_lane(float v, int lane, int m) { return __builtin_bit_cast(float, __builtin_amdgcn_ds_bpermute((lane ^ m) << 2, __builtin_bit_cast(int, v))); }
#define XB_TMO      128
#define XB_XCNT(j)  (256  + 64 * (j))
#define XB_XSUB(j)  (1280 + 64 * (j))
#define XB_XGEN(j)  (2304 + 64 * (j))
#define XB_TOP      3328
#define XB_TOPGEN   3392
#define XCD_BAR_WORDS 3456
#define XB_SPIN_CAP (1u << 18)

__device__ __forceinline__ unsigned xb_ld(unsigned* p)              { return __hip_atomic_load(p, __ATOMIC_RELAXED, __HIP_MEMORY_SCOPE_AGENT); }
__device__ __forceinline__ unsigned xb_add(unsigned* p, unsigned v) { return __hip_atomic_fetch_add(p, v, __ATOMIC_RELAXED, __HIP_MEMORY_SCOPE_AGENT); }
__device__ __forceinline__ unsigned xb_xcc_id() { return (unsigned)__builtin_amdgcn_s_getreg((3 << 11) | 20) & 0xFu; }
#define XB_SPIN(cond, bar) do { unsigned _sp = 0; while (cond) { __builtin_amdgcn_s_sleep(1); \
    if ((++_sp & 255u) == 0u) { if (xb_ld(&(bar)[XB_TMO])) break; if (_sp > XB_SPIN_CAP) { atomicAdd(&(bar)[XB_TMO], 1u); break; } } } } while (0)

struct XcdBarrier {
    unsigned* bar; unsigned x;
    volatile LAS unsigned* st;
};

__device__ __forceinline__ XcdBarrier xcd_barrier_post(unsigned* bar, volatile LAS unsigned* st) {
    XcdBarrier b; b.bar = bar; b.x = xb_xcc_id(); b.st = st;
    if (threadIdx.x == 0) (void)xb_add(&bar[XB_XCNT(b.x)], 1u);
    return b;
}
__device__ __forceinline__ void xcd_barrier_complete(unsigned* bar, unsigned x, unsigned& nloc, unsigned& nx) {
    const unsigned G = gridDim.x * gridDim.y * gridDim.z;
    unsigned sum, cnt, mine, sp = 0u;
    for (;;) {
        sum = 0u; cnt = 0u; mine = 0u;
#pragma unroll
        for (unsigned j = 0; j < 16; ++j) { const unsigned c = xb_ld(&bar[XB_XCNT(j)]); sum += c; cnt += (c > 0u) ? 1u : 0u; mine = (j == x) ? c : mine; }
        if (sum == G) break;
        __builtin_amdgcn_s_sleep(1);
        if ((++sp & 255u) == 0u) { if (xb_ld(&bar[XB_TMO])) break; if (sp > XB_SPIN_CAP) { atomicAdd(&bar[XB_TMO], 1u); break; } }
    }
    nloc = mine > 0u ? mine : 1u; nx = cnt > 0u ? cnt : 1u;
}

__device__ __forceinline__ void xcd_barrier(const XcdBarrier& b) {
    asm volatile("s_waitcnt vmcnt(0)" ::: "memory");
    __syncthreads();
    if (threadIdx.x == 0) {
        unsigned* bar = b.bar;
        __builtin_amdgcn_s_waitcnt(0);
        unsigned nloc = b.st[0], nx = b.st[1];
        if (nloc == 0u) { xcd_barrier_complete(bar, b.x, nloc, nx); b.st[0] = nloc; b.st[1] = nx; }
        const unsigned old = xb_add(&bar[XB_XSUB(b.x)], 1u);
        const unsigned gen = old / nloc;
        if (old + 1u == (gen + 1u) * nloc) {
            __builtin_amdgcn_fence(__ATOMIC_RELEASE, "agent");
            asm volatile("s_waitcnt vmcnt(0)" ::: "memory");
            const unsigned og = xb_add(&bar[XB_TOP], 1u);
            const unsigned tg = og / nx;
            if (og + 1u == (tg + 1u) * nx) xb_add(&bar[XB_TOPGEN], 1u);
            else XB_SPIN(xb_ld(&bar[XB_TOPGEN]) == tg, bar);
            __builtin_amdgcn_fence(__ATOMIC_ACQUIRE, "agent");
            xb_add(&bar[XB_XGEN(b.x)], 1u);
            asm volatile("s_waitcnt vmcnt(0)" ::: "memory");
        } else {
            XB_SPIN(xb_ld(&bar[XB_XGEN(b.x)]) == gen, bar);
            __builtin_amdgcn_fence(__ATOMIC_ACQUIRE, "agent");
            asm volatile("s_waitcnt vmcnt(0)" ::: "memory");
        }
    }
    __syncthreads();
}


namespace pg8 {
constexpr int BM = 256, BK = 64, HALF = 128, HTB = HALF * BK * 2, STAGE_BYTES = 8 * HTB, NXCD = 8, WGM = 8;
__host__ __device__ __forceinline__ int lds_byte(int r, int c) { const int st = (r >> 4) * 2 + (c >> 5), rr = r & 15, cc = c & 31, ob = rr * 64 + cc * 2; return st * 1024 + (ob ^ (((ob >> 9) & 1) << 5)); }
__host__ __device__ __forceinline__ void stage_rc(int b, int& R, int& C) { const int st = b / 1024, sb = b % 1024, swz = sb ^ (((sb >> 9) & 1) << 5); R = (st >> 1) * 16 + swz / 64; C = (st & 1) * 32 + (swz % 64) / 2; }
__host__ __device__ __forceinline__ int perm32(int rho) { const int n = rho >> 4, i = rho & 15; return 8 * (i >> 2) + 4 * n + (i & 3); }

struct Unit { const char* A; const char* B; char* C; int row0, col0, aux; };
struct GemmP { int K, lda, ldb; };

__device__ __forceinline__ void xcd_tile(int L, int nM, int nN, int& pm, int& pn) {
    const int nwg = nM * nN; int wgid = L;
    { const int q = nwg / NXCD, r = nwg % NXCD, xcd = wgid % NXCD, off = wgid / NXCD; wgid = (xcd < r ? xcd * (q + 1) : r * (q + 1) + (xcd - r) * q) + off; }
    const int nig = WGM * nN, gid = wgid / nig, fm = gid * WGM, gsz = (nM - fm) < WGM ? (nM - fm) : WGM;
    pm = fm + ((wgid % nig) % gsz); pn = (wgid % nig) / gsz;
}

typedef f32x4 Acc[2][2][4][2];

template <class Epi, class Sched, bool GATHER>
__device__ __forceinline__ void gemm_phase(LAS unsigned char* lds, const GemmP g, const Sched& S, const Epi& E, const int wave_id) {
    const int tid = tid_from_wave(wave_id), wid = __builtin_amdgcn_readfirstlane(tid >> 6), lane = tid & 63, wr = wid >> 2, wc = wid & 3, fr = lane & 15, fq = lane >> 4;
    const int K = g.K, nt = K / BK;
    int Rr[2], Cc[2]; unsigned voffB[2];
#pragma unroll
    for (int i = 0; i < 2; ++i) { int R, C; stage_rc(tid * 16 + i * 8192, R, C); const int Rb = Epi::PERM ? ((R & ~31) + perm32(R & 31)) : R;
        Rr[i] = R; Cc[i] = C; voffB[i] = (unsigned)(Rb * g.ldb + C) * 2u; }
    const size_t kstep = (size_t)(BK * 2);
    const size_t hstepB = (size_t)HALF * g.ldb * 2;
    const unsigned ldsw = (unsigned)wid * 1024u;
    const int aoff = lds_byte(wr * 64 + fr, fq * 8), boff = lds_byte(wc * 32 + fr, fq * 8);
#define PG8_SA(b, h) (((b) * 2 + (h)) * HTB)
#define PG8_SB(b, h) ((4 + (b) * 2 + (h)) * HTB)
#define PG8_STAGE_B(bufoff, gbase) do { _Pragma("unroll") for (int _i = 0; _i < 2; ++_i) \
        __builtin_amdgcn_global_load_lds((const unsigned*)((const char*)(gbase) + voffB[_i]), (LAS unsigned*)(lds + (bufoff) + ldsw + _i * 8192), 16, 0, 0); } while (0)
#define PG8_STAGE_A(bufoff, gbase, OFF, h) do { _Pragma("unroll") for (int _i = 0; _i < 2; ++_i) \
        __builtin_amdgcn_global_load_lds((const unsigned*)((const char*)(gbase) + (OFF)[h][_i]), (LAS unsigned*)(lds + (bufoff) + ldsw + _i * 8192), 16, 0, 0); } while (0)
#define PG8_OFFS(u, OFF) do { _Pragma("unroll") for (int _h = 0; _h < 2; ++_h) _Pragma("unroll") for (int _i = 0; _i < 2; ++_i) { \
        const int _row = _h * HALF + Rr[_i]; const int _src = GATHER ? S.arow((u), _row) : _row; (OFF)[_h][_i] = (unsigned)(_src * g.lda + Cc[_i]) * 2u; } } while (0)
#define PG8_LDA(dst, b, h) do { _Pragma("unroll") for (int m = 0; m < 4; ++m) _Pragma("unroll") for (int k = 0; k < 2; ++k) dst[m][k] = *(const LAS bf16x8*)(lds + PG8_SA(b, h) + aoff + m * 2048 + k * 1024); } while (0)
#define PG8_LDB(dst, b, h) do { _Pragma("unroll") for (int n = 0; n < 2; ++n) _Pragma("unroll") for (int k = 0; k < 2; ++k) dst[n][k] = *(const LAS bf16x8*)(lds + PG8_SB(b, h) + boff + n * 2048 + k * 1024); } while (0)
#define PG8_MMA(ai, bj, At, Bt) do { __builtin_amdgcn_s_setprio(1); _Pragma("unroll") for (int m = 0; m < 4; ++m) _Pragma("unroll") for (int n = 0; n < 2; ++n) _Pragma("unroll") for (int k = 0; k < 2; ++k) \
        acc[ai][bj][m][n] = __builtin_amdgcn_mfma_f32_16x16x32_bf16(Bt[n][k], At[m][k], acc[ai][bj][m][n], 0, 0, 0); __builtin_amdgcn_s_setprio(0); } while (0)
#define PG8_WAIT_V(n) asm volatile("s_waitcnt vmcnt(" #n ")" ::: "memory")
#define PG8_WAIT_L(n) asm volatile("s_waitcnt lgkmcnt(" #n ")" ::: "memory")
#define PG8_BAR __builtin_amdgcn_s_barrier()
#define PG8_SCHED __builtin_amdgcn_sched_barrier(0)
    Unit cur, nxt; int ui = 0;
    if (!S.next(0, cur)) return;
    f32x4 acc[2][2][4][2];
#pragma unroll
    for (int a = 0; a < 2; ++a)
#pragma unroll
        for (int b = 0; b < 2; ++b)
#pragma unroll
            for (int m = 0; m < 4; ++m)
#pragma unroll
                for (int n = 0; n < 2; ++n) acc[a][b][m][n] = (f32x4){0.f, 0.f, 0.f, 0.f};
    bf16x8 At[4][2], B0[2][2], B1[2][2];
    const char* cA = cur.A; const char* cB = cur.B;
    unsigned coffA[2][2], noffA[2][2];
    PG8_OFFS(cur, coffA);
    PG8_STAGE_B(PG8_SB(0, 0), cB); PG8_STAGE_A(PG8_SA(0, 0), cA, coffA, 0); PG8_STAGE_B(PG8_SB(0, 1), cB + hstepB); PG8_STAGE_A(PG8_SA(0, 1), cA, coffA, 1);
    if (wr == 1) PG8_BAR;
    PG8_WAIT_V(4); PG8_BAR;
    PG8_STAGE_B(PG8_SB(1, 0), cB + kstep); PG8_STAGE_A(PG8_SA(1, 0), cA + kstep, coffA, 0); PG8_STAGE_B(PG8_SB(1, 1), cB + hstepB + kstep);
    PG8_WAIT_V(6); PG8_BAR;
    for (;;) {
        const bool has_next = S.next(ui + 1, nxt);
        const char* nA = has_next ? nxt.A : cA; const char* nB = has_next ? nxt.B : cB;
        if (has_next) { PG8_OFFS(nxt, noffA); }
        else {
#pragma unroll
            for (int _h = 0; _h < 2; ++_h)
#pragma unroll
                for (int _i = 0; _i < 2; ++_i) noffA[_h][_i] = coffA[_h][_i]; }
        for (int t = 0; t < nt; t += 2) {
            const bool last = (t == nt - 2);
            const char* a1 = cA + (size_t)(t + 1) * kstep;
            const char* a2 = last ? nA : cA + (size_t)(t + 2) * kstep; const char* b2 = last ? nB : cB + (size_t)(t + 2) * kstep;
            const char* a3 = a2 + kstep; const char* b3 = b2 + kstep;
            unsigned o2[2][2];
#pragma unroll
            for (int _h = 0; _h < 2; ++_h)
#pragma unroll
                for (int _i = 0; _i < 2; ++_i) o2[_h][_i] = last ? noffA[_h][_i] : coffA[_h][_i];
            PG8_LDB(B0, 0, 0); PG8_SCHED; PG8_LDA(At, 0, 0); PG8_STAGE_A(PG8_SA(1, 1), a1, coffA, 1);
            PG8_WAIT_L(8); PG8_BAR; PG8_WAIT_L(0); PG8_MMA(0, 0, At, B0); PG8_BAR; PG8_SCHED;
            PG8_LDB(B1, 0, 1); PG8_STAGE_B(PG8_SB(0, 0), b2);
            PG8_BAR; PG8_WAIT_L(0); PG8_MMA(0, 1, At, B1); PG8_BAR;
            PG8_LDA(At, 0, 1); PG8_STAGE_A(PG8_SA(0, 0), a2, o2, 0);
            PG8_BAR; PG8_WAIT_L(0); PG8_MMA(1, 0, At, B0); PG8_BAR; PG8_SCHED;
            PG8_STAGE_B(PG8_SB(0, 1), b2 + hstepB);
            PG8_WAIT_V(6); PG8_BAR; PG8_MMA(1, 1, At, B1); PG8_BAR;
            PG8_LDB(B0, 1, 0); PG8_SCHED; PG8_LDA(At, 1, 0); PG8_STAGE_A(PG8_SA(0, 1), a2, o2, 1);
            PG8_WAIT_L(8); PG8_BAR; PG8_WAIT_L(0); PG8_MMA(0, 0, At, B0); PG8_BAR; PG8_SCHED;
            PG8_LDB(B1, 1, 1); PG8_STAGE_B(PG8_SB(1, 0), b3);
            PG8_BAR; PG8_WAIT_L(0); PG8_MMA(0, 1, At, B1); PG8_BAR;
            PG8_LDA(At, 1, 1); PG8_STAGE_A(PG8_SA(1, 0), a3, o2, 0);
            PG8_BAR; PG8_WAIT_L(0); PG8_MMA(1, 0, At, B0); PG8_BAR; PG8_SCHED;
            PG8_STAGE_B(PG8_SB(1, 1), b3 + hstepB);
            PG8_WAIT_V(6); PG8_BAR; PG8_MMA(1, 1, At, B1); PG8_BAR;
        }
        if constexpr (!Epi::AFTER_DRAIN) { E(acc, cur, wr, wc, fr, fq); }
        if (!has_next) break;
#pragma unroll
        for (int a = 0; a < 2; ++a)
#pragma unroll
            for (int b = 0; b < 2; ++b)
#pragma unroll
                for (int m = 0; m < 4; ++m)
#pragma unroll
                    for (int n = 0; n < 2; ++n) acc[a][b][m][n] = (f32x4){0.f, 0.f, 0.f, 0.f};
        cur = nxt; cA = nA; cB = nB; ++ui;
#pragma unroll
        for (int _h = 0; _h < 2; ++_h)
#pragma unroll
            for (int _i = 0; _i < 2; ++_i) coffA[_h][_i] = noffA[_h][_i];
    }
    PG8_WAIT_V(0);
    if (wr == 0) PG8_BAR;
    PG8_BAR;
    if constexpr (Epi::AFTER_DRAIN) { E.fused(acc, cur, wr, wc, fr, fq, lds, wid, lane); }
#undef PG8_SA
#undef PG8_SB
#undef PG8_STAGE_A
#undef PG8_STAGE_B
#undef PG8_OFFS
#undef PG8_LDA
#undef PG8_LDB
#undef PG8_MMA
#undef PG8_WAIT_V
#undef PG8_WAIT_L
#undef PG8_BAR
#undef PG8_SCHED
}

struct EpiBf16 {
    static constexpr bool PERM = true, AFTER_DRAIN = false;
    int ldc;
    __device__ __forceinline__ void operator()(const Acc& acc, const Unit& u, int wr, int wc, int fr, int fq) const {
        bf16* base = (bf16*)u.C + (size_t)(wr * 64 + fr) * ldc + wc * 32 + 8 * fq;
#pragma unroll
        for (int ai = 0; ai < 2; ++ai)
#pragma unroll
            for (int m = 0; m < 4; ++m) { bf16* rowp = base + (size_t)(ai * HALF + m * 16) * ldc;
#pragma unroll
                for (int bj = 0; bj < 2; ++bj) { const f32x4 v0 = acc[ai][bj][m][0], v1 = acc[ai][bj][m][1];
                    u32x4 w; w.x = pk2(v0[0], v0[1]); w.y = pk2(v0[2], v0[3]); w.z = pk2(v1[0], v1[1]); w.w = pk2(v1[2], v1[3]);
                    *(u32x4*)(rowp + bj * HALF) = w; } }
    }
};
struct EpiF32Res {
    static constexpr bool PERM = false, AFTER_DRAIN = false;
    int ldc; const float* resid; float* out;
    __device__ __forceinline__ void operator()(const Acc& acc, const Unit& u, int wr, int wc, int fr, int fq) const {
        const size_t o0 = (size_t)(u.row0 + wr * 64 + fr) * ldc + u.col0 + wc * 32 + 4 * fq;
#pragma unroll
        for (int ai = 0; ai < 2; ++ai)
#pragma unroll
            for (int m = 0; m < 4; ++m) { const size_t ro = o0 + (size_t)(ai * HALF + m * 16) * ldc;
#pragma unroll
                for (int bj = 0; bj < 2; ++bj)
#pragma unroll
                    for (int n = 0; n < 2; ++n) { const size_t o = ro + bj * HALF + n * 16; const f32x4 b = *(const f32x4*)(resid + o); *(f32x4*)(out + o) = acc[ai][bj][m][n] + b; } }
    }
};
struct EpiSwiGlu {
    static constexpr bool PERM = true, AFTER_DRAIN = false;
    int ldc;
    __device__ __forceinline__ void operator()(const Acc& acc, const Unit& u, int wr, int wc, int fr, int fq) const {
        bf16* base = (bf16*)u.C + (size_t)(wr * 64 + fr) * ldc + wc * 32 + 8 * fq;
#pragma unroll
        for (int ai = 0; ai < 2; ++ai)
#pragma unroll
            for (int m = 0; m < 4; ++m) { bf16* rowp = base + (size_t)(ai * HALF + m * 16) * ldc;
                float h[8];
#pragma unroll
                for (int n = 0; n < 2; ++n)
#pragma unroll
                    for (int e = 0; e < 4; ++e) { const float a = acc[ai][0][m][n][e], b = acc[ai][1][m][n][e]; h[n * 4 + e] = a / (1.f + __expf(-a)) * b; }
                u32x4 w; w.x = pk2(h[0], h[1]); w.y = pk2(h[2], h[3]); w.z = pk2(h[4], h[5]); w.w = pk2(h[6], h[7]);
                *(u32x4*)rowp = w; }
    }
};
struct EpiGate {
    static constexpr bool PERM = true, AFTER_DRAIN = false;
    int ldc; const float* egate; const int* cnt_lds_unused;
    __device__ __forceinline__ void operator()(const Acc& acc, const Unit& u, int wr, int wc, int fr, int fq) const {
        bf16* base = (bf16*)u.C + (size_t)(wr * 64 + fr) * ldc + wc * 32 + 8 * fq;
        const int e = u.aux >> 16, nvalid = u.aux & 0xffff;
        const float* gp = egate + (size_t)e * ECAP + u.row0;
#pragma unroll
        for (int ai = 0; ai < 2; ++ai)
#pragma unroll
            for (int m = 0; m < 4; ++m) { const int r = ai * HALF + wr * 64 + m * 16 + fr; const float gt = (r < nvalid) ? gp[r] : 0.f;
                bf16* rowp = base + (size_t)(ai * HALF + m * 16) * ldc;
#pragma unroll
                for (int bj = 0; bj < 2; ++bj) { const f32x4 v0 = acc[ai][bj][m][0] * gt, v1 = acc[ai][bj][m][1] * gt;
                    u32x4 w; w.x = pk2(v0[0], v0[1]); w.y = pk2(v0[2], v0[3]); w.z = pk2(v1[0], v1[1]); w.w = pk2(v1[2], v1[3]);
                    *(u32x4*)(rowp + bj * HALF) = w; } }
    }
};
struct EpiSoftmax {
    static constexpr bool PERM = true, AFTER_DRAIN = true;
    int ldc; float scale_log2e;
    __device__ __forceinline__ void operator()(const Acc&, const Unit&, int, int, int, int) const {}
    __device__ __forceinline__ void fused(const Acc& acc, const Unit& u, int wr, int wc, int fr, int fq, LAS unsigned char* lds, int wid, int lane) const {
        LAS float* RM = (LAS float*)lds;
        LAS float* RS = (LAS float*)(lds + 4096);
        float mx[2][4];
#pragma unroll
        for (int ai = 0; ai < 2; ++ai)
#pragma unroll
            for (int m = 0; m < 4; ++m) { float v = -3.0e38f;
#pragma unroll
                for (int bj = 0; bj < 2; ++bj)
#pragma unroll
                    for (int n = 0; n < 2; ++n) { const f32x4 x = acc[ai][bj][m][n]; v = fmaxf(v, fmaxf(fmaxf(x[0], x[1]), fmaxf(x[2], x[3]))); }
                v = fmaxf(v, xor_lane(v, lane, 16)); v = fmaxf(v, xor_lane(v, lane, 32));
                if (fq == 0) RM[(ai * HALF + wr * 64 + m * 16 + fr) * 4 + wc] = v; }
        asm volatile("s_waitcnt lgkmcnt(0)" ::: "memory"); __builtin_amdgcn_s_barrier(); asm volatile("" ::: "memory");
#pragma unroll
        for (int ai = 0; ai < 2; ++ai)
#pragma unroll
            for (int m = 0; m < 4; ++m) { const int row = ai * HALF + wr * 64 + m * 16 + fr; const f32x4 q = *(const LAS f32x4*)(RM + row * 4);
                const float M = fmaxf(fmaxf(q[0], q[1]), fmaxf(q[2], q[3])); const float mc = -M * scale_log2e; float s = 0.f;
#pragma unroll
                for (int bj = 0; bj < 2; ++bj)
#pragma unroll
                    for (int n = 0; n < 2; ++n)
#pragma unroll
                        for (int e = 0; e < 4; ++e) s += __builtin_amdgcn_exp2f(fmaf(acc[ai][bj][m][n][e], scale_log2e, mc));
                s += xor_lane(s, lane, 16); s += xor_lane(s, lane, 32);
                if (fq == 0) RS[row * 4 + wc] = s; }
        asm volatile("s_waitcnt lgkmcnt(0)" ::: "memory"); __builtin_amdgcn_s_barrier(); asm volatile("" ::: "memory");
        bf16* base = (bf16*)u.C + (size_t)(wr * 64 + fr) * ldc + wc * 32 + 8 * fq;
#pragma unroll
        for (int ai = 0; ai < 2; ++ai)
#pragma unroll
            for (int m = 0; m < 4; ++m) { const int row = ai * HALF + wr * 64 + m * 16 + fr; const f32x4 q = *(const LAS f32x4*)(RS + row * 4); const f32x4 qm = *(const LAS f32x4*)(RM + row * 4);
                const float M = fmaxf(fmaxf(qm[0], qm[1]), fmaxf(qm[2], qm[3])); const float mc = -M * scale_log2e;
                const float inv = 1.f / ((q[0] + q[1]) + (q[2] + q[3])); bf16* rowp = base + (size_t)(ai * HALF + m * 16) * ldc;
#pragma unroll
                for (int bj = 0; bj < 2; ++bj) { float pp[8];
#pragma unroll
                    for (int n = 0; n < 2; ++n)
#pragma unroll
                        for (int e = 0; e < 4; ++e) pp[n * 4 + e] = __builtin_amdgcn_exp2f(fmaf(acc[ai][bj][m][n][e], scale_log2e, mc)) * inv;
                    u32x4 w; w.x = pk2(pp[0], pp[1]); w.y = pk2(pp[2], pp[3]); w.z = pk2(pp[4], pp[5]); w.w = pk2(pp[6], pp[7]);
                    *(u32x4*)(rowp + bj * HALF) = w; } }
        asm volatile("s_waitcnt lgkmcnt(0)" ::: "memory"); __builtin_amdgcn_s_barrier(); asm volatile("" ::: "memory");
    }
};
}

namespace att {
constexpr int KVBLK = 64;
constexpr size_t SHM_V = KVBLK * 128 * 2, SHM_K = KVBLK * 128 * 2;
#define KSWZ(row, colB) ((row) * 256 + ((colB) ^ (((row) & 7) << 4)))
#define SBAR() __builtin_amdgcn_sched_barrier(0)
__device__ __forceinline__ int crow(int r, int hi) { return (r & 3) + 8 * (r >> 2) + 4 * hi; }
__device__ __forceinline__ bf16x8 ld8(const bf16* p) { return *reinterpret_cast<const bf16x8*>(p); }

__device__ __forceinline__ void partialSM(f32x16& p0, f32x16& p1, float& m_reg, float& mn, float& alpha, const float SCALE, const float THR) {
  const float C = SCALE * 1.4426950408889634f;
  float pmax = p0[0];
#pragma unroll
  for (int r = 1; r < 16; ++r) pmax = fmaxf(pmax, p0[r]);
#pragma unroll
  for (int r = 0; r < 16; ++r) pmax = fmaxf(pmax, p1[r]);
  { auto rr = __builtin_amdgcn_permlane32_swap(__float_as_uint(pmax), __float_as_uint(pmax), false, false);
    pmax = fmaxf(__uint_as_float(rr[0]), __uint_as_float(rr[1])); }
  if (__builtin_expect(__all(pmax - m_reg <= THR / SCALE), 1)) { mn = m_reg; alpha = 1.f; }
  else { mn = fmaxf(m_reg, pmax); alpha = __builtin_amdgcn_exp2f((m_reg - mn) * C); m_reg = mn; }
  const float mnC = -mn * C;
#pragma unroll
  for (int r = 0; r < 16; ++r) p0[r] = fmaf(p0[r], C, mnC);
#pragma unroll
  for (int r = 0; r < 16; ++r) p1[r] = fmaf(p1[r], C, mnC);
#pragma unroll
  for (int r = 0; r < 16; ++r) p0[r] = __builtin_amdgcn_exp2f(p0[r]);
}
__device__ __forceinline__ void finishSM(f32x16& p0, f32x16& p1, float alpha, float& l_reg, bf16x8& pa0, bf16x8& pa1, bf16x8& pa2, bf16x8& pa3) {
#pragma unroll
  for (int r = 0; r < 16; ++r) p1[r] = __builtin_amdgcn_exp2f(p1[r]);
  float ps = 0;
#pragma unroll
  for (int r = 0; r < 16; ++r) ps += p0[r];
#pragma unroll
  for (int r = 0; r < 16; ++r) ps += p1[r];
  { auto rr = __builtin_amdgcn_permlane32_swap(__float_as_uint(ps), __float_as_uint(ps), false, false);
    ps = __uint_as_float(rr[0]) + __uint_as_float(rr[1]); }
  l_reg = l_reg * alpha + ps;
#define PK4(P, BASE, OUT) do { unsigned a0 = pk2(P[BASE + 0], P[BASE + 1]), a1 = pk2(P[BASE + 2], P[BASE + 3]);   \
    unsigned b0 = pk2(P[BASE + 4], P[BASE + 5]), b1 = pk2(P[BASE + 6], P[BASE + 7]);                              \
    auto r0 = __builtin_amdgcn_permlane32_swap(a0, b0, false, false); auto r1 = __builtin_amdgcn_permlane32_swap(a1, b1, false, false); \
    u32x4 w = {r0[0], r1[0], r0[1], r1[1]}; OUT = *reinterpret_cast<bf16x8*>(&w); } while (0)
  PK4(p0, 0, pa0); PK4(p0, 8, pa1); PK4(p1, 0, pa2); PK4(p1, 8, pa3);
#undef PK4
}
template <int ND0> __device__ __forceinline__ void qkt(f32x16& p0, f32x16& p1, const char* Ks, const bf16x8* qr, int r32, int hi, int c0) {
  p0 = f32x16{}; p1 = f32x16{};
#pragma unroll
  for (int d0 = 0; d0 < ND0; ++d0) { const int cb = (c0 + d0 * 16 + hi * 8) * 2;
    const bf16x8 b0 = *reinterpret_cast<const bf16x8*>(Ks + KSWZ(r32, cb));
    const bf16x8 b1 = *reinterpret_cast<const bf16x8*>(Ks + KSWZ(32 + r32, cb));
    p0 = __builtin_amdgcn_mfma_f32_32x32x16_bf16(b0, qr[d0], p0, 0, 0, 0);
    p1 = __builtin_amdgcn_mfma_f32_32x32x16_bf16(b1, qr[d0], p1, 0, 0, 0); }
}
__device__ __forceinline__ int v_st(int k, int c) { const int kk = (k & ~0xC) | ((k & 4) << 1) | ((k & 8) >> 1); return ((kk >> 3) * 4 + (c >> 5)) * 512 + ((kk & 7) * 32 + (c & 31)) * 2; }
__device__ __forceinline__ int v_rd_base(int lane) { return ((lane & 3) << 3) | (((lane >> 2) & 3) << 6) | (((lane >> 4) & 1) << 5) | (((lane >> 5) & 1) << 8); }
constexpr int v_rd_off(int d0, int ks, int half) { return d0 * 512 + ks * 4096 + half * 2048; }
template <int OFF> __device__ __forceinline__ s16x4 tr_read(int vb) {
  s16x4 r; asm volatile("ds_read_b64_tr_b16 %0, %1 offset:%2" : "=&v"(r) : "v"(vb), "i"(OFF) : "memory"); return r;
}
template <int D0> __device__ __forceinline__ void pv_one(f32x16& od, int vb, bf16x8 pa0, bf16x8 pa1, bf16x8 pa2, bf16x8 pa3) {
  const s16x4 l0 = tr_read<v_rd_off(D0, 0, 0)>(vb), h0 = tr_read<v_rd_off(D0, 0, 1)>(vb), l1 = tr_read<v_rd_off(D0, 1, 0)>(vb), h1 = tr_read<v_rd_off(D0, 1, 1)>(vb);
  const s16x4 l2 = tr_read<v_rd_off(D0, 2, 0)>(vb), h2 = tr_read<v_rd_off(D0, 2, 1)>(vb), l3 = tr_read<v_rd_off(D0, 3, 0)>(vb), h3 = tr_read<v_rd_off(D0, 3, 1)>(vb);
  asm volatile("s_waitcnt lgkmcnt(0)" ::: "memory"); SBAR();
#define PK(L, H) (bf16x8){L[0], L[1], L[2], L[3], H[0], H[1], H[2], H[3]}
  od = __builtin_amdgcn_mfma_f32_32x32x16_bf16(pa0, PK(l0, h0), od, 0, 0, 0);
  od = __builtin_amdgcn_mfma_f32_32x32x16_bf16(pa1, PK(l1, h1), od, 0, 0, 0);
  od = __builtin_amdgcn_mfma_f32_32x32x16_bf16(pa2, PK(l2, h2), od, 0, 0, 0);
  od = __builtin_amdgcn_mfma_f32_32x32x16_bf16(pa3, PK(l3, h3), od, 0, 0, 0);
#undef PK
}
__device__ __forceinline__ void pv_d0(f32x16* o, int vb, bf16x8 pa0, bf16x8 pa1, bf16x8 pa2, bf16x8 pa3) {
  pv_one<0>(o[0], vb, pa0, pa1, pa2, pa3); pv_one<1>(o[1], vb, pa0, pa1, pa2, pa3); pv_one<2>(o[2], vb, pa0, pa1, pa2, pa3); pv_one<3>(o[3], vb, pa0, pa1, pa2, pa3);
}

__device__ __forceinline__ void diff_attn_unit(const bf16* Qb, const bf16* Kh, const bf16* Vh, int ld, int seq, bf16* outb, int ldo,
                                               const float lam, const float post_scale, const float* subln_g, char* lds, const int wave_id) {
  constexpr float SCALE = 0.125f, THR = 8.f;
  const int tid = tid_from_wave(wave_id), wid = __builtin_amdgcn_readfirstlane(tid >> 6), lane = tid & 63, r32 = lane & 31, hi = lane >> 5;
  const int csel = wid >> 2, wq = wid & 3;
  char* V_lds = lds; char* K_lds = lds + 2 * SHM_V;
  float* ws = (float*)(lds + 2 * SHM_V + 2 * SHM_K) + wid * 64; float* li_l = ws; float* al_l = ws + 32;
  float m_reg = -1e30f, l_reg = 0; f32x16 o[4] = {}; bf16x8 qr[4];
  const bf16* Qw = Qb + (long)(wq * 32 + r32) * ld + csel * 64 + hi * 8;
#pragma unroll
  for (int d0 = 0; d0 < 4; ++d0) qr[d0] = ld8(Qw + d0 * 16);
  const int sr = tid >> 4, sc = (tid & 15) * 8, vst0 = v_st(sr, sc), vst1 = v_st(32 + sr, sc);
  const int vb0 = (int)(uintptr_t)V_lds + v_rd_base(lane);
  const int kc0 = csel * 64;
  struct { bf16x8 vs0, vs1, ks0, ks1; } sr_[2];
#define SLOAD(i, k0) do { sr_[i].vs0 = ld8(&Vh[(long)((k0) + sr) * ld + sc]); sr_[i].vs1 = ld8(&Vh[(long)((k0) + 32 + sr) * ld + sc]); \
    sr_[i].ks0 = ld8(&Kh[(long)((k0) + sr) * ld + sc]); sr_[i].ks1 = ld8(&Kh[(long)((k0) + 32 + sr) * ld + sc]); } while (0)
#define SWRITE(b, i) do { *(bf16x8*)(V_lds + (b) * SHM_V + vst0) = sr_[i].vs0;          \
    *(bf16x8*)(V_lds + (b) * SHM_V + vst1) = sr_[i].vs1; const int kc = sc * 2;               \
    *(bf16x8*)(K_lds + (b) * SHM_K + KSWZ(sr, kc)) = sr_[i].ks0;                       \
    *(bf16x8*)(K_lds + (b) * SHM_K + KSWZ(32 + sr, kc)) = sr_[i].ks1; } while (0)
#define SWAIT() asm volatile("s_waitcnt vmcnt(4)" ::: "memory")
#define RESC(a) do { if (__any((a) < 1.f)) { if (hi == 0) al_l[r32] = (a); asm volatile("s_waitcnt lgkmcnt(0)" ::: "memory"); \
    _Pragma("unroll") for (int d = 0; d < 4; ++d) _Pragma("unroll") for (int r = 0; r < 16; ++r) o[d][r] *= al_l[crow(r, hi)]; } } while (0)
  f32x16 pA0, pA1, pB0, pB1; float mnA, mnB, alA, alB; bf16x8 pa0, pa1, pa2, pa3; const int NT = seq / KVBLK;
  constexpr int SE = 0, SO = 1;
  __syncthreads();
  SLOAD(SE, 0); asm volatile("s_waitcnt vmcnt(0)" ::: "memory"); SWRITE(0, SE); __syncthreads();
  qkt<4>(pA0, pA1, K_lds, qr, r32, hi, kc0); partialSM(pA0, pA1, m_reg, mnA, alA, SCALE, THR);
  SLOAD(SO, KVBLK); if (2 < NT) SLOAD(SE, 2 * KVBLK);
  SWAIT(); SWRITE(1, SO); __syncthreads();
  for (int j = 1; j + 1 < NT; j += 2) {
    SBAR(); qkt<4>(pB0, pB1, K_lds + SHM_K, qr, r32, hi, kc0);
    finishSM(pA0, pA1, alA, l_reg, pa0, pa1, pa2, pa3); SBAR();
    SLOAD(SO, (j + 2) * KVBLK); SBAR();
    pv_d0(o, vb0, pa0, pa1, pa2, pa3); partialSM(pB0, pB1, m_reg, mnB, alB, SCALE, THR);
    __syncthreads(); SWAIT(); SWRITE(0, SE);
    RESC(alB); __syncthreads();
    SBAR(); qkt<4>(pA0, pA1, K_lds, qr, r32, hi, kc0);
    finishSM(pB0, pB1, alB, l_reg, pa0, pa1, pa2, pa3); SBAR();
    if (j + 3 < NT) SLOAD(SE, (j + 3) * KVBLK); SBAR();
    pv_d0(o, vb0 + (int)SHM_V, pa0, pa1, pa2, pa3); partialSM(pA0, pA1, m_reg, mnA, alA, SCALE, THR);
    __syncthreads(); SWAIT(); SWRITE(1, SO);
    RESC(alA); __syncthreads();
  }
  SBAR(); qkt<4>(pB0, pB1, K_lds + SHM_K, qr, r32, hi, kc0);
  finishSM(pA0, pA1, alA, l_reg, pa0, pa1, pa2, pa3); SBAR();
  pv_d0(o, vb0, pa0, pa1, pa2, pa3); partialSM(pB0, pB1, m_reg, mnB, alB, SCALE, THR);
  __syncthreads(); RESC(alB);
  finishSM(pB0, pB1, alB, l_reg, pa0, pa1, pa2, pa3); SBAR();
  pv_d0(o, vb0 + (int)SHM_V, pa0, pa1, pa2, pa3);
  asm volatile("s_waitcnt vmcnt(0)" ::: "memory");
  if (hi == 0) li_l[r32] = l_reg; asm volatile("s_waitcnt lgkmcnt(0)" ::: "memory");
  float rli[16];
#pragma unroll
  for (int r = 0; r < 16; ++r) rli[r] = __builtin_amdgcn_rcpf(li_l[crow(r, hi)]);
  __syncthreads();
  float* X = (float*)lds + (size_t)wq * 4096;
  if (csel == 1) {
#pragma unroll
    for (int d0 = 0; d0 < 4; ++d0)
#pragma unroll
      for (int r = 0; r < 16; ++r) X[(d0 * 16 + r) * 64 + lane] = o[d0][r] * rli[r];
  }
  __syncthreads();
  if (csel == 0) {
    float ss[16];
#pragma unroll
    for (int r = 0; r < 16; ++r) ss[r] = 0.f;
#pragma unroll
    for (int d0 = 0; d0 < 4; ++d0)
#pragma unroll
      for (int r = 0; r < 16; ++r) { const float v = o[d0][r] * rli[r] - lam * X[(d0 * 16 + r) * 64 + lane]; o[d0][r] = v; ss[r] += v * v; }
#pragma unroll
    for (int r = 0; r < 16; ++r) { float s = ss[r];
      s = row_sum(s); s += xor_lane(s, lane, 16);
      ss[r] = __builtin_amdgcn_rsqf(s * (1.f / 128.f) + RMS_EPS) * post_scale; }
    float gg[4];
#pragma unroll
    for (int d0 = 0; d0 < 4; ++d0) gg[d0] = subln_g[d0 * 32 + r32];
    bf16* Ow = outb + (long)(wq * 32) * ldo;
#pragma unroll
    for (int r = 0; r < 16; ++r) { const int orow = crow(r, hi);
#pragma unroll
      for (int d0 = 0; d0 < 4; ++d0) Ow[(long)orow * ldo + d0 * 32 + r32] = f2bf(o[d0][r] * ss[r] * gg[d0]); }
  }
#undef SLOAD
#undef SWRITE
#undef SWAIT
}

__device__ __forceinline__ void dil_attn_unit(const bf16* Qh, const bf16* Kh, const bf16* Vh, int ld, int dil, int rho, int u0, int L,
                                              float* Oc, float* lsep, char* lds, const int wave_id) {
  constexpr float SCALE = 0.08838834764831845f; constexpr float C = SCALE * 1.4426950408889634f;
  const int tid = tid_from_wave(wave_id), wid = __builtin_amdgcn_readfirstlane(tid >> 6), lane = tid & 63, r32 = lane & 31, hi = lane >> 5;
  char* V_lds = lds; char* K_lds = lds + 2 * SHM_V;
  float* ws = (float*)(lds + 2 * SHM_V + 2 * SHM_K) + wid * 64; float* li_l = ws; float* al_l = ws + 32;
  float m_reg = -1e30f, l_reg = 0; f32x16 o[4] = {}; bf16x8 qr[8];
  const int uq = u0 + wid * 32 + r32;
  const bf16* Qw = Qh + (long)(rho + dil * uq) * ld + hi * 8;
#pragma unroll
  for (int d0 = 0; d0 < 8; ++d0) qr[d0] = ld8(Qw + d0 * 16);
  const int sr = tid >> 4, sc = (tid & 15) * 8, vst0 = v_st(sr, sc), vst1 = v_st(32 + sr, sc);
  const int vb0 = (int)(uintptr_t)V_lds + v_rd_base(lane);
  const int tlo = wid >> 1;
  for (int t = 0; t < 6; ++t) {
    const int kt0 = u0 - 64 + 64 * t;
    __syncthreads();
    { int ua = kt0 + sr, ub = kt0 + 32 + sr; ua = ua < 0 ? 0 : (ua >= L ? L - 1 : ua); ub = ub < 0 ? 0 : (ub >= L ? L - 1 : ub);
      const long ra = (long)(rho + dil * ua) * ld + sc, rb = (long)(rho + dil * ub) * ld + sc;
      const bf16x8 va = ld8(Vh + ra), vb = ld8(Vh + rb), ka = ld8(Kh + ra), kb = ld8(Kh + rb);
      *(bf16x8*)(V_lds + vst0) = va; *(bf16x8*)(V_lds + vst1) = vb; const int kc = sc * 2;
      *(bf16x8*)(K_lds + KSWZ(sr, kc)) = ka; *(bf16x8*)(K_lds + KSWZ(32 + sr, kc)) = kb; }
    __syncthreads();
    if (t >= tlo && t <= tlo + 2) {
      f32x16 p0, p1;
      qkt<8>(p0, p1, K_lds, qr, r32, hi, 0);
#pragma unroll
      for (int r = 0; r < 16; ++r) { const int uk0 = kt0 + crow(r, hi), uk1 = uk0 + 32; const int d0 = uk0 - uq, d1 = uk1 - uq;
        const bool ok0 = (uk0 >= 0) && (uk0 < L) && (d0 >= -64) && (d0 <= 64), ok1 = (uk1 >= 0) && (uk1 < L) && (d1 >= -64) && (d1 <= 64);
        p0[r] = ok0 ? p0[r] : -1e30f; p1[r] = ok1 ? p1[r] : -1e30f; }
      float pmax = p0[0];
#pragma unroll
      for (int r = 1; r < 16; ++r) pmax = fmaxf(pmax, p0[r]);
#pragma unroll
      for (int r = 0; r < 16; ++r) pmax = fmaxf(pmax, p1[r]);
      { auto rr = __builtin_amdgcn_permlane32_swap(__float_as_uint(pmax), __float_as_uint(pmax), false, false);
        pmax = fmaxf(__uint_as_float(rr[0]), __uint_as_float(rr[1])); }
      const float mn = fmaxf(m_reg, pmax); const float alpha = __builtin_amdgcn_exp2f((m_reg - mn) * C); m_reg = mn;
      const float mnC = -mn * C;
#pragma unroll
      for (int r = 0; r < 16; ++r) { p0[r] = __builtin_amdgcn_exp2f(fmaf(p0[r], C, mnC)); p1[r] = fmaf(p1[r], C, mnC); }
      bf16x8 pa0, pa1, pa2, pa3;
      finishSM(p0, p1, alpha, l_reg, pa0, pa1, pa2, pa3);
      RESC(alpha);
      pv_d0(o, vb0, pa0, pa1, pa2, pa3);
    }
  }
  if (hi == 0) li_l[r32] = l_reg; asm volatile("s_waitcnt lgkmcnt(0)" ::: "memory");
  float rli[16];
#pragma unroll
  for (int r = 0; r < 16; ++r) rli[r] = __builtin_amdgcn_rcpf(li_l[crow(r, hi)]);
#pragma unroll
  for (int r = 0; r < 16; ++r) { const int uo = u0 + wid * 32 + crow(r, hi); float* orow = Oc + (long)(rho + dil * uo) * 512;
#pragma unroll
    for (int d0 = 0; d0 < 4; ++d0) orow[d0 * 32 + r32] = o[d0][r] * rli[r]; }
  if (hi == 0) lsep[(long)(rho + dil * uq) * 4] = m_reg * SCALE + __logf(l_reg);
}
#undef RESC
#undef KSWZ
#undef SBAR
}

struct Args { const float* in[N_INPUTS]; float* out; unsigned char* ws; int ph_lo, ph_hi; };
typedef const __attribute__((address_space(4))) Args* ArgsP;
struct Frame {
    LAS unsigned char* lds; volatile LAS unsigned* MISC; unsigned* ctl; unsigned char* ws;
    int tid, lane, wave, G, bid;
};
constexpr int PH_P0 = 0, PH_L0 = 1, NPH_L = 13, PH_FINAL = PH_L0 + DEPTH * NPH_L, NPHASES = PH_FINAL + 1;
enum { LP_NORM1 = 0, LP_G1, LP_PREP, LP_CPREP, LP_MIX, LP_POST, LP_G2, LP_NORM2, LP_GS, LP_GO, LP_NORM3, LP_M1, LP_M2 };

__device__ __forceinline__ int q_next(Frame& F, int q) {
    __syncthreads();
    if (F.tid == 0) F.MISC[0] = __hip_atomic_fetch_add(F.ctl + CW_Q + 64 * q, 1u, __ATOMIC_RELAXED, __HIP_MEMORY_SCOPE_AGENT);
    __syncthreads();
    return (int)F.MISC[0];
}

template <class RowMap>
__device__ __forceinline__ void transpose_item(const float* W, int ldn, bf16* WT, int ldt, RowMap rm, LAS float* scr, int k0, int n0, int lane) {
#pragma unroll 8
    for (int i = 0; i < 32; ++i) { const int kk = 2 * i + (lane >> 5); scr[kk * 33 + (lane & 31)] = W[(size_t)(k0 + kk) * ldn + n0 + (lane & 31)]; }
    LDS_WAIT(); asm volatile("" ::: "memory");
    const int c = lane & 7;
#pragma unroll
    for (int j = 0; j < 4; ++j) { const int n = (lane >> 3) + 8 * j; const LAS float* s = scr + (8 * c) * 33 + n;
        u32x4 o; o.x = pk2(s[0 * 33], s[1 * 33]); o.y = pk2(s[2 * 33], s[3 * 33]); o.z = pk2(s[4 * 33], s[5 * 33]); o.w = pk2(s[6 * 33], s[7 * 33]);
        *(u32x4*)(WT + (size_t)rm(n0 + n) * ldt + k0 + 8 * c) = o; }
    LDS_WAIT(); asm volatile("" ::: "memory");
}
struct RmId { __device__ __forceinline__ int operator()(int n) const { return n; } };
struct RmW13 { int off; __device__ __forceinline__ int operator()(int n) const { return 256 * (n >> 7) + off + (n & 127); } };

__device__ __forceinline__ void p0_prologue(Frame& F, ArgsP a) {
    unsigned char* ws = F.ws;
    LAS float* scr = (LAS float*)(F.lds + F.wave * 16384);
    const int gw = F.bid * 8 + F.wave, NGW = F.G * 8;
    constexpr int I_WIN = (DM / 64) * (IN_TOTAL / 32), I_SQ = (DM / 64) * (DM / 32), I_WKV = (DM / 64) * (4096 / 32), I_W1 = (DM / 64) * (DEXP / 32), I_W2 = (DEXP / 64) * (DM / 32);
    constexpr int PER_L = I_WIN + I_SQ + I_WKV + I_SQ + NEXP * (2 * I_W1 + I_W2);
    for (int it = gw; it < DEPTH * PER_L; it += NGW) {
        const int l = it / PER_L; int r = it % PER_L;
        if (r < I_WIN) { const int nb = IN_TOTAL / 32; transpose_item(a->in[I_W_IN] + (size_t)l * DM * IN_TOTAL, IN_TOTAL, (bf16*)(ws + WS_WIN) + (size_t)l * ZLD * DM, DM, RmId{}, scr, 64 * (r / nb), 32 * (r % nb), F.lane); continue; } r -= I_WIN;
        if (r < I_SQ) { const int nb = DM / 32; transpose_item(a->in[I_W_OUT] + (size_t)l * DM * DM, DM, (bf16*)(ws + WS_WOUT) + (size_t)l * DM * DM, DM, RmId{}, scr, 64 * (r / nb), 32 * (r % nb), F.lane); continue; } r -= I_SQ;
        if (r < I_WKV) { const int nb = 4096 / 32; transpose_item(a->in[I_XA_WKV] + (size_t)l * DM * 4096, 4096, (bf16*)(ws + SC_WKVT) + (size_t)l * 4096 * DM, DM, RmId{}, scr, 64 * (r / nb), 32 * (r % nb), F.lane); continue; } r -= I_WKV;
        if (r < I_SQ) { const int nb = DM / 32; transpose_item(a->in[I_XA_WO] + (size_t)l * DM * DM, DM, (bf16*)(ws + SC_WOT) + (size_t)l * DM * DM, DM, RmId{}, scr, 64 * (r / nb), 32 * (r % nb), F.lane); continue; } r -= I_SQ;
        const int e = r / (2 * I_W1 + I_W2); r = r % (2 * I_W1 + I_W2);
        const size_t le = (size_t)l * NEXP + e;
        if (r < I_W1) { const int nb = DEXP / 32; transpose_item(a->in[I_MOE_W1] + le * DM * DEXP, DEXP, (bf16*)(ws + WS_W13) + le * 1024 * DM, DM, RmW13{0}, scr, 64 * (r / nb), 32 * (r % nb), F.lane); continue; } r -= I_W1;
        if (r < I_W1) { const int nb = DEXP / 32; transpose_item(a->in[I_MOE_W3] + le * DM * DEXP, DEXP, (bf16*)(ws + WS_W13) + le * 1024 * DM, DM, RmW13{128}, scr, 64 * (r / nb), 32 * (r % nb), F.lane); continue; } r -= I_W1;
        { const int nb = DM / 32; transpose_item(a->in[I_MOE_W2] + le * DEXP * DM, DM, (bf16*)(ws + WS_W2) + le * DM * DEXP, DEXP, RmId{}, scr, 64 * (r / nb), 32 * (r % nb), F.lane); }
    }
    for (int it = gw; it < DEPTH * 96; it += NGW) { const int l = it / 96; int r = it % 96; bf16* base = (bf16*)(ws + WS_LORA + l * LORA_LAYER);
        if (r < 32) { const int d = r >> 4, nb = r & 15; transpose_item(a->in[I_RWKV_W2] + ((size_t)l * 2 + d) * 64 * 512, 512, base + (size_t)d * 512 * 64, 64, RmId{}, scr, 0, 32 * nb, F.lane); continue; } r -= 32;
        if (r < 32) { const int d = r >> 4, nb = r & 15; transpose_item(a->in[I_RWKV_A2] + ((size_t)l * 2 + d) * 64 * 512, 512, base + (size_t)(2 + d) * 512 * 64, 64, RmId{}, scr, 0, 32 * nb, F.lane); continue; } r -= 32;
        { const int kb = r >> 4, nb = r & 15; transpose_item(a->in[I_RWKV_G2] + (size_t)l * 128 * 512, 512, base + (size_t)4 * 512 * 64, 128, RmId{}, scr, 64 * kb, 32 * nb, F.lane); } }
    for (int it = gw; it < DEPTH * 128; it += NGW) { const int l = it / 128, r = it % 128, kb = r >> 4, nb = r & 15;
        transpose_item(a->in[I_S5_GLU_W] + (size_t)l * 512 * 512, 512, (bf16*)(ws + WS_GLUT) + (size_t)l * 512 * 512, 512, RmId{}, scr, 64 * kb, 32 * nb, F.lane); }
    const int gt = F.bid * 512 + F.tid, NGT = F.G * 512;
    for (int i = gt; i < DEPTH * 32 * 16 * 64; i += NGT) { const int n = i & 63, row = i >> 6;
        bf16* cw = (bf16*)(ws + WS_S5CW) + (size_t)row * 128; cw[n] = f2bf(a->in[I_S5_C_RE][i]); cw[64 + n] = f2bf(-a->in[I_S5_C_IM][i]); }
    for (int i = gt; i < DEPTH * DM * 32; i += NGT) { const int l = i / (DM * 32), r = i % (DM * 32), k = r >> 5, e = r & 31;
        ((float*)(ws + WS_RTE))[(((size_t)l * 4 + (e >> 3)) * DM + k) * 8 + (e & 7)] = a->in[I_ROUTER_EXPERT][i]; }
    for (int i = gt; i < DEPTH * (ZLD - IN_TOTAL) * DM / 8; i += NGT) { const int l = i / ((ZLD - IN_TOTAL) * DM / 8), r = i % ((ZLD - IN_TOTAL) * DM / 8);
        *(u32x4*)((bf16*)(ws + WS_WIN) + (size_t)l * ZLD * DM + (size_t)IN_TOTAL * DM + (size_t)r * 8) = (u32x4){0u, 0u, 0u, 0u}; }
    for (int i = gt; i < DEPTH * DM * DM / 8; i += NGT) { const f32x4 x0 = *(const f32x4*)(a->in[I_XA_WQ] + (size_t)i * 8), x1 = *(const f32x4*)(a->in[I_XA_WQ] + (size_t)i * 8 + 4);
        u32x4 o; o.x = pk2(x0[0], x0[1]); o.y = pk2(x0[2], x0[3]); o.z = pk2(x1[0], x1[1]); o.w = pk2(x1[2], x1[3]); *(u32x4*)((bf16*)(ws + SC_WQB) + (size_t)i * 8) = o; }
    { float* cosA = (float*)(ws + WS_ROPE); float* sinA = cosA + SEQ * 32; float* cosC = sinA + SEQ * 32; float* sinC = cosC + SEQ * 64;
      for (int i = gt; i < SEQ * 96; i += NGT) { const int s = i / 96, j = i % 96; const bool isA = j < 32; const int jj = isA ? j : j - 32; const float dim = isA ? 64.f : 128.f;
          const float inv = 1.0f / powf(10000.0f, (float)(2 * jj) / dim); const float ang = (float)s * inv; float sn, cs; sincosf(ang, &sn, &cs);
          if (isA) { cosA[s * 32 + jj] = cs; sinA[s * 32 + jj] = sn; } else { cosC[s * 64 + jj] = cs; sinC[s * 64 + jj] = sn; } } }
    for (int i = gt; i < DEPTH * 2 * 32 * 64; i += NGT) { const int l = i / (2 * 32 * 64), r = i % (2 * 32 * 64), dir = r / (32 * 64), g = (r / 64) % 32, n = r % 64;
        float* ab = (float*)(ws + WS_S5P + l * S5P_LAYER); float* bb = ab + 2 * 32 * 64 * 2;
        const size_t pi = (((size_t)l * 2 + dir) * 32 + g) * 64 + n;
        const float lr = fminf(a->in[I_S5_A_RE][pi], -1e-4f), li = a->in[I_S5_A_IM][pi], dt = __expf(a->in[I_S5_LOG_DT][((size_t)l * 2 + dir) * 32 + g]);
        const float mag = __expf(dt * lr); float sn, cs; sincosf(dt * li, &sn, &cs); const float abr = mag * cs, abi = mag * sn;
        const float den = lr * lr + li * li; const float ir = lr / den, ii = -li / den;
        const float fr_ = (abr - 1.f) * ir - abi * ii, fi_ = (abr - 1.f) * ii + abi * ir;
        ab[(size_t)r * 2] = abr; ab[(size_t)r * 2 + 1] = abi;
        { float* ab256 = bb + 2 * 32 * 64 * 16 * 2; const float m256 = __expf(256.f * dt * lr); float s2, c2; sincosf(256.f * dt * li, &s2, &c2); ab256[(size_t)r * 2] = m256 * c2; ab256[(size_t)r * 2 + 1] = m256 * s2; }
        const size_t bi = (((size_t)l * 32 + g) * 64 + n) * 16;
#pragma unroll
        for (int c = 0; c < 16; ++c) { const float br = a->in[I_S5_B_RE][bi + c], bim = a->in[I_S5_B_IM][bi + c];
            bb[((size_t)r * 16 + c) * 2] = fr_ * br - fi_ * bim; bb[((size_t)r * 16 + c) * 2 + 1] = fr_ * bim + fi_ * br; } }
    for (int it = gw; it < DEPTH * BATCH * NMEM; it += NGW) { const int l = it / (BATCH * NMEM), row = it % (BATCH * NMEM);
        const f32x4* xr = (const f32x4*)(a->in[I_MEM] + (size_t)row * DM) + F.lane; const f32x4* gr = (const f32x4*)(a->in[I_NORM_MEM] + (size_t)l * DM) + F.lane;
        f32x4 v[8]; float s = 0.f;
#pragma unroll
        for (int j = 0; j < 8; ++j) { v[j] = xr[64 * j]; s += (v[j].x * v[j].x + v[j].y * v[j].y) + (v[j].z * v[j].z + v[j].w * v[j].w); }
        const float rstd = 1.f / sqrtf(wave_sum(s) * (1.f / DM) + RMS_EPS);
        u32x2* o8 = (u32x2*)((bf16*)(ws + SC_MEMN) + ((size_t)l * 512 + row) * DM) + F.lane;
#pragma unroll
        for (int j = 0; j < 8; ++j) { const f32x4 gv = gr[64 * j]; u32x2 w; w.x = pk2(v[j].x * rstd * gv.x, v[j].y * rstd * gv.y); w.y = pk2(v[j].z * rstd * gv.z, v[j].w * rstd * gv.w); o8[64 * j] = w; } }
}

struct SchedDense { const char* A; const char* B; char* C; int nM, nN, G, c, lda, ldb, ldcb  , cesz  ;
    __device__ __forceinline__ bool next(int i, pg8::Unit& u) const { const long L = (long)i * G + c; if (L >= (long)nM * nN) return false; int pm, pn; pg8::xcd_tile((int)L, nM, nN, pm, pn);
        u.A = A + (size_t)pm * 256 * lda * 2; u.B = B + (size_t)pn * 256 * ldb * 2; u.C = C + (size_t)pm * 256 * ldcb + (size_t)pn * 256 * cesz; u.row0 = pm * 256; u.col0 = pn * 256; u.aux = 0; return true; }
    __device__ __forceinline__ int arow(const pg8::Unit&, int r) const { return r; } };
struct SchedG1P1 { const char* A; const char* B; char* C; int nM, nN, G, c, nextra; unsigned char* ws;
    __device__ __forceinline__ bool next(int i, pg8::Unit& u) const { const long L = (long)i * G + c; const int nd = nM * nN;
        if (L < nd) { int pm, pn; pg8::xcd_tile((int)L, nM, nN, pm, pn); u.A = A + (size_t)pm * 256 * DM * 2; u.B = B + (size_t)pn * 256 * DM * 2; u.C = C + (size_t)pm * 256 * ZLD * 2 + (size_t)pn * 512; u.row0 = pm * 256; u.col0 = pn * 256; u.aux = ZLD; return true; }
        if (L >= nd + nextra) return false;
        const int r = (int)(L - nd), l = r >> 5, pm = (r >> 4) & 1, pn = r & 15;
        u.A = (const char*)(ws + SC_MEMN) + ((size_t)l * 512 + pm * 256) * DM * 2; u.B = (const char*)(ws + SC_WKVT) + ((size_t)l * 4096 + pn * 256) * DM * 2;
        u.C = (char*)(ws + SC_KVB) + ((size_t)l * 512 + pm * 256) * 4096 * 2 + (size_t)pn * 512; u.row0 = pm * 256; u.col0 = pn * 256; u.aux = 4096; return true; }
    __device__ __forceinline__ int arow(const pg8::Unit&, int r) const { return r; } };
struct SchedBatch { const char* A; const char* B; char* C; size_t sA, sB, sC; int nM, nN, nb, G, c, lda, ldb, ldcb, cesz, rowsPerBatch;
    __device__ __forceinline__ bool next(int i, pg8::Unit& u) const { const long L = (long)i * G + c; const int per = nM * nN; if (L >= (long)per * nb) return false; const int b = (int)(L / per), r = (int)(L % per), pm = r / nN, pn = r % nN;
        u.A = A + b * sA + (size_t)pm * 256 * lda * 2; u.B = B + b * sB + (size_t)pn * 256 * ldb * 2; u.C = C + b * sC + (size_t)pm * 256 * ldcb + (size_t)pn * 256 * cesz; u.row0 = b * rowsPerBatch + pm * 256; u.col0 = pn * 256; u.aux = b; return true; }
    __device__ __forceinline__ int arow(const pg8::Unit&, int r) const { return r; } };
struct SchedXaPre { unsigned char* ws; int G, c, kind;
    __device__ __forceinline__ bool next(int i, pg8::Unit& u) const { const long L = (long)i * G + c; if (L >= 128) return false; const int r = (int)L, p = r >> 3, t = r & 7, l = p >> 3, b = (p >> 2) & 1, h = p & 3;
        const bf16* kvb = (const bf16*)(ws + SC_KVB) + (size_t)l * 512 * 4096 + (size_t)(b * 256) * 4096;
        if (kind == 0) { u.A = (const char*)(kvb + h * 512); u.B = (const char*)((const bf16*)(ws + SC_WQB) + (size_t)l * DM * DM + (size_t)(t * 256) * DM + h * 512);
            u.C = (char*)((bf16*)(ws + WS_WQK) + ((size_t)(l * 2 + b) * 1024 + h * 256) * DM + t * 256); u.aux = DM; }
        else { u.A = (const char*)((const bf16*)(ws + SC_WOT) + (size_t)l * DM * DM + (size_t)(t * 256) * DM + h * 512); u.B = (const char*)(kvb + 2048 + h * 512);
            u.C = (char*)((bf16*)(ws + WS_VWO) + ((size_t)(l * 2 + b) * DM + t * 256) * 1024 + h * 256); u.aux = 1024; }
        u.row0 = 0; u.col0 = 0; return true; }
    __device__ __forceinline__ int arow(const pg8::Unit&, int r) const { return r; } };
struct EpiBf16U { static constexpr bool PERM = true, AFTER_DRAIN = false;
    __device__ __forceinline__ void operator()(const pg8::Acc& acc, const pg8::Unit& u, int wr, int wc, int fr, int fq) const { pg8::EpiBf16 e{u.aux}; e(acc, u, wr, wc, fr, fq); } };
struct SchedMoe { unsigned char* ws; const volatile LAS int* tp; const volatile LAS int* cnt; int layer, G, c, which;
    __device__ __forceinline__ bool next(int i, pg8::Unit& u) const {
        const int npn = which == 0 ? 4 : 8; const long L = (long)i * G + c; const int ntile = tp[32]; if (L >= (long)ntile * npn) return false;
        const int mt = (int)(L / npn), pn = (int)(L % npn); int e = 0;
#pragma unroll 1
        for (int k = 1; k < 32; ++k) e += (mt >= tp[k]) ? 1 : 0;
        const int lt = mt - tp[e]; const int nvalid = min(256, cnt[e] - lt * 256);
        u.row0 = lt * 256; u.col0 = pn * 256; u.aux = (e << 16) | nvalid;
        if (which == 0) { u.A = (const char*)(ws + WS_HN); u.B = (const char*)((const bf16*)(ws + WS_W13) + ((size_t)(layer * NEXP + e) * 1024 + pn * 256) * DM);
            u.C = (char*)((bf16*)(ws + SC_HMID) + (size_t)(mt * 256) * DEXP + pn * 128); }
        else { u.A = (const char*)((const bf16*)(ws + SC_HMID) + (size_t)(mt * 256) * DEXP); u.B = (const char*)((const bf16*)(ws + WS_W2) + ((size_t)(layer * NEXP + e) * DM + pn * 256) * DEXP);
            u.C = (char*)((bf16*)(ws + SC_YBUF) + (size_t)(mt * 256) * DM + pn * 256); }
        return true; }
    __device__ __forceinline__ int arow(const pg8::Unit& u, int r) const { const int e = u.aux >> 16, nvalid = u.aux & 0xffff; const int idx = (r < nvalid) ? (u.row0 + r) : u.row0;
        return ((const int*)(ws + WS_ETOK))[(size_t)e * ECAP + idx]; } };

__device__ __forceinline__ void moe_prefix(Frame& F, int layer, volatile LAS int* tp, volatile LAS int* cnt) {
    __syncthreads();
    if (F.tid < 32) cnt[F.tid] = (int)__hip_atomic_load(F.ctl + CW_CNT + (layer * 32 + F.tid) * 64, __ATOMIC_RELAXED, __HIP_MEMORY_SCOPE_AGENT);
    __syncthreads();
    if (F.tid == 0) { int s = 0; for (int e = 0; e < 32; ++e) { tp[e] = s; s += (cnt[e] + 255) >> 8; } tp[32] = s; }
    __syncthreads();
}
template <int MODE>
__device__ __forceinline__ void norm_phase(Frame& F, ArgsP a, const float* src, const float* gain, int layer) {
    unsigned char* ws = F.ws; float* H = (float*)(ws + WS_H); bf16* HN = (bf16*)(ws + WS_HN);
    volatile LAS int* tp = (volatile LAS int*)(F.lds + 1024); volatile LAS int* cnt = tp + 40;
    if (MODE & 1) moe_prefix(F, layer - 1, tp, cnt);
    const int gw = F.bid * 8 + F.wave, NGW = F.G * 8;
    const f32x4* gr = (const f32x4*)gain + F.lane;
    int pend = 0, prow = 0, pe0 = 0, pe1 = 0, pp0 = 0, pp1 = 0; float pg0 = 0.f, pg1 = 0.f;
    constexpr int NR = (MODE & 2) ? 1 : 2;
    for (int row0 = gw; row0 < NTOK; row0 += NR * NGW) {
        f32x4 v[NR][8]; int rw[NR];
#pragma unroll
        for (int u = 0; u < NR; ++u) { rw[u] = (row0 + u * NGW < NTOK) ? row0 + u * NGW : row0; const f32x4* xr = (const f32x4*)(src + (size_t)rw[u] * DM) + F.lane;
#pragma unroll
            for (int j = 0; j < 8; ++j) v[u][j] = xr[64 * j]; }
        if (MODE & 1) {
#pragma unroll
            for (int u = 0; u < NR; ++u) {
                const int* ti = (const int*)(ws + WS_TINFO) + (size_t)rw[u] * 4;
                const int e0 = ti[0], p0 = ti[1], e1 = ti[2], p1 = ti[3];
                const size_t s0 = (size_t)tp[e0] * 256 + p0, s1 = (size_t)tp[e1] * 256 + p1;
                const u32x2* y0 = (const u32x2*)((const bf16*)(ws + SC_YBUF) + s0 * DM) + F.lane; const u32x2* y1 = (const u32x2*)((const bf16*)(ws + SC_YBUF) + s1 * DM) + F.lane;
#pragma unroll
                for (int j = 0; j < 8; ++j) { const u32x2 a0 = y0[64 * j], a1 = y1[64 * j];
                    v[u][j].x += __uint_as_float(a0.x << 16) + __uint_as_float(a1.x << 16); v[u][j].y += __uint_as_float(a0.x & 0xffff0000u) + __uint_as_float(a1.x & 0xffff0000u);
                    v[u][j].z += __uint_as_float(a0.y << 16) + __uint_as_float(a1.y << 16); v[u][j].w += __uint_as_float(a0.y & 0xffff0000u) + __uint_as_float(a1.y & 0xffff0000u); }
                if (!(MODE & 4) && (u == 0 || row0 + u * NGW < NTOK)) { f32x4* hr = (f32x4*)(H + (size_t)rw[u] * DM) + F.lane;
#pragma unroll
                    for (int j = 0; j < 8; ++j) hr[64 * j] = v[u][j]; } }
        }
        float rstd[NR];
#pragma unroll
        for (int u = 0; u < NR; ++u) { float s = 0.f;
#pragma unroll
            for (int j = 0; j < 8; ++j) s += (v[u][j].x * v[u][j].x + v[u][j].y * v[u][j].y) + (v[u][j].z * v[u][j].z + v[u][j].w * v[u][j].w);
            rstd[u] = 1.f / sqrtf(wave_sum(s) * (1.f / DM) + RMS_EPS); }
#pragma unroll
        for (int j = 0; j < 8; ++j) { const f32x4 gv = gr[64 * j];
#pragma unroll
            for (int u = 0; u < NR; ++u) { v[u][j].x *= rstd[u] * gv.x; v[u][j].y *= rstd[u] * gv.y; v[u][j].z *= rstd[u] * gv.z; v[u][j].w *= rstd[u] * gv.w; } }
#pragma unroll
        for (int u = 0; u < NR; ++u) { if (u > 0 && !(row0 + u * NGW < NTOK)) continue;
            if (MODE & 4) { f32x4* orow = (f32x4*)(a->out + (size_t)rw[u] * DM) + F.lane;
#pragma unroll
                for (int j = 0; j < 8; ++j) orow[64 * j] = v[u][j]; }
            else { u32x2* o8 = (u32x2*)(HN + (size_t)rw[u] * DM) + F.lane;
#pragma unroll
                for (int j = 0; j < 8; ++j) { u32x2 w; w.x = pk2(v[u][j].x, v[u][j].y); w.y = pk2(v[u][j].z, v[u][j].w); o8[64 * j] = w; } } }
        if (MODE & 2) {
            const float* wg = a->in[I_ROUTER_GROUP] + (size_t)layer * DM * 4;
            float lg[NR][4];
#pragma unroll
            for (int u = 0; u < NR; ++u) { lg[u][0] = lg[u][1] = lg[u][2] = lg[u][3] = 0.f; }
#pragma unroll 2
            for (int j = 0; j < 8; ++j) { const int k0 = (64 * j + F.lane) * 4;
#pragma unroll
                for (int q = 0; q < 4; ++q) { const f32x4 w4 = *(const f32x4*)(wg + (size_t)(k0 + q) * 4);
#pragma unroll
                    for (int u = 0; u < NR; ++u) { const float x = v[u][j][q]; lg[u][0] += x * w4.x; lg[u][1] += x * w4.y; lg[u][2] += x * w4.z; lg[u][3] += x * w4.w; } } }
            int gi[NR]; float gw_[NR];
#pragma unroll
            for (int u = 0; u < NR; ++u) {
#pragma unroll
                for (int q = 0; q < 4; ++q) lg[u][q] = wave_sum(lg[u][q]);
                gi[u] = 0; float gm = lg[u][0];
#pragma unroll
                for (int q = 1; q < 4; ++q) if (lg[u][q] > gm) { gm = lg[u][q]; gi[u] = q; }
                gw_[u] = 1.f / (__expf(lg[u][0] - gm) + __expf(lg[u][1] - gm) + __expf(lg[u][2] - gm) + __expf(lg[u][3] - gm)); }
            float le[NR][8];
#pragma unroll
            for (int u = 0; u < NR; ++u) {
#pragma unroll
                for (int q = 0; q < 8; ++q) le[u][q] = 0.f; }
#pragma unroll
            for (int u = 0; u < NR; ++u) { const float* we = (const float*)(ws + WS_RTE) + ((size_t)layer * 4 + gi[u]) * DM * 8;
#pragma unroll 2
                for (int j = 0; j < 8; ++j) { const int k0 = (64 * j + F.lane) * 4;
#pragma unroll
                    for (int q = 0; q < 4; ++q) { const float* wp = we + (size_t)(k0 + q) * 8; const f32x4 wa = *(const f32x4*)wp, wb = *(const f32x4*)(wp + 4); const float x = v[u][j][q];
                        le[u][0] += x * wa.x; le[u][1] += x * wa.y; le[u][2] += x * wa.z; le[u][3] += x * wa.w; le[u][4] += x * wb.x; le[u][5] += x * wb.y; le[u][6] += x * wb.z; le[u][7] += x * wb.w; } } }
#pragma unroll
            for (int u = 0; u < NR; ++u) {
#pragma unroll
                for (int q = 0; q < 8; ++q) le[u][q] = wave_sum(le[u][q]);
                int i0 = 0; float m0 = le[u][0];
#pragma unroll
                for (int q = 1; q < 8; ++q) if (le[u][q] > m0) { m0 = le[u][q]; i0 = q; }
                int i1 = -1; float m1 = -3.0e38f;
#pragma unroll
                for (int q = 0; q < 8; ++q) if (q != i0 && le[u][q] > m1) { m1 = le[u][q]; i1 = q; }
                const float t = __expf(m1 - m0); const float w0 = 1.f / (1.f + t), w1 = t / (1.f + t);
                if (F.lane == 0 && (u == 0 || row0 + u * NGW < NTOK)) {
                    if (pend) { int* et = (int*)(ws + WS_ETOK); float* eg = (float*)(ws + WS_EGATE); int* ti = (int*)(ws + WS_TINFO) + (size_t)prow * 4;
                        et[(size_t)pe0 * ECAP + pp0] = prow; eg[(size_t)pe0 * ECAP + pp0] = pg0; et[(size_t)pe1 * ECAP + pp1] = prow; eg[(size_t)pe1 * ECAP + pp1] = pg1;
                        ti[0] = pe0; ti[1] = pp0; ti[2] = pe1; ti[3] = pp1; }
                    prow = rw[u]; pe0 = gi[u] * 8 + i0; pe1 = gi[u] * 8 + i1; pg0 = gw_[u] * w0; pg1 = gw_[u] * w1; pend = 1;
                    pp0 = (int)__hip_atomic_fetch_add(F.ctl + CW_CNT + (layer * 32 + pe0) * 64, 1u, __ATOMIC_RELAXED, __HIP_MEMORY_SCOPE_AGENT);
                    pp1 = (int)__hip_atomic_fetch_add(F.ctl + CW_CNT + (layer * 32 + pe1) * 64, 1u, __ATOMIC_RELAXED, __HIP_MEMORY_SCOPE_AGENT);
                } }
        }
    }
    if ((MODE & 2) && F.lane == 0 && pend) { int* et = (int*)(ws + WS_ETOK); float* eg = (float*)(ws + WS_EGATE); int* ti = (int*)(ws + WS_TINFO) + (size_t)prow * 4;
        et[(size_t)pe0 * ECAP + pp0] = prow; eg[(size_t)pe0 * ECAP + pp0] = pg0; et[(size_t)pe1 * ECAP + pp1] = prow; eg[(size_t)pe1 * ECAP + pp1] = pg1;
        ti[0] = pe0; ti[1] = pp0; ti[2] = pe1; ti[3] = pp1; }
}

__device__ __forceinline__ void rope8(bf16* p1, bf16* p2, const float* cs, const float* sn) {
    const u32x4 a = *(const u32x4*)p1, b = *(const u32x4*)p2; const f32x4 c0 = *(const f32x4*)cs, c1 = *(const f32x4*)(cs + 4), s0 = *(const f32x4*)sn, s1 = *(const f32x4*)(sn + 4);
    const float x1[8] = {__uint_as_float(a.x << 16), __uint_as_float(a.x & 0xffff0000u), __uint_as_float(a.y << 16), __uint_as_float(a.y & 0xffff0000u), __uint_as_float(a.z << 16), __uint_as_float(a.z & 0xffff0000u), __uint_as_float(a.w << 16), __uint_as_float(a.w & 0xffff0000u)};
    const float x2[8] = {__uint_as_float(b.x << 16), __uint_as_float(b.x & 0xffff0000u), __uint_as_float(b.y << 16), __uint_as_float(b.y & 0xffff0000u), __uint_as_float(b.z << 16), __uint_as_float(b.z & 0xffff0000u), __uint_as_float(b.w << 16), __uint_as_float(b.w & 0xffff0000u)};
    const float cc[8] = {c0[0], c0[1], c0[2], c0[3], c1[0], c1[1], c1[2], c1[3]}, ss[8] = {s0[0], s0[1], s0[2], s0[3], s1[0], s1[1], s1[2], s1[3]};
    float o1[8], o2[8];
#pragma unroll
    for (int i = 0; i < 8; ++i) { o1[i] = x1[i] * cc[i] - x2[i] * ss[i]; o2[i] = x2[i] * cc[i] + x1[i] * ss[i]; }
    *(u32x4*)p1 = (u32x4){pk2(o1[0], o1[1]), pk2(o1[2], o1[3]), pk2(o1[4], o1[5]), pk2(o1[6], o1[7])};
    *(u32x4*)p2 = (u32x4){pk2(o2[0], o2[1]), pk2(o2[2], o2[3]), pk2(o2[4], o2[5]), pk2(o2[6], o2[7])};
}
__device__ __forceinline__ void rope_token(Frame& F, bf16* zrow, int s) {
    const float* cosA = (const float*)(F.ws + WS_ROPE); const float* sinA = cosA + SEQ * 32; const float* cosC = sinA + SEQ * 32; const float* sinC = cosC + SEQ * 64;
    { const int blk = F.lane >> 2, pc = F.lane & 3; bf16* p = zrow + ZA + blk * 64 + pc * 8; rope8(p, p + 32, cosA + s * 32 + pc * 8, sinA + s * 32 + pc * 8); }
    { const int blk = F.lane >> 3, pc = F.lane & 7; bf16* p = zrow + ZC + blk * 128 + pc * 8; rope8(p, p + 64, cosC + s * 64 + pc * 8, sinC + s * 64 + pc * 8); }
}

constexpr int RWT = 16;
__device__ __forceinline__ float zs_ld(const LAS unsigned short* zr, const float* mu, int t, int col) {
    const float z0 = bf2f(zr[(t + 1) * IN_B + col]), zp = bf2f(zr[t * IN_B + col]), zn = bf2f(zr[(t + 2) * IN_B + col]);
    return z0 + mu[col] * (zp - z0) + mu[IN_B + col] * (zn - z0);
}
__device__ __forceinline__ void rwkv_prep_tile(Frame& F, ArgsP a, int layer, int tile) {
    unsigned char* ws = F.ws; const bf16* Z = (const bf16*)(ws + SC_Z);
    LAS unsigned short* zr = (LAS unsigned short*)F.lds; LAS unsigned short* act = zr + (RWT + 2) * IN_B;
    const int t0 = tile * RWT; const int b = t0 / SEQ, s0 = t0 % SEQ;
    __syncthreads();
#pragma unroll 1
    for (int i = F.tid; i < (RWT + 2) * (IN_B / 8); i += 512) { const int rr = i / (IN_B / 8), c8 = i % (IN_B / 8); const int s = s0 - 1 + rr;
        u32x4 w = {0u, 0u, 0u, 0u};
        if (s >= 0 && s < SEQ) w = *(const u32x4*)(Z + (size_t)(b * SEQ + s) * ZLD + ZB + c8 * 8);
        *(LAS u32x4*)(zr + rr * IN_B + c8 * 8) = w; }
    __syncthreads();
    const float* mu = a->in[I_RWKV_MU] + (size_t)layer * 2 * IN_B;
#pragma unroll 1
    for (int i = F.tid; i < RWT * 384; i += 512) { const int t = i / 384, j = i % 384; const float x = zs_ld(zr, mu, t, 1536 + j);
        act[t * 392 + j] = f2bf((j < 128) ? tanhf(x) : ((j < 256) ? x : sigmoidf_(x))); }
    __syncthreads();
    const int lane = F.lane, r = lane & 15, g = lane >> 4, hd = F.wave;
    const bf16* lw = (const bf16*)(ws + WS_LORA + layer * LORA_LAYER);
    bf16x8 af[12];
#pragma unroll
    for (int ks = 0; ks < 12; ++ks) af[ks] = *(const LAS bf16x8*)(act + r * 392 + ks * 32 + g * 8);
    float* RW = (float*)(ws + SC_RW); const size_t N1 = (size_t)NTOK * 512;
    f32x4 dw0[4], dw1[4], da0[4], da1[4], dg[4];
#pragma unroll
    for (int nt = 0; nt < 4; ++nt) { const int c = hd * 64 + nt * 16 + r;
        bf16x8 bw[12];
#pragma unroll
        for (int ks = 0; ks < 2; ++ks) { bw[ks] = *(const bf16x8*)(lw + ((size_t)0 * 512 + c) * 64 + ks * 32 + g * 8); bw[2 + ks] = *(const bf16x8*)(lw + ((size_t)1 * 512 + c) * 64 + ks * 32 + g * 8);
            bw[4 + ks] = *(const bf16x8*)(lw + ((size_t)2 * 512 + c) * 64 + ks * 32 + g * 8); bw[6 + ks] = *(const bf16x8*)(lw + ((size_t)3 * 512 + c) * 64 + ks * 32 + g * 8); }
#pragma unroll
        for (int ks = 0; ks < 4; ++ks) bw[8 + ks] = *(const bf16x8*)(lw + (size_t)4 * 512 * 64 + (size_t)c * 128 + ks * 32 + g * 8);
        f32x4 z4 = {0.f, 0.f, 0.f, 0.f};
        dw0[nt] = __builtin_amdgcn_mfma_f32_16x16x32_bf16(af[0], bw[0], z4, 0, 0, 0); dw0[nt] = __builtin_amdgcn_mfma_f32_16x16x32_bf16(af[1], bw[1], dw0[nt], 0, 0, 0);
        dw1[nt] = __builtin_amdgcn_mfma_f32_16x16x32_bf16(af[2], bw[2], z4, 0, 0, 0); dw1[nt] = __builtin_amdgcn_mfma_f32_16x16x32_bf16(af[3], bw[3], dw1[nt], 0, 0, 0);
        da0[nt] = __builtin_amdgcn_mfma_f32_16x16x32_bf16(af[4], bw[4], z4, 0, 0, 0); da0[nt] = __builtin_amdgcn_mfma_f32_16x16x32_bf16(af[5], bw[5], da0[nt], 0, 0, 0);
        da1[nt] = __builtin_amdgcn_mfma_f32_16x16x32_bf16(af[6], bw[6], z4, 0, 0, 0); da1[nt] = __builtin_amdgcn_mfma_f32_16x16x32_bf16(af[7], bw[7], da1[nt], 0, 0, 0);
        dg[nt] = __builtin_amdgcn_mfma_f32_16x16x32_bf16(af[8], bw[8], z4, 0, 0, 0); dg[nt] = __builtin_amdgcn_mfma_f32_16x16x32_bf16(af[9], bw[9], dg[nt], 0, 0, 0);
        dg[nt] = __builtin_amdgcn_mfma_f32_16x16x32_bf16(af[10], bw[10], dg[nt], 0, 0, 0); dg[nt] = __builtin_amdgcn_mfma_f32_16x16x32_bf16(af[11], bw[11], dg[nt], 0, 0, 0);
    }
    float w00[4], w01[4], a00[4], a01[4], kkw[4], kaw[4];
#pragma unroll
    for (int nt = 0; nt < 4; ++nt) { const int c = hd * 64 + nt * 16 + r;
        w00[nt] = a->in[I_RWKV_W0][(size_t)layer * 1024 + c]; w01[nt] = a->in[I_RWKV_W0][(size_t)layer * 1024 + 512 + c];
        a00[nt] = a->in[I_RWKV_A0][(size_t)layer * 1024 + c]; a01[nt] = a->in[I_RWKV_A0][(size_t)layer * 1024 + 512 + c];
        kkw[nt] = a->in[I_RWKV_KK][(size_t)layer * 512 + c]; kaw[nt] = a->in[I_RWKV_KA][(size_t)layer * 512 + c]; }
#pragma unroll
    for (int q = 0; q < 4; ++q) { const int t = 4 * g + q;
        float k_[4], kk[4]; float ssq = 0.f;
#pragma unroll
        for (int nt = 0; nt < 4; ++nt) { const int c = hd * 64 + nt * 16 + r; k_[nt] = zs_ld(zr, mu, t, 512 + c); kk[nt] = k_[nt] * kkw[nt]; ssq += kk[nt] * kk[nt]; }
        ssq = row_sum(ssq);
        const float rn = 1.f / sqrtf(ssq + 1e-12f);
#pragma unroll
        for (int nt = 0; nt < 4; ++nt) { const int c = hd * 64 + nt * 16 + r;
            const float r_ = zs_ld(zr, mu, t, c), v_ = zs_ld(zr, mu, t, 1024 + c);
            const float x0 = -(w00[nt] + dw0[nt][q]), x1 = -(w01[nt] + dw1[nt][q]);
            const float sp0 = fmaxf(x0, 0.f) + __logf(1.f + __expf(-fabsf(x0))), sp1 = fmaxf(x1, 0.f) + __logf(1.f + __expf(-fabsf(x1)));
            const float d0 = -__expf(-sp0 - 0.5f), d1 = -__expf(-sp1 - 0.5f);
            const float al0 = sigmoidf_(a00[nt] + da0[nt][q]), al1 = sigmoidf_(a01[nt] + da1[nt][q]);
            const float kn = kk[nt] * rn;
            const float km0 = k_[nt] * (1.f + (al0 - 1.f) * kaw[nt]), km1 = k_[nt] * (1.f + (al1 - 1.f) * kaw[nt]);
            const size_t o = (size_t)(t0 + t) * 512 + c;
            RW[0 * N1 + o] = r_; RW[1 * N1 + o] = v_; RW[2 * N1 + o] = kn; RW[3 * N1 + o] = d0; RW[4 * N1 + o] = d1;
            RW[5 * N1 + o] = km0; RW[6 * N1 + o] = km1; RW[7 * N1 + o] = kn * al0; RW[8 * N1 + o] = kn * al1; RW[9 * N1 + o] = dg[nt][q]; }
    }
}

constexpr size_t SC_S5E = SC_MIX_END + (size_t)32 * 256 * 11520;
constexpr size_t SC_MIX_END3 = SC_S5E + (size_t)2 * BATCH * 16 * 32 * 64 * 2 * 4;
template <int LEVEL>
__device__ __forceinline__ void s5_block_task(Frame& F, int layer, int task, LAS float* ul) {
    unsigned char* ws = F.ws; const bf16* Z = (const bf16*)(ws + SC_Z);
    const int blk = task & 15, dir = (task >> 4) & 1, g = (task >> 5) & 31, b = task >> 10; const int n = F.lane;
    const float* ab = (const float*)(ws + WS_S5P + layer * S5P_LAYER); const float* bb = ab + 2 * 32 * 64 * 2; const float* ab256 = bb + 2 * 32 * 64 * 16 * 2;
    const int pr = (dir * 32 + g) * 64 + n;
    const float abr = ab[pr * 2], abi = ab[pr * 2 + 1];
    float bbr[16], bbi[16];
#pragma unroll
    for (int c = 0; c < 16; ++c) { bbr[c] = bb[((size_t)pr * 16 + c) * 2]; bbi[c] = bb[((size_t)pr * 16 + c) * 2 + 1]; }
    float* E = (float*)(ws + SC_S5E);
    float xr = 0.f, xi = 0.f;
    if (LEVEL == 2) { const float pr_ = ab256[pr * 2], pi_ = ab256[pr * 2 + 1];
        for (int k = 0; k < blk; ++k) { const float* ep = E + ((((size_t)dir * BATCH + b) * 16 + k) * 32 + g) * 128 + n * 2; const float er = ep[0], ei = ep[1];
            const float nr = pr_ * xr - pi_ * xi + er, ni = pr_ * xi + pi_ * xr + ei; xr = nr; xi = ni; } }
    float* carry = (float*)(ws + SC_CARRY);
    for (int q4 = 0; q4 < 4; ++q4) {
        { const int st = blk * 256 + q4 * 64 + n; const int sl = dir ? (SEQ - 1 - st) : st; const bf16* zp = Z + (size_t)(b * SEQ + sl) * ZLD + ZD + g * 16;
          const u32x4 w0 = *(const u32x4*)zp, w1 = *(const u32x4*)(zp + 8);
          LAS f32x4* d = (LAS f32x4*)(ul + n * 16);
          d[0] = (f32x4){__uint_as_float(w0.x << 16), __uint_as_float(w0.x & 0xffff0000u), __uint_as_float(w0.y << 16), __uint_as_float(w0.y & 0xffff0000u)};
          d[1] = (f32x4){__uint_as_float(w0.z << 16), __uint_as_float(w0.z & 0xffff0000u), __uint_as_float(w0.w << 16), __uint_as_float(w0.w & 0xffff0000u)};
          d[2] = (f32x4){__uint_as_float(w1.x << 16), __uint_as_float(w1.x & 0xffff0000u), __uint_as_float(w1.y << 16), __uint_as_float(w1.y & 0xffff0000u)};
          d[3] = (f32x4){__uint_as_float(w1.z << 16), __uint_as_float(w1.z & 0xffff0000u), __uint_as_float(w1.w << 16), __uint_as_float(w1.w & 0xffff0000u)}; }
        LDS_WAIT(); asm volatile("" ::: "memory");
#pragma unroll 4
        for (int i = 0; i < 64; ++i) {
            const int step = blk * 256 + q4 * 64 + i;
            if (LEVEL == 2 && (step & (S5CH - 1)) == 0) { const int sl = dir ? (SEQ - 1 - step) : step; const int ch = sl / S5CH;
                float* cp = carry + ((((size_t)dir * BATCH + b) * S5NCH + ch) * 32 + g) * 128 + n * 2; cp[0] = xr; cp[1] = xi; }
            const f32x4 u0 = *(const LAS f32x4*)(ul + i * 16), u1 = *(const LAS f32x4*)(ul + i * 16 + 4), u2 = *(const LAS f32x4*)(ul + i * 16 + 8), u3 = *(const LAS f32x4*)(ul + i * 16 + 12);
            float br = 0.f, bi = 0.f;
#pragma unroll
            for (int c = 0; c < 4; ++c) { br += bbr[c] * u0[c] + bbr[4 + c] * u1[c] + bbr[8 + c] * u2[c] + bbr[12 + c] * u3[c]; bi += bbi[c] * u0[c] + bbi[4 + c] * u1[c] + bbi[8 + c] * u2[c] + bbi[12 + c] * u3[c]; }
            const float nr = abr * xr - abi * xi + br, ni = abr * xi + abi * xr + bi; xr = nr; xi = ni;
        }
        asm volatile("" ::: "memory");
    }
    if (LEVEL == 1) { float* ep = E + ((((size_t)dir * BATCH + b) * 16 + blk) * 32 + g) * 128 + n * 2; ep[0] = xr; ep[1] = xi; }
}

__device__ __forceinline__ void prep_phase(Frame& F, ArgsP a, int layer, const int rep) {
    const int qb_ = (rep * 2 + layer) * 8;
#ifndef DBG_PREPMASK
#define DBG_PREPMASK 7
#endif
    if (DBG_PREPMASK & 1) for (;;) { const int it = q_next(F, qb_ + 0); if (it >= 256) break; s5_block_task<1>(F, layer, it * 8 + F.wave, (LAS float*)(F.lds + F.wave * 4096)); }
    if (DBG_PREPMASK & 2) for (;;) { const int it = q_next(F, qb_ + 5); if (it >= NTOK / RWT) break; rwkv_prep_tile(F, a, layer, it); }
    if ((DBG_PREPMASK & 4) && rep == 0) for (;;) { const int r = q_next(F, qb_ + 6); if (r >= NTOK / 64) break;
        for (int k = 0; k < 8; ++k) { const int tok = r * 64 + F.wave * 8 + k; rope_token(F, (bf16*)(F.ws + SC_Z) + (size_t)tok * ZLD, tok % SEQ); } }
}

constexpr int CR_TA = 0, CR_GH = 2048, CR_WBK = 4096, CR_TM = 8192, CR_N = 8704, CR_V = 9216, CR_WL = 11264, CR_BYTES = 11520;
constexpr size_t SC_CREC = SC_MIX_END;
constexpr size_t SC_MIX_END2 = SC_CREC + (size_t)32 * 256 * CR_BYTES;
static_assert(SC_MIX_END2 <= 1140000000ull, "workspace budget");

__device__ __forceinline__ void mm16(const LAS float* A, const LAS float* B, int t, int sq, float (&out)[4]) {
    out[0] = out[1] = out[2] = out[3] = 0.f;
#pragma unroll
    for (int s4 = 0; s4 < 4; ++s4) { const f32x4 a4 = *(const LAS f32x4*)(A + t * 16 + s4 * 4);
#pragma unroll
        for (int q = 0; q < 4; ++q) { const f32x4 b4 = *(const LAS f32x4*)(B + (s4 * 4 + q) * 16 + sq * 4); const float av = a4[q];
            out[0] += av * b4[0]; out[1] += av * b4[1]; out[2] += av * b4[2]; out[3] += av * b4[3]; } }
}
__device__ __forceinline__ void st16(LAS float* M, int t, int sq, const float (&v)[4]) { *(LAS f32x4*)(M + t * 16 + sq * 4) = (f32x4){v[0], v[1], v[2], v[3]}; }

__device__ __forceinline__ void rwkv_cprep_item(Frame& F, int chain, int c, LAS float* Lw) {
    unsigned char* ws = F.ws; const float* RW = (const float*)(ws + SC_RW); const size_t N1 = (size_t)NTOK * 512;
    const int dir = chain & 1, h = (chain >> 1) & 7, b = chain >> 4; const int lane = F.lane;
    const float* Rp = RW; const float* Vp = RW + N1; const float* KKp = RW + 2 * N1; const float* LDp = RW + (3 + dir) * N1; const float* KMp = RW + (5 + dir) * N1; const float* BBp = RW + (7 + dir) * N1;
    constexpr int RS = 68;
    LAS float* At = Lw; LAS float* Bt = Lw + 16 * RS; LAS float* Kt = Lw + 32 * RS; LAS float* mat = Lw + 48 * RS;
    float at[16], rt[16], wb[16], wk[16];
    { float lw = 0.f, lwi[16], bb[16], km[16];
#pragma unroll
      for (int t = 0; t < 16; ++t) { const int pos = dir ? (SEQ - 1 - 16 * c - t) : (16 * c + t); const size_t idx = (size_t)(b * SEQ + pos) * 512 + h * 64 + lane;
          const float r_ = Rp[idx], ld = LDp[idx], a_ = -KKp[idx]; km[t] = KMp[idx]; bb[t] = BBp[idx];
          at[t] = a_ * __expf(lw); lw += ld; lwi[t] = lw; rt[t] = r_ * __expf(lw);
          const float iw = __expf(-lw); At[t * RS + lane] = at[t]; Bt[t * RS + lane] = bb[t] * iw; Kt[t * RS + lane] = km[t] * iw; }
#pragma unroll
      for (int t = 0; t < 16; ++t) { const float e = __expf(lw - lwi[t]); wb[t] = bb[t] * e; wk[t] = km[t] * e; }
      float* rec = (float*)(ws + SC_CREC + ((size_t)chain * 256 + c) * CR_BYTES + CR_WL); rec[lane] = __expf(lw); }
    LDS_WAIT(); asm volatile("" ::: "memory");
    const int t = lane >> 2, sq = lane & 3;
    float mab[4] = {0.f, 0.f, 0.f, 0.f}, mak[4] = {0.f, 0.f, 0.f, 0.f}, mrb[4] = {0.f, 0.f, 0.f, 0.f}, mrk[4] = {0.f, 0.f, 0.f, 0.f};
#pragma unroll 4
    for (int j = 0; j < 64; j += 4) { const f32x4 a4 = *(const LAS f32x4*)(At + t * RS + j);
#pragma unroll
        for (int e = 0; e < 4; ++e) { const f32x4 b4 = *(const LAS f32x4*)(Bt + (sq * 4 + e) * RS + j), k4 = *(const LAS f32x4*)(Kt + (sq * 4 + e) * RS + j);
            mab[e] += a4[0] * b4[0] + a4[1] * b4[1] + a4[2] * b4[2] + a4[3] * b4[3]; mak[e] += a4[0] * k4[0] + a4[1] * k4[1] + a4[2] * k4[2] + a4[3] * k4[3]; } }
    asm volatile("" ::: "memory");
#pragma unroll
    for (int tt = 0; tt < 16; ++tt) At[tt * RS + lane] = rt[tt];
    LDS_WAIT(); asm volatile("" ::: "memory");
#pragma unroll 4
    for (int j = 0; j < 64; j += 4) { const f32x4 a4 = *(const LAS f32x4*)(At + t * RS + j);
#pragma unroll
        for (int e = 0; e < 4; ++e) { const f32x4 b4 = *(const LAS f32x4*)(Bt + (sq * 4 + e) * RS + j), k4 = *(const LAS f32x4*)(Kt + (sq * 4 + e) * RS + j);
            mrb[e] += a4[0] * b4[0] + a4[1] * b4[1] + a4[2] * b4[2] + a4[3] * b4[3]; mrk[e] += a4[0] * k4[0] + a4[1] * k4[1] + a4[2] * k4[2] + a4[3] * k4[3]; } }
#pragma unroll
    for (int e = 0; e < 4; ++e) { const int s = sq * 4 + e; if (s >= t) { mab[e] = 0.f; mak[e] = 0.f; } if (s > t) { mrb[e] = 0.f; mrk[e] = 0.f; } }
    LAS float* m0 = mat; LAS float* m1 = mat + 256; LAS float* m2 = mat + 512; LAS float* m3 = mat + 768;
    float T[4], P[4], Q[4];
    st16(m0, t, sq, mab); LDS_WAIT(); asm volatile("" ::: "memory");
#pragma unroll
    for (int e = 0; e < 4; ++e) T[e] = mab[e] + ((sq * 4 + e) == t ? 1.f : 0.f);
    mm16(m0, m0, t, sq, P);
    st16(m1, t, sq, P); st16(m2, t, sq, T); LDS_WAIT(); asm volatile("" ::: "memory");
    mm16(m2, m1, t, sq, Q);
#pragma unroll
    for (int e = 0; e < 4; ++e) T[e] += Q[e];
    mm16(m1, m1, t, sq, P);
    asm volatile("" ::: "memory");
    st16(m0, t, sq, P); st16(m2, t, sq, T); LDS_WAIT(); asm volatile("" ::: "memory");
    mm16(m2, m0, t, sq, Q);
#pragma unroll
    for (int e = 0; e < 4; ++e) T[e] += Q[e];
    mm16(m0, m0, t, sq, P);
    asm volatile("" ::: "memory");
    st16(m1, t, sq, P); st16(m2, t, sq, T); LDS_WAIT(); asm volatile("" ::: "memory");
    mm16(m2, m1, t, sq, Q);
#pragma unroll
    for (int e = 0; e < 4; ++e) T[e] += Q[e];
    asm volatile("" ::: "memory");
    st16(m2, t, sq, T); st16(m0, t, sq, mrb); st16(m1, t, sq, mak); LDS_WAIT(); asm volatile("" ::: "memory");
    float P1[4], TM[4], Nn[4];
    mm16(m0, m2, t, sq, P1); mm16(m2, m1, t, sq, TM);
    st16(m3, t, sq, P1); LDS_WAIT(); asm volatile("" ::: "memory");
    mm16(m3, m1, t, sq, Nn);
#pragma unroll
    for (int e = 0; e < 4; ++e) Nn[e] += mrk[e];
    unsigned char* rec = ws + SC_CREC + ((size_t)chain * 256 + c) * CR_BYTES;
    { u32x2 w; w.x = pk2(TM[0], TM[1]); w.y = pk2(TM[2], TM[3]); *(u32x2*)(rec + CR_TM + (16 * sq + t) * 8) = w;
      w.x = pk2(Nn[0], Nn[1]); w.y = pk2(Nn[2], Nn[3]); *(u32x2*)(rec + CR_N + (16 * sq + t) * 8) = w; }
    LAS unsigned short* TAh = (LAS unsigned short*)Bt; LAS unsigned short* GHh = TAh + 1024;
#pragma unroll
    for (int tt = 0; tt < 16; ++tt) { float ta = 0.f, gh = rt[tt];
#pragma unroll
        for (int s4 = 0; s4 < 4; ++s4) { const f32x4 t4 = *(const LAS f32x4*)(m2 + tt * 16 + s4 * 4), p4 = *(const LAS f32x4*)(m3 + tt * 16 + s4 * 4);
            ta += t4[0] * at[s4 * 4] + t4[1] * at[s4 * 4 + 1] + t4[2] * at[s4 * 4 + 2] + t4[3] * at[s4 * 4 + 3];
            gh += p4[0] * at[s4 * 4] + p4[1] * at[s4 * 4 + 1] + p4[2] * at[s4 * 4 + 2] + p4[3] * at[s4 * 4 + 3]; }
        TAh[tt * 64 + lane] = f2bf(ta); GHh[tt * 64 + lane] = f2bf(gh); }
    LDS_WAIT(); asm volatile("" ::: "memory");
    { const int r = lane & 15, g = lane >> 4;
#pragma unroll
      for (int ks = 0; ks < 2; ++ks) { const u32x2 a0 = *(const LAS u32x2*)(TAh + r * 64 + 32 * ks + 4 * g), a1 = *(const LAS u32x2*)(TAh + r * 64 + 32 * ks + 16 + 4 * g);
          *(u32x4*)(rec + CR_TA + (ks * 64 + lane) * 16) = (u32x4){a0.x, a0.y, a1.x, a1.y};
          const u32x2 g0 = *(const LAS u32x2*)(GHh + r * 64 + 32 * ks + 4 * g), g1 = *(const LAS u32x2*)(GHh + r * 64 + 32 * ks + 16 + 4 * g);
          *(u32x4*)(rec + CR_GH + (ks * 64 + lane) * 16) = (u32x4){g0.x, g0.y, g1.x, g1.y}; } }
    { const int jb = lane >> 4, r = lane & 15; float vv[16];
#pragma unroll
      for (int tt = 0; tt < 16; ++tt) { const int pos = dir ? (SEQ - 1 - 16 * c - tt) : (16 * c + tt); vv[tt] = Vp[(size_t)(b * SEQ + pos) * 512 + h * 64 + lane]; }
#pragma unroll
      for (int g = 0; g < 4; ++g) { u32x4 w; w.x = pk2(wb[4 * g], wb[4 * g + 1]); w.y = pk2(wb[4 * g + 2], wb[4 * g + 3]); w.z = pk2(wk[4 * g], wk[4 * g + 1]); w.w = pk2(wk[4 * g + 2], wk[4 * g + 3]);
          *(u32x4*)(rec + CR_WBK + (jb * 64 + 16 * g + r) * 16) = w;
          u32x2 x; x.x = pk2(vv[4 * g], vv[4 * g + 1]); x.y = pk2(vv[4 * g + 2], vv[4 * g + 3]); *(u32x2*)(rec + CR_V + (jb * 64 + 16 * g + r) * 8) = x; } }
    LDS_WAIT(); asm volatile("" ::: "memory");
}

__device__ __forceinline__ void cprep_phase(Frame& F, int layer) {
    LAS float* Lw = (LAS float*)(F.lds + F.wave * 17408);
    for (int it = F.bid * 8 + F.wave; it < 32 * 256; it += F.G * 8) { const int c = it >> 5, chain = it & 31; rwkv_cprep_item(F, chain, c, Lw); }
    asm volatile("" ::: "memory");
    for (int it = F.bid * 8 + F.wave; it < 2048; it += F.G * 8) s5_block_task<2>(F, layer, it, Lw);
}

template <class P, class T> struct RwPtr { typedef const T* type; };
template <class T> struct RwPtr<const LAS unsigned char*, T> { typedef const LAS T* type; };
struct RwOps { bf16x8 ta[2], gh[2], wbk[4]; u32x2 tm, nn, vq[2]; f32x4 wl[4]; };
template <class P> __device__ __forceinline__ void rw_load(RwOps& o, P rec, int lane, int half) {
    const int g = lane >> 4;
#pragma unroll
    for (int ks = 0; ks < 2; ++ks) { o.ta[ks] = *(const typename RwPtr<P, bf16x8>::type)(rec + CR_TA + (ks * 64 + lane) * 16); o.gh[ks] = *(const typename RwPtr<P, bf16x8>::type)(rec + CR_GH + (ks * 64 + lane) * 16); }
#pragma unroll
    for (int jb = 0; jb < 4; ++jb) { o.wbk[jb] = *(const typename RwPtr<P, bf16x8>::type)(rec + CR_WBK + (jb * 64 + lane) * 16); o.wl[jb] = *(const typename RwPtr<P, f32x4>::type)(rec + CR_WL + (jb * 16 + g * 4) * 4); }
    o.tm = *(const typename RwPtr<P, u32x2>::type)(rec + CR_TM + lane * 8); o.nn = *(const typename RwPtr<P, u32x2>::type)(rec + CR_N + lane * 8);
#pragma unroll
    for (int it = 0; it < 2; ++it) o.vq[it] = *(const typename RwPtr<P, u32x2>::type)(rec + CR_V + ((half * 2 + it) * 64 + lane) * 8);
}
__device__ __forceinline__ bf16x8 mk8(unsigned a, unsigned b, unsigned c, unsigned d) { u32x4 w = {a, b, c, d}; return *reinterpret_cast<bf16x8*>(&w); }
__device__ __forceinline__ void rw_step(const RwOps& o, f32x4 (&X)[4][2], float* ysb, const long rs, int lane) {
    const int r = lane & 15, g = lane >> 4;
    const bf16x8 tmf = mk8(o.tm.x, o.tm.y, 0u, 0u), nf = mk8(o.nn.x, o.nn.y, 0u, 0u);
#pragma unroll
    for (int it = 0; it < 2; ++it) {
        bf16x8 xb[2];
#pragma unroll
        for (int ks = 0; ks < 2; ++ks) xb[ks] = mk8(pk2c(X[2 * ks][it][0], X[2 * ks][it][1]), pk2c(X[2 * ks][it][2], X[2 * ks][it][3]), pk2c(X[2 * ks + 1][it][0], X[2 * ks + 1][it][1]), pk2c(X[2 * ks + 1][it][2], X[2 * ks + 1][it][3]));
        const bf16x8 vb = mk8(o.vq[it].x, o.vq[it].y, 0u, 0u);
        f32x4 U = {0.f, 0.f, 0.f, 0.f}, Y = {0.f, 0.f, 0.f, 0.f};
        U = __builtin_amdgcn_mfma_f32_16x16x32_bf16(o.ta[0], xb[0], U, 0, 0, 0); Y = __builtin_amdgcn_mfma_f32_16x16x32_bf16(o.gh[0], xb[0], Y, 0, 0, 0);
        U = __builtin_amdgcn_mfma_f32_16x16x32_bf16(o.ta[1], xb[1], U, 0, 0, 0); Y = __builtin_amdgcn_mfma_f32_16x16x32_bf16(o.gh[1], xb[1], Y, 0, 0, 0);
        U = __builtin_amdgcn_mfma_f32_16x16x32_bf16(tmf, vb, U, 0, 0, 0);       Y = __builtin_amdgcn_mfma_f32_16x16x32_bf16(nf, vb, Y, 0, 0, 0);
        const bf16x8 uvb = mk8(pk2c(U[0], U[1]), pk2c(U[2], U[3]), o.vq[it].x, o.vq[it].y);
#pragma unroll
        for (int jb = 0; jb < 4; ++jb) X[jb][it] = __builtin_amdgcn_mfma_f32_16x16x32_bf16(o.wbk[jb], uvb, X[jb][it] * o.wl[jb], 0, 0, 0);
#pragma unroll
        for (int q = 0; q < 4; ++q) ysb[(long)(4 * g + q) * rs + 16 * it + r] = Y[q];
    }
}
__device__ __forceinline__ void rwkv_scan_chunked(Frame& F, int chain, int half) {
    unsigned char* ws = F.ws; asm volatile("" : "+s"(ws)); const int dir = chain & 1, h = (chain >> 1) & 7, b = chain >> 4; const int lane = F.lane;
    const unsigned char* rec0 = ws + SC_CREC + (size_t)chain * 256 * CR_BYTES;
#ifdef DBG_RWCHK
    float* YS = (float*)(ws + WS_HN) + (size_t)dir * NTOK * 512;
#else
    float* YS = (float*)(ws + SC_YS) + (size_t)dir * NTOK * 512;
#endif
    f32x4 X[4][2];
#pragma unroll
    for (int jb = 0; jb < 4; ++jb) { X[jb][0] = (f32x4){0.f, 0.f, 0.f, 0.f}; X[jb][1] = (f32x4){0.f, 0.f, 0.f, 0.f}; }
    RwOps oa, ob;
    rw_load(oa, rec0, lane, half);
    const long rs = dir ? -512 : 512;
    for (int c = 0; c < 256; c += 2) {
        rw_load(ob, rec0 + (size_t)(c + 1) * CR_BYTES, lane, half);
        { const int pos0 = dir ? (SEQ - 1 - 16 * c) : 16 * c; rw_step(oa, X, YS + (size_t)(b * SEQ + pos0) * 512 + h * 64 + half * 32, rs, lane); }
        if (c + 2 < 256) rw_load(oa, rec0 + (size_t)(c + 2) * CR_BYTES, lane, half);
        { const int pos0 = dir ? (SEQ - 1 - 16 * (c + 1)) : 16 * (c + 1); rw_step(ob, X, YS + (size_t)(b * SEQ + pos0) * 512 + h * 64 + half * 32, rs, lane); }
    }
}

__device__ __forceinline__ void rwkv_scan_ring(Frame& F, int pair) {
    unsigned char* ws = F.ws; asm volatile("" : "+s"(ws));
    const int w = F.wave, lane = F.lane;
    LAS unsigned char* ring = F.lds;
    __syncthreads();
    if (w < 4) {
        const int chain = pair * 2 + (w >> 1), half = w & 1; const int dir = chain & 1, h = (chain >> 1) & 7, b = chain >> 4;
        float* YS = (float*)(ws + SC_YS) + (size_t)dir * NTOK * 512;
        f32x4 X[4][2];
#pragma unroll
        for (int jb = 0; jb < 4; ++jb) { X[jb][0] = (f32x4){0.f, 0.f, 0.f, 0.f}; X[jb][1] = (f32x4){0.f, 0.f, 0.f, 0.f}; }
        const long rs = dir ? -512 : 512;
        __syncthreads();
#pragma unroll 1
        for (int c = 0; c < 256; ++c) {
            RwOps o; rw_load(o, (const LAS unsigned char*)(ring + ((w >> 1) * 2 + (c & 1)) * CR_BYTES), lane, half);
            const int pos0 = dir ? (SEQ - 1 - 16 * c) : 16 * c; rw_step(o, X, YS + (size_t)(b * SEQ + pos0) * 512 + h * 64 + half * 32, rs, lane);
            __syncthreads();
        }
    } else {
        const int k = (w - 4) >> 1, part = (w - 4) & 1; const int chain = pair * 2 + k;
        const unsigned char* rec0 = ws + SC_CREC + (size_t)chain * 256 * CR_BYTES;
        LAS unsigned char* dst0 = ring + (k * 2) * CR_BYTES;
        const int i0 = (part * 64 + lane) * 16;
        u32x4 R0[6], R1[6], R2[6], R3[6], R4[6], R5[6];
#define RW_LD(R, cc) do { const unsigned char* p_ = rec0 + (size_t)(cc) * CR_BYTES + i0; _Pragma("unroll") for (int j = 0; j < 6; ++j) if (j < 5 || i0 + 2048 * 5 < CR_BYTES) R[j] = *(const u32x4*)(p_ + 2048 * j); } while (0)
#define RW_ST(R, cc) do { LAS unsigned char* d_ = dst0 + ((cc) & 1) * CR_BYTES + i0; _Pragma("unroll") for (int j = 0; j < 6; ++j) if (j < 5 || i0 + 2048 * 5 < CR_BYTES) *(LAS u32x4*)(d_ + 2048 * j) = R[j]; } while (0)
#define RW_STEP(R, cc) do { RW_ST(R, cc); if ((cc) + 6 < 256) RW_LD(R, (cc) + 6); __syncthreads(); } while (0)
        RW_LD(R0, 0); RW_LD(R1, 1); RW_LD(R2, 2); RW_LD(R3, 3); RW_LD(R4, 4); RW_LD(R5, 5);
        RW_ST(R0, 0); RW_LD(R0, 6);
        __syncthreads();
#pragma unroll 1
        for (int c = 1; c < 253; c += 6) { RW_STEP(R1, c); RW_STEP(R2, c + 1); RW_STEP(R3, c + 2); RW_STEP(R4, c + 3); RW_STEP(R5, c + 4); RW_STEP(R0, c + 5); }
        RW_STEP(R1, 253); RW_STEP(R2, 254); RW_STEP(R3, 255);
        __syncthreads();
#undef RW_STEP
#undef RW_LD
#undef RW_ST
    }
}

__device__ __forceinline__ void rwkv_scan_naive(Frame& F, int chain) {
    unsigned char* ws = F.ws; const float* RW = (const float*)(ws + SC_RW); const size_t N1 = (size_t)NTOK * 512;
    const int dir = chain & 1, h = (chain >> 1) & 7, b = chain >> 4;
    const float* Rp = RW; const float* Vp = RW + N1; const float* KKp = RW + 2 * N1; const float* Wp = RW + (3 + dir) * N1; const float* KMp = RW + (5 + dir) * N1; const float* BBp = RW + (7 + dir) * N1;
    float* YS = (float*)(ws + SC_YS) + (size_t)dir * N1;
    LAS float* L = (LAS float*)(F.lds + F.wave * 2048);
    float st[64];
#pragma unroll
    for (int j = 0; j < 64; ++j) st[j] = 0.f;
    size_t idx = (size_t)(b * SEQ + (dir ? SEQ - 1 : 0)) * 512 + h * 64 + F.lane;
    float va = -KKp[idx], vw = __expf(Wp[idx]), vb = BBp[idx], vk = KMp[idx], vr = Rp[idx], vv = Vp[idx];
    for (int t = 0; t < SEQ; ++t) {
        L[F.lane] = va; L[64 + F.lane] = vw; L[128 + F.lane] = vb; L[192 + F.lane] = vk; L[256 + F.lane] = vr;
        const float v = vv; const size_t oidx = idx;
        if (t + 1 < SEQ) { idx = dir ? idx - 512 : idx + 512; va = -KKp[idx]; vw = __expf(Wp[idx]); vb = BBp[idx]; vk = KMp[idx]; vr = Rp[idx]; vv = Vp[idx]; }
        LDS_WAIT(); asm volatile("" ::: "memory");
        float sa0 = 0.f, sa1 = 0.f, sa2 = 0.f, sa3 = 0.f;
#pragma unroll
        for (int j = 0; j < 64; j += 4) { const f32x4 x = *(const LAS f32x4*)(L + j); sa0 += st[j] * x[0]; sa1 += st[j + 1] * x[1]; sa2 += st[j + 2] * x[2]; sa3 += st[j + 3] * x[3]; }
        const float sa = (sa0 + sa1) + (sa2 + sa3);
        float y0 = 0.f, y1 = 0.f, y2 = 0.f, y3 = 0.f;
#pragma unroll
        for (int j = 0; j < 64; j += 4) { const f32x4 w4 = *(const LAS f32x4*)(L + 64 + j), b4 = *(const LAS f32x4*)(L + 128 + j), k4 = *(const LAS f32x4*)(L + 192 + j), r4 = *(const LAS f32x4*)(L + 256 + j);
            st[j] = st[j] * w4[0] + (sa * b4[0] + v * k4[0]); st[j + 1] = st[j + 1] * w4[1] + (sa * b4[1] + v * k4[1]); st[j + 2] = st[j + 2] * w4[2] + (sa * b4[2] + v * k4[2]); st[j + 3] = st[j + 3] * w4[3] + (sa * b4[3] + v * k4[3]);
            y0 += st[j] * r4[0]; y1 += st[j + 1] * r4[1]; y2 += st[j + 2] * r4[2]; y3 += st[j + 3] * r4[3]; }
        YS[oidx] = (y0 + y1) + (y2 + y3);
        asm volatile("" ::: "memory");
    }
}

__device__ __forceinline__ void s5_unit(Frame& F, ArgsP a, int layer, int unit) {
    unsigned char* ws = F.ws; asm volatile("" : "+s"(ws)); const bf16* Z = (const bf16*)(ws + SC_Z);
    const int b = unit / S5NCH, ch = unit % S5NCH; const int tok0 = b * SEQ + ch * S5CH;
    LAS float* ybuf = (LAS float*)F.lds;
    LAS unsigned short* gla = (LAS unsigned short*)(F.lds + 32768);
    LAS unsigned short* xa = (LAS unsigned short*)(F.lds + 49408 + F.wave * 4352);
    LAS float* ulw = (LAS float*)(F.lds + RING_BYTES + F.wave * 1024);
    const float* ab = (const float*)(ws + WS_S5P + layer * S5P_LAYER); const float* bb = ab + 2 * 32 * 64 * 2;
    const float* carry = (const float*)(ws + SC_CARRY);
    const int n = F.lane, r = n & 15, g4 = n >> 4;
    __syncthreads();
    for (int gi = 0; gi < 4; ++gi) {
        const int g = gi * 8 + F.wave;
        { const int tl = (n >> 1) & 15, hf = n & 1; const u32x4 w0 = *(const u32x4*)(Z + (size_t)(tok0 + tl) * ZLD + ZD + g * 16 + hf * 8);
          if (n < 32) { LAS f32x4* d = (LAS f32x4*)(ulw + tl * 16 + hf * 8);
            d[0] = (f32x4){__uint_as_float(w0.x << 16), __uint_as_float(w0.x & 0xffff0000u), __uint_as_float(w0.y << 16), __uint_as_float(w0.y & 0xffff0000u)};
            d[1] = (f32x4){__uint_as_float(w0.z << 16), __uint_as_float(w0.z & 0xffff0000u), __uint_as_float(w0.w << 16), __uint_as_float(w0.w & 0xffff0000u)}; } }
        float abr2[2], abi2[2], cr2[2], ci2[2];
#pragma unroll
        for (int dir = 0; dir < 2; ++dir) { const int pr = (dir * 32 + g) * 64 + n; abr2[dir] = ab[pr * 2]; abi2[dir] = ab[pr * 2 + 1];
            const float* cp = carry + ((((size_t)dir * BATCH + b) * S5NCH + ch) * 32 + g) * 128 + n * 2; cr2[dir] = cp[0]; ci2[dir] = cp[1]; }
        bf16x8 cwf[4];
        { const bf16* cw = (const bf16*)(ws + WS_S5CW) + ((size_t)(layer * 32 + g) * 16 + r) * 128 + g4 * 8;
#pragma unroll
          for (int ks = 0; ks < 4; ++ks) cwf[ks] = *(const bf16x8*)(cw + ks * 32); }
        LDS_WAIT(); asm volatile("" ::: "memory");
        float xfr[16], xfi[16];
#pragma unroll
        for (int dir = 0; dir < 2; ++dir) {
            const int pr = (dir * 32 + g) * 64 + n; const float abr = abr2[dir], abi = abi2[dir];
            float bbr[16], bbi[16];
            { const f32x4* bp = (const f32x4*)(bb + (size_t)pr * 32);
#pragma unroll
              for (int c4 = 0; c4 < 8; ++c4) { const f32x4 q = bp[c4]; bbr[c4 * 2] = q[0]; bbi[c4 * 2] = q[1]; bbr[c4 * 2 + 1] = q[2]; bbi[c4 * 2 + 1] = q[3]; } }
            float xr = cr2[dir], xi = ci2[dir];
#pragma unroll
            for (int i = 0; i < S5CH; ++i) { const int tl = dir ? (S5CH - 1 - i) : i;
                const f32x4 u0 = *(const LAS f32x4*)(ulw + tl * 16), u1 = *(const LAS f32x4*)(ulw + tl * 16 + 4), u2 = *(const LAS f32x4*)(ulw + tl * 16 + 8), u3 = *(const LAS f32x4*)(ulw + tl * 16 + 12);
                float br = 0.f, bi = 0.f;
#pragma unroll
                for (int c = 0; c < 4; ++c) { br += bbr[c] * u0[c] + bbr[4 + c] * u1[c] + bbr[8 + c] * u2[c] + bbr[12 + c] * u3[c]; bi += bbi[c] * u0[c] + bbi[4 + c] * u1[c] + bbi[8 + c] * u2[c] + bbi[12 + c] * u3[c]; }
                const float nr = abr * xr - abi * xi + br, ni = abr * xi + abi * xr + bi; xr = nr; xi = ni;
                if (dir == 0) { xfr[tl] = xr; xfi[tl] = xi; }
                else { xa[tl * 136 + n] = f2bf(xfr[tl] + xr); xa[tl * 136 + 64 + n] = f2bf(xfi[tl] + xi); }
                if ((i & 3) == 3) asm volatile("" ::: "memory"); }
        }
        LDS_WAIT(); asm volatile("" ::: "memory");
        { f32x4 y = {0.f, 0.f, 0.f, 0.f};
#pragma unroll
          for (int ks = 0; ks < 4; ++ks) { const bf16x8 af = *(const LAS bf16x8*)(xa + r * 136 + ks * 32 + g4 * 8); y = __builtin_amdgcn_mfma_f32_16x16x32_bf16(af, cwf[ks], y, 0, 0, 0); }
          const float dsk = a->in[I_S5_D][(size_t)layer * 512 + g * 16 + r];
#pragma unroll
          for (int q = 0; q < 4; ++q) { const int tl = 4 * g4 + q; const float yy = y[q] + dsk * ulw[tl * 16 + r];
              const float x3 = yy * yy * yy; const float gl = 0.5f * yy * (1.f + tanhf(0.7978845608028654f * (yy + 0.044715f * x3)));
              ybuf[tl * 512 + g * 16 + r] = gl; gla[tl * 520 + g * 16 + r] = f2bf(gl); } }
        LDS_WAIT(); asm volatile("" ::: "memory");
    }
    __syncthreads();
    { f32x4 acc[4];
#pragma unroll
      for (int j = 0; j < 4; ++j) acc[j] = (f32x4){0.f, 0.f, 0.f, 0.f};
      const bf16* wt = (const bf16*)(ws + WS_GLUT) + (size_t)layer * 512 * 512 + (size_t)(F.wave * 64 + r) * 512 + g4 * 8;
#pragma unroll 1
      for (int k0 = 0; k0 < 16; k0 += 4) { bf16x8 bf_[4][4];
#pragma unroll
          for (int kk = 0; kk < 4; ++kk)
#pragma unroll
              for (int j = 0; j < 4; ++j) bf_[kk][j] = *(const bf16x8*)(wt + (size_t)j * 16 * 512 + (k0 + kk) * 32);
#pragma unroll
          for (int kk = 0; kk < 4; ++kk) { const bf16x8 af = *(const LAS bf16x8*)(gla + r * 520 + (k0 + kk) * 32 + g4 * 8);
#pragma unroll
              for (int j = 0; j < 4; ++j) acc[j] = __builtin_amdgcn_mfma_f32_16x16x32_bf16(af, bf_[kk][j], acc[j], 0, 0, 0); } }
#pragma unroll
      for (int j = 0; j < 4; ++j) { const int c = F.wave * 64 + j * 16 + r; const float bias = a->in[I_S5_GLU_B][(size_t)layer * 512 + c];
#pragma unroll
          for (int q = 0; q < 4; ++q) { const int tl = 4 * g4 + q; const float gl = ybuf[tl * 512 + c]; ybuf[tl * 512 + c] = gl * sigmoidf_(acc[j][q] + bias); } } }
    __syncthreads();
    { const float* gn = a->in[I_MIX_OUT_NORM] + ((size_t)layer * 2 + 1) * 512; bf16* MIX = (bf16*)(ws + WS_MIX);
#pragma unroll
      for (int q = 0; q < 2; ++q) { const int tl = F.wave * 2 + q; float v[8]; float s = 0.f;
#pragma unroll
          for (int j = 0; j < 8; ++j) { v[j] = ybuf[tl * 512 + j * 64 + F.lane]; s += v[j] * v[j]; }
          const float rstd = 1.f / sqrtf(wave_sum(s) * (1.f / 512.f) + RMS_EPS);
#pragma unroll
          for (int j = 0; j < 8; ++j) MIX[(size_t)(tok0 + tl) * DM + 1536 + j * 64 + F.lane] = f2bf(v[j] * rstd * gn[j * 64 + F.lane]); } }
}

template <int mask>
__device__ __forceinline__ void mix_phase(Frame& F, ArgsP a, int layer, const int rep) {
    const int qb_ = (rep * 2 + layer) * 8;
    constexpr int NB = 16, NA = BATCH * 4 * (SEQ / 128), NC = BATCH * 4 * 48, ND = BATCH * S5NCH;
    if (mask & 1) for (;;) { const int it = q_next(F, qb_ + 1); if (it >= NB) break; rwkv_scan_ring(F, it); }
    if (mask & 2) for (;;) { const int it = q_next(F, qb_ + 2); if (it >= NA) break;
        unsigned char* ws = F.ws; asm volatile("" : "+s"(ws)); const bf16* Z = (const bf16*)(ws + SC_Z);
        const int qb = it % (SEQ / 128), h = (it / (SEQ / 128)) % 4, b = it / (4 * (SEQ / 128));
        const bf16* zb = Z + (size_t)(b * SEQ) * ZLD + ZA;
        float lam, lam_init;
        { const float* lv = a->in[I_DIFF_LAMBDA] + (size_t)layer * 4 * 64; float d1 = 0.f, d2 = 0.f;
          for (int i = 0; i < 64; ++i) { d1 += lv[i] * lv[64 + i]; d2 += lv[128 + i] * lv[192 + i]; }
          lam_init = 0.8f - 0.6f * expf(-0.3f * (float)layer); lam = expf(d1) - expf(d2) + lam_init; }
        att::diff_attn_unit(zb + (size_t)(qb * 128) * ZLD + h * 128, zb + 512 + h * 128, zb + 1024 + h * 128, ZLD, SEQ,
                            (bf16*)(ws + WS_MIX) + (size_t)(b * SEQ + qb * 128) * DM + h * 128, DM, lam, 1.f - lam_init, a->in[I_DIFF_SUBLN] + (size_t)layer * 128, (char*)F.lds, F.wave); }
#ifdef DBG_RWCHK
    for (;;) { const int it = q_next(F, layer * 8 + 5); if (it >= 4) break; rwkv_scan_naive(F, it * 8 + F.wave); }
#endif
    if (mask & 8) for (;;) { const int it = q_next(F, qb_ + 4); if (it >= ND) break; s5_unit(F, a, layer, it); }
    if (mask & 4) for (;;) { const int it = q_next(F, qb_ + 3); if (it >= NC) break;
        unsigned char* ws = F.ws; asm volatile("" : "+s"(ws)); const bf16* Z = (const bf16*)(ws + SC_Z);
        const int r = it % 48, h = (it / 48) % 4, b = it / (48 * 4); const int p = r / 16, rr = r % 16;
        const int dil = p == 0 ? 1 : (p == 1 ? 4 : 16); const int L = SEQ / dil; const int nqb = L / 256; const int rho = rr / nqb, qb = rr % nqb;
        const bf16* zb = Z + (size_t)(b * SEQ) * ZLD + ZC;
        att::dil_attn_unit(zb + h * 128, zb + 512 + h * 128, zb + 1024 + h * 128, ZLD, dil, rho, qb * 256, L,
                           (float*)(ws + SC_OC) + ((size_t)p * NTOK + (size_t)b * SEQ) * 512 + h * 128, (float*)(ws + SC_LSE) + ((size_t)p * NTOK + (size_t)b * SEQ) * 4 + h, (char*)F.lds, F.wave); }
}

__device__ __forceinline__ void post_phase(Frame& F, ArgsP a, int layer) {
    unsigned char* ws = F.ws; bf16* MIX = (bf16*)(ws + WS_MIX);
    const int gw = F.bid * 8 + F.wave, NGW = F.G * 8;
    const float* RW = (const float*)(ws + SC_RW); const size_t N1 = (size_t)NTOK * 512; const float* YS = (const float*)(ws + SC_YS);
#ifdef DBG_RWCHK
    { const float* Y2 = (const float*)(ws + WS_HN); float e = 0.f, r2 = 0.f; int bad = 0;
      for (size_t i = (size_t)F.bid * 512 + F.tid; i < (size_t)2 * NTOK * 512; i += (size_t)F.G * 512) { const float a0 = ((const float*)(ws + SC_YS))[i], b0 = Y2[i]; const float d = fabsf(a0 - b0); if (!(d < 1e30f)) bad = 1; else e = fmaxf(e, d); r2 = fmaxf(r2, fabsf(a0)); }
      e = wave_max(e); r2 = wave_max(r2); bad = __any(bad) ? 1 : 0;
      if (F.lane == 0) { atomicMax(F.ctl + 32768 + layer * 64, __float_as_uint(e)); atomicMax(F.ctl + 32768 + layer * 64 + 1, __float_as_uint(r2)); if (bad) atomicMax(F.ctl + 32768 + layer * 64 + 2, 1u); } }
#endif
    for (int tok = gw; tok < NTOK; tok += NGW) {
        float y[8], r_[8], v_[8], kb[8], gg[8];
#pragma unroll
        for (int h = 0; h < 8; ++h) { const size_t o = (size_t)tok * 512 + h * 64 + F.lane; y[h] = YS[o] + YS[N1 + o]; r_[h] = RW[o]; v_[h] = RW[N1 + o]; kb[h] = 0.5f * (RW[5 * N1 + o] + RW[6 * N1 + o]); gg[h] = RW[9 * N1 + o]; }
#pragma unroll
        for (int h = 0; h < 8; ++h) { const int c = h * 64 + F.lane;
            const float mean = wave_sum(y[h]) * (1.f / 64.f); const float d = y[h] - mean; const float var = wave_sum(d * d) * (1.f / 64.f);
            const float yn = d * (1.f / sqrtf(var + 64e-5f)) * a->in[I_RWKV_LNX_W][(size_t)layer * 512 + c] + a->in[I_RWKV_LNX_B][(size_t)layer * 512 + c];
            const float bon = wave_sum(r_[h] * kb[h] * a->in[I_RWKV_RK][(size_t)layer * 512 + c]) * v_[h];
            MIX[(size_t)tok * DM + 512 + c] = f2bf((yn + bon) * gg[h]); } }
    const float* OC = (const float*)(ws + SC_OC); const float* LSE = (const float*)(ws + SC_LSE); const float* gn = a->in[I_MIX_OUT_NORM] + ((size_t)layer * 2 + 0) * 512;
    for (int tok = gw; tok < NTOK; tok += NGW) { const int h = F.lane >> 4;
        const float l0 = LSE[((size_t)0 * NTOK + tok) * 4 + h], l1 = LSE[((size_t)1 * NTOK + tok) * 4 + h], l2 = LSE[((size_t)2 * NTOK + tok) * 4 + h];
        const float m = fmaxf(l0, fmaxf(l1, l2)); float w0 = __expf(l0 - m), w1 = __expf(l1 - m), w2 = __expf(l2 - m); const float inv = 1.f / (w0 + w1 + w2); w0 *= inv; w1 *= inv; w2 *= inv;
        float v[8]; float s = 0.f;
        const f32x4* p0 = (const f32x4*)(OC + ((size_t)0 * NTOK + tok) * 512) + F.lane * 2; const f32x4* p1 = (const f32x4*)(OC + ((size_t)1 * NTOK + tok) * 512) + F.lane * 2; const f32x4* p2 = (const f32x4*)(OC + ((size_t)2 * NTOK + tok) * 512) + F.lane * 2;
#pragma unroll
        for (int j = 0; j < 2; ++j) { const f32x4 a0 = p0[j], a1 = p1[j], a2 = p2[j];
#pragma unroll
            for (int e = 0; e < 4; ++e) { const float x = w0 * a0[e] + w1 * a1[e] + w2 * a2[e]; v[j * 4 + e] = x; s += x * x; } }
        const float rstd = 1.f / sqrtf(wave_sum(s) * (1.f / 512.f) + RMS_EPS);
        const f32x4 g0 = *((const f32x4*)gn + F.lane * 2), g1 = *((const f32x4*)gn + F.lane * 2 + 1);
        u32x4 w; w.x = pk2(v[0] * rstd * g0[0], v[1] * rstd * g0[1]); w.y = pk2(v[2] * rstd * g0[2], v[3] * rstd * g0[3]); w.z = pk2(v[4] * rstd * g1[0], v[5] * rstd * g1[1]); w.w = pk2(v[6] * rstd * g1[2], v[7] * rstd * g1[3]);
        *(u32x4*)(MIX + (size_t)tok * DM + 1024 + F.lane * 8) = w; }
}

#ifndef MK_FUSED
#define MK_FUSED 1
#endif
__global__ void __launch_bounds__(512, 2) enc_fwd(Args args_) {
    extern __shared__ __attribute__((aligned(16))) unsigned char lds_raw[];
    Frame F;
    F.lds = (LAS unsigned char*)lds_raw; F.MISC = (volatile LAS unsigned*)(F.lds + MISC_OFF);
    F.tid = threadIdx.x; F.lane = F.tid & 63; F.wave = __builtin_amdgcn_readfirstlane(F.tid >> 6); F.G = gridDim.x; F.bid = blockIdx.x;
    const int wave0 = F.wave;
    ArgsP ap = (ArgsP)__builtin_amdgcn_kernarg_segment_ptr();
    unsigned char* ws = ap->ws; F.ws = ws; F.ctl = (unsigned*)(ws + WS_CTL);
    for (int u = F.tid; u < (LDS_BYTES - MISC_OFF) / 4; u += 512) ((LAS unsigned*)(F.lds + MISC_OFF))[u] = 0u;
    __syncthreads();
    const int lo = ap->ph_lo, hi = ap->ph_hi;
    if (hi - lo > 1) (void)xcd_barrier_post(F.ctl + CW_BAR, F.MISC + 8);
#ifdef DBG_ONLY
#define IN(k) (((k) < PH_L0 ? (k) : ((k) == PH_FINAL ? 100 : 3 + ((k) - PH_L0) % NPH_L)) == DBG_ONLY && lo <= (k) && (k) < hi)
#else
#define IN(k) ({ int lo_ = lo, hi_ = hi; asm volatile("" : "+s"(lo_), "+s"(hi_)); lo_ <= (k) && (k) < hi_; })
#endif
#define args (*ap)
#define REFRESH() do { int wv_ = wave0, bi_ = blockIdx.x, gg_ = gridDim.x; asm volatile("" : "+s"(wv_), "+s"(bi_), "+s"(gg_)); const int t_ = tid_from_wave(wv_); F.tid = t_; F.lane = t_ & 63; F.wave = wv_; F.bid = bi_; F.G = gg_; ap = (ArgsP)__builtin_amdgcn_kernarg_segment_ptr(); asm volatile("" : "+s"(ap)); unsigned char* w_ = ap->ws; F.ws = w_; ws = w_; F.ctl = (unsigned*)(w_ + WS_CTL); } while (0)
#ifndef DBG_MIXMASK
#define DBG_MIXMASK 15
#endif
#ifndef DBG_REP_CODE
#define DBG_REP_CODE -1
#define DBG_REP_N 0
#endif
#define REPS(code) (((code) == DBG_REP_CODE && l_ == 0) ? 1 + DBG_REP_N : 1)
#ifdef DBG_TIME_A
#define STAMP(k) do { if (blockIdx.x == 0 && threadIdx.x == 0) { const unsigned long long t_ = wall_clock64(); F.MISC[192 + 2 * (k)] = (unsigned)t_; F.MISC[193 + 2 * (k)] = (unsigned)(t_ >> 32); } } while (0)
#else
#define STAMP(k) do {} while (0)
#endif
#define SEAM(k) do { if (IN(k) && IN((k) + 1)) { XcdBarrier b_; b_.bar = (unsigned*)(ap->ws + WS_CTL) + CW_BAR; b_.x = xb_xcc_id(); b_.st = F.MISC + 8; xcd_barrier(b_); } } while (0)

    { const int l_ = 0; STAMP(PH_P0); if (IN(PH_P0)) { REFRESH(); for (int rep = 0; rep < REPS(0); ++rep) p0_prologue(F, ap); } } SEAM(PH_P0);
    if (DBG_REP_CODE == 30 && hi - lo > 1) { for (int i = 0; i < 20; ++i) { XcdBarrier b_; b_.bar = (unsigned*)(ap->ws + WS_CTL) + CW_BAR; b_.x = xb_xcc_id(); b_.st = F.MISC + 8; xcd_barrier(b_); } }
    for (int l = 0; l < DEPTH; ++l) {
        const int pb = PH_L0 + l * NPH_L; const int l_ = l;
        float* H = (float*)(ws + WS_H);
        STAMP(pb + LP_NORM1); if (IN(pb + LP_NORM1)) { REFRESH(); if (l == 0) { for (int rep = 0; rep < REPS(22); ++rep) norm_phase<0>(F, ap, args.in[I_X], args.in[I_NORM_MIX], l); } else norm_phase<1>(F, ap, H, args.in[I_NORM_MIX] + (size_t)l * DM, l); } SEAM(pb + LP_NORM1);
        STAMP(pb + LP_G1); if (IN(pb + LP_G1)) { REFRESH();
            SchedG1P1 S{(const char*)(ws + WS_HN), (const char*)(ws + WS_WIN) + (size_t)l * ZLD * DM * 2, (char*)(ws + SC_Z), NTOK / 256, ZLD / 256, F.G, F.bid, l == 0 ? 64 : 0, ws};
            pg8::gemm_phase<EpiBf16U, SchedG1P1, false>(F.lds, pg8::GemmP{DM, DM, DM}, S, EpiBf16U{}, F.wave);
        } SEAM(pb + LP_G1);
        STAMP(pb + LP_PREP); if (IN(pb + LP_PREP)) { REFRESH(); for (int rep = 0; rep < REPS(11); ++rep) prep_phase(F, ap, l, rep); } SEAM(pb + LP_PREP);
        STAMP(pb + LP_CPREP); if (IN(pb + LP_CPREP)) { REFRESH(); cprep_phase(F, l);
            if (l == 0) {
                __syncthreads();
                { SchedXaPre S{ws, F.G, F.bid, 0}; pg8::gemm_phase<EpiBf16U, SchedXaPre, false>(F.lds, pg8::GemmP{512, 4096, DM}, S, EpiBf16U{}, F.wave); }
                { SchedXaPre S{ws, F.G, F.bid, 1}; pg8::gemm_phase<EpiBf16U, SchedXaPre, false>(F.lds, pg8::GemmP{512, DM, 4096}, S, EpiBf16U{}, F.wave); } } } SEAM(pb + LP_CPREP);
        STAMP(pb + LP_MIX); if (IN(pb + LP_MIX)) { REFRESH(); mix_phase<DBG_MIXMASK>(F, ap, l, 0); if (DBG_REP_CODE >= 13 && DBG_REP_CODE <= 16 && l_ == 0) { REFRESH(); mix_phase<(DBG_REP_CODE >= 13 && DBG_REP_CODE <= 16) ? (1 << (DBG_REP_CODE - 13)) : 1>(F, ap, l, 1); if (DBG_REP_N > 1) { REFRESH(); mix_phase<(DBG_REP_CODE >= 13 && DBG_REP_CODE <= 16) ? (1 << (DBG_REP_CODE - 13)) : 1>(F, ap, l, 2); } } } SEAM(pb + LP_MIX);
        STAMP(pb + LP_POST); if (IN(pb + LP_POST)) { REFRESH(); for (int rep = 0; rep < REPS(17); ++rep) post_phase(F, ap, l); } SEAM(pb + LP_POST);
        STAMP(pb + LP_G2); if (IN(pb + LP_G2)) { REFRESH();
            SchedDense S{(const char*)(ws + WS_MIX), (const char*)(ws + WS_WOUT) + (size_t)l * DM * DM * 2, (char*)H, NTOK / 256, DM / 256, F.G, F.bid, DM, DM, DM * 4, 4};
            for (int rep = 0; rep < REPS(23); ++rep) pg8::gemm_phase<pg8::EpiF32Res, SchedDense, false>(F.lds, pg8::GemmP{DM, DM, DM}, S, pg8::EpiF32Res{DM, l == 0 ? args.in[I_X] : (const float*)H, H}, F.wave);
        } SEAM(pb + LP_G2);
        STAMP(pb + LP_NORM2); if (IN(pb + LP_NORM2)) { REFRESH(); for (int rep = 0; rep < REPS(18); ++rep) norm_phase<0>(F, ap, H, args.in[I_NORM_CROSS] + (size_t)l * DM, l); } SEAM(pb + LP_NORM2);
        STAMP(pb + LP_GS); if (IN(pb + LP_GS)) { REFRESH();
            SchedBatch S{(const char*)(ws + WS_HN), (const char*)(ws + WS_WQK) + (size_t)l * 2 * 1024 * DM * 2, (char*)(ws + WS_P), (size_t)SEQ * DM * 2, (size_t)1024 * DM * 2, (size_t)SEQ * 1024 * 2, SEQ / 256, 4, BATCH, F.G, F.bid, DM, DM, 1024 * 2, 2, SEQ};
            for (int rep = 0; rep < REPS(19); ++rep) pg8::gemm_phase<pg8::EpiSoftmax, SchedBatch, false>(F.lds, pg8::GemmP{DM, DM, DM}, S, pg8::EpiSoftmax{1024, 0.044194173824159216f * 1.4426950408889634f}, F.wave);
        } SEAM(pb + LP_GS);
        STAMP(pb + LP_GO); if (IN(pb + LP_GO)) { REFRESH();
            SchedBatch S{(const char*)(ws + WS_P), (const char*)(ws + WS_VWO) + (size_t)l * 2 * DM * 1024 * 2, (char*)H, (size_t)SEQ * 1024 * 2, (size_t)DM * 1024 * 2, (size_t)SEQ * DM * 4, SEQ / 256, DM / 256, BATCH, F.G, F.bid, 1024, 1024, DM * 4, 4, SEQ};
            pg8::gemm_phase<pg8::EpiF32Res, SchedBatch, false>(F.lds, pg8::GemmP{1024, 1024, 1024}, S, pg8::EpiF32Res{DM, (const float*)H, H}, F.wave);
        } SEAM(pb + LP_GO);
        STAMP(pb + LP_NORM3); if (IN(pb + LP_NORM3)) { REFRESH(); norm_phase<2>(F, ap, H, args.in[I_NORM_MOE] + (size_t)l * DM, l); } SEAM(pb + LP_NORM3);
        STAMP(pb + LP_M1); if (IN(pb + LP_M1)) { REFRESH();
            volatile LAS int* tp = (volatile LAS int*)(F.lds + MISC_OFF + 256); volatile LAS int* cnt = tp + 40;
            moe_prefix(F, l, tp, cnt);
            SchedMoe S{ws, tp, cnt, l, F.G, F.bid, 0};
            for (int rep = 0; rep < REPS(20); ++rep) pg8::gemm_phase<pg8::EpiSwiGlu, SchedMoe, true>(F.lds, pg8::GemmP{DM, DM, DM}, S, pg8::EpiSwiGlu{DEXP}, F.wave);
        } SEAM(pb + LP_M1);
        STAMP(pb + LP_M2); if (IN(pb + LP_M2)) { REFRESH();
            volatile LAS int* tp = (volatile LAS int*)(F.lds + MISC_OFF + 256); volatile LAS int* cnt = tp + 40;
            moe_prefix(F, l, tp, cnt);
            SchedMoe S{ws, tp, cnt, l, F.G, F.bid, 1};
            for (int rep = 0; rep < REPS(21); ++rep) pg8::gemm_phase<pg8::EpiGate, SchedMoe, false>(F.lds, pg8::GemmP{DEXP, DEXP, DEXP}, S, pg8::EpiGate{DM, (const float*)(ws + WS_EGATE), nullptr}, F.wave);
        } SEAM(pb + LP_M2);
    }
#ifdef DBG_TIME_A
    STAMP(PH_FINAL);
    if (blockIdx.x == 0 && threadIdx.x == 0) { const unsigned long long ta = ((unsigned long long)F.MISC[193 + 2 * (DBG_TIME_A)] << 32) | F.MISC[192 + 2 * (DBG_TIME_A)], tb = ((unsigned long long)F.MISC[193 + 2 * (DBG_TIME_B)] << 32) | F.MISC[192 + 2 * (DBG_TIME_B)];
        const unsigned long long dl = (tb - ta) * DBG_TIME_K; const unsigned long long t0_ = wall_clock64(); while (wall_clock64() - t0_ < dl) __builtin_amdgcn_s_sleep(8); }
    if (hi - lo > 1) { XcdBarrier b_; b_.bar = (unsigned*)(ap->ws + WS_CTL) + CW_BAR; b_.x = xb_xcc_id(); b_.st = F.MISC + 8; xcd_barrier(b_); }
#endif
    STAMP(PH_FINAL); if (IN(PH_FINAL)) { REFRESH(); norm_phase<5>(F, ap, (const float*)(ws + WS_H), args.in[I_NORM_FINAL], DEPTH); }
#undef IN
#undef SEAM
#undef args
}

extern "C" void kernel_launch(void* const* d_in, const int* in_sizes, int n_in, void* d_out, int out_size, void* d_ws, size_t ws_size, hipStream_t stream) {
    static int grid = 0;
    if (grid == 0) {
        if (n_in != N_INPUTS || out_size != NTOK * DM || ws_size < cmax(WS_END, SC_MIX_END3)) { fprintf(stderr, "kernel_launch: built for %d inputs, out %d, ws >= %zu; got %d, %d, %zu\n", N_INPUTS, NTOK * DM, cmax(WS_END, SC_MIX_END3), n_in, out_size, ws_size); grid = -1; return; }
        int dev = 0, cus = 0, per_cu = 0;
        if (hipGetDevice(&dev) != hipSuccess || hipDeviceGetAttribute(&cus, hipDeviceAttributeMultiprocessorCount, dev) != hipSuccess) { fprintf(stderr, "kernel_launch: device query failed\n"); grid = -1; return; }
        if (hipFuncSetAttribute((const void*)enc_fwd, hipFuncAttributeMaxDynamicSharedMemorySize, LDS_BYTES) != hipSuccess) { fprintf(stderr, "kernel_launch: hipFuncSetAttribute failed\n"); grid = -1; return; }
        if (hipOccupancyMaxActiveBlocksPerMultiprocessor(&per_cu, (const void*)enc_fwd, 512, LDS_BYTES) != hipSuccess || per_cu < 1) fprintf(stderr, "kernel_launch: occupancy query says %d blocks per CU\n", per_cu);
        grid = cus;
    }
    if (grid < 0) return;
    hipMemsetAsync((char*)d_ws + WS_CTL, 0, CTL_BYTES, stream);
    Args a; memset(&a, 0, sizeof(a));
    for (int i = 0; i < N_INPUTS; ++i) a.in[i] = (const float*)d_in[i];
    a.out = (float*)d_out; a.ws = (unsigned char*)d_ws;
#if MK_FUSED
    a.ph_lo = 0; a.ph_hi = NPHASES;
    hipLaunchKernelGGL(enc_fwd, dim3(grid), dim3(512), LDS_BYTES, stream, a);
#else
    for (int p = 0; p < NPHASES; ++p) { a.ph_lo = p; a.ph_hi = p + 1; hipLaunchKernelGGL(enc_fwd, dim3(grid), dim3(512), LDS_BYTES, stream, a); }
#endif
    const hipError_t le = hipPeekAtLastError();
    if (le != hipSuccess) fprintf(stderr, "kernel_launch: launch failed: %s\n", hipGetErrorName(le));
}
```
